# Optimizing an MI355X kernel written in HIP

```python
import math
import jax, jax.numpy as jnp
from jax import lax
import numpy as np

D_MODEL = 1024
BATCH = 4
SEQ = 8192
DEPTH = 2

N_AB_LAYERS = (DEPTH + 1) // 2
N_NSA_LAYERS = DEPTH // 2
DEEPNORM_ALPHA = (2.0 * DEPTH) ** 0.25
DEEPNORM_BETA = (8.0 * DEPTH) ** -0.25
LN_EPS = 1e-5

POOL_WIDTH = D_MODEL // 2
POOL_WINDOWS = (2, 4, 8, 16)
POOL_GROUP = POOL_WIDTH // len(POOL_WINDOWS)
CONV_CH = D_MODEL // 2
CONV_TAPS = 31
AB_IN = POOL_WIDTH + 2 * CONV_CH
AB_CAT = POOL_WIDTH + CONV_CH

N_HEADS = 16
HEAD_DIM = 64
N_KV_GROUPS = 4
HEADS_PER_GROUP = N_HEADS // N_KV_GROUPS
KV_WIDTH = N_KV_GROUPS * HEAD_DIM
CMP_BLOCK = 32
CMP_STRIDE = 16
CMP_HIDDEN = 128
SLC_BLOCK = 64
N_SELECT = 16
WINDOW = 512
Q_BLOCK = 128
N_BRANCH = 3
ROPE_THETA = 500000.0
ROPE_DIM = HEAD_DIM // 4
SLC_PER_CMP = SLC_BLOCK // CMP_STRIDE
SLC_OVERLAP_W = (1.0, 2.0, 2.0, 2.0, 1.0)
NSA_IN = N_HEADS * HEAD_DIM + 6 * KV_WIDTH + N_HEADS * N_BRANCH

N_EXPERTS = 256
TOP_K = 8
N_EXPERT_GROUPS = 8
TOPK_GROUPS = 4
EXPERT_FF = 256
SHARED_FF = 256
ROUTED_SCALE = 2.5
EXPERT_ROW_BLOCK = 128

kernel_name = "hybrid_pool_conv_nsa_moe_deepnorm"


def layer_norm(x, g, b):
    xf = x.astype(jnp.float32)
    mu = xf.mean(-1, keepdims=True)
    var = jnp.square(xf - mu).mean(-1, keepdims=True)
    y = (xf - mu) * lax.rsqrt(var + LN_EPS)
    return (y * g.astype(jnp.float32) + b.astype(jnp.float32)).astype(x.dtype)


def masked_softmax(s, mask):
    s = jnp.where(mask, s.astype(jnp.float32), -jnp.inf)
    m = jnp.max(s, -1, keepdims=True)
    m = jnp.where(jnp.isfinite(m), m, 0.0)
    e = jnp.exp(s - m)
    d = e.sum(-1, keepdims=True)
    return e / jnp.where(d > 0, d, 1.0)


def partial_rotary(x, pos):
    half = ROPE_DIM // 2
    inv_freq = jnp.power(jnp.float32(ROPE_THETA), -jnp.arange(0, ROPE_DIM, 2, dtype=jnp.float32) / ROPE_DIM)
    ang = pos.astype(jnp.float32)[:, None] * inv_freq[None, :]
    cos = jnp.cos(ang)[:, None, :]
    sin = jnp.sin(ang)[:, None, :]
    xf = x.astype(jnp.float32)
    x1, x2 = xf[..., :half], xf[..., half:ROPE_DIM]
    rot = jnp.concatenate([x1 * cos - x2 * sin, x2 * cos + x1 * sin], -1)
    return jnp.concatenate([rot.astype(x.dtype), x[..., ROPE_DIM:]], -1)


def causal_pool_minus_self(u, window):
    T = u.shape[1]
    uf = u.astype(jnp.float32)
    c = jnp.cumsum(uf, axis=1)
    prev = jnp.pad(c, ((0, 0), (window, 0), (0, 0)))[:, :T]
    count = jnp.minimum(jnp.arange(1, T + 1), window).astype(jnp.float32)
    return ((c - prev) / count[None, :, None] - uf).astype(u.dtype)


def pool_conv_mixer(x, w_in, pool_mix, pool_scale, conv_w, conv_b, conv_ln_g, conv_ln_b, w_out):
    B, T, _ = x.shape
    h = x @ w_in
    u = h[..., :POOL_WIDTH]
    val = h[..., POOL_WIDTH:POOL_WIDTH + CONV_CH]
    gate = h[..., POOL_WIDTH + CONV_CH:]
    p = jnp.stack([causal_pool_minus_self(u[..., gi * POOL_GROUP:(gi + 1) * POOL_GROUP], w)
                   for gi, w in enumerate(POOL_WINDOWS)], axis=2)
    a = jnp.einsum('btgc,gcd->btgd', p, pool_mix).reshape(B, T, POOL_WIDTH) * pool_scale
    v = val * jax.nn.sigmoid(gate)
    c = lax.conv_general_dilated(v, conv_w, window_strides=(1,), padding=((CONV_TAPS - 1, 0),),
                                 dimension_numbers=('NWC', 'WIO', 'NWC'),
                                 feature_group_count=CONV_CH) + conv_b
    c = jax.nn.silu(layer_norm(c, conv_ln_g, conv_ln_b))
    return jnp.concatenate([a, c], -1) @ w_out


def compress_blocks(kv, pos_emb, w1, w2):
    B, T, G, dh = kv.shape
    chunks = kv.reshape(B, T // CMP_STRIDE, CMP_STRIDE, G, dh)
    blocks = jnp.concatenate([chunks[:, :-1], chunks[:, 1:]], axis=2)
    blocks = blocks + pos_emb[None, None, :, None, :]
    nc = blocks.shape[1]
    flat = jnp.moveaxis(blocks, 3, 2).reshape(B, nc, G, CMP_BLOCK * dh)
    return jax.nn.gelu(flat @ w1) @ w2


def nsa_sequence(q, q_rot, kc, vc, ks, vs, kw, vw, gates):
    T = q.shape[0]
    nc = kc.shape[0]
    ns = T // SLC_BLOCK
    n_sel = min(N_SELECT, ns)
    n_qb = T // Q_BLOCK
    G, HPG, dh = N_KV_GROUPS, HEADS_PER_GROUP, HEAD_DIM
    scale = HEAD_DIM ** -0.5
    cmp_end = jnp.arange(nc) * CMP_STRIDE + CMP_BLOCK - 1
    blk_ids = jnp.arange(ns)
    ks_blocks = jnp.moveaxis(ks.reshape(ns, SLC_BLOCK, G, dh), 2, 0)
    vs_blocks = jnp.moveaxis(vs.reshape(ns, SLC_BLOCK, G, dh), 2, 0)
    kw_pad = jnp.pad(kw, ((WINDOW, 0), (0, 0), (0, 0)))
    vw_pad = jnp.pad(vw, ((WINDOW, 0), (0, 0), (0, 0)))
    right_pad = SLC_PER_CMP * ns + 1 - (nc + 1)
    grp = jnp.arange(G)[:, None, None]

    def block(qi):
        s0 = qi * Q_BLOCK
        t = s0 + jnp.arange(Q_BLOCK)
        qb = lax.dynamic_slice_in_dim(q, s0, Q_BLOCK, 0).reshape(Q_BLOCK, G, HPG, dh)
        qr = lax.dynamic_slice_in_dim(q_rot, s0, Q_BLOCK, 0).reshape(Q_BLOCK, G, HPG, dh)
        gb = lax.dynamic_slice_in_dim(gates, s0, Q_BLOCK, 0).reshape(Q_BLOCK, G, HPG, N_BRANCH)
        sc = jnp.einsum('qghd,ngd->ghqn', qb, kc) * scale
        pc = masked_softmax(sc, (cmp_end[None, :] <= t[:, None])[None, None])
        o_cmp = jnp.einsum('ghqn,ngd->qghd', pc, vc)
        imp_c = jnp.pad(pc.sum(1), ((0, 0), (0, 0), (1, right_pad)))
        imp = sum(SLC_OVERLAP_W[k] * imp_c[..., k:k + SLC_PER_CMP * ns:SLC_PER_CMP]
                  for k in range(len(SLC_OVERLAP_W)))
        cur = t // SLC_BLOCK
        forced = (blk_ids[None, :] == 0) | (blk_ids[None, :] == cur[:, None]) | (blk_ids[None, :] == cur[:, None] - 1)
        valid = blk_ids[None, :] * SLC_BLOCK <= t[:, None]
        imp = jnp.where(forced[None], jnp.inf, jnp.where(valid[None], imp, -jnp.inf))
        _, sel = lax.top_k(imp, n_sel)
        k_sel = ks_blocks[grp, sel]
        v_sel = vs_blocks[grp, sel].reshape(G, Q_BLOCK, n_sel * SLC_BLOCK, dh)
        tok = sel[..., None] * SLC_BLOCK + jnp.arange(SLC_BLOCK)
        m_sel = (tok <= t[None, :, None, None]).reshape(G, Q_BLOCK, n_sel * SLC_BLOCK)[:, None]
        ss = jnp.einsum('qghd,gqskd->ghqsk', qr, k_sel).reshape(G, HPG, Q_BLOCK, n_sel * SLC_BLOCK) * scale
        ps = masked_softmax(ss, m_sel)
        o_slc = jnp.einsum('ghqk,gqkd->qghd', ps, v_sel)
        kwb = lax.dynamic_slice_in_dim(kw_pad, s0, WINDOW + Q_BLOCK, 0)
        vwb = lax.dynamic_slice_in_dim(vw_pad, s0, WINDOW + Q_BLOCK, 0)
        kpos = s0 - WINDOW + jnp.arange(WINDOW + Q_BLOCK)
        dlt = t[:, None] - kpos[None, :]
        m_win = (dlt >= 0) & (dlt < WINDOW) & (kpos[None, :] >= 0)
        sw = jnp.einsum('qghd,kgd->ghqk', qr, kwb) * scale
        pw = masked_softmax(sw, m_win[None, None])
        o_win = jnp.einsum('ghqk,kgd->qghd', pw, vwb)
        o = gb[..., 0:1] * o_cmp + gb[..., 1:2] * o_slc + gb[..., 2:3] * o_win
        return o.reshape(Q_BLOCK, N_HEADS * HEAD_DIM).astype(q.dtype)

    return lax.map(block, jnp.arange(n_qb)).reshape(T, N_HEADS * HEAD_DIM)


def nsa_mixer(x, w_in, cmp_pos_k, cmp_w1_k, cmp_w2_k, cmp_pos_v, cmp_w1_v, cmp_w2_v, w_out):
    B, T, _ = x.shape
    h = x @ w_in
    splits = tuple(int(s) for s in np.cumsum([N_HEADS * HEAD_DIM] + [KV_WIDTH] * 6))
    q, kc, vc, ks, vs, kw, vw, g = jnp.split(h, splits, axis=-1)
    q = q.reshape(B, T, N_HEADS, HEAD_DIM)
    kv_shape = (B, T, N_KV_GROUPS, HEAD_DIM)
    kc, vc, ks, vs, kw, vw = (a.reshape(kv_shape) for a in (kc, vc, ks, vs, kw, vw))
    gates = jax.nn.sigmoid(g.astype(jnp.float32)).reshape(B, T, N_HEADS, N_BRANCH)
    pos = jnp.arange(T)
    q_rot = partial_rotary(q, pos)
    ks = partial_rotary(ks, pos)
    kw = partial_rotary(kw, pos)
    kc = compress_blocks(kc, cmp_pos_k, cmp_w1_k, cmp_w2_k)
    vc = compress_blocks(vc, cmp_pos_v, cmp_w1_v, cmp_w2_v)
    o = lax.map(lambda a: nsa_sequence(*a), (q, q_rot, kc, vc, ks, vs, kw, vw, gates))
    return o @ w_out


def moe_ffn(x, w_router, b_router, w_gate, w_up, w_down, ws_gate, ws_up, ws_down):
    B, T, D = x.shape
    N = B * T
    h = x.reshape(N, D)
    scores = jax.nn.sigmoid((h @ w_router).astype(jnp.float32))
    biased = scores + b_router.astype(jnp.float32)
    per_group = N_EXPERTS // N_EXPERT_GROUPS
    grp_score = lax.top_k(biased.reshape(N, N_EXPERT_GROUPS, per_group), 2)[0].sum(-1)
    _, top_grp = lax.top_k(grp_score, TOPK_GROUPS)
    grp_mask = (top_grp[..., None] == jnp.arange(N_EXPERT_GROUPS)).any(1)
    exp_mask = jnp.repeat(grp_mask, per_group, axis=1)
    _, idx = lax.top_k(jnp.where(exp_mask, biased, -jnp.inf), TOP_K)
    wts = jnp.take_along_axis(scores, idx, axis=1)
    wts = wts / wts.sum(-1, keepdims=True) * ROUTED_SCALE
    A = N * TOP_K
    M = EXPERT_ROW_BLOCK
    flat_e = idx.reshape(A)
    flat_tok = jnp.arange(A, dtype=jnp.int32) // TOP_K
    flat_w = wts.reshape(A)
    order = jnp.argsort(flat_e)
    sorted_e = flat_e[order]
    counts = jnp.bincount(flat_e, length=N_EXPERTS)
    padded = (counts + M - 1) // M * M
    start = jnp.cumsum(counts) - counts
    pend = jnp.cumsum(padded)
    pstart = pend - padded
    dest = pstart[sorted_e] + jnp.arange(A) - start[sorted_e]
    n_blocks = -(-(A + N_EXPERTS * (M - 1)) // M)
    P = n_blocks * M
    row_tok = jnp.zeros((P,), jnp.int32).at[dest].set(flat_tok[order])
    row_w = jnp.zeros((P,), jnp.float32).at[dest].set(flat_w[order])
    block_exp = jnp.minimum(jnp.searchsorted(pend, jnp.arange(n_blocks) * M, side='right'), N_EXPERTS - 1)

    def step(acc, blk):
        toks, rw, e = blk
        xb = h[toks]
        hid = jax.nn.silu(xb @ w_gate[e]) * (xb @ w_up[e])
        yb = (hid @ w_down[e]).astype(jnp.float32) * rw[:, None]
        return acc.at[toks].add(yb), None

    routed, _ = lax.scan(step, jnp.zeros((N, D), jnp.float32),
                         (row_tok.reshape(n_blocks, M), row_w.reshape(n_blocks, M), block_exp))
    shared = (jax.nn.silu(h @ ws_gate) * (h @ ws_up)) @ ws_down
    return (routed.astype(h.dtype) + shared).reshape(B, T, D)


def setup_inputs(seed: int = 0) -> dict:
    key = jax.random.key(seed)
    keys = iter(jax.random.split(key, 40))
    def nrm(shape, scale):
        return jax.random.normal(next(keys), shape, jnp.float32) * scale
    D = D_MODEL
    NA, NN = N_AB_LAYERS, N_NSA_LAYERS
    beta = DEEPNORM_BETA
    return {
        "x": nrm((BATCH, SEQ, D), 1.0),
        "ab_w_in": nrm((NA, D, AB_IN), D ** -0.5),
        "ab_pool_mix": nrm((NA, len(POOL_WINDOWS), POOL_GROUP, POOL_GROUP), POOL_GROUP ** -0.5),
        "ab_pool_scale": 1.0 + nrm((NA, POOL_WIDTH), 0.1),
        "ab_conv_w": nrm((NA, CONV_TAPS, 1, CONV_CH), CONV_TAPS ** -0.5),
        "ab_conv_b": nrm((NA, CONV_CH), 0.02),
        "ab_conv_ln_g": 1.0 + nrm((NA, CONV_CH), 0.05),
        "ab_conv_ln_b": nrm((NA, CONV_CH), 0.02),
        "ab_w_out": nrm((NA, AB_CAT, D), beta * AB_CAT ** -0.5),
        "nsa_w_in": nrm((NN, D, NSA_IN), D ** -0.5),
        "nsa_cmp_pos_k": nrm((NN, CMP_BLOCK, HEAD_DIM), 0.1),
        "nsa_cmp_w1_k": nrm((NN, CMP_BLOCK * HEAD_DIM, CMP_HIDDEN), (CMP_BLOCK * HEAD_DIM) ** -0.5),
        "nsa_cmp_w2_k": nrm((NN, CMP_HIDDEN, HEAD_DIM), CMP_HIDDEN ** -0.5),
        "nsa_cmp_pos_v": nrm((NN, CMP_BLOCK, HEAD_DIM), 0.1),
        "nsa_cmp_w1_v": nrm((NN, CMP_BLOCK * HEAD_DIM, CMP_HIDDEN), (CMP_BLOCK * HEAD_DIM) ** -0.5),
        "nsa_cmp_w2_v": nrm((NN, CMP_HIDDEN, HEAD_DIM), CMP_HIDDEN ** -0.5),
        "nsa_w_out": nrm((NN, N_HEADS * HEAD_DIM, D), beta * (N_HEADS * HEAD_DIM) ** -0.5),
        "ln_mix_g": 1.0 + nrm((DEPTH, D), 0.05),
        "ln_mix_b": nrm((DEPTH, D), 0.02),
        "ln_ffn_g": 1.0 + nrm((DEPTH, D), 0.05),
        "ln_ffn_b": nrm((DEPTH, D), 0.02),
        "moe_w_router": nrm((DEPTH, D, N_EXPERTS), D ** -0.5),
        "moe_b_router": nrm((DEPTH, N_EXPERTS), 0.01),
        "moe_w_gate": nrm((DEPTH, N_EXPERTS, D, EXPERT_FF), D ** -0.5),
        "moe_w_up": nrm((DEPTH, N_EXPERTS, D, EXPERT_FF), D ** -0.5),
        "moe_w_down": nrm((DEPTH, N_EXPERTS, EXPERT_FF, D), beta * EXPERT_FF ** -0.5),
        "moe_ws_gate": nrm((DEPTH, D, SHARED_FF), D ** -0.5),
        "moe_ws_up": nrm((DEPTH, D, SHARED_FF), D ** -0.5),
        "moe_ws_down": nrm((DEPTH, SHARED_FF, D), beta * SHARED_FF ** -0.5),
    }


def reference(x, ab_w_in, ab_pool_mix, ab_pool_scale, ab_conv_w, ab_conv_b, ab_conv_ln_g, ab_conv_ln_b,
              ab_w_out, nsa_w_in, nsa_cmp_pos_k, nsa_cmp_w1_k, nsa_cmp_w2_k, nsa_cmp_pos_v, nsa_cmp_w1_v,
              nsa_cmp_w2_v, nsa_w_out, ln_mix_g, ln_mix_b, ln_ffn_g, ln_ffn_b, moe_w_router, moe_b_router,
              moe_w_gate, moe_w_up, moe_w_down, moe_ws_gate, moe_ws_up, moe_ws_down):
    for i in range(DEPTH):
        j = i // 2
        if i % 2 == 0:
            mix = pool_conv_mixer(x, ab_w_in[j], ab_pool_mix[j], ab_pool_scale[j], ab_conv_w[j], ab_conv_b[j],
                                  ab_conv_ln_g[j], ab_conv_ln_b[j], ab_w_out[j])
        else:
            mix = nsa_mixer(x, nsa_w_in[j], nsa_cmp_pos_k[j], nsa_cmp_w1_k[j], nsa_cmp_w2_k[j],
                            nsa_cmp_pos_v[j], nsa_cmp_w1_v[j], nsa_cmp_w2_v[j], nsa_w_out[j])
        x = layer_norm(DEEPNORM_ALPHA * x + mix, ln_mix_g[i], ln_mix_b[i])
        ffn = moe_ffn(x, moe_w_router[i], moe_b_router[i], moe_w_gate[i], moe_w_up[i], moe_w_down[i],
                      moe_ws_gate[i], moe_ws_up[i], moe_ws_down[i])
        x = layer_norm(DEEPNORM_ALPHA * x + ffn, ln_ffn_g[i], ln_ffn_b[i])
    return x
```

```cpp
#include <hip/hip_runtime.h>
#include <cstdint>
#include <cstdio>
#include <cmath>

#ifndef MK_ONE_LAUNCH
#define MK_ONE_LAUNCH 0
#endif

#define LAS __attribute__((address_space(3)))
typedef unsigned short bf16_t;
typedef short bf16x8 __attribute__((ext_vector_type(8)));
typedef float f32x4 __attribute__((ext_vector_type(4)));
typedef unsigned u32x2 __attribute__((ext_vector_type(2)));
typedef unsigned u32x4 __attribute__((ext_vector_type(4)));

constexpr int NB = 4, T = 8192, D = 1024, M = NB * T;
constexpr int NE = 256, TOPK = 8, FF = 256;
constexpr int HNW = 2816;
constexpr int LISTCAP = 32768;
constexpr float ALPHA = 1.4142135623730951f;
constexpr float LN_EPS = 1e-5f;
constexpr float QSCALE = 0.125f * 1.4426950408889634f;
constexpr int NPHASE = 22;

constexpr size_t MiB = 1u << 20;
constexpr size_t WS_CTL = 0, CTL_BYTES = 1 * MiB;
constexpr size_t WS_X1 = 1 * MiB;
constexpr size_t WS_X2 = WS_X1 + 64 * MiB;
constexpr size_t WS_LOG = WS_X2 + 64 * MiB;
constexpr size_t WS_LIST = WS_LOG + 32 * MiB;
constexpr size_t WS_WTS = WS_LIST + 32 * MiB;
constexpr size_t WS_HID = WS_WTS + 2 * MiB;
constexpr size_t WS_YB = WS_HID + 184 * MiB;
constexpr size_t WS_END_NAIVE = WS_YB + 576 * MiB;
constexpr size_t WS_H0 = WS_YB;
constexpr size_t WS_PM = WS_H0 + 64 * MiB;
constexpr size_t WS_CAT = WS_PM + 32 * MiB;
constexpr size_t WS_Y = WS_CAT + 64 * MiB;
constexpr size_t WS_HN = WS_YB;
constexpr size_t WS_QR = WS_HN + 176 * MiB;
constexpr size_t WS_GATES = WS_QR + 64 * MiB;
constexpr size_t WS_CH1 = WS_GATES + 8 * MiB;
constexpr size_t WS_KC = WS_CH1 + 4 * MiB;
constexpr size_t WS_O = WS_KC + 2 * MiB;
constexpr size_t WS_Y2 = WS_O + 64 * MiB;
static_assert(WS_Y2 + 64 * MiB <= WS_END_NAIVE, "overlay");
static_assert(WS_Y + 64 * MiB <= WS_END_NAIVE, "overlay");

constexpr int CW_CNT = 64;
constexpr int CW_BAR = 4096;

constexpr int LDS_BYTES = 147456;

__device__ __forceinline__ float bf2f(bf16_t h) { return __uint_as_float(((unsigned)h) << 16); }
__device__ __forceinline__ bf16_t f2bf(float f) { unsigned u = __float_as_uint(f); return (bf16_t)((u + 0x7fffu + ((u >> 16) & 1u)) >> 16); }
__device__ __forceinline__ unsigned pk2(float lo, float hi) { return (unsigned)f2bf(lo) | ((unsigned)f2bf(hi) << 16); }
__device__ __forceinline__ float wave_sum(float v) {
#pragma unroll
    for (int o = 1; o < 64; o <<= 1) v += __shfl_xor(v, o);
    return v;
}
__device__ __forceinline__ float wave_max(float v) {
#pragma unroll
    for (int o = 1; o < 64; o <<= 1) v = fmaxf(v, __shfl_xor(v, o));
    return v;
}
__device__ __forceinline__ float sigmoidf_(float x) { return 1.0f / (1.0f + __expf(-x)); }
__device__ __forceinline__ float gelu_tanh(float x) {
    const float u = 0.7978845608028654f * (x + 0.044715f * x * x * x);
    const float e = __expf(2.0f * u);
    const float th = 1.0f - 2.0f / (e + 1.0f);
    return 0.5f * x * (1.0f + th);
}
__device__ __forceinline__ bf16x8 cvt8(const float* p) {
    const float4 a = *(const float4*)p, b = *(const float4*)(p + 4);
    bf16x8 r;
    r[0] = (short)f2bf(a.x); r[1] = (short)f2bf(a.y); r[2] = (short)f2bf(a.z); r[3] = (short)f2bf(a.w);
    r[4] = (short)f2bf(b.x); r[5] = (short)f2bf(b.y); r[6] = (short)f2bf(b.z); r[7] = (short)f2bf(b.w);
    return r;
}
__device__ __forceinline__ bf16x8 colk8(const float* W, int N, int k, int col) {
    bf16x8 r;
#pragma unroll
    for (int j = 0; j < 8; ++j) r[j] = (short)f2bf(W[(size_t)(k + j) * N + col]);
    return r;
}
__device__ __forceinline__ bf16x8 zero8() { return (bf16x8){0, 0, 0, 0, 0, 0, 0, 0}; }
#define WSYNC() asm volatile("s_waitcnt lgkmcnt(0)" ::: "memory")

#define XB_TMO      128
#define XB_XCNT(j)  (256  + 64 * (j))
#define XB_XSUB(j)  (1280 + 64 * (j))
#define XB_XGEN(j)  (2304 + 64 * (j))
#define XB_TOP      3328
#define XB_TOPGEN   3392
#define XCD_BAR_WORDS 3456
#define XB_SPIN_CAP (1u << 22)
__device__ __forceinline__ unsigned xb_ld(unsigned* p)              { return __hip_atomic_load(p, __ATOMIC_RELAXED, __HIP_MEMORY_SCOPE_AGENT); }
__device__ __forceinline__ unsigned xb_add(unsigned* p, unsigned v) { return __hip_atomic_fetch_add(p, v, __ATOMIC_RELAXED, __HIP_MEMORY_SCOPE_AGENT); }
__device__ __forceinline__ unsigned xb_xcc_id() { return (unsigned)__builtin_amdgcn_s_getreg((3 << 11) | 20) & 0xFu; }
#define XB_SPIN(cond, bar) do { unsigned _sp = 0; while (cond) { __builtin_amdgcn_s_sleep(1); \
    if ((++_sp & 255u) == 0u) { if (xb_ld(&(bar)[XB_TMO])) break; if (_sp > XB_SPIN_CAP) { atomicAdd(&(bar)[XB_TMO], 1u); break; } } } } while (0)
struct XcdBarrier { unsigned* bar; unsigned x; volatile LAS unsigned* st; };
__device__ __forceinline__ XcdBarrier xcd_barrier_post(unsigned* bar, volatile LAS unsigned* st) {
    XcdBarrier b; b.bar = bar; b.x = xb_xcc_id(); b.st = st;
    if (threadIdx.x == 0) (void)xb_add(&bar[XB_XCNT(b.x)], 1u);
    return b;
}
__device__ __forceinline__ void xcd_barrier_complete(unsigned* bar, unsigned x, unsigned& nloc, unsigned& nx) {
    const unsigned G = gridDim.x * gridDim.y * gridDim.z;
    unsigned sum, cnt, mine, sp = 0u;
    for (;;) {
        sum = 0u; cnt = 0u; mine = 0u;
#pragma unroll
        for (unsigned j = 0; j < 16; ++j) { const unsigned c = xb_ld(&bar[XB_XCNT(j)]); sum += c; cnt += (c > 0u) ? 1u : 0u; mine = (j == x) ? c : mine; }
        if (sum == G) break;
        __builtin_amdgcn_s_sleep(1);
        if ((++sp & 255u) == 0u) { if (xb_ld(&bar[XB_TMO])) break; if (sp > XB_SPIN_CAP) { atomicAdd(&bar[XB_TMO], 1u); break; } }
    }
    nloc = mine > 0u ? mine : 1u; nx = cnt > 0u ? cnt : 1u;
}
__device__ __forceinline__ void xcd_barrier(const XcdBarrier& b) {
    asm volatile("s_waitcnt vmcnt(0)" ::: "memory");
    __syncthreads();
    if (threadIdx.x == 0) {
        unsigned* bar = b.bar;
        __builtin_amdgcn_s_waitcnt(0);
        unsigned nloc = b.st[0], nx = b.st[1];
        if (nloc == 0u) { xcd_barrier_complete(bar, b.x, nloc, nx); b.st[0] = nloc; b.st[1] = nx; }
        const unsigned old = xb_add(&bar[XB_XSUB(b.x)], 1u);
        const unsigned gen = old / nloc;
        if (old + 1u == (gen + 1u) * nloc) {
            __builtin_amdgcn_fence(__ATOMIC_RELEASE, "agent");
            asm volatile("s_waitcnt vmcnt(0)" ::: "memory");
            const unsigned og = xb_add(&bar[XB_TOP], 1u);
            const unsigned tg = og / nx;
            if (og + 1u == (tg + 1u) * nx) xb_add(&bar[XB_TOPGEN], 1u);
            else XB_SPIN(xb_ld(&bar[XB_TOPGEN]) == tg, bar);
            __builtin_amdgcn_fence(__ATOMIC_ACQUIRE, "agent");
            xb_add(&bar[XB_XGEN(b.x)], 1u);
            asm volatile("s_waitcnt vmcnt(0)" ::: "memory");
        } else {
            XB_SPIN(xb_ld(&bar[XB_XGEN(b.x)]) == gen, bar);
            __builtin_amdgcn_fence(__ATOMIC_ACQUIRE, "agent");
            asm volatile("s_waitcnt vmcnt(0)" ::: "memory");
        }
    }
    __syncthreads();
}

template <class AL, class BL, class EP>
__device__ __forceinline__ void mgemm_tile(unsigned char* lds, int K, const AL& al, const BL& bl, const EP& ep) {
    bf16_t* As = (bf16_t*)lds;
    bf16_t* Bs = As + 128 * 40;
    const int tid = threadIdx.x, lane = tid & 63, wave = tid >> 6;
    const int ar = tid >> 2, ac = (tid & 3) * 8;
    const int bn = tid & 127, bc = (tid >> 7) * 8;
    f32x4 acc[8];
#pragma unroll
    for (int s = 0; s < 8; ++s) acc[s] = (f32x4){0.f, 0.f, 0.f, 0.f};
    bf16x8 ra = al(ac), rb = bl(bc);
    for (int k0 = 0; k0 < K; k0 += 32) {
        __syncthreads();
        *(bf16x8*)(As + ar * 40 + ac) = ra;
        *(bf16x8*)(Bs + bn * 40 + bc) = rb;
        __syncthreads();
        if (k0 + 32 < K) { ra = al(k0 + 32 + ac); rb = bl(k0 + 32 + bc); }
        const bf16x8 af = *(const bf16x8*)(As + (wave * 16 + (lane & 15)) * 40 + (lane >> 4) * 8);
#pragma unroll
        for (int s = 0; s < 8; ++s) {
            const bf16x8 wf = *(const bf16x8*)(Bs + (16 * s + (lane & 15)) * 40 + (lane >> 4) * 8);
            acc[s] = __builtin_amdgcn_mfma_f32_16x16x32_bf16(wf, af, acc[s], 0, 0, 0);
        }
    }
    ep(wave * 16 + (lane & 15), (lane >> 4) * 4, acc);
}
__device__ __forceinline__ void store4bf(bf16_t* p, const f32x4 v) { u32x2 w; w.x = pk2(v[0], v[1]); w.y = pk2(v[2], v[3]); *(u32x2*)p = w; }

struct Args {
    const float* in[29];
    float* out;
    unsigned char* ws;
    float inv_freq[8];
    int ph_lo, ph_hi;
};

__device__ __forceinline__ void ph_inproj0(const Args& a, unsigned char* lds) {
    const float* x = a.in[0]; const float* w = a.in[1];
    bf16_t* H0 = (bf16_t*)(a.ws + WS_H0);
    const int tid = threadIdx.x;
    for (int u = blockIdx.x; u < 256 * 12; u += gridDim.x) {
        const int rt = u / 12, ct = u % 12;
        const float* xr = x + (size_t)(rt * 128 + (tid >> 2)) * D;
        const int n = tid & 127;
        int col;
        if (ct < 4) col = ct * 128 + n; else { const int j0 = (ct - 4) * 64; col = (n < 64) ? (512 + j0 + n) : (1024 + j0 + (n - 64)); }
        auto al = [&](int k) { return cvt8(xr + k); };
        auto bl = [&](int k) { return colk8(w, 1536, k, col); };
        auto ep = [&](int r, int cb, const f32x4 (&acc)[8]) {
            bf16_t* o = H0 + (size_t)(rt * 128 + r) * 1024;
            if (ct < 4) {
#pragma unroll
                for (int s = 0; s < 8; ++s) store4bf(o + ct * 128 + 16 * s + cb, acc[s]);
            } else {
                const int j0 = (ct - 4) * 64;
#pragma unroll
                for (int s = 0; s < 4; ++s) {
                    f32x4 v;
#pragma unroll
                    for (int i = 0; i < 4; ++i) v[i] = acc[s][i] * sigmoidf_(acc[s + 4][i]);
                    store4bf(o + 512 + j0 + 16 * s + cb, v);
                }
            }
        };
        mgemm_tile(lds, D, al, bl, ep);
    }
}

__device__ __forceinline__ void ph_convpool(const Args& a) {
    const bf16_t* H0 = (const bf16_t*)(a.ws + WS_H0);
    bf16_t* PM = (bf16_t*)(a.ws + WS_PM);
    bf16_t* CAT = (bf16_t*)(a.ws + WS_CAT);
    const float* cw = a.in[4]; const float* cb = a.in[5]; const float* lg = a.in[6]; const float* lb = a.in[7];
    const int lane = threadIdx.x & 63, wave = threadIdx.x >> 6;
    const int gw = blockIdx.x * 8 + wave, ngw = gridDim.x * 8;
    const int ch = lane * 8;
    for (int tok = gw; tok < M; tok += ngw) {
        const int t = tok % T;
        {
            const int w = 2 << (lane >> 4);
            const int cnt = (t + 1 < w) ? (t + 1) : w;
            float s[8];
#pragma unroll
            for (int j = 0; j < 8; ++j) s[j] = 0.f;
            float self[8];
            for (int k = 0; k < cnt; ++k) {
                const bf16x8 v = *(const bf16x8*)(H0 + (size_t)(tok - k) * 1024 + ch);
#pragma unroll
                for (int j = 0; j < 8; ++j) { const float f = bf2f((bf16_t)v[j]); s[j] += f; if (k == 0) self[j] = f; }
            }
            const float inv = 1.0f / (float)cnt;
            u32x4 o;
            o.x = pk2(s[0] * inv - self[0], s[1] * inv - self[1]); o.y = pk2(s[2] * inv - self[2], s[3] * inv - self[3]);
            o.z = pk2(s[4] * inv - self[4], s[5] * inv - self[5]); o.w = pk2(s[6] * inv - self[6], s[7] * inv - self[7]);
            *(u32x4*)(PM + (size_t)tok * 512 + ch) = o;
        }
        float c[8];
#pragma unroll
        for (int j = 0; j < 8; ++j) c[j] = cb[ch + j];
        for (int k = 0; k < 31; ++k) {
            const int tt = t - 30 + k;
            if (tt < 0) continue;
            const bf16x8 v = *(const bf16x8*)(H0 + (size_t)(tok - 30 + k) * 1024 + 512 + ch);
            const float4 w0 = *(const float4*)(cw + k * 512 + ch), w1 = *(const float4*)(cw + k * 512 + ch + 4);
            c[0] += w0.x * bf2f((bf16_t)v[0]); c[1] += w0.y * bf2f((bf16_t)v[1]); c[2] += w0.z * bf2f((bf16_t)v[2]); c[3] += w0.w * bf2f((bf16_t)v[3]);
            c[4] += w1.x * bf2f((bf16_t)v[4]); c[5] += w1.y * bf2f((bf16_t)v[5]); c[6] += w1.z * bf2f((bf16_t)v[6]); c[7] += w1.w * bf2f((bf16_t)v[7]);
        }
        float sm = 0.f;
#pragma unroll
        for (int j = 0; j < 8; ++j) sm += c[j];
        const float mean = wave_sum(sm) * (1.0f / 512.0f);
        float sq = 0.f;
#pragma unroll
        for (int j = 0; j < 8; ++j) { c[j] -= mean; sq += c[j] * c[j]; }
        const float rstd = rsqrtf(wave_sum(sq) * (1.0f / 512.0f) + LN_EPS);
        float y[8];
#pragma unroll
        for (int j = 0; j < 8; ++j) { const float z = c[j] * rstd * lg[ch + j] + lb[ch + j]; y[j] = z * sigmoidf_(z); }
        u32x4 o; o.x = pk2(y[0], y[1]); o.y = pk2(y[2], y[3]); o.z = pk2(y[4], y[5]); o.w = pk2(y[6], y[7]);
        *(u32x4*)(CAT + (size_t)tok * 1024 + 512 + ch) = o;
    }
}

__device__ __forceinline__ void ph_poolmix(const Args& a, unsigned char* lds) {
    const bf16_t* PM = (const bf16_t*)(a.ws + WS_PM);
    bf16_t* CAT = (bf16_t*)(a.ws + WS_CAT);
    const float* mix = a.in[2]; const float* sc = a.in[3];
    const int tid = threadIdx.x;
    for (int u = blockIdx.x; u < 256 * 4; u += gridDim.x) {
        const int rt = u >> 2, g = u & 3;
        const bf16_t* pr = PM + (size_t)(rt * 128 + (tid >> 2)) * 512 + g * 128;
        const float* mg = mix + (size_t)g * 128 * 128;
        const int n = tid & 127;
        auto al = [&](int k) { return *(const bf16x8*)(pr + k); };
        auto bl = [&](int k) { return colk8(mg, 128, k, n); };
        auto ep = [&](int r, int cb, const f32x4 (&acc)[8]) {
            bf16_t* o = CAT + (size_t)(rt * 128 + r) * 1024 + g * 128;
#pragma unroll
            for (int s = 0; s < 8; ++s) {
                const float4 sv = *(const float4*)(sc + g * 128 + 16 * s + cb);
                f32x4 v = acc[s]; v[0] *= sv.x; v[1] *= sv.y; v[2] *= sv.z; v[3] *= sv.w;
                store4bf(o + 16 * s + cb, v);
            }
        };
        mgemm_tile(lds, 128, al, bl, ep);
    }
}

__device__ __forceinline__ void ph_outproj(const bf16_t* A, const float* W, const float* resf, const bf16_t* resb, bf16_t* Y, unsigned char* lds) {
    const int tid = threadIdx.x;
    for (int u = blockIdx.x; u < 256 * 8; u += gridDim.x) {
        const int rt = u >> 3, ct = u & 7;
        const bf16_t* ar = A + (size_t)(rt * 128 + (tid >> 2)) * 1024;
        const int col = ct * 128 + (tid & 127);
        auto al = [&](int k) { return *(const bf16x8*)(ar + k); };
        auto bl = [&](int k) { return colk8(W, 1024, k, col); };
        auto ep = [&](int r, int cb, const f32x4 (&acc)[8]) {
            const size_t ro = (size_t)(rt * 128 + r) * 1024 + ct * 128;
#pragma unroll
            for (int s = 0; s < 8; ++s) {
                f32x4 v = acc[s];
                if (resf) { const float4 xv = *(const float4*)(resf + ro + 16 * s + cb); v[0] += ALPHA * xv.x; v[1] += ALPHA * xv.y; v[2] += ALPHA * xv.z; v[3] += ALPHA * xv.w; }
                else { const u32x2 xv = *(const u32x2*)(resb + ro + 16 * s + cb);
                    v[0] += ALPHA * __uint_as_float(xv.x << 16); v[1] += ALPHA * __uint_as_float(xv.x & 0xffff0000u);
                    v[2] += ALPHA * __uint_as_float(xv.y << 16); v[3] += ALPHA * __uint_as_float(xv.y & 0xffff0000u); }
                store4bf(Y + ro + 16 * s + cb, v);
            }
        };
        mgemm_tile(lds, 1024, al, bl, ep);
    }
}

__device__ __forceinline__ void ph_ln(const bf16_t* Y, const float* g, const float* b, bf16_t* X) {
    const int lane = threadIdx.x & 63, wave = threadIdx.x >> 6;
    const int gw = blockIdx.x * 8 + wave, ngw = gridDim.x * 8;
    for (int row = gw; row < M; row += ngw) {
        float v[16];
        const bf16x8 p0 = *(const bf16x8*)(Y + (size_t)row * 1024 + lane * 8), p1 = *(const bf16x8*)(Y + (size_t)row * 1024 + 512 + lane * 8);
#pragma unroll
        for (int j = 0; j < 8; ++j) { v[j] = bf2f((bf16_t)p0[j]); v[8 + j] = bf2f((bf16_t)p1[j]); }
        float s = 0.f;
#pragma unroll
        for (int j = 0; j < 16; ++j) s += v[j];
        const float mean = wave_sum(s) * (1.0f / 1024.0f);
        float q = 0.f;
#pragma unroll
        for (int j = 0; j < 16; ++j) { v[j] -= mean; q += v[j] * v[j]; }
        const float rstd = rsqrtf(wave_sum(q) * (1.0f / 1024.0f) + LN_EPS);
        float o[16];
#pragma unroll
        for (int j = 0; j < 8; ++j) { o[j] = v[j] * rstd * g[lane * 8 + j] + b[lane * 8 + j]; o[8 + j] = v[8 + j] * rstd * g[512 + lane * 8 + j] + b[512 + lane * 8 + j]; }
        u32x4 w0, w1;
        w0.x = pk2(o[0], o[1]); w0.y = pk2(o[2], o[3]); w0.z = pk2(o[4], o[5]); w0.w = pk2(o[6], o[7]);
        w1.x = pk2(o[8], o[9]); w1.y = pk2(o[10], o[11]); w1.z = pk2(o[12], o[13]); w1.w = pk2(o[14], o[15]);
        *(u32x4*)(X + (size_t)row * 1024 + lane * 8) = w0; *(u32x4*)(X + (size_t)row * 1024 + 512 + lane * 8) = w1;
    }
}

__device__ __forceinline__ void ph_router(const bf16_t* X, const float* Wr, float* LOG, unsigned char* lds) {
    const int tid = threadIdx.x;
    for (int u = blockIdx.x; u < 256 * 2; u += gridDim.x) {
        const int rt = u >> 1, ct = u & 1;
        const bf16_t* ar = X + (size_t)(rt * 128 + (tid >> 2)) * 1024;
        const int col = ct * 128 + (tid & 127);
        auto al = [&](int k) { return *(const bf16x8*)(ar + k); };
        auto bl = [&](int k) { return colk8(Wr, 256, k, col); };
        auto ep = [&](int r, int cb, const f32x4 (&acc)[8]) {
            float* o = LOG + (size_t)(rt * 128 + r) * 256 + ct * 128;
#pragma unroll
            for (int s = 0; s < 8; ++s) *(f32x4*)(o + 16 * s + cb) = acc[s];
        };
        mgemm_tile(lds, 1024, al, bl, ep);
    }
}

__device__ __forceinline__ void ph_route(const float* LOG, const float* bias, unsigned* cnt, int* list, float* wts) {
    const int lane = threadIdx.x & 63, wave = threadIdx.x >> 6;
    const int gw = blockIdx.x * 8 + wave, ngw = gridDim.x * 8;
    const float NEG = -INFINITY;
    const float4 bb = *(const float4*)(bias + lane * 4);
    for (int tok = gw; tok < M; tok += ngw) {
        const float4 lg = *(const float4*)(LOG + (size_t)tok * 256 + lane * 4);
        const float s0 = sigmoidf_(lg.x), s1 = sigmoidf_(lg.y), s2 = sigmoidf_(lg.z), s3 = sigmoidf_(lg.w);
        float v0 = s0 + bb.x, v1 = s1 + bb.y, v2 = s2 + bb.z, v3 = s3 + bb.w;
        float m1 = fmaxf(v0, v1), m2 = fminf(v0, v1);
        { const float hi = fmaxf(v2, v3), lo = fminf(v2, v3); const float n1 = fmaxf(m1, hi); const float n2 = fmaxf(fminf(m1, hi), fmaxf(m2, lo)); m1 = n1; m2 = n2; }
#pragma unroll
        for (int o = 1; o < 8; o <<= 1) {
            const float a1 = __shfl_xor(m1, o), a2 = __shfl_xor(m2, o);
            const float n1 = fmaxf(m1, a1), n2 = fmaxf(fminf(m1, a1), fmaxf(m2, a2));
            m1 = n1; m2 = n2;
        }
        const float gs = m1 + m2;
        const int mygrp = lane >> 3;
        int rank = 0;
#pragma unroll
        for (int g2 = 0; g2 < 8; ++g2) { const float og = __shfl(gs, g2 * 8); rank += (og > gs || (og == gs && g2 < mygrp)) ? 1 : 0; }
        if (rank >= 4) { v0 = NEG; v1 = NEG; v2 = NEG; v3 = NEG; }
        int my_e = 0; float my_s = 0.f;
#pragma unroll
        for (int it = 0; it < 8; ++it) {
            float bv = v0; int bj = 0;
            if (v1 > bv) { bv = v1; bj = 1; }
            if (v2 > bv) { bv = v2; bj = 2; }
            if (v3 > bv) { bv = v3; bj = 3; }
            int bi = lane * 4 + bj;
#pragma unroll
            for (int o = 1; o < 64; o <<= 1) {
                const float ov = __shfl_xor(bv, o); const int oi = __shfl_xor(bi, o);
                if (ov > bv || (ov == bv && oi < bi)) { bv = ov; bi = oi; }
            }
            const int jj = bi & 3, ol = bi >> 2;
            const float mys = (jj == 0) ? s0 : (jj == 1) ? s1 : (jj == 2) ? s2 : s3;
            const float wsc = __shfl(mys, ol);
            if (lane == ol) { if (jj == 0) v0 = NEG; else if (jj == 1) v1 = NEG; else if (jj == 2) v2 = NEG; else v3 = NEG; }
            if (lane == it) { my_e = bi; my_s = wsc; }
        }
        const float ssum = wave_sum(lane < 8 ? my_s : 0.f);
        if (lane < 8) {
            const unsigned pos = atomicAdd(&cnt[my_e], 1u);
            list[(size_t)my_e * LISTCAP + pos] = tok * 9 + lane;
            wts[(size_t)tok * 9 + lane] = my_s / ssum * 2.5f;
        } else if (lane == 8) wts[(size_t)tok * 9 + 8] = 1.0f;
    }
}

__device__ __forceinline__ int moe_setup(const unsigned* cnt, unsigned char* lds) {
    int* tstart = (int*)(lds + 32768);
    int* scnt = (int*)(lds + 32768 + 2048);
    unsigned short* texp = (unsigned short*)(lds + 36864);
    const int tid = threadIdx.x;
    __syncthreads();
    if (tid < 256) scnt[tid] = (int)cnt[tid];
    __syncthreads();
    if (tid == 0) { int s = 0; for (int e = 0; e < 256; ++e) { tstart[e] = s; s += (scnt[e] + 127) >> 7; } tstart[256] = s; }
    __syncthreads();
    if (tid < 256) for (int q = tstart[tid]; q < tstart[tid + 1]; ++q) texp[q] = (unsigned short)tid;
    __syncthreads();
    return tstart[256];
}

__device__ __forceinline__ void ph_gateup(const Args& a, int layer, const bf16_t* X, unsigned char* lds) {
    const unsigned* cnt = (const unsigned*)(a.ws + WS_CTL) + CW_CNT + layer * 256;
    const int* list = (const int*)(a.ws + WS_LIST);
    bf16_t* HID = (bf16_t*)(a.ws + WS_HID);
    const int R = moe_setup(cnt, lds);
    const int* tstart = (const int*)(lds + 32768); const int* scnt = (const int*)(lds + 32768 + 2048);
    const unsigned short* texp = (const unsigned short*)(lds + 36864);
    const int tid = threadIdx.x;
    const int nunits = (R + 256) * 4;
    for (int u = blockIdx.x; u < nunits; u += gridDim.x) {
        const int q = u >> 2, ct = u & 3, j0 = ct * 64;
        const float *Wg, *Wu; int token;
        const int r0 = tid >> 2;
        if (q < R) {
            const int e = texp[q]; int lr = (q - tstart[e]) * 128 + r0; const int c = scnt[e]; if (lr >= c) lr = c - 1;
            token = list[(size_t)e * LISTCAP + lr] / 9;
            Wg = a.in[23] + ((size_t)layer * NE + e) * (size_t)(D * FF); Wu = a.in[24] + ((size_t)layer * NE + e) * (size_t)(D * FF);
        } else {
            token = (q - R) * 128 + r0;
            Wg = a.in[26] + (size_t)layer * (D * FF); Wu = a.in[27] + (size_t)layer * (D * FF);
        }
        const bf16_t* xr = X + (size_t)token * 1024;
        const int n = tid & 127;
        const float* Wsel = (n < 64) ? Wg : Wu; const int col = j0 + (n & 63);
        auto al = [&](int k) { return *(const bf16x8*)(xr + k); };
        auto bl = [&](int k) { return colk8(Wsel, FF, k, col); };
        auto ep = [&](int r, int cb, const f32x4 (&acc)[8]) {
            bf16_t* o = HID + (size_t)(q * 128 + r) * 256 + j0;
#pragma unroll
            for (int s = 0; s < 4; ++s) {
                f32x4 v;
#pragma unroll
                for (int i = 0; i < 4; ++i) { const float gq = acc[s][i]; v[i] = gq * sigmoidf_(gq) * acc[s + 4][i]; }
                store4bf(o + 16 * s + cb, v);
            }
        };
        mgemm_tile(lds, D, al, bl, ep);
    }
}

__device__ __forceinline__ void ph_down(const Args& a, int layer, unsigned char* lds) {
    const unsigned* cnt = (const unsigned*)(a.ws + WS_CTL) + CW_CNT + layer * 256;
    const int* list = (const int*)(a.ws + WS_LIST);
    const float* wts = (const float*)(a.ws + WS_WTS);
    const bf16_t* HID = (const bf16_t*)(a.ws + WS_HID);
    bf16_t* YB = (bf16_t*)(a.ws + WS_YB);
    const int R = moe_setup(cnt, lds);
    const int* tstart = (const int*)(lds + 32768); const int* scnt = (const int*)(lds + 32768 + 2048);
    const unsigned short* texp = (const unsigned short*)(lds + 36864);
    const int tid = threadIdx.x, lane = tid & 63, wave = tid >> 6;
    const int nunits = (R + 256) * 8;
    for (int u = blockIdx.x; u < nunits; u += gridDim.x) {
        const int q = u >> 3, ct = u & 7;
        const float* Wd; int yrow = -1; float w = 1.0f;
        const int re = wave * 16 + (lane & 15);
        if (q < R) {
            const int e = texp[q]; const int lr = (q - tstart[e]) * 128 + re;
            if (lr < scnt[e]) { yrow = list[(size_t)e * LISTCAP + lr]; w = wts[yrow]; }
            Wd = a.in[25] + ((size_t)layer * NE + e) * (size_t)(FF * D);
        } else {
            yrow = ((q - R) * 128 + re) * 9 + 8;
            Wd = a.in[28] + (size_t)layer * (FF * D);
        }
        const bf16_t* hr = HID + (size_t)(q * 128 + (tid >> 2)) * 256;
        const int col = ct * 128 + (tid & 127);
        auto al = [&](int k) { return *(const bf16x8*)(hr + k); };
        auto bl = [&](int k) { return colk8(Wd, D, k, col); };
        auto ep = [&](int r, int cb, const f32x4 (&acc)[8]) {
            if (yrow >= 0) {
                bf16_t* o = YB + (size_t)yrow * 1024 + ct * 128;
#pragma unroll
                for (int s = 0; s < 8; ++s) { f32x4 v = acc[s]; v[0] *= w; v[1] *= w; v[2] *= w; v[3] *= w; store4bf(o + 16 * s + cb, v); }
            }
        };
        mgemm_tile(lds, FF, al, bl, ep);
    }
}

__device__ __forceinline__ void ph_combine(const Args& a, const bf16_t* X, const float* g, const float* b, bf16_t* Xo, float* outf) {
    const bf16_t* YB = (const bf16_t*)(a.ws + WS_YB);
    const int lane = threadIdx.x & 63, wave = threadIdx.x >> 6;
    const int gw = blockIdx.x * 8 + wave, ngw = gridDim.x * 8;
    for (int row = gw; row < M; row += ngw) {
        float v[16];
        {
            const bf16x8 p0 = *(const bf16x8*)(X + (size_t)row * 1024 + lane * 8), p1 = *(const bf16x8*)(X + (size_t)row * 1024 + 512 + lane * 8);
#pragma unroll
            for (int j = 0; j < 8; ++j) { v[j] = ALPHA * bf2f((bf16_t)p0[j]); v[8 + j] = ALPHA * bf2f((bf16_t)p1[j]); }
        }
        for (int k = 0; k < 9; ++k) {
            const bf16_t* yr = YB + ((size_t)row * 9 + k) * 1024;
            const bf16x8 p0 = *(const bf16x8*)(yr + lane * 8), p1 = *(const bf16x8*)(yr + 512 + lane * 8);
#pragma unroll
            for (int j = 0; j < 8; ++j) { v[j] += bf2f((bf16_t)p0[j]); v[8 + j] += bf2f((bf16_t)p1[j]); }
        }
        float s = 0.f;
#pragma unroll
        for (int j = 0; j < 16; ++j) s += v[j];
        const float mean = wave_sum(s) * (1.0f / 1024.0f);
        float q = 0.f;
#pragma unroll
        for (int j = 0; j < 16; ++j) { v[j] -= mean; q += v[j] * v[j]; }
        const float rstd = rsqrtf(wave_sum(q) * (1.0f / 1024.0f) + LN_EPS);
        float o[16];
#pragma unroll
        for (int j = 0; j < 8; ++j) { o[j] = v[j] * rstd * g[lane * 8 + j] + b[lane * 8 + j]; o[8 + j] = v[8 + j] * rstd * g[512 + lane * 8 + j] + b[512 + lane * 8 + j]; }
        if (outf) {
            float* op = outf + (size_t)row * 1024;
            *(float4*)(op + lane * 8) = make_float4(o[0], o[1], o[2], o[3]); *(float4*)(op + lane * 8 + 4) = make_float4(o[4], o[5], o[6], o[7]);
            *(float4*)(op + 512 + lane * 8) = make_float4(o[8], o[9], o[10], o[11]); *(float4*)(op + 512 + lane * 8 + 4) = make_float4(o[12], o[13], o[14], o[15]);
        } else {
            u32x4 w0, w1;
            w0.x = pk2(o[0], o[1]); w0.y = pk2(o[2], o[3]); w0.z = pk2(o[4], o[5]); w0.w = pk2(o[6], o[7]);
            w1.x = pk2(o[8], o[9]); w1.y = pk2(o[10], o[11]); w1.z = pk2(o[12], o[13]); w1.w = pk2(o[14], o[15]);
            *(u32x4*)(Xo + (size_t)row * 1024 + lane * 8) = w0; *(u32x4*)(Xo + (size_t)row * 1024 + 512 + lane * 8) = w1;
        }
    }
}

__device__ __forceinline__ void ph_inprojN(const Args& a, unsigned char* lds) {
    const bf16_t* X = (const bf16_t*)(a.ws + WS_X2);
    const float* w = a.in[9];
    bf16_t* HN = (bf16_t*)(a.ws + WS_HN);
    const int tid = threadIdx.x;
    for (int u = blockIdx.x; u < 256 * 21; u += gridDim.x) {
        const int rt = u / 21, ct = u % 21;
        const bf16_t* ar = X + (size_t)(rt * 128 + (tid >> 2)) * 1024;
        const int col = ct * 128 + (tid & 127);
        auto al = [&](int k) { return *(const bf16x8*)(ar + k); };
        auto bl = [&](int k) { return (col < 2608) ? colk8(w, 2608, k, col) : zero8(); };
        auto ep = [&](int r, int cb, const f32x4 (&acc)[8]) {
            bf16_t* o = HN + (size_t)(rt * 128 + r) * HNW + ct * 128;
#pragma unroll
            for (int s = 0; s < 8; ++s) store4bf(o + 16 * s + cb, acc[s]);
        };
        mgemm_tile(lds, D, al, bl, ep);
    }
}

__device__ __forceinline__ void rot16(float (&v)[16], const float (&cs)[8], const float (&sn)[8]) {
#pragma unroll
    for (int i = 0; i < 8; ++i) { const float x1 = v[i], x2 = v[8 + i]; v[i] = x1 * cs[i] - x2 * sn[i]; v[8 + i] = x2 * cs[i] + x1 * sn[i]; }
}
__device__ __forceinline__ void ld16(const bf16_t* p, float (&v)[16]) {
    const bf16x8 a = *(const bf16x8*)p, b = *(const bf16x8*)(p + 8);
#pragma unroll
    for (int j = 0; j < 8; ++j) { v[j] = bf2f((bf16_t)a[j]); v[8 + j] = bf2f((bf16_t)b[j]); }
}
__device__ __forceinline__ void st16(bf16_t* p, const float (&v)[16], float sc) {
    u32x4 w0, w1;
    w0.x = pk2(v[0] * sc, v[1] * sc); w0.y = pk2(v[2] * sc, v[3] * sc); w0.z = pk2(v[4] * sc, v[5] * sc); w0.w = pk2(v[6] * sc, v[7] * sc);
    w1.x = pk2(v[8] * sc, v[9] * sc); w1.y = pk2(v[10] * sc, v[11] * sc); w1.z = pk2(v[12] * sc, v[13] * sc); w1.w = pk2(v[14] * sc, v[15] * sc);
    *(u32x4*)p = w0; *(u32x4*)(p + 8) = w1;
}
__device__ __forceinline__ void ph_rotary(const Args& a) {
    bf16_t* HN = (bf16_t*)(a.ws + WS_HN);
    bf16_t* QR = (bf16_t*)(a.ws + WS_QR);
    float* GATES = (float*)(a.ws + WS_GATES);
    const int lane = threadIdx.x & 63, wave = threadIdx.x >> 6;
    const int gw = blockIdx.x * 8 + wave, ngw = gridDim.x * 8;
    for (int tok = gw; tok < M; tok += ngw) {
        const int t = tok % T;
        float cs[8], sn[8];
#pragma unroll
        for (int i = 0; i < 8; ++i) {
            const float ang = (float)t * a.inv_freq[i];
            const double rev = (double)ang * 0.15915494309189535;
            const float fr = (float)(rev - floor(rev));
            cs[i] = __builtin_amdgcn_cosf(fr); sn[i] = __builtin_amdgcn_sinf(fr);
        }
        bf16_t* row = HN + (size_t)tok * HNW;
        float v[16];
        ld16(row + lane * 16, v);
        st16(row + lane * 16, v, QSCALE);
        if ((lane & 3) == 0) rot16(v, cs, sn);
        st16(QR + (size_t)tok * 1024 + lane * 16, v, QSCALE);
        if (lane < 16) {
            ld16(row + 1536 + lane * 16, v); if ((lane & 3) == 0) { rot16(v, cs, sn); st16(row + 1536 + lane * 16, v, 1.0f); }
            ld16(row + 2048 + lane * 16, v); if ((lane & 3) == 0) { rot16(v, cs, sn); st16(row + 2048 + lane * 16, v, 1.0f); }
        }
        if (lane < 48) GATES[(size_t)tok * 48 + lane] = sigmoidf_(bf2f(row[2560 + lane]));
    }
}

__device__ __forceinline__ void ph_cmp1(const Args& a, unsigned char* lds) {
    const bf16_t* HN = (const bf16_t*)(a.ws + WS_HN);
    bf16_t* CH1 = (bf16_t*)(a.ws + WS_CH1);
    const int tid = threadIdx.x;
    for (int u = blockIdx.x; u < 64 * 2; u += gridDim.x) {
        const int rt = u >> 1, kv = u & 1;
        const int rr = rt * 128 + (tid >> 2);
        const int bg = rr >> 9, n = rr & 511, b = bg >> 2, g = bg & 3;
        const float* pos = a.in[kv ? 13 : 10];
        const float* w1 = a.in[kv ? 14 : 11];
        const int colbase = 1024 + kv * 256 + g * 64;
        const int col = tid & 127;
        auto al = [&](int k) {
            const int i = k >> 6, d = k & 63;
            int tt = 16 * n + i; if (tt > T - 1) tt = T - 1;
            const bf16x8 x = *(const bf16x8*)(HN + (size_t)(b * T + tt) * HNW + colbase + d);
            const float4 p0 = *(const float4*)(pos + i * 64 + d), p1 = *(const float4*)(pos + i * 64 + d + 4);
            bf16x8 r;
            r[0] = (short)f2bf(bf2f((bf16_t)x[0]) + p0.x); r[1] = (short)f2bf(bf2f((bf16_t)x[1]) + p0.y); r[2] = (short)f2bf(bf2f((bf16_t)x[2]) + p0.z); r[3] = (short)f2bf(bf2f((bf16_t)x[3]) + p0.w);
            r[4] = (short)f2bf(bf2f((bf16_t)x[4]) + p1.x); r[5] = (short)f2bf(bf2f((bf16_t)x[5]) + p1.y); r[6] = (short)f2bf(bf2f((bf16_t)x[6]) + p1.z); r[7] = (short)f2bf(bf2f((bf16_t)x[7]) + p1.w);
            return r;
        };
        auto bl = [&](int k) { return colk8(w1, 128, k, col); };
        auto ep = [&](int r, int cb, const f32x4 (&acc)[8]) {
            bf16_t* o = CH1 + ((size_t)kv * 8192 + rt * 128 + r) * 128;
#pragma unroll
            for (int s = 0; s < 8; ++s) { f32x4 v; v[0] = gelu_tanh(acc[s][0]); v[1] = gelu_tanh(acc[s][1]); v[2] = gelu_tanh(acc[s][2]); v[3] = gelu_tanh(acc[s][3]); store4bf(o + 16 * s + cb, v); }
        };
        mgemm_tile(lds, 2048, al, bl, ep);
    }
}
__device__ __forceinline__ void ph_cmp2(const Args& a, unsigned char* lds) {
    const bf16_t* CH1 = (const bf16_t*)(a.ws + WS_CH1);
    bf16_t* KC = (bf16_t*)(a.ws + WS_KC);
    const int tid = threadIdx.x;
    for (int u = blockIdx.x; u < 64 * 2; u += gridDim.x) {
        const int rt = u >> 1, kv = u & 1;
        const bf16_t* ar = CH1 + ((size_t)kv * 8192 + rt * 128 + (tid >> 2)) * 128;
        const float* w2 = a.in[kv ? 15 : 12];
        const int col = tid & 127;
        auto al = [&](int k) { return *(const bf16x8*)(ar + k); };
        auto bl = [&](int k) { return (col < 64) ? colk8(w2, 64, k, col) : zero8(); };
        auto ep = [&](int r, int cb, const f32x4 (&acc)[8]) {
            bf16_t* o = KC + ((size_t)kv * 8192 + rt * 128 + r) * 64;
#pragma unroll
            for (int s = 0; s < 4; ++s) store4bf(o + 16 * s + cb, acc[s]);
        };
        mgemm_tile(lds, 128, al, bl, ep);
    }
}

__device__ __forceinline__ float dot64(const float* qs, const bf16_t* krow) {
    float s = 0.f;
#pragma unroll
    for (int c = 0; c < 8; ++c) {
        const bf16x8 kk = *(const bf16x8*)(krow + c * 8);
#pragma unroll
        for (int j = 0; j < 8; ++j) s += qs[c * 8 + j] * bf2f((bf16_t)kk[j]);
    }
    return s;
}
__device__ __forceinline__ void ph_attn_simple(const Args& a, unsigned char* lds) {
    const bf16_t* HN = (const bf16_t*)(a.ws + WS_HN);
    const bf16_t* QR = (const bf16_t*)(a.ws + WS_QR);
    const float* GATES = (const float*)(a.ws + WS_GATES);
    const bf16_t* KC = (const bf16_t*)(a.ws + WS_KC);
    const bf16_t* VC = KC + (size_t)8192 * 64;
    bf16_t* O = (bf16_t*)(a.ws + WS_O);
    const int lane = threadIdx.x & 63, wave = threadIdx.x >> 6;
    float* sc = (float*)(lds + wave * 8192);
    float* ps = sc + 1024;
    float* qs = ps + 512;
    int* sel = (int*)(qs + 64);
    const int gw = blockIdx.x * 8 + wave, ngw = gridDim.x * 8;
    for (int unit = gw; unit < M * 4; unit += ngw) {
        const int tok = unit >> 2, g = unit & 3;
        const int b = tok / T, t = tok % T;
        const int cur = t >> 6;
        const int ncv = (t >= 31) ? ((t - 31) / 16 + 1) : 0;
        const bf16_t* kc = KC + (size_t)(b * 4 + g) * 512 * 64;
        const bf16_t* vc = VC + (size_t)(b * 4 + g) * 512 * 64;
        float ocmp[4] = {0.f, 0.f, 0.f, 0.f};
        for (int n = lane; n < 512; n += 64) ps[n] = 0.f;
        WSYNC();
#pragma unroll
        for (int h4 = 0; h4 < 4; ++h4) {
            const int head = g * 4 + h4;
            qs[lane] = bf2f(HN[(size_t)tok * HNW + head * 64 + lane]);
            WSYNC();
            float mx = -INFINITY;
            for (int n = lane; n < ncv; n += 64) { const float s = dot64(qs, kc + (size_t)n * 64); sc[n] = s; mx = fmaxf(mx, s); }
            mx = wave_max(mx);
            float sm = 0.f;
            for (int n = lane; n < ncv; n += 64) { const float p = exp2f(sc[n] - mx); sc[n] = p; sm += p; }
            sm = wave_sum(sm);
            const float inv = (ncv > 0) ? 1.0f / sm : 0.f;
            for (int n = lane; n < ncv; n += 64) { const float p = sc[n] * inv; sc[n] = p; ps[n] += p; }
            WSYNC();
            float o = 0.f;
            for (int n = 0; n < ncv; ++n) o += sc[n] * bf2f(vc[(size_t)n * 64 + lane]);
            ocmp[h4] = o;
            WSYNC();
        }
        float iv[2];
#pragma unroll
        for (int c = 0; c < 2; ++c) {
            const int j = lane + 64 * c;
            float v;
            if (j > cur) v = -INFINITY;
            else if (j == 0 || j == cur || j == cur - 1) v = INFINITY;
            else {
                const int n0 = 4 * j;
                v = ps[n0 - 1] + 2.0f * (ps[n0] + ps[n0 + 1] + ps[n0 + 2]) + ps[n0 + 3];
            }
            iv[c] = v;
        }
        const int nsel = (cur + 1 < 16) ? (cur + 1) : 16;
        for (int it = 0; it < nsel; ++it) {
            float bv; int bi;
            if (iv[0] >= iv[1]) { bv = iv[0]; bi = lane; } else { bv = iv[1]; bi = lane + 64; }
#pragma unroll
            for (int o = 1; o < 64; o <<= 1) {
                const float ov = __shfl_xor(bv, o); const int oi = __shfl_xor(bi, o);
                if (ov > bv || (ov == bv && oi < bi)) { bv = ov; bi = oi; }
            }
            if ((bi & 63) == lane) { if (bi < 64) iv[0] = -INFINITY; else iv[1] = -INFINITY; }
            if (lane == 0) sel[it] = bi;
        }
        WSYNC();
#pragma unroll
        for (int h4 = 0; h4 < 4; ++h4) {
            const int head = g * 4 + h4;
            qs[lane] = bf2f(QR[(size_t)tok * 1024 + head * 64 + lane]);
            WSYNC();
            float oslc, owin;
            {
                const int nk = nsel * 64;
                float mx = -INFINITY;
                for (int idx = lane; idx < nk; idx += 64) {
                    const int key = sel[idx >> 6] * 64 + (idx & 63);
                    float s = -INFINITY;
                    if (key <= t) s = dot64(qs, HN + (size_t)(b * T + key) * HNW + 1536 + g * 64);
                    sc[idx] = s; mx = fmaxf(mx, s);
                }
                mx = wave_max(mx);
                float sm = 0.f;
                for (int idx = lane; idx < nk; idx += 64) { const float p = exp2f(sc[idx] - mx); sc[idx] = p; sm += p; }
                sm = wave_sum(sm);
                WSYNC();
                float o = 0.f;
                for (int idx = 0; idx < nk; ++idx) {
                    const float p = sc[idx];
                    if (p != 0.f) { const int key = sel[idx >> 6] * 64 + (idx & 63); o += p * bf2f(HN[(size_t)(b * T + key) * HNW + 1792 + g * 64 + lane]); }
                }
                oslc = o / sm;
                WSYNC();
            }
            {
                const int nk = (t + 1 < 512) ? (t + 1) : 512;
                const int k0 = t - nk + 1;
                float mx = -INFINITY;
                for (int idx = lane; idx < nk; idx += 64) { const float s = dot64(qs, HN + (size_t)(b * T + k0 + idx) * HNW + 2048 + g * 64); sc[idx] = s; mx = fmaxf(mx, s); }
                mx = wave_max(mx);
                float sm = 0.f;
                for (int idx = lane; idx < nk; idx += 64) { const float p = exp2f(sc[idx] - mx); sc[idx] = p; sm += p; }
                sm = wave_sum(sm);
                WSYNC();
                float o = 0.f;
                for (int idx = 0; idx < nk; ++idx) o += sc[idx] * bf2f(HN[(size_t)(b * T + k0 + idx) * HNW + 2304 + g * 64 + lane]);
                owin = o / sm;
                WSYNC();
            }
            const float* gt = GATES + (size_t)tok * 48 + head * 3;
            O[(size_t)tok * 1024 + head * 64 + lane] = f2bf(gt[0] * ocmp[h4] + gt[1] * oslc + gt[2] * owin);
        }
    }
}

__global__ void __launch_bounds__(512, 2) fwd_kernel(Args a) {
    extern __shared__ __attribute__((aligned(16))) unsigned char lds[];
    volatile LAS unsigned* MISC = (volatile LAS unsigned*)((LAS unsigned char*)lds + (LDS_BYTES - 64));
    if (threadIdx.x < 16) MISC[threadIdx.x] = 0u;
    __syncthreads();
    unsigned* ctl = (unsigned*)(a.ws + WS_CTL);
#if MK_ONE_LAUNCH
    XcdBarrier bar = xcd_barrier_post(ctl + CW_BAR, MISC + 8);
#define SEAM() xcd_barrier(bar)
#else
#define SEAM() do {} while (0)
#endif
    const int lo = a.ph_lo, hi = a.ph_hi;
#define IN(k) (lo <= (k) && (k) < hi)
#define BOTH(k) (IN(k) && IN((k) + 1))
    bf16_t* X1 = (bf16_t*)(a.ws + WS_X1);
    bf16_t* X2 = (bf16_t*)(a.ws + WS_X2);
    float* LOG = (float*)(a.ws + WS_LOG);
    int* LIST = (int*)(a.ws + WS_LIST);
    float* WTS = (float*)(a.ws + WS_WTS);

    if (IN(0)) { ph_inproj0(a, lds); if (BOTH(0)) SEAM(); }
    if (IN(1)) { ph_convpool(a); if (BOTH(1)) SEAM(); }
    if (IN(2)) { ph_poolmix(a, lds); if (BOTH(2)) SEAM(); }
    if (IN(3)) { ph_outproj((const bf16_t*)(a.ws + WS_CAT), a.in[8], a.in[0], nullptr, (bf16_t*)(a.ws + WS_Y), lds); if (BOTH(3)) SEAM(); }
    if (IN(4)) { ph_ln((const bf16_t*)(a.ws + WS_Y), a.in[17], a.in[18], X1); if (BOTH(4)) SEAM(); }
    if (IN(5)) { ph_router(X1, a.in[21], LOG, lds); if (BOTH(5)) SEAM(); }
    if (IN(6)) { ph_route(LOG, a.in[22], ctl + CW_CNT, LIST, WTS); if (BOTH(6)) SEAM(); }
    if (IN(7)) { ph_gateup(a, 0, X1, lds); if (BOTH(7)) SEAM(); }
    if (IN(8)) { ph_down(a, 0, lds); if (BOTH(8)) SEAM(); }
    if (IN(9)) { ph_combine(a, X1, a.in[19], a.in[20], X2, nullptr); if (BOTH(9)) SEAM(); }
    if (IN(10)) { ph_inprojN(a, lds); if (BOTH(10)) SEAM(); }
    if (IN(11)) { ph_rotary(a); if (BOTH(11)) SEAM(); }
    if (IN(12)) { ph_cmp1(a, lds); if (BOTH(12)) SEAM(); }
    if (IN(13)) { ph_cmp2(a, lds); if (BOTH(13)) SEAM(); }
    if (IN(14)) { ph_attn_simple(a, lds); if (BOTH(14)) SEAM(); }
    if (IN(15)) { ph_outproj((const bf16_t*)(a.ws + WS_O), a.in[16], nullptr, X2, (bf16_t*)(a.ws + WS_Y2), lds); if (BOTH(15)) SEAM(); }
    if (IN(16)) { ph_ln((const bf16_t*)(a.ws + WS_Y2), a.in[17] + D, a.in[18] + D, X1); if (BOTH(16)) SEAM(); }
    if (IN(17)) { ph_router(X1, a.in[21] + (size_t)D * NE, LOG, lds); if (BOTH(17)) SEAM(); }
    if (IN(18)) { ph_route(LOG, a.in[22] + NE, ctl + CW_CNT + 256, LIST, WTS); if (BOTH(18)) SEAM(); }
    if (IN(19)) { ph_gateup(a, 1, X1, lds); if (BOTH(19)) SEAM(); }
    if (IN(20)) { ph_down(a, 1, lds); if (BOTH(20)) SEAM(); }
    if (IN(21)) { ph_combine(a, X1, a.in[19] + D, a.in[20] + D, nullptr, a.out); }
}

extern "C" void kernel_launch(void* const* d_in, const int* in_sizes, int n_in, void* d_out, int out_size, void* d_ws, size_t ws_size, hipStream_t stream) {
    static int grid = 0;
    if (grid == 0) {
        if (n_in != 29 || out_size != M * D || ws_size < WS_END_NAIVE) { fprintf(stderr, "kernel_launch: unexpected problem (n_in %d out %d ws %zu)\n", n_in, out_size, ws_size); grid = -1; return; }
        int dev = 0, cus = 0;
        if (hipGetDevice(&dev) != hipSuccess || hipDeviceGetAttribute(&cus, hipDeviceAttributeMultiprocessorCount, dev) != hipSuccess) { grid = -1; return; }
        if (hipFuncSetAttribute((const void*)fwd_kernel, hipFuncAttributeMaxDynamicSharedMemorySize, LDS_BYTES) != hipSuccess) { grid = -1; return; }
        int per_cu = 0;
        (void)hipOccupancyMaxActiveBlocksPerMultiprocessor(&per_cu, (const void*)fwd_kernel, 512, LDS_BYTES);
        (void)hipGetLastError();
        grid = cus;
    }
    if (grid < 0) return;
    (void)hipMemsetAsync((char*)d_ws + WS_CTL, 0, CTL_BYTES, stream);
    Args a{};
    for (int i = 0; i < 29; ++i) a.in[i] = (const float*)d_in[i];
    a.out = (float*)d_out; a.ws = (unsigned char*)d_ws;
    for (int i = 0; i < 8; ++i) a.inv_freq[i] = powf(500000.0f, -(float)(2 * i) / 16.0f);
#if MK_ONE_LAUNCH
    a.ph_lo = 0; a.ph_hi = NPHASE;
    hipLaunchKernelGGL(fwd_kernel, dim3(grid), dim3(512), LDS_BYTES, stream, a);
#else
    for (int p = 0; p < NPHASE; ++p) { a.ph_lo = p; a.ph_hi = p + 1; hipLaunchKernelGGL(fwd_kernel, dim3(grid), dim3(512), LDS_BYTES, stream, a); }
#endif
}
```

```cpp
#include <hip/hip_runtime.h>
#include <cstdint>
#include <cstdio>
#include <cmath>

#ifndef MK_ONE_LAUNCH
#define MK_ONE_LAUNCH 1
#endif

#define LAS __attribute__((address_space(3)))
typedef unsigned short bf16_t;
typedef short bf16x8 __attribute__((ext_vector_type(8)));
typedef float f32x4 __attribute__((ext_vector_type(4)));
typedef unsigned u32x2 __attribute__((ext_vector_type(2)));
typedef unsigned u32x4 __attribute__((ext_vector_type(4)));

constexpr int NB = 4, T = 8192, D = 1024, M = NB * T;
constexpr int NE = 256, TOPK = 8, FF = 256;
constexpr int HNW = 2816;
constexpr int LISTCAP = 32768;
constexpr float ALPHA = 1.4142135623730951f;
constexpr float LN_EPS = 1e-5f;
constexpr float QSCALE = 0.125f * 1.4426950408889634f;
constexpr float YB_SCALE = 16.0f;
constexpr int NPHASE = 23;

constexpr size_t MiB = 1u << 20;
constexpr size_t WS_CTL = 0, CTL_BYTES = 1 * MiB;
constexpr size_t WS_X1 = 1 * MiB;
constexpr size_t WS_X2 = WS_X1 + 64 * MiB;
constexpr size_t WS_LOG = WS_X2 + 64 * MiB;
constexpr size_t WS_LIST = WS_LOG + 32 * MiB;
constexpr size_t WS_WTS = WS_LIST + 64 * MiB;
constexpr size_t WS_HID = WS_WTS + 2 * MiB;
constexpr size_t WS_YB = WS_HID + 184 * MiB;
constexpr size_t WS_END_NAIVE = WS_YB + 576 * MiB;
constexpr size_t WS_WIN0 = WS_END_NAIVE;
constexpr size_t WS_WOUT0 = WS_WIN0 + 3 * MiB;
constexpr size_t WS_WINN = WS_WOUT0 + 2 * MiB;
constexpr size_t WS_WOUTN = WS_WINN + 6 * MiB;
constexpr size_t WS_WR = WS_WOUTN + 2 * MiB;
constexpr size_t WS_CW1 = WS_WR + 1 * MiB;
constexpr size_t WS_MISC = WS_CW1 + 2 * MiB;
constexpr size_t WS_WGU = WS_MISC + 1 * MiB;
constexpr size_t WS_X8 = WS_WGU + 257 * MiB;
constexpr float X8_SCALE = 8.0f, W8_SCALE = 64.0f, H8_SCALE = 16.0f;
constexpr size_t WS_WD = WS_WGU + 514 * MiB;
constexpr size_t WS_END = WS_WD + 257 * MiB;
constexpr size_t WS_XA = WS_X2;
constexpr size_t WS_H0 = WS_YB;
constexpr size_t WS_PM = WS_H0 + 64 * MiB;
constexpr size_t WS_CAT = WS_PM + 32 * MiB;
constexpr size_t WS_Y = WS_CAT + 64 * MiB;
constexpr size_t WS_HN = WS_YB;
constexpr size_t WS_KV6 = WS_HN + 64 * MiB;
constexpr size_t WS_QR = WS_HN + 176 * MiB;
constexpr size_t WS_GATES = WS_QR + 64 * MiB;
constexpr size_t WS_CH1 = WS_GATES + 8 * MiB;
constexpr size_t WS_KC = WS_CH1 + 4 * MiB;
constexpr size_t WS_O = WS_KC + 2 * MiB;
constexpr size_t WS_Y2 = WS_O + 64 * MiB;
static_assert(WS_Y2 + 64 * MiB <= WS_END_NAIVE, "overlay");
static_assert(WS_Y + 64 * MiB <= WS_END_NAIVE, "overlay");

constexpr int CW_CNT = 64;
constexpr int CW_BAR = 4096;

constexpr int LDS_BYTES = 163840;

__device__ __forceinline__ float bf2f(bf16_t h) { return __uint_as_float(((unsigned)h) << 16); }
__device__ __forceinline__ bf16_t f2bf(float f) { unsigned u = __float_as_uint(f); return (bf16_t)((u + 0x7fffu + ((u >> 16) & 1u)) >> 16); }
__device__ __forceinline__ unsigned pk2(float lo, float hi) { return (unsigned)f2bf(lo) | ((unsigned)f2bf(hi) << 16); }
__device__ __forceinline__ float wave_sum(float v) {
#pragma unroll
    for (int o = 1; o < 64; o <<= 1) v += __shfl_xor(v, o);
    return v;
}
__device__ __forceinline__ float wave_max(float v) {
#pragma unroll
    for (int o = 1; o < 64; o <<= 1) v = fmaxf(v, __shfl_xor(v, o));
    return v;
}
__device__ __forceinline__ float sigmoidf_(float x) { return 1.0f / (1.0f + __expf(-x)); }
__device__ __forceinline__ float gelu_tanh(float x) {
    const float u = 0.7978845608028654f * (x + 0.044715f * x * x * x);
    const float e = __expf(2.0f * u);
    const float th = 1.0f - 2.0f / (e + 1.0f);
    return 0.5f * x * (1.0f + th);
}
__device__ __forceinline__ bf16x8 cvt8(const float* p) {
    const float4 a = *(const float4*)p, b = *(const float4*)(p + 4);
    bf16x8 r;
    r[0] = (short)f2bf(a.x); r[1] = (short)f2bf(a.y); r[2] = (short)f2bf(a.z); r[3] = (short)f2bf(a.w);
    r[4] = (short)f2bf(b.x); r[5] = (short)f2bf(b.y); r[6] = (short)f2bf(b.z); r[7] = (short)f2bf(b.w);
    return r;
}
__device__ __forceinline__ bf16x8 colk8(const float* W, int N, int k, int col) {
    bf16x8 r;
#pragma unroll
    for (int j = 0; j < 8; ++j) r[j] = (short)f2bf(W[(size_t)(k + j) * N + col]);
    return r;
}
__device__ __forceinline__ bf16x8 zero8() { return (bf16x8){0, 0, 0, 0, 0, 0, 0, 0}; }
#define WSYNC() asm volatile("s_waitcnt lgkmcnt(0)" ::: "memory")

#define XB_TMO      128
#define XB_XCNT(j)  (256  + 64 * (j))
#define XB_XSUB(j)  (1280 + 64 * (j))
#define XB_XGEN(j)  (2304 + 64 * (j))
#define XB_TOP      3328
#define XB_TOPGEN   3392
#define XCD_BAR_WORDS 3456
#define XB_SPIN_CAP (1u << 22)
__device__ __forceinline__ unsigned xb_ld(unsigned* p)              { return __hip_atomic_load(p, __ATOMIC_RELAXED, __HIP_MEMORY_SCOPE_AGENT); }
__device__ __forceinline__ unsigned xb_add(unsigned* p, unsigned v) { return __hip_atomic_fetch_add(p, v, __ATOMIC_RELAXED, __HIP_MEMORY_SCOPE_AGENT); }
__device__ __forceinline__ unsigned xb_xcc_id() { return (unsigned)__builtin_amdgcn_s_getreg((3 << 11) | 20) & 0xFu; }
#define XB_SPIN(cond, bar) do { unsigned _sp = 0; while (cond) { __builtin_amdgcn_s_sleep(1); \
    if ((++_sp & 255u) == 0u) { if (xb_ld(&(bar)[XB_TMO])) break; if (_sp > XB_SPIN_CAP) { atomicAdd(&(bar)[XB_TMO], 1u); break; } } } } while (0)
struct XcdBarrier { unsigned* bar; unsigned x; volatile LAS unsigned* st; };
__device__ __forceinline__ XcdBarrier xcd_barrier_post(unsigned* bar, volatile LAS unsigned* st) {
    XcdBarrier b; b.bar = bar; b.x = xb_xcc_id(); b.st = st;
    if (threadIdx.x == 0) (void)xb_add(&bar[XB_XCNT(b.x)], 1u);
    return b;
}
__device__ __forceinline__ void xcd_barrier_complete(unsigned* bar, unsigned x, unsigned& nloc, unsigned& nx) {
    const unsigned G = gridDim.x * gridDim.y * gridDim.z;
    unsigned sum, cnt, mine, sp = 0u;
    for (;;) {
        sum = 0u; cnt = 0u; mine = 0u;
#pragma unroll
        for (unsigned j = 0; j < 16; ++j) { const unsigned c = xb_ld(&bar[XB_XCNT(j)]); sum += c; cnt += (c > 0u) ? 1u : 0u; mine = (j == x) ? c : mine; }
        if (sum == G) break;
        __builtin_amdgcn_s_sleep(1);
        if ((++sp & 255u) == 0u) { if (xb_ld(&bar[XB_TMO])) break; if (sp > XB_SPIN_CAP) { atomicAdd(&bar[XB_TMO], 1u); break; } }
    }
    nloc = mine > 0u ? mine : 1u; nx = cnt > 0u ? cnt : 1u;
}
__device__ __forceinline__ void xcd_barrier(const XcdBarrier& b) {
    asm volatile("s_waitcnt vmcnt(0)" ::: "memory");
    __syncthreads();
    if (threadIdx.x == 0) {
        unsigned* bar = b.bar;
        __builtin_amdgcn_s_waitcnt(0);
        unsigned nloc = b.st[0], nx = b.st[1];
        if (nloc == 0u) { xcd_barrier_complete(bar, b.x, nloc, nx); b.st[0] = nloc; b.st[1] = nx; }
        const unsigned old = xb_add(&bar[XB_XSUB(b.x)], 1u);
        const unsigned gen = old / nloc;
        if (old + 1u == (gen + 1u) * nloc) {
            __builtin_amdgcn_fence(__ATOMIC_RELEASE, "agent");
            asm volatile("s_waitcnt vmcnt(0)" ::: "memory");
            const unsigned og = xb_add(&bar[XB_TOP], 1u);
            const unsigned tg = og / nx;
            if (og + 1u == (tg + 1u) * nx) xb_add(&bar[XB_TOPGEN], 1u);
            else XB_SPIN(xb_ld(&bar[XB_TOPGEN]) == tg, bar);
            __builtin_amdgcn_fence(__ATOMIC_ACQUIRE, "agent");
            xb_add(&bar[XB_XGEN(b.x)], 1u);
            asm volatile("s_waitcnt vmcnt(0)" ::: "memory");
        } else {
            XB_SPIN(xb_ld(&bar[XB_XGEN(b.x)]) == gen, bar);
            __builtin_amdgcn_fence(__ATOMIC_ACQUIRE, "agent");
            asm volatile("s_waitcnt vmcnt(0)" ::: "memory");
        }
    }
    __syncthreads();
}

template <class AL, class BL, class EP>
__device__ __forceinline__ void mgemm_tile(unsigned char* lds, int K, const AL& al, const BL& bl, const EP& ep) {
    bf16_t* As = (bf16_t*)lds;
    bf16_t* Bs = As + 128 * 40;
    const int tid = threadIdx.x, lane = tid & 63, wave = tid >> 6;
    const int ar = tid >> 2, ac = (tid & 3) * 8;
    const int bn = tid & 127, bc = (tid >> 7) * 8;
    f32x4 acc[8];
#pragma unroll
    for (int s = 0; s < 8; ++s) acc[s] = (f32x4){0.f, 0.f, 0.f, 0.f};
    bf16x8 ra = al(ac), rb = bl(bc);
    for (int k0 = 0; k0 < K; k0 += 32) {
        __syncthreads();
        *(bf16x8*)(As + ar * 40 + ac) = ra;
        *(bf16x8*)(Bs + bn * 40 + bc) = rb;
        __syncthreads();
        if (k0 + 32 < K) { ra = al(k0 + 32 + ac); rb = bl(k0 + 32 + bc); }
        const bf16x8 af = *(const bf16x8*)(As + (wave * 16 + (lane & 15)) * 40 + (lane >> 4) * 8);
#pragma unroll
        for (int s = 0; s < 8; ++s) {
            const bf16x8 wf = *(const bf16x8*)(Bs + (16 * s + (lane & 15)) * 40 + (lane >> 4) * 8);
            acc[s] = __builtin_amdgcn_mfma_f32_16x16x32_bf16(wf, af, acc[s], 0, 0, 0);
        }
    }
    ep(wave * 16 + (lane & 15), (lane >> 4) * 4, acc);
}
__device__ __forceinline__ void store4bf(bf16_t* p, const f32x4 v) { u32x2 w; w.x = pk2(v[0], v[1]); w.y = pk2(v[2], v[3]); *(u32x2*)p = w; }

struct Args {
    const float* in[29];
    float* out;
    unsigned char* ws;
    float inv_freq[8];
    int ph_lo, ph_hi;
};

__device__ __forceinline__ unsigned pk4_fp8(float a, float b, float c, float d) { int w = __builtin_amdgcn_cvt_pk_fp8_f32(a, b, 0, false); return (unsigned)__builtin_amdgcn_cvt_pk_fp8_f32(c, d, w, true); }
__device__ __forceinline__ u32x2 pack8_fp8(const f32x4 v0, const f32x4 v1) {
    int a = __builtin_amdgcn_cvt_pk_fp8_f32(v0[0], v0[1], 0, false); a = __builtin_amdgcn_cvt_pk_fp8_f32(v0[2], v0[3], a, true);
    int b = __builtin_amdgcn_cvt_pk_fp8_f32(v1[0], v1[1], 0, false); b = __builtin_amdgcn_cvt_pk_fp8_f32(v1[2], v1[3], b, true);
    u32x2 w; w.x = (unsigned)a; w.y = (unsigned)b; return w;
}
__device__ __forceinline__ float clamp8(float v) { return __builtin_amdgcn_fmed3f(v, -448.0f, 448.0f); }
__device__ __forceinline__ void ph_ln(const bf16_t* Y, const float* g, const float* b, bf16_t* X, unsigned char* X8) {
    const int lane = threadIdx.x & 63, wave = threadIdx.x >> 6;
    const int gw = blockIdx.x * 8 + wave, ngw = gridDim.x * 8;
    float gg[16], bb[16];
#pragma unroll
    for (int j = 0; j < 8; ++j) { gg[j] = g[lane * 8 + j]; gg[8 + j] = g[512 + lane * 8 + j]; bb[j] = b[lane * 8 + j]; bb[8 + j] = b[512 + lane * 8 + j]; }
    for (int row0 = gw * 4; row0 < M; row0 += ngw * 4) {
        bf16x8 p0[4], p1[4];
#pragma unroll
        for (int r = 0; r < 4; ++r) { p0[r] = __builtin_nontemporal_load((const bf16x8*)(Y + (size_t)(row0 + r) * 1024 + lane * 8)); p1[r] = __builtin_nontemporal_load((const bf16x8*)(Y + (size_t)(row0 + r) * 1024 + 512 + lane * 8)); }
#pragma unroll
        for (int r = 0; r < 4; ++r) {
            float v[16];
#pragma unroll
            for (int j = 0; j < 8; ++j) { v[j] = bf2f((bf16_t)p0[r][j]); v[8 + j] = bf2f((bf16_t)p1[r][j]); }
            float s = 0.f;
#pragma unroll
            for (int j = 0; j < 16; ++j) s += v[j];
            const float mean = wave_sum(s) * (1.0f / 1024.0f);
            float q = 0.f;
#pragma unroll
            for (int j = 0; j < 16; ++j) { v[j] -= mean; q += v[j] * v[j]; }
            const float rstd = rsqrtf(wave_sum(q) * (1.0f / 1024.0f) + LN_EPS);
            float o[16];
#pragma unroll
            for (int j = 0; j < 16; ++j) o[j] = v[j] * rstd * gg[j] + bb[j];
            u32x4 w0, w1;
            w0.x = pk2(o[0], o[1]); w0.y = pk2(o[2], o[3]); w0.z = pk2(o[4], o[5]); w0.w = pk2(o[6], o[7]);
            w1.x = pk2(o[8], o[9]); w1.y = pk2(o[10], o[11]); w1.z = pk2(o[12], o[13]); w1.w = pk2(o[14], o[15]);
            *(u32x4*)(X + (size_t)(row0 + r) * 1024 + lane * 8) = w0; *(u32x4*)(X + (size_t)(row0 + r) * 1024 + 512 + lane * 8) = w1;
#pragma unroll
            for (int j = 0; j < 16; ++j) o[j] = clamp8(o[j] * X8_SCALE);
            u32x2 q0, q1; q0.x = pk4_fp8(o[0], o[1], o[2], o[3]); q0.y = pk4_fp8(o[4], o[5], o[6], o[7]); q1.x = pk4_fp8(o[8], o[9], o[10], o[11]); q1.y = pk4_fp8(o[12], o[13], o[14], o[15]);
            *(u32x2*)(X8 + (size_t)(row0 + r) * 1024 + lane * 8) = q0; *(u32x2*)(X8 + (size_t)(row0 + r) * 1024 + 512 + lane * 8) = q1;
        }
    }
}

__device__ __forceinline__ void ph_combine(const Args& a, const bf16_t* X, const float* g, const float* b, bf16_t* Xo, float* outf) {
    const unsigned char* YB = (const unsigned char*)(a.ws + WS_YB);
    const int lane = threadIdx.x & 63, wave = threadIdx.x >> 6;
    const int gw = blockIdx.x * 8 + wave, ngw = gridDim.x * 8;
    for (int row = gw; row < M; row += ngw) {
        float v[16];
#pragma unroll
        for (int j = 0; j < 16; ++j) v[j] = 0.f;
        u32x2 q0[10], q1[10];
#pragma unroll
        for (int k = 0; k < 10; ++k) { const unsigned char* yr = YB + ((size_t)row * 10 + k) * 1024; q0[k] = __builtin_nontemporal_load((const u32x2*)(yr + lane * 8)); q1[k] = __builtin_nontemporal_load((const u32x2*)(yr + 512 + lane * 8)); }
#pragma unroll
        for (int k = 0; k < 10; ++k) {
            const auto a0 = __builtin_amdgcn_cvt_pk_f32_fp8((int)q0[k].x, false), a1 = __builtin_amdgcn_cvt_pk_f32_fp8((int)q0[k].x, true), a2 = __builtin_amdgcn_cvt_pk_f32_fp8((int)q0[k].y, false), a3 = __builtin_amdgcn_cvt_pk_f32_fp8((int)q0[k].y, true);
            const auto b0 = __builtin_amdgcn_cvt_pk_f32_fp8((int)q1[k].x, false), b1 = __builtin_amdgcn_cvt_pk_f32_fp8((int)q1[k].x, true), b2 = __builtin_amdgcn_cvt_pk_f32_fp8((int)q1[k].y, false), b3 = __builtin_amdgcn_cvt_pk_f32_fp8((int)q1[k].y, true);
            v[0] += a0[0]; v[1] += a0[1]; v[2] += a1[0]; v[3] += a1[1]; v[4] += a2[0]; v[5] += a2[1]; v[6] += a3[0]; v[7] += a3[1];
            v[8] += b0[0]; v[9] += b0[1]; v[10] += b1[0]; v[11] += b1[1]; v[12] += b2[0]; v[13] += b2[1]; v[14] += b3[0]; v[15] += b3[1];
        }
        {
            const bf16x8 p0 = *(const bf16x8*)(X + (size_t)row * 1024 + lane * 8), p1 = *(const bf16x8*)(X + (size_t)row * 1024 + 512 + lane * 8);
#pragma unroll
            for (int j = 0; j < 8; ++j) { v[j] = v[j] * (1.0f / YB_SCALE) + ALPHA * bf2f((bf16_t)p0[j]); v[8 + j] = v[8 + j] * (1.0f / YB_SCALE) + ALPHA * bf2f((bf16_t)p1[j]); }
        }
        float s = 0.f;
#pragma unroll
        for (int j = 0; j < 16; ++j) s += v[j];
        const float mean = wave_sum(s) * (1.0f / 1024.0f);
        float q = 0.f;
#pragma unroll
        for (int j = 0; j < 16; ++j) { v[j] -= mean; q += v[j] * v[j]; }
        const float rstd = rsqrtf(wave_sum(q) * (1.0f / 1024.0f) + LN_EPS);
        float o[16];
#pragma unroll
        for (int j = 0; j < 8; ++j) { o[j] = v[j] * rstd * g[lane * 8 + j] + b[lane * 8 + j]; o[8 + j] = v[8 + j] * rstd * g[512 + lane * 8 + j] + b[512 + lane * 8 + j]; }
        if (outf) {
            float* op = outf + (size_t)row * 1024;
            *(float4*)(op + lane * 8) = make_float4(o[0], o[1], o[2], o[3]); *(float4*)(op + lane * 8 + 4) = make_float4(o[4], o[5], o[6], o[7]);
            *(float4*)(op + 512 + lane * 8) = make_float4(o[8], o[9], o[10], o[11]); *(float4*)(op + 512 + lane * 8 + 4) = make_float4(o[12], o[13], o[14], o[15]);
        } else {
            u32x4 w0, w1;
            w0.x = pk2(o[0], o[1]); w0.y = pk2(o[2], o[3]); w0.z = pk2(o[4], o[5]); w0.w = pk2(o[6], o[7]);
            w1.x = pk2(o[8], o[9]); w1.y = pk2(o[10], o[11]); w1.z = pk2(o[12], o[13]); w1.w = pk2(o[14], o[15]);
            *(u32x4*)(Xo + (size_t)row * 1024 + lane * 8) = w0; *(u32x4*)(Xo + (size_t)row * 1024 + 512 + lane * 8) = w1;
        }
    }
}

__device__ __forceinline__ void ph_cmp2(const Args& a, unsigned char* lds) {
    const bf16_t* CH1 = (const bf16_t*)(a.ws + WS_CH1);
    bf16_t* KC = (bf16_t*)(a.ws + WS_KC);
    const int tid = threadIdx.x;
    for (int u = blockIdx.x; u < 64 * 2; u += gridDim.x) {
        const int rt = u >> 1, kv = u & 1;
        const bf16_t* ar = CH1 + ((size_t)kv * 8192 + rt * 128 + (tid >> 2)) * 128;
        const float* w2 = a.in[kv ? 15 : 12];
        const int col = tid & 127;
        auto al = [&](int k) { return *(const bf16x8*)(ar + k); };
        auto bl = [&](int k) { return (col < 64) ? colk8(w2, 64, k, col) : zero8(); };
        auto ep = [&](int r, int cb, const f32x4 (&acc)[8]) {
            bf16_t* o = KC + ((size_t)kv * 8192 + rt * 128 + r) * 64;
#pragma unroll
            for (int s = 0; s < 4; ++s) store4bf(o + 16 * s + cb, acc[s]);
        };
        mgemm_tile(lds, 128, al, bl, ep);
    }
}

namespace pg8 {
constexpr int BM = 256, BK = 64, HALF = 128, HTB = HALF * BK * 2, STAGE_BYTES = 8 * HTB;
__device__ __forceinline__ int lds_byte(int r, int c) { const int st = (r >> 4) * 2 + (c >> 5), rr = r & 15, cc = c & 31, ob = rr * 64 + cc * 2; return st * 1024 + (ob ^ (((ob >> 9) & 1) << 5)); }
__device__ __forceinline__ void stage_rc(int b, int& R, int& C) { const int st = b / 1024, sb = b % 1024, swz = sb ^ (((sb >> 9) & 1) << 5); R = (st >> 1) * 16 + swz / 64; C = (st & 1) * 32 + (swz % 64) / 2; }
__device__ __forceinline__ int perm32(int rho) { const int n = rho >> 4, i = rho & 15; return 8 * (i >> 2) + 4 * n + (i & 3); }
struct Unit { int pm, pn, ord; };
typedef float f32x16 __attribute__((ext_vector_type(16)));
typedef int i32x8 __attribute__((ext_vector_type(8))); typedef int i32x4_ __attribute__((ext_vector_type(4)));
__device__ __forceinline__ i32x8 f8cat(const bf16x8 lo, const bf16x8 hi) { return __builtin_shufflevector(__builtin_bit_cast(i32x4_, lo), __builtin_bit_cast(i32x4_, hi), 0, 1, 2, 3, 4, 5, 6, 7); }
template <class Epi, class Sched, bool ALIGN_EPI, bool F8 = false>
__device__ __forceinline__ void gemm_phase(LAS unsigned char* lds, const int K, const unsigned kstepA, const Sched& S, const Epi& E) {
    const int tid = threadIdx.x, wid = __builtin_amdgcn_readfirstlane(tid >> 6), lane = tid & 63, wr = wid >> 2, wc = wid & 3, fr = lane & 15, fq = lane >> 4;
    const int nt = K / BK;
    constexpr bool GA = Sched::GATHER;
    int RA[2]; unsigned CA2[2], voffB[2], voffB1[2], voffA[2];
    constexpr bool P16 = Epi::PERM16;
#pragma unroll
    for (int i = 0; i < 2; ++i) { int R, C; stage_rc(tid * 16 + i * 8192, R, C); const int Rb = Epi::PERM ? ((R & ~31) + perm32(R & 31)) : R;
        RA[i] = R; CA2[i] = (unsigned)C * 2u; voffB[i] = (unsigned)(Rb * K + C) * 2u; voffA[i] = GA ? 0u : (S.lane_off(R) + (unsigned)C * 2u);
        if (P16) { const int c16 = 64 * (R >> 5) + 16 * ((R >> 2) & 3) + 4 * ((R >> 4) & 1) + (R & 3); voffB[i] = (unsigned)(c16 * K + C) * 2u; voffB1[i] = (unsigned)((c16 + 8) * K + C) * 2u; } else voffB1[i] = 0u; }
    const size_t kstepB = (size_t)(BK * 2);
    const size_t hstepB = (size_t)HALF * K * 2;
    const unsigned ldsw = (unsigned)wid * 1024u;
    const int aoff = lds_byte(wr * 64 + fr, fq * 8), boff = lds_byte(wc * 32 + fr, fq * 8);
    const char* const Ab = S.abase();
    unsigned aoC[2][2], aoN[2][2];
    unsigned uC[2], uN[2];
#define PG8_SA(b, h) (((b) * 2 + (h)) * HTB)
#define PG8_SB(b, h) ((4 + (b) * 2 + (h)) * HTB)
#define PG8_GLDS(sbase, voff, ldsoff) do { const char* _b = (const char*)(sbase); unsigned _v = (voff); asm volatile("" : "+s"(_b), "+v"(_v)); \
        __builtin_amdgcn_global_load_lds((const unsigned*)(_b + _v), (LAS unsigned*)(lds + (ldsoff)), 16, 0, 0); } while (0)
#define PG8_STAGE_B(bufoff, gbase) do { _Pragma("unroll") for (int _i = 0; _i < 2; ++_i) PG8_GLDS(gbase, voffB[_i], (bufoff) + ldsw + _i * 8192); } while (0)
#define PG8_STAGE_B1(bufoff, gbase) do { _Pragma("unroll") for (int _i = 0; _i < 2; ++_i) PG8_GLDS((const char*)(gbase) + (P16 ? (size_t)0 : hstepB), (P16 ? voffB1[_i] : voffB[_i]), (bufoff) + ldsw + _i * 8192); } while (0)
#define PG8_STAGE_A(bufoff, kb, UO, LO) do { _Pragma("unroll") for (int _i = 0; _i < 2; ++_i) PG8_GLDS(Ab + (size_t)((kb) + (UO)), (GA ? (LO)[_i] : voffA[_i]), (bufoff) + ldsw + _i * 8192); } while (0)
#define PG8_LDA(dst, b, h) do { _Pragma("unroll") for (int m = 0; m < 4; ++m) _Pragma("unroll") for (int k = 0; k < 2; ++k) dst[m][k] = *(const LAS bf16x8*)(lds + PG8_SA(b, h) + aoff + m * 2048 + k * 1024); } while (0)
#define PG8_LDB(dst, b, h) do { _Pragma("unroll") for (int n = 0; n < 2; ++n) _Pragma("unroll") for (int k = 0; k < 2; ++k) dst[n][k] = *(const LAS bf16x8*)(lds + PG8_SB(b, h) + boff + n * 2048 + k * 1024); } while (0)
#define PG8_MMA(ai, bj, At, Bt) do { __builtin_amdgcn_s_setprio(1); _Pragma("unroll") for (int m = 0; m < 4; ++m) _Pragma("unroll") for (int n = 0; n < 2; ++n) { \
        if constexpr (F8) { f32x16& _w = accw[ai][bj][m >> 1]; const int _q = ((m & 1) * 2 + n) * 4; f32x4 _c = {_w[_q], _w[_q + 1], _w[_q + 2], _w[_q + 3]}; \
            _c = __builtin_amdgcn_mfma_scale_f32_16x16x128_f8f6f4(f8cat(Bt[n][0], Bt[n][1]), f8cat(At[m][0], At[m][1]), _c, 0, 0, 0, 0, 0, 0); _w[_q] = _c[0]; _w[_q + 1] = _c[1]; _w[_q + 2] = _c[2]; _w[_q + 3] = _c[3]; } \
        else { _Pragma("unroll") for (int k = 0; k < 2; ++k) acc[ai][bj][m][n] = __builtin_amdgcn_mfma_f32_16x16x32_bf16(Bt[n][k], At[m][k], acc[ai][bj][m][n], 0, 0, 0); } } __builtin_amdgcn_s_setprio(0); } while (0)
#define PG8_WAIT_V(n) asm volatile("s_waitcnt vmcnt(" #n ")" ::: "memory")
#define PG8_WAIT_L(n) asm volatile("s_waitcnt lgkmcnt(" #n ")" ::: "memory")
#define PG8_BAR __builtin_amdgcn_s_barrier()
#define PG8_SCHED __builtin_amdgcn_sched_barrier(0)
#define PG8_KPAIR(KB1, KB2, KB3, BP2, BP3) do { \
            PG8_LDB(B0, 0, 0); PG8_LDB(B1, 0, 1); PG8_SCHED; PG8_LDA(At, 0, 0); PG8_STAGE_A(PG8_SA(1, 1), KB1, uC[1], aoC[1]); \
            PG8_WAIT_V(8); PG8_WAIT_L(0); PG8_BAR; PG8_MMA(0, 0, At, B0); PG8_MMA(0, 1, At, B1); PG8_BAR; PG8_SCHED; \
            PG8_LDA(At, 0, 1); PG8_STAGE_B(PG8_SB(0, 0), BP2); PG8_STAGE_B1(PG8_SB(0, 1), BP2); PG8_STAGE_A(PG8_SA(0, 0), KB2, u2[0], a2o[0]); \
            PG8_WAIT_V(8); PG8_WAIT_L(0); PG8_BAR; PG8_MMA(1, 0, At, B0); PG8_MMA(1, 1, At, B1); PG8_BAR; PG8_SCHED; \
            PG8_LDB(B0, 1, 0); PG8_LDB(B1, 1, 1); PG8_SCHED; PG8_LDA(At, 1, 0); PG8_STAGE_A(PG8_SA(0, 1), KB2, u2[1], a2o[1]); \
            PG8_WAIT_V(8); PG8_WAIT_L(0); PG8_BAR; PG8_MMA(0, 0, At, B0); PG8_MMA(0, 1, At, B1); PG8_BAR; PG8_SCHED; \
            PG8_LDA(At, 1, 1); PG8_STAGE_B(PG8_SB(1, 0), BP3); PG8_STAGE_B1(PG8_SB(1, 1), BP3); PG8_STAGE_A(PG8_SA(1, 0), KB3, u2[0], a2o[0]); \
            PG8_WAIT_V(8); PG8_WAIT_L(0); PG8_BAR; PG8_MMA(1, 0, At, B0); PG8_MMA(1, 1, At, B1); PG8_BAR; PG8_SCHED; } while (0)
    Unit cur, nxt; int ui = 0;
    if (!S.next(0, cur)) return;
    f32x4 acc[2][2][4][2];
#pragma unroll
    for (int a = 0; a < 2; ++a)
#pragma unroll
        for (int b = 0; b < 2; ++b)
#pragma unroll
            for (int m = 0; m < 4; ++m)
#pragma unroll
                for (int n = 0; n < 2; ++n) acc[a][b][m][n] = (f32x4){0.f, 0.f, 0.f, 0.f};
    bf16x8 At[4][2], B0[2][2], B1[2][2];
    f32x16 accw[2][2][2];
#define PG8_ZERO_W() do { if constexpr (F8) { _Pragma("unroll") for (int _a = 0; _a < 2; ++_a) _Pragma("unroll") for (int _b = 0; _b < 2; ++_b) _Pragma("unroll") for (int _m = 0; _m < 2; ++_m) _Pragma("unroll") for (int _e = 0; _e < 16; ++_e) accw[_a][_b][_m][_e] = 0.f; } } while (0)
    PG8_ZERO_W();
#pragma unroll
    for (int h = 0; h < 2; ++h) { uC[h] = GA ? 0u : S.unit_off(cur, h); uN[h] = uC[h];
#pragma unroll
        for (int i = 0; i < 2; ++i) { aoC[h][i] = GA ? (S.aoff(cur, h * HALF + RA[i]) + CA2[i]) : 0u; aoN[h][i] = aoC[h][i]; } }
    const char* cB = S.bptr(cur);
    PG8_STAGE_B(PG8_SB(0, 0), cB); PG8_STAGE_B1(PG8_SB(0, 1), cB); PG8_STAGE_A(PG8_SA(0, 0), 0u, uC[0], aoC[0]); PG8_STAGE_A(PG8_SA(0, 1), 0u, uC[1], aoC[1]);
    if (wr == 1) PG8_BAR;
    PG8_WAIT_V(2); PG8_BAR;
    PG8_STAGE_B(PG8_SB(1, 0), cB + kstepB); PG8_STAGE_A(PG8_SA(1, 0), kstepA, uC[0], aoC[0]); PG8_STAGE_B1(PG8_SB(1, 1), cB + kstepB);
    PG8_WAIT_V(6); PG8_BAR;
    for (;;) {
        const bool has_next = S.next(ui + 1, nxt);
        const char* nB = has_next ? S.bptr(nxt) : cB;
#pragma unroll
        for (int h = 0; h < 2; ++h) { uN[h] = (GA || !has_next) ? uC[h] : S.unit_off(nxt, h);
#pragma unroll
            for (int i = 0; i < 2; ++i) aoN[h][i] = (GA && has_next) ? (S.aoff(nxt, h * HALF + RA[i]) + CA2[i]) : aoC[h][i]; }
#pragma nounroll
        for (int t = 0; t < nt; t += 2) {
            const bool last = (t == nt - 2);
            const unsigned kb1 = (unsigned)(t + 1) * kstepA, kb2 = last ? 0u : (unsigned)(t + 2) * kstepA, kb3 = kb2 + kstepA;
            const char* b2 = last ? nB : cB + (size_t)(t + 2) * kstepB; const char* b3 = b2 + kstepB;
            unsigned u2[2], a2o[2][2];
#pragma unroll
            for (int h = 0; h < 2; ++h) { u2[h] = last ? uN[h] : uC[h];
#pragma unroll
                for (int i = 0; i < 2; ++i) a2o[h][i] = GA ? (last ? aoN[h][i] : aoC[h][i]) : 0u; }
            PG8_KPAIR(kb1, kb2, kb3, b2, b3);
        }
        if constexpr (ALIGN_EPI) { if (wr == 0) PG8_BAR; }
        if constexpr (F8) {
#pragma unroll
            for (int _a = 0; _a < 2; ++_a)
#pragma unroll
                for (int _b = 0; _b < 2; ++_b)
#pragma unroll
                    for (int _m = 0; _m < 4; ++_m)
#pragma unroll
                        for (int _n = 0; _n < 2; ++_n) { const f32x16& _w = accw[_a][_b][_m >> 1]; const int _q = ((_m & 1) * 2 + _n) * 4; acc[_a][_b][_m][_n] = (f32x4){_w[_q], _w[_q + 1], _w[_q + 2], _w[_q + 3]}; }
        }
        E(acc, cur, wr, wc, fr, fq);
        PG8_ZERO_W();
        if (!has_next) break;
#pragma unroll
        for (int a = 0; a < 2; ++a)
#pragma unroll
            for (int b = 0; b < 2; ++b)
#pragma unroll
                for (int m = 0; m < 4; ++m)
#pragma unroll
                    for (int n = 0; n < 2; ++n) acc[a][b][m][n] = (f32x4){0.f, 0.f, 0.f, 0.f};
        cur = nxt; cB = nB; ++ui;
#pragma unroll
        for (int h = 0; h < 2; ++h) { uC[h] = uN[h];
#pragma unroll
            for (int i = 0; i < 2; ++i) aoC[h][i] = aoN[h][i]; }
        if constexpr (ALIGN_EPI) { if (wr == 1) PG8_BAR; }
    }
    PG8_WAIT_V(0);
    if constexpr (!ALIGN_EPI) { if (wr == 0) PG8_BAR; }
    PG8_BAR;
#undef PG8_SA
#undef PG8_ZERO_W
#undef PG8_GLDS
#undef PG8_SB
#undef PG8_STAGE_A
#undef PG8_STAGE_B
#undef PG8_STAGE_B1
#undef PG8_LDA
#undef PG8_LDB
#undef PG8_MMA
#undef PG8_WAIT_V
#undef PG8_WAIT_L
#undef PG8_BAR
#undef PG8_SCHED
#undef PG8_KPAIR
}

struct DenseSched {
    const char* A; const char* Bt; unsigned lda2; size_t btile; int nM, nN, nwg, G, c;
    __device__ __forceinline__ void init(const bf16_t* A_, int lda, const bf16_t* Bt_, int K, int Mrows, int N) {
        A = (const char*)A_; Bt = (const char*)Bt_; lda2 = (unsigned)lda * 2u; btile = (size_t)256 * K * 2; nM = Mrows / BM; nN = N / BM; nwg = nM * nN; G = gridDim.x; c = blockIdx.x; }
    __device__ __forceinline__ bool next(int i, Unit& u) const {
        const long L = (long)i * G + c; if (L >= nwg) return false;
        int wgid = (int)L; { const int q = nwg / 8, r = nwg % 8, xcd = wgid % 8, off = wgid / 8; wgid = (xcd < r ? xcd * (q + 1) : r * (q + 1) + (xcd - r) * q) + off; }
        const int nig = 8 * nN, gid = wgid / nig, fm = gid * 8, gsz = (nM - fm) < 8 ? (nM - fm) : 8;
        u.pm = fm + ((wgid % nig) % gsz); u.pn = (wgid % nig) / gsz; u.ord = i; return true;
    }
    static constexpr bool GATHER = false;
    __device__ __forceinline__ unsigned lane_off(int r) const { return (unsigned)r * lda2; }
    __device__ __forceinline__ unsigned unit_off(const Unit& u, int h) const { return (unsigned)(u.pm * BM + h * HALF) * lda2; }
    __device__ __forceinline__ unsigned aoff(const Unit&, int) const { return 0u; }
    __device__ __forceinline__ const char* abase() const { return A; }
    __device__ __forceinline__ const char* bptr(const Unit& u) const { return Bt + (size_t)u.pn * btile; }
};
}
typedef float f32x2_t __attribute__((ext_vector_type(2))); typedef __bf16 bf16x2_t __attribute__((ext_vector_type(2)));
__device__ __forceinline__ unsigned cvt_pk_bf16(float lo, float hi) { const f32x2_t v = {lo, hi}; const bf16x2_t b = __builtin_convertvector(v, bf16x2_t); return __builtin_bit_cast(unsigned, b); }
__device__ __forceinline__ u32x4 pack8(const f32x4 v0, const f32x4 v1) { u32x4 w; w.x = cvt_pk_bf16(v0[0], v0[1]); w.y = cvt_pk_bf16(v0[2], v0[3]); w.z = cvt_pk_bf16(v1[0], v1[1]); w.w = cvt_pk_bf16(v1[2], v1[3]); return w; }
__device__ __forceinline__ unsigned cvtpk_m(float lo, float hi) { const f32x2_t v = {lo, hi}; const bf16x2_t b = __builtin_convertvector(v, bf16x2_t); return __builtin_bit_cast(unsigned, b); }
__device__ __forceinline__ u32x4 pack8m(const f32x4 v0, const f32x4 v1) { u32x4 w; w.x = cvtpk_m(v0[0], v0[1]); w.y = cvtpk_m(v0[2], v0[3]); w.z = cvtpk_m(v1[0], v1[1]); w.w = cvtpk_m(v1[2], v1[3]); return w; }
#define MFMA_SETTLE(S) asm volatile("s_nop 15\n\ts_nop 7" : "+v"(S[0][0]), "+v"(S[0][1]), "+v"(S[0][2]), "+v"(S[0][3]), "+v"(S[1][0]), "+v"(S[1][1]), "+v"(S[1][2]), "+v"(S[1][3]))
__device__ __forceinline__ f32x4 sig4(const f32x4 v) { f32x4 r; r[0] = sigmoidf_(v[0]); r[1] = sigmoidf_(v[1]); r[2] = sigmoidf_(v[2]); r[3] = sigmoidf_(v[3]); return r; }

#define EPI_ROWLOOP for (int ai = 0; ai < 2; ++ai) _Pragma("unroll") for (int m = 0; m < 4; ++m)
struct EpiInproj0 {
    static constexpr bool PERM = true, PERM16 = false; bf16_t* H0;
    __device__ __forceinline__ void operator()(const f32x4 (&acc)[2][2][4][2], const pg8::Unit& u, int wr, int wc, int fr, int fq) const {
        const int row0 = u.pm * 256 + wr * 64 + fr, cl = wc * 32 + 8 * fq;
#pragma unroll
        EPI_ROWLOOP { bf16_t* rp = H0 + (size_t)(row0 + ai * 128 + m * 16) * 1024;
            if (u.pn < 2) {
#pragma unroll
                for (int bj = 0; bj < 2; ++bj) *(u32x4*)(rp + u.pn * 256 + bj * 128 + cl) = pack8(acc[ai][bj][m][0], acc[ai][bj][m][1]);
            } else {
                const f32x4 v0 = acc[ai][0][m][0] * sig4(acc[ai][1][m][0]), v1 = acc[ai][0][m][1] * sig4(acc[ai][1][m][1]);
                *(u32x4*)(rp + 512 + (u.pn - 2) * 128 + cl) = pack8(v0, v1);
            } }
    }
};
struct EpiRes {
    static constexpr bool PERM = true, PERM16 = false; const float* resf; const bf16_t* resb; bf16_t* Y;
    __device__ __forceinline__ void operator()(const f32x4 (&acc)[2][2][4][2], const pg8::Unit& u, int wr, int wc, int fr, int fq) const {
        const int row0 = u.pm * 256 + wr * 64 + fr, c0 = u.pn * 256 + wc * 32 + 8 * fq;
#pragma unroll
        EPI_ROWLOOP { const size_t ro = (size_t)(row0 + ai * 128 + m * 16) * 1024 + c0;
#pragma unroll
            for (int bj = 0; bj < 2; ++bj) {
                f32x4 r0, r1;
                if (resf) { r0 = *(const f32x4*)(resf + ro + bj * 128); r1 = *(const f32x4*)(resf + ro + bj * 128 + 4); }
                else { const u32x4 xv = *(const u32x4*)(resb + ro + bj * 128);
                    r0[0] = __uint_as_float(xv.x << 16); r0[1] = __uint_as_float(xv.x & 0xffff0000u); r0[2] = __uint_as_float(xv.y << 16); r0[3] = __uint_as_float(xv.y & 0xffff0000u);
                    r1[0] = __uint_as_float(xv.z << 16); r1[1] = __uint_as_float(xv.z & 0xffff0000u); r1[2] = __uint_as_float(xv.w << 16); r1[3] = __uint_as_float(xv.w & 0xffff0000u); }
                *(u32x4*)(Y + ro + bj * 128) = pack8(acc[ai][bj][m][0] + r0 * ALPHA, acc[ai][bj][m][1] + r1 * ALPHA);
            } }
    }
};
struct EpiLogits {
    static constexpr bool PERM = true, PERM16 = false; float* LOG;
    __device__ __forceinline__ void operator()(const f32x4 (&acc)[2][2][4][2], const pg8::Unit& u, int wr, int wc, int fr, int fq) const {
        const int row0 = u.pm * 256 + wr * 64 + fr, cl = wc * 32 + 8 * fq;
#pragma unroll
        EPI_ROWLOOP { float* rp = LOG + (size_t)(row0 + ai * 128 + m * 16) * 256 + cl;
#pragma unroll
            for (int bj = 0; bj < 2; ++bj) { *(f32x4*)(rp + bj * 128) = acc[ai][bj][m][0]; *(f32x4*)(rp + bj * 128 + 4) = acc[ai][bj][m][1]; } }
    }
};

constexpr int MOE_TAB_OFF = 131072;
__device__ __forceinline__ int moe_setup256(const unsigned* cnt, LAS unsigned char* lds) {
    LAS int* tstart = (LAS int*)(lds + MOE_TAB_OFF);
    LAS int* scnt = (LAS int*)(lds + MOE_TAB_OFF + 1088);
    LAS unsigned short* texp = (LAS unsigned short*)(lds + MOE_TAB_OFF + 2176);
    const int tid = threadIdx.x;
    __syncthreads();
    if (tid < 256) scnt[tid] = (int)cnt[tid];
    __syncthreads();
    if (tid == 0) { int s = 0; for (int e = 0; e < 256; ++e) { tstart[e] = s; s += (scnt[e] + 255) >> 8; } tstart[256] = s; }
    __syncthreads();
    if (tid < 256) for (int q = tstart[tid]; q < tstart[tid + 1]; ++q) texp[q] = (unsigned short)tid;
    __syncthreads();
    return __builtin_amdgcn_readfirstlane(tstart[256]);
}
constexpr int MOE_TOK_OFF = MOE_TAB_OFF + 5120;
constexpr int MOE_MAX_ORD = 20;
struct MoeGuSched {
    static constexpr bool GATHER = true;
    const char* X; const char* W; const int2* list; LAS unsigned char* lds; int R, nunits, G, c;
    __device__ __forceinline__ int vcu() const { return (G % 8 == 0) ? (c % 8) * (G / 8) + c / 8 : c; }
    __device__ __forceinline__ bool next(int i, pg8::Unit& u) const {
        const int L = i * G + vcu(); if (L >= nunits || i >= MOE_MAX_ORD) return false;
        const int q = L >> 1; const int e = __builtin_amdgcn_readfirstlane((q < R) ? (int)((LAS unsigned short*)(lds + MOE_TAB_OFF + 2176))[q] : 256);
        u.pm = q; u.pn = e * 2 + (L & 1); u.ord = i; return true; }
    __device__ __forceinline__ void prepare() const {
        const int tid = threadIdx.x, r = tid & 255;
        pg8::Unit u;
        for (int i = tid >> 8; next(i, u); i += 2) {
            const int e = u.pn >> 1; int token;
            if (e < 256) { const int ts = ((LAS int*)(lds + MOE_TAB_OFF))[e], cn = ((LAS int*)(lds + MOE_TAB_OFF + 1088))[e]; int lr = (u.pm - ts) * 256 + r; if (lr >= cn) lr = cn - 1;
                token = list[(size_t)e * LISTCAP + lr].x / 10; }
            else token = (u.pm - R) * 256 + r;
            ((LAS unsigned short*)(lds + MOE_TOK_OFF))[i * 256 + r] = (unsigned short)token;
        }
        __syncthreads();
    }
    __device__ __forceinline__ unsigned aoff(const pg8::Unit& u, int r) const { return (unsigned)((LAS unsigned short*)(lds + MOE_TOK_OFF))[u.ord * 256 + r] * 1024u; }
    __device__ __forceinline__ unsigned lane_off(int) const { return 0u; }
    __device__ __forceinline__ unsigned unit_off(const pg8::Unit&, int) const { return 0u; }
    __device__ __forceinline__ const char* abase() const { return X; }
    __device__ __forceinline__ const char* bptr(const pg8::Unit& u) const { return W + (size_t)u.pn * (256 * 1024); }
};
constexpr float GU_SC = 1.0f / (X8_SCALE * W8_SCALE);
struct EpiGateUp {
    static constexpr bool PERM = true, PERM16 = false; unsigned char* HID;
    __device__ __forceinline__ void operator()(const f32x4 (&acc)[2][2][4][2], const pg8::Unit& u, int wr, int wc, int fr, int fq) const {
        const int row0 = u.pm * 256 + wr * 64 + fr, c0 = (u.pn & 1) * 128 + wc * 32 + 8 * fq;
#pragma unroll
        EPI_ROWLOOP { const f32x4 g0 = acc[ai][0][m][0] * GU_SC, g1 = acc[ai][0][m][1] * GU_SC;
            f32x4 h0 = g0 * sig4(g0) * (acc[ai][1][m][0] * (GU_SC * H8_SCALE)), h1 = g1 * sig4(g1) * (acc[ai][1][m][1] * (GU_SC * H8_SCALE));
#pragma unroll
            for (int i = 0; i < 4; ++i) { h0[i] = clamp8(h0[i]); h1[i] = clamp8(h1[i]); }
            *(u32x2*)(HID + (size_t)(row0 + ai * 128 + m * 16) * 256 + c0) = pack8_fp8(h0, h1); }
    }
};
constexpr int MOE_RI_OFF = MOE_TAB_OFF + 5120;
constexpr int MOE_MAX_RT = 6;
struct MoeDownSched {
    const char* HID; const char* W; const int2* list; LAS unsigned char* lds; int R, ntile, G, c;
    __device__ __forceinline__ int vcu() const { return (G % 8 == 0) ? (c % 8) * (G / 8) + c / 8 : c; }
    __device__ __forceinline__ bool next(int i, pg8::Unit& u) const {
        const int q = vcu() + G * (i >> 2); if (q >= ntile || (i >> 2) >= MOE_MAX_RT) return false;
        const int e = (q < R) ? (int)((LAS unsigned short*)(lds + MOE_TAB_OFF + 2176))[q] : 256;
        u.pm = q; u.pn = e * 4 + (i & 3); u.ord = i >> 2; return true; }
    __device__ __forceinline__ void prepare() const {
        const int tid = threadIdx.x, r = tid & 255;
        for (int o = tid >> 8; o < MOE_MAX_RT; o += 2) {
            const int q = vcu() + G * o; if (q >= ntile) break;
            u32x2 en;
            if (q < R) { const int e = ((LAS unsigned short*)(lds + MOE_TAB_OFF + 2176))[q]; const int ts = ((LAS int*)(lds + MOE_TAB_OFF))[e], cn = ((LAS int*)(lds + MOE_TAB_OFF + 1088))[e];
                const int lr = (q - ts) * 256 + r; if (lr < cn) { const int2 le = list[(size_t)e * LISTCAP + lr]; en.x = (unsigned)le.x; en.y = (unsigned)le.y; } else { en.x = 0xffffffffu; en.y = 0u; } }
            else { en.x = (unsigned)(((q - R) * 256 + r) * 10 + 8); en.y = __float_as_uint(1.0f); }
            ((LAS u32x2*)(lds + MOE_RI_OFF))[o * 256 + r] = en;
        }
        __syncthreads();
    }
    static constexpr bool GATHER = false;
    __device__ __forceinline__ unsigned lane_off(int r) const { return (unsigned)r * 256u; }
    __device__ __forceinline__ unsigned unit_off(const pg8::Unit& u, int h) const { return (unsigned)(u.pm * 256 + h * 128) * 256u; }
    __device__ __forceinline__ unsigned aoff(const pg8::Unit&, int) const { return 0u; }
    __device__ __forceinline__ const char* abase() const { return HID; }
    __device__ __forceinline__ const char* bptr(const pg8::Unit& u) const { return W + (size_t)u.pn * (256 * 256); }
};
struct EpiDown {
    static constexpr bool PERM = true, PERM16 = true;
    unsigned char* YB; LAS unsigned char* lds;
    __device__ __forceinline__ void operator()(const f32x4 (&acc)[2][2][4][2], const pg8::Unit& u, int wr, int wc, int fr, int fq) const {
        asm volatile("" : "+v"(fr), "+v"(fq));
        const unsigned c0b = (unsigned)((u.pn & 3) * 256 + wc * 64 + 16 * fq); const bool shared = (u.pn >> 2) == 256;
        const LAS u32x2* ri = (const LAS u32x2*)(lds + MOE_RI_OFF) + u.ord * 256 + wr * 64 + fr;
#pragma unroll
        for (int ai = 0; ai < 2; ++ai)
#pragma unroll
            for (int m = 0; m < 4; ++m) { const u32x2 en = ri[ai * 128 + m * 16]; const float wv = __uint_as_float(en.y) * (YB_SCALE / (H8_SCALE * W8_SCALE));
                if ((int)en.x >= 0) { unsigned char* rp = YB + (size_t)(en.x * 1024u + c0b);
                    const f32x4 v00 = acc[ai][0][m][0] * wv, v01 = acc[ai][0][m][1] * wv, v10 = acc[ai][1][m][0] * wv, v11 = acc[ai][1][m][1] * wv;
                    const u32x2 h0 = pack8_fp8(v00, v01), h1 = pack8_fp8(v10, v11);
                    *(u32x4*)rp = (u32x4){h0.x, h0.y, h1.x, h1.y};
                    if (shared) {
                        u32x2 r_[2];
#pragma unroll
                        for (int bj = 0; bj < 2; ++bj) { const u32x2 h = bj ? h1 : h0; const f32x4 v0 = bj ? v10 : v00, v1 = bj ? v11 : v01;
                            const auto a0 = __builtin_amdgcn_cvt_pk_f32_fp8((int)h.x, false), a1 = __builtin_amdgcn_cvt_pk_f32_fp8((int)h.x, true), a2 = __builtin_amdgcn_cvt_pk_f32_fp8((int)h.y, false), a3 = __builtin_amdgcn_cvt_pk_f32_fp8((int)h.y, true);
                            const f32x4 r0 = {v0[0] - a0[0], v0[1] - a0[1], v0[2] - a1[0], v0[3] - a1[1]}, r1 = {v1[0] - a2[0], v1[1] - a2[1], v1[2] - a3[0], v1[3] - a3[1]};
                            r_[bj] = pack8_fp8(r0, r1); }
                        *(u32x4*)(rp + 1024) = (u32x4){r_[0].x, r_[0].y, r_[1].x, r_[1].y}; } } }
    }
};

struct EpiInprojN {
    static constexpr bool PERM = true, PERM16 = false; bf16_t* QN; bf16_t* QR; bf16_t* KV6; float* GATES; const float* ROT;
    __device__ __forceinline__ void operator()(const f32x4 (&acc)[2][2][4][2], const pg8::Unit& u, int wr, int wc, int fr, int fq) const {
        const int row0 = u.pm * 256 + wr * 64 + fr, cl = wc * 32 + 8 * fq, pn = u.pn;
        const bool isq = pn < 4, rotk = (pn == 6 || pn == 8), dorot = (isq || rotk) && ((wc & 1) == 0);
#pragma unroll
        EPI_ROWLOOP { const int row = row0 + ai * 128 + m * 16;
            if (pn == 10) {
                if (cl < 48) { *(f32x4*)(GATES + (size_t)row * 48 + cl) = sig4(acc[ai][0][m][0]); *(f32x4*)(GATES + (size_t)row * 48 + cl + 4) = sig4(acc[ai][0][m][1]); }
            } else {
                f32x4 cs0, cs1, sn0, sn1;
                if (dorot) { const float* rt = ROT + (size_t)(row & (T - 1)) * 16; cs0 = *(const f32x4*)rt; cs1 = *(const f32x4*)(rt + 4); sn0 = *(const f32x4*)(rt + 8); sn1 = *(const f32x4*)(rt + 12); }
#pragma unroll
                for (int bj = 0; bj < 2; ++bj) {
                    const f32x4 v0 = acc[ai][bj][m][0], v1 = acc[ai][bj][m][1];
                    f32x4 r0 = v0, r1 = v1;
                    if (dorot) {
                        f32x4 p0, p1;
#pragma unroll
                        for (int i = 0; i < 4; ++i) { p0[i] = __shfl_xor(v0[i], 16); p1[i] = __shfl_xor(v1[i], 16); }
                        if (fq == 0) { r0 = v0 * cs0 - p0 * sn0; r1 = v1 * cs1 - p1 * sn1; }
                        else if (fq == 1) { r0 = v0 * cs0 + p0 * sn0; r1 = v1 * cs1 + p1 * sn1; }
                    }
                    if (isq) { const int c = pn * 256 + bj * 128 + cl;
                        *(u32x4*)(QN + (size_t)row * 1024 + c) = pack8(v0 * QSCALE, v1 * QSCALE); *(u32x4*)(QR + (size_t)row * 1024 + c) = pack8(r0 * QSCALE, r1 * QSCALE); }
                    else { const int cc = bj * 128 + cl, g = cc >> 6, d = cc & 63, b = row >> 13, t = row & (T - 1);
                        *(u32x4*)(KV6 + ((size_t)((pn - 4) * 16 + b * 4 + g) * T + t) * 64 + d) = pack8(r0, r1); }
                }
            } }
    }
};

struct Cmp1Sched {
    const char* KV6; const char* W; int G, c;
    static constexpr bool GATHER = false;
    __device__ __forceinline__ bool next(int i, pg8::Unit& u) const { const int L = i * G + c; if (L >= 64) return false; u.pm = L >> 1; u.pn = L & 1; u.ord = i; return true; }
    __device__ __forceinline__ unsigned lane_off(int r) const { return (unsigned)r * 2048u; }
    __device__ __forceinline__ unsigned unit_off(const pg8::Unit& u, int h) const { return (unsigned)u.pn * (unsigned)(16 * T * 64 * 2) + (unsigned)(u.pm * 256 + h * 128) * 2048u; }
    __device__ __forceinline__ unsigned aoff(const pg8::Unit&, int) const { return 0u; }
    __device__ __forceinline__ const char* abase() const { return KV6; }
    __device__ __forceinline__ const char* bptr(const pg8::Unit& u) const { return W + (size_t)u.pn * (256 * 2048 * 2); }
};
struct EpiCmp1 {
    static constexpr bool PERM = true, PERM16 = false; bf16_t* CH1; const float* bias1;
    __device__ __forceinline__ void operator()(const f32x4 (&acc)[2][2][4][2], const pg8::Unit& u, int wr, int wc, int fr, int fq) const {
        const int row0 = u.pm * 256 + wr * 64 + fr, cl = wc * 32 + 8 * fq;
        const f32x4 b0 = *(const f32x4*)(bias1 + u.pn * 128 + cl), b1 = *(const f32x4*)(bias1 + u.pn * 128 + cl + 4);
#pragma unroll
        EPI_ROWLOOP { f32x4 v0 = acc[ai][0][m][0] + b0, v1 = acc[ai][0][m][1] + b1;
#pragma unroll
            for (int i = 0; i < 4; ++i) { v0[i] = gelu_tanh(v0[i]); v1[i] = gelu_tanh(v1[i]); }
            *(u32x4*)(CH1 + ((size_t)u.pn * 8192 + row0 + ai * 128 + m * 16) * 128 + cl) = pack8(v0, v1); }
    }
};

__device__ __forceinline__ void p0_item(const float* W, int K, int N, bf16_t* WT, int kb, int n0, int drow0, LAS float* scr, int lane, bool f8 = false) {
    const int k0 = 64 * kb, n4 = (lane & 15) * 4;
    const bool cok = (n0 + n4) < N;
    f32x4 v[16];
#pragma unroll
    for (int i = 0; i < 16; ++i) { const int kk = 4 * i + (lane >> 4); v[i] = cok ? __builtin_nontemporal_load((const f32x4*)(W + (size_t)(k0 + kk) * N + n0 + n4)) : (f32x4){0.f, 0.f, 0.f, 0.f}; }
#pragma unroll
    for (int i = 0; i < 16; ++i) { const int kk = 4 * i + (lane >> 4); LAS float* d = scr + kk * 65 + n4; d[0] = v[i][0]; d[1] = v[i][1]; d[2] = v[i][2]; d[3] = v[i][3]; }
    asm volatile("s_waitcnt lgkmcnt(0)" ::: "memory");
    if (f8) {
        const int c4 = lane & 3;
#pragma unroll
        for (int j = 0; j < 4; ++j) { const int n = (lane >> 2) + 16 * j; const LAS float* sp = scr + (16 * c4) * 65 + n;
            u32x4 o;
            o.x = pk4_fp8(sp[0 * 65] * W8_SCALE, sp[1 * 65] * W8_SCALE, sp[2 * 65] * W8_SCALE, sp[3 * 65] * W8_SCALE); o.y = pk4_fp8(sp[4 * 65] * W8_SCALE, sp[5 * 65] * W8_SCALE, sp[6 * 65] * W8_SCALE, sp[7 * 65] * W8_SCALE);
            o.z = pk4_fp8(sp[8 * 65] * W8_SCALE, sp[9 * 65] * W8_SCALE, sp[10 * 65] * W8_SCALE, sp[11 * 65] * W8_SCALE); o.w = pk4_fp8(sp[12 * 65] * W8_SCALE, sp[13 * 65] * W8_SCALE, sp[14 * 65] * W8_SCALE, sp[15 * 65] * W8_SCALE);
            if (n0 + n < N) __builtin_nontemporal_store(o, (u32x4*)((unsigned char*)WT + (size_t)(drow0 + n) * K + k0 + 16 * c4)); }
        asm volatile("s_waitcnt lgkmcnt(0)" ::: "memory");
        return;
    }
    const int c = lane & 7;
#pragma unroll
    for (int j = 0; j < 8; ++j) { const int n = (lane >> 3) + 8 * j; const LAS float* sp = scr + (8 * c) * 65 + n;
        u32x4 o; o.x = pk2(sp[0 * 65], sp[1 * 65]); o.y = pk2(sp[2 * 65], sp[3 * 65]); o.z = pk2(sp[4 * 65], sp[5 * 65]); o.w = pk2(sp[6 * 65], sp[7 * 65]);
        if (n0 + n < N) __builtin_nontemporal_store(o, (u32x4*)(WT + (size_t)(drow0 + n) * K + k0 + 8 * c)); }
    asm volatile("s_waitcnt lgkmcnt(0)" ::: "memory");
}
struct CvtItem { const float* W; bf16_t* WT; int K, N, k0, n0, drow0; };
__device__ __forceinline__ void cvt32_load(const CvtItem& it, int lane, f32x4 (&v)[8]) {
    const int n4 = (lane & 7) * 4;
#pragma unroll
    for (int i = 0; i < 8; ++i) { const int kk = 8 * i + (lane >> 3); v[i] = __builtin_nontemporal_load((const f32x4*)(it.W + (size_t)(it.k0 + kk) * it.N + it.n0 + n4)); }
}
__device__ __forceinline__ void cvt32_finish(const CvtItem& it, int lane, const f32x4 (&v)[8], LAS float* scr) {
    const int n4 = (lane & 7) * 4;
#pragma unroll
    for (int i = 0; i < 8; ++i) { const int kk = 8 * i + (lane >> 3); LAS float* d = scr + kk * 33 + n4; d[0] = v[i][0]; d[1] = v[i][1]; d[2] = v[i][2]; d[3] = v[i][3]; }
    asm volatile("s_waitcnt lgkmcnt(0)" ::: "memory");
    const int c = lane & 7;
#pragma unroll
    for (int j = 0; j < 4; ++j) { const int n = (lane >> 3) + 8 * j; const LAS float* sp = scr + (8 * c) * 33 + n;
        const float v0 = sp[0 * 33], v1 = sp[1 * 33], v2 = sp[2 * 33], v3 = sp[3 * 33], v4 = sp[4 * 33], v5 = sp[5 * 33], v6 = sp[6 * 33], v7 = sp[7 * 33];
        u32x2 o; o.x = pk4_fp8(v0 * W8_SCALE, v1 * W8_SCALE, v2 * W8_SCALE, v3 * W8_SCALE); o.y = pk4_fp8(v4 * W8_SCALE, v5 * W8_SCALE, v6 * W8_SCALE, v7 * W8_SCALE);
        __builtin_nontemporal_store(o, (u32x2*)((unsigned char*)it.WT + (size_t)(it.drow0 + n) * it.K + it.k0 + 8 * c)); }
    asm volatile("s_waitcnt lgkmcnt(0)" ::: "memory");
}
constexpr int CVT1_ITEMS = 257 * 384;
__device__ __forceinline__ CvtItem cvt1_item(const Args& a, int idx) {
    const int e = idx / 384, sub = idx % 384, mat = sub >> 7, r = sub & 127;
    CvtItem it;
    if (mat < 2) { it.W = (e < 256) ? a.in[23 + mat] + ((size_t)256 + e) * (size_t)(D * FF) : a.in[26 + mat] + (size_t)(D * FF);
        it.K = D; it.N = FF; it.k0 = (r >> 3) * 64; it.n0 = (r & 7) * 32; it.drow0 = (it.n0 >> 7) * 256 + mat * 128 + (it.n0 & 127);
        it.WT = (bf16_t*)(a.ws + WS_WGU + (size_t)(257 + e) * 512 * 1024); }
    else { it.W = (e < 256) ? a.in[25] + ((size_t)256 + e) * (size_t)(FF * D) : a.in[28] + (size_t)(FF * D);
        it.K = FF; it.N = D; it.k0 = (r >> 5) * 64; it.n0 = (r & 31) * 32; it.drow0 = it.n0;
        it.WT = (bf16_t*)(a.ws + WS_WD + (size_t)(257 + e) * 1024 * 256); }
    return it;
}
__device__ __forceinline__ void cvt1_run(const Args& a, int& next, int stride, int quota, LAS float* scr, int lane) {
#pragma unroll 1
    for (int q = 0; q < quota && next < CVT1_ITEMS; ++q) {
        CvtItem t[4]; f32x4 v[4][8]; bool ok[4];
#pragma unroll
        for (int u = 0; u < 4; ++u) { const int idx = next + u * stride; ok[u] = idx < CVT1_ITEMS; t[u] = cvt1_item(a, ok[u] ? idx : 0); if (ok[u]) cvt32_load(t[u], lane, v[u]); }
        next += 4 * stride;
#pragma unroll
        for (int u = 0; u < 4; ++u) if (ok[u]) cvt32_finish(t[u], lane, v[u], scr);
    }
}
__device__ __forceinline__ void ph_prologue(const Args& a, LAS unsigned char* lds) {
    const int lane = threadIdx.x & 63, wave = threadIdx.x >> 6;
    LAS float* scr = (LAS float*)(lds + wave * 16640);
    const int gw = blockIdx.x * 8 + wave, ngw = gridDim.x * 8;
    for (int it = gw; it < 257 * 192; it += ngw) {
        const int le = it / 192, sub = it % 192, l = 0, e = le, mat = sub >> 6, r = sub & 63;
        if (mat < 2) {
            const float* W = (e < 256) ? a.in[23 + mat] + ((size_t)l * 256 + e) * (size_t)(D * FF) : a.in[26 + mat] + (size_t)l * (D * FF);
            const int kb = r >> 2, n0 = (r & 3) * 64;
            p0_item(W, D, FF, (bf16_t*)(a.ws + WS_WGU + (size_t)le * 512 * 1024), kb, n0, (n0 >> 7) * 256 + mat * 128 + (n0 & 127), scr, lane, true);
        } else {
            const float* W = (e < 256) ? a.in[25] + ((size_t)l * 256 + e) * (size_t)(FF * D) : a.in[28] + (size_t)l * (FF * D);
            const int kb = r >> 4, n0 = (r & 15) * 64;
            p0_item(W, FF, D, (bf16_t*)(a.ws + WS_WD + (size_t)le * 1024 * 256), kb, n0, n0, scr, lane, true);
        }
    }
    {
        for (int it = gw; it < 512; it += ngw) { const int w = it >> 8, r = it & 255;
            p0_item(a.in[w ? 16 : 8], D, D, (bf16_t*)(a.ws + (w ? WS_WOUTN : WS_WOUT0)), r >> 4, (r & 15) * 64, (r & 15) * 64, scr, lane); }
        for (int it = gw; it < 16 * 41; it += ngw) p0_item(a.in[9], D, 2608, (bf16_t*)(a.ws + WS_WINN), it / 41, (it % 41) * 64, (it % 41) * 64, scr, lane);
        for (int it = gw; it < 128; it += ngw) { const int l = it >> 6, r = it & 63;
            p0_item(a.in[21] + (size_t)l * D * NE, D, NE, (bf16_t*)(a.ws + WS_WR) + (size_t)l * NE * D, r >> 2, (r & 3) * 64, (r & 3) * 64, scr, lane); }
        for (int it = gw; it < 16 * 16; it += ngw) { const int kb = it >> 4, n0 = (8 + (it & 15)) * 64;
            const int isg = (n0 >= 1024) ? 1 : 0, rel = n0 - 512 - isg * 512;
            p0_item(a.in[1], D, 1536, (bf16_t*)(a.ws + WS_WIN0), kb, n0, 512 + (rel >> 7) * 256 + isg * 128 + (rel & 127), scr, lane); }
        for (int it = gw; it < 128; it += ngw) { const int kv = it >> 6, r = it & 63;
            p0_item(a.in[kv ? 14 : 11], 2048, 128, (bf16_t*)(a.ws + WS_CW1) + (size_t)kv * 256 * 2048, r >> 1, (r & 1) * 64, (r & 1) * 64, scr, lane); }
    }
    {
        const int gt = blockIdx.x * 512 + threadIdx.x, ngt = gridDim.x * 512;
        u32x4* z0 = (u32x4*)((bf16_t*)(a.ws + WS_WINN) + (size_t)2608 * 1024);
        for (int i = gt; i < 208 * 1024 / 8; i += ngt) z0[i] = (u32x4){0u, 0u, 0u, 0u};
        for (int kv = 0; kv < 2; ++kv) { u32x4* z1 = (u32x4*)((bf16_t*)(a.ws + WS_CW1) + ((size_t)kv * 256 + 128) * 2048);
            for (int i = gt; i < 128 * 2048 / 8; i += ngt) z1[i] = (u32x4){0u, 0u, 0u, 0u}; }
        const float* x = a.in[0]; bf16_t* XA = (bf16_t*)(a.ws + WS_XA);
        for (size_t i = gt; i < (size_t)M * D / 8; i += ngt) { const f32x4 v0 = *(const f32x4*)(x + i * 8), v1 = *(const f32x4*)(x + i * 8 + 4);
            u32x4 o; o.x = pk2(v0[0], v0[1]); o.y = pk2(v0[2], v0[3]); o.z = pk2(v1[0], v1[1]); o.w = pk2(v1[2], v1[3]); *(u32x4*)(XA + i * 8) = o; }
        const float* win = a.in[1]; const float* mix = a.in[2]; const float* psc = a.in[3]; bf16_t* WIN0 = (bf16_t*)(a.ws + WS_WIN0);
        for (int i = gt; i < 512 * 1024; i += ngt) { const int n = i & 511, k = i >> 9, g = n >> 7, nn = n & 127;
            const float* wr_ = win + (size_t)k * 1536 + g * 128; const float* mx = mix + (size_t)g * 128 * 128 + nn;
            float s = 0.f;
            for (int c = 0; c < 128; ++c) s += wr_[c] * mx[(size_t)c * 128];
            WIN0[(size_t)n * 1024 + k] = f2bf(s * psc[n]); }
        float* misc = (float*)(a.ws + WS_MISC);
        for (int i = gt; i < 256; i += ngt) { const int kv = i >> 7, j = i & 127; const float* pos = a.in[kv ? 13 : 10]; const float* w1 = a.in[kv ? 14 : 11];
            float s = 0.f; for (int k = 0; k < 2048; ++k) s += pos[k] * w1[(size_t)k * 128 + j]; misc[i] = s; }
        float* rot = misc + 1024;
        for (int i = gt; i < T * 8; i += ngt) { const int t = i >> 3, f = i & 7;
            const float ang = (float)t * a.inv_freq[f]; const double rev = (double)ang * 0.15915494309189535; const float fr = (float)(rev - floor(rev));
            rot[t * 16 + f] = __builtin_amdgcn_cosf(fr); rot[t * 16 + 8 + f] = __builtin_amdgcn_sinf(fr); }
    }
}

typedef short v4i16_t __attribute__((ext_vector_type(4)));
constexpr int AT_KB = 0, AT_VB = 16384, AT_PS = 32768, AT_MSK = 32768 + 65536;
__device__ __forceinline__ bf16x8 tr_frag(LAS unsigned char* p0, LAS unsigned char* p1) {
    const v4i16_t a = __builtin_amdgcn_ds_read_tr16_b64_v4i16((LAS v4i16_t*)p0), b = __builtin_amdgcn_ds_read_tr16_b64_v4i16((LAS v4i16_t*)p1);
    return (bf16x8){a[0], a[1], a[2], a[3], b[0], b[1], b[2], b[3]};
}
constexpr size_t TN2_OFF = 786432;
__device__ __forceinline__ void ph_knorm(const Args& a) {
    const bf16_t* KV6 = (const bf16_t*)(a.ws + WS_KV6);
    float* TN2 = (float*)(a.ws + WS_MISC + TN2_OFF);
    const int lane = threadIdx.x & 63, wave = threadIdx.x >> 6;
    const int first = (gridDim.x > 64) ? 64 : 0;
    if ((int)blockIdx.x < first) return;
    const int wi = ((int)blockIdx.x - first) * 8 + wave, nw = ((int)gridDim.x - first) * 8;
    for (int id = wi; id < 4096; id += nw) {
        const int ty = id >> 11, bg = (id >> 7) & 15, tile = id & 127;
        const bf16_t* rp = KV6 + ((size_t)((ty ? 4 : 2) * 16 + bg) * T + tile * 64 + lane) * 64;
        float ssq = 0.f;
#pragma unroll
        for (int c = 0; c < 8; ++c) { const bf16x8 v = *(const bf16x8*)(rp + 8 * c);
#pragma unroll
            for (int j = 0; j < 8; ++j) { const float f = bf2f((bf16_t)v[j]); ssq += f * f; } }
        ssq = wave_max(ssq);
        if (lane == 0) TN2[id] = ssq;
    }
}
__device__ __forceinline__ void attn_qk2(LAS unsigned char* Kb, const bf16x8 (&q)[2][2], int fr, int g4, const float (&cinit)[2], f32x4 (&s)[2][4]) {
#pragma unroll
    for (int c = 0; c < 4; ++c) {
#pragma unroll
        for (int rb = 0; rb < 2; ++rb) s[rb][c] = (f32x4){cinit[rb], cinit[rb], cinit[rb], cinit[rb]};
#pragma unroll
        for (int ks = 0; ks < 2; ++ks) {
            const bf16x8 kf = *(const LAS bf16x8*)(Kb + pg8::lds_byte(16 * c + fr, 32 * ks + 8 * g4));
#pragma unroll
            for (int rb = 0; rb < 2; ++rb) s[rb][c] = __builtin_amdgcn_mfma_f32_16x16x32_bf16(kf, q[rb][ks], s[rb][c], 0, 0, 0);
        }
    }
}
__device__ __forceinline__ void attn_qk2z(LAS unsigned char* Kb, const bf16x8 (&q)[2][2], int fr, int g4, f32x4 (&s)[2][4]) {
    bf16x8 kf[4][2];
#pragma unroll
    for (int c = 0; c < 4; ++c)
#pragma unroll
        for (int ks = 0; ks < 2; ++ks) kf[c][ks] = *(const LAS bf16x8*)(Kb + pg8::lds_byte(16 * c + fr, 32 * ks + 8 * g4));
    __builtin_amdgcn_sched_barrier(0);
#pragma unroll
    for (int c = 0; c < 4; ++c) {
#pragma unroll
        for (int ks = 0; ks < 2; ++ks) {
#pragma unroll
            for (int rb = 0; rb < 2; ++rb) s[rb][c] = __builtin_amdgcn_mfma_f32_16x16x32_bf16(kf[c][ks], q[rb][ks], ks == 0 ? (f32x4){0.f, 0.f, 0.f, 0.f} : s[rb][c], 0, 0, 0);
        }
    }
}
struct AttnRow { float m; f32x4 o[4]; f32x4 ol; };
__device__ __forceinline__ float max3f(float a, float b, float c) { float r; asm("v_max3_f32 %0, %1, %2, %3" : "=v"(r) : "v"(a), "v"(b), "v"(c)); return r; }
__device__ __forceinline__ bool attn_sm2(f32x4 (&s)[4], AttnRow& st, int kbase, int g4, int lo, int hi, bool en, bool emask) {
    const float NEG = -INFINITY;
    if (emask) {
#pragma unroll
        for (int c = 0; c < 4; ++c)
#pragma unroll
            for (int i = 0; i < 4; ++i) { const int key = kbase + 16 * c + 4 * g4 + i; if (key < lo || key > hi) s[c][i] = NEG; }
    }
    float mx = max3f(s[0][0], s[0][1], s[0][2]); mx = max3f(mx, s[0][3], s[1][0]); mx = max3f(mx, s[1][1], s[1][2]); mx = max3f(mx, s[1][3], s[2][0]);
    mx = max3f(mx, s[2][1], s[2][2]); mx = max3f(mx, s[2][3], s[3][0]); mx = max3f(mx, s[3][1], s[3][2]); mx = max3f(mx, s[3][3], mx);
    if (!en) mx = NEG;
    mx = max3f(mx, __shfl_xor(mx, 16), mx); mx = max3f(mx, __shfl_xor(mx, 32), mx);
    const float delta = (mx > 20.0f) ? mx : 0.f;
    const bool moved = __builtin_amdgcn_ballot_w64(delta != 0.f) != 0ull;
    if (moved) {
        const float alpha = __builtin_amdgcn_exp2f(-delta);
#pragma unroll
        for (int c = 0; c < 4; ++c) s[c] = s[c] - delta;
#pragma unroll
        for (int dt = 0; dt < 4; ++dt) st.o[dt] *= alpha;
        st.ol *= alpha;
        st.m += delta;
    }
#pragma unroll
    for (int c = 0; c < 4; ++c)
#pragma unroll
        for (int i = 0; i < 4; ++i) s[c][i] = __builtin_amdgcn_exp2f(s[c][i]);
    return moved;
}
__device__ __forceinline__ bool attn_sm2x(f32x4 (&s)[2][4], AttnRow (&st)[2], int kbase, int g4, const int (&lo)[2], const int (&hi)[2], const bool (&en)[2], bool emask) {
    const float NEG = -INFINITY;
    if (emask) {
#pragma unroll
        for (int rb = 0; rb < 2; ++rb)
#pragma unroll
            for (int c = 0; c < 4; ++c)
#pragma unroll
                for (int i = 0; i < 4; ++i) { const int key = kbase + 16 * c + 4 * g4 + i; if (key < lo[rb] || key > hi[rb]) s[rb][c][i] = NEG; }
    }
    float mx[2];
#pragma unroll
    for (int rb = 0; rb < 2; ++rb) {
        float m = max3f(s[rb][0][0], s[rb][0][1], s[rb][0][2]); m = max3f(m, s[rb][0][3], s[rb][1][0]); m = max3f(m, s[rb][1][1], s[rb][1][2]); m = max3f(m, s[rb][1][3], s[rb][2][0]);
        m = max3f(m, s[rb][2][1], s[rb][2][2]); m = max3f(m, s[rb][2][3], s[rb][3][0]); m = max3f(m, s[rb][3][1], s[rb][3][2]); m = max3f(m, s[rb][3][3], m);
        mx[rb] = en[rb] ? m : NEG;
    }
    { const float t0 = __shfl_xor(mx[0], 16), t1 = __shfl_xor(mx[1], 16); mx[0] = max3f(mx[0], t0, t0); mx[1] = max3f(mx[1], t1, t1); }
    { const float t0 = __shfl_xor(mx[0], 32), t1 = __shfl_xor(mx[1], 32); mx[0] = max3f(mx[0], t0, t0); mx[1] = max3f(mx[1], t1, t1); }
    const float d0 = (mx[0] > 20.0f) ? mx[0] : 0.f, d1 = (mx[1] > 20.0f) ? mx[1] : 0.f;
    const bool moved = __builtin_amdgcn_ballot_w64((d0 != 0.f) || (d1 != 0.f)) != 0ull;
    if (moved) {
        const float dl[2] = {d0, d1};
#pragma unroll
        for (int rb = 0; rb < 2; ++rb) {
            const float alpha = __builtin_amdgcn_exp2f(-dl[rb]);
#pragma unroll
            for (int c = 0; c < 4; ++c) s[rb][c] = s[rb][c] - dl[rb];
#pragma unroll
            for (int dt = 0; dt < 4; ++dt) st[rb].o[dt] *= alpha;
            st[rb].ol *= alpha; st[rb].m += dl[rb];
        }
    }
#pragma unroll
    for (int rb = 0; rb < 2; ++rb)
#pragma unroll
        for (int c = 0; c < 4; ++c)
#pragma unroll
            for (int i = 0; i < 4; ++i) s[rb][c][i] = __builtin_amdgcn_exp2f(s[rb][c][i]);
    return moved;
}
__device__ __forceinline__ void attn_pv2x(LAS unsigned char* Vb, const f32x4 (&p)[2][4], int vlane, int swz, const unsigned (&enm)[2], const bool (&act)[2], const bf16x8 onesf, AttnRow (&st)[2]) {
#pragma unroll
    for (int ks = 0; ks < 2; ++ks) {
        bf16x8 pb[2];
#pragma unroll
        for (int rb = 0; rb < 2; ++rb) { u32x4 pw = pack8m(p[rb][2 * ks], p[rb][2 * ks + 1]); pw.x &= enm[rb]; pw.y &= enm[rb]; pw.z &= enm[rb]; pw.w &= enm[rb]; pb[rb] = __builtin_bit_cast(bf16x8, pw); }
#pragma unroll
        for (int dt = 0; dt < 4; ++dt) {
            LAS unsigned char* a0 = Vb + vlane + (2 * ks) * 2048 + ((dt ^ swz) * 32);
            const bf16x8 vf = tr_frag(a0, a0 + 2048);
#pragma unroll
            for (int rb = 0; rb < 2; ++rb) if (act[rb]) st[rb].o[dt] = __builtin_amdgcn_mfma_f32_16x16x32_bf16(vf, pb[rb], st[rb].o[dt], 0, 0, 0);
        }
#pragma unroll
        for (int rb = 0; rb < 2; ++rb) if (act[rb]) st[rb].ol = __builtin_amdgcn_mfma_f32_16x16x32_bf16(onesf, pb[rb], st[rb].ol, 0, 0, 0);
    }
}
__device__ __forceinline__ bool attn_max2x(f32x4 (&s)[2][4], int kbase, int g4, const int (&lo)[2], const int (&hi)[2], const bool (&en)[2], bool emask, float (&d)[2]) {
    const float NEG = -INFINITY;
    MFMA_SETTLE(s);
    if (emask) {
#pragma unroll
        for (int rb = 0; rb < 2; ++rb)
#pragma unroll
            for (int c = 0; c < 4; ++c)
#pragma unroll
                for (int i = 0; i < 4; ++i) { const int key = kbase + 16 * c + 4 * g4 + i; if (key < lo[rb] || key > hi[rb]) s[rb][c][i] = NEG; }
    }
    float mx[2];
#pragma unroll
    for (int rb = 0; rb < 2; ++rb) {
        float m = max3f(s[rb][0][0], s[rb][0][1], s[rb][0][2]); m = max3f(m, s[rb][0][3], s[rb][1][0]); m = max3f(m, s[rb][1][1], s[rb][1][2]); m = max3f(m, s[rb][1][3], s[rb][2][0]);
        m = max3f(m, s[rb][2][1], s[rb][2][2]); m = max3f(m, s[rb][2][3], s[rb][3][0]); m = max3f(m, s[rb][3][1], s[rb][3][2]); m = max3f(m, s[rb][3][3], m);
        mx[rb] = en[rb] ? m : NEG;
    }
    { const float t0 = __shfl_xor(mx[0], 16), t1 = __shfl_xor(mx[1], 16); mx[0] = max3f(mx[0], t0, t0); mx[1] = max3f(mx[1], t1, t1); }
    { const float t0 = __shfl_xor(mx[0], 32), t1 = __shfl_xor(mx[1], 32); mx[0] = max3f(mx[0], t0, t0); mx[1] = max3f(mx[1], t1, t1); }
    d[0] = (mx[0] > 20.0f) ? mx[0] : 0.f; d[1] = (mx[1] > 20.0f) ? mx[1] : 0.f;
    return __builtin_amdgcn_ballot_w64((d[0] != 0.f) || (d[1] != 0.f)) != 0ull;
}
__device__ __forceinline__ void attn_rescale2x(f32x4 (&s)[2][4], AttnRow (&st)[2], const float (&d)[2]) {
#pragma unroll
    for (int rb = 0; rb < 2; ++rb) {
        const float alpha = __builtin_amdgcn_exp2f(-d[rb]);
#pragma unroll
        for (int c = 0; c < 4; ++c) s[rb][c] = s[rb][c] - d[rb];
#pragma unroll
        for (int dt = 0; dt < 4; ++dt) st[rb].o[dt] *= alpha;
        st[rb].ol *= alpha; st[rb].m += d[rb];
    }
}
__device__ __forceinline__ void attn_exp1(f32x4 (&s)[4], unsigned enm, bf16x8 (&pb)[2]) {
#pragma unroll
    for (int c = 0; c < 4; ++c)
#pragma unroll
        for (int i = 0; i < 4; ++i) s[c][i] = __builtin_amdgcn_exp2f(s[c][i]);
#pragma unroll
    for (int ks = 0; ks < 2; ++ks) { u32x4 pw = pack8m(s[2 * ks], s[2 * ks + 1]); pw.x &= enm; pw.y &= enm; pw.z &= enm; pw.w &= enm; pb[ks] = __builtin_bit_cast(bf16x8, pw); }
}
__device__ __forceinline__ void attn_pv1(LAS unsigned char* Vb, const bf16x8 (&pb)[2], int vlane, int swz, const bf16x8 onesf, AttnRow& st) {
#pragma unroll
    for (int ks = 0; ks < 2; ++ks) {
#pragma unroll
        for (int dt = 0; dt < 4; ++dt) {
            LAS unsigned char* a0 = Vb + vlane + (2 * ks) * 2048 + ((dt ^ swz) * 32);
            const bf16x8 vf = tr_frag(a0, a0 + 2048);
            st.o[dt] = __builtin_amdgcn_mfma_f32_16x16x32_bf16(vf, pb[ks], st.o[dt], 0, 0, 0);
        }
        st.ol = __builtin_amdgcn_mfma_f32_16x16x32_bf16(onesf, pb[ks], st.ol, 0, 0, 0);
    }
}
__device__ __forceinline__ bool attn_step2x(LAS unsigned char* Vb, f32x4 (&s)[2][4], AttnRow (&st)[2], int kbase, int g4, const int (&lo)[2], const int (&hi)[2], const bool (&en)[2], const unsigned (&enm)[2], bool emask,
                                            int vlane, int swz, const bf16x8 onesf) {
    float d[2];
    const bool moved = attn_max2x(s, kbase, g4, lo, hi, en, emask, d);
    if (moved) attn_rescale2x(s, st, d);
    bf16x8 p0[2], p1[2];
    attn_exp1(s[0], enm[0], p0);
    attn_pv1(Vb, p0, vlane, swz, onesf, st[0]);
    attn_exp1(s[1], enm[1], p1);
    attn_pv1(Vb, p1, vlane, swz, onesf, st[1]);
    return moved;
}
__device__ __forceinline__ void attn_step2x_nomax(LAS unsigned char* Vb, f32x4 (&s)[2][4], AttnRow (&st)[2], int kbase, int g4, const int (&lo)[2], const int (&hi)[2], const unsigned (&enm)[2], bool emask,
                                                  int vlane, int swz, const bf16x8 onesf) {
    if (emask) {
#pragma unroll
        for (int rb = 0; rb < 2; ++rb)
#pragma unroll
            for (int c = 0; c < 4; ++c)
#pragma unroll
                for (int i = 0; i < 4; ++i) { const int key = kbase + 16 * c + 4 * g4 + i; if (key < lo[rb] || key > hi[rb]) s[rb][c][i] = -INFINITY; }
    }
    bf16x8 p0[2], p1[2];
    attn_exp1(s[0], enm[0], p0);
    attn_pv1(Vb, p0, vlane, swz, onesf, st[0]);
    attn_exp1(s[1], enm[1], p1);
    attn_pv1(Vb, p1, vlane, swz, onesf, st[1]);
}
typedef _Float16 f16x4 __attribute__((ext_vector_type(4)));
constexpr int AT4_KB = 0, AT4_VB = 32768, AT2_PS = 65536, AT2_MSK = 65536 + 65536;
__device__ __forceinline__ void ph_attn_fast2(const Args& a, LAS unsigned char* lds) {
    const bf16_t* QN = (const bf16_t*)(a.ws + WS_HN);
    const bf16_t* QR = (const bf16_t*)(a.ws + WS_QR);
    const bf16_t* KV6 = (const bf16_t*)(a.ws + WS_KV6);
    const float* GATES = (const float*)(a.ws + WS_GATES);
    const bf16_t* KC = (const bf16_t*)(a.ws + WS_KC);
    const bf16_t* VC = KC + (size_t)8192 * 64;
    bf16_t* O = (bf16_t*)(a.ws + WS_O);
    const int tid = threadIdx.x, lane = tid & 63, wave = __builtin_amdgcn_readfirstlane(tid >> 6);
    const int fr = lane & 15, g4 = lane >> 4;
    int ksrc, vsrc;
    { int R, C; pg8::stage_rc(wave * 1024 + lane * 16, R, C); ksrc = R * 64 + C;
      const int key = 8 * wave + (lane >> 3), pos = lane & 7, chunk = (pos >> 1) ^ ((key >> 1) & 3); vsrc = key * 64 + (chunk * 2 + (pos & 1)) * 8; }
    const int vlane = (4 * g4 + (fr >> 2)) * 128 + (fr & 3) * 8, swz = (2 * g4 + (fr >> 3)) & 3;
    LAS _Float16* ps = (LAS _Float16*)(lds + AT2_PS + wave * 8192);
    LAS unsigned* mskl = (LAS unsigned*)(lds + AT2_MSK + wave * 128);
    const float NEG = -INFINITY;
    const bf16x8 onesf = (fr == 0) ? (bf16x8){0x3F80, 0x3F80, 0x3F80, 0x3F80, 0x3F80, 0x3F80, 0x3F80, 0x3F80} : (bf16x8){0, 0, 0, 0, 0, 0, 0, 0};
    const int vcu = (gridDim.x % 8 == 0) ? (int)((blockIdx.x % 8) * (gridDim.x / 8) + blockIdx.x / 8) : (int)blockIdx.x;
    int cvt_next = (int)blockIdx.x * 8 + wave; const int cvt_stride = (int)gridDim.x * 8;
    LAS float* cvt_scr = (LAS float*)(lds + AT2_PS + wave * 8448);
    for (int pr = vcu; pr < 1024; pr += gridDim.x) {
#pragma unroll 1
        for (int half = 0; half < 2; ++half) {
            const int bg = pr >> 6, cc = half ? (127 - (pr & 63)) : (pr & 63);
            const int b = bg >> 2, g = bg & 3, t0 = cc * 64, cur = cc;
            const int head = g * 4 + (fr & 3);
            int trow[2];
            bf16x8 qn[2][2];
#pragma unroll
            for (int rb = 0; rb < 2; ++rb) {
                trow[rb] = t0 + 8 * wave + 4 * rb + (fr >> 2);
#pragma unroll
                for (int ks = 0; ks < 2; ++ks) qn[rb][ks] = *(const bf16x8*)(QN + ((size_t)b * T + trow[rb]) * 1024 + head * 64 + 32 * ks + 8 * g4);
            }
#define TROW_PIN() asm volatile("" : "+v"(trow[0]), "+v"(trow[1]))
#define TOKROW(rb) ((size_t)b * T + trow[rb])
#define GATE(rb, br) (GATES[TOKROW(rb) * 48 + head * 3 + (br)])
            const bf16_t* kcb = KC + (size_t)bg * 512 * 64;
            const bf16_t* kvb = KV6 + (size_t)bg * T * 64;
#define ATK(sl) (((sl) < 4 ? AT4_KB : AT2_PS - 4 * 8192) + (sl) * 8192)
#define ATV(sl) (((sl) < 4 ? AT4_VB : AT2_PS + 32768 - 4 * 8192) + (sl) * 8192)
#define AT_DMA(BR, tile, slot) do { const bf16_t* kp_; const bf16_t* vp_; \
                if ((BR) == 0) { kp_ = kcb + (size_t)(tile) * 4096; vp_ = kp_ + (size_t)8192 * 64; } \
                else { kp_ = kvb + (size_t)((BR) == 1 ? 2 : 4) * 16 * T * 64 + (size_t)(tile) * 4096; vp_ = kp_ + (size_t)16 * T * 64; } \
                __builtin_amdgcn_global_load_lds((const unsigned*)(kp_ + ksrc), (LAS unsigned*)(lds + ATK(slot) + wave * 1024), 16, 0, 0); \
                __builtin_amdgcn_global_load_lds((const unsigned*)(vp_ + vsrc), (LAS unsigned*)(lds + ATV(slot) + wave * 1024), 16, 0, 0); } while (0)
            int ncv[2];
#pragma unroll
            for (int rb = 0; rb < 2; ++rb) ncv[rb] = (trow[rb] >= 31) ? ((trow[rb] - 31) / 16 + 1) : 0;
            const int nct = (((t0 + 63 - 31) / 16 + 1) + 63) >> 6;
            float mc[2], invc[2];
            {
                float m1[2] = {NEG, NEG}, l1[2] = {0.f, 0.f};
                const float zero2[2] = {0.f, 0.f};
#define CMP1_TILE(J, SLOT) do { const int j = (J); const int SLOT_ = (SLOT); \
                    f32x4 s[2][4]; attn_qk2(lds + AT4_KB + SLOT_ * 8192, qn, fr, g4, zero2, s); \
                    _Pragma("unroll") \
                    for (int rb = 0; rb < 2; ++rb) { \
                        float mx = NEG; \
                    _Pragma("unroll") \
                        for (int c = 0; c < 4; ++c) \
                    _Pragma("unroll") \
                            for (int i = 0; i < 4; ++i) { const int n = 64 * j + 16 * c + 4 * g4 + i; if (n >= ncv[rb]) s[rb][c][i] = NEG; mx = fmaxf(mx, s[rb][c][i]); } \
                        mx = fmaxf(mx, __shfl_xor(mx, 16)); mx = fmaxf(mx, __shfl_xor(mx, 32)); \
                        const float mn = fmaxf(m1[rb], mx), msafe = (mn == NEG) ? 0.f : mn; \
                        const float alpha = (m1[rb] == NEG) ? 0.f : __builtin_amdgcn_exp2f(m1[rb] - msafe); \
                        float sum = 0.f; \
                    _Pragma("unroll") \
                        for (int c = 0; c < 4; ++c) \
                    _Pragma("unroll") \
                            for (int i = 0; i < 4; ++i) sum += __builtin_amdgcn_exp2f(s[rb][c][i] - msafe); \
                        l1[rb] = l1[rb] * alpha + sum; m1[rb] = mn; \
                    } \
                } while (0)
                AT_DMA(0, 0, 0); if (nct > 1) AT_DMA(0, 1, 1); __syncthreads();
                for (int j0 = 0; j0 < nct; j0 += 2) { const int sb = (j0 & 2);
                    if (j0 + 2 < nct) AT_DMA(0, j0 + 2, sb ^ 2);
                    if (j0 + 3 < nct) AT_DMA(0, j0 + 3, (sb ^ 2) + 1);
                    CMP1_TILE(j0, sb); if (j0 + 1 < nct) CMP1_TILE(j0 + 1, sb + 1);
                    __syncthreads();
                }
#undef CMP1_TILE
#pragma unroll
                for (int rb = 0; rb < 2; ++rb) { float lc = l1[rb]; lc += __shfl_xor(lc, 16); lc += __shfl_xor(lc, 32); invc[rb] = (lc > 0.f) ? 1.0f / lc : 0.f; mc[rb] = (m1[rb] == NEG) ? 0.f : m1[rb]; }
            }
            {
                AttnRow oc[2];
#pragma unroll
                for (int rb = 0; rb < 2; ++rb) { oc[rb].m = 0.f; oc[rb].ol = (f32x4){0.f, 0.f, 0.f, 0.f};
#pragma unroll
                    for (int dt = 0; dt < 4; ++dt) oc[rb].o[dt] = (f32x4){0.f, 0.f, 0.f, 0.f}; }
                const float cin[2] = {-mc[0], -mc[1]};
                const unsigned full[2] = {0xffffffffu, 0xffffffffu}; const bool both[2] = {true, true};
#define CMP2_TILE(J, SLOT) do { const int j = (J); const int SLOT_ = (SLOT); \
                    f32x4 s[2][4]; attn_qk2(lds + AT4_KB + SLOT_ * 8192, qn, fr, g4, cin, s); \
                    _Pragma("unroll") \
                    for (int rb = 0; rb < 2; ++rb) \
                    _Pragma("unroll") \
                        for (int c = 0; c < 4; ++c) { \
                            f16x4 hs; \
                    _Pragma("unroll") \
                            for (int i = 0; i < 4; ++i) { const int n = 64 * j + 16 * c + 4 * g4 + i; const float p = (n < ncv[rb]) ? __builtin_amdgcn_exp2f(s[rb][c][i]) * invc[rb] : 0.f; s[rb][c][i] = p; \
                                float h = p; h += __shfl_xor(h, 1); h += __shfl_xor(h, 2); hs[i] = (_Float16)h; } \
                            if ((fr & 3) == 0) *(LAS f16x4*)(ps + (4 * rb + (fr >> 2)) * 512 + 64 * j + 16 * c + 4 * g4) = hs; \
                        } \
                    attn_pv2x(lds + AT4_VB + SLOT_ * 8192, s, vlane, swz, full, both, onesf, oc); \
                } while (0)
                AT_DMA(0, 0, 0); if (nct > 1) AT_DMA(0, 1, 1); __syncthreads();
                for (int j0 = 0; j0 < nct; j0 += 2) { const int sb = (j0 & 2);
                    if (j0 + 2 < nct) AT_DMA(0, j0 + 2, sb ^ 2);
                    if (j0 + 3 < nct) AT_DMA(0, j0 + 3, (sb ^ 2) + 1);
                    CMP2_TILE(j0, sb); if (j0 + 1 < nct) CMP2_TILE(j0 + 1, sb + 1);
                    __syncthreads();
                }
#undef CMP2_TILE
                TROW_PIN();
#pragma unroll
                for (int rb = 0; rb < 2; ++rb) { bf16_t* op = O + TOKROW(rb) * 1024 + head * 64 + 4 * g4; const float g0 = GATE(rb, 0);
#pragma unroll
                    for (int dt = 0; dt < 4; ++dt) { const f32x4 v = oc[rb].o[dt] * g0; u32x2 w; w.x = cvt_pk_bf16(v[0], v[1]); w.y = cvt_pk_bf16(v[2], v[3]); *(u32x2*)(op + 16 * dt) = w; } }
            }
            {
                WSYNC();
                const int tl = lane >> 4, li = lane & 15;
                const int nsel = (cur + 1 < 16) ? (cur + 1) : 16;
#pragma unroll 1
                for (int rnd = 0; rnd < 2; ++rnd) {
                    const LAS _Float16* pst = ps + (4 * rnd + tl) * 512;
                    float v[8];
#pragma unroll
                    for (int k = 0; k < 8; ++k) { const int j = li + 16 * k;
                        float x;
                        if (j > cur) x = NEG;
                        else if (j == 0 || j == cur || j == cur - 1) x = INFINITY;
                        else { const int n0 = 4 * j; x = (float)pst[n0 - 1] + 2.0f * ((float)pst[n0] + (float)pst[n0 + 1] + (float)pst[n0 + 2]) + (float)pst[n0 + 3]; }
                        v[k] = x; }
                    unsigned mm[4] = {0u, 0u, 0u, 0u};
                    for (int it = 0; it < nsel; ++it) {
                        float bv = v[0]; int bk = 0;
#pragma unroll
                        for (int k = 1; k < 8; ++k) if (v[k] > bv) { bv = v[k]; bk = k; }
                        int bi = li + 16 * bk;
#pragma unroll
                        for (int o = 1; o < 16; o <<= 1) { const float ov = __shfl_xor(bv, o); const int oi = __shfl_xor(bi, o); if (ov > bv || (ov == bv && oi < bi)) { bv = ov; bi = oi; } }
                        const unsigned bit = 1u << (bi & 31); const int wsel = bi >> 5;
                        mm[0] |= (wsel == 0) ? bit : 0u; mm[1] |= (wsel == 1) ? bit : 0u; mm[2] |= (wsel == 2) ? bit : 0u; mm[3] |= (wsel == 3) ? bit : 0u;
                        if ((bi & 15) == li) {
#pragma unroll
                            for (int k = 0; k < 8; ++k) if ((bi >> 4) == k) v[k] = NEG;
                        }
                    }
                    if (li == 0) { mskl[(4 * rnd + tl) * 4 + 0] = mm[0]; mskl[(4 * rnd + tl) * 4 + 1] = mm[1]; mskl[(4 * rnd + tl) * 4 + 2] = mm[2]; mskl[(4 * rnd + tl) * 4 + 3] = mm[3]; }
                }
                WSYNC();
            }
            bf16x8 qr[2][2];
            TROW_PIN();
#pragma unroll
            for (int rb = 0; rb < 2; ++rb)
#pragma unroll
                for (int ks = 0; ks < 2; ++ks) qr[rb][ks] = *(const bf16x8*)(QR + TOKROW(rb) * 1024 + head * 64 + 32 * ks + 8 * g4);
            bool nomax_slc, nomax_win;
            {
                float qq = 0.f;
#pragma unroll
                for (int rb = 0; rb < 2; ++rb) { float q2 = 0.f;
#pragma unroll
                    for (int ks = 0; ks < 2; ++ks)
#pragma unroll
                        for (int j = 0; j < 8; ++j) { const float x = bf2f((bf16_t)qr[rb][ks][j]); q2 += x * x; }
                    q2 += __shfl_xor(q2, 16); q2 += __shfl_xor(q2, 32); qq = fmaxf(qq, q2); }
                qq = wave_max(qq);
                const float* tn = (const float*)(a.ws + WS_MISC + TN2_OFF) + bg * 128;
                const int jt0w = (t0 >= 511) ? ((t0 - 511) >> 6) : 0;
                float ts = 0.f, tw = 0.f;
#pragma unroll
                for (int h2 = 0; h2 < 2; ++h2) { const int tl_ = lane + 64 * h2; if (tl_ <= cur) { ts = fmaxf(ts, tn[tl_]); if (tl_ >= jt0w) tw = fmaxf(tw, tn[2048 + tl_]); } }
                ts = wave_max(ts); tw = wave_max(tw);
                nomax_slc = __builtin_amdgcn_readfirstlane((qq * ts <= 3500.0f) ? 1 : 0) != 0;
                nomax_win = __builtin_amdgcn_readfirstlane((qq * tw <= 3500.0f) ? 1 : 0) != 0;
            }
            {
                AttnRow ss[2];
#pragma unroll
                for (int rb = 0; rb < 2; ++rb) { ss[rb].m = 0.f; ss[rb].ol = (f32x4){0.f, 0.f, 0.f, 0.f};
#pragma unroll
                    for (int dt = 0; dt < 4; ++dt) ss[rb].o[dt] = (f32x4){0.f, 0.f, 0.f, 0.f}; }
                const int nt_ = cur + 1;
                bool refmoved = false;
#define SLC_PRE(J) const int j_ = (J); bool en[2], act[2]; unsigned enm[2]; \
                    _Pragma("unroll") for (int rb = 0; rb < 2; ++rb) { const unsigned mw = mwg[rb]; \
                        en[rb] = (mw >> (j_ & 31)) & 1u; act[rb] = __any(en[rb]); enm[rb] = en[rb] ? 0xffffffffu : 0u; } const int lo2[2] = {0, 0};
#define SLC_TILE(J, SLOT) do { SLC_PRE(J) \
                    if (act[0] || act[1]) { f32x4 s[2][4]; \
                        if (refmoved) { const float cin[2] = {-ss[0].m, -ss[1].m}; attn_qk2(lds + ATK(SLOT), qr, fr, g4, cin, s); } \
                        else attn_qk2z(lds + ATK(SLOT), qr, fr, g4, s); \
                        refmoved |= attn_step2x(lds + ATV(SLOT), s, ss, 64 * j_, g4, lo2, trow, en, enm, j_ == cur, vlane, swz, onesf); } } while (0)
#define SLC_TILE_NM(J, SLOT) do { SLC_PRE(J) \
                    if (act[0] || act[1]) { f32x4 s[2][4]; attn_qk2z(lds + ATK(SLOT), qr, fr, g4, s); \
                        attn_step2x_nomax(lds + ATV(SLOT), s, ss, 64 * j_, g4, lo2, trow, enm, j_ == cur, vlane, swz, onesf); } } while (0)
#pragma unroll
                for (int i = 0; i < 4; ++i) if (i < nt_) AT_DMA(1, i, i);
                __syncthreads();
#define SLC_LOOP(TILE) for (int j0 = 0; j0 < nt_; j0 += 4) { const int sb = (j0 & 4); \
                    const unsigned mwg[2] = {mskl[(fr >> 2) * 4 + (j0 >> 5)], mskl[(4 + (fr >> 2)) * 4 + (j0 >> 5)]};       \
                    _Pragma("unroll") for (int i = 0; i < 4; ++i) if (j0 + 4 + i < nt_) AT_DMA(1, j0 + 4 + i, (sb ^ 4) + i); \
                    TILE(j0, sb); if (j0 + 1 < nt_) TILE(j0 + 1, sb + 1); if (j0 + 2 < nt_) TILE(j0 + 2, sb + 2); if (j0 + 3 < nt_) TILE(j0 + 3, sb + 3); \
                    __syncthreads(); }
                if (nomax_slc) { SLC_LOOP(SLC_TILE_NM) } else { SLC_LOOP(SLC_TILE) }
#undef SLC_LOOP
#undef SLC_TILE_NM
#undef SLC_PRE
#undef SLC_TILE
                TROW_PIN();
#pragma unroll
                for (int rb = 0; rb < 2; ++rb) { const float l = __shfl(ss[rb].ol[0], fr); const float sc1 = (l > 0.f) ? GATE(rb, 1) / l : 0.f;
                    bf16_t* op = O + TOKROW(rb) * 1024 + head * 64 + 4 * g4;
#pragma unroll
                    for (int dt = 0; dt < 4; ++dt) { const u32x2 pv = *(const u32x2*)(op + 16 * dt); f32x4 v = ss[rb].o[dt] * sc1;
                        v[0] += __uint_as_float(pv.x << 16); v[1] += __uint_as_float(pv.x & 0xffff0000u); v[2] += __uint_as_float(pv.y << 16); v[3] += __uint_as_float(pv.y & 0xffff0000u);
                        u32x2 w; w.x = cvt_pk_bf16(v[0], v[1]); w.y = cvt_pk_bf16(v[2], v[3]); *(u32x2*)(op + 16 * dt) = w; } }
            }
            {
                AttnRow sw[2];
#pragma unroll
                for (int rb = 0; rb < 2; ++rb) { sw[rb].m = 0.f; sw[rb].ol = (f32x4){0.f, 0.f, 0.f, 0.f};
#pragma unroll
                    for (int dt = 0; dt < 4; ++dt) sw[rb].o[dt] = (f32x4){0.f, 0.f, 0.f, 0.f}; }
                const int jt0 = (t0 >= 511) ? ((t0 - 511) >> 6) : 0;
                const int nt_ = cur - jt0 + 1;
                const unsigned full[2] = {0xffffffffu, 0xffffffffu}; const bool both[2] = {true, true};
                bool refmoved = false;
#define WIN_PRE(JJ) const int j = jt0 + (JJ); f32x4 s[2][4]; const bool edge = (j == cur) || (64 * j < t0 + 63 - 511); const int lo2[2] = {trow[0] - 511, trow[1] - 511};
#define WIN_TILE(JJ, SLOT) do { WIN_PRE(JJ) \
                    if (refmoved) { const float cin[2] = {-sw[0].m, -sw[1].m}; attn_qk2(lds + AT4_KB + (SLOT) * 8192, qr, fr, g4, cin, s); } \
                    else attn_qk2z(lds + AT4_KB + (SLOT) * 8192, qr, fr, g4, s); \
                    refmoved |= attn_step2x(lds + AT4_VB + (SLOT) * 8192, s, sw, 64 * j, g4, lo2, trow, both, full, edge, vlane, swz, onesf); } while (0)
#define WIN_TILE_NM(JJ, SLOT) do { WIN_PRE(JJ) attn_qk2z(lds + AT4_KB + (SLOT) * 8192, qr, fr, g4, s); \
                    attn_step2x_nomax(lds + AT4_VB + (SLOT) * 8192, s, sw, 64 * j, g4, lo2, trow, full, edge, vlane, swz, onesf); } while (0)
                AT_DMA(2, jt0, 0); if (nt_ > 1) AT_DMA(2, jt0 + 1, 1); __syncthreads();
#define WIN_LOOP(TILE) for (int j0 = 0; j0 < nt_; j0 += 2) { const int sb = (j0 & 2); \
                    if (j0 + 2 < nt_) AT_DMA(2, jt0 + j0 + 2, sb ^ 2); \
                    if (j0 + 3 < nt_) AT_DMA(2, jt0 + j0 + 3, (sb ^ 2) + 1); \
                    TILE(j0, sb); if (j0 + 1 < nt_) TILE(j0 + 1, sb + 1); \
                    __syncthreads(); }
                if (nomax_win) { WIN_LOOP(WIN_TILE_NM) } else { WIN_LOOP(WIN_TILE) }
#undef WIN_LOOP
#undef WIN_TILE_NM
#undef WIN_PRE
#undef WIN_TILE
                TROW_PIN();
#pragma unroll
                for (int rb = 0; rb < 2; ++rb) { const float l = __shfl(sw[rb].ol[0], fr); const float sc2 = (l > 0.f) ? GATE(rb, 2) / l : 0.f;
                    bf16_t* op = O + TOKROW(rb) * 1024 + head * 64 + 4 * g4;
#pragma unroll
                    for (int dt = 0; dt < 4; ++dt) { const u32x2 pv = *(const u32x2*)(op + 16 * dt); f32x4 v = sw[rb].o[dt] * sc2;
                        v[0] += __uint_as_float(pv.x << 16); v[1] += __uint_as_float(pv.x & 0xffff0000u); v[2] += __uint_as_float(pv.y << 16); v[3] += __uint_as_float(pv.y & 0xffff0000u);
                        u32x2 w; w.x = cvt_pk_bf16(v[0], v[1]); w.y = cvt_pk_bf16(v[2], v[3]); *(u32x2*)(op + 16 * dt) = w; } }
            }
#undef AT_DMA
#undef ATK
#undef ATV
#undef TROW_PIN
#undef TOKROW
#undef GATE
            cvt1_run(a, cvt_next, cvt_stride, 2, cvt_scr, lane);
        }
    }
    cvt1_run(a, cvt_next, cvt_stride, 1 << 20, cvt_scr, lane);
}

__device__ __forceinline__ void unpack8(const u32x4 w, float (&f)[8]) {
    f[0] = __uint_as_float(w.x << 16); f[1] = __uint_as_float(w.x & 0xffff0000u); f[2] = __uint_as_float(w.y << 16); f[3] = __uint_as_float(w.y & 0xffff0000u);
    f[4] = __uint_as_float(w.z << 16); f[5] = __uint_as_float(w.z & 0xffff0000u); f[6] = __uint_as_float(w.w << 16); f[7] = __uint_as_float(w.w & 0xffff0000u);
}
__device__ __forceinline__ void ph_convpool_fast(const Args& a, LAS unsigned char* lds) {
    const bf16_t* H0 = (const bf16_t*)(a.ws + WS_H0);
    bf16_t* CAT = (bf16_t*)(a.ws + WS_CAT);
    const float* cw = a.in[4]; const float* cb = a.in[5]; const float* lg = a.in[6]; const float* lb = a.in[7];
    const int tid = threadIdx.x, lane = tid & 63, wave = tid >> 6, ch = lane * 8;
    constexpr int VT_OFF = 0, UT_OFF = 62 * 1024, CW_OFF = UT_OFF + 47 * 1024;
    for (int i = tid; i < 31 * 64; i += 512) { const int k = i >> 6, c8 = (i & 63) * 8;
        const f32x4 w0 = *(const f32x4*)(cw + k * 512 + c8), w1 = *(const f32x4*)(cw + k * 512 + c8 + 4);
        u32x4 o; o.x = pk2(w0[0], w0[1]); o.y = pk2(w0[2], w0[3]); o.z = pk2(w1[0], w1[1]); o.w = pk2(w1[2], w1[3]);
        *(LAS u32x4*)(lds + CW_OFF + k * 1024 + c8 * 2) = o; }
    float bias[8], gam[8], bet[8];
#pragma unroll
    for (int j = 0; j < 8; ++j) { bias[j] = cb[ch + j]; gam[j] = lg[ch + j]; bet[j] = lb[ch + j]; }
    for (int tile = blockIdx.x; tile < M / 32; tile += gridDim.x) {
        const int tok0 = tile * 32, t0 = tok0 & (T - 1);
        __syncthreads();
        for (int i = tid; i < 62 * 64; i += 512) { const int r = i >> 6, c8 = (i & 63) * 8; const int tt = t0 - 30 + r;
            u32x4 v = (u32x4){0u, 0u, 0u, 0u}; if (tt >= 0) v = *(const u32x4*)(H0 + (size_t)(tok0 - 30 + r) * 1024 + 512 + c8);
            *(LAS u32x4*)(lds + VT_OFF + r * 1024 + c8 * 2) = v; }
        for (int i = tid; i < 47 * 64; i += 512) { const int r = i >> 6, c8 = (i & 63) * 8; const int tt = t0 - 15 + r;
            u32x4 v = (u32x4){0u, 0u, 0u, 0u}; if (tt >= 0) v = *(const u32x4*)(H0 + (size_t)(tok0 - 15 + r) * 1024 + c8);
            *(LAS u32x4*)(lds + UT_OFF + r * 1024 + c8 * 2) = v; }
        __syncthreads();
        float acc[4][8];
#pragma unroll
        for (int j = 0; j < 4; ++j)
#pragma unroll
            for (int c = 0; c < 8; ++c) acc[j][c] = bias[c];
#pragma unroll 1
        for (int k = 0; k < 31; ++k) {
            float w[8]; unpack8(*(const LAS u32x4*)(lds + CW_OFF + k * 1024 + ch * 2), w);
#pragma unroll
            for (int j = 0; j < 4; ++j) { float v[8]; unpack8(*(const LAS u32x4*)(lds + VT_OFF + (4 * wave + j + k) * 1024 + ch * 2), v);
#pragma unroll
                for (int c = 0; c < 8; ++c) acc[j][c] += w[c] * v[c]; }
        }
        const int wnd = 2 << (lane >> 4);
#pragma unroll
        for (int j = 0; j < 4; ++j) {
            const int tl = 4 * wave + j, t = t0 + tl; const size_t tok = (size_t)tok0 + tl;
            const int cnt = (t + 1 < wnd) ? (t + 1) : wnd;
            float s[8], self[8];
            unpack8(*(const LAS u32x4*)(lds + UT_OFF + (15 + tl) * 1024 + ch * 2), self);
#pragma unroll
            for (int c = 0; c < 8; ++c) s[c] = self[c];
            for (int k = 1; k < cnt; ++k) { float v[8]; unpack8(*(const LAS u32x4*)(lds + UT_OFF + (15 + tl - k) * 1024 + ch * 2), v);
#pragma unroll
                for (int c = 0; c < 8; ++c) s[c] += v[c]; }
            const float inv = 1.0f / (float)cnt;
            u32x4 o; o.x = pk2(s[0] * inv - self[0], s[1] * inv - self[1]); o.y = pk2(s[2] * inv - self[2], s[3] * inv - self[3]);
            o.z = pk2(s[4] * inv - self[4], s[5] * inv - self[5]); o.w = pk2(s[6] * inv - self[6], s[7] * inv - self[7]);
            *(u32x4*)(CAT + tok * 1024 + ch) = o;
            float sm = 0.f;
#pragma unroll
            for (int c = 0; c < 8; ++c) sm += acc[j][c];
            const float mean = wave_sum(sm) * (1.0f / 512.0f);
            float sq = 0.f;
#pragma unroll
            for (int c = 0; c < 8; ++c) { acc[j][c] -= mean; sq += acc[j][c] * acc[j][c]; }
            const float rstd = rsqrtf(wave_sum(sq) * (1.0f / 512.0f) + LN_EPS);
            float y[8];
#pragma unroll
            for (int c = 0; c < 8; ++c) { const float z = acc[j][c] * rstd * gam[c] + bet[c]; y[c] = z * sigmoidf_(z); }
            u32x4 o2; o2.x = pk2(y[0], y[1]); o2.y = pk2(y[2], y[3]); o2.z = pk2(y[4], y[5]); o2.w = pk2(y[6], y[7]);
            *(u32x4*)(CAT + tok * 1024 + 512 + ch) = o2;
        }
    }
}


__device__ __forceinline__ void ph_route_fast(const float* LOG, const float* bias, unsigned* gcnt, int2* list, unsigned char* ldsg) {
    unsigned* hist = (unsigned*)ldsg; unsigned* base = hist + 256; u32x2* sel = (u32x2*)(ldsg + 2048);
    const int tid = threadIdx.x, lane = tid & 63, wave = tid >> 6;
    const float NEG = -INFINITY;
    const float4 bb = *(const float4*)(bias + lane * 4);
    for (int chunk = blockIdx.x; chunk < M / 128; chunk += gridDim.x) {
        __syncthreads();
        if (tid < 256) hist[tid] = 0u;
        __syncthreads();
        for (int i = 0; i < 16; ++i) {
            const int tl = wave * 16 + i, tok = chunk * 128 + tl;
            const float4 lg = *(const float4*)(LOG + (size_t)tok * 256 + lane * 4);
            const float s0 = sigmoidf_(lg.x), s1 = sigmoidf_(lg.y), s2 = sigmoidf_(lg.z), s3 = sigmoidf_(lg.w);
            float v0 = s0 + bb.x, v1 = s1 + bb.y, v2 = s2 + bb.z, v3 = s3 + bb.w;
            float m1 = fmaxf(v0, v1), m2 = fminf(v0, v1);
            { const float hi = fmaxf(v2, v3), lo = fminf(v2, v3); const float n1 = fmaxf(m1, hi); const float n2 = fmaxf(fminf(m1, hi), fmaxf(m2, lo)); m1 = n1; m2 = n2; }
#pragma unroll
            for (int o = 1; o < 8; o <<= 1) { const float a1 = __shfl_xor(m1, o), a2 = __shfl_xor(m2, o); const float n1 = fmaxf(m1, a1), n2 = fmaxf(fminf(m1, a1), fmaxf(m2, a2)); m1 = n1; m2 = n2; }
            const float gs = m1 + m2; const int mygrp = lane >> 3;
            int rank = 0;
#pragma unroll
            for (int g2 = 0; g2 < 8; ++g2) { const float og = __shfl(gs, g2 * 8); rank += (og > gs || (og == gs && g2 < mygrp)) ? 1 : 0; }
            if (rank >= 4) { v0 = NEG; v1 = NEG; v2 = NEG; v3 = NEG; }
            int my_e = 0; float my_s = 0.f;
#pragma unroll
            for (int it = 0; it < 8; ++it) {
                float bv = v0; int bj = 0;
                if (v1 > bv) { bv = v1; bj = 1; }
                if (v2 > bv) { bv = v2; bj = 2; }
                if (v3 > bv) { bv = v3; bj = 3; }
                int bi = lane * 4 + bj;
#pragma unroll
                for (int o = 1; o < 64; o <<= 1) { const float ov = __shfl_xor(bv, o); const int oi = __shfl_xor(bi, o); if (ov > bv || (ov == bv && oi < bi)) { bv = ov; bi = oi; } }
                const int jj = bi & 3, ol = bi >> 2;
                const float mys = (jj == 0) ? s0 : (jj == 1) ? s1 : (jj == 2) ? s2 : s3;
                const float wsc = __shfl(mys, ol);
                if (lane == ol) { if (jj == 0) v0 = NEG; else if (jj == 1) v1 = NEG; else if (jj == 2) v2 = NEG; else v3 = NEG; }
                if (lane == it) { my_e = bi; my_s = wsc; }
            }
            const float ssum = wave_sum(lane < 8 ? my_s : 0.f);
            if (lane < 8) { const unsigned rk = atomicAdd(&hist[my_e], 1u); u32x2 en; en.x = (unsigned)my_e | (rk << 16); en.y = __float_as_uint(my_s / ssum * 2.5f); sel[tl * 8 + lane] = en; }
        }
        __syncthreads();
        if (tid < 256) { const unsigned h = hist[tid]; base[tid] = h ? atomicAdd(&gcnt[tid], h) : 0u; }
        __syncthreads();
#pragma unroll
        for (int rep = 0; rep < 2; ++rep) { const int idx = tid + rep * 512, tok = chunk * 128 + (idx >> 3), k = idx & 7;
            const u32x2 en = sel[idx]; const unsigned e = en.x & 0xffffu, pos = base[e] + (en.x >> 16);
            list[(size_t)e * LISTCAP + pos] = make_int2(tok * 10 + k, (int)en.y); }
    }
}

__global__ void __launch_bounds__(512, 2) fwd_kernel(Args a) {
    extern __shared__ __attribute__((aligned(16))) unsigned char lds[];
    volatile LAS unsigned* MISC = (volatile LAS unsigned*)((LAS unsigned char*)lds + (LDS_BYTES - 64));
    if (threadIdx.x < 16) MISC[threadIdx.x] = 0u;
    __syncthreads();
    unsigned* ctl = (unsigned*)(a.ws + WS_CTL);
#if MK_ONE_LAUNCH
    (void)xcd_barrier_post(ctl + CW_BAR, MISC + 8);
#define SEAM() do { XcdBarrier b_; b_.bar = (unsigned*)(a.ws + WS_CTL) + CW_BAR; b_.x = xb_xcc_id(); b_.st = MISC + 8; xcd_barrier(b_); } while (0)
#else
#define SEAM() do {} while (0)
#endif
    const int lo = a.ph_lo, hi = a.ph_hi;
#define IN(k) (lo <= (k) && (k) < hi)
#define BOTH(k) (IN(k) && (k) + 1 < hi)
#define X1 ((bf16_t*)(a.ws + WS_X1))
#define X2 ((bf16_t*)(a.ws + WS_X2))
#define LOG ((float*)(a.ws + WS_LOG))

    LAS unsigned char* L = (LAS unsigned char*)lds;
#define LIST ((int2*)(a.ws + WS_LIST))
#ifndef PROBE_DUP_MASK
#define PROBE_DUP_MASK 0u
#endif
#define RUN(k, ...) if (IN(k)) { { __VA_ARGS__ } if ((PROBE_DUP_MASK >> (k)) & 1u) { __syncthreads(); { __VA_ARGS__ } } if (BOTH(k)) SEAM(); }
    RUN(0, ph_prologue(a, L);)
    RUN(1, pg8::DenseSched S; S.init((const bf16_t*)(a.ws + WS_XA), D, (const bf16_t*)(a.ws + WS_WIN0), D, M, 1536);
           EpiInproj0 E{(bf16_t*)(a.ws + WS_H0)};
           pg8::gemm_phase<EpiInproj0, pg8::DenseSched, true>(L, D, 128u, S, E);)
    RUN(2, ph_convpool_fast(a, L);)
    RUN(4, pg8::DenseSched S; S.init((const bf16_t*)(a.ws + WS_CAT), D, (const bf16_t*)(a.ws + WS_WOUT0), D, M, D);
           EpiRes E{a.in[0], nullptr, (bf16_t*)(a.ws + WS_Y)};
           pg8::gemm_phase<EpiRes, pg8::DenseSched, true>(L, D, 128u, S, E);)
    RUN(5, ph_ln((const bf16_t*)(a.ws + WS_Y), a.in[17], a.in[18], X1, (unsigned char*)(a.ws + WS_X8));)
#define MOE_LAYER(P, LAYER, XIN, XOUT, OUTF) \
    RUN(P, pg8::DenseSched S; S.init(XIN, D, (const bf16_t*)(a.ws + WS_WR) + (size_t)(LAYER) * NE * D, D, M, NE); \
           EpiLogits E{LOG}; pg8::gemm_phase<EpiLogits, pg8::DenseSched, true>(L, D, 128u, S, E);) \
    if (IN(P + 1)) { ph_route_fast(LOG, a.in[22] + (LAYER) * NE, ctl + CW_CNT + (LAYER) * 256, LIST, lds); if (BOTH(P + 1)) SEAM(); } \
    RUN(P + 2, const int R = moe_setup256(ctl + CW_CNT + (LAYER) * 256, L); \
            MoeGuSched S{(const char*)(a.ws + WS_X8), (const char*)(a.ws + WS_WGU) + (size_t)(LAYER) * 257 * 512 * 1024, LIST, L, R, (R + 128) * 2, (int)gridDim.x, (int)blockIdx.x}; \
            S.prepare(); EpiGateUp E{(unsigned char*)(a.ws + WS_HID)}; pg8::gemm_phase<EpiGateUp, MoeGuSched, true, true>(L, D / 2, 128u, S, E);) \
    RUN(P + 3, const int R = moe_setup256(ctl + CW_CNT + (LAYER) * 256, L); \
            MoeDownSched S{(const char*)(a.ws + WS_HID), (const char*)(a.ws + WS_WD) + (size_t)(LAYER) * 257 * 1024 * 256, LIST, L, R, R + 128, (int)gridDim.x, (int)blockIdx.x}; \
            S.prepare(); EpiDown E{(unsigned char*)(a.ws + WS_YB), L}; pg8::gemm_phase<EpiDown, MoeDownSched, true, true>(L, FF / 2, 128u, S, E);) \
    RUN(P + 4, ph_combine(a, XIN, a.in[19] + (LAYER) * D, a.in[20] + (LAYER) * D, XOUT, OUTF);)
    MOE_LAYER(6, 0, X1, X2, nullptr)
    RUN(11, pg8::DenseSched S; S.init(X2, D, (const bf16_t*)(a.ws + WS_WINN), D, M, HNW);
            EpiInprojN E{(bf16_t*)(a.ws + WS_HN), (bf16_t*)(a.ws + WS_QR), (bf16_t*)(a.ws + WS_KV6), (float*)(a.ws + WS_GATES), (const float*)(a.ws + WS_MISC) + 1024};
            pg8::gemm_phase<EpiInprojN, pg8::DenseSched, true>(L, D, 128u, S, E);)
    RUN(13, Cmp1Sched S{(const char*)(a.ws + WS_KV6), (const char*)(a.ws + WS_CW1), (int)gridDim.x, (int)blockIdx.x};
            EpiCmp1 E{(bf16_t*)(a.ws + WS_CH1), (const float*)(a.ws + WS_MISC)};
            pg8::gemm_phase<EpiCmp1, Cmp1Sched, true>(L, 2048, 128u, S, E); ph_knorm(a);)
    RUN(14, ph_cmp2(a, lds);)
    RUN(15, ph_attn_fast2(a, L);)
    RUN(16, pg8::DenseSched S; S.init((const bf16_t*)(a.ws + WS_O), D, (const bf16_t*)(a.ws + WS_WOUTN), D, M, D);
            EpiRes E{nullptr, X2, (bf16_t*)(a.ws + WS_Y2)};
            pg8::gemm_phase<EpiRes, pg8::DenseSched, true>(L, D, 128u, S, E);)
    RUN(17, ph_ln((const bf16_t*)(a.ws + WS_Y2), a.in[17] + D, a.in[18] + D, X1, (unsigned char*)(a.ws + WS_X8));)
    MOE_LAYER(18, 1, X1, (bf16_t*)nullptr, a.out)
}

extern "C" void kernel_launch(void* const* d_in, const int* in_sizes, int n_in, void* d_out, int out_size, void* d_ws, size_t ws_size, hipStream_t stream) {
    static int grid = 0;
    if (grid == 0) {
        if (n_in != 29 || out_size != M * D || ws_size < WS_END) { fprintf(stderr, "kernel_launch: unexpected problem (n_in %d out %d ws %zu)\n", n_in, out_size, ws_size); grid = -1; return; }
        int dev = 0, cus = 0;
        if (hipGetDevice(&dev) != hipSuccess || hipDeviceGetAttribute(&cus, hipDeviceAttributeMultiprocessorCount, dev) != hipSuccess) { grid = -1; return; }
        if (hipFuncSetAttribute((const void*)fwd_kernel, hipFuncAttributeMaxDynamicSharedMemorySize, LDS_BYTES) != hipSuccess) { grid = -1; return; }
        int per_cu = 0;
        (void)hipOccupancyMaxActiveBlocksPerMultiprocessor(&per_cu, (const void*)fwd_kernel, 512, LDS_BYTES);
        (void)hipGetLastError();
        grid = cus;
    }
    if (grid < 0) return;
    (void)hipMemsetAsync((char*)d_ws + WS_CTL, 0, CTL_BYTES, stream);
    Args a{};
    for (int i = 0; i < 29; ++i) a.in[i] = (const float*)d_in[i];
    a.out = (float*)d_out; a.ws = (unsigned char*)d_ws;
    for (int i = 0; i < 8; ++i) a.inv_freq[i] = powf(500000.0f, -(float)(2 * i) / 16.0f);
#if MK_ONE_LAUNCH
    a.ph_lo = 0; a.ph_hi = NPHASE;
    hipLaunchKernelGGL(fwd_kernel, dim3(grid), dim3(512), LDS_BYTES, stream, a);
#else
    for (int p = 0; p < NPHASE; ++p) { a.ph_lo = p; a.ph_hi = p + 1; hipLaunchKernelGGL(fwd_kernel, dim3(grid), dim3(512), LDS_BYTES, stream, a); }
#endif
}
```

```cpp
#include <hip/hip_runtime.h>
#include <cstdint>
#include <cstdio>
#include <cmath>

#ifndef MK_ONE_LAUNCH
#define MK_ONE_LAUNCH 1
#endif

#define LAS __attribute__((address_space(3)))
typedef unsigned short bf16_t;
typedef short bf16x8 __attribute__((ext_vector_type(8)));
typedef float f32x4 __attribute__((ext_vector_type(4)));
typedef unsigned u32x2 __attribute__((ext_vector_type(2)));
typedef unsigned u32x4 __attribute__((ext_vector_type(4)));

constexpr int NB = 4, T = 8192, D = 1024, M = NB * T;
constexpr int NE = 256, TOPK = 8, FF = 256;
constexpr int HNW = 2816;
constexpr int LISTCAP = 32768;
constexpr float ALPHA = 1.4142135623730951f;
constexpr float LN_EPS = 1e-5f;
constexpr float QSCALE = 0.125f * 1.4426950408889634f;
constexpr int YB_NSLOT = 9;
constexpr float YB_SCALE = 16.0f;
constexpr int NPHASE = 23;

constexpr size_t MiB = 1u << 20;
constexpr size_t WS_CTL = 0, CTL_BYTES = 1 * MiB;
constexpr size_t WS_X1 = 1 * MiB;
constexpr size_t WS_X2 = WS_X1 + 64 * MiB;
constexpr size_t WS_LOG = WS_X2 + 64 * MiB;
constexpr size_t WS_LIST = WS_LOG + 32 * MiB;
constexpr size_t WS_WTS = WS_LIST + 64 * MiB;
constexpr size_t WS_HID = WS_WTS + 2 * MiB;
constexpr size_t WS_YB = WS_HID + 184 * MiB;
constexpr size_t WS_END_NAIVE = WS_YB + 576 * MiB;
constexpr size_t WS_WIN0 = WS_END_NAIVE;
constexpr size_t WS_WOUT0 = WS_WIN0 + 3 * MiB;
constexpr size_t WS_WINN = WS_WOUT0 + 2 * MiB;
constexpr size_t WS_WOUTN = WS_WINN + 6 * MiB;
constexpr size_t WS_WR = WS_WOUTN + 2 * MiB;
constexpr size_t WS_CW1 = WS_WR + 1 * MiB;
constexpr size_t WS_MISC = WS_CW1 + 2 * MiB;
constexpr size_t WS_WGU = WS_MISC + 1 * MiB;
constexpr size_t WS_X8 = WS_WGU + 257 * MiB;
constexpr float X8_SCALE = 8.0f, W8_SCALE = 64.0f, H8_SCALE = 16.0f;
constexpr size_t WS_WD = WS_WGU + 514 * MiB;
constexpr size_t WS_END = WS_WD + 257 * MiB;
constexpr size_t WS_XA = WS_X2;
constexpr size_t WS_H0 = WS_YB;
constexpr size_t WS_PM = WS_H0 + 64 * MiB;
constexpr size_t WS_CAT = WS_PM + 32 * MiB;
constexpr size_t WS_Y = WS_CAT + 64 * MiB;
constexpr size_t WS_HN = WS_YB;
constexpr size_t WS_KV6 = WS_HN + 64 * MiB;
constexpr size_t WS_QR = WS_HN + 176 * MiB;
constexpr size_t WS_GATES = WS_QR + 64 * MiB;
constexpr size_t WS_CH1 = WS_GATES + 8 * MiB;
constexpr size_t WS_KC = WS_CH1 + 4 * MiB;
constexpr size_t WS_O = WS_KC + 2 * MiB;
constexpr size_t WS_Y2 = WS_O + 64 * MiB;
static_assert(WS_Y2 + 64 * MiB <= WS_END_NAIVE, "overlay");
static_assert(WS_Y + 64 * MiB <= WS_END_NAIVE, "overlay");

constexpr int CW_CNT = 64;
constexpr int CW_BAR = 4096;

constexpr int LDS_BYTES = 163840;

__device__ __forceinline__ float bf2f(bf16_t h) { return __uint_as_float(((unsigned)h) << 16); }
__device__ __forceinline__ bf16_t f2bf(float f) { unsigned u = __float_as_uint(f); return (bf16_t)((u + 0x7fffu + ((u >> 16) & 1u)) >> 16); }
__device__ __forceinline__ unsigned pk2(float lo, float hi) { return (unsigned)f2bf(lo) | ((unsigned)f2bf(hi) << 16); }
__device__ __forceinline__ float wave_sum(float v) {
#pragma unroll
    for (int o = 1; o < 64; o <<= 1) v += __shfl_xor(v, o);
    return v;
}
__device__ __forceinline__ float wave_max(float v) {
#pragma unroll
    for (int o = 1; o < 64; o <<= 1) v = fmaxf(v, __shfl_xor(v, o));
    return v;
}
__device__ __forceinline__ float sigmoidf_(float x) { return 1.0f / (1.0f + __expf(-x)); }
__device__ __forceinline__ float gelu_tanh(float x) {
    const float u = 0.7978845608028654f * (x + 0.044715f * x * x * x);
    const float e = __expf(2.0f * u);
    const float th = 1.0f - 2.0f / (e + 1.0f);
    return 0.5f * x * (1.0f + th);
}
__device__ __forceinline__ bf16x8 cvt8(const float* p) {
    const float4 a = *(const float4*)p, b = *(const float4*)(p + 4);
    bf16x8 r;
    r[0] = (short)f2bf(a.x); r[1] = (short)f2bf(a.y); r[2] = (short)f2bf(a.z); r[3] = (short)f2bf(a.w);
    r[4] = (short)f2bf(b.x); r[5] = (short)f2bf(b.y); r[6] = (short)f2bf(b.z); r[7] = (short)f2bf(b.w);
    return r;
}
__device__ __forceinline__ bf16x8 colk8(const float* W, int N, int k, int col) {
    bf16x8 r;
#pragma unroll
    for (int j = 0; j < 8; ++j) r[j] = (short)f2bf(W[(size_t)(k + j) * N + col]);
    return r;
}
__device__ __forceinline__ bf16x8 zero8() { return (bf16x8){0, 0, 0, 0, 0, 0, 0, 0}; }
#define WSYNC() asm volatile("s_waitcnt lgkmcnt(0)" ::: "memory")

#define XB_TMO      128
#define XB_XCNT(j)  (256  + 64 * (j))
#define XB_XSUB(j)  (1280 + 64 * (j))
#define XB_XGEN(j)  (2304 + 64 * (j))
#define XB_TOP      3328
#define XB_TOPGEN   3392
#define XCD_BAR_WORDS 3456
#define XB_SPIN_CAP (1u << 22)
__device__ __forceinline__ unsigned xb_ld(unsigned* p)              { return __hip_atomic_load(p, __ATOMIC_RELAXED, __HIP_MEMORY_SCOPE_AGENT); }
__device__ __forceinline__ unsigned xb_add(unsigned* p, unsigned v) { return __hip_atomic_fetch_add(p, v, __ATOMIC_RELAXED, __HIP_MEMORY_SCOPE_AGENT); }
__device__ __forceinline__ unsigned xb_xcc_id() { return (unsigned)__builtin_amdgcn_s_getreg((3 << 11) | 20) & 0xFu; }
#define XB_SPIN(cond, bar) do { unsigned _sp = 0; while (cond) { __builtin_amdgcn_s_sleep(1); \
    if ((++_sp & 255u) == 0u) { if (xb_ld(&(bar)[XB_TMO])) break; if (_sp > XB_SPIN_CAP) { atomicAdd(&(bar)[XB_TMO], 1u); break; } } } } while (0)
struct XcdBarrier { unsigned* bar; unsigned x; volatile LAS unsigned* st; };
__device__ __forceinline__ XcdBarrier xcd_barrier_post(unsigned* bar, volatile LAS unsigned* st) {
    XcdBarrier b; b.bar = bar; b.x = xb_xcc_id(); b.st = st;
    if (threadIdx.x == 0) (void)xb_add(&bar[XB_XCNT(b.x)], 1u);
    return b;
}
__device__ __forceinline__ void xcd_barrier_complete(unsigned* bar, unsigned x, unsigned& nloc, unsigned& nx) {
    const unsigned G = gridDim.x * gridDim.y * gridDim.z;
    unsigned sum, cnt, mine, sp = 0u;
    for (;;) {
        sum = 0u; cnt = 0u; mine = 0u;
#pragma unroll
        for (unsigned j = 0; j < 16; ++j) { const unsigned c = xb_ld(&bar[XB_XCNT(j)]); sum += c; cnt += (c > 0u) ? 1u : 0u; mine = (j == x) ? c : mine; }
        if (sum == G) break;
        __builtin_amdgcn_s_sleep(1);
        if ((++sp & 255u) == 0u) { if (xb_ld(&bar[XB_TMO])) break; if (sp > XB_SPIN_CAP) { atomicAdd(&bar[XB_TMO], 1u); break; } }
    }
    nloc = mine > 0u ? mine : 1u; nx = cnt > 0u ? cnt : 1u;
}
__device__ __forceinline__ void xcd_barrier(const XcdBarrier& b) {
    asm volatile("s_waitcnt vmcnt(0)" ::: "memory");
    __syncthreads();
    if (threadIdx.x == 0) {
        unsigned* bar = b.bar;
        __builtin_amdgcn_s_waitcnt(0);
        unsigned nloc = b.st[0], nx = b.st[1];
        if (nloc == 0u) { xcd_barrier_complete(bar, b.x, nloc, nx); b.st[0] = nloc; b.st[1] = nx; }
        const unsigned old = xb_add(&bar[XB_XSUB(b.x)], 1u);
        const unsigned gen = old / nloc;
        if (old + 1u == (gen + 1u) * nloc) {
            __builtin_amdgcn_fence(__ATOMIC_RELEASE, "agent");
            asm volatile("s_waitcnt vmcnt(0)" ::: "memory");
            const unsigned og = xb_add(&bar[XB_TOP], 1u);
            const unsigned tg = og / nx;
            if (og + 1u == (tg + 1u) * nx) xb_add(&bar[XB_TOPGEN], 1u);
            else XB_SPIN(xb_ld(&bar[XB_TOPGEN]) == tg, bar);
            __builtin_amdgcn_fence(__ATOMIC_ACQUIRE, "agent");
            xb_add(&bar[XB_XGEN(b.x)], 1u);
            asm volatile("s_waitcnt vmcnt(0)" ::: "memory");
        } else {
            XB_SPIN(xb_ld(&bar[XB_XGEN(b.x)]) == gen, bar);
            __builtin_amdgcn_fence(__ATOMIC_ACQUIRE, "agent");
            asm volatile("s_waitcnt vmcnt(0)" ::: "memory");
        }
    }
    __syncthreads();
}

template <class AL, class BL, class EP>
__device__ __forceinline__ void mgemm_tile(unsigned char* lds, int K, const AL& al, const BL& bl, const EP& ep) {
    bf16_t* As = (bf16_t*)lds;
    bf16_t* Bs = As + 128 * 40;
    const int tid = threadIdx.x, lane = tid & 63, wave = tid >> 6;
    const int ar = tid >> 2, ac = (tid & 3) * 8;
    const int bn = tid & 127, bc = (tid >> 7) * 8;
    f32x4 acc[8];
#pragma unroll
    for (int s = 0; s < 8; ++s) acc[s] = (f32x4){0.f, 0.f, 0.f, 0.f};
    bf16x8 ra = al(ac), rb = bl(bc);
    for (int k0 = 0; k0 < K; k0 += 32) {
        __syncthreads();
        *(bf16x8*)(As + ar * 40 + ac) = ra;
        *(bf16x8*)(Bs + bn * 40 + bc) = rb;
        __syncthreads();
        if (k0 + 32 < K) { ra = al(k0 + 32 + ac); rb = bl(k0 + 32 + bc); }
        const bf16x8 af = *(const bf16x8*)(As + (wave * 16 + (lane & 15)) * 40 + (lane >> 4) * 8);
#pragma unroll
        for (int s = 0; s < 8; ++s) {
            const bf16x8 wf = *(const bf16x8*)(Bs + (16 * s + (lane & 15)) * 40 + (lane >> 4) * 8);
            acc[s] = __builtin_amdgcn_mfma_f32_16x16x32_bf16(wf, af, acc[s], 0, 0, 0);
        }
    }
    ep(wave * 16 + (lane & 15), (lane >> 4) * 4, acc);
}
__device__ __forceinline__ void store4bf(bf16_t* p, const f32x4 v) { u32x2 w; w.x = pk2(v[0], v[1]); w.y = pk2(v[2], v[3]); *(u32x2*)p = w; }

struct Args {
    const float* in[29];
    float* out;
    unsigned char* ws;
    float inv_freq[8];
    int ph_lo, ph_hi;
};

__device__ __forceinline__ unsigned pk4_fp8(float a, float b, float c, float d) { int w = __builtin_amdgcn_cvt_pk_fp8_f32(a, b, 0, false); return (unsigned)__builtin_amdgcn_cvt_pk_fp8_f32(c, d, w, true); }
__device__ __forceinline__ u32x2 pack8_fp8(const f32x4 v0, const f32x4 v1) {
    int a = __builtin_amdgcn_cvt_pk_fp8_f32(v0[0], v0[1], 0, false); a = __builtin_amdgcn_cvt_pk_fp8_f32(v0[2], v0[3], a, true);
    int b = __builtin_amdgcn_cvt_pk_fp8_f32(v1[0], v1[1], 0, false); b = __builtin_amdgcn_cvt_pk_fp8_f32(v1[2], v1[3], b, true);
    u32x2 w; w.x = (unsigned)a; w.y = (unsigned)b; return w;
}
__device__ __forceinline__ float clamp8(float v) { return __builtin_amdgcn_fmed3f(v, -448.0f, 448.0f); }
__device__ __forceinline__ void ph_ln(const bf16_t* Y, const float* g, const float* b, bf16_t* X, unsigned char* X8) {
    const int lane = threadIdx.x & 63, wave = threadIdx.x >> 6;
    const int gw = blockIdx.x * 8 + wave, ngw = gridDim.x * 8;
    float gg[16], bb[16];
#pragma unroll
    for (int j = 0; j < 8; ++j) { gg[j] = g[lane * 8 + j]; gg[8 + j] = g[512 + lane * 8 + j]; bb[j] = b[lane * 8 + j]; bb[8 + j] = b[512 + lane * 8 + j]; }
    for (int row0 = gw * 4; row0 < M; row0 += ngw * 4) {
        bf16x8 p0[4], p1[4];
#pragma unroll
        for (int r = 0; r < 4; ++r) { p0[r] = __builtin_nontemporal_load((const bf16x8*)(Y + (size_t)(row0 + r) * 1024 + lane * 8)); p1[r] = __builtin_nontemporal_load((const bf16x8*)(Y + (size_t)(row0 + r) * 1024 + 512 + lane * 8)); }
#pragma unroll
        for (int r = 0; r < 4; ++r) {
            float v[16];
#pragma unroll
            for (int j = 0; j < 8; ++j) { v[j] = bf2f((bf16_t)p0[r][j]); v[8 + j] = bf2f((bf16_t)p1[r][j]); }
            float s = 0.f;
#pragma unroll
            for (int j = 0; j < 16; ++j) s += v[j];
            const float mean = wave_sum(s) * (1.0f / 1024.0f);
            float q = 0.f;
#pragma unroll
            for (int j = 0; j < 16; ++j) { v[j] -= mean; q += v[j] * v[j]; }
            const float rstd = rsqrtf(wave_sum(q) * (1.0f / 1024.0f) + LN_EPS);
            float o[16];
#pragma unroll
            for (int j = 0; j < 16; ++j) o[j] = v[j] * rstd * gg[j] + bb[j];
            u32x4 w0, w1;
            w0.x = pk2(o[0], o[1]); w0.y = pk2(o[2], o[3]); w0.z = pk2(o[4], o[5]); w0.w = pk2(o[6], o[7]);
            w1.x = pk2(o[8], o[9]); w1.y = pk2(o[10], o[11]); w1.z = pk2(o[12], o[13]); w1.w = pk2(o[14], o[15]);
            *(u32x4*)(X + (size_t)(row0 + r) * 1024 + lane * 8) = w0; *(u32x4*)(X + (size_t)(row0 + r) * 1024 + 512 + lane * 8) = w1;
#pragma unroll
            for (int j = 0; j < 16; ++j) o[j] = clamp8(o[j] * X8_SCALE);
            u32x2 q0, q1; q0.x = pk4_fp8(o[0], o[1], o[2], o[3]); q0.y = pk4_fp8(o[4], o[5], o[6], o[7]); q1.x = pk4_fp8(o[8], o[9], o[10], o[11]); q1.y = pk4_fp8(o[12], o[13], o[14], o[15]);
            *(u32x2*)(X8 + (size_t)(row0 + r) * 1024 + lane * 8) = q0; *(u32x2*)(X8 + (size_t)(row0 + r) * 1024 + 512 + lane * 8) = q1;
        }
    }
}

__device__ __forceinline__ void ph_combine(const Args& a, const bf16_t* X, const float* g, const float* b, bf16_t* Xo, float* outf) {
    const unsigned char* YB = (const unsigned char*)(a.ws + WS_YB);
    const int lane = threadIdx.x & 63, wave = threadIdx.x >> 6;
    const int gw = blockIdx.x * 8 + wave, ngw = gridDim.x * 8;
    for (int row = gw; row < M; row += ngw) {
        float v[16];
#pragma unroll
        for (int j = 0; j < 16; ++j) v[j] = 0.f;
        u32x2 q0[YB_NSLOT], q1[YB_NSLOT];
#pragma unroll
        for (int k = 0; k < YB_NSLOT; ++k) { const unsigned char* yr = YB + ((size_t)row * 10 + k) * 1024; q0[k] = __builtin_nontemporal_load((const u32x2*)(yr + lane * 8)); q1[k] = __builtin_nontemporal_load((const u32x2*)(yr + 512 + lane * 8)); }
#pragma unroll
        for (int k = 0; k < YB_NSLOT; ++k) {
            const auto a0 = __builtin_amdgcn_cvt_pk_f32_fp8((int)q0[k].x, false), a1 = __builtin_amdgcn_cvt_pk_f32_fp8((int)q0[k].x, true), a2 = __builtin_amdgcn_cvt_pk_f32_fp8((int)q0[k].y, false), a3 = __builtin_amdgcn_cvt_pk_f32_fp8((int)q0[k].y, true);
            const auto b0 = __builtin_amdgcn_cvt_pk_f32_fp8((int)q1[k].x, false), b1 = __builtin_amdgcn_cvt_pk_f32_fp8((int)q1[k].x, true), b2 = __builtin_amdgcn_cvt_pk_f32_fp8((int)q1[k].y, false), b3 = __builtin_amdgcn_cvt_pk_f32_fp8((int)q1[k].y, true);
            v[0] += a0[0]; v[1] += a0[1]; v[2] += a1[0]; v[3] += a1[1]; v[4] += a2[0]; v[5] += a2[1]; v[6] += a3[0]; v[7] += a3[1];
            v[8] += b0[0]; v[9] += b0[1]; v[10] += b1[0]; v[11] += b1[1]; v[12] += b2[0]; v[13] += b2[1]; v[14] += b3[0]; v[15] += b3[1];
        }
        {
            const bf16x8 p0 = *(const bf16x8*)(X + (size_t)row * 1024 + lane * 8), p1 = *(const bf16x8*)(X + (size_t)row * 1024 + 512 + lane * 8);
#pragma unroll
            for (int j = 0; j < 8; ++j) { v[j] = v[j] * (1.0f / YB_SCALE) + ALPHA * bf2f((bf16_t)p0[j]); v[8 + j] = v[8 + j] * (1.0f / YB_SCALE) + ALPHA * bf2f((bf16_t)p1[j]); }
        }
        float s = 0.f;
#pragma unroll
        for (int j = 0; j < 16; ++j) s += v[j];
        const float mean = wave_sum(s) * (1.0f / 1024.0f);
        float q = 0.f;
#pragma unroll
        for (int j = 0; j < 16; ++j) { v[j] -= mean; q += v[j] * v[j]; }
        const float rstd = rsqrtf(wave_sum(q) * (1.0f / 1024.0f) + LN_EPS);
        float o[16];
#pragma unroll
        for (int j = 0; j < 8; ++j) { o[j] = v[j] * rstd * g[lane * 8 + j] + b[lane * 8 + j]; o[8 + j] = v[8 + j] * rstd * g[512 + lane * 8 + j] + b[512 + lane * 8 + j]; }
        if (outf) {
            float* op = outf + (size_t)row * 1024;
            *(float4*)(op + lane * 8) = make_float4(o[0], o[1], o[2], o[3]); *(float4*)(op + lane * 8 + 4) = make_float4(o[4], o[5], o[6], o[7]);
            *(float4*)(op + 512 + lane * 8) = make_float4(o[8], o[9], o[10], o[11]); *(float4*)(op + 512 + lane * 8 + 4) = make_float4(o[12], o[13], o[14], o[15]);
        } else {
            u32x4 w0, w1;
            w0.x = pk2(o[0], o[1]); w0.y = pk2(o[2], o[3]); w0.z = pk2(o[4], o[5]); w0.w = pk2(o[6], o[7]);
            w1.x = pk2(o[8], o[9]); w1.y = pk2(o[10], o[11]); w1.z = pk2(o[12], o[13]); w1.w = pk2(o[14], o[15]);
            *(u32x4*)(Xo + (size_t)row * 1024 + lane * 8) = w0; *(u32x4*)(Xo + (size_t)row * 1024 + 512 + lane * 8) = w1;
        }
    }
}

__device__ __forceinline__ void ph_cmp2(const Args& a, unsigned char* lds) {
    const bf16_t* CH1 = (const bf16_t*)(a.ws + WS_CH1);
    bf16_t* KC = (bf16_t*)(a.ws + WS_KC);
    const int tid = threadIdx.x;
    for (int u = blockIdx.x; u < 64 * 2; u += gridDim.x) {
        const int rt = u >> 1, kv = u & 1;
        const bf16_t* ar = CH1 + ((size_t)kv * 8192 + rt * 128 + (tid >> 2)) * 128;
        const float* w2 = a.in[kv ? 15 : 12];
        const int col = tid & 127;
        auto al = [&](int k) { return *(const bf16x8*)(ar + k); };
        auto bl = [&](int k) { return (col < 64) ? colk8(w2, 64, k, col) : zero8(); };
        auto ep = [&](int r, int cb, const f32x4 (&acc)[8]) {
            bf16_t* o = KC + ((size_t)kv * 8192 + rt * 128 + r) * 64;
#pragma unroll
            for (int s = 0; s < 4; ++s) store4bf(o + 16 * s + cb, acc[s]);
        };
        mgemm_tile(lds, 128, al, bl, ep);
    }
}

namespace pg8 {
constexpr int BM = 256, BK = 64, HALF = 128, HTB = HALF * BK * 2, STAGE_BYTES = 8 * HTB;
__device__ __forceinline__ int lds_byte(int r, int c) { const int st = (r >> 4) * 2 + (c >> 5), rr = r & 15, cc = c & 31, ob = rr * 64 + cc * 2; return st * 1024 + (ob ^ (((ob >> 9) & 1) << 5)); }
__device__ __forceinline__ void stage_rc(int b, int& R, int& C) { const int st = b / 1024, sb = b % 1024, swz = sb ^ (((sb >> 9) & 1) << 5); R = (st >> 1) * 16 + swz / 64; C = (st & 1) * 32 + (swz % 64) / 2; }
__device__ __forceinline__ int perm32(int rho) { const int n = rho >> 4, i = rho & 15; return 8 * (i >> 2) + 4 * n + (i & 3); }
struct Unit { int pm, pn, ord; };
typedef float f32x16 __attribute__((ext_vector_type(16)));
typedef int i32x8 __attribute__((ext_vector_type(8))); typedef int i32x4_ __attribute__((ext_vector_type(4)));
__device__ __forceinline__ i32x8 f8cat(const bf16x8 lo, const bf16x8 hi) { return __builtin_shufflevector(__builtin_bit_cast(i32x4_, lo), __builtin_bit_cast(i32x4_, hi), 0, 1, 2, 3, 4, 5, 6, 7); }
template <class Epi, class Sched, bool ALIGN_EPI, bool F8 = false>
__device__ __forceinline__ void gemm_phase(LAS unsigned char* lds, const int K, const unsigned kstepA, const Sched& S, const Epi& E) {
    const int tid = threadIdx.x, wid = __builtin_amdgcn_readfirstlane(tid >> 6), lane = tid & 63, wr = wid >> 2, wc = wid & 3, fr = lane & 15, fq = lane >> 4;
    const int nt = K / BK;
    constexpr bool GA = Sched::GATHER;
    int RA[2]; unsigned CA2[2], voffB[2], voffB1[2], voffA[2];
    constexpr bool P16 = Epi::PERM16;
#pragma unroll
    for (int i = 0; i < 2; ++i) { int R, C; stage_rc(tid * 16 + i * 8192, R, C); const int Rb = Epi::PERM ? ((R & ~31) + perm32(R & 31)) : R;
        RA[i] = R; CA2[i] = (unsigned)C * 2u; voffB[i] = (unsigned)(Rb * K + C) * 2u; voffA[i] = GA ? 0u : (S.lane_off(R) + (unsigned)C * 2u);
        if (P16) { const int c16 = 64 * (R >> 5) + 16 * ((R >> 2) & 3) + 4 * ((R >> 4) & 1) + (R & 3); voffB[i] = (unsigned)(c16 * K + C) * 2u; voffB1[i] = (unsigned)((c16 + 8) * K + C) * 2u; } else voffB1[i] = 0u; }
    const size_t kstepB = (size_t)(BK * 2);
    const size_t hstepB = (size_t)HALF * K * 2;
    const unsigned ldsw = (unsigned)wid * 1024u;
    const int aoff = lds_byte(wr * 64 + fr, fq * 8), boff = lds_byte(wc * 32 + fr, fq * 8);
    const char* const Ab = S.abase();
    unsigned aoC[2][2], aoN[2][2];
    unsigned uC[2], uN[2];
#define PG8_SA(b, h) (((b) * 2 + (h)) * HTB)
#define PG8_SB(b, h) ((4 + (b) * 2 + (h)) * HTB)
#define PG8_GLDS(sbase, voff, ldsoff) do { const char* _b = (const char*)(sbase); unsigned _v = (voff); asm volatile("" : "+s"(_b), "+v"(_v)); \
        __builtin_amdgcn_global_load_lds((const unsigned*)(_b + _v), (LAS unsigned*)(lds + (ldsoff)), 16, 0, 0); } while (0)
#define PG8_STAGE_B(bufoff, gbase) do { _Pragma("unroll") for (int _i = 0; _i < 2; ++_i) PG8_GLDS(gbase, voffB[_i], (bufoff) + ldsw + _i * 8192); } while (0)
#define PG8_STAGE_B1(bufoff, gbase) do { _Pragma("unroll") for (int _i = 0; _i < 2; ++_i) PG8_GLDS((const char*)(gbase) + (P16 ? (size_t)0 : hstepB), (P16 ? voffB1[_i] : voffB[_i]), (bufoff) + ldsw + _i * 8192); } while (0)
#define PG8_STAGE_A(bufoff, kb, UO, LO) do { _Pragma("unroll") for (int _i = 0; _i < 2; ++_i) PG8_GLDS(Ab + (size_t)((kb) + (UO)), (GA ? (LO)[_i] : voffA[_i]), (bufoff) + ldsw + _i * 8192); } while (0)
#define PG8_LDA(dst, b, h) do { _Pragma("unroll") for (int m = 0; m < 4; ++m) _Pragma("unroll") for (int k = 0; k < 2; ++k) dst[m][k] = *(const LAS bf16x8*)(lds + PG8_SA(b, h) + aoff + m * 2048 + k * 1024); } while (0)
#define PG8_LDB(dst, b, h) do { _Pragma("unroll") for (int n = 0; n < 2; ++n) _Pragma("unroll") for (int k = 0; k < 2; ++k) dst[n][k] = *(const LAS bf16x8*)(lds + PG8_SB(b, h) + boff + n * 2048 + k * 1024); } while (0)
#define PG8_MMA(ai, bj, At, Bt) do { __builtin_amdgcn_s_setprio(1); _Pragma("unroll") for (int m = 0; m < 4; ++m) _Pragma("unroll") for (int n = 0; n < 2; ++n) { \
        if constexpr (F8) { f32x16& _w = accw[ai][bj][m >> 1]; const int _q = ((m & 1) * 2 + n) * 4; f32x4 _c = {_w[_q], _w[_q + 1], _w[_q + 2], _w[_q + 3]}; \
            _c = __builtin_amdgcn_mfma_scale_f32_16x16x128_f8f6f4(f8cat(Bt[n][0], Bt[n][1]), f8cat(At[m][0], At[m][1]), _c, 0, 0, 0, 0, 0, 0); _w[_q] = _c[0]; _w[_q + 1] = _c[1]; _w[_q + 2] = _c[2]; _w[_q + 3] = _c[3]; } \
        else { _Pragma("unroll") for (int k = 0; k < 2; ++k) acc[ai][bj][m][n] = __builtin_amdgcn_mfma_f32_16x16x32_bf16(Bt[n][k], At[m][k], acc[ai][bj][m][n], 0, 0, 0); } } __builtin_amdgcn_s_setprio(0); } while (0)
#define PG8_WAIT_V(n) asm volatile("s_waitcnt vmcnt(" #n ")" ::: "memory")
#define PG8_WAIT_L(n) asm volatile("s_waitcnt lgkmcnt(" #n ")" ::: "memory")
#define PG8_BAR __builtin_amdgcn_s_barrier()
#define PG8_SCHED __builtin_amdgcn_sched_barrier(0)
#define PG8_KPAIR(KB1, KB2, KB3, BP2, BP3) do { \
            PG8_LDB(B0, 0, 0); PG8_LDB(B1, 0, 1); PG8_SCHED; PG8_LDA(At, 0, 0); PG8_STAGE_A(PG8_SA(1, 1), KB1, uC[1], aoC[1]); \
            PG8_WAIT_V(8); PG8_WAIT_L(0); PG8_BAR; PG8_MMA(0, 0, At, B0); PG8_MMA(0, 1, At, B1); PG8_BAR; PG8_SCHED; \
            PG8_LDA(At, 0, 1); PG8_STAGE_B(PG8_SB(0, 0), BP2); PG8_STAGE_B1(PG8_SB(0, 1), BP2); PG8_STAGE_A(PG8_SA(0, 0), KB2, u2[0], a2o[0]); \
            PG8_WAIT_V(8); PG8_WAIT_L(0); PG8_BAR; PG8_MMA(1, 0, At, B0); PG8_MMA(1, 1, At, B1); PG8_BAR; PG8_SCHED; \
            PG8_LDB(B0, 1, 0); PG8_LDB(B1, 1, 1); PG8_SCHED; PG8_LDA(At, 1, 0); PG8_STAGE_A(PG8_SA(0, 1), KB2, u2[1], a2o[1]); \
            PG8_WAIT_V(8); PG8_WAIT_L(0); PG8_BAR; PG8_MMA(0, 0, At, B0); PG8_MMA(0, 1, At, B1); PG8_BAR; PG8_SCHED; \
            PG8_LDA(At, 1, 1); PG8_STAGE_B(PG8_SB(1, 0), BP3); PG8_STAGE_B1(PG8_SB(1, 1), BP3); PG8_STAGE_A(PG8_SA(1, 0), KB3, u2[0], a2o[0]); \
            PG8_WAIT_V(8); PG8_WAIT_L(0); PG8_BAR; PG8_MMA(1, 0, At, B0); PG8_MMA(1, 1, At, B1); PG8_BAR; PG8_SCHED; } while (0)
    Unit cur, nxt; int ui = 0;
    if (!S.next(0, cur)) return;
    f32x4 acc[2][2][4][2];
#pragma unroll
    for (int a = 0; a < 2; ++a)
#pragma unroll
        for (int b = 0; b < 2; ++b)
#pragma unroll
            for (int m = 0; m < 4; ++m)
#pragma unroll
                for (int n = 0; n < 2; ++n) acc[a][b][m][n] = (f32x4){0.f, 0.f, 0.f, 0.f};
    bf16x8 At[4][2], B0[2][2], B1[2][2];
    f32x16 accw[2][2][2];
#define PG8_ZERO_W() do { if constexpr (F8) { _Pragma("unroll") for (int _a = 0; _a < 2; ++_a) _Pragma("unroll") for (int _b = 0; _b < 2; ++_b) _Pragma("unroll") for (int _m = 0; _m < 2; ++_m) _Pragma("unroll") for (int _e = 0; _e < 16; ++_e) accw[_a][_b][_m][_e] = 0.f; } } while (0)
    PG8_ZERO_W();
#pragma unroll
    for (int h = 0; h < 2; ++h) { uC[h] = GA ? 0u : S.unit_off(cur, h); uN[h] = uC[h];
#pragma unroll
        for (int i = 0; i < 2; ++i) { aoC[h][i] = GA ? (S.aoff(cur, h * HALF + RA[i]) + CA2[i]) : 0u; aoN[h][i] = aoC[h][i]; } }
    const char* cB = S.bptr(cur);
    PG8_STAGE_B(PG8_SB(0, 0), cB); PG8_STAGE_B1(PG8_SB(0, 1), cB); PG8_STAGE_A(PG8_SA(0, 0), 0u, uC[0], aoC[0]); PG8_STAGE_A(PG8_SA(0, 1), 0u, uC[1], aoC[1]);
    if (wr == 1) PG8_BAR;
    PG8_WAIT_V(2); PG8_BAR;
    PG8_STAGE_B(PG8_SB(1, 0), cB + kstepB); PG8_STAGE_A(PG8_SA(1, 0), kstepA, uC[0], aoC[0]); PG8_STAGE_B1(PG8_SB(1, 1), cB + kstepB);
    PG8_WAIT_V(6); PG8_BAR;
    for (;;) {
        const bool has_next = S.next(ui + 1, nxt);
        const char* nB = has_next ? S.bptr(nxt) : cB;
#pragma unroll
        for (int h = 0; h < 2; ++h) { uN[h] = (GA || !has_next) ? uC[h] : S.unit_off(nxt, h);
#pragma unroll
            for (int i = 0; i < 2; ++i) aoN[h][i] = (GA && has_next) ? (S.aoff(nxt, h * HALF + RA[i]) + CA2[i]) : aoC[h][i]; }
#pragma nounroll
        for (int t = 0; t < nt; t += 2) {
            const bool last = (t == nt - 2);
            const unsigned kb1 = (unsigned)(t + 1) * kstepA, kb2 = last ? 0u : (unsigned)(t + 2) * kstepA, kb3 = kb2 + kstepA;
            const char* b2 = last ? nB : cB + (size_t)(t + 2) * kstepB; const char* b3 = b2 + kstepB;
            unsigned u2[2], a2o[2][2];
#pragma unroll
            for (int h = 0; h < 2; ++h) { u2[h] = last ? uN[h] : uC[h];
#pragma unroll
                for (int i = 0; i < 2; ++i) a2o[h][i] = GA ? (last ? aoN[h][i] : aoC[h][i]) : 0u; }
            PG8_KPAIR(kb1, kb2, kb3, b2, b3);
        }
        if constexpr (ALIGN_EPI) { if (wr == 0) PG8_BAR; }
        if constexpr (F8) {
#pragma unroll
            for (int _a = 0; _a < 2; ++_a)
#pragma unroll
                for (int _b = 0; _b < 2; ++_b)
#pragma unroll
                    for (int _m = 0; _m < 4; ++_m)
#pragma unroll
                        for (int _n = 0; _n < 2; ++_n) { const f32x16& _w = accw[_a][_b][_m >> 1]; const int _q = ((_m & 1) * 2 + _n) * 4; acc[_a][_b][_m][_n] = (f32x4){_w[_q], _w[_q + 1], _w[_q + 2], _w[_q + 3]}; }
        }
        E(acc, cur, wr, wc, fr, fq);
        PG8_ZERO_W();
        if (!has_next) break;
#pragma unroll
        for (int a = 0; a < 2; ++a)
#pragma unroll
            for (int b = 0; b < 2; ++b)
#pragma unroll
                for (int m = 0; m < 4; ++m)
#pragma unroll
                    for (int n = 0; n < 2; ++n) acc[a][b][m][n] = (f32x4){0.f, 0.f, 0.f, 0.f};
        cur = nxt; cB = nB; ++ui;
#pragma unroll
        for (int h = 0; h < 2; ++h) { uC[h] = uN[h];
#pragma unroll
            for (int i = 0; i < 2; ++i) aoC[h][i] = aoN[h][i]; }
        if constexpr (ALIGN_EPI) { if (wr == 1) PG8_BAR; }
    }
    PG8_WAIT_V(0);
    if constexpr (!ALIGN_EPI) { if (wr == 0) PG8_BAR; }
    PG8_BAR;
#undef PG8_SA
#undef PG8_ZERO_W
#undef PG8_GLDS
#undef PG8_SB
#undef PG8_STAGE_A
#undef PG8_STAGE_B
#undef PG8_STAGE_B1
#undef PG8_LDA
#undef PG8_LDB
#undef PG8_MMA
#undef PG8_WAIT_V
#undef PG8_WAIT_L
#undef PG8_BAR
#undef PG8_SCHED
#undef PG8_KPAIR
}

struct DenseSched {
    const char* A; const char* Bt; unsigned lda2; size_t btile; int nM, nN, nwg, G, c;
    __device__ __forceinline__ void init(const bf16_t* A_, int lda, const bf16_t* Bt_, int K, int Mrows, int N) {
        A = (const char*)A_; Bt = (const char*)Bt_; lda2 = (unsigned)lda * 2u; btile = (size_t)256 * K * 2; nM = Mrows / BM; nN = N / BM; nwg = nM * nN; G = gridDim.x; c = blockIdx.x; }
    __device__ __forceinline__ bool next(int i, Unit& u) const {
        const long L = (long)i * G + c; if (L >= nwg) return false;
        int wgid = (int)L; { const int q = nwg / 8, r = nwg % 8, xcd = wgid % 8, off = wgid / 8; wgid = (xcd < r ? xcd * (q + 1) : r * (q + 1) + (xcd - r) * q) + off; }
        const int nig = 8 * nN, gid = wgid / nig, fm = gid * 8, gsz = (nM - fm) < 8 ? (nM - fm) : 8;
        u.pm = fm + ((wgid % nig) % gsz); u.pn = (wgid % nig) / gsz; u.ord = i; return true;
    }
    static constexpr bool GATHER = false;
    __device__ __forceinline__ unsigned lane_off(int r) const { return (unsigned)r * lda2; }
    __device__ __forceinline__ unsigned unit_off(const Unit& u, int h) const { return (unsigned)(u.pm * BM + h * HALF) * lda2; }
    __device__ __forceinline__ unsigned aoff(const Unit&, int) const { return 0u; }
    __device__ __forceinline__ const char* abase() const { return A; }
    __device__ __forceinline__ const char* bptr(const Unit& u) const { return Bt + (size_t)u.pn * btile; }
};
}
typedef float f32x2_t __attribute__((ext_vector_type(2))); typedef __bf16 bf16x2_t __attribute__((ext_vector_type(2)));
__device__ __forceinline__ unsigned cvt_pk_bf16(float lo, float hi) { const f32x2_t v = {lo, hi}; const bf16x2_t b = __builtin_convertvector(v, bf16x2_t); return __builtin_bit_cast(unsigned, b); }
__device__ __forceinline__ u32x4 pack8(const f32x4 v0, const f32x4 v1) { u32x4 w; w.x = cvt_pk_bf16(v0[0], v0[1]); w.y = cvt_pk_bf16(v0[2], v0[3]); w.z = cvt_pk_bf16(v1[0], v1[1]); w.w = cvt_pk_bf16(v1[2], v1[3]); return w; }
__device__ __forceinline__ unsigned cvtpk_m(float lo, float hi) { const f32x2_t v = {lo, hi}; const bf16x2_t b = __builtin_convertvector(v, bf16x2_t); return __builtin_bit_cast(unsigned, b); }
__device__ __forceinline__ u32x4 pack8m(const f32x4 v0, const f32x4 v1) { u32x4 w; w.x = cvtpk_m(v0[0], v0[1]); w.y = cvtpk_m(v0[2], v0[3]); w.z = cvtpk_m(v1[0], v1[1]); w.w = cvtpk_m(v1[2], v1[3]); return w; }
#define MFMA_SETTLE(S) asm volatile("s_nop 15\n\ts_nop 7" : "+v"(S[0][0]), "+v"(S[0][1]), "+v"(S[0][2]), "+v"(S[0][3]), "+v"(S[1][0]), "+v"(S[1][1]), "+v"(S[1][2]), "+v"(S[1][3]))
__device__ __forceinline__ f32x4 sig4(const f32x4 v) { f32x4 r; r[0] = sigmoidf_(v[0]); r[1] = sigmoidf_(v[1]); r[2] = sigmoidf_(v[2]); r[3] = sigmoidf_(v[3]); return r; }

#define EPI_ROWLOOP for (int ai = 0; ai < 2; ++ai) _Pragma("unroll") for (int m = 0; m < 4; ++m)
struct EpiInproj0 {
    static constexpr bool PERM = true, PERM16 = false; bf16_t* H0;
    __device__ __forceinline__ void operator()(const f32x4 (&acc)[2][2][4][2], const pg8::Unit& u, int wr, int wc, int fr, int fq) const {
        const int row0 = u.pm * 256 + wr * 64 + fr, cl = wc * 32 + 8 * fq;
#pragma unroll
        EPI_ROWLOOP { bf16_t* rp = H0 + (size_t)(row0 + ai * 128 + m * 16) * 1024;
            if (u.pn < 2) {
#pragma unroll
                for (int bj = 0; bj < 2; ++bj) *(u32x4*)(rp + u.pn * 256 + bj * 128 + cl) = pack8(acc[ai][bj][m][0], acc[ai][bj][m][1]);
            } else {
                const f32x4 v0 = acc[ai][0][m][0] * sig4(acc[ai][1][m][0]), v1 = acc[ai][0][m][1] * sig4(acc[ai][1][m][1]);
                *(u32x4*)(rp + 512 + (u.pn - 2) * 128 + cl) = pack8(v0, v1);
            } }
    }
};
struct EpiRes {
    static constexpr bool PERM = true, PERM16 = false; const float* resf; const bf16_t* resb; bf16_t* Y;
    __device__ __forceinline__ void operator()(const f32x4 (&acc)[2][2][4][2], const pg8::Unit& u, int wr, int wc, int fr, int fq) const {
        const int row0 = u.pm * 256 + wr * 64 + fr, c0 = u.pn * 256 + wc * 32 + 8 * fq;
#pragma unroll
        EPI_ROWLOOP { const size_t ro = (size_t)(row0 + ai * 128 + m * 16) * 1024 + c0;
#pragma unroll
            for (int bj = 0; bj < 2; ++bj) {
                f32x4 r0, r1;
                if (resf) { r0 = *(const f32x4*)(resf + ro + bj * 128); r1 = *(const f32x4*)(resf + ro + bj * 128 + 4); }
                else { const u32x4 xv = *(const u32x4*)(resb + ro + bj * 128);
                    r0[0] = __uint_as_float(xv.x << 16); r0[1] = __uint_as_float(xv.x & 0xffff0000u); r0[2] = __uint_as_float(xv.y << 16); r0[3] = __uint_as_float(xv.y & 0xffff0000u);
                    r1[0] = __uint_as_float(xv.z << 16); r1[1] = __uint_as_float(xv.z & 0xffff0000u); r1[2] = __uint_as_float(xv.w << 16); r1[3] = __uint_as_float(xv.w & 0xffff0000u); }
                *(u32x4*)(Y + ro + bj * 128) = pack8(acc[ai][bj][m][0] + r0 * ALPHA, acc[ai][bj][m][1] + r1 * ALPHA);
            } }
    }
};
struct EpiLogits {
    static constexpr bool PERM = true, PERM16 = false; float* LOG;
    __device__ __forceinline__ void operator()(const f32x4 (&acc)[2][2][4][2], const pg8::Unit& u, int wr, int wc, int fr, int fq) const {
        const int row0 = u.pm * 256 + wr * 64 + fr, cl = wc * 32 + 8 * fq;
#pragma unroll
        EPI_ROWLOOP { float* rp = LOG + (size_t)(row0 + ai * 128 + m * 16) * 256 + cl;
#pragma unroll
            for (int bj = 0; bj < 2; ++bj) { *(f32x4*)(rp + bj * 128) = acc[ai][bj][m][0]; *(f32x4*)(rp + bj * 128 + 4) = acc[ai][bj][m][1]; } }
    }
};

constexpr int MOE_TAB_OFF = 131072;
__device__ __forceinline__ int moe_setup256(const unsigned* cnt, LAS unsigned char* lds) {
    LAS int* tstart = (LAS int*)(lds + MOE_TAB_OFF);
    LAS int* scnt = (LAS int*)(lds + MOE_TAB_OFF + 1088);
    LAS unsigned short* texp = (LAS unsigned short*)(lds + MOE_TAB_OFF + 2176);
    const int tid = threadIdx.x;
    __syncthreads();
    if (tid < 256) scnt[tid] = (int)cnt[tid];
    __syncthreads();
    if (tid == 0) { int s = 0; for (int e = 0; e < 256; ++e) { tstart[e] = s; s += (scnt[e] + 255) >> 8; } tstart[256] = s; }
    __syncthreads();
    if (tid < 256) for (int q = tstart[tid]; q < tstart[tid + 1]; ++q) texp[q] = (unsigned short)tid;
    __syncthreads();
    return __builtin_amdgcn_readfirstlane(tstart[256]);
}
constexpr int MOE_TOK_OFF = MOE_TAB_OFF + 5120;
constexpr int MOE_MAX_ORD = 20;
struct MoeGuSched {
    static constexpr bool GATHER = true;
    const char* X; const char* W; const int2* list; LAS unsigned char* lds; int R, nunits, G, c;
    __device__ __forceinline__ int vcu() const { return (G % 8 == 0) ? (c % 8) * (G / 8) + c / 8 : c; }
    __device__ __forceinline__ bool next(int i, pg8::Unit& u) const {
        const int L = i * G + vcu(); if (L >= nunits || i >= MOE_MAX_ORD) return false;
        const int q = L >> 1; const int e = __builtin_amdgcn_readfirstlane((q < R) ? (int)((LAS unsigned short*)(lds + MOE_TAB_OFF + 2176))[q] : 256);
        u.pm = q; u.pn = e * 2 + (L & 1); u.ord = i; return true; }
    __device__ __forceinline__ void prepare() const {
        const int tid = threadIdx.x, r = tid & 255;
        pg8::Unit u;
        for (int i = tid >> 8; next(i, u); i += 2) {
            const int e = u.pn >> 1; int token;
            if (e < 256) { const int ts = ((LAS int*)(lds + MOE_TAB_OFF))[e], cn = ((LAS int*)(lds + MOE_TAB_OFF + 1088))[e]; int lr = (u.pm - ts) * 256 + r; if (lr >= cn) lr = cn - 1;
                token = list[(size_t)e * LISTCAP + lr].x / 10; }
            else token = (u.pm - R) * 256 + r;
            ((LAS unsigned short*)(lds + MOE_TOK_OFF))[i * 256 + r] = (unsigned short)token;
        }
        __syncthreads();
    }
    __device__ __forceinline__ unsigned aoff(const pg8::Unit& u, int r) const { return (unsigned)((LAS unsigned short*)(lds + MOE_TOK_OFF))[u.ord * 256 + r] * 1024u; }
    __device__ __forceinline__ unsigned lane_off(int) const { return 0u; }
    __device__ __forceinline__ unsigned unit_off(const pg8::Unit&, int) const { return 0u; }
    __device__ __forceinline__ const char* abase() const { return X; }
    __device__ __forceinline__ const char* bptr(const pg8::Unit& u) const { return W + (size_t)u.pn * (256 * 1024); }
};
constexpr float GU_SC = 1.0f / (X8_SCALE * W8_SCALE);
struct EpiGateUp {
    static constexpr bool PERM = true, PERM16 = false; unsigned char* HID;
    __device__ __forceinline__ void operator()(const f32x4 (&acc)[2][2][4][2], const pg8::Unit& u, int wr, int wc, int fr, int fq) const {
        const int row0 = u.pm * 256 + wr * 64 + fr, c0 = (u.pn & 1) * 128 + wc * 32 + 8 * fq;
#pragma unroll
        EPI_ROWLOOP { const f32x4 g0 = acc[ai][0][m][0] * GU_SC, g1 = acc[ai][0][m][1] * GU_SC;
            f32x4 h0 = g0 * sig4(g0) * (acc[ai][1][m][0] * (GU_SC * H8_SCALE)), h1 = g1 * sig4(g1) * (acc[ai][1][m][1] * (GU_SC * H8_SCALE));
#pragma unroll
            for (int i = 0; i < 4; ++i) { h0[i] = clamp8(h0[i]); h1[i] = clamp8(h1[i]); }
            *(u32x2*)(HID + (size_t)(row0 + ai * 128 + m * 16) * 256 + c0) = pack8_fp8(h0, h1); }
    }
};
constexpr int MOE_RI_OFF = MOE_TAB_OFF + 5120;
constexpr int MOE_MAX_RT = 6;
struct MoeDownSched {
    const char* HID; const char* W; const int2* list; LAS unsigned char* lds; int R, ntile, G, c;
    __device__ __forceinline__ int vcu() const { return (G % 8 == 0) ? (c % 8) * (G / 8) + c / 8 : c; }
    __device__ __forceinline__ bool next(int i, pg8::Unit& u) const {
        const int q = vcu() + G * (i >> 2); if (q >= ntile || (i >> 2) >= MOE_MAX_RT) return false;
        const int e = (q < R) ? (int)((LAS unsigned short*)(lds + MOE_TAB_OFF + 2176))[q] : 256;
        u.pm = q; u.pn = e * 4 + (i & 3); u.ord = i >> 2; return true; }
    __device__ __forceinline__ void prepare() const {
        const int tid = threadIdx.x, r = tid & 255;
        for (int o = tid >> 8; o < MOE_MAX_RT; o += 2) {
            const int q = vcu() + G * o; if (q >= ntile) break;
            u32x2 en;
            if (q < R) { const int e = ((LAS unsigned short*)(lds + MOE_TAB_OFF + 2176))[q]; const int ts = ((LAS int*)(lds + MOE_TAB_OFF))[e], cn = ((LAS int*)(lds + MOE_TAB_OFF + 1088))[e];
                const int lr = (q - ts) * 256 + r; if (lr < cn) { const int2 le = list[(size_t)e * LISTCAP + lr]; en.x = (unsigned)le.x; en.y = (unsigned)le.y; } else { en.x = 0xffffffffu; en.y = 0u; } }
            else { en.x = (unsigned)(((q - R) * 256 + r) * 10 + 8); en.y = __float_as_uint(1.0f); }
            ((LAS u32x2*)(lds + MOE_RI_OFF))[o * 256 + r] = en;
        }
        __syncthreads();
    }
    static constexpr bool GATHER = false;
    __device__ __forceinline__ unsigned lane_off(int r) const { return (unsigned)r * 256u; }
    __device__ __forceinline__ unsigned unit_off(const pg8::Unit& u, int h) const { return (unsigned)(u.pm * 256 + h * 128) * 256u; }
    __device__ __forceinline__ unsigned aoff(const pg8::Unit&, int) const { return 0u; }
    __device__ __forceinline__ const char* abase() const { return HID; }
    __device__ __forceinline__ const char* bptr(const pg8::Unit& u) const { return W + (size_t)u.pn * (256 * 256); }
};
struct EpiDown {
    static constexpr bool PERM = true, PERM16 = true;
    unsigned char* YB; LAS unsigned char* lds;
    __device__ __forceinline__ void operator()(const f32x4 (&acc)[2][2][4][2], const pg8::Unit& u, int wr, int wc, int fr, int fq) const {
        asm volatile("" : "+v"(fr), "+v"(fq));
        const unsigned c0b = (unsigned)((u.pn & 3) * 256 + wc * 64 + 16 * fq); const bool shared = (u.pn >> 2) == 256;
        const LAS u32x2* ri = (const LAS u32x2*)(lds + MOE_RI_OFF) + u.ord * 256 + wr * 64 + fr;
#pragma unroll
        for (int ai = 0; ai < 2; ++ai)
#pragma unroll
            for (int m = 0; m < 4; ++m) { const u32x2 en = ri[ai * 128 + m * 16]; const float wv = __uint_as_float(en.y) * (YB_SCALE / (H8_SCALE * W8_SCALE));
                if ((int)en.x >= 0) { unsigned char* rp = YB + (size_t)(en.x * 1024u + c0b);
                    const f32x4 v00 = acc[ai][0][m][0] * wv, v01 = acc[ai][0][m][1] * wv, v10 = acc[ai][1][m][0] * wv, v11 = acc[ai][1][m][1] * wv;
                    const u32x2 h0 = pack8_fp8(v00, v01), h1 = pack8_fp8(v10, v11);
                    *(u32x4*)rp = (u32x4){h0.x, h0.y, h1.x, h1.y};
                    if (YB_NSLOT == 10 && shared) {
                        u32x2 r_[2];
#pragma unroll
                        for (int bj = 0; bj < 2; ++bj) { const u32x2 h = bj ? h1 : h0; const f32x4 v0 = bj ? v10 : v00, v1 = bj ? v11 : v01;
                            const auto a0 = __builtin_amdgcn_cvt_pk_f32_fp8((int)h.x, false), a1 = __builtin_amdgcn_cvt_pk_f32_fp8((int)h.x, true), a2 = __builtin_amdgcn_cvt_pk_f32_fp8((int)h.y, false), a3 = __builtin_amdgcn_cvt_pk_f32_fp8((int)h.y, true);
                            const f32x4 r0 = {v0[0] - a0[0], v0[1] - a0[1], v0[2] - a1[0], v0[3] - a1[1]}, r1 = {v1[0] - a2[0], v1[1] - a2[1], v1[2] - a3[0], v1[3] - a3[1]};
                            r_[bj] = pack8_fp8(r0, r1); }
                        *(u32x4*)(rp + 1024) = (u32x4){r_[0].x, r_[0].y, r_[1].x, r_[1].y}; } } }
    }
};

struct EpiInprojN {
    static constexpr bool PERM = true, PERM16 = false; bf16_t* QN; bf16_t* QR; bf16_t* KV6; float* GATES; const float* ROT;
    __device__ __forceinline__ void operator()(const f32x4 (&acc)[2][2][4][2], const pg8::Unit& u, int wr, int wc, int fr, int fq) const {
        const int row0 = u.pm * 256 + wr * 64 + fr, cl = wc * 32 + 8 * fq, pn = u.pn;
        const bool isq = pn < 4, rotk = (pn == 6 || pn == 8), dorot = (isq || rotk) && ((wc & 1) == 0);
#pragma unroll
        EPI_ROWLOOP { const int row = row0 + ai * 128 + m * 16;
            if (pn == 10) {
                if (cl < 48) { *(f32x4*)(GATES + (size_t)row * 48 + cl) = sig4(acc[ai][0][m][0]); *(f32x4*)(GATES + (size_t)row * 48 + cl + 4) = sig4(acc[ai][0][m][1]); }
            } else {
                f32x4 cs0, cs1, sn0, sn1;
                if (dorot) { const float* rt = ROT + (size_t)(row & (T - 1)) * 16; cs0 = *(const f32x4*)rt; cs1 = *(const f32x4*)(rt + 4); sn0 = *(const f32x4*)(rt + 8); sn1 = *(const f32x4*)(rt + 12); }
#pragma unroll
                for (int bj = 0; bj < 2; ++bj) {
                    const f32x4 v0 = acc[ai][bj][m][0], v1 = acc[ai][bj][m][1];
                    f32x4 r0 = v0, r1 = v1;
                    if (dorot) {
                        f32x4 p0, p1;
#pragma unroll
                        for (int i = 0; i < 4; ++i) { p0[i] = __shfl_xor(v0[i], 16); p1[i] = __shfl_xor(v1[i], 16); }
                        if (fq == 0) { r0 = v0 * cs0 - p0 * sn0; r1 = v1 * cs1 - p1 * sn1; }
                        else if (fq == 1) { r0 = v0 * cs0 + p0 * sn0; r1 = v1 * cs1 + p1 * sn1; }
                    }
                    if (isq) { const int c = pn * 256 + bj * 128 + cl;
                        *(u32x4*)(QN + (size_t)row * 1024 + c) = pack8(v0 * QSCALE, v1 * QSCALE); *(u32x4*)(QR + (size_t)row * 1024 + c) = pack8(r0 * QSCALE, r1 * QSCALE); }
                    else { const int cc = bj * 128 + cl, g = cc >> 6, d = cc & 63, b = row >> 13, t = row & (T - 1);
                        *(u32x4*)(KV6 + ((size_t)((pn - 4) * 16 + b * 4 + g) * T + t) * 64 + d) = pack8(r0, r1); }
                }
            } }
    }
};

struct Cmp1Sched {
    const char* KV6; const char* W; int G, c;
    static constexpr bool GATHER = false;
    __device__ __forceinline__ bool next(int i, pg8::Unit& u) const { const int L = i * G + c; if (L >= 64) return false; u.pm = L >> 1; u.pn = L & 1; u.ord = i; return true; }
    __device__ __forceinline__ unsigned lane_off(int r) const { return (unsigned)r * 2048u; }
    __device__ __forceinline__ unsigned unit_off(const pg8::Unit& u, int h) const { return (unsigned)u.pn * (unsigned)(16 * T * 64 * 2) + (unsigned)(u.pm * 256 + h * 128) * 2048u; }
    __device__ __forceinline__ unsigned aoff(const pg8::Unit&, int) const { return 0u; }
    __device__ __forceinline__ const char* abase() const { return KV6; }
    __device__ __forceinline__ const char* bptr(const pg8::Unit& u) const { return W + (size_t)u.pn * (256 * 2048 * 2); }
};
struct EpiCmp1 {
    static constexpr bool PERM = true, PERM16 = false; bf16_t* CH1; const float* bias1;
    __device__ __forceinline__ void operator()(const f32x4 (&acc)[2][2][4][2], const pg8::Unit& u, int wr, int wc, int fr, int fq) const {
        const int row0 = u.pm * 256 + wr * 64 + fr, cl = wc * 32 + 8 * fq;
        const f32x4 b0 = *(const f32x4*)(bias1 + u.pn * 128 + cl), b1 = *(const f32x4*)(bias1 + u.pn * 128 + cl + 4);
#pragma unroll
        EPI_ROWLOOP { f32x4 v0 = acc[ai][0][m][0] + b0, v1 = acc[ai][0][m][1] + b1;
#pragma unroll
            for (int i = 0; i < 4; ++i) { v0[i] = gelu_tanh(v0[i]); v1[i] = gelu_tanh(v1[i]); }
            *(u32x4*)(CH1 + ((size_t)u.pn * 8192 + row0 + ai * 128 + m * 16) * 128 + cl) = pack8(v0, v1); }
    }
};

__device__ __forceinline__ void p0_item(const float* W, int K, int N, bf16_t* WT, int kb, int n0, int drow0, LAS float* scr, int lane, bool f8 = false) {
    const int k0 = 64 * kb, n4 = (lane & 15) * 4;
    const bool cok = (n0 + n4) < N;
    f32x4 v[16];
#pragma unroll
    for (int i = 0; i < 16; ++i) { const int kk = 4 * i + (lane >> 4); v[i] = cok ? __builtin_nontemporal_load((const f32x4*)(W + (size_t)(k0 + kk) * N + n0 + n4)) : (f32x4){0.f, 0.f, 0.f, 0.f}; }
#pragma unroll
    for (int i = 0; i < 16; ++i) { const int kk = 4 * i + (lane >> 4); LAS float* d = scr + kk * 65 + n4; d[0] = v[i][0]; d[1] = v[i][1]; d[2] = v[i][2]; d[3] = v[i][3]; }
    asm volatile("s_waitcnt lgkmcnt(0)" ::: "memory");
    if (f8) {
        const int c4 = lane & 3;
#pragma unroll
        for (int j = 0; j < 4; ++j) { const int n = (lane >> 2) + 16 * j; const LAS float* sp = scr + (16 * c4) * 65 + n;
            u32x4 o;
            o.x = pk4_fp8(sp[0 * 65] * W8_SCALE, sp[1 * 65] * W8_SCALE, sp[2 * 65] * W8_SCALE, sp[3 * 65] * W8_SCALE); o.y = pk4_fp8(sp[4 * 65] * W8_SCALE, sp[5 * 65] * W8_SCALE, sp[6 * 65] * W8_SCALE, sp[7 * 65] * W8_SCALE);
            o.z = pk4_fp8(sp[8 * 65] * W8_SCALE, sp[9 * 65] * W8_SCALE, sp[10 * 65] * W8_SCALE, sp[11 * 65] * W8_SCALE); o.w = pk4_fp8(sp[12 * 65] * W8_SCALE, sp[13 * 65] * W8_SCALE, sp[14 * 65] * W8_SCALE, sp[15 * 65] * W8_SCALE);
            if (n0 + n < N) __builtin_nontemporal_store(o, (u32x4*)((unsigned char*)WT + (size_t)(drow0 + n) * K + k0 + 16 * c4)); }
        asm volatile("s_waitcnt lgkmcnt(0)" ::: "memory");
        return;
    }
    const int c = lane & 7;
#pragma unroll
    for (int j = 0; j < 8; ++j) { const int n = (lane >> 3) + 8 * j; const LAS float* sp = scr + (8 * c) * 65 + n;
        u32x4 o; o.x = pk2(sp[0 * 65], sp[1 * 65]); o.y = pk2(sp[2 * 65], sp[3 * 65]); o.z = pk2(sp[4 * 65], sp[5 * 65]); o.w = pk2(sp[6 * 65], sp[7 * 65]);
        if (n0 + n < N) __builtin_nontemporal_store(o, (u32x4*)(WT + (size_t)(drow0 + n) * K + k0 + 8 * c)); }
    asm volatile("s_waitcnt lgkmcnt(0)" ::: "memory");
}
struct CvtItem { const float* W; bf16_t* WT; int K, N, k0, n0, drow0; };
__device__ __forceinline__ void cvt32_load(const CvtItem& it, int lane, f32x4 (&v)[8]) {
    const int n4 = (lane & 7) * 4;
#pragma unroll
    for (int i = 0; i < 8; ++i) { const int kk = 8 * i + (lane >> 3); v[i] = __builtin_nontemporal_load((const f32x4*)(it.W + (size_t)(it.k0 + kk) * it.N + it.n0 + n4)); }
}
__device__ __forceinline__ void cvt32_finish(const CvtItem& it, int lane, const f32x4 (&v)[8], LAS float* scr) {
    const int n4 = (lane & 7) * 4;
#pragma unroll
    for (int i = 0; i < 8; ++i) { const int kk = 8 * i + (lane >> 3); LAS float* d = scr + kk * 33 + n4; d[0] = v[i][0]; d[1] = v[i][1]; d[2] = v[i][2]; d[3] = v[i][3]; }
    asm volatile("s_waitcnt lgkmcnt(0)" ::: "memory");
    const int c = lane & 7;
#pragma unroll
    for (int j = 0; j < 4; ++j) { const int n = (lane >> 3) + 8 * j; const LAS float* sp = scr + (8 * c) * 33 + n;
        const float v0 = sp[0 * 33], v1 = sp[1 * 33], v2 = sp[2 * 33], v3 = sp[3 * 33], v4 = sp[4 * 33], v5 = sp[5 * 33], v6 = sp[6 * 33], v7 = sp[7 * 33];
        u32x2 o; o.x = pk4_fp8(v0 * W8_SCALE, v1 * W8_SCALE, v2 * W8_SCALE, v3 * W8_SCALE); o.y = pk4_fp8(v4 * W8_SCALE, v5 * W8_SCALE, v6 * W8_SCALE, v7 * W8_SCALE);
        __builtin_nontemporal_store(o, (u32x2*)((unsigned char*)it.WT + (size_t)(it.drow0 + n) * it.K + it.k0 + 8 * c)); }
    asm volatile("s_waitcnt lgkmcnt(0)" ::: "memory");
}
constexpr int CVT1_ITEMS = 257 * 384;
__device__ __forceinline__ CvtItem cvt1_item(const Args& a, int idx) {
    const int e = idx / 384, sub = idx % 384, mat = sub >> 7, r = sub & 127;
    CvtItem it;
    if (mat < 2) { it.W = (e < 256) ? a.in[23 + mat] + ((size_t)256 + e) * (size_t)(D * FF) : a.in[26 + mat] + (size_t)(D * FF);
        it.K = D; it.N = FF; it.k0 = (r >> 3) * 64; it.n0 = (r & 7) * 32; it.drow0 = (it.n0 >> 7) * 256 + mat * 128 + (it.n0 & 127);
        it.WT = (bf16_t*)(a.ws + WS_WGU + (size_t)(257 + e) * 512 * 1024); }
    else { it.W = (e < 256) ? a.in[25] + ((size_t)256 + e) * (size_t)(FF * D) : a.in[28] + (size_t)(FF * D);
        it.K = FF; it.N = D; it.k0 = (r >> 5) * 64; it.n0 = (r & 31) * 32; it.drow0 = it.n0;
        it.WT = (bf16_t*)(a.ws + WS_WD + (size_t)(257 + e) * 1024 * 256); }
    return it;
}
__device__ __forceinline__ void cvt1_run(const Args& a, int& next, int stride, int quota, LAS float* scr, int lane) {
#pragma unroll 1
    for (int q = 0; q < quota && next < CVT1_ITEMS; ++q) {
        CvtItem t[4]; f32x4 v[4][8]; bool ok[4];
#pragma unroll
        for (int u = 0; u < 4; ++u) { const int idx = next + u * stride; ok[u] = idx < CVT1_ITEMS; t[u] = cvt1_item(a, ok[u] ? idx : 0); if (ok[u]) cvt32_load(t[u], lane, v[u]); }
        next += 4 * stride;
#pragma unroll
        for (int u = 0; u < 4; ++u) if (ok[u]) cvt32_finish(t[u], lane, v[u], scr);
    }
}
__device__ __forceinline__ void ph_prologue(const Args& a, LAS unsigned char* lds) {
    const int lane = threadIdx.x & 63, wave = threadIdx.x >> 6;
    LAS float* scr = (LAS float*)(lds + wave * 16640);
    const int gw = blockIdx.x * 8 + wave, ngw = gridDim.x * 8;
    for (int it = gw; it < 257 * 192; it += ngw) {
        const int le = it / 192, sub = it % 192, l = 0, e = le, mat = sub >> 6, r = sub & 63;
        if (mat < 2) {
            const float* W = (e < 256) ? a.in[23 + mat] + ((size_t)l * 256 + e) * (size_t)(D * FF) : a.in[26 + mat] + (size_t)l * (D * FF);
            const int kb = r >> 2, n0 = (r & 3) * 64;
            p0_item(W, D, FF, (bf16_t*)(a.ws + WS_WGU + (size_t)le * 512 * 1024), kb, n0, (n0 >> 7) * 256 + mat * 128 + (n0 & 127), scr, lane, true);
        } else {
            const float* W = (e < 256) ? a.in[25] + ((size_t)l * 256 + e) * (size_t)(FF * D) : a.in[28] + (size_t)l * (FF * D);
            const int kb = r >> 4, n0 = (r & 15) * 64;
            p0_item(W, FF, D, (bf16_t*)(a.ws + WS_WD + (size_t)le * 1024 * 256), kb, n0, n0, scr, lane, true);
        }
    }
    {
        for (int it = gw; it < 512; it += ngw) { const int w = it >> 8, r = it & 255;
            p0_item(a.in[w ? 16 : 8], D, D, (bf16_t*)(a.ws + (w ? WS_WOUTN : WS_WOUT0)), r >> 4, (r & 15) * 64, (r & 15) * 64, scr, lane); }
        for (int it = gw; it < 16 * 41; it += ngw) p0_item(a.in[9], D, 2608, (bf16_t*)(a.ws + WS_WINN), it / 41, (it % 41) * 64, (it % 41) * 64, scr, lane);
        for (int it = gw; it < 128; it += ngw) { const int l = it >> 6, r = it & 63;
            p0_item(a.in[21] + (size_t)l * D * NE, D, NE, (bf16_t*)(a.ws + WS_WR) + (size_t)l * NE * D, r >> 2, (r & 3) * 64, (r & 3) * 64, scr, lane); }
        for (int it = gw; it < 16 * 16; it += ngw) { const int kb = it >> 4, n0 = (8 + (it & 15)) * 64;
            const int isg = (n0 >= 1024) ? 1 : 0, rel = n0 - 512 - isg * 512;
            p0_item(a.in[1], D, 1536, (bf16_t*)(a.ws + WS_WIN0), kb, n0, 512 + (rel >> 7) * 256 + isg * 128 + (rel & 127), scr, lane); }
        for (int it = gw; it < 128; it += ngw) { const int kv = it >> 6, r = it & 63;
            p0_item(a.in[kv ? 14 : 11], 2048, 128, (bf16_t*)(a.ws + WS_CW1) + (size_t)kv * 256 * 2048, r >> 1, (r & 1) * 64, (r & 1) * 64, scr, lane); }
    }
    {
        const int gt = blockIdx.x * 512 + threadIdx.x, ngt = gridDim.x * 512;
        u32x4* z0 = (u32x4*)((bf16_t*)(a.ws + WS_WINN) + (size_t)2608 * 1024);
        for (int i = gt; i < 208 * 1024 / 8; i += ngt) z0[i] = (u32x4){0u, 0u, 0u, 0u};
        for (int kv = 0; kv < 2; ++kv) { u32x4* z1 = (u32x4*)((bf16_t*)(a.ws + WS_CW1) + ((size_t)kv * 256 + 128) * 2048);
            for (int i = gt; i < 128 * 2048 / 8; i += ngt) z1[i] = (u32x4){0u, 0u, 0u, 0u}; }
        const float* x = a.in[0]; bf16_t* XA = (bf16_t*)(a.ws + WS_XA);
        for (size_t i = gt; i < (size_t)M * D / 8; i += ngt) { const f32x4 v0 = *(const f32x4*)(x + i * 8), v1 = *(const f32x4*)(x + i * 8 + 4);
            u32x4 o; o.x = pk2(v0[0], v0[1]); o.y = pk2(v0[2], v0[3]); o.z = pk2(v1[0], v1[1]); o.w = pk2(v1[2], v1[3]); *(u32x4*)(XA + i * 8) = o; }
        const float* win = a.in[1]; const float* mix = a.in[2]; const float* psc = a.in[3]; bf16_t* WIN0 = (bf16_t*)(a.ws + WS_WIN0);
        for (int i = gt; i < 512 * 1024; i += ngt) { const int n = i & 511, k = i >> 9, g = n >> 7, nn = n & 127;
            const float* wr_ = win + (size_t)k * 1536 + g * 128; const float* mx = mix + (size_t)g * 128 * 128 + nn;
            float s = 0.f;
            for (int c = 0; c < 128; ++c) s += wr_[c] * mx[(size_t)c * 128];
            WIN0[(size_t)n * 1024 + k] = f2bf(s * psc[n]); }
        float* misc = (float*)(a.ws + WS_MISC);
        for (int i = gt; i < 256; i += ngt) { const int kv = i >> 7, j = i & 127; const float* pos = a.in[kv ? 13 : 10]; const float* w1 = a.in[kv ? 14 : 11];
            float s = 0.f; for (int k = 0; k < 2048; ++k) s += pos[k] * w1[(size_t)k * 128 + j]; misc[i] = s; }
        float* rot = misc + 1024;
        for (int i = gt; i < T * 8; i += ngt) { const int t = i >> 3, f = i & 7;
            const float ang = (float)t * a.inv_freq[f]; const double rev = (double)ang * 0.15915494309189535; const float fr = (float)(rev - floor(rev));
            rot[t * 16 + f] = __builtin_amdgcn_cosf(fr); rot[t * 16 + 8 + f] = __builtin_amdgcn_sinf(fr); }
    }
}

typedef short v4i16_t __attribute__((ext_vector_type(4)));
constexpr int AT_KB = 0, AT_VB = 16384, AT_PS = 32768, AT_MSK = 32768 + 65536;
__device__ __forceinline__ bf16x8 tr_frag(LAS unsigned char* p0, LAS unsigned char* p1) {
    const v4i16_t a = __builtin_amdgcn_ds_read_tr16_b64_v4i16((LAS v4i16_t*)p0), b = __builtin_amdgcn_ds_read_tr16_b64_v4i16((LAS v4i16_t*)p1);
    return (bf16x8){a[0], a[1], a[2], a[3], b[0], b[1], b[2], b[3]};
}
constexpr size_t TN2_OFF = 786432;
__device__ __forceinline__ void ph_knorm(const Args& a) {
    const bf16_t* KV6 = (const bf16_t*)(a.ws + WS_KV6);
    float* TN2 = (float*)(a.ws + WS_MISC + TN2_OFF);
    const int lane = threadIdx.x & 63, wave = threadIdx.x >> 6;
    const int first = (gridDim.x > 64) ? 64 : 0;
    if ((int)blockIdx.x < first) return;
    const int wi = ((int)blockIdx.x - first) * 8 + wave, nw = ((int)gridDim.x - first) * 8;
    for (int id = wi; id < 4096; id += nw) {
        const int ty = id >> 11, bg = (id >> 7) & 15, tile = id & 127;
        const bf16_t* rp = KV6 + ((size_t)((ty ? 4 : 2) * 16 + bg) * T + tile * 64 + lane) * 64;
        float ssq = 0.f;
#pragma unroll
        for (int c = 0; c < 8; ++c) { const bf16x8 v = *(const bf16x8*)(rp + 8 * c);
#pragma unroll
            for (int j = 0; j < 8; ++j) { const float f = bf2f((bf16_t)v[j]); ssq += f * f; } }
        ssq = wave_max(ssq);
        if (lane == 0) TN2[id] = ssq;
    }
}
__device__ __forceinline__ void attn_qk2(LAS unsigned char* Kb, const bf16x8 (&q)[2][2], int fr, int g4, const float (&cinit)[2], f32x4 (&s)[2][4]) {
#pragma unroll
    for (int c = 0; c < 4; ++c) {
#pragma unroll
        for (int rb = 0; rb < 2; ++rb) s[rb][c] = (f32x4){cinit[rb], cinit[rb], cinit[rb], cinit[rb]};
#pragma unroll
        for (int ks = 0; ks < 2; ++ks) {
            const bf16x8 kf = *(const LAS bf16x8*)(Kb + pg8::lds_byte(16 * c + fr, 32 * ks + 8 * g4));
#pragma unroll
            for (int rb = 0; rb < 2; ++rb) s[rb][c] = __builtin_amdgcn_mfma_f32_16x16x32_bf16(kf, q[rb][ks], s[rb][c], 0, 0, 0);
        }
    }
}
__device__ __forceinline__ void attn_qk2z(LAS unsigned char* Kb, const bf16x8 (&q)[2][2], int fr, int g4, f32x4 (&s)[2][4]) {
    bf16x8 kf[4][2];
#pragma unroll
    for (int c = 0; c < 4; ++c)
#pragma unroll
        for (int ks = 0; ks < 2; ++ks) kf[c][ks] = *(const LAS bf16x8*)(Kb + pg8::lds_byte(16 * c + fr, 32 * ks + 8 * g4));
    __builtin_amdgcn_sched_barrier(0);
#pragma unroll
    for (int c = 0; c < 4; ++c) {
#pragma unroll
        for (int ks = 0; ks < 2; ++ks) {
#pragma unroll
            for (int rb = 0; rb < 2; ++rb) s[rb][c] = __builtin_amdgcn_mfma_f32_16x16x32_bf16(kf[c][ks], q[rb][ks], ks == 0 ? (f32x4){0.f, 0.f, 0.f, 0.f} : s[rb][c], 0, 0, 0);
        }
    }
}
struct AttnRow { float m; f32x4 o[4]; f32x4 ol; };
__device__ __forceinline__ float max3f(float a, float b, float c) { float r; asm("v_max3_f32 %0, %1, %2, %3" : "=v"(r) : "v"(a), "v"(b), "v"(c)); return r; }
__device__ __forceinline__ bool attn_sm2(f32x4 (&s)[4], AttnRow& st, int kbase, int g4, int lo, int hi, bool en, bool emask) {
    const float NEG = -INFINITY;
    if (emask) {
#pragma unroll
        for (int c = 0; c < 4; ++c)
#pragma unroll
            for (int i = 0; i < 4; ++i) { const int key = kbase + 16 * c + 4 * g4 + i; if (key < lo || key > hi) s[c][i] = NEG; }
    }
    float mx = max3f(s[0][0], s[0][1], s[0][2]); mx = max3f(mx, s[0][3], s[1][0]); mx = max3f(mx, s[1][1], s[1][2]); mx = max3f(mx, s[1][3], s[2][0]);
    mx = max3f(mx, s[2][1], s[2][2]); mx = max3f(mx, s[2][3], s[3][0]); mx = max3f(mx, s[3][1], s[3][2]); mx = max3f(mx, s[3][3], mx);
    if (!en) mx = NEG;
    mx = max3f(mx, __shfl_xor(mx, 16), mx); mx = max3f(mx, __shfl_xor(mx, 32), mx);
    const float delta = (mx > 20.0f) ? mx : 0.f;
    const bool moved = __builtin_amdgcn_ballot_w64(delta != 0.f) != 0ull;
    if (moved) {
        const float alpha = __builtin_amdgcn_exp2f(-delta);
#pragma unroll
        for (int c = 0; c < 4; ++c) s[c] = s[c] - delta;
#pragma unroll
        for (int dt = 0; dt < 4; ++dt) st.o[dt] *= alpha;
        st.ol *= alpha;
        st.m += delta;
    }
#pragma unroll
    for (int c = 0; c < 4; ++c)
#pragma unroll
        for (int i = 0; i < 4; ++i) s[c][i] = __builtin_amdgcn_exp2f(s[c][i]);
    return moved;
}
__device__ __forceinline__ bool attn_sm2x(f32x4 (&s)[2][4], AttnRow (&st)[2], int kbase, int g4, const int (&lo)[2], const int (&hi)[2], const bool (&en)[2], bool emask) {
    const float NEG = -INFINITY;
    if (emask) {
#pragma unroll
        for (int rb = 0; rb < 2; ++rb)
#pragma unroll
            for (int c = 0; c < 4; ++c)
#pragma unroll
                for (int i = 0; i < 4; ++i) { const int key = kbase + 16 * c + 4 * g4 + i; if (key < lo[rb] || key > hi[rb]) s[rb][c][i] = NEG; }
    }
    float mx[2];
#pragma unroll
    for (int rb = 0; rb < 2; ++rb) {
        float m = max3f(s[rb][0][0], s[rb][0][1], s[rb][0][2]); m = max3f(m, s[rb][0][3], s[rb][1][0]); m = max3f(m, s[rb][1][1], s[rb][1][2]); m = max3f(m, s[rb][1][3], s[rb][2][0]);
        m = max3f(m, s[rb][2][1], s[rb][2][2]); m = max3f(m, s[rb][2][3], s[rb][3][0]); m = max3f(m, s[rb][3][1], s[rb][3][2]); m = max3f(m, s[rb][3][3], m);
        mx[rb] = en[rb] ? m : NEG;
    }
    { const float t0 = __shfl_xor(mx[0], 16), t1 = __shfl_xor(mx[1], 16); mx[0] = max3f(mx[0], t0, t0); mx[1] = max3f(mx[1], t1, t1); }
    { const float t0 = __shfl_xor(mx[0], 32), t1 = __shfl_xor(mx[1], 32); mx[0] = max3f(mx[0], t0, t0); mx[1] = max3f(mx[1], t1, t1); }
    const float d0 = (mx[0] > 20.0f) ? mx[0] : 0.f, d1 = (mx[1] > 20.0f) ? mx[1] : 0.f;
    const bool moved = __builtin_amdgcn_ballot_w64((d0 != 0.f) || (d1 != 0.f)) != 0ull;
    if (moved) {
        const float dl[2] = {d0, d1};
#pragma unroll
        for (int rb = 0; rb < 2; ++rb) {
            const float alpha = __builtin_amdgcn_exp2f(-dl[rb]);
#pragma unroll
            for (int c = 0; c < 4; ++c) s[rb][c] = s[rb][c] - dl[rb];
#pragma unroll
            for (int dt = 0; dt < 4; ++dt) st[rb].o[dt] *= alpha;
            st[rb].ol *= alpha; st[rb].m += dl[rb];
        }
    }
#pragma unroll
    for (int rb = 0; rb < 2; ++rb)
#pragma unroll
        for (int c = 0; c < 4; ++c)
#pragma unroll
            for (int i = 0; i < 4; ++i) s[rb][c][i] = __builtin_amdgcn_exp2f(s[rb][c][i]);
    return moved;
}
__device__ __forceinline__ void attn_pv2x(LAS unsigned char* Vb, const f32x4 (&p)[2][4], int vlane, int swz, const unsigned (&enm)[2], const bool (&act)[2], const bf16x8 onesf, AttnRow (&st)[2]) {
#pragma unroll
    for (int ks = 0; ks < 2; ++ks) {
        bf16x8 pb[2];
#pragma unroll
        for (int rb = 0; rb < 2; ++rb) { u32x4 pw = pack8m(p[rb][2 * ks], p[rb][2 * ks + 1]); pw.x &= enm[rb]; pw.y &= enm[rb]; pw.z &= enm[rb]; pw.w &= enm[rb]; pb[rb] = __builtin_bit_cast(bf16x8, pw); }
#pragma unroll
        for (int dt = 0; dt < 4; ++dt) {
            LAS unsigned char* a0 = Vb + vlane + (2 * ks) * 2048 + ((dt ^ swz) * 32);
            const bf16x8 vf = tr_frag(a0, a0 + 2048);
#pragma unroll
            for (int rb = 0; rb < 2; ++rb) if (act[rb]) st[rb].o[dt] = __builtin_amdgcn_mfma_f32_16x16x32_bf16(vf, pb[rb], st[rb].o[dt], 0, 0, 0);
        }
#pragma unroll
        for (int rb = 0; rb < 2; ++rb) if (act[rb]) st[rb].ol = __builtin_amdgcn_mfma_f32_16x16x32_bf16(onesf, pb[rb], st[rb].ol, 0, 0, 0);
    }
}
__device__ __forceinline__ bool attn_max2x(f32x4 (&s)[2][4], int kbase, int g4, const int (&lo)[2], const int (&hi)[2], const bool (&en)[2], bool emask, float (&d)[2]) {
    const float NEG = -INFINITY;
    MFMA_SETTLE(s);
    if (emask) {
#pragma unroll
        for (int rb = 0; rb < 2; ++rb)
#pragma unroll
            for (int c = 0; c < 4; ++c)
#pragma unroll
                for (int i = 0; i < 4; ++i) { const int key = kbase + 16 * c + 4 * g4 + i; if (key < lo[rb] || key > hi[rb]) s[rb][c][i] = NEG; }
    }
    float mx[2];
#pragma unroll
    for (int rb = 0; rb < 2; ++rb) {
        float m = max3f(s[rb][0][0], s[rb][0][1], s[rb][0][2]); m = max3f(m, s[rb][0][3], s[rb][1][0]); m = max3f(m, s[rb][1][1], s[rb][1][2]); m = max3f(m, s[rb][1][3], s[rb][2][0]);
        m = max3f(m, s[rb][2][1], s[rb][2][2]); m = max3f(m, s[rb][2][3], s[rb][3][0]); m = max3f(m, s[rb][3][1], s[rb][3][2]); m = max3f(m, s[rb][3][3], m);
        mx[rb] = en[rb] ? m : NEG;
    }
    { const float t0 = __shfl_xor(mx[0], 16), t1 = __shfl_xor(mx[1], 16); mx[0] = max3f(mx[0], t0, t0); mx[1] = max3f(mx[1], t1, t1); }
    { const float t0 = __shfl_xor(mx[0], 32), t1 = __shfl_xor(mx[1], 32); mx[0] = max3f(mx[0], t0, t0); mx[1] = max3f(mx[1], t1, t1); }
    d[0] = (mx[0] > 20.0f) ? mx[0] : 0.f; d[1] = (mx[1] > 20.0f) ? mx[1] : 0.f;
    return __builtin_amdgcn_ballot_w64((d[0] != 0.f) || (d[1] != 0.f)) != 0ull;
}
__device__ __forceinline__ void attn_rescale2x(f32x4 (&s)[2][4], AttnRow (&st)[2], const float (&d)[2]) {
#pragma unroll
    for (int rb = 0; rb < 2; ++rb) {
        const float alpha = __builtin_amdgcn_exp2f(-d[rb]);
#pragma unroll
        for (int c = 0; c < 4; ++c) s[rb][c] = s[rb][c] - d[rb];
#pragma unroll
        for (int dt = 0; dt < 4; ++dt) st[rb].o[dt] *= alpha;
        st[rb].ol *= alpha; st[rb].m += d[rb];
    }
}
__device__ __forceinline__ void attn_exp1(f32x4 (&s)[4], unsigned enm, bf16x8 (&pb)[2]) {
#pragma unroll
    for (int c = 0; c < 4; ++c)
#pragma unroll
        for (int i = 0; i < 4; ++i) s[c][i] = __builtin_amdgcn_exp2f(s[c][i]);
#pragma unroll
    for (int ks = 0; ks < 2; ++ks) { u32x4 pw = pack8m(s[2 * ks], s[2 * ks + 1]); pw.x &= enm; pw.y &= enm; pw.z &= enm; pw.w &= enm; pb[ks] = __builtin_bit_cast(bf16x8, pw); }
}
__device__ __forceinline__ void attn_pv1(LAS unsigned char* Vb, const bf16x8 (&pb)[2], int vlane, int swz, const bf16x8 onesf, AttnRow& st) {
#pragma unroll
    for (int ks = 0; ks < 2; ++ks) {
#pragma unroll
        for (int dt = 0; dt < 4; ++dt) {
            LAS unsigned char* a0 = Vb + vlane + (2 * ks) * 2048 + ((dt ^ swz) * 32);
            const bf16x8 vf = tr_frag(a0, a0 + 2048);
            st.o[dt] = __builtin_amdgcn_mfma_f32_16x16x32_bf16(vf, pb[ks], st.o[dt], 0, 0, 0);
        }
        st.ol = __builtin_amdgcn_mfma_f32_16x16x32_bf16(onesf, pb[ks], st.ol, 0, 0, 0);
    }
}
__device__ __forceinline__ bool attn_step2x(LAS unsigned char* Vb, f32x4 (&s)[2][4], AttnRow (&st)[2], int kbase, int g4, const int (&lo)[2], const int (&hi)[2], const bool (&en)[2], const unsigned (&enm)[2], bool emask,
                                            int vlane, int swz, const bf16x8 onesf) {
    float d[2];
    const bool moved = attn_max2x(s, kbase, g4, lo, hi, en, emask, d);
    if (moved) attn_rescale2x(s, st, d);
    bf16x8 p0[2], p1[2];
    attn_exp1(s[0], enm[0], p0);
    attn_pv1(Vb, p0, vlane, swz, onesf, st[0]);
    attn_exp1(s[1], enm[1], p1);
    attn_pv1(Vb, p1, vlane, swz, onesf, st[1]);
    return moved;
}
__device__ __forceinline__ void attn_step2x_nomax(LAS unsigned char* Vb, f32x4 (&s)[2][4], AttnRow (&st)[2], int kbase, int g4, const int (&lo)[2], const int (&hi)[2], const unsigned (&enm)[2], bool emask,
                                                  int vlane, int swz, const bf16x8 onesf) {
    if (emask) {
#pragma unroll
        for (int rb = 0; rb < 2; ++rb)
#pragma unroll
            for (int c = 0; c < 4; ++c)
#pragma unroll
                for (int i = 0; i < 4; ++i) { const int key = kbase + 16 * c + 4 * g4 + i; if (key < lo[rb] || key > hi[rb]) s[rb][c][i] = -INFINITY; }
    }
    bf16x8 p0[2], p1[2];
    attn_exp1(s[0], enm[0], p0);
    attn_pv1(Vb, p0, vlane, swz, onesf, st[0]);
    attn_exp1(s[1], enm[1], p1);
    attn_pv1(Vb, p1, vlane, swz, onesf, st[1]);
}
typedef _Float16 f16x4 __attribute__((ext_vector_type(4)));
constexpr int AT4_KB = 0, AT4_VB = 32768, AT2_PS = 65536, AT2_MSK = 65536 + 65536;
__device__ __forceinline__ void ph_attn_fast2(const Args& a, LAS unsigned char* lds) {
    const bf16_t* QN = (const bf16_t*)(a.ws + WS_HN);
    const bf16_t* QR = (const bf16_t*)(a.ws + WS_QR);
    const bf16_t* KV6 = (const bf16_t*)(a.ws + WS_KV6);
    const float* GATES = (const float*)(a.ws + WS_GATES);
    const bf16_t* KC = (const bf16_t*)(a.ws + WS_KC);
    const bf16_t* VC = KC + (size_t)8192 * 64;
    bf16_t* O = (bf16_t*)(a.ws + WS_O);
    const int tid = threadIdx.x, lane = tid & 63, wave = __builtin_amdgcn_readfirstlane(tid >> 6);
    const int fr = lane & 15, g4 = lane >> 4;
    int ksrc, vsrc;
    { int R, C; pg8::stage_rc(wave * 1024 + lane * 16, R, C); ksrc = R * 64 + C;
      const int key = 8 * wave + (lane >> 3), pos = lane & 7, chunk = (pos >> 1) ^ ((key >> 1) & 3); vsrc = key * 64 + (chunk * 2 + (pos & 1)) * 8; }
    const int vlane = (4 * g4 + (fr >> 2)) * 128 + (fr & 3) * 8, swz = (2 * g4 + (fr >> 3)) & 3;
    LAS _Float16* ps = (LAS _Float16*)(lds + AT2_PS + wave * 8192);
    LAS unsigned* mskl = (LAS unsigned*)(lds + AT2_MSK + wave * 128);
    const float NEG = -INFINITY;
    const bf16x8 onesf = (fr == 0) ? (bf16x8){0x3F80, 0x3F80, 0x3F80, 0x3F80, 0x3F80, 0x3F80, 0x3F80, 0x3F80} : (bf16x8){0, 0, 0, 0, 0, 0, 0, 0};
    const int vcu = (gridDim.x % 8 == 0) ? (int)((blockIdx.x % 8) * (gridDim.x / 8) + blockIdx.x / 8) : (int)blockIdx.x;
    int cvt_next = (int)blockIdx.x * 8 + wave; const int cvt_stride = (int)gridDim.x * 8;
    LAS float* cvt_scr = (LAS float*)(lds + AT2_PS + wave * 8448);
    for (int pr = vcu; pr < 1024; pr += gridDim.x) {
#pragma unroll 1
        for (int half = 0; half < 2; ++half) {
            const int bg = pr >> 6, cc = half ? (127 - (pr & 63)) : (pr & 63);
            const int b = bg >> 2, g = bg & 3, t0 = cc * 64, cur = cc;
            const int head = g * 4 + (fr & 3);
            int trow[2];
            bf16x8 qn[2][2];
#pragma unroll
            for (int rb = 0; rb < 2; ++rb) {
                trow[rb] = t0 + 8 * wave + 4 * rb + (fr >> 2);
#pragma unroll
                for (int ks = 0; ks < 2; ++ks) qn[rb][ks] = *(const bf16x8*)(QN + ((size_t)b * T + trow[rb]) * 1024 + head * 64 + 32 * ks + 8 * g4);
            }
#define TROW_PIN() asm volatile("" : "+v"(trow[0]), "+v"(trow[1]))
#define TOKROW(rb) ((size_t)b * T + trow[rb])
#define GATE(rb, br) (GATES[TOKROW(rb) * 48 + head * 3 + (br)])
            const bf16_t* kcb = KC + (size_t)bg * 512 * 64;
            const bf16_t* kvb = KV6 + (size_t)bg * T * 64;
#define ATK(sl) (((sl) < 4 ? AT4_KB : AT2_PS - 4 * 8192) + (sl) * 8192)
#define ATV(sl) (((sl) < 4 ? AT4_VB : AT2_PS + 32768 - 4 * 8192) + (sl) * 8192)
#define AT_DMA(BR, tile, slot) do { const bf16_t* kp_; const bf16_t* vp_; \
                if ((BR) == 0) { kp_ = kcb + (size_t)(tile) * 4096; vp_ = kp_ + (size_t)8192 * 64; } \
                else { kp_ = kvb + (size_t)((BR) == 1 ? 2 : 4) * 16 * T * 64 + (size_t)(tile) * 4096; vp_ = kp_ + (size_t)16 * T * 64; } \
                __builtin_amdgcn_global_load_lds((const unsigned*)(kp_ + ksrc), (LAS unsigned*)(lds + ATK(slot) + wave * 1024), 16, 0, 0); \
                __builtin_amdgcn_global_load_lds((const unsigned*)(vp_ + vsrc), (LAS unsigned*)(lds + ATV(slot) + wave * 1024), 16, 0, 0); } while (0)
            int ncv[2];
#pragma unroll
            for (int rb = 0; rb < 2; ++rb) ncv[rb] = (trow[rb] >= 31) ? ((trow[rb] - 31) / 16 + 1) : 0;
            const int nct = (((t0 + 63 - 31) / 16 + 1) + 63) >> 6;
            float mc[2], invc[2];
            {
                float m1[2] = {NEG, NEG}, l1[2] = {0.f, 0.f};
                const float zero2[2] = {0.f, 0.f};
#define CMP1_TILE(J, SLOT) do { const int j = (J); const int SLOT_ = (SLOT); \
                    f32x4 s[2][4]; attn_qk2(lds + AT4_KB + SLOT_ * 8192, qn, fr, g4, zero2, s); \
                    _Pragma("unroll") \
                    for (int rb = 0; rb < 2; ++rb) { \
                        float mx = NEG; \
                    _Pragma("unroll") \
                        for (int c = 0; c < 4; ++c) \
                    _Pragma("unroll") \
                            for (int i = 0; i < 4; ++i) { const int n = 64 * j + 16 * c + 4 * g4 + i; if (n >= ncv[rb]) s[rb][c][i] = NEG; mx = fmaxf(mx, s[rb][c][i]); } \
                        mx = fmaxf(mx, __shfl_xor(mx, 16)); mx = fmaxf(mx, __shfl_xor(mx, 32)); \
                        const float mn = fmaxf(m1[rb], mx), msafe = (mn == NEG) ? 0.f : mn; \
                        const float alpha = (m1[rb] == NEG) ? 0.f : __builtin_amdgcn_exp2f(m1[rb] - msafe); \
                        float sum = 0.f; \
                    _Pragma("unroll") \
                        for (int c = 0; c < 4; ++c) \
                    _Pragma("unroll") \
                            for (int i = 0; i < 4; ++i) sum += __builtin_amdgcn_exp2f(s[rb][c][i] - msafe); \
                        l1[rb] = l1[rb] * alpha + sum; m1[rb] = mn; \
                    } \
                } while (0)
                AT_DMA(0, 0, 0); if (nct > 1) AT_DMA(0, 1, 1); __syncthreads();
                for (int j0 = 0; j0 < nct; j0 += 2) { const int sb = (j0 & 2);
                    if (j0 + 2 < nct) AT_DMA(0, j0 + 2, sb ^ 2);
                    if (j0 + 3 < nct) AT_DMA(0, j0 + 3, (sb ^ 2) + 1);
                    CMP1_TILE(j0, sb); if (j0 + 1 < nct) CMP1_TILE(j0 + 1, sb + 1);
                    __syncthreads();
                }
#undef CMP1_TILE
#pragma unroll
                for (int rb = 0; rb < 2; ++rb) { float lc = l1[rb]; lc += __shfl_xor(lc, 16); lc += __shfl_xor(lc, 32); invc[rb] = (lc > 0.f) ? 1.0f / lc : 0.f; mc[rb] = (m1[rb] == NEG) ? 0.f : m1[rb]; }
            }
            {
                AttnRow oc[2];
#pragma unroll
                for (int rb = 0; rb < 2; ++rb) { oc[rb].m = 0.f; oc[rb].ol = (f32x4){0.f, 0.f, 0.f, 0.f};
#pragma unroll
                    for (int dt = 0; dt < 4; ++dt) oc[rb].o[dt] = (f32x4){0.f, 0.f, 0.f, 0.f}; }
                const float cin[2] = {-mc[0], -mc[1]};
                const unsigned full[2] = {0xffffffffu, 0xffffffffu}; const bool both[2] = {true, true};
#define CMP2_TILE(J, SLOT) do { const int j = (J); const int SLOT_ = (SLOT); \
                    f32x4 s[2][4]; attn_qk2(lds + AT4_KB + SLOT_ * 8192, qn, fr, g4, cin, s); \
                    _Pragma("unroll") \
                    for (int rb = 0; rb < 2; ++rb) \
                    _Pragma("unroll") \
                        for (int c = 0; c < 4; ++c) { \
                            f16x4 hs; \
                    _Pragma("unroll") \
                            for (int i = 0; i < 4; ++i) { const int n = 64 * j + 16 * c + 4 * g4 + i; const float p = (n < ncv[rb]) ? __builtin_amdgcn_exp2f(s[rb][c][i]) * invc[rb] : 0.f; s[rb][c][i] = p; \
                                float h = p; h += __shfl_xor(h, 1); h += __shfl_xor(h, 2); hs[i] = (_Float16)h; } \
                            if ((fr & 3) == 0) *(LAS f16x4*)(ps + (4 * rb + (fr >> 2)) * 512 + 64 * j + 16 * c + 4 * g4) = hs; \
                        } \
                    attn_pv2x(lds + AT4_VB + SLOT_ * 8192, s, vlane, swz, full, both, onesf, oc); \
                } while (0)
                AT_DMA(0, 0, 0); if (nct > 1) AT_DMA(0, 1, 1); __syncthreads();
                for (int j0 = 0; j0 < nct; j0 += 2) { const int sb = (j0 & 2);
                    if (j0 + 2 < nct) AT_DMA(0, j0 + 2, sb ^ 2);
                    if (j0 + 3 < nct) AT_DMA(0, j0 + 3, (sb ^ 2) + 1);
                    CMP2_TILE(j0, sb); if (j0 + 1 < nct) CMP2_TILE(j0 + 1, sb + 1);
                    __syncthreads();
                }
#undef CMP2_TILE
                TROW_PIN();
#pragma unroll
                for (int rb = 0; rb < 2; ++rb) { bf16_t* op = O + TOKROW(rb) * 1024 + head * 64 + 4 * g4; const float g0 = GATE(rb, 0);
#pragma unroll
                    for (int dt = 0; dt < 4; ++dt) { const f32x4 v = oc[rb].o[dt] * g0; u32x2 w; w.x = cvt_pk_bf16(v[0], v[1]); w.y = cvt_pk_bf16(v[2], v[3]); *(u32x2*)(op + 16 * dt) = w; } }
            }
            {
                WSYNC();
                const int tl = lane >> 4, li = lane & 15;
                const int nsel = (cur + 1 < 16) ? (cur + 1) : 16;
#pragma unroll 1
                for (int rnd = 0; rnd < 2; ++rnd) {
                    const LAS _Float16* pst = ps + (4 * rnd + tl) * 512;
                    float v[8];
#pragma unroll
                    for (int k = 0; k < 8; ++k) { const int j = li + 16 * k;
                        float x;
                        if (j > cur) x = NEG;
                        else if (j == 0 || j == cur || j == cur - 1) x = INFINITY;
                        else { const int n0 = 4 * j; x = (float)pst[n0 - 1] + 2.0f * ((float)pst[n0] + (float)pst[n0 + 1] + (float)pst[n0 + 2]) + (float)pst[n0 + 3]; }
                        v[k] = x; }
                    unsigned mm[4] = {0u, 0u, 0u, 0u};
                    for (int it = 0; it < nsel; ++it) {
                        float bv = v[0]; int bk = 0;
#pragma unroll
                        for (int k = 1; k < 8; ++k) if (v[k] > bv) { bv = v[k]; bk = k; }
                        int bi = li + 16 * bk;
#pragma unroll
                        for (int o = 1; o < 16; o <<= 1) { const float ov = __shfl_xor(bv, o); const int oi = __shfl_xor(bi, o); if (ov > bv || (ov == bv && oi < bi)) { bv = ov; bi = oi; } }
                        const unsigned bit = 1u << (bi & 31); const int wsel = bi >> 5;
                        mm[0] |= (wsel == 0) ? bit : 0u; mm[1] |= (wsel == 1) ? bit : 0u; mm[2] |= (wsel == 2) ? bit : 0u; mm[3] |= (wsel == 3) ? bit : 0u;
                        if ((bi & 15) == li) {
#pragma unroll
                            for (int k = 0; k < 8; ++k) if ((bi >> 4) == k) v[k] = NEG;
                        }
                    }
                    if (li == 0) { mskl[(4 * rnd + tl) * 4 + 0] = mm[0]; mskl[(4 * rnd + tl) * 4 + 1] = mm[1]; mskl[(4 * rnd + tl) * 4 + 2] = mm[2]; mskl[(4 * rnd + tl) * 4 + 3] = mm[3]; }
                }
                WSYNC();
            }
            bf16x8 qr[2][2];
            TROW_PIN();
#pragma unroll
            for (int rb = 0; rb < 2; ++rb)
#pragma unroll
                for (int ks = 0; ks < 2; ++ks) qr[rb][ks] = *(const bf16x8*)(QR + TOKROW(rb) * 1024 + head * 64 + 32 * ks + 8 * g4);
            bool nomax_slc, nomax_win;
            {
                float qq = 0.f;
#pragma unroll
                for (int rb = 0; rb < 2; ++rb) { float q2 = 0.f;
#pragma unroll
                    for (int ks = 0; ks < 2; ++ks)
#pragma unroll
                        for (int j = 0; j < 8; ++j) { const float x = bf2f((bf16_t)qr[rb][ks][j]); q2 += x * x; }
                    q2 += __shfl_xor(q2, 16); q2 += __shfl_xor(q2, 32); qq = fmaxf(qq, q2); }
                qq = wave_max(qq);
                const float* tn = (const float*)(a.ws + WS_MISC + TN2_OFF) + bg * 128;
                const int jt0w = (t0 >= 511) ? ((t0 - 511) >> 6) : 0;
                float ts = 0.f, tw = 0.f;
#pragma unroll
                for (int h2 = 0; h2 < 2; ++h2) { const int tl_ = lane + 64 * h2; if (tl_ <= cur) { ts = fmaxf(ts, tn[tl_]); if (tl_ >= jt0w) tw = fmaxf(tw, tn[2048 + tl_]); } }
                ts = wave_max(ts); tw = wave_max(tw);
                nomax_slc = __builtin_amdgcn_readfirstlane((qq * ts <= 3500.0f) ? 1 : 0) != 0;
                nomax_win = __builtin_amdgcn_readfirstlane((qq * tw <= 3500.0f) ? 1 : 0) != 0;
            }
            {
                AttnRow ss[2];
#pragma unroll
                for (int rb = 0; rb < 2; ++rb) { ss[rb].m = 0.f; ss[rb].ol = (f32x4){0.f, 0.f, 0.f, 0.f};
#pragma unroll
                    for (int dt = 0; dt < 4; ++dt) ss[rb].o[dt] = (f32x4){0.f, 0.f, 0.f, 0.f}; }
                const int nt_ = cur + 1;
                bool refmoved = false;
#define SLC_PRE(J) const int j_ = (J); bool en[2], act[2]; unsigned enm[2]; \
                    _Pragma("unroll") for (int rb = 0; rb < 2; ++rb) { const unsigned mw = mwg[rb]; \
                        en[rb] = (mw >> (j_ & 31)) & 1u; act[rb] = __any(en[rb]); enm[rb] = en[rb] ? 0xffffffffu : 0u; } const int lo2[2] = {0, 0};
#define SLC_TILE(J, SLOT) do { SLC_PRE(J) \
                    if (act[0] || act[1]) { f32x4 s[2][4]; \
                        if (refmoved) { const float cin[2] = {-ss[0].m, -ss[1].m}; attn_qk2(lds + ATK(SLOT), qr, fr, g4, cin, s); } \
                        else attn_qk2z(lds + ATK(SLOT), qr, fr, g4, s); \
                        refmoved |= attn_step2x(lds + ATV(SLOT), s, ss, 64 * j_, g4, lo2, trow, en, enm, j_ == cur, vlane, swz, onesf); } } while (0)
#define SLC_TILE_NM(J, SLOT) do { SLC_PRE(J) \
                    if (act[0] || act[1]) { f32x4 s[2][4]; attn_qk2z(lds + ATK(SLOT), qr, fr, g4, s); \
                        attn_step2x_nomax(lds + ATV(SLOT), s, ss, 64 * j_, g4, lo2, trow, enm, j_ == cur, vlane, swz, onesf); } } while (0)
#pragma unroll
                for (int i = 0; i < 4; ++i) if (i < nt_) AT_DMA(1, i, i);
                __syncthreads();
#define SLC_LOOP(TILE) for (int j0 = 0; j0 < nt_; j0 += 4) { const int sb = (j0 & 4); \
                    const unsigned mwg[2] = {mskl[(fr >> 2) * 4 + (j0 >> 5)], mskl[(4 + (fr >> 2)) * 4 + (j0 >> 5)]};       \
                    _Pragma("unroll") for (int i = 0; i < 4; ++i) if (j0 + 4 + i < nt_) AT_DMA(1, j0 + 4 + i, (sb ^ 4) + i); \
                    TILE(j0, sb); if (j0 + 1 < nt_) TILE(j0 + 1, sb + 1); if (j0 + 2 < nt_) TILE(j0 + 2, sb + 2); if (j0 + 3 < nt_) TILE(j0 + 3, sb + 3); \
                    __syncthreads(); }
                if (nomax_slc) { SLC_LOOP(SLC_TILE_NM) } else { SLC_LOOP(SLC_TILE) }
#undef SLC_LOOP
#undef SLC_TILE_NM
#undef SLC_PRE
#undef SLC_TILE
                TROW_PIN();
#pragma unroll
                for (int rb = 0; rb < 2; ++rb) { const float l = __shfl(ss[rb].ol[0], fr); const float sc1 = (l > 0.f) ? GATE(rb, 1) / l : 0.f;
                    bf16_t* op = O + TOKROW(rb) * 1024 + head * 64 + 4 * g4;
#pragma unroll
                    for (int dt = 0; dt < 4; ++dt) { const u32x2 pv = *(const u32x2*)(op + 16 * dt); f32x4 v = ss[rb].o[dt] * sc1;
                        v[0] += __uint_as_float(pv.x << 16); v[1] += __uint_as_float(pv.x & 0xffff0000u); v[2] += __uint_as_float(pv.y << 16); v[3] += __uint_as_float(pv.y & 0xffff0000u);
                        u32x2 w; w.x = cvt_pk_bf16(v[0], v[1]); w.y = cvt_pk_bf16(v[2], v[3]); *(u32x2*)(op + 16 * dt) = w; } }
            }
            {
                AttnRow sw[2];
#pragma unroll
                for (int rb = 0; rb < 2; ++rb) { sw[rb].m = 0.f; sw[rb].ol = (f32x4){0.f, 0.f, 0.f, 0.f};
#pragma unroll
                    for (int dt = 0; dt < 4; ++dt) sw[rb].o[dt] = (f32x4){0.f, 0.f, 0.f, 0.f}; }
                const int jt0 = (t0 >= 511) ? ((t0 - 511) >> 6) : 0;
                const int nt_ = cur - jt0 + 1;
                const unsigned full[2] = {0xffffffffu, 0xffffffffu}; const bool both[2] = {true, true};
                bool refmoved = false;
#define WIN_PRE(JJ) const int j = jt0 + (JJ); f32x4 s[2][4]; const bool edge = (j == cur) || (64 * j < t0 + 63 - 511); const int lo2[2] = {trow[0] - 511, trow[1] - 511};
#define WIN_TILE(JJ, SLOT) do { WIN_PRE(JJ) \
                    if (refmoved) { const float cin[2] = {-sw[0].m, -sw[1].m}; attn_qk2(lds + AT4_KB + (SLOT) * 8192, qr, fr, g4, cin, s); } \
                    else attn_qk2z(lds + AT4_KB + (SLOT) * 8192, qr, fr, g4, s); \
                    refmoved |= attn_step2x(lds + AT4_VB + (SLOT) * 8192, s, sw, 64 * j, g4, lo2, trow, both, full, edge, vlane, swz, onesf); } while (0)
#define WIN_TILE_NM(JJ, SLOT) do { WIN_PRE(JJ) attn_qk2z(lds + AT4_KB + (SLOT) * 8192, qr, fr, g4, s); \
                    attn_step2x_nomax(lds + AT4_VB + (SLOT) * 8192, s, sw, 64 * j, g4, lo2, trow, full, edge, vlane, swz, onesf); } while (0)
                AT_DMA(2, jt0, 0); if (nt_ > 1) AT_DMA(2, jt0 + 1, 1); __syncthreads();
#define WIN_LOOP(TILE) for (int j0 = 0; j0 < nt_; j0 += 2) { const int sb = (j0 & 2); \
                    if (j0 + 2 < nt_) AT_DMA(2, jt0 + j0 + 2, sb ^ 2); \
                    if (j0 + 3 < nt_) AT_DMA(2, jt0 + j0 + 3, (sb ^ 2) + 1); \
                    TILE(j0, sb); if (j0 + 1 < nt_) TILE(j0 + 1, sb + 1); \
                    __syncthreads(); }
                if (nomax_win) { WIN_LOOP(WIN_TILE_NM) } else { WIN_LOOP(WIN_TILE) }
#undef WIN_LOOP
#undef WIN_TILE_NM
#undef WIN_PRE
#undef WIN_TILE
                TROW_PIN();
#pragma unroll
                for (int rb = 0; rb < 2; ++rb) { const float l = __shfl(sw[rb].ol[0], fr); const float sc2 = (l > 0.f) ? GATE(rb, 2) / l : 0.f;
                    bf16_t* op = O + TOKROW(rb) * 1024 + head * 64 + 4 * g4;
#pragma unroll
                    for (int dt = 0; dt < 4; ++dt) { const u32x2 pv = *(const u32x2*)(op + 16 * dt); f32x4 v = sw[rb].o[dt] * sc2;
                        v[0] += __uint_as_float(pv.x << 16); v[1] += __uint_as_float(pv.x & 0xffff0000u); v[2] += __uint_as_float(pv.y << 16); v[3] += __uint_as_float(pv.y & 0xffff0000u);
                        u32x2 w; w.x = cvt_pk_bf16(v[0], v[1]); w.y = cvt_pk_bf16(v[2], v[3]); *(u32x2*)(op + 16 * dt) = w; } }
            }
#undef AT_DMA
#undef ATK
#undef ATV
#undef TROW_PIN
#undef TOKROW
#undef GATE
            cvt1_run(a, cvt_next, cvt_stride, 2, cvt_scr, lane);
        }
    }
    cvt1_run(a, cvt_next, cvt_stride, 1 << 20, cvt_scr, lane);
}

__device__ __forceinline__ void unpack8(const u32x4 w, float (&f)[8]) {
    f[0] = __uint_as_float(w.x << 16); f[1] = __uint_as_float(w.x & 0xffff0000u); f[2] = __uint_as_float(w.y << 16); f[3] = __uint_as_float(w.y & 0xffff0000u);
    f[4] = __uint_as_float(w.z << 16); f[5] = __uint_as_float(w.z & 0xffff0000u); f[6] = __uint_as_float(w.w << 16); f[7] = __uint_as_float(w.w & 0xffff0000u);
}
__device__ __forceinline__ void ph_convpool_fast(const Args& a, LAS unsigned char* lds) {
    const bf16_t* H0 = (const bf16_t*)(a.ws + WS_H0);
    bf16_t* CAT = (bf16_t*)(a.ws + WS_CAT);
    const float* cw = a.in[4]; const float* cb = a.in[5]; const float* lg = a.in[6]; const float* lb = a.in[7];
    const int tid = threadIdx.x, lane = tid & 63, wave = tid >> 6, ch = lane * 8;
    constexpr int VT_OFF = 0, UT_OFF = 62 * 1024, CW_OFF = UT_OFF + 47 * 1024;
    for (int i = tid; i < 31 * 64; i += 512) { const int k = i >> 6, c8 = (i & 63) * 8;
        const f32x4 w0 = *(const f32x4*)(cw + k * 512 + c8), w1 = *(const f32x4*)(cw + k * 512 + c8 + 4);
        u32x4 o; o.x = pk2(w0[0], w0[1]); o.y = pk2(w0[2], w0[3]); o.z = pk2(w1[0], w1[1]); o.w = pk2(w1[2], w1[3]);
        *(LAS u32x4*)(lds + CW_OFF + k * 1024 + c8 * 2) = o; }
    float bias[8], gam[8], bet[8];
#pragma unroll
    for (int j = 0; j < 8; ++j) { bias[j] = cb[ch + j]; gam[j] = lg[ch + j]; bet[j] = lb[ch + j]; }
    for (int tile = blockIdx.x; tile < M / 32; tile += gridDim.x) {
        const int tok0 = tile * 32, t0 = tok0 & (T - 1);
        __syncthreads();
        for (int i = tid; i < 62 * 64; i += 512) { const int r = i >> 6, c8 = (i & 63) * 8; const int tt = t0 - 30 + r;
            u32x4 v = (u32x4){0u, 0u, 0u, 0u}; if (tt >= 0) v = *(const u32x4*)(H0 + (size_t)(tok0 - 30 + r) * 1024 + 512 + c8);
            *(LAS u32x4*)(lds + VT_OFF + r * 1024 + c8 * 2) = v; }
        for (int i = tid; i < 47 * 64; i += 512) { const int r = i >> 6, c8 = (i & 63) * 8; const int tt = t0 - 15 + r;
            u32x4 v = (u32x4){0u, 0u, 0u, 0u}; if (tt >= 0) v = *(const u32x4*)(H0 + (size_t)(tok0 - 15 + r) * 1024 + c8);
            *(LAS u32x4*)(lds + UT_OFF + r * 1024 + c8 * 2) = v; }
        __syncthreads();
        float acc[4][8];
#pragma unroll
        for (int j = 0; j < 4; ++j)
#pragma unroll
            for (int c = 0; c < 8; ++c) acc[j][c] = bias[c];
#pragma unroll 1
        for (int k = 0; k < 31; ++k) {
            float w[8]; unpack8(*(const LAS u32x4*)(lds + CW_OFF + k * 1024 + ch * 2), w);
#pragma unroll
            for (int j = 0; j < 4; ++j) { float v[8]; unpack8(*(const LAS u32x4*)(lds + VT_OFF + (4 * wave + j + k) * 1024 + ch * 2), v);
#pragma unroll
                for (int c = 0; c < 8; ++c) acc[j][c] += w[c] * v[c]; }
        }
        const int wnd = 2 << (lane >> 4);
#pragma unroll
        for (int j = 0; j < 4; ++j) {
            const int tl = 4 * wave + j, t = t0 + tl; const size_t tok = (size_t)tok0 + tl;
            const int cnt = (t + 1 < wnd) ? (t + 1) : wnd;
            float s[8], self[8];
            unpack8(*(const LAS u32x4*)(lds + UT_OFF + (15 + tl) * 1024 + ch * 2), self);
#pragma unroll
            for (int c = 0; c < 8; ++c) s[c] = self[c];
            for (int k = 1; k < cnt; ++k) { float v[8]; unpack8(*(const LAS u32x4*)(lds + UT_OFF + (15 + tl - k) * 1024 + ch * 2), v);
#pragma unroll
                for (int c = 0; c < 8; ++c) s[c] += v[c]; }
            const float inv = 1.0f / (float)cnt;
            u32x4 o; o.x = pk2(s[0] * inv - self[0], s[1] * inv - self[1]); o.y = pk2(s[2] * inv - self[2], s[3] * inv - self[3]);
            o.z = pk2(s[4] * inv - self[4], s[5] * inv - self[5]); o.w = pk2(s[6] * inv - self[6], s[7] * inv - self[7]);
            *(u32x4*)(CAT + tok * 1024 + ch) = o;
            float sm = 0.f;
#pragma unroll
            for (int c = 0; c < 8; ++c) sm += acc[j][c];
            const float mean = wave_sum(sm) * (1.0f / 512.0f);
            float sq = 0.f;
#pragma unroll
            for (int c = 0; c < 8; ++c) { acc[j][c] -= mean; sq += acc[j][c] * acc[j][c]; }
            const float rstd = rsqrtf(wave_sum(sq) * (1.0f / 512.0f) + LN_EPS);
            float y[8];
#pragma unroll
            for (int c = 0; c < 8; ++c) { const float z = acc[j][c] * rstd * gam[c] + bet[c]; y[c] = z * sigmoidf_(z); }
            u32x4 o2; o2.x = pk2(y[0], y[1]); o2.y = pk2(y[2], y[3]); o2.z = pk2(y[4], y[5]); o2.w = pk2(y[6], y[7]);
            *(u32x4*)(CAT + tok * 1024 + 512 + ch) = o2;
        }
    }
}


__device__ __forceinline__ void ph_route_fast(const float* LOG, const float* bias, unsigned* gcnt, int2* list, unsigned char* ldsg) {
    unsigned* hist = (unsigned*)ldsg; unsigned* base = hist + 256; u32x2* sel = (u32x2*)(ldsg + 2048);
    const int tid = threadIdx.x, lane = tid & 63, wave = tid >> 6;
    const float NEG = -INFINITY;
    const float4 bb = *(const float4*)(bias + lane * 4);
    for (int chunk = blockIdx.x; chunk < M / 128; chunk += gridDim.x) {
        __syncthreads();
        if (tid < 256) hist[tid] = 0u;
        __syncthreads();
        for (int i = 0; i < 16; ++i) {
            const int tl = wave * 16 + i, tok = chunk * 128 + tl;
            const float4 lg = *(const float4*)(LOG + (size_t)tok * 256 + lane * 4);
            const float s0 = sigmoidf_(lg.x), s1 = sigmoidf_(lg.y), s2 = sigmoidf_(lg.z), s3 = sigmoidf_(lg.w);
            float v0 = s0 + bb.x, v1 = s1 + bb.y, v2 = s2 + bb.z, v3 = s3 + bb.w;
            float m1 = fmaxf(v0, v1), m2 = fminf(v0, v1);
            { const float hi = fmaxf(v2, v3), lo = fminf(v2, v3); const float n1 = fmaxf(m1, hi); const float n2 = fmaxf(fminf(m1, hi), fmaxf(m2, lo)); m1 = n1; m2 = n2; }
#pragma unroll
            for (int o = 1; o < 8; o <<= 1) { const float a1 = __shfl_xor(m1, o), a2 = __shfl_xor(m2, o); const float n1 = fmaxf(m1, a1), n2 = fmaxf(fminf(m1, a1), fmaxf(m2, a2)); m1 = n1; m2 = n2; }
            const float gs = m1 + m2; const int mygrp = lane >> 3;
            int rank = 0;
#pragma unroll
            for (int g2 = 0; g2 < 8; ++g2) { const float og = __shfl(gs, g2 * 8); rank += (og > gs || (og == gs && g2 < mygrp)) ? 1 : 0; }
            if (rank >= 4) { v0 = NEG; v1 = NEG; v2 = NEG; v3 = NEG; }
            int my_e = 0; float my_s = 0.f;
#pragma unroll
            for (int it = 0; it < 8; ++it) {
                float bv = v0; int bj = 0;
                if (v1 > bv) { bv = v1; bj = 1; }
                if (v2 > bv) { bv = v2; bj = 2; }
                if (v3 > bv) { bv = v3; bj = 3; }
                int bi = lane * 4 + bj;
#pragma unroll
                for (int o = 1; o < 64; o <<= 1) { const float ov = __shfl_xor(bv, o); const int oi = __shfl_xor(bi, o); if (ov > bv || (ov == bv && oi < bi)) { bv = ov; bi = oi; } }
                const int jj = bi & 3, ol = bi >> 2;
                const float mys = (jj == 0) ? s0 : (jj == 1) ? s1 : (jj == 2) ? s2 : s3;
                const float wsc = __shfl(mys, ol);
                if (lane == ol) { if (jj == 0) v0 = NEG; else if (jj == 1) v1 = NEG; else if (jj == 2) v2 = NEG; else v3 = NEG; }
                if (lane == it) { my_e = bi; my_s = wsc; }
            }
            const float ssum = wave_sum(lane < 8 ? my_s : 0.f);
            if (lane < 8) { const unsigned rk = atomicAdd(&hist[my_e], 1u); u32x2 en; en.x = (unsigned)my_e | (rk << 16); en.y = __float_as_uint(my_s / ssum * 2.5f); sel[tl * 8 + lane] = en; }
        }
        __syncthreads();
        if (tid < 256) { const unsigned h = hist[tid]; base[tid] = h ? atomicAdd(&gcnt[tid], h) : 0u; }
        __syncthreads();
#pragma unroll
        for (int rep = 0; rep < 2; ++rep) { const int idx = tid + rep * 512, tok = chunk * 128 + (idx >> 3), k = idx & 7;
            const u32x2 en = sel[idx]; const unsigned e = en.x & 0xffffu, pos = base[e] + (en.x >> 16);
            list[(size_t)e * LISTCAP + pos] = make_int2(tok * 10 + k, (int)en.y); }
    }
}

__global__ void __launch_bounds__(512, 2) fwd_kernel(Args a) {
    extern __shared__ __attribute__((aligned(16))) unsigned char lds[];
    volatile LAS unsigned* MISC = (volatile LAS unsigned*)((LAS unsigned char*)lds + (LDS_BYTES - 64));
    if (threadIdx.x < 16) MISC[threadIdx.x] = 0u;
    __syncthreads();
    unsigned* ctl = (unsigned*)(a.ws + WS_CTL);
#if MK_ONE_LAUNCH
    (void)xcd_barrier_post(ctl + CW_BAR, MISC + 8);
#define SEAM() do { XcdBarrier b_; b_.bar = (unsigned*)(a.ws + WS_CTL) + CW_BAR; b_.x = xb_xcc_id(); b_.st = MISC + 8; xcd_barrier(b_); } while (0)
#else
#define SEAM() do {} while (0)
#endif
    const int lo = a.ph_lo, hi = a.ph_hi;
#define IN(k) (lo <= (k) && (k) < hi)
#define BOTH(k) (IN(k) && (k) + 1 < hi)
#define X1 ((bf16_t*)(a.ws + WS_X1))
#define X2 ((bf16_t*)(a.ws + WS_X2))
#define LOG ((float*)(a.ws + WS_LOG))

    LAS unsigned char* L = (LAS unsigned char*)lds;
#define LIST ((int2*)(a.ws + WS_LIST))
#ifndef PROBE_DUP_MASK
#define PROBE_DUP_MASK 0u
#endif
#define RUN(k, ...) if (IN(k)) { { __VA_ARGS__ } if ((PROBE_DUP_MASK >> (k)) & 1u) { __syncthreads(); { __VA_ARGS__ } } if (BOTH(k)) SEAM(); }
    RUN(0, ph_prologue(a, L);)
    RUN(1, pg8::DenseSched S; S.init((const bf16_t*)(a.ws + WS_XA), D, (const bf16_t*)(a.ws + WS_WIN0), D, M, 1536);
           EpiInproj0 E{(bf16_t*)(a.ws + WS_H0)};
           pg8::gemm_phase<EpiInproj0, pg8::DenseSched, true>(L, D, 128u, S, E);)
    RUN(2, ph_convpool_fast(a, L);)
    RUN(4, pg8::DenseSched S; S.init((const bf16_t*)(a.ws + WS_CAT), D, (const bf16_t*)(a.ws + WS_WOUT0), D, M, D);
           EpiRes E{a.in[0], nullptr, (bf16_t*)(a.ws + WS_Y)};
           pg8::gemm_phase<EpiRes, pg8::DenseSched, true>(L, D, 128u, S, E);)
    RUN(5, ph_ln((const bf16_t*)(a.ws + WS_Y), a.in[17], a.in[18], X1, (unsigned char*)(a.ws + WS_X8));)
#define MOE_LAYER(P, LAYER, XIN, XOUT, OUTF) \
    RUN(P, pg8::DenseSched S; S.init(XIN, D, (const bf16_t*)(a.ws + WS_WR) + (size_t)(LAYER) * NE * D, D, M, NE); \
           EpiLogits E{LOG}; pg8::gemm_phase<EpiLogits, pg8::DenseSched, true>(L, D, 128u, S, E);) \
    if (IN(P + 1)) { ph_route_fast(LOG, a.in[22] + (LAYER) * NE, ctl + CW_CNT + (LAYER) * 256, LIST, lds); if (BOTH(P + 1)) SEAM(); } \
    RUN(P + 2, const int R = moe_setup256(ctl + CW_CNT + (LAYER) * 256, L); \
            MoeGuSched S{(const char*)(a.ws + WS_X8), (const char*)(a.ws + WS_WGU) + (size_t)(LAYER) * 257 * 512 * 1024, LIST, L, R, (R + 128) * 2, (int)gridDim.x, (int)blockIdx.x}; \
            S.prepare(); EpiGateUp E{(unsigned char*)(a.ws + WS_HID)}; pg8::gemm_phase<EpiGateUp, MoeGuSched, true, true>(L, D / 2, 128u, S, E);) \
    RUN(P + 3, const int R = moe_setup256(ctl + CW_CNT + (LAYER) * 256, L); \
            MoeDownSched S{(const char*)(a.ws + WS_HID), (const char*)(a.ws + WS_WD) + (size_t)(LAYER) * 257 * 1024 * 256, LIST, L, R, R + 128, (int)gridDim.x, (int)blockIdx.x}; \
            S.prepare(); EpiDown E{(unsigned char*)(a.ws + WS_YB), L}; pg8::gemm_phase<EpiDown, MoeDownSched, true, true>(L, FF / 2, 128u, S, E);) \
    RUN(P + 4, ph_combine(a, XIN, a.in[19] + (LAYER) * D, a.in[20] + (LAYER) * D, XOUT, OUTF);)
    MOE_LAYER(6, 0, X1, X2, nullptr)
    RUN(11, pg8::DenseSched S; S.init(X2, D, (const bf16_t*)(a.ws + WS_WINN), D, M, HNW);
            EpiInprojN E{(bf16_t*)(a.ws + WS_HN), (bf16_t*)(a.ws + WS_QR), (bf16_t*)(a.ws + WS_KV6), (float*)(a.ws + WS_GATES), (const float*)(a.ws + WS_MISC) + 1024};
            pg8::gemm_phase<EpiInprojN, pg8::DenseSched, true>(L, D, 128u, S, E);)
    RUN(13, Cmp1Sched S{(const char*)(a.ws + WS_KV6), (const char*)(a.ws + WS_CW1), (int)gridDim.x, (int)blockIdx.x};
            EpiCmp1 E{(bf16_t*)(a.ws + WS_CH1), (const float*)(a.ws + WS_MISC)};
            pg8::gemm_phase<EpiCmp1, Cmp1Sched, true>(L, 2048, 128u, S, E); ph_knorm(a);)
    RUN(14, ph_cmp2(a, lds);)
    RUN(15, ph_attn_fast2(a, L);)
    RUN(16, pg8::DenseSched S; S.init((const bf16_t*)(a.ws + WS_O), D, (const bf16_t*)(a.ws + WS_WOUTN), D, M, D);
            EpiRes E{nullptr, X2, (bf16_t*)(a.ws + WS_Y2)};
            pg8::gemm_phase<EpiRes, pg8::DenseSched, true>(L, D, 128u, S, E);)
    RUN(17, ph_ln((const bf16_t*)(a.ws + WS_Y2), a.in[17] + D, a.in[18] + D, X1, (unsigned char*)(a.ws + WS_X8));)
    MOE_LAYER(18, 1, X1, (bf16_t*)nullptr, a.out)
}

extern "C" void kernel_launch(void* const* d_in, const int* in_sizes, int n_in, void* d_out, int out_size, void* d_ws, size_t ws_size, hipStream_t stream) {
    static int grid = 0;
    if (grid == 0) {
        if (n_in != 29 || out_size != M * D || ws_size < WS_END) { fprintf(stderr, "kernel_launch: unexpected problem (n_in %d out %d ws %zu)\n", n_in, out_size, ws_size); grid = -1; return; }
        int dev = 0, cus = 0;
        if (hipGetDevice(&dev) != hipSuccess || hipDeviceGetAttribute(&cus, hipDeviceAttributeMultiprocessorCount, dev) != hipSuccess) { grid = -1; return; }
        if (hipFuncSetAttribute((const void*)fwd_kernel, hipFuncAttributeMaxDynamicSharedMemorySize, LDS_BYTES) != hipSuccess) { grid = -1; return; }
        int per_cu = 0;
        (void)hipOccupancyMaxActiveBlocksPerMultiprocessor(&per_cu, (const void*)fwd_kernel, 512, LDS_BYTES);
        (void)hipGetLastError();
        grid = cus;
    }
    if (grid < 0) return;
    (void)hipMemsetAsync((char*)d_ws + WS_CTL, 0, CTL_BYTES, stream);
    Args a{};
    for (int i = 0; i < 29; ++i) a.in[i] = (const float*)d_in[i];
    a.out = (float*)d_out; a.ws = (unsigned char*)d_ws;
    for (int i = 0; i < 8; ++i) a.inv_freq[i] = powf(500000.0f, -(float)(2 * i) / 16.0f);
#if MK_ONE_LAUNCH
    a.ph_lo = 0; a.ph_hi = NPHASE;
    hipLaunchKernelGGL(fwd_kernel, dim3(grid), dim3(512), LDS_BYTES, stream, a);
#else
    for (int p = 0; p < NPHASE; ++p) { a.ph_lo = p; a.ph_hi = p + 1; hipLaunchKernelGGL(fwd_kernel, dim3(grid), dim3(512), LDS_BYTES, stream, a); }
#endif
}
```

```cpp
#include <hip/hip_runtime.h>
#include <cstdint>
#include <cstdio>
#include <cmath>

#ifndef MK_ONE_LAUNCH
#define MK_ONE_LAUNCH 1
#endif

#define LAS __attribute__((address_space(3)))
typedef unsigned short bf16_t;
typedef short bf16x8 __attribute__((ext_vector_type(8)));
typedef float f32x4 __attribute__((ext_vector_type(4)));
typedef unsigned u32x2 __attribute__((ext_vector_type(2)));
typedef unsigned u32x4 __attribute__((ext_vector_type(4)));

constexpr int NB = 4, T = 8192, D = 1024, M = NB * T;
constexpr int NE = 256, TOPK = 8, FF = 256;
constexpr int HNW = 2816;
constexpr int LISTCAP = 32768;
constexpr float ALPHA = 1.4142135623730951f;
constexpr float LN_EPS = 1e-5f;
constexpr float QSCALE = 0.125f * 1.4426950408889634f;
constexpr int YB_NSLOT = 9;
constexpr float YB_SCALE = 16.0f;
constexpr int NPHASE = 23;

constexpr size_t MiB = 1u << 20;
constexpr size_t WS_CTL = 0, CTL_BYTES = 1 * MiB;
constexpr size_t WS_X1 = 1 * MiB;
constexpr size_t WS_X2 = WS_X1 + 64 * MiB;
constexpr size_t WS_LOG = WS_X2 + 64 * MiB;
constexpr size_t WS_LIST = WS_LOG + 32 * MiB;
constexpr size_t WS_WTS = WS_LIST + 64 * MiB;
constexpr size_t WS_HID = WS_WTS + 2 * MiB;
constexpr size_t WS_YB = WS_HID + 184 * MiB;
constexpr size_t WS_END_NAIVE = WS_YB + 576 * MiB;
constexpr size_t WS_WIN0 = WS_END_NAIVE;
constexpr size_t WS_WOUT0 = WS_WIN0 + 3 * MiB;
constexpr size_t WS_WINN = WS_WOUT0 + 2 * MiB;
constexpr size_t WS_WOUTN = WS_WINN + 6 * MiB;
constexpr size_t WS_WR = WS_WOUTN + 2 * MiB;
constexpr size_t WS_CW1 = WS_WR + 1 * MiB;
constexpr size_t WS_MISC = WS_CW1 + 2 * MiB;
constexpr size_t WS_WGU = WS_MISC + 1 * MiB;
constexpr size_t WS_X8 = WS_WGU + 257 * MiB;
constexpr float X8_SCALE = 8.0f, W8_SCALE = 64.0f, H8_SCALE = 16.0f;
constexpr size_t WS_WD = WS_WGU + 514 * MiB;
constexpr size_t WS_END = WS_WD + 257 * MiB;
constexpr size_t WS_XA = WS_X2;
constexpr size_t WS_H0 = WS_YB;
constexpr size_t WS_PM = WS_H0 + 64 * MiB;
constexpr size_t WS_CAT = WS_PM + 32 * MiB;
constexpr size_t WS_Y = WS_CAT + 64 * MiB;
constexpr size_t WS_HN = WS_YB;
constexpr size_t WS_KV6 = WS_HN + 64 * MiB;
constexpr size_t WS_QR = WS_HN + 176 * MiB;
constexpr size_t WS_GATES = WS_QR + 64 * MiB;
constexpr size_t WS_CH1 = WS_GATES + 8 * MiB;
constexpr size_t WS_KC = WS_CH1 + 4 * MiB;
constexpr size_t WS_O = WS_KC + 2 * MiB;
constexpr size_t WS_Y2 = WS_O + 64 * MiB;
static_assert(WS_Y2 + 64 * MiB <= WS_END_NAIVE, "overlay");
static_assert(WS_Y + 64 * MiB <= WS_END_NAIVE, "overlay");

constexpr int CW_CNT = 64;
constexpr int CW_BAR = 4096;

constexpr int LDS_BYTES = 163840;

__device__ __forceinline__ float bf2f(bf16_t h) { return __uint_as_float(((unsigned)h) << 16); }
__device__ __forceinline__ bf16_t f2bf(float f) { unsigned u = __float_as_uint(f); return (bf16_t)((u + 0x7fffu + ((u >> 16) & 1u)) >> 16); }
__device__ __forceinline__ unsigned pk2(float lo, float hi) { return (unsigned)f2bf(lo) | ((unsigned)f2bf(hi) << 16); }
__device__ __forceinline__ float wave_sum(float v) {
#pragma unroll
    for (int o = 1; o < 64; o <<= 1) v += __shfl_xor(v, o);
    return v;
}
__device__ __forceinline__ float wave_max(float v) {
#pragma unroll
    for (int o = 1; o < 64; o <<= 1) v = fmaxf(v, __shfl_xor(v, o));
    return v;
}
__device__ __forceinline__ float sigmoidf_(float x) { return 1.0f / (1.0f + __expf(-x)); }
__device__ __forceinline__ float gelu_tanh(float x) {
    const float u = 0.7978845608028654f * (x + 0.044715f * x * x * x);
    const float e = __expf(2.0f * u);
    const float th = 1.0f - 2.0f / (e + 1.0f);
    return 0.5f * x * (1.0f + th);
}
__device__ __forceinline__ bf16x8 cvt8(const float* p) {
    const float4 a = *(const float4*)p, b = *(const float4*)(p + 4);
    bf16x8 r;
    r[0] = (short)f2bf(a.x); r[1] = (short)f2bf(a.y); r[2] = (short)f2bf(a.z); r[3] = (short)f2bf(a.w);
    r[4] = (short)f2bf(b.x); r[5] = (short)f2bf(b.y); r[6] = (short)f2bf(b.z); r[7] = (short)f2bf(b.w);
    return r;
}
__device__ __forceinline__ bf16x8 colk8(const float* W, int N, int k, int col) {
    bf16x8 r;
#pragma unroll
    for (int j = 0; j < 8; ++j) r[j] = (short)f2bf(W[(size_t)(k + j) * N + col]);
    return r;
}
__device__ __forceinline__ bf16x8 zero8() { return (bf16x8){0, 0, 0, 0, 0, 0, 0, 0}; }
#define WSYNC() asm volatile("s_waitcnt lgkmcnt(0)" ::: "memory")

#define XB_TMO      128
#define XB_XCNT(j)  (256  + 64 * (j))
#define XB_XSUB(j)  (1280 + 64 * (j))
#define XB_XGEN(j)  (2304 + 64 * (j))
#define XB_TOP      3328
#define XB_TOPGEN   3392
#define XCD_BAR_WORDS 3456
#define XB_SPIN_CAP (1u << 22)
__device__ __forceinline__ unsigned xb_ld(unsigned* p)              { return __hip_atomic_load(p, __ATOMIC_RELAXED, __HIP_MEMORY_SCOPE_AGENT); }
__device__ __forceinline__ unsigned xb_add(unsigned* p, unsigned v) { return __hip_atomic_fetch_add(p, v, __ATOMIC_RELAXED, __HIP_MEMORY_SCOPE_AGENT); }
__device__ __forceinline__ unsigned xb_xcc_id() { return (unsigned)__builtin_amdgcn_s_getreg((3 << 11) | 20) & 0xFu; }
#define XB_SPIN(cond, bar) do { unsigned _sp = 0; while (cond) { __builtin_amdgcn_s_sleep(1); \
    if ((++_sp & 255u) == 0u) { if (xb_ld(&(bar)[XB_TMO])) break; if (_sp > XB_SPIN_CAP) { atomicAdd(&(bar)[XB_TMO], 1u); break; } } } } while (0)
struct XcdBarrier { unsigned* bar; unsigned x; volatile LAS unsigned* st; };
__device__ __forceinline__ XcdBarrier xcd_barrier_post(unsigned* bar, volatile LAS unsigned* st) {
    XcdBarrier b; b.bar = bar; b.x = xb_xcc_id(); b.st = st;
    if (threadIdx.x == 0) (void)xb_add(&bar[XB_XCNT(b.x)], 1u);
    return b;
}
__device__ __forceinline__ void xcd_barrier_complete(unsigned* bar, unsigned x, unsigned& nloc, unsigned& nx) {
    const unsigned G = gridDim.x * gridDim.y * gridDim.z;
    unsigned sum, cnt, mine, sp = 0u;
    for (;;) {
        sum = 0u; cnt = 0u; mine = 0u;
#pragma unroll
        for (unsigned j = 0; j < 16; ++j) { const unsigned c = xb_ld(&bar[XB_XCNT(j)]); sum += c; cnt += (c > 0u) ? 1u : 0u; mine = (j == x) ? c : mine; }
        if (sum == G) break;
        __builtin_amdgcn_s_sleep(1);
        if ((++sp & 255u) == 0u) { if (xb_ld(&bar[XB_TMO])) break; if (sp > XB_SPIN_CAP) { atomicAdd(&bar[XB_TMO], 1u); break; } }
    }
    nloc = mine > 0u ? mine : 1u; nx = cnt > 0u ? cnt : 1u;
}
__device__ __forceinline__ void xcd_barrier(const XcdBarrier& b) {
    asm volatile("s_waitcnt vmcnt(0)" ::: "memory");
    __syncthreads();
    if (threadIdx.x == 0) {
        unsigned* bar = b.bar;
        __builtin_amdgcn_s_waitcnt(0);
        unsigned nloc = b.st[0], nx = b.st[1];
        if (nloc == 0u) { xcd_barrier_complete(bar, b.x, nloc, nx); b.st[0] = nloc; b.st[1] = nx; }
        const unsigned old = xb_add(&bar[XB_XSUB(b.x)], 1u);
        const unsigned gen = old / nloc;
        if (old + 1u == (gen + 1u) * nloc) {
            __builtin_amdgcn_fence(__ATOMIC_RELEASE, "agent");
            asm volatile("s_waitcnt vmcnt(0)" ::: "memory");
            const unsigned og = xb_add(&bar[XB_TOP], 1u);
            const unsigned tg = og / nx;
            if (og + 1u == (tg + 1u) * nx) xb_add(&bar[XB_TOPGEN], 1u);
            else XB_SPIN(xb_ld(&bar[XB_TOPGEN]) == tg, bar);
            __builtin_amdgcn_fence(__ATOMIC_ACQUIRE, "agent");
            xb_add(&bar[XB_XGEN(b.x)], 1u);
            asm volatile("s_waitcnt vmcnt(0)" ::: "memory");
        } else {
            XB_SPIN(xb_ld(&bar[XB_XGEN(b.x)]) == gen, bar);
            __builtin_amdgcn_fence(__ATOMIC_ACQUIRE, "agent");
            asm volatile("s_waitcnt vmcnt(0)" ::: "memory");
        }
    }
    __syncthreads();
}

template <class AL, class BL, class EP>
__device__ __forceinline__ void mgemm_tile(unsigned char* lds, int K, const AL& al, const BL& bl, const EP& ep) {
    bf16_t* As = (bf16_t*)lds;
    bf16_t* Bs = As + 128 * 40;
    const int tid = threadIdx.x, lane = tid & 63, wave = tid >> 6;
    const int ar = tid >> 2, ac = (tid & 3) * 8;
    const int bn = tid & 127, bc = (tid >> 7) * 8;
    f32x4 acc[8];
#pragma unroll
    for (int s = 0; s < 8; ++s) acc[s] = (f32x4){0.f, 0.f, 0.f, 0.f};
    bf16x8 ra = al(ac), rb = bl(bc);
    for (int k0 = 0; k0 < K; k0 += 32) {
        __syncthreads();
        *(bf16x8*)(As + ar * 40 + ac) = ra;
        *(bf16x8*)(Bs + bn * 40 + bc) = rb;
        __syncthreads();
        if (k0 + 32 < K) { ra = al(k0 + 32 + ac); rb = bl(k0 + 32 + bc); }
        const bf16x8 af = *(const bf16x8*)(As + (wave * 16 + (lane & 15)) * 40 + (lane >> 4) * 8);
#pragma unroll
        for (int s = 0; s < 8; ++s) {
            const bf16x8 wf = *(const bf16x8*)(Bs + (16 * s + (lane & 15)) * 40 + (lane >> 4) * 8);
            acc[s] = __builtin_amdgcn_mfma_f32_16x16x32_bf16(wf, af, acc[s], 0, 0, 0);
        }
    }
    ep(wave * 16 + (lane & 15), (lane >> 4) * 4, acc);
}
__device__ __forceinline__ void store4bf(bf16_t* p, const f32x4 v) { u32x2 w; w.x = pk2(v[0], v[1]); w.y = pk2(v[2], v[3]); *(u32x2*)p = w; }

struct Args {
    const float* in[29];
    float* out;
    unsigned char* ws;
    float inv_freq[8];
    int ph_lo, ph_hi;
};

__device__ __forceinline__ unsigned pk4_fp8(float a, float b, float c, float d) { int w = __builtin_amdgcn_cvt_pk_fp8_f32(a, b, 0, false); return (unsigned)__builtin_amdgcn_cvt_pk_fp8_f32(c, d, w, true); }
__device__ __forceinline__ u32x2 pack8_fp8(const f32x4 v0, const f32x4 v1) {
    int a = __builtin_amdgcn_cvt_pk_fp8_f32(v0[0], v0[1], 0, false); a = __builtin_amdgcn_cvt_pk_fp8_f32(v0[2], v0[3], a, true);
    int b = __builtin_amdgcn_cvt_pk_fp8_f32(v1[0], v1[1], 0, false); b = __builtin_amdgcn_cvt_pk_fp8_f32(v1[2], v1[3], b, true);
    u32x2 w; w.x = (unsigned)a; w.y = (unsigned)b; return w;
}
__device__ __forceinline__ float clamp8(float v) { return __builtin_amdgcn_fmed3f(v, -448.0f, 448.0f); }
__device__ __forceinline__ void ph_ln(const bf16_t* Y, const float* g, const float* b, bf16_t* X, unsigned char* X8) {
    const int lane = threadIdx.x & 63, wave = threadIdx.x >> 6;
    const int gw = blockIdx.x * 8 + wave, ngw = gridDim.x * 8;
    float gg[16], bb[16];
#pragma unroll
    for (int j = 0; j < 8; ++j) { gg[j] = g[lane * 8 + j]; gg[8 + j] = g[512 + lane * 8 + j]; bb[j] = b[lane * 8 + j]; bb[8 + j] = b[512 + lane * 8 + j]; }
    for (int row0 = gw * 4; row0 < M; row0 += ngw * 4) {
        bf16x8 p0[4], p1[4];
#pragma unroll
        for (int r = 0; r < 4; ++r) { p0[r] = __builtin_nontemporal_load((const bf16x8*)(Y + (size_t)(row0 + r) * 1024 + lane * 8)); p1[r] = __builtin_nontemporal_load((const bf16x8*)(Y + (size_t)(row0 + r) * 1024 + 512 + lane * 8)); }
#pragma unroll
        for (int r = 0; r < 4; ++r) {
            float v[16];
#pragma unroll
            for (int j = 0; j < 8; ++j) { v[j] = bf2f((bf16_t)p0[r][j]); v[8 + j] = bf2f((bf16_t)p1[r][j]); }
            float s = 0.f;
#pragma unroll
            for (int j = 0; j < 16; ++j) s += v[j];
            const float mean = wave_sum(s) * (1.0f / 1024.0f);
            float q = 0.f;
#pragma unroll
            for (int j = 0; j < 16; ++j) { v[j] -= mean; q += v[j] * v[j]; }
            const float rstd = rsqrtf(wave_sum(q) * (1.0f / 1024.0f) + LN_EPS);
            float o[16];
#pragma unroll
            for (int j = 0; j < 16; ++j) o[j] = v[j] * rstd * gg[j] + bb[j];
            u32x4 w0, w1;
            w0.x = pk2(o[0], o[1]); w0.y = pk2(o[2], o[3]); w0.z = pk2(o[4], o[5]); w0.w = pk2(o[6], o[7]);
            w1.x = pk2(o[8], o[9]); w1.y = pk2(o[10], o[11]); w1.z = pk2(o[12], o[13]); w1.w = pk2(o[14], o[15]);
            *(u32x4*)(X + (size_t)(row0 + r) * 1024 + lane * 8) = w0; *(u32x4*)(X + (size_t)(row0 + r) * 1024 + 512 + lane * 8) = w1;
#pragma unroll
            for (int j = 0; j < 16; ++j) o[j] = clamp8(o[j] * X8_SCALE);
            u32x2 q0, q1; q0.x = pk4_fp8(o[0], o[1], o[2], o[3]); q0.y = pk4_fp8(o[4], o[5], o[6], o[7]); q1.x = pk4_fp8(o[8], o[9], o[10], o[11]); q1.y = pk4_fp8(o[12], o[13], o[14], o[15]);
            *(u32x2*)(X8 + (size_t)(row0 + r) * 1024 + lane * 8) = q0; *(u32x2*)(X8 + (size_t)(row0 + r) * 1024 + 512 + lane * 8) = q1;
        }
    }
}

__device__ __forceinline__ void ph_combine(const Args& a, const bf16_t* X, const float* g, const float* b, bf16_t* Xo, float* outf) {
    const unsigned char* YB = (const unsigned char*)(a.ws + WS_YB);
    const int lane = threadIdx.x & 63, wave = threadIdx.x >> 6;
    const int gw = blockIdx.x * 8 + wave, ngw = gridDim.x * 8;
    for (int row = gw; row < M; row += ngw) {
        float v[16];
#pragma unroll
        for (int j = 0; j < 16; ++j) v[j] = 0.f;
        u32x2 q0[YB_NSLOT], q1[YB_NSLOT];
#pragma unroll
        for (int k = 0; k < YB_NSLOT; ++k) { const unsigned char* yr = YB + ((size_t)row * 10 + k) * 1024; q0[k] = __builtin_nontemporal_load((const u32x2*)(yr + lane * 8)); q1[k] = __builtin_nontemporal_load((const u32x2*)(yr + 512 + lane * 8)); }
#pragma unroll
        for (int k = 0; k < YB_NSLOT; ++k) {
            const auto a0 = __builtin_amdgcn_cvt_pk_f32_fp8((int)q0[k].x, false), a1 = __builtin_amdgcn_cvt_pk_f32_fp8((int)q0[k].x, true), a2 = __builtin_amdgcn_cvt_pk_f32_fp8((int)q0[k].y, false), a3 = __builtin_amdgcn_cvt_pk_f32_fp8((int)q0[k].y, true);
            const auto b0 = __builtin_amdgcn_cvt_pk_f32_fp8((int)q1[k].x, false), b1 = __builtin_amdgcn_cvt_pk_f32_fp8((int)q1[k].x, true), b2 = __builtin_amdgcn_cvt_pk_f32_fp8((int)q1[k].y, false), b3 = __builtin_amdgcn_cvt_pk_f32_fp8((int)q1[k].y, true);
            v[0] += a0[0]; v[1] += a0[1]; v[2] += a1[0]; v[3] += a1[1]; v[4] += a2[0]; v[5] += a2[1]; v[6] += a3[0]; v[7] += a3[1];
            v[8] += b0[0]; v[9] += b0[1]; v[10] += b1[0]; v[11] += b1[1]; v[12] += b2[0]; v[13] += b2[1]; v[14] += b3[0]; v[15] += b3[1];
        }
        {
            const bf16x8 p0 = *(const bf16x8*)(X + (size_t)row * 1024 + lane * 8), p1 = *(const bf16x8*)(X + (size_t)row * 1024 + 512 + lane * 8);
#pragma unroll
            for (int j = 0; j < 8; ++j) { v[j] = v[j] * (1.0f / YB_SCALE) + ALPHA * bf2f((bf16_t)p0[j]); v[8 + j] = v[8 + j] * (1.0f / YB_SCALE) + ALPHA * bf2f((bf16_t)p1[j]); }
        }
        float s = 0.f;
#pragma unroll
        for (int j = 0; j < 16; ++j) s += v[j];
        const float mean = wave_sum(s) * (1.0f / 1024.0f);
        float q = 0.f;
#pragma unroll
        for (int j = 0; j < 16; ++j) { v[j] -= mean; q += v[j] * v[j]; }
        const float rstd = rsqrtf(wave_sum(q) * (1.0f / 1024.0f) + LN_EPS);
        float o[16];
#pragma unroll
        for (int j = 0; j < 8; ++j) { o[j] = v[j] * rstd * g[lane * 8 + j] + b[lane * 8 + j]; o[8 + j] = v[8 + j] * rstd * g[512 + lane * 8 + j] + b[512 + lane * 8 + j]; }
        if (outf) {
            float* op = outf + (size_t)row * 1024;
            *(float4*)(op + lane * 8) = make_float4(o[0], o[1], o[2], o[3]); *(float4*)(op + lane * 8 + 4) = make_float4(o[4], o[5], o[6], o[7]);
            *(float4*)(op + 512 + lane * 8) = make_float4(o[8], o[9], o[10], o[11]); *(float4*)(op + 512 + lane * 8 + 4) = make_float4(o[12], o[13], o[14], o[15]);
        } else {
            u32x4 w0, w1;
            w0.x = pk2(o[0], o[1]); w0.y = pk2(o[2], o[3]); w0.z = pk2(o[4], o[5]); w0.w = pk2(o[6], o[7]);
            w1.x = pk2(o[8], o[9]); w1.y = pk2(o[10], o[11]); w1.z = pk2(o[12], o[13]); w1.w = pk2(o[14], o[15]);
            *(u32x4*)(Xo + (size_t)row * 1024 + lane * 8) = w0; *(u32x4*)(Xo + (size_t)row * 1024 + 512 + lane * 8) = w1;
        }
    }
}

__device__ __forceinline__ void ph_cmp2(const Args& a, unsigned char* lds) {
    const bf16_t* CH1 = (const bf16_t*)(a.ws + WS_CH1);
    bf16_t* KC = (bf16_t*)(a.ws + WS_KC);
    const int tid = threadIdx.x;
    for (int u = blockIdx.x; u < 64 * 2; u += gridDim.x) {
        const int rt = u >> 1, kv = u & 1;
        const bf16_t* ar = CH1 + ((size_t)kv * 8192 + rt * 128 + (tid >> 2)) * 128;
        const float* w2 = a.in[kv ? 15 : 12];
        const int col = tid & 127;
        auto al = [&](int k) { return *(const bf16x8*)(ar + k); };
        auto bl = [&](int k) { return (col < 64) ? colk8(w2, 64, k, col) : zero8(); };
        auto ep = [&](int r, int cb, const f32x4 (&acc)[8]) {
            bf16_t* o = KC + ((size_t)kv * 8192 + rt * 128 + r) * 64;
#pragma unroll
            for (int s = 0; s < 4; ++s) store4bf(o + 16 * s + cb, acc[s]);
        };
        mgemm_tile(lds, 128, al, bl, ep);
    }
}

namespace pg8 {
constexpr int BM = 256, BK = 64, HALF = 128, HTB = HALF * BK * 2, STAGE_BYTES = 8 * HTB;
__device__ __forceinline__ int lds_byte(int r, int c) { const int st = (r >> 4) * 2 + (c >> 5), rr = r & 15, cc = c & 31, ob = rr * 64 + cc * 2; return st * 1024 + (ob ^ (((ob >> 9) & 1) << 5)); }
__device__ __forceinline__ void stage_rc(int b, int& R, int& C) { const int st = b / 1024, sb = b % 1024, swz = sb ^ (((sb >> 9) & 1) << 5); R = (st >> 1) * 16 + swz / 64; C = (st & 1) * 32 + (swz % 64) / 2; }
__device__ __forceinline__ int perm32(int rho) { const int n = rho >> 4, i = rho & 15; return 8 * (i >> 2) + 4 * n + (i & 3); }
struct Unit { int pm, pn, ord; };
typedef float f32x16 __attribute__((ext_vector_type(16)));
typedef int i32x8 __attribute__((ext_vector_type(8))); typedef int i32x4_ __attribute__((ext_vector_type(4)));
__device__ __forceinline__ i32x8 f8cat(const bf16x8 lo, const bf16x8 hi) { return __builtin_shufflevector(__builtin_bit_cast(i32x4_, lo), __builtin_bit_cast(i32x4_, hi), 0, 1, 2, 3, 4, 5, 6, 7); }
template <class Epi, class Sched, bool ALIGN_EPI, bool F8 = false>
__device__ __forceinline__ void gemm_phase(LAS unsigned char* lds, const int K, const unsigned kstepA, const Sched& S, const Epi& E) {
    const int tid = threadIdx.x, wid = __builtin_amdgcn_readfirstlane(tid >> 6), lane = tid & 63, wr = wid >> 2, wc = wid & 3, fr = lane & 15, fq = lane >> 4;
    const int nt = K / BK;
    constexpr bool GA = Sched::GATHER;
    int RA[2]; unsigned CA2[2], voffB[2], voffB1[2], voffA[2];
    constexpr bool P16 = Epi::PERM16;
#pragma unroll
    for (int i = 0; i < 2; ++i) { int R, C; stage_rc(tid * 16 + i * 8192, R, C); const int Rb = Epi::PERM ? ((R & ~31) + perm32(R & 31)) : R;
        RA[i] = R; CA2[i] = (unsigned)C * 2u; voffB[i] = (unsigned)(Rb * K + C) * 2u; voffA[i] = GA ? 0u : (S.lane_off(R) + (unsigned)C * 2u);
        if (P16) { const int c16 = 64 * (R >> 5) + 16 * ((R >> 2) & 3) + 4 * ((R >> 4) & 1) + (R & 3); voffB[i] = (unsigned)(c16 * K + C) * 2u; voffB1[i] = (unsigned)((c16 + 8) * K + C) * 2u; } else voffB1[i] = 0u; }
    const size_t kstepB = (size_t)(BK * 2);
    const size_t hstepB = (size_t)HALF * K * 2;
    const unsigned ldsw = (unsigned)wid * 1024u;
    const int aoff = lds_byte(wr * 64 + fr, fq * 8), boff = lds_byte(wc * 32 + fr, fq * 8);
    const char* const Ab = S.abase();
    unsigned aoC[2][2], aoN[2][2];
    unsigned uC[2], uN[2];
#define PG8_SA(b, h) (((b) * 2 + (h)) * HTB)
#define PG8_SB(b, h) ((4 + (b) * 2 + (h)) * HTB)
#define PG8_GLDS(sbase, voff, ldsoff) do { const char* _b = (const char*)(sbase); unsigned _v = (voff); asm volatile("" : "+s"(_b), "+v"(_v)); \
        __builtin_amdgcn_global_load_lds((const unsigned*)(_b + _v), (LAS unsigned*)(lds + (ldsoff)), 16, 0, 0); } while (0)
#define PG8_STAGE_B(bufoff, gbase) do { _Pragma("unroll") for (int _i = 0; _i < 2; ++_i) PG8_GLDS(gbase, voffB[_i], (bufoff) + ldsw + _i * 8192); } while (0)
#define PG8_STAGE_B1(bufoff, gbase) do { _Pragma("unroll") for (int _i = 0; _i < 2; ++_i) PG8_GLDS((const char*)(gbase) + (P16 ? (size_t)0 : hstepB), (P16 ? voffB1[_i] : voffB[_i]), (bufoff) + ldsw + _i * 8192); } while (0)
#define PG8_STAGE_A(bufoff, kb, UO, LO) do { _Pragma("unroll") for (int _i = 0; _i < 2; ++_i) PG8_GLDS(Ab + (size_t)((kb) + (UO)), (GA ? (LO)[_i] : voffA[_i]), (bufoff) + ldsw + _i * 8192); } while (0)
#define PG8_LDA(dst, b, h) do { _Pragma("unroll") for (int m = 0; m < 4; ++m) _Pragma("unroll") for (int k = 0; k < 2; ++k) dst[m][k] = *(const LAS bf16x8*)(lds + PG8_SA(b, h) + aoff + m * 2048 + k * 1024); } while (0)
#define PG8_LDB(dst, b, h) do { _Pragma("unroll") for (int n = 0; n < 2; ++n) _Pragma("unroll") for (int k = 0; k < 2; ++k) dst[n][k] = *(const LAS bf16x8*)(lds + PG8_SB(b, h) + boff + n * 2048 + k * 1024); } while (0)
#define PG8_MMA(ai, bj, At, Bt) do { __builtin_amdgcn_s_setprio(1); _Pragma("unroll") for (int m = 0; m < 4; ++m) _Pragma("unroll") for (int n = 0; n < 2; ++n) { \
        if constexpr (F8) { f32x16& _w = accw[ai][bj][m >> 1]; const int _q = ((m & 1) * 2 + n) * 4; f32x4 _c = {_w[_q], _w[_q + 1], _w[_q + 2], _w[_q + 3]}; \
            _c = __builtin_amdgcn_mfma_scale_f32_16x16x128_f8f6f4(f8cat(Bt[n][0], Bt[n][1]), f8cat(At[m][0], At[m][1]), _c, 0, 0, 0, 0, 0, 0); _w[_q] = _c[0]; _w[_q + 1] = _c[1]; _w[_q + 2] = _c[2]; _w[_q + 3] = _c[3]; } \
        else { _Pragma("unroll") for (int k = 0; k < 2; ++k) acc[ai][bj][m][n] = __builtin_amdgcn_mfma_f32_16x16x32_bf16(Bt[n][k], At[m][k], acc[ai][bj][m][n], 0, 0, 0); } } __builtin_amdgcn_s_setprio(0); } while (0)
#define PG8_WAIT_V(n) asm volatile("s_waitcnt vmcnt(" #n ")" ::: "memory")
#define PG8_WAIT_L(n) asm volatile("s_waitcnt lgkmcnt(" #n ")" ::: "memory")
#define PG8_BAR __builtin_amdgcn_s_barrier()
#define PG8_SCHED __builtin_amdgcn_sched_barrier(0)
#define PG8_KPAIR(KB1, KB2, KB3, BP2, BP3) do { \
            PG8_LDB(B0, 0, 0); PG8_LDB(B1, 0, 1); PG8_SCHED; PG8_LDA(At, 0, 0); PG8_STAGE_A(PG8_SA(1, 1), KB1, uC[1], aoC[1]); \
            PG8_WAIT_V(8); PG8_WAIT_L(0); PG8_BAR; PG8_MMA(0, 0, At, B0); PG8_MMA(0, 1, At, B1); PG8_BAR; PG8_SCHED; \
            PG8_LDA(At, 0, 1); PG8_STAGE_B(PG8_SB(0, 0), BP2); PG8_STAGE_B1(PG8_SB(0, 1), BP2); PG8_STAGE_A(PG8_SA(0, 0), KB2, u2[0], a2o[0]); \
            PG8_WAIT_V(8); PG8_WAIT_L(0); PG8_BAR; PG8_MMA(1, 0, At, B0); PG8_MMA(1, 1, At, B1); PG8_BAR; PG8_SCHED; \
            PG8_LDB(B0, 1, 0); PG8_LDB(B1, 1, 1); PG8_SCHED; PG8_LDA(At, 1, 0); PG8_STAGE_A(PG8_SA(0, 1), KB2, u2[1], a2o[1]); \
            PG8_WAIT_V(8); PG8_WAIT_L(0); PG8_BAR; PG8_MMA(0, 0, At, B0); PG8_MMA(0, 1, At, B1); PG8_BAR; PG8_SCHED; \
            PG8_LDA(At, 1, 1); PG8_STAGE_B(PG8_SB(1, 0), BP3); PG8_STAGE_B1(PG8_SB(1, 1), BP3); PG8_STAGE_A(PG8_SA(1, 0), KB3, u2[0], a2o[0]); \
            PG8_WAIT_V(8); PG8_WAIT_L(0); PG8_BAR; PG8_MMA(1, 0, At, B0); PG8_MMA(1, 1, At, B1); PG8_BAR; PG8_SCHED; } while (0)
    Unit cur, nxt; int ui = 0;
    if (!S.next(0, cur)) return;
    f32x4 acc[2][2][4][2];
#pragma unroll
    for (int a = 0; a < 2; ++a)
#pragma unroll
        for (int b = 0; b < 2; ++b)
#pragma unroll
            for (int m = 0; m < 4; ++m)
#pragma unroll
                for (int n = 0; n < 2; ++n) acc[a][b][m][n] = (f32x4){0.f, 0.f, 0.f, 0.f};
    bf16x8 At[4][2], B0[2][2], B1[2][2];
    f32x16 accw[2][2][2];
#define PG8_ZERO_W() do { if constexpr (F8) { _Pragma("unroll") for (int _a = 0; _a < 2; ++_a) _Pragma("unroll") for (int _b = 0; _b < 2; ++_b) _Pragma("unroll") for (int _m = 0; _m < 2; ++_m) _Pragma("unroll") for (int _e = 0; _e < 16; ++_e) accw[_a][_b][_m][_e] = 0.f; } } while (0)
    PG8_ZERO_W();
#pragma unroll
    for (int h = 0; h < 2; ++h) { uC[h] = GA ? 0u : S.unit_off(cur, h); uN[h] = uC[h];
#pragma unroll
        for (int i = 0; i < 2; ++i) { aoC[h][i] = GA ? (S.aoff(cur, h * HALF + RA[i]) + CA2[i]) : 0u; aoN[h][i] = aoC[h][i]; } }
    const char* cB = S.bptr(cur);
    PG8_STAGE_B(PG8_SB(0, 0), cB); PG8_STAGE_B1(PG8_SB(0, 1), cB); PG8_STAGE_A(PG8_SA(0, 0), 0u, uC[0], aoC[0]); PG8_STAGE_A(PG8_SA(0, 1), 0u, uC[1], aoC[1]);
    if (wr == 1) PG8_BAR;
    PG8_WAIT_V(2); PG8_BAR;
    PG8_STAGE_B(PG8_SB(1, 0), cB + kstepB); PG8_STAGE_A(PG8_SA(1, 0), kstepA, uC[0], aoC[0]); PG8_STAGE_B1(PG8_SB(1, 1), cB + kstepB);
    PG8_WAIT_V(6); PG8_BAR;
    for (;;) {
        const bool has_next = S.next(ui + 1, nxt);
        const char* nB = has_next ? S.bptr(nxt) : cB;
#pragma unroll
        for (int h = 0; h < 2; ++h) { uN[h] = (GA || !has_next) ? uC[h] : S.unit_off(nxt, h);
#pragma unroll
            for (int i = 0; i < 2; ++i) aoN[h][i] = (GA && has_next) ? (S.aoff(nxt, h * HALF + RA[i]) + CA2[i]) : aoC[h][i]; }
#pragma nounroll
        for (int t = 0; t < nt; t += 2) {
            const bool last = (t == nt - 2);
            const unsigned kb1 = (unsigned)(t + 1) * kstepA, kb2 = last ? 0u : (unsigned)(t + 2) * kstepA, kb3 = kb2 + kstepA;
            const char* b2 = last ? nB : cB + (size_t)(t + 2) * kstepB; const char* b3 = b2 + kstepB;
            unsigned u2[2], a2o[2][2];
#pragma unroll
            for (int h = 0; h < 2; ++h) { u2[h] = last ? uN[h] : uC[h];
#pragma unroll
                for (int i = 0; i < 2; ++i) a2o[h][i] = GA ? (last ? aoN[h][i] : aoC[h][i]) : 0u; }
            PG8_KPAIR(kb1, kb2, kb3, b2, b3);
        }
        if constexpr (ALIGN_EPI) { if (wr == 0) PG8_BAR; }
        if constexpr (F8) {
#pragma unroll
            for (int _a = 0; _a < 2; ++_a)
#pragma unroll
                for (int _b = 0; _b < 2; ++_b)
#pragma unroll
                    for (int _m = 0; _m < 4; ++_m)
#pragma unroll
                        for (int _n = 0; _n < 2; ++_n) { const f32x16& _w = accw[_a][_b][_m >> 1]; const int _q = ((_m & 1) * 2 + _n) * 4; acc[_a][_b][_m][_n] = (f32x4){_w[_q], _w[_q + 1], _w[_q + 2], _w[_q + 3]}; }
        }
        E(acc, cur, wr, wc, fr, fq);
        PG8_ZERO_W();
        if (!has_next) break;
#pragma unroll
        for (int a = 0; a < 2; ++a)
#pragma unroll
            for (int b = 0; b < 2; ++b)
#pragma unroll
                for (int m = 0; m < 4; ++m)
#pragma unroll
                    for (int n = 0; n < 2; ++n) acc[a][b][m][n] = (f32x4){0.f, 0.f, 0.f, 0.f};
        cur = nxt; cB = nB; ++ui;
#pragma unroll
        for (int h = 0; h < 2; ++h) { uC[h] = uN[h];
#pragma unroll
            for (int i = 0; i < 2; ++i) aoC[h][i] = aoN[h][i]; }
        if constexpr (ALIGN_EPI) { if (wr == 1) PG8_BAR; }
    }
    PG8_WAIT_V(0);
    if constexpr (!ALIGN_EPI) { if (wr == 0) PG8_BAR; }
    PG8_BAR;
#undef PG8_SA
#undef PG8_ZERO_W
#undef PG8_GLDS
#undef PG8_SB
#undef PG8_STAGE_A
#undef PG8_STAGE_B
#undef PG8_STAGE_B1
#undef PG8_LDA
#undef PG8_LDB
#undef PG8_MMA
#undef PG8_WAIT_V
#undef PG8_WAIT_L
#undef PG8_BAR
#undef PG8_SCHED
#undef PG8_KPAIR
}

struct DenseSched {
    const char* A; const char* Bt; unsigned lda2; size_t btile; int nM, nN, nwg, G, c;
    __device__ __forceinline__ void init(const bf16_t* A_, int lda, const bf16_t* Bt_, int K, int Mrows, int N) {
        A = (const char*)A_; Bt = (const char*)Bt_; lda2 = (unsigned)lda * 2u; btile = (size_t)256 * K * 2; nM = Mrows / BM; nN = N / BM; nwg = nM * nN; G = gridDim.x; c = blockIdx.x; }
    __device__ __forceinline__ bool next(int i, Unit& u) const {
        const long L = (long)i * G + c; if (L >= nwg) return false;
        int wgid = (int)L; { const int q = nwg / 8, r = nwg % 8, xcd = wgid % 8, off = wgid / 8; wgid = (xcd < r ? xcd * (q + 1) : r * (q + 1) + (xcd - r) * q) + off; }
        const int nig = 8 * nN, gid = wgid / nig, fm = gid * 8, gsz = (nM - fm) < 8 ? (nM - fm) : 8;
        u.pm = fm + ((wgid % nig) % gsz); u.pn = (wgid % nig) / gsz; u.ord = i; return true;
    }
    static constexpr bool GATHER = false;
    __device__ __forceinline__ unsigned lane_off(int r) const { return (unsigned)r * lda2; }
    __device__ __forceinline__ unsigned unit_off(const Unit& u, int h) const { return (unsigned)(u.pm * BM + h * HALF) * lda2; }
    __device__ __forceinline__ unsigned aoff(const Unit&, int) const { return 0u; }
    __device__ __forceinline__ const char* abase() const { return A; }
    __device__ __forceinline__ const char* bptr(const Unit& u) const { return Bt + (size_t)u.pn * btile; }
};
}
typedef float f32x2_t __attribute__((ext_vector_type(2))); typedef __bf16 bf16x2_t __attribute__((ext_vector_type(2)));
__device__ __forceinline__ unsigned cvt_pk_bf16(float lo, float hi) { const f32x2_t v = {lo, hi}; const bf16x2_t b = __builtin_convertvector(v, bf16x2_t); return __builtin_bit_cast(unsigned, b); }
__device__ __forceinline__ u32x4 pack8(const f32x4 v0, const f32x4 v1) { u32x4 w; w.x = cvt_pk_bf16(v0[0], v0[1]); w.y = cvt_pk_bf16(v0[2], v0[3]); w.z = cvt_pk_bf16(v1[0], v1[1]); w.w = cvt_pk_bf16(v1[2], v1[3]); return w; }
__device__ __forceinline__ unsigned cvtpk_m(float lo, float hi) { const f32x2_t v = {lo, hi}; const bf16x2_t b = __builtin_convertvector(v, bf16x2_t); return __builtin_bit_cast(unsigned, b); }
__device__ __forceinline__ u32x4 pack8m(const f32x4 v0, const f32x4 v1) { u32x4 w; w.x = cvtpk_m(v0[0], v0[1]); w.y = cvtpk_m(v0[2], v0[3]); w.z = cvtpk_m(v1[0], v1[1]); w.w = cvtpk_m(v1[2], v1[3]); return w; }
#define MFMA_SETTLE(S) asm volatile("s_nop 15\n\ts_nop 7" : "+v"(S[0][0]), "+v"(S[0][1]), "+v"(S[0][2]), "+v"(S[0][3]), "+v"(S[1][0]), "+v"(S[1][1]), "+v"(S[1][2]), "+v"(S[1][3]))
__device__ __forceinline__ f32x4 sig4(const f32x4 v) { f32x4 r; r[0] = sigmoidf_(v[0]); r[1] = sigmoidf_(v[1]); r[2] = sigmoidf_(v[2]); r[3] = sigmoidf_(v[3]); return r; }

#define EPI_ROWLOOP for (int ai = 0; ai < 2; ++ai) _Pragma("unroll") for (int m = 0; m < 4; ++m)
struct EpiInproj0 {
    static constexpr bool PERM = true, PERM16 = false; bf16_t* H0;
    __device__ __forceinline__ void operator()(const f32x4 (&acc)[2][2][4][2], const pg8::Unit& u, int wr, int wc, int fr, int fq) const {
        const int row0 = u.pm * 256 + wr * 64 + fr, cl = wc * 32 + 8 * fq;
#pragma unroll
        EPI_ROWLOOP { bf16_t* rp = H0 + (size_t)(row0 + ai * 128 + m * 16) * 1024;
            if (u.pn < 2) {
#pragma unroll
                for (int bj = 0; bj < 2; ++bj) *(u32x4*)(rp + u.pn * 256 + bj * 128 + cl) = pack8(acc[ai][bj][m][0], acc[ai][bj][m][1]);
            } else {
                const f32x4 v0 = acc[ai][0][m][0] * sig4(acc[ai][1][m][0]), v1 = acc[ai][0][m][1] * sig4(acc[ai][1][m][1]);
                *(u32x4*)(rp + 512 + (u.pn - 2) * 128 + cl) = pack8(v0, v1);
            } }
    }
};
struct EpiRes {
    static constexpr bool PERM = true, PERM16 = false; const float* resf; const bf16_t* resb; bf16_t* Y;
    __device__ __forceinline__ void operator()(const f32x4 (&acc)[2][2][4][2], const pg8::Unit& u, int wr, int wc, int fr, int fq) const {
        const int row0 = u.pm * 256 + wr * 64 + fr, c0 = u.pn * 256 + wc * 32 + 8 * fq;
#pragma unroll
        EPI_ROWLOOP { const size_t ro = (size_t)(row0 + ai * 128 + m * 16) * 1024 + c0;
#pragma unroll
            for (int bj = 0; bj < 2; ++bj) {
                f32x4 r0, r1;
                if (resf) { r0 = *(const f32x4*)(resf + ro + bj * 128); r1 = *(const f32x4*)(resf + ro + bj * 128 + 4); }
                else { const u32x4 xv = *(const u32x4*)(resb + ro + bj * 128);
                    r0[0] = __uint_as_float(xv.x << 16); r0[1] = __uint_as_float(xv.x & 0xffff0000u); r0[2] = __uint_as_float(xv.y << 16); r0[3] = __uint_as_float(xv.y & 0xffff0000u);
                    r1[0] = __uint_as_float(xv.z << 16); r1[1] = __uint_as_float(xv.z & 0xffff0000u); r1[2] = __uint_as_float(xv.w << 16); r1[3] = __uint_as_float(xv.w & 0xffff0000u); }
                *(u32x4*)(Y + ro + bj * 128) = pack8(acc[ai][bj][m][0] + r0 * ALPHA, acc[ai][bj][m][1] + r1 * ALPHA);
            } }
    }
};
struct EpiLogits {
    static constexpr bool PERM = true, PERM16 = false; float* LOG;
    __device__ __forceinline__ void operator()(const f32x4 (&acc)[2][2][4][2], const pg8::Unit& u, int wr, int wc, int fr, int fq) const {
        const int row0 = u.pm * 256 + wr * 64 + fr, cl = wc * 32 + 8 * fq;
#pragma unroll
        EPI_ROWLOOP { float* rp = LOG + (size_t)(row0 + ai * 128 + m * 16) * 256 + cl;
#pragma unroll
            for (int bj = 0; bj < 2; ++bj) { *(f32x4*)(rp + bj * 128) = acc[ai][bj][m][0]; *(f32x4*)(rp + bj * 128 + 4) = acc[ai][bj][m][1]; } }
    }
};

constexpr int MOE_TAB_OFF = 131072;
__device__ __forceinline__ int moe_setup256(const unsigned* cnt, LAS unsigned char* lds) {
    LAS int* tstart = (LAS int*)(lds + MOE_TAB_OFF);
    LAS int* scnt = (LAS int*)(lds + MOE_TAB_OFF + 1088);
    LAS unsigned short* texp = (LAS unsigned short*)(lds + MOE_TAB_OFF + 2176);
    const int tid = threadIdx.x;
    __syncthreads();
    if (tid < 256) scnt[tid] = (int)cnt[tid];
    __syncthreads();
    if (tid == 0) { int s = 0; for (int e = 0; e < 256; ++e) { tstart[e] = s; s += (scnt[e] + 255) >> 8; } tstart[256] = s; }
    __syncthreads();
    if (tid < 256) for (int q = tstart[tid]; q < tstart[tid + 1]; ++q) texp[q] = (unsigned short)tid;
    __syncthreads();
    return __builtin_amdgcn_readfirstlane(tstart[256]);
}
constexpr int MOE_TOK_OFF = MOE_TAB_OFF + 5120;
constexpr int MOE_MAX_ORD = 20;
struct MoeGuSched {
    static constexpr bool GATHER = true;
    const char* X; const char* W; const int2* list; LAS unsigned char* lds; int R, nunits, G, c;
    __device__ __forceinline__ int vcu() const { return (G % 8 == 0) ? (c % 8) * (G / 8) + c / 8 : c; }
    __device__ __forceinline__ bool next(int i, pg8::Unit& u) const {
        const int L = i * G + vcu(); if (L >= nunits || i >= MOE_MAX_ORD) return false;
        const int q = L >> 1; const int e = __builtin_amdgcn_readfirstlane((q < R) ? (int)((LAS unsigned short*)(lds + MOE_TAB_OFF + 2176))[q] : 256);
        u.pm = q; u.pn = e * 2 + (L & 1); u.ord = i; return true; }
    __device__ __forceinline__ void prepare() const {
        const int tid = threadIdx.x, r = tid & 255;
        pg8::Unit u;
        for (int i = tid >> 8; next(i, u); i += 2) {
            const int e = u.pn >> 1; int token;
            if (e < 256) { const int ts = ((LAS int*)(lds + MOE_TAB_OFF))[e], cn = ((LAS int*)(lds + MOE_TAB_OFF + 1088))[e]; int lr = (u.pm - ts) * 256 + r; if (lr >= cn) lr = cn - 1;
                token = list[(size_t)e * LISTCAP + lr].x / 10; }
            else token = (u.pm - R) * 256 + r;
            ((LAS unsigned short*)(lds + MOE_TOK_OFF))[i * 256 + r] = (unsigned short)token;
        }
        __syncthreads();
    }
    __device__ __forceinline__ unsigned aoff(const pg8::Unit& u, int r) const { return (unsigned)((LAS unsigned short*)(lds + MOE_TOK_OFF))[u.ord * 256 + r] * 1024u; }
    __device__ __forceinline__ unsigned lane_off(int) const { return 0u; }
    __device__ __forceinline__ unsigned unit_off(const pg8::Unit&, int) const { return 0u; }
    __device__ __forceinline__ const char* abase() const { return X; }
    __device__ __forceinline__ const char* bptr(const pg8::Unit& u) const { return W + (size_t)u.pn * (256 * 1024); }
};
constexpr float GU_SC = 1.0f / (X8_SCALE * W8_SCALE);
struct EpiGateUp {
    static constexpr bool PERM = true, PERM16 = false; unsigned char* HID;
    __device__ __forceinline__ void operator()(const f32x4 (&acc)[2][2][4][2], const pg8::Unit& u, int wr, int wc, int fr, int fq) const {
        const int row0 = u.pm * 256 + wr * 64 + fr, c0 = (u.pn & 1) * 128 + wc * 32 + 8 * fq;
#pragma unroll
        EPI_ROWLOOP { const f32x4 g0 = acc[ai][0][m][0] * GU_SC, g1 = acc[ai][0][m][1] * GU_SC;
            f32x4 h0 = g0 * sig4(g0) * (acc[ai][1][m][0] * (GU_SC * H8_SCALE)), h1 = g1 * sig4(g1) * (acc[ai][1][m][1] * (GU_SC * H8_SCALE));
#pragma unroll
            for (int i = 0; i < 4; ++i) { h0[i] = clamp8(h0[i]); h1[i] = clamp8(h1[i]); }
            *(u32x2*)(HID + (size_t)(row0 + ai * 128 + m * 16) * 256 + c0) = pack8_fp8(h0, h1); }
    }
};
constexpr int MOE_RI_OFF = MOE_TAB_OFF + 5120;
constexpr int MOE_MAX_RT = 6;
struct MoeDownSched {
    const char* HID; const char* W; const int2* list; LAS unsigned char* lds; int R, ntile, G, c;
    __device__ __forceinline__ int vcu() const { return (G % 8 == 0) ? (c % 8) * (G / 8) + c / 8 : c; }
    __device__ __forceinline__ bool next(int i, pg8::Unit& u) const {
        const int q = vcu() + G * (i >> 2); if (q >= ntile || (i >> 2) >= MOE_MAX_RT) return false;
        const int e = (q < R) ? (int)((LAS unsigned short*)(lds + MOE_TAB_OFF + 2176))[q] : 256;
        u.pm = q; u.pn = e * 4 + (i & 3); u.ord = i >> 2; return true; }
    __device__ __forceinline__ void prepare() const {
        const int tid = threadIdx.x, r = tid & 255;
        for (int o = tid >> 8; o < MOE_MAX_RT; o += 2) {
            const int q = vcu() + G * o; if (q >= ntile) break;
            u32x2 en;
            if (q < R) { const int e = ((LAS unsigned short*)(lds + MOE_TAB_OFF + 2176))[q]; const int ts = ((LAS int*)(lds + MOE_TAB_OFF))[e], cn = ((LAS int*)(lds + MOE_TAB_OFF + 1088))[e];
                const int lr = (q - ts) * 256 + r; if (lr < cn) { const int2 le = list[(size_t)e * LISTCAP + lr]; en.x = (unsigned)le.x; en.y = (unsigned)le.y; } else { en.x = 0xffffffffu; en.y = 0u; } }
            else { en.x = (unsigned)(((q - R) * 256 + r) * 10 + 8); en.y = __float_as_uint(1.0f); }
            ((LAS u32x2*)(lds + MOE_RI_OFF))[o * 256 + r] = en;
        }
        __syncthreads();
    }
    static constexpr bool GATHER = false;
    __device__ __forceinline__ unsigned lane_off(int r) const { return (unsigned)r * 256u; }
    __device__ __forceinline__ unsigned unit_off(const pg8::Unit& u, int h) const { return (unsigned)(u.pm * 256 + h * 128) * 256u; }
    __device__ __forceinline__ unsigned aoff(const pg8::Unit&, int) const { return 0u; }
    __device__ __forceinline__ const char* abase() const { return HID; }
    __device__ __forceinline__ const char* bptr(const pg8::Unit& u) const { return W + (size_t)u.pn * (256 * 256); }
};
struct EpiDown {
    static constexpr bool PERM = true, PERM16 = true;
    unsigned char* YB; LAS unsigned char* lds;
    __device__ __forceinline__ void operator()(const f32x4 (&acc)[2][2][4][2], const pg8::Unit& u, int wr, int wc, int fr, int fq) const {
        asm volatile("" : "+v"(fr), "+v"(fq));
        const unsigned c0b = (unsigned)((u.pn & 3) * 256 + wc * 64 + 16 * fq); const bool shared = (u.pn >> 2) == 256;
        const LAS u32x2* ri = (const LAS u32x2*)(lds + MOE_RI_OFF) + u.ord * 256 + wr * 64 + fr;
#pragma unroll
        for (int ai = 0; ai < 2; ++ai)
#pragma unroll
            for (int m = 0; m < 4; ++m) { const u32x2 en = ri[ai * 128 + m * 16]; const float wv = __uint_as_float(en.y) * (YB_SCALE / (H8_SCALE * W8_SCALE));
                if ((int)en.x >= 0) { unsigned char* rp = YB + (size_t)(en.x * 1024u + c0b);
                    const f32x4 v00 = acc[ai][0][m][0] * wv, v01 = acc[ai][0][m][1] * wv, v10 = acc[ai][1][m][0] * wv, v11 = acc[ai][1][m][1] * wv;
                    const u32x2 h0 = pack8_fp8(v00, v01), h1 = pack8_fp8(v10, v11);
                    *(u32x4*)rp = (u32x4){h0.x, h0.y, h1.x, h1.y};
                    if (YB_NSLOT == 10 && shared) {
                        u32x2 r_[2];
#pragma unroll
                        for (int bj = 0; bj < 2; ++bj) { const u32x2 h = bj ? h1 : h0; const f32x4 v0 = bj ? v10 : v00, v1 = bj ? v11 : v01;
                            const auto a0 = __builtin_amdgcn_cvt_pk_f32_fp8((int)h.x, false), a1 = __builtin_amdgcn_cvt_pk_f32_fp8((int)h.x, true), a2 = __builtin_amdgcn_cvt_pk_f32_fp8((int)h.y, false), a3 = __builtin_amdgcn_cvt_pk_f32_fp8((int)h.y, true);
                            const f32x4 r0 = {v0[0] - a0[0], v0[1] - a0[1], v0[2] - a1[0], v0[3] - a1[1]}, r1 = {v1[0] - a2[0], v1[1] - a2[1], v1[2] - a3[0], v1[3] - a3[1]};
                            r_[bj] = pack8_fp8(r0, r1); }
                        *(u32x4*)(rp + 1024) = (u32x4){r_[0].x, r_[0].y, r_[1].x, r_[1].y}; } } }
    }
};

struct EpiInprojN {
    static constexpr bool PERM = true, PERM16 = false; bf16_t* QN; bf16_t* QR; bf16_t* KV6; float* GATES; const float* ROT;
    __device__ __forceinline__ void operator()(const f32x4 (&acc)[2][2][4][2], const pg8::Unit& u, int wr, int wc, int fr, int fq) const {
        const int row0 = u.pm * 256 + wr * 64 + fr, cl = wc * 32 + 8 * fq, pn = u.pn;
        const bool isq = pn < 4, rotk = (pn == 6 || pn == 8), dorot = (isq || rotk) && ((wc & 1) == 0);
#pragma unroll
        EPI_ROWLOOP { const int row = row0 + ai * 128 + m * 16;
            if (pn == 10) {
                if (cl < 48) { *(f32x4*)(GATES + (size_t)row * 48 + cl) = sig4(acc[ai][0][m][0]); *(f32x4*)(GATES + (size_t)row * 48 + cl + 4) = sig4(acc[ai][0][m][1]); }
            } else {
                f32x4 cs0, cs1, sn0, sn1;
                if (dorot) { const float* rt = ROT + (size_t)(row & (T - 1)) * 16; cs0 = *(const f32x4*)rt; cs1 = *(const f32x4*)(rt + 4); sn0 = *(const f32x4*)(rt + 8); sn1 = *(const f32x4*)(rt + 12); }
#pragma unroll
                for (int bj = 0; bj < 2; ++bj) {
                    const f32x4 v0 = acc[ai][bj][m][0], v1 = acc[ai][bj][m][1];
                    f32x4 r0 = v0, r1 = v1;
                    if (dorot) {
                        f32x4 p0, p1;
#pragma unroll
                        for (int i = 0; i < 4; ++i) { p0[i] = __shfl_xor(v0[i], 16); p1[i] = __shfl_xor(v1[i], 16); }
                        if (fq == 0) { r0 = v0 * cs0 - p0 * sn0; r1 = v1 * cs1 - p1 * sn1; }
                        else if (fq == 1) { r0 = v0 * cs0 + p0 * sn0; r1 = v1 * cs1 + p1 * sn1; }
                    }
                    if (isq) { const int c = pn * 256 + bj * 128 + cl;
                        *(u32x4*)(QN + (size_t)row * 1024 + c) = pack8(v0 * QSCALE, v1 * QSCALE); *(u32x4*)(QR + (size_t)row * 1024 + c) = pack8(r0 * QSCALE, r1 * QSCALE); }
                    else { const int cc = bj * 128 + cl, g = cc >> 6, d = cc & 63, b = row >> 13, t = row & (T - 1);
                        *(u32x4*)(KV6 + ((size_t)((pn - 4) * 16 + b * 4 + g) * T + t) * 64 + d) = pack8(r0, r1); }
                }
            } }
    }
};

struct Cmp1Sched {
    const char* KV6; const char* W; int G, c;
    static constexpr bool GATHER = false;
    __device__ __forceinline__ bool next(int i, pg8::Unit& u) const { const int L = i * G + c; if (L >= 64) return false; u.pm = L >> 1; u.pn = L & 1; u.ord = i; return true; }
    __device__ __forceinline__ unsigned lane_off(int r) const { return (unsigned)r * 2048u; }
    __device__ __forceinline__ unsigned unit_off(const pg8::Unit& u, int h) const { return (unsigned)u.pn * (unsigned)(16 * T * 64 * 2) + (unsigned)(u.pm * 256 + h * 128) * 2048u; }
    __device__ __forceinline__ unsigned aoff(const pg8::Unit&, int) const { return 0u; }
    __device__ __forceinline__ const char* abase() const { return KV6; }
    __device__ __forceinline__ const char* bptr(const pg8::Unit& u) const { return W + (size_t)u.pn * (256 * 2048 * 2); }
};
struct EpiCmp1 {
    static constexpr bool PERM = true, PERM16 = false; bf16_t* CH1; const float* bias1;
    __device__ __forceinline__ void operator()(const f32x4 (&acc)[2][2][4][2], const pg8::Unit& u, int wr, int wc, int fr, int fq) const {
        const int row0 = u.pm * 256 + wr * 64 + fr, cl = wc * 32 + 8 * fq;
        const f32x4 b0 = *(const f32x4*)(bias1 + u.pn * 128 + cl), b1 = *(const f32x4*)(bias1 + u.pn * 128 + cl + 4);
#pragma unroll
        EPI_ROWLOOP { f32x4 v0 = acc[ai][0][m][0] + b0, v1 = acc[ai][0][m][1] + b1;
#pragma unroll
            for (int i = 0; i < 4; ++i) { v0[i] = gelu_tanh(v0[i]); v1[i] = gelu_tanh(v1[i]); }
            *(u32x4*)(CH1 + ((size_t)u.pn * 8192 + row0 + ai * 128 + m * 16) * 128 + cl) = pack8(v0, v1); }
    }
};

__device__ __forceinline__ void p0_item(const float* W, int K, int N, bf16_t* WT, int kb, int n0, int drow0, LAS float* scr, int lane, bool f8 = false) {
    const int k0 = 64 * kb, n4 = (lane & 15) * 4;
    const bool cok = (n0 + n4) < N;
    f32x4 v[16];
#pragma unroll
    for (int i = 0; i < 16; ++i) { const int kk = 4 * i + (lane >> 4); v[i] = cok ? __builtin_nontemporal_load((const f32x4*)(W + (size_t)(k0 + kk) * N + n0 + n4)) : (f32x4){0.f, 0.f, 0.f, 0.f}; }
#pragma unroll
    for (int i = 0; i < 16; ++i) { const int kk = 4 * i + (lane >> 4); LAS float* d = scr + kk * 65 + n4; d[0] = v[i][0]; d[1] = v[i][1]; d[2] = v[i][2]; d[3] = v[i][3]; }
    asm volatile("s_waitcnt lgkmcnt(0)" ::: "memory");
    if (f8) {
        const int c4 = lane & 3;
#pragma unroll
        for (int j = 0; j < 4; ++j) { const int n = (lane >> 2) + 16 * j; const LAS float* sp = scr + (16 * c4) * 65 + n;
            u32x4 o;
            o.x = pk4_fp8(sp[0 * 65] * W8_SCALE, sp[1 * 65] * W8_SCALE, sp[2 * 65] * W8_SCALE, sp[3 * 65] * W8_SCALE); o.y = pk4_fp8(sp[4 * 65] * W8_SCALE, sp[5 * 65] * W8_SCALE, sp[6 * 65] * W8_SCALE, sp[7 * 65] * W8_SCALE);
            o.z = pk4_fp8(sp[8 * 65] * W8_SCALE, sp[9 * 65] * W8_SCALE, sp[10 * 65] * W8_SCALE, sp[11 * 65] * W8_SCALE); o.w = pk4_fp8(sp[12 * 65] * W8_SCALE, sp[13 * 65] * W8_SCALE, sp[14 * 65] * W8_SCALE, sp[15 * 65] * W8_SCALE);
            if (n0 + n < N) __builtin_nontemporal_store(o, (u32x4*)((unsigned char*)WT + (size_t)(drow0 + n) * K + k0 + 16 * c4)); }
        asm volatile("s_waitcnt lgkmcnt(0)" ::: "memory");
        return;
    }
    const int c = lane & 7;
#pragma unroll
    for (int j = 0; j < 8; ++j) { const int n = (lane >> 3) + 8 * j; const LAS float* sp = scr + (8 * c) * 65 + n;
        u32x4 o; o.x = pk2(sp[0 * 65], sp[1 * 65]); o.y = pk2(sp[2 * 65], sp[3 * 65]); o.z = pk2(sp[4 * 65], sp[5 * 65]); o.w = pk2(sp[6 * 65], sp[7 * 65]);
        if (n0 + n < N) __builtin_nontemporal_store(o, (u32x4*)(WT + (size_t)(drow0 + n) * K + k0 + 8 * c)); }
    asm volatile("s_waitcnt lgkmcnt(0)" ::: "memory");
}
struct CvtItem { const float* W; bf16_t* WT; int K, N, k0, n0, drow0; };
__device__ __forceinline__ void cvt32_load(const CvtItem& it, int lane, f32x4 (&v)[8]) {
    const int n4 = (lane & 7) * 4;
#pragma unroll
    for (int i = 0; i < 8; ++i) { const int kk = 8 * i + (lane >> 3); v[i] = __builtin_nontemporal_load((const f32x4*)(it.W + (size_t)(it.k0 + kk) * it.N + it.n0 + n4)); }
}
__device__ __forceinline__ void cvt32_finish(const CvtItem& it, int lane, const f32x4 (&v)[8], LAS float* scr) {
    const int n4 = (lane & 7) * 4;
#pragma unroll
    for (int i = 0; i < 8; ++i) { const int kk = 8 * i + (lane >> 3); LAS float* d = scr + kk * 33 + n4; d[0] = v[i][0]; d[1] = v[i][1]; d[2] = v[i][2]; d[3] = v[i][3]; }
    asm volatile("s_waitcnt lgkmcnt(0)" ::: "memory");
    const int c = lane & 7;
#pragma unroll
    for (int j = 0; j < 4; ++j) { const int n = (lane >> 3) + 8 * j; const LAS float* sp = scr + (8 * c) * 33 + n;
        const float v0 = sp[0 * 33], v1 = sp[1 * 33], v2 = sp[2 * 33], v3 = sp[3 * 33], v4 = sp[4 * 33], v5 = sp[5 * 33], v6 = sp[6 * 33], v7 = sp[7 * 33];
        u32x2 o; o.x = pk4_fp8(v0 * W8_SCALE, v1 * W8_SCALE, v2 * W8_SCALE, v3 * W8_SCALE); o.y = pk4_fp8(v4 * W8_SCALE, v5 * W8_SCALE, v6 * W8_SCALE, v7 * W8_SCALE);
        __builtin_nontemporal_store(o, (u32x2*)((unsigned char*)it.WT + (size_t)(it.drow0 + n) * it.K + it.k0 + 8 * c)); }
    asm volatile("s_waitcnt lgkmcnt(0)" ::: "memory");
}
constexpr int CVT1_ITEMS = 257 * 384;
__device__ __forceinline__ CvtItem cvt1_item(const Args& a, int idx) {
    const int e = idx / 384, sub = idx % 384, mat = sub >> 7, r = sub & 127;
    CvtItem it;
    if (mat < 2) { it.W = (e < 256) ? a.in[23 + mat] + ((size_t)256 + e) * (size_t)(D * FF) : a.in[26 + mat] + (size_t)(D * FF);
        it.K = D; it.N = FF; it.k0 = (r >> 3) * 64; it.n0 = (r & 7) * 32; it.drow0 = (it.n0 >> 7) * 256 + mat * 128 + (it.n0 & 127);
        it.WT = (bf16_t*)(a.ws + WS_WGU + (size_t)(257 + e) * 512 * 1024); }
    else { it.W = (e < 256) ? a.in[25] + ((size_t)256 + e) * (size_t)(FF * D) : a.in[28] + (size_t)(FF * D);
        it.K = FF; it.N = D; it.k0 = (r >> 5) * 64; it.n0 = (r & 31) * 32; it.drow0 = it.n0;
        it.WT = (bf16_t*)(a.ws + WS_WD + (size_t)(257 + e) * 1024 * 256); }
    return it;
}
__device__ __forceinline__ void cvt1_run(const Args& a, int& next, int stride, int quota, LAS float* scr, int lane) {
#pragma unroll 1
    for (int q = 0; q < quota && next < CVT1_ITEMS; ++q) {
        CvtItem t[4]; f32x4 v[4][8]; bool ok[4];
#pragma unroll
        for (int u = 0; u < 4; ++u) { const int idx = next + u * stride; ok[u] = idx < CVT1_ITEMS; t[u] = cvt1_item(a, ok[u] ? idx : 0); if (ok[u]) cvt32_load(t[u], lane, v[u]); }
        next += 4 * stride;
#pragma unroll
        for (int u = 0; u < 4; ++u) if (ok[u]) cvt32_finish(t[u], lane, v[u], scr);
    }
}
__device__ __forceinline__ void ph_prologue(const Args& a, LAS unsigned char* lds) {
    const int lane = threadIdx.x & 63, wave = threadIdx.x >> 6;
    LAS float* scr = (LAS float*)(lds + wave * 16640);
    const int gw = blockIdx.x * 8 + wave, ngw = gridDim.x * 8;
    for (int it = gw; it < 257 * 192; it += ngw) {
        const int le = it / 192, sub = it % 192, l = 0, e = le, mat = sub >> 6, r = sub & 63;
        if (mat < 2) {
            const float* W = (e < 256) ? a.in[23 + mat] + ((size_t)l * 256 + e) * (size_t)(D * FF) : a.in[26 + mat] + (size_t)l * (D * FF);
            const int kb = r >> 2, n0 = (r & 3) * 64;
            p0_item(W, D, FF, (bf16_t*)(a.ws + WS_WGU + (size_t)le * 512 * 1024), kb, n0, (n0 >> 7) * 256 + mat * 128 + (n0 & 127), scr, lane, true);
        } else {
            const float* W = (e < 256) ? a.in[25] + ((size_t)l * 256 + e) * (size_t)(FF * D) : a.in[28] + (size_t)l * (FF * D);
            const int kb = r >> 4, n0 = (r & 15) * 64;
            p0_item(W, FF, D, (bf16_t*)(a.ws + WS_WD + (size_t)le * 1024 * 256), kb, n0, n0, scr, lane, true);
        }
    }
    {
        for (int it = gw; it < 512; it += ngw) { const int w = it >> 8, r = it & 255;
            p0_item(a.in[w ? 16 : 8], D, D, (bf16_t*)(a.ws + (w ? WS_WOUTN : WS_WOUT0)), r >> 4, (r & 15) * 64, (r & 15) * 64, scr, lane); }
        for (int it = gw; it < 16 * 41; it += ngw) p0_item(a.in[9], D, 2608, (bf16_t*)(a.ws + WS_WINN), it / 41, (it % 41) * 64, (it % 41) * 64, scr, lane);
        for (int it = gw; it < 128; it += ngw) { const int l = it >> 6, r = it & 63;
            p0_item(a.in[21] + (size_t)l * D * NE, D, NE, (bf16_t*)(a.ws + WS_WR) + (size_t)l * NE * D, r >> 2, (r & 3) * 64, (r & 3) * 64, scr, lane); }
        for (int it = gw; it < 16 * 16; it += ngw) { const int kb = it >> 4, n0 = (8 + (it & 15)) * 64;
            const int isg = (n0 >= 1024) ? 1 : 0, rel = n0 - 512 - isg * 512;
            p0_item(a.in[1], D, 1536, (bf16_t*)(a.ws + WS_WIN0), kb, n0, 512 + (rel >> 7) * 256 + isg * 128 + (rel & 127), scr, lane); }
        for (int it = gw; it < 128; it += ngw) { const int kv = it >> 6, r = it & 63;
            p0_item(a.in[kv ? 14 : 11], 2048, 128, (bf16_t*)(a.ws + WS_CW1) + (size_t)kv * 256 * 2048, r >> 1, (r & 1) * 64, (r & 1) * 64, scr, lane); }
    }
    {
        const int gt = blockIdx.x * 512 + threadIdx.x, ngt = gridDim.x * 512;
        u32x4* z0 = (u32x4*)((bf16_t*)(a.ws + WS_WINN) + (size_t)2608 * 1024);
        for (int i = gt; i < 208 * 1024 / 8; i += ngt) z0[i] = (u32x4){0u, 0u, 0u, 0u};
        for (int kv = 0; kv < 2; ++kv) { u32x4* z1 = (u32x4*)((bf16_t*)(a.ws + WS_CW1) + ((size_t)kv * 256 + 128) * 2048);
            for (int i = gt; i < 128 * 2048 / 8; i += ngt) z1[i] = (u32x4){0u, 0u, 0u, 0u}; }
        const float* x = a.in[0]; bf16_t* XA = (bf16_t*)(a.ws + WS_XA);
        for (size_t i = gt; i < (size_t)M * D / 8; i += ngt) { const f32x4 v0 = *(const f32x4*)(x + i * 8), v1 = *(const f32x4*)(x + i * 8 + 4);
            u32x4 o; o.x = pk2(v0[0], v0[1]); o.y = pk2(v0[2], v0[3]); o.z = pk2(v1[0], v1[1]); o.w = pk2(v1[2], v1[3]); *(u32x4*)(XA + i * 8) = o; }
        const float* win = a.in[1]; const float* mix = a.in[2]; const float* psc = a.in[3]; bf16_t* WIN0 = (bf16_t*)(a.ws + WS_WIN0);
        for (int i = gt; i < 512 * 1024; i += ngt) { const int n = i & 511, k = i >> 9, g = n >> 7, nn = n & 127;
            const float* wr_ = win + (size_t)k * 1536 + g * 128; const float* mx = mix + (size_t)g * 128 * 128 + nn;
            float s = 0.f;
            for (int c = 0; c < 128; ++c) s += wr_[c] * mx[(size_t)c * 128];
            WIN0[(size_t)n * 1024 + k] = f2bf(s * psc[n]); }
        float* misc = (float*)(a.ws + WS_MISC);
        for (int i = gt; i < 256; i += ngt) { const int kv = i >> 7, j = i & 127; const float* pos = a.in[kv ? 13 : 10]; const float* w1 = a.in[kv ? 14 : 11];
            float s = 0.f; for (int k = 0; k < 2048; ++k) s += pos[k] * w1[(size_t)k * 128 + j]; misc[i] = s; }
        float* rot = misc + 1024;
        for (int i = gt; i < T * 8; i += ngt) { const int t = i >> 3, f = i & 7;
            const float ang = (float)t * a.inv_freq[f]; const double rev = (double)ang * 0.15915494309189535; const float fr = (float)(rev - floor(rev));
            rot[t * 16 + f] = __builtin_amdgcn_cosf(fr); rot[t * 16 + 8 + f] = __builtin_amdgcn_sinf(fr); }
    }
}

typedef short v4i16_t __attribute__((ext_vector_type(4)));
constexpr int AT_KB = 0, AT_VB = 16384, AT_PS = 32768, AT_MSK = 32768 + 65536;
#define DPP_I(x, ctrl) __builtin_amdgcn_update_dpp((int)(x), (int)(x), (ctrl), 0xF, 0xF, true)
#define DPP_F(x, ctrl) __builtin_bit_cast(float, __builtin_amdgcn_update_dpp(__builtin_bit_cast(int, (float)(x)), __builtin_bit_cast(int, (float)(x)), (ctrl), 0xF, 0xF, false))
__device__ __forceinline__ bf16x8 tr_frag(LAS unsigned char* p0, LAS unsigned char* p1) {
    const v4i16_t a = __builtin_amdgcn_ds_read_tr16_b64_v4i16((LAS v4i16_t*)p0), b = __builtin_amdgcn_ds_read_tr16_b64_v4i16((LAS v4i16_t*)p1);
    return (bf16x8){a[0], a[1], a[2], a[3], b[0], b[1], b[2], b[3]};
}
constexpr size_t TN2_OFF = 786432;
__device__ __forceinline__ void ph_knorm(const Args& a) {
    const bf16_t* KV6 = (const bf16_t*)(a.ws + WS_KV6);
    float* TN2 = (float*)(a.ws + WS_MISC + TN2_OFF);
    const int lane = threadIdx.x & 63, wave = threadIdx.x >> 6;
    const int first = (gridDim.x > 64) ? 64 : 0;
    if ((int)blockIdx.x < first) return;
    const int wi = ((int)blockIdx.x - first) * 8 + wave, nw = ((int)gridDim.x - first) * 8;
    for (int id = wi; id < 4096; id += nw) {
        const int ty = id >> 11, bg = (id >> 7) & 15, tile = id & 127;
        const bf16_t* rp = KV6 + ((size_t)((ty ? 4 : 2) * 16 + bg) * T + tile * 64 + lane) * 64;
        float ssq = 0.f;
#pragma unroll
        for (int c = 0; c < 8; ++c) { const bf16x8 v = *(const bf16x8*)(rp + 8 * c);
#pragma unroll
            for (int j = 0; j < 8; ++j) { const float f = bf2f((bf16_t)v[j]); ssq += f * f; } }
        ssq = wave_max(ssq);
        if (lane == 0) TN2[id] = ssq;
    }
}
__device__ __forceinline__ void attn_qk2(LAS unsigned char* Kb, const bf16x8 (&q)[2][2], int fr, int g4, const float (&cinit)[2], f32x4 (&s)[2][4]) {
#pragma unroll
    for (int c = 0; c < 4; ++c) {
#pragma unroll
        for (int rb = 0; rb < 2; ++rb) s[rb][c] = (f32x4){cinit[rb], cinit[rb], cinit[rb], cinit[rb]};
#pragma unroll
        for (int ks = 0; ks < 2; ++ks) {
            const bf16x8 kf = *(const LAS bf16x8*)(Kb + pg8::lds_byte(16 * c + fr, 32 * ks + 8 * g4));
#pragma unroll
            for (int rb = 0; rb < 2; ++rb) s[rb][c] = __builtin_amdgcn_mfma_f32_16x16x32_bf16(kf, q[rb][ks], s[rb][c], 0, 0, 0);
        }
    }
}
__device__ __forceinline__ void attn_qk2z(LAS unsigned char* Kb, const bf16x8 (&q)[2][2], int fr, int g4, f32x4 (&s)[2][4]) {
    bf16x8 kf[4][2];
#pragma unroll
    for (int c = 0; c < 4; ++c)
#pragma unroll
        for (int ks = 0; ks < 2; ++ks) kf[c][ks] = *(const LAS bf16x8*)(Kb + pg8::lds_byte(16 * c + fr, 32 * ks + 8 * g4));
    __builtin_amdgcn_sched_barrier(0);
#pragma unroll
    for (int c = 0; c < 4; ++c) {
#pragma unroll
        for (int ks = 0; ks < 2; ++ks) {
#pragma unroll
            for (int rb = 0; rb < 2; ++rb) s[rb][c] = __builtin_amdgcn_mfma_f32_16x16x32_bf16(kf[c][ks], q[rb][ks], ks == 0 ? (f32x4){0.f, 0.f, 0.f, 0.f} : s[rb][c], 0, 0, 0);
        }
    }
}
struct AttnRow { float m; f32x4 o[4]; f32x4 ol; };
__device__ __forceinline__ float max3f(float a, float b, float c) { float r; asm("v_max3_f32 %0, %1, %2, %3" : "=v"(r) : "v"(a), "v"(b), "v"(c)); return r; }
__device__ __forceinline__ bool attn_sm2(f32x4 (&s)[4], AttnRow& st, int kbase, int g4, int lo, int hi, bool en, bool emask) {
    const float NEG = -INFINITY;
    if (emask) {
#pragma unroll
        for (int c = 0; c < 4; ++c)
#pragma unroll
            for (int i = 0; i < 4; ++i) { const int key = kbase + 16 * c + 4 * g4 + i; if (key < lo || key > hi) s[c][i] = NEG; }
    }
    float mx = max3f(s[0][0], s[0][1], s[0][2]); mx = max3f(mx, s[0][3], s[1][0]); mx = max3f(mx, s[1][1], s[1][2]); mx = max3f(mx, s[1][3], s[2][0]);
    mx = max3f(mx, s[2][1], s[2][2]); mx = max3f(mx, s[2][3], s[3][0]); mx = max3f(mx, s[3][1], s[3][2]); mx = max3f(mx, s[3][3], mx);
    if (!en) mx = NEG;
    mx = max3f(mx, __shfl_xor(mx, 16), mx); mx = max3f(mx, __shfl_xor(mx, 32), mx);
    const float delta = (mx > 20.0f) ? mx : 0.f;
    const bool moved = __builtin_amdgcn_ballot_w64(delta != 0.f) != 0ull;
    if (moved) {
        const float alpha = __builtin_amdgcn_exp2f(-delta);
#pragma unroll
        for (int c = 0; c < 4; ++c) s[c] = s[c] - delta;
#pragma unroll
        for (int dt = 0; dt < 4; ++dt) st.o[dt] *= alpha;
        st.ol *= alpha;
        st.m += delta;
    }
#pragma unroll
    for (int c = 0; c < 4; ++c)
#pragma unroll
        for (int i = 0; i < 4; ++i) s[c][i] = __builtin_amdgcn_exp2f(s[c][i]);
    return moved;
}
__device__ __forceinline__ bool attn_sm2x(f32x4 (&s)[2][4], AttnRow (&st)[2], int kbase, int g4, const int (&lo)[2], const int (&hi)[2], const bool (&en)[2], bool emask) {
    const float NEG = -INFINITY;
    if (emask) {
#pragma unroll
        for (int rb = 0; rb < 2; ++rb)
#pragma unroll
            for (int c = 0; c < 4; ++c)
#pragma unroll
                for (int i = 0; i < 4; ++i) { const int key = kbase + 16 * c + 4 * g4 + i; if (key < lo[rb] || key > hi[rb]) s[rb][c][i] = NEG; }
    }
    float mx[2];
#pragma unroll
    for (int rb = 0; rb < 2; ++rb) {
        float m = max3f(s[rb][0][0], s[rb][0][1], s[rb][0][2]); m = max3f(m, s[rb][0][3], s[rb][1][0]); m = max3f(m, s[rb][1][1], s[rb][1][2]); m = max3f(m, s[rb][1][3], s[rb][2][0]);
        m = max3f(m, s[rb][2][1], s[rb][2][2]); m = max3f(m, s[rb][2][3], s[rb][3][0]); m = max3f(m, s[rb][3][1], s[rb][3][2]); m = max3f(m, s[rb][3][3], m);
        mx[rb] = en[rb] ? m : NEG;
    }
    { const float t0 = __shfl_xor(mx[0], 16), t1 = __shfl_xor(mx[1], 16); mx[0] = max3f(mx[0], t0, t0); mx[1] = max3f(mx[1], t1, t1); }
    { const float t0 = __shfl_xor(mx[0], 32), t1 = __shfl_xor(mx[1], 32); mx[0] = max3f(mx[0], t0, t0); mx[1] = max3f(mx[1], t1, t1); }
    const float d0 = (mx[0] > 20.0f) ? mx[0] : 0.f, d1 = (mx[1] > 20.0f) ? mx[1] : 0.f;
    const bool moved = __builtin_amdgcn_ballot_w64((d0 != 0.f) || (d1 != 0.f)) != 0ull;
    if (moved) {
        const float dl[2] = {d0, d1};
#pragma unroll
        for (int rb = 0; rb < 2; ++rb) {
            const float alpha = __builtin_amdgcn_exp2f(-dl[rb]);
#pragma unroll
            for (int c = 0; c < 4; ++c) s[rb][c] = s[rb][c] - dl[rb];
#pragma unroll
            for (int dt = 0; dt < 4; ++dt) st[rb].o[dt] *= alpha;
            st[rb].ol *= alpha; st[rb].m += dl[rb];
        }
    }
#pragma unroll
    for (int rb = 0; rb < 2; ++rb)
#pragma unroll
        for (int c = 0; c < 4; ++c)
#pragma unroll
            for (int i = 0; i < 4; ++i) s[rb][c][i] = __builtin_amdgcn_exp2f(s[rb][c][i]);
    return moved;
}
__device__ __forceinline__ void attn_pv2x(LAS unsigned char* Vb, const f32x4 (&p)[2][4], int vlane, int swz, const unsigned (&enm)[2], const bool (&act)[2], const bf16x8 onesf, AttnRow (&st)[2]) {
#pragma unroll
    for (int ks = 0; ks < 2; ++ks) {
        bf16x8 pb[2];
#pragma unroll
        for (int rb = 0; rb < 2; ++rb) { u32x4 pw = pack8m(p[rb][2 * ks], p[rb][2 * ks + 1]); pw.x &= enm[rb]; pw.y &= enm[rb]; pw.z &= enm[rb]; pw.w &= enm[rb]; pb[rb] = __builtin_bit_cast(bf16x8, pw); }
#pragma unroll
        for (int dt = 0; dt < 4; ++dt) {
            LAS unsigned char* a0 = Vb + vlane + (2 * ks) * 2048 + ((dt ^ swz) * 32);
            const bf16x8 vf = tr_frag(a0, a0 + 2048);
#pragma unroll
            for (int rb = 0; rb < 2; ++rb) if (act[rb]) st[rb].o[dt] = __builtin_amdgcn_mfma_f32_16x16x32_bf16(vf, pb[rb], st[rb].o[dt], 0, 0, 0);
        }
#pragma unroll
        for (int rb = 0; rb < 2; ++rb) if (act[rb]) st[rb].ol = __builtin_amdgcn_mfma_f32_16x16x32_bf16(onesf, pb[rb], st[rb].ol, 0, 0, 0);
    }
}
__device__ __forceinline__ bool attn_max2x(f32x4 (&s)[2][4], int kbase, int g4, const int (&lo)[2], const int (&hi)[2], const bool (&en)[2], bool emask, float (&d)[2]) {
    const float NEG = -INFINITY;
    MFMA_SETTLE(s);
    if (emask) {
#pragma unroll
        for (int rb = 0; rb < 2; ++rb)
#pragma unroll
            for (int c = 0; c < 4; ++c)
#pragma unroll
                for (int i = 0; i < 4; ++i) { const int key = kbase + 16 * c + 4 * g4 + i; if (key < lo[rb] || key > hi[rb]) s[rb][c][i] = NEG; }
    }
    float mx[2];
#pragma unroll
    for (int rb = 0; rb < 2; ++rb) {
        float m = max3f(s[rb][0][0], s[rb][0][1], s[rb][0][2]); m = max3f(m, s[rb][0][3], s[rb][1][0]); m = max3f(m, s[rb][1][1], s[rb][1][2]); m = max3f(m, s[rb][1][3], s[rb][2][0]);
        m = max3f(m, s[rb][2][1], s[rb][2][2]); m = max3f(m, s[rb][2][3], s[rb][3][0]); m = max3f(m, s[rb][3][1], s[rb][3][2]); m = max3f(m, s[rb][3][3], m);
        mx[rb] = en[rb] ? m : NEG;
    }
    { const float t0 = __shfl_xor(mx[0], 16), t1 = __shfl_xor(mx[1], 16); mx[0] = max3f(mx[0], t0, t0); mx[1] = max3f(mx[1], t1, t1); }
    { const float t0 = __shfl_xor(mx[0], 32), t1 = __shfl_xor(mx[1], 32); mx[0] = max3f(mx[0], t0, t0); mx[1] = max3f(mx[1], t1, t1); }
    d[0] = (mx[0] > 20.0f) ? mx[0] : 0.f; d[1] = (mx[1] > 20.0f) ? mx[1] : 0.f;
    return __builtin_amdgcn_ballot_w64((d[0] != 0.f) || (d[1] != 0.f)) != 0ull;
}
__device__ __forceinline__ void attn_rescale2x(f32x4 (&s)[2][4], AttnRow (&st)[2], const float (&d)[2]) {
#pragma unroll
    for (int rb = 0; rb < 2; ++rb) {
        const float alpha = __builtin_amdgcn_exp2f(-d[rb]);
#pragma unroll
        for (int c = 0; c < 4; ++c) s[rb][c] = s[rb][c] - d[rb];
#pragma unroll
        for (int dt = 0; dt < 4; ++dt) st[rb].o[dt] *= alpha;
        st[rb].ol *= alpha; st[rb].m += d[rb];
    }
}
__device__ __forceinline__ void attn_exp1(f32x4 (&s)[4], unsigned enm, bf16x8 (&pb)[2]) {
#pragma unroll
    for (int c = 0; c < 4; ++c)
#pragma unroll
        for (int i = 0; i < 4; ++i) s[c][i] = __builtin_amdgcn_exp2f(s[c][i]);
#pragma unroll
    for (int ks = 0; ks < 2; ++ks) { u32x4 pw = pack8m(s[2 * ks], s[2 * ks + 1]); pw.x &= enm; pw.y &= enm; pw.z &= enm; pw.w &= enm; pb[ks] = __builtin_bit_cast(bf16x8, pw); }
}
__device__ __forceinline__ void attn_pv1(LAS unsigned char* Vb, const bf16x8 (&pb)[2], int vlane, int swz, const bf16x8 onesf, AttnRow& st) {
#pragma unroll
    for (int ks = 0; ks < 2; ++ks) {
#pragma unroll
        for (int dt = 0; dt < 4; ++dt) {
            LAS unsigned char* a0 = Vb + vlane + (2 * ks) * 2048 + ((dt ^ swz) * 32);
            const bf16x8 vf = tr_frag(a0, a0 + 2048);
            st.o[dt] = __builtin_amdgcn_mfma_f32_16x16x32_bf16(vf, pb[ks], st.o[dt], 0, 0, 0);
        }
        st.ol = __builtin_amdgcn_mfma_f32_16x16x32_bf16(onesf, pb[ks], st.ol, 0, 0, 0);
    }
}
__device__ __forceinline__ bool attn_step2x(LAS unsigned char* Vb, f32x4 (&s)[2][4], AttnRow (&st)[2], int kbase, int g4, const int (&lo)[2], const int (&hi)[2], const bool (&en)[2], const unsigned (&enm)[2], bool emask,
                                            int vlane, int swz, const bf16x8 onesf) {
    float d[2];
    const bool moved = attn_max2x(s, kbase, g4, lo, hi, en, emask, d);
    if (moved) attn_rescale2x(s, st, d);
    bf16x8 p0[2], p1[2];
    attn_exp1(s[0], enm[0], p0);
    attn_pv1(Vb, p0, vlane, swz, onesf, st[0]);
    attn_exp1(s[1], enm[1], p1);
    attn_pv1(Vb, p1, vlane, swz, onesf, st[1]);
    return moved;
}
__device__ __forceinline__ void attn_step2x_nomax(LAS unsigned char* Vb, f32x4 (&s)[2][4], AttnRow (&st)[2], int kbase, int g4, const int (&lo)[2], const int (&hi)[2], const unsigned (&enm)[2], bool emask,
                                                  int vlane, int swz, const bf16x8 onesf) {
    if (emask) {
#pragma unroll
        for (int rb = 0; rb < 2; ++rb)
#pragma unroll
            for (int c = 0; c < 4; ++c)
#pragma unroll
                for (int i = 0; i < 4; ++i) { const int key = kbase + 16 * c + 4 * g4 + i; if (key < lo[rb] || key > hi[rb]) s[rb][c][i] = -INFINITY; }
    }
    bf16x8 p0[2], p1[2];
    attn_exp1(s[0], enm[0], p0);
    attn_pv1(Vb, p0, vlane, swz, onesf, st[0]);
    attn_exp1(s[1], enm[1], p1);
    attn_pv1(Vb, p1, vlane, swz, onesf, st[1]);
}
typedef _Float16 f16x4 __attribute__((ext_vector_type(4)));
constexpr int AT4_KB = 0, AT4_VB = 32768, AT2_PS = 65536, AT2_MSK = 65536 + 65536;
__device__ __forceinline__ void ph_attn_fast2(const Args& a, LAS unsigned char* lds) {
    const bf16_t* QN = (const bf16_t*)(a.ws + WS_HN);
    const bf16_t* QR = (const bf16_t*)(a.ws + WS_QR);
    const bf16_t* KV6 = (const bf16_t*)(a.ws + WS_KV6);
    const float* GATES = (const float*)(a.ws + WS_GATES);
    const bf16_t* KC = (const bf16_t*)(a.ws + WS_KC);
    const bf16_t* VC = KC + (size_t)8192 * 64;
    bf16_t* O = (bf16_t*)(a.ws + WS_O);
    const int tid = threadIdx.x, lane = tid & 63, wave = __builtin_amdgcn_readfirstlane(tid >> 6);
    const int fr = lane & 15, g4 = lane >> 4;
    int ksrc, vsrc;
    { int R, C; pg8::stage_rc(wave * 1024 + lane * 16, R, C); ksrc = R * 64 + C;
      const int key = 8 * wave + (lane >> 3), pos = lane & 7, chunk = (pos >> 1) ^ ((key >> 1) & 3); vsrc = key * 64 + (chunk * 2 + (pos & 1)) * 8; }
    const int vlane = (4 * g4 + (fr >> 2)) * 128 + (fr & 3) * 8, swz = (2 * g4 + (fr >> 3)) & 3;
    LAS _Float16* ps = (LAS _Float16*)(lds + AT2_PS + wave * 8192);
    LAS unsigned* mskl = (LAS unsigned*)(lds + AT2_MSK + wave * 128);
    const float NEG = -INFINITY;
    const bf16x8 onesf = (fr == 0) ? (bf16x8){0x3F80, 0x3F80, 0x3F80, 0x3F80, 0x3F80, 0x3F80, 0x3F80, 0x3F80} : (bf16x8){0, 0, 0, 0, 0, 0, 0, 0};
    const int vcu = (gridDim.x % 8 == 0) ? (int)((blockIdx.x % 8) * (gridDim.x / 8) + blockIdx.x / 8) : (int)blockIdx.x;
    int cvt_next = (int)blockIdx.x * 8 + wave; const int cvt_stride = (int)gridDim.x * 8;
    LAS float* cvt_scr = (LAS float*)(lds + AT2_PS + wave * 8448);
    for (int pr = vcu; pr < 1024; pr += gridDim.x) {
#pragma unroll 1
        for (int half = 0; half < 2; ++half) {
            const int bg = pr >> 6, cc = half ? (127 - (pr & 63)) : (pr & 63);
            const int b = bg >> 2, g = bg & 3, t0 = cc * 64, cur = cc;
            const int head = g * 4 + (fr & 3);
            int trow[2];
            bf16x8 qn[2][2];
#pragma unroll
            for (int rb = 0; rb < 2; ++rb) {
                trow[rb] = t0 + 8 * wave + 4 * rb + (fr >> 2);
#pragma unroll
                for (int ks = 0; ks < 2; ++ks) qn[rb][ks] = *(const bf16x8*)(QN + ((size_t)b * T + trow[rb]) * 1024 + head * 64 + 32 * ks + 8 * g4);
            }
#define TROW_PIN() asm volatile("" : "+v"(trow[0]), "+v"(trow[1]))
#define TOKROW(rb) ((size_t)b * T + trow[rb])
#define GATE(rb, br) (GATES[TOKROW(rb) * 48 + head * 3 + (br)])
            const bf16_t* kcb = KC + (size_t)bg * 512 * 64;
            const bf16_t* kvb = KV6 + (size_t)bg * T * 64;
#define ATK(sl) (((sl) < 4 ? AT4_KB : AT2_PS - 4 * 8192) + (sl) * 8192)
#define ATV(sl) (((sl) < 4 ? AT4_VB : AT2_PS + 32768 - 4 * 8192) + (sl) * 8192)
#define AT_DMA(BR, tile, slot) do { const bf16_t* kp_; const bf16_t* vp_; \
                if ((BR) == 0) { kp_ = kcb + (size_t)(tile) * 4096; vp_ = kp_ + (size_t)8192 * 64; } \
                else { kp_ = kvb + (size_t)((BR) == 1 ? 2 : 4) * 16 * T * 64 + (size_t)(tile) * 4096; vp_ = kp_ + (size_t)16 * T * 64; } \
                __builtin_amdgcn_global_load_lds((const unsigned*)(kp_ + ksrc), (LAS unsigned*)(lds + ATK(slot) + wave * 1024), 16, 0, 0); \
                __builtin_amdgcn_global_load_lds((const unsigned*)(vp_ + vsrc), (LAS unsigned*)(lds + ATV(slot) + wave * 1024), 16, 0, 0); } while (0)
            int ncv[2];
#pragma unroll
            for (int rb = 0; rb < 2; ++rb) ncv[rb] = (trow[rb] >= 31) ? ((trow[rb] - 31) / 16 + 1) : 0;
            const int nct = (((t0 + 63 - 31) / 16 + 1) + 63) >> 6;
            float mc[2], invc[2];
            {
                float m1[2] = {NEG, NEG}, l1[2] = {0.f, 0.f};
                const float zero2[2] = {0.f, 0.f};
#define CMP1_TILE(J, SLOT) do { const int j = (J); const int SLOT_ = (SLOT); \
                    f32x4 s[2][4]; attn_qk2(lds + AT4_KB + SLOT_ * 8192, qn, fr, g4, zero2, s); \
                    _Pragma("unroll") \
                    for (int rb = 0; rb < 2; ++rb) { \
                        float mx = NEG; \
                    _Pragma("unroll") \
                        for (int c = 0; c < 4; ++c) \
                    _Pragma("unroll") \
                            for (int i = 0; i < 4; ++i) { const int n = 64 * j + 16 * c + 4 * g4 + i; if (n >= ncv[rb]) s[rb][c][i] = NEG; mx = fmaxf(mx, s[rb][c][i]); } \
                        mx = fmaxf(mx, __shfl_xor(mx, 16)); mx = fmaxf(mx, __shfl_xor(mx, 32)); \
                        const float mn = fmaxf(m1[rb], mx), msafe = (mn == NEG) ? 0.f : mn; \
                        const float alpha = (m1[rb] == NEG) ? 0.f : __builtin_amdgcn_exp2f(m1[rb] - msafe); \
                        float sum = 0.f; \
                    _Pragma("unroll") \
                        for (int c = 0; c < 4; ++c) \
                    _Pragma("unroll") \
                            for (int i = 0; i < 4; ++i) sum += __builtin_amdgcn_exp2f(s[rb][c][i] - msafe); \
                        l1[rb] = l1[rb] * alpha + sum; m1[rb] = mn; \
                    } \
                } while (0)
                AT_DMA(0, 0, 0); if (nct > 1) AT_DMA(0, 1, 1); __syncthreads();
                for (int j0 = 0; j0 < nct; j0 += 2) { const int sb = (j0 & 2);
                    if (j0 + 2 < nct) AT_DMA(0, j0 + 2, sb ^ 2);
                    if (j0 + 3 < nct) AT_DMA(0, j0 + 3, (sb ^ 2) + 1);
                    CMP1_TILE(j0, sb); if (j0 + 1 < nct) CMP1_TILE(j0 + 1, sb + 1);
                    __syncthreads();
                }
#undef CMP1_TILE
#pragma unroll
                for (int rb = 0; rb < 2; ++rb) { float lc = l1[rb]; lc += __shfl_xor(lc, 16); lc += __shfl_xor(lc, 32); invc[rb] = (lc > 0.f) ? 1.0f / lc : 0.f; mc[rb] = (m1[rb] == NEG) ? 0.f : m1[rb]; }
            }
            {
                AttnRow oc[2];
#pragma unroll
                for (int rb = 0; rb < 2; ++rb) { oc[rb].m = 0.f; oc[rb].ol = (f32x4){0.f, 0.f, 0.f, 0.f};
#pragma unroll
                    for (int dt = 0; dt < 4; ++dt) oc[rb].o[dt] = (f32x4){0.f, 0.f, 0.f, 0.f}; }
                const float cin[2] = {-mc[0], -mc[1]};
                const unsigned full[2] = {0xffffffffu, 0xffffffffu}; const bool both[2] = {true, true};
#define CMP2_TILE(J, SLOT) do { const int j = (J); const int SLOT_ = (SLOT); \
                    f32x4 s[2][4]; attn_qk2(lds + AT4_KB + SLOT_ * 8192, qn, fr, g4, cin, s); \
                    _Pragma("unroll") \
                    for (int rb = 0; rb < 2; ++rb) \
                    _Pragma("unroll") \
                        for (int c = 0; c < 4; ++c) { \
                            f16x4 hs; \
                    _Pragma("unroll") \
                            for (int i = 0; i < 4; ++i) { const int n = 64 * j + 16 * c + 4 * g4 + i; const float p = (n < ncv[rb]) ? __builtin_amdgcn_exp2f(s[rb][c][i]) * invc[rb] : 0.f; s[rb][c][i] = p; \
                                float h = p; h += __shfl_xor(h, 1); h += __shfl_xor(h, 2); hs[i] = (_Float16)h; } \
                            if ((fr & 3) == 0) *(LAS f16x4*)(ps + (4 * rb + (fr >> 2)) * 512 + 64 * j + 16 * c + 4 * g4) = hs; \
                        } \
                    attn_pv2x(lds + AT4_VB + SLOT_ * 8192, s, vlane, swz, full, both, onesf, oc); \
                } while (0)
                AT_DMA(0, 0, 0); if (nct > 1) AT_DMA(0, 1, 1); __syncthreads();
                for (int j0 = 0; j0 < nct; j0 += 2) { const int sb = (j0 & 2);
                    if (j0 + 2 < nct) AT_DMA(0, j0 + 2, sb ^ 2);
                    if (j0 + 3 < nct) AT_DMA(0, j0 + 3, (sb ^ 2) + 1);
                    CMP2_TILE(j0, sb); if (j0 + 1 < nct) CMP2_TILE(j0 + 1, sb + 1);
                    __syncthreads();
                }
#undef CMP2_TILE
                TROW_PIN();
#pragma unroll
                for (int rb = 0; rb < 2; ++rb) { bf16_t* op = O + TOKROW(rb) * 1024 + head * 64 + 4 * g4; const float g0 = GATE(rb, 0);
#pragma unroll
                    for (int dt = 0; dt < 4; ++dt) { const f32x4 v = oc[rb].o[dt] * g0; u32x2 w; w.x = cvt_pk_bf16(v[0], v[1]); w.y = cvt_pk_bf16(v[2], v[3]); *(u32x2*)(op + 16 * dt) = w; } }
            }
            {
                WSYNC();
                const int tl = lane >> 4, li = lane & 15;
                const int nsel = (cur + 1 < 16) ? (cur + 1) : 16;
#pragma unroll 1
                for (int rnd = 0; rnd < 2; ++rnd) {
                    const LAS _Float16* pst = ps + (4 * rnd + tl) * 512;
                    float v[8];
#pragma unroll
                    for (int k = 0; k < 8; ++k) { const int j = li + 16 * k;
                        float x;
                        if (j > cur) x = NEG;
                        else if (j == 0 || j == cur || j == cur - 1) x = INFINITY;
                        else { const int n0 = 4 * j; x = (float)pst[n0 - 1] + 2.0f * ((float)pst[n0] + (float)pst[n0 + 1] + (float)pst[n0 + 2]) + (float)pst[n0 + 3]; }
                        v[k] = x; }
                    int vi[8];
#pragma unroll
                    for (int k = 0; k < 8; ++k) vi[k] = __builtin_bit_cast(int, v[k]);
                    unsigned mm[4] = {0u, 0u, 0u, 0u};
                    for (int it = 0; it < nsel; ++it) {
                        int bv = max(max(max(vi[0], vi[1]), max(vi[2], vi[3])), max(max(vi[4], vi[5]), max(vi[6], vi[7])));
                        bv = max(bv, DPP_I(bv, 0xB1)); bv = max(bv, DPP_I(bv, 0x4E)); bv = max(bv, DPP_I(bv, 0x141)); bv = max(bv, DPP_I(bv, 0x140));
                        int bi = 255;
#pragma unroll
                        for (int k = 7; k >= 0; --k) bi = (vi[k] == bv) ? (li + 16 * k) : bi;
                        bi = min(bi, DPP_I(bi, 0xB1)); bi = min(bi, DPP_I(bi, 0x4E)); bi = min(bi, DPP_I(bi, 0x141)); bi = min(bi, DPP_I(bi, 0x140));
                        const unsigned bit = 1u << (bi & 31); const int wsel = bi >> 5;
                        mm[0] |= (wsel == 0) ? bit : 0u; mm[1] |= (wsel == 1) ? bit : 0u; mm[2] |= (wsel == 2) ? bit : 0u; mm[3] |= (wsel == 3) ? bit : 0u;
                        if ((bi & 15) == li) {
#pragma unroll
                            for (int k = 0; k < 8; ++k) if ((bi >> 4) == k) vi[k] = (int)0xFF800000;
                        }
                    }
                    if (li == 0) { mskl[(4 * rnd + tl) * 4 + 0] = mm[0]; mskl[(4 * rnd + tl) * 4 + 1] = mm[1]; mskl[(4 * rnd + tl) * 4 + 2] = mm[2]; mskl[(4 * rnd + tl) * 4 + 3] = mm[3]; }
                }
                WSYNC();
            }
            bf16x8 qr[2][2];
            TROW_PIN();
#pragma unroll
            for (int rb = 0; rb < 2; ++rb)
#pragma unroll
                for (int ks = 0; ks < 2; ++ks) qr[rb][ks] = *(const bf16x8*)(QR + TOKROW(rb) * 1024 + head * 64 + 32 * ks + 8 * g4);
            bool nomax_slc, nomax_win;
            {
                float qq = 0.f;
#pragma unroll
                for (int rb = 0; rb < 2; ++rb) { float q2 = 0.f;
#pragma unroll
                    for (int ks = 0; ks < 2; ++ks)
#pragma unroll
                        for (int j = 0; j < 8; ++j) { const float x = bf2f((bf16_t)qr[rb][ks][j]); q2 += x * x; }
                    q2 += __shfl_xor(q2, 16); q2 += __shfl_xor(q2, 32); qq = fmaxf(qq, q2); }
                qq = wave_max(qq);
                const float* tn = (const float*)(a.ws + WS_MISC + TN2_OFF) + bg * 128;
                const int jt0w = (t0 >= 511) ? ((t0 - 511) >> 6) : 0;
                float ts = 0.f, tw = 0.f;
#pragma unroll
                for (int h2 = 0; h2 < 2; ++h2) { const int tl_ = lane + 64 * h2; if (tl_ <= cur) { ts = fmaxf(ts, tn[tl_]); if (tl_ >= jt0w) tw = fmaxf(tw, tn[2048 + tl_]); } }
                ts = wave_max(ts); tw = wave_max(tw);
                nomax_slc = __builtin_amdgcn_readfirstlane((qq * ts <= 3500.0f) ? 1 : 0) != 0;
                nomax_win = __builtin_amdgcn_readfirstlane((qq * tw <= 3500.0f) ? 1 : 0) != 0;
            }
            {
                AttnRow ss[2];
#pragma unroll
                for (int rb = 0; rb < 2; ++rb) { ss[rb].m = 0.f; ss[rb].ol = (f32x4){0.f, 0.f, 0.f, 0.f};
#pragma unroll
                    for (int dt = 0; dt < 4; ++dt) ss[rb].o[dt] = (f32x4){0.f, 0.f, 0.f, 0.f}; }
                const int nt_ = cur + 1;
                bool refmoved = false;
#define SLC_PRE(J) const int j_ = (J); bool en[2], act[2]; unsigned enm[2]; \
                    _Pragma("unroll") for (int rb = 0; rb < 2; ++rb) { const unsigned mw = mwg[rb]; \
                        en[rb] = (mw >> (j_ & 31)) & 1u; act[rb] = __any(en[rb]); enm[rb] = en[rb] ? 0xffffffffu : 0u; } const int lo2[2] = {0, 0};
#define SLC_TILE(J, SLOT) do { SLC_PRE(J) \
                    if (act[0] || act[1]) { f32x4 s[2][4]; \
                        if (refmoved) { const float cin[2] = {-ss[0].m, -ss[1].m}; attn_qk2(lds + ATK(SLOT), qr, fr, g4, cin, s); } \
                        else attn_qk2z(lds + ATK(SLOT), qr, fr, g4, s); \
                        refmoved |= attn_step2x(lds + ATV(SLOT), s, ss, 64 * j_, g4, lo2, trow, en, enm, j_ == cur, vlane, swz, onesf); } } while (0)
#define SLC_TILE_NM(J, SLOT) do { SLC_PRE(J) \
                    if (act[0] || act[1]) { f32x4 s[2][4]; attn_qk2z(lds + ATK(SLOT), qr, fr, g4, s); \
                        attn_step2x_nomax(lds + ATV(SLOT), s, ss, 64 * j_, g4, lo2, trow, enm, j_ == cur, vlane, swz, onesf); } } while (0)
#pragma unroll
                for (int i = 0; i < 4; ++i) if (i < nt_) AT_DMA(1, i, i);
                __syncthreads();
#define SLC_LOOP(TILE) for (int j0 = 0; j0 < nt_; j0 += 4) { const int sb = (j0 & 4); \
                    const unsigned mwg[2] = {mskl[(fr >> 2) * 4 + (j0 >> 5)], mskl[(4 + (fr >> 2)) * 4 + (j0 >> 5)]};       \
                    _Pragma("unroll") for (int i = 0; i < 4; ++i) if (j0 + 4 + i < nt_) AT_DMA(1, j0 + 4 + i, (sb ^ 4) + i); \
                    TILE(j0, sb); if (j0 + 1 < nt_) TILE(j0 + 1, sb + 1); if (j0 + 2 < nt_) TILE(j0 + 2, sb + 2); if (j0 + 3 < nt_) TILE(j0 + 3, sb + 3); \
                    __syncthreads(); }
                if (nomax_slc) { SLC_LOOP(SLC_TILE_NM) } else { SLC_LOOP(SLC_TILE) }
#undef SLC_LOOP
#undef SLC_TILE_NM
#undef SLC_PRE
#undef SLC_TILE
                TROW_PIN();
#pragma unroll
                for (int rb = 0; rb < 2; ++rb) { const float l = __shfl(ss[rb].ol[0], fr); const float sc1 = (l > 0.f) ? GATE(rb, 1) / l : 0.f;
                    bf16_t* op = O + TOKROW(rb) * 1024 + head * 64 + 4 * g4;
#pragma unroll
                    for (int dt = 0; dt < 4; ++dt) { const u32x2 pv = *(const u32x2*)(op + 16 * dt); f32x4 v = ss[rb].o[dt] * sc1;
                        v[0] += __uint_as_float(pv.x << 16); v[1] += __uint_as_float(pv.x & 0xffff0000u); v[2] += __uint_as_float(pv.y << 16); v[3] += __uint_as_float(pv.y & 0xffff0000u);
                        u32x2 w; w.x = cvt_pk_bf16(v[0], v[1]); w.y = cvt_pk_bf16(v[2], v[3]); *(u32x2*)(op + 16 * dt) = w; } }
            }
            {
                AttnRow sw[2];
#pragma unroll
                for (int rb = 0; rb < 2; ++rb) { sw[rb].m = 0.f; sw[rb].ol = (f32x4){0.f, 0.f, 0.f, 0.f};
#pragma unroll
                    for (int dt = 0; dt < 4; ++dt) sw[rb].o[dt] = (f32x4){0.f, 0.f, 0.f, 0.f}; }
                const int jt0 = (t0 >= 511) ? ((t0 - 511) >> 6) : 0;
                const int nt_ = cur - jt0 + 1;
                const unsigned full[2] = {0xffffffffu, 0xffffffffu}; const bool both[2] = {true, true};
                bool refmoved = false;
#define WIN_PRE(JJ) const int j = jt0 + (JJ); f32x4 s[2][4]; const bool edge = (j == cur) || (64 * j < t0 + 63 - 511); const int lo2[2] = {trow[0] - 511, trow[1] - 511};
#define WIN_TILE(JJ, SLOT) do { WIN_PRE(JJ) \
                    if (refmoved) { const float cin[2] = {-sw[0].m, -sw[1].m}; attn_qk2(lds + AT4_KB + (SLOT) * 8192, qr, fr, g4, cin, s); } \
                    else attn_qk2z(lds + AT4_KB + (SLOT) * 8192, qr, fr, g4, s); \
                    refmoved |= attn_step2x(lds + AT4_VB + (SLOT) * 8192, s, sw, 64 * j, g4, lo2, trow, both, full, edge, vlane, swz, onesf); } while (0)
#define WIN_TILE_NM(JJ, SLOT) do { WIN_PRE(JJ) attn_qk2z(lds + AT4_KB + (SLOT) * 8192, qr, fr, g4, s); \
                    attn_step2x_nomax(lds + AT4_VB + (SLOT) * 8192, s, sw, 64 * j, g4, lo2, trow, full, edge, vlane, swz, onesf); } while (0)
                AT_DMA(2, jt0, 0); if (nt_ > 1) AT_DMA(2, jt0 + 1, 1); __syncthreads();
#define WIN_LOOP(TILE) for (int j0 = 0; j0 < nt_; j0 += 2) { const int sb = (j0 & 2); \
                    if (j0 + 2 < nt_) AT_DMA(2, jt0 + j0 + 2, sb ^ 2); \
                    if (j0 + 3 < nt_) AT_DMA(2, jt0 + j0 + 3, (sb ^ 2) + 1); \
                    TILE(j0, sb); if (j0 + 1 < nt_) TILE(j0 + 1, sb + 1); \
                    __syncthreads(); }
                if (nomax_win) { WIN_LOOP(WIN_TILE_NM) } else { WIN_LOOP(WIN_TILE) }
#undef WIN_LOOP
#undef WIN_TILE_NM
#undef WIN_PRE
#undef WIN_TILE
                TROW_PIN();
#pragma unroll
                for (int rb = 0; rb < 2; ++rb) { const float l = __shfl(sw[rb].ol[0], fr); const float sc2 = (l > 0.f) ? GATE(rb, 2) / l : 0.f;
                    bf16_t* op = O + TOKROW(rb) * 1024 + head * 64 + 4 * g4;
#pragma unroll
                    for (int dt = 0; dt < 4; ++dt) { const u32x2 pv = *(const u32x2*)(op + 16 * dt); f32x4 v = sw[rb].o[dt] * sc2;
                        v[0] += __uint_as_float(pv.x << 16); v[1] += __uint_as_float(pv.x & 0xffff0000u); v[2] += __uint_as_float(pv.y << 16); v[3] += __uint_as_float(pv.y & 0xffff0000u);
                        u32x2 w; w.x = cvt_pk_bf16(v[0], v[1]); w.y = cvt_pk_bf16(v[2], v[3]); *(u32x2*)(op + 16 * dt) = w; } }
            }
#undef AT_DMA
#undef ATK
#undef ATV
#undef TROW_PIN
#undef TOKROW
#undef GATE
            cvt1_run(a, cvt_next, cvt_stride, 2, cvt_scr, lane);
        }
    }
    cvt1_run(a, cvt_next, cvt_stride, 1 << 20, cvt_scr, lane);
}

__device__ __forceinline__ void unpack8(const u32x4 w, float (&f)[8]) {
    f[0] = __uint_as_float(w.x << 16); f[1] = __uint_as_float(w.x & 0xffff0000u); f[2] = __uint_as_float(w.y << 16); f[3] = __uint_as_float(w.y & 0xffff0000u);
    f[4] = __uint_as_float(w.z << 16); f[5] = __uint_as_float(w.z & 0xffff0000u); f[6] = __uint_as_float(w.w << 16); f[7] = __uint_as_float(w.w & 0xffff0000u);
}
__device__ __forceinline__ void ph_convpool_fast(const Args& a, LAS unsigned char* lds) {
    const bf16_t* H0 = (const bf16_t*)(a.ws + WS_H0);
    bf16_t* CAT = (bf16_t*)(a.ws + WS_CAT);
    const float* cw = a.in[4]; const float* cb = a.in[5]; const float* lg = a.in[6]; const float* lb = a.in[7];
    const int tid = threadIdx.x, lane = tid & 63, wave = tid >> 6, ch = lane * 8;
    constexpr int VT_OFF = 0, UT_OFF = 62 * 1024, CW_OFF = UT_OFF + 47 * 1024;
    for (int i = tid; i < 31 * 64; i += 512) { const int k = i >> 6, c8 = (i & 63) * 8;
        const f32x4 w0 = *(const f32x4*)(cw + k * 512 + c8), w1 = *(const f32x4*)(cw + k * 512 + c8 + 4);
        u32x4 o; o.x = pk2(w0[0], w0[1]); o.y = pk2(w0[2], w0[3]); o.z = pk2(w1[0], w1[1]); o.w = pk2(w1[2], w1[3]);
        *(LAS u32x4*)(lds + CW_OFF + k * 1024 + c8 * 2) = o; }
    float bias[8], gam[8], bet[8];
#pragma unroll
    for (int j = 0; j < 8; ++j) { bias[j] = cb[ch + j]; gam[j] = lg[ch + j]; bet[j] = lb[ch + j]; }
    for (int tile = blockIdx.x; tile < M / 32; tile += gridDim.x) {
        const int tok0 = tile * 32, t0 = tok0 & (T - 1);
        __syncthreads();
        for (int i = tid; i < 62 * 64; i += 512) { const int r = i >> 6, c8 = (i & 63) * 8; const int tt = t0 - 30 + r;
            u32x4 v = (u32x4){0u, 0u, 0u, 0u}; if (tt >= 0) v = *(const u32x4*)(H0 + (size_t)(tok0 - 30 + r) * 1024 + 512 + c8);
            *(LAS u32x4*)(lds + VT_OFF + r * 1024 + c8 * 2) = v; }
        for (int i = tid; i < 47 * 64; i += 512) { const int r = i >> 6, c8 = (i & 63) * 8; const int tt = t0 - 15 + r;
            u32x4 v = (u32x4){0u, 0u, 0u, 0u}; if (tt >= 0) v = *(const u32x4*)(H0 + (size_t)(tok0 - 15 + r) * 1024 + c8);
            *(LAS u32x4*)(lds + UT_OFF + r * 1024 + c8 * 2) = v; }
        __syncthreads();
        float acc[4][8];
#pragma unroll
        for (int j = 0; j < 4; ++j)
#pragma unroll
            for (int c = 0; c < 8; ++c) acc[j][c] = bias[c];
#pragma unroll 1
        for (int k = 0; k < 31; ++k) {
            float w[8]; unpack8(*(const LAS u32x4*)(lds + CW_OFF + k * 1024 + ch * 2), w);
#pragma unroll
            for (int j = 0; j < 4; ++j) { float v[8]; unpack8(*(const LAS u32x4*)(lds + VT_OFF + (4 * wave + j + k) * 1024 + ch * 2), v);
#pragma unroll
                for (int c = 0; c < 8; ++c) acc[j][c] += w[c] * v[c]; }
        }
        const int wnd = 2 << (lane >> 4);
#pragma unroll
        for (int j = 0; j < 4; ++j) {
            const int tl = 4 * wave + j, t = t0 + tl; const size_t tok = (size_t)tok0 + tl;
            const int cnt = (t + 1 < wnd) ? (t + 1) : wnd;
            float s[8], self[8];
            unpack8(*(const LAS u32x4*)(lds + UT_OFF + (15 + tl) * 1024 + ch * 2), self);
#pragma unroll
            for (int c = 0; c < 8; ++c) s[c] = self[c];
            for (int k = 1; k < cnt; ++k) { float v[8]; unpack8(*(const LAS u32x4*)(lds + UT_OFF + (15 + tl - k) * 1024 + ch * 2), v);
#pragma unroll
                for (int c = 0; c < 8; ++c) s[c] += v[c]; }
            const float inv = 1.0f / (float)cnt;
            u32x4 o; o.x = pk2(s[0] * inv - self[0], s[1] * inv - self[1]); o.y = pk2(s[2] * inv - self[2], s[3] * inv - self[3]);
            o.z = pk2(s[4] * inv - self[4], s[5] * inv - self[5]); o.w = pk2(s[6] * inv - self[6], s[7] * inv - self[7]);
            *(u32x4*)(CAT + tok * 1024 + ch) = o;
            float sm = 0.f;
#pragma unroll
            for (int c = 0; c < 8; ++c) sm += acc[j][c];
            const float mean = wave_sum(sm) * (1.0f / 512.0f);
            float sq = 0.f;
#pragma unroll
            for (int c = 0; c < 8; ++c) { acc[j][c] -= mean; sq += acc[j][c] * acc[j][c]; }
            const float rstd = rsqrtf(wave_sum(sq) * (1.0f / 512.0f) + LN_EPS);
            float y[8];
#pragma unroll
            for (int c = 0; c < 8; ++c) { const float z = acc[j][c] * rstd * gam[c] + bet[c]; y[c] = z * sigmoidf_(z); }
            u32x4 o2; o2.x = pk2(y[0], y[1]); o2.y = pk2(y[2], y[3]); o2.z = pk2(y[4], y[5]); o2.w = pk2(y[6], y[7]);
            *(u32x4*)(CAT + tok * 1024 + 512 + ch) = o2;
        }
    }
}


__device__ __forceinline__ void ph_route_fast(const float* LOG, const float* bias, unsigned* gcnt, int2* list, unsigned char* ldsg) {
    unsigned* hist = (unsigned*)ldsg; unsigned* base = hist + 256; u32x2* sel = (u32x2*)(ldsg + 2048);
    const int tid = threadIdx.x, lane = tid & 63, wave = tid >> 6;
    const float NEG = -INFINITY;
    const float4 bb = *(const float4*)(bias + lane * 4);
    for (int chunk = blockIdx.x; chunk < M / 128; chunk += gridDim.x) {
        __syncthreads();
        if (tid < 256) hist[tid] = 0u;
        __syncthreads();
        for (int i = 0; i < 16; ++i) {
            const int tl = wave * 16 + i, tok = chunk * 128 + tl;
            const float4 lg = *(const float4*)(LOG + (size_t)tok * 256 + lane * 4);
            const float s0 = sigmoidf_(lg.x), s1 = sigmoidf_(lg.y), s2 = sigmoidf_(lg.z), s3 = sigmoidf_(lg.w);
            float v0 = s0 + bb.x, v1 = s1 + bb.y, v2 = s2 + bb.z, v3 = s3 + bb.w;
            float m1 = fmaxf(v0, v1), m2 = fminf(v0, v1);
            { const float hi = fmaxf(v2, v3), lo = fminf(v2, v3); const float n1 = fmaxf(m1, hi); const float n2 = fmaxf(fminf(m1, hi), fmaxf(m2, lo)); m1 = n1; m2 = n2; }
#pragma unroll
            for (int o = 1; o < 8; o <<= 1) { const float a1 = __shfl_xor(m1, o), a2 = __shfl_xor(m2, o); const float n1 = fmaxf(m1, a1), n2 = fmaxf(fminf(m1, a1), fmaxf(m2, a2)); m1 = n1; m2 = n2; }
            const float gs = m1 + m2; const int mygrp = lane >> 3;
            int rank = 0;
#pragma unroll
            for (int g2 = 0; g2 < 8; ++g2) { const float og = __shfl(gs, g2 * 8); rank += (og > gs || (og == gs && g2 < mygrp)) ? 1 : 0; }
            if (rank >= 4) { v0 = NEG; v1 = NEG; v2 = NEG; v3 = NEG; }
            int my_e = 0; float my_s = 0.f;
#pragma unroll
            for (int it = 0; it < 8; ++it) {
                float bv = v0; int bj = 0;
                if (v1 > bv) { bv = v1; bj = 1; }
                if (v2 > bv) { bv = v2; bj = 2; }
                if (v3 > bv) { bv = v3; bj = 3; }
                int bi = lane * 4 + bj;
#pragma unroll
                for (int o = 1; o < 64; o <<= 1) { const float ov = __shfl_xor(bv, o); const int oi = __shfl_xor(bi, o); if (ov > bv || (ov == bv && oi < bi)) { bv = ov; bi = oi; } }
                const int jj = bi & 3, ol = bi >> 2;
                const float mys = (jj == 0) ? s0 : (jj == 1) ? s1 : (jj == 2) ? s2 : s3;
                const float wsc = __shfl(mys, ol);
                if (lane == ol) { if (jj == 0) v0 = NEG; else if (jj == 1) v1 = NEG; else if (jj == 2) v2 = NEG; else v3 = NEG; }
                if (lane == it) { my_e = bi; my_s = wsc; }
            }
            const float ssum = wave_sum(lane < 8 ? my_s : 0.f);
            if (lane < 8) { const unsigned rk = atomicAdd(&hist[my_e], 1u); u32x2 en; en.x = (unsigned)my_e | (rk << 16); en.y = __float_as_uint(my_s / ssum * 2.5f); sel[tl * 8 + lane] = en; }
        }
        __syncthreads();
        if (tid < 256) { const unsigned h = hist[tid]; base[tid] = h ? atomicAdd(&gcnt[tid], h) : 0u; }
        __syncthreads();
#pragma unroll
        for (int rep = 0; rep < 2; ++rep) { const int idx = tid + rep * 512, tok = chunk * 128 + (idx >> 3), k = idx & 7;
            const u32x2 en = sel[idx]; const unsigned e = en.x & 0xffffu, pos = base[e] + (en.x >> 16);
            list[(size_t)e * LISTCAP + pos] = make_int2(tok * 10 + k, (int)en.y); }
    }
}

__global__ void __launch_bounds__(512, 2) fwd_kernel(Args a) {
    extern __shared__ __attribute__((aligned(16))) unsigned char lds[];
    volatile LAS unsigned* MISC = (volatile LAS unsigned*)((LAS unsigned char*)lds + (LDS_BYTES - 64));
    if (threadIdx.x < 16) MISC[threadIdx.x] = 0u;
    __syncthreads();
    unsigned* ctl = (unsigned*)(a.ws + WS_CTL);
#if MK_ONE_LAUNCH
    (void)xcd_barrier_post(ctl + CW_BAR, MISC + 8);
#define SEAM() do { XcdBarrier b_; b_.bar = (unsigned*)(a.ws + WS_CTL) + CW_BAR; b_.x = xb_xcc_id(); b_.st = MISC + 8; xcd_barrier(b_); } while (0)
#else
#define SEAM() do {} while (0)
#endif
    const int lo = a.ph_lo, hi = a.ph_hi;
#define IN(k) (lo <= (k) && (k) < hi)
#define BOTH(k) (IN(k) && (k) + 1 < hi)
#define X1 ((bf16_t*)(a.ws + WS_X1))
#define X2 ((bf16_t*)(a.ws + WS_X2))
#define LOG ((float*)(a.ws + WS_LOG))

    LAS unsigned char* L = (LAS unsigned char*)lds;
#define LIST ((int2*)(a.ws + WS_LIST))
#ifndef PROBE_DUP_MASK
#define PROBE_DUP_MASK 0u
#endif
#define RUN(k, ...) if (IN(k)) { { __VA_ARGS__ } if ((PROBE_DUP_MASK >> (k)) & 1u) { __syncthreads(); { __VA_ARGS__ } } if (BOTH(k)) SEAM(); }
    RUN(0, ph_prologue(a, L);)
    RUN(1, pg8::DenseSched S; S.init((const bf16_t*)(a.ws + WS_XA), D, (const bf16_t*)(a.ws + WS_WIN0), D, M, 1536);
           EpiInproj0 E{(bf16_t*)(a.ws + WS_H0)};
           pg8::gemm_phase<EpiInproj0, pg8::DenseSched, true>(L, D, 128u, S, E);)
    RUN(2, ph_convpool_fast(a, L);)
    RUN(4, pg8::DenseSched S; S.init((const bf16_t*)(a.ws + WS_CAT), D, (const bf16_t*)(a.ws + WS_WOUT0), D, M, D);
           EpiRes E{a.in[0], nullptr, (bf16_t*)(a.ws + WS_Y)};
           pg8::gemm_phase<EpiRes, pg8::DenseSched, true>(L, D, 128u, S, E);)
    RUN(5, ph_ln((const bf16_t*)(a.ws + WS_Y), a.in[17], a.in[18], X1, (unsigned char*)(a.ws + WS_X8));)
#define MOE_LAYER(P, LAYER, XIN, XOUT, OUTF) \
    RUN(P, pg8::DenseSched S; S.init(XIN, D, (const bf16_t*)(a.ws + WS_WR) + (size_t)(LAYER) * NE * D, D, M, NE); \
           EpiLogits E{LOG}; pg8::gemm_phase<EpiLogits, pg8::DenseSched, true>(L, D, 128u, S, E);) \
    if (IN(P + 1)) { ph_route_fast(LOG, a.in[22] + (LAYER) * NE, ctl + CW_CNT + (LAYER) * 256, LIST, lds); if (BOTH(P + 1)) SEAM(); } \
    RUN(P + 2, const int R = moe_setup256(ctl + CW_CNT + (LAYER) * 256, L); \
            MoeGuSched S{(const char*)(a.ws + WS_X8), (const char*)(a.ws + WS_WGU) + (size_t)(LAYER) * 257 * 512 * 1024, LIST, L, R, (R + 128) * 2, (int)gridDim.x, (int)blockIdx.x}; \
            S.prepare(); EpiGateUp E{(unsigned char*)(a.ws + WS_HID)}; pg8::gemm_phase<EpiGateUp, MoeGuSched, true, true>(L, D / 2, 128u, S, E);) \
    RUN(P + 3, const int R = moe_setup256(ctl + CW_CNT + (LAYER) * 256, L); \
            MoeDownSched S{(const char*)(a.ws + WS_HID), (const char*)(a.ws + WS_WD) + (size_t)(LAYER) * 257 * 1024 * 256, LIST, L, R, R + 128, (int)gridDim.x, (int)blockIdx.x}; \
            S.prepare(); EpiDown E{(unsigned char*)(a.ws + WS_YB), L}; pg8::gemm_phase<EpiDown, MoeDownSched, true, true>(L, FF / 2, 128u, S, E);) \
    RUN(P + 4, ph_combine(a, XIN, a.in[19] + (LAYER) * D, a.in[20] + (LAYER) * D, XOUT, OUTF);)
    MOE_LAYER(6, 0, X1, X2, nullptr)
    RUN(11, pg8::DenseSched S; S.init(X2, D, (const bf16_t*)(a.ws + WS_WINN), D, M, HNW);
            EpiInprojN E{(bf16_t*)(a.ws + WS_HN), (bf16_t*)(a.ws + WS_QR), (bf16_t*)(a.ws + WS_KV6), (float*)(a.ws + WS_GATES), (const float*)(a.ws + WS_MISC) + 1024};
            pg8::gemm_phase<EpiInprojN, pg8::DenseSched, true>(L, D, 128u, S, E);)
    RUN(13, Cmp1Sched S{(const char*)(a.ws + WS_KV6), (const char*)(a.ws + WS_CW1), (int)gridDim.x, (int)blockIdx.x};
            EpiCmp1 E{(bf16_t*)(a.ws + WS_CH1), (const float*)(a.ws + WS_MISC)};
            pg8::gemm_phase<EpiCmp1, Cmp1Sched, true>(L, 2048, 128u, S, E); ph_knorm(a);)
    RUN(14, ph_cmp2(a, lds);)
    RUN(15, ph_attn_fast2(a, L);)
    RUN(16, pg8::DenseSched S; S.init((const bf16_t*)(a.ws + WS_O), D, (const bf16_t*)(a.ws + WS_WOUTN), D, M, D);
            EpiRes E{nullptr, X2, (bf16_t*)(a.ws + WS_Y2)};
            pg8::gemm_phase<EpiRes, pg8::DenseSched, true>(L, D, 128u, S, E);)
    RUN(17, ph_ln((const bf16_t*)(a.ws + WS_Y2), a.in[17] + D, a.in[18] + D, X1, (unsigned char*)(a.ws + WS_X8));)
    MOE_LAYER(18, 1, X1, (bf16_t*)nullptr, a.out)
}

extern "C" void kernel_launch(void* const* d_in, const int* in_sizes, int n_in, void* d_out, int out_size, void* d_ws, size_t ws_size, hipStream_t stream) {
    static int grid = 0;
    if (grid == 0) {
        if (n_in != 29 || out_size != M * D || ws_size < WS_END) { fprintf(stderr, "kernel_launch: unexpected problem (n_in %d out %d ws %zu)\n", n_in, out_size, ws_size); grid = -1; return; }
        int dev = 0, cus = 0;
        if (hipGetDevice(&dev) != hipSuccess || hipDeviceGetAttribute(&cus, hipDeviceAttributeMultiprocessorCount, dev) != hipSuccess) { grid = -1; return; }
        if (hipFuncSetAttribute((const void*)fwd_kernel, hipFuncAttributeMaxDynamicSharedMemorySize, LDS_BYTES) != hipSuccess) { grid = -1; return; }
        int per_cu = 0;
        (void)hipOccupancyMaxActiveBlocksPerMultiprocessor(&per_cu, (const void*)fwd_kernel, 512, LDS_BYTES);
        (void)hipGetLastError();
        grid = cus;
    }
    if (grid < 0) return;
    (void)hipMemsetAsync((char*)d_ws + WS_CTL, 0, CTL_BYTES, stream);
    Args a{};
    for (int i = 0; i < 29; ++i) a.in[i] = (const float*)d_in[i];
    a.out = (float*)d_out; a.ws = (unsigned char*)d_ws;
    for (int i = 0; i < 8; ++i) a.inv_freq[i] = powf(500000.0f, -(float)(2 * i) / 16.0f);
#if MK_ONE_LAUNCH
    a.ph_lo = 0; a.ph_hi = NPHASE;
    hipLaunchKernelGGL(fwd_kernel, dim3(grid), dim3(512), LDS_BYTES, stream, a);
#else
    for (int p = 0; p < NPHASE; ++p) { a.ph_lo = p; a.ph_hi = p + 1; hipLaunchKernelGGL(fwd_kernel, dim3(grid), dim3(512), LDS_BYTES, stream, a); }
#endif
}
```

```cpp
#include <hip/hip_runtime.h>
#include <cstdint>
#include <cstdio>
#include <cmath>

#ifndef MK_ONE_LAUNCH
#define MK_ONE_LAUNCH 1
#endif

#define LAS __attribute__((address_space(3)))
typedef unsigned short bf16_t;
typedef short bf16x8 __attribute__((ext_vector_type(8)));
typedef float f32x4 __attribute__((ext_vector_type(4)));
typedef unsigned u32x2 __attribute__((ext_vector_type(2)));
typedef unsigned u32x4 __attribute__((ext_vector_type(4)));

constexpr int NB = 4, T = 8192, D = 1024, M = NB * T;
constexpr int NE = 256, TOPK = 8, FF = 256;
constexpr int HNW = 2816;
constexpr int LISTCAP = 32768;
constexpr float ALPHA = 1.4142135623730951f;
constexpr float LN_EPS = 1e-5f;
constexpr float QSCALE = 0.125f * 1.4426950408889634f;
constexpr int YB_NSLOT = 9;
constexpr float YB_SCALE = 16.0f;
constexpr int NPHASE = 23;

constexpr size_t MiB = 1u << 20;
constexpr size_t WS_CTL = 0, CTL_BYTES = 1 * MiB;
constexpr size_t WS_X1 = 1 * MiB;
constexpr size_t WS_X2 = WS_X1 + 64 * MiB;
constexpr size_t WS_LOG = WS_X2 + 64 * MiB;
constexpr size_t WS_LIST = WS_LOG + 32 * MiB;
constexpr size_t WS_WTS = WS_LIST + 64 * MiB;
constexpr size_t WS_HID = WS_WTS + 2 * MiB;
constexpr size_t WS_YB = WS_HID + 184 * MiB;
constexpr size_t WS_END_NAIVE = WS_YB + 576 * MiB;
constexpr size_t WS_WIN0 = WS_END_NAIVE;
constexpr size_t WS_WOUT0 = WS_WIN0 + 3 * MiB;
constexpr size_t WS_WINN = WS_WOUT0 + 2 * MiB;
constexpr size_t WS_WOUTN = WS_WINN + 6 * MiB;
constexpr size_t WS_WR = WS_WOUTN + 2 * MiB;
constexpr size_t WS_CW1 = WS_WR + 1 * MiB;
constexpr size_t WS_MISC = WS_CW1 + 2 * MiB;
constexpr size_t WS_WGU = WS_MISC + 1 * MiB;
constexpr size_t WS_X8 = WS_WGU + 257 * MiB;
constexpr float X8_SCALE = 8.0f, W8_SCALE = 64.0f, H8_SCALE = 16.0f;
constexpr size_t WS_WD = WS_WGU + 514 * MiB;
constexpr size_t WS_END = WS_WD + 257 * MiB;
constexpr size_t WS_XA = WS_X2;
constexpr size_t WS_H0 = WS_YB;
constexpr size_t WS_PM = WS_H0 + 64 * MiB;
constexpr size_t WS_CAT = WS_PM + 32 * MiB;
constexpr size_t WS_Y = WS_CAT + 64 * MiB;
constexpr size_t WS_HN = WS_YB;
constexpr size_t WS_KV6 = WS_HN + 64 * MiB;
constexpr size_t WS_QR = WS_HN + 176 * MiB;
constexpr size_t WS_GATES = WS_QR + 64 * MiB;
constexpr size_t WS_CH1 = WS_GATES + 8 * MiB;
constexpr size_t WS_KC = WS_CH1 + 4 * MiB;
constexpr size_t WS_O = WS_KC + 2 * MiB;
constexpr size_t WS_Y2 = WS_O + 64 * MiB;
static_assert(WS_Y2 + 64 * MiB <= WS_END_NAIVE, "overlay");
static_assert(WS_Y + 64 * MiB <= WS_END_NAIVE, "overlay");

constexpr int CW_CNT = 64;
constexpr int CW_BAR = 4096;

constexpr int LDS_BYTES = 163840;

__device__ __forceinline__ float bf2f(bf16_t h) { return __uint_as_float(((unsigned)h) << 16); }
__device__ __forceinline__ bf16_t f2bf(float f) { unsigned u = __float_as_uint(f); return (bf16_t)((u + 0x7fffu + ((u >> 16) & 1u)) >> 16); }
__device__ __forceinline__ unsigned pk2(float lo, float hi) { return (unsigned)f2bf(lo) | ((unsigned)f2bf(hi) << 16); }
__device__ __forceinline__ float wave_sum(float v) {
#pragma unroll
    for (int o = 1; o < 64; o <<= 1) v += __shfl_xor(v, o);
    return v;
}
__device__ __forceinline__ float wave_max(float v) {
#pragma unroll
    for (int o = 1; o < 64; o <<= 1) v = fmaxf(v, __shfl_xor(v, o));
    return v;
}
__device__ __forceinline__ float sigmoidf_(float x) { return 1.0f / (1.0f + __expf(-x)); }
__device__ __forceinline__ float gelu_tanh(float x) {
    const float u = 0.7978845608028654f * (x + 0.044715f * x * x * x);
    const float e = __expf(2.0f * u);
    const float th = 1.0f - 2.0f / (e + 1.0f);
    return 0.5f * x * (1.0f + th);
}
__device__ __forceinline__ bf16x8 cvt8(const float* p) {
    const float4 a = *(const float4*)p, b = *(const float4*)(p + 4);
    bf16x8 r;
    r[0] = (short)f2bf(a.x); r[1] = (short)f2bf(a.y); r[2] = (short)f2bf(a.z); r[3] = (short)f2bf(a.w);
    r[4] = (short)f2bf(b.x); r[5] = (short)f2bf(b.y); r[6] = (short)f2bf(b.z); r[7] = (short)f2bf(b.w);
    return r;
}
__device__ __forceinline__ bf16x8 colk8(const float* W, int N, int k, int col) {
    bf16x8 r;
#pragma unroll
    for (int j = 0; j < 8; ++j) r[j] = (short)f2bf(W[(size_t)(k + j) * N + col]);
    return r;
}
__device__ __forceinline__ bf16x8 zero8() { return (bf16x8){0, 0, 0, 0, 0, 0, 0, 0}; }
#define WSYNC() asm volatile("s_waitcnt lgkmcnt(0)" ::: "memory")

#define XB_TMO      128
#define XB_XCNT(j)  (256  + 64 * (j))
#define XB_XSUB(j)  (1280 + 64 * (j))
#define XB_XGEN(j)  (2304 + 64 * (j))
#define XB_TOP      3328
#define XB_TOPGEN   3392
#define XCD_BAR_WORDS 3456
#define XB_SPIN_CAP (1u << 22)
__device__ __forceinline__ unsigned xb_ld(unsigned* p)              { return __hip_atomic_load(p, __ATOMIC_RELAXED, __HIP_MEMORY_SCOPE_AGENT); }
__device__ __forceinline__ unsigned xb_add(unsigned* p, unsigned v) { return __hip_atomic_fetch_add(p, v, __ATOMIC_RELAXED, __HIP_MEMORY_SCOPE_AGENT); }
__device__ __forceinline__ unsigned xb_xcc_id() { return (unsigned)__builtin_amdgcn_s_getreg((3 << 11) | 20) & 0xFu; }
#define XB_SPIN(cond, bar) do { unsigned _sp = 0; while (cond) { __builtin_amdgcn_s_sleep(1); \
    if ((++_sp & 255u) == 0u) { if (xb_ld(&(bar)[XB_TMO])) break; if (_sp > XB_SPIN_CAP) { atomicAdd(&(bar)[XB_TMO], 1u); break; } } } } while (0)
struct XcdBarrier { unsigned* bar; unsigned x; volatile LAS unsigned* st; };
__device__ __forceinline__ XcdBarrier xcd_barrier_post(unsigned* bar, volatile LAS unsigned* st) {
    XcdBarrier b; b.bar = bar; b.x = xb_xcc_id(); b.st = st;
    if (threadIdx.x == 0) (void)xb_add(&bar[XB_XCNT(b.x)], 1u);
    return b;
}
__device__ __forceinline__ void xcd_barrier_complete(unsigned* bar, unsigned x, unsigned& nloc, unsigned& nx) {
    const unsigned G = gridDim.x * gridDim.y * gridDim.z;
    unsigned sum, cnt, mine, sp = 0u;
    for (;;) {
        sum = 0u; cnt = 0u; mine = 0u;
#pragma unroll
        for (unsigned j = 0; j < 16; ++j) { const unsigned c = xb_ld(&bar[XB_XCNT(j)]); sum += c; cnt += (c > 0u) ? 1u : 0u; mine = (j == x) ? c : mine; }
        if (sum == G) break;
        __builtin_amdgcn_s_sleep(1);
        if ((++sp & 255u) == 0u) { if (xb_ld(&bar[XB_TMO])) break; if (sp > XB_SPIN_CAP) { atomicAdd(&bar[XB_TMO], 1u); break; } }
    }
    nloc = mine > 0u ? mine : 1u; nx = cnt > 0u ? cnt : 1u;
}
__device__ __forceinline__ void xcd_barrier(const XcdBarrier& b) {
    asm volatile("s_waitcnt vmcnt(0)" ::: "memory");
    __syncthreads();
    if (threadIdx.x == 0) {
        unsigned* bar = b.bar;
        __builtin_amdgcn_s_waitcnt(0);
        unsigned nloc = b.st[0], nx = b.st[1];
        if (nloc == 0u) { xcd_barrier_complete(bar, b.x, nloc, nx); b.st[0] = nloc; b.st[1] = nx; }
        const unsigned old = xb_add(&bar[XB_XSUB(b.x)], 1u);
        const unsigned gen = old / nloc;
        if (old + 1u == (gen + 1u) * nloc) {
            __builtin_amdgcn_fence(__ATOMIC_RELEASE, "agent");
            asm volatile("s_waitcnt vmcnt(0)" ::: "memory");
            const unsigned og = xb_add(&bar[XB_TOP], 1u);
            const unsigned tg = og / nx;
            if (og + 1u == (tg + 1u) * nx) xb_add(&bar[XB_TOPGEN], 1u);
            else XB_SPIN(xb_ld(&bar[XB_TOPGEN]) == tg, bar);
            __builtin_amdgcn_fence(__ATOMIC_ACQUIRE, "agent");
            xb_add(&bar[XB_XGEN(b.x)], 1u);
            asm volatile("s_waitcnt vmcnt(0)" ::: "memory");
        } else {
            XB_SPIN(xb_ld(&bar[XB_XGEN(b.x)]) == gen, bar);
            __builtin_amdgcn_fence(__ATOMIC_ACQUIRE, "agent");
            asm volatile("s_waitcnt vmcnt(0)" ::: "memory");
        }
    }
    __syncthreads();
}

template <class AL, class BL, class EP>
__device__ __forceinline__ void mgemm_tile(unsigned char* lds, int K, const AL& al, const BL& bl, const EP& ep) {
    bf16_t* As = (bf16_t*)lds;
    bf16_t* Bs = As + 128 * 40;
    const int tid = threadIdx.x, lane = tid & 63, wave = tid >> 6;
    const int ar = tid >> 2, ac = (tid & 3) * 8;
    const int bn = tid & 127, bc = (tid >> 7) * 8;
    f32x4 acc[8];
#pragma unroll
    for (int s = 0; s < 8; ++s) acc[s] = (f32x4){0.f, 0.f, 0.f, 0.f};
    bf16x8 ra = al(ac), rb = bl(bc);
    for (int k0 = 0; k0 < K; k0 += 32) {
        __syncthreads();
        *(bf16x8*)(As + ar * 40 + ac) = ra;
        *(bf16x8*)(Bs + bn * 40 + bc) = rb;
        __syncthreads();
        if (k0 + 32 < K) { ra = al(k0 + 32 + ac); rb = bl(k0 + 32 + bc); }
        const bf16x8 af = *(const bf16x8*)(As + (wave * 16 + (lane & 15)) * 40 + (lane >> 4) * 8);
#pragma unroll
        for (int s = 0; s < 8; ++s) {
            const bf16x8 wf = *(const bf16x8*)(Bs + (16 * s + (lane & 15)) * 40 + (lane >> 4) * 8);
            acc[s] = __builtin_amdgcn_mfma_f32_16x16x32_bf16(wf, af, acc[s], 0, 0, 0);
        }
    }
    ep(wave * 16 + (lane & 15), (lane >> 4) * 4, acc);
}
__device__ __forceinline__ void store4bf(bf16_t* p, const f32x4 v) { u32x2 w; w.x = pk2(v[0], v[1]); w.y = pk2(v[2], v[3]); *(u32x2*)p = w; }

struct Args {
    const float* in[29];
    float* out;
    unsigned char* ws;
    float inv_freq[8];
    int ph_lo, ph_hi;
};

__device__ __forceinline__ unsigned pk4_fp8(float a, float b, float c, float d) { int w = __builtin_amdgcn_cvt_pk_fp8_f32(a, b, 0, false); return (unsigned)__builtin_amdgcn_cvt_pk_fp8_f32(c, d, w, true); }
__device__ __forceinline__ u32x2 pack8_fp8(const f32x4 v0, const f32x4 v1) {
    int a = __builtin_amdgcn_cvt_pk_fp8_f32(v0[0], v0[1], 0, false); a = __builtin_amdgcn_cvt_pk_fp8_f32(v0[2], v0[3], a, true);
    int b = __builtin_amdgcn_cvt_pk_fp8_f32(v1[0], v1[1], 0, false); b = __builtin_amdgcn_cvt_pk_fp8_f32(v1[2], v1[3], b, true);
    u32x2 w; w.x = (unsigned)a; w.y = (unsigned)b; return w;
}
__device__ __forceinline__ float clamp8(float v) { return __builtin_amdgcn_fmed3f(v, -448.0f, 448.0f); }
__device__ __forceinline__ void ph_ln(const bf16_t* Y, const float* g, const float* b, bf16_t* X, unsigned char* X8) {
    const int lane = threadIdx.x & 63, wave = threadIdx.x >> 6;
    const int gw = blockIdx.x * 8 + wave, ngw = gridDim.x * 8;
    float gg[16], bb[16];
#pragma unroll
    for (int j = 0; j < 8; ++j) { gg[j] = g[lane * 8 + j]; gg[8 + j] = g[512 + lane * 8 + j]; bb[j] = b[lane * 8 + j]; bb[8 + j] = b[512 + lane * 8 + j]; }
    for (int row0 = gw * 4; row0 < M; row0 += ngw * 4) {
        bf16x8 p0[4], p1[4];
#pragma unroll
        for (int r = 0; r < 4; ++r) { p0[r] = __builtin_nontemporal_load((const bf16x8*)(Y + (size_t)(row0 + r) * 1024 + lane * 8)); p1[r] = __builtin_nontemporal_load((const bf16x8*)(Y + (size_t)(row0 + r) * 1024 + 512 + lane * 8)); }
#pragma unroll
        for (int r = 0; r < 4; ++r) {
            float v[16];
#pragma unroll
            for (int j = 0; j < 8; ++j) { v[j] = bf2f((bf16_t)p0[r][j]); v[8 + j] = bf2f((bf16_t)p1[r][j]); }
            float s = 0.f;
#pragma unroll
            for (int j = 0; j < 16; ++j) s += v[j];
            const float mean = wave_sum(s) * (1.0f / 1024.0f);
            float q = 0.f;
#pragma unroll
            for (int j = 0; j < 16; ++j) { v[j] -= mean; q += v[j] * v[j]; }
            const float rstd = rsqrtf(wave_sum(q) * (1.0f / 1024.0f) + LN_EPS);
            float o[16];
#pragma unroll
            for (int j = 0; j < 16; ++j) o[j] = v[j] * rstd * gg[j] + bb[j];
            u32x4 w0, w1;
            w0.x = pk2(o[0], o[1]); w0.y = pk2(o[2], o[3]); w0.z = pk2(o[4], o[5]); w0.w = pk2(o[6], o[7]);
            w1.x = pk2(o[8], o[9]); w1.y = pk2(o[10], o[11]); w1.z = pk2(o[12], o[13]); w1.w = pk2(o[14], o[15]);
            *(u32x4*)(X + (size_t)(row0 + r) * 1024 + lane * 8) = w0; *(u32x4*)(X + (size_t)(row0 + r) * 1024 + 512 + lane * 8) = w1;
#pragma unroll
            for (int j = 0; j < 16; ++j) o[j] = clamp8(o[j] * X8_SCALE);
            u32x2 q0, q1; q0.x = pk4_fp8(o[0], o[1], o[2], o[3]); q0.y = pk4_fp8(o[4], o[5], o[6], o[7]); q1.x = pk4_fp8(o[8], o[9], o[10], o[11]); q1.y = pk4_fp8(o[12], o[13], o[14], o[15]);
            *(u32x2*)(X8 + (size_t)(row0 + r) * 1024 + lane * 8) = q0; *(u32x2*)(X8 + (size_t)(row0 + r) * 1024 + 512 + lane * 8) = q1;
        }
    }
}

__device__ __forceinline__ void ph_combine(const Args& a, const bf16_t* X, const float* g, const float* b, bf16_t* Xo, float* outf) {
    const unsigned char* YB = (const unsigned char*)(a.ws + WS_YB);
    const int lane = threadIdx.x & 63, wave = threadIdx.x >> 6;
    const int gw = blockIdx.x * 8 + wave, ngw = gridDim.x * 8;
    for (int row = gw; row < M; row += ngw) {
        float v[16];
#pragma unroll
        for (int j = 0; j < 16; ++j) v[j] = 0.f;
        u32x2 q0[YB_NSLOT], q1[YB_NSLOT];
#pragma unroll
        for (int k = 0; k < YB_NSLOT; ++k) { const unsigned char* yr = YB + ((size_t)row * 10 + k) * 1024; q0[k] = __builtin_nontemporal_load((const u32x2*)(yr + lane * 8)); q1[k] = __builtin_nontemporal_load((const u32x2*)(yr + 512 + lane * 8)); }
#pragma unroll
        for (int k = 0; k < YB_NSLOT; ++k) {
            const auto a0 = __builtin_amdgcn_cvt_pk_f32_fp8((int)q0[k].x, false), a1 = __builtin_amdgcn_cvt_pk_f32_fp8((int)q0[k].x, true), a2 = __builtin_amdgcn_cvt_pk_f32_fp8((int)q0[k].y, false), a3 = __builtin_amdgcn_cvt_pk_f32_fp8((int)q0[k].y, true);
            const auto b0 = __builtin_amdgcn_cvt_pk_f32_fp8((int)q1[k].x, false), b1 = __builtin_amdgcn_cvt_pk_f32_fp8((int)q1[k].x, true), b2 = __builtin_amdgcn_cvt_pk_f32_fp8((int)q1[k].y, false), b3 = __builtin_amdgcn_cvt_pk_f32_fp8((int)q1[k].y, true);
            v[0] += a0[0]; v[1] += a0[1]; v[2] += a1[0]; v[3] += a1[1]; v[4] += a2[0]; v[5] += a2[1]; v[6] += a3[0]; v[7] += a3[1];
            v[8] += b0[0]; v[9] += b0[1]; v[10] += b1[0]; v[11] += b1[1]; v[12] += b2[0]; v[13] += b2[1]; v[14] += b3[0]; v[15] += b3[1];
        }
        {
            const bf16x8 p0 = *(const bf16x8*)(X + (size_t)row * 1024 + lane * 8), p1 = *(const bf16x8*)(X + (size_t)row * 1024 + 512 + lane * 8);
#pragma unroll
            for (int j = 0; j < 8; ++j) { v[j] = v[j] * (1.0f / YB_SCALE) + ALPHA * bf2f((bf16_t)p0[j]); v[8 + j] = v[8 + j] * (1.0f / YB_SCALE) + ALPHA * bf2f((bf16_t)p1[j]); }
        }
        float s = 0.f;
#pragma unroll
        for (int j = 0; j < 16; ++j) s += v[j];
        const float mean = wave_sum(s) * (1.0f / 1024.0f);
        float q = 0.f;
#pragma unroll
        for (int j = 0; j < 16; ++j) { v[j] -= mean; q += v[j] * v[j]; }
        const float rstd = rsqrtf(wave_sum(q) * (1.0f / 1024.0f) + LN_EPS);
        float o[16];
#pragma unroll
        for (int j = 0; j < 8; ++j) { o[j] = v[j] * rstd * g[lane * 8 + j] + b[lane * 8 + j]; o[8 + j] = v[8 + j] * rstd * g[512 + lane * 8 + j] + b[512 + lane * 8 + j]; }
        if (outf) {
            float* op = outf + (size_t)row * 1024;
            *(float4*)(op + lane * 8) = make_float4(o[0], o[1], o[2], o[3]); *(float4*)(op + lane * 8 + 4) = make_float4(o[4], o[5], o[6], o[7]);
            *(float4*)(op + 512 + lane * 8) = make_float4(o[8], o[9], o[10], o[11]); *(float4*)(op + 512 + lane * 8 + 4) = make_float4(o[12], o[13], o[14], o[15]);
        } else {
            u32x4 w0, w1;
            w0.x = pk2(o[0], o[1]); w0.y = pk2(o[2], o[3]); w0.z = pk2(o[4], o[5]); w0.w = pk2(o[6], o[7]);
            w1.x = pk2(o[8], o[9]); w1.y = pk2(o[10], o[11]); w1.z = pk2(o[12], o[13]); w1.w = pk2(o[14], o[15]);
            *(u32x4*)(Xo + (size_t)row * 1024 + lane * 8) = w0; *(u32x4*)(Xo + (size_t)row * 1024 + 512 + lane * 8) = w1;
        }
    }
}

__device__ __forceinline__ void ph_cmp2(const Args& a, unsigned char* lds) {
    const bf16_t* CH1 = (const bf16_t*)(a.ws + WS_CH1);
    bf16_t* KC = (bf16_t*)(a.ws + WS_KC);
    const int tid = threadIdx.x;
    for (int u = blockIdx.x; u < 64 * 2; u += gridDim.x) {
        const int rt = u >> 1, kv = u & 1;
        const bf16_t* ar = CH1 + ((size_t)kv * 8192 + rt * 128 + (tid >> 2)) * 128;
        const float* w2 = a.in[kv ? 15 : 12];
        const int col = tid & 127;
        auto al = [&](int k) { return *(const bf16x8*)(ar + k); };
        auto bl = [&](int k) { return (col < 64) ? colk8(w2, 64, k, col) : zero8(); };
        auto ep = [&](int r, int cb, const f32x4 (&acc)[8]) {
            bf16_t* o = KC + ((size_t)kv * 8192 + rt * 128 + r) * 64;
#pragma unroll
            for (int s = 0; s < 4; ++s) store4bf(o + 16 * s + cb, acc[s]);
        };
        mgemm_tile(lds, 128, al, bl, ep);
    }
}

namespace pg8 {
constexpr int BM = 256, BK = 64, HALF = 128, HTB = HALF * BK * 2, STAGE_BYTES = 8 * HTB;
__device__ __forceinline__ int lds_byte(int r, int c) { const int st = (r >> 4) * 2 + (c >> 5), rr = r & 15, cc = c & 31, ob = rr * 64 + cc * 2; return st * 1024 + (ob ^ (((ob >> 9) & 1) << 5)); }
__device__ __forceinline__ void stage_rc(int b, int& R, int& C) { const int st = b / 1024, sb = b % 1024, swz = sb ^ (((sb >> 9) & 1) << 5); R = (st >> 1) * 16 + swz / 64; C = (st & 1) * 32 + (swz % 64) / 2; }
__device__ __forceinline__ int perm32(int rho) { const int n = rho >> 4, i = rho & 15; return 8 * (i >> 2) + 4 * n + (i & 3); }
struct Unit { int pm, pn, ord; };
typedef float f32x16 __attribute__((ext_vector_type(16)));
typedef int i32x8 __attribute__((ext_vector_type(8))); typedef int i32x4_ __attribute__((ext_vector_type(4)));
__device__ __forceinline__ i32x8 f8cat(const bf16x8 lo, const bf16x8 hi) { return __builtin_shufflevector(__builtin_bit_cast(i32x4_, lo), __builtin_bit_cast(i32x4_, hi), 0, 1, 2, 3, 4, 5, 6, 7); }
template <class Epi, class Sched, bool ALIGN_EPI, bool F8 = false>
__device__ __forceinline__ void gemm_phase(LAS unsigned char* lds, const int K, const unsigned kstepA, const Sched& S, const Epi& E) {
    const int tid = threadIdx.x, wid = __builtin_amdgcn_readfirstlane(tid >> 6), lane = tid & 63, wr = wid >> 2, wc = wid & 3, fr = lane & 15, fq = lane >> 4;
    const int nt = K / BK;
    constexpr bool GA = Sched::GATHER;
    int RA[2]; unsigned CA2[2], voffB[2], voffB1[2], voffA[2];
    constexpr bool P16 = Epi::PERM16;
#pragma unroll
    for (int i = 0; i < 2; ++i) { int R, C; stage_rc(tid * 16 + i * 8192, R, C); const int Rb = Epi::PERM ? ((R & ~31) + perm32(R & 31)) : R;
        RA[i] = R; CA2[i] = (unsigned)C * 2u; voffB[i] = (unsigned)(Rb * K + C) * 2u; voffA[i] = GA ? 0u : (S.lane_off(R) + (unsigned)C * 2u);
        if (P16) { const int c16 = 64 * (R >> 5) + 16 * ((R >> 2) & 3) + 4 * ((R >> 4) & 1) + (R & 3); voffB[i] = (unsigned)(c16 * K + C) * 2u; voffB1[i] = (unsigned)((c16 + 8) * K + C) * 2u; } else voffB1[i] = 0u; }
    const size_t kstepB = (size_t)(BK * 2);
    const size_t hstepB = (size_t)HALF * K * 2;
    const unsigned ldsw = (unsigned)wid * 1024u;
    const int aoff = lds_byte(wr * 64 + fr, fq * 8), boff = lds_byte(wc * 32 + fr, fq * 8);
    const char* const Ab = S.abase();
    unsigned aoC[2][2], aoN[2][2];
    unsigned uC[2], uN[2];
#define PG8_SA(b, h) (((b) * 2 + (h)) * HTB)
#define PG8_SB(b, h) ((4 + (b) * 2 + (h)) * HTB)
#define PG8_GLDS(sbase, voff, ldsoff) do { const char* _b = (const char*)(sbase); unsigned _v = (voff); asm volatile("" : "+s"(_b), "+v"(_v)); \
        __builtin_amdgcn_global_load_lds((const unsigned*)(_b + _v), (LAS unsigned*)(lds + (ldsoff)), 16, 0, 0); } while (0)
#define PG8_STAGE_B(bufoff, gbase) do { _Pragma("unroll") for (int _i = 0; _i < 2; ++_i) PG8_GLDS(gbase, voffB[_i], (bufoff) + ldsw + _i * 8192); } while (0)
#define PG8_STAGE_B1(bufoff, gbase) do { _Pragma("unroll") for (int _i = 0; _i < 2; ++_i) PG8_GLDS((const char*)(gbase) + (P16 ? (size_t)0 : hstepB), (P16 ? voffB1[_i] : voffB[_i]), (bufoff) + ldsw + _i * 8192); } while (0)
#define PG8_STAGE_A(bufoff, kb, UO, LO) do { _Pragma("unroll") for (int _i = 0; _i < 2; ++_i) PG8_GLDS(Ab + (size_t)((kb) + (UO)), (GA ? (LO)[_i] : voffA[_i]), (bufoff) + ldsw + _i * 8192); } while (0)
#define PG8_LDA(dst, b, h) do { _Pragma("unroll") for (int m = 0; m < 4; ++m) _Pragma("unroll") for (int k = 0; k < 2; ++k) dst[m][k] = *(const LAS bf16x8*)(lds + PG8_SA(b, h) + aoff + m * 2048 + k * 1024); } while (0)
#define PG8_LDB(dst, b, h) do { _Pragma("unroll") for (int n = 0; n < 2; ++n) _Pragma("unroll") for (int k = 0; k < 2; ++k) dst[n][k] = *(const LAS bf16x8*)(lds + PG8_SB(b, h) + boff + n * 2048 + k * 1024); } while (0)
#define PG8_MMA(ai, bj, At, Bt) do { __builtin_amdgcn_s_setprio(1); _Pragma("unroll") for (int m = 0; m < 4; ++m) _Pragma("unroll") for (int n = 0; n < 2; ++n) { \
        if constexpr (F8) { f32x16& _w = accw[ai][bj][m >> 1]; const int _q = ((m & 1) * 2 + n) * 4; f32x4 _c = {_w[_q], _w[_q + 1], _w[_q + 2], _w[_q + 3]}; \
            _c = __builtin_amdgcn_mfma_scale_f32_16x16x128_f8f6f4(f8cat(Bt[n][0], Bt[n][1]), f8cat(At[m][0], At[m][1]), _c, 0, 0, 0, 0, 0, 0); _w[_q] = _c[0]; _w[_q + 1] = _c[1]; _w[_q + 2] = _c[2]; _w[_q + 3] = _c[3]; } \
        else { _Pragma("unroll") for (int k = 0; k < 2; ++k) acc[ai][bj][m][n] = __builtin_amdgcn_mfma_f32_16x16x32_bf16(Bt[n][k], At[m][k], acc[ai][bj][m][n], 0, 0, 0); } } __builtin_amdgcn_s_setprio(0); } while (0)
#define PG8_WAIT_V(n) asm volatile("s_waitcnt vmcnt(" #n ")" ::: "memory")
#define PG8_WAIT_L(n) asm volatile("s_waitcnt lgkmcnt(" #n ")" ::: "memory")
#define PG8_BAR __builtin_amdgcn_s_barrier()
#define PG8_SCHED __builtin_amdgcn_sched_barrier(0)
#define PG8_KPAIR(KB1, KB2, KB3, BP2, BP3) do { \
            PG8_LDB(B0, 0, 0); PG8_LDB(B1, 0, 1); PG8_SCHED; PG8_LDA(At, 0, 0); PG8_STAGE_A(PG8_SA(1, 1), KB1, uC[1], aoC[1]); \
            PG8_WAIT_V(8); PG8_WAIT_L(0); PG8_BAR; PG8_MMA(0, 0, At, B0); PG8_MMA(0, 1, At, B1); PG8_BAR; PG8_SCHED; \
            PG8_LDA(At, 0, 1); PG8_STAGE_B(PG8_SB(0, 0), BP2); PG8_STAGE_B1(PG8_SB(0, 1), BP2); PG8_STAGE_A(PG8_SA(0, 0), KB2, u2[0], a2o[0]); \
            PG8_WAIT_V(8); PG8_WAIT_L(0); PG8_BAR; PG8_MMA(1, 0, At, B0); PG8_MMA(1, 1, At, B1); PG8_BAR; PG8_SCHED; \
            PG8_LDB(B0, 1, 0); PG8_LDB(B1, 1, 1); PG8_SCHED; PG8_LDA(At, 1, 0); PG8_STAGE_A(PG8_SA(0, 1), KB2, u2[1], a2o[1]); \
            PG8_WAIT_V(8); PG8_WAIT_L(0); PG8_BAR; PG8_MMA(0, 0, At, B0); PG8_MMA(0, 1, At, B1); PG8_BAR; PG8_SCHED; \
            PG8_LDA(At, 1, 1); PG8_STAGE_B(PG8_SB(1, 0), BP3); PG8_STAGE_B1(PG8_SB(1, 1), BP3); PG8_STAGE_A(PG8_SA(1, 0), KB3, u2[0], a2o[0]); \
            PG8_WAIT_V(8); PG8_WAIT_L(0); PG8_BAR; PG8_MMA(1, 0, At, B0); PG8_MMA(1, 1, At, B1); PG8_BAR; PG8_SCHED; } while (0)
    Unit cur, nxt; int ui = 0;
    if (!S.next(0, cur)) return;
    f32x4 acc[2][2][4][2];
#pragma unroll
    for (int a = 0; a < 2; ++a)
#pragma unroll
        for (int b = 0; b < 2; ++b)
#pragma unroll
            for (int m = 0; m < 4; ++m)
#pragma unroll
                for (int n = 0; n < 2; ++n) acc[a][b][m][n] = (f32x4){0.f, 0.f, 0.f, 0.f};
    bf16x8 At[4][2], B0[2][2], B1[2][2];
    f32x16 accw[2][2][2];
#define PG8_ZERO_W() do { if constexpr (F8) { _Pragma("unroll") for (int _a = 0; _a < 2; ++_a) _Pragma("unroll") for (int _b = 0; _b < 2; ++_b) _Pragma("unroll") for (int _m = 0; _m < 2; ++_m) _Pragma("unroll") for (int _e = 0; _e < 16; ++_e) accw[_a][_b][_m][_e] = 0.f; } } while (0)
    PG8_ZERO_W();
#pragma unroll
    for (int h = 0; h < 2; ++h) { uC[h] = GA ? 0u : S.unit_off(cur, h); uN[h] = uC[h];
#pragma unroll
        for (int i = 0; i < 2; ++i) { aoC[h][i] = GA ? (S.aoff(cur, h * HALF + RA[i]) + CA2[i]) : 0u; aoN[h][i] = aoC[h][i]; } }
    const char* cB = S.bptr(cur);
    PG8_STAGE_B(PG8_SB(0, 0), cB); PG8_STAGE_B1(PG8_SB(0, 1), cB); PG8_STAGE_A(PG8_SA(0, 0), 0u, uC[0], aoC[0]); PG8_STAGE_A(PG8_SA(0, 1), 0u, uC[1], aoC[1]);
    if (wr == 1) PG8_BAR;
    PG8_WAIT_V(2); PG8_BAR;
    PG8_STAGE_B(PG8_SB(1, 0), cB + kstepB); PG8_STAGE_A(PG8_SA(1, 0), kstepA, uC[0], aoC[0]); PG8_STAGE_B1(PG8_SB(1, 1), cB + kstepB);
    PG8_WAIT_V(6); PG8_BAR;
    for (;;) {
        const bool has_next = S.next(ui + 1, nxt);
        const char* nB = has_next ? S.bptr(nxt) : cB;
#pragma unroll
        for (int h = 0; h < 2; ++h) { uN[h] = (GA || !has_next) ? uC[h] : S.unit_off(nxt, h);
#pragma unroll
            for (int i = 0; i < 2; ++i) aoN[h][i] = (GA && has_next) ? (S.aoff(nxt, h * HALF + RA[i]) + CA2[i]) : aoC[h][i]; }
#pragma nounroll
        for (int t = 0; t < nt; t += 2) {
            const bool last = (t == nt - 2);
            const unsigned kb1 = (unsigned)(t + 1) * kstepA, kb2 = last ? 0u : (unsigned)(t + 2) * kstepA, kb3 = kb2 + kstepA;
            const char* b2 = last ? nB : cB + (size_t)(t + 2) * kstepB; const char* b3 = b2 + kstepB;
            unsigned u2[2], a2o[2][2];
#pragma unroll
            for (int h = 0; h < 2; ++h) { u2[h] = last ? uN[h] : uC[h];
#pragma unroll
                for (int i = 0; i < 2; ++i) a2o[h][i] = GA ? (last ? aoN[h][i] : aoC[h][i]) : 0u; }
            PG8_KPAIR(kb1, kb2, kb3, b2, b3);
        }
        if constexpr (ALIGN_EPI) { if (wr == 0) PG8_BAR; }
        if constexpr (F8) {
#pragma unroll
            for (int _a = 0; _a < 2; ++_a)
#pragma unroll
                for (int _b = 0; _b < 2; ++_b)
#pragma unroll
                    for (int _m = 0; _m < 4; ++_m)
#pragma unroll
                        for (int _n = 0; _n < 2; ++_n) { const f32x16& _w = accw[_a][_b][_m >> 1]; const int _q = ((_m & 1) * 2 + _n) * 4; acc[_a][_b][_m][_n] = (f32x4){_w[_q], _w[_q + 1], _w[_q + 2], _w[_q + 3]}; }
        }
        E(acc, cur, wr, wc, fr, fq);
        PG8_ZERO_W();
        if (!has_next) break;
#pragma unroll
        for (int a = 0; a < 2; ++a)
#pragma unroll
            for (int b = 0; b < 2; ++b)
#pragma unroll
                for (int m = 0; m < 4; ++m)
#pragma unroll
                    for (int n = 0; n < 2; ++n) acc[a][b][m][n] = (f32x4){0.f, 0.f, 0.f, 0.f};
        cur = nxt; cB = nB; ++ui;
#pragma unroll
        for (int h = 0; h < 2; ++h) { uC[h] = uN[h];
#pragma unroll
            for (int i = 0; i < 2; ++i) aoC[h][i] = aoN[h][i]; }
        if constexpr (ALIGN_EPI) { if (wr == 1) PG8_BAR; }
    }
    PG8_WAIT_V(0);
    if constexpr (!ALIGN_EPI) { if (wr == 0) PG8_BAR; }
    PG8_BAR;
#undef PG8_SA
#undef PG8_ZERO_W
#undef PG8_GLDS
#undef PG8_SB
#undef PG8_STAGE_A
#undef PG8_STAGE_B
#undef PG8_STAGE_B1
#undef PG8_LDA
#undef PG8_LDB
#undef PG8_MMA
#undef PG8_WAIT_V
#undef PG8_WAIT_L
#undef PG8_BAR
#undef PG8_SCHED
#undef PG8_KPAIR
}

struct DenseSched {
    const char* A; const char* Bt; unsigned lda2; size_t btile; int nM, nN, nwg, G, c;
    __device__ __forceinline__ void init(const bf16_t* A_, int lda, const bf16_t* Bt_, int K, int Mrows, int N) {
        A = (const char*)A_; Bt = (const char*)Bt_; lda2 = (unsigned)lda * 2u; btile = (size_t)256 * K * 2; nM = Mrows / BM; nN = N / BM; nwg = nM * nN; G = gridDim.x; c = blockIdx.x; }
    __device__ __forceinline__ bool next(int i, Unit& u) const {
        const long L = (long)i * G + c; if (L >= nwg) return false;
        int wgid = (int)L; { const int q = nwg / 8, r = nwg % 8, xcd = wgid % 8, off = wgid / 8; wgid = (xcd < r ? xcd * (q + 1) : r * (q + 1) + (xcd - r) * q) + off; }
        const int nig = 8 * nN, gid = wgid / nig, fm = gid * 8, gsz = (nM - fm) < 8 ? (nM - fm) : 8;
        u.pm = fm + ((wgid % nig) % gsz); u.pn = (wgid % nig) / gsz; u.ord = i; return true;
    }
    static constexpr bool GATHER = false;
    __device__ __forceinline__ unsigned lane_off(int r) const { return (unsigned)r * lda2; }
    __device__ __forceinline__ unsigned unit_off(const Unit& u, int h) const { return (unsigned)(u.pm * BM + h * HALF) * lda2; }
    __device__ __forceinline__ unsigned aoff(const Unit&, int) const { return 0u; }
    __device__ __forceinline__ const char* abase() const { return A; }
    __device__ __forceinline__ const char* bptr(const Unit& u) const { return Bt + (size_t)u.pn * btile; }
};
}
typedef float f32x2_t __attribute__((ext_vector_type(2))); typedef __bf16 bf16x2_t __attribute__((ext_vector_type(2)));
__device__ __forceinline__ unsigned cvt_pk_bf16(float lo, float hi) { const f32x2_t v = {lo, hi}; const bf16x2_t b = __builtin_convertvector(v, bf16x2_t); return __builtin_bit_cast(unsigned, b); }
__device__ __forceinline__ u32x4 pack8(const f32x4 v0, const f32x4 v1) { u32x4 w; w.x = cvt_pk_bf16(v0[0], v0[1]); w.y = cvt_pk_bf16(v0[2], v0[3]); w.z = cvt_pk_bf16(v1[0], v1[1]); w.w = cvt_pk_bf16(v1[2], v1[3]); return w; }
__device__ __forceinline__ unsigned cvtpk_m(float lo, float hi) { const f32x2_t v = {lo, hi}; const bf16x2_t b = __builtin_convertvector(v, bf16x2_t); return __builtin_bit_cast(unsigned, b); }
__device__ __forceinline__ u32x4 pack8m(const f32x4 v0, const f32x4 v1) { u32x4 w; w.x = cvtpk_m(v0[0], v0[1]); w.y = cvtpk_m(v0[2], v0[3]); w.z = cvtpk_m(v1[0], v1[1]); w.w = cvtpk_m(v1[2], v1[3]); return w; }
#define MFMA_SETTLE(S) asm volatile("s_nop 15\n\ts_nop 7" : "+v"(S[0][0]), "+v"(S[0][1]), "+v"(S[0][2]), "+v"(S[0][3]), "+v"(S[1][0]), "+v"(S[1][1]), "+v"(S[1][2]), "+v"(S[1][3]))
__device__ __forceinline__ f32x4 sig4(const f32x4 v) { f32x4 r; r[0] = sigmoidf_(v[0]); r[1] = sigmoidf_(v[1]); r[2] = sigmoidf_(v[2]); r[3] = sigmoidf_(v[3]); return r; }

#define EPI_ROWLOOP for (int ai = 0; ai < 2; ++ai) _Pragma("unroll") for (int m = 0; m < 4; ++m)
struct EpiInproj0 {
    static constexpr bool PERM = true, PERM16 = false; bf16_t* H0;
    __device__ __forceinline__ void operator()(const f32x4 (&acc)[2][2][4][2], const pg8::Unit& u, int wr, int wc, int fr, int fq) const {
        const int row0 = u.pm * 256 + wr * 64 + fr, cl = wc * 32 + 8 * fq;
#pragma unroll
        EPI_ROWLOOP { bf16_t* rp = H0 + (size_t)(row0 + ai * 128 + m * 16) * 1024;
            if (u.pn < 2) {
#pragma unroll
                for (int bj = 0; bj < 2; ++bj) *(u32x4*)(rp + u.pn * 256 + bj * 128 + cl) = pack8(acc[ai][bj][m][0], acc[ai][bj][m][1]);
            } else {
                const f32x4 v0 = acc[ai][0][m][0] * sig4(acc[ai][1][m][0]), v1 = acc[ai][0][m][1] * sig4(acc[ai][1][m][1]);
                *(u32x4*)(rp + 512 + (u.pn - 2) * 128 + cl) = pack8(v0, v1);
            } }
    }
};
struct EpiRes {
    static constexpr bool PERM = true, PERM16 = false; const float* resf; const bf16_t* resb; bf16_t* Y;
    __device__ __forceinline__ void operator()(const f32x4 (&acc)[2][2][4][2], const pg8::Unit& u, int wr, int wc, int fr, int fq) const {
        const int row0 = u.pm * 256 + wr * 64 + fr, c0 = u.pn * 256 + wc * 32 + 8 * fq;
#pragma unroll
        EPI_ROWLOOP { const size_t ro = (size_t)(row0 + ai * 128 + m * 16) * 1024 + c0;
#pragma unroll
            for (int bj = 0; bj < 2; ++bj) {
                f32x4 r0, r1;
                if (resf) { r0 = *(const f32x4*)(resf + ro + bj * 128); r1 = *(const f32x4*)(resf + ro + bj * 128 + 4); }
                else { const u32x4 xv = *(const u32x4*)(resb + ro + bj * 128);
                    r0[0] = __uint_as_float(xv.x << 16); r0[1] = __uint_as_float(xv.x & 0xffff0000u); r0[2] = __uint_as_float(xv.y << 16); r0[3] = __uint_as_float(xv.y & 0xffff0000u);
                    r1[0] = __uint_as_float(xv.z << 16); r1[1] = __uint_as_float(xv.z & 0xffff0000u); r1[2] = __uint_as_float(xv.w << 16); r1[3] = __uint_as_float(xv.w & 0xffff0000u); }
                *(u32x4*)(Y + ro + bj * 128) = pack8(acc[ai][bj][m][0] + r0 * ALPHA, acc[ai][bj][m][1] + r1 * ALPHA);
            } }
    }
};
struct EpiLogits {
    static constexpr bool PERM = true, PERM16 = false; float* LOG;
    __device__ __forceinline__ void operator()(const f32x4 (&acc)[2][2][4][2], const pg8::Unit& u, int wr, int wc, int fr, int fq) const {
        const int row0 = u.pm * 256 + wr * 64 + fr, cl = wc * 32 + 8 * fq;
#pragma unroll
        EPI_ROWLOOP { float* rp = LOG + (size_t)(row0 + ai * 128 + m * 16) * 256 + cl;
#pragma unroll
            for (int bj = 0; bj < 2; ++bj) { *(f32x4*)(rp + bj * 128) = acc[ai][bj][m][0]; *(f32x4*)(rp + bj * 128 + 4) = acc[ai][bj][m][1]; } }
    }
};

constexpr int MOE_TAB_OFF = 131072;
__device__ __forceinline__ int moe_setup256(const unsigned* cnt, LAS unsigned char* lds) {
    LAS int* tstart = (LAS int*)(lds + MOE_TAB_OFF);
    LAS int* scnt = (LAS int*)(lds + MOE_TAB_OFF + 1088);
    LAS unsigned short* texp = (LAS unsigned short*)(lds + MOE_TAB_OFF + 2176);
    const int tid = threadIdx.x;
    __syncthreads();
    if (tid < 256) scnt[tid] = (int)cnt[tid];
    __syncthreads();
    if (tid == 0) { int s = 0; for (int e = 0; e < 256; ++e) { tstart[e] = s; s += (scnt[e] + 255) >> 8; } tstart[256] = s; }
    __syncthreads();
    if (tid < 256) for (int q = tstart[tid]; q < tstart[tid + 1]; ++q) texp[q] = (unsigned short)tid;
    __syncthreads();
    return __builtin_amdgcn_readfirstlane(tstart[256]);
}
constexpr int MOE_TOK_OFF = MOE_TAB_OFF + 5120;
constexpr int MOE_MAX_ORD = 20;
struct MoeGuSched {
    static constexpr bool GATHER = true;
    const char* X; const char* W; const int2* list; LAS unsigned char* lds; int R, nunits, G, c;
    __device__ __forceinline__ int vcu() const { return (G % 8 == 0) ? (c % 8) * (G / 8) + c / 8 : c; }
    __device__ __forceinline__ bool next(int i, pg8::Unit& u) const {
        const int L = i * G + vcu(); if (L >= nunits || i >= MOE_MAX_ORD) return false;
        const int q = L >> 1; const int e = __builtin_amdgcn_readfirstlane((q < R) ? (int)((LAS unsigned short*)(lds + MOE_TAB_OFF + 2176))[q] : 256);
        u.pm = q; u.pn = e * 2 + (L & 1); u.ord = i; return true; }
    __device__ __forceinline__ void prepare() const {
        const int tid = threadIdx.x, r = tid & 255;
        pg8::Unit u;
        for (int i = tid >> 8; next(i, u); i += 2) {
            const int e = u.pn >> 1; int token;
            if (e < 256) { const int ts = ((LAS int*)(lds + MOE_TAB_OFF))[e], cn = ((LAS int*)(lds + MOE_TAB_OFF + 1088))[e]; int lr = (u.pm - ts) * 256 + r; if (lr >= cn) lr = cn - 1;
                token = list[(size_t)e * LISTCAP + lr].x / 10; }
            else token = (u.pm - R) * 256 + r;
            ((LAS unsigned short*)(lds + MOE_TOK_OFF))[i * 256 + r] = (unsigned short)token;
        }
        __syncthreads();
    }
    __device__ __forceinline__ unsigned aoff(const pg8::Unit& u, int r) const { return (unsigned)((LAS unsigned short*)(lds + MOE_TOK_OFF))[u.ord * 256 + r] * 1024u; }
    __device__ __forceinline__ unsigned lane_off(int) const { return 0u; }
    __device__ __forceinline__ unsigned unit_off(const pg8::Unit&, int) const { return 0u; }
    __device__ __forceinline__ const char* abase() const { return X; }
    __device__ __forceinline__ const char* bptr(const pg8::Unit& u) const { return W + (size_t)u.pn * (256 * 1024); }
};
constexpr float GU_SC = 1.0f / (X8_SCALE * W8_SCALE);
struct EpiGateUp {
    static constexpr bool PERM = true, PERM16 = false; unsigned char* HID;
    __device__ __forceinline__ void operator()(const f32x4 (&acc)[2][2][4][2], const pg8::Unit& u, int wr, int wc, int fr, int fq) const {
        const int row0 = u.pm * 256 + wr * 64 + fr, c0 = (u.pn & 1) * 128 + wc * 32 + 8 * fq;
#pragma unroll
        EPI_ROWLOOP { const f32x4 g0 = acc[ai][0][m][0] * GU_SC, g1 = acc[ai][0][m][1] * GU_SC;
            f32x4 h0 = g0 * sig4(g0) * (acc[ai][1][m][0] * (GU_SC * H8_SCALE)), h1 = g1 * sig4(g1) * (acc[ai][1][m][1] * (GU_SC * H8_SCALE));
#pragma unroll
            for (int i = 0; i < 4; ++i) { h0[i] = clamp8(h0[i]); h1[i] = clamp8(h1[i]); }
            *(u32x2*)(HID + (size_t)(row0 + ai * 128 + m * 16) * 256 + c0) = pack8_fp8(h0, h1); }
    }
};
constexpr int MOE_RI_OFF = MOE_TAB_OFF + 5120;
constexpr int MOE_MAX_RT = 6;
struct MoeDownSched {
    const char* HID; const char* W; const int2* list; LAS unsigned char* lds; int R, ntile, G, c;
    __device__ __forceinline__ int vcu() const { return (G % 8 == 0) ? (c % 8) * (G / 8) + c / 8 : c; }
    __device__ __forceinline__ bool next(int i, pg8::Unit& u) const {
        const int q = vcu() + G * (i >> 2); if (q >= ntile || (i >> 2) >= MOE_MAX_RT) return false;
        const int e = (q < R) ? (int)((LAS unsigned short*)(lds + MOE_TAB_OFF + 2176))[q] : 256;
        u.pm = q; u.pn = e * 4 + (i & 3); u.ord = i >> 2; return true; }
    __device__ __forceinline__ void prepare() const {
        const int tid = threadIdx.x, r = tid & 255;
        for (int o = tid >> 8; o < MOE_MAX_RT; o += 2) {
            const int q = vcu() + G * o; if (q >= ntile) break;
            u32x2 en;
            if (q < R) { const int e = ((LAS unsigned short*)(lds + MOE_TAB_OFF + 2176))[q]; const int ts = ((LAS int*)(lds + MOE_TAB_OFF))[e], cn = ((LAS int*)(lds + MOE_TAB_OFF + 1088))[e];
                const int lr = (q - ts) * 256 + r; if (lr < cn) { const int2 le = list[(size_t)e * LISTCAP + lr]; en.x = (unsigned)le.x; en.y = (unsigned)le.y; } else { en.x = 0xffffffffu; en.y = 0u; } }
            else { en.x = (unsigned)(((q - R) * 256 + r) * 10 + 8); en.y = __float_as_uint(1.0f); }
            ((LAS u32x2*)(lds + MOE_RI_OFF))[o * 256 + r] = en;
        }
        __syncthreads();
    }
    static constexpr bool GATHER = false;
    __device__ __forceinline__ unsigned lane_off(int r) const { return (unsigned)r * 256u; }
    __device__ __forceinline__ unsigned unit_off(const pg8::Unit& u, int h) const { return (unsigned)(u.pm * 256 + h * 128) * 256u; }
    __device__ __forceinline__ unsigned aoff(const pg8::Unit&, int) const { return 0u; }
    __device__ __forceinline__ const char* abase() const { return HID; }
    __device__ __forceinline__ const char* bptr(const pg8::Unit& u) const { return W + (size_t)u.pn * (256 * 256); }
};
struct EpiDown {
    static constexpr bool PERM = true, PERM16 = true;
    unsigned char* YB; LAS unsigned char* lds;
    __device__ __forceinline__ void operator()(const f32x4 (&acc)[2][2][4][2], const pg8::Unit& u, int wr, int wc, int fr, int fq) const {
        asm volatile("" : "+v"(fr), "+v"(fq));
        const unsigned c0b = (unsigned)((u.pn & 3) * 256 + wc * 64 + 16 * fq); const bool shared = (u.pn >> 2) == 256;
        const LAS u32x2* ri = (const LAS u32x2*)(lds + MOE_RI_OFF) + u.ord * 256 + wr * 64 + fr;
#pragma unroll
        for (int ai = 0; ai < 2; ++ai)
#pragma unroll
            for (int m = 0; m < 4; ++m) { const u32x2 en = ri[ai * 128 + m * 16]; const float wv = __uint_as_float(en.y) * (YB_SCALE / (H8_SCALE * W8_SCALE));
                if ((int)en.x >= 0) { unsigned char* rp = YB + (size_t)(en.x * 1024u + c0b);
                    const f32x4 v00 = acc[ai][0][m][0] * wv, v01 = acc[ai][0][m][1] * wv, v10 = acc[ai][1][m][0] * wv, v11 = acc[ai][1][m][1] * wv;
                    const u32x2 h0 = pack8_fp8(v00, v01), h1 = pack8_fp8(v10, v11);
                    *(u32x4*)rp = (u32x4){h0.x, h0.y, h1.x, h1.y};
                    if (YB_NSLOT == 10 && shared) {
                        u32x2 r_[2];
#pragma unroll
                        for (int bj = 0; bj < 2; ++bj) { const u32x2 h = bj ? h1 : h0; const f32x4 v0 = bj ? v10 : v00, v1 = bj ? v11 : v01;
                            const auto a0 = __builtin_amdgcn_cvt_pk_f32_fp8((int)h.x, false), a1 = __builtin_amdgcn_cvt_pk_f32_fp8((int)h.x, true), a2 = __builtin_amdgcn_cvt_pk_f32_fp8((int)h.y, false), a3 = __builtin_amdgcn_cvt_pk_f32_fp8((int)h.y, true);
                            const f32x4 r0 = {v0[0] - a0[0], v0[1] - a0[1], v0[2] - a1[0], v0[3] - a1[1]}, r1 = {v1[0] - a2[0], v1[1] - a2[1], v1[2] - a3[0], v1[3] - a3[1]};
                            r_[bj] = pack8_fp8(r0, r1); }
                        *(u32x4*)(rp + 1024) = (u32x4){r_[0].x, r_[0].y, r_[1].x, r_[1].y}; } } }
    }
};

struct EpiInprojN {
    static constexpr bool PERM = true, PERM16 = false; bf16_t* QN; bf16_t* QR; bf16_t* KV6; float* GATES; const float* ROT;
    __device__ __forceinline__ void operator()(const f32x4 (&acc)[2][2][4][2], const pg8::Unit& u, int wr, int wc, int fr, int fq) const {
        const int row0 = u.pm * 256 + wr * 64 + fr, cl = wc * 32 + 8 * fq, pn = u.pn;
        const bool isq = pn < 4, rotk = (pn == 6 || pn == 8), dorot = (isq || rotk) && ((wc & 1) == 0);
#pragma unroll
        EPI_ROWLOOP { const int row = row0 + ai * 128 + m * 16;
            if (pn == 10) {
                if (cl < 48) { *(f32x4*)(GATES + (size_t)row * 48 + cl) = sig4(acc[ai][0][m][0]); *(f32x4*)(GATES + (size_t)row * 48 + cl + 4) = sig4(acc[ai][0][m][1]); }
            } else {
                f32x4 cs0, cs1, sn0, sn1;
                if (dorot) { const float* rt = ROT + (size_t)(row & (T - 1)) * 16; cs0 = *(const f32x4*)rt; cs1 = *(const f32x4*)(rt + 4); sn0 = *(const f32x4*)(rt + 8); sn1 = *(const f32x4*)(rt + 12); }
#pragma unroll
                for (int bj = 0; bj < 2; ++bj) {
                    const f32x4 v0 = acc[ai][bj][m][0], v1 = acc[ai][bj][m][1];
                    f32x4 r0 = v0, r1 = v1;
                    if (dorot) {
                        f32x4 p0, p1;
#pragma unroll
                        for (int i = 0; i < 4; ++i) { p0[i] = __shfl_xor(v0[i], 16); p1[i] = __shfl_xor(v1[i], 16); }
                        if (fq == 0) { r0 = v0 * cs0 - p0 * sn0; r1 = v1 * cs1 - p1 * sn1; }
                        else if (fq == 1) { r0 = v0 * cs0 + p0 * sn0; r1 = v1 * cs1 + p1 * sn1; }
                    }
                    if (isq) { const int c = pn * 256 + bj * 128 + cl;
                        *(u32x4*)(QN + (size_t)row * 1024 + c) = pack8(v0 * QSCALE, v1 * QSCALE); *(u32x4*)(QR + (size_t)row * 1024 + c) = pack8(r0 * QSCALE, r1 * QSCALE); }
                    else { const int cc = bj * 128 + cl, g = cc >> 6, d = cc & 63, b = row >> 13, t = row & (T - 1);
                        *(u32x4*)(KV6 + ((size_t)((pn - 4) * 16 + b * 4 + g) * T + t) * 64 + d) = pack8(r0, r1); }
                }
            } }
    }
};

struct Cmp1Sched {
    const char* KV6; const char* W; int G, c;
    static constexpr bool GATHER = false;
    __device__ __forceinline__ bool next(int i, pg8::Unit& u) const { const int L = i * G + c; if (L >= 64) return false; u.pm = L >> 1; u.pn = L & 1; u.ord = i; return true; }
    __device__ __forceinline__ unsigned lane_off(int r) const { return (unsigned)r * 2048u; }
    __device__ __forceinline__ unsigned unit_off(const pg8::Unit& u, int h) const { return (unsigned)u.pn * (unsigned)(16 * T * 64 * 2) + (unsigned)(u.pm * 256 + h * 128) * 2048u; }
    __device__ __forceinline__ unsigned aoff(const pg8::Unit&, int) const { return 0u; }
    __device__ __forceinline__ const char* abase() const { return KV6; }
    __device__ __forceinline__ const char* bptr(const pg8::Unit& u) const { return W + (size_t)u.pn * (256 * 2048 * 2); }
};
struct EpiCmp1 {
    static constexpr bool PERM = true, PERM16 = false; bf16_t* CH1; const float* bias1;
    __device__ __forceinline__ void operator()(const f32x4 (&acc)[2][2][4][2], const pg8::Unit& u, int wr, int wc, int fr, int fq) const {
        const int row0 = u.pm * 256 + wr * 64 + fr, cl = wc * 32 + 8 * fq;
        const f32x4 b0 = *(const f32x4*)(bias1 + u.pn * 128 + cl), b1 = *(const f32x4*)(bias1 + u.pn * 128 + cl + 4);
#pragma unroll
        EPI_ROWLOOP { f32x4 v0 = acc[ai][0][m][0] + b0, v1 = acc[ai][0][m][1] + b1;
#pragma unroll
            for (int i = 0; i < 4; ++i) { v0[i] = gelu_tanh(v0[i]); v1[i] = gelu_tanh(v1[i]); }
            *(u32x4*)(CH1 + ((size_t)u.pn * 8192 + row0 + ai * 128 + m * 16) * 128 + cl) = pack8(v0, v1); }
    }
};

__device__ __forceinline__ void p0_item(const float* W, int K, int N, bf16_t* WT, int kb, int n0, int drow0, LAS float* scr, int lane, bool f8 = false) {
    const int k0 = 64 * kb, n4 = (lane & 15) * 4;
    const bool cok = (n0 + n4) < N;
    f32x4 v[16];
#pragma unroll
    for (int i = 0; i < 16; ++i) { const int kk = 4 * i + (lane >> 4); v[i] = cok ? __builtin_nontemporal_load((const f32x4*)(W + (size_t)(k0 + kk) * N + n0 + n4)) : (f32x4){0.f, 0.f, 0.f, 0.f}; }
#pragma unroll
    for (int i = 0; i < 16; ++i) { const int kk = 4 * i + (lane >> 4); LAS float* d = scr + kk * 65 + n4; d[0] = v[i][0]; d[1] = v[i][1]; d[2] = v[i][2]; d[3] = v[i][3]; }
    asm volatile("s_waitcnt lgkmcnt(0)" ::: "memory");
    if (f8) {
        const int c4 = lane & 3;
#pragma unroll
        for (int j = 0; j < 4; ++j) { const int n = (lane >> 2) + 16 * j; const LAS float* sp = scr + (16 * c4) * 65 + n;
            u32x4 o;
            o.x = pk4_fp8(sp[0 * 65] * W8_SCALE, sp[1 * 65] * W8_SCALE, sp[2 * 65] * W8_SCALE, sp[3 * 65] * W8_SCALE); o.y = pk4_fp8(sp[4 * 65] * W8_SCALE, sp[5 * 65] * W8_SCALE, sp[6 * 65] * W8_SCALE, sp[7 * 65] * W8_SCALE);
            o.z = pk4_fp8(sp[8 * 65] * W8_SCALE, sp[9 * 65] * W8_SCALE, sp[10 * 65] * W8_SCALE, sp[11 * 65] * W8_SCALE); o.w = pk4_fp8(sp[12 * 65] * W8_SCALE, sp[13 * 65] * W8_SCALE, sp[14 * 65] * W8_SCALE, sp[15 * 65] * W8_SCALE);
            if (n0 + n < N) __builtin_nontemporal_store(o, (u32x4*)((unsigned char*)WT + (size_t)(drow0 + n) * K + k0 + 16 * c4)); }
        asm volatile("s_waitcnt lgkmcnt(0)" ::: "memory");
        return;
    }
    const int c = lane & 7;
#pragma unroll
    for (int j = 0; j < 8; ++j) { const int n = (lane >> 3) + 8 * j; const LAS float* sp = scr + (8 * c) * 65 + n;
        u32x4 o; o.x = pk2(sp[0 * 65], sp[1 * 65]); o.y = pk2(sp[2 * 65], sp[3 * 65]); o.z = pk2(sp[4 * 65], sp[5 * 65]); o.w = pk2(sp[6 * 65], sp[7 * 65]);
        if (n0 + n < N) __builtin_nontemporal_store(o, (u32x4*)(WT + (size_t)(drow0 + n) * K + k0 + 8 * c)); }
    asm volatile("s_waitcnt lgkmcnt(0)" ::: "memory");
}
struct CvtItem { const float* W; bf16_t* WT; int K, N, k0, n0, drow0; };
__device__ __forceinline__ void cvt32_load(const CvtItem& it, int lane, f32x4 (&v)[8]) {
    const int n4 = (lane & 7) * 4;
#pragma unroll
    for (int i = 0; i < 8; ++i) { const int kk = 8 * i + (lane >> 3); v[i] = __builtin_nontemporal_load((const f32x4*)(it.W + (size_t)(it.k0 + kk) * it.N + it.n0 + n4)); }
}
__device__ __forceinline__ void cvt32_finish(const CvtItem& it, int lane, const f32x4 (&v)[8], LAS float* scr) {
    const int n4 = (lane & 7) * 4;
#pragma unroll
    for (int i = 0; i < 8; ++i) { const int kk = 8 * i + (lane >> 3); LAS float* d = scr + kk * 33 + n4; d[0] = v[i][0]; d[1] = v[i][1]; d[2] = v[i][2]; d[3] = v[i][3]; }
    asm volatile("s_waitcnt lgkmcnt(0)" ::: "memory");
    const int c = lane & 7;
#pragma unroll
    for (int j = 0; j < 4; ++j) { const int n = (lane >> 3) + 8 * j; const LAS float* sp = scr + (8 * c) * 33 + n;
        const float v0 = sp[0 * 33], v1 = sp[1 * 33], v2 = sp[2 * 33], v3 = sp[3 * 33], v4 = sp[4 * 33], v5 = sp[5 * 33], v6 = sp[6 * 33], v7 = sp[7 * 33];
        u32x2 o; o.x = pk4_fp8(v0 * W8_SCALE, v1 * W8_SCALE, v2 * W8_SCALE, v3 * W8_SCALE); o.y = pk4_fp8(v4 * W8_SCALE, v5 * W8_SCALE, v6 * W8_SCALE, v7 * W8_SCALE);
        __builtin_nontemporal_store(o, (u32x2*)((unsigned char*)it.WT + (size_t)(it.drow0 + n) * it.K + it.k0 + 8 * c)); }
    asm volatile("s_waitcnt lgkmcnt(0)" ::: "memory");
}
constexpr int CVT1_ITEMS = 257 * 384;
__device__ __forceinline__ CvtItem cvt1_item(const Args& a, int idx) {
    const int e = idx / 384, sub = idx % 384, mat = sub >> 7, r = sub & 127;
    CvtItem it;
    if (mat < 2) { it.W = (e < 256) ? a.in[23 + mat] + ((size_t)256 + e) * (size_t)(D * FF) : a.in[26 + mat] + (size_t)(D * FF);
        it.K = D; it.N = FF; it.k0 = (r >> 3) * 64; it.n0 = (r & 7) * 32; it.drow0 = (it.n0 >> 7) * 256 + mat * 128 + (it.n0 & 127);
        it.WT = (bf16_t*)(a.ws + WS_WGU + (size_t)(257 + e) * 512 * 1024); }
    else { it.W = (e < 256) ? a.in[25] + ((size_t)256 + e) * (size_t)(FF * D) : a.in[28] + (size_t)(FF * D);
        it.K = FF; it.N = D; it.k0 = (r >> 5) * 64; it.n0 = (r & 31) * 32; it.drow0 = it.n0;
        it.WT = (bf16_t*)(a.ws + WS_WD + (size_t)(257 + e) * 1024 * 256); }
    return it;
}
__device__ __forceinline__ void cvt1_run(const Args& a, int& next, int stride, int quota, LAS float* scr, int lane) {
#pragma unroll 1
    for (int q = 0; q < quota && next < CVT1_ITEMS; ++q) {
        CvtItem t[4]; f32x4 v[4][8]; bool ok[4];
#pragma unroll
        for (int u = 0; u < 4; ++u) { const int idx = next + u * stride; ok[u] = idx < CVT1_ITEMS; t[u] = cvt1_item(a, ok[u] ? idx : 0); if (ok[u]) cvt32_load(t[u], lane, v[u]); }
        next += 4 * stride;
#pragma unroll
        for (int u = 0; u < 4; ++u) if (ok[u]) cvt32_finish(t[u], lane, v[u], scr);
    }
}
__device__ __forceinline__ void ph_prologue(const Args& a, LAS unsigned char* lds) {
    const int lane = threadIdx.x & 63, wave = threadIdx.x >> 6;
    LAS float* scr = (LAS float*)(lds + wave * 16640);
    const int gw = blockIdx.x * 8 + wave, ngw = gridDim.x * 8;
    for (int it = gw; it < 257 * 192; it += ngw) {
        const int le = it / 192, sub = it % 192, l = 0, e = le, mat = sub >> 6, r = sub & 63;
        if (mat < 2) {
            const float* W = (e < 256) ? a.in[23 + mat] + ((size_t)l * 256 + e) * (size_t)(D * FF) : a.in[26 + mat] + (size_t)l * (D * FF);
            const int kb = r >> 2, n0 = (r & 3) * 64;
            p0_item(W, D, FF, (bf16_t*)(a.ws + WS_WGU + (size_t)le * 512 * 1024), kb, n0, (n0 >> 7) * 256 + mat * 128 + (n0 & 127), scr, lane, true);
        } else {
            const float* W = (e < 256) ? a.in[25] + ((size_t)l * 256 + e) * (size_t)(FF * D) : a.in[28] + (size_t)l * (FF * D);
            const int kb = r >> 4, n0 = (r & 15) * 64;
            p0_item(W, FF, D, (bf16_t*)(a.ws + WS_WD + (size_t)le * 1024 * 256), kb, n0, n0, scr, lane, true);
        }
    }
    {
        for (int it = gw; it < 512; it += ngw) { const int w = it >> 8, r = it & 255;
            p0_item(a.in[w ? 16 : 8], D, D, (bf16_t*)(a.ws + (w ? WS_WOUTN : WS_WOUT0)), r >> 4, (r & 15) * 64, (r & 15) * 64, scr, lane); }
        for (int it = gw; it < 16 * 41; it += ngw) p0_item(a.in[9], D, 2608, (bf16_t*)(a.ws + WS_WINN), it / 41, (it % 41) * 64, (it % 41) * 64, scr, lane);
        for (int it = gw; it < 128; it += ngw) { const int l = it >> 6, r = it & 63;
            p0_item(a.in[21] + (size_t)l * D * NE, D, NE, (bf16_t*)(a.ws + WS_WR) + (size_t)l * NE * D, r >> 2, (r & 3) * 64, (r & 3) * 64, scr, lane); }
        for (int it = gw; it < 16 * 16; it += ngw) { const int kb = it >> 4, n0 = (8 + (it & 15)) * 64;
            const int isg = (n0 >= 1024) ? 1 : 0, rel = n0 - 512 - isg * 512;
            p0_item(a.in[1], D, 1536, (bf16_t*)(a.ws + WS_WIN0), kb, n0, 512 + (rel >> 7) * 256 + isg * 128 + (rel & 127), scr, lane); }
        for (int it = gw; it < 128; it += ngw) { const int kv = it >> 6, r = it & 63;
            p0_item(a.in[kv ? 14 : 11], 2048, 128, (bf16_t*)(a.ws + WS_CW1) + (size_t)kv * 256 * 2048, r >> 1, (r & 1) * 64, (r & 1) * 64, scr, lane); }
    }
    {
        const int gt = blockIdx.x * 512 + threadIdx.x, ngt = gridDim.x * 512;
        u32x4* z0 = (u32x4*)((bf16_t*)(a.ws + WS_WINN) + (size_t)2608 * 1024);
        for (int i = gt; i < 208 * 1024 / 8; i += ngt) z0[i] = (u32x4){0u, 0u, 0u, 0u};
        for (int kv = 0; kv < 2; ++kv) { u32x4* z1 = (u32x4*)((bf16_t*)(a.ws + WS_CW1) + ((size_t)kv * 256 + 128) * 2048);
            for (int i = gt; i < 128 * 2048 / 8; i += ngt) z1[i] = (u32x4){0u, 0u, 0u, 0u}; }
        const float* x = a.in[0]; bf16_t* XA = (bf16_t*)(a.ws + WS_XA);
        for (size_t i = gt; i < (size_t)M * D / 8; i += ngt) { const f32x4 v0 = *(const f32x4*)(x + i * 8), v1 = *(const f32x4*)(x + i * 8 + 4);
            u32x4 o; o.x = pk2(v0[0], v0[1]); o.y = pk2(v0[2], v0[3]); o.z = pk2(v1[0], v1[1]); o.w = pk2(v1[2], v1[3]); *(u32x4*)(XA + i * 8) = o; }
        const float* win = a.in[1]; const float* mix = a.in[2]; const float* psc = a.in[3]; bf16_t* WIN0 = (bf16_t*)(a.ws + WS_WIN0);
        for (int i = gt; i < 512 * 1024; i += ngt) { const int n = i & 511, k = i >> 9, g = n >> 7, nn = n & 127;
            const float* wr_ = win + (size_t)k * 1536 + g * 128; const float* mx = mix + (size_t)g * 128 * 128 + nn;
            float s = 0.f;
            for (int c = 0; c < 128; ++c) s += wr_[c] * mx[(size_t)c * 128];
            WIN0[(size_t)n * 1024 + k] = f2bf(s * psc[n]); }
        float* misc = (float*)(a.ws + WS_MISC);
        for (int i = gt; i < 256; i += ngt) { const int kv = i >> 7, j = i & 127; const float* pos = a.in[kv ? 13 : 10]; const float* w1 = a.in[kv ? 14 : 11];
            float s = 0.f; for (int k = 0; k < 2048; ++k) s += pos[k] * w1[(size_t)k * 128 + j]; misc[i] = s; }
        float* rot = misc + 1024;
        for (int i = gt; i < T * 8; i += ngt) { const int t = i >> 3, f = i & 7;
            const float ang = (float)t * a.inv_freq[f]; const double rev = (double)ang * 0.15915494309189535; const float fr = (float)(rev - floor(rev));
            rot[t * 16 + f] = __builtin_amdgcn_cosf(fr); rot[t * 16 + 8 + f] = __builtin_amdgcn_sinf(fr); }
    }
}

typedef short v4i16_t __attribute__((ext_vector_type(4)));
constexpr int AT_KB = 0, AT_VB = 16384, AT_PS = 32768, AT_MSK = 32768 + 65536;
#define DPP_I(x, ctrl) __builtin_amdgcn_update_dpp((int)(x), (int)(x), (ctrl), 0xF, 0xF, true)
#define DPP_F(x, ctrl) __builtin_bit_cast(float, __builtin_amdgcn_update_dpp(__builtin_bit_cast(int, (float)(x)), __builtin_bit_cast(int, (float)(x)), (ctrl), 0xF, 0xF, true))
__device__ __forceinline__ bf16x8 tr_frag(LAS unsigned char* p0, LAS unsigned char* p1) {
    const v4i16_t a = __builtin_amdgcn_ds_read_tr16_b64_v4i16((LAS v4i16_t*)p0), b = __builtin_amdgcn_ds_read_tr16_b64_v4i16((LAS v4i16_t*)p1);
    return (bf16x8){a[0], a[1], a[2], a[3], b[0], b[1], b[2], b[3]};
}
constexpr size_t TN2_OFF = 786432;
__device__ __forceinline__ void ph_knorm(const Args& a) {
    const bf16_t* KV6 = (const bf16_t*)(a.ws + WS_KV6);
    float* TN2 = (float*)(a.ws + WS_MISC + TN2_OFF);
    const int lane = threadIdx.x & 63, wave = threadIdx.x >> 6;
    const int first = (gridDim.x > 64) ? 64 : 0;
    if ((int)blockIdx.x < first) return;
    const int wi = ((int)blockIdx.x - first) * 8 + wave, nw = ((int)gridDim.x - first) * 8;
    for (int id = wi; id < 4096; id += nw) {
        const int ty = id >> 11, bg = (id >> 7) & 15, tile = id & 127;
        const bf16_t* rp = KV6 + ((size_t)((ty ? 4 : 2) * 16 + bg) * T + tile * 64 + lane) * 64;
        float ssq = 0.f;
#pragma unroll
        for (int c = 0; c < 8; ++c) { const bf16x8 v = *(const bf16x8*)(rp + 8 * c);
#pragma unroll
            for (int j = 0; j < 8; ++j) { const float f = bf2f((bf16_t)v[j]); ssq += f * f; } }
        ssq = wave_max(ssq);
        if (lane == 0) TN2[id] = ssq;
    }
}
__device__ __forceinline__ void attn_qk2(LAS unsigned char* Kb, const bf16x8 (&q)[2][2], int fr, int g4, const float (&cinit)[2], f32x4 (&s)[2][4]) {
#pragma unroll
    for (int c = 0; c < 4; ++c) {
#pragma unroll
        for (int rb = 0; rb < 2; ++rb) s[rb][c] = (f32x4){cinit[rb], cinit[rb], cinit[rb], cinit[rb]};
#pragma unroll
        for (int ks = 0; ks < 2; ++ks) {
            const bf16x8 kf = *(const LAS bf16x8*)(Kb + pg8::lds_byte(16 * c + fr, 32 * ks + 8 * g4));
#pragma unroll
            for (int rb = 0; rb < 2; ++rb) s[rb][c] = __builtin_amdgcn_mfma_f32_16x16x32_bf16(kf, q[rb][ks], s[rb][c], 0, 0, 0);
        }
    }
}
__device__ __forceinline__ void attn_qk2z(LAS unsigned char* Kb, const bf16x8 (&q)[2][2], int fr, int g4, f32x4 (&s)[2][4]) {
    bf16x8 kf[4][2];
#pragma unroll
    for (int c = 0; c < 4; ++c)
#pragma unroll
        for (int ks = 0; ks < 2; ++ks) kf[c][ks] = *(const LAS bf16x8*)(Kb + pg8::lds_byte(16 * c + fr, 32 * ks + 8 * g4));
    __builtin_amdgcn_sched_barrier(0);
#pragma unroll
    for (int c = 0; c < 4; ++c) {
#pragma unroll
        for (int ks = 0; ks < 2; ++ks) {
#pragma unroll
            for (int rb = 0; rb < 2; ++rb) s[rb][c] = __builtin_amdgcn_mfma_f32_16x16x32_bf16(kf[c][ks], q[rb][ks], ks == 0 ? (f32x4){0.f, 0.f, 0.f, 0.f} : s[rb][c], 0, 0, 0);
        }
    }
}
struct AttnRow { float m; f32x4 o[4]; f32x4 ol; };
__device__ __forceinline__ float max3f(float a, float b, float c) { float r; asm("v_max3_f32 %0, %1, %2, %3" : "=v"(r) : "v"(a), "v"(b), "v"(c)); return r; }
__device__ __forceinline__ bool attn_sm2(f32x4 (&s)[4], AttnRow& st, int kbase, int g4, int lo, int hi, bool en, bool emask) {
    const float NEG = -INFINITY;
    if (emask) {
#pragma unroll
        for (int c = 0; c < 4; ++c)
#pragma unroll
            for (int i = 0; i < 4; ++i) { const int key = kbase + 16 * c + 4 * g4 + i; if (key < lo || key > hi) s[c][i] = NEG; }
    }
    float mx = max3f(s[0][0], s[0][1], s[0][2]); mx = max3f(mx, s[0][3], s[1][0]); mx = max3f(mx, s[1][1], s[1][2]); mx = max3f(mx, s[1][3], s[2][0]);
    mx = max3f(mx, s[2][1], s[2][2]); mx = max3f(mx, s[2][3], s[3][0]); mx = max3f(mx, s[3][1], s[3][2]); mx = max3f(mx, s[3][3], mx);
    if (!en) mx = NEG;
    mx = max3f(mx, __shfl_xor(mx, 16), mx); mx = max3f(mx, __shfl_xor(mx, 32), mx);
    const float delta = (mx > 20.0f) ? mx : 0.f;
    const bool moved = __builtin_amdgcn_ballot_w64(delta != 0.f) != 0ull;
    if (moved) {
        const float alpha = __builtin_amdgcn_exp2f(-delta);
#pragma unroll
        for (int c = 0; c < 4; ++c) s[c] = s[c] - delta;
#pragma unroll
        for (int dt = 0; dt < 4; ++dt) st.o[dt] *= alpha;
        st.ol *= alpha;
        st.m += delta;
    }
#pragma unroll
    for (int c = 0; c < 4; ++c)
#pragma unroll
        for (int i = 0; i < 4; ++i) s[c][i] = __builtin_amdgcn_exp2f(s[c][i]);
    return moved;
}
__device__ __forceinline__ bool attn_sm2x(f32x4 (&s)[2][4], AttnRow (&st)[2], int kbase, int g4, const int (&lo)[2], const int (&hi)[2], const bool (&en)[2], bool emask) {
    const float NEG = -INFINITY;
    if (emask) {
#pragma unroll
        for (int rb = 0; rb < 2; ++rb)
#pragma unroll
            for (int c = 0; c < 4; ++c)
#pragma unroll
                for (int i = 0; i < 4; ++i) { const int key = kbase + 16 * c + 4 * g4 + i; if (key < lo[rb] || key > hi[rb]) s[rb][c][i] = NEG; }
    }
    float mx[2];
#pragma unroll
    for (int rb = 0; rb < 2; ++rb) {
        float m = max3f(s[rb][0][0], s[rb][0][1], s[rb][0][2]); m = max3f(m, s[rb][0][3], s[rb][1][0]); m = max3f(m, s[rb][1][1], s[rb][1][2]); m = max3f(m, s[rb][1][3], s[rb][2][0]);
        m = max3f(m, s[rb][2][1], s[rb][2][2]); m = max3f(m, s[rb][2][3], s[rb][3][0]); m = max3f(m, s[rb][3][1], s[rb][3][2]); m = max3f(m, s[rb][3][3], m);
        mx[rb] = en[rb] ? m : NEG;
    }
    { const float t0 = __shfl_xor(mx[0], 16), t1 = __shfl_xor(mx[1], 16); mx[0] = max3f(mx[0], t0, t0); mx[1] = max3f(mx[1], t1, t1); }
    { const float t0 = __shfl_xor(mx[0], 32), t1 = __shfl_xor(mx[1], 32); mx[0] = max3f(mx[0], t0, t0); mx[1] = max3f(mx[1], t1, t1); }
    const float d0 = (mx[0] > 20.0f) ? mx[0] : 0.f, d1 = (mx[1] > 20.0f) ? mx[1] : 0.f;
    const bool moved = __builtin_amdgcn_ballot_w64((d0 != 0.f) || (d1 != 0.f)) != 0ull;
    if (moved) {
        const float dl[2] = {d0, d1};
#pragma unroll
        for (int rb = 0; rb < 2; ++rb) {
            const float alpha = __builtin_amdgcn_exp2f(-dl[rb]);
#pragma unroll
            for (int c = 0; c < 4; ++c) s[rb][c] = s[rb][c] - dl[rb];
#pragma unroll
            for (int dt = 0; dt < 4; ++dt) st[rb].o[dt] *= alpha;
            st[rb].ol *= alpha; st[rb].m += dl[rb];
        }
    }
#pragma unroll
    for (int rb = 0; rb < 2; ++rb)
#pragma unroll
        for (int c = 0; c < 4; ++c)
#pragma unroll
            for (int i = 0; i < 4; ++i) s[rb][c][i] = __builtin_amdgcn_exp2f(s[rb][c][i]);
    return moved;
}
__device__ __forceinline__ void attn_pv2x(LAS unsigned char* Vb, const f32x4 (&p)[2][4], int vlane, int swz, const unsigned (&enm)[2], const bool (&act)[2], const bf16x8 onesf, AttnRow (&st)[2]) {
#pragma unroll
    for (int ks = 0; ks < 2; ++ks) {
        bf16x8 pb[2];
#pragma unroll
        for (int rb = 0; rb < 2; ++rb) { u32x4 pw = pack8m(p[rb][2 * ks], p[rb][2 * ks + 1]); pw.x &= enm[rb]; pw.y &= enm[rb]; pw.z &= enm[rb]; pw.w &= enm[rb]; pb[rb] = __builtin_bit_cast(bf16x8, pw); }
#pragma unroll
        for (int dt = 0; dt < 4; ++dt) {
            LAS unsigned char* a0 = Vb + vlane + (2 * ks) * 2048 + ((dt ^ swz) * 32);
            const bf16x8 vf = tr_frag(a0, a0 + 2048);
#pragma unroll
            for (int rb = 0; rb < 2; ++rb) if (act[rb]) st[rb].o[dt] = __builtin_amdgcn_mfma_f32_16x16x32_bf16(vf, pb[rb], st[rb].o[dt], 0, 0, 0);
        }
#pragma unroll
        for (int rb = 0; rb < 2; ++rb) if (act[rb]) st[rb].ol = __builtin_amdgcn_mfma_f32_16x16x32_bf16(onesf, pb[rb], st[rb].ol, 0, 0, 0);
    }
}
__device__ __forceinline__ bool attn_max2x(f32x4 (&s)[2][4], int kbase, int g4, const int (&lo)[2], const int (&hi)[2], const bool (&en)[2], bool emask, float (&d)[2]) {
    const float NEG = -INFINITY;
    MFMA_SETTLE(s);
    if (emask) {
#pragma unroll
        for (int rb = 0; rb < 2; ++rb)
#pragma unroll
            for (int c = 0; c < 4; ++c)
#pragma unroll
                for (int i = 0; i < 4; ++i) { const int key = kbase + 16 * c + 4 * g4 + i; if (key < lo[rb] || key > hi[rb]) s[rb][c][i] = NEG; }
    }
    float mx[2];
#pragma unroll
    for (int rb = 0; rb < 2; ++rb) {
        float m = max3f(s[rb][0][0], s[rb][0][1], s[rb][0][2]); m = max3f(m, s[rb][0][3], s[rb][1][0]); m = max3f(m, s[rb][1][1], s[rb][1][2]); m = max3f(m, s[rb][1][3], s[rb][2][0]);
        m = max3f(m, s[rb][2][1], s[rb][2][2]); m = max3f(m, s[rb][2][3], s[rb][3][0]); m = max3f(m, s[rb][3][1], s[rb][3][2]); m = max3f(m, s[rb][3][3], m);
        mx[rb] = en[rb] ? m : NEG;
    }
    { const float t0 = __shfl_xor(mx[0], 16), t1 = __shfl_xor(mx[1], 16); mx[0] = max3f(mx[0], t0, t0); mx[1] = max3f(mx[1], t1, t1); }
    { const float t0 = __shfl_xor(mx[0], 32), t1 = __shfl_xor(mx[1], 32); mx[0] = max3f(mx[0], t0, t0); mx[1] = max3f(mx[1], t1, t1); }
    d[0] = (mx[0] > 20.0f) ? mx[0] : 0.f; d[1] = (mx[1] > 20.0f) ? mx[1] : 0.f;
    return __builtin_amdgcn_ballot_w64((d[0] != 0.f) || (d[1] != 0.f)) != 0ull;
}
__device__ __forceinline__ void attn_rescale2x(f32x4 (&s)[2][4], AttnRow (&st)[2], const float (&d)[2]) {
#pragma unroll
    for (int rb = 0; rb < 2; ++rb) {
        const float alpha = __builtin_amdgcn_exp2f(-d[rb]);
#pragma unroll
        for (int c = 0; c < 4; ++c) s[rb][c] = s[rb][c] - d[rb];
#pragma unroll
        for (int dt = 0; dt < 4; ++dt) st[rb].o[dt] *= alpha;
        st[rb].ol *= alpha; st[rb].m += d[rb];
    }
}
__device__ __forceinline__ void attn_exp1(f32x4 (&s)[4], unsigned enm, bf16x8 (&pb)[2]) {
#pragma unroll
    for (int c = 0; c < 4; ++c)
#pragma unroll
        for (int i = 0; i < 4; ++i) s[c][i] = __builtin_amdgcn_exp2f(s[c][i]);
#pragma unroll
    for (int ks = 0; ks < 2; ++ks) { u32x4 pw = pack8m(s[2 * ks], s[2 * ks + 1]); pw.x &= enm; pw.y &= enm; pw.z &= enm; pw.w &= enm; pb[ks] = __builtin_bit_cast(bf16x8, pw); }
}
__device__ __forceinline__ void attn_pv1(LAS unsigned char* Vb, const bf16x8 (&pb)[2], int vlane, int swz, const bf16x8 onesf, AttnRow& st) {
#pragma unroll
    for (int ks = 0; ks < 2; ++ks) {
#pragma unroll
        for (int dt = 0; dt < 4; ++dt) {
            LAS unsigned char* a0 = Vb + vlane + (2 * ks) * 2048 + ((dt ^ swz) * 32);
            const bf16x8 vf = tr_frag(a0, a0 + 2048);
            st.o[dt] = __builtin_amdgcn_mfma_f32_16x16x32_bf16(vf, pb[ks], st.o[dt], 0, 0, 0);
        }
        st.ol = __builtin_amdgcn_mfma_f32_16x16x32_bf16(onesf, pb[ks], st.ol, 0, 0, 0);
    }
}
__device__ __forceinline__ bool attn_step2x(LAS unsigned char* Vb, f32x4 (&s)[2][4], AttnRow (&st)[2], int kbase, int g4, const int (&lo)[2], const int (&hi)[2], const bool (&en)[2], const unsigned (&enm)[2], bool emask,
                                            int vlane, int swz, const bf16x8 onesf) {
    float d[2];
    const bool moved = attn_max2x(s, kbase, g4, lo, hi, en, emask, d);
    if (moved) attn_rescale2x(s, st, d);
    bf16x8 p0[2], p1[2];
    attn_exp1(s[0], enm[0], p0);
    attn_pv1(Vb, p0, vlane, swz, onesf, st[0]);
    attn_exp1(s[1], enm[1], p1);
    attn_pv1(Vb, p1, vlane, swz, onesf, st[1]);
    return moved;
}
__device__ __forceinline__ void attn_step2x_nomax(LAS unsigned char* Vb, f32x4 (&s)[2][4], AttnRow (&st)[2], int kbase, int g4, const int (&lo)[2], const int (&hi)[2], const unsigned (&enm)[2], bool emask,
                                                  int vlane, int swz, const bf16x8 onesf) {
    if (emask) {
#pragma unroll
        for (int rb = 0; rb < 2; ++rb)
#pragma unroll
            for (int c = 0; c < 4; ++c)
#pragma unroll
                for (int i = 0; i < 4; ++i) { const int key = kbase + 16 * c + 4 * g4 + i; if (key < lo[rb] || key > hi[rb]) s[rb][c][i] = -INFINITY; }
    }
    bf16x8 p0[2], p1[2];
    attn_exp1(s[0], enm[0], p0);
    attn_pv1(Vb, p0, vlane, swz, onesf, st[0]);
    attn_exp1(s[1], enm[1], p1);
    attn_pv1(Vb, p1, vlane, swz, onesf, st[1]);
}
typedef _Float16 f16x4 __attribute__((ext_vector_type(4)));
constexpr int AT4_KB = 0, AT4_VB = 32768, AT2_PS = 65536, AT2_MSK = 65536 + 65536;
__device__ __forceinline__ void ph_attn_fast2(const Args& a, LAS unsigned char* lds) {
    const bf16_t* QN = (const bf16_t*)(a.ws + WS_HN);
    const bf16_t* QR = (const bf16_t*)(a.ws + WS_QR);
    const bf16_t* KV6 = (const bf16_t*)(a.ws + WS_KV6);
    const float* GATES = (const float*)(a.ws + WS_GATES);
    const bf16_t* KC = (const bf16_t*)(a.ws + WS_KC);
    const bf16_t* VC = KC + (size_t)8192 * 64;
    bf16_t* O = (bf16_t*)(a.ws + WS_O);
    const int tid = threadIdx.x, lane = tid & 63, wave = __builtin_amdgcn_readfirstlane(tid >> 6);
    const int fr = lane & 15, g4 = lane >> 4;
    int ksrc, vsrc;
    { int R, C; pg8::stage_rc(wave * 1024 + lane * 16, R, C); ksrc = R * 64 + C;
      const int key = 8 * wave + (lane >> 3), pos = lane & 7, chunk = (pos >> 1) ^ ((key >> 1) & 3); vsrc = key * 64 + (chunk * 2 + (pos & 1)) * 8; }
    const int vlane = (4 * g4 + (fr >> 2)) * 128 + (fr & 3) * 8, swz = (2 * g4 + (fr >> 3)) & 3;
    LAS _Float16* ps = (LAS _Float16*)(lds + AT2_PS + wave * 8192);
    LAS unsigned* mskl = (LAS unsigned*)(lds + AT2_MSK + wave * 128);
    const float NEG = -INFINITY;
    const bf16x8 onesf = (fr == 0) ? (bf16x8){0x3F80, 0x3F80, 0x3F80, 0x3F80, 0x3F80, 0x3F80, 0x3F80, 0x3F80} : (bf16x8){0, 0, 0, 0, 0, 0, 0, 0};
    const int vcu = (gridDim.x % 8 == 0) ? (int)((blockIdx.x % 8) * (gridDim.x / 8) + blockIdx.x / 8) : (int)blockIdx.x;
    int cvt_next = (int)blockIdx.x * 8 + wave; const int cvt_stride = (int)gridDim.x * 8;
    LAS float* cvt_scr = (LAS float*)(lds + AT2_PS + wave * 8448);
    bool cmp_pref = false;
    for (int pr = vcu; pr < 1024; pr += gridDim.x) {
#pragma unroll 1
        for (int half = 0; half < 2; ++half) {
            const int bg = pr >> 6, cc = half ? (127 - (pr & 63)) : (pr & 63);
            const int b = bg >> 2, g = bg & 3, t0 = cc * 64, cur = cc;
            const int head = g * 4 + (fr & 3);
            int trow[2];
            bf16x8 qn[2][2];
#pragma unroll
            for (int rb = 0; rb < 2; ++rb) {
                trow[rb] = t0 + 8 * wave + 4 * rb + (fr >> 2);
#pragma unroll
                for (int ks = 0; ks < 2; ++ks) qn[rb][ks] = *(const bf16x8*)(QN + ((size_t)b * T + trow[rb]) * 1024 + head * 64 + 32 * ks + 8 * g4);
            }
#define TROW_PIN() asm volatile("" : "+v"(trow[0]), "+v"(trow[1]))
#define TOKROW(rb) ((size_t)b * T + trow[rb])
#define GATE(rb, br) (GATES[TOKROW(rb) * 48 + head * 3 + (br)])
            const bf16_t* kcb = KC + (size_t)bg * 512 * 64;
            const bf16_t* kvb = KV6 + (size_t)bg * T * 64;
#define ATK(sl) (((sl) < 4 ? AT4_KB : AT2_PS - 4 * 8192) + (sl) * 8192)
#define ATV(sl) (((sl) < 4 ? AT4_VB : AT2_PS + 32768 - 4 * 8192) + (sl) * 8192)
#define AT_DMA(BR, tile, slot) do { const bf16_t* kp_; const bf16_t* vp_; \
                if ((BR) == 0) { kp_ = kcb + (size_t)(tile) * 4096; vp_ = kp_ + (size_t)8192 * 64; } \
                else { kp_ = kvb + (size_t)((BR) == 1 ? 2 : 4) * 16 * T * 64 + (size_t)(tile) * 4096; vp_ = kp_ + (size_t)16 * T * 64; } \
                __builtin_amdgcn_global_load_lds((const unsigned*)(kp_ + ksrc), (LAS unsigned*)(lds + ATK(slot) + wave * 1024), 16, 0, 0); \
                __builtin_amdgcn_global_load_lds((const unsigned*)(vp_ + vsrc), (LAS unsigned*)(lds + ATV(slot) + wave * 1024), 16, 0, 0); } while (0)
            int ncv[2];
#pragma unroll
            for (int rb = 0; rb < 2; ++rb) ncv[rb] = (trow[rb] >= 31) ? ((trow[rb] - 31) / 16 + 1) : 0;
            const int nct = (((t0 + 63 - 31) / 16 + 1) + 63) >> 6;
            float mc[2], invc[2];
            const int t_lo = t0 + 8 * wave, ncv_lo = (t_lo >= 31) ? ((t_lo - 31) / 16 + 1) : 0;
            {
                float m1[2] = {NEG, NEG}, l1[2] = {0.f, 0.f};
                const float zero2[2] = {0.f, 0.f};
#define CMP1_TILE(J, SLOT, MASKED) do { const int j = (J); const int SLOT_ = (SLOT); \
                    f32x4 s[2][4]; attn_qk2(lds + AT4_KB + SLOT_ * 8192, qn, fr, g4, zero2, s); \
                    _Pragma("unroll") \
                    for (int rb = 0; rb < 2; ++rb) { \
                        float mx = NEG; \
                    _Pragma("unroll") \
                        for (int c = 0; c < 4; ++c) \
                    _Pragma("unroll") \
                            for (int i = 0; i < 4; ++i) { const int n = 64 * j + 16 * c + 4 * g4 + i; if ((MASKED) && n >= ncv[rb]) s[rb][c][i] = NEG; mx = fmaxf(mx, s[rb][c][i]); } \
                        mx = fmaxf(mx, __shfl_xor(mx, 16)); mx = fmaxf(mx, __shfl_xor(mx, 32)); \
                        const float mn = fmaxf(m1[rb], mx), msafe = (mn == NEG) ? 0.f : mn; \
                        const float alpha = (m1[rb] == NEG) ? 0.f : __builtin_amdgcn_exp2f(m1[rb] - msafe); \
                        float sum = 0.f; \
                    _Pragma("unroll") \
                        for (int c = 0; c < 4; ++c) \
                    _Pragma("unroll") \
                            for (int i = 0; i < 4; ++i) sum += __builtin_amdgcn_exp2f(s[rb][c][i] - msafe); \
                        l1[rb] = l1[rb] * alpha + sum; m1[rb] = mn; \
                    } \
                } while (0)
                if (!cmp_pref) { AT_DMA(0, 0, 0); if (nct > 1) AT_DMA(0, 1, 1); } __syncthreads();
                for (int j0 = 0; j0 < nct; j0 += 2) { const int sb = (j0 & 2);
                    if (j0 + 2 < nct) AT_DMA(0, j0 + 2, sb ^ 2);
                    if (j0 + 3 < nct) AT_DMA(0, j0 + 3, (sb ^ 2) + 1);
                    CMP1_TILE(j0, sb, true); if (j0 + 1 < nct) CMP1_TILE(j0 + 1, sb + 1, true);
                    __syncthreads();
                }
#undef CMP1_TILE
#pragma unroll
                for (int rb = 0; rb < 2; ++rb) { float lc = l1[rb]; lc += __shfl_xor(lc, 16); lc += __shfl_xor(lc, 32); invc[rb] = (lc > 0.f) ? -(((m1[rb] == NEG) ? 0.f : m1[rb]) + __builtin_amdgcn_logf(lc)) : 0.f; mc[rb] = (m1[rb] == NEG) ? 0.f : m1[rb]; }
            }
            {
                AttnRow oc[2];
#pragma unroll
                for (int rb = 0; rb < 2; ++rb) { oc[rb].m = 0.f; oc[rb].ol = (f32x4){0.f, 0.f, 0.f, 0.f};
#pragma unroll
                    for (int dt = 0; dt < 4; ++dt) oc[rb].o[dt] = (f32x4){0.f, 0.f, 0.f, 0.f}; }
                const float cin[2] = {invc[0], invc[1]};
                const unsigned full[2] = {0xffffffffu, 0xffffffffu}; const bool both[2] = {true, true};
#define CMP2_TILE(J, SLOT, MASKED) do { const int j = (J); const int SLOT_ = (SLOT); \
                    f32x4 s[2][4]; attn_qk2(lds + AT4_KB + SLOT_ * 8192, qn, fr, g4, cin, s); \
                    _Pragma("unroll") \
                    for (int rb = 0; rb < 2; ++rb) \
                    _Pragma("unroll") \
                        for (int c = 0; c < 4; ++c) { \
                            f16x4 hs; \
                    _Pragma("unroll") \
                            for (int i = 0; i < 4; ++i) { const int n = 64 * j + 16 * c + 4 * g4 + i; const float p = (!(MASKED) || n < ncv[rb]) ? __builtin_amdgcn_exp2f(s[rb][c][i]) : 0.f; s[rb][c][i] = p; \
                                float h = p; h += DPP_F(h, 0xB1); h += DPP_F(h, 0x4E); hs[i] = (_Float16)h; }        \
                            if ((fr & 3) == 0) *(LAS f16x4*)(ps + (4 * rb + (fr >> 2)) * 512 + 64 * j + 16 * c + 4 * g4) = hs; \
                        } \
                    attn_pv2x(lds + AT4_VB + SLOT_ * 8192, s, vlane, swz, full, both, onesf, oc); \
                } while (0)
                const bool reload = nct > 4;
                if (reload) { AT_DMA(0, 0, 0); AT_DMA(0, 1, 1); __syncthreads(); }
                for (int j0 = 0; j0 < nct; j0 += 2) { const int sb = (j0 & 2);
                    if (reload && j0 + 2 < nct) AT_DMA(0, j0 + 2, sb ^ 2);
                    if (reload && j0 + 3 < nct) AT_DMA(0, j0 + 3, (sb ^ 2) + 1);
                    CMP2_TILE(j0, sb, true); if (j0 + 1 < nct) CMP2_TILE(j0 + 1, sb + 1, true);
                    __syncthreads();
                }
#undef CMP2_TILE
                TROW_PIN();
#pragma unroll
                for (int rb = 0; rb < 2; ++rb) { bf16_t* op = O + TOKROW(rb) * 1024 + head * 64 + 4 * g4; const float g0 = GATE(rb, 0);
#pragma unroll
                    for (int dt = 0; dt < 4; ++dt) { const f32x4 v = oc[rb].o[dt] * g0; u32x2 w; w.x = cvt_pk_bf16(v[0], v[1]); w.y = cvt_pk_bf16(v[2], v[3]); *(u32x2*)(op + 16 * dt) = w; } }
            }
            {
                WSYNC();
                const int tl = lane >> 4, li = lane & 15;
                const int nsel = (cur + 1 < 16) ? (cur + 1) : 16;
#pragma unroll 1
                for (int rnd = 0; rnd < 2; ++rnd) {
                    const LAS _Float16* pst = ps + (4 * rnd + tl) * 512;
                    float v[8];
#pragma unroll
                    for (int k = 0; k < 8; ++k) { const int j = li + 16 * k;
                        float x;
                        if (j > cur) x = NEG;
                        else if (j == 0 || j == cur || j == cur - 1) x = INFINITY;
                        else { const int n0 = 4 * j; x = (float)pst[n0 - 1] + 2.0f * ((float)pst[n0] + (float)pst[n0 + 1] + (float)pst[n0 + 2]) + (float)pst[n0 + 3]; }
                        v[k] = x; }
                    int vi[8];
#pragma unroll
                    for (int k = 0; k < 8; ++k) vi[k] = __builtin_bit_cast(int, v[k]);
                    unsigned mm[4] = {0u, 0u, 0u, 0u};
                    for (int it = 0; it < nsel; ++it) {
                        int bv = max(max(max(vi[0], vi[1]), max(vi[2], vi[3])), max(max(vi[4], vi[5]), max(vi[6], vi[7])));
                        bv = max(bv, DPP_I(bv, 0xB1)); bv = max(bv, DPP_I(bv, 0x4E)); bv = max(bv, DPP_I(bv, 0x141)); bv = max(bv, DPP_I(bv, 0x140));
                        int bi = 255;
#pragma unroll
                        for (int k = 7; k >= 0; --k) bi = (vi[k] == bv) ? (li + 16 * k) : bi;
                        bi = min(bi, DPP_I(bi, 0xB1)); bi = min(bi, DPP_I(bi, 0x4E)); bi = min(bi, DPP_I(bi, 0x141)); bi = min(bi, DPP_I(bi, 0x140));
                        const unsigned bit = 1u << (bi & 31); const int wsel = bi >> 5;
                        mm[0] |= (wsel == 0) ? bit : 0u; mm[1] |= (wsel == 1) ? bit : 0u; mm[2] |= (wsel == 2) ? bit : 0u; mm[3] |= (wsel == 3) ? bit : 0u;
                        if ((bi & 15) == li) {
#pragma unroll
                            for (int k = 0; k < 8; ++k) if ((bi >> 4) == k) vi[k] = (int)0xFF800000;
                        }
                    }
                    if (li == 0) { mskl[(4 * rnd + tl) * 4 + 0] = mm[0]; mskl[(4 * rnd + tl) * 4 + 1] = mm[1]; mskl[(4 * rnd + tl) * 4 + 2] = mm[2]; mskl[(4 * rnd + tl) * 4 + 3] = mm[3]; }
                }
                WSYNC();
            }
            bf16x8 qr[2][2];
            TROW_PIN();
#pragma unroll
            for (int rb = 0; rb < 2; ++rb)
#pragma unroll
                for (int ks = 0; ks < 2; ++ks) qr[rb][ks] = *(const bf16x8*)(QR + TOKROW(rb) * 1024 + head * 64 + 32 * ks + 8 * g4);
            bool nomax_slc, nomax_win;
            {
                float qq = 0.f;
#pragma unroll
                for (int rb = 0; rb < 2; ++rb) { float q2 = 0.f;
#pragma unroll
                    for (int ks = 0; ks < 2; ++ks)
#pragma unroll
                        for (int j = 0; j < 8; ++j) { const float x = bf2f((bf16_t)qr[rb][ks][j]); q2 += x * x; }
                    q2 += __shfl_xor(q2, 16); q2 += __shfl_xor(q2, 32); qq = fmaxf(qq, q2); }
                qq = wave_max(qq);
                const float* tn = (const float*)(a.ws + WS_MISC + TN2_OFF) + bg * 128;
                const int jt0w = (t0 >= 511) ? ((t0 - 511) >> 6) : 0;
                float ts = 0.f, tw = 0.f;
#pragma unroll
                for (int h2 = 0; h2 < 2; ++h2) { const int tl_ = lane + 64 * h2; if (tl_ <= cur) { ts = fmaxf(ts, tn[tl_]); if (tl_ >= jt0w) tw = fmaxf(tw, tn[2048 + tl_]); } }
                ts = wave_max(ts); tw = wave_max(tw);
                nomax_slc = __builtin_amdgcn_readfirstlane((qq * ts <= 3500.0f) ? 1 : 0) != 0;
                nomax_win = __builtin_amdgcn_readfirstlane((qq * tw <= 3500.0f) ? 1 : 0) != 0;
            }
            {
                AttnRow ss[2];
#pragma unroll
                for (int rb = 0; rb < 2; ++rb) { ss[rb].m = 0.f; ss[rb].ol = (f32x4){0.f, 0.f, 0.f, 0.f};
#pragma unroll
                    for (int dt = 0; dt < 4; ++dt) ss[rb].o[dt] = (f32x4){0.f, 0.f, 0.f, 0.f}; }
                const int nt_ = cur + 1;
                bool refmoved = false;
#define SLC_PRE(J) const int j_ = (J); bool en[2], act[2]; unsigned enm[2]; \
                    _Pragma("unroll") for (int rb = 0; rb < 2; ++rb) { const unsigned mw = mwg[rb]; \
                        en[rb] = (mw >> (j_ & 31)) & 1u; act[rb] = __any(en[rb]); enm[rb] = en[rb] ? 0xffffffffu : 0u; } const int lo2[2] = {0, 0};
#define SLC_TILE(J, SLOT) do { SLC_PRE(J) \
                    if (act[0] || act[1]) { f32x4 s[2][4]; \
                        if (refmoved) { const float cin[2] = {-ss[0].m, -ss[1].m}; attn_qk2(lds + ATK(SLOT), qr, fr, g4, cin, s); } \
                        else attn_qk2z(lds + ATK(SLOT), qr, fr, g4, s); \
                        refmoved |= attn_step2x(lds + ATV(SLOT), s, ss, 64 * j_, g4, lo2, trow, en, enm, j_ == cur, vlane, swz, onesf); } } while (0)
#define SLC_TILE_NM(J, SLOT) do { SLC_PRE(J) \
                    if (act[0] || act[1]) { f32x4 s[2][4]; attn_qk2z(lds + ATK(SLOT), qr, fr, g4, s); \
                        attn_step2x_nomax(lds + ATV(SLOT), s, ss, 64 * j_, g4, lo2, trow, enm, j_ == cur, vlane, swz, onesf); } } while (0)
#pragma unroll
                for (int i = 0; i < 4; ++i) if (i < nt_) AT_DMA(1, i, i);
                __syncthreads();
#define SLC_LOOP(TILE) for (int j0 = 0; j0 < nt_; j0 += 4) { const int sb = (j0 & 4); \
                    const unsigned mwg[2] = {mskl[(fr >> 2) * 4 + (j0 >> 5)], mskl[(4 + (fr >> 2)) * 4 + (j0 >> 5)]};       \
                    _Pragma("unroll") for (int i = 0; i < 4; ++i) if (j0 + 4 + i < nt_) AT_DMA(1, j0 + 4 + i, (sb ^ 4) + i); \
                    TILE(j0, sb); if (j0 + 1 < nt_) TILE(j0 + 1, sb + 1); if (j0 + 2 < nt_) TILE(j0 + 2, sb + 2); if (j0 + 3 < nt_) TILE(j0 + 3, sb + 3); \
                    __syncthreads(); }
                if (nomax_slc) { SLC_LOOP(SLC_TILE_NM) } else { SLC_LOOP(SLC_TILE) }
#undef SLC_LOOP
#undef SLC_TILE_NM
#undef SLC_PRE
#undef SLC_TILE
                TROW_PIN();
#pragma unroll
                for (int rb = 0; rb < 2; ++rb) { const float l = __shfl(ss[rb].ol[0], fr); const float sc1 = (l > 0.f) ? GATE(rb, 1) / l : 0.f;
                    bf16_t* op = O + TOKROW(rb) * 1024 + head * 64 + 4 * g4;
#pragma unroll
                    for (int dt = 0; dt < 4; ++dt) { const u32x2 pv = *(const u32x2*)(op + 16 * dt); f32x4 v = ss[rb].o[dt] * sc1;
                        v[0] += __uint_as_float(pv.x << 16); v[1] += __uint_as_float(pv.x & 0xffff0000u); v[2] += __uint_as_float(pv.y << 16); v[3] += __uint_as_float(pv.y & 0xffff0000u);
                        u32x2 w; w.x = cvt_pk_bf16(v[0], v[1]); w.y = cvt_pk_bf16(v[2], v[3]); *(u32x2*)(op + 16 * dt) = w; } }
            }
            {
                AttnRow sw[2];
#pragma unroll
                for (int rb = 0; rb < 2; ++rb) { sw[rb].m = 0.f; sw[rb].ol = (f32x4){0.f, 0.f, 0.f, 0.f};
#pragma unroll
                    for (int dt = 0; dt < 4; ++dt) sw[rb].o[dt] = (f32x4){0.f, 0.f, 0.f, 0.f}; }
                const int jt0 = (t0 >= 511) ? ((t0 - 511) >> 6) : 0;
                const int nt_ = cur - jt0 + 1;
                const unsigned full[2] = {0xffffffffu, 0xffffffffu}; const bool both[2] = {true, true};
                bool refmoved = false;
#define WIN_PRE(JJ) const int j = jt0 + (JJ); f32x4 s[2][4]; const bool edge = (j == cur) || (64 * j < t0 + 63 - 511); const int lo2[2] = {trow[0] - 511, trow[1] - 511};
#define WIN_TILE(JJ, SLOT) do { WIN_PRE(JJ) \
                    if (refmoved) { const float cin[2] = {-sw[0].m, -sw[1].m}; attn_qk2(lds + AT4_KB + (SLOT) * 8192, qr, fr, g4, cin, s); } \
                    else attn_qk2z(lds + AT4_KB + (SLOT) * 8192, qr, fr, g4, s); \
                    refmoved |= attn_step2x(lds + AT4_VB + (SLOT) * 8192, s, sw, 64 * j, g4, lo2, trow, both, full, edge, vlane, swz, onesf); } while (0)
#define WIN_TILE_NM(JJ, SLOT) do { WIN_PRE(JJ) attn_qk2z(lds + AT4_KB + (SLOT) * 8192, qr, fr, g4, s); \
                    attn_step2x_nomax(lds + AT4_VB + (SLOT) * 8192, s, sw, 64 * j, g4, lo2, trow, full, edge, vlane, swz, onesf); } while (0)
                AT_DMA(2, jt0, 0); if (nt_ > 1) AT_DMA(2, jt0 + 1, 1); __syncthreads();
#define WIN_LOOP(TILE) for (int j0 = 0; j0 < nt_; j0 += 2) { const int sb = (j0 & 2); \
                    if (j0 + 2 < nt_) AT_DMA(2, jt0 + j0 + 2, sb ^ 2); \
                    if (j0 + 3 < nt_) AT_DMA(2, jt0 + j0 + 3, (sb ^ 2) + 1); \
                    TILE(j0, sb); if (j0 + 1 < nt_) TILE(j0 + 1, sb + 1); \
                    __syncthreads(); }
                if (nomax_win) { WIN_LOOP(WIN_TILE_NM) } else { WIN_LOOP(WIN_TILE) }
#undef WIN_LOOP
#undef WIN_TILE_NM
#undef WIN_PRE
#undef WIN_TILE
                TROW_PIN();
#pragma unroll
                for (int rb = 0; rb < 2; ++rb) { const float l = __shfl(sw[rb].ol[0], fr); const float sc2 = (l > 0.f) ? GATE(rb, 2) / l : 0.f;
                    bf16_t* op = O + TOKROW(rb) * 1024 + head * 64 + 4 * g4;
#pragma unroll
                    for (int dt = 0; dt < 4; ++dt) { const u32x2 pv = *(const u32x2*)(op + 16 * dt); f32x4 v = sw[rb].o[dt] * sc2;
                        v[0] += __uint_as_float(pv.x << 16); v[1] += __uint_as_float(pv.x & 0xffff0000u); v[2] += __uint_as_float(pv.y << 16); v[3] += __uint_as_float(pv.y & 0xffff0000u);
                        u32x2 w; w.x = cvt_pk_bf16(v[0], v[1]); w.y = cvt_pk_bf16(v[2], v[3]); *(u32x2*)(op + 16 * dt) = w; } }
            }
#undef AT_DMA
#undef ATK
#undef ATV
#undef TROW_PIN
#undef TOKROW
#undef GATE
            {
                const int npr = half ? pr + (int)gridDim.x : pr, nhalf = half ^ 1;
                cmp_pref = npr < 1024;
                if (cmp_pref) { const int nbg = npr >> 6, ncc = nhalf ? (127 - (npr & 63)) : (npr & 63);
                    const int nnct = (((ncc * 64 + 63 - 31) / 16 + 1) + 63) >> 6;
                    const bf16_t* nk = KC + (size_t)nbg * 512 * 64;
                    __builtin_amdgcn_global_load_lds((const unsigned*)(nk + ksrc), (LAS unsigned*)(lds + AT4_KB + wave * 1024), 16, 0, 0);
                    __builtin_amdgcn_global_load_lds((const unsigned*)(nk + (size_t)8192 * 64 + vsrc), (LAS unsigned*)(lds + AT4_VB + wave * 1024), 16, 0, 0);
                    if (nnct > 1) {
                        __builtin_amdgcn_global_load_lds((const unsigned*)(nk + 4096 + ksrc), (LAS unsigned*)(lds + AT4_KB + 8192 + wave * 1024), 16, 0, 0);
                        __builtin_amdgcn_global_load_lds((const unsigned*)(nk + (size_t)8192 * 64 + 4096 + vsrc), (LAS unsigned*)(lds + AT4_VB + 8192 + wave * 1024), 16, 0, 0); } } }
            cvt1_run(a, cvt_next, cvt_stride, 2, cvt_scr, lane);
        }
    }
    cvt1_run(a, cvt_next, cvt_stride, 1 << 20, cvt_scr, lane);
}

__device__ __forceinline__ void unpack8(const u32x4 w, float (&f)[8]) {
    f[0] = __uint_as_float(w.x << 16); f[1] = __uint_as_float(w.x & 0xffff0000u); f[2] = __uint_as_float(w.y << 16); f[3] = __uint_as_float(w.y & 0xffff0000u);
    f[4] = __uint_as_float(w.z << 16); f[5] = __uint_as_float(w.z & 0xffff0000u); f[6] = __uint_as_float(w.w << 16); f[7] = __uint_as_float(w.w & 0xffff0000u);
}
__device__ __forceinline__ void ph_convpool_fast(const Args& a, LAS unsigned char* lds) {
    const bf16_t* H0 = (const bf16_t*)(a.ws + WS_H0);
    bf16_t* CAT = (bf16_t*)(a.ws + WS_CAT);
    const float* cw = a.in[4]; const float* cb = a.in[5]; const float* lg = a.in[6]; const float* lb = a.in[7];
    const int tid = threadIdx.x, lane = tid & 63, wave = tid >> 6, ch = lane * 8;
    constexpr int VT_OFF = 0, UT_OFF = 62 * 1024, CW_OFF = UT_OFF + 47 * 1024;
    for (int i = tid; i < 31 * 64; i += 512) { const int k = i >> 6, c8 = (i & 63) * 8;
        const f32x4 w0 = *(const f32x4*)(cw + k * 512 + c8), w1 = *(const f32x4*)(cw + k * 512 + c8 + 4);
        u32x4 o; o.x = pk2(w0[0], w0[1]); o.y = pk2(w0[2], w0[3]); o.z = pk2(w1[0], w1[1]); o.w = pk2(w1[2], w1[3]);
        *(LAS u32x4*)(lds + CW_OFF + k * 1024 + c8 * 2) = o; }
    float bias[8], gam[8], bet[8];
#pragma unroll
    for (int j = 0; j < 8; ++j) { bias[j] = cb[ch + j]; gam[j] = lg[ch + j]; bet[j] = lb[ch + j]; }
    for (int tile = blockIdx.x; tile < M / 32; tile += gridDim.x) {
        const int tok0 = tile * 32, t0 = tok0 & (T - 1);
        __syncthreads();
        for (int i = tid; i < 62 * 64; i += 512) { const int r = i >> 6, c8 = (i & 63) * 8; const int tt = t0 - 30 + r;
            u32x4 v = (u32x4){0u, 0u, 0u, 0u}; if (tt >= 0) v = *(const u32x4*)(H0 + (size_t)(tok0 - 30 + r) * 1024 + 512 + c8);
            *(LAS u32x4*)(lds + VT_OFF + r * 1024 + c8 * 2) = v; }
        for (int i = tid; i < 47 * 64; i += 512) { const int r = i >> 6, c8 = (i & 63) * 8; const int tt = t0 - 15 + r;
            u32x4 v = (u32x4){0u, 0u, 0u, 0u}; if (tt >= 0) v = *(const u32x4*)(H0 + (size_t)(tok0 - 15 + r) * 1024 + c8);
            *(LAS u32x4*)(lds + UT_OFF + r * 1024 + c8 * 2) = v; }
        __syncthreads();
        float acc[4][8];
#pragma unroll
        for (int j = 0; j < 4; ++j)
#pragma unroll
            for (int c = 0; c < 8; ++c) acc[j][c] = bias[c];
#pragma unroll 1
        for (int k = 0; k < 31; ++k) {
            float w[8]; unpack8(*(const LAS u32x4*)(lds + CW_OFF + k * 1024 + ch * 2), w);
#pragma unroll
            for (int j = 0; j < 4; ++j) { float v[8]; unpack8(*(const LAS u32x4*)(lds + VT_OFF + (4 * wave + j + k) * 1024 + ch * 2), v);
#pragma unroll
                for (int c = 0; c < 8; ++c) acc[j][c] += w[c] * v[c]; }
        }
        const int wnd = 2 << (lane >> 4);
#pragma unroll
        for (int j = 0; j < 4; ++j) {
            const int tl = 4 * wave + j, t = t0 + tl; const size_t tok = (size_t)tok0 + tl;
            const int cnt = (t + 1 < wnd) ? (t + 1) : wnd;
            float s[8], self[8];
            unpack8(*(const LAS u32x4*)(lds + UT_OFF + (15 + tl) * 1024 + ch * 2), self);
#pragma unroll
            for (int c = 0; c < 8; ++c) s[c] = self[c];
            for (int k = 1; k < cnt; ++k) { float v[8]; unpack8(*(const LAS u32x4*)(lds + UT_OFF + (15 + tl - k) * 1024 + ch * 2), v);
#pragma unroll
                for (int c = 0; c < 8; ++c) s[c] += v[c]; }
            const float inv = 1.0f / (float)cnt;
            u32x4 o; o.x = pk2(s[0] * inv - self[0], s[1] * inv - self[1]); o.y = pk2(s[2] * inv - self[2], s[3] * inv - self[3]);
            o.z = pk2(s[4] * inv - self[4], s[5] * inv - self[5]); o.w = pk2(s[6] * inv - self[6], s[7] * inv - self[7]);
            *(u32x4*)(CAT + tok * 1024 + ch) = o;
            float sm = 0.f;
#pragma unroll
            for (int c = 0; c < 8; ++c) sm += acc[j][c];
            const float mean = wave_sum(sm) * (1.0f / 512.0f);
            float sq = 0.f;
#pragma unroll
            for (int c = 0; c < 8; ++c) { acc[j][c] -= mean; sq += acc[j][c] * acc[j][c]; }
            const float rstd = rsqrtf(wave_sum(sq) * (1.0f / 512.0f) + LN_EPS);
            float y[8];
#pragma unroll
            for (int c = 0; c < 8; ++c) { const float z = acc[j][c] * rstd * gam[c] + bet[c]; y[c] = z * sigmoidf_(z); }
            u32x4 o2; o2.x = pk2(y[0], y[1]); o2.y = pk2(y[2], y[3]); o2.z = pk2(y[4], y[5]); o2.w = pk2(y[6], y[7]);
            *(u32x4*)(CAT + tok * 1024 + 512 + ch) = o2;
        }
    }
}


__device__ __forceinline__ void ph_route_fast(const float* LOG, const float* bias, unsigned* gcnt, int2* list, unsigned char* ldsg) {
    unsigned* hist = (unsigned*)ldsg; unsigned* base = hist + 256; u32x2* sel = (u32x2*)(ldsg + 2048);
    const int tid = threadIdx.x, lane = tid & 63, wave = tid >> 6;
    const float NEG = -INFINITY;
    const float4 bb = *(const float4*)(bias + lane * 4);
    for (int chunk = blockIdx.x; chunk < M / 128; chunk += gridDim.x) {
        __syncthreads();
        if (tid < 256) hist[tid] = 0u;
        __syncthreads();
        for (int i = 0; i < 16; ++i) {
            const int tl = wave * 16 + i, tok = chunk * 128 + tl;
            const float4 lg = *(const float4*)(LOG + (size_t)tok * 256 + lane * 4);
            const float s0 = sigmoidf_(lg.x), s1 = sigmoidf_(lg.y), s2 = sigmoidf_(lg.z), s3 = sigmoidf_(lg.w);
            float v0 = s0 + bb.x, v1 = s1 + bb.y, v2 = s2 + bb.z, v3 = s3 + bb.w;
            float m1 = fmaxf(v0, v1), m2 = fminf(v0, v1);
            { const float hi = fmaxf(v2, v3), lo = fminf(v2, v3); const float n1 = fmaxf(m1, hi); const float n2 = fmaxf(fminf(m1, hi), fmaxf(m2, lo)); m1 = n1; m2 = n2; }
#pragma unroll
            for (int o = 1; o < 8; o <<= 1) { const float a1 = __shfl_xor(m1, o), a2 = __shfl_xor(m2, o); const float n1 = fmaxf(m1, a1), n2 = fmaxf(fminf(m1, a1), fmaxf(m2, a2)); m1 = n1; m2 = n2; }
            const float gs = m1 + m2; const int mygrp = lane >> 3;
            int rank = 0;
#pragma unroll
            for (int g2 = 0; g2 < 8; ++g2) { const float og = __shfl(gs, g2 * 8); rank += (og > gs || (og == gs && g2 < mygrp)) ? 1 : 0; }
            if (rank >= 4) { v0 = NEG; v1 = NEG; v2 = NEG; v3 = NEG; }
            int my_e = 0; float my_s = 0.f;
#pragma unroll
            for (int it = 0; it < 8; ++it) {
                float bv = v0; int bj = 0;
                if (v1 > bv) { bv = v1; bj = 1; }
                if (v2 > bv) { bv = v2; bj = 2; }
                if (v3 > bv) { bv = v3; bj = 3; }
                int bi = lane * 4 + bj;
#pragma unroll
                for (int o = 1; o < 64; o <<= 1) { const float ov = __shfl_xor(bv, o); const int oi = __shfl_xor(bi, o); if (ov > bv || (ov == bv && oi < bi)) { bv = ov; bi = oi; } }
                const int jj = bi & 3, ol = bi >> 2;
                const float mys = (jj == 0) ? s0 : (jj == 1) ? s1 : (jj == 2) ? s2 : s3;
                const float wsc = __shfl(mys, ol);
                if (lane == ol) { if (jj == 0) v0 = NEG; else if (jj == 1) v1 = NEG; else if (jj == 2) v2 = NEG; else v3 = NEG; }
                if (lane == it) { my_e = bi; my_s = wsc; }
            }
            const float ssum = wave_sum(lane < 8 ? my_s : 0.f);
            if (lane < 8) { const unsigned rk = atomicAdd(&hist[my_e], 1u); u32x2 en; en.x = (unsigned)my_e | (rk << 16); en.y = __float_as_uint(my_s / ssum * 2.5f); sel[tl * 8 + lane] = en; }
        }
        __syncthreads();
        if (tid < 256) { const unsigned h = hist[tid]; base[tid] = h ? atomicAdd(&gcnt[tid], h) : 0u; }
        __syncthreads();
#pragma unroll
        for (int rep = 0; rep < 2; ++rep) { const int idx = tid + rep * 512, tok = chunk * 128 + (idx >> 3), k = idx & 7;
            const u32x2 en = sel[idx]; const unsigned e = en.x & 0xffffu, pos = base[e] + (en.x >> 16);
            list[(size_t)e * LISTCAP + pos] = make_int2(tok * 10 + k, (int)en.y); }
    }
}

__global__ void __launch_bounds__(512, 2) fwd_kernel(Args a) {
    extern __shared__ __attribute__((aligned(16))) unsigned char lds[];
    volatile LAS unsigned* MISC = (volatile LAS unsigned*)((LAS unsigned char*)lds + (LDS_BYTES - 64));
    if (threadIdx.x < 16) MISC[threadIdx.x] = 0u;
    __syncthreads();
    unsigned* ctl = (unsigned*)(a.ws + WS_CTL);
#if MK_ONE_LAUNCH
    (void)xcd_barrier_post(ctl + CW_BAR, MISC + 8);
#define SEAM() do { XcdBarrier b_; b_.bar = (unsigned*)(a.ws + WS_CTL) + CW_BAR; b_.x = xb_xcc_id(); b_.st = MISC + 8; xcd_barrier(b_); } while (0)
#else
#define SEAM() do {} while (0)
#endif
    const int lo = a.ph_lo, hi = a.ph_hi;
#define IN(k) (lo <= (k) && (k) < hi)
#define BOTH(k) (IN(k) && (k) + 1 < hi)
#define X1 ((bf16_t*)(a.ws + WS_X1))
#define X2 ((bf16_t*)(a.ws + WS_X2))
#define LOG ((float*)(a.ws + WS_LOG))

    LAS unsigned char* L = (LAS unsigned char*)lds;
#define LIST ((int2*)(a.ws + WS_LIST))
#ifndef PROBE_DUP_MASK
#define PROBE_DUP_MASK 0u
#endif
#define RUN(k, ...) if (IN(k)) { { __VA_ARGS__ } if ((PROBE_DUP_MASK >> (k)) & 1u) { __syncthreads(); { __VA_ARGS__ } } if (BOTH(k)) SEAM(); }
    RUN(0, ph_prologue(a, L);)
    RUN(1, pg8::DenseSched S; S.init((const bf16_t*)(a.ws + WS_XA), D, (const bf16_t*)(a.ws + WS_WIN0), D, M, 1536);
           EpiInproj0 E{(bf16_t*)(a.ws + WS_H0)};
           pg8::gemm_phase<EpiInproj0, pg8::DenseSched, true>(L, D, 128u, S, E);)
    RUN(2, ph_convpool_fast(a, L);)
    RUN(4, pg8::DenseSched S; S.init((const bf16_t*)(a.ws + WS_CAT), D, (const bf16_t*)(a.ws + WS_WOUT0), D, M, D);
           EpiRes E{a.in[0], nullptr, (bf16_t*)(a.ws + WS_Y)};
           pg8::gemm_phase<EpiRes, pg8::DenseSched, true>(L, D, 128u, S, E);)
    RUN(5, ph_ln((const bf16_t*)(a.ws + WS_Y), a.in[17], a.in[18], X1, (unsigned char*)(a.ws + WS_X8));)
#define MOE_LAYER(P, LAYER, XIN, XOUT, OUTF) \
    RUN(P, pg8::DenseSched S; S.init(XIN, D, (const bf16_t*)(a.ws + WS_WR) + (size_t)(LAYER) * NE * D, D, M, NE); \
           EpiLogits E{LOG}; pg8::gemm_phase<EpiLogits, pg8::DenseSched, true>(L, D, 128u, S, E);) \
    if (IN(P + 1)) { ph_route_fast(LOG, a.in[22] + (LAYER) * NE, ctl + CW_CNT + (LAYER) * 256, LIST, lds); if (BOTH(P + 1)) SEAM(); } \
    RUN(P + 2, const int R = moe_setup256(ctl + CW_CNT + (LAYER) * 256, L); \
            MoeGuSched S{(const char*)(a.ws + WS_X8), (const char*)(a.ws + WS_WGU) + (size_t)(LAYER) * 257 * 512 * 1024, LIST, L, R, (R + 128) * 2, (int)gridDim.x, (int)blockIdx.x}; \
            S.prepare(); EpiGateUp E{(unsigned char*)(a.ws + WS_HID)}; pg8::gemm_phase<EpiGateUp, MoeGuSched, true, true>(L, D / 2, 128u, S, E);) \
    RUN(P + 3, const int R = moe_setup256(ctl + CW_CNT + (LAYER) * 256, L); \
            MoeDownSched S{(const char*)(a.ws + WS_HID), (const char*)(a.ws + WS_WD) + (size_t)(LAYER) * 257 * 1024 * 256, LIST, L, R, R + 128, (int)gridDim.x, (int)blockIdx.x}; \
            S.prepare(); EpiDown E{(unsigned char*)(a.ws + WS_YB), L}; pg8::gemm_phase<EpiDown, MoeDownSched, true, true>(L, FF / 2, 128u, S, E);) \
    RUN(P + 4, ph_combine(a, XIN, a.in[19] + (LAYER) * D, a.in[20] + (LAYER) * D, XOUT, OUTF);)
    MOE_LAYER(6, 0, X1, X2, nullptr)
    RUN(11, pg8::DenseSched S; S.init(X2, D, (const bf16_t*)(a.ws + WS_WINN), D, M, HNW);
            EpiInprojN E{(bf16_t*)(a.ws + WS_HN), (bf16_t*)(a.ws + WS_QR), (bf16_t*)(a.ws + WS_KV6), (float*)(a.ws + WS_GATES), (const float*)(a.ws + WS_MISC) + 1024};
            pg8::gemm_phase<EpiInprojN, pg8::DenseSched, true>(L, D, 128u, S, E);)
    RUN(13, Cmp1Sched S{(const char*)(a.ws + WS_KV6), (const char*)(a.ws + WS_CW1), (int)gridDim.x, (int)blockIdx.x};
            EpiCmp1 E{(bf16_t*)(a.ws + WS_CH1), (const float*)(a.ws + WS_MISC)};
            pg8::gemm_phase<EpiCmp1, Cmp1Sched, true>(L, 2048, 128u, S, E); ph_knorm(a);)
    RUN(14, ph_cmp2(a, lds);)
    RUN(15, ph_attn_fast2(a, L);)
    RUN(16, pg8::DenseSched S; S.init((const bf16_t*)(a.ws + WS_O), D, (const bf16_t*)(a.ws + WS_WOUTN), D, M, D);
            EpiRes E{nullptr, X2, (bf16_t*)(a.ws + WS_Y2)};
            pg8::gemm_phase<EpiRes, pg8::DenseSched, true>(L, D, 128u, S, E);)
    RUN(17, ph_ln((const bf16_t*)(a.ws + WS_Y2), a.in[17] + D, a.in[18] + D, X1, (unsigned char*)(a.ws + WS_X8));)
    MOE_LAYER(18, 1, X1, (bf16_t*)nullptr, a.out)
}

extern "C" void kernel_launch(void* const* d_in, const int* in_sizes, int n_in, void* d_out, int out_size, void* d_ws, size_t ws_size, hipStream_t stream) {
    static int grid = 0;
    if (grid == 0) {
        if (n_in != 29 || out_size != M * D || ws_size < WS_END) { fprintf(stderr, "kernel_launch: unexpected problem (n_in %d out %d ws %zu)\n", n_in, out_size, ws_size); grid = -1; return; }
        int dev = 0, cus = 0;
        if (hipGetDevice(&dev) != hipSuccess || hipDeviceGetAttribute(&cus, hipDeviceAttributeMultiprocessorCount, dev) != hipSuccess) { grid = -1; return; }
        if (hipFuncSetAttribute((const void*)fwd_kernel, hipFuncAttributeMaxDynamicSharedMemorySize, LDS_BYTES) != hipSuccess) { grid = -1; return; }
        int per_cu = 0;
        (void)hipOccupancyMaxActiveBlocksPerMultiprocessor(&per_cu, (const void*)fwd_kernel, 512, LDS_BYTES);
        (void)hipGetLastError();
        grid = cus;
    }
    if (grid < 0) return;
    (void)hipMemsetAsync((char*)d_ws + WS_CTL, 0, CTL_BYTES, stream);
    Args a{};
    for (int i = 0; i < 29; ++i) a.in[i] = (const float*)d_in[i];
    a.out = (float*)d_out; a.ws = (unsigned char*)d_ws;
    for (int i = 0; i < 8; ++i) a.inv_freq[i] = powf(500000.0f, -(float)(2 * i) / 16.0f);
#if MK_ONE_LAUNCH
    a.ph_lo = 0; a.ph_hi = NPHASE;
    hipLaunchKernelGGL(fwd_kernel, dim3(grid), dim3(512), LDS_BYTES, stream, a);
#else
    for (int p = 0; p < NPHASE; ++p) { a.ph_lo = p; a.ph_hi = p + 1; hipLaunchKernelGGL(fwd_kernel, dim3(grid), dim3(512), LDS_BYTES, stream, a); }
#endif
}
```

```cpp
#include <hip/hip_runtime.h>
#include <cstdint>
#include <cstdio>
#include <cmath>

#ifndef MK_ONE_LAUNCH
#define MK_ONE_LAUNCH 1
#endif

#define LAS __attribute__((address_space(3)))
typedef unsigned short bf16_t;
typedef short bf16x8 __attribute__((ext_vector_type(8)));
typedef float f32x4 __attribute__((ext_vector_type(4)));
typedef unsigned u32x2 __attribute__((ext_vector_type(2)));
typedef unsigned u32x4 __attribute__((ext_vector_type(4)));

constexpr int NB = 4, T = 8192, D = 1024, M = NB * T;
constexpr int NE = 256, TOPK = 8, FF = 256;
constexpr int HNW = 2816;
constexpr int LISTCAP = 32768;
constexpr float ALPHA = 1.4142135623730951f;
constexpr float LN_EPS = 1e-5f;
constexpr float QSCALE = 0.125f * 1.4426950408889634f;
constexpr int YB_NSLOT = 9;
constexpr float YB_SCALE = 16.0f;
constexpr int NPHASE = 23;

constexpr size_t MiB = 1u << 20;
constexpr size_t WS_CTL = 0, CTL_BYTES = 1 * MiB;
constexpr size_t WS_X1 = 1 * MiB;
constexpr size_t WS_X2 = WS_X1 + 64 * MiB;
constexpr size_t WS_LOG = WS_X2 + 64 * MiB;
constexpr size_t WS_LIST = WS_LOG + 32 * MiB;
constexpr size_t WS_WTS = WS_LIST + 64 * MiB;
constexpr size_t WS_HID = WS_WTS + 2 * MiB;
constexpr size_t WS_YB = WS_HID + 184 * MiB;
constexpr size_t WS_END_NAIVE = WS_YB + 576 * MiB;
constexpr size_t WS_WIN0 = WS_END_NAIVE;
constexpr size_t WS_WOUT0 = WS_WIN0 + 3 * MiB;
constexpr size_t WS_WINN = WS_WOUT0 + 2 * MiB;
constexpr size_t WS_WOUTN = WS_WINN + 6 * MiB;
constexpr size_t WS_WR = WS_WOUTN + 2 * MiB;
constexpr size_t WS_CW1 = WS_WR + 1 * MiB;
constexpr size_t WS_MISC = WS_CW1 + 2 * MiB;
constexpr size_t WS_WGU = WS_MISC + 1 * MiB;
constexpr size_t WS_X8 = WS_WGU + 257 * MiB;
constexpr float X8_SCALE = 8.0f, W8_SCALE = 64.0f, H8_SCALE = 16.0f;
constexpr size_t WS_WD = WS_WGU + 514 * MiB;
constexpr size_t WS_END = WS_WD + 257 * MiB;
constexpr size_t WS_XA = WS_X2;
constexpr size_t WS_H0 = WS_YB;
constexpr size_t WS_PM = WS_H0 + 64 * MiB;
constexpr size_t WS_CAT = WS_PM + 32 * MiB;
constexpr size_t WS_Y = WS_CAT + 64 * MiB;
constexpr size_t WS_HN = WS_YB;
constexpr size_t WS_KV6 = WS_HN + 64 * MiB;
constexpr size_t WS_QR = WS_HN + 176 * MiB;
constexpr size_t WS_GATES = WS_QR + 64 * MiB;
constexpr size_t WS_CH1 = WS_GATES + 8 * MiB;
constexpr size_t WS_KC = WS_CH1 + 4 * MiB;
constexpr size_t WS_O = WS_KC + 2 * MiB;
constexpr size_t WS_Y2 = WS_O + 64 * MiB;
static_assert(WS_Y2 + 64 * MiB <= WS_END_NAIVE, "overlay");
static_assert(WS_Y + 64 * MiB <= WS_END_NAIVE, "overlay");

constexpr int CW_CNT = 64;
constexpr int CW_BAR = 4096;

constexpr int LDS_BYTES = 163840;

__device__ __forceinline__ float bf2f(bf16_t h) { return __uint_as_float(((unsigned)h) << 16); }
__device__ __forceinline__ bf16_t f2bf(float f) { unsigned u = __float_as_uint(f); return (bf16_t)((u + 0x7fffu + ((u >> 16) & 1u)) >> 16); }
__device__ __forceinline__ unsigned pk2(float lo, float hi) { return (unsigned)f2bf(lo) | ((unsigned)f2bf(hi) << 16); }
__device__ __forceinline__ float wave_sum(float v) {
#pragma unroll
    for (int o = 1; o < 64; o <<= 1) v += __shfl_xor(v, o);
    return v;
}
__device__ __forceinline__ float wave_max(float v) {
#pragma unroll
    for (int o = 1; o < 64; o <<= 1) v = fmaxf(v, __shfl_xor(v, o));
    return v;
}
__device__ __forceinline__ float sigmoidf_(float x) { return 1.0f / (1.0f + __expf(-x)); }
__device__ __forceinline__ float gelu_tanh(float x) {
    const float u = 0.7978845608028654f * (x + 0.044715f * x * x * x);
    const float e = __expf(2.0f * u);
    const float th = 1.0f - 2.0f / (e + 1.0f);
    return 0.5f * x * (1.0f + th);
}
__device__ __forceinline__ bf16x8 cvt8(const float* p) {
    const float4 a = *(const float4*)p, b = *(const float4*)(p + 4);
    bf16x8 r;
    r[0] = (short)f2bf(a.x); r[1] = (short)f2bf(a.y); r[2] = (short)f2bf(a.z); r[3] = (short)f2bf(a.w);
    r[4] = (short)f2bf(b.x); r[5] = (short)f2bf(b.y); r[6] = (short)f2bf(b.z); r[7] = (short)f2bf(b.w);
    return r;
}
__device__ __forceinline__ bf16x8 colk8(const float* W, int N, int k, int col) {
    bf16x8 r;
#pragma unroll
    for (int j = 0; j < 8; ++j) r[j] = (short)f2bf(W[(size_t)(k + j) * N + col]);
    return r;
}
__device__ __forceinline__ bf16x8 zero8() { return (bf16x8){0, 0, 0, 0, 0, 0, 0, 0}; }
#define WSYNC() asm volatile("s_waitcnt lgkmcnt(0)" ::: "memory")

#define XB_TMO      128
#define XB_XCNT(j)  (256  + 64 * (j))
#define XB_XSUB(j)  (1280 + 64 * (j))
#define XB_XGEN(j)  (2304 + 64 * (j))
#define XB_TOP      3328
#define XB_TOPGEN   3392
#define XCD_BAR_WORDS 3456
#define XB_SPIN_CAP (1u << 22)
__device__ __forceinline__ unsigned xb_ld(unsigned* p)              { return __hip_atomic_load(p, __ATOMIC_RELAXED, __HIP_MEMORY_SCOPE_AGENT); }
__device__ __forceinline__ unsigned xb_add(unsigned* p, unsigned v) { return __hip_atomic_fetch_add(p, v, __ATOMIC_RELAXED, __HIP_MEMORY_SCOPE_AGENT); }
__device__ __forceinline__ unsigned xb_xcc_id() { return (unsigned)__builtin_amdgcn_s_getreg((3 << 11) | 20) & 0xFu; }
#define XB_SPIN(cond, bar) do { unsigned _sp = 0; while (cond) { __builtin_amdgcn_s_sleep(1); \
    if ((++_sp & 255u) == 0u) { if (xb_ld(&(bar)[XB_TMO])) break; if (_sp > XB_SPIN_CAP) { atomicAdd(&(bar)[XB_TMO], 1u); break; } } } } while (0)
struct XcdBarrier { unsigned* bar; unsigned x; volatile LAS unsigned* st; };
__device__ __forceinline__ XcdBarrier xcd_barrier_post(unsigned* bar, volatile LAS unsigned* st) {
    XcdBarrier b; b.bar = bar; b.x = xb_xcc_id(); b.st = st;
    if (threadIdx.x == 0) (void)xb_add(&bar[XB_XCNT(b.x)], 1u);
    return b;
}
__device__ __forceinline__ void xcd_barrier_complete(unsigned* bar, unsigned x, unsigned& nloc, unsigned& nx) {
    const unsigned G = gridDim.x * gridDim.y * gridDim.z;
    unsigned sum, cnt, mine, sp = 0u;
    for (;;) {
        sum = 0u; cnt = 0u; mine = 0u;
#pragma unroll
        for (unsigned j = 0; j < 16; ++j) { const unsigned c = xb_ld(&bar[XB_XCNT(j)]); sum += c; cnt += (c > 0u) ? 1u : 0u; mine = (j == x) ? c : mine; }
        if (sum == G) break;
        __builtin_amdgcn_s_sleep(1);
        if ((++sp & 255u) == 0u) { if (xb_ld(&bar[XB_TMO])) break; if (sp > XB_SPIN_CAP) { atomicAdd(&bar[XB_TMO], 1u); break; } }
    }
    nloc = mine > 0u ? mine : 1u; nx = cnt > 0u ? cnt : 1u;
}
__device__ __forceinline__ void xcd_barrier(const XcdBarrier& b) {
    asm volatile("s_waitcnt vmcnt(0)" ::: "memory");
    __syncthreads();
    if (threadIdx.x == 0) {
        unsigned* bar = b.bar;
        __builtin_amdgcn_s_waitcnt(0);
        unsigned nloc = b.st[0], nx = b.st[1];
        if (nloc == 0u) { xcd_barrier_complete(bar, b.x, nloc, nx); b.st[0] = nloc; b.st[1] = nx; }
        const unsigned old = xb_add(&bar[XB_XSUB(b.x)], 1u);
        const unsigned gen = old / nloc;
        if (old + 1u == (gen + 1u) * nloc) {
            __builtin_amdgcn_fence(__ATOMIC_RELEASE, "agent");
            asm volatile("s_waitcnt vmcnt(0)" ::: "memory");
            const unsigned og = xb_add(&bar[XB_TOP], 1u);
            const unsigned tg = og / nx;
            if (og + 1u == (tg + 1u) * nx) xb_add(&bar[XB_TOPGEN], 1u);
            else XB_SPIN(xb_ld(&bar[XB_TOPGEN]) == tg, bar);
            __builtin_amdgcn_fence(__ATOMIC_ACQUIRE, "agent");
            xb_add(&bar[XB_XGEN(b.x)], 1u);
            asm volatile("s_waitcnt vmcnt(0)" ::: "memory");
        } else {
            XB_SPIN(xb_ld(&bar[XB_XGEN(b.x)]) == gen, bar);
            __builtin_amdgcn_fence(__ATOMIC_ACQUIRE, "agent");
            asm volatile("s_waitcnt vmcnt(0)" ::: "memory");
        }
    }
    __syncthreads();
}

template <class AL, class BL, class EP>
__device__ __forceinline__ void mgemm_tile(unsigned char* lds, int K, const AL& al, const BL& bl, const EP& ep) {
    bf16_t* As = (bf16_t*)lds;
    bf16_t* Bs = As + 128 * 40;
    const int tid = threadIdx.x, lane = tid & 63, wave = tid >> 6;
    const int ar = tid >> 2, ac = (tid & 3) * 8;
    const int bn = tid & 127, bc = (tid >> 7) * 8;
    f32x4 acc[8];
#pragma unroll
    for (int s = 0; s < 8; ++s) acc[s] = (f32x4){0.f, 0.f, 0.f, 0.f};
    bf16x8 ra = al(ac), rb = bl(bc);
    for (int k0 = 0; k0 < K; k0 += 32) {
        __syncthreads();
        *(bf16x8*)(As + ar * 40 + ac) = ra;
        *(bf16x8*)(Bs + bn * 40 + bc) = rb;
        __syncthreads();
        if (k0 + 32 < K) { ra = al(k0 + 32 + ac); rb = bl(k0 + 32 + bc); }
        const bf16x8 af = *(const bf16x8*)(As + (wave * 16 + (lane & 15)) * 40 + (lane >> 4) * 8);
#pragma unroll
        for (int s = 0; s < 8; ++s) {
            const bf16x8 wf = *(const bf16x8*)(Bs + (16 * s + (lane & 15)) * 40 + (lane >> 4) * 8);
            acc[s] = __builtin_amdgcn_mfma_f32_16x16x32_bf16(wf, af, acc[s], 0, 0, 0);
        }
    }
    ep(wave * 16 + (lane & 15), (lane >> 4) * 4, acc);
}
__device__ __forceinline__ void store4bf(bf16_t* p, const f32x4 v) { u32x2 w; w.x = pk2(v[0], v[1]); w.y = pk2(v[2], v[3]); *(u32x2*)p = w; }

struct Args {
    const float* in[29];
    float* out;
    unsigned char* ws;
    float inv_freq[8];
    int ph_lo, ph_hi;
};

__device__ __forceinline__ unsigned pk4_fp8(float a, float b, float c, float d) { int w = __builtin_amdgcn_cvt_pk_fp8_f32(a, b, 0, false); return (unsigned)__builtin_amdgcn_cvt_pk_fp8_f32(c, d, w, true); }
__device__ __forceinline__ u32x2 pack8_fp8(const f32x4 v0, const f32x4 v1) {
    int a = __builtin_amdgcn_cvt_pk_fp8_f32(v0[0], v0[1], 0, false); a = __builtin_amdgcn_cvt_pk_fp8_f32(v0[2], v0[3], a, true);
    int b = __builtin_amdgcn_cvt_pk_fp8_f32(v1[0], v1[1], 0, false); b = __builtin_amdgcn_cvt_pk_fp8_f32(v1[2], v1[3], b, true);
    u32x2 w; w.x = (unsigned)a; w.y = (unsigned)b; return w;
}
__device__ __forceinline__ float clamp8(float v) { return __builtin_amdgcn_fmed3f(v, -448.0f, 448.0f); }
__device__ __forceinline__ void ph_ln(const bf16_t* Y, const float* g, const float* b, bf16_t* X, unsigned char* X8) {
    const int lane = threadIdx.x & 63, wave = threadIdx.x >> 6;
    const int gw = blockIdx.x * 8 + wave, ngw = gridDim.x * 8;
    float gg[16], bb[16];
#pragma unroll
    for (int j = 0; j < 8; ++j) { gg[j] = g[lane * 8 + j]; gg[8 + j] = g[512 + lane * 8 + j]; bb[j] = b[lane * 8 + j]; bb[8 + j] = b[512 + lane * 8 + j]; }
    for (int row0 = gw * 4; row0 < M; row0 += ngw * 4) {
        bf16x8 p0[4], p1[4];
#pragma unroll
        for (int r = 0; r < 4; ++r) { p0[r] = __builtin_nontemporal_load((const bf16x8*)(Y + (size_t)(row0 + r) * 1024 + lane * 8)); p1[r] = __builtin_nontemporal_load((const bf16x8*)(Y + (size_t)(row0 + r) * 1024 + 512 + lane * 8)); }
#pragma unroll
        for (int r = 0; r < 4; ++r) {
            float v[16];
#pragma unroll
            for (int j = 0; j < 8; ++j) { v[j] = bf2f((bf16_t)p0[r][j]); v[8 + j] = bf2f((bf16_t)p1[r][j]); }
            float s = 0.f;
#pragma unroll
            for (int j = 0; j < 16; ++j) s += v[j];
            const float mean = wave_sum(s) * (1.0f / 1024.0f);
            float q = 0.f;
#pragma unroll
            for (int j = 0; j < 16; ++j) { v[j] -= mean; q += v[j] * v[j]; }
            const float rstd = rsqrtf(wave_sum(q) * (1.0f / 1024.0f) + LN_EPS);
            float o[16];
#pragma unroll
            for (int j = 0; j < 16; ++j) o[j] = v[j] * rstd * gg[j] + bb[j];
            u32x4 w0, w1;
            w0.x = pk2(o[0], o[1]); w0.y = pk2(o[2], o[3]); w0.z = pk2(o[4], o[5]); w0.w = pk2(o[6], o[7]);
            w1.x = pk2(o[8], o[9]); w1.y = pk2(o[10], o[11]); w1.z = pk2(o[12], o[13]); w1.w = pk2(o[14], o[15]);
            *(u32x4*)(X + (size_t)(row0 + r) * 1024 + lane * 8) = w0; *(u32x4*)(X + (size_t)(row0 + r) * 1024 + 512 + lane * 8) = w1;
#pragma unroll
            for (int j = 0; j < 16; ++j) o[j] = clamp8(o[j] * X8_SCALE);
            u32x2 q0, q1; q0.x = pk4_fp8(o[0], o[1], o[2], o[3]); q0.y = pk4_fp8(o[4], o[5], o[6], o[7]); q1.x = pk4_fp8(o[8], o[9], o[10], o[11]); q1.y = pk4_fp8(o[12], o[13], o[14], o[15]);
            *(u32x2*)(X8 + (size_t)(row0 + r) * 1024 + lane * 8) = q0; *(u32x2*)(X8 + (size_t)(row0 + r) * 1024 + 512 + lane * 8) = q1;
        }
    }
}

__device__ __forceinline__ void ph_combine(const Args& a, const bf16_t* X, const float* g, const float* b, bf16_t* Xo, float* outf) {
    const unsigned char* YB = (const unsigned char*)(a.ws + WS_YB);
    const int lane = threadIdx.x & 63, wave = threadIdx.x >> 6;
    const int gw = blockIdx.x * 8 + wave, ngw = gridDim.x * 8;
    for (int row = gw; row < M; row += ngw) {
        float v[16];
#pragma unroll
        for (int j = 0; j < 16; ++j) v[j] = 0.f;
        u32x2 q0[YB_NSLOT], q1[YB_NSLOT];
#pragma unroll
        for (int k = 0; k < YB_NSLOT; ++k) { const unsigned char* yr = YB + ((size_t)row * 10 + k) * 1024; q0[k] = __builtin_nontemporal_load((const u32x2*)(yr + lane * 8)); q1[k] = __builtin_nontemporal_load((const u32x2*)(yr + 512 + lane * 8)); }
#pragma unroll
        for (int k = 0; k < YB_NSLOT; ++k) {
            const auto a0 = __builtin_amdgcn_cvt_pk_f32_fp8((int)q0[k].x, false), a1 = __builtin_amdgcn_cvt_pk_f32_fp8((int)q0[k].x, true), a2 = __builtin_amdgcn_cvt_pk_f32_fp8((int)q0[k].y, false), a3 = __builtin_amdgcn_cvt_pk_f32_fp8((int)q0[k].y, true);
            const auto b0 = __builtin_amdgcn_cvt_pk_f32_fp8((int)q1[k].x, false), b1 = __builtin_amdgcn_cvt_pk_f32_fp8((int)q1[k].x, true), b2 = __builtin_amdgcn_cvt_pk_f32_fp8((int)q1[k].y, false), b3 = __builtin_amdgcn_cvt_pk_f32_fp8((int)q1[k].y, true);
            v[0] += a0[0]; v[1] += a0[1]; v[2] += a1[0]; v[3] += a1[1]; v[4] += a2[0]; v[5] += a2[1]; v[6] += a3[0]; v[7] += a3[1];
            v[8] += b0[0]; v[9] += b0[1]; v[10] += b1[0]; v[11] += b1[1]; v[12] += b2[0]; v[13] += b2[1]; v[14] += b3[0]; v[15] += b3[1];
        }
        {
            const bf16x8 p0 = *(const bf16x8*)(X + (size_t)row * 1024 + lane * 8), p1 = *(const bf16x8*)(X + (size_t)row * 1024 + 512 + lane * 8);
#pragma unroll
            for (int j = 0; j < 8; ++j) { v[j] = v[j] * (1.0f / YB_SCALE) + ALPHA * bf2f((bf16_t)p0[j]); v[8 + j] = v[8 + j] * (1.0f / YB_SCALE) + ALPHA * bf2f((bf16_t)p1[j]); }
        }
        float s = 0.f;
#pragma unroll
        for (int j = 0; j < 16; ++j) s += v[j];
        const float mean = wave_sum(s) * (1.0f / 1024.0f);
        float q = 0.f;
#pragma unroll
        for (int j = 0; j < 16; ++j) { v[j] -= mean; q += v[j] * v[j]; }
        const float rstd = rsqrtf(wave_sum(q) * (1.0f / 1024.0f) + LN_EPS);
        float o[16];
#pragma unroll
        for (int j = 0; j < 8; ++j) { o[j] = v[j] * rstd * g[lane * 8 + j] + b[lane * 8 + j]; o[8 + j] = v[8 + j] * rstd * g[512 + lane * 8 + j] + b[512 + lane * 8 + j]; }
        if (outf) {
            float* op = outf + (size_t)row * 1024;
            *(float4*)(op + lane * 8) = make_float4(o[0], o[1], o[2], o[3]); *(float4*)(op + lane * 8 + 4) = make_float4(o[4], o[5], o[6], o[7]);
            *(float4*)(op + 512 + lane * 8) = make_float4(o[8], o[9], o[10], o[11]); *(float4*)(op + 512 + lane * 8 + 4) = make_float4(o[12], o[13], o[14], o[15]);
        } else {
            u32x4 w0, w1;
            w0.x = pk2(o[0], o[1]); w0.y = pk2(o[2], o[3]); w0.z = pk2(o[4], o[5]); w0.w = pk2(o[6], o[7]);
            w1.x = pk2(o[8], o[9]); w1.y = pk2(o[10], o[11]); w1.z = pk2(o[12], o[13]); w1.w = pk2(o[14], o[15]);
            *(u32x4*)(Xo + (size_t)row * 1024 + lane * 8) = w0; *(u32x4*)(Xo + (size_t)row * 1024 + 512 + lane * 8) = w1;
        }
    }
}

__device__ __forceinline__ void ph_cmp2(const Args& a, unsigned char* lds) {
    const bf16_t* CH1 = (const bf16_t*)(a.ws + WS_CH1);
    bf16_t* KC = (bf16_t*)(a.ws + WS_KC);
    const int tid = threadIdx.x;
    for (int u = blockIdx.x; u < 64 * 2; u += gridDim.x) {
        const int rt = u >> 1, kv = u & 1;
        const bf16_t* ar = CH1 + ((size_t)kv * 8192 + rt * 128 + (tid >> 2)) * 128;
        const float* w2 = a.in[kv ? 15 : 12];
        const int col = tid & 127;
        auto al = [&](int k) { return *(const bf16x8*)(ar + k); };
        auto bl = [&](int k) { return (col < 64) ? colk8(w2, 64, k, col) : zero8(); };
        auto ep = [&](int r, int cb, const f32x4 (&acc)[8]) {
            bf16_t* o = KC + ((size_t)kv * 8192 + rt * 128 + r) * 64;
#pragma unroll
            for (int s = 0; s < 4; ++s) store4bf(o + 16 * s + cb, acc[s]);
        };
        mgemm_tile(lds, 128, al, bl, ep);
    }
}

namespace pg8 {
constexpr int BM = 256, BK = 64, HALF = 128, HTB = HALF * BK * 2, STAGE_BYTES = 8 * HTB;
__device__ __forceinline__ int lds_byte(int r, int c) { const int st = (r >> 4) * 2 + (c >> 5), rr = r & 15, cc = c & 31, ob = rr * 64 + cc * 2; return st * 1024 + (ob ^ (((ob >> 9) & 1) << 5)); }
__device__ __forceinline__ void stage_rc(int b, int& R, int& C) { const int st = b / 1024, sb = b % 1024, swz = sb ^ (((sb >> 9) & 1) << 5); R = (st >> 1) * 16 + swz / 64; C = (st & 1) * 32 + (swz % 64) / 2; }
__device__ __forceinline__ int perm32(int rho) { const int n = rho >> 4, i = rho & 15; return 8 * (i >> 2) + 4 * n + (i & 3); }
struct Unit { int pm, pn, ord; };
typedef float f32x16 __attribute__((ext_vector_type(16)));
typedef int i32x8 __attribute__((ext_vector_type(8))); typedef int i32x4_ __attribute__((ext_vector_type(4)));
__device__ __forceinline__ i32x8 f8cat(const bf16x8 lo, const bf16x8 hi) { return __builtin_shufflevector(__builtin_bit_cast(i32x4_, lo), __builtin_bit_cast(i32x4_, hi), 0, 1, 2, 3, 4, 5, 6, 7); }
template <class Epi, class Sched, bool ALIGN_EPI, bool F8 = false>
__device__ __forceinline__ void gemm_phase(LAS unsigned char* lds, const int K, const unsigned kstepA, const Sched& S, const Epi& E) {
    const int tid = threadIdx.x, wid = __builtin_amdgcn_readfirstlane(tid >> 6), lane = tid & 63, wr = wid >> 2, wc = wid & 3, fr = lane & 15, fq = lane >> 4;
    const int nt = K / BK;
    constexpr bool GA = Sched::GATHER;
    int RA[2]; unsigned CA2[2], voffB[2], voffB1[2], voffA[2];
    constexpr bool P16 = Epi::PERM16;
#pragma unroll
    for (int i = 0; i < 2; ++i) { int R, C; stage_rc(tid * 16 + i * 8192, R, C); const int Rb = Epi::PERM ? ((R & ~31) + perm32(R & 31)) : R;
        RA[i] = R; CA2[i] = (unsigned)C * 2u; voffB[i] = (unsigned)(Rb * K + C) * 2u; voffA[i] = GA ? 0u : (S.lane_off(R) + (unsigned)C * 2u);
        if (P16) { const int c16 = 64 * (R >> 5) + 16 * ((R >> 2) & 3) + 4 * ((R >> 4) & 1) + (R & 3); voffB[i] = (unsigned)(c16 * K + C) * 2u; voffB1[i] = (unsigned)((c16 + 8) * K + C) * 2u; } else voffB1[i] = 0u; }
    const size_t kstepB = (size_t)(BK * 2);
    const size_t hstepB = (size_t)HALF * K * 2;
    const unsigned ldsw = (unsigned)wid * 1024u;
    const int aoff = lds_byte(wr * 64 + fr, fq * 8), boff = lds_byte(wc * 32 + fr, fq * 8);
    const char* const Ab = S.abase();
    unsigned aoC[2][2], aoN[2][2];
    unsigned uC[2], uN[2];
#define PG8_SA(b, h) (((b) * 2 + (h)) * HTB)
#define PG8_SB(b, h) ((4 + (b) * 2 + (h)) * HTB)
#define PG8_GLDS(sbase, voff, ldsoff) do { const char* _b = (const char*)(sbase); unsigned _v = (voff); asm volatile("" : "+s"(_b), "+v"(_v)); \
        __builtin_amdgcn_global_load_lds((const unsigned*)(_b + _v), (LAS unsigned*)(lds + (ldsoff)), 16, 0, 0); } while (0)
#define PG8_STAGE_B(bufoff, gbase) do { _Pragma("unroll") for (int _i = 0; _i < 2; ++_i) PG8_GLDS(gbase, voffB[_i], (bufoff) + ldsw + _i * 8192); } while (0)
#define PG8_STAGE_B1(bufoff, gbase) do { _Pragma("unroll") for (int _i = 0; _i < 2; ++_i) PG8_GLDS((const char*)(gbase) + (P16 ? (size_t)0 : hstepB), (P16 ? voffB1[_i] : voffB[_i]), (bufoff) + ldsw + _i * 8192); } while (0)
#define PG8_STAGE_A(bufoff, kb, UO, LO) do { _Pragma("unroll") for (int _i = 0; _i < 2; ++_i) PG8_GLDS(Ab + (size_t)((kb) + (UO)), (GA ? (LO)[_i] : voffA[_i]), (bufoff) + ldsw + _i * 8192); } while (0)
#define PG8_LDA(dst, b, h) do { _Pragma("unroll") for (int m = 0; m < 4; ++m) _Pragma("unroll") for (int k = 0; k < 2; ++k) dst[m][k] = *(const LAS bf16x8*)(lds + PG8_SA(b, h) + aoff + m * 2048 + k * 1024); } while (0)
#define PG8_LDB(dst, b, h) do { _Pragma("unroll") for (int n = 0; n < 2; ++n) _Pragma("unroll") for (int k = 0; k < 2; ++k) dst[n][k] = *(const LAS bf16x8*)(lds + PG8_SB(b, h) + boff + n * 2048 + k * 1024); } while (0)
#define PG8_MMA(ai, bj, At, Bt) do { __builtin_amdgcn_s_setprio(1); _Pragma("unroll") for (int m = 0; m < 4; ++m) _Pragma("unroll") for (int n = 0; n < 2; ++n) { \
        if constexpr (F8) { f32x16& _w = accw[ai][bj][m >> 1]; const int _q = ((m & 1) * 2 + n) * 4; f32x4 _c = {_w[_q], _w[_q + 1], _w[_q + 2], _w[_q + 3]}; \
            _c = __builtin_amdgcn_mfma_scale_f32_16x16x128_f8f6f4(f8cat(Bt[n][0], Bt[n][1]), f8cat(At[m][0], At[m][1]), _c, 0, 0, 0, 0, 0, 0); _w[_q] = _c[0]; _w[_q + 1] = _c[1]; _w[_q + 2] = _c[2]; _w[_q + 3] = _c[3]; } \
        else { _Pragma("unroll") for (int k = 0; k < 2; ++k) acc[ai][bj][m][n] = __builtin_amdgcn_mfma_f32_16x16x32_bf16(Bt[n][k], At[m][k], acc[ai][bj][m][n], 0, 0, 0); } } __builtin_amdgcn_s_setprio(0); } while (0)
#define PG8_WAIT_V(n) asm volatile("s_waitcnt vmcnt(" #n ")" ::: "memory")
#define PG8_WAIT_L(n) asm volatile("s_waitcnt lgkmcnt(" #n ")" ::: "memory")
#define PG8_BAR __builtin_amdgcn_s_barrier()
#define PG8_SCHED __builtin_amdgcn_sched_barrier(0)
#define PG8_KPAIR(KB1, KB2, KB3, BP2, BP3) do { \
            PG8_LDB(B0, 0, 0); PG8_LDB(B1, 0, 1); PG8_SCHED; PG8_LDA(At, 0, 0); PG8_STAGE_A(PG8_SA(1, 1), KB1, uC[1], aoC[1]); \
            PG8_WAIT_V(8); PG8_WAIT_L(0); PG8_BAR; PG8_MMA(0, 0, At, B0); PG8_MMA(0, 1, At, B1); PG8_BAR; PG8_SCHED; \
            PG8_LDA(At, 0, 1); PG8_STAGE_B(PG8_SB(0, 0), BP2); PG8_STAGE_B1(PG8_SB(0, 1), BP2); PG8_STAGE_A(PG8_SA(0, 0), KB2, u2[0], a2o[0]); \
            PG8_WAIT_V(8); PG8_WAIT_L(0); PG8_BAR; PG8_MMA(1, 0, At, B0); PG8_MMA(1, 1, At, B1); PG8_BAR; PG8_SCHED; \
            PG8_LDB(B0, 1, 0); PG8_LDB(B1, 1, 1); PG8_SCHED; PG8_LDA(At, 1, 0); PG8_STAGE_A(PG8_SA(0, 1), KB2, u2[1], a2o[1]); \
            PG8_WAIT_V(8); PG8_WAIT_L(0); PG8_BAR; PG8_MMA(0, 0, At, B0); PG8_MMA(0, 1, At, B1); PG8_BAR; PG8_SCHED; \
            PG8_LDA(At, 1, 1); PG8_STAGE_B(PG8_SB(1, 0), BP3); PG8_STAGE_B1(PG8_SB(1, 1), BP3); PG8_STAGE_A(PG8_SA(1, 0), KB3, u2[0], a2o[0]); \
            PG8_WAIT_V(8); PG8_WAIT_L(0); PG8_BAR; PG8_MMA(1, 0, At, B0); PG8_MMA(1, 1, At, B1); PG8_BAR; PG8_SCHED; } while (0)
    Unit cur, nxt; int ui = 0;
    if (!S.next(0, cur)) return;
    f32x4 acc[2][2][4][2];
#pragma unroll
    for (int a = 0; a < 2; ++a)
#pragma unroll
        for (int b = 0; b < 2; ++b)
#pragma unroll
            for (int m = 0; m < 4; ++m)
#pragma unroll
                for (int n = 0; n < 2; ++n) acc[a][b][m][n] = (f32x4){0.f, 0.f, 0.f, 0.f};
    bf16x8 At[4][2], B0[2][2], B1[2][2];
    f32x16 accw[2][2][2];
#define PG8_ZERO_W() do { if constexpr (F8) { _Pragma("unroll") for (int _a = 0; _a < 2; ++_a) _Pragma("unroll") for (int _b = 0; _b < 2; ++_b) _Pragma("unroll") for (int _m = 0; _m < 2; ++_m) _Pragma("unroll") for (int _e = 0; _e < 16; ++_e) accw[_a][_b][_m][_e] = 0.f; } } while (0)
    PG8_ZERO_W();
#pragma unroll
    for (int h = 0; h < 2; ++h) { uC[h] = GA ? 0u : S.unit_off(cur, h); uN[h] = uC[h];
#pragma unroll
        for (int i = 0; i < 2; ++i) { aoC[h][i] = GA ? (S.aoff(cur, h * HALF + RA[i]) + CA2[i]) : 0u; aoN[h][i] = aoC[h][i]; } }
    const char* cB = S.bptr(cur);
    PG8_STAGE_B(PG8_SB(0, 0), cB); PG8_STAGE_B1(PG8_SB(0, 1), cB); PG8_STAGE_A(PG8_SA(0, 0), 0u, uC[0], aoC[0]); PG8_STAGE_A(PG8_SA(0, 1), 0u, uC[1], aoC[1]);
    if (wr == 1) PG8_BAR;
    PG8_WAIT_V(2); PG8_BAR;
    PG8_STAGE_B(PG8_SB(1, 0), cB + kstepB); PG8_STAGE_A(PG8_SA(1, 0), kstepA, uC[0], aoC[0]); PG8_STAGE_B1(PG8_SB(1, 1), cB + kstepB);
    PG8_WAIT_V(6); PG8_BAR;
    for (;;) {
        const bool has_next = S.next(ui + 1, nxt);
        const char* nB = has_next ? S.bptr(nxt) : cB;
#pragma unroll
        for (int h = 0; h < 2; ++h) { uN[h] = (GA || !has_next) ? uC[h] : S.unit_off(nxt, h);
#pragma unroll
            for (int i = 0; i < 2; ++i) aoN[h][i] = (GA && has_next) ? (S.aoff(nxt, h * HALF + RA[i]) + CA2[i]) : aoC[h][i]; }
#pragma nounroll
        for (int t = 0; t < nt; t += 2) {
            const bool last = (t == nt - 2);
            const unsigned kb1 = (unsigned)(t + 1) * kstepA, kb2 = last ? 0u : (unsigned)(t + 2) * kstepA, kb3 = kb2 + kstepA;
            const char* b2 = last ? nB : cB + (size_t)(t + 2) * kstepB; const char* b3 = b2 + kstepB;
            unsigned u2[2], a2o[2][2];
#pragma unroll
            for (int h = 0; h < 2; ++h) { u2[h] = last ? uN[h] : uC[h];
#pragma unroll
                for (int i = 0; i < 2; ++i) a2o[h][i] = GA ? (last ? aoN[h][i] : aoC[h][i]) : 0u; }
            PG8_KPAIR(kb1, kb2, kb3, b2, b3);
        }
        if constexpr (ALIGN_EPI) { if (wr == 0) PG8_BAR; }
        if constexpr (F8) {
#pragma unroll
            for (int _a = 0; _a < 2; ++_a)
#pragma unroll
                for (int _b = 0; _b < 2; ++_b)
#pragma unroll
                    for (int _m = 0; _m < 4; ++_m)
#pragma unroll
                        for (int _n = 0; _n < 2; ++_n) { const f32x16& _w = accw[_a][_b][_m >> 1]; const int _q = ((_m & 1) * 2 + _n) * 4; acc[_a][_b][_m][_n] = (f32x4){_w[_q], _w[_q + 1], _w[_q + 2], _w[_q + 3]}; }
        }
        E(acc, cur, wr, wc, fr, fq);
        PG8_ZERO_W();
        if (!has_next) break;
#pragma unroll
        for (int a = 0; a < 2; ++a)
#pragma unroll
            for (int b = 0; b < 2; ++b)
#pragma unroll
                for (int m = 0; m < 4; ++m)
#pragma unroll
                    for (int n = 0; n < 2; ++n) acc[a][b][m][n] = (f32x4){0.f, 0.f, 0.f, 0.f};
        cur = nxt; cB = nB; ++ui;
#pragma unroll
        for (int h = 0; h < 2; ++h) { uC[h] = uN[h];
#pragma unroll
            for (int i = 0; i < 2; ++i) aoC[h][i] = aoN[h][i]; }
        if constexpr (ALIGN_EPI) { if (wr == 1) PG8_BAR; }
    }
    PG8_WAIT_V(0);
    if constexpr (!ALIGN_EPI) { if (wr == 0) PG8_BAR; }
    PG8_BAR;
#undef PG8_SA
#undef PG8_ZERO_W
#undef PG8_GLDS
#undef PG8_SB
#undef PG8_STAGE_A
#undef PG8_STAGE_B
#undef PG8_STAGE_B1
#undef PG8_LDA
#undef PG8_LDB
#undef PG8_MMA
#undef PG8_WAIT_V
#undef PG8_WAIT_L
#undef PG8_BAR
#undef PG8_SCHED
#undef PG8_KPAIR
}

struct DenseSched {
    const char* A; const char* Bt; unsigned lda2; size_t btile; int nM, nN, nwg, G, c;
    __device__ __forceinline__ void init(const bf16_t* A_, int lda, const bf16_t* Bt_, int K, int Mrows, int N) {
        A = (const char*)A_; Bt = (const char*)Bt_; lda2 = (unsigned)lda * 2u; btile = (size_t)256 * K * 2; nM = Mrows / BM; nN = N / BM; nwg = nM * nN; G = gridDim.x; c = blockIdx.x; }
    __device__ __forceinline__ bool next(int i, Unit& u) const {
        const long L = (long)i * G + c; if (L >= nwg) return false;
        int wgid = (int)L; { const int q = nwg / 8, r = nwg % 8, xcd = wgid % 8, off = wgid / 8; wgid = (xcd < r ? xcd * (q + 1) : r * (q + 1) + (xcd - r) * q) + off; }
        const int nig = 8 * nN, gid = wgid / nig, fm = gid * 8, gsz = (nM - fm) < 8 ? (nM - fm) : 8;
        u.pm = fm + ((wgid % nig) % gsz); u.pn = (wgid % nig) / gsz; u.ord = i; return true;
    }
    static constexpr bool GATHER = false;
    __device__ __forceinline__ unsigned lane_off(int r) const { return (unsigned)r * lda2; }
    __device__ __forceinline__ unsigned unit_off(const Unit& u, int h) const { return (unsigned)(u.pm * BM + h * HALF) * lda2; }
    __device__ __forceinline__ unsigned aoff(const Unit&, int) const { return 0u; }
    __device__ __forceinline__ const char* abase() const { return A; }
    __device__ __forceinline__ const char* bptr(const Unit& u) const { return Bt + (size_t)u.pn * btile; }
};
}
typedef float f32x2_t __attribute__((ext_vector_type(2))); typedef __bf16 bf16x2_t __attribute__((ext_vector_type(2)));
__device__ __forceinline__ unsigned cvt_pk_bf16(float lo, float hi) { const f32x2_t v = {lo, hi}; const bf16x2_t b = __builtin_convertvector(v, bf16x2_t); return __builtin_bit_cast(unsigned, b); }
__device__ __forceinline__ u32x4 pack8(const f32x4 v0, const f32x4 v1) { u32x4 w; w.x = cvt_pk_bf16(v0[0], v0[1]); w.y = cvt_pk_bf16(v0[2], v0[3]); w.z = cvt_pk_bf16(v1[0], v1[1]); w.w = cvt_pk_bf16(v1[2], v1[3]); return w; }
__device__ __forceinline__ unsigned cvtpk_m(float lo, float hi) { const f32x2_t v = {lo, hi}; const bf16x2_t b = __builtin_convertvector(v, bf16x2_t); return __builtin_bit_cast(unsigned, b); }
__device__ __forceinline__ u32x4 pack8m(const f32x4 v0, const f32x4 v1) { u32x4 w; w.x = cvtpk_m(v0[0], v0[1]); w.y = cvtpk_m(v0[2], v0[3]); w.z = cvtpk_m(v1[0], v1[1]); w.w = cvtpk_m(v1[2], v1[3]); return w; }
#define MFMA_SETTLE(S) asm volatile("s_nop 15\n\ts_nop 7" : "+v"(S[0][0]), "+v"(S[0][1]), "+v"(S[0][2]), "+v"(S[0][3]), "+v"(S[1][0]), "+v"(S[1][1]), "+v"(S[1][2]), "+v"(S[1][3]))
__device__ __forceinline__ f32x4 sig4(const f32x4 v) { f32x4 r; r[0] = sigmoidf_(v[0]); r[1] = sigmoidf_(v[1]); r[2] = sigmoidf_(v[2]); r[3] = sigmoidf_(v[3]); return r; }

#define EPI_ROWLOOP for (int ai = 0; ai < 2; ++ai) _Pragma("unroll") for (int m = 0; m < 4; ++m)
struct EpiInproj0 {
    static constexpr bool PERM = true, PERM16 = false; bf16_t* H0;
    __device__ __forceinline__ void operator()(const f32x4 (&acc)[2][2][4][2], const pg8::Unit& u, int wr, int wc, int fr, int fq) const {
        const int row0 = u.pm * 256 + wr * 64 + fr, cl = wc * 32 + 8 * fq;
#pragma unroll
        EPI_ROWLOOP { bf16_t* rp = H0 + (size_t)(row0 + ai * 128 + m * 16) * 1024;
            if (u.pn < 2) {
#pragma unroll
                for (int bj = 0; bj < 2; ++bj) *(u32x4*)(rp + u.pn * 256 + bj * 128 + cl) = pack8(acc[ai][bj][m][0], acc[ai][bj][m][1]);
            } else {
                const f32x4 v0 = acc[ai][0][m][0] * sig4(acc[ai][1][m][0]), v1 = acc[ai][0][m][1] * sig4(acc[ai][1][m][1]);
                *(u32x4*)(rp + 512 + (u.pn - 2) * 128 + cl) = pack8(v0, v1);
            } }
    }
};
struct EpiRes {
    static constexpr bool PERM = true, PERM16 = false; const float* resf; const bf16_t* resb; bf16_t* Y;
    __device__ __forceinline__ void operator()(const f32x4 (&acc)[2][2][4][2], const pg8::Unit& u, int wr, int wc, int fr, int fq) const {
        const int row0 = u.pm * 256 + wr * 64 + fr, c0 = u.pn * 256 + wc * 32 + 8 * fq;
#pragma unroll
        EPI_ROWLOOP { const size_t ro = (size_t)(row0 + ai * 128 + m * 16) * 1024 + c0;
#pragma unroll
            for (int bj = 0; bj < 2; ++bj) {
                f32x4 r0, r1;
                if (resf) { r0 = *(const f32x4*)(resf + ro + bj * 128); r1 = *(const f32x4*)(resf + ro + bj * 128 + 4); }
                else { const u32x4 xv = *(const u32x4*)(resb + ro + bj * 128);
                    r0[0] = __uint_as_float(xv.x << 16); r0[1] = __uint_as_float(xv.x & 0xffff0000u); r0[2] = __uint_as_float(xv.y << 16); r0[3] = __uint_as_float(xv.y & 0xffff0000u);
                    r1[0] = __uint_as_float(xv.z << 16); r1[1] = __uint_as_float(xv.z & 0xffff0000u); r1[2] = __uint_as_float(xv.w << 16); r1[3] = __uint_as_float(xv.w & 0xffff0000u); }
                *(u32x4*)(Y + ro + bj * 128) = pack8(acc[ai][bj][m][0] + r0 * ALPHA, acc[ai][bj][m][1] + r1 * ALPHA);
            } }
    }
};
struct EpiLogits {
    static constexpr bool PERM = true, PERM16 = false; float* LOG;
    __device__ __forceinline__ void operator()(const f32x4 (&acc)[2][2][4][2], const pg8::Unit& u, int wr, int wc, int fr, int fq) const {
        const int row0 = u.pm * 256 + wr * 64 + fr, cl = wc * 32 + 8 * fq;
#pragma unroll
        EPI_ROWLOOP { float* rp = LOG + (size_t)(row0 + ai * 128 + m * 16) * 256 + cl;
#pragma unroll
            for (int bj = 0; bj < 2; ++bj) { *(f32x4*)(rp + bj * 128) = acc[ai][bj][m][0]; *(f32x4*)(rp + bj * 128 + 4) = acc[ai][bj][m][1]; } }
    }
};

constexpr int MOE_TAB_OFF = 131072;
__device__ __forceinline__ int moe_setup256(const unsigned* cnt, LAS unsigned char* lds) {
    LAS int* tstart = (LAS int*)(lds + MOE_TAB_OFF);
    LAS int* scnt = (LAS int*)(lds + MOE_TAB_OFF + 1088);
    LAS unsigned short* texp = (LAS unsigned short*)(lds + MOE_TAB_OFF + 2176);
    const int tid = threadIdx.x;
    __syncthreads();
    if (tid < 256) scnt[tid] = (int)cnt[tid];
    __syncthreads();
    if (tid == 0) { int s = 0; for (int e = 0; e < 256; ++e) { tstart[e] = s; s += (scnt[e] + 255) >> 8; } tstart[256] = s; }
    __syncthreads();
    if (tid < 256) for (int q = tstart[tid]; q < tstart[tid + 1]; ++q) texp[q] = (unsigned short)tid;
    __syncthreads();
    return __builtin_amdgcn_readfirstlane(tstart[256]);
}
constexpr int MOE_TOK_OFF = MOE_TAB_OFF + 5120;
constexpr int MOE_MAX_ORD = 20;
struct MoeGuSched {
    static constexpr bool GATHER = true;
    const char* X; const char* W; const int2* list; LAS unsigned char* lds; int R, nunits, G, c;
    __device__ __forceinline__ int vcu() const { return (G % 8 == 0) ? (c % 8) * (G / 8) + c / 8 : c; }
    __device__ __forceinline__ bool next(int i, pg8::Unit& u) const {
        const int L = i * G + vcu(); if (L >= nunits || i >= MOE_MAX_ORD) return false;
        const int q = L >> 1; const int e = __builtin_amdgcn_readfirstlane((q < R) ? (int)((LAS unsigned short*)(lds + MOE_TAB_OFF + 2176))[q] : 256);
        u.pm = q; u.pn = e * 2 + (L & 1); u.ord = i; return true; }
    __device__ __forceinline__ void prepare() const {
        const int tid = threadIdx.x, r = tid & 255;
        pg8::Unit u;
        for (int i = tid >> 8; next(i, u); i += 2) {
            const int e = u.pn >> 1; int token;
            if (e < 256) { const int ts = ((LAS int*)(lds + MOE_TAB_OFF))[e], cn = ((LAS int*)(lds + MOE_TAB_OFF + 1088))[e]; int lr = (u.pm - ts) * 256 + r; if (lr >= cn) lr = cn - 1;
                token = list[(size_t)e * LISTCAP + lr].x / 10; }
            else token = (u.pm - R) * 256 + r;
            ((LAS unsigned short*)(lds + MOE_TOK_OFF))[i * 256 + r] = (unsigned short)token;
        }
        __syncthreads();
    }
    __device__ __forceinline__ unsigned aoff(const pg8::Unit& u, int r) const { return (unsigned)((LAS unsigned short*)(lds + MOE_TOK_OFF))[u.ord * 256 + r] * 1024u; }
    __device__ __forceinline__ unsigned lane_off(int) const { return 0u; }
    __device__ __forceinline__ unsigned unit_off(const pg8::Unit&, int) const { return 0u; }
    __device__ __forceinline__ const char* abase() const { return X; }
    __device__ __forceinline__ const char* bptr(const pg8::Unit& u) const { return W + (size_t)u.pn * (256 * 1024); }
};
constexpr float GU_SC = 1.0f / (X8_SCALE * W8_SCALE);
struct EpiGateUp {
    static constexpr bool PERM = true, PERM16 = false; unsigned char* HID;
    __device__ __forceinline__ void operator()(const f32x4 (&acc)[2][2][4][2], const pg8::Unit& u, int wr, int wc, int fr, int fq) const {
        const int row0 = u.pm * 256 + wr * 64 + fr, c0 = (u.pn & 1) * 128 + wc * 32 + 8 * fq;
#pragma unroll
        EPI_ROWLOOP { const f32x4 g0 = acc[ai][0][m][0] * GU_SC, g1 = acc[ai][0][m][1] * GU_SC;
            f32x4 h0 = g0 * sig4(g0) * (acc[ai][1][m][0] * (GU_SC * H8_SCALE)), h1 = g1 * sig4(g1) * (acc[ai][1][m][1] * (GU_SC * H8_SCALE));
#pragma unroll
            for (int i = 0; i < 4; ++i) { h0[i] = clamp8(h0[i]); h1[i] = clamp8(h1[i]); }
            *(u32x2*)(HID + (size_t)(row0 + ai * 128 + m * 16) * 256 + c0) = pack8_fp8(h0, h1); }
    }
};
constexpr int MOE_RI_OFF = MOE_TAB_OFF + 5120;
constexpr int MOE_MAX_RT = 6;
struct MoeDownSched {
    const char* HID; const char* W; const int2* list; LAS unsigned char* lds; int R, ntile, G, c;
    __device__ __forceinline__ int vcu() const { return (G % 8 == 0) ? (c % 8) * (G / 8) + c / 8 : c; }
    __device__ __forceinline__ bool next(int i, pg8::Unit& u) const {
        const int q = vcu() + G * (i >> 2); if (q >= ntile || (i >> 2) >= MOE_MAX_RT) return false;
        const int e = (q < R) ? (int)((LAS unsigned short*)(lds + MOE_TAB_OFF + 2176))[q] : 256;
        u.pm = q; u.pn = e * 4 + (i & 3); u.ord = i >> 2; return true; }
    __device__ __forceinline__ void prepare() const {
        const int tid = threadIdx.x, r = tid & 255;
        for (int o = tid >> 8; o < MOE_MAX_RT; o += 2) {
            const int q = vcu() + G * o; if (q >= ntile) break;
            u32x2 en;
            if (q < R) { const int e = ((LAS unsigned short*)(lds + MOE_TAB_OFF + 2176))[q]; const int ts = ((LAS int*)(lds + MOE_TAB_OFF))[e], cn = ((LAS int*)(lds + MOE_TAB_OFF + 1088))[e];
                const int lr = (q - ts) * 256 + r; if (lr < cn) { const int2 le = list[(size_t)e * LISTCAP + lr]; en.x = (unsigned)le.x; en.y = (unsigned)le.y; } else { en.x = 0xffffffffu; en.y = 0u; } }
            else { en.x = (unsigned)(((q - R) * 256 + r) * 10 + 8); en.y = __float_as_uint(1.0f); }
            ((LAS u32x2*)(lds + MOE_RI_OFF))[o * 256 + r] = en;
        }
        __syncthreads();
    }
    static constexpr bool GATHER = false;
    __device__ __forceinline__ unsigned lane_off(int r) const { return (unsigned)r * 256u; }
    __device__ __forceinline__ unsigned unit_off(const pg8::Unit& u, int h) const { return (unsigned)(u.pm * 256 + h * 128) * 256u; }
    __device__ __forceinline__ unsigned aoff(const pg8::Unit&, int) const { return 0u; }
    __device__ __forceinline__ const char* abase() const { return HID; }
    __device__ __forceinline__ const char* bptr(const pg8::Unit& u) const { return W + (size_t)u.pn * (256 * 256); }
};
struct EpiDown {
    static constexpr bool PERM = true, PERM16 = true;
    unsigned char* YB; LAS unsigned char* lds;
    __device__ __forceinline__ void operator()(const f32x4 (&acc)[2][2][4][2], const pg8::Unit& u, int wr, int wc, int fr, int fq) const {
        asm volatile("" : "+v"(fr), "+v"(fq));
        const unsigned c0b = (unsigned)((u.pn & 3) * 256 + wc * 64 + 16 * fq); const bool shared = (u.pn >> 2) == 256;
        const LAS u32x2* ri = (const LAS u32x2*)(lds + MOE_RI_OFF) + u.ord * 256 + wr * 64 + fr;
#pragma unroll
        for (int ai = 0; ai < 2; ++ai)
#pragma unroll
            for (int m = 0; m < 4; ++m) { const u32x2 en = ri[ai * 128 + m * 16]; const float wv = __uint_as_float(en.y) * (YB_SCALE / (H8_SCALE * W8_SCALE));
                if ((int)en.x >= 0) { unsigned char* rp = YB + (size_t)(en.x * 1024u + c0b);
                    const f32x4 v00 = acc[ai][0][m][0] * wv, v01 = acc[ai][0][m][1] * wv, v10 = acc[ai][1][m][0] * wv, v11 = acc[ai][1][m][1] * wv;
                    const u32x2 h0 = pack8_fp8(v00, v01), h1 = pack8_fp8(v10, v11);
                    *(u32x4*)rp = (u32x4){h0.x, h0.y, h1.x, h1.y};
                    if (YB_NSLOT == 10 && shared) {
                        u32x2 r_[2];
#pragma unroll
                        for (int bj = 0; bj < 2; ++bj) { const u32x2 h = bj ? h1 : h0; const f32x4 v0 = bj ? v10 : v00, v1 = bj ? v11 : v01;
                            const auto a0 = __builtin_amdgcn_cvt_pk_f32_fp8((int)h.x, false), a1 = __builtin_amdgcn_cvt_pk_f32_fp8((int)h.x, true), a2 = __builtin_amdgcn_cvt_pk_f32_fp8((int)h.y, false), a3 = __builtin_amdgcn_cvt_pk_f32_fp8((int)h.y, true);
                            const f32x4 r0 = {v0[0] - a0[0], v0[1] - a0[1], v0[2] - a1[0], v0[3] - a1[1]}, r1 = {v1[0] - a2[0], v1[1] - a2[1], v1[2] - a3[0], v1[3] - a3[1]};
                            r_[bj] = pack8_fp8(r0, r1); }
                        *(u32x4*)(rp + 1024) = (u32x4){r_[0].x, r_[0].y, r_[1].x, r_[1].y}; } } }
    }
};

struct EpiInprojN {
    static constexpr bool PERM = true, PERM16 = false; bf16_t* QN; bf16_t* QR; bf16_t* KV6; float* GATES; const float* ROT;
    __device__ __forceinline__ void operator()(const f32x4 (&acc)[2][2][4][2], const pg8::Unit& u, int wr, int wc, int fr, int fq) const {
        const int row0 = u.pm * 256 + wr * 64 + fr, cl = wc * 32 + 8 * fq, pn = u.pn;
        const bool isq = pn < 4, rotk = (pn == 6 || pn == 8), dorot = (isq || rotk) && ((wc & 1) == 0);
#pragma unroll
        EPI_ROWLOOP { const int row = row0 + ai * 128 + m * 16;
            if (pn == 10) {
                if (cl < 48) { *(f32x4*)(GATES + (size_t)row * 48 + cl) = sig4(acc[ai][0][m][0]); *(f32x4*)(GATES + (size_t)row * 48 + cl + 4) = sig4(acc[ai][0][m][1]); }
            } else {
                f32x4 cs0, cs1, sn0, sn1;
                if (dorot) { const float* rt = ROT + (size_t)(row & (T - 1)) * 16; cs0 = *(const f32x4*)rt; cs1 = *(const f32x4*)(rt + 4); sn0 = *(const f32x4*)(rt + 8); sn1 = *(const f32x4*)(rt + 12); }
#pragma unroll
                for (int bj = 0; bj < 2; ++bj) {
                    const f32x4 v0 = acc[ai][bj][m][0], v1 = acc[ai][bj][m][1];
                    f32x4 r0 = v0, r1 = v1;
                    if (dorot) {
                        f32x4 p0, p1;
#pragma unroll
                        for (int i = 0; i < 4; ++i) { p0[i] = __shfl_xor(v0[i], 16); p1[i] = __shfl_xor(v1[i], 16); }
                        if (fq == 0) { r0 = v0 * cs0 - p0 * sn0; r1 = v1 * cs1 - p1 * sn1; }
                        else if (fq == 1) { r0 = v0 * cs0 + p0 * sn0; r1 = v1 * cs1 + p1 * sn1; }
                    }
                    if (isq) { const int c = pn * 256 + bj * 128 + cl;
                        *(u32x4*)(QN + (size_t)row * 1024 + c) = pack8(v0 * QSCALE, v1 * QSCALE); *(u32x4*)(QR + (size_t)row * 1024 + c) = pack8(r0 * QSCALE, r1 * QSCALE); }
                    else { const int cc = bj * 128 + cl, g = cc >> 6, d = cc & 63, b = row >> 13, t = row & (T - 1);
                        *(u32x4*)(KV6 + ((size_t)((pn - 4) * 16 + b * 4 + g) * T + t) * 64 + d) = pack8(r0, r1); }
                }
            } }
    }
};

struct Cmp1Sched {
    const char* KV6; const char* W; int G, c;
    static constexpr bool GATHER = false;
    __device__ __forceinline__ bool next(int i, pg8::Unit& u) const { const int L = i * G + c; if (L >= 64) return false; u.pm = L >> 1; u.pn = L & 1; u.ord = i; return true; }
    __device__ __forceinline__ unsigned lane_off(int r) const { return (unsigned)r * 2048u; }
    __device__ __forceinline__ unsigned unit_off(const pg8::Unit& u, int h) const { return (unsigned)u.pn * (unsigned)(16 * T * 64 * 2) + (unsigned)(u.pm * 256 + h * 128) * 2048u; }
    __device__ __forceinline__ unsigned aoff(const pg8::Unit&, int) const { return 0u; }
    __device__ __forceinline__ const char* abase() const { return KV6; }
    __device__ __forceinline__ const char* bptr(const pg8::Unit& u) const { return W + (size_t)u.pn * (256 * 2048 * 2); }
};
struct EpiCmp1 {
    static constexpr bool PERM = true, PERM16 = false; bf16_t* CH1; const float* bias1;
    __device__ __forceinline__ void operator()(const f32x4 (&acc)[2][2][4][2], const pg8::Unit& u, int wr, int wc, int fr, int fq) const {
        const int row0 = u.pm * 256 + wr * 64 + fr, cl = wc * 32 + 8 * fq;
        const f32x4 b0 = *(const f32x4*)(bias1 + u.pn * 128 + cl), b1 = *(const f32x4*)(bias1 + u.pn * 128 + cl + 4);
#pragma unroll
        EPI_ROWLOOP { f32x4 v0 = acc[ai][0][m][0] + b0, v1 = acc[ai][0][m][1] + b1;
#pragma unroll
            for (int i = 0; i < 4; ++i) { v0[i] = gelu_tanh(v0[i]); v1[i] = gelu_tanh(v1[i]); }
            *(u32x4*)(CH1 + ((size_t)u.pn * 8192 + row0 + ai * 128 + m * 16) * 128 + cl) = pack8(v0, v1); }
    }
};

__device__ __forceinline__ void p0_item(const float* W, int K, int N, bf16_t* WT, int kb, int n0, int drow0, LAS float* scr, int lane, bool f8 = false) {
    const int k0 = 64 * kb, n4 = (lane & 15) * 4;
    const bool cok = (n0 + n4) < N;
    f32x4 v[16];
#pragma unroll
    for (int i = 0; i < 16; ++i) { const int kk = 4 * i + (lane >> 4); v[i] = cok ? __builtin_nontemporal_load((const f32x4*)(W + (size_t)(k0 + kk) * N + n0 + n4)) : (f32x4){0.f, 0.f, 0.f, 0.f}; }
#pragma unroll
    for (int i = 0; i < 16; ++i) { const int kk = 4 * i + (lane >> 4); LAS float* d = scr + kk * 65 + n4; d[0] = v[i][0]; d[1] = v[i][1]; d[2] = v[i][2]; d[3] = v[i][3]; }
    asm volatile("s_waitcnt lgkmcnt(0)" ::: "memory");
    if (f8) {
        const int c4 = lane & 3;
#pragma unroll
        for (int j = 0; j < 4; ++j) { const int n = (lane >> 2) + 16 * j; const LAS float* sp = scr + (16 * c4) * 65 + n;
            u32x4 o;
            o.x = pk4_fp8(sp[0 * 65] * W8_SCALE, sp[1 * 65] * W8_SCALE, sp[2 * 65] * W8_SCALE, sp[3 * 65] * W8_SCALE); o.y = pk4_fp8(sp[4 * 65] * W8_SCALE, sp[5 * 65] * W8_SCALE, sp[6 * 65] * W8_SCALE, sp[7 * 65] * W8_SCALE);
            o.z = pk4_fp8(sp[8 * 65] * W8_SCALE, sp[9 * 65] * W8_SCALE, sp[10 * 65] * W8_SCALE, sp[11 * 65] * W8_SCALE); o.w = pk4_fp8(sp[12 * 65] * W8_SCALE, sp[13 * 65] * W8_SCALE, sp[14 * 65] * W8_SCALE, sp[15 * 65] * W8_SCALE);
            if (n0 + n < N) __builtin_nontemporal_store(o, (u32x4*)((unsigned char*)WT + (size_t)(drow0 + n) * K + k0 + 16 * c4)); }
        asm volatile("s_waitcnt lgkmcnt(0)" ::: "memory");
        return;
    }
    const int c = lane & 7;
#pragma unroll
    for (int j = 0; j < 8; ++j) { const int n = (lane >> 3) + 8 * j; const LAS float* sp = scr + (8 * c) * 65 + n;
        u32x4 o; o.x = pk2(sp[0 * 65], sp[1 * 65]); o.y = pk2(sp[2 * 65], sp[3 * 65]); o.z = pk2(sp[4 * 65], sp[5 * 65]); o.w = pk2(sp[6 * 65], sp[7 * 65]);
        if (n0 + n < N) __builtin_nontemporal_store(o, (u32x4*)(WT + (size_t)(drow0 + n) * K + k0 + 8 * c)); }
    asm volatile("s_waitcnt lgkmcnt(0)" ::: "memory");
}
struct CvtItem { const float* W; bf16_t* WT; int K, N, k0, n0, drow0; };
__device__ __forceinline__ void cvt32_load(const CvtItem& it, int lane, f32x4 (&v)[8]) {
    const int n4 = (lane & 7) * 4;
#pragma unroll
    for (int i = 0; i < 8; ++i) { const int kk = 8 * i + (lane >> 3); v[i] = __builtin_nontemporal_load((const f32x4*)(it.W + (size_t)(it.k0 + kk) * it.N + it.n0 + n4)); }
}
__device__ __forceinline__ void cvt32_finish(const CvtItem& it, int lane, const f32x4 (&v)[8], LAS float* scr) {
    const int n4 = (lane & 7) * 4;
#pragma unroll
    for (int i = 0; i < 8; ++i) { const int kk = 8 * i + (lane >> 3); LAS float* d = scr + kk * 33 + n4; d[0] = v[i][0]; d[1] = v[i][1]; d[2] = v[i][2]; d[3] = v[i][3]; }
    asm volatile("s_waitcnt lgkmcnt(0)" ::: "memory");
    const int c = lane & 7;
#pragma unroll
    for (int j = 0; j < 4; ++j) { const int n = (lane >> 3) + 8 * j; const LAS float* sp = scr + (8 * c) * 33 + n;
        const float v0 = sp[0 * 33], v1 = sp[1 * 33], v2 = sp[2 * 33], v3 = sp[3 * 33], v4 = sp[4 * 33], v5 = sp[5 * 33], v6 = sp[6 * 33], v7 = sp[7 * 33];
        u32x2 o; o.x = pk4_fp8(v0 * W8_SCALE, v1 * W8_SCALE, v2 * W8_SCALE, v3 * W8_SCALE); o.y = pk4_fp8(v4 * W8_SCALE, v5 * W8_SCALE, v6 * W8_SCALE, v7 * W8_SCALE);
        __builtin_nontemporal_store(o, (u32x2*)((unsigned char*)it.WT + (size_t)(it.drow0 + n) * it.K + it.k0 + 8 * c)); }
    asm volatile("s_waitcnt lgkmcnt(0)" ::: "memory");
}
constexpr int CVT1_ITEMS = 257 * 384;
__device__ __forceinline__ CvtItem cvt1_item(const Args& a, int idx) {
    const int e = idx / 384, sub = idx % 384, mat = sub >> 7, r = sub & 127;
    CvtItem it;
    if (mat < 2) { it.W = (e < 256) ? a.in[23 + mat] + ((size_t)256 + e) * (size_t)(D * FF) : a.in[26 + mat] + (size_t)(D * FF);
        it.K = D; it.N = FF; it.k0 = (r >> 3) * 64; it.n0 = (r & 7) * 32; it.drow0 = (it.n0 >> 7) * 256 + mat * 128 + (it.n0 & 127);
        it.WT = (bf16_t*)(a.ws + WS_WGU + (size_t)(257 + e) * 512 * 1024); }
    else { it.W = (e < 256) ? a.in[25] + ((size_t)256 + e) * (size_t)(FF * D) : a.in[28] + (size_t)(FF * D);
        it.K = FF; it.N = D; it.k0 = (r >> 5) * 64; it.n0 = (r & 31) * 32; it.drow0 = it.n0;
        it.WT = (bf16_t*)(a.ws + WS_WD + (size_t)(257 + e) * 1024 * 256); }
    return it;
}
__device__ __forceinline__ void cvt1_run(const Args& a, int& next, int stride, int quota, LAS float* scr, int lane) {
#pragma unroll 1
    for (int q = 0; q < quota && next < CVT1_ITEMS; ++q) {
        CvtItem t[4]; f32x4 v[4][8]; bool ok[4];
#pragma unroll
        for (int u = 0; u < 4; ++u) { const int idx = next + u * stride; ok[u] = idx < CVT1_ITEMS; t[u] = cvt1_item(a, ok[u] ? idx : 0); if (ok[u]) cvt32_load(t[u], lane, v[u]); }
        next += 4 * stride;
#pragma unroll
        for (int u = 0; u < 4; ++u) if (ok[u]) cvt32_finish(t[u], lane, v[u], scr);
    }
}
__device__ __forceinline__ void ph_prologue(const Args& a, LAS unsigned char* lds) {
    const int lane = threadIdx.x & 63, wave = threadIdx.x >> 6;
    LAS float* scr = (LAS float*)(lds + wave * 16640);
    const int gw = blockIdx.x * 8 + wave, ngw = gridDim.x * 8;
    for (int it = gw; it < 257 * 192; it += ngw) {
        const int le = it / 192, sub = it % 192, l = 0, e = le, mat = sub >> 6, r = sub & 63;
        if (mat < 2) {
            const float* W = (e < 256) ? a.in[23 + mat] + ((size_t)l * 256 + e) * (size_t)(D * FF) : a.in[26 + mat] + (size_t)l * (D * FF);
            const int kb = r >> 2, n0 = (r & 3) * 64;
            p0_item(W, D, FF, (bf16_t*)(a.ws + WS_WGU + (size_t)le * 512 * 1024), kb, n0, (n0 >> 7) * 256 + mat * 128 + (n0 & 127), scr, lane, true);
        } else {
            const float* W = (e < 256) ? a.in[25] + ((size_t)l * 256 + e) * (size_t)(FF * D) : a.in[28] + (size_t)l * (FF * D);
            const int kb = r >> 4, n0 = (r & 15) * 64;
            p0_item(W, FF, D, (bf16_t*)(a.ws + WS_WD + (size_t)le * 1024 * 256), kb, n0, n0, scr, lane, true);
        }
    }
    {
        for (int it = gw; it < 512; it += ngw) { const int w = it >> 8, r = it & 255;
            p0_item(a.in[w ? 16 : 8], D, D, (bf16_t*)(a.ws + (w ? WS_WOUTN : WS_WOUT0)), r >> 4, (r & 15) * 64, (r & 15) * 64, scr, lane); }
        for (int it = gw; it < 16 * 41; it += ngw) p0_item(a.in[9], D, 2608, (bf16_t*)(a.ws + WS_WINN), it / 41, (it % 41) * 64, (it % 41) * 64, scr, lane);
        for (int it = gw; it < 128; it += ngw) { const int l = it >> 6, r = it & 63;
            p0_item(a.in[21] + (size_t)l * D * NE, D, NE, (bf16_t*)(a.ws + WS_WR) + (size_t)l * NE * D, r >> 2, (r & 3) * 64, (r & 3) * 64, scr, lane); }
        for (int it = gw; it < 16 * 16; it += ngw) { const int kb = it >> 4, n0 = (8 + (it & 15)) * 64;
            const int isg = (n0 >= 1024) ? 1 : 0, rel = n0 - 512 - isg * 512;
            p0_item(a.in[1], D, 1536, (bf16_t*)(a.ws + WS_WIN0), kb, n0, 512 + (rel >> 7) * 256 + isg * 128 + (rel & 127), scr, lane); }
        for (int it = gw; it < 128; it += ngw) { const int kv = it >> 6, r = it & 63;
            p0_item(a.in[kv ? 14 : 11], 2048, 128, (bf16_t*)(a.ws + WS_CW1) + (size_t)kv * 256 * 2048, r >> 1, (r & 1) * 64, (r & 1) * 64, scr, lane); }
    }
    {
        const int gt = blockIdx.x * 512 + threadIdx.x, ngt = gridDim.x * 512;
        u32x4* z0 = (u32x4*)((bf16_t*)(a.ws + WS_WINN) + (size_t)2608 * 1024);
        for (int i = gt; i < 208 * 1024 / 8; i += ngt) z0[i] = (u32x4){0u, 0u, 0u, 0u};
        for (int kv = 0; kv < 2; ++kv) { u32x4* z1 = (u32x4*)((bf16_t*)(a.ws + WS_CW1) + ((size_t)kv * 256 + 128) * 2048);
            for (int i = gt; i < 128 * 2048 / 8; i += ngt) z1[i] = (u32x4){0u, 0u, 0u, 0u}; }
        const float* x = a.in[0]; bf16_t* XA = (bf16_t*)(a.ws + WS_XA);
        for (size_t i = gt; i < (size_t)M * D / 8; i += ngt) { const f32x4 v0 = *(const f32x4*)(x + i * 8), v1 = *(const f32x4*)(x + i * 8 + 4);
            u32x4 o; o.x = pk2(v0[0], v0[1]); o.y = pk2(v0[2], v0[3]); o.z = pk2(v1[0], v1[1]); o.w = pk2(v1[2], v1[3]); *(u32x4*)(XA + i * 8) = o; }
        const float* win = a.in[1]; const float* mix = a.in[2]; const float* psc = a.in[3]; bf16_t* WIN0 = (bf16_t*)(a.ws + WS_WIN0);
        for (int i = gt; i < 512 * 1024; i += ngt) { const int n = i & 511, k = i >> 9, g = n >> 7, nn = n & 127;
            const float* wr_ = win + (size_t)k * 1536 + g * 128; const float* mx = mix + (size_t)g * 128 * 128 + nn;
            float s = 0.f;
            for (int c = 0; c < 128; ++c) s += wr_[c] * mx[(size_t)c * 128];
            WIN0[(size_t)n * 1024 + k] = f2bf(s * psc[n]); }
        float* misc = (float*)(a.ws + WS_MISC);
        for (int i = gt; i < 256; i += ngt) { const int kv = i >> 7, j = i & 127; const float* pos = a.in[kv ? 13 : 10]; const float* w1 = a.in[kv ? 14 : 11];
            float s = 0.f; for (int k = 0; k < 2048; ++k) s += pos[k] * w1[(size_t)k * 128 + j]; misc[i] = s; }
        float* rot = misc + 1024;
        for (int i = gt; i < T * 8; i += ngt) { const int t = i >> 3, f = i & 7;
            const float ang = (float)t * a.inv_freq[f]; const double rev = (double)ang * 0.15915494309189535; const float fr = (float)(rev - floor(rev));
            rot[t * 16 + f] = __builtin_amdgcn_cosf(fr); rot[t * 16 + 8 + f] = __builtin_amdgcn_sinf(fr); }
    }
}

typedef short v4i16_t __attribute__((ext_vector_type(4)));
constexpr int AT_KB = 0, AT_VB = 16384, AT_PS = 32768, AT_MSK = 32768 + 65536;
#define DPP_I(x, ctrl) __builtin_amdgcn_update_dpp((int)(x), (int)(x), (ctrl), 0xF, 0xF, true)
#define DPP_F(x, ctrl) __builtin_bit_cast(float, __builtin_amdgcn_update_dpp(__builtin_bit_cast(int, (float)(x)), __builtin_bit_cast(int, (float)(x)), (ctrl), 0xF, 0xF, true))
__device__ __forceinline__ bf16x8 tr_frag(LAS unsigned char* p0, LAS unsigned char* p1) {
    const v4i16_t a = __builtin_amdgcn_ds_read_tr16_b64_v4i16((LAS v4i16_t*)p0), b = __builtin_amdgcn_ds_read_tr16_b64_v4i16((LAS v4i16_t*)p1);
    return (bf16x8){a[0], a[1], a[2], a[3], b[0], b[1], b[2], b[3]};
}
constexpr size_t TN2_OFF = 786432;
__device__ __forceinline__ void ph_knorm(const Args& a) {
    const bf16_t* KV6 = (const bf16_t*)(a.ws + WS_KV6);
    float* TN2 = (float*)(a.ws + WS_MISC + TN2_OFF);
    const int lane = threadIdx.x & 63, wave = threadIdx.x >> 6;
    const int first = (gridDim.x > 64) ? 64 : 0;
    if ((int)blockIdx.x < first) return;
    const int wi = ((int)blockIdx.x - first) * 8 + wave, nw = ((int)gridDim.x - first) * 8;
    for (int id = wi; id < 4096; id += nw) {
        const int ty = id >> 11, bg = (id >> 7) & 15, tile = id & 127;
        const bf16_t* rp = KV6 + ((size_t)((ty ? 4 : 2) * 16 + bg) * T + tile * 64 + lane) * 64;
        float ssq = 0.f;
#pragma unroll
        for (int c = 0; c < 8; ++c) { const bf16x8 v = *(const bf16x8*)(rp + 8 * c);
#pragma unroll
            for (int j = 0; j < 8; ++j) { const float f = bf2f((bf16_t)v[j]); ssq += f * f; } }
        ssq = wave_max(ssq);
        if (lane == 0) TN2[id] = ssq;
    }
}
__device__ __forceinline__ void attn_qk2(LAS unsigned char* Kb, const bf16x8 (&q)[2][2], int fr, int g4, const float (&cinit)[2], f32x4 (&s)[2][4]) {
#pragma unroll
    for (int c = 0; c < 4; ++c) {
#pragma unroll
        for (int rb = 0; rb < 2; ++rb) s[rb][c] = (f32x4){cinit[rb], cinit[rb], cinit[rb], cinit[rb]};
#pragma unroll
        for (int ks = 0; ks < 2; ++ks) {
            const bf16x8 kf = *(const LAS bf16x8*)(Kb + pg8::lds_byte(16 * c + fr, 32 * ks + 8 * g4));
#pragma unroll
            for (int rb = 0; rb < 2; ++rb) s[rb][c] = __builtin_amdgcn_mfma_f32_16x16x32_bf16(kf, q[rb][ks], s[rb][c], 0, 0, 0);
        }
    }
}
__device__ __forceinline__ void attn_qk2m(LAS unsigned char* Kb, const bf16x8 (&q)[2][2], int fr, int g4, const float (&cinit)[2], f32x4 (&s)[2][4]) {
    bf16x8 kf[4][2];
#pragma unroll
    for (int c = 0; c < 4; ++c)
#pragma unroll
        for (int ks = 0; ks < 2; ++ks) kf[c][ks] = *(const LAS bf16x8*)(Kb + pg8::lds_byte(16 * c + fr, 32 * ks + 8 * g4));
    __builtin_amdgcn_sched_barrier(0);
    f32x4 ci[2];
#pragma unroll
    for (int rb = 0; rb < 2; ++rb) ci[rb] = (f32x4){cinit[rb], cinit[rb], cinit[rb], cinit[rb]};
#pragma unroll
    for (int c = 0; c < 4; ++c) {
#pragma unroll
        for (int ks = 0; ks < 2; ++ks) {
#pragma unroll
            for (int rb = 0; rb < 2; ++rb) s[rb][c] = __builtin_amdgcn_mfma_f32_16x16x32_bf16(kf[c][ks], q[rb][ks], ks == 0 ? ci[rb] : s[rb][c], 0, 0, 0);
        }
    }
}
__device__ __forceinline__ void attn_qk2z(LAS unsigned char* Kb, const bf16x8 (&q)[2][2], int fr, int g4, f32x4 (&s)[2][4]) {
    bf16x8 kf[4][2];
#pragma unroll
    for (int c = 0; c < 4; ++c)
#pragma unroll
        for (int ks = 0; ks < 2; ++ks) kf[c][ks] = *(const LAS bf16x8*)(Kb + pg8::lds_byte(16 * c + fr, 32 * ks + 8 * g4));
    __builtin_amdgcn_sched_barrier(0);
#pragma unroll
    for (int c = 0; c < 4; ++c) {
#pragma unroll
        for (int ks = 0; ks < 2; ++ks) {
#pragma unroll
            for (int rb = 0; rb < 2; ++rb) s[rb][c] = __builtin_amdgcn_mfma_f32_16x16x32_bf16(kf[c][ks], q[rb][ks], ks == 0 ? (f32x4){0.f, 0.f, 0.f, 0.f} : s[rb][c], 0, 0, 0);
        }
    }
}
struct AttnRow { float m; f32x4 o[4]; f32x4 ol; };
__device__ __forceinline__ float max3f(float a, float b, float c) { float r; asm("v_max3_f32 %0, %1, %2, %3" : "=v"(r) : "v"(a), "v"(b), "v"(c)); return r; }
__device__ __forceinline__ bool attn_sm2(f32x4 (&s)[4], AttnRow& st, int kbase, int g4, int lo, int hi, bool en, bool emask) {
    const float NEG = -INFINITY;
    if (emask) {
#pragma unroll
        for (int c = 0; c < 4; ++c)
#pragma unroll
            for (int i = 0; i < 4; ++i) { const int key = kbase + 16 * c + 4 * g4 + i; if (key < lo || key > hi) s[c][i] = NEG; }
    }
    float mx = max3f(s[0][0], s[0][1], s[0][2]); mx = max3f(mx, s[0][3], s[1][0]); mx = max3f(mx, s[1][1], s[1][2]); mx = max3f(mx, s[1][3], s[2][0]);
    mx = max3f(mx, s[2][1], s[2][2]); mx = max3f(mx, s[2][3], s[3][0]); mx = max3f(mx, s[3][1], s[3][2]); mx = max3f(mx, s[3][3], mx);
    if (!en) mx = NEG;
    mx = max3f(mx, __shfl_xor(mx, 16), mx); mx = max3f(mx, __shfl_xor(mx, 32), mx);
    const float delta = (mx > 20.0f) ? mx : 0.f;
    const bool moved = __builtin_amdgcn_ballot_w64(delta != 0.f) != 0ull;
    if (moved) {
        const float alpha = __builtin_amdgcn_exp2f(-delta);
#pragma unroll
        for (int c = 0; c < 4; ++c) s[c] = s[c] - delta;
#pragma unroll
        for (int dt = 0; dt < 4; ++dt) st.o[dt] *= alpha;
        st.ol *= alpha;
        st.m += delta;
    }
#pragma unroll
    for (int c = 0; c < 4; ++c)
#pragma unroll
        for (int i = 0; i < 4; ++i) s[c][i] = __builtin_amdgcn_exp2f(s[c][i]);
    return moved;
}
__device__ __forceinline__ bool attn_sm2x(f32x4 (&s)[2][4], AttnRow (&st)[2], int kbase, int g4, const int (&lo)[2], const int (&hi)[2], const bool (&en)[2], bool emask) {
    const float NEG = -INFINITY;
    if (emask) {
#pragma unroll
        for (int rb = 0; rb < 2; ++rb)
#pragma unroll
            for (int c = 0; c < 4; ++c)
#pragma unroll
                for (int i = 0; i < 4; ++i) { const int key = kbase + 16 * c + 4 * g4 + i; if (key < lo[rb] || key > hi[rb]) s[rb][c][i] = NEG; }
    }
    float mx[2];
#pragma unroll
    for (int rb = 0; rb < 2; ++rb) {
        float m = max3f(s[rb][0][0], s[rb][0][1], s[rb][0][2]); m = max3f(m, s[rb][0][3], s[rb][1][0]); m = max3f(m, s[rb][1][1], s[rb][1][2]); m = max3f(m, s[rb][1][3], s[rb][2][0]);
        m = max3f(m, s[rb][2][1], s[rb][2][2]); m = max3f(m, s[rb][2][3], s[rb][3][0]); m = max3f(m, s[rb][3][1], s[rb][3][2]); m = max3f(m, s[rb][3][3], m);
        mx[rb] = en[rb] ? m : NEG;
    }
    { const float t0 = __shfl_xor(mx[0], 16), t1 = __shfl_xor(mx[1], 16); mx[0] = max3f(mx[0], t0, t0); mx[1] = max3f(mx[1], t1, t1); }
    { const float t0 = __shfl_xor(mx[0], 32), t1 = __shfl_xor(mx[1], 32); mx[0] = max3f(mx[0], t0, t0); mx[1] = max3f(mx[1], t1, t1); }
    const float d0 = (mx[0] > 20.0f) ? mx[0] : 0.f, d1 = (mx[1] > 20.0f) ? mx[1] : 0.f;
    const bool moved = __builtin_amdgcn_ballot_w64((d0 != 0.f) || (d1 != 0.f)) != 0ull;
    if (moved) {
        const float dl[2] = {d0, d1};
#pragma unroll
        for (int rb = 0; rb < 2; ++rb) {
            const float alpha = __builtin_amdgcn_exp2f(-dl[rb]);
#pragma unroll
            for (int c = 0; c < 4; ++c) s[rb][c] = s[rb][c] - dl[rb];
#pragma unroll
            for (int dt = 0; dt < 4; ++dt) st[rb].o[dt] *= alpha;
            st[rb].ol *= alpha; st[rb].m += dl[rb];
        }
    }
#pragma unroll
    for (int rb = 0; rb < 2; ++rb)
#pragma unroll
        for (int c = 0; c < 4; ++c)
#pragma unroll
            for (int i = 0; i < 4; ++i) s[rb][c][i] = __builtin_amdgcn_exp2f(s[rb][c][i]);
    return moved;
}
__device__ __forceinline__ void attn_pv2x(LAS unsigned char* Vb, const f32x4 (&p)[2][4], int vlane, int swz, const unsigned (&enm)[2], const bool (&act)[2], const bf16x8 onesf, AttnRow (&st)[2]) {
#pragma unroll
    for (int ks = 0; ks < 2; ++ks) {
        bf16x8 pb[2];
#pragma unroll
        for (int rb = 0; rb < 2; ++rb) { u32x4 pw = pack8m(p[rb][2 * ks], p[rb][2 * ks + 1]); pw.x &= enm[rb]; pw.y &= enm[rb]; pw.z &= enm[rb]; pw.w &= enm[rb]; pb[rb] = __builtin_bit_cast(bf16x8, pw); }
#pragma unroll
        for (int dt = 0; dt < 4; ++dt) {
            LAS unsigned char* a0 = Vb + vlane + (2 * ks) * 2048 + ((dt ^ swz) * 32);
            const bf16x8 vf = tr_frag(a0, a0 + 2048);
#pragma unroll
            for (int rb = 0; rb < 2; ++rb) if (act[rb]) st[rb].o[dt] = __builtin_amdgcn_mfma_f32_16x16x32_bf16(vf, pb[rb], st[rb].o[dt], 0, 0, 0);
        }
#pragma unroll
        for (int rb = 0; rb < 2; ++rb) if (act[rb]) st[rb].ol = __builtin_amdgcn_mfma_f32_16x16x32_bf16(onesf, pb[rb], st[rb].ol, 0, 0, 0);
    }
}
__device__ __forceinline__ bool attn_max2x(f32x4 (&s)[2][4], int kbase, int g4, const int (&lo)[2], const int (&hi)[2], const bool (&en)[2], bool emask, float (&d)[2]) {
    const float NEG = -INFINITY;
    MFMA_SETTLE(s);
    if (emask) {
#pragma unroll
        for (int rb = 0; rb < 2; ++rb)
#pragma unroll
            for (int c = 0; c < 4; ++c)
#pragma unroll
                for (int i = 0; i < 4; ++i) { const int key = kbase + 16 * c + 4 * g4 + i; if (key < lo[rb] || key > hi[rb]) s[rb][c][i] = NEG; }
    }
    float mx[2];
#pragma unroll
    for (int rb = 0; rb < 2; ++rb) {
        float m = max3f(s[rb][0][0], s[rb][0][1], s[rb][0][2]); m = max3f(m, s[rb][0][3], s[rb][1][0]); m = max3f(m, s[rb][1][1], s[rb][1][2]); m = max3f(m, s[rb][1][3], s[rb][2][0]);
        m = max3f(m, s[rb][2][1], s[rb][2][2]); m = max3f(m, s[rb][2][3], s[rb][3][0]); m = max3f(m, s[rb][3][1], s[rb][3][2]); m = max3f(m, s[rb][3][3], m);
        mx[rb] = en[rb] ? m : NEG;
    }
    { const float t0 = __shfl_xor(mx[0], 16), t1 = __shfl_xor(mx[1], 16); mx[0] = max3f(mx[0], t0, t0); mx[1] = max3f(mx[1], t1, t1); }
    { const float t0 = __shfl_xor(mx[0], 32), t1 = __shfl_xor(mx[1], 32); mx[0] = max3f(mx[0], t0, t0); mx[1] = max3f(mx[1], t1, t1); }
    d[0] = (mx[0] > 20.0f) ? mx[0] : 0.f; d[1] = (mx[1] > 20.0f) ? mx[1] : 0.f;
    return __builtin_amdgcn_ballot_w64((d[0] != 0.f) || (d[1] != 0.f)) != 0ull;
}
__device__ __forceinline__ void attn_rescale2x(f32x4 (&s)[2][4], AttnRow (&st)[2], const float (&d)[2]) {
#pragma unroll
    for (int rb = 0; rb < 2; ++rb) {
        const float alpha = __builtin_amdgcn_exp2f(-d[rb]);
#pragma unroll
        for (int c = 0; c < 4; ++c) s[rb][c] = s[rb][c] - d[rb];
#pragma unroll
        for (int dt = 0; dt < 4; ++dt) st[rb].o[dt] *= alpha;
        st[rb].ol *= alpha; st[rb].m += d[rb];
    }
}
__device__ __forceinline__ void attn_exp1(f32x4 (&s)[4], unsigned enm, bf16x8 (&pb)[2]) {
#pragma unroll
    for (int c = 0; c < 4; ++c)
#pragma unroll
        for (int i = 0; i < 4; ++i) s[c][i] = __builtin_amdgcn_exp2f(s[c][i]);
#pragma unroll
    for (int ks = 0; ks < 2; ++ks) { u32x4 pw = pack8m(s[2 * ks], s[2 * ks + 1]); pw.x &= enm; pw.y &= enm; pw.z &= enm; pw.w &= enm; pb[ks] = __builtin_bit_cast(bf16x8, pw); }
}
__device__ __forceinline__ void attn_pv1(LAS unsigned char* Vb, const bf16x8 (&pb)[2], int vlane, int swz, const bf16x8 onesf, AttnRow& st) {
#pragma unroll
    for (int ks = 0; ks < 2; ++ks) {
#pragma unroll
        for (int dt = 0; dt < 4; ++dt) {
            LAS unsigned char* a0 = Vb + vlane + (2 * ks) * 2048 + ((dt ^ swz) * 32);
            const bf16x8 vf = tr_frag(a0, a0 + 2048);
            st.o[dt] = __builtin_amdgcn_mfma_f32_16x16x32_bf16(vf, pb[ks], st.o[dt], 0, 0, 0);
        }
        st.ol = __builtin_amdgcn_mfma_f32_16x16x32_bf16(onesf, pb[ks], st.ol, 0, 0, 0);
    }
}
__device__ __forceinline__ bool attn_step2x(LAS unsigned char* Vb, f32x4 (&s)[2][4], AttnRow (&st)[2], int kbase, int g4, const int (&lo)[2], const int (&hi)[2], const bool (&en)[2], const unsigned (&enm)[2], bool emask,
                                            int vlane, int swz, const bf16x8 onesf) {
    float d[2];
    const bool moved = attn_max2x(s, kbase, g4, lo, hi, en, emask, d);
    if (moved) attn_rescale2x(s, st, d);
    bf16x8 p0[2], p1[2];
    attn_exp1(s[0], enm[0], p0);
    attn_pv1(Vb, p0, vlane, swz, onesf, st[0]);
    attn_exp1(s[1], enm[1], p1);
    attn_pv1(Vb, p1, vlane, swz, onesf, st[1]);
    return moved;
}
__device__ __forceinline__ void attn_step2x_nomax(LAS unsigned char* Vb, f32x4 (&s)[2][4], AttnRow (&st)[2], int kbase, int g4, const int (&lo)[2], const int (&hi)[2], const unsigned (&enm)[2], bool emask,
                                                  int vlane, int swz, const bf16x8 onesf) {
    if (emask) {
#pragma unroll
        for (int rb = 0; rb < 2; ++rb)
#pragma unroll
            for (int c = 0; c < 4; ++c)
#pragma unroll
                for (int i = 0; i < 4; ++i) { const int key = kbase + 16 * c + 4 * g4 + i; if (key < lo[rb] || key > hi[rb]) s[rb][c][i] = -INFINITY; }
    }
    bf16x8 p0[2], p1[2];
    attn_exp1(s[0], enm[0], p0);
    attn_pv1(Vb, p0, vlane, swz, onesf, st[0]);
    attn_exp1(s[1], enm[1], p1);
    attn_pv1(Vb, p1, vlane, swz, onesf, st[1]);
}
typedef _Float16 f16x4 __attribute__((ext_vector_type(4)));
constexpr int AT4_KB = 0, AT4_VB = 32768, AT2_PS = 65536, AT2_MSK = 65536 + 65536;
__device__ __forceinline__ void ph_attn_fast2(const Args& a, LAS unsigned char* lds) {
    const bf16_t* QN = (const bf16_t*)(a.ws + WS_HN);
    const bf16_t* QR = (const bf16_t*)(a.ws + WS_QR);
    const bf16_t* KV6 = (const bf16_t*)(a.ws + WS_KV6);
    const float* GATES = (const float*)(a.ws + WS_GATES);
    const bf16_t* KC = (const bf16_t*)(a.ws + WS_KC);
    const bf16_t* VC = KC + (size_t)8192 * 64;
    bf16_t* O = (bf16_t*)(a.ws + WS_O);
    const int tid = threadIdx.x, lane = tid & 63, wave = __builtin_amdgcn_readfirstlane(tid >> 6);
    const int fr = lane & 15, g4 = lane >> 4;
    int ksrc, vsrc;
    { int R, C; pg8::stage_rc(wave * 1024 + lane * 16, R, C); ksrc = R * 64 + C;
      const int key = 8 * wave + (lane >> 3), pos = lane & 7, chunk = (pos >> 1) ^ ((key >> 1) & 3); vsrc = key * 64 + (chunk * 2 + (pos & 1)) * 8; }
    const int vlane = (4 * g4 + (fr >> 2)) * 128 + (fr & 3) * 8, swz = (2 * g4 + (fr >> 3)) & 3;
    LAS _Float16* ps = (LAS _Float16*)(lds + AT2_PS + wave * 8192);
    LAS unsigned* mskl = (LAS unsigned*)(lds + AT2_MSK + wave * 128);
    const float NEG = -INFINITY;
    const bf16x8 onesf = (fr == 0) ? (bf16x8){0x3F80, 0x3F80, 0x3F80, 0x3F80, 0x3F80, 0x3F80, 0x3F80, 0x3F80} : (bf16x8){0, 0, 0, 0, 0, 0, 0, 0};
    const int vcu = (gridDim.x % 8 == 0) ? (int)((blockIdx.x % 8) * (gridDim.x / 8) + blockIdx.x / 8) : (int)blockIdx.x;
    int cvt_next = (int)blockIdx.x * 8 + wave; const int cvt_stride = (int)gridDim.x * 8;
    LAS float* cvt_scr = (LAS float*)(lds + AT2_PS + wave * 8448);
    bool cmp_pref = false;
    for (int pr = vcu; pr < 1024; pr += gridDim.x) {
#pragma unroll 1
        for (int half = 0; half < 2; ++half) {
            const int bg = pr >> 6, cc = half ? (127 - (pr & 63)) : (pr & 63);
            const int b = bg >> 2, g = bg & 3, t0 = cc * 64, cur = cc;
            const int head = g * 4 + (fr & 3);
            int trow[2];
            bf16x8 qn[2][2];
#pragma unroll
            for (int rb = 0; rb < 2; ++rb) {
                trow[rb] = t0 + 8 * wave + 4 * rb + (fr >> 2);
#pragma unroll
                for (int ks = 0; ks < 2; ++ks) qn[rb][ks] = *(const bf16x8*)(QN + ((size_t)b * T + trow[rb]) * 1024 + head * 64 + 32 * ks + 8 * g4);
            }
#define TROW_PIN() asm volatile("" : "+v"(trow[0]), "+v"(trow[1]))
#define TOKROW(rb) ((size_t)b * T + trow[rb])
#define GATE(rb, br) (GATES[TOKROW(rb) * 48 + head * 3 + (br)])
            const bf16_t* kcb = KC + (size_t)bg * 512 * 64;
            const bf16_t* kvb = KV6 + (size_t)bg * T * 64;
#define ATK(sl) (((sl) < 4 ? AT4_KB : AT2_PS - 4 * 8192) + (sl) * 8192)
#define ATV(sl) (((sl) < 4 ? AT4_VB : AT2_PS + 32768 - 4 * 8192) + (sl) * 8192)
#define AT_DMA(BR, tile, slot) do { const bf16_t* kp_; const bf16_t* vp_; \
                if ((BR) == 0) { kp_ = kcb + (size_t)(tile) * 4096; vp_ = kp_ + (size_t)8192 * 64; } \
                else { kp_ = kvb + (size_t)((BR) == 1 ? 2 : 4) * 16 * T * 64 + (size_t)(tile) * 4096; vp_ = kp_ + (size_t)16 * T * 64; } \
                __builtin_amdgcn_global_load_lds((const unsigned*)(kp_ + ksrc), (LAS unsigned*)(lds + ATK(slot) + wave * 1024), 16, 0, 0); \
                __builtin_amdgcn_global_load_lds((const unsigned*)(vp_ + vsrc), (LAS unsigned*)(lds + ATV(slot) + wave * 1024), 16, 0, 0); } while (0)
            int ncv[2];
#pragma unroll
            for (int rb = 0; rb < 2; ++rb) ncv[rb] = (trow[rb] >= 31) ? ((trow[rb] - 31) / 16 + 1) : 0;
            const int nct = (((t0 + 63 - 31) / 16 + 1) + 63) >> 6;
            float mc[2], invc[2];
            const int t_lo = t0 + 8 * wave, ncv_lo = (t_lo >= 31) ? ((t_lo - 31) / 16 + 1) : 0;
            {
                float m1[2] = {NEG, NEG}, l1[2] = {0.f, 0.f};
                const float zero2[2] = {0.f, 0.f};
#define CMP1_TILE(J, SLOT, MASKED) do { const int j = (J); const int SLOT_ = (SLOT); \
                    f32x4 s[2][4]; attn_qk2(lds + AT4_KB + SLOT_ * 8192, qn, fr, g4, zero2, s); \
                    _Pragma("unroll") \
                    for (int rb = 0; rb < 2; ++rb) { \
                        float mx = NEG; \
                    _Pragma("unroll") \
                        for (int c = 0; c < 4; ++c) \
                    _Pragma("unroll") \
                            for (int i = 0; i < 4; ++i) { const int n = 64 * j + 16 * c + 4 * g4 + i; if ((MASKED) && n >= ncv[rb]) s[rb][c][i] = NEG; mx = fmaxf(mx, s[rb][c][i]); } \
                        mx = fmaxf(mx, __shfl_xor(mx, 16)); mx = fmaxf(mx, __shfl_xor(mx, 32)); \
                        const float mn = fmaxf(m1[rb], mx), msafe = (mn == NEG) ? 0.f : mn; \
                        const float alpha = (m1[rb] == NEG) ? 0.f : __builtin_amdgcn_exp2f(m1[rb] - msafe); \
                        float sum = 0.f; \
                    _Pragma("unroll") \
                        for (int c = 0; c < 4; ++c) \
                    _Pragma("unroll") \
                            for (int i = 0; i < 4; ++i) sum += __builtin_amdgcn_exp2f(s[rb][c][i] - msafe); \
                        l1[rb] = l1[rb] * alpha + sum; m1[rb] = mn; \
                    } \
                } while (0)
                if (!cmp_pref) { AT_DMA(0, 0, 0); if (nct > 1) AT_DMA(0, 1, 1); } __syncthreads();
                for (int j0 = 0; j0 < nct; j0 += 2) { const int sb = (j0 & 2);
                    if (j0 + 2 < nct) AT_DMA(0, j0 + 2, sb ^ 2);
                    if (j0 + 3 < nct) AT_DMA(0, j0 + 3, (sb ^ 2) + 1);
                    CMP1_TILE(j0, sb, true); if (j0 + 1 < nct) CMP1_TILE(j0 + 1, sb + 1, true);
                    __syncthreads();
                }
#undef CMP1_TILE
#pragma unroll
                for (int rb = 0; rb < 2; ++rb) { float lc = l1[rb]; lc += __shfl_xor(lc, 16); lc += __shfl_xor(lc, 32); invc[rb] = (lc > 0.f) ? -(((m1[rb] == NEG) ? 0.f : m1[rb]) + __builtin_amdgcn_logf(lc)) : 0.f; mc[rb] = (m1[rb] == NEG) ? 0.f : m1[rb]; }
            }
            {
                AttnRow oc[2];
#pragma unroll
                for (int rb = 0; rb < 2; ++rb) { oc[rb].m = 0.f; oc[rb].ol = (f32x4){0.f, 0.f, 0.f, 0.f};
#pragma unroll
                    for (int dt = 0; dt < 4; ++dt) oc[rb].o[dt] = (f32x4){0.f, 0.f, 0.f, 0.f}; }
                const float cin[2] = {invc[0], invc[1]};
                const unsigned full[2] = {0xffffffffu, 0xffffffffu}; const bool both[2] = {true, true};
#define CMP2_TILE(J, SLOT, MASKED) do { const int j = (J); const int SLOT_ = (SLOT); \
                    f32x4 s[2][4]; attn_qk2(lds + AT4_KB + SLOT_ * 8192, qn, fr, g4, cin, s); \
                    _Pragma("unroll") \
                    for (int rb = 0; rb < 2; ++rb) \
                    _Pragma("unroll") \
                        for (int c = 0; c < 4; ++c) { \
                            f16x4 hs; \
                    _Pragma("unroll") \
                            for (int i = 0; i < 4; ++i) { const int n = 64 * j + 16 * c + 4 * g4 + i; const float p = (!(MASKED) || n < ncv[rb]) ? __builtin_amdgcn_exp2f(s[rb][c][i]) : 0.f; s[rb][c][i] = p; \
                                float h = p; h += DPP_F(h, 0xB1); h += DPP_F(h, 0x4E); hs[i] = (_Float16)h; }        \
                            if ((fr & 3) == 0) *(LAS f16x4*)(ps + (4 * rb + (fr >> 2)) * 512 + 64 * j + 16 * c + 4 * g4) = hs; \
                        } \
                    attn_pv2x(lds + AT4_VB + SLOT_ * 8192, s, vlane, swz, full, both, onesf, oc); \
                } while (0)
                const bool reload = nct > 4;
                if (reload) { AT_DMA(0, 0, 0); AT_DMA(0, 1, 1); __syncthreads(); }
                for (int j0 = 0; j0 < nct; j0 += 2) { const int sb = (j0 & 2);
                    if (reload && j0 + 2 < nct) AT_DMA(0, j0 + 2, sb ^ 2);
                    if (reload && j0 + 3 < nct) AT_DMA(0, j0 + 3, (sb ^ 2) + 1);
                    CMP2_TILE(j0, sb, true); if (j0 + 1 < nct) CMP2_TILE(j0 + 1, sb + 1, true);
                    __syncthreads();
                }
#undef CMP2_TILE
                TROW_PIN();
#pragma unroll
                for (int rb = 0; rb < 2; ++rb) { bf16_t* op = O + TOKROW(rb) * 1024 + head * 64 + 4 * g4; const float g0 = GATE(rb, 0);
#pragma unroll
                    for (int dt = 0; dt < 4; ++dt) { const f32x4 v = oc[rb].o[dt] * g0; u32x2 w; w.x = cvt_pk_bf16(v[0], v[1]); w.y = cvt_pk_bf16(v[2], v[3]); *(u32x2*)(op + 16 * dt) = w; } }
            }
            {
                WSYNC();
                const int tl = lane >> 4, li = lane & 15;
                const int nsel = (cur + 1 < 16) ? (cur + 1) : 16;
#pragma unroll 1
                for (int rnd = 0; rnd < 2; ++rnd) {
                    const LAS _Float16* pst = ps + (4 * rnd + tl) * 512;
                    float v[8];
#pragma unroll
                    for (int k = 0; k < 8; ++k) { const int j = li + 16 * k;
                        float x;
                        if (j > cur) x = NEG;
                        else if (j == 0 || j == cur || j == cur - 1) x = INFINITY;
                        else { const int n0 = 4 * j; x = (float)pst[n0 - 1] + 2.0f * ((float)pst[n0] + (float)pst[n0 + 1] + (float)pst[n0 + 2]) + (float)pst[n0 + 3]; }
                        v[k] = x; }
                    int vi[8];
#pragma unroll
                    for (int k = 0; k < 8; ++k) vi[k] = __builtin_bit_cast(int, v[k]);
                    unsigned mm[4] = {0u, 0u, 0u, 0u};
                    for (int it = 0; it < nsel; ++it) {
                        int bv = max(max(max(vi[0], vi[1]), max(vi[2], vi[3])), max(max(vi[4], vi[5]), max(vi[6], vi[7])));
                        bv = max(bv, DPP_I(bv, 0xB1)); bv = max(bv, DPP_I(bv, 0x4E)); bv = max(bv, DPP_I(bv, 0x141)); bv = max(bv, DPP_I(bv, 0x140));
                        int bi = 255;
#pragma unroll
                        for (int k = 7; k >= 0; --k) bi = (vi[k] == bv) ? (li + 16 * k) : bi;
                        bi = min(bi, DPP_I(bi, 0xB1)); bi = min(bi, DPP_I(bi, 0x4E)); bi = min(bi, DPP_I(bi, 0x141)); bi = min(bi, DPP_I(bi, 0x140));
                        const unsigned bit = 1u << (bi & 31); const int wsel = bi >> 5;
                        mm[0] |= (wsel == 0) ? bit : 0u; mm[1] |= (wsel == 1) ? bit : 0u; mm[2] |= (wsel == 2) ? bit : 0u; mm[3] |= (wsel == 3) ? bit : 0u;
                        if ((bi & 15) == li) {
#pragma unroll
                            for (int k = 0; k < 8; ++k) if ((bi >> 4) == k) vi[k] = (int)0xFF800000;
                        }
                    }
                    if (li == 0) { mskl[(4 * rnd + tl) * 4 + 0] = mm[0]; mskl[(4 * rnd + tl) * 4 + 1] = mm[1]; mskl[(4 * rnd + tl) * 4 + 2] = mm[2]; mskl[(4 * rnd + tl) * 4 + 3] = mm[3]; }
                }
                WSYNC();
            }
            bf16x8 qr[2][2];
            TROW_PIN();
#pragma unroll
            for (int rb = 0; rb < 2; ++rb)
#pragma unroll
                for (int ks = 0; ks < 2; ++ks) qr[rb][ks] = *(const bf16x8*)(QR + TOKROW(rb) * 1024 + head * 64 + 32 * ks + 8 * g4);
            bool nomax_slc, nomax_win;
            {
                float qq = 0.f;
#pragma unroll
                for (int rb = 0; rb < 2; ++rb) { float q2 = 0.f;
#pragma unroll
                    for (int ks = 0; ks < 2; ++ks)
#pragma unroll
                        for (int j = 0; j < 8; ++j) { const float x = bf2f((bf16_t)qr[rb][ks][j]); q2 += x * x; }
                    q2 += __shfl_xor(q2, 16); q2 += __shfl_xor(q2, 32); qq = fmaxf(qq, q2); }
                qq = wave_max(qq);
                const float* tn = (const float*)(a.ws + WS_MISC + TN2_OFF) + bg * 128;
                const int jt0w = (t0 >= 511) ? ((t0 - 511) >> 6) : 0;
                float ts = 0.f, tw = 0.f;
#pragma unroll
                for (int h2 = 0; h2 < 2; ++h2) { const int tl_ = lane + 64 * h2; if (tl_ <= cur) { ts = fmaxf(ts, tn[tl_]); if (tl_ >= jt0w) tw = fmaxf(tw, tn[2048 + tl_]); } }
                ts = wave_max(ts); tw = wave_max(tw);
                nomax_slc = __builtin_amdgcn_readfirstlane((qq * ts <= 3500.0f) ? 1 : 0) != 0;
                nomax_win = __builtin_amdgcn_readfirstlane((qq * tw <= 3500.0f) ? 1 : 0) != 0;
            }
            {
                AttnRow ss[2];
#pragma unroll
                for (int rb = 0; rb < 2; ++rb) { ss[rb].m = 0.f; ss[rb].ol = (f32x4){0.f, 0.f, 0.f, 0.f};
#pragma unroll
                    for (int dt = 0; dt < 4; ++dt) ss[rb].o[dt] = (f32x4){0.f, 0.f, 0.f, 0.f}; }
                const int nt_ = cur + 1;
                bool refmoved = false;
#define SLC_PRE(J) const int j_ = (J); bool en[2], act[2]; unsigned enm[2]; \
                    _Pragma("unroll") for (int rb = 0; rb < 2; ++rb) { const unsigned mw = mwg[rb]; \
                        en[rb] = (mw >> (j_ & 31)) & 1u; act[rb] = __any(en[rb]); enm[rb] = en[rb] ? 0xffffffffu : 0u; } const int lo2[2] = {0, 0};
#define SLC_TILE(J, SLOT) do { SLC_PRE(J) \
                    if (act[0] || act[1]) { f32x4 s[2][4]; \
                        if (refmoved) { const float cin[2] = {-ss[0].m, -ss[1].m}; attn_qk2(lds + ATK(SLOT), qr, fr, g4, cin, s); } \
                        else attn_qk2z(lds + ATK(SLOT), qr, fr, g4, s); \
                        refmoved |= attn_step2x(lds + ATV(SLOT), s, ss, 64 * j_, g4, lo2, trow, en, enm, j_ == cur, vlane, swz, onesf); } } while (0)
#define SLC_TILE_NM(J, SLOT) do { SLC_PRE(J) \
                    if (act[0] || act[1]) { f32x4 s[2][4]; const float cm_[2] = {en[0] ? 0.f : -1e30f, en[1] ? 0.f : -1e30f}; attn_qk2m(lds + ATK(SLOT), qr, fr, g4, cm_, s); \
                        const unsigned fullm_[2] = {0xffffffffu, 0xffffffffu}; \
                        attn_step2x_nomax(lds + ATV(SLOT), s, ss, 64 * j_, g4, lo2, trow, fullm_, j_ == cur, vlane, swz, onesf); } } while (0)
#pragma unroll
                for (int i = 0; i < 4; ++i) if (i < nt_) AT_DMA(1, i, i);
                __syncthreads();
#define SLC_LOOP(TILE) for (int j0 = 0; j0 < nt_; j0 += 4) { const int sb = (j0 & 4); \
                    const unsigned mwg[2] = {mskl[(fr >> 2) * 4 + (j0 >> 5)], mskl[(4 + (fr >> 2)) * 4 + (j0 >> 5)]};       \
                    _Pragma("unroll") for (int i = 0; i < 4; ++i) if (j0 + 4 + i < nt_) AT_DMA(1, j0 + 4 + i, (sb ^ 4) + i); \
                    TILE(j0, sb); if (j0 + 1 < nt_) TILE(j0 + 1, sb + 1); if (j0 + 2 < nt_) TILE(j0 + 2, sb + 2); if (j0 + 3 < nt_) TILE(j0 + 3, sb + 3); \
                    __syncthreads(); }
                if (nomax_slc) { SLC_LOOP(SLC_TILE_NM) } else { SLC_LOOP(SLC_TILE) }
#undef SLC_LOOP
#undef SLC_TILE_NM
#undef SLC_PRE
#undef SLC_TILE
                TROW_PIN();
#pragma unroll
                for (int rb = 0; rb < 2; ++rb) { const float l = __shfl(ss[rb].ol[0], fr); const float sc1 = (l > 0.f) ? GATE(rb, 1) / l : 0.f;
                    bf16_t* op = O + TOKROW(rb) * 1024 + head * 64 + 4 * g4;
#pragma unroll
                    for (int dt = 0; dt < 4; ++dt) { const u32x2 pv = *(const u32x2*)(op + 16 * dt); f32x4 v = ss[rb].o[dt] * sc1;
                        v[0] += __uint_as_float(pv.x << 16); v[1] += __uint_as_float(pv.x & 0xffff0000u); v[2] += __uint_as_float(pv.y << 16); v[3] += __uint_as_float(pv.y & 0xffff0000u);
                        u32x2 w; w.x = cvt_pk_bf16(v[0], v[1]); w.y = cvt_pk_bf16(v[2], v[3]); *(u32x2*)(op + 16 * dt) = w; } }
            }
            {
                AttnRow sw[2];
#pragma unroll
                for (int rb = 0; rb < 2; ++rb) { sw[rb].m = 0.f; sw[rb].ol = (f32x4){0.f, 0.f, 0.f, 0.f};
#pragma unroll
                    for (int dt = 0; dt < 4; ++dt) sw[rb].o[dt] = (f32x4){0.f, 0.f, 0.f, 0.f}; }
                const int jt0 = (t0 >= 511) ? ((t0 - 511) >> 6) : 0;
                const int nt_ = cur - jt0 + 1;
                const unsigned full[2] = {0xffffffffu, 0xffffffffu}; const bool both[2] = {true, true};
                bool refmoved = false;
#define WIN_PRE(JJ) const int j = jt0 + (JJ); f32x4 s[2][4]; const bool edge = (j == cur) || (64 * j < t0 + 63 - 511); const int lo2[2] = {trow[0] - 511, trow[1] - 511};
#define WIN_TILE(JJ, SLOT) do { WIN_PRE(JJ) \
                    if (refmoved) { const float cin[2] = {-sw[0].m, -sw[1].m}; attn_qk2(lds + AT4_KB + (SLOT) * 8192, qr, fr, g4, cin, s); } \
                    else attn_qk2z(lds + AT4_KB + (SLOT) * 8192, qr, fr, g4, s); \
                    refmoved |= attn_step2x(lds + AT4_VB + (SLOT) * 8192, s, sw, 64 * j, g4, lo2, trow, both, full, edge, vlane, swz, onesf); } while (0)
#define WIN_TILE_NM(JJ, SLOT) do { WIN_PRE(JJ) attn_qk2z(lds + AT4_KB + (SLOT) * 8192, qr, fr, g4, s); \
                    attn_step2x_nomax(lds + AT4_VB + (SLOT) * 8192, s, sw, 64 * j, g4, lo2, trow, full, edge, vlane, swz, onesf); } while (0)
                AT_DMA(2, jt0, 0); if (nt_ > 1) AT_DMA(2, jt0 + 1, 1); __syncthreads();
#define WIN_LOOP(TILE) for (int j0 = 0; j0 < nt_; j0 += 2) { const int sb = (j0 & 2); \
                    if (j0 + 2 < nt_) AT_DMA(2, jt0 + j0 + 2, sb ^ 2); \
                    if (j0 + 3 < nt_) AT_DMA(2, jt0 + j0 + 3, (sb ^ 2) + 1); \
                    TILE(j0, sb); if (j0 + 1 < nt_) TILE(j0 + 1, sb + 1); \
                    __syncthreads(); }
                if (nomax_win) { WIN_LOOP(WIN_TILE_NM) } else { WIN_LOOP(WIN_TILE) }
#undef WIN_LOOP
#undef WIN_TILE_NM
#undef WIN_PRE
#undef WIN_TILE
                TROW_PIN();
#pragma unroll
                for (int rb = 0; rb < 2; ++rb) { const float l = __shfl(sw[rb].ol[0], fr); const float sc2 = (l > 0.f) ? GATE(rb, 2) / l : 0.f;
                    bf16_t* op = O + TOKROW(rb) * 1024 + head * 64 + 4 * g4;
#pragma unroll
                    for (int dt = 0; dt < 4; ++dt) { const u32x2 pv = *(const u32x2*)(op + 16 * dt); f32x4 v = sw[rb].o[dt] * sc2;
                        v[0] += __uint_as_float(pv.x << 16); v[1] += __uint_as_float(pv.x & 0xffff0000u); v[2] += __uint_as_float(pv.y << 16); v[3] += __uint_as_float(pv.y & 0xffff0000u);
                        u32x2 w; w.x = cvt_pk_bf16(v[0], v[1]); w.y = cvt_pk_bf16(v[2], v[3]); *(u32x2*)(op + 16 * dt) = w; } }
            }
#undef AT_DMA
#undef ATK
#undef ATV
#undef TROW_PIN
#undef TOKROW
#undef GATE
            {
                const int npr = half ? pr + (int)gridDim.x : pr, nhalf = half ^ 1;
                cmp_pref = npr < 1024;
                if (cmp_pref) { const int nbg = npr >> 6, ncc = nhalf ? (127 - (npr & 63)) : (npr & 63);
                    const int nnct = (((ncc * 64 + 63 - 31) / 16 + 1) + 63) >> 6;
                    const bf16_t* nk = KC + (size_t)nbg * 512 * 64;
                    __builtin_amdgcn_global_load_lds((const unsigned*)(nk + ksrc), (LAS unsigned*)(lds + AT4_KB + wave * 1024), 16, 0, 0);
                    __builtin_amdgcn_global_load_lds((const unsigned*)(nk + (size_t)8192 * 64 + vsrc), (LAS unsigned*)(lds + AT4_VB + wave * 1024), 16, 0, 0);
                    if (nnct > 1) {
                        __builtin_amdgcn_global_load_lds((const unsigned*)(nk + 4096 + ksrc), (LAS unsigned*)(lds + AT4_KB + 8192 + wave * 1024), 16, 0, 0);
                        __builtin_amdgcn_global_load_lds((const unsigned*)(nk + (size_t)8192 * 64 + 4096 + vsrc), (LAS unsigned*)(lds + AT4_VB + 8192 + wave * 1024), 16, 0, 0); } } }
            cvt1_run(a, cvt_next, cvt_stride, 2, cvt_scr, lane);
        }
    }
    cvt1_run(a, cvt_next, cvt_stride, 1 << 20, cvt_scr, lane);
}

__device__ __forceinline__ void unpack8(const u32x4 w, float (&f)[8]) {
    f[0] = __uint_as_float(w.x << 16); f[1] = __uint_as_float(w.x & 0xffff0000u); f[2] = __uint_as_float(w.y << 16); f[3] = __uint_as_float(w.y & 0xffff0000u);
    f[4] = __uint_as_float(w.z << 16); f[5] = __uint_as_float(w.z & 0xffff0000u); f[6] = __uint_as_float(w.w << 16); f[7] = __uint_as_float(w.w & 0xffff0000u);
}
__device__ __forceinline__ void ph_convpool_fast(const Args& a, LAS unsigned char* lds) {
    const bf16_t* H0 = (const bf16_t*)(a.ws + WS_H0);
    bf16_t* CAT = (bf16_t*)(a.ws + WS_CAT);
    const float* cw = a.in[4]; const float* cb = a.in[5]; const float* lg = a.in[6]; const float* lb = a.in[7];
    const int tid = threadIdx.x, lane = tid & 63, wave = tid >> 6, ch = lane * 8;
    constexpr int VT_OFF = 0, UT_OFF = 62 * 1024, CW_OFF = UT_OFF + 47 * 1024;
    for (int i = tid; i < 31 * 64; i += 512) { const int k = i >> 6, c8 = (i & 63) * 8;
        const f32x4 w0 = *(const f32x4*)(cw + k * 512 + c8), w1 = *(const f32x4*)(cw + k * 512 + c8 + 4);
        u32x4 o; o.x = pk2(w0[0], w0[1]); o.y = pk2(w0[2], w0[3]); o.z = pk2(w1[0], w1[1]); o.w = pk2(w1[2], w1[3]);
        *(LAS u32x4*)(lds + CW_OFF + k * 1024 + c8 * 2) = o; }
    float bias[8], gam[8], bet[8];
#pragma unroll
    for (int j = 0; j < 8; ++j) { bias[j] = cb[ch + j]; gam[j] = lg[ch + j]; bet[j] = lb[ch + j]; }
    for (int tile = blockIdx.x; tile < M / 32; tile += gridDim.x) {
        const int tok0 = tile * 32, t0 = tok0 & (T - 1);
        __syncthreads();
        for (int i = tid; i < 62 * 64; i += 512) { const int r = i >> 6, c8 = (i & 63) * 8; const int tt = t0 - 30 + r;
            u32x4 v = (u32x4){0u, 0u, 0u, 0u}; if (tt >= 0) v = *(const u32x4*)(H0 + (size_t)(tok0 - 30 + r) * 1024 + 512 + c8);
            *(LAS u32x4*)(lds + VT_OFF + r * 1024 + c8 * 2) = v; }
        for (int i = tid; i < 47 * 64; i += 512) { const int r = i >> 6, c8 = (i & 63) * 8; const int tt = t0 - 15 + r;
            u32x4 v = (u32x4){0u, 0u, 0u, 0u}; if (tt >= 0) v = *(const u32x4*)(H0 + (size_t)(tok0 - 15 + r) * 1024 + c8);
            *(LAS u32x4*)(lds + UT_OFF + r * 1024 + c8 * 2) = v; }
        __syncthreads();
        float acc[4][8];
#pragma unroll
        for (int j = 0; j < 4; ++j)
#pragma unroll
            for (int c = 0; c < 8; ++c) acc[j][c] = bias[c];
#pragma unroll 1
        for (int k = 0; k < 31; ++k) {
            float w[8]; unpack8(*(const LAS u32x4*)(lds + CW_OFF + k * 1024 + ch * 2), w);
#pragma unroll
            for (int j = 0; j < 4; ++j) { float v[8]; unpack8(*(const LAS u32x4*)(lds + VT_OFF + (4 * wave + j + k) * 1024 + ch * 2), v);
#pragma unroll
                for (int c = 0; c < 8; ++c) acc[j][c] += w[c] * v[c]; }
        }
        const int wnd = 2 << (lane >> 4);
#pragma unroll
        for (int j = 0; j < 4; ++j) {
            const int tl = 4 * wave + j, t = t0 + tl; const size_t tok = (size_t)tok0 + tl;
            const int cnt = (t + 1 < wnd) ? (t + 1) : wnd;
            float s[8], self[8];
            unpack8(*(const LAS u32x4*)(lds + UT_OFF + (15 + tl) * 1024 + ch * 2), self);
#pragma unroll
            for (int c = 0; c < 8; ++c) s[c] = self[c];
            for (int k = 1; k < cnt; ++k) { float v[8]; unpack8(*(const LAS u32x4*)(lds + UT_OFF + (15 + tl - k) * 1024 + ch * 2), v);
#pragma unroll
                for (int c = 0; c < 8; ++c) s[c] += v[c]; }
            const float inv = 1.0f / (float)cnt;
            u32x4 o; o.x = pk2(s[0] * inv - self[0], s[1] * inv - self[1]); o.y = pk2(s[2] * inv - self[2], s[3] * inv - self[3]);
            o.z = pk2(s[4] * inv - self[4], s[5] * inv - self[5]); o.w = pk2(s[6] * inv - self[6], s[7] * inv - self[7]);
            *(u32x4*)(CAT + tok * 1024 + ch) = o;
            float sm = 0.f;
#pragma unroll
            for (int c = 0; c < 8; ++c) sm += acc[j][c];
            const float mean = wave_sum(sm) * (1.0f / 512.0f);
            float sq = 0.f;
#pragma unroll
            for (int c = 0; c < 8; ++c) { acc[j][c] -= mean; sq += acc[j][c] * acc[j][c]; }
            const float rstd = rsqrtf(wave_sum(sq) * (1.0f / 512.0f) + LN_EPS);
            float y[8];
#pragma unroll
            for (int c = 0; c < 8; ++c) { const float z = acc[j][c] * rstd * gam[c] + bet[c]; y[c] = z * sigmoidf_(z); }
            u32x4 o2; o2.x = pk2(y[0], y[1]); o2.y = pk2(y[2], y[3]); o2.z = pk2(y[4], y[5]); o2.w = pk2(y[6], y[7]);
            *(u32x4*)(CAT + tok * 1024 + 512 + ch) = o2;
        }
    }
}


__device__ __forceinline__ void ph_route_fast(const float* LOG, const float* bias, unsigned* gcnt, int2* list, unsigned char* ldsg) {
    unsigned* hist = (unsigned*)ldsg; unsigned* base = hist + 256; u32x2* sel = (u32x2*)(ldsg + 2048);
    const int tid = threadIdx.x, lane = tid & 63, wave = tid >> 6;
    const float NEG = -INFINITY;
    const float4 bb = *(const float4*)(bias + lane * 4);
    for (int chunk = blockIdx.x; chunk < M / 128; chunk += gridDim.x) {
        __syncthreads();
        if (tid < 256) hist[tid] = 0u;
        __syncthreads();
        for (int i = 0; i < 16; ++i) {
            const int tl = wave * 16 + i, tok = chunk * 128 + tl;
            const float4 lg = *(const float4*)(LOG + (size_t)tok * 256 + lane * 4);
            const float s0 = sigmoidf_(lg.x), s1 = sigmoidf_(lg.y), s2 = sigmoidf_(lg.z), s3 = sigmoidf_(lg.w);
            float v0 = s0 + bb.x, v1 = s1 + bb.y, v2 = s2 + bb.z, v3 = s3 + bb.w;
            float m1 = fmaxf(v0, v1), m2 = fminf(v0, v1);
            { const float hi = fmaxf(v2, v3), lo = fminf(v2, v3); const float n1 = fmaxf(m1, hi); const float n2 = fmaxf(fminf(m1, hi), fmaxf(m2, lo)); m1 = n1; m2 = n2; }
#pragma unroll
            for (int o = 1; o < 8; o <<= 1) { const float a1 = __shfl_xor(m1, o), a2 = __shfl_xor(m2, o); const float n1 = fmaxf(m1, a1), n2 = fmaxf(fminf(m1, a1), fmaxf(m2, a2)); m1 = n1; m2 = n2; }
            const float gs = m1 + m2; const int mygrp = lane >> 3;
            int rank = 0;
#pragma unroll
            for (int g2 = 0; g2 < 8; ++g2) { const float og = __shfl(gs, g2 * 8); rank += (og > gs || (og == gs && g2 < mygrp)) ? 1 : 0; }
            if (rank >= 4) { v0 = NEG; v1 = NEG; v2 = NEG; v3 = NEG; }
            int my_e = 0; float my_s = 0.f;
#pragma unroll
            for (int it = 0; it < 8; ++it) {
                float bv = v0; int bj = 0;
                if (v1 > bv) { bv = v1; bj = 1; }
                if (v2 > bv) { bv = v2; bj = 2; }
                if (v3 > bv) { bv = v3; bj = 3; }
                int bi = lane * 4 + bj;
#pragma unroll
                for (int o = 1; o < 64; o <<= 1) { const float ov = __shfl_xor(bv, o); const int oi = __shfl_xor(bi, o); if (ov > bv || (ov == bv && oi < bi)) { bv = ov; bi = oi; } }
                const int jj = bi & 3, ol = bi >> 2;
                const float mys = (jj == 0) ? s0 : (jj == 1) ? s1 : (jj == 2) ? s2 : s3;
                const float wsc = __shfl(mys, ol);
                if (lane == ol) { if (jj == 0) v0 = NEG; else if (jj == 1) v1 = NEG; else if (jj == 2) v2 = NEG; else v3 = NEG; }
                if (lane == it) { my_e = bi; my_s = wsc; }
            }
            const float ssum = wave_sum(lane < 8 ? my_s : 0.f);
            if (lane < 8) { const unsigned rk = atomicAdd(&hist[my_e], 1u); u32x2 en; en.x = (unsigned)my_e | (rk << 16); en.y = __float_as_uint(my_s / ssum * 2.5f); sel[tl * 8 + lane] = en; }
        }
        __syncthreads();
        if (tid < 256) { const unsigned h = hist[tid]; base[tid] = h ? atomicAdd(&gcnt[tid], h) : 0u; }
        __syncthreads();
#pragma unroll
        for (int rep = 0; rep < 2; ++rep) { const int idx = tid + rep * 512, tok = chunk * 128 + (idx >> 3), k = idx & 7;
            const u32x2 en = sel[idx]; const unsigned e = en.x & 0xffffu, pos = base[e] + (en.x >> 16);
            list[(size_t)e * LISTCAP + pos] = make_int2(tok * 10 + k, (int)en.y); }
    }
}

__global__ void __launch_bounds__(512, 2) fwd_kernel(Args a) {
    extern __shared__ __attribute__((aligned(16))) unsigned char lds[];
    volatile LAS unsigned* MISC = (volatile LAS unsigned*)((LAS unsigned char*)lds + (LDS_BYTES - 64));
    if (threadIdx.x < 16) MISC[threadIdx.x] = 0u;
    __syncthreads();
    unsigned* ctl = (unsigned*)(a.ws + WS_CTL);
#if MK_ONE_LAUNCH
    (void)xcd_barrier_post(ctl + CW_BAR, MISC + 8);
#define SEAM() do { XcdBarrier b_; b_.bar = (unsigned*)(a.ws + WS_CTL) + CW_BAR; b_.x = xb_xcc_id(); b_.st = MISC + 8; xcd_barrier(b_); } while (0)
#else
#define SEAM() do {} while (0)
#endif
    const int lo = a.ph_lo, hi = a.ph_hi;
#define IN(k) (lo <= (k) && (k) < hi)
#define BOTH(k) (IN(k) && (k) + 1 < hi)
#define X1 ((bf16_t*)(a.ws + WS_X1))
#define X2 ((bf16_t*)(a.ws + WS_X2))
#define LOG ((float*)(a.ws + WS_LOG))

    LAS unsigned char* L = (LAS unsigned char*)lds;
#define LIST ((int2*)(a.ws + WS_LIST))
#ifndef PROBE_DUP_MASK
#define PROBE_DUP_MASK 0u
#endif
#define RUN(k, ...) if (IN(k)) { { __VA_ARGS__ } if ((PROBE_DUP_MASK >> (k)) & 1u) { __syncthreads(); { __VA_ARGS__ } } if (BOTH(k)) SEAM(); }
    RUN(0, ph_prologue(a, L);)
    RUN(1, pg8::DenseSched S; S.init((const bf16_t*)(a.ws + WS_XA), D, (const bf16_t*)(a.ws + WS_WIN0), D, M, 1536);
           EpiInproj0 E{(bf16_t*)(a.ws + WS_H0)};
           pg8::gemm_phase<EpiInproj0, pg8::DenseSched, true>(L, D, 128u, S, E);)
    RUN(2, ph_convpool_fast(a, L);)
    RUN(4, pg8::DenseSched S; S.init((const bf16_t*)(a.ws + WS_CAT), D, (const bf16_t*)(a.ws + WS_WOUT0), D, M, D);
           EpiRes E{a.in[0], nullptr, (bf16_t*)(a.ws + WS_Y)};
           pg8::gemm_phase<EpiRes, pg8::DenseSched, true>(L, D, 128u, S, E);)
    RUN(5, ph_ln((const bf16_t*)(a.ws + WS_Y), a.in[17], a.in[18], X1, (unsigned char*)(a.ws + WS_X8));)
#define MOE_LAYER(P, LAYER, XIN, XOUT, OUTF) \
    RUN(P, pg8::DenseSched S; S.init(XIN, D, (const bf16_t*)(a.ws + WS_WR) + (size_t)(LAYER) * NE * D, D, M, NE); \
           EpiLogits E{LOG}; pg8::gemm_phase<EpiLogits, pg8::DenseSched, true>(L, D, 128u, S, E);) \
    if (IN(P + 1)) { ph_route_fast(LOG, a.in[22] + (LAYER) * NE, ctl + CW_CNT + (LAYER) * 256, LIST, lds); if (BOTH(P + 1)) SEAM(); } \
    RUN(P + 2, const int R = moe_setup256(ctl + CW_CNT + (LAYER) * 256, L); \
            MoeGuSched S{(const char*)(a.ws + WS_X8), (const char*)(a.ws + WS_WGU) + (size_t)(LAYER) * 257 * 512 * 1024, LIST, L, R, (R + 128) * 2, (int)gridDim.x, (int)blockIdx.x}; \
            S.prepare(); EpiGateUp E{(unsigned char*)(a.ws + WS_HID)}; pg8::gemm_phase<EpiGateUp, MoeGuSched, true, true>(L, D / 2, 128u, S, E);) \
    RUN(P + 3, const int R = moe_setup256(ctl + CW_CNT + (LAYER) * 256, L); \
            MoeDownSched S{(const char*)(a.ws + WS_HID), (const char*)(a.ws + WS_WD) + (size_t)(LAYER) * 257 * 1024 * 256, LIST, L, R, R + 128, (int)gridDim.x, (int)blockIdx.x}; \
            S.prepare(); EpiDown E{(unsigned char*)(a.ws + WS_YB), L}; pg8::gemm_phase<EpiDown, MoeDownSched, true, true>(L, FF / 2, 128u, S, E);) \
    RUN(P + 4, ph_combine(a, XIN, a.in[19] + (LAYER) * D, a.in[20] + (LAYER) * D, XOUT, OUTF);)
    MOE_LAYER(6, 0, X1, X2, nullptr)
    RUN(11, pg8::DenseSched S; S.init(X2, D, (const bf16_t*)(a.ws + WS_WINN), D, M, HNW);
            EpiInprojN E{(bf16_t*)(a.ws + WS_HN), (bf16_t*)(a.ws + WS_QR), (bf16_t*)(a.ws + WS_KV6), (float*)(a.ws + WS_GATES), (const float*)(a.ws + WS_MISC) + 1024};
            pg8::gemm_phase<EpiInprojN, pg8::DenseSched, true>(L, D, 128u, S, E);)
    RUN(13, Cmp1Sched S{(const char*)(a.ws + WS_KV6), (const char*)(a.ws + WS_CW1), (int)gridDim.x, (int)blockIdx.x};
            EpiCmp1 E{(bf16_t*)(a.ws + WS_CH1), (const float*)(a.ws + WS_MISC)};
            pg8::gemm_phase<EpiCmp1, Cmp1Sched, true>(L, 2048, 128u, S, E); ph_knorm(a);)
    RUN(14, ph_cmp2(a, lds);)
    RUN(15, ph_attn_fast2(a, L);)
    RUN(16, pg8::DenseSched S; S.init((const bf16_t*)(a.ws + WS_O), D, (const bf16_t*)(a.ws + WS_WOUTN), D, M, D);
            EpiRes E{nullptr, X2, (bf16_t*)(a.ws + WS_Y2)};
            pg8::gemm_phase<EpiRes, pg8::DenseSched, true>(L, D, 128u, S, E);)
    RUN(17, ph_ln((const bf16_t*)(a.ws + WS_Y2), a.in[17] + D, a.in[18] + D, X1, (unsigned char*)(a.ws + WS_X8));)
    MOE_LAYER(18, 1, X1, (bf16_t*)nullptr, a.out)
}

extern "C" void kernel_launch(void* const* d_in, const int* in_sizes, int n_in, void* d_out, int out_size, void* d_ws, size_t ws_size, hipStream_t stream) {
    static int grid = 0;
    if (grid == 0) {
        if (n_in != 29 || out_size != M * D || ws_size < WS_END) { fprintf(stderr, "kernel_launch: unexpected problem (n_in %d out %d ws %zu)\n", n_in, out_size, ws_size); grid = -1; return; }
        int dev = 0, cus = 0;
        if (hipGetDevice(&dev) != hipSuccess || hipDeviceGetAttribute(&cus, hipDeviceAttributeMultiprocessorCount, dev) != hipSuccess) { grid = -1; return; }
        if (hipFuncSetAttribute((const void*)fwd_kernel, hipFuncAttributeMaxDynamicSharedMemorySize, LDS_BYTES) != hipSuccess) { grid = -1; return; }
        int per_cu = 0;
        (void)hipOccupancyMaxActiveBlocksPerMultiprocessor(&per_cu, (const void*)fwd_kernel, 512, LDS_BYTES);
        (void)hipGetLastError();
        grid = cus;
    }
    if (grid < 0) return;
    (void)hipMemsetAsync((char*)d_ws + WS_CTL, 0, CTL_BYTES, stream);
    Args a{};
    for (int i = 0; i < 29; ++i) a.in[i] = (const float*)d_in[i];
    a.out = (float*)d_out; a.ws = (unsigned char*)d_ws;
    for (int i = 0; i < 8; ++i) a.inv_freq[i] = powf(500000.0f, -(float)(2 * i) / 16.0f);
#if MK_ONE_LAUNCH
    a.ph_lo = 0; a.ph_hi = NPHASE;
    hipLaunchKernelGGL(fwd_kernel, dim3(grid), dim3(512), LDS_BYTES, stream, a);
#else
    for (int p = 0; p < NPHASE; ++p) { a.ph_lo = p; a.ph_hi = p + 1; hipLaunchKernelGGL(fwd_kernel, dim3(grid), dim3(512), LDS_BYTES, stream, a); }
#endif
}
```

```cpp
#include <hip/hip_runtime.h>
#include <cstdint>
#include <cstdio>
#include <cmath>

#ifndef MK_ONE_LAUNCH
#define MK_ONE_LAUNCH 1
#endif

#define LAS __attribute__((address_space(3)))
typedef unsigned short bf16_t;
typedef short bf16x8 __attribute__((ext_vector_type(8)));
typedef float f32x4 __attribute__((ext_vector_type(4)));
typedef unsigned u32x2 __attribute__((ext_vector_type(2)));
typedef unsigned u32x4 __attribute__((ext_vector_type(4)));

constexpr int NB = 4, T = 8192, D = 1024, M = NB * T;
constexpr int NE = 256, TOPK = 8, FF = 256;
constexpr int HNW = 2816;
constexpr int LISTCAP = 32768;
constexpr float ALPHA = 1.4142135623730951f;
constexpr float LN_EPS = 1e-5f;
constexpr float QSCALE = 0.125f * 1.4426950408889634f;
constexpr int YB_NSLOT = 9;
constexpr float YB_SCALE = 16.0f;
constexpr int NPHASE = 23;

constexpr size_t MiB = 1u << 20;
constexpr size_t WS_CTL = 0, CTL_BYTES = 1 * MiB;
constexpr size_t WS_X1 = 1 * MiB;
constexpr size_t WS_X2 = WS_X1 + 64 * MiB;
constexpr size_t WS_LOG = WS_X2 + 64 * MiB;
constexpr size_t WS_LIST = WS_LOG + 32 * MiB;
constexpr size_t WS_WTS = WS_LIST + 64 * MiB;
constexpr size_t WS_HID = WS_WTS + 2 * MiB;
constexpr size_t WS_YB = WS_HID + 184 * MiB;
constexpr size_t WS_END_NAIVE = WS_YB + 576 * MiB;
constexpr size_t WS_WIN0 = WS_END_NAIVE;
constexpr size_t WS_WOUT0 = WS_WIN0 + 3 * MiB;
constexpr size_t WS_WINN = WS_WOUT0 + 2 * MiB;
constexpr size_t WS_WOUTN = WS_WINN + 6 * MiB;
constexpr size_t WS_WR = WS_WOUTN + 2 * MiB;
constexpr size_t WS_CW1 = WS_WR + 1 * MiB;
constexpr size_t WS_MISC = WS_CW1 + 2 * MiB;
constexpr size_t WS_WGU = WS_MISC + 1 * MiB;
constexpr size_t WS_X8 = WS_WGU + 257 * MiB;
constexpr float X8_SCALE = 8.0f, W8_SCALE = 64.0f, H8_SCALE = 16.0f;
constexpr size_t WS_WD = WS_WGU + 514 * MiB;
constexpr size_t WS_END = WS_WD + 257 * MiB;
constexpr size_t WS_XA = WS_X2;
constexpr size_t WS_H0 = WS_YB;
constexpr size_t WS_PM = WS_H0 + 64 * MiB;
constexpr size_t WS_CAT = WS_PM + 32 * MiB;
constexpr size_t WS_Y = WS_CAT + 64 * MiB;
constexpr size_t WS_HN = WS_YB;
constexpr size_t WS_KV6 = WS_HN + 64 * MiB;
constexpr size_t WS_QR = WS_HN + 176 * MiB;
constexpr size_t WS_GATES = WS_QR + 64 * MiB;
constexpr size_t WS_CH1 = WS_GATES + 8 * MiB;
constexpr size_t WS_KC = WS_CH1 + 4 * MiB;
constexpr size_t WS_O = WS_KC + 2 * MiB;
constexpr size_t WS_Y2 = WS_O + 64 * MiB;
static_assert(WS_Y2 + 64 * MiB <= WS_END_NAIVE, "overlay");
static_assert(WS_Y + 64 * MiB <= WS_END_NAIVE, "overlay");

constexpr int CW_CNT = 64;
constexpr int CW_BAR = 4096;

constexpr int LDS_BYTES = 163840;

__device__ __forceinline__ float bf2f(bf16_t h) { return __uint_as_float(((unsigned)h) << 16); }
__device__ __forceinline__ bf16_t f2bf(float f) { unsigned u = __float_as_uint(f); return (bf16_t)((u + 0x7fffu + ((u >> 16) & 1u)) >> 16); }
__device__ __forceinline__ unsigned pk2(float lo, float hi) { return (unsigned)f2bf(lo) | ((unsigned)f2bf(hi) << 16); }
#define WR_DPP(x, ctrl) __builtin_bit_cast(float, __builtin_amdgcn_update_dpp(__builtin_bit_cast(int, (float)(x)), __builtin_bit_cast(int, (float)(x)), (ctrl), 0xF, 0xF, true))
#define WR_ROW(x, r) __builtin_bit_cast(float, __builtin_amdgcn_readlane(__builtin_bit_cast(int, (float)(x)), 16 * (r)))
__device__ __forceinline__ float wave_sum(float v) {
    v += WR_DPP(v, 0xB1); v += WR_DPP(v, 0x4E); v += WR_DPP(v, 0x141); v += WR_DPP(v, 0x140);
    return (WR_ROW(v, 0) + WR_ROW(v, 1)) + (WR_ROW(v, 2) + WR_ROW(v, 3));
}
__device__ __forceinline__ float wave_max(float v) {
    v = fmaxf(v, WR_DPP(v, 0xB1)); v = fmaxf(v, WR_DPP(v, 0x4E)); v = fmaxf(v, WR_DPP(v, 0x141)); v = fmaxf(v, WR_DPP(v, 0x140));
    return fmaxf(fmaxf(WR_ROW(v, 0), WR_ROW(v, 1)), fmaxf(WR_ROW(v, 2), WR_ROW(v, 3)));
}
__device__ __forceinline__ float sigmoidf_(float x) { return 1.0f / (1.0f + __expf(-x)); }
__device__ __forceinline__ float gelu_tanh(float x) {
    const float u = 0.7978845608028654f * (x + 0.044715f * x * x * x);
    const float e = __expf(2.0f * u);
    const float th = 1.0f - 2.0f / (e + 1.0f);
    return 0.5f * x * (1.0f + th);
}
__device__ __forceinline__ bf16x8 cvt8(const float* p) {
    const float4 a = *(const float4*)p, b = *(const float4*)(p + 4);
    bf16x8 r;
    r[0] = (short)f2bf(a.x); r[1] = (short)f2bf(a.y); r[2] = (short)f2bf(a.z); r[3] = (short)f2bf(a.w);
    r[4] = (short)f2bf(b.x); r[5] = (short)f2bf(b.y); r[6] = (short)f2bf(b.z); r[7] = (short)f2bf(b.w);
    return r;
}
__device__ __forceinline__ bf16x8 colk8(const float* W, int N, int k, int col) {
    bf16x8 r;
#pragma unroll
    for (int j = 0; j < 8; ++j) r[j] = (short)f2bf(W[(size_t)(k + j) * N + col]);
    return r;
}
__device__ __forceinline__ bf16x8 zero8() { return (bf16x8){0, 0, 0, 0, 0, 0, 0, 0}; }
#define WSYNC() asm volatile("s_waitcnt lgkmcnt(0)" ::: "memory")

#define XB_TMO      128
#define XB_XCNT(j)  (256  + 64 * (j))
#define XB_XSUB(j)  (1280 + 64 * (j))
#define XB_XGEN(j)  (2304 + 64 * (j))
#define XB_TOP      3328
#define XB_TOPGEN   3392
#define XCD_BAR_WORDS 3456
#define XB_SPIN_CAP (1u << 22)
__device__ __forceinline__ unsigned xb_ld(unsigned* p)              { return __hip_atomic_load(p, __ATOMIC_RELAXED, __HIP_MEMORY_SCOPE_AGENT); }
__device__ __forceinline__ unsigned xb_add(unsigned* p, unsigned v) { return __hip_atomic_fetch_add(p, v, __ATOMIC_RELAXED, __HIP_MEMORY_SCOPE_AGENT); }
__device__ __forceinline__ unsigned xb_xcc_id() { return (unsigned)__builtin_amdgcn_s_getreg((3 << 11) | 20) & 0xFu; }
#define XB_SPIN(cond, bar) do { unsigned _sp = 0; while (cond) { __builtin_amdgcn_s_sleep(1); \
    if ((++_sp & 255u) == 0u) { if (xb_ld(&(bar)[XB_TMO])) break; if (_sp > XB_SPIN_CAP) { atomicAdd(&(bar)[XB_TMO], 1u); break; } } } } while (0)
struct XcdBarrier { unsigned* bar; unsigned x; volatile LAS unsigned* st; };
__device__ __forceinline__ XcdBarrier xcd_barrier_post(unsigned* bar, volatile LAS unsigned* st) {
    XcdBarrier b; b.bar = bar; b.x = xb_xcc_id(); b.st = st;
    if (threadIdx.x == 0) (void)xb_add(&bar[XB_XCNT(b.x)], 1u);
    return b;
}
__device__ __forceinline__ void xcd_barrier_complete(unsigned* bar, unsigned x, unsigned& nloc, unsigned& nx) {
    const unsigned G = gridDim.x * gridDim.y * gridDim.z;
    unsigned sum, cnt, mine, sp = 0u;
    for (;;) {
        sum = 0u; cnt = 0u; mine = 0u;
#pragma unroll
        for (unsigned j = 0; j < 16; ++j) { const unsigned c = xb_ld(&bar[XB_XCNT(j)]); sum += c; cnt += (c > 0u) ? 1u : 0u; mine = (j == x) ? c : mine; }
        if (sum == G) break;
        __builtin_amdgcn_s_sleep(1);
        if ((++sp & 255u) == 0u) { if (xb_ld(&bar[XB_TMO])) break; if (sp > XB_SPIN_CAP) { atomicAdd(&bar[XB_TMO], 1u); break; } }
    }
    nloc = mine > 0u ? mine : 1u; nx = cnt > 0u ? cnt : 1u;
}
__device__ __forceinline__ void xcd_barrier(const XcdBarrier& b) {
    asm volatile("s_waitcnt vmcnt(0)" ::: "memory");
    __syncthreads();
    if (threadIdx.x == 0) {
        unsigned* bar = b.bar;
        __builtin_amdgcn_s_waitcnt(0);
        unsigned nloc = b.st[0], nx = b.st[1];
        if (nloc == 0u) { xcd_barrier_complete(bar, b.x, nloc, nx); b.st[0] = nloc; b.st[1] = nx; }
        const unsigned old = xb_add(&bar[XB_XSUB(b.x)], 1u);
        const unsigned gen = old / nloc;
        if (old + 1u == (gen + 1u) * nloc) {
            __builtin_amdgcn_fence(__ATOMIC_RELEASE, "agent");
            asm volatile("s_waitcnt vmcnt(0)" ::: "memory");
            const unsigned og = xb_add(&bar[XB_TOP], 1u);
            const unsigned tg = og / nx;
            if (og + 1u == (tg + 1u) * nx) xb_add(&bar[XB_TOPGEN], 1u);
            else XB_SPIN(xb_ld(&bar[XB_TOPGEN]) == tg, bar);
            __builtin_amdgcn_fence(__ATOMIC_ACQUIRE, "agent");
            xb_add(&bar[XB_XGEN(b.x)], 1u);
            asm volatile("s_waitcnt vmcnt(0)" ::: "memory");
        } else {
            XB_SPIN(xb_ld(&bar[XB_XGEN(b.x)]) == gen, bar);
            __builtin_amdgcn_fence(__ATOMIC_ACQUIRE, "agent");
            asm volatile("s_waitcnt vmcnt(0)" ::: "memory");
        }
    }
    __syncthreads();
}

template <class AL, class BL, class EP>
__device__ __forceinline__ void mgemm_tile(unsigned char* lds, int K, const AL& al, const BL& bl, const EP& ep) {
    bf16_t* As = (bf16_t*)lds;
    bf16_t* Bs = As + 128 * 40;
    const int tid = threadIdx.x, lane = tid & 63, wave = tid >> 6;
    const int ar = tid >> 2, ac = (tid & 3) * 8;
    const int bn = tid & 127, bc = (tid >> 7) * 8;
    f32x4 acc[8];
#pragma unroll
    for (int s = 0; s < 8; ++s) acc[s] = (f32x4){0.f, 0.f, 0.f, 0.f};
    bf16x8 ra = al(ac), rb = bl(bc);
    for (int k0 = 0; k0 < K; k0 += 32) {
        __syncthreads();
        *(bf16x8*)(As + ar * 40 + ac) = ra;
        *(bf16x8*)(Bs + bn * 40 + bc) = rb;
        __syncthreads();
        if (k0 + 32 < K) { ra = al(k0 + 32 + ac); rb = bl(k0 + 32 + bc); }
        const bf16x8 af = *(const bf16x8*)(As + (wave * 16 + (lane & 15)) * 40 + (lane >> 4) * 8);
#pragma unroll
        for (int s = 0; s < 8; ++s) {
            const bf16x8 wf = *(const bf16x8*)(Bs + (16 * s + (lane & 15)) * 40 + (lane >> 4) * 8);
            acc[s] = __builtin_amdgcn_mfma_f32_16x16x32_bf16(wf, af, acc[s], 0, 0, 0);
        }
    }
    ep(wave * 16 + (lane & 15), (lane >> 4) * 4, acc);
}
__device__ __forceinline__ void store4bf(bf16_t* p, const f32x4 v) { u32x2 w; w.x = pk2(v[0], v[1]); w.y = pk2(v[2], v[3]); *(u32x2*)p = w; }

struct Args {
    const float* in[29];
    float* out;
    unsigned char* ws;
    float inv_freq[8];
    int ph_lo, ph_hi;
};

__device__ __forceinline__ unsigned pk4_fp8(float a, float b, float c, float d) { int w = __builtin_amdgcn_cvt_pk_fp8_f32(a, b, 0, false); return (unsigned)__builtin_amdgcn_cvt_pk_fp8_f32(c, d, w, true); }
__device__ __forceinline__ u32x2 pack8_fp8(const f32x4 v0, const f32x4 v1) {
    int a = __builtin_amdgcn_cvt_pk_fp8_f32(v0[0], v0[1], 0, false); a = __builtin_amdgcn_cvt_pk_fp8_f32(v0[2], v0[3], a, true);
    int b = __builtin_amdgcn_cvt_pk_fp8_f32(v1[0], v1[1], 0, false); b = __builtin_amdgcn_cvt_pk_fp8_f32(v1[2], v1[3], b, true);
    u32x2 w; w.x = (unsigned)a; w.y = (unsigned)b; return w;
}
__device__ __forceinline__ float clamp8(float v) { return __builtin_amdgcn_fmed3f(v, -448.0f, 448.0f); }
__device__ __forceinline__ void ph_ln(const bf16_t* Y, const float* g, const float* b, bf16_t* X, unsigned char* X8) {
    const int lane = threadIdx.x & 63, wave = threadIdx.x >> 6;
    const int gw = blockIdx.x * 8 + wave, ngw = gridDim.x * 8;
    float gg[16], bb[16];
#pragma unroll
    for (int j = 0; j < 8; ++j) { gg[j] = g[lane * 8 + j]; gg[8 + j] = g[512 + lane * 8 + j]; bb[j] = b[lane * 8 + j]; bb[8 + j] = b[512 + lane * 8 + j]; }
    for (int row0 = gw * 4; row0 < M; row0 += ngw * 4) {
        bf16x8 p0[4], p1[4];
#pragma unroll
        for (int r = 0; r < 4; ++r) { p0[r] = __builtin_nontemporal_load((const bf16x8*)(Y + (size_t)(row0 + r) * 1024 + lane * 8)); p1[r] = __builtin_nontemporal_load((const bf16x8*)(Y + (size_t)(row0 + r) * 1024 + 512 + lane * 8)); }
#pragma unroll
        for (int r = 0; r < 4; ++r) {
            float v[16];
#pragma unroll
            for (int j = 0; j < 8; ++j) { v[j] = bf2f((bf16_t)p0[r][j]); v[8 + j] = bf2f((bf16_t)p1[r][j]); }
            float s = 0.f;
#pragma unroll
            for (int j = 0; j < 16; ++j) s += v[j];
            const float mean = wave_sum(s) * (1.0f / 1024.0f);
            float q = 0.f;
#pragma unroll
            for (int j = 0; j < 16; ++j) { v[j] -= mean; q += v[j] * v[j]; }
            const float rstd = rsqrtf(wave_sum(q) * (1.0f / 1024.0f) + LN_EPS);
            float o[16];
#pragma unroll
            for (int j = 0; j < 16; ++j) o[j] = v[j] * rstd * gg[j] + bb[j];
            u32x4 w0, w1;
            w0.x = pk2(o[0], o[1]); w0.y = pk2(o[2], o[3]); w0.z = pk2(o[4], o[5]); w0.w = pk2(o[6], o[7]);
            w1.x = pk2(o[8], o[9]); w1.y = pk2(o[10], o[11]); w1.z = pk2(o[12], o[13]); w1.w = pk2(o[14], o[15]);
            *(u32x4*)(X + (size_t)(row0 + r) * 1024 + lane * 8) = w0; *(u32x4*)(X + (size_t)(row0 + r) * 1024 + 512 + lane * 8) = w1;
#pragma unroll
            for (int j = 0; j < 16; ++j) o[j] = clamp8(o[j] * X8_SCALE);
            u32x2 q0, q1; q0.x = pk4_fp8(o[0], o[1], o[2], o[3]); q0.y = pk4_fp8(o[4], o[5], o[6], o[7]); q1.x = pk4_fp8(o[8], o[9], o[10], o[11]); q1.y = pk4_fp8(o[12], o[13], o[14], o[15]);
            *(u32x2*)(X8 + (size_t)(row0 + r) * 1024 + lane * 8) = q0; *(u32x2*)(X8 + (size_t)(row0 + r) * 1024 + 512 + lane * 8) = q1;
        }
    }
}

__device__ __forceinline__ void ph_combine(const Args& a, const bf16_t* X, const float* g, const float* b, bf16_t* Xo, float* outf) {
    const unsigned char* YB = (const unsigned char*)(a.ws + WS_YB);
    const int lane = threadIdx.x & 63, wave = threadIdx.x >> 6;
    const int gw = blockIdx.x * 8 + wave, ngw = gridDim.x * 8;
    for (int row = gw; row < M; row += ngw) {
        float v[16];
#pragma unroll
        for (int j = 0; j < 16; ++j) v[j] = 0.f;
        u32x2 q0[YB_NSLOT], q1[YB_NSLOT];
#pragma unroll
        for (int k = 0; k < YB_NSLOT; ++k) { const unsigned char* yr = YB + ((size_t)row * 10 + k) * 1024; q0[k] = __builtin_nontemporal_load((const u32x2*)(yr + lane * 8)); q1[k] = __builtin_nontemporal_load((const u32x2*)(yr + 512 + lane * 8)); }
#pragma unroll
        for (int k = 0; k < YB_NSLOT; ++k) {
            const auto a0 = __builtin_amdgcn_cvt_pk_f32_fp8((int)q0[k].x, false), a1 = __builtin_amdgcn_cvt_pk_f32_fp8((int)q0[k].x, true), a2 = __builtin_amdgcn_cvt_pk_f32_fp8((int)q0[k].y, false), a3 = __builtin_amdgcn_cvt_pk_f32_fp8((int)q0[k].y, true);
            const auto b0 = __builtin_amdgcn_cvt_pk_f32_fp8((int)q1[k].x, false), b1 = __builtin_amdgcn_cvt_pk_f32_fp8((int)q1[k].x, true), b2 = __builtin_amdgcn_cvt_pk_f32_fp8((int)q1[k].y, false), b3 = __builtin_amdgcn_cvt_pk_f32_fp8((int)q1[k].y, true);
            v[0] += a0[0]; v[1] += a0[1]; v[2] += a1[0]; v[3] += a1[1]; v[4] += a2[0]; v[5] += a2[1]; v[6] += a3[0]; v[7] += a3[1];
            v[8] += b0[0]; v[9] += b0[1]; v[10] += b1[0]; v[11] += b1[1]; v[12] += b2[0]; v[13] += b2[1]; v[14] += b3[0]; v[15] += b3[1];
        }
        {
            const bf16x8 p0 = *(const bf16x8*)(X + (size_t)row * 1024 + lane * 8), p1 = *(const bf16x8*)(X + (size_t)row * 1024 + 512 + lane * 8);
#pragma unroll
            for (int j = 0; j < 8; ++j) { v[j] = v[j] * (1.0f / YB_SCALE) + ALPHA * bf2f((bf16_t)p0[j]); v[8 + j] = v[8 + j] * (1.0f / YB_SCALE) + ALPHA * bf2f((bf16_t)p1[j]); }
        }
        float s = 0.f;
#pragma unroll
        for (int j = 0; j < 16; ++j) s += v[j];
        const float mean = wave_sum(s) * (1.0f / 1024.0f);
        float q = 0.f;
#pragma unroll
        for (int j = 0; j < 16; ++j) { v[j] -= mean; q += v[j] * v[j]; }
        const float rstd = rsqrtf(wave_sum(q) * (1.0f / 1024.0f) + LN_EPS);
        float o[16];
#pragma unroll
        for (int j = 0; j < 8; ++j) { o[j] = v[j] * rstd * g[lane * 8 + j] + b[lane * 8 + j]; o[8 + j] = v[8 + j] * rstd * g[512 + lane * 8 + j] + b[512 + lane * 8 + j]; }
        if (outf) {
            float* op = outf + (size_t)row * 1024;
            *(float4*)(op + lane * 8) = make_float4(o[0], o[1], o[2], o[3]); *(float4*)(op + lane * 8 + 4) = make_float4(o[4], o[5], o[6], o[7]);
            *(float4*)(op + 512 + lane * 8) = make_float4(o[8], o[9], o[10], o[11]); *(float4*)(op + 512 + lane * 8 + 4) = make_float4(o[12], o[13], o[14], o[15]);
        } else {
            u32x4 w0, w1;
            w0.x = pk2(o[0], o[1]); w0.y = pk2(o[2], o[3]); w0.z = pk2(o[4], o[5]); w0.w = pk2(o[6], o[7]);
            w1.x = pk2(o[8], o[9]); w1.y = pk2(o[10], o[11]); w1.z = pk2(o[12], o[13]); w1.w = pk2(o[14], o[15]);
            *(u32x4*)(Xo + (size_t)row * 1024 + lane * 8) = w0; *(u32x4*)(Xo + (size_t)row * 1024 + 512 + lane * 8) = w1;
        }
    }
}

__device__ __forceinline__ void ph_cmp2(const Args& a, unsigned char* lds) {
    const bf16_t* CH1 = (const bf16_t*)(a.ws + WS_CH1);
    bf16_t* KC = (bf16_t*)(a.ws + WS_KC);
    const int tid = threadIdx.x;
    for (int u = blockIdx.x; u < 64 * 2; u += gridDim.x) {
        const int rt = u >> 1, kv = u & 1;
        const bf16_t* ar = CH1 + ((size_t)kv * 8192 + rt * 128 + (tid >> 2)) * 128;
        const float* w2 = a.in[kv ? 15 : 12];
        const int col = tid & 127;
        auto al = [&](int k) { return *(const bf16x8*)(ar + k); };
        auto bl = [&](int k) { return (col < 64) ? colk8(w2, 64, k, col) : zero8(); };
        auto ep = [&](int r, int cb, const f32x4 (&acc)[8]) {
            bf16_t* o = KC + ((size_t)kv * 8192 + rt * 128 + r) * 64;
#pragma unroll
            for (int s = 0; s < 4; ++s) store4bf(o + 16 * s + cb, acc[s]);
        };
        mgemm_tile(lds, 128, al, bl, ep);
    }
}

namespace pg8 {
constexpr int BM = 256, BK = 64, HALF = 128, HTB = HALF * BK * 2, STAGE_BYTES = 8 * HTB;
__device__ __forceinline__ int lds_byte(int r, int c) { const int st = (r >> 4) * 2 + (c >> 5), rr = r & 15, cc = c & 31, ob = rr * 64 + cc * 2; return st * 1024 + (ob ^ (((ob >> 9) & 1) << 5)); }
__device__ __forceinline__ void stage_rc(int b, int& R, int& C) { const int st = b / 1024, sb = b % 1024, swz = sb ^ (((sb >> 9) & 1) << 5); R = (st >> 1) * 16 + swz / 64; C = (st & 1) * 32 + (swz % 64) / 2; }
__device__ __forceinline__ int perm32(int rho) { const int n = rho >> 4, i = rho & 15; return 8 * (i >> 2) + 4 * n + (i & 3); }
struct Unit { int pm, pn, ord; };
typedef float f32x16 __attribute__((ext_vector_type(16)));
typedef int i32x8 __attribute__((ext_vector_type(8))); typedef int i32x4_ __attribute__((ext_vector_type(4)));
__device__ __forceinline__ i32x8 f8cat(const bf16x8 lo, const bf16x8 hi) { return __builtin_shufflevector(__builtin_bit_cast(i32x4_, lo), __builtin_bit_cast(i32x4_, hi), 0, 1, 2, 3, 4, 5, 6, 7); }
template <class Epi, class Sched, bool ALIGN_EPI, bool F8 = false>
__device__ __forceinline__ void gemm_phase(LAS unsigned char* lds, const int K, const unsigned kstepA, const Sched& S, const Epi& E) {
    const int tid = threadIdx.x, wid = __builtin_amdgcn_readfirstlane(tid >> 6), lane = tid & 63, wr = wid >> 2, wc = wid & 3, fr = lane & 15, fq = lane >> 4;
    const int nt = K / BK;
    constexpr bool GA = Sched::GATHER;
    int RA[2]; unsigned CA2[2], voffB[2], voffB1[2], voffA[2];
    constexpr bool P16 = Epi::PERM16;
#pragma unroll
    for (int i = 0; i < 2; ++i) { int R, C; stage_rc(tid * 16 + i * 8192, R, C); const int Rb = Epi::PERM ? ((R & ~31) + perm32(R & 31)) : R;
        RA[i] = R; CA2[i] = (unsigned)C * 2u; voffB[i] = (unsigned)(Rb * K + C) * 2u; voffA[i] = GA ? 0u : (S.lane_off(R) + (unsigned)C * 2u);
        if (P16) { const int c16 = 64 * (R >> 5) + 16 * ((R >> 2) & 3) + 4 * ((R >> 4) & 1) + (R & 3); voffB[i] = (unsigned)(c16 * K + C) * 2u; voffB1[i] = (unsigned)((c16 + 8) * K + C) * 2u; } else voffB1[i] = 0u; }
    const size_t kstepB = (size_t)(BK * 2);
    const size_t hstepB = (size_t)HALF * K * 2;
    const unsigned ldsw = (unsigned)wid * 1024u;
    const int aoff = lds_byte(wr * 64 + fr, fq * 8), boff = lds_byte(wc * 32 + fr, fq * 8);
    const char* const Ab = S.abase();
    unsigned aoC[2][2], aoN[2][2];
    unsigned uC[2], uN[2];
#define PG8_SA(b, h) (((b) * 2 + (h)) * HTB)
#define PG8_SB(b, h) ((4 + (b) * 2 + (h)) * HTB)
#define PG8_GLDS(sbase, voff, ldsoff) do { const char* _b = (const char*)(sbase); unsigned _v = (voff); asm volatile("" : "+s"(_b), "+v"(_v)); \
        __builtin_amdgcn_global_load_lds((const unsigned*)(_b + _v), (LAS unsigned*)(lds + (ldsoff)), 16, 0, 0); } while (0)
#define PG8_STAGE_B(bufoff, gbase) do { _Pragma("unroll") for (int _i = 0; _i < 2; ++_i) PG8_GLDS(gbase, voffB[_i], (bufoff) + ldsw + _i * 8192); } while (0)
#define PG8_STAGE_B1(bufoff, gbase) do { _Pragma("unroll") for (int _i = 0; _i < 2; ++_i) PG8_GLDS((const char*)(gbase) + (P16 ? (size_t)0 : hstepB), (P16 ? voffB1[_i] : voffB[_i]), (bufoff) + ldsw + _i * 8192); } while (0)
#define PG8_STAGE_A(bufoff, kb, UO, LO) do { _Pragma("unroll") for (int _i = 0; _i < 2; ++_i) PG8_GLDS(Ab + (size_t)((kb) + (UO)), (GA ? (LO)[_i] : voffA[_i]), (bufoff) + ldsw + _i * 8192); } while (0)
#define PG8_LDA(dst, b, h) do { _Pragma("unroll") for (int m = 0; m < 4; ++m) _Pragma("unroll") for (int k = 0; k < 2; ++k) dst[m][k] = *(const LAS bf16x8*)(lds + PG8_SA(b, h) + aoff + m * 2048 + k * 1024); } while (0)
#define PG8_LDB(dst, b, h) do { _Pragma("unroll") for (int n = 0; n < 2; ++n) _Pragma("unroll") for (int k = 0; k < 2; ++k) dst[n][k] = *(const LAS bf16x8*)(lds + PG8_SB(b, h) + boff + n * 2048 + k * 1024); } while (0)
#define PG8_MMA(ai, bj, At, Bt) do { __builtin_amdgcn_s_setprio(1); _Pragma("unroll") for (int m = 0; m < 4; ++m) _Pragma("unroll") for (int n = 0; n < 2; ++n) { \
        if constexpr (F8) { f32x16& _w = accw[ai][bj][m >> 1]; const int _q = ((m & 1) * 2 + n) * 4; f32x4 _c = {_w[_q], _w[_q + 1], _w[_q + 2], _w[_q + 3]}; \
            _c = __builtin_amdgcn_mfma_scale_f32_16x16x128_f8f6f4(f8cat(Bt[n][0], Bt[n][1]), f8cat(At[m][0], At[m][1]), _c, 0, 0, 0, 0, 0, 0); _w[_q] = _c[0]; _w[_q + 1] = _c[1]; _w[_q + 2] = _c[2]; _w[_q + 3] = _c[3]; } \
        else { _Pragma("unroll") for (int k = 0; k < 2; ++k) acc[ai][bj][m][n] = __builtin_amdgcn_mfma_f32_16x16x32_bf16(Bt[n][k], At[m][k], acc[ai][bj][m][n], 0, 0, 0); } } __builtin_amdgcn_s_setprio(0); } while (0)
#define PG8_WAIT_V(n) asm volatile("s_waitcnt vmcnt(" #n ")" ::: "memory")
#define PG8_WAIT_L(n) asm volatile("s_waitcnt lgkmcnt(" #n ")" ::: "memory")
#define PG8_BAR __builtin_amdgcn_s_barrier()
#define PG8_SCHED __builtin_amdgcn_sched_barrier(0)
#define PG8_KPAIR(KB1, KB2, KB3, BP2, BP3) do { \
            PG8_LDB(B0, 0, 0); PG8_LDB(B1, 0, 1); PG8_SCHED; PG8_LDA(At, 0, 0); PG8_STAGE_A(PG8_SA(1, 1), KB1, uC[1], aoC[1]); \
            PG8_WAIT_V(8); PG8_WAIT_L(0); PG8_BAR; PG8_MMA(0, 0, At, B0); PG8_MMA(0, 1, At, B1); PG8_BAR; PG8_SCHED; \
            PG8_LDA(At, 0, 1); PG8_STAGE_B(PG8_SB(0, 0), BP2); PG8_STAGE_B1(PG8_SB(0, 1), BP2); PG8_STAGE_A(PG8_SA(0, 0), KB2, u2[0], a2o[0]); \
            PG8_WAIT_V(8); PG8_WAIT_L(0); PG8_BAR; PG8_MMA(1, 0, At, B0); PG8_MMA(1, 1, At, B1); PG8_BAR; PG8_SCHED; \
            PG8_LDB(B0, 1, 0); PG8_LDB(B1, 1, 1); PG8_SCHED; PG8_LDA(At, 1, 0); PG8_STAGE_A(PG8_SA(0, 1), KB2, u2[1], a2o[1]); \
            PG8_WAIT_V(8); PG8_WAIT_L(0); PG8_BAR; PG8_MMA(0, 0, At, B0); PG8_MMA(0, 1, At, B1); PG8_BAR; PG8_SCHED; \
            PG8_LDA(At, 1, 1); PG8_STAGE_B(PG8_SB(1, 0), BP3); PG8_STAGE_B1(PG8_SB(1, 1), BP3); PG8_STAGE_A(PG8_SA(1, 0), KB3, u2[0], a2o[0]); \
            PG8_WAIT_V(8); PG8_WAIT_L(0); PG8_BAR; PG8_MMA(1, 0, At, B0); PG8_MMA(1, 1, At, B1); PG8_BAR; PG8_SCHED; } while (0)
    Unit cur, nxt; int ui = 0;
    if (!S.next(0, cur)) return;
    f32x4 acc[2][2][4][2];
#pragma unroll
    for (int a = 0; a < 2; ++a)
#pragma unroll
        for (int b = 0; b < 2; ++b)
#pragma unroll
            for (int m = 0; m < 4; ++m)
#pragma unroll
                for (int n = 0; n < 2; ++n) acc[a][b][m][n] = (f32x4){0.f, 0.f, 0.f, 0.f};
    bf16x8 At[4][2], B0[2][2], B1[2][2];
    f32x16 accw[2][2][2];
#define PG8_ZERO_W() do { if constexpr (F8) { _Pragma("unroll") for (int _a = 0; _a < 2; ++_a) _Pragma("unroll") for (int _b = 0; _b < 2; ++_b) _Pragma("unroll") for (int _m = 0; _m < 2; ++_m) _Pragma("unroll") for (int _e = 0; _e < 16; ++_e) accw[_a][_b][_m][_e] = 0.f; } } while (0)
    PG8_ZERO_W();
#pragma unroll
    for (int h = 0; h < 2; ++h) { uC[h] = GA ? 0u : S.unit_off(cur, h); uN[h] = uC[h];
#pragma unroll
        for (int i = 0; i < 2; ++i) { aoC[h][i] = GA ? (S.aoff(cur, h * HALF + RA[i]) + CA2[i]) : 0u; aoN[h][i] = aoC[h][i]; } }
    const char* cB = S.bptr(cur);
    PG8_STAGE_B(PG8_SB(0, 0), cB); PG8_STAGE_B1(PG8_SB(0, 1), cB); PG8_STAGE_A(PG8_SA(0, 0), 0u, uC[0], aoC[0]); PG8_STAGE_A(PG8_SA(0, 1), 0u, uC[1], aoC[1]);
    if (wr == 1) PG8_BAR;
    PG8_WAIT_V(2); PG8_BAR;
    PG8_STAGE_B(PG8_SB(1, 0), cB + kstepB); PG8_STAGE_A(PG8_SA(1, 0), kstepA, uC[0], aoC[0]); PG8_STAGE_B1(PG8_SB(1, 1), cB + kstepB);
    PG8_WAIT_V(6); PG8_BAR;
    for (;;) {
        const bool has_next = S.next(ui + 1, nxt);
        const char* nB = has_next ? S.bptr(nxt) : cB;
#pragma unroll
        for (int h = 0; h < 2; ++h) { uN[h] = (GA || !has_next) ? uC[h] : S.unit_off(nxt, h);
#pragma unroll
            for (int i = 0; i < 2; ++i) aoN[h][i] = (GA && has_next) ? (S.aoff(nxt, h * HALF + RA[i]) + CA2[i]) : aoC[h][i]; }
#pragma nounroll
        for (int t = 0; t < nt; t += 2) {
            const bool last = (t == nt - 2);
            const unsigned kb1 = (unsigned)(t + 1) * kstepA, kb2 = last ? 0u : (unsigned)(t + 2) * kstepA, kb3 = kb2 + kstepA;
            const char* b2 = last ? nB : cB + (size_t)(t + 2) * kstepB; const char* b3 = b2 + kstepB;
            unsigned u2[2], a2o[2][2];
#pragma unroll
            for (int h = 0; h < 2; ++h) { u2[h] = last ? uN[h] : uC[h];
#pragma unroll
                for (int i = 0; i < 2; ++i) a2o[h][i] = GA ? (last ? aoN[h][i] : aoC[h][i]) : 0u; }
            PG8_KPAIR(kb1, kb2, kb3, b2, b3);
        }
        if constexpr (ALIGN_EPI) { if (wr == 0) PG8_BAR; }
        if constexpr (F8) {
#pragma unroll
            for (int _a = 0; _a < 2; ++_a)
#pragma unroll
                for (int _b = 0; _b < 2; ++_b)
#pragma unroll
                    for (int _m = 0; _m < 4; ++_m)
#pragma unroll
                        for (int _n = 0; _n < 2; ++_n) { const f32x16& _w = accw[_a][_b][_m >> 1]; const int _q = ((_m & 1) * 2 + _n) * 4; acc[_a][_b][_m][_n] = (f32x4){_w[_q], _w[_q + 1], _w[_q + 2], _w[_q + 3]}; }
        }
        E(acc, cur, wr, wc, fr, fq);
        PG8_ZERO_W();
        if (!has_next) break;
#pragma unroll
        for (int a = 0; a < 2; ++a)
#pragma unroll
            for (int b = 0; b < 2; ++b)
#pragma unroll
                for (int m = 0; m < 4; ++m)
#pragma unroll
                    for (int n = 0; n < 2; ++n) acc[a][b][m][n] = (f32x4){0.f, 0.f, 0.f, 0.f};
        cur = nxt; cB = nB; ++ui;
#pragma unroll
        for (int h = 0; h < 2; ++h) { uC[h] = uN[h];
#pragma unroll
            for (int i = 0; i < 2; ++i) aoC[h][i] = aoN[h][i]; }
        if constexpr (ALIGN_EPI) { if (wr == 1) PG8_BAR; }
    }
    PG8_WAIT_V(0);
    if constexpr (!ALIGN_EPI) { if (wr == 0) PG8_BAR; }
    PG8_BAR;
#undef PG8_SA
#undef PG8_ZERO_W
#undef PG8_GLDS
#undef PG8_SB
#undef PG8_STAGE_A
#undef PG8_STAGE_B
#undef PG8_STAGE_B1
#undef PG8_LDA
#undef PG8_LDB
#undef PG8_MMA
#undef PG8_WAIT_V
#undef PG8_WAIT_L
#undef PG8_BAR
#undef PG8_SCHED
#undef PG8_KPAIR
}

struct DenseSched {
    const char* A; const char* Bt; unsigned lda2; size_t btile; int nM, nN, nwg, G, c;
    __device__ __forceinline__ void init(const bf16_t* A_, int lda, const bf16_t* Bt_, int K, int Mrows, int N) {
        A = (const char*)A_; Bt = (const char*)Bt_; lda2 = (unsigned)lda * 2u; btile = (size_t)256 * K * 2; nM = Mrows / BM; nN = N / BM; nwg = nM * nN; G = gridDim.x; c = blockIdx.x; }
    __device__ __forceinline__ bool next(int i, Unit& u) const {
        const long L = (long)i * G + c; if (L >= nwg) return false;
        int wgid = (int)L; { const int q = nwg / 8, r = nwg % 8, xcd = wgid % 8, off = wgid / 8; wgid = (xcd < r ? xcd * (q + 1) : r * (q + 1) + (xcd - r) * q) + off; }
        const int nig = 8 * nN, gid = wgid / nig, fm = gid * 8, gsz = (nM - fm) < 8 ? (nM - fm) : 8;
        u.pm = fm + ((wgid % nig) % gsz); u.pn = (wgid % nig) / gsz; u.ord = i; return true;
    }
    static constexpr bool GATHER = false;
    __device__ __forceinline__ unsigned lane_off(int r) const { return (unsigned)r * lda2; }
    __device__ __forceinline__ unsigned unit_off(const Unit& u, int h) const { return (unsigned)(u.pm * BM + h * HALF) * lda2; }
    __device__ __forceinline__ unsigned aoff(const Unit&, int) const { return 0u; }
    __device__ __forceinline__ const char* abase() const { return A; }
    __device__ __forceinline__ const char* bptr(const Unit& u) const { return Bt + (size_t)u.pn * btile; }
};
}
typedef float f32x2_t __attribute__((ext_vector_type(2))); typedef __bf16 bf16x2_t __attribute__((ext_vector_type(2)));
__device__ __forceinline__ unsigned cvt_pk_bf16(float lo, float hi) { const f32x2_t v = {lo, hi}; const bf16x2_t b = __builtin_convertvector(v, bf16x2_t); return __builtin_bit_cast(unsigned, b); }
__device__ __forceinline__ u32x4 pack8(const f32x4 v0, const f32x4 v1) { u32x4 w; w.x = cvt_pk_bf16(v0[0], v0[1]); w.y = cvt_pk_bf16(v0[2], v0[3]); w.z = cvt_pk_bf16(v1[0], v1[1]); w.w = cvt_pk_bf16(v1[2], v1[3]); return w; }
__device__ __forceinline__ unsigned cvtpk_m(float lo, float hi) { const f32x2_t v = {lo, hi}; const bf16x2_t b = __builtin_convertvector(v, bf16x2_t); return __builtin_bit_cast(unsigned, b); }
__device__ __forceinline__ u32x4 pack8m(const f32x4 v0, const f32x4 v1) { u32x4 w; w.x = cvtpk_m(v0[0], v0[1]); w.y = cvtpk_m(v0[2], v0[3]); w.z = cvtpk_m(v1[0], v1[1]); w.w = cvtpk_m(v1[2], v1[3]); return w; }
#define MFMA_SETTLE(S) asm volatile("s_nop 15\n\ts_nop 7" : "+v"(S[0][0]), "+v"(S[0][1]), "+v"(S[0][2]), "+v"(S[0][3]), "+v"(S[1][0]), "+v"(S[1][1]), "+v"(S[1][2]), "+v"(S[1][3]))
__device__ __forceinline__ f32x4 sig4(const f32x4 v) { f32x4 r; r[0] = sigmoidf_(v[0]); r[1] = sigmoidf_(v[1]); r[2] = sigmoidf_(v[2]); r[3] = sigmoidf_(v[3]); return r; }

#define EPI_ROWLOOP for (int ai = 0; ai < 2; ++ai) _Pragma("unroll") for (int m = 0; m < 4; ++m)
struct EpiInproj0 {
    static constexpr bool PERM = true, PERM16 = false; bf16_t* H0;
    __device__ __forceinline__ void operator()(const f32x4 (&acc)[2][2][4][2], const pg8::Unit& u, int wr, int wc, int fr, int fq) const {
        const int row0 = u.pm * 256 + wr * 64 + fr, cl = wc * 32 + 8 * fq;
#pragma unroll
        EPI_ROWLOOP { bf16_t* rp = H0 + (size_t)(row0 + ai * 128 + m * 16) * 1024;
            if (u.pn < 2) {
#pragma unroll
                for (int bj = 0; bj < 2; ++bj) *(u32x4*)(rp + u.pn * 256 + bj * 128 + cl) = pack8(acc[ai][bj][m][0], acc[ai][bj][m][1]);
            } else {
                const f32x4 v0 = acc[ai][0][m][0] * sig4(acc[ai][1][m][0]), v1 = acc[ai][0][m][1] * sig4(acc[ai][1][m][1]);
                *(u32x4*)(rp + 512 + (u.pn - 2) * 128 + cl) = pack8(v0, v1);
            } }
    }
};
struct EpiRes {
    static constexpr bool PERM = true, PERM16 = false; const float* resf; const bf16_t* resb; bf16_t* Y;
    __device__ __forceinline__ void operator()(const f32x4 (&acc)[2][2][4][2], const pg8::Unit& u, int wr, int wc, int fr, int fq) const {
        const int row0 = u.pm * 256 + wr * 64 + fr, c0 = u.pn * 256 + wc * 32 + 8 * fq;
#pragma unroll
        EPI_ROWLOOP { const size_t ro = (size_t)(row0 + ai * 128 + m * 16) * 1024 + c0;
#pragma unroll
            for (int bj = 0; bj < 2; ++bj) {
                f32x4 r0, r1;
                if (resf) { r0 = *(const f32x4*)(resf + ro + bj * 128); r1 = *(const f32x4*)(resf + ro + bj * 128 + 4); }
                else { const u32x4 xv = *(const u32x4*)(resb + ro + bj * 128);
                    r0[0] = __uint_as_float(xv.x << 16); r0[1] = __uint_as_float(xv.x & 0xffff0000u); r0[2] = __uint_as_float(xv.y << 16); r0[3] = __uint_as_float(xv.y & 0xffff0000u);
                    r1[0] = __uint_as_float(xv.z << 16); r1[1] = __uint_as_float(xv.z & 0xffff0000u); r1[2] = __uint_as_float(xv.w << 16); r1[3] = __uint_as_float(xv.w & 0xffff0000u); }
                *(u32x4*)(Y + ro + bj * 128) = pack8(acc[ai][bj][m][0] + r0 * ALPHA, acc[ai][bj][m][1] + r1 * ALPHA);
            } }
    }
};
struct EpiLogits {
    static constexpr bool PERM = true, PERM16 = false; float* LOG;
    __device__ __forceinline__ void operator()(const f32x4 (&acc)[2][2][4][2], const pg8::Unit& u, int wr, int wc, int fr, int fq) const {
        const int row0 = u.pm * 256 + wr * 64 + fr, cl = wc * 32 + 8 * fq;
#pragma unroll
        EPI_ROWLOOP { float* rp = LOG + (size_t)(row0 + ai * 128 + m * 16) * 256 + cl;
#pragma unroll
            for (int bj = 0; bj < 2; ++bj) { *(f32x4*)(rp + bj * 128) = acc[ai][bj][m][0]; *(f32x4*)(rp + bj * 128 + 4) = acc[ai][bj][m][1]; } }
    }
};

constexpr int MOE_TAB_OFF = 131072;
__device__ __forceinline__ int moe_setup256(const unsigned* cnt, LAS unsigned char* lds) {
    LAS int* tstart = (LAS int*)(lds + MOE_TAB_OFF);
    LAS int* scnt = (LAS int*)(lds + MOE_TAB_OFF + 1088);
    LAS unsigned short* texp = (LAS unsigned short*)(lds + MOE_TAB_OFF + 2176);
    const int tid = threadIdx.x;
    __syncthreads();
    if (tid < 256) scnt[tid] = (int)cnt[tid];
    __syncthreads();
    if (tid == 0) { int s = 0; for (int e = 0; e < 256; ++e) { tstart[e] = s; s += (scnt[e] + 255) >> 8; } tstart[256] = s; }
    __syncthreads();
    if (tid < 256) for (int q = tstart[tid]; q < tstart[tid + 1]; ++q) texp[q] = (unsigned short)tid;
    __syncthreads();
    return __builtin_amdgcn_readfirstlane(tstart[256]);
}
constexpr int MOE_TOK_OFF = MOE_TAB_OFF + 5120;
constexpr int MOE_MAX_ORD = 20;
struct MoeGuSched {
    static constexpr bool GATHER = true;
    const char* X; const char* W; const int2* list; LAS unsigned char* lds; int R, nunits, G, c;
    __device__ __forceinline__ int vcu() const { return (G % 8 == 0) ? (c % 8) * (G / 8) + c / 8 : c; }
    __device__ __forceinline__ bool next(int i, pg8::Unit& u) const {
        const int L = i * G + vcu(); if (L >= nunits || i >= MOE_MAX_ORD) return false;
        const int q = L >> 1; const int e = __builtin_amdgcn_readfirstlane((q < R) ? (int)((LAS unsigned short*)(lds + MOE_TAB_OFF + 2176))[q] : 256);
        u.pm = q; u.pn = e * 2 + (L & 1); u.ord = i; return true; }
    __device__ __forceinline__ void prepare() const {
        const int tid = threadIdx.x, r = tid & 255;
        pg8::Unit u;
        for (int i = tid >> 8; next(i, u); i += 2) {
            const int e = u.pn >> 1; int token;
            if (e < 256) { const int ts = ((LAS int*)(lds + MOE_TAB_OFF))[e], cn = ((LAS int*)(lds + MOE_TAB_OFF + 1088))[e]; int lr = (u.pm - ts) * 256 + r; if (lr >= cn) lr = cn - 1;
                token = list[(size_t)e * LISTCAP + lr].x / 10; }
            else token = (u.pm - R) * 256 + r;
            ((LAS unsigned short*)(lds + MOE_TOK_OFF))[i * 256 + r] = (unsigned short)token;
        }
        __syncthreads();
    }
    __device__ __forceinline__ unsigned aoff(const pg8::Unit& u, int r) const { return (unsigned)((LAS unsigned short*)(lds + MOE_TOK_OFF))[u.ord * 256 + r] * 1024u; }
    __device__ __forceinline__ unsigned lane_off(int) const { return 0u; }
    __device__ __forceinline__ unsigned unit_off(const pg8::Unit&, int) const { return 0u; }
    __device__ __forceinline__ const char* abase() const { return X; }
    __device__ __forceinline__ const char* bptr(const pg8::Unit& u) const { return W + (size_t)u.pn * (256 * 1024); }
};
constexpr float GU_SC = 1.0f / (X8_SCALE * W8_SCALE);
struct EpiGateUp {
    static constexpr bool PERM = true, PERM16 = false; unsigned char* HID;
    __device__ __forceinline__ void operator()(const f32x4 (&acc)[2][2][4][2], const pg8::Unit& u, int wr, int wc, int fr, int fq) const {
        const int row0 = u.pm * 256 + wr * 64 + fr, c0 = (u.pn & 1) * 128 + wc * 32 + 8 * fq;
#pragma unroll
        EPI_ROWLOOP { const f32x4 g0 = acc[ai][0][m][0] * GU_SC, g1 = acc[ai][0][m][1] * GU_SC;
            f32x4 h0 = g0 * sig4(g0) * (acc[ai][1][m][0] * (GU_SC * H8_SCALE)), h1 = g1 * sig4(g1) * (acc[ai][1][m][1] * (GU_SC * H8_SCALE));
#pragma unroll
            for (int i = 0; i < 4; ++i) { h0[i] = clamp8(h0[i]); h1[i] = clamp8(h1[i]); }
            *(u32x2*)(HID + (size_t)(row0 + ai * 128 + m * 16) * 256 + c0) = pack8_fp8(h0, h1); }
    }
};
constexpr int MOE_RI_OFF = MOE_TAB_OFF + 5120;
constexpr int MOE_MAX_RT = 6;
struct MoeDownSched {
    const char* HID; const char* W; const int2* list; LAS unsigned char* lds; int R, ntile, G, c;
    __device__ __forceinline__ int vcu() const { return (G % 8 == 0) ? (c % 8) * (G / 8) + c / 8 : c; }
    __device__ __forceinline__ bool next(int i, pg8::Unit& u) const {
        const int q = vcu() + G * (i >> 2); if (q >= ntile || (i >> 2) >= MOE_MAX_RT) return false;
        const int e = (q < R) ? (int)((LAS unsigned short*)(lds + MOE_TAB_OFF + 2176))[q] : 256;
        u.pm = q; u.pn = e * 4 + (i & 3); u.ord = i >> 2; return true; }
    __device__ __forceinline__ void prepare() const {
        const int tid = threadIdx.x, r = tid & 255;
        for (int o = tid >> 8; o < MOE_MAX_RT; o += 2) {
            const int q = vcu() + G * o; if (q >= ntile) break;
            u32x2 en;
            if (q < R) { const int e = ((LAS unsigned short*)(lds + MOE_TAB_OFF + 2176))[q]; const int ts = ((LAS int*)(lds + MOE_TAB_OFF))[e], cn = ((LAS int*)(lds + MOE_TAB_OFF + 1088))[e];
                const int lr = (q - ts) * 256 + r; if (lr < cn) { const int2 le = list[(size_t)e * LISTCAP + lr]; en.x = (unsigned)le.x; en.y = (unsigned)le.y; } else { en.x = 0xffffffffu; en.y = 0u; } }
            else { en.x = (unsigned)(((q - R) * 256 + r) * 10 + 8); en.y = __float_as_uint(1.0f); }
            ((LAS u32x2*)(lds + MOE_RI_OFF))[o * 256 + r] = en;
        }
        __syncthreads();
    }
    static constexpr bool GATHER = false;
    __device__ __forceinline__ unsigned lane_off(int r) const { return (unsigned)r * 256u; }
    __device__ __forceinline__ unsigned unit_off(const pg8::Unit& u, int h) const { return (unsigned)(u.pm * 256 + h * 128) * 256u; }
    __device__ __forceinline__ unsigned aoff(const pg8::Unit&, int) const { return 0u; }
    __device__ __forceinline__ const char* abase() const { return HID; }
    __device__ __forceinline__ const char* bptr(const pg8::Unit& u) const { return W + (size_t)u.pn * (256 * 256); }
};
struct EpiDown {
    static constexpr bool PERM = true, PERM16 = true;
    unsigned char* YB; LAS unsigned char* lds;
    __device__ __forceinline__ void operator()(const f32x4 (&acc)[2][2][4][2], const pg8::Unit& u, int wr, int wc, int fr, int fq) const {
        asm volatile("" : "+v"(fr), "+v"(fq));
        const unsigned c0b = (unsigned)((u.pn & 3) * 256 + wc * 64 + 16 * fq); const bool shared = (u.pn >> 2) == 256;
        const LAS u32x2* ri = (const LAS u32x2*)(lds + MOE_RI_OFF) + u.ord * 256 + wr * 64 + fr;
#pragma unroll
        for (int ai = 0; ai < 2; ++ai)
#pragma unroll
            for (int m = 0; m < 4; ++m) { const u32x2 en = ri[ai * 128 + m * 16]; const float wv = __uint_as_float(en.y) * (YB_SCALE / (H8_SCALE * W8_SCALE));
                if ((int)en.x >= 0) { unsigned char* rp = YB + (size_t)(en.x * 1024u + c0b);
                    const f32x4 v00 = acc[ai][0][m][0] * wv, v01 = acc[ai][0][m][1] * wv, v10 = acc[ai][1][m][0] * wv, v11 = acc[ai][1][m][1] * wv;
                    const u32x2 h0 = pack8_fp8(v00, v01), h1 = pack8_fp8(v10, v11);
                    *(u32x4*)rp = (u32x4){h0.x, h0.y, h1.x, h1.y};
                    if (YB_NSLOT == 10 && shared) {
                        u32x2 r_[2];
#pragma unroll
                        for (int bj = 0; bj < 2; ++bj) { const u32x2 h = bj ? h1 : h0; const f32x4 v0 = bj ? v10 : v00, v1 = bj ? v11 : v01;
                            const auto a0 = __builtin_amdgcn_cvt_pk_f32_fp8((int)h.x, false), a1 = __builtin_amdgcn_cvt_pk_f32_fp8((int)h.x, true), a2 = __builtin_amdgcn_cvt_pk_f32_fp8((int)h.y, false), a3 = __builtin_amdgcn_cvt_pk_f32_fp8((int)h.y, true);
                            const f32x4 r0 = {v0[0] - a0[0], v0[1] - a0[1], v0[2] - a1[0], v0[3] - a1[1]}, r1 = {v1[0] - a2[0], v1[1] - a2[1], v1[2] - a3[0], v1[3] - a3[1]};
                            r_[bj] = pack8_fp8(r0, r1); }
                        *(u32x4*)(rp + 1024) = (u32x4){r_[0].x, r_[0].y, r_[1].x, r_[1].y}; } } }
    }
};

struct EpiInprojN {
    static constexpr bool PERM = true, PERM16 = false; bf16_t* QN; bf16_t* QR; bf16_t* KV6; float* GATES; const float* ROT;
    __device__ __forceinline__ void operator()(const f32x4 (&acc)[2][2][4][2], const pg8::Unit& u, int wr, int wc, int fr, int fq) const {
        const int row0 = u.pm * 256 + wr * 64 + fr, cl = wc * 32 + 8 * fq, pn = u.pn;
        const bool isq = pn < 4, rotk = (pn == 6 || pn == 8), dorot = (isq || rotk) && ((wc & 1) == 0);
#pragma unroll
        EPI_ROWLOOP { const int row = row0 + ai * 128 + m * 16;
            if (pn == 10) {
                if (cl < 48) { *(f32x4*)(GATES + (size_t)row * 48 + cl) = sig4(acc[ai][0][m][0]); *(f32x4*)(GATES + (size_t)row * 48 + cl + 4) = sig4(acc[ai][0][m][1]); }
            } else {
                f32x4 cs0, cs1, sn0, sn1;
                if (dorot) { const float* rt = ROT + (size_t)(row & (T - 1)) * 16; cs0 = *(const f32x4*)rt; cs1 = *(const f32x4*)(rt + 4); sn0 = *(const f32x4*)(rt + 8); sn1 = *(const f32x4*)(rt + 12); }
#pragma unroll
                for (int bj = 0; bj < 2; ++bj) {
                    const f32x4 v0 = acc[ai][bj][m][0], v1 = acc[ai][bj][m][1];
                    f32x4 r0 = v0, r1 = v1;
                    if (dorot) {
                        f32x4 p0, p1;
#pragma unroll
                        for (int i = 0; i < 4; ++i) { p0[i] = __shfl_xor(v0[i], 16); p1[i] = __shfl_xor(v1[i], 16); }
                        if (fq == 0) { r0 = v0 * cs0 - p0 * sn0; r1 = v1 * cs1 - p1 * sn1; }
                        else if (fq == 1) { r0 = v0 * cs0 + p0 * sn0; r1 = v1 * cs1 + p1 * sn1; }
                    }
                    if (isq) { const int c = pn * 256 + bj * 128 + cl;
                        *(u32x4*)(QN + (size_t)row * 1024 + c) = pack8(v0 * QSCALE, v1 * QSCALE); *(u32x4*)(QR + (size_t)row * 1024 + c) = pack8(r0 * QSCALE, r1 * QSCALE); }
                    else { const int cc = bj * 128 + cl, g = cc >> 6, d = cc & 63, b = row >> 13, t = row & (T - 1);
                        *(u32x4*)(KV6 + ((size_t)((pn - 4) * 16 + b * 4 + g) * T + t) * 64 + d) = pack8(r0, r1); }
                }
            } }
    }
};

struct Cmp1Sched {
    const char* KV6; const char* W; int G, c;
    static constexpr bool GATHER = false;
    __device__ __forceinline__ bool next(int i, pg8::Unit& u) const { const int L = i * G + c; if (L >= 64) return false; u.pm = L >> 1; u.pn = L & 1; u.ord = i; return true; }
    __device__ __forceinline__ unsigned lane_off(int r) const { return (unsigned)r * 2048u; }
    __device__ __forceinline__ unsigned unit_off(const pg8::Unit& u, int h) const { return (unsigned)u.pn * (unsigned)(16 * T * 64 * 2) + (unsigned)(u.pm * 256 + h * 128) * 2048u; }
    __device__ __forceinline__ unsigned aoff(const pg8::Unit&, int) const { return 0u; }
    __device__ __forceinline__ const char* abase() const { return KV6; }
    __device__ __forceinline__ const char* bptr(const pg8::Unit& u) const { return W + (size_t)u.pn * (256 * 2048 * 2); }
};
struct EpiCmp1 {
    static constexpr bool PERM = true, PERM16 = false; bf16_t* CH1; const float* bias1;
    __device__ __forceinline__ void operator()(const f32x4 (&acc)[2][2][4][2], const pg8::Unit& u, int wr, int wc, int fr, int fq) const {
        const int row0 = u.pm * 256 + wr * 64 + fr, cl = wc * 32 + 8 * fq;
        const f32x4 b0 = *(const f32x4*)(bias1 + u.pn * 128 + cl), b1 = *(const f32x4*)(bias1 + u.pn * 128 + cl + 4);
#pragma unroll
        EPI_ROWLOOP { f32x4 v0 = acc[ai][0][m][0] + b0, v1 = acc[ai][0][m][1] + b1;
#pragma unroll
            for (int i = 0; i < 4; ++i) { v0[i] = gelu_tanh(v0[i]); v1[i] = gelu_tanh(v1[i]); }
            *(u32x4*)(CH1 + ((size_t)u.pn * 8192 + row0 + ai * 128 + m * 16) * 128 + cl) = pack8(v0, v1); }
    }
};

__device__ __forceinline__ void p0_item(const float* W, int K, int N, bf16_t* WT, int kb, int n0, int drow0, LAS float* scr, int lane, bool f8 = false) {
    const int k0 = 64 * kb, n4 = (lane & 15) * 4;
    const bool cok = (n0 + n4) < N;
    f32x4 v[16];
#pragma unroll
    for (int i = 0; i < 16; ++i) { const int kk = 4 * i + (lane >> 4); v[i] = cok ? __builtin_nontemporal_load((const f32x4*)(W + (size_t)(k0 + kk) * N + n0 + n4)) : (f32x4){0.f, 0.f, 0.f, 0.f}; }
#pragma unroll
    for (int i = 0; i < 16; ++i) { const int kk = 4 * i + (lane >> 4); LAS float* d = scr + kk * 65 + n4; d[0] = v[i][0]; d[1] = v[i][1]; d[2] = v[i][2]; d[3] = v[i][3]; }
    asm volatile("s_waitcnt lgkmcnt(0)" ::: "memory");
    if (f8) {
        const int c4 = lane & 3;
#pragma unroll
        for (int j = 0; j < 4; ++j) { const int n = (lane >> 2) + 16 * j; const LAS float* sp = scr + (16 * c4) * 65 + n;
            u32x4 o;
            o.x = pk4_fp8(sp[0 * 65] * W8_SCALE, sp[1 * 65] * W8_SCALE, sp[2 * 65] * W8_SCALE, sp[3 * 65] * W8_SCALE); o.y = pk4_fp8(sp[4 * 65] * W8_SCALE, sp[5 * 65] * W8_SCALE, sp[6 * 65] * W8_SCALE, sp[7 * 65] * W8_SCALE);
            o.z = pk4_fp8(sp[8 * 65] * W8_SCALE, sp[9 * 65] * W8_SCALE, sp[10 * 65] * W8_SCALE, sp[11 * 65] * W8_SCALE); o.w = pk4_fp8(sp[12 * 65] * W8_SCALE, sp[13 * 65] * W8_SCALE, sp[14 * 65] * W8_SCALE, sp[15 * 65] * W8_SCALE);
            if (n0 + n < N) __builtin_nontemporal_store(o, (u32x4*)((unsigned char*)WT + (size_t)(drow0 + n) * K + k0 + 16 * c4)); }
        asm volatile("s_waitcnt lgkmcnt(0)" ::: "memory");
        return;
    }
    const int c = lane & 7;
#pragma unroll
    for (int j = 0; j < 8; ++j) { const int n = (lane >> 3) + 8 * j; const LAS float* sp = scr + (8 * c) * 65 + n;
        u32x4 o; o.x = pk2(sp[0 * 65], sp[1 * 65]); o.y = pk2(sp[2 * 65], sp[3 * 65]); o.z = pk2(sp[4 * 65], sp[5 * 65]); o.w = pk2(sp[6 * 65], sp[7 * 65]);
        if (n0 + n < N) __builtin_nontemporal_store(o, (u32x4*)(WT + (size_t)(drow0 + n) * K + k0 + 8 * c)); }
    asm volatile("s_waitcnt lgkmcnt(0)" ::: "memory");
}
struct CvtItem { const float* W; bf16_t* WT; int K, N, k0, n0, drow0; };
__device__ __forceinline__ void cvt32_load(const CvtItem& it, int lane, f32x4 (&v)[8]) {
    const int n4 = (lane & 7) * 4;
#pragma unroll
    for (int i = 0; i < 8; ++i) { const int kk = 8 * i + (lane >> 3); v[i] = __builtin_nontemporal_load((const f32x4*)(it.W + (size_t)(it.k0 + kk) * it.N + it.n0 + n4)); }
}
__device__ __forceinline__ void cvt32_finish(const CvtItem& it, int lane, const f32x4 (&v)[8], LAS float* scr) {
    const int n4 = (lane & 7) * 4;
#pragma unroll
    for (int i = 0; i < 8; ++i) { const int kk = 8 * i + (lane >> 3); LAS float* d = scr + kk * 33 + n4; d[0] = v[i][0]; d[1] = v[i][1]; d[2] = v[i][2]; d[3] = v[i][3]; }
    asm volatile("s_waitcnt lgkmcnt(0)" ::: "memory");
    const int c = lane & 7;
#pragma unroll
    for (int j = 0; j < 4; ++j) { const int n = (lane >> 3) + 8 * j; const LAS float* sp = scr + (8 * c) * 33 + n;
        const float v0 = sp[0 * 33], v1 = sp[1 * 33], v2 = sp[2 * 33], v3 = sp[3 * 33], v4 = sp[4 * 33], v5 = sp[5 * 33], v6 = sp[6 * 33], v7 = sp[7 * 33];
        u32x2 o; o.x = pk4_fp8(v0 * W8_SCALE, v1 * W8_SCALE, v2 * W8_SCALE, v3 * W8_SCALE); o.y = pk4_fp8(v4 * W8_SCALE, v5 * W8_SCALE, v6 * W8_SCALE, v7 * W8_SCALE);
        __builtin_nontemporal_store(o, (u32x2*)((unsigned char*)it.WT + (size_t)(it.drow0 + n) * it.K + it.k0 + 8 * c)); }
    asm volatile("s_waitcnt lgkmcnt(0)" ::: "memory");
}
constexpr int CVT1_ITEMS = 257 * 384;
__device__ __forceinline__ CvtItem cvt1_item(const Args& a, int idx) {
    const int e = idx / 384, sub = idx % 384, mat = sub >> 7, r = sub & 127;
    CvtItem it;
    if (mat < 2) { it.W = (e < 256) ? a.in[23 + mat] + ((size_t)256 + e) * (size_t)(D * FF) : a.in[26 + mat] + (size_t)(D * FF);
        it.K = D; it.N = FF; it.k0 = (r >> 3) * 64; it.n0 = (r & 7) * 32; it.drow0 = (it.n0 >> 7) * 256 + mat * 128 + (it.n0 & 127);
        it.WT = (bf16_t*)(a.ws + WS_WGU + (size_t)(257 + e) * 512 * 1024); }
    else { it.W = (e < 256) ? a.in[25] + ((size_t)256 + e) * (size_t)(FF * D) : a.in[28] + (size_t)(FF * D);
        it.K = FF; it.N = D; it.k0 = (r >> 5) * 64; it.n0 = (r & 31) * 32; it.drow0 = it.n0;
        it.WT = (bf16_t*)(a.ws + WS_WD + (size_t)(257 + e) * 1024 * 256); }
    return it;
}
__device__ __forceinline__ void cvt1_run(const Args& a, int& next, int stride, int quota, LAS float* scr, int lane) {
#pragma unroll 1
    for (int q = 0; q < quota && next < CVT1_ITEMS; ++q) {
        CvtItem t[4]; f32x4 v[4][8]; bool ok[4];
#pragma unroll
        for (int u = 0; u < 4; ++u) { const int idx = next + u * stride; ok[u] = idx < CVT1_ITEMS; t[u] = cvt1_item(a, ok[u] ? idx : 0); if (ok[u]) cvt32_load(t[u], lane, v[u]); }
        next += 4 * stride;
#pragma unroll
        for (int u = 0; u < 4; ++u) if (ok[u]) cvt32_finish(t[u], lane, v[u], scr);
    }
}
__device__ __forceinline__ void ph_prologue(const Args& a, LAS unsigned char* lds) {
    const int lane = threadIdx.x & 63, wave = threadIdx.x >> 6;
    LAS float* scr = (LAS float*)(lds + wave * 16640);
    const int gw = blockIdx.x * 8 + wave, ngw = gridDim.x * 8;
    for (int it = gw; it < 257 * 192; it += ngw) {
        const int le = it / 192, sub = it % 192, l = 0, e = le, mat = sub >> 6, r = sub & 63;
        if (mat < 2) {
            const float* W = (e < 256) ? a.in[23 + mat] + ((size_t)l * 256 + e) * (size_t)(D * FF) : a.in[26 + mat] + (size_t)l * (D * FF);
            const int kb = r >> 2, n0 = (r & 3) * 64;
            p0_item(W, D, FF, (bf16_t*)(a.ws + WS_WGU + (size_t)le * 512 * 1024), kb, n0, (n0 >> 7) * 256 + mat * 128 + (n0 & 127), scr, lane, true);
        } else {
            const float* W = (e < 256) ? a.in[25] + ((size_t)l * 256 + e) * (size_t)(FF * D) : a.in[28] + (size_t)l * (FF * D);
            const int kb = r >> 4, n0 = (r & 15) * 64;
            p0_item(W, FF, D, (bf16_t*)(a.ws + WS_WD + (size_t)le * 1024 * 256), kb, n0, n0, scr, lane, true);
        }
    }
    {
        for (int it = gw; it < 512; it += ngw) { const int w = it >> 8, r = it & 255;
            p0_item(a.in[w ? 16 : 8], D, D, (bf16_t*)(a.ws + (w ? WS_WOUTN : WS_WOUT0)), r >> 4, (r & 15) * 64, (r & 15) * 64, scr, lane); }
        for (int it = gw; it < 16 * 41; it += ngw) p0_item(a.in[9], D, 2608, (bf16_t*)(a.ws + WS_WINN), it / 41, (it % 41) * 64, (it % 41) * 64, scr, lane);
        for (int it = gw; it < 128; it += ngw) { const int l = it >> 6, r = it & 63;
            p0_item(a.in[21] + (size_t)l * D * NE, D, NE, (bf16_t*)(a.ws + WS_WR) + (size_t)l * NE * D, r >> 2, (r & 3) * 64, (r & 3) * 64, scr, lane); }
        for (int it = gw; it < 16 * 16; it += ngw) { const int kb = it >> 4, n0 = (8 + (it & 15)) * 64;
            const int isg = (n0 >= 1024) ? 1 : 0, rel = n0 - 512 - isg * 512;
            p0_item(a.in[1], D, 1536, (bf16_t*)(a.ws + WS_WIN0), kb, n0, 512 + (rel >> 7) * 256 + isg * 128 + (rel & 127), scr, lane); }
        for (int it = gw; it < 128; it += ngw) { const int kv = it >> 6, r = it & 63;
            p0_item(a.in[kv ? 14 : 11], 2048, 128, (bf16_t*)(a.ws + WS_CW1) + (size_t)kv * 256 * 2048, r >> 1, (r & 1) * 64, (r & 1) * 64, scr, lane); }
    }
    {
        const int gt = blockIdx.x * 512 + threadIdx.x, ngt = gridDim.x * 512;
        u32x4* z0 = (u32x4*)((bf16_t*)(a.ws + WS_WINN) + (size_t)2608 * 1024);
        for (int i = gt; i < 208 * 1024 / 8; i += ngt) z0[i] = (u32x4){0u, 0u, 0u, 0u};
        for (int kv = 0; kv < 2; ++kv) { u32x4* z1 = (u32x4*)((bf16_t*)(a.ws + WS_CW1) + ((size_t)kv * 256 + 128) * 2048);
            for (int i = gt; i < 128 * 2048 / 8; i += ngt) z1[i] = (u32x4){0u, 0u, 0u, 0u}; }
        const float* x = a.in[0]; bf16_t* XA = (bf16_t*)(a.ws + WS_XA);
        for (size_t i = gt; i < (size_t)M * D / 8; i += ngt) { const f32x4 v0 = *(const f32x4*)(x + i * 8), v1 = *(const f32x4*)(x + i * 8 + 4);
            u32x4 o; o.x = pk2(v0[0], v0[1]); o.y = pk2(v0[2], v0[3]); o.z = pk2(v1[0], v1[1]); o.w = pk2(v1[2], v1[3]); *(u32x4*)(XA + i * 8) = o; }
        const float* win = a.in[1]; const float* mix = a.in[2]; const float* psc = a.in[3]; bf16_t* WIN0 = (bf16_t*)(a.ws + WS_WIN0);
        for (int i = gt; i < 512 * 1024; i += ngt) { const int n = i & 511, k = i >> 9, g = n >> 7, nn = n & 127;
            const float* wr_ = win + (size_t)k * 1536 + g * 128; const float* mx = mix + (size_t)g * 128 * 128 + nn;
            float s = 0.f;
            for (int c = 0; c < 128; ++c) s += wr_[c] * mx[(size_t)c * 128];
            WIN0[(size_t)n * 1024 + k] = f2bf(s * psc[n]); }
        float* misc = (float*)(a.ws + WS_MISC);
        for (int i = gt; i < 256; i += ngt) { const int kv = i >> 7, j = i & 127; const float* pos = a.in[kv ? 13 : 10]; const float* w1 = a.in[kv ? 14 : 11];
            float s = 0.f; for (int k = 0; k < 2048; ++k) s += pos[k] * w1[(size_t)k * 128 + j]; misc[i] = s; }
        float* rot = misc + 1024;
        for (int i = gt; i < T * 8; i += ngt) { const int t = i >> 3, f = i & 7;
            const float ang = (float)t * a.inv_freq[f]; const double rev = (double)ang * 0.15915494309189535; const float fr = (float)(rev - floor(rev));
            rot[t * 16 + f] = __builtin_amdgcn_cosf(fr); rot[t * 16 + 8 + f] = __builtin_amdgcn_sinf(fr); }
    }
}

typedef short v4i16_t __attribute__((ext_vector_type(4)));
constexpr int AT_KB = 0, AT_VB = 16384, AT_PS = 32768, AT_MSK = 32768 + 65536;
#define DPP_I(x, ctrl) __builtin_amdgcn_update_dpp((int)(x), (int)(x), (ctrl), 0xF, 0xF, true)
#define DPP_F(x, ctrl) __builtin_bit_cast(float, __builtin_amdgcn_update_dpp(__builtin_bit_cast(int, (float)(x)), __builtin_bit_cast(int, (float)(x)), (ctrl), 0xF, 0xF, true))
__device__ __forceinline__ bf16x8 tr_frag(LAS unsigned char* p0, LAS unsigned char* p1) {
    const v4i16_t a = __builtin_amdgcn_ds_read_tr16_b64_v4i16((LAS v4i16_t*)p0), b = __builtin_amdgcn_ds_read_tr16_b64_v4i16((LAS v4i16_t*)p1);
    return (bf16x8){a[0], a[1], a[2], a[3], b[0], b[1], b[2], b[3]};
}
constexpr size_t TN2_OFF = 786432;
__device__ __forceinline__ void ph_knorm(const Args& a) {
    const bf16_t* KV6 = (const bf16_t*)(a.ws + WS_KV6);
    float* TN2 = (float*)(a.ws + WS_MISC + TN2_OFF);
    const int lane = threadIdx.x & 63, wave = threadIdx.x >> 6;
    const int first = (gridDim.x > 64) ? 64 : 0;
    if ((int)blockIdx.x < first) return;
    const int wi = ((int)blockIdx.x - first) * 8 + wave, nw = ((int)gridDim.x - first) * 8;
    for (int id = wi; id < 4096; id += nw) {
        const int ty = id >> 11, bg = (id >> 7) & 15, tile = id & 127;
        const bf16_t* rp = KV6 + ((size_t)((ty ? 4 : 2) * 16 + bg) * T + tile * 64 + lane) * 64;
        float ssq = 0.f;
#pragma unroll
        for (int c = 0; c < 8; ++c) { const bf16x8 v = *(const bf16x8*)(rp + 8 * c);
#pragma unroll
            for (int j = 0; j < 8; ++j) { const float f = bf2f((bf16_t)v[j]); ssq += f * f; } }
        ssq = wave_max(ssq);
        if (lane == 0) TN2[id] = ssq;
    }
}
__device__ __forceinline__ void attn_qk2(LAS unsigned char* Kb, const bf16x8 (&q)[2][2], int fr, int g4, const float (&cinit)[2], f32x4 (&s)[2][4]) {
#pragma unroll
    for (int c = 0; c < 4; ++c) {
#pragma unroll
        for (int rb = 0; rb < 2; ++rb) s[rb][c] = (f32x4){cinit[rb], cinit[rb], cinit[rb], cinit[rb]};
#pragma unroll
        for (int ks = 0; ks < 2; ++ks) {
            const bf16x8 kf = *(const LAS bf16x8*)(Kb + pg8::lds_byte(16 * c + fr, 32 * ks + 8 * g4));
#pragma unroll
            for (int rb = 0; rb < 2; ++rb) s[rb][c] = __builtin_amdgcn_mfma_f32_16x16x32_bf16(kf, q[rb][ks], s[rb][c], 0, 0, 0);
        }
    }
}
__device__ __forceinline__ void attn_qk2m(LAS unsigned char* Kb, const bf16x8 (&q)[2][2], int fr, int g4, const float (&cinit)[2], f32x4 (&s)[2][4]) {
    bf16x8 kf[4][2];
#pragma unroll
    for (int c = 0; c < 4; ++c)
#pragma unroll
        for (int ks = 0; ks < 2; ++ks) kf[c][ks] = *(const LAS bf16x8*)(Kb + pg8::lds_byte(16 * c + fr, 32 * ks + 8 * g4));
    __builtin_amdgcn_sched_barrier(0);
    f32x4 ci[2];
#pragma unroll
    for (int rb = 0; rb < 2; ++rb) ci[rb] = (f32x4){cinit[rb], cinit[rb], cinit[rb], cinit[rb]};
#pragma unroll
    for (int c = 0; c < 4; ++c) {
#pragma unroll
        for (int ks = 0; ks < 2; ++ks) {
#pragma unroll
            for (int rb = 0; rb < 2; ++rb) s[rb][c] = __builtin_amdgcn_mfma_f32_16x16x32_bf16(kf[c][ks], q[rb][ks], ks == 0 ? ci[rb] : s[rb][c], 0, 0, 0);
        }
    }
}
__device__ __forceinline__ void attn_qk2z(LAS unsigned char* Kb, const bf16x8 (&q)[2][2], int fr, int g4, f32x4 (&s)[2][4]) {
    bf16x8 kf[4][2];
#pragma unroll
    for (int c = 0; c < 4; ++c)
#pragma unroll
        for (int ks = 0; ks < 2; ++ks) kf[c][ks] = *(const LAS bf16x8*)(Kb + pg8::lds_byte(16 * c + fr, 32 * ks + 8 * g4));
    __builtin_amdgcn_sched_barrier(0);
#pragma unroll
    for (int c = 0; c < 4; ++c) {
#pragma unroll
        for (int ks = 0; ks < 2; ++ks) {
#pragma unroll
            for (int rb = 0; rb < 2; ++rb) s[rb][c] = __builtin_amdgcn_mfma_f32_16x16x32_bf16(kf[c][ks], q[rb][ks], ks == 0 ? (f32x4){0.f, 0.f, 0.f, 0.f} : s[rb][c], 0, 0, 0);
        }
    }
}
struct AttnRow { float m; f32x4 o[4]; f32x4 ol; };
__device__ __forceinline__ float max3f(float a, float b, float c) { float r; asm("v_max3_f32 %0, %1, %2, %3" : "=v"(r) : "v"(a), "v"(b), "v"(c)); return r; }
__device__ __forceinline__ bool attn_sm2(f32x4 (&s)[4], AttnRow& st, int kbase, int g4, int lo, int hi, bool en, bool emask) {
    const float NEG = -INFINITY;
    if (emask) {
#pragma unroll
        for (int c = 0; c < 4; ++c)
#pragma unroll
            for (int i = 0; i < 4; ++i) { const int key = kbase + 16 * c + 4 * g4 + i; if (key < lo || key > hi) s[c][i] = NEG; }
    }
    float mx = max3f(s[0][0], s[0][1], s[0][2]); mx = max3f(mx, s[0][3], s[1][0]); mx = max3f(mx, s[1][1], s[1][2]); mx = max3f(mx, s[1][3], s[2][0]);
    mx = max3f(mx, s[2][1], s[2][2]); mx = max3f(mx, s[2][3], s[3][0]); mx = max3f(mx, s[3][1], s[3][2]); mx = max3f(mx, s[3][3], mx);
    if (!en) mx = NEG;
    mx = max3f(mx, __shfl_xor(mx, 16), mx); mx = max3f(mx, __shfl_xor(mx, 32), mx);
    const float delta = (mx > 20.0f) ? mx : 0.f;
    const bool moved = __builtin_amdgcn_ballot_w64(delta != 0.f) != 0ull;
    if (moved) {
        const float alpha = __builtin_amdgcn_exp2f(-delta);
#pragma unroll
        for (int c = 0; c < 4; ++c) s[c] = s[c] - delta;
#pragma unroll
        for (int dt = 0; dt < 4; ++dt) st.o[dt] *= alpha;
        st.ol *= alpha;
        st.m += delta;
    }
#pragma unroll
    for (int c = 0; c < 4; ++c)
#pragma unroll
        for (int i = 0; i < 4; ++i) s[c][i] = __builtin_amdgcn_exp2f(s[c][i]);
    return moved;
}
__device__ __forceinline__ bool attn_sm2x(f32x4 (&s)[2][4], AttnRow (&st)[2], int kbase, int g4, const int (&lo)[2], const int (&hi)[2], const bool (&en)[2], bool emask) {
    const float NEG = -INFINITY;
    if (emask) {
#pragma unroll
        for (int rb = 0; rb < 2; ++rb)
#pragma unroll
            for (int c = 0; c < 4; ++c)
#pragma unroll
                for (int i = 0; i < 4; ++i) { const int key = kbase + 16 * c + 4 * g4 + i; if (key < lo[rb] || key > hi[rb]) s[rb][c][i] = NEG; }
    }
    float mx[2];
#pragma unroll
    for (int rb = 0; rb < 2; ++rb) {
        float m = max3f(s[rb][0][0], s[rb][0][1], s[rb][0][2]); m = max3f(m, s[rb][0][3], s[rb][1][0]); m = max3f(m, s[rb][1][1], s[rb][1][2]); m = max3f(m, s[rb][1][3], s[rb][2][0]);
        m = max3f(m, s[rb][2][1], s[rb][2][2]); m = max3f(m, s[rb][2][3], s[rb][3][0]); m = max3f(m, s[rb][3][1], s[rb][3][2]); m = max3f(m, s[rb][3][3], m);
        mx[rb] = en[rb] ? m : NEG;
    }
    { const float t0 = __shfl_xor(mx[0], 16), t1 = __shfl_xor(mx[1], 16); mx[0] = max3f(mx[0], t0, t0); mx[1] = max3f(mx[1], t1, t1); }
    { const float t0 = __shfl_xor(mx[0], 32), t1 = __shfl_xor(mx[1], 32); mx[0] = max3f(mx[0], t0, t0); mx[1] = max3f(mx[1], t1, t1); }
    const float d0 = (mx[0] > 20.0f) ? mx[0] : 0.f, d1 = (mx[1] > 20.0f) ? mx[1] : 0.f;
    const bool moved = __builtin_amdgcn_ballot_w64((d0 != 0.f) || (d1 != 0.f)) != 0ull;
    if (moved) {
        const float dl[2] = {d0, d1};
#pragma unroll
        for (int rb = 0; rb < 2; ++rb) {
            const float alpha = __builtin_amdgcn_exp2f(-dl[rb]);
#pragma unroll
            for (int c = 0; c < 4; ++c) s[rb][c] = s[rb][c] - dl[rb];
#pragma unroll
            for (int dt = 0; dt < 4; ++dt) st[rb].o[dt] *= alpha;
            st[rb].ol *= alpha; st[rb].m += dl[rb];
        }
    }
#pragma unroll
    for (int rb = 0; rb < 2; ++rb)
#pragma unroll
        for (int c = 0; c < 4; ++c)
#pragma unroll
            for (int i = 0; i < 4; ++i) s[rb][c][i] = __builtin_amdgcn_exp2f(s[rb][c][i]);
    return moved;
}
__device__ __forceinline__ void attn_pv2x(LAS unsigned char* Vb, const f32x4 (&p)[2][4], int vlane, int swz, const unsigned (&enm)[2], const bool (&act)[2], const bf16x8 onesf, AttnRow (&st)[2]) {
#pragma unroll
    for (int ks = 0; ks < 2; ++ks) {
        bf16x8 pb[2];
#pragma unroll
        for (int rb = 0; rb < 2; ++rb) { u32x4 pw = pack8m(p[rb][2 * ks], p[rb][2 * ks + 1]); pw.x &= enm[rb]; pw.y &= enm[rb]; pw.z &= enm[rb]; pw.w &= enm[rb]; pb[rb] = __builtin_bit_cast(bf16x8, pw); }
#pragma unroll
        for (int dt = 0; dt < 4; ++dt) {
            LAS unsigned char* a0 = Vb + vlane + (2 * ks) * 2048 + ((dt ^ swz) * 32);
            const bf16x8 vf = tr_frag(a0, a0 + 2048);
#pragma unroll
            for (int rb = 0; rb < 2; ++rb) if (act[rb]) st[rb].o[dt] = __builtin_amdgcn_mfma_f32_16x16x32_bf16(vf, pb[rb], st[rb].o[dt], 0, 0, 0);
        }
#pragma unroll
        for (int rb = 0; rb < 2; ++rb) if (act[rb]) st[rb].ol = __builtin_amdgcn_mfma_f32_16x16x32_bf16(onesf, pb[rb], st[rb].ol, 0, 0, 0);
    }
}
__device__ __forceinline__ bool attn_max2x(f32x4 (&s)[2][4], int kbase, int g4, const int (&lo)[2], const int (&hi)[2], const bool (&en)[2], bool emask, float (&d)[2]) {
    const float NEG = -INFINITY;
    MFMA_SETTLE(s);
    if (emask) {
#pragma unroll
        for (int rb = 0; rb < 2; ++rb)
#pragma unroll
            for (int c = 0; c < 4; ++c)
#pragma unroll
                for (int i = 0; i < 4; ++i) { const int key = kbase + 16 * c + 4 * g4 + i; if (key < lo[rb] || key > hi[rb]) s[rb][c][i] = NEG; }
    }
    float mx[2];
#pragma unroll
    for (int rb = 0; rb < 2; ++rb) {
        float m = max3f(s[rb][0][0], s[rb][0][1], s[rb][0][2]); m = max3f(m, s[rb][0][3], s[rb][1][0]); m = max3f(m, s[rb][1][1], s[rb][1][2]); m = max3f(m, s[rb][1][3], s[rb][2][0]);
        m = max3f(m, s[rb][2][1], s[rb][2][2]); m = max3f(m, s[rb][2][3], s[rb][3][0]); m = max3f(m, s[rb][3][1], s[rb][3][2]); m = max3f(m, s[rb][3][3], m);
        mx[rb] = en[rb] ? m : NEG;
    }
    { const float t0 = __shfl_xor(mx[0], 16), t1 = __shfl_xor(mx[1], 16); mx[0] = max3f(mx[0], t0, t0); mx[1] = max3f(mx[1], t1, t1); }
    { const float t0 = __shfl_xor(mx[0], 32), t1 = __shfl_xor(mx[1], 32); mx[0] = max3f(mx[0], t0, t0); mx[1] = max3f(mx[1], t1, t1); }
    d[0] = (mx[0] > 20.0f) ? mx[0] : 0.f; d[1] = (mx[1] > 20.0f) ? mx[1] : 0.f;
    return __builtin_amdgcn_ballot_w64((d[0] != 0.f) || (d[1] != 0.f)) != 0ull;
}
__device__ __forceinline__ void attn_rescale2x(f32x4 (&s)[2][4], AttnRow (&st)[2], const float (&d)[2]) {
#pragma unroll
    for (int rb = 0; rb < 2; ++rb) {
        const float alpha = __builtin_amdgcn_exp2f(-d[rb]);
#pragma unroll
        for (int c = 0; c < 4; ++c) s[rb][c] = s[rb][c] - d[rb];
#pragma unroll
        for (int dt = 0; dt < 4; ++dt) st[rb].o[dt] *= alpha;
        st[rb].ol *= alpha; st[rb].m += d[rb];
    }
}
__device__ __forceinline__ void attn_exp1(f32x4 (&s)[4], unsigned enm, bf16x8 (&pb)[2]) {
#pragma unroll
    for (int c = 0; c < 4; ++c)
#pragma unroll
        for (int i = 0; i < 4; ++i) s[c][i] = __builtin_amdgcn_exp2f(s[c][i]);
#pragma unroll
    for (int ks = 0; ks < 2; ++ks) { u32x4 pw = pack8m(s[2 * ks], s[2 * ks + 1]); pw.x &= enm; pw.y &= enm; pw.z &= enm; pw.w &= enm; pb[ks] = __builtin_bit_cast(bf16x8, pw); }
}
__device__ __forceinline__ void attn_pv1(LAS unsigned char* Vb, const bf16x8 (&pb)[2], int vlane, int swz, const bf16x8 onesf, AttnRow& st) {
#pragma unroll
    for (int ks = 0; ks < 2; ++ks) {
#pragma unroll
        for (int dt = 0; dt < 4; ++dt) {
            LAS unsigned char* a0 = Vb + vlane + (2 * ks) * 2048 + ((dt ^ swz) * 32);
            const bf16x8 vf = tr_frag(a0, a0 + 2048);
            st.o[dt] = __builtin_amdgcn_mfma_f32_16x16x32_bf16(vf, pb[ks], st.o[dt], 0, 0, 0);
        }
        st.ol = __builtin_amdgcn_mfma_f32_16x16x32_bf16(onesf, pb[ks], st.ol, 0, 0, 0);
    }
}
__device__ __forceinline__ bool attn_step2x(LAS unsigned char* Vb, f32x4 (&s)[2][4], AttnRow (&st)[2], int kbase, int g4, const int (&lo)[2], const int (&hi)[2], const bool (&en)[2], const unsigned (&enm)[2], bool emask,
                                            int vlane, int swz, const bf16x8 onesf) {
    float d[2];
    const bool moved = attn_max2x(s, kbase, g4, lo, hi, en, emask, d);
    if (moved) attn_rescale2x(s, st, d);
    bf16x8 p0[2], p1[2];
    attn_exp1(s[0], enm[0], p0);
    attn_pv1(Vb, p0, vlane, swz, onesf, st[0]);
    attn_exp1(s[1], enm[1], p1);
    attn_pv1(Vb, p1, vlane, swz, onesf, st[1]);
    return moved;
}
__device__ __forceinline__ void attn_step2x_nomax(LAS unsigned char* Vb, f32x4 (&s)[2][4], AttnRow (&st)[2], int kbase, int g4, const int (&lo)[2], const int (&hi)[2], const unsigned (&enm)[2], bool emask,
                                                  int vlane, int swz, const bf16x8 onesf) {
    if (emask) {
#pragma unroll
        for (int rb = 0; rb < 2; ++rb)
#pragma unroll
            for (int c = 0; c < 4; ++c)
#pragma unroll
                for (int i = 0; i < 4; ++i) { const int key = kbase + 16 * c + 4 * g4 + i; if (key < lo[rb] || key > hi[rb]) s[rb][c][i] = -INFINITY; }
    }
    bf16x8 p0[2], p1[2];
    attn_exp1(s[0], enm[0], p0);
    attn_pv1(Vb, p0, vlane, swz, onesf, st[0]);
    attn_exp1(s[1], enm[1], p1);
    attn_pv1(Vb, p1, vlane, swz, onesf, st[1]);
}
typedef _Float16 f16x4 __attribute__((ext_vector_type(4)));
constexpr int AT4_KB = 0, AT4_VB = 32768, AT2_PS = 65536, AT2_MSK = 65536 + 65536;
__device__ __forceinline__ void ph_attn_fast2(const Args& a, LAS unsigned char* lds) {
    const bf16_t* QN = (const bf16_t*)(a.ws + WS_HN);
    const bf16_t* QR = (const bf16_t*)(a.ws + WS_QR);
    const bf16_t* KV6 = (const bf16_t*)(a.ws + WS_KV6);
    const float* GATES = (const float*)(a.ws + WS_GATES);
    const bf16_t* KC = (const bf16_t*)(a.ws + WS_KC);
    const bf16_t* VC = KC + (size_t)8192 * 64;
    bf16_t* O = (bf16_t*)(a.ws + WS_O);
    const int tid = threadIdx.x, lane = tid & 63, wave = __builtin_amdgcn_readfirstlane(tid >> 6);
    const int fr = lane & 15, g4 = lane >> 4;
    int ksrc, vsrc;
    { int R, C; pg8::stage_rc(wave * 1024 + lane * 16, R, C); ksrc = R * 64 + C;
      const int key = 8 * wave + (lane >> 3), pos = lane & 7, chunk = (pos >> 1) ^ ((key >> 1) & 3); vsrc = key * 64 + (chunk * 2 + (pos & 1)) * 8; }
    const int vlane = (4 * g4 + (fr >> 2)) * 128 + (fr & 3) * 8, swz = (2 * g4 + (fr >> 3)) & 3;
    LAS _Float16* ps = (LAS _Float16*)(lds + AT2_PS + wave * 8192);
    LAS unsigned* mskl = (LAS unsigned*)(lds + AT2_MSK + wave * 128);
    const float NEG = -INFINITY;
    const bf16x8 onesf = (fr == 0) ? (bf16x8){0x3F80, 0x3F80, 0x3F80, 0x3F80, 0x3F80, 0x3F80, 0x3F80, 0x3F80} : (bf16x8){0, 0, 0, 0, 0, 0, 0, 0};
    const int vcu = (gridDim.x % 8 == 0) ? (int)((blockIdx.x % 8) * (gridDim.x / 8) + blockIdx.x / 8) : (int)blockIdx.x;
    int cvt_next = (int)blockIdx.x * 8 + wave; const int cvt_stride = (int)gridDim.x * 8;
    LAS float* cvt_scr = (LAS float*)(lds + AT2_PS + wave * 8448);
    bool cmp_pref = false;
    for (int pr = vcu; pr < 1024; pr += gridDim.x) {
#pragma unroll 1
        for (int half = 0; half < 2; ++half) {
            const int bg = pr >> 6, cc = half ? (127 - (pr & 63)) : (pr & 63);
            const int b = bg >> 2, g = bg & 3, t0 = cc * 64, cur = cc;
            const int head = g * 4 + (fr & 3);
            int trow[2];
            bf16x8 qn[2][2];
#pragma unroll
            for (int rb = 0; rb < 2; ++rb) {
                trow[rb] = t0 + 8 * wave + 4 * rb + (fr >> 2);
#pragma unroll
                for (int ks = 0; ks < 2; ++ks) qn[rb][ks] = *(const bf16x8*)(QN + ((size_t)b * T + trow[rb]) * 1024 + head * 64 + 32 * ks + 8 * g4);
            }
#define TROW_PIN() asm volatile("" : "+v"(trow[0]), "+v"(trow[1]))
#define TOKROW(rb) ((size_t)b * T + trow[rb])
#define GATE(rb, br) (GATES[TOKROW(rb) * 48 + head * 3 + (br)])
            const bf16_t* kcb = KC + (size_t)bg * 512 * 64;
            const bf16_t* kvb = KV6 + (size_t)bg * T * 64;
#define ATK(sl) (((sl) < 4 ? AT4_KB : AT2_PS - 4 * 8192) + (sl) * 8192)
#define ATV(sl) (((sl) < 4 ? AT4_VB : AT2_PS + 32768 - 4 * 8192) + (sl) * 8192)
#define AT_DMA(BR, tile, slot) do { const bf16_t* kp_; const bf16_t* vp_; \
                if ((BR) == 0) { kp_ = kcb + (size_t)(tile) * 4096; vp_ = kp_ + (size_t)8192 * 64; } \
                else { kp_ = kvb + (size_t)((BR) == 1 ? 2 : 4) * 16 * T * 64 + (size_t)(tile) * 4096; vp_ = kp_ + (size_t)16 * T * 64; } \
                __builtin_amdgcn_global_load_lds((const unsigned*)(kp_ + ksrc), (LAS unsigned*)(lds + ATK(slot) + wave * 1024), 16, 0, 0); \
                __builtin_amdgcn_global_load_lds((const unsigned*)(vp_ + vsrc), (LAS unsigned*)(lds + ATV(slot) + wave * 1024), 16, 0, 0); } while (0)
            int ncv[2];
#pragma unroll
            for (int rb = 0; rb < 2; ++rb) ncv[rb] = (trow[rb] >= 31) ? ((trow[rb] - 31) / 16 + 1) : 0;
            const int nct = (((t0 + 63 - 31) / 16 + 1) + 63) >> 6;
            float mc[2], invc[2];
            const int t_lo = t0 + 8 * wave, ncv_lo = (t_lo >= 31) ? ((t_lo - 31) / 16 + 1) : 0;
            {
                float m1[2] = {NEG, NEG}, l1[2] = {0.f, 0.f};
                const float zero2[2] = {0.f, 0.f};
#define CMP1_TILE(J, SLOT, MASKED) do { const int j = (J); const int SLOT_ = (SLOT); \
                    f32x4 s[2][4]; attn_qk2(lds + AT4_KB + SLOT_ * 8192, qn, fr, g4, zero2, s); \
                    _Pragma("unroll") \
                    for (int rb = 0; rb < 2; ++rb) { \
                        float mx = NEG; \
                    _Pragma("unroll") \
                        for (int c = 0; c < 4; ++c) \
                    _Pragma("unroll") \
                            for (int i = 0; i < 4; ++i) { const int n = 64 * j + 16 * c + 4 * g4 + i; if ((MASKED) && n >= ncv[rb]) s[rb][c][i] = NEG; mx = fmaxf(mx, s[rb][c][i]); } \
                        mx = fmaxf(mx, __shfl_xor(mx, 16)); mx = fmaxf(mx, __shfl_xor(mx, 32)); \
                        const float mn = fmaxf(m1[rb], mx), msafe = (mn == NEG) ? 0.f : mn; \
                        const float alpha = (m1[rb] == NEG) ? 0.f : __builtin_amdgcn_exp2f(m1[rb] - msafe); \
                        float sum = 0.f; \
                    _Pragma("unroll") \
                        for (int c = 0; c < 4; ++c) \
                    _Pragma("unroll") \
                            for (int i = 0; i < 4; ++i) sum += __builtin_amdgcn_exp2f(s[rb][c][i] - msafe); \
                        l1[rb] = l1[rb] * alpha + sum; m1[rb] = mn; \
                    } \
                } while (0)
                if (!cmp_pref) { AT_DMA(0, 0, 0); if (nct > 1) AT_DMA(0, 1, 1); } __syncthreads();
                for (int j0 = 0; j0 < nct; j0 += 2) { const int sb = (j0 & 2);
                    if (j0 + 2 < nct) AT_DMA(0, j0 + 2, sb ^ 2);
                    if (j0 + 3 < nct) AT_DMA(0, j0 + 3, (sb ^ 2) + 1);
                    CMP1_TILE(j0, sb, true); if (j0 + 1 < nct) CMP1_TILE(j0 + 1, sb + 1, true);
                    __syncthreads();
                }
#undef CMP1_TILE
#pragma unroll
                for (int rb = 0; rb < 2; ++rb) { float lc = l1[rb]; lc += __shfl_xor(lc, 16); lc += __shfl_xor(lc, 32); invc[rb] = (lc > 0.f) ? -(((m1[rb] == NEG) ? 0.f : m1[rb]) + __builtin_amdgcn_logf(lc)) : 0.f; mc[rb] = (m1[rb] == NEG) ? 0.f : m1[rb]; }
            }
            {
                AttnRow oc[2];
#pragma unroll
                for (int rb = 0; rb < 2; ++rb) { oc[rb].m = 0.f; oc[rb].ol = (f32x4){0.f, 0.f, 0.f, 0.f};
#pragma unroll
                    for (int dt = 0; dt < 4; ++dt) oc[rb].o[dt] = (f32x4){0.f, 0.f, 0.f, 0.f}; }
                const float cin[2] = {invc[0], invc[1]};
                const unsigned full[2] = {0xffffffffu, 0xffffffffu}; const bool both[2] = {true, true};
#define CMP2_TILE(J, SLOT, MASKED) do { const int j = (J); const int SLOT_ = (SLOT); \
                    f32x4 s[2][4]; attn_qk2(lds + AT4_KB + SLOT_ * 8192, qn, fr, g4, cin, s); \
                    _Pragma("unroll") \
                    for (int rb = 0; rb < 2; ++rb) \
                    _Pragma("unroll") \
                        for (int c = 0; c < 4; ++c) { \
                            f16x4 hs; \
                    _Pragma("unroll") \
                            for (int i = 0; i < 4; ++i) { const int n = 64 * j + 16 * c + 4 * g4 + i; const float p = (!(MASKED) || n < ncv[rb]) ? __builtin_amdgcn_exp2f(s[rb][c][i]) : 0.f; s[rb][c][i] = p; \
                                float h = p; h += DPP_F(h, 0xB1); h += DPP_F(h, 0x4E); hs[i] = (_Float16)h; }        \
                            if ((fr & 3) == 0) *(LAS f16x4*)(ps + (4 * rb + (fr >> 2)) * 512 + 64 * j + 16 * c + 4 * g4) = hs; \
                        } \
                    attn_pv2x(lds + AT4_VB + SLOT_ * 8192, s, vlane, swz, full, both, onesf, oc); \
                } while (0)
                const bool reload = nct > 4;
                if (reload) { AT_DMA(0, 0, 0); AT_DMA(0, 1, 1); __syncthreads(); }
                for (int j0 = 0; j0 < nct; j0 += 2) { const int sb = (j0 & 2);
                    if (reload && j0 + 2 < nct) AT_DMA(0, j0 + 2, sb ^ 2);
                    if (reload && j0 + 3 < nct) AT_DMA(0, j0 + 3, (sb ^ 2) + 1);
                    CMP2_TILE(j0, sb, true); if (j0 + 1 < nct) CMP2_TILE(j0 + 1, sb + 1, true);
                    __syncthreads();
                }
#undef CMP2_TILE
                TROW_PIN();
#pragma unroll
                for (int rb = 0; rb < 2; ++rb) { bf16_t* op = O + TOKROW(rb) * 1024 + head * 64 + 4 * g4; const float g0 = GATE(rb, 0);
#pragma unroll
                    for (int dt = 0; dt < 4; ++dt) { const f32x4 v = oc[rb].o[dt] * g0; u32x2 w; w.x = cvt_pk_bf16(v[0], v[1]); w.y = cvt_pk_bf16(v[2], v[3]); *(u32x2*)(op + 16 * dt) = w; } }
            }
            {
                WSYNC();
                const int tl = lane >> 4, li = lane & 15;
                const int nsel = (cur + 1 < 16) ? (cur + 1) : 16;
#pragma unroll 1
                for (int rnd = 0; rnd < 2; ++rnd) {
                    const LAS _Float16* pst = ps + (4 * rnd + tl) * 512;
                    float v[8];
#pragma unroll
                    for (int k = 0; k < 8; ++k) { const int j = li + 16 * k;
                        float x;
                        if (j > cur) x = NEG;
                        else if (j == 0 || j == cur || j == cur - 1) x = INFINITY;
                        else { const int n0 = 4 * j; x = (float)pst[n0 - 1] + 2.0f * ((float)pst[n0] + (float)pst[n0 + 1] + (float)pst[n0 + 2]) + (float)pst[n0 + 3]; }
                        v[k] = x; }
                    int vi[8];
#pragma unroll
                    for (int k = 0; k < 8; ++k) vi[k] = __builtin_bit_cast(int, v[k]);
                    unsigned mm[4] = {0u, 0u, 0u, 0u};
                    for (int it = 0; it < nsel; ++it) {
                        int bv = max(max(max(vi[0], vi[1]), max(vi[2], vi[3])), max(max(vi[4], vi[5]), max(vi[6], vi[7])));
                        bv = max(bv, DPP_I(bv, 0xB1)); bv = max(bv, DPP_I(bv, 0x4E)); bv = max(bv, DPP_I(bv, 0x141)); bv = max(bv, DPP_I(bv, 0x140));
                        int bi = 255;
#pragma unroll
                        for (int k = 7; k >= 0; --k) bi = (vi[k] == bv) ? (li + 16 * k) : bi;
                        bi = min(bi, DPP_I(bi, 0xB1)); bi = min(bi, DPP_I(bi, 0x4E)); bi = min(bi, DPP_I(bi, 0x141)); bi = min(bi, DPP_I(bi, 0x140));
                        const unsigned bit = 1u << (bi & 31); const int wsel = bi >> 5;
                        mm[0] |= (wsel == 0) ? bit : 0u; mm[1] |= (wsel == 1) ? bit : 0u; mm[2] |= (wsel == 2) ? bit : 0u; mm[3] |= (wsel == 3) ? bit : 0u;
                        if ((bi & 15) == li) {
#pragma unroll
                            for (int k = 0; k < 8; ++k) if ((bi >> 4) == k) vi[k] = (int)0xFF800000;
                        }
                    }
                    if (li == 0) { mskl[(4 * rnd + tl) * 4 + 0] = mm[0]; mskl[(4 * rnd + tl) * 4 + 1] = mm[1]; mskl[(4 * rnd + tl) * 4 + 2] = mm[2]; mskl[(4 * rnd + tl) * 4 + 3] = mm[3]; }
                }
                WSYNC();
            }
            bf16x8 qr[2][2];
            TROW_PIN();
#pragma unroll
            for (int rb = 0; rb < 2; ++rb)
#pragma unroll
                for (int ks = 0; ks < 2; ++ks) qr[rb][ks] = *(const bf16x8*)(QR + TOKROW(rb) * 1024 + head * 64 + 32 * ks + 8 * g4);
            bool nomax_slc, nomax_win;
            {
                float qq = 0.f;
#pragma unroll
                for (int rb = 0; rb < 2; ++rb) { float q2 = 0.f;
#pragma unroll
                    for (int ks = 0; ks < 2; ++ks)
#pragma unroll
                        for (int j = 0; j < 8; ++j) { const float x = bf2f((bf16_t)qr[rb][ks][j]); q2 += x * x; }
                    q2 += __shfl_xor(q2, 16); q2 += __shfl_xor(q2, 32); qq = fmaxf(qq, q2); }
                qq = wave_max(qq);
                const float* tn = (const float*)(a.ws + WS_MISC + TN2_OFF) + bg * 128;
                const int jt0w = (t0 >= 511) ? ((t0 - 511) >> 6) : 0;
                float ts = 0.f, tw = 0.f;
#pragma unroll
                for (int h2 = 0; h2 < 2; ++h2) { const int tl_ = lane + 64 * h2; if (tl_ <= cur) { ts = fmaxf(ts, tn[tl_]); if (tl_ >= jt0w) tw = fmaxf(tw, tn[2048 + tl_]); } }
                ts = wave_max(ts); tw = wave_max(tw);
                nomax_slc = __builtin_amdgcn_readfirstlane((qq * ts <= 3500.0f) ? 1 : 0) != 0;
                nomax_win = __builtin_amdgcn_readfirstlane((qq * tw <= 3500.0f) ? 1 : 0) != 0;
            }
            {
                AttnRow ss[2];
#pragma unroll
                for (int rb = 0; rb < 2; ++rb) { ss[rb].m = 0.f; ss[rb].ol = (f32x4){0.f, 0.f, 0.f, 0.f};
#pragma unroll
                    for (int dt = 0; dt < 4; ++dt) ss[rb].o[dt] = (f32x4){0.f, 0.f, 0.f, 0.f}; }
                const int nt_ = cur + 1;
                bool refmoved = false;
#define SLC_PRE(J) const int j_ = (J); bool en[2], act[2]; unsigned enm[2]; \
                    _Pragma("unroll") for (int rb = 0; rb < 2; ++rb) { const unsigned mw = mwg[rb]; \
                        en[rb] = (mw >> (j_ & 31)) & 1u; act[rb] = __any(en[rb]); enm[rb] = en[rb] ? 0xffffffffu : 0u; } const int lo2[2] = {0, 0};
#define SLC_TILE(J, SLOT) do { SLC_PRE(J) \
                    if (act[0] || act[1]) { f32x4 s[2][4]; \
                        if (refmoved) { const float cin[2] = {-ss[0].m, -ss[1].m}; attn_qk2(lds + ATK(SLOT), qr, fr, g4, cin, s); } \
                        else attn_qk2z(lds + ATK(SLOT), qr, fr, g4, s); \
                        refmoved |= attn_step2x(lds + ATV(SLOT), s, ss, 64 * j_, g4, lo2, trow, en, enm, j_ == cur, vlane, swz, onesf); } } while (0)
#define SLC_TILE_NM(J, SLOT) do { SLC_PRE(J) \
                    if (act[0] || act[1]) { f32x4 s[2][4]; const float cm_[2] = {en[0] ? 0.f : -1e30f, en[1] ? 0.f : -1e30f}; attn_qk2m(lds + ATK(SLOT), qr, fr, g4, cm_, s); \
                        const unsigned fullm_[2] = {0xffffffffu, 0xffffffffu}; \
                        attn_step2x_nomax(lds + ATV(SLOT), s, ss, 64 * j_, g4, lo2, trow, fullm_, j_ == cur, vlane, swz, onesf); } } while (0)
#pragma unroll
                for (int i = 0; i < 4; ++i) if (i < nt_) AT_DMA(1, i, i);
                __syncthreads();
#define SLC_LOOP(TILE) for (int j0 = 0; j0 < nt_; j0 += 4) { const int sb = (j0 & 4); \
                    const unsigned mwg[2] = {mskl[(fr >> 2) * 4 + (j0 >> 5)], mskl[(4 + (fr >> 2)) * 4 + (j0 >> 5)]};       \
                    _Pragma("unroll") for (int i = 0; i < 4; ++i) if (j0 + 4 + i < nt_) AT_DMA(1, j0 + 4 + i, (sb ^ 4) + i); \
                    TILE(j0, sb); if (j0 + 1 < nt_) TILE(j0 + 1, sb + 1); if (j0 + 2 < nt_) TILE(j0 + 2, sb + 2); if (j0 + 3 < nt_) TILE(j0 + 3, sb + 3); \
                    __syncthreads(); }
                if (nomax_slc) { SLC_LOOP(SLC_TILE_NM) } else { SLC_LOOP(SLC_TILE) }
#undef SLC_LOOP
#undef SLC_TILE_NM
#undef SLC_PRE
#undef SLC_TILE
                TROW_PIN();
#pragma unroll
                for (int rb = 0; rb < 2; ++rb) { const float l = __shfl(ss[rb].ol[0], fr); const float sc1 = (l > 0.f) ? GATE(rb, 1) / l : 0.f;
                    bf16_t* op = O + TOKROW(rb) * 1024 + head * 64 + 4 * g4;
#pragma unroll
                    for (int dt = 0; dt < 4; ++dt) { const u32x2 pv = *(const u32x2*)(op + 16 * dt); f32x4 v = ss[rb].o[dt] * sc1;
                        v[0] += __uint_as_float(pv.x << 16); v[1] += __uint_as_float(pv.x & 0xffff0000u); v[2] += __uint_as_float(pv.y << 16); v[3] += __uint_as_float(pv.y & 0xffff0000u);
                        u32x2 w; w.x = cvt_pk_bf16(v[0], v[1]); w.y = cvt_pk_bf16(v[2], v[3]); *(u32x2*)(op + 16 * dt) = w; } }
            }
            {
                AttnRow sw[2];
#pragma unroll
                for (int rb = 0; rb < 2; ++rb) { sw[rb].m = 0.f; sw[rb].ol = (f32x4){0.f, 0.f, 0.f, 0.f};
#pragma unroll
                    for (int dt = 0; dt < 4; ++dt) sw[rb].o[dt] = (f32x4){0.f, 0.f, 0.f, 0.f}; }
                const int jt0 = (t0 >= 511) ? ((t0 - 511) >> 6) : 0;
                const int nt_ = cur - jt0 + 1;
                const unsigned full[2] = {0xffffffffu, 0xffffffffu}; const bool both[2] = {true, true};
                bool refmoved = false;
#define WIN_PRE(JJ) const int j = jt0 + (JJ); f32x4 s[2][4]; const bool edge = (j == cur) || (64 * j < t0 + 63 - 511); const int lo2[2] = {trow[0] - 511, trow[1] - 511};
#define WIN_TILE(JJ, SLOT) do { WIN_PRE(JJ) \
                    if (refmoved) { const float cin[2] = {-sw[0].m, -sw[1].m}; attn_qk2(lds + AT4_KB + (SLOT) * 8192, qr, fr, g4, cin, s); } \
                    else attn_qk2z(lds + AT4_KB + (SLOT) * 8192, qr, fr, g4, s); \
                    refmoved |= attn_step2x(lds + AT4_VB + (SLOT) * 8192, s, sw, 64 * j, g4, lo2, trow, both, full, edge, vlane, swz, onesf); } while (0)
#define WIN_TILE_NM(JJ, SLOT) do { WIN_PRE(JJ) attn_qk2z(lds + AT4_KB + (SLOT) * 8192, qr, fr, g4, s); \
                    attn_step2x_nomax(lds + AT4_VB + (SLOT) * 8192, s, sw, 64 * j, g4, lo2, trow, full, edge, vlane, swz, onesf); } while (0)
                AT_DMA(2, jt0, 0); if (nt_ > 1) AT_DMA(2, jt0 + 1, 1); __syncthreads();
#define WIN_LOOP(TILE) for (int j0 = 0; j0 < nt_; j0 += 2) { const int sb = (j0 & 2); \
                    if (j0 + 2 < nt_) AT_DMA(2, jt0 + j0 + 2, sb ^ 2); \
                    if (j0 + 3 < nt_) AT_DMA(2, jt0 + j0 + 3, (sb ^ 2) + 1); \
                    TILE(j0, sb); if (j0 + 1 < nt_) TILE(j0 + 1, sb + 1); \
                    __syncthreads(); }
                if (nomax_win) { WIN_LOOP(WIN_TILE_NM) } else { WIN_LOOP(WIN_TILE) }
#undef WIN_LOOP
#undef WIN_TILE_NM
#undef WIN_PRE
#undef WIN_TILE
                TROW_PIN();
#pragma unroll
                for (int rb = 0; rb < 2; ++rb) { const float l = __shfl(sw[rb].ol[0], fr); const float sc2 = (l > 0.f) ? GATE(rb, 2) / l : 0.f;
                    bf16_t* op = O + TOKROW(rb) * 1024 + head * 64 + 4 * g4;
#pragma unroll
                    for (int dt = 0; dt < 4; ++dt) { const u32x2 pv = *(const u32x2*)(op + 16 * dt); f32x4 v = sw[rb].o[dt] * sc2;
                        v[0] += __uint_as_float(pv.x << 16); v[1] += __uint_as_float(pv.x & 0xffff0000u); v[2] += __uint_as_float(pv.y << 16); v[3] += __uint_as_float(pv.y & 0xffff0000u);
                        u32x2 w; w.x = cvt_pk_bf16(v[0], v[1]); w.y = cvt_pk_bf16(v[2], v[3]); *(u32x2*)(op + 16 * dt) = w; } }
            }
#undef AT_DMA
#undef ATK
#undef ATV
#undef TROW_PIN
#undef TOKROW
#undef GATE
            {
                const int npr = half ? pr + (int)gridDim.x : pr, nhalf = half ^ 1;
                cmp_pref = npr < 1024;
                if (cmp_pref) { const int nbg = npr >> 6, ncc = nhalf ? (127 - (npr & 63)) : (npr & 63);
                    const int nnct = (((ncc * 64 + 63 - 31) / 16 + 1) + 63) >> 6;
                    const bf16_t* nk = KC + (size_t)nbg * 512 * 64;
                    __builtin_amdgcn_global_load_lds((const unsigned*)(nk + ksrc), (LAS unsigned*)(lds + AT4_KB + wave * 1024), 16, 0, 0);
                    __builtin_amdgcn_global_load_lds((const unsigned*)(nk + (size_t)8192 * 64 + vsrc), (LAS unsigned*)(lds + AT4_VB + wave * 1024), 16, 0, 0);
                    if (nnct > 1) {
                        __builtin_amdgcn_global_load_lds((const unsigned*)(nk + 4096 + ksrc), (LAS unsigned*)(lds + AT4_KB + 8192 + wave * 1024), 16, 0, 0);
                        __builtin_amdgcn_global_load_lds((const unsigned*)(nk + (size_t)8192 * 64 + 4096 + vsrc), (LAS unsigned*)(lds + AT4_VB + 8192 + wave * 1024), 16, 0, 0); } } }
            cvt1_run(a, cvt_next, cvt_stride, 2, cvt_scr, lane);
        }
    }
    cvt1_run(a, cvt_next, cvt_stride, 1 << 20, cvt_scr, lane);
}

__device__ __forceinline__ void unpack8(const u32x4 w, float (&f)[8]) {
    f[0] = __uint_as_float(w.x << 16); f[1] = __uint_as_float(w.x & 0xffff0000u); f[2] = __uint_as_float(w.y << 16); f[3] = __uint_as_float(w.y & 0xffff0000u);
    f[4] = __uint_as_float(w.z << 16); f[5] = __uint_as_float(w.z & 0xffff0000u); f[6] = __uint_as_float(w.w << 16); f[7] = __uint_as_float(w.w & 0xffff0000u);
}
__device__ __forceinline__ void ph_convpool_fast(const Args& a, LAS unsigned char* lds) {
    const bf16_t* H0 = (const bf16_t*)(a.ws + WS_H0);
    bf16_t* CAT = (bf16_t*)(a.ws + WS_CAT);
    const float* cw = a.in[4]; const float* cb = a.in[5]; const float* lg = a.in[6]; const float* lb = a.in[7];
    const int tid = threadIdx.x, lane = tid & 63, wave = tid >> 6, ch = lane * 8;
    constexpr int VT_OFF = 0, UT_OFF = 62 * 1024, CW_OFF = UT_OFF + 47 * 1024;
    for (int i = tid; i < 31 * 64; i += 512) { const int k = i >> 6, c8 = (i & 63) * 8;
        const f32x4 w0 = *(const f32x4*)(cw + k * 512 + c8), w1 = *(const f32x4*)(cw + k * 512 + c8 + 4);
        u32x4 o; o.x = pk2(w0[0], w0[1]); o.y = pk2(w0[2], w0[3]); o.z = pk2(w1[0], w1[1]); o.w = pk2(w1[2], w1[3]);
        *(LAS u32x4*)(lds + CW_OFF + k * 1024 + c8 * 2) = o; }
    float bias[8], gam[8], bet[8];
#pragma unroll
    for (int j = 0; j < 8; ++j) { bias[j] = cb[ch + j]; gam[j] = lg[ch + j]; bet[j] = lb[ch + j]; }
    for (int tile = blockIdx.x; tile < M / 32; tile += gridDim.x) {
        const int tok0 = tile * 32, t0 = tok0 & (T - 1);
        __syncthreads();
        for (int i = tid; i < 62 * 64; i += 512) { const int r = i >> 6, c8 = (i & 63) * 8; const int tt = t0 - 30 + r;
            u32x4 v = (u32x4){0u, 0u, 0u, 0u}; if (tt >= 0) v = *(const u32x4*)(H0 + (size_t)(tok0 - 30 + r) * 1024 + 512 + c8);
            *(LAS u32x4*)(lds + VT_OFF + r * 1024 + c8 * 2) = v; }
        for (int i = tid; i < 47 * 64; i += 512) { const int r = i >> 6, c8 = (i & 63) * 8; const int tt = t0 - 15 + r;
            u32x4 v = (u32x4){0u, 0u, 0u, 0u}; if (tt >= 0) v = *(const u32x4*)(H0 + (size_t)(tok0 - 15 + r) * 1024 + c8);
            *(LAS u32x4*)(lds + UT_OFF + r * 1024 + c8 * 2) = v; }
        __syncthreads();
        float acc[4][8];
#pragma unroll
        for (int j = 0; j < 4; ++j)
#pragma unroll
            for (int c = 0; c < 8; ++c) acc[j][c] = bias[c];
#pragma unroll 1
        for (int k = 0; k < 31; ++k) {
            float w[8]; unpack8(*(const LAS u32x4*)(lds + CW_OFF + k * 1024 + ch * 2), w);
#pragma unroll
            for (int j = 0; j < 4; ++j) { float v[8]; unpack8(*(const LAS u32x4*)(lds + VT_OFF + (4 * wave + j + k) * 1024 + ch * 2), v);
#pragma unroll
                for (int c = 0; c < 8; ++c) acc[j][c] += w[c] * v[c]; }
        }
        const int wnd = 2 << (lane >> 4);
#pragma unroll
        for (int j = 0; j < 4; ++j) {
            const int tl = 4 * wave + j, t = t0 + tl; const size_t tok = (size_t)tok0 + tl;
            const int cnt = (t + 1 < wnd) ? (t + 1) : wnd;
            float s[8], self[8];
            unpack8(*(const LAS u32x4*)(lds + UT_OFF + (15 + tl) * 1024 + ch * 2), self);
#pragma unroll
            for (int c = 0; c < 8; ++c) s[c] = self[c];
            for (int k = 1; k < cnt; ++k) { float v[8]; unpack8(*(const LAS u32x4*)(lds + UT_OFF + (15 + tl - k) * 1024 + ch * 2), v);
#pragma unroll
                for (int c = 0; c < 8; ++c) s[c] += v[c]; }
            const float inv = 1.0f / (float)cnt;
            u32x4 o; o.x = pk2(s[0] * inv - self[0], s[1] * inv - self[1]); o.y = pk2(s[2] * inv - self[2], s[3] * inv - self[3]);
            o.z = pk2(s[4] * inv - self[4], s[5] * inv - self[5]); o.w = pk2(s[6] * inv - self[6], s[7] * inv - self[7]);
            *(u32x4*)(CAT + tok * 1024 + ch) = o;
            float sm = 0.f;
#pragma unroll
            for (int c = 0; c < 8; ++c) sm += acc[j][c];
            const float mean = wave_sum(sm) * (1.0f / 512.0f);
            float sq = 0.f;
#pragma unroll
            for (int c = 0; c < 8; ++c) { acc[j][c] -= mean; sq += acc[j][c] * acc[j][c]; }
            const float rstd = rsqrtf(wave_sum(sq) * (1.0f / 512.0f) + LN_EPS);
            float y[8];
#pragma unroll
            for (int c = 0; c < 8; ++c) { const float z = acc[j][c] * rstd * gam[c] + bet[c]; y[c] = z * sigmoidf_(z); }
            u32x4 o2; o2.x = pk2(y[0], y[1]); o2.y = pk2(y[2], y[3]); o2.z = pk2(y[4], y[5]); o2.w = pk2(y[6], y[7]);
            *(u32x4*)(CAT + tok * 1024 + 512 + ch) = o2;
        }
    }
}


__device__ __forceinline__ void ph_route_fast(const float* LOG, const float* bias, unsigned* gcnt, int2* list, unsigned char* ldsg) {
    unsigned* hist = (unsigned*)ldsg; unsigned* base = hist + 256; u32x2* sel = (u32x2*)(ldsg + 2048);
    const int tid = threadIdx.x, lane = tid & 63, wave = tid >> 6;
    const float NEG = -INFINITY;
    const float4 bb = *(const float4*)(bias + lane * 4);
    for (int chunk = blockIdx.x; chunk < M / 128; chunk += gridDim.x) {
        __syncthreads();
        if (tid < 256) hist[tid] = 0u;
        __syncthreads();
        for (int i = 0; i < 16; ++i) {
            const int tl = wave * 16 + i, tok = chunk * 128 + tl;
            const float4 lg = *(const float4*)(LOG + (size_t)tok * 256 + lane * 4);
            const float s0 = sigmoidf_(lg.x), s1 = sigmoidf_(lg.y), s2 = sigmoidf_(lg.z), s3 = sigmoidf_(lg.w);
            float v0 = s0 + bb.x, v1 = s1 + bb.y, v2 = s2 + bb.z, v3 = s3 + bb.w;
            float m1 = fmaxf(v0, v1), m2 = fminf(v0, v1);
            { const float hi = fmaxf(v2, v3), lo = fminf(v2, v3); const float n1 = fmaxf(m1, hi); const float n2 = fmaxf(fminf(m1, hi), fmaxf(m2, lo)); m1 = n1; m2 = n2; }
#pragma unroll
            for (int o = 1; o < 8; o <<= 1) { const float a1 = __shfl_xor(m1, o), a2 = __shfl_xor(m2, o); const float n1 = fmaxf(m1, a1), n2 = fmaxf(fminf(m1, a1), fmaxf(m2, a2)); m1 = n1; m2 = n2; }
            const float gs = m1 + m2; const int mygrp = lane >> 3;
            int rank = 0;
#pragma unroll
            for (int g2 = 0; g2 < 8; ++g2) { const float og = __shfl(gs, g2 * 8); rank += (og > gs || (og == gs && g2 < mygrp)) ? 1 : 0; }
            if (rank >= 4) { v0 = NEG; v1 = NEG; v2 = NEG; v3 = NEG; }
            int my_e = 0; float my_s = 0.f;
#pragma unroll
            for (int it = 0; it < 8; ++it) {
                float bv = v0; int bj = 0;
                if (v1 > bv) { bv = v1; bj = 1; }
                if (v2 > bv) { bv = v2; bj = 2; }
                if (v3 > bv) { bv = v3; bj = 3; }
                int bi = lane * 4 + bj;
#pragma unroll
                for (int o = 1; o < 64; o <<= 1) { const float ov = __shfl_xor(bv, o); const int oi = __shfl_xor(bi, o); if (ov > bv || (ov == bv && oi < bi)) { bv = ov; bi = oi; } }
                const int jj = bi & 3, ol = bi >> 2;
                const float mys = (jj == 0) ? s0 : (jj == 1) ? s1 : (jj == 2) ? s2 : s3;
                const float wsc = __shfl(mys, ol);
                if (lane == ol) { if (jj == 0) v0 = NEG; else if (jj == 1) v1 = NEG; else if (jj == 2) v2 = NEG; else v3 = NEG; }
                if (lane == it) { my_e = bi; my_s = wsc; }
            }
            const float ssum = wave_sum(lane < 8 ? my_s : 0.f);
            if (lane < 8) { const unsigned rk = atomicAdd(&hist[my_e], 1u); u32x2 en; en.x = (unsigned)my_e | (rk << 16); en.y = __float_as_uint(my_s / ssum * 2.5f); sel[tl * 8 + lane] = en; }
        }
        __syncthreads();
        if (tid < 256) { const unsigned h = hist[tid]; base[tid] = h ? atomicAdd(&gcnt[tid], h) : 0u; }
        __syncthreads();
#pragma unroll
        for (int rep = 0; rep < 2; ++rep) { const int idx = tid + rep * 512, tok = chunk * 128 + (idx >> 3), k = idx & 7;
            const u32x2 en = sel[idx]; const unsigned e = en.x & 0xffffu, pos = base[e] + (en.x >> 16);
            list[(size_t)e * LISTCAP + pos] = make_int2(tok * 10 + k, (int)en.y); }
    }
}

__global__ void __launch_bounds__(512, 2) fwd_kernel(Args a) {
    extern __shared__ __attribute__((aligned(16))) unsigned char lds[];
    volatile LAS unsigned* MISC = (volatile LAS unsigned*)((LAS unsigned char*)lds + (LDS_BYTES - 64));
    if (threadIdx.x < 16) MISC[threadIdx.x] = 0u;
    __syncthreads();
    unsigned* ctl = (unsigned*)(a.ws + WS_CTL);
#if MK_ONE_LAUNCH
    (void)xcd_barrier_post(ctl + CW_BAR, MISC + 8);
#define SEAM() do { XcdBarrier b_; b_.bar = (unsigned*)(a.ws + WS_CTL) + CW_BAR; b_.x = xb_xcc_id(); b_.st = MISC + 8; xcd_barrier(b_); } while (0)
#else
#define SEAM() do {} while (0)
#endif
    const int lo = a.ph_lo, hi = a.ph_hi;
#define IN(k) (lo <= (k) && (k) < hi)
#define BOTH(k) (IN(k) && (k) + 1 < hi)
#define X1 ((bf16_t*)(a.ws + WS_X1))
#define X2 ((bf16_t*)(a.ws + WS_X2))
#define LOG ((float*)(a.ws + WS_LOG))

    LAS unsigned char* L = (LAS unsigned char*)lds;
#define LIST ((int2*)(a.ws + WS_LIST))
#ifndef PROBE_DUP_MASK
#define PROBE_DUP_MASK 0u
#endif
#define RUN(k, ...) if (IN(k)) { { __VA_ARGS__ } if ((PROBE_DUP_MASK >> (k)) & 1u) { __syncthreads(); { __VA_ARGS__ } } if (BOTH(k)) SEAM(); }
    RUN(0, ph_prologue(a, L);)
    RUN(1, pg8::DenseSched S; S.init((const bf16_t*)(a.ws + WS_XA), D, (const bf16_t*)(a.ws + WS_WIN0), D, M, 1536);
           EpiInproj0 E{(bf16_t*)(a.ws + WS_H0)};
           pg8::gemm_phase<EpiInproj0, pg8::DenseSched, true>(L, D, 128u, S, E);)
    RUN(2, ph_convpool_fast(a, L);)
    RUN(4, pg8::DenseSched S; S.init((const bf16_t*)(a.ws + WS_CAT), D, (const bf16_t*)(a.ws + WS_WOUT0), D, M, D);
           EpiRes E{a.in[0], nullptr, (bf16_t*)(a.ws + WS_Y)};
           pg8::gemm_phase<EpiRes, pg8::DenseSched, true>(L, D, 128u, S, E);)
    RUN(5, ph_ln((const bf16_t*)(a.ws + WS_Y), a.in[17], a.in[18], X1, (unsigned char*)(a.ws + WS_X8));)
#define MOE_LAYER(P, LAYER, XIN, XOUT, OUTF) \
    RUN(P, pg8::DenseSched S; S.init(XIN, D, (const bf16_t*)(a.ws + WS_WR) + (size_t)(LAYER) * NE * D, D, M, NE); \
           EpiLogits E{LOG}; pg8::gemm_phase<EpiLogits, pg8::DenseSched, true>(L, D, 128u, S, E);) \
    if (IN(P + 1)) { ph_route_fast(LOG, a.in[22] + (LAYER) * NE, ctl + CW_CNT + (LAYER) * 256, LIST, lds); if (BOTH(P + 1)) SEAM(); } \
    RUN(P + 2, const int R = moe_setup256(ctl + CW_CNT + (LAYER) * 256, L); \
            MoeGuSched S{(const char*)(a.ws + WS_X8), (const char*)(a.ws + WS_WGU) + (size_t)(LAYER) * 257 * 512 * 1024, LIST, L, R, (R + 128) * 2, (int)gridDim.x, (int)blockIdx.x}; \
            S.prepare(); EpiGateUp E{(unsigned char*)(a.ws + WS_HID)}; pg8::gemm_phase<EpiGateUp, MoeGuSched, true, true>(L, D / 2, 128u, S, E);) \
    RUN(P + 3, const int R = moe_setup256(ctl + CW_CNT + (LAYER) * 256, L); \
            MoeDownSched S{(const char*)(a.ws + WS_HID), (const char*)(a.ws + WS_WD) + (size_t)(LAYER) * 257 * 1024 * 256, LIST, L, R, R + 128, (int)gridDim.x, (int)blockIdx.x}; \
            S.prepare(); EpiDown E{(unsigned char*)(a.ws + WS_YB), L}; pg8::gemm_phase<EpiDown, MoeDownSched, true, true>(L, FF / 2, 128u, S, E);) \
    RUN(P + 4, ph_combine(a, XIN, a.in[19] + (LAYER) * D, a.in[20] + (LAYER) * D, XOUT, OUTF);)
    MOE_LAYER(6, 0, X1, X2, nullptr)
    RUN(11, pg8::DenseSched S; S.init(X2, D, (const bf16_t*)(a.ws + WS_WINN), D, M, HNW);
            EpiInprojN E{(bf16_t*)(a.ws + WS_HN), (bf16_t*)(a.ws + WS_QR), (bf16_t*)(a.ws + WS_KV6), (float*)(a.ws + WS_GATES), (const float*)(a.ws + WS_MISC) + 1024};
            pg8::gemm_phase<EpiInprojN, pg8::DenseSched, true>(L, D, 128u, S, E);)
    RUN(13, Cmp1Sched S{(const char*)(a.ws + WS_KV6), (const char*)(a.ws + WS_CW1), (int)gridDim.x, (int)blockIdx.x};
            EpiCmp1 E{(bf16_t*)(a.ws + WS_CH1), (const float*)(a.ws + WS_MISC)};
            pg8::gemm_phase<EpiCmp1, Cmp1Sched, true>(L, 2048, 128u, S, E); ph_knorm(a);)
    RUN(14, ph_cmp2(a, lds);)
    RUN(15, ph_attn_fast2(a, L);)
    RUN(16, pg8::DenseSched S; S.init((const bf16_t*)(a.ws + WS_O), D, (const bf16_t*)(a.ws + WS_WOUTN), D, M, D);
            EpiRes E{nullptr, X2, (bf16_t*)(a.ws + WS_Y2)};
            pg8::gemm_phase<EpiRes, pg8::DenseSched, true>(L, D, 128u, S, E);)
    RUN(17, ph_ln((const bf16_t*)(a.ws + WS_Y2), a.in[17] + D, a.in[18] + D, X1, (unsigned char*)(a.ws + WS_X8));)
    MOE_LAYER(18, 1, X1, (bf16_t*)nullptr, a.out)
}

extern "C" void kernel_launch(void* const* d_in, const int* in_sizes, int n_in, void* d_out, int out_size, void* d_ws, size_t ws_size, hipStream_t stream) {
    static int grid = 0;
    if (grid == 0) {
        if (n_in != 29 || out_size != M * D || ws_size < WS_END) { fprintf(stderr, "kernel_launch: unexpected problem (n_in %d out %d ws %zu)\n", n_in, out_size, ws_size); grid = -1; return; }
        int dev = 0, cus = 0;
        if (hipGetDevice(&dev) != hipSuccess || hipDeviceGetAttribute(&cus, hipDeviceAttributeMultiprocessorCount, dev) != hipSuccess) { grid = -1; return; }
        if (hipFuncSetAttribute((const void*)fwd_kernel, hipFuncAttributeMaxDynamicSharedMemorySize, LDS_BYTES) != hipSuccess) { grid = -1; return; }
        int per_cu = 0;
        (void)hipOccupancyMaxActiveBlocksPerMultiprocessor(&per_cu, (const void*)fwd_kernel, 512, LDS_BYTES);
        (void)hipGetLastError();
        grid = cus;
    }
    if (grid < 0) return;
    (void)hipMemsetAsync((char*)d_ws + WS_CTL, 0, CTL_BYTES, stream);
    Args a{};
    for (int i = 0; i < 29; ++i) a.in[i] = (const float*)d_in[i];
    a.out = (float*)d_out; a.ws = (unsigned char*)d_ws;
    for (int i = 0; i < 8; ++i) a.inv_freq[i] = powf(500000.0f, -(float)(2 * i) / 16.0f);
#if MK_ONE_LAUNCH
    a.ph_lo = 0; a.ph_hi = NPHASE;
    hipLaunchKernelGGL(fwd_kernel, dim3(grid), dim3(512), LDS_BYTES, stream, a);
#else
    for (int p = 0; p < NPHASE; ++p) { a.ph_lo = p; a.ph_hi = p + 1; hipLaunchKernelGGL(fwd_kernel, dim3(grid), dim3(512), LDS_BYTES, stream, a); }
#endif
}
```

```cpp
#include <hip/hip_runtime.h>
#include <cstdint>
#include <cstdio>
#include <cmath>

#ifndef MK_ONE_LAUNCH
#define MK_ONE_LAUNCH 1
#endif

#define LAS __attribute__((address_space(3)))
typedef unsigned short bf16_t;
typedef short bf16x8 __attribute__((ext_vector_type(8)));
typedef float f32x4 __attribute__((ext_vector_type(4)));
typedef unsigned u32x2 __attribute__((ext_vector_type(2)));
typedef unsigned u32x4 __attribute__((ext_vector_type(4)));

constexpr int NB = 4, T = 8192, D = 1024, M = NB * T;
constexpr int NE = 256, TOPK = 8, FF = 256;
constexpr int HNW = 2816;
constexpr int LISTCAP = 32768;
constexpr float ALPHA = 1.4142135623730951f;
constexpr float LN_EPS = 1e-5f;
constexpr float QSCALE = 0.125f * 1.4426950408889634f;
constexpr int YB_NSLOT = 9;
constexpr float YB_SCALE = 16.0f;
constexpr int NPHASE = 23;

constexpr size_t MiB = 1u << 20;
constexpr size_t WS_CTL = 0, CTL_BYTES = 1 * MiB;
constexpr size_t WS_X1 = 1 * MiB;
constexpr size_t WS_X2 = WS_X1 + 64 * MiB;
constexpr size_t WS_LOG = WS_X2 + 64 * MiB;
constexpr size_t WS_LIST = WS_LOG + 32 * MiB;
constexpr size_t WS_WTS = WS_LIST + 64 * MiB;
constexpr size_t WS_HID = WS_WTS + 2 * MiB;
constexpr size_t WS_YB = WS_HID + 184 * MiB;
constexpr size_t WS_END_NAIVE = WS_YB + 576 * MiB;
constexpr size_t WS_WIN0 = WS_END_NAIVE;
constexpr size_t WS_WOUT0 = WS_WIN0 + 3 * MiB;
constexpr size_t WS_WINN = WS_WOUT0 + 2 * MiB;
constexpr size_t WS_WOUTN = WS_WINN + 6 * MiB;
constexpr size_t WS_WR = WS_WOUTN + 2 * MiB;
constexpr size_t WS_CW1 = WS_WR + 1 * MiB;
constexpr size_t WS_MISC = WS_CW1 + 2 * MiB;
constexpr size_t WS_WGU = WS_MISC + 1 * MiB;
constexpr size_t WS_X8 = WS_WGU + 257 * MiB;
constexpr float X8_SCALE = 8.0f, W8_SCALE = 64.0f, H8_SCALE = 16.0f;
constexpr size_t WS_WD = WS_WGU + 514 * MiB;
constexpr size_t WS_END = WS_WD + 257 * MiB;
constexpr size_t WS_XA = WS_X2;
constexpr size_t WS_H0 = WS_YB;
constexpr size_t WS_PM = WS_H0 + 64 * MiB;
constexpr size_t WS_CAT = WS_PM + 32 * MiB;
constexpr size_t WS_Y = WS_CAT + 64 * MiB;
constexpr size_t WS_HN = WS_YB;
constexpr size_t WS_KV6 = WS_HN + 64 * MiB;
constexpr size_t WS_QR = WS_HN + 176 * MiB;
constexpr size_t WS_GATES = WS_QR + 64 * MiB;
constexpr size_t WS_CH1 = WS_GATES + 8 * MiB;
constexpr size_t WS_KC = WS_CH1 + 4 * MiB;
constexpr size_t WS_O = WS_KC + 2 * MiB;
constexpr size_t WS_Y2 = WS_O + 64 * MiB;
static_assert(WS_Y2 + 64 * MiB <= WS_END_NAIVE, "overlay");
static_assert(WS_Y + 64 * MiB <= WS_END_NAIVE, "overlay");

constexpr int CW_CNT = 64;
constexpr int CW_BAR = 4096;

constexpr int LDS_BYTES = 163840;

__device__ __forceinline__ float bf2f(bf16_t h) { return __uint_as_float(((unsigned)h) << 16); }
__device__ __forceinline__ bf16_t f2bf(float f) { unsigned u = __float_as_uint(f); return (bf16_t)((u + 0x7fffu + ((u >> 16) & 1u)) >> 16); }
__device__ __forceinline__ unsigned pk2(float lo, float hi) { return (unsigned)f2bf(lo) | ((unsigned)f2bf(hi) << 16); }
#define WR_DPP(x, ctrl) __builtin_bit_cast(float, __builtin_amdgcn_update_dpp(__builtin_bit_cast(int, (float)(x)), __builtin_bit_cast(int, (float)(x)), (ctrl), 0xF, 0xF, true))
#define WR_ROW(x, r) __builtin_bit_cast(float, __builtin_amdgcn_readlane(__builtin_bit_cast(int, (float)(x)), 16 * (r)))
__device__ __forceinline__ float wave_sum(float v) {
    v += WR_DPP(v, 0xB1); v += WR_DPP(v, 0x4E); v += WR_DPP(v, 0x141); v += WR_DPP(v, 0x140);
    return (WR_ROW(v, 0) + WR_ROW(v, 1)) + (WR_ROW(v, 2) + WR_ROW(v, 3));
}
__device__ __forceinline__ float wave_max(float v) {
    v = fmaxf(v, WR_DPP(v, 0xB1)); v = fmaxf(v, WR_DPP(v, 0x4E)); v = fmaxf(v, WR_DPP(v, 0x141)); v = fmaxf(v, WR_DPP(v, 0x140));
    return fmaxf(fmaxf(WR_ROW(v, 0), WR_ROW(v, 1)), fmaxf(WR_ROW(v, 2), WR_ROW(v, 3)));
}
__device__ __forceinline__ float sigmoidf_(float x) { return 1.0f / (1.0f + __expf(-x)); }
__device__ __forceinline__ float gelu_tanh(float x) {
    const float u = 0.7978845608028654f * (x + 0.044715f * x * x * x);
    const float e = __expf(2.0f * u);
    const float th = 1.0f - 2.0f / (e + 1.0f);
    return 0.5f * x * (1.0f + th);
}
__device__ __forceinline__ bf16x8 cvt8(const float* p) {
    const float4 a = *(const float4*)p, b = *(const float4*)(p + 4);
    bf16x8 r;
    r[0] = (short)f2bf(a.x); r[1] = (short)f2bf(a.y); r[2] = (short)f2bf(a.z); r[3] = (short)f2bf(a.w);
    r[4] = (short)f2bf(b.x); r[5] = (short)f2bf(b.y); r[6] = (short)f2bf(b.z); r[7] = (short)f2bf(b.w);
    return r;
}
__device__ __forceinline__ bf16x8 colk8(const float* W, int N, int k, int col) {
    bf16x8 r;
#pragma unroll
    for (int j = 0; j < 8; ++j) r[j] = (short)f2bf(W[(size_t)(k + j) * N + col]);
    return r;
}
__device__ __forceinline__ bf16x8 zero8() { return (bf16x8){0, 0, 0, 0, 0, 0, 0, 0}; }
#define WSYNC() asm volatile("s_waitcnt lgkmcnt(0)" ::: "memory")

#define XB_TMO      128
#define XB_XCNT(j)  (256  + 64 * (j))
#define XB_XSUB(j)  (1280 + 64 * (j))
#define XB_XGEN(j)  (2304 + 64 * (j))
#define XB_TOP      3328
#define XB_TOPGEN   3392
#define XCD_BAR_WORDS 3456
#define XB_SPIN_CAP (1u << 22)
__device__ __forceinline__ unsigned xb_ld(unsigned* p)              { return __hip_atomic_load(p, __ATOMIC_RELAXED, __HIP_MEMORY_SCOPE_AGENT); }
__device__ __forceinline__ unsigned xb_add(unsigned* p, unsigned v) { return __hip_atomic_fetch_add(p, v, __ATOMIC_RELAXED, __HIP_MEMORY_SCOPE_AGENT); }
__device__ __forceinline__ unsigned xb_xcc_id() { return (unsigned)__builtin_amdgcn_s_getreg((3 << 11) | 20) & 0xFu; }
#define XB_SPIN(cond, bar) do { unsigned _sp = 0; while (cond) { __builtin_amdgcn_s_sleep(1); \
    if ((++_sp & 255u) == 0u) { if (xb_ld(&(bar)[XB_TMO])) break; if (_sp > XB_SPIN_CAP) { atomicAdd(&(bar)[XB_TMO], 1u); break; } } } } while (0)
struct XcdBarrier { unsigned* bar; unsigned x; volatile LAS unsigned* st; };
__device__ __forceinline__ XcdBarrier xcd_barrier_post(unsigned* bar, volatile LAS unsigned* st) {
    XcdBarrier b; b.bar = bar; b.x = xb_xcc_id(); b.st = st;
    if (threadIdx.x == 0) (void)xb_add(&bar[XB_XCNT(b.x)], 1u);
    return b;
}
__device__ __forceinline__ void xcd_barrier_complete(unsigned* bar, unsigned x, unsigned& nloc, unsigned& nx) {
    const unsigned G = gridDim.x * gridDim.y * gridDim.z;
    unsigned sum, cnt, mine, sp = 0u;
    for (;;) {
        sum = 0u; cnt = 0u; mine = 0u;
#pragma unroll
        for (unsigned j = 0; j < 16; ++j) { const unsigned c = xb_ld(&bar[XB_XCNT(j)]); sum += c; cnt += (c > 0u) ? 1u : 0u; mine = (j == x) ? c : mine; }
        if (sum == G) break;
        __builtin_amdgcn_s_sleep(1);
        if ((++sp & 255u) == 0u) { if (xb_ld(&bar[XB_TMO])) break; if (sp > XB_SPIN_CAP) { atomicAdd(&bar[XB_TMO], 1u); break; } }
    }
    nloc = mine > 0u ? mine : 1u; nx = cnt > 0u ? cnt : 1u;
}
__device__ __forceinline__ void xcd_barrier(const XcdBarrier& b) {
    asm volatile("s_waitcnt vmcnt(0)" ::: "memory");
    __syncthreads();
    if (threadIdx.x == 0) {
        unsigned* bar = b.bar;
        __builtin_amdgcn_s_waitcnt(0);
        unsigned nloc = b.st[0], nx = b.st[1];
        if (nloc == 0u) { xcd_barrier_complete(bar, b.x, nloc, nx); b.st[0] = nloc; b.st[1] = nx; }
        const unsigned old = xb_add(&bar[XB_XSUB(b.x)], 1u);
        const unsigned gen = old / nloc;
        if (old + 1u == (gen + 1u) * nloc) {
            __builtin_amdgcn_fence(__ATOMIC_RELEASE, "agent");
            asm volatile("s_waitcnt vmcnt(0)" ::: "memory");
            const unsigned og = xb_add(&bar[XB_TOP], 1u);
            const unsigned tg = og / nx;
            if (og + 1u == (tg + 1u) * nx) xb_add(&bar[XB_TOPGEN], 1u);
            else XB_SPIN(xb_ld(&bar[XB_TOPGEN]) == tg, bar);
            __builtin_amdgcn_fence(__ATOMIC_ACQUIRE, "agent");
            xb_add(&bar[XB_XGEN(b.x)], 1u);
            asm volatile("s_waitcnt vmcnt(0)" ::: "memory");
        } else {
            XB_SPIN(xb_ld(&bar[XB_XGEN(b.x)]) == gen, bar);
            __builtin_amdgcn_fence(__ATOMIC_ACQUIRE, "agent");
            asm volatile("s_waitcnt vmcnt(0)" ::: "memory");
        }
    }
    __syncthreads();
}

template <class AL, class BL, class EP>
__device__ __forceinline__ void mgemm_tile(unsigned char* lds, int K, const AL& al, const BL& bl, const EP& ep) {
    bf16_t* As = (bf16_t*)lds;
    bf16_t* Bs = As + 128 * 40;
    const int tid = threadIdx.x, lane = tid & 63, wave = tid >> 6;
    const int ar = tid >> 2, ac = (tid & 3) * 8;
    const int bn = tid & 127, bc = (tid >> 7) * 8;
    f32x4 acc[8];
#pragma unroll
    for (int s = 0; s < 8; ++s) acc[s] = (f32x4){0.f, 0.f, 0.f, 0.f};
    bf16x8 ra = al(ac), rb = bl(bc);
    for (int k0 = 0; k0 < K; k0 += 32) {
        __syncthreads();
        *(bf16x8*)(As + ar * 40 + ac) = ra;
        *(bf16x8*)(Bs + bn * 40 + bc) = rb;
        __syncthreads();
        if (k0 + 32 < K) { ra = al(k0 + 32 + ac); rb = bl(k0 + 32 + bc); }
        const bf16x8 af = *(const bf16x8*)(As + (wave * 16 + (lane & 15)) * 40 + (lane >> 4) * 8);
#pragma unroll
        for (int s = 0; s < 8; ++s) {
            const bf16x8 wf = *(const bf16x8*)(Bs + (16 * s + (lane & 15)) * 40 + (lane >> 4) * 8);
            acc[s] = __builtin_amdgcn_mfma_f32_16x16x32_bf16(wf, af, acc[s], 0, 0, 0);
        }
    }
    ep(wave * 16 + (lane & 15), (lane >> 4) * 4, acc);
}
__device__ __forceinline__ void store4bf(bf16_t* p, const f32x4 v) { u32x2 w; w.x = pk2(v[0], v[1]); w.y = pk2(v[2], v[3]); *(u32x2*)p = w; }

struct Args {
    const float* in[29];
    float* out;
    unsigned char* ws;
    float inv_freq[8];
    int ph_lo, ph_hi;
};

__device__ __forceinline__ unsigned pk4_fp8(float a, float b, float c, float d) { int w = __builtin_amdgcn_cvt_pk_fp8_f32(a, b, 0, false); return (unsigned)__builtin_amdgcn_cvt_pk_fp8_f32(c, d, w, true); }
__device__ __forceinline__ u32x2 pack8_fp8(const f32x4 v0, const f32x4 v1) {
    int a = __builtin_amdgcn_cvt_pk_fp8_f32(v0[0], v0[1], 0, false); a = __builtin_amdgcn_cvt_pk_fp8_f32(v0[2], v0[3], a, true);
    int b = __builtin_amdgcn_cvt_pk_fp8_f32(v1[0], v1[1], 0, false); b = __builtin_amdgcn_cvt_pk_fp8_f32(v1[2], v1[3], b, true);
    u32x2 w; w.x = (unsigned)a; w.y = (unsigned)b; return w;
}
__device__ __forceinline__ float clamp8(float v) { return __builtin_amdgcn_fmed3f(v, -448.0f, 448.0f); }
__device__ __forceinline__ void ph_ln(const bf16_t* Y, const float* g, const float* b, bf16_t* X, unsigned char* X8) {
    const int lane = threadIdx.x & 63, wave = threadIdx.x >> 6;
    const int gw = blockIdx.x * 8 + wave, ngw = gridDim.x * 8;
    float gg[16], bb[16];
#pragma unroll
    for (int j = 0; j < 8; ++j) { gg[j] = g[lane * 8 + j]; gg[8 + j] = g[512 + lane * 8 + j]; bb[j] = b[lane * 8 + j]; bb[8 + j] = b[512 + lane * 8 + j]; }
    for (int row0 = gw * 4; row0 < M; row0 += ngw * 4) {
        bf16x8 p0[4], p1[4];
#pragma unroll
        for (int r = 0; r < 4; ++r) { p0[r] = __builtin_nontemporal_load((const bf16x8*)(Y + (size_t)(row0 + r) * 1024 + lane * 8)); p1[r] = __builtin_nontemporal_load((const bf16x8*)(Y + (size_t)(row0 + r) * 1024 + 512 + lane * 8)); }
#pragma unroll
        for (int r = 0; r < 4; ++r) {
            float v[16];
#pragma unroll
            for (int j = 0; j < 8; ++j) { v[j] = bf2f((bf16_t)p0[r][j]); v[8 + j] = bf2f((bf16_t)p1[r][j]); }
            float s = 0.f;
#pragma unroll
            for (int j = 0; j < 16; ++j) s += v[j];
            const float mean = wave_sum(s) * (1.0f / 1024.0f);
            float q = 0.f;
#pragma unroll
            for (int j = 0; j < 16; ++j) { v[j] -= mean; q += v[j] * v[j]; }
            const float rstd = rsqrtf(wave_sum(q) * (1.0f / 1024.0f) + LN_EPS);
            float o[16];
#pragma unroll
            for (int j = 0; j < 16; ++j) o[j] = v[j] * rstd * gg[j] + bb[j];
            u32x4 w0, w1;
            w0.x = pk2(o[0], o[1]); w0.y = pk2(o[2], o[3]); w0.z = pk2(o[4], o[5]); w0.w = pk2(o[6], o[7]);
            w1.x = pk2(o[8], o[9]); w1.y = pk2(o[10], o[11]); w1.z = pk2(o[12], o[13]); w1.w = pk2(o[14], o[15]);
            *(u32x4*)(X + (size_t)(row0 + r) * 1024 + lane * 8) = w0; *(u32x4*)(X + (size_t)(row0 + r) * 1024 + 512 + lane * 8) = w1;
#pragma unroll
            for (int j = 0; j < 16; ++j) o[j] = clamp8(o[j] * X8_SCALE);
            u32x2 q0, q1; q0.x = pk4_fp8(o[0], o[1], o[2], o[3]); q0.y = pk4_fp8(o[4], o[5], o[6], o[7]); q1.x = pk4_fp8(o[8], o[9], o[10], o[11]); q1.y = pk4_fp8(o[12], o[13], o[14], o[15]);
            *(u32x2*)(X8 + (size_t)(row0 + r) * 1024 + lane * 8) = q0; *(u32x2*)(X8 + (size_t)(row0 + r) * 1024 + 512 + lane * 8) = q1;
        }
    }
}

__device__ __forceinline__ void ph_combine(const Args& a, const bf16_t* X, const float* g, const float* b, bf16_t* Xo, float* outf) {
    const unsigned char* YB = (const unsigned char*)(a.ws + WS_YB);
    const int lane = threadIdx.x & 63, wave = threadIdx.x >> 6;
    const int gw = blockIdx.x * 8 + wave, ngw = gridDim.x * 8;
    for (int row = gw; row < M; row += ngw) {
        float v[16];
#pragma unroll
        for (int j = 0; j < 16; ++j) v[j] = 0.f;
        u32x2 q0[YB_NSLOT], q1[YB_NSLOT];
#pragma unroll
        for (int k = 0; k < YB_NSLOT; ++k) { const unsigned char* yr = YB + ((size_t)row * 10 + k) * 1024; q0[k] = __builtin_nontemporal_load((const u32x2*)(yr + lane * 8)); q1[k] = __builtin_nontemporal_load((const u32x2*)(yr + 512 + lane * 8)); }
#pragma unroll
        for (int k = 0; k < YB_NSLOT; ++k) {
            const auto a0 = __builtin_amdgcn_cvt_pk_f32_fp8((int)q0[k].x, false), a1 = __builtin_amdgcn_cvt_pk_f32_fp8((int)q0[k].x, true), a2 = __builtin_amdgcn_cvt_pk_f32_fp8((int)q0[k].y, false), a3 = __builtin_amdgcn_cvt_pk_f32_fp8((int)q0[k].y, true);
            const auto b0 = __builtin_amdgcn_cvt_pk_f32_fp8((int)q1[k].x, false), b1 = __builtin_amdgcn_cvt_pk_f32_fp8((int)q1[k].x, true), b2 = __builtin_amdgcn_cvt_pk_f32_fp8((int)q1[k].y, false), b3 = __builtin_amdgcn_cvt_pk_f32_fp8((int)q1[k].y, true);
            v[0] += a0[0]; v[1] += a0[1]; v[2] += a1[0]; v[3] += a1[1]; v[4] += a2[0]; v[5] += a2[1]; v[6] += a3[0]; v[7] += a3[1];
            v[8] += b0[0]; v[9] += b0[1]; v[10] += b1[0]; v[11] += b1[1]; v[12] += b2[0]; v[13] += b2[1]; v[14] += b3[0]; v[15] += b3[1];
        }
        {
            const bf16x8 p0 = *(const bf16x8*)(X + (size_t)row * 1024 + lane * 8), p1 = *(const bf16x8*)(X + (size_t)row * 1024 + 512 + lane * 8);
#pragma unroll
            for (int j = 0; j < 8; ++j) { v[j] = v[j] * (1.0f / YB_SCALE) + ALPHA * bf2f((bf16_t)p0[j]); v[8 + j] = v[8 + j] * (1.0f / YB_SCALE) + ALPHA * bf2f((bf16_t)p1[j]); }
        }
        float s = 0.f;
#pragma unroll
        for (int j = 0; j < 16; ++j) s += v[j];
        const float mean = wave_sum(s) * (1.0f / 1024.0f);
        float q = 0.f;
#pragma unroll
        for (int j = 0; j < 16; ++j) { v[j] -= mean; q += v[j] * v[j]; }
        const float rstd = rsqrtf(wave_sum(q) * (1.0f / 1024.0f) + LN_EPS);
        float o[16];
#pragma unroll
        for (int j = 0; j < 8; ++j) { o[j] = v[j] * rstd * g[lane * 8 + j] + b[lane * 8 + j]; o[8 + j] = v[8 + j] * rstd * g[512 + lane * 8 + j] + b[512 + lane * 8 + j]; }
        if (outf) {
            float* op = outf + (size_t)row * 1024;
            *(float4*)(op + lane * 8) = make_float4(o[0], o[1], o[2], o[3]); *(float4*)(op + lane * 8 + 4) = make_float4(o[4], o[5], o[6], o[7]);
            *(float4*)(op + 512 + lane * 8) = make_float4(o[8], o[9], o[10], o[11]); *(float4*)(op + 512 + lane * 8 + 4) = make_float4(o[12], o[13], o[14], o[15]);
        } else {
            u32x4 w0, w1;
            w0.x = pk2(o[0], o[1]); w0.y = pk2(o[2], o[3]); w0.z = pk2(o[4], o[5]); w0.w = pk2(o[6], o[7]);
            w1.x = pk2(o[8], o[9]); w1.y = pk2(o[10], o[11]); w1.z = pk2(o[12], o[13]); w1.w = pk2(o[14], o[15]);
            *(u32x4*)(Xo + (size_t)row * 1024 + lane * 8) = w0; *(u32x4*)(Xo + (size_t)row * 1024 + 512 + lane * 8) = w1;
        }
    }
}

__device__ __forceinline__ void ph_cmp2(const Args& a, unsigned char* lds) {
    const bf16_t* CH1 = (const bf16_t*)(a.ws + WS_CH1);
    bf16_t* KC = (bf16_t*)(a.ws + WS_KC);
    const int tid = threadIdx.x;
    for (int u = blockIdx.x; u < 64 * 2; u += gridDim.x) {
        const int rt = u >> 1, kv = u & 1;
        const bf16_t* ar = CH1 + ((size_t)kv * 8192 + rt * 128 + (tid >> 2)) * 128;
        const float* w2 = a.in[kv ? 15 : 12];
        const int col = tid & 127;
        auto al = [&](int k) { return *(const bf16x8*)(ar + k); };
        auto bl = [&](int k) { return (col < 64) ? colk8(w2, 64, k, col) : zero8(); };
        auto ep = [&](int r, int cb, const f32x4 (&acc)[8]) {
            bf16_t* o = KC + ((size_t)kv * 8192 + rt * 128 + r) * 64;
#pragma unroll
            for (int s = 0; s < 4; ++s) store4bf(o + 16 * s + cb, acc[s]);
        };
        mgemm_tile(lds, 128, al, bl, ep);
    }
}

namespace pg8 {
constexpr int BM = 256, BK = 64, HALF = 128, HTB = HALF * BK * 2, STAGE_BYTES = 8 * HTB;
__device__ __forceinline__ int lds_byte(int r, int c) { const int st = (r >> 4) * 2 + (c >> 5), rr = r & 15, cc = c & 31, ob = rr * 64 + cc * 2; return st * 1024 + (ob ^ (((ob >> 9) & 1) << 5)); }
__device__ __forceinline__ void stage_rc(int b, int& R, int& C) { const int st = b / 1024, sb = b % 1024, swz = sb ^ (((sb >> 9) & 1) << 5); R = (st >> 1) * 16 + swz / 64; C = (st & 1) * 32 + (swz % 64) / 2; }
__device__ __forceinline__ int perm32(int rho) { const int n = rho >> 4, i = rho & 15; return 8 * (i >> 2) + 4 * n + (i & 3); }
struct Unit { int pm, pn, ord; };
typedef float f32x16 __attribute__((ext_vector_type(16)));
typedef int i32x8 __attribute__((ext_vector_type(8))); typedef int i32x4_ __attribute__((ext_vector_type(4)));
__device__ __forceinline__ i32x8 f8cat(const bf16x8 lo, const bf16x8 hi) { return __builtin_shufflevector(__builtin_bit_cast(i32x4_, lo), __builtin_bit_cast(i32x4_, hi), 0, 1, 2, 3, 4, 5, 6, 7); }
template <class Epi, class Sched, bool ALIGN_EPI, bool F8 = false>
__device__ __forceinline__ void gemm_phase(LAS unsigned char* lds, const int K, const unsigned kstepA, const Sched& S, const Epi& E) {
    const int tid = threadIdx.x, wid = __builtin_amdgcn_readfirstlane(tid >> 6), lane = tid & 63, wr = wid >> 2, wc = wid & 3, fr = lane & 15, fq = lane >> 4;
    const int nt = K / BK;
    constexpr bool GA = Sched::GATHER;
    int RA[2]; unsigned CA2[2], voffB[2], voffB1[2], voffA[2];
    constexpr bool P16 = Epi::PERM16;
#pragma unroll
    for (int i = 0; i < 2; ++i) { int R, C; stage_rc(tid * 16 + i * 8192, R, C); const int Rb = Epi::PERM ? ((R & ~31) + perm32(R & 31)) : R;
        RA[i] = R; CA2[i] = (unsigned)C * 2u; voffB[i] = (unsigned)(Rb * K + C) * 2u; voffA[i] = GA ? 0u : (S.lane_off(R) + (unsigned)C * 2u);
        if (P16) { const int c16 = 64 * (R >> 5) + 16 * ((R >> 2) & 3) + 4 * ((R >> 4) & 1) + (R & 3); voffB[i] = (unsigned)(c16 * K + C) * 2u; voffB1[i] = (unsigned)((c16 + 8) * K + C) * 2u; } else voffB1[i] = 0u; }
    const size_t kstepB = (size_t)(BK * 2);
    const size_t hstepB = (size_t)HALF * K * 2;
    const unsigned ldsw = (unsigned)wid * 1024u;
    const int aoff = lds_byte(wr * 64 + fr, fq * 8), boff = lds_byte(wc * 32 + fr, fq * 8);
    const char* const Ab = S.abase();
    unsigned aoC[2][2], aoN[2][2];
    unsigned uC[2], uN[2];
#define PG8_SA(b, h) (((b) * 2 + (h)) * HTB)
#define PG8_SB(b, h) ((4 + (b) * 2 + (h)) * HTB)
#define PG8_GLDS(sbase, voff, ldsoff) do { const char* _b = (const char*)(sbase); unsigned _v = (voff); asm volatile("" : "+s"(_b), "+v"(_v)); \
        __builtin_amdgcn_global_load_lds((const unsigned*)(_b + _v), (LAS unsigned*)(lds + (ldsoff)), 16, 0, 0); } while (0)
#define PG8_STAGE_B(bufoff, gbase) do { _Pragma("unroll") for (int _i = 0; _i < 2; ++_i) PG8_GLDS(gbase, voffB[_i], (bufoff) + ldsw + _i * 8192); } while (0)
#define PG8_STAGE_B1(bufoff, gbase) do { _Pragma("unroll") for (int _i = 0; _i < 2; ++_i) PG8_GLDS((const char*)(gbase) + (P16 ? (size_t)0 : hstepB), (P16 ? voffB1[_i] : voffB[_i]), (bufoff) + ldsw + _i * 8192); } while (0)
#define PG8_STAGE_A(bufoff, kb, UO, LO) do { _Pragma("unroll") for (int _i = 0; _i < 2; ++_i) PG8_GLDS(Ab + (size_t)((kb) + (UO)), (GA ? (LO)[_i] : voffA[_i]), (bufoff) + ldsw + _i * 8192); } while (0)
#define PG8_LDA(dst, b, h) do { _Pragma("unroll") for (int m = 0; m < 4; ++m) _Pragma("unroll") for (int k = 0; k < 2; ++k) dst[m][k] = *(const LAS bf16x8*)(lds + PG8_SA(b, h) + aoff + m * 2048 + k * 1024); } while (0)
#define PG8_LDB(dst, b, h) do { _Pragma("unroll") for (int n = 0; n < 2; ++n) _Pragma("unroll") for (int k = 0; k < 2; ++k) dst[n][k] = *(const LAS bf16x8*)(lds + PG8_SB(b, h) + boff + n * 2048 + k * 1024); } while (0)
#define PG8_MMA(ai, bj, At, Bt) do { __builtin_amdgcn_s_setprio(1); _Pragma("unroll") for (int m = 0; m < 4; ++m) _Pragma("unroll") for (int n = 0; n < 2; ++n) { \
        if constexpr (F8) { f32x16& _w = accw[ai][bj][m >> 1]; const int _q = ((m & 1) * 2 + n) * 4; f32x4 _c = {_w[_q], _w[_q + 1], _w[_q + 2], _w[_q + 3]}; \
            _c = __builtin_amdgcn_mfma_scale_f32_16x16x128_f8f6f4(f8cat(Bt[n][0], Bt[n][1]), f8cat(At[m][0], At[m][1]), _c, 0, 0, 0, 0, 0, 0); _w[_q] = _c[0]; _w[_q + 1] = _c[1]; _w[_q + 2] = _c[2]; _w[_q + 3] = _c[3]; } \
        else { _Pragma("unroll") for (int k = 0; k < 2; ++k) acc[ai][bj][m][n] = __builtin_amdgcn_mfma_f32_16x16x32_bf16(Bt[n][k], At[m][k], acc[ai][bj][m][n], 0, 0, 0); } } __builtin_amdgcn_s_setprio(0); } while (0)
#define PG8_WAIT_V(n) asm volatile("s_waitcnt vmcnt(" #n ")" ::: "memory")
#define PG8_WAIT_L(n) asm volatile("s_waitcnt lgkmcnt(" #n ")" ::: "memory")
#define PG8_BAR __builtin_amdgcn_s_barrier()
#define PG8_SCHED __builtin_amdgcn_sched_barrier(0)
#define PG8_KPAIR(KB1, KB2, KB3, BP2, BP3) do { \
            PG8_LDB(B0, 0, 0); PG8_LDB(B1, 0, 1); PG8_SCHED; PG8_LDA(At, 0, 0); PG8_STAGE_A(PG8_SA(1, 1), KB1, uC[1], aoC[1]); \
            PG8_WAIT_V(8); PG8_WAIT_L(0); PG8_BAR; PG8_MMA(0, 0, At, B0); PG8_MMA(0, 1, At, B1); PG8_BAR; PG8_SCHED; \
            PG8_LDA(At, 0, 1); PG8_STAGE_B(PG8_SB(0, 0), BP2); PG8_STAGE_B1(PG8_SB(0, 1), BP2); PG8_STAGE_A(PG8_SA(0, 0), KB2, u2[0], a2o[0]); \
            PG8_WAIT_V(8); PG8_WAIT_L(0); PG8_BAR; PG8_MMA(1, 0, At, B0); PG8_MMA(1, 1, At, B1); PG8_BAR; PG8_SCHED; \
            PG8_LDB(B0, 1, 0); PG8_LDB(B1, 1, 1); PG8_SCHED; PG8_LDA(At, 1, 0); PG8_STAGE_A(PG8_SA(0, 1), KB2, u2[1], a2o[1]); \
            PG8_WAIT_V(8); PG8_WAIT_L(0); PG8_BAR; PG8_MMA(0, 0, At, B0); PG8_MMA(0, 1, At, B1); PG8_BAR; PG8_SCHED; \
            PG8_LDA(At, 1, 1); PG8_STAGE_B(PG8_SB(1, 0), BP3); PG8_STAGE_B1(PG8_SB(1, 1), BP3); PG8_STAGE_A(PG8_SA(1, 0), KB3, u2[0], a2o[0]); \
            PG8_WAIT_V(8); PG8_WAIT_L(0); PG8_BAR; PG8_MMA(1, 0, At, B0); PG8_MMA(1, 1, At, B1); PG8_BAR; PG8_SCHED; } while (0)
    Unit cur, nxt; int ui = 0;
    if (!S.next(0, cur)) return;
    f32x4 acc[2][2][4][2];
#pragma unroll
    for (int a = 0; a < 2; ++a)
#pragma unroll
        for (int b = 0; b < 2; ++b)
#pragma unroll
            for (int m = 0; m < 4; ++m)
#pragma unroll
                for (int n = 0; n < 2; ++n) acc[a][b][m][n] = (f32x4){0.f, 0.f, 0.f, 0.f};
    bf16x8 At[4][2], B0[2][2], B1[2][2];
    f32x16 accw[2][2][2];
#define PG8_ZERO_W() do { if constexpr (F8) { _Pragma("unroll") for (int _a = 0; _a < 2; ++_a) _Pragma("unroll") for (int _b = 0; _b < 2; ++_b) _Pragma("unroll") for (int _m = 0; _m < 2; ++_m) _Pragma("unroll") for (int _e = 0; _e < 16; ++_e) accw[_a][_b][_m][_e] = 0.f; } } while (0)
    PG8_ZERO_W();
#pragma unroll
    for (int h = 0; h < 2; ++h) { uC[h] = GA ? 0u : S.unit_off(cur, h); uN[h] = uC[h];
#pragma unroll
        for (int i = 0; i < 2; ++i) { aoC[h][i] = GA ? (S.aoff(cur, h * HALF + RA[i]) + CA2[i]) : 0u; aoN[h][i] = aoC[h][i]; } }
    const char* cB = S.bptr(cur);
    PG8_STAGE_B(PG8_SB(0, 0), cB); PG8_STAGE_B1(PG8_SB(0, 1), cB); PG8_STAGE_A(PG8_SA(0, 0), 0u, uC[0], aoC[0]); PG8_STAGE_A(PG8_SA(0, 1), 0u, uC[1], aoC[1]);
    if (wr == 1) PG8_BAR;
    PG8_WAIT_V(2); PG8_BAR;
    PG8_STAGE_B(PG8_SB(1, 0), cB + kstepB); PG8_STAGE_A(PG8_SA(1, 0), kstepA, uC[0], aoC[0]); PG8_STAGE_B1(PG8_SB(1, 1), cB + kstepB);
    PG8_WAIT_V(6); PG8_BAR;
    for (;;) {
        const bool has_next = S.next(ui + 1, nxt);
        const char* nB = has_next ? S.bptr(nxt) : cB;
#pragma unroll
        for (int h = 0; h < 2; ++h) { uN[h] = (GA || !has_next) ? uC[h] : S.unit_off(nxt, h);
#pragma unroll
            for (int i = 0; i < 2; ++i) aoN[h][i] = (GA && has_next) ? (S.aoff(nxt, h * HALF + RA[i]) + CA2[i]) : aoC[h][i]; }
#pragma nounroll
        for (int t = 0; t < nt; t += 2) {
            const bool last = (t == nt - 2);
            const unsigned kb1 = (unsigned)(t + 1) * kstepA, kb2 = last ? 0u : (unsigned)(t + 2) * kstepA, kb3 = kb2 + kstepA;
            const char* b2 = last ? nB : cB + (size_t)(t + 2) * kstepB; const char* b3 = b2 + kstepB;
            unsigned u2[2], a2o[2][2];
#pragma unroll
            for (int h = 0; h < 2; ++h) { u2[h] = last ? uN[h] : uC[h];
#pragma unroll
                for (int i = 0; i < 2; ++i) a2o[h][i] = GA ? (last ? aoN[h][i] : aoC[h][i]) : 0u; }
            PG8_KPAIR(kb1, kb2, kb3, b2, b3);
        }
        if constexpr (ALIGN_EPI) { if (wr == 0) PG8_BAR; }
        if constexpr (F8) {
#pragma unroll
            for (int _a = 0; _a < 2; ++_a)
#pragma unroll
                for (int _b = 0; _b < 2; ++_b)
#pragma unroll
                    for (int _m = 0; _m < 4; ++_m)
#pragma unroll
                        for (int _n = 0; _n < 2; ++_n) { const f32x16& _w = accw[_a][_b][_m >> 1]; const int _q = ((_m & 1) * 2 + _n) * 4; acc[_a][_b][_m][_n] = (f32x4){_w[_q], _w[_q + 1], _w[_q + 2], _w[_q + 3]}; }
        }
        E(acc, cur, wr, wc, fr, fq);
        PG8_ZERO_W();
        if (!has_next) break;
#pragma unroll
        for (int a = 0; a < 2; ++a)
#pragma unroll
            for (int b = 0; b < 2; ++b)
#pragma unroll
                for (int m = 0; m < 4; ++m)
#pragma unroll
                    for (int n = 0; n < 2; ++n) acc[a][b][m][n] = (f32x4){0.f, 0.f, 0.f, 0.f};
        cur = nxt; cB = nB; ++ui;
#pragma unroll
        for (int h = 0; h < 2; ++h) { uC[h] = uN[h];
#pragma unroll
            for (int i = 0; i < 2; ++i) aoC[h][i] = aoN[h][i]; }
        if constexpr (ALIGN_EPI) { if (wr == 1) PG8_BAR; }
    }
    PG8_WAIT_V(0);
    if constexpr (!ALIGN_EPI) { if (wr == 0) PG8_BAR; }
    PG8_BAR;
#undef PG8_SA
#undef PG8_ZERO_W
#undef PG8_GLDS
#undef PG8_SB
#undef PG8_STAGE_A
#undef PG8_STAGE_B
#undef PG8_STAGE_B1
#undef PG8_LDA
#undef PG8_LDB
#undef PG8_MMA
#undef PG8_WAIT_V
#undef PG8_WAIT_L
#undef PG8_BAR
#undef PG8_SCHED
#undef PG8_KPAIR
}

struct DenseSched {
    const char* A; const char* Bt; unsigned lda2; size_t btile; int nM, nN, nwg, G, c;
    __device__ __forceinline__ void init(const bf16_t* A_, int lda, const bf16_t* Bt_, int K, int Mrows, int N) {
        A = (const char*)A_; Bt = (const char*)Bt_; lda2 = (unsigned)lda * 2u; btile = (size_t)256 * K * 2; nM = Mrows / BM; nN = N / BM; nwg = nM * nN; G = gridDim.x; c = blockIdx.x; }
    __device__ __forceinline__ bool next(int i, Unit& u) const {
        const long L = (long)i * G + c; if (L >= nwg) return false;
        int wgid = (int)L; { const int q = nwg / 8, r = nwg % 8, xcd = wgid % 8, off = wgid / 8; wgid = (xcd < r ? xcd * (q + 1) : r * (q + 1) + (xcd - r) * q) + off; }
        const int nig = 8 * nN, gid = wgid / nig, fm = gid * 8, gsz = (nM - fm) < 8 ? (nM - fm) : 8;
        u.pm = fm + ((wgid % nig) % gsz); u.pn = (wgid % nig) / gsz; u.ord = i; return true;
    }
    static constexpr bool GATHER = false;
    __device__ __forceinline__ unsigned lane_off(int r) const { return (unsigned)r * lda2; }
    __device__ __forceinline__ unsigned unit_off(const Unit& u, int h) const { return (unsigned)(u.pm * BM + h * HALF) * lda2; }
    __device__ __forceinline__ unsigned aoff(const Unit&, int) const { return 0u; }
    __device__ __forceinline__ const char* abase() const { return A; }
    __device__ __forceinline__ const char* bptr(const Unit& u) const { return Bt + (size_t)u.pn * btile; }
};
}
typedef float f32x2_t __attribute__((ext_vector_type(2))); typedef __bf16 bf16x2_t __attribute__((ext_vector_type(2)));
__device__ __forceinline__ unsigned cvt_pk_bf16(float lo, float hi) { const f32x2_t v = {lo, hi}; const bf16x2_t b = __builtin_convertvector(v, bf16x2_t); return __builtin_bit_cast(unsigned, b); }
__device__ __forceinline__ u32x4 pack8(const f32x4 v0, const f32x4 v1) { u32x4 w; w.x = cvt_pk_bf16(v0[0], v0[1]); w.y = cvt_pk_bf16(v0[2], v0[3]); w.z = cvt_pk_bf16(v1[0], v1[1]); w.w = cvt_pk_bf16(v1[2], v1[3]); return w; }
__device__ __forceinline__ unsigned cvtpk_m(float lo, float hi) { const f32x2_t v = {lo, hi}; const bf16x2_t b = __builtin_convertvector(v, bf16x2_t); return __builtin_bit_cast(unsigned, b); }
__device__ __forceinline__ u32x4 pack8m(const f32x4 v0, const f32x4 v1) { u32x4 w; w.x = cvtpk_m(v0[0], v0[1]); w.y = cvtpk_m(v0[2], v0[3]); w.z = cvtpk_m(v1[0], v1[1]); w.w = cvtpk_m(v1[2], v1[3]); return w; }
#define MFMA_SETTLE(S) asm volatile("s_nop 15\n\ts_nop 7" : "+v"(S[0][0]), "+v"(S[0][1]), "+v"(S[0][2]), "+v"(S[0][3]), "+v"(S[1][0]), "+v"(S[1][1]), "+v"(S[1][2]), "+v"(S[1][3]))
__device__ __forceinline__ f32x4 sig4(const f32x4 v) { f32x4 r; r[0] = sigmoidf_(v[0]); r[1] = sigmoidf_(v[1]); r[2] = sigmoidf_(v[2]); r[3] = sigmoidf_(v[3]); return r; }

#define EPI_ROWLOOP for (int ai = 0; ai < 2; ++ai) _Pragma("unroll") for (int m = 0; m < 4; ++m)
struct EpiInproj0 {
    static constexpr bool PERM = true, PERM16 = false; bf16_t* H0;
    __device__ __forceinline__ void operator()(const f32x4 (&acc)[2][2][4][2], const pg8::Unit& u, int wr, int wc, int fr, int fq) const {
        const int row0 = u.pm * 256 + wr * 64 + fr, cl = wc * 32 + 8 * fq;
#pragma unroll
        EPI_ROWLOOP { bf16_t* rp = H0 + (size_t)(row0 + ai * 128 + m * 16) * 1024;
            if (u.pn < 2) {
#pragma unroll
                for (int bj = 0; bj < 2; ++bj) *(u32x4*)(rp + u.pn * 256 + bj * 128 + cl) = pack8(acc[ai][bj][m][0], acc[ai][bj][m][1]);
            } else {
                const f32x4 v0 = acc[ai][0][m][0] * sig4(acc[ai][1][m][0]), v1 = acc[ai][0][m][1] * sig4(acc[ai][1][m][1]);
                *(u32x4*)(rp + 512 + (u.pn - 2) * 128 + cl) = pack8(v0, v1);
            } }
    }
};
struct EpiRes {
    static constexpr bool PERM = true, PERM16 = false; const float* resf; const bf16_t* resb; bf16_t* Y;
    __device__ __forceinline__ void operator()(const f32x4 (&acc)[2][2][4][2], const pg8::Unit& u, int wr, int wc, int fr, int fq) const {
        const int row0 = u.pm * 256 + wr * 64 + fr, c0 = u.pn * 256 + wc * 32 + 8 * fq;
#pragma unroll
        EPI_ROWLOOP { const size_t ro = (size_t)(row0 + ai * 128 + m * 16) * 1024 + c0;
#pragma unroll
            for (int bj = 0; bj < 2; ++bj) {
                f32x4 r0, r1;
                if (resf) { r0 = *(const f32x4*)(resf + ro + bj * 128); r1 = *(const f32x4*)(resf + ro + bj * 128 + 4); }
                else { const u32x4 xv = *(const u32x4*)(resb + ro + bj * 128);
                    r0[0] = __uint_as_float(xv.x << 16); r0[1] = __uint_as_float(xv.x & 0xffff0000u); r0[2] = __uint_as_float(xv.y << 16); r0[3] = __uint_as_float(xv.y & 0xffff0000u);
                    r1[0] = __uint_as_float(xv.z << 16); r1[1] = __uint_as_float(xv.z & 0xffff0000u); r1[2] = __uint_as_float(xv.w << 16); r1[3] = __uint_as_float(xv.w & 0xffff0000u); }
                *(u32x4*)(Y + ro + bj * 128) = pack8(acc[ai][bj][m][0] + r0 * ALPHA, acc[ai][bj][m][1] + r1 * ALPHA);
            } }
    }
};
struct EpiLogits {
    static constexpr bool PERM = true, PERM16 = false; float* LOG;
    __device__ __forceinline__ void operator()(const f32x4 (&acc)[2][2][4][2], const pg8::Unit& u, int wr, int wc, int fr, int fq) const {
        const int row0 = u.pm * 256 + wr * 64 + fr, cl = wc * 32 + 8 * fq;
#pragma unroll
        EPI_ROWLOOP { float* rp = LOG + (size_t)(row0 + ai * 128 + m * 16) * 256 + cl;
#pragma unroll
            for (int bj = 0; bj < 2; ++bj) { *(f32x4*)(rp + bj * 128) = acc[ai][bj][m][0]; *(f32x4*)(rp + bj * 128 + 4) = acc[ai][bj][m][1]; } }
    }
};

constexpr int MOE_TAB_OFF = 131072;
__device__ __forceinline__ int moe_setup256(const unsigned* cnt, LAS unsigned char* lds) {
    LAS int* tstart = (LAS int*)(lds + MOE_TAB_OFF);
    LAS int* scnt = (LAS int*)(lds + MOE_TAB_OFF + 1088);
    LAS unsigned short* texp = (LAS unsigned short*)(lds + MOE_TAB_OFF + 2176);
    const int tid = threadIdx.x;
    __syncthreads();
    if (tid < 256) scnt[tid] = (int)cnt[tid];
    __syncthreads();
    if (tid == 0) { int s = 0; for (int e = 0; e < 256; ++e) { tstart[e] = s; s += (scnt[e] + 255) >> 8; } tstart[256] = s; }
    __syncthreads();
    if (tid < 256) for (int q = tstart[tid]; q < tstart[tid + 1]; ++q) texp[q] = (unsigned short)tid;
    __syncthreads();
    return __builtin_amdgcn_readfirstlane(tstart[256]);
}
constexpr int MOE_TOK_OFF = MOE_TAB_OFF + 5120;
constexpr int MOE_MAX_ORD = 20;
struct MoeGuSched {
    static constexpr bool GATHER = true;
    const char* X; const char* W; const int2* list; LAS unsigned char* lds; int R, nunits, G, c;
    __device__ __forceinline__ int vcu() const { return (G % 8 == 0) ? (c % 8) * (G / 8) + c / 8 : c; }
    __device__ __forceinline__ bool next(int i, pg8::Unit& u) const {
        const int L = i * G + vcu(); if (L >= nunits || i >= MOE_MAX_ORD) return false;
        const int q = L >> 1; const int e = __builtin_amdgcn_readfirstlane((q < R) ? (int)((LAS unsigned short*)(lds + MOE_TAB_OFF + 2176))[q] : 256);
        u.pm = q; u.pn = e * 2 + (L & 1); u.ord = i; return true; }
    __device__ __forceinline__ void prepare() const {
        const int tid = threadIdx.x, r = tid & 255;
        pg8::Unit u;
        for (int i = tid >> 8; next(i, u); i += 2) {
            const int e = u.pn >> 1; int token;
            if (e < 256) { const int ts = ((LAS int*)(lds + MOE_TAB_OFF))[e], cn = ((LAS int*)(lds + MOE_TAB_OFF + 1088))[e]; int lr = (u.pm - ts) * 256 + r; if (lr >= cn) lr = cn - 1;
                token = list[(size_t)e * LISTCAP + lr].x / 10; }
            else token = (u.pm - R) * 256 + r;
            ((LAS unsigned short*)(lds + MOE_TOK_OFF))[i * 256 + r] = (unsigned short)token;
        }
        __syncthreads();
    }
    __device__ __forceinline__ unsigned aoff(const pg8::Unit& u, int r) const { return (unsigned)((LAS unsigned short*)(lds + MOE_TOK_OFF))[u.ord * 256 + r] * 1024u; }
    __device__ __forceinline__ unsigned lane_off(int) const { return 0u; }
    __device__ __forceinline__ unsigned unit_off(const pg8::Unit&, int) const { return 0u; }
    __device__ __forceinline__ const char* abase() const { return X; }
    __device__ __forceinline__ const char* bptr(const pg8::Unit& u) const { return W + (size_t)u.pn * (256 * 1024); }
};
constexpr float GU_SC = 1.0f / (X8_SCALE * W8_SCALE);
struct EpiGateUp {
    static constexpr bool PERM = true, PERM16 = false; unsigned char* HID;
    __device__ __forceinline__ void operator()(const f32x4 (&acc)[2][2][4][2], const pg8::Unit& u, int wr, int wc, int fr, int fq) const {
        const int row0 = u.pm * 256 + wr * 64 + fr, c0 = (u.pn & 1) * 128 + wc * 32 + 8 * fq;
#pragma unroll
        EPI_ROWLOOP { const f32x4 g0 = acc[ai][0][m][0] * GU_SC, g1 = acc[ai][0][m][1] * GU_SC;
            f32x4 h0 = g0 * sig4(g0) * (acc[ai][1][m][0] * (GU_SC * H8_SCALE)), h1 = g1 * sig4(g1) * (acc[ai][1][m][1] * (GU_SC * H8_SCALE));
#pragma unroll
            for (int i = 0; i < 4; ++i) { h0[i] = clamp8(h0[i]); h1[i] = clamp8(h1[i]); }
            *(u32x2*)(HID + (size_t)(row0 + ai * 128 + m * 16) * 256 + c0) = pack8_fp8(h0, h1); }
    }
};
constexpr int MOE_RI_OFF = MOE_TAB_OFF + 5120;
constexpr int MOE_MAX_RT = 6;
struct MoeDownSched {
    const char* HID; const char* W; const int2* list; LAS unsigned char* lds; int R, ntile, G, c;
    __device__ __forceinline__ int vcu() const { return (G % 8 == 0) ? (c % 8) * (G / 8) + c / 8 : c; }
    __device__ __forceinline__ bool next(int i, pg8::Unit& u) const {
        const int q = vcu() + G * (i >> 2); if (q >= ntile || (i >> 2) >= MOE_MAX_RT) return false;
        const int e = (q < R) ? (int)((LAS unsigned short*)(lds + MOE_TAB_OFF + 2176))[q] : 256;
        u.pm = q; u.pn = e * 4 + (i & 3); u.ord = i >> 2; return true; }
    __device__ __forceinline__ void prepare() const {
        const int tid = threadIdx.x, r = tid & 255;
        for (int o = tid >> 8; o < MOE_MAX_RT; o += 2) {
            const int q = vcu() + G * o; if (q >= ntile) break;
            u32x2 en;
            if (q < R) { const int e = ((LAS unsigned short*)(lds + MOE_TAB_OFF + 2176))[q]; const int ts = ((LAS int*)(lds + MOE_TAB_OFF))[e], cn = ((LAS int*)(lds + MOE_TAB_OFF + 1088))[e];
                const int lr = (q - ts) * 256 + r; if (lr < cn) { const int2 le = list[(size_t)e * LISTCAP + lr]; en.x = (unsigned)le.x; en.y = (unsigned)le.y; } else { en.x = 0xffffffffu; en.y = 0u; } }
            else { en.x = (unsigned)(((q - R) * 256 + r) * 10 + 8); en.y = __float_as_uint(1.0f); }
            ((LAS u32x2*)(lds + MOE_RI_OFF))[o * 256 + r] = en;
        }
        __syncthreads();
    }
    static constexpr bool GATHER = false;
    __device__ __forceinline__ unsigned lane_off(int r) const { return (unsigned)r * 256u; }
    __device__ __forceinline__ unsigned unit_off(const pg8::Unit& u, int h) const { return (unsigned)(u.pm * 256 + h * 128) * 256u; }
    __device__ __forceinline__ unsigned aoff(const pg8::Unit&, int) const { return 0u; }
    __device__ __forceinline__ const char* abase() const { return HID; }
    __device__ __forceinline__ const char* bptr(const pg8::Unit& u) const { return W + (size_t)u.pn * (256 * 256); }
};
struct EpiDown {
    static constexpr bool PERM = true, PERM16 = true;
    unsigned char* YB; LAS unsigned char* lds;
    __device__ __forceinline__ void operator()(const f32x4 (&acc)[2][2][4][2], const pg8::Unit& u, int wr, int wc, int fr, int fq) const {
        asm volatile("" : "+v"(fr), "+v"(fq));
        const unsigned c0b = (unsigned)((u.pn & 3) * 256 + wc * 64 + 16 * fq); const bool shared = (u.pn >> 2) == 256;
        const LAS u32x2* ri = (const LAS u32x2*)(lds + MOE_RI_OFF) + u.ord * 256 + wr * 64 + fr;
#pragma unroll
        for (int ai = 0; ai < 2; ++ai)
#pragma unroll
            for (int m = 0; m < 4; ++m) { const u32x2 en = ri[ai * 128 + m * 16]; const float wv = __uint_as_float(en.y) * (YB_SCALE / (H8_SCALE * W8_SCALE));
                if ((int)en.x >= 0) { unsigned char* rp = YB + (size_t)(en.x * 1024u + c0b);
                    const f32x4 v00 = acc[ai][0][m][0] * wv, v01 = acc[ai][0][m][1] * wv, v10 = acc[ai][1][m][0] * wv, v11 = acc[ai][1][m][1] * wv;
                    const u32x2 h0 = pack8_fp8(v00, v01), h1 = pack8_fp8(v10, v11);
                    *(u32x4*)rp = (u32x4){h0.x, h0.y, h1.x, h1.y};
                    if (YB_NSLOT == 10 && shared) {
                        u32x2 r_[2];
#pragma unroll
                        for (int bj = 0; bj < 2; ++bj) { const u32x2 h = bj ? h1 : h0; const f32x4 v0 = bj ? v10 : v00, v1 = bj ? v11 : v01;
                            const auto a0 = __builtin_amdgcn_cvt_pk_f32_fp8((int)h.x, false), a1 = __builtin_amdgcn_cvt_pk_f32_fp8((int)h.x, true), a2 = __builtin_amdgcn_cvt_pk_f32_fp8((int)h.y, false), a3 = __builtin_amdgcn_cvt_pk_f32_fp8((int)h.y, true);
                            const f32x4 r0 = {v0[0] - a0[0], v0[1] - a0[1], v0[2] - a1[0], v0[3] - a1[1]}, r1 = {v1[0] - a2[0], v1[1] - a2[1], v1[2] - a3[0], v1[3] - a3[1]};
                            r_[bj] = pack8_fp8(r0, r1); }
                        *(u32x4*)(rp + 1024) = (u32x4){r_[0].x, r_[0].y, r_[1].x, r_[1].y}; } } }
    }
};

struct EpiInprojN {
    static constexpr bool PERM = true, PERM16 = false; bf16_t* QN; bf16_t* QR; bf16_t* KV6; float* GATES; const float* ROT;
    __device__ __forceinline__ void operator()(const f32x4 (&acc)[2][2][4][2], const pg8::Unit& u, int wr, int wc, int fr, int fq) const {
        const int row0 = u.pm * 256 + wr * 64 + fr, cl = wc * 32 + 8 * fq, pn = u.pn;
        const bool isq = pn < 4, rotk = (pn == 6 || pn == 8), dorot = (isq || rotk) && ((wc & 1) == 0);
#pragma unroll
        EPI_ROWLOOP { const int row = row0 + ai * 128 + m * 16;
            if (pn == 10) {
                if (cl < 48) { *(f32x4*)(GATES + (size_t)row * 48 + cl) = sig4(acc[ai][0][m][0]); *(f32x4*)(GATES + (size_t)row * 48 + cl + 4) = sig4(acc[ai][0][m][1]); }
            } else {
                f32x4 cs0, cs1, sn0, sn1;
                if (dorot) { const float* rt = ROT + (size_t)(row & (T - 1)) * 16; cs0 = *(const f32x4*)rt; cs1 = *(const f32x4*)(rt + 4); sn0 = *(const f32x4*)(rt + 8); sn1 = *(const f32x4*)(rt + 12); }
#pragma unroll
                for (int bj = 0; bj < 2; ++bj) {
                    const f32x4 v0 = acc[ai][bj][m][0], v1 = acc[ai][bj][m][1];
                    f32x4 r0 = v0, r1 = v1;
                    if (dorot) {
                        f32x4 p0, p1;
#pragma unroll
                        for (int i = 0; i < 4; ++i) { p0[i] = __shfl_xor(v0[i], 16); p1[i] = __shfl_xor(v1[i], 16); }
                        if (fq == 0) { r0 = v0 * cs0 - p0 * sn0; r1 = v1 * cs1 - p1 * sn1; }
                        else if (fq == 1) { r0 = v0 * cs0 + p0 * sn0; r1 = v1 * cs1 + p1 * sn1; }
                    }
                    if (isq) { const int c = pn * 256 + bj * 128 + cl;
                        *(u32x4*)(QN + (size_t)row * 1024 + c) = pack8(v0 * QSCALE, v1 * QSCALE); *(u32x4*)(QR + (size_t)row * 1024 + c) = pack8(r0 * QSCALE, r1 * QSCALE); }
                    else { const int cc = bj * 128 + cl, g = cc >> 6, d = cc & 63, b = row >> 13, t = row & (T - 1);
                        *(u32x4*)(KV6 + ((size_t)((pn - 4) * 16 + b * 4 + g) * T + t) * 64 + d) = pack8(r0, r1); }
                }
            } }
    }
};

struct Cmp1Sched {
    const char* KV6; const char* W; int G, c;
    static constexpr bool GATHER = false;
    __device__ __forceinline__ bool next(int i, pg8::Unit& u) const { const int L = i * G + c; if (L >= 64) return false; u.pm = L >> 1; u.pn = L & 1; u.ord = i; return true; }
    __device__ __forceinline__ unsigned lane_off(int r) const { return (unsigned)r * 2048u; }
    __device__ __forceinline__ unsigned unit_off(const pg8::Unit& u, int h) const { return (unsigned)u.pn * (unsigned)(16 * T * 64 * 2) + (unsigned)(u.pm * 256 + h * 128) * 2048u; }
    __device__ __forceinline__ unsigned aoff(const pg8::Unit&, int) const { return 0u; }
    __device__ __forceinline__ const char* abase() const { return KV6; }
    __device__ __forceinline__ const char* bptr(const pg8::Unit& u) const { return W + (size_t)u.pn * (256 * 2048 * 2); }
};
struct EpiCmp1 {
    static constexpr bool PERM = true, PERM16 = false; bf16_t* CH1; const float* bias1;
    __device__ __forceinline__ void operator()(const f32x4 (&acc)[2][2][4][2], const pg8::Unit& u, int wr, int wc, int fr, int fq) const {
        const int row0 = u.pm * 256 + wr * 64 + fr, cl = wc * 32 + 8 * fq;
        const f32x4 b0 = *(const f32x4*)(bias1 + u.pn * 128 + cl), b1 = *(const f32x4*)(bias1 + u.pn * 128 + cl + 4);
#pragma unroll
        EPI_ROWLOOP { f32x4 v0 = acc[ai][0][m][0] + b0, v1 = acc[ai][0][m][1] + b1;
#pragma unroll
            for (int i = 0; i < 4; ++i) { v0[i] = gelu_tanh(v0[i]); v1[i] = gelu_tanh(v1[i]); }
            *(u32x4*)(CH1 + ((size_t)u.pn * 8192 + row0 + ai * 128 + m * 16) * 128 + cl) = pack8(v0, v1); }
    }
};

__device__ __forceinline__ void p0_item(const float* W, int K, int N, bf16_t* WT, int kb, int n0, int drow0, LAS float* scr, int lane, bool f8 = false) {
    const int k0 = 64 * kb, n4 = (lane & 15) * 4;
    const bool cok = (n0 + n4) < N;
    f32x4 v[16];
#pragma unroll
    for (int i = 0; i < 16; ++i) { const int kk = 4 * i + (lane >> 4); v[i] = cok ? __builtin_nontemporal_load((const f32x4*)(W + (size_t)(k0 + kk) * N + n0 + n4)) : (f32x4){0.f, 0.f, 0.f, 0.f}; }
#pragma unroll
    for (int i = 0; i < 16; ++i) { const int kk = 4 * i + (lane >> 4); LAS float* d = scr + kk * 65 + n4; d[0] = v[i][0]; d[1] = v[i][1]; d[2] = v[i][2]; d[3] = v[i][3]; }
    asm volatile("s_waitcnt lgkmcnt(0)" ::: "memory");
    if (f8) {
        const int c4 = lane & 3;
#pragma unroll
        for (int j = 0; j < 4; ++j) { const int n = (lane >> 2) + 16 * j; const LAS float* sp = scr + (16 * c4) * 65 + n;
            u32x4 o;
            o.x = pk4_fp8(sp[0 * 65] * W8_SCALE, sp[1 * 65] * W8_SCALE, sp[2 * 65] * W8_SCALE, sp[3 * 65] * W8_SCALE); o.y = pk4_fp8(sp[4 * 65] * W8_SCALE, sp[5 * 65] * W8_SCALE, sp[6 * 65] * W8_SCALE, sp[7 * 65] * W8_SCALE);
            o.z = pk4_fp8(sp[8 * 65] * W8_SCALE, sp[9 * 65] * W8_SCALE, sp[10 * 65] * W8_SCALE, sp[11 * 65] * W8_SCALE); o.w = pk4_fp8(sp[12 * 65] * W8_SCALE, sp[13 * 65] * W8_SCALE, sp[14 * 65] * W8_SCALE, sp[15 * 65] * W8_SCALE);
            if (n0 + n < N) __builtin_nontemporal_store(o, (u32x4*)((unsigned char*)WT + (size_t)(drow0 + n) * K + k0 + 16 * c4)); }
        asm volatile("s_waitcnt lgkmcnt(0)" ::: "memory");
        return;
    }
    const int c = lane & 7;
#pragma unroll
    for (int j = 0; j < 8; ++j) { const int n = (lane >> 3) + 8 * j; const LAS float* sp = scr + (8 * c) * 65 + n;
        u32x4 o; o.x = pk2(sp[0 * 65], sp[1 * 65]); o.y = pk2(sp[2 * 65], sp[3 * 65]); o.z = pk2(sp[4 * 65], sp[5 * 65]); o.w = pk2(sp[6 * 65], sp[7 * 65]);
        if (n0 + n < N) __builtin_nontemporal_store(o, (u32x4*)(WT + (size_t)(drow0 + n) * K + k0 + 8 * c)); }
    asm volatile("s_waitcnt lgkmcnt(0)" ::: "memory");
}
struct CvtItem { const float* W; bf16_t* WT; int K, N, k0, n0, drow0; };
__device__ __forceinline__ void cvt32_load(const CvtItem& it, int lane, f32x4 (&v)[8]) {
    const int n4 = (lane & 7) * 4;
#pragma unroll
    for (int i = 0; i < 8; ++i) { const int kk = 8 * i + (lane >> 3); v[i] = __builtin_nontemporal_load((const f32x4*)(it.W + (size_t)(it.k0 + kk) * it.N + it.n0 + n4)); }
}
__device__ __forceinline__ void cvt32_finish(const CvtItem& it, int lane, const f32x4 (&v)[8], LAS float* scr) {
    const int n4 = (lane & 7) * 4;
#pragma unroll
    for (int i = 0; i < 8; ++i) { const int kk = 8 * i + (lane >> 3); LAS float* d = scr + kk * 33 + n4; d[0] = v[i][0]; d[1] = v[i][1]; d[2] = v[i][2]; d[3] = v[i][3]; }
    asm volatile("s_waitcnt lgkmcnt(0)" ::: "memory");
    const int c = lane & 7;
#pragma unroll
    for (int j = 0; j < 4; ++j) { const int n = (lane >> 3) + 8 * j; const LAS float* sp = scr + (8 * c) * 33 + n;
        const float v0 = sp[0 * 33], v1 = sp[1 * 33], v2 = sp[2 * 33], v3 = sp[3 * 33], v4 = sp[4 * 33], v5 = sp[5 * 33], v6 = sp[6 * 33], v7 = sp[7 * 33];
        u32x2 o; o.x = pk4_fp8(v0 * W8_SCALE, v1 * W8_SCALE, v2 * W8_SCALE, v3 * W8_SCALE); o.y = pk4_fp8(v4 * W8_SCALE, v5 * W8_SCALE, v6 * W8_SCALE, v7 * W8_SCALE);
        __builtin_nontemporal_store(o, (u32x2*)((unsigned char*)it.WT + (size_t)(it.drow0 + n) * it.K + it.k0 + 8 * c)); }
    asm volatile("s_waitcnt lgkmcnt(0)" ::: "memory");
}
constexpr int CVT1_ITEMS = 257 * 384;
__device__ __forceinline__ CvtItem cvt1_item(const Args& a, int idx) {
    const int e = idx / 384, sub = idx % 384, mat = sub >> 7, r = sub & 127;
    CvtItem it;
    if (mat < 2) { it.W = (e < 256) ? a.in[23 + mat] + ((size_t)256 + e) * (size_t)(D * FF) : a.in[26 + mat] + (size_t)(D * FF);
        it.K = D; it.N = FF; it.k0 = (r >> 3) * 64; it.n0 = (r & 7) * 32; it.drow0 = (it.n0 >> 7) * 256 + mat * 128 + (it.n0 & 127);
        it.WT = (bf16_t*)(a.ws + WS_WGU + (size_t)(257 + e) * 512 * 1024); }
    else { it.W = (e < 256) ? a.in[25] + ((size_t)256 + e) * (size_t)(FF * D) : a.in[28] + (size_t)(FF * D);
        it.K = FF; it.N = D; it.k0 = (r >> 5) * 64; it.n0 = (r & 31) * 32; it.drow0 = it.n0;
        it.WT = (bf16_t*)(a.ws + WS_WD + (size_t)(257 + e) * 1024 * 256); }
    return it;
}
__device__ __forceinline__ void cvt1_run(const Args& a, int& next, int stride, int quota, LAS float* scr, int lane) {
#pragma unroll 1
    for (int q = 0; q < quota && next < CVT1_ITEMS; ++q) {
        CvtItem t[4]; f32x4 v[4][8]; bool ok[4];
#pragma unroll
        for (int u = 0; u < 4; ++u) { const int idx = next + u * stride; ok[u] = idx < CVT1_ITEMS; t[u] = cvt1_item(a, ok[u] ? idx : 0); if (ok[u]) cvt32_load(t[u], lane, v[u]); }
        next += 4 * stride;
#pragma unroll
        for (int u = 0; u < 4; ++u) if (ok[u]) cvt32_finish(t[u], lane, v[u], scr);
    }
}
__device__ __forceinline__ void ph_prologue(const Args& a, LAS unsigned char* lds) {
    const int lane = threadIdx.x & 63, wave = threadIdx.x >> 6;
    LAS float* scr = (LAS float*)(lds + wave * 16640);
    const int gw = blockIdx.x * 8 + wave, ngw = gridDim.x * 8;
    for (int it = gw; it < 257 * 192; it += ngw) {
        const int le = it / 192, sub = it % 192, l = 0, e = le, mat = sub >> 6, r = sub & 63;
        if (mat < 2) {
            const float* W = (e < 256) ? a.in[23 + mat] + ((size_t)l * 256 + e) * (size_t)(D * FF) : a.in[26 + mat] + (size_t)l * (D * FF);
            const int kb = r >> 2, n0 = (r & 3) * 64;
            p0_item(W, D, FF, (bf16_t*)(a.ws + WS_WGU + (size_t)le * 512 * 1024), kb, n0, (n0 >> 7) * 256 + mat * 128 + (n0 & 127), scr, lane, true);
        } else {
            const float* W = (e < 256) ? a.in[25] + ((size_t)l * 256 + e) * (size_t)(FF * D) : a.in[28] + (size_t)l * (FF * D);
            const int kb = r >> 4, n0 = (r & 15) * 64;
            p0_item(W, FF, D, (bf16_t*)(a.ws + WS_WD + (size_t)le * 1024 * 256), kb, n0, n0, scr, lane, true);
        }
    }
    {
        for (int it = gw; it < 512; it += ngw) { const int w = it >> 8, r = it & 255;
            p0_item(a.in[w ? 16 : 8], D, D, (bf16_t*)(a.ws + (w ? WS_WOUTN : WS_WOUT0)), r >> 4, (r & 15) * 64, (r & 15) * 64, scr, lane); }
        for (int it = gw; it < 16 * 41; it += ngw) p0_item(a.in[9], D, 2608, (bf16_t*)(a.ws + WS_WINN), it / 41, (it % 41) * 64, (it % 41) * 64, scr, lane);
        for (int it = gw; it < 128; it += ngw) { const int l = it >> 6, r = it & 63;
            p0_item(a.in[21] + (size_t)l * D * NE, D, NE, (bf16_t*)(a.ws + WS_WR) + (size_t)l * NE * D, r >> 2, (r & 3) * 64, (r & 3) * 64, scr, lane); }
        for (int it = gw; it < 16 * 16; it += ngw) { const int kb = it >> 4, n0 = (8 + (it & 15)) * 64;
            const int isg = (n0 >= 1024) ? 1 : 0, rel = n0 - 512 - isg * 512;
            p0_item(a.in[1], D, 1536, (bf16_t*)(a.ws + WS_WIN0), kb, n0, 512 + (rel >> 7) * 256 + isg * 128 + (rel & 127), scr, lane); }
        for (int it = gw; it < 128; it += ngw) { const int kv = it >> 6, r = it & 63;
            p0_item(a.in[kv ? 14 : 11], 2048, 128, (bf16_t*)(a.ws + WS_CW1) + (size_t)kv * 256 * 2048, r >> 1, (r & 1) * 64, (r & 1) * 64, scr, lane); }
    }
    {
        const int gt = blockIdx.x * 512 + threadIdx.x, ngt = gridDim.x * 512;
        u32x4* z0 = (u32x4*)((bf16_t*)(a.ws + WS_WINN) + (size_t)2608 * 1024);
        for (int i = gt; i < 208 * 1024 / 8; i += ngt) z0[i] = (u32x4){0u, 0u, 0u, 0u};
        for (int kv = 0; kv < 2; ++kv) { u32x4* z1 = (u32x4*)((bf16_t*)(a.ws + WS_CW1) + ((size_t)kv * 256 + 128) * 2048);
            for (int i = gt; i < 128 * 2048 / 8; i += ngt) z1[i] = (u32x4){0u, 0u, 0u, 0u}; }
        const float* x = a.in[0]; bf16_t* XA = (bf16_t*)(a.ws + WS_XA);
        for (size_t i = gt; i < (size_t)M * D / 8; i += ngt) { const f32x4 v0 = *(const f32x4*)(x + i * 8), v1 = *(const f32x4*)(x + i * 8 + 4);
            u32x4 o; o.x = pk2(v0[0], v0[1]); o.y = pk2(v0[2], v0[3]); o.z = pk2(v1[0], v1[1]); o.w = pk2(v1[2], v1[3]); *(u32x4*)(XA + i * 8) = o; }
        const float* win = a.in[1]; const float* mix = a.in[2]; const float* psc = a.in[3]; bf16_t* WIN0 = (bf16_t*)(a.ws + WS_WIN0);
        for (int i = gt; i < 512 * 1024; i += ngt) { const int n = i & 511, k = i >> 9, g = n >> 7, nn = n & 127;
            const float* wr_ = win + (size_t)k * 1536 + g * 128; const float* mx = mix + (size_t)g * 128 * 128 + nn;
            float s = 0.f;
            for (int c = 0; c < 128; ++c) s += wr_[c] * mx[(size_t)c * 128];
            WIN0[(size_t)n * 1024 + k] = f2bf(s * psc[n]); }
        float* misc = (float*)(a.ws + WS_MISC);
        for (int i = gt; i < 256; i += ngt) { const int kv = i >> 7, j = i & 127; const float* pos = a.in[kv ? 13 : 10]; const float* w1 = a.in[kv ? 14 : 11];
            float s = 0.f; for (int k = 0; k < 2048; ++k) s += pos[k] * w1[(size_t)k * 128 + j]; misc[i] = s; }
        float* rot = misc + 1024;
        for (int i = gt; i < T * 8; i += ngt) { const int t = i >> 3, f = i & 7;
            const float ang = (float)t * a.inv_freq[f]; const double rev = (double)ang * 0.15915494309189535; const float fr = (float)(rev - floor(rev));
            rot[t * 16 + f] = __builtin_amdgcn_cosf(fr); rot[t * 16 + 8 + f] = __builtin_amdgcn_sinf(fr); }
    }
}

typedef short v4i16_t __attribute__((ext_vector_type(4)));
constexpr int AT_KB = 0, AT_VB = 16384, AT_PS = 32768, AT_MSK = 32768 + 65536;
#define DPP_I(x, ctrl) __builtin_amdgcn_update_dpp((int)(x), (int)(x), (ctrl), 0xF, 0xF, true)
#define DPP_F(x, ctrl) __builtin_bit_cast(float, __builtin_amdgcn_update_dpp(__builtin_bit_cast(int, (float)(x)), __builtin_bit_cast(int, (float)(x)), (ctrl), 0xF, 0xF, true))
__device__ __forceinline__ bf16x8 tr_frag(LAS unsigned char* p0, LAS unsigned char* p1) {
    const v4i16_t a = __builtin_amdgcn_ds_read_tr16_b64_v4i16((LAS v4i16_t*)p0), b = __builtin_amdgcn_ds_read_tr16_b64_v4i16((LAS v4i16_t*)p1);
    return (bf16x8){a[0], a[1], a[2], a[3], b[0], b[1], b[2], b[3]};
}
constexpr size_t TN2_OFF = 786432;
__device__ __forceinline__ void ph_knorm(const Args& a) {
    const bf16_t* KV6 = (const bf16_t*)(a.ws + WS_KV6);
    float* TN2 = (float*)(a.ws + WS_MISC + TN2_OFF);
    const int lane = threadIdx.x & 63, wave = threadIdx.x >> 6;
    const int first = (gridDim.x > 64) ? 64 : 0;
    if ((int)blockIdx.x < first) return;
    const int wi = ((int)blockIdx.x - first) * 8 + wave, nw = ((int)gridDim.x - first) * 8;
    for (int id = wi; id < 4096; id += nw) {
        const int ty = id >> 11, bg = (id >> 7) & 15, tile = id & 127;
        const bf16_t* rp = KV6 + ((size_t)((ty ? 4 : 2) * 16 + bg) * T + tile * 64 + lane) * 64;
        float ssq = 0.f;
#pragma unroll
        for (int c = 0; c < 8; ++c) { const bf16x8 v = *(const bf16x8*)(rp + 8 * c);
#pragma unroll
            for (int j = 0; j < 8; ++j) { const float f = bf2f((bf16_t)v[j]); ssq += f * f; } }
        ssq = wave_max(ssq);
        if (lane == 0) TN2[id] = ssq;
    }
}
__device__ __forceinline__ void attn_qk2(LAS unsigned char* Kb, const bf16x8 (&q)[2][2], int fr, int g4, const float (&cinit)[2], f32x4 (&s)[2][4]) {
#pragma unroll
    for (int c = 0; c < 4; ++c) {
#pragma unroll
        for (int rb = 0; rb < 2; ++rb) s[rb][c] = (f32x4){cinit[rb], cinit[rb], cinit[rb], cinit[rb]};
#pragma unroll
        for (int ks = 0; ks < 2; ++ks) {
            const bf16x8 kf = *(const LAS bf16x8*)(Kb + pg8::lds_byte(16 * c + fr, 32 * ks + 8 * g4));
#pragma unroll
            for (int rb = 0; rb < 2; ++rb) s[rb][c] = __builtin_amdgcn_mfma_f32_16x16x32_bf16(kf, q[rb][ks], s[rb][c], 0, 0, 0);
        }
    }
}
__device__ __forceinline__ void attn_qk2m(LAS unsigned char* Kb, const bf16x8 (&q)[2][2], int fr, int g4, const float (&cinit)[2], f32x4 (&s)[2][4]) {
    bf16x8 kf[4][2];
#pragma unroll
    for (int c = 0; c < 4; ++c)
#pragma unroll
        for (int ks = 0; ks < 2; ++ks) kf[c][ks] = *(const LAS bf16x8*)(Kb + pg8::lds_byte(16 * c + fr, 32 * ks + 8 * g4));
    __builtin_amdgcn_sched_barrier(0);
    f32x4 ci[2];
#pragma unroll
    for (int rb = 0; rb < 2; ++rb) ci[rb] = (f32x4){cinit[rb], cinit[rb], cinit[rb], cinit[rb]};
#pragma unroll
    for (int c = 0; c < 4; ++c) {
#pragma unroll
        for (int ks = 0; ks < 2; ++ks) {
#pragma unroll
            for (int rb = 0; rb < 2; ++rb) s[rb][c] = __builtin_amdgcn_mfma_f32_16x16x32_bf16(kf[c][ks], q[rb][ks], ks == 0 ? ci[rb] : s[rb][c], 0, 0, 0);
        }
    }
}
__device__ __forceinline__ void attn_qk2z(LAS unsigned char* Kb, const bf16x8 (&q)[2][2], int fr, int g4, f32x4 (&s)[2][4]) {
    bf16x8 kf[4][2];
#pragma unroll
    for (int c = 0; c < 4; ++c)
#pragma unroll
        for (int ks = 0; ks < 2; ++ks) kf[c][ks] = *(const LAS bf16x8*)(Kb + pg8::lds_byte(16 * c + fr, 32 * ks + 8 * g4));
    __builtin_amdgcn_sched_barrier(0);
#pragma unroll
    for (int c = 0; c < 4; ++c) {
#pragma unroll
        for (int ks = 0; ks < 2; ++ks) {
#pragma unroll
            for (int rb = 0; rb < 2; ++rb) s[rb][c] = __builtin_amdgcn_mfma_f32_16x16x32_bf16(kf[c][ks], q[rb][ks], ks == 0 ? (f32x4){0.f, 0.f, 0.f, 0.f} : s[rb][c], 0, 0, 0);
        }
    }
}
struct AttnRow { float m; f32x4 o[4]; f32x4 ol; };
__device__ __forceinline__ float max3f(float a, float b, float c) { float r; asm("v_max3_f32 %0, %1, %2, %3" : "=v"(r) : "v"(a), "v"(b), "v"(c)); return r; }
__device__ __forceinline__ bool attn_sm2(f32x4 (&s)[4], AttnRow& st, int kbase, int g4, int lo, int hi, bool en, bool emask) {
    const float NEG = -INFINITY;
    if (emask) {
#pragma unroll
        for (int c = 0; c < 4; ++c)
#pragma unroll
            for (int i = 0; i < 4; ++i) { const int key = kbase + 16 * c + 4 * g4 + i; if (key < lo || key > hi) s[c][i] = NEG; }
    }
    float mx = max3f(s[0][0], s[0][1], s[0][2]); mx = max3f(mx, s[0][3], s[1][0]); mx = max3f(mx, s[1][1], s[1][2]); mx = max3f(mx, s[1][3], s[2][0]);
    mx = max3f(mx, s[2][1], s[2][2]); mx = max3f(mx, s[2][3], s[3][0]); mx = max3f(mx, s[3][1], s[3][2]); mx = max3f(mx, s[3][3], mx);
    if (!en) mx = NEG;
    mx = max3f(mx, __shfl_xor(mx, 16), mx); mx = max3f(mx, __shfl_xor(mx, 32), mx);
    const float delta = (mx > 20.0f) ? mx : 0.f;
    const bool moved = __builtin_amdgcn_ballot_w64(delta != 0.f) != 0ull;
    if (moved) {
        const float alpha = __builtin_amdgcn_exp2f(-delta);
#pragma unroll
        for (int c = 0; c < 4; ++c) s[c] = s[c] - delta;
#pragma unroll
        for (int dt = 0; dt < 4; ++dt) st.o[dt] *= alpha;
        st.ol *= alpha;
        st.m += delta;
    }
#pragma unroll
    for (int c = 0; c < 4; ++c)
#pragma unroll
        for (int i = 0; i < 4; ++i) s[c][i] = __builtin_amdgcn_exp2f(s[c][i]);
    return moved;
}
__device__ __forceinline__ bool attn_sm2x(f32x4 (&s)[2][4], AttnRow (&st)[2], int kbase, int g4, const int (&lo)[2], const int (&hi)[2], const bool (&en)[2], bool emask) {
    const float NEG = -INFINITY;
    if (emask) {
#pragma unroll
        for (int rb = 0; rb < 2; ++rb)
#pragma unroll
            for (int c = 0; c < 4; ++c)
#pragma unroll
                for (int i = 0; i < 4; ++i) { const int key = kbase + 16 * c + 4 * g4 + i; if (key < lo[rb] || key > hi[rb]) s[rb][c][i] = NEG; }
    }
    float mx[2];
#pragma unroll
    for (int rb = 0; rb < 2; ++rb) {
        float m = max3f(s[rb][0][0], s[rb][0][1], s[rb][0][2]); m = max3f(m, s[rb][0][3], s[rb][1][0]); m = max3f(m, s[rb][1][1], s[rb][1][2]); m = max3f(m, s[rb][1][3], s[rb][2][0]);
        m = max3f(m, s[rb][2][1], s[rb][2][2]); m = max3f(m, s[rb][2][3], s[rb][3][0]); m = max3f(m, s[rb][3][1], s[rb][3][2]); m = max3f(m, s[rb][3][3], m);
        mx[rb] = en[rb] ? m : NEG;
    }
    { const float t0 = __shfl_xor(mx[0], 16), t1 = __shfl_xor(mx[1], 16); mx[0] = max3f(mx[0], t0, t0); mx[1] = max3f(mx[1], t1, t1); }
    { const float t0 = __shfl_xor(mx[0], 32), t1 = __shfl_xor(mx[1], 32); mx[0] = max3f(mx[0], t0, t0); mx[1] = max3f(mx[1], t1, t1); }
    const float d0 = (mx[0] > 20.0f) ? mx[0] : 0.f, d1 = (mx[1] > 20.0f) ? mx[1] : 0.f;
    const bool moved = __builtin_amdgcn_ballot_w64((d0 != 0.f) || (d1 != 0.f)) != 0ull;
    if (moved) {
        const float dl[2] = {d0, d1};
#pragma unroll
        for (int rb = 0; rb < 2; ++rb) {
            const float alpha = __builtin_amdgcn_exp2f(-dl[rb]);
#pragma unroll
            for (int c = 0; c < 4; ++c) s[rb][c] = s[rb][c] - dl[rb];
#pragma unroll
            for (int dt = 0; dt < 4; ++dt) st[rb].o[dt] *= alpha;
            st[rb].ol *= alpha; st[rb].m += dl[rb];
        }
    }
#pragma unroll
    for (int rb = 0; rb < 2; ++rb)
#pragma unroll
        for (int c = 0; c < 4; ++c)
#pragma unroll
            for (int i = 0; i < 4; ++i) s[rb][c][i] = __builtin_amdgcn_exp2f(s[rb][c][i]);
    return moved;
}
__device__ __forceinline__ void attn_pv2x(LAS unsigned char* Vb, const f32x4 (&p)[2][4], int vlane, int swz, const unsigned (&enm)[2], const bool (&act)[2], const bf16x8 onesf, AttnRow (&st)[2]) {
#pragma unroll
    for (int ks = 0; ks < 2; ++ks) {
        bf16x8 pb[2];
#pragma unroll
        for (int rb = 0; rb < 2; ++rb) { u32x4 pw = pack8m(p[rb][2 * ks], p[rb][2 * ks + 1]); pw.x &= enm[rb]; pw.y &= enm[rb]; pw.z &= enm[rb]; pw.w &= enm[rb]; pb[rb] = __builtin_bit_cast(bf16x8, pw); }
#pragma unroll
        for (int dt = 0; dt < 4; ++dt) {
            LAS unsigned char* a0 = Vb + vlane + (2 * ks) * 2048 + ((dt ^ swz) * 32);
            const bf16x8 vf = tr_frag(a0, a0 + 2048);
#pragma unroll
            for (int rb = 0; rb < 2; ++rb) if (act[rb]) st[rb].o[dt] = __builtin_amdgcn_mfma_f32_16x16x32_bf16(vf, pb[rb], st[rb].o[dt], 0, 0, 0);
        }
#pragma unroll
        for (int rb = 0; rb < 2; ++rb) if (act[rb]) st[rb].ol = __builtin_amdgcn_mfma_f32_16x16x32_bf16(onesf, pb[rb], st[rb].ol, 0, 0, 0);
    }
}
__device__ __forceinline__ bool attn_max2x(f32x4 (&s)[2][4], int kbase, int g4, const int (&lo)[2], const int (&hi)[2], const bool (&en)[2], bool emask, float (&d)[2]) {
    const float NEG = -INFINITY;
    MFMA_SETTLE(s);
    if (emask) {
#pragma unroll
        for (int rb = 0; rb < 2; ++rb)
#pragma unroll
            for (int c = 0; c < 4; ++c)
#pragma unroll
                for (int i = 0; i < 4; ++i) { const int key = kbase + 16 * c + 4 * g4 + i; if (key < lo[rb] || key > hi[rb]) s[rb][c][i] = NEG; }
    }
    float mx[2];
#pragma unroll
    for (int rb = 0; rb < 2; ++rb) {
        float m = max3f(s[rb][0][0], s[rb][0][1], s[rb][0][2]); m = max3f(m, s[rb][0][3], s[rb][1][0]); m = max3f(m, s[rb][1][1], s[rb][1][2]); m = max3f(m, s[rb][1][3], s[rb][2][0]);
        m = max3f(m, s[rb][2][1], s[rb][2][2]); m = max3f(m, s[rb][2][3], s[rb][3][0]); m = max3f(m, s[rb][3][1], s[rb][3][2]); m = max3f(m, s[rb][3][3], m);
        mx[rb] = en[rb] ? m : NEG;
    }
    { const float t0 = __shfl_xor(mx[0], 16), t1 = __shfl_xor(mx[1], 16); mx[0] = max3f(mx[0], t0, t0); mx[1] = max3f(mx[1], t1, t1); }
    { const float t0 = __shfl_xor(mx[0], 32), t1 = __shfl_xor(mx[1], 32); mx[0] = max3f(mx[0], t0, t0); mx[1] = max3f(mx[1], t1, t1); }
    d[0] = (mx[0] > 20.0f) ? mx[0] : 0.f; d[1] = (mx[1] > 20.0f) ? mx[1] : 0.f;
    return __builtin_amdgcn_ballot_w64((d[0] != 0.f) || (d[1] != 0.f)) != 0ull;
}
__device__ __forceinline__ void attn_rescale2x(f32x4 (&s)[2][4], AttnRow (&st)[2], const float (&d)[2]) {
#pragma unroll
    for (int rb = 0; rb < 2; ++rb) {
        const float alpha = __builtin_amdgcn_exp2f(-d[rb]);
#pragma unroll
        for (int c = 0; c < 4; ++c) s[rb][c] = s[rb][c] - d[rb];
#pragma unroll
        for (int dt = 0; dt < 4; ++dt) st[rb].o[dt] *= alpha;
        st[rb].ol *= alpha; st[rb].m += d[rb];
    }
}
__device__ __forceinline__ void attn_exp1(f32x4 (&s)[4], unsigned enm, bf16x8 (&pb)[2]) {
#pragma unroll
    for (int c = 0; c < 4; ++c)
#pragma unroll
        for (int i = 0; i < 4; ++i) s[c][i] = __builtin_amdgcn_exp2f(s[c][i]);
#pragma unroll
    for (int ks = 0; ks < 2; ++ks) { u32x4 pw = pack8m(s[2 * ks], s[2 * ks + 1]); pw.x &= enm; pw.y &= enm; pw.z &= enm; pw.w &= enm; pb[ks] = __builtin_bit_cast(bf16x8, pw); }
}
__device__ __forceinline__ void attn_pv1(LAS unsigned char* Vb, const bf16x8 (&pb)[2], int vlane, int swz, const bf16x8 onesf, AttnRow& st) {
#pragma unroll
    for (int ks = 0; ks < 2; ++ks) {
#pragma unroll
        for (int dt = 0; dt < 4; ++dt) {
            LAS unsigned char* a0 = Vb + vlane + (2 * ks) * 2048 + ((dt ^ swz) * 32);
            const bf16x8 vf = tr_frag(a0, a0 + 2048);
            st.o[dt] = __builtin_amdgcn_mfma_f32_16x16x32_bf16(vf, pb[ks], st.o[dt], 0, 0, 0);
        }
        st.ol = __builtin_amdgcn_mfma_f32_16x16x32_bf16(onesf, pb[ks], st.ol, 0, 0, 0);
    }
}
__device__ __forceinline__ bool attn_step2x(LAS unsigned char* Vb, f32x4 (&s)[2][4], AttnRow (&st)[2], int kbase, int g4, const int (&lo)[2], const int (&hi)[2], const bool (&en)[2], const unsigned (&enm)[2], bool emask,
                                            int vlane, int swz, const bf16x8 onesf) {
    float d[2];
    const bool moved = attn_max2x(s, kbase, g4, lo, hi, en, emask, d);
    if (moved) attn_rescale2x(s, st, d);
    bf16x8 p0[2], p1[2];
    attn_exp1(s[0], enm[0], p0);
    attn_pv1(Vb, p0, vlane, swz, onesf, st[0]);
    attn_exp1(s[1], enm[1], p1);
    attn_pv1(Vb, p1, vlane, swz, onesf, st[1]);
    return moved;
}
__device__ __forceinline__ void attn_step2x_nomax(LAS unsigned char* Vb, f32x4 (&s)[2][4], AttnRow (&st)[2], int kbase, int g4, const int (&lo)[2], const int (&hi)[2], const unsigned (&enm)[2], bool emask,
                                                  int vlane, int swz, const bf16x8 onesf) {
    if (emask) {
#pragma unroll
        for (int rb = 0; rb < 2; ++rb)
#pragma unroll
            for (int c = 0; c < 4; ++c)
#pragma unroll
                for (int i = 0; i < 4; ++i) { const int key = kbase + 16 * c + 4 * g4 + i; if (key < lo[rb] || key > hi[rb]) s[rb][c][i] = -INFINITY; }
    }
    bf16x8 p0[2], p1[2];
    attn_exp1(s[0], enm[0], p0);
    attn_pv1(Vb, p0, vlane, swz, onesf, st[0]);
    attn_exp1(s[1], enm[1], p1);
    attn_pv1(Vb, p1, vlane, swz, onesf, st[1]);
}
typedef _Float16 f16x4 __attribute__((ext_vector_type(4)));
constexpr int AT4_KB = 0, AT4_VB = 32768, AT2_PS = 65536, AT2_MSK = 65536 + 65536;
__device__ __forceinline__ void ph_attn_fast2(const Args& a, LAS unsigned char* lds) {
    const bf16_t* QN = (const bf16_t*)(a.ws + WS_HN);
    const bf16_t* QR = (const bf16_t*)(a.ws + WS_QR);
    const bf16_t* KV6 = (const bf16_t*)(a.ws + WS_KV6);
    const float* GATES = (const float*)(a.ws + WS_GATES);
    const bf16_t* KC = (const bf16_t*)(a.ws + WS_KC);
    const bf16_t* VC = KC + (size_t)8192 * 64;
    bf16_t* O = (bf16_t*)(a.ws + WS_O);
    const int tid = threadIdx.x, lane = tid & 63, wave = __builtin_amdgcn_readfirstlane(tid >> 6);
    const int fr = lane & 15, g4 = lane >> 4;
    int ksrc, vsrc;
    { int R, C; pg8::stage_rc(wave * 1024 + lane * 16, R, C); ksrc = R * 64 + C;
      const int key = 8 * wave + (lane >> 3), pos = lane & 7, chunk = (pos >> 1) ^ ((key >> 1) & 3); vsrc = key * 64 + (chunk * 2 + (pos & 1)) * 8; }
    const int vlane = (4 * g4 + (fr >> 2)) * 128 + (fr & 3) * 8, swz = (2 * g4 + (fr >> 3)) & 3;
    LAS _Float16* ps = (LAS _Float16*)(lds + AT2_PS + wave * 8192);
    LAS unsigned* mskl = (LAS unsigned*)(lds + AT2_MSK + wave * 128);
    const float NEG = -INFINITY;
    const bf16x8 onesf = (fr == 0) ? (bf16x8){0x3F80, 0x3F80, 0x3F80, 0x3F80, 0x3F80, 0x3F80, 0x3F80, 0x3F80} : (bf16x8){0, 0, 0, 0, 0, 0, 0, 0};
    const int vcu = (gridDim.x % 8 == 0) ? (int)((blockIdx.x % 8) * (gridDim.x / 8) + blockIdx.x / 8) : (int)blockIdx.x;
    int cvt_next = (int)blockIdx.x * 8 + wave; const int cvt_stride = (int)gridDim.x * 8;
    LAS float* cvt_scr = (LAS float*)(lds + AT2_PS + wave * 8448);
    bool cmp_pref = false;
    for (int pr = vcu; pr < 1024; pr += gridDim.x) {
#pragma unroll 1
        for (int half = 0; half < 2; ++half) {
            const int bg = pr >> 6, cc = half ? (127 - (pr & 63)) : (pr & 63);
            const int b = bg >> 2, g = bg & 3, t0 = cc * 64, cur = cc;
            const int head = g * 4 + (fr & 3);
            int trow[2];
            bf16x8 qn[2][2];
#pragma unroll
            for (int rb = 0; rb < 2; ++rb) {
                trow[rb] = t0 + 8 * wave + 4 * rb + (fr >> 2);
#pragma unroll
                for (int ks = 0; ks < 2; ++ks) qn[rb][ks] = *(const bf16x8*)(QN + ((size_t)b * T + trow[rb]) * 1024 + head * 64 + 32 * ks + 8 * g4);
            }
#define TROW_PIN() asm volatile("" : "+v"(trow[0]), "+v"(trow[1]))
#define TOKROW(rb) ((size_t)b * T + trow[rb])
#define GATE(rb, br) (GATES[TOKROW(rb) * 48 + head * 3 + (br)])
            const bf16_t* kcb = KC + (size_t)bg * 512 * 64;
            const bf16_t* kvb = KV6 + (size_t)bg * T * 64;
#define ATK(sl) (((sl) < 4 ? AT4_KB : AT2_PS - 4 * 8192) + (sl) * 8192)
#define ATV(sl) (((sl) < 4 ? AT4_VB : AT2_PS + 32768 - 4 * 8192) + (sl) * 8192)
#define AT_DMA(BR, tile, slot) do { const bf16_t* kp_; const bf16_t* vp_; \
                if ((BR) == 0) { kp_ = kcb + (size_t)(tile) * 4096; vp_ = kp_ + (size_t)8192 * 64; } \
                else { kp_ = kvb + (size_t)((BR) == 1 ? 2 : 4) * 16 * T * 64 + (size_t)(tile) * 4096; vp_ = kp_ + (size_t)16 * T * 64; } \
                __builtin_amdgcn_global_load_lds((const unsigned*)(kp_ + ksrc), (LAS unsigned*)(lds + ATK(slot) + wave * 1024), 16, 0, 0); \
                __builtin_amdgcn_global_load_lds((const unsigned*)(vp_ + vsrc), (LAS unsigned*)(lds + ATV(slot) + wave * 1024), 16, 0, 0); } while (0)
            int ncv[2];
#pragma unroll
            for (int rb = 0; rb < 2; ++rb) ncv[rb] = (trow[rb] >= 31) ? ((trow[rb] - 31) / 16 + 1) : 0;
            const int nct = (((t0 + 63 - 31) / 16 + 1) + 63) >> 6;
            float mc[2], invc[2];
            const int t_lo = t0 + 8 * wave, ncv_lo = (t_lo >= 31) ? ((t_lo - 31) / 16 + 1) : 0;
            {
                float m1[2] = {NEG, NEG}, l1[2] = {0.f, 0.f};
                const float zero2[2] = {0.f, 0.f};
#define CMP1_TILE(J, SLOT, MASKED) do { const int j = (J); const int SLOT_ = (SLOT); \
                    f32x4 s[2][4]; attn_qk2(lds + AT4_KB + SLOT_ * 8192, qn, fr, g4, zero2, s); \
                    _Pragma("unroll") \
                    for (int rb = 0; rb < 2; ++rb) { \
                        float mx = NEG; \
                    _Pragma("unroll") \
                        for (int c = 0; c < 4; ++c) \
                    _Pragma("unroll") \
                            for (int i = 0; i < 4; ++i) { const int n = 64 * j + 16 * c + 4 * g4 + i; if ((MASKED) && n >= ncv[rb]) s[rb][c][i] = NEG; mx = fmaxf(mx, s[rb][c][i]); } \
                        mx = fmaxf(mx, __shfl_xor(mx, 16)); mx = fmaxf(mx, __shfl_xor(mx, 32)); \
                        const float mn = fmaxf(m1[rb], mx), msafe = (mn == NEG) ? 0.f : mn; \
                        const float alpha = (m1[rb] == NEG) ? 0.f : __builtin_amdgcn_exp2f(m1[rb] - msafe); \
                        float sum = 0.f; \
                    _Pragma("unroll") \
                        for (int c = 0; c < 4; ++c) \
                    _Pragma("unroll") \
                            for (int i = 0; i < 4; ++i) sum += __builtin_amdgcn_exp2f(s[rb][c][i] - msafe); \
                        l1[rb] = l1[rb] * alpha + sum; m1[rb] = mn; \
                    } \
                } while (0)
                if (!cmp_pref) { AT_DMA(0, 0, 0); if (nct > 1) AT_DMA(0, 1, 1); } __syncthreads();
                for (int j0 = 0; j0 < nct; j0 += 2) { const int sb = (j0 & 2);
                    if (j0 + 2 < nct) AT_DMA(0, j0 + 2, sb ^ 2);
                    if (j0 + 3 < nct) AT_DMA(0, j0 + 3, (sb ^ 2) + 1);
                    CMP1_TILE(j0, sb, true); if (j0 + 1 < nct) CMP1_TILE(j0 + 1, sb + 1, true);
                    __syncthreads();
                }
#undef CMP1_TILE
#pragma unroll
                for (int rb = 0; rb < 2; ++rb) { float lc = l1[rb]; lc += __shfl_xor(lc, 16); lc += __shfl_xor(lc, 32); invc[rb] = (lc > 0.f) ? -(((m1[rb] == NEG) ? 0.f : m1[rb]) + __builtin_amdgcn_logf(lc)) : 0.f; mc[rb] = (m1[rb] == NEG) ? 0.f : m1[rb]; }
            }
            {
                AttnRow oc[2];
#pragma unroll
                for (int rb = 0; rb < 2; ++rb) { oc[rb].m = 0.f; oc[rb].ol = (f32x4){0.f, 0.f, 0.f, 0.f};
#pragma unroll
                    for (int dt = 0; dt < 4; ++dt) oc[rb].o[dt] = (f32x4){0.f, 0.f, 0.f, 0.f}; }
                const float cin[2] = {invc[0], invc[1]};
                const unsigned full[2] = {0xffffffffu, 0xffffffffu}; const bool both[2] = {true, true};
#define CMP2_TILE(J, SLOT, MASKED) do { const int j = (J); const int SLOT_ = (SLOT); \
                    f32x4 s[2][4]; attn_qk2(lds + AT4_KB + SLOT_ * 8192, qn, fr, g4, cin, s); \
                    _Pragma("unroll") \
                    for (int rb = 0; rb < 2; ++rb) \
                    _Pragma("unroll") \
                        for (int c = 0; c < 4; ++c) { \
                            f16x4 hs; \
                    _Pragma("unroll") \
                            for (int i = 0; i < 4; ++i) { const int n = 64 * j + 16 * c + 4 * g4 + i; const float p = (!(MASKED) || n < ncv[rb]) ? __builtin_amdgcn_exp2f(s[rb][c][i]) : 0.f; s[rb][c][i] = p; \
                                float h = p; h += DPP_F(h, 0xB1); h += DPP_F(h, 0x4E); hs[i] = (_Float16)h; }        \
                            if ((fr & 3) == 0) *(LAS f16x4*)(ps + (4 * rb + (fr >> 2)) * 512 + 64 * j + 16 * c + 4 * g4) = hs; \
                        } \
                    attn_pv2x(lds + AT4_VB + SLOT_ * 8192, s, vlane, swz, full, both, onesf, oc); \
                } while (0)
                const bool reload = nct > 4;
                if (reload) { AT_DMA(0, 0, 0); AT_DMA(0, 1, 1); __syncthreads(); }
                for (int j0 = 0; j0 < nct; j0 += 2) { const int sb = (j0 & 2);
                    if (reload && j0 + 2 < nct) AT_DMA(0, j0 + 2, sb ^ 2);
                    if (reload && j0 + 3 < nct) AT_DMA(0, j0 + 3, (sb ^ 2) + 1);
                    CMP2_TILE(j0, sb, true); if (j0 + 1 < nct) CMP2_TILE(j0 + 1, sb + 1, true);
                    __syncthreads();
                }
#undef CMP2_TILE
                TROW_PIN();
#pragma unroll
                for (int rb = 0; rb < 2; ++rb) { bf16_t* op = O + TOKROW(rb) * 1024 + head * 64 + 4 * g4; const float g0 = GATE(rb, 0);
#pragma unroll
                    for (int dt = 0; dt < 4; ++dt) { const f32x4 v = oc[rb].o[dt] * g0; u32x2 w; w.x = cvt_pk_bf16(v[0], v[1]); w.y = cvt_pk_bf16(v[2], v[3]); *(u32x2*)(op + 16 * dt) = w; } }
            }
            {
                WSYNC();
                const int tl = lane >> 4, li = lane & 15;
                const int nsel = (cur + 1 < 16) ? (cur + 1) : 16;
#pragma unroll 1
                for (int rnd = 0; rnd < 2; ++rnd) {
                    const LAS _Float16* pst = ps + (4 * rnd + tl) * 512;
                    float v[8];
#pragma unroll
                    for (int k = 0; k < 8; ++k) { const int j = li + 16 * k;
                        float x;
                        if (j > cur) x = NEG;
                        else if (j == 0 || j == cur || j == cur - 1) x = NEG;
                        else { const int n0 = 4 * j; x = (float)pst[n0 - 1] + 2.0f * ((float)pst[n0] + (float)pst[n0 + 1] + (float)pst[n0 + 2]) + (float)pst[n0 + 3]; }
                        v[k] = x; }
                    int vi[8];
#pragma unroll
                    for (int k = 0; k < 8; ++k) vi[k] = __builtin_bit_cast(int, v[k]);
                    unsigned mm[4] = {1u, 0u, 0u, 0u};
                    {
                        const unsigned bc = 1u << (cur & 31); const int wc_ = cur >> 5;
                        mm[0] |= (wc_ == 0) ? bc : 0u; mm[1] |= (wc_ == 1) ? bc : 0u; mm[2] |= (wc_ == 2) ? bc : 0u; mm[3] |= (wc_ == 3) ? bc : 0u;
                        if (cur >= 1) { const unsigned bp = 1u << ((cur - 1) & 31); const int wp_ = (cur - 1) >> 5;
                            mm[0] |= (wp_ == 0) ? bp : 0u; mm[1] |= (wp_ == 1) ? bp : 0u; mm[2] |= (wp_ == 2) ? bp : 0u; mm[3] |= (wp_ == 3) ? bp : 0u; }
                    }
                    const int nforced = (cur >= 2) ? 3 : (cur + 1);
                    for (int it = 0; it < nsel - nforced; ++it) {
                        int bv = max(max(max(vi[0], vi[1]), max(vi[2], vi[3])), max(max(vi[4], vi[5]), max(vi[6], vi[7])));
                        bv = max(bv, DPP_I(bv, 0xB1)); bv = max(bv, DPP_I(bv, 0x4E)); bv = max(bv, DPP_I(bv, 0x141)); bv = max(bv, DPP_I(bv, 0x140));
                        int bi = 255;
#pragma unroll
                        for (int k = 7; k >= 0; --k) bi = (vi[k] == bv) ? (li + 16 * k) : bi;
                        bi = min(bi, DPP_I(bi, 0xB1)); bi = min(bi, DPP_I(bi, 0x4E)); bi = min(bi, DPP_I(bi, 0x141)); bi = min(bi, DPP_I(bi, 0x140));
                        const unsigned bit = 1u << (bi & 31); const int wsel = bi >> 5;
                        mm[0] |= (wsel == 0) ? bit : 0u; mm[1] |= (wsel == 1) ? bit : 0u; mm[2] |= (wsel == 2) ? bit : 0u; mm[3] |= (wsel == 3) ? bit : 0u;
                        if ((bi & 15) == li) {
#pragma unroll
                            for (int k = 0; k < 8; ++k) if ((bi >> 4) == k) vi[k] = (int)0xFF800000;
                        }
                    }
                    if (li == 0) { mskl[(4 * rnd + tl) * 4 + 0] = mm[0]; mskl[(4 * rnd + tl) * 4 + 1] = mm[1]; mskl[(4 * rnd + tl) * 4 + 2] = mm[2]; mskl[(4 * rnd + tl) * 4 + 3] = mm[3]; }
                }
                WSYNC();
            }
            bf16x8 qr[2][2];
            TROW_PIN();
#pragma unroll
            for (int rb = 0; rb < 2; ++rb)
#pragma unroll
                for (int ks = 0; ks < 2; ++ks) qr[rb][ks] = *(const bf16x8*)(QR + TOKROW(rb) * 1024 + head * 64 + 32 * ks + 8 * g4);
            bool nomax_slc, nomax_win;
            {
                float qq = 0.f;
#pragma unroll
                for (int rb = 0; rb < 2; ++rb) { float q2 = 0.f;
#pragma unroll
                    for (int ks = 0; ks < 2; ++ks)
#pragma unroll
                        for (int j = 0; j < 8; ++j) { const float x = bf2f((bf16_t)qr[rb][ks][j]); q2 += x * x; }
                    q2 += __shfl_xor(q2, 16); q2 += __shfl_xor(q2, 32); qq = fmaxf(qq, q2); }
                qq = wave_max(qq);
                const float* tn = (const float*)(a.ws + WS_MISC + TN2_OFF) + bg * 128;
                const int jt0w = (t0 >= 511) ? ((t0 - 511) >> 6) : 0;
                float ts = 0.f, tw = 0.f;
#pragma unroll
                for (int h2 = 0; h2 < 2; ++h2) { const int tl_ = lane + 64 * h2; if (tl_ <= cur) { ts = fmaxf(ts, tn[tl_]); if (tl_ >= jt0w) tw = fmaxf(tw, tn[2048 + tl_]); } }
                ts = wave_max(ts); tw = wave_max(tw);
                nomax_slc = __builtin_amdgcn_readfirstlane((qq * ts <= 3500.0f) ? 1 : 0) != 0;
                nomax_win = __builtin_amdgcn_readfirstlane((qq * tw <= 3500.0f) ? 1 : 0) != 0;
            }
            {
                AttnRow ss[2];
#pragma unroll
                for (int rb = 0; rb < 2; ++rb) { ss[rb].m = 0.f; ss[rb].ol = (f32x4){0.f, 0.f, 0.f, 0.f};
#pragma unroll
                    for (int dt = 0; dt < 4; ++dt) ss[rb].o[dt] = (f32x4){0.f, 0.f, 0.f, 0.f}; }
                const int nt_ = cur + 1;
                bool refmoved = false;
#define SLC_PRE(J) const int j_ = (J); bool en[2], act[2]; unsigned enm[2]; \
                    _Pragma("unroll") for (int rb = 0; rb < 2; ++rb) { const unsigned mw = mwg[rb]; \
                        en[rb] = (mw >> (j_ & 31)) & 1u; act[rb] = __any(en[rb]); enm[rb] = en[rb] ? 0xffffffffu : 0u; } const int lo2[2] = {0, 0};
#define SLC_TILE(J, SLOT) do { SLC_PRE(J) \
                    if (act[0] || act[1]) { f32x4 s[2][4]; \
                        if (refmoved) { const float cin[2] = {-ss[0].m, -ss[1].m}; attn_qk2(lds + ATK(SLOT), qr, fr, g4, cin, s); } \
                        else attn_qk2z(lds + ATK(SLOT), qr, fr, g4, s); \
                        refmoved |= attn_step2x(lds + ATV(SLOT), s, ss, 64 * j_, g4, lo2, trow, en, enm, j_ == cur, vlane, swz, onesf); } } while (0)
#define SLC_TILE_NM(J, SLOT) do { SLC_PRE(J) \
                    if (act[0] || act[1]) { f32x4 s[2][4]; const float cm_[2] = {en[0] ? 0.f : -1e30f, en[1] ? 0.f : -1e30f}; attn_qk2m(lds + ATK(SLOT), qr, fr, g4, cm_, s); \
                        const unsigned fullm_[2] = {0xffffffffu, 0xffffffffu}; \
                        attn_step2x_nomax(lds + ATV(SLOT), s, ss, 64 * j_, g4, lo2, trow, fullm_, j_ == cur, vlane, swz, onesf); } } while (0)
#pragma unroll
                for (int i = 0; i < 4; ++i) if (i < nt_) AT_DMA(1, i, i);
                __syncthreads();
#define SLC_LOOP(TILE) for (int j0 = 0; j0 < nt_; j0 += 4) { const int sb = (j0 & 4); \
                    const unsigned mwg[2] = {mskl[(fr >> 2) * 4 + (j0 >> 5)], mskl[(4 + (fr >> 2)) * 4 + (j0 >> 5)]};       \
                    _Pragma("unroll") for (int i = 0; i < 4; ++i) if (j0 + 4 + i < nt_) AT_DMA(1, j0 + 4 + i, (sb ^ 4) + i); \
                    TILE(j0, sb); if (j0 + 1 < nt_) TILE(j0 + 1, sb + 1); if (j0 + 2 < nt_) TILE(j0 + 2, sb + 2); if (j0 + 3 < nt_) TILE(j0 + 3, sb + 3); \
                    __syncthreads(); }
                if (nomax_slc) { SLC_LOOP(SLC_TILE_NM) } else { SLC_LOOP(SLC_TILE) }
#undef SLC_LOOP
#undef SLC_TILE_NM
#undef SLC_PRE
#undef SLC_TILE
                TROW_PIN();
#pragma unroll
                for (int rb = 0; rb < 2; ++rb) { const float l = __shfl(ss[rb].ol[0], fr); const float sc1 = (l > 0.f) ? GATE(rb, 1) / l : 0.f;
                    bf16_t* op = O + TOKROW(rb) * 1024 + head * 64 + 4 * g4;
#pragma unroll
                    for (int dt = 0; dt < 4; ++dt) { const u32x2 pv = *(const u32x2*)(op + 16 * dt); f32x4 v = ss[rb].o[dt] * sc1;
                        v[0] += __uint_as_float(pv.x << 16); v[1] += __uint_as_float(pv.x & 0xffff0000u); v[2] += __uint_as_float(pv.y << 16); v[3] += __uint_as_float(pv.y & 0xffff0000u);
                        u32x2 w; w.x = cvt_pk_bf16(v[0], v[1]); w.y = cvt_pk_bf16(v[2], v[3]); *(u32x2*)(op + 16 * dt) = w; } }
            }
            {
                AttnRow sw[2];
#pragma unroll
                for (int rb = 0; rb < 2; ++rb) { sw[rb].m = 0.f; sw[rb].ol = (f32x4){0.f, 0.f, 0.f, 0.f};
#pragma unroll
                    for (int dt = 0; dt < 4; ++dt) sw[rb].o[dt] = (f32x4){0.f, 0.f, 0.f, 0.f}; }
                const int jt0 = (t0 >= 511) ? ((t0 - 511) >> 6) : 0;
                const int nt_ = cur - jt0 + 1;
                const unsigned full[2] = {0xffffffffu, 0xffffffffu}; const bool both[2] = {true, true};
                bool refmoved = false;
#define WIN_PRE(JJ) const int j = jt0 + (JJ); f32x4 s[2][4]; const bool edge = (j == cur) || (64 * j < t0 + 63 - 511); const int lo2[2] = {trow[0] - 511, trow[1] - 511};
#define WIN_TILE(JJ, SLOT) do { WIN_PRE(JJ) \
                    if (refmoved) { const float cin[2] = {-sw[0].m, -sw[1].m}; attn_qk2(lds + AT4_KB + (SLOT) * 8192, qr, fr, g4, cin, s); } \
                    else attn_qk2z(lds + AT4_KB + (SLOT) * 8192, qr, fr, g4, s); \
                    refmoved |= attn_step2x(lds + AT4_VB + (SLOT) * 8192, s, sw, 64 * j, g4, lo2, trow, both, full, edge, vlane, swz, onesf); } while (0)
#define WIN_TILE_NM(JJ, SLOT) do { WIN_PRE(JJ) attn_qk2z(lds + AT4_KB + (SLOT) * 8192, qr, fr, g4, s); \
                    attn_step2x_nomax(lds + AT4_VB + (SLOT) * 8192, s, sw, 64 * j, g4, lo2, trow, full, edge, vlane, swz, onesf); } while (0)
                AT_DMA(2, jt0, 0); if (nt_ > 1) AT_DMA(2, jt0 + 1, 1); __syncthreads();
#define WIN_LOOP(TILE) for (int j0 = 0; j0 < nt_; j0 += 2) { const int sb = (j0 & 2); \
                    if (j0 + 2 < nt_) AT_DMA(2, jt0 + j0 + 2, sb ^ 2); \
                    if (j0 + 3 < nt_) AT_DMA(2, jt0 + j0 + 3, (sb ^ 2) + 1); \
                    TILE(j0, sb); if (j0 + 1 < nt_) TILE(j0 + 1, sb + 1); \
                    __syncthreads(); }
                if (nomax_win) { WIN_LOOP(WIN_TILE_NM) } else { WIN_LOOP(WIN_TILE) }
#undef WIN_LOOP
#undef WIN_TILE_NM
#undef WIN_PRE
#undef WIN_TILE
                TROW_PIN();
#pragma unroll
                for (int rb = 0; rb < 2; ++rb) { const float l = __shfl(sw[rb].ol[0], fr); const float sc2 = (l > 0.f) ? GATE(rb, 2) / l : 0.f;
                    bf16_t* op = O + TOKROW(rb) * 1024 + head * 64 + 4 * g4;
#pragma unroll
                    for (int dt = 0; dt < 4; ++dt) { const u32x2 pv = *(const u32x2*)(op + 16 * dt); f32x4 v = sw[rb].o[dt] * sc2;
                        v[0] += __uint_as_float(pv.x << 16); v[1] += __uint_as_float(pv.x & 0xffff0000u); v[2] += __uint_as_float(pv.y << 16); v[3] += __uint_as_float(pv.y & 0xffff0000u);
                        u32x2 w; w.x = cvt_pk_bf16(v[0], v[1]); w.y = cvt_pk_bf16(v[2], v[3]); *(u32x2*)(op + 16 * dt) = w; } }
            }
#undef AT_DMA
#undef ATK
#undef ATV
#undef TROW_PIN
#undef TOKROW
#undef GATE
            {
                const int npr = half ? pr + (int)gridDim.x : pr, nhalf = half ^ 1;
                cmp_pref = npr < 1024;
                if (cmp_pref) { const int nbg = npr >> 6, ncc = nhalf ? (127 - (npr & 63)) : (npr & 63);
                    const int nnct = (((ncc * 64 + 63 - 31) / 16 + 1) + 63) >> 6;
                    const bf16_t* nk = KC + (size_t)nbg * 512 * 64;
                    __builtin_amdgcn_global_load_lds((const unsigned*)(nk + ksrc), (LAS unsigned*)(lds + AT4_KB + wave * 1024), 16, 0, 0);
                    __builtin_amdgcn_global_load_lds((const unsigned*)(nk + (size_t)8192 * 64 + vsrc), (LAS unsigned*)(lds + AT4_VB + wave * 1024), 16, 0, 0);
                    if (nnct > 1) {
                        __builtin_amdgcn_global_load_lds((const unsigned*)(nk + 4096 + ksrc), (LAS unsigned*)(lds + AT4_KB + 8192 + wave * 1024), 16, 0, 0);
                        __builtin_amdgcn_global_load_lds((const unsigned*)(nk + (size_t)8192 * 64 + 4096 + vsrc), (LAS unsigned*)(lds + AT4_VB + 8192 + wave * 1024), 16, 0, 0); } } }
            cvt1_run(a, cvt_next, cvt_stride, 2, cvt_scr, lane);
        }
    }
    cvt1_run(a, cvt_next, cvt_stride, 1 << 20, cvt_scr, lane);
}

__device__ __forceinline__ void unpack8(const u32x4 w, float (&f)[8]) {
    f[0] = __uint_as_float(w.x << 16); f[1] = __uint_as_float(w.x & 0xffff0000u); f[2] = __uint_as_float(w.y << 16); f[3] = __uint_as_float(w.y & 0xffff0000u);
    f[4] = __uint_as_float(w.z << 16); f[5] = __uint_as_float(w.z & 0xffff0000u); f[6] = __uint_as_float(w.w << 16); f[7] = __uint_as_float(w.w & 0xffff0000u);
}
__device__ __forceinline__ void ph_convpool_fast(const Args& a, LAS unsigned char* lds) {
    const bf16_t* H0 = (const bf16_t*)(a.ws + WS_H0);
    bf16_t* CAT = (bf16_t*)(a.ws + WS_CAT);
    const float* cw = a.in[4]; const float* cb = a.in[5]; const float* lg = a.in[6]; const float* lb = a.in[7];
    const int tid = threadIdx.x, lane = tid & 63, wave = tid >> 6, ch = lane * 8;
    constexpr int VT_OFF = 0, UT_OFF = 62 * 1024, CW_OFF = UT_OFF + 47 * 1024;
    for (int i = tid; i < 31 * 64; i += 512) { const int k = i >> 6, c8 = (i & 63) * 8;
        const f32x4 w0 = *(const f32x4*)(cw + k * 512 + c8), w1 = *(const f32x4*)(cw + k * 512 + c8 + 4);
        u32x4 o; o.x = pk2(w0[0], w0[1]); o.y = pk2(w0[2], w0[3]); o.z = pk2(w1[0], w1[1]); o.w = pk2(w1[2], w1[3]);
        *(LAS u32x4*)(lds + CW_OFF + k * 1024 + c8 * 2) = o; }
    float bias[8], gam[8], bet[8];
#pragma unroll
    for (int j = 0; j < 8; ++j) { bias[j] = cb[ch + j]; gam[j] = lg[ch + j]; bet[j] = lb[ch + j]; }
    for (int tile = blockIdx.x; tile < M / 32; tile += gridDim.x) {
        const int tok0 = tile * 32, t0 = tok0 & (T - 1);
        __syncthreads();
        for (int i = tid; i < 62 * 64; i += 512) { const int r = i >> 6, c8 = (i & 63) * 8; const int tt = t0 - 30 + r;
            u32x4 v = (u32x4){0u, 0u, 0u, 0u}; if (tt >= 0) v = *(const u32x4*)(H0 + (size_t)(tok0 - 30 + r) * 1024 + 512 + c8);
            *(LAS u32x4*)(lds + VT_OFF + r * 1024 + c8 * 2) = v; }
        for (int i = tid; i < 47 * 64; i += 512) { const int r = i >> 6, c8 = (i & 63) * 8; const int tt = t0 - 15 + r;
            u32x4 v = (u32x4){0u, 0u, 0u, 0u}; if (tt >= 0) v = *(const u32x4*)(H0 + (size_t)(tok0 - 15 + r) * 1024 + c8);
            *(LAS u32x4*)(lds + UT_OFF + r * 1024 + c8 * 2) = v; }
        __syncthreads();
        float acc[4][8];
#pragma unroll
        for (int j = 0; j < 4; ++j)
#pragma unroll
            for (int c = 0; c < 8; ++c) acc[j][c] = bias[c];
#pragma unroll 1
        for (int k = 0; k < 31; ++k) {
            float w[8]; unpack8(*(const LAS u32x4*)(lds + CW_OFF + k * 1024 + ch * 2), w);
#pragma unroll
            for (int j = 0; j < 4; ++j) { float v[8]; unpack8(*(const LAS u32x4*)(lds + VT_OFF + (4 * wave + j + k) * 1024 + ch * 2), v);
#pragma unroll
                for (int c = 0; c < 8; ++c) acc[j][c] += w[c] * v[c]; }
        }
        const int wnd = 2 << (lane >> 4);
#pragma unroll
        for (int j = 0; j < 4; ++j) {
            const int tl = 4 * wave + j, t = t0 + tl; const size_t tok = (size_t)tok0 + tl;
            const int cnt = (t + 1 < wnd) ? (t + 1) : wnd;
            float s[8], self[8];
            unpack8(*(const LAS u32x4*)(lds + UT_OFF + (15 + tl) * 1024 + ch * 2), self);
#pragma unroll
            for (int c = 0; c < 8; ++c) s[c] = self[c];
            for (int k = 1; k < cnt; ++k) { float v[8]; unpack8(*(const LAS u32x4*)(lds + UT_OFF + (15 + tl - k) * 1024 + ch * 2), v);
#pragma unroll
                for (int c = 0; c < 8; ++c) s[c] += v[c]; }
            const float inv = 1.0f / (float)cnt;
            u32x4 o; o.x = pk2(s[0] * inv - self[0], s[1] * inv - self[1]); o.y = pk2(s[2] * inv - self[2], s[3] * inv - self[3]);
            o.z = pk2(s[4] * inv - self[4], s[5] * inv - self[5]); o.w = pk2(s[6] * inv - self[6], s[7] * inv - self[7]);
            *(u32x4*)(CAT + tok * 1024 + ch) = o;
            float sm = 0.f;
#pragma unroll
            for (int c = 0; c < 8; ++c) sm += acc[j][c];
            const float mean = wave_sum(sm) * (1.0f / 512.0f);
            float sq = 0.f;
#pragma unroll
            for (int c = 0; c < 8; ++c) { acc[j][c] -= mean; sq += acc[j][c] * acc[j][c]; }
            const float rstd = rsqrtf(wave_sum(sq) * (1.0f / 512.0f) + LN_EPS);
            float y[8];
#pragma unroll
            for (int c = 0; c < 8; ++c) { const float z = acc[j][c] * rstd * gam[c] + bet[c]; y[c] = z * sigmoidf_(z); }
            u32x4 o2; o2.x = pk2(y[0], y[1]); o2.y = pk2(y[2], y[3]); o2.z = pk2(y[4], y[5]); o2.w = pk2(y[6], y[7]);
            *(u32x4*)(CAT + tok * 1024 + 512 + ch) = o2;
        }
    }
}


__device__ __forceinline__ void ph_route_fast(const float* LOG, const float* bias, unsigned* gcnt, int2* list, unsigned char* ldsg) {
    unsigned* hist = (unsigned*)ldsg; unsigned* base = hist + 256; u32x2* sel = (u32x2*)(ldsg + 2048);
    const int tid = threadIdx.x, lane = tid & 63, wave = tid >> 6;
    const float NEG = -INFINITY;
    const float4 bb = *(const float4*)(bias + lane * 4);
    for (int chunk = blockIdx.x; chunk < M / 128; chunk += gridDim.x) {
        __syncthreads();
        if (tid < 256) hist[tid] = 0u;
        __syncthreads();
        for (int i = 0; i < 16; ++i) {
            const int tl = wave * 16 + i, tok = chunk * 128 + tl;
            const float4 lg = *(const float4*)(LOG + (size_t)tok * 256 + lane * 4);
            const float s0 = sigmoidf_(lg.x), s1 = sigmoidf_(lg.y), s2 = sigmoidf_(lg.z), s3 = sigmoidf_(lg.w);
            float v0 = s0 + bb.x, v1 = s1 + bb.y, v2 = s2 + bb.z, v3 = s3 + bb.w;
            float m1 = fmaxf(v0, v1), m2 = fminf(v0, v1);
            { const float hi = fmaxf(v2, v3), lo = fminf(v2, v3); const float n1 = fmaxf(m1, hi); const float n2 = fmaxf(fminf(m1, hi), fmaxf(m2, lo)); m1 = n1; m2 = n2; }
#pragma unroll
            for (int o = 1; o < 8; o <<= 1) { const float a1 = __shfl_xor(m1, o), a2 = __shfl_xor(m2, o); const float n1 = fmaxf(m1, a1), n2 = fmaxf(fminf(m1, a1), fmaxf(m2, a2)); m1 = n1; m2 = n2; }
            const float gs = m1 + m2; const int mygrp = lane >> 3;
            int rank = 0;
#pragma unroll
            for (int g2 = 0; g2 < 8; ++g2) { const float og = __shfl(gs, g2 * 8); rank += (og > gs || (og == gs && g2 < mygrp)) ? 1 : 0; }
            if (rank >= 4) { v0 = NEG; v1 = NEG; v2 = NEG; v3 = NEG; }
            int my_e = 0; float my_s = 0.f;
#pragma unroll
            for (int it = 0; it < 8; ++it) {
                float bv = v0; int bj = 0;
                if (v1 > bv) { bv = v1; bj = 1; }
                if (v2 > bv) { bv = v2; bj = 2; }
                if (v3 > bv) { bv = v3; bj = 3; }
                int bi = lane * 4 + bj;
#pragma unroll
                for (int o = 1; o < 64; o <<= 1) { const float ov = __shfl_xor(bv, o); const int oi = __shfl_xor(bi, o); if (ov > bv || (ov == bv && oi < bi)) { bv = ov; bi = oi; } }
                const int jj = bi & 3, ol = bi >> 2;
                const float mys = (jj == 0) ? s0 : (jj == 1) ? s1 : (jj == 2) ? s2 : s3;
                const float wsc = __shfl(mys, ol);
                if (lane == ol) { if (jj == 0) v0 = NEG; else if (jj == 1) v1 = NEG; else if (jj == 2) v2 = NEG; else v3 = NEG; }
                if (lane == it) { my_e = bi; my_s = wsc; }
            }
            const float ssum = wave_sum(lane < 8 ? my_s : 0.f);
            if (lane < 8) { const unsigned rk = atomicAdd(&hist[my_e], 1u); u32x2 en; en.x = (unsigned)my_e | (rk << 16); en.y = __float_as_uint(my_s / ssum * 2.5f); sel[tl * 8 + lane] = en; }
        }
        __syncthreads();
        if (tid < 256) { const unsigned h = hist[tid]; base[tid] = h ? atomicAdd(&gcnt[tid], h) : 0u; }
        __syncthreads();
#pragma unroll
        for (int rep = 0; rep < 2; ++rep) { const int idx = tid + rep * 512, tok = chunk * 128 + (idx >> 3), k = idx & 7;
            const u32x2 en = sel[idx]; const unsigned e = en.x & 0xffffu, pos = base[e] + (en.x >> 16);
            list[(size_t)e * LISTCAP + pos] = make_int2(tok * 10 + k, (int)en.y); }
    }
}

__global__ void __launch_bounds__(512, 2) fwd_kernel(Args a) {
    extern __shared__ __attribute__((aligned(16))) unsigned char lds[];
    volatile LAS unsigned* MISC = (volatile LAS unsigned*)((LAS unsigned char*)lds + (LDS_BYTES - 64));
    if (threadIdx.x < 16) MISC[threadIdx.x] = 0u;
    __syncthreads();
    unsigned* ctl = (unsigned*)(a.ws + WS_CTL);
#if MK_ONE_LAUNCH
    (void)xcd_barrier_post(ctl + CW_BAR, MISC + 8);
#define SEAM() do { XcdBarrier b_; b_.bar = (unsigned*)(a.ws + WS_CTL) + CW_BAR; b_.x = xb_xcc_id(); b_.st = MISC + 8; xcd_barrier(b_); } while (0)
#else
#define SEAM() do {} while (0)
#endif
    const int lo = a.ph_lo, hi = a.ph_hi;
#define IN(k) (lo <= (k) && (k) < hi)
#define BOTH(k) (IN(k) && (k) + 1 < hi)
#define X1 ((bf16_t*)(a.ws + WS_X1))
#define X2 ((bf16_t*)(a.ws + WS_X2))
#define LOG ((float*)(a.ws + WS_LOG))

    LAS unsigned char* L = (LAS unsigned char*)lds;
#define LIST ((int2*)(a.ws + WS_LIST))
#ifndef PROBE_DUP_MASK
#define PROBE_DUP_MASK 0u
#endif
#define RUN(k, ...) if (IN(k)) { { __VA_ARGS__ } if ((PROBE_DUP_MASK >> (k)) & 1u) { __syncthreads(); { __VA_ARGS__ } } if (BOTH(k)) SEAM(); }
    RUN(0, ph_prologue(a, L);)
    RUN(1, pg8::DenseSched S; S.init((const bf16_t*)(a.ws + WS_XA), D, (const bf16_t*)(a.ws + WS_WIN0), D, M, 1536);
           EpiInproj0 E{(bf16_t*)(a.ws + WS_H0)};
           pg8::gemm_phase<EpiInproj0, pg8::DenseSched, true>(L, D, 128u, S, E);)
    RUN(2, ph_convpool_fast(a, L);)
    RUN(4, pg8::DenseSched S; S.init((const bf16_t*)(a.ws + WS_CAT), D, (const bf16_t*)(a.ws + WS_WOUT0), D, M, D);
           EpiRes E{a.in[0], nullptr, (bf16_t*)(a.ws + WS_Y)};
           pg8::gemm_phase<EpiRes, pg8::DenseSched, true>(L, D, 128u, S, E);)
    RUN(5, ph_ln((const bf16_t*)(a.ws + WS_Y), a.in[17], a.in[18], X1, (unsigned char*)(a.ws + WS_X8));)
#define MOE_LAYER(P, LAYER, XIN, XOUT, OUTF) \
    RUN(P, pg8::DenseSched S; S.init(XIN, D, (const bf16_t*)(a.ws + WS_WR) + (size_t)(LAYER) * NE * D, D, M, NE); \
           EpiLogits E{LOG}; pg8::gemm_phase<EpiLogits, pg8::DenseSched, true>(L, D, 128u, S, E);) \
    if (IN(P + 1)) { ph_route_fast(LOG, a.in[22] + (LAYER) * NE, ctl + CW_CNT + (LAYER) * 256, LIST, lds); if (BOTH(P + 1)) SEAM(); } \
    RUN(P + 2, const int R = moe_setup256(ctl + CW_CNT + (LAYER) * 256, L); \
            MoeGuSched S{(const char*)(a.ws + WS_X8), (const char*)(a.ws + WS_WGU) + (size_t)(LAYER) * 257 * 512 * 1024, LIST, L, R, (R + 128) * 2, (int)gridDim.x, (int)blockIdx.x}; \
            S.prepare(); EpiGateUp E{(unsigned char*)(a.ws + WS_HID)}; pg8::gemm_phase<EpiGateUp, MoeGuSched, true, true>(L, D / 2, 128u, S, E);) \
    RUN(P + 3, const int R = moe_setup256(ctl + CW_CNT + (LAYER) * 256, L); \
            MoeDownSched S{(const char*)(a.ws + WS_HID), (const char*)(a.ws + WS_WD) + (size_t)(LAYER) * 257 * 1024 * 256, LIST, L, R, R + 128, (int)gridDim.x, (int)blockIdx.x}; \
            S.prepare(); EpiDown E{(unsigned char*)(a.ws + WS_YB), L}; pg8::gemm_phase<EpiDown, MoeDownSched, true, true>(L, FF / 2, 128u, S, E);) \
    RUN(P + 4, ph_combine(a, XIN, a.in[19] + (LAYER) * D, a.in[20] + (LAYER) * D, XOUT, OUTF);)
    MOE_LAYER(6, 0, X1, X2, nullptr)
    RUN(11, pg8::DenseSched S; S.init(X2, D, (const bf16_t*)(a.ws + WS_WINN), D, M, HNW);
            EpiInprojN E{(bf16_t*)(a.ws + WS_HN), (bf16_t*)(a.ws + WS_QR), (bf16_t*)(a.ws + WS_KV6), (float*)(a.ws + WS_GATES), (const float*)(a.ws + WS_MISC) + 1024};
            pg8::gemm_phase<EpiInprojN, pg8::DenseSched, true>(L, D, 128u, S, E);)
    RUN(13, Cmp1Sched S{(const char*)(a.ws + WS_KV6), (const char*)(a.ws + WS_CW1), (int)gridDim.x, (int)blockIdx.x};
            EpiCmp1 E{(bf16_t*)(a.ws + WS_CH1), (const float*)(a.ws + WS_MISC)};
            pg8::gemm_phase<EpiCmp1, Cmp1Sched, true>(L, 2048, 128u, S, E); ph_knorm(a);)
    RUN(14, ph_cmp2(a, lds);)
    RUN(15, ph_attn_fast2(a, L);)
    RUN(16, pg8::DenseSched S; S.init((const bf16_t*)(a.ws + WS_O), D, (const bf16_t*)(a.ws + WS_WOUTN), D, M, D);
            EpiRes E{nullptr, X2, (bf16_t*)(a.ws + WS_Y2)};
            pg8::gemm_phase<EpiRes, pg8::DenseSched, true>(L, D, 128u, S, E);)
    RUN(17, ph_ln((const bf16_t*)(a.ws + WS_Y2), a.in[17] + D, a.in[18] + D, X1, (unsigned char*)(a.ws + WS_X8));)
    MOE_LAYER(18, 1, X1, (bf16_t*)nullptr, a.out)
}

extern "C" void kernel_launch(void* const* d_in, const int* in_sizes, int n_in, void* d_out, int out_size, void* d_ws, size_t ws_size, hipStream_t stream) {
    static int grid = 0;
    if (grid == 0) {
        if (n_in != 29 || out_size != M * D || ws_size < WS_END) { fprintf(stderr, "kernel_launch: unexpected problem (n_in %d out %d ws %zu)\n", n_in, out_size, ws_size); grid = -1; return; }
        int dev = 0, cus = 0;
        if (hipGetDevice(&dev) != hipSuccess || hipDeviceGetAttribute(&cus, hipDeviceAttributeMultiprocessorCount, dev) != hipSuccess) { grid = -1; return; }
        if (hipFuncSetAttribute((const void*)fwd_kernel, hipFuncAttributeMaxDynamicSharedMemorySize, LDS_BYTES) != hipSuccess) { grid = -1; return; }
        int per_cu = 0;
        (void)hipOccupancyMaxActiveBlocksPerMultiprocessor(&per_cu, (const void*)fwd_kernel, 512, LDS_BYTES);
        (void)hipGetLastError();
        grid = cus;
    }
    if (grid < 0) return;
    (void)hipMemsetAsync((char*)d_ws + WS_CTL, 0, CTL_BYTES, stream);
    Args a{};
    for (int i = 0; i < 29; ++i) a.in[i] = (const float*)d_in[i];
    a.out = (float*)d_out; a.ws = (unsigned char*)d_ws;
    for (int i = 0; i < 8; ++i) a.inv_freq[i] = powf(500000.0f, -(float)(2 * i) / 16.0f);
#if MK_ONE_LAUNCH
    a.ph_lo = 0; a.ph_hi = NPHASE;
    hipLaunchKernelGGL(fwd_kernel, dim3(grid), dim3(512), LDS_BYTES, stream, a);
#else
    for (int p = 0; p < NPHASE; ++p) { a.ph_lo = p; a.ph_hi = p + 1; hipLaunchKernelGGL(fwd_kernel, dim3(grid), dim3(512), LDS_BYTES, stream, a); }
#endif
}
```

```cpp
#include <hip/hip_runtime.h>
#include <cstdint>
#include <cstdio>
#include <cmath>

#ifndef MK_ONE_LAUNCH
#define MK_ONE_LAUNCH 1
#endif

#define LAS __attribute__((address_space(3)))
typedef unsigned short bf16_t;
typedef short bf16x8 __attribute__((ext_vector_type(8)));
typedef float f32x4 __attribute__((ext_vector_type(4)));
typedef unsigned u32x2 __attribute__((ext_vector_type(2)));
typedef unsigned u32x4 __attribute__((ext_vector_type(4)));

constexpr int NB = 4, T = 8192, D = 1024, M = NB * T;
constexpr int NE = 256, TOPK = 8, FF = 256;
constexpr int HNW = 2816;
constexpr int LISTCAP = 32768;
constexpr float ALPHA = 1.4142135623730951f;
constexpr float LN_EPS = 1e-5f;
constexpr float QSCALE = 0.125f * 1.4426950408889634f;
constexpr int YB_NSLOT = 9;
constexpr float YB_SCALE = 16.0f;
constexpr int NPHASE = 23;

constexpr size_t MiB = 1u << 20;
constexpr size_t WS_CTL = 0, CTL_BYTES = 1 * MiB;
constexpr size_t WS_X1 = 1 * MiB;
constexpr size_t WS_X2 = WS_X1 + 64 * MiB;
constexpr size_t WS_LOG = WS_X2 + 64 * MiB;
constexpr size_t WS_LIST = WS_LOG + 32 * MiB;
constexpr size_t WS_WTS = WS_LIST + 64 * MiB;
constexpr size_t WS_HID = WS_WTS + 2 * MiB;
constexpr size_t WS_YB = WS_HID + 184 * MiB;
constexpr size_t WS_END_NAIVE = WS_YB + 576 * MiB;
constexpr size_t WS_WIN0 = WS_END_NAIVE;
constexpr size_t WS_WOUT0 = WS_WIN0 + 3 * MiB;
constexpr size_t WS_WINN = WS_WOUT0 + 2 * MiB;
constexpr size_t WS_WOUTN = WS_WINN + 6 * MiB;
constexpr size_t WS_WR = WS_WOUTN + 2 * MiB;
constexpr size_t WS_CW1 = WS_WR + 1 * MiB;
constexpr size_t WS_MISC = WS_CW1 + 2 * MiB;
constexpr size_t WS_WGU = WS_MISC + 1 * MiB;
constexpr size_t WS_X8 = WS_WGU + 257 * MiB;
constexpr float X8_SCALE = 8.0f, W8_SCALE = 64.0f, H8_SCALE = 16.0f;
constexpr size_t WS_WD = WS_WGU + 514 * MiB;
constexpr size_t WS_END = WS_WD + 257 * MiB;
constexpr size_t WS_XA = WS_X2;
constexpr size_t WS_H0 = WS_YB;
constexpr size_t WS_PM = WS_H0 + 64 * MiB;
constexpr size_t WS_CAT = WS_PM + 32 * MiB;
constexpr size_t WS_Y = WS_CAT + 64 * MiB;
constexpr size_t WS_HN = WS_YB;
constexpr size_t WS_KV6 = WS_HN + 64 * MiB;
constexpr size_t WS_QR = WS_HN + 176 * MiB;
constexpr size_t WS_GATES = WS_QR + 64 * MiB;
constexpr size_t WS_CH1 = WS_GATES + 8 * MiB;
constexpr size_t WS_KC = WS_CH1 + 4 * MiB;
constexpr size_t WS_O = WS_KC + 2 * MiB;
constexpr size_t WS_Y2 = WS_O + 64 * MiB;
static_assert(WS_Y2 + 64 * MiB <= WS_END_NAIVE, "overlay");
static_assert(WS_Y + 64 * MiB <= WS_END_NAIVE, "overlay");

constexpr int CW_CNT = 64;
constexpr int CW_BAR = 4096;

constexpr int LDS_BYTES = 163840;

__device__ __forceinline__ float bf2f(bf16_t h) { return __uint_as_float(((unsigned)h) << 16); }
__device__ __forceinline__ bf16_t f2bf(float f) { unsigned u = __float_as_uint(f); return (bf16_t)((u + 0x7fffu + ((u >> 16) & 1u)) >> 16); }
__device__ __forceinline__ unsigned pk2(float lo, float hi) { return (unsigned)f2bf(lo) | ((unsigned)f2bf(hi) << 16); }
#define WR_DPP(x, ctrl) __builtin_bit_cast(float, __builtin_amdgcn_update_dpp(__builtin_bit_cast(int, (float)(x)), __builtin_bit_cast(int, (float)(x)), (ctrl), 0xF, 0xF, true))
#define WR_ROW(x, r) __builtin_bit_cast(float, __builtin_amdgcn_readlane(__builtin_bit_cast(int, (float)(x)), 16 * (r)))
__device__ __forceinline__ float wave_sum(float v) {
    v += WR_DPP(v, 0xB1); v += WR_DPP(v, 0x4E); v += WR_DPP(v, 0x141); v += WR_DPP(v, 0x140);
    return (WR_ROW(v, 0) + WR_ROW(v, 1)) + (WR_ROW(v, 2) + WR_ROW(v, 3));
}
__device__ __forceinline__ float wave_max(float v) {
    v = fmaxf(v, WR_DPP(v, 0xB1)); v = fmaxf(v, WR_DPP(v, 0x4E)); v = fmaxf(v, WR_DPP(v, 0x141)); v = fmaxf(v, WR_DPP(v, 0x140));
    return fmaxf(fmaxf(WR_ROW(v, 0), WR_ROW(v, 1)), fmaxf(WR_ROW(v, 2), WR_ROW(v, 3)));
}
__device__ __forceinline__ float sigmoidf_(float x) { return 1.0f / (1.0f + __expf(-x)); }
__device__ __forceinline__ float gelu_tanh(float x) {
    const float u = 0.7978845608028654f * (x + 0.044715f * x * x * x);
    const float e = __expf(2.0f * u);
    const float th = 1.0f - 2.0f / (e + 1.0f);
    return 0.5f * x * (1.0f + th);
}
__device__ __forceinline__ bf16x8 cvt8(const float* p) {
    const float4 a = *(const float4*)p, b = *(const float4*)(p + 4);
    bf16x8 r;
    r[0] = (short)f2bf(a.x); r[1] = (short)f2bf(a.y); r[2] = (short)f2bf(a.z); r[3] = (short)f2bf(a.w);
    r[4] = (short)f2bf(b.x); r[5] = (short)f2bf(b.y); r[6] = (short)f2bf(b.z); r[7] = (short)f2bf(b.w);
    return r;
}
__device__ __forceinline__ bf16x8 colk8(const float* W, int N, int k, int col) {
    bf16x8 r;
#pragma unroll
    for (int j = 0; j < 8; ++j) r[j] = (short)f2bf(W[(size_t)(k + j) * N + col]);
    return r;
}
__device__ __forceinline__ bf16x8 zero8() { return (bf16x8){0, 0, 0, 0, 0, 0, 0, 0}; }
#define WSYNC() asm volatile("s_waitcnt lgkmcnt(0)" ::: "memory")

#define XB_TMO      128
#define XB_XCNT(j)  (256  + 64 * (j))
#define XB_XSUB(j)  (1280 + 64 * (j))
#define XB_XGEN(j)  (2304 + 64 * (j))
#define XB_TOP      3328
#define XB_TOPGEN   3392
#define XCD_BAR_WORDS 3456
#define XB_SPIN_CAP (1u << 22)
__device__ __forceinline__ unsigned xb_ld(unsigned* p)              { return __hip_atomic_load(p, __ATOMIC_RELAXED, __HIP_MEMORY_SCOPE_AGENT); }
__device__ __forceinline__ unsigned xb_add(unsigned* p, unsigned v) { return __hip_atomic_fetch_add(p, v, __ATOMIC_RELAXED, __HIP_MEMORY_SCOPE_AGENT); }
__device__ __forceinline__ unsigned xb_xcc_id() { return (unsigned)__builtin_amdgcn_s_getreg((3 << 11) | 20) & 0xFu; }
#define XB_SPIN(cond, bar) do { unsigned _sp = 0; while (cond) { __builtin_amdgcn_s_sleep(1); \
    if ((++_sp & 255u) == 0u) { if (xb_ld(&(bar)[XB_TMO])) break; if (_sp > XB_SPIN_CAP) { atomicAdd(&(bar)[XB_TMO], 1u); break; } } } } while (0)
struct XcdBarrier { unsigned* bar; unsigned x; volatile LAS unsigned* st; };
__device__ __forceinline__ XcdBarrier xcd_barrier_post(unsigned* bar, volatile LAS unsigned* st) {
    XcdBarrier b; b.bar = bar; b.x = xb_xcc_id(); b.st = st;
    if (threadIdx.x == 0) (void)xb_add(&bar[XB_XCNT(b.x)], 1u);
    return b;
}
__device__ __forceinline__ void xcd_barrier_complete(unsigned* bar, unsigned x, unsigned& nloc, unsigned& nx) {
    const unsigned G = gridDim.x * gridDim.y * gridDim.z;
    unsigned sum, cnt, mine, sp = 0u;
    for (;;) {
        sum = 0u; cnt = 0u; mine = 0u;
#pragma unroll
        for (unsigned j = 0; j < 16; ++j) { const unsigned c = xb_ld(&bar[XB_XCNT(j)]); sum += c; cnt += (c > 0u) ? 1u : 0u; mine = (j == x) ? c : mine; }
        if (sum == G) break;
        __builtin_amdgcn_s_sleep(1);
        if ((++sp & 255u) == 0u) { if (xb_ld(&bar[XB_TMO])) break; if (sp > XB_SPIN_CAP) { atomicAdd(&bar[XB_TMO], 1u); break; } }
    }
    nloc = mine > 0u ? mine : 1u; nx = cnt > 0u ? cnt : 1u;
}
__device__ __forceinline__ void xcd_barrier(const XcdBarrier& b) {
    asm volatile("s_waitcnt vmcnt(0)" ::: "memory");
    __syncthreads();
    if (threadIdx.x == 0) {
        unsigned* bar = b.bar;
        __builtin_amdgcn_s_waitcnt(0);
        unsigned nloc = b.st[0], nx = b.st[1];
        if (nloc == 0u) { xcd_barrier_complete(bar, b.x, nloc, nx); b.st[0] = nloc; b.st[1] = nx; }
        const unsigned old = xb_add(&bar[XB_XSUB(b.x)], 1u);
        const unsigned gen = old / nloc;
        if (old + 1u == (gen + 1u) * nloc) {
            __builtin_amdgcn_fence(__ATOMIC_RELEASE, "agent");
            asm volatile("s_waitcnt vmcnt(0)" ::: "memory");
            const unsigned og = xb_add(&bar[XB_TOP], 1u);
            const unsigned tg = og / nx;
            if (og + 1u == (tg + 1u) * nx) xb_add(&bar[XB_TOPGEN], 1u);
            else XB_SPIN(xb_ld(&bar[XB_TOPGEN]) == tg, bar);
            __builtin_amdgcn_fence(__ATOMIC_ACQUIRE, "agent");
            xb_add(&bar[XB_XGEN(b.x)], 1u);
            asm volatile("s_waitcnt vmcnt(0)" ::: "memory");
        } else {
            XB_SPIN(xb_ld(&bar[XB_XGEN(b.x)]) == gen, bar);
            __builtin_amdgcn_fence(__ATOMIC_ACQUIRE, "agent");
            asm volatile("s_waitcnt vmcnt(0)" ::: "memory");
        }
    }
    __syncthreads();
}

template <class AL, class BL, class EP>
__device__ __forceinline__ void mgemm_tile(unsigned char* lds, int K, const AL& al, const BL& bl, const EP& ep) {
    bf16_t* As = (bf16_t*)lds;
    bf16_t* Bs = As + 128 * 40;
    const int tid = threadIdx.x, lane = tid & 63, wave = tid >> 6;
    const int ar = tid >> 2, ac = (tid & 3) * 8;
    const int bn = tid & 127, bc = (tid >> 7) * 8;
    f32x4 acc[8];
#pragma unroll
    for (int s = 0; s < 8; ++s) acc[s] = (f32x4){0.f, 0.f, 0.f, 0.f};
    bf16x8 ra = al(ac), rb = bl(bc);
    for (int k0 = 0; k0 < K; k0 += 32) {
        __syncthreads();
        *(bf16x8*)(As + ar * 40 + ac) = ra;
        *(bf16x8*)(Bs + bn * 40 + bc) = rb;
        __syncthreads();
        if (k0 + 32 < K) { ra = al(k0 + 32 + ac); rb = bl(k0 + 32 + bc); }
        const bf16x8 af = *(const bf16x8*)(As + (wave * 16 + (lane & 15)) * 40 + (lane >> 4) * 8);
#pragma unroll
        for (int s = 0; s < 8; ++s) {
            const bf16x8 wf = *(const bf16x8*)(Bs + (16 * s + (lane & 15)) * 40 + (lane >> 4) * 8);
            acc[s] = __builtin_amdgcn_mfma_f32_16x16x32_bf16(wf, af, acc[s], 0, 0, 0);
        }
    }
    ep(wave * 16 + (lane & 15), (lane >> 4) * 4, acc);
}
__device__ __forceinline__ void store4bf(bf16_t* p, const f32x4 v) { u32x2 w; w.x = pk2(v[0], v[1]); w.y = pk2(v[2], v[3]); *(u32x2*)p = w; }

struct Args {
    const float* in[29];
    float* out;
    unsigned char* ws;
    float inv_freq[8];
    int ph_lo, ph_hi;
};

__device__ __forceinline__ unsigned pk4_fp8(float a, float b, float c, float d) { int w = __builtin_amdgcn_cvt_pk_fp8_f32(a, b, 0, false); return (unsigned)__builtin_amdgcn_cvt_pk_fp8_f32(c, d, w, true); }
__device__ __forceinline__ u32x2 pack8_fp8(const f32x4 v0, const f32x4 v1) {
    int a = __builtin_amdgcn_cvt_pk_fp8_f32(v0[0], v0[1], 0, false); a = __builtin_amdgcn_cvt_pk_fp8_f32(v0[2], v0[3], a, true);
    int b = __builtin_amdgcn_cvt_pk_fp8_f32(v1[0], v1[1], 0, false); b = __builtin_amdgcn_cvt_pk_fp8_f32(v1[2], v1[3], b, true);
    u32x2 w; w.x = (unsigned)a; w.y = (unsigned)b; return w;
}
__device__ __forceinline__ float clamp8(float v) { return __builtin_amdgcn_fmed3f(v, -448.0f, 448.0f); }
__device__ __forceinline__ void ph_ln(const bf16_t* Y, const float* g, const float* b, bf16_t* X, unsigned char* X8) {
    const int lane = threadIdx.x & 63, wave = threadIdx.x >> 6;
    const int gw = blockIdx.x * 8 + wave, ngw = gridDim.x * 8;
    float gg[16], bb[16];
#pragma unroll
    for (int j = 0; j < 8; ++j) { gg[j] = g[lane * 8 + j]; gg[8 + j] = g[512 + lane * 8 + j]; bb[j] = b[lane * 8 + j]; bb[8 + j] = b[512 + lane * 8 + j]; }
    for (int row0 = gw * 4; row0 < M; row0 += ngw * 4) {
        bf16x8 p0[4], p1[4];
#pragma unroll
        for (int r = 0; r < 4; ++r) { p0[r] = __builtin_nontemporal_load((const bf16x8*)(Y + (size_t)(row0 + r) * 1024 + lane * 8)); p1[r] = __builtin_nontemporal_load((const bf16x8*)(Y + (size_t)(row0 + r) * 1024 + 512 + lane * 8)); }
#pragma unroll
        for (int r = 0; r < 4; ++r) {
            float v[16];
#pragma unroll
            for (int j = 0; j < 8; ++j) { v[j] = bf2f((bf16_t)p0[r][j]); v[8 + j] = bf2f((bf16_t)p1[r][j]); }
            float s = 0.f;
#pragma unroll
            for (int j = 0; j < 16; ++j) s += v[j];
            const float mean = wave_sum(s) * (1.0f / 1024.0f);
            float q = 0.f;
#pragma unroll
            for (int j = 0; j < 16; ++j) { v[j] -= mean; q += v[j] * v[j]; }
            const float rstd = rsqrtf(wave_sum(q) * (1.0f / 1024.0f) + LN_EPS);
            float o[16];
#pragma unroll
            for (int j = 0; j < 16; ++j) o[j] = v[j] * rstd * gg[j] + bb[j];
            u32x4 w0, w1;
            w0.x = pk2(o[0], o[1]); w0.y = pk2(o[2], o[3]); w0.z = pk2(o[4], o[5]); w0.w = pk2(o[6], o[7]);
            w1.x = pk2(o[8], o[9]); w1.y = pk2(o[10], o[11]); w1.z = pk2(o[12], o[13]); w1.w = pk2(o[14], o[15]);
            *(u32x4*)(X + (size_t)(row0 + r) * 1024 + lane * 8) = w0; *(u32x4*)(X + (size_t)(row0 + r) * 1024 + 512 + lane * 8) = w1;
#pragma unroll
            for (int j = 0; j < 16; ++j) o[j] = clamp8(o[j] * X8_SCALE);
            u32x2 q0, q1; q0.x = pk4_fp8(o[0], o[1], o[2], o[3]); q0.y = pk4_fp8(o[4], o[5], o[6], o[7]); q1.x = pk4_fp8(o[8], o[9], o[10], o[11]); q1.y = pk4_fp8(o[12], o[13], o[14], o[15]);
            *(u32x2*)(X8 + (size_t)(row0 + r) * 1024 + lane * 8) = q0; *(u32x2*)(X8 + (size_t)(row0 + r) * 1024 + 512 + lane * 8) = q1;
        }
    }
}

__device__ __forceinline__ void ph_combine(const Args& a, const bf16_t* X, const float* g, const float* b, bf16_t* Xo, float* outf) {
    const unsigned char* YB = (const unsigned char*)(a.ws + WS_YB);
    const int lane = threadIdx.x & 63, wave = threadIdx.x >> 6;
    const int gw = blockIdx.x * 8 + wave, ngw = gridDim.x * 8;
    for (int row = gw; row < M; row += ngw) {
        float v[16];
#pragma unroll
        for (int j = 0; j < 16; ++j) v[j] = 0.f;
        u32x2 q0[YB_NSLOT], q1[YB_NSLOT];
#pragma unroll
        for (int k = 0; k < YB_NSLOT; ++k) { const unsigned char* yr = YB + ((size_t)row * 10 + k) * 1024; q0[k] = __builtin_nontemporal_load((const u32x2*)(yr + lane * 8)); q1[k] = __builtin_nontemporal_load((const u32x2*)(yr + 512 + lane * 8)); }
#pragma unroll
        for (int k = 0; k < YB_NSLOT; ++k) {
            const auto a0 = __builtin_amdgcn_cvt_pk_f32_fp8((int)q0[k].x, false), a1 = __builtin_amdgcn_cvt_pk_f32_fp8((int)q0[k].x, true), a2 = __builtin_amdgcn_cvt_pk_f32_fp8((int)q0[k].y, false), a3 = __builtin_amdgcn_cvt_pk_f32_fp8((int)q0[k].y, true);
            const auto b0 = __builtin_amdgcn_cvt_pk_f32_fp8((int)q1[k].x, false), b1 = __builtin_amdgcn_cvt_pk_f32_fp8((int)q1[k].x, true), b2 = __builtin_amdgcn_cvt_pk_f32_fp8((int)q1[k].y, false), b3 = __builtin_amdgcn_cvt_pk_f32_fp8((int)q1[k].y, true);
            v[0] += a0[0]; v[1] += a0[1]; v[2] += a1[0]; v[3] += a1[1]; v[4] += a2[0]; v[5] += a2[1]; v[6] += a3[0]; v[7] += a3[1];
            v[8] += b0[0]; v[9] += b0[1]; v[10] += b1[0]; v[11] += b1[1]; v[12] += b2[0]; v[13] += b2[1]; v[14] += b3[0]; v[15] += b3[1];
        }
        {
            const bf16x8 p0 = *(const bf16x8*)(X + (size_t)row * 1024 + lane * 8), p1 = *(const bf16x8*)(X + (size_t)row * 1024 + 512 + lane * 8);
#pragma unroll
            for (int j = 0; j < 8; ++j) { v[j] = v[j] * (1.0f / YB_SCALE) + ALPHA * bf2f((bf16_t)p0[j]); v[8 + j] = v[8 + j] * (1.0f / YB_SCALE) + ALPHA * bf2f((bf16_t)p1[j]); }
        }
        float s = 0.f;
#pragma unroll
        for (int j = 0; j < 16; ++j) s += v[j];
        const float mean = wave_sum(s) * (1.0f / 1024.0f);
        float q = 0.f;
#pragma unroll
        for (int j = 0; j < 16; ++j) { v[j] -= mean; q += v[j] * v[j]; }
        const float rstd = rsqrtf(wave_sum(q) * (1.0f / 1024.0f) + LN_EPS);
        float o[16];
#pragma unroll
        for (int j = 0; j < 8; ++j) { o[j] = v[j] * rstd * g[lane * 8 + j] + b[lane * 8 + j]; o[8 + j] = v[8 + j] * rstd * g[512 + lane * 8 + j] + b[512 + lane * 8 + j]; }
        if (outf) {
            float* op = outf + (size_t)row * 1024;
            *(float4*)(op + lane * 8) = make_float4(o[0], o[1], o[2], o[3]); *(float4*)(op + lane * 8 + 4) = make_float4(o[4], o[5], o[6], o[7]);
            *(float4*)(op + 512 + lane * 8) = make_float4(o[8], o[9], o[10], o[11]); *(float4*)(op + 512 + lane * 8 + 4) = make_float4(o[12], o[13], o[14], o[15]);
        } else {
            u32x4 w0, w1;
            w0.x = pk2(o[0], o[1]); w0.y = pk2(o[2], o[3]); w0.z = pk2(o[4], o[5]); w0.w = pk2(o[6], o[7]);
            w1.x = pk2(o[8], o[9]); w1.y = pk2(o[10], o[11]); w1.z = pk2(o[12], o[13]); w1.w = pk2(o[14], o[15]);
            *(u32x4*)(Xo + (size_t)row * 1024 + lane * 8) = w0; *(u32x4*)(Xo + (size_t)row * 1024 + 512 + lane * 8) = w1;
        }
    }
}

__device__ __forceinline__ void ph_cmp2(const Args& a, unsigned char* lds) {
    const bf16_t* CH1 = (const bf16_t*)(a.ws + WS_CH1);
    bf16_t* KC = (bf16_t*)(a.ws + WS_KC);
    const int tid = threadIdx.x;
    for (int u = blockIdx.x; u < 64 * 2; u += gridDim.x) {
        const int rt = u >> 1, kv = u & 1;
        const bf16_t* ar = CH1 + ((size_t)kv * 8192 + rt * 128 + (tid >> 2)) * 128;
        const float* w2 = a.in[kv ? 15 : 12];
        const int col = tid & 127;
        auto al = [&](int k) { return *(const bf16x8*)(ar + k); };
        auto bl = [&](int k) { return (col < 64) ? colk8(w2, 64, k, col) : zero8(); };
        auto ep = [&](int r, int cb, const f32x4 (&acc)[8]) {
            bf16_t* o = KC + ((size_t)kv * 8192 + rt * 128 + r) * 64;
#pragma unroll
            for (int s = 0; s < 4; ++s) store4bf(o + 16 * s + cb, acc[s]);
        };
        mgemm_tile(lds, 128, al, bl, ep);
    }
}

namespace pg8 {
constexpr int BM = 256, BK = 64, HALF = 128, HTB = HALF * BK * 2, STAGE_BYTES = 8 * HTB;
__device__ __forceinline__ int lds_byte(int r, int c) { const int st = (r >> 4) * 2 + (c >> 5), rr = r & 15, cc = c & 31, ob = rr * 64 + cc * 2; return st * 1024 + (ob ^ (((ob >> 9) & 1) << 5)); }
__device__ __forceinline__ void stage_rc(int b, int& R, int& C) { const int st = b / 1024, sb = b % 1024, swz = sb ^ (((sb >> 9) & 1) << 5); R = (st >> 1) * 16 + swz / 64; C = (st & 1) * 32 + (swz % 64) / 2; }
__device__ __forceinline__ int perm32(int rho) { const int n = rho >> 4, i = rho & 15; return 8 * (i >> 2) + 4 * n + (i & 3); }
struct Unit { int pm, pn, ord; };
typedef float f32x16 __attribute__((ext_vector_type(16)));
typedef int i32x8 __attribute__((ext_vector_type(8))); typedef int i32x4_ __attribute__((ext_vector_type(4)));
__device__ __forceinline__ i32x8 f8cat(const bf16x8 lo, const bf16x8 hi) { return __builtin_shufflevector(__builtin_bit_cast(i32x4_, lo), __builtin_bit_cast(i32x4_, hi), 0, 1, 2, 3, 4, 5, 6, 7); }
template <class Epi, class Sched, bool ALIGN_EPI, bool F8 = false>
__device__ __forceinline__ void gemm_phase(LAS unsigned char* lds, const int K, const unsigned kstepA, const Sched& S, const Epi& E) {
    const int tid = threadIdx.x, wid = __builtin_amdgcn_readfirstlane(tid >> 6), lane = tid & 63, wr = wid >> 2, wc = wid & 3, fr = lane & 15, fq = lane >> 4;
    const int nt = K / BK;
    constexpr bool GA = Sched::GATHER;
    int RA[2]; unsigned CA2[2], voffB[2], voffB1[2], voffA[2];
    constexpr bool P16 = Epi::PERM16;
#pragma unroll
    for (int i = 0; i < 2; ++i) { int R, C; stage_rc(tid * 16 + i * 8192, R, C); const int Rb = Epi::PERM ? ((R & ~31) + perm32(R & 31)) : R;
        RA[i] = R; CA2[i] = (unsigned)C * 2u; voffB[i] = (unsigned)(Rb * K + C) * 2u; voffA[i] = GA ? 0u : (S.lane_off(R) + (unsigned)C * 2u);
        if (P16) { const int c16 = 64 * (R >> 5) + 16 * ((R >> 2) & 3) + 4 * ((R >> 4) & 1) + (R & 3); voffB[i] = (unsigned)(c16 * K + C) * 2u; voffB1[i] = (unsigned)((c16 + 8) * K + C) * 2u; } else voffB1[i] = 0u; }
    const size_t kstepB = (size_t)(BK * 2);
    const size_t hstepB = (size_t)HALF * K * 2;
    const unsigned ldsw = (unsigned)wid * 1024u;
    const int aoff = lds_byte(wr * 64 + fr, fq * 8), boff = lds_byte(wc * 32 + fr, fq * 8);
    const char* const Ab = S.abase();
    unsigned aoC[2][2], aoN[2][2];
    unsigned uC[2], uN[2];
#define PG8_SA(b, h) (((b) * 2 + (h)) * HTB)
#define PG8_SB(b, h) ((4 + (b) * 2 + (h)) * HTB)
#define PG8_GLDS(sbase, voff, ldsoff) do { const char* _b = (const char*)(sbase); unsigned _v = (voff); asm volatile("" : "+s"(_b), "+v"(_v)); \
        __builtin_amdgcn_global_load_lds((const unsigned*)(_b + _v), (LAS unsigned*)(lds + (ldsoff)), 16, 0, 0); } while (0)
#define PG8_STAGE_B(bufoff, gbase) do { _Pragma("unroll") for (int _i = 0; _i < 2; ++_i) PG8_GLDS(gbase, voffB[_i], (bufoff) + ldsw + _i * 8192); } while (0)
#define PG8_STAGE_B1(bufoff, gbase) do { _Pragma("unroll") for (int _i = 0; _i < 2; ++_i) PG8_GLDS((const char*)(gbase) + (P16 ? (size_t)0 : hstepB), (P16 ? voffB1[_i] : voffB[_i]), (bufoff) + ldsw + _i * 8192); } while (0)
#define PG8_STAGE_A(bufoff, kb, UO, LO) do { _Pragma("unroll") for (int _i = 0; _i < 2; ++_i) PG8_GLDS(Ab + (size_t)((kb) + (UO)), (GA ? (LO)[_i] : voffA[_i]), (bufoff) + ldsw + _i * 8192); } while (0)
#define PG8_LDA(dst, b, h) do { _Pragma("unroll") for (int m = 0; m < 4; ++m) _Pragma("unroll") for (int k = 0; k < 2; ++k) dst[m][k] = *(const LAS bf16x8*)(lds + PG8_SA(b, h) + aoff + m * 2048 + k * 1024); } while (0)
#define PG8_LDB(dst, b, h) do { _Pragma("unroll") for (int n = 0; n < 2; ++n) _Pragma("unroll") for (int k = 0; k < 2; ++k) dst[n][k] = *(const LAS bf16x8*)(lds + PG8_SB(b, h) + boff + n * 2048 + k * 1024); } while (0)
#define PG8_MMA(ai, bj, At, Bt) do { __builtin_amdgcn_s_setprio(1); _Pragma("unroll") for (int m = 0; m < 4; ++m) _Pragma("unroll") for (int n = 0; n < 2; ++n) { \
        if constexpr (F8) { f32x16& _w = accw[ai][bj][m >> 1]; const int _q = ((m & 1) * 2 + n) * 4; f32x4 _c = {_w[_q], _w[_q + 1], _w[_q + 2], _w[_q + 3]}; \
            _c = __builtin_amdgcn_mfma_scale_f32_16x16x128_f8f6f4(f8cat(Bt[n][0], Bt[n][1]), f8cat(At[m][0], At[m][1]), _c, 0, 0, 0, 0, 0, 0); _w[_q] = _c[0]; _w[_q + 1] = _c[1]; _w[_q + 2] = _c[2]; _w[_q + 3] = _c[3]; } \
        else { _Pragma("unroll") for (int k = 0; k < 2; ++k) acc[ai][bj][m][n] = __builtin_amdgcn_mfma_f32_16x16x32_bf16(Bt[n][k], At[m][k], acc[ai][bj][m][n], 0, 0, 0); } } __builtin_amdgcn_s_setprio(0); } while (0)
#define PG8_WAIT_V(n) asm volatile("s_waitcnt vmcnt(" #n ")" ::: "memory")
#define PG8_WAIT_L(n) asm volatile("s_waitcnt lgkmcnt(" #n ")" ::: "memory")
#define PG8_BAR __builtin_amdgcn_s_barrier()
#define PG8_SCHED __builtin_amdgcn_sched_barrier(0)
#define PG8_KPAIR(KB1, KB2, KB3, BP2, BP3) do { \
            PG8_LDB(B0, 0, 0); PG8_LDB(B1, 0, 1); PG8_SCHED; PG8_LDA(At, 0, 0); PG8_STAGE_A(PG8_SA(1, 1), KB1, uC[1], aoC[1]); \
            PG8_WAIT_V(8); PG8_WAIT_L(0); PG8_BAR; PG8_MMA(0, 0, At, B0); PG8_MMA(0, 1, At, B1); PG8_BAR; PG8_SCHED; \
            PG8_LDA(At, 0, 1); PG8_STAGE_B(PG8_SB(0, 0), BP2); PG8_STAGE_B1(PG8_SB(0, 1), BP2); PG8_STAGE_A(PG8_SA(0, 0), KB2, u2[0], a2o[0]); \
            PG8_WAIT_V(8); PG8_WAIT_L(0); PG8_BAR; PG8_MMA(1, 0, At, B0); PG8_MMA(1, 1, At, B1); PG8_BAR; PG8_SCHED; \
            PG8_LDB(B0, 1, 0); PG8_LDB(B1, 1, 1); PG8_SCHED; PG8_LDA(At, 1, 0); PG8_STAGE_A(PG8_SA(0, 1), KB2, u2[1], a2o[1]); \
            PG8_WAIT_V(8); PG8_WAIT_L(0); PG8_BAR; PG8_MMA(0, 0, At, B0); PG8_MMA(0, 1, At, B1); PG8_BAR; PG8_SCHED; \
            PG8_LDA(At, 1, 1); PG8_STAGE_B(PG8_SB(1, 0), BP3); PG8_STAGE_B1(PG8_SB(1, 1), BP3); PG8_STAGE_A(PG8_SA(1, 0), KB3, u2[0], a2o[0]); \
            PG8_WAIT_V(8); PG8_WAIT_L(0); PG8_BAR; PG8_MMA(1, 0, At, B0); PG8_MMA(1, 1, At, B1); PG8_BAR; PG8_SCHED; } while (0)
    Unit cur, nxt; int ui = 0;
    if (!S.next(0, cur)) return;
    f32x4 acc[2][2][4][2];
#pragma unroll
    for (int a = 0; a < 2; ++a)
#pragma unroll
        for (int b = 0; b < 2; ++b)
#pragma unroll
            for (int m = 0; m < 4; ++m)
#pragma unroll
                for (int n = 0; n < 2; ++n) acc[a][b][m][n] = (f32x4){0.f, 0.f, 0.f, 0.f};
    bf16x8 At[4][2], B0[2][2], B1[2][2];
    f32x16 accw[2][2][2];
#define PG8_ZERO_W() do { if constexpr (F8) { _Pragma("unroll") for (int _a = 0; _a < 2; ++_a) _Pragma("unroll") for (int _b = 0; _b < 2; ++_b) _Pragma("unroll") for (int _m = 0; _m < 2; ++_m) _Pragma("unroll") for (int _e = 0; _e < 16; ++_e) accw[_a][_b][_m][_e] = 0.f; } } while (0)
    PG8_ZERO_W();
#pragma unroll
    for (int h = 0; h < 2; ++h) { uC[h] = GA ? 0u : S.unit_off(cur, h); uN[h] = uC[h];
#pragma unroll
        for (int i = 0; i < 2; ++i) { aoC[h][i] = GA ? (S.aoff(cur, h * HALF + RA[i]) + CA2[i]) : 0u; aoN[h][i] = aoC[h][i]; } }
    const char* cB = S.bptr(cur);
    PG8_STAGE_B(PG8_SB(0, 0), cB); PG8_STAGE_B1(PG8_SB(0, 1), cB); PG8_STAGE_A(PG8_SA(0, 0), 0u, uC[0], aoC[0]); PG8_STAGE_A(PG8_SA(0, 1), 0u, uC[1], aoC[1]);
    if (wr == 1) PG8_BAR;
    PG8_WAIT_V(2); PG8_BAR;
    PG8_STAGE_B(PG8_SB(1, 0), cB + kstepB); PG8_STAGE_A(PG8_SA(1, 0), kstepA, uC[0], aoC[0]); PG8_STAGE_B1(PG8_SB(1, 1), cB + kstepB);
    PG8_WAIT_V(6); PG8_BAR;
    for (;;) {
        const bool has_next = S.next(ui + 1, nxt);
        const char* nB = has_next ? S.bptr(nxt) : cB;
#pragma unroll
        for (int h = 0; h < 2; ++h) { uN[h] = (GA || !has_next) ? uC[h] : S.unit_off(nxt, h);
#pragma unroll
            for (int i = 0; i < 2; ++i) aoN[h][i] = (GA && has_next) ? (S.aoff(nxt, h * HALF + RA[i]) + CA2[i]) : aoC[h][i]; }
#pragma nounroll
        for (int t = 0; t < nt; t += 2) {
            const bool last = (t == nt - 2);
            const unsigned kb1 = (unsigned)(t + 1) * kstepA, kb2 = last ? 0u : (unsigned)(t + 2) * kstepA, kb3 = kb2 + kstepA;
            const char* b2 = last ? nB : cB + (size_t)(t + 2) * kstepB; const char* b3 = b2 + kstepB;
            unsigned u2[2], a2o[2][2];
#pragma unroll
            for (int h = 0; h < 2; ++h) { u2[h] = last ? uN[h] : uC[h];
#pragma unroll
                for (int i = 0; i < 2; ++i) a2o[h][i] = GA ? (last ? aoN[h][i] : aoC[h][i]) : 0u; }
            PG8_KPAIR(kb1, kb2, kb3, b2, b3);
        }
        if constexpr (ALIGN_EPI) { if (wr == 0) PG8_BAR; }
        if constexpr (F8) {
#pragma unroll
            for (int _a = 0; _a < 2; ++_a)
#pragma unroll
                for (int _b = 0; _b < 2; ++_b)
#pragma unroll
                    for (int _m = 0; _m < 4; ++_m)
#pragma unroll
                        for (int _n = 0; _n < 2; ++_n) { const f32x16& _w = accw[_a][_b][_m >> 1]; const int _q = ((_m & 1) * 2 + _n) * 4; acc[_a][_b][_m][_n] = (f32x4){_w[_q], _w[_q + 1], _w[_q + 2], _w[_q + 3]}; }
        }
        E(acc, cur, wr, wc, fr, fq);
        PG8_ZERO_W();
        if (!has_next) break;
#pragma unroll
        for (int a = 0; a < 2; ++a)
#pragma unroll
            for (int b = 0; b < 2; ++b)
#pragma unroll
                for (int m = 0; m < 4; ++m)
#pragma unroll
                    for (int n = 0; n < 2; ++n) acc[a][b][m][n] = (f32x4){0.f, 0.f, 0.f, 0.f};
        cur = nxt; cB = nB; ++ui;
#pragma unroll
        for (int h = 0; h < 2; ++h) { uC[h] = uN[h];
#pragma unroll
            for (int i = 0; i < 2; ++i) aoC[h][i] = aoN[h][i]; }
        if constexpr (ALIGN_EPI) { if (wr == 1) PG8_BAR; }
    }
    PG8_WAIT_V(0);
    if constexpr (!ALIGN_EPI) { if (wr == 0) PG8_BAR; }
    PG8_BAR;
#undef PG8_SA
#undef PG8_ZERO_W
#undef PG8_GLDS
#undef PG8_SB
#undef PG8_STAGE_A
#undef PG8_STAGE_B
#undef PG8_STAGE_B1
#undef PG8_LDA
#undef PG8_LDB
#undef PG8_MMA
#undef PG8_WAIT_V
#undef PG8_WAIT_L
#undef PG8_BAR
#undef PG8_SCHED
#undef PG8_KPAIR
}

struct DenseSched {
    const char* A; const char* Bt; unsigned lda2; size_t btile; int nM, nN, nwg, G, c;
    __device__ __forceinline__ void init(const bf16_t* A_, int lda, const bf16_t* Bt_, int K, int Mrows, int N) {
        A = (const char*)A_; Bt = (const char*)Bt_; lda2 = (unsigned)lda * 2u; btile = (size_t)256 * K * 2; nM = Mrows / BM; nN = N / BM; nwg = nM * nN; G = gridDim.x; c = blockIdx.x; }
    __device__ __forceinline__ bool next(int i, Unit& u) const {
        const long L = (long)i * G + c; if (L >= nwg) return false;
        int wgid = (int)L; { const int q = nwg / 8, r = nwg % 8, xcd = wgid % 8, off = wgid / 8; wgid = (xcd < r ? xcd * (q + 1) : r * (q + 1) + (xcd - r) * q) + off; }
        const int nig = 8 * nN, gid = wgid / nig, fm = gid * 8, gsz = (nM - fm) < 8 ? (nM - fm) : 8;
        u.pm = fm + ((wgid % nig) % gsz); u.pn = (wgid % nig) / gsz; u.ord = i; return true;
    }
    static constexpr bool GATHER = false;
    __device__ __forceinline__ unsigned lane_off(int r) const { return (unsigned)r * lda2; }
    __device__ __forceinline__ unsigned unit_off(const Unit& u, int h) const { return (unsigned)(u.pm * BM + h * HALF) * lda2; }
    __device__ __forceinline__ unsigned aoff(const Unit&, int) const { return 0u; }
    __device__ __forceinline__ const char* abase() const { return A; }
    __device__ __forceinline__ const char* bptr(const Unit& u) const { return Bt + (size_t)u.pn * btile; }
};
}
typedef float f32x2_t __attribute__((ext_vector_type(2))); typedef __bf16 bf16x2_t __attribute__((ext_vector_type(2)));
__device__ __forceinline__ unsigned cvt_pk_bf16(float lo, float hi) { const f32x2_t v = {lo, hi}; const bf16x2_t b = __builtin_convertvector(v, bf16x2_t); return __builtin_bit_cast(unsigned, b); }
__device__ __forceinline__ u32x4 pack8(const f32x4 v0, const f32x4 v1) { u32x4 w; w.x = cvt_pk_bf16(v0[0], v0[1]); w.y = cvt_pk_bf16(v0[2], v0[3]); w.z = cvt_pk_bf16(v1[0], v1[1]); w.w = cvt_pk_bf16(v1[2], v1[3]); return w; }
__device__ __forceinline__ unsigned cvtpk_m(float lo, float hi) { const f32x2_t v = {lo, hi}; const bf16x2_t b = __builtin_convertvector(v, bf16x2_t); return __builtin_bit_cast(unsigned, b); }
__device__ __forceinline__ u32x4 pack8m(const f32x4 v0, const f32x4 v1) { u32x4 w; w.x = cvtpk_m(v0[0], v0[1]); w.y = cvtpk_m(v0[2], v0[3]); w.z = cvtpk_m(v1[0], v1[1]); w.w = cvtpk_m(v1[2], v1[3]); return w; }
#define MFMA_SETTLE(S) asm volatile("s_nop 15\n\ts_nop 7" : "+v"(S[0][0]), "+v"(S[0][1]), "+v"(S[0][2]), "+v"(S[0][3]), "+v"(S[1][0]), "+v"(S[1][1]), "+v"(S[1][2]), "+v"(S[1][3]))
__device__ __forceinline__ f32x4 sig4(const f32x4 v) { f32x4 r; r[0] = sigmoidf_(v[0]); r[1] = sigmoidf_(v[1]); r[2] = sigmoidf_(v[2]); r[3] = sigmoidf_(v[3]); return r; }

#define EPI_ROWLOOP for (int ai = 0; ai < 2; ++ai) _Pragma("unroll") for (int m = 0; m < 4; ++m)
struct EpiInproj0 {
    static constexpr bool PERM = true, PERM16 = false; bf16_t* H0;
    __device__ __forceinline__ void operator()(const f32x4 (&acc)[2][2][4][2], const pg8::Unit& u, int wr, int wc, int fr, int fq) const {
        const int row0 = u.pm * 256 + wr * 64 + fr, cl = wc * 32 + 8 * fq;
#pragma unroll
        EPI_ROWLOOP { bf16_t* rp = H0 + (size_t)(row0 + ai * 128 + m * 16) * 1024;
            if (u.pn < 2) {
#pragma unroll
                for (int bj = 0; bj < 2; ++bj) *(u32x4*)(rp + u.pn * 256 + bj * 128 + cl) = pack8(acc[ai][bj][m][0], acc[ai][bj][m][1]);
            } else {
                const f32x4 v0 = acc[ai][0][m][0] * sig4(acc[ai][1][m][0]), v1 = acc[ai][0][m][1] * sig4(acc[ai][1][m][1]);
                *(u32x4*)(rp + 512 + (u.pn - 2) * 128 + cl) = pack8(v0, v1);
            } }
    }
};
struct EpiRes {
    static constexpr bool PERM = true, PERM16 = false; const float* resf; const bf16_t* resb; bf16_t* Y;
    __device__ __forceinline__ void operator()(const f32x4 (&acc)[2][2][4][2], const pg8::Unit& u, int wr, int wc, int fr, int fq) const {
        const int row0 = u.pm * 256 + wr * 64 + fr, c0 = u.pn * 256 + wc * 32 + 8 * fq;
#pragma unroll
        EPI_ROWLOOP { const size_t ro = (size_t)(row0 + ai * 128 + m * 16) * 1024 + c0;
#pragma unroll
            for (int bj = 0; bj < 2; ++bj) {
                f32x4 r0, r1;
                if (resf) { r0 = *(const f32x4*)(resf + ro + bj * 128); r1 = *(const f32x4*)(resf + ro + bj * 128 + 4); }
                else { const u32x4 xv = *(const u32x4*)(resb + ro + bj * 128);
                    r0[0] = __uint_as_float(xv.x << 16); r0[1] = __uint_as_float(xv.x & 0xffff0000u); r0[2] = __uint_as_float(xv.y << 16); r0[3] = __uint_as_float(xv.y & 0xffff0000u);
                    r1[0] = __uint_as_float(xv.z << 16); r1[1] = __uint_as_float(xv.z & 0xffff0000u); r1[2] = __uint_as_float(xv.w << 16); r1[3] = __uint_as_float(xv.w & 0xffff0000u); }
                *(u32x4*)(Y + ro + bj * 128) = pack8(acc[ai][bj][m][0] + r0 * ALPHA, acc[ai][bj][m][1] + r1 * ALPHA);
            } }
    }
};
struct EpiLogits {
    static constexpr bool PERM = true, PERM16 = false; float* LOG;
    __device__ __forceinline__ void operator()(const f32x4 (&acc)[2][2][4][2], const pg8::Unit& u, int wr, int wc, int fr, int fq) const {
        const int row0 = u.pm * 256 + wr * 64 + fr, cl = wc * 32 + 8 * fq;
#pragma unroll
        EPI_ROWLOOP { float* rp = LOG + (size_t)(row0 + ai * 128 + m * 16) * 256 + cl;
#pragma unroll
            for (int bj = 0; bj < 2; ++bj) { *(f32x4*)(rp + bj * 128) = acc[ai][bj][m][0]; *(f32x4*)(rp + bj * 128 + 4) = acc[ai][bj][m][1]; } }
    }
};

constexpr int MOE_TAB_OFF = 131072;
__device__ __forceinline__ int moe_setup256(const unsigned* cnt, LAS unsigned char* lds) {
    LAS int* tstart = (LAS int*)(lds + MOE_TAB_OFF);
    LAS int* scnt = (LAS int*)(lds + MOE_TAB_OFF + 1088);
    LAS unsigned short* texp = (LAS unsigned short*)(lds + MOE_TAB_OFF + 2176);
    const int tid = threadIdx.x;
    __syncthreads();
    const int lane = tid & 63, wave = tid >> 6;
    LAS int* wtot = tstart + 260;
    int c = 0;
    if (tid < 256) { const int n = (int)cnt[tid]; scnt[tid] = n; c = (n + 255) >> 8; }
    int incl = c;
#pragma unroll
    for (int o = 1; o < 64; o <<= 1) { const int t = __shfl_up(incl, o); if (lane >= o) incl += t; }
    if (tid < 256 && lane == 63) wtot[wave] = incl;
    __syncthreads();
    if (tid < 256) { int off = 0;
#pragma unroll
        for (int w = 0; w < 3; ++w) off += (w < wave) ? wtot[w] : 0;
        tstart[tid] = off + incl - c; if (tid == 255) tstart[256] = off + incl; }
    __syncthreads();
    if (tid < 256) for (int q = tstart[tid]; q < tstart[tid + 1]; ++q) texp[q] = (unsigned short)tid;
    __syncthreads();
    return __builtin_amdgcn_readfirstlane(tstart[256]);
}
constexpr int MOE_TOK_OFF = MOE_TAB_OFF + 5120;
constexpr int MOE_MAX_ORD = 20;
struct MoeGuSched {
    static constexpr bool GATHER = true;
    const char* X; const char* W; const int2* list; LAS unsigned char* lds; int R, nunits, G, c;
    __device__ __forceinline__ int vcu() const { return (G % 8 == 0) ? (c % 8) * (G / 8) + c / 8 : c; }
    __device__ __forceinline__ bool next(int i, pg8::Unit& u) const {
        const int L = i * G + vcu(); if (L >= nunits || i >= MOE_MAX_ORD) return false;
        const int q = L >> 1; const int e = __builtin_amdgcn_readfirstlane((q < R) ? (int)((LAS unsigned short*)(lds + MOE_TAB_OFF + 2176))[q] : 256);
        u.pm = q; u.pn = e * 2 + (L & 1); u.ord = i; return true; }
    __device__ __forceinline__ void prepare() const {
        const int tid = threadIdx.x, r = tid & 255;
        pg8::Unit u;
        for (int i = tid >> 8; next(i, u); i += 2) {
            const int e = u.pn >> 1; int token;
            if (e < 256) { const int ts = ((LAS int*)(lds + MOE_TAB_OFF))[e], cn = ((LAS int*)(lds + MOE_TAB_OFF + 1088))[e]; int lr = (u.pm - ts) * 256 + r; if (lr >= cn) lr = cn - 1;
                token = list[(size_t)e * LISTCAP + lr].x / 10; }
            else token = (u.pm - R) * 256 + r;
            ((LAS unsigned short*)(lds + MOE_TOK_OFF))[i * 256 + r] = (unsigned short)token;
        }
        __syncthreads();
    }
    __device__ __forceinline__ unsigned aoff(const pg8::Unit& u, int r) const { return (unsigned)((LAS unsigned short*)(lds + MOE_TOK_OFF))[u.ord * 256 + r] * 1024u; }
    __device__ __forceinline__ unsigned lane_off(int) const { return 0u; }
    __device__ __forceinline__ unsigned unit_off(const pg8::Unit&, int) const { return 0u; }
    __device__ __forceinline__ const char* abase() const { return X; }
    __device__ __forceinline__ const char* bptr(const pg8::Unit& u) const { return W + (size_t)u.pn * (256 * 1024); }
};
constexpr float GU_SC = 1.0f / (X8_SCALE * W8_SCALE);
struct EpiGateUp {
    static constexpr bool PERM = true, PERM16 = false; unsigned char* HID;
    __device__ __forceinline__ void operator()(const f32x4 (&acc)[2][2][4][2], const pg8::Unit& u, int wr, int wc, int fr, int fq) const {
        const int row0 = u.pm * 256 + wr * 64 + fr, c0 = (u.pn & 1) * 128 + wc * 32 + 8 * fq;
#pragma unroll
        EPI_ROWLOOP { const f32x4 g0 = acc[ai][0][m][0] * GU_SC, g1 = acc[ai][0][m][1] * GU_SC;
            f32x4 h0 = g0 * sig4(g0) * (acc[ai][1][m][0] * (GU_SC * H8_SCALE)), h1 = g1 * sig4(g1) * (acc[ai][1][m][1] * (GU_SC * H8_SCALE));
#pragma unroll
            for (int i = 0; i < 4; ++i) { h0[i] = clamp8(h0[i]); h1[i] = clamp8(h1[i]); }
            *(u32x2*)(HID + (size_t)(row0 + ai * 128 + m * 16) * 256 + c0) = pack8_fp8(h0, h1); }
    }
};
constexpr int MOE_RI_OFF = MOE_TAB_OFF + 5120;
constexpr int MOE_MAX_RT = 6;
struct MoeDownSched {
    const char* HID; const char* W; const int2* list; LAS unsigned char* lds; int R, ntile, G, c;
    __device__ __forceinline__ int vcu() const { return (G % 8 == 0) ? (c % 8) * (G / 8) + c / 8 : c; }
    __device__ __forceinline__ bool next(int i, pg8::Unit& u) const {
        const int q = vcu() + G * (i >> 2); if (q >= ntile || (i >> 2) >= MOE_MAX_RT) return false;
        const int e = (q < R) ? (int)((LAS unsigned short*)(lds + MOE_TAB_OFF + 2176))[q] : 256;
        u.pm = q; u.pn = e * 4 + (i & 3); u.ord = i >> 2; return true; }
    __device__ __forceinline__ void prepare() const {
        const int tid = threadIdx.x, r = tid & 255;
        for (int o = tid >> 8; o < MOE_MAX_RT; o += 2) {
            const int q = vcu() + G * o; if (q >= ntile) break;
            u32x2 en;
            if (q < R) { const int e = ((LAS unsigned short*)(lds + MOE_TAB_OFF + 2176))[q]; const int ts = ((LAS int*)(lds + MOE_TAB_OFF))[e], cn = ((LAS int*)(lds + MOE_TAB_OFF + 1088))[e];
                const int lr = (q - ts) * 256 + r; if (lr < cn) { const int2 le = list[(size_t)e * LISTCAP + lr]; en.x = (unsigned)le.x; en.y = (unsigned)le.y; } else { en.x = 0xffffffffu; en.y = 0u; } }
            else { en.x = (unsigned)(((q - R) * 256 + r) * 10 + 8); en.y = __float_as_uint(1.0f); }
            ((LAS u32x2*)(lds + MOE_RI_OFF))[o * 256 + r] = en;
        }
        __syncthreads();
    }
    static constexpr bool GATHER = false;
    __device__ __forceinline__ unsigned lane_off(int r) const { return (unsigned)r * 256u; }
    __device__ __forceinline__ unsigned unit_off(const pg8::Unit& u, int h) const { return (unsigned)(u.pm * 256 + h * 128) * 256u; }
    __device__ __forceinline__ unsigned aoff(const pg8::Unit&, int) const { return 0u; }
    __device__ __forceinline__ const char* abase() const { return HID; }
    __device__ __forceinline__ const char* bptr(const pg8::Unit& u) const { return W + (size_t)u.pn * (256 * 256); }
};
struct EpiDown {
    static constexpr bool PERM = true, PERM16 = true;
    unsigned char* YB; LAS unsigned char* lds;
    __device__ __forceinline__ void operator()(const f32x4 (&acc)[2][2][4][2], const pg8::Unit& u, int wr, int wc, int fr, int fq) const {
        asm volatile("" : "+v"(fr), "+v"(fq));
        const unsigned c0b = (unsigned)((u.pn & 3) * 256 + wc * 64 + 16 * fq); const bool shared = (u.pn >> 2) == 256;
        const LAS u32x2* ri = (const LAS u32x2*)(lds + MOE_RI_OFF) + u.ord * 256 + wr * 64 + fr;
#pragma unroll
        for (int ai = 0; ai < 2; ++ai)
#pragma unroll
            for (int m = 0; m < 4; ++m) { const u32x2 en = ri[ai * 128 + m * 16]; const float wv = __uint_as_float(en.y) * (YB_SCALE / (H8_SCALE * W8_SCALE));
                if ((int)en.x >= 0) { unsigned char* rp = YB + (size_t)(en.x * 1024u + c0b);
                    const f32x4 v00 = acc[ai][0][m][0] * wv, v01 = acc[ai][0][m][1] * wv, v10 = acc[ai][1][m][0] * wv, v11 = acc[ai][1][m][1] * wv;
                    const u32x2 h0 = pack8_fp8(v00, v01), h1 = pack8_fp8(v10, v11);
                    *(u32x4*)rp = (u32x4){h0.x, h0.y, h1.x, h1.y};
                    if (YB_NSLOT == 10 && shared) {
                        u32x2 r_[2];
#pragma unroll
                        for (int bj = 0; bj < 2; ++bj) { const u32x2 h = bj ? h1 : h0; const f32x4 v0 = bj ? v10 : v00, v1 = bj ? v11 : v01;
                            const auto a0 = __builtin_amdgcn_cvt_pk_f32_fp8((int)h.x, false), a1 = __builtin_amdgcn_cvt_pk_f32_fp8((int)h.x, true), a2 = __builtin_amdgcn_cvt_pk_f32_fp8((int)h.y, false), a3 = __builtin_amdgcn_cvt_pk_f32_fp8((int)h.y, true);
                            const f32x4 r0 = {v0[0] - a0[0], v0[1] - a0[1], v0[2] - a1[0], v0[3] - a1[1]}, r1 = {v1[0] - a2[0], v1[1] - a2[1], v1[2] - a3[0], v1[3] - a3[1]};
                            r_[bj] = pack8_fp8(r0, r1); }
                        *(u32x4*)(rp + 1024) = (u32x4){r_[0].x, r_[0].y, r_[1].x, r_[1].y}; } } }
    }
};

struct EpiInprojN {
    static constexpr bool PERM = true, PERM16 = false; bf16_t* QN; bf16_t* QR; bf16_t* KV6; float* GATES; const float* ROT;
    __device__ __forceinline__ void operator()(const f32x4 (&acc)[2][2][4][2], const pg8::Unit& u, int wr, int wc, int fr, int fq) const {
        const int row0 = u.pm * 256 + wr * 64 + fr, cl = wc * 32 + 8 * fq, pn = u.pn;
        const bool isq = pn < 4, rotk = (pn == 6 || pn == 8), dorot = (isq || rotk) && ((wc & 1) == 0);
#pragma unroll
        EPI_ROWLOOP { const int row = row0 + ai * 128 + m * 16;
            if (pn == 10) {
                if (cl < 48) { *(f32x4*)(GATES + (size_t)row * 48 + cl) = sig4(acc[ai][0][m][0]); *(f32x4*)(GATES + (size_t)row * 48 + cl + 4) = sig4(acc[ai][0][m][1]); }
            } else {
                f32x4 cs0, cs1, sn0, sn1;
                if (dorot) { const float* rt = ROT + (size_t)(row & (T - 1)) * 16; cs0 = *(const f32x4*)rt; cs1 = *(const f32x4*)(rt + 4); sn0 = *(const f32x4*)(rt + 8); sn1 = *(const f32x4*)(rt + 12); }
#pragma unroll
                for (int bj = 0; bj < 2; ++bj) {
                    const f32x4 v0 = acc[ai][bj][m][0], v1 = acc[ai][bj][m][1];
                    f32x4 r0 = v0, r1 = v1;
                    if (dorot) {
                        f32x4 p0, p1;
#pragma unroll
                        for (int i = 0; i < 4; ++i) { p0[i] = __shfl_xor(v0[i], 16); p1[i] = __shfl_xor(v1[i], 16); }
                        if (fq == 0) { r0 = v0 * cs0 - p0 * sn0; r1 = v1 * cs1 - p1 * sn1; }
                        else if (fq == 1) { r0 = v0 * cs0 + p0 * sn0; r1 = v1 * cs1 + p1 * sn1; }
                    }
                    if (isq) { const int c = pn * 256 + bj * 128 + cl;
                        *(u32x4*)(QN + (size_t)row * 1024 + c) = pack8(v0 * QSCALE, v1 * QSCALE); *(u32x4*)(QR + (size_t)row * 1024 + c) = pack8(r0 * QSCALE, r1 * QSCALE); }
                    else { const int cc = bj * 128 + cl, g = cc >> 6, d = cc & 63, b = row >> 13, t = row & (T - 1);
                        *(u32x4*)(KV6 + ((size_t)((pn - 4) * 16 + b * 4 + g) * T + t) * 64 + d) = pack8(r0, r1); }
                }
            } }
    }
};

struct Cmp1Sched {
    const char* KV6; const char* W; int G, c;
    static constexpr bool GATHER = false;
    __device__ __forceinline__ bool next(int i, pg8::Unit& u) const { const int L = i * G + c; if (L >= 64) return false; u.pm = L >> 1; u.pn = L & 1; u.ord = i; return true; }
    __device__ __forceinline__ unsigned lane_off(int r) const { return (unsigned)r * 2048u; }
    __device__ __forceinline__ unsigned unit_off(const pg8::Unit& u, int h) const { return (unsigned)u.pn * (unsigned)(16 * T * 64 * 2) + (unsigned)(u.pm * 256 + h * 128) * 2048u; }
    __device__ __forceinline__ unsigned aoff(const pg8::Unit&, int) const { return 0u; }
    __device__ __forceinline__ const char* abase() const { return KV6; }
    __device__ __forceinline__ const char* bptr(const pg8::Unit& u) const { return W + (size_t)u.pn * (256 * 2048 * 2); }
};
struct EpiCmp1 {
    static constexpr bool PERM = true, PERM16 = false; bf16_t* CH1; const float* bias1;
    __device__ __forceinline__ void operator()(const f32x4 (&acc)[2][2][4][2], const pg8::Unit& u, int wr, int wc, int fr, int fq) const {
        const int row0 = u.pm * 256 + wr * 64 + fr, cl = wc * 32 + 8 * fq;
        const f32x4 b0 = *(const f32x4*)(bias1 + u.pn * 128 + cl), b1 = *(const f32x4*)(bias1 + u.pn * 128 + cl + 4);
#pragma unroll
        EPI_ROWLOOP { f32x4 v0 = acc[ai][0][m][0] + b0, v1 = acc[ai][0][m][1] + b1;
#pragma unroll
            for (int i = 0; i < 4; ++i) { v0[i] = gelu_tanh(v0[i]); v1[i] = gelu_tanh(v1[i]); }
            *(u32x4*)(CH1 + ((size_t)u.pn * 8192 + row0 + ai * 128 + m * 16) * 128 + cl) = pack8(v0, v1); }
    }
};

__device__ __forceinline__ void p0_item(const float* W, int K, int N, bf16_t* WT, int kb, int n0, int drow0, LAS float* scr, int lane, bool f8 = false) {
    const int k0 = 64 * kb, n4 = (lane & 15) * 4;
    const bool cok = (n0 + n4) < N;
    f32x4 v[16];
#pragma unroll
    for (int i = 0; i < 16; ++i) { const int kk = 4 * i + (lane >> 4); v[i] = cok ? __builtin_nontemporal_load((const f32x4*)(W + (size_t)(k0 + kk) * N + n0 + n4)) : (f32x4){0.f, 0.f, 0.f, 0.f}; }
#pragma unroll
    for (int i = 0; i < 16; ++i) { const int kk = 4 * i + (lane >> 4); LAS float* d = scr + kk * 65 + n4; d[0] = v[i][0]; d[1] = v[i][1]; d[2] = v[i][2]; d[3] = v[i][3]; }
    asm volatile("s_waitcnt lgkmcnt(0)" ::: "memory");
    if (f8) {
        const int c4 = lane & 3;
#pragma unroll
        for (int j = 0; j < 4; ++j) { const int n = (lane >> 2) + 16 * j; const LAS float* sp = scr + (16 * c4) * 65 + n;
            u32x4 o;
            o.x = pk4_fp8(sp[0 * 65] * W8_SCALE, sp[1 * 65] * W8_SCALE, sp[2 * 65] * W8_SCALE, sp[3 * 65] * W8_SCALE); o.y = pk4_fp8(sp[4 * 65] * W8_SCALE, sp[5 * 65] * W8_SCALE, sp[6 * 65] * W8_SCALE, sp[7 * 65] * W8_SCALE);
            o.z = pk4_fp8(sp[8 * 65] * W8_SCALE, sp[9 * 65] * W8_SCALE, sp[10 * 65] * W8_SCALE, sp[11 * 65] * W8_SCALE); o.w = pk4_fp8(sp[12 * 65] * W8_SCALE, sp[13 * 65] * W8_SCALE, sp[14 * 65] * W8_SCALE, sp[15 * 65] * W8_SCALE);
            if (n0 + n < N) __builtin_nontemporal_store(o, (u32x4*)((unsigned char*)WT + (size_t)(drow0 + n) * K + k0 + 16 * c4)); }
        asm volatile("s_waitcnt lgkmcnt(0)" ::: "memory");
        return;
    }
    const int c = lane & 7;
#pragma unroll
    for (int j = 0; j < 8; ++j) { const int n = (lane >> 3) + 8 * j; const LAS float* sp = scr + (8 * c) * 65 + n;
        u32x4 o; o.x = pk2(sp[0 * 65], sp[1 * 65]); o.y = pk2(sp[2 * 65], sp[3 * 65]); o.z = pk2(sp[4 * 65], sp[5 * 65]); o.w = pk2(sp[6 * 65], sp[7 * 65]);
        if (n0 + n < N) __builtin_nontemporal_store(o, (u32x4*)(WT + (size_t)(drow0 + n) * K + k0 + 8 * c)); }
    asm volatile("s_waitcnt lgkmcnt(0)" ::: "memory");
}
struct CvtItem { const float* W; bf16_t* WT; int K, N, k0, n0, drow0; };
__device__ __forceinline__ void cvt32_load(const CvtItem& it, int lane, f32x4 (&v)[8]) {
    const int n4 = (lane & 7) * 4;
#pragma unroll
    for (int i = 0; i < 8; ++i) { const int kk = 8 * i + (lane >> 3); v[i] = __builtin_nontemporal_load((const f32x4*)(it.W + (size_t)(it.k0 + kk) * it.N + it.n0 + n4)); }
}
__device__ __forceinline__ void cvt32_finish(const CvtItem& it, int lane, const f32x4 (&v)[8], LAS float* scr) {
    const int n4 = (lane & 7) * 4;
#pragma unroll
    for (int i = 0; i < 8; ++i) { const int kk = 8 * i + (lane >> 3); LAS float* d = scr + kk * 33 + n4; d[0] = v[i][0]; d[1] = v[i][1]; d[2] = v[i][2]; d[3] = v[i][3]; }
    asm volatile("s_waitcnt lgkmcnt(0)" ::: "memory");
    const int c = lane & 7;
#pragma unroll
    for (int j = 0; j < 4; ++j) { const int n = (lane >> 3) + 8 * j; const LAS float* sp = scr + (8 * c) * 33 + n;
        const float v0 = sp[0 * 33], v1 = sp[1 * 33], v2 = sp[2 * 33], v3 = sp[3 * 33], v4 = sp[4 * 33], v5 = sp[5 * 33], v6 = sp[6 * 33], v7 = sp[7 * 33];
        u32x2 o; o.x = pk4_fp8(v0 * W8_SCALE, v1 * W8_SCALE, v2 * W8_SCALE, v3 * W8_SCALE); o.y = pk4_fp8(v4 * W8_SCALE, v5 * W8_SCALE, v6 * W8_SCALE, v7 * W8_SCALE);
        __builtin_nontemporal_store(o, (u32x2*)((unsigned char*)it.WT + (size_t)(it.drow0 + n) * it.K + it.k0 + 8 * c)); }
    asm volatile("s_waitcnt lgkmcnt(0)" ::: "memory");
}
constexpr int CVT1_ITEMS = 257 * 384;
__device__ __forceinline__ CvtItem cvt1_item(const Args& a, int idx) {
    const int e = idx / 384, sub = idx % 384, mat = sub >> 7, r = sub & 127;
    CvtItem it;
    if (mat < 2) { it.W = (e < 256) ? a.in[23 + mat] + ((size_t)256 + e) * (size_t)(D * FF) : a.in[26 + mat] + (size_t)(D * FF);
        it.K = D; it.N = FF; it.k0 = (r >> 3) * 64; it.n0 = (r & 7) * 32; it.drow0 = (it.n0 >> 7) * 256 + mat * 128 + (it.n0 & 127);
        it.WT = (bf16_t*)(a.ws + WS_WGU + (size_t)(257 + e) * 512 * 1024); }
    else { it.W = (e < 256) ? a.in[25] + ((size_t)256 + e) * (size_t)(FF * D) : a.in[28] + (size_t)(FF * D);
        it.K = FF; it.N = D; it.k0 = (r >> 5) * 64; it.n0 = (r & 31) * 32; it.drow0 = it.n0;
        it.WT = (bf16_t*)(a.ws + WS_WD + (size_t)(257 + e) * 1024 * 256); }
    return it;
}
__device__ __forceinline__ void cvt1_run(const Args& a, int& next, int stride, int quota, LAS float* scr, int lane) {
#pragma unroll 1
    for (int q = 0; q < quota && next < CVT1_ITEMS; ++q) {
        CvtItem t[4]; f32x4 v[4][8]; bool ok[4];
#pragma unroll
        for (int u = 0; u < 4; ++u) { const int idx = next + u * stride; ok[u] = idx < CVT1_ITEMS; t[u] = cvt1_item(a, ok[u] ? idx : 0); if (ok[u]) cvt32_load(t[u], lane, v[u]); }
        next += 4 * stride;
#pragma unroll
        for (int u = 0; u < 4; ++u) if (ok[u]) cvt32_finish(t[u], lane, v[u], scr);
    }
}
__device__ __forceinline__ void ph_prologue(const Args& a, LAS unsigned char* lds) {
    const int lane = threadIdx.x & 63, wave = threadIdx.x >> 6;
    LAS float* scr = (LAS float*)(lds + wave * 16640);
    const int gw = blockIdx.x * 8 + wave, ngw = gridDim.x * 8;
    for (int it = gw; it < 257 * 192; it += ngw) {
        const int le = it / 192, sub = it % 192, l = 0, e = le, mat = sub >> 6, r = sub & 63;
        if (mat < 2) {
            const float* W = (e < 256) ? a.in[23 + mat] + ((size_t)l * 256 + e) * (size_t)(D * FF) : a.in[26 + mat] + (size_t)l * (D * FF);
            const int kb = r >> 2, n0 = (r & 3) * 64;
            p0_item(W, D, FF, (bf16_t*)(a.ws + WS_WGU + (size_t)le * 512 * 1024), kb, n0, (n0 >> 7) * 256 + mat * 128 + (n0 & 127), scr, lane, true);
        } else {
            const float* W = (e < 256) ? a.in[25] + ((size_t)l * 256 + e) * (size_t)(FF * D) : a.in[28] + (size_t)l * (FF * D);
            const int kb = r >> 4, n0 = (r & 15) * 64;
            p0_item(W, FF, D, (bf16_t*)(a.ws + WS_WD + (size_t)le * 1024 * 256), kb, n0, n0, scr, lane, true);
        }
    }
    {
        for (int it = gw; it < 512; it += ngw) { const int w = it >> 8, r = it & 255;
            p0_item(a.in[w ? 16 : 8], D, D, (bf16_t*)(a.ws + (w ? WS_WOUTN : WS_WOUT0)), r >> 4, (r & 15) * 64, (r & 15) * 64, scr, lane); }
        for (int it = gw; it < 16 * 41; it += ngw) p0_item(a.in[9], D, 2608, (bf16_t*)(a.ws + WS_WINN), it / 41, (it % 41) * 64, (it % 41) * 64, scr, lane);
        for (int it = gw; it < 128; it += ngw) { const int l = it >> 6, r = it & 63;
            p0_item(a.in[21] + (size_t)l * D * NE, D, NE, (bf16_t*)(a.ws + WS_WR) + (size_t)l * NE * D, r >> 2, (r & 3) * 64, (r & 3) * 64, scr, lane); }
        for (int it = gw; it < 16 * 16; it += ngw) { const int kb = it >> 4, n0 = (8 + (it & 15)) * 64;
            const int isg = (n0 >= 1024) ? 1 : 0, rel = n0 - 512 - isg * 512;
            p0_item(a.in[1], D, 1536, (bf16_t*)(a.ws + WS_WIN0), kb, n0, 512 + (rel >> 7) * 256 + isg * 128 + (rel & 127), scr, lane); }
        for (int it = gw; it < 128; it += ngw) { const int kv = it >> 6, r = it & 63;
            p0_item(a.in[kv ? 14 : 11], 2048, 128, (bf16_t*)(a.ws + WS_CW1) + (size_t)kv * 256 * 2048, r >> 1, (r & 1) * 64, (r & 1) * 64, scr, lane); }
    }
    {
        const int gt = blockIdx.x * 512 + threadIdx.x, ngt = gridDim.x * 512;
        u32x4* z0 = (u32x4*)((bf16_t*)(a.ws + WS_WINN) + (size_t)2608 * 1024);
        for (int i = gt; i < 208 * 1024 / 8; i += ngt) z0[i] = (u32x4){0u, 0u, 0u, 0u};
        for (int kv = 0; kv < 2; ++kv) { u32x4* z1 = (u32x4*)((bf16_t*)(a.ws + WS_CW1) + ((size_t)kv * 256 + 128) * 2048);
            for (int i = gt; i < 128 * 2048 / 8; i += ngt) z1[i] = (u32x4){0u, 0u, 0u, 0u}; }
        const float* x = a.in[0]; bf16_t* XA = (bf16_t*)(a.ws + WS_XA);
        for (size_t i = gt; i < (size_t)M * D / 8; i += ngt) { const f32x4 v0 = *(const f32x4*)(x + i * 8), v1 = *(const f32x4*)(x + i * 8 + 4);
            u32x4 o; o.x = pk2(v0[0], v0[1]); o.y = pk2(v0[2], v0[3]); o.z = pk2(v1[0], v1[1]); o.w = pk2(v1[2], v1[3]); *(u32x4*)(XA + i * 8) = o; }
        const float* win = a.in[1]; const float* mix = a.in[2]; const float* psc = a.in[3]; bf16_t* WIN0 = (bf16_t*)(a.ws + WS_WIN0);
        for (int i = gt; i < 512 * 1024; i += ngt) { const int n = i & 511, k = i >> 9, g = n >> 7, nn = n & 127;
            const float* wr_ = win + (size_t)k * 1536 + g * 128; const float* mx = mix + (size_t)g * 128 * 128 + nn;
            float s = 0.f;
            for (int c = 0; c < 128; ++c) s += wr_[c] * mx[(size_t)c * 128];
            WIN0[(size_t)n * 1024 + k] = f2bf(s * psc[n]); }
        float* misc = (float*)(a.ws + WS_MISC);
        for (int i = gt; i < 256; i += ngt) { const int kv = i >> 7, j = i & 127; const float* pos = a.in[kv ? 13 : 10]; const float* w1 = a.in[kv ? 14 : 11];
            float s = 0.f; for (int k = 0; k < 2048; ++k) s += pos[k] * w1[(size_t)k * 128 + j]; misc[i] = s; }
        float* rot = misc + 1024;
        for (int i = gt; i < T * 8; i += ngt) { const int t = i >> 3, f = i & 7;
            const float ang = (float)t * a.inv_freq[f]; const double rev = (double)ang * 0.15915494309189535; const float fr = (float)(rev - floor(rev));
            rot[t * 16 + f] = __builtin_amdgcn_cosf(fr); rot[t * 16 + 8 + f] = __builtin_amdgcn_sinf(fr); }
    }
}

typedef short v4i16_t __attribute__((ext_vector_type(4)));
constexpr int AT_KB = 0, AT_VB = 16384, AT_PS = 32768, AT_MSK = 32768 + 65536;
#define DPP_I(x, ctrl) __builtin_amdgcn_update_dpp((int)(x), (int)(x), (ctrl), 0xF, 0xF, true)
#define DPP_F(x, ctrl) __builtin_bit_cast(float, __builtin_amdgcn_update_dpp(__builtin_bit_cast(int, (float)(x)), __builtin_bit_cast(int, (float)(x)), (ctrl), 0xF, 0xF, true))
__device__ __forceinline__ bf16x8 tr_frag(LAS unsigned char* p0, LAS unsigned char* p1) {
    const v4i16_t a = __builtin_amdgcn_ds_read_tr16_b64_v4i16((LAS v4i16_t*)p0), b = __builtin_amdgcn_ds_read_tr16_b64_v4i16((LAS v4i16_t*)p1);
    return (bf16x8){a[0], a[1], a[2], a[3], b[0], b[1], b[2], b[3]};
}
constexpr size_t TN2_OFF = 786432;
__device__ __forceinline__ void ph_knorm(const Args& a) {
    const bf16_t* KV6 = (const bf16_t*)(a.ws + WS_KV6);
    float* TN2 = (float*)(a.ws + WS_MISC + TN2_OFF);
    const int lane = threadIdx.x & 63, wave = threadIdx.x >> 6;
    const int first = (gridDim.x > 64) ? 64 : 0;
    if ((int)blockIdx.x < first) return;
    const int wi = ((int)blockIdx.x - first) * 8 + wave, nw = ((int)gridDim.x - first) * 8;
    for (int id = wi; id < 4096; id += nw) {
        const int ty = id >> 11, bg = (id >> 7) & 15, tile = id & 127;
        const bf16_t* rp = KV6 + ((size_t)((ty ? 4 : 2) * 16 + bg) * T + tile * 64 + lane) * 64;
        float ssq = 0.f;
#pragma unroll
        for (int c = 0; c < 8; ++c) { const bf16x8 v = *(const bf16x8*)(rp + 8 * c);
#pragma unroll
            for (int j = 0; j < 8; ++j) { const float f = bf2f((bf16_t)v[j]); ssq += f * f; } }
        ssq = wave_max(ssq);
        if (lane == 0) TN2[id] = ssq;
    }
}
__device__ __forceinline__ void attn_qk2(LAS unsigned char* Kb, const bf16x8 (&q)[2][2], int fr, int g4, const float (&cinit)[2], f32x4 (&s)[2][4]) {
#pragma unroll
    for (int c = 0; c < 4; ++c) {
#pragma unroll
        for (int rb = 0; rb < 2; ++rb) s[rb][c] = (f32x4){cinit[rb], cinit[rb], cinit[rb], cinit[rb]};
#pragma unroll
        for (int ks = 0; ks < 2; ++ks) {
            const bf16x8 kf = *(const LAS bf16x8*)(Kb + pg8::lds_byte(16 * c + fr, 32 * ks + 8 * g4));
#pragma unroll
            for (int rb = 0; rb < 2; ++rb) s[rb][c] = __builtin_amdgcn_mfma_f32_16x16x32_bf16(kf, q[rb][ks], s[rb][c], 0, 0, 0);
        }
    }
}
__device__ __forceinline__ void attn_qk2m(LAS unsigned char* Kb, const bf16x8 (&q)[2][2], int fr, int g4, const float (&cinit)[2], f32x4 (&s)[2][4]) {
    bf16x8 kf[4][2];
#pragma unroll
    for (int c = 0; c < 4; ++c)
#pragma unroll
        for (int ks = 0; ks < 2; ++ks) kf[c][ks] = *(const LAS bf16x8*)(Kb + pg8::lds_byte(16 * c + fr, 32 * ks + 8 * g4));
    __builtin_amdgcn_sched_barrier(0);
    f32x4 ci[2];
#pragma unroll
    for (int rb = 0; rb < 2; ++rb) ci[rb] = (f32x4){cinit[rb], cinit[rb], cinit[rb], cinit[rb]};
#pragma unroll
    for (int c = 0; c < 4; ++c) {
#pragma unroll
        for (int ks = 0; ks < 2; ++ks) {
#pragma unroll
            for (int rb = 0; rb < 2; ++rb) s[rb][c] = __builtin_amdgcn_mfma_f32_16x16x32_bf16(kf[c][ks], q[rb][ks], ks == 0 ? ci[rb] : s[rb][c], 0, 0, 0);
        }
    }
}
__device__ __forceinline__ void attn_qk2z(LAS unsigned char* Kb, const bf16x8 (&q)[2][2], int fr, int g4, f32x4 (&s)[2][4]) {
    bf16x8 kf[4][2];
#pragma unroll
    for (int c = 0; c < 4; ++c)
#pragma unroll
        for (int ks = 0; ks < 2; ++ks) kf[c][ks] = *(const LAS bf16x8*)(Kb + pg8::lds_byte(16 * c + fr, 32 * ks + 8 * g4));
    __builtin_amdgcn_sched_barrier(0);
#pragma unroll
    for (int c = 0; c < 4; ++c) {
#pragma unroll
        for (int ks = 0; ks < 2; ++ks) {
#pragma unroll
            for (int rb = 0; rb < 2; ++rb) s[rb][c] = __builtin_amdgcn_mfma_f32_16x16x32_bf16(kf[c][ks], q[rb][ks], ks == 0 ? (f32x4){0.f, 0.f, 0.f, 0.f} : s[rb][c], 0, 0, 0);
        }
    }
}
struct AttnRow { float m; f32x4 o[4]; f32x4 ol; };
__device__ __forceinline__ float max3f(float a, float b, float c) { float r; asm("v_max3_f32 %0, %1, %2, %3" : "=v"(r) : "v"(a), "v"(b), "v"(c)); return r; }
__device__ __forceinline__ bool attn_sm2(f32x4 (&s)[4], AttnRow& st, int kbase, int g4, int lo, int hi, bool en, bool emask) {
    const float NEG = -INFINITY;
    if (emask) {
#pragma unroll
        for (int c = 0; c < 4; ++c)
#pragma unroll
            for (int i = 0; i < 4; ++i) { const int key = kbase + 16 * c + 4 * g4 + i; if (key < lo || key > hi) s[c][i] = NEG; }
    }
    float mx = max3f(s[0][0], s[0][1], s[0][2]); mx = max3f(mx, s[0][3], s[1][0]); mx = max3f(mx, s[1][1], s[1][2]); mx = max3f(mx, s[1][3], s[2][0]);
    mx = max3f(mx, s[2][1], s[2][2]); mx = max3f(mx, s[2][3], s[3][0]); mx = max3f(mx, s[3][1], s[3][2]); mx = max3f(mx, s[3][3], mx);
    if (!en) mx = NEG;
    mx = max3f(mx, __shfl_xor(mx, 16), mx); mx = max3f(mx, __shfl_xor(mx, 32), mx);
    const float delta = (mx > 20.0f) ? mx : 0.f;
    const bool moved = __builtin_amdgcn_ballot_w64(delta != 0.f) != 0ull;
    if (moved) {
        const float alpha = __builtin_amdgcn_exp2f(-delta);
#pragma unroll
        for (int c = 0; c < 4; ++c) s[c] = s[c] - delta;
#pragma unroll
        for (int dt = 0; dt < 4; ++dt) st.o[dt] *= alpha;
        st.ol *= alpha;
        st.m += delta;
    }
#pragma unroll
    for (int c = 0; c < 4; ++c)
#pragma unroll
        for (int i = 0; i < 4; ++i) s[c][i] = __builtin_amdgcn_exp2f(s[c][i]);
    return moved;
}
__device__ __forceinline__ bool attn_sm2x(f32x4 (&s)[2][4], AttnRow (&st)[2], int kbase, int g4, const int (&lo)[2], const int (&hi)[2], const bool (&en)[2], bool emask) {
    const float NEG = -INFINITY;
    if (emask) {
#pragma unroll
        for (int rb = 0; rb < 2; ++rb)
#pragma unroll
            for (int c = 0; c < 4; ++c)
#pragma unroll
                for (int i = 0; i < 4; ++i) { const int key = kbase + 16 * c + 4 * g4 + i; if (key < lo[rb] || key > hi[rb]) s[rb][c][i] = NEG; }
    }
    float mx[2];
#pragma unroll
    for (int rb = 0; rb < 2; ++rb) {
        float m = max3f(s[rb][0][0], s[rb][0][1], s[rb][0][2]); m = max3f(m, s[rb][0][3], s[rb][1][0]); m = max3f(m, s[rb][1][1], s[rb][1][2]); m = max3f(m, s[rb][1][3], s[rb][2][0]);
        m = max3f(m, s[rb][2][1], s[rb][2][2]); m = max3f(m, s[rb][2][3], s[rb][3][0]); m = max3f(m, s[rb][3][1], s[rb][3][2]); m = max3f(m, s[rb][3][3], m);
        mx[rb] = en[rb] ? m : NEG;
    }
    { const float t0 = __shfl_xor(mx[0], 16), t1 = __shfl_xor(mx[1], 16); mx[0] = max3f(mx[0], t0, t0); mx[1] = max3f(mx[1], t1, t1); }
    { const float t0 = __shfl_xor(mx[0], 32), t1 = __shfl_xor(mx[1], 32); mx[0] = max3f(mx[0], t0, t0); mx[1] = max3f(mx[1], t1, t1); }
    const float d0 = (mx[0] > 20.0f) ? mx[0] : 0.f, d1 = (mx[1] > 20.0f) ? mx[1] : 0.f;
    const bool moved = __builtin_amdgcn_ballot_w64((d0 != 0.f) || (d1 != 0.f)) != 0ull;
    if (moved) {
        const float dl[2] = {d0, d1};
#pragma unroll
        for (int rb = 0; rb < 2; ++rb) {
            const float alpha = __builtin_amdgcn_exp2f(-dl[rb]);
#pragma unroll
            for (int c = 0; c < 4; ++c) s[rb][c] = s[rb][c] - dl[rb];
#pragma unroll
            for (int dt = 0; dt < 4; ++dt) st[rb].o[dt] *= alpha;
            st[rb].ol *= alpha; st[rb].m += dl[rb];
        }
    }
#pragma unroll
    for (int rb = 0; rb < 2; ++rb)
#pragma unroll
        for (int c = 0; c < 4; ++c)
#pragma unroll
            for (int i = 0; i < 4; ++i) s[rb][c][i] = __builtin_amdgcn_exp2f(s[rb][c][i]);
    return moved;
}
__device__ __forceinline__ void attn_pv2x(LAS unsigned char* Vb, const f32x4 (&p)[2][4], int vlane, int swz, const unsigned (&enm)[2], const bool (&act)[2], const bf16x8 onesf, AttnRow (&st)[2]) {
#pragma unroll
    for (int ks = 0; ks < 2; ++ks) {
        bf16x8 pb[2];
#pragma unroll
        for (int rb = 0; rb < 2; ++rb) { u32x4 pw = pack8m(p[rb][2 * ks], p[rb][2 * ks + 1]); pw.x &= enm[rb]; pw.y &= enm[rb]; pw.z &= enm[rb]; pw.w &= enm[rb]; pb[rb] = __builtin_bit_cast(bf16x8, pw); }
#pragma unroll
        for (int dt = 0; dt < 4; ++dt) {
            LAS unsigned char* a0 = Vb + vlane + (2 * ks) * 2048 + ((dt ^ swz) * 32);
            const bf16x8 vf = tr_frag(a0, a0 + 2048);
#pragma unroll
            for (int rb = 0; rb < 2; ++rb) if (act[rb]) st[rb].o[dt] = __builtin_amdgcn_mfma_f32_16x16x32_bf16(vf, pb[rb], st[rb].o[dt], 0, 0, 0);
        }
#pragma unroll
        for (int rb = 0; rb < 2; ++rb) if (act[rb]) st[rb].ol = __builtin_amdgcn_mfma_f32_16x16x32_bf16(onesf, pb[rb], st[rb].ol, 0, 0, 0);
    }
}
__device__ __forceinline__ bool attn_max2x(f32x4 (&s)[2][4], int kbase, int g4, const int (&lo)[2], const int (&hi)[2], const bool (&en)[2], bool emask, float (&d)[2]) {
    const float NEG = -INFINITY;
    MFMA_SETTLE(s);
    if (emask) {
#pragma unroll
        for (int rb = 0; rb < 2; ++rb)
#pragma unroll
            for (int c = 0; c < 4; ++c)
#pragma unroll
                for (int i = 0; i < 4; ++i) { const int key = kbase + 16 * c + 4 * g4 + i; if (key < lo[rb] || key > hi[rb]) s[rb][c][i] = NEG; }
    }
    float mx[2];
#pragma unroll
    for (int rb = 0; rb < 2; ++rb) {
        float m = max3f(s[rb][0][0], s[rb][0][1], s[rb][0][2]); m = max3f(m, s[rb][0][3], s[rb][1][0]); m = max3f(m, s[rb][1][1], s[rb][1][2]); m = max3f(m, s[rb][1][3], s[rb][2][0]);
        m = max3f(m, s[rb][2][1], s[rb][2][2]); m = max3f(m, s[rb][2][3], s[rb][3][0]); m = max3f(m, s[rb][3][1], s[rb][3][2]); m = max3f(m, s[rb][3][3], m);
        mx[rb] = en[rb] ? m : NEG;
    }
    { const float t0 = __shfl_xor(mx[0], 16), t1 = __shfl_xor(mx[1], 16); mx[0] = max3f(mx[0], t0, t0); mx[1] = max3f(mx[1], t1, t1); }
    { const float t0 = __shfl_xor(mx[0], 32), t1 = __shfl_xor(mx[1], 32); mx[0] = max3f(mx[0], t0, t0); mx[1] = max3f(mx[1], t1, t1); }
    d[0] = (mx[0] > 20.0f) ? mx[0] : 0.f; d[1] = (mx[1] > 20.0f) ? mx[1] : 0.f;
    return __builtin_amdgcn_ballot_w64((d[0] != 0.f) || (d[1] != 0.f)) != 0ull;
}
__device__ __forceinline__ void attn_rescale2x(f32x4 (&s)[2][4], AttnRow (&st)[2], const float (&d)[2]) {
#pragma unroll
    for (int rb = 0; rb < 2; ++rb) {
        const float alpha = __builtin_amdgcn_exp2f(-d[rb]);
#pragma unroll
        for (int c = 0; c < 4; ++c) s[rb][c] = s[rb][c] - d[rb];
#pragma unroll
        for (int dt = 0; dt < 4; ++dt) st[rb].o[dt] *= alpha;
        st[rb].ol *= alpha; st[rb].m += d[rb];
    }
}
__device__ __forceinline__ void attn_exp1(f32x4 (&s)[4], unsigned enm, bf16x8 (&pb)[2]) {
#pragma unroll
    for (int c = 0; c < 4; ++c)
#pragma unroll
        for (int i = 0; i < 4; ++i) s[c][i] = __builtin_amdgcn_exp2f(s[c][i]);
#pragma unroll
    for (int ks = 0; ks < 2; ++ks) { u32x4 pw = pack8m(s[2 * ks], s[2 * ks + 1]); pw.x &= enm; pw.y &= enm; pw.z &= enm; pw.w &= enm; pb[ks] = __builtin_bit_cast(bf16x8, pw); }
}
__device__ __forceinline__ void attn_pv1(LAS unsigned char* Vb, const bf16x8 (&pb)[2], int vlane, int swz, const bf16x8 onesf, AttnRow& st) {
#pragma unroll
    for (int ks = 0; ks < 2; ++ks) {
#pragma unroll
        for (int dt = 0; dt < 4; ++dt) {
            LAS unsigned char* a0 = Vb + vlane + (2 * ks) * 2048 + ((dt ^ swz) * 32);
            const bf16x8 vf = tr_frag(a0, a0 + 2048);
            st.o[dt] = __builtin_amdgcn_mfma_f32_16x16x32_bf16(vf, pb[ks], st.o[dt], 0, 0, 0);
        }
        st.ol = __builtin_amdgcn_mfma_f32_16x16x32_bf16(onesf, pb[ks], st.ol, 0, 0, 0);
    }
}
__device__ __forceinline__ bool attn_step2x(LAS unsigned char* Vb, f32x4 (&s)[2][4], AttnRow (&st)[2], int kbase, int g4, const int (&lo)[2], const int (&hi)[2], const bool (&en)[2], const unsigned (&enm)[2], bool emask,
                                            int vlane, int swz, const bf16x8 onesf) {
    float d[2];
    const bool moved = attn_max2x(s, kbase, g4, lo, hi, en, emask, d);
    if (moved) attn_rescale2x(s, st, d);
    bf16x8 p0[2], p1[2];
    attn_exp1(s[0], enm[0], p0);
    attn_pv1(Vb, p0, vlane, swz, onesf, st[0]);
    attn_exp1(s[1], enm[1], p1);
    attn_pv1(Vb, p1, vlane, swz, onesf, st[1]);
    return moved;
}
__device__ __forceinline__ void attn_step2x_nomax(LAS unsigned char* Vb, f32x4 (&s)[2][4], AttnRow (&st)[2], int kbase, int g4, const int (&lo)[2], const int (&hi)[2], const unsigned (&enm)[2], bool emask,
                                                  int vlane, int swz, const bf16x8 onesf) {
    if (emask) {
#pragma unroll
        for (int rb = 0; rb < 2; ++rb)
#pragma unroll
            for (int c = 0; c < 4; ++c)
#pragma unroll
                for (int i = 0; i < 4; ++i) { const int key = kbase + 16 * c + 4 * g4 + i; if (key < lo[rb] || key > hi[rb]) s[rb][c][i] = -INFINITY; }
    }
    bf16x8 p0[2], p1[2];
    attn_exp1(s[0], enm[0], p0);
    attn_pv1(Vb, p0, vlane, swz, onesf, st[0]);
    attn_exp1(s[1], enm[1], p1);
    attn_pv1(Vb, p1, vlane, swz, onesf, st[1]);
}
typedef _Float16 f16x4 __attribute__((ext_vector_type(4)));
constexpr int AT4_KB = 0, AT4_VB = 32768, AT2_PS = 65536, AT2_MSK = 65536 + 65536;
__device__ __forceinline__ void ph_attn_fast2(const Args& a, LAS unsigned char* lds) {
    const bf16_t* QN = (const bf16_t*)(a.ws + WS_HN);
    const bf16_t* QR = (const bf16_t*)(a.ws + WS_QR);
    const bf16_t* KV6 = (const bf16_t*)(a.ws + WS_KV6);
    const float* GATES = (const float*)(a.ws + WS_GATES);
    const bf16_t* KC = (const bf16_t*)(a.ws + WS_KC);
    const bf16_t* VC = KC + (size_t)8192 * 64;
    bf16_t* O = (bf16_t*)(a.ws + WS_O);
    const int tid = threadIdx.x, lane = tid & 63, wave = __builtin_amdgcn_readfirstlane(tid >> 6);
    const int fr = lane & 15, g4 = lane >> 4;
    int ksrc, vsrc;
    { int R, C; pg8::stage_rc(wave * 1024 + lane * 16, R, C); ksrc = R * 64 + C;
      const int key = 8 * wave + (lane >> 3), pos = lane & 7, chunk = (pos >> 1) ^ ((key >> 1) & 3); vsrc = key * 64 + (chunk * 2 + (pos & 1)) * 8; }
    const int vlane = (4 * g4 + (fr >> 2)) * 128 + (fr & 3) * 8, swz = (2 * g4 + (fr >> 3)) & 3;
    LAS _Float16* ps = (LAS _Float16*)(lds + AT2_PS + wave * 8192);
    LAS unsigned* mskl = (LAS unsigned*)(lds + AT2_MSK + wave * 128);
    const float NEG = -INFINITY;
    const bf16x8 onesf = (fr == 0) ? (bf16x8){0x3F80, 0x3F80, 0x3F80, 0x3F80, 0x3F80, 0x3F80, 0x3F80, 0x3F80} : (bf16x8){0, 0, 0, 0, 0, 0, 0, 0};
    const int vcu = (gridDim.x % 8 == 0) ? (int)((blockIdx.x % 8) * (gridDim.x / 8) + blockIdx.x / 8) : (int)blockIdx.x;
    int cvt_next = (int)blockIdx.x * 8 + wave; const int cvt_stride = (int)gridDim.x * 8;
    LAS float* cvt_scr = (LAS float*)(lds + AT2_PS + wave * 8448);
    bool cmp_pref = false;
    for (int pr = vcu; pr < 1024; pr += gridDim.x) {
#pragma unroll 1
        for (int half = 0; half < 2; ++half) {
            const int bg = pr >> 6, cc = half ? (127 - (pr & 63)) : (pr & 63);
            const int b = bg >> 2, g = bg & 3, t0 = cc * 64, cur = cc;
            const int head = g * 4 + (fr & 3);
            int trow[2];
            bf16x8 qn[2][2];
#pragma unroll
            for (int rb = 0; rb < 2; ++rb) {
                trow[rb] = t0 + 8 * wave + 4 * rb + (fr >> 2);
#pragma unroll
                for (int ks = 0; ks < 2; ++ks) qn[rb][ks] = *(const bf16x8*)(QN + ((size_t)b * T + trow[rb]) * 1024 + head * 64 + 32 * ks + 8 * g4);
            }
#define TROW_PIN() asm volatile("" : "+v"(trow[0]), "+v"(trow[1]))
#define TOKROW(rb) ((size_t)b * T + trow[rb])
#define GATE(rb, br) (GATES[TOKROW(rb) * 48 + head * 3 + (br)])
            const bf16_t* kcb = KC + (size_t)bg * 512 * 64;
            const bf16_t* kvb = KV6 + (size_t)bg * T * 64;
#define ATK(sl) (((sl) < 4 ? AT4_KB : AT2_PS - 4 * 8192) + (sl) * 8192)
#define ATV(sl) (((sl) < 4 ? AT4_VB : AT2_PS + 32768 - 4 * 8192) + (sl) * 8192)
#define AT_DMA(BR, tile, slot) do { const bf16_t* kp_; const bf16_t* vp_; \
                if ((BR) == 0) { kp_ = kcb + (size_t)(tile) * 4096; vp_ = kp_ + (size_t)8192 * 64; } \
                else { kp_ = kvb + (size_t)((BR) == 1 ? 2 : 4) * 16 * T * 64 + (size_t)(tile) * 4096; vp_ = kp_ + (size_t)16 * T * 64; } \
                __builtin_amdgcn_global_load_lds((const unsigned*)(kp_ + ksrc), (LAS unsigned*)(lds + ATK(slot) + wave * 1024), 16, 0, 0); \
                __builtin_amdgcn_global_load_lds((const unsigned*)(vp_ + vsrc), (LAS unsigned*)(lds + ATV(slot) + wave * 1024), 16, 0, 0); } while (0)
            int ncv[2];
#pragma unroll
            for (int rb = 0; rb < 2; ++rb) ncv[rb] = (trow[rb] >= 31) ? ((trow[rb] - 31) / 16 + 1) : 0;
            const int nct = (((t0 + 63 - 31) / 16 + 1) + 63) >> 6;
            float mc[2], invc[2];
            const int t_lo = t0 + 8 * wave, ncv_lo = (t_lo >= 31) ? ((t_lo - 31) / 16 + 1) : 0;
            {
                float m1[2] = {NEG, NEG}, l1[2] = {0.f, 0.f};
                const float zero2[2] = {0.f, 0.f};
#define CMP1_TILE(J, SLOT, MASKED) do { const int j = (J); const int SLOT_ = (SLOT); \
                    f32x4 s[2][4]; attn_qk2(lds + AT4_KB + SLOT_ * 8192, qn, fr, g4, zero2, s); \
                    _Pragma("unroll") \
                    for (int rb = 0; rb < 2; ++rb) { \
                        float mx = NEG; \
                    _Pragma("unroll") \
                        for (int c = 0; c < 4; ++c) \
                    _Pragma("unroll") \
                            for (int i = 0; i < 4; ++i) { const int n = 64 * j + 16 * c + 4 * g4 + i; if ((MASKED) && n >= ncv[rb]) s[rb][c][i] = NEG; mx = fmaxf(mx, s[rb][c][i]); } \
                        mx = fmaxf(mx, __shfl_xor(mx, 16)); mx = fmaxf(mx, __shfl_xor(mx, 32)); \
                        const float mn = fmaxf(m1[rb], mx), msafe = (mn == NEG) ? 0.f : mn; \
                        const float alpha = (m1[rb] == NEG) ? 0.f : __builtin_amdgcn_exp2f(m1[rb] - msafe); \
                        float sum = 0.f; \
                    _Pragma("unroll") \
                        for (int c = 0; c < 4; ++c) \
                    _Pragma("unroll") \
                            for (int i = 0; i < 4; ++i) sum += __builtin_amdgcn_exp2f(s[rb][c][i] - msafe); \
                        l1[rb] = l1[rb] * alpha + sum; m1[rb] = mn; \
                    } \
                } while (0)
                if (!cmp_pref) { AT_DMA(0, 0, 0); if (nct > 1) AT_DMA(0, 1, 1); } __syncthreads();
                for (int j0 = 0; j0 < nct; j0 += 2) { const int sb = (j0 & 2);
                    if (j0 + 2 < nct) AT_DMA(0, j0 + 2, sb ^ 2);
                    if (j0 + 3 < nct) AT_DMA(0, j0 + 3, (sb ^ 2) + 1);
                    CMP1_TILE(j0, sb, true); if (j0 + 1 < nct) CMP1_TILE(j0 + 1, sb + 1, true);
                    __syncthreads();
                }
#undef CMP1_TILE
#pragma unroll
                for (int rb = 0; rb < 2; ++rb) { float lc = l1[rb]; lc += __shfl_xor(lc, 16); lc += __shfl_xor(lc, 32); invc[rb] = (lc > 0.f) ? -(((m1[rb] == NEG) ? 0.f : m1[rb]) + __builtin_amdgcn_logf(lc)) : 0.f; mc[rb] = (m1[rb] == NEG) ? 0.f : m1[rb]; }
            }
            {
                AttnRow oc[2];
#pragma unroll
                for (int rb = 0; rb < 2; ++rb) { oc[rb].m = 0.f; oc[rb].ol = (f32x4){0.f, 0.f, 0.f, 0.f};
#pragma unroll
                    for (int dt = 0; dt < 4; ++dt) oc[rb].o[dt] = (f32x4){0.f, 0.f, 0.f, 0.f}; }
                const float cin[2] = {invc[0], invc[1]};
                const unsigned full[2] = {0xffffffffu, 0xffffffffu}; const bool both[2] = {true, true};
#define CMP2_TILE(J, SLOT, MASKED) do { const int j = (J); const int SLOT_ = (SLOT); \
                    f32x4 s[2][4]; attn_qk2(lds + AT4_KB + SLOT_ * 8192, qn, fr, g4, cin, s); \
                    _Pragma("unroll") \
                    for (int rb = 0; rb < 2; ++rb) \
                    _Pragma("unroll") \
                        for (int c = 0; c < 4; ++c) { \
                            f16x4 hs; \
                    _Pragma("unroll") \
                            for (int i = 0; i < 4; ++i) { const int n = 64 * j + 16 * c + 4 * g4 + i; const float p = (!(MASKED) || n < ncv[rb]) ? __builtin_amdgcn_exp2f(s[rb][c][i]) : 0.f; s[rb][c][i] = p; \
                                float h = p; h += DPP_F(h, 0xB1); h += DPP_F(h, 0x4E); hs[i] = (_Float16)h; }        \
                            if ((fr & 3) == 0) *(LAS f16x4*)(ps + (4 * rb + (fr >> 2)) * 512 + 64 * j + 16 * c + 4 * g4) = hs; \
                        } \
                    attn_pv2x(lds + AT4_VB + SLOT_ * 8192, s, vlane, swz, full, both, onesf, oc); \
                } while (0)
                const bool reload = nct > 4;
                if (reload) { AT_DMA(0, 0, 0); AT_DMA(0, 1, 1); __syncthreads(); }
                for (int j0 = 0; j0 < nct; j0 += 2) { const int sb = (j0 & 2);
                    if (reload && j0 + 2 < nct) AT_DMA(0, j0 + 2, sb ^ 2);
                    if (reload && j0 + 3 < nct) AT_DMA(0, j0 + 3, (sb ^ 2) + 1);
                    CMP2_TILE(j0, sb, true); if (j0 + 1 < nct) CMP2_TILE(j0 + 1, sb + 1, true);
                    __syncthreads();
                }
#undef CMP2_TILE
                TROW_PIN();
#pragma unroll
                for (int rb = 0; rb < 2; ++rb) { bf16_t* op = O + TOKROW(rb) * 1024 + head * 64 + 4 * g4; const float g0 = GATE(rb, 0);
#pragma unroll
                    for (int dt = 0; dt < 4; ++dt) { const f32x4 v = oc[rb].o[dt] * g0; u32x2 w; w.x = cvt_pk_bf16(v[0], v[1]); w.y = cvt_pk_bf16(v[2], v[3]); *(u32x2*)(op + 16 * dt) = w; } }
            }
            {
                WSYNC();
                const int tl = lane >> 4, li = lane & 15;
                const int nsel = (cur + 1 < 16) ? (cur + 1) : 16;
#pragma unroll 1
                for (int rnd = 0; rnd < 2; ++rnd) {
                    const LAS _Float16* pst = ps + (4 * rnd + tl) * 512;
                    float v[8];
#pragma unroll
                    for (int k = 0; k < 8; ++k) { const int j = li + 16 * k;
                        float x;
                        if (j > cur) x = NEG;
                        else if (j == 0 || j == cur || j == cur - 1) x = NEG;
                        else { const int n0 = 4 * j; x = (float)pst[n0 - 1] + 2.0f * ((float)pst[n0] + (float)pst[n0 + 1] + (float)pst[n0 + 2]) + (float)pst[n0 + 3]; }
                        v[k] = x; }
                    int vi[8];
#pragma unroll
                    for (int k = 0; k < 8; ++k) vi[k] = __builtin_bit_cast(int, v[k]);
                    unsigned mm[4] = {1u, 0u, 0u, 0u};
                    {
                        const unsigned bc = 1u << (cur & 31); const int wc_ = cur >> 5;
                        mm[0] |= (wc_ == 0) ? bc : 0u; mm[1] |= (wc_ == 1) ? bc : 0u; mm[2] |= (wc_ == 2) ? bc : 0u; mm[3] |= (wc_ == 3) ? bc : 0u;
                        if (cur >= 1) { const unsigned bp = 1u << ((cur - 1) & 31); const int wp_ = (cur - 1) >> 5;
                            mm[0] |= (wp_ == 0) ? bp : 0u; mm[1] |= (wp_ == 1) ? bp : 0u; mm[2] |= (wp_ == 2) ? bp : 0u; mm[3] |= (wp_ == 3) ? bp : 0u; }
                    }
                    const int nforced = (cur >= 2) ? 3 : (cur + 1);
                    for (int it = 0; it < nsel - nforced; ++it) {
                        int bv = max(max(max(vi[0], vi[1]), max(vi[2], vi[3])), max(max(vi[4], vi[5]), max(vi[6], vi[7])));
                        bv = max(bv, DPP_I(bv, 0xB1)); bv = max(bv, DPP_I(bv, 0x4E)); bv = max(bv, DPP_I(bv, 0x141)); bv = max(bv, DPP_I(bv, 0x140));
                        int bi = 255;
#pragma unroll
                        for (int k = 7; k >= 0; --k) bi = (vi[k] == bv) ? (li + 16 * k) : bi;
                        bi = min(bi, DPP_I(bi, 0xB1)); bi = min(bi, DPP_I(bi, 0x4E)); bi = min(bi, DPP_I(bi, 0x141)); bi = min(bi, DPP_I(bi, 0x140));
                        const unsigned bit = 1u << (bi & 31); const int wsel = bi >> 5;
                        mm[0] |= (wsel == 0) ? bit : 0u; mm[1] |= (wsel == 1) ? bit : 0u; mm[2] |= (wsel == 2) ? bit : 0u; mm[3] |= (wsel == 3) ? bit : 0u;
                        if ((bi & 15) == li) {
#pragma unroll
                            for (int k = 0; k < 8; ++k) if ((bi >> 4) == k) vi[k] = (int)0xFF800000;
                        }
                    }
                    if (li == 0) { mskl[(4 * rnd + tl) * 4 + 0] = mm[0]; mskl[(4 * rnd + tl) * 4 + 1] = mm[1]; mskl[(4 * rnd + tl) * 4 + 2] = mm[2]; mskl[(4 * rnd + tl) * 4 + 3] = mm[3]; }
                }
                WSYNC();
            }
            bf16x8 qr[2][2];
            TROW_PIN();
#pragma unroll
            for (int rb = 0; rb < 2; ++rb)
#pragma unroll
                for (int ks = 0; ks < 2; ++ks) qr[rb][ks] = *(const bf16x8*)(QR + TOKROW(rb) * 1024 + head * 64 + 32 * ks + 8 * g4);
            bool nomax_slc, nomax_win;
            {
                float qq = 0.f;
#pragma unroll
                for (int rb = 0; rb < 2; ++rb) { float q2 = 0.f;
#pragma unroll
                    for (int ks = 0; ks < 2; ++ks)
#pragma unroll
                        for (int j = 0; j < 8; ++j) { const float x = bf2f((bf16_t)qr[rb][ks][j]); q2 += x * x; }
                    q2 += __shfl_xor(q2, 16); q2 += __shfl_xor(q2, 32); qq = fmaxf(qq, q2); }
                qq = wave_max(qq);
                const float* tn = (const float*)(a.ws + WS_MISC + TN2_OFF) + bg * 128;
                const int jt0w = (t0 >= 511) ? ((t0 - 511) >> 6) : 0;
                float ts = 0.f, tw = 0.f;
#pragma unroll
                for (int h2 = 0; h2 < 2; ++h2) { const int tl_ = lane + 64 * h2; if (tl_ <= cur) { ts = fmaxf(ts, tn[tl_]); if (tl_ >= jt0w) tw = fmaxf(tw, tn[2048 + tl_]); } }
                ts = wave_max(ts); tw = wave_max(tw);
                nomax_slc = __builtin_amdgcn_readfirstlane((qq * ts <= 3500.0f) ? 1 : 0) != 0;
                nomax_win = __builtin_amdgcn_readfirstlane((qq * tw <= 3500.0f) ? 1 : 0) != 0;
            }
            {
                AttnRow ss[2];
#pragma unroll
                for (int rb = 0; rb < 2; ++rb) { ss[rb].m = 0.f; ss[rb].ol = (f32x4){0.f, 0.f, 0.f, 0.f};
#pragma unroll
                    for (int dt = 0; dt < 4; ++dt) ss[rb].o[dt] = (f32x4){0.f, 0.f, 0.f, 0.f}; }
                const int nt_ = cur + 1;
                bool refmoved = false;
#define SLC_PRE(J) const int j_ = (J); bool en[2], act[2]; unsigned enm[2]; \
                    _Pragma("unroll") for (int rb = 0; rb < 2; ++rb) { const unsigned mw = mwg[rb]; \
                        en[rb] = (mw >> (j_ & 31)) & 1u; act[rb] = __any(en[rb]); enm[rb] = en[rb] ? 0xffffffffu : 0u; } const int lo2[2] = {0, 0};
#define SLC_TILE(J, SLOT) do { SLC_PRE(J) \
                    if (act[0] || act[1]) { f32x4 s[2][4]; \
                        if (refmoved) { const float cin[2] = {-ss[0].m, -ss[1].m}; attn_qk2(lds + ATK(SLOT), qr, fr, g4, cin, s); } \
                        else attn_qk2z(lds + ATK(SLOT), qr, fr, g4, s); \
                        refmoved |= attn_step2x(lds + ATV(SLOT), s, ss, 64 * j_, g4, lo2, trow, en, enm, j_ == cur, vlane, swz, onesf); } } while (0)
#define SLC_TILE_NM(J, SLOT) do { SLC_PRE(J) \
                    if (act[0] || act[1]) { f32x4 s[2][4]; const float cm_[2] = {en[0] ? 0.f : -1e30f, en[1] ? 0.f : -1e30f}; attn_qk2m(lds + ATK(SLOT), qr, fr, g4, cm_, s); \
                        const unsigned fullm_[2] = {0xffffffffu, 0xffffffffu}; \
                        attn_step2x_nomax(lds + ATV(SLOT), s, ss, 64 * j_, g4, lo2, trow, fullm_, j_ == cur, vlane, swz, onesf); } } while (0)
#pragma unroll
                for (int i = 0; i < 4; ++i) if (i < nt_) AT_DMA(1, i, i);
                __syncthreads();
#define SLC_LOOP(TILE) for (int j0 = 0; j0 < nt_; j0 += 4) { const int sb = (j0 & 4); \
                    const unsigned mwg[2] = {mskl[(fr >> 2) * 4 + (j0 >> 5)], mskl[(4 + (fr >> 2)) * 4 + (j0 >> 5)]};       \
                    _Pragma("unroll") for (int i = 0; i < 4; ++i) if (j0 + 4 + i < nt_) AT_DMA(1, j0 + 4 + i, (sb ^ 4) + i); \
                    TILE(j0, sb); if (j0 + 1 < nt_) TILE(j0 + 1, sb + 1); if (j0 + 2 < nt_) TILE(j0 + 2, sb + 2); if (j0 + 3 < nt_) TILE(j0 + 3, sb + 3); \
                    __syncthreads(); }
                if (nomax_slc) { SLC_LOOP(SLC_TILE_NM) } else { SLC_LOOP(SLC_TILE) }
#undef SLC_LOOP
#undef SLC_TILE_NM
#undef SLC_PRE
#undef SLC_TILE
                TROW_PIN();
#pragma unroll
                for (int rb = 0; rb < 2; ++rb) { const float l = __shfl(ss[rb].ol[0], fr); const float sc1 = (l > 0.f) ? GATE(rb, 1) / l : 0.f;
                    bf16_t* op = O + TOKROW(rb) * 1024 + head * 64 + 4 * g4;
#pragma unroll
                    for (int dt = 0; dt < 4; ++dt) { const u32x2 pv = *(const u32x2*)(op + 16 * dt); f32x4 v = ss[rb].o[dt] * sc1;
                        v[0] += __uint_as_float(pv.x << 16); v[1] += __uint_as_float(pv.x & 0xffff0000u); v[2] += __uint_as_float(pv.y << 16); v[3] += __uint_as_float(pv.y & 0xffff0000u);
                        u32x2 w; w.x = cvt_pk_bf16(v[0], v[1]); w.y = cvt_pk_bf16(v[2], v[3]); *(u32x2*)(op + 16 * dt) = w; } }
            }
            {
                AttnRow sw[2];
#pragma unroll
                for (int rb = 0; rb < 2; ++rb) { sw[rb].m = 0.f; sw[rb].ol = (f32x4){0.f, 0.f, 0.f, 0.f};
#pragma unroll
                    for (int dt = 0; dt < 4; ++dt) sw[rb].o[dt] = (f32x4){0.f, 0.f, 0.f, 0.f}; }
                const int jt0 = (t0 >= 511) ? ((t0 - 511) >> 6) : 0;
                const int nt_ = cur - jt0 + 1;
                const unsigned full[2] = {0xffffffffu, 0xffffffffu}; const bool both[2] = {true, true};
                bool refmoved = false;
#define WIN_PRE(JJ) const int j = jt0 + (JJ); f32x4 s[2][4]; const bool edge = (j == cur) || (64 * j < t0 + 63 - 511); const int lo2[2] = {trow[0] - 511, trow[1] - 511};
#define WIN_TILE(JJ, SLOT) do { WIN_PRE(JJ) \
                    if (refmoved) { const float cin[2] = {-sw[0].m, -sw[1].m}; attn_qk2(lds + AT4_KB + (SLOT) * 8192, qr, fr, g4, cin, s); } \
                    else attn_qk2z(lds + AT4_KB + (SLOT) * 8192, qr, fr, g4, s); \
                    refmoved |= attn_step2x(lds + AT4_VB + (SLOT) * 8192, s, sw, 64 * j, g4, lo2, trow, both, full, edge, vlane, swz, onesf); } while (0)
#define WIN_TILE_NM(JJ, SLOT) do { WIN_PRE(JJ) attn_qk2z(lds + AT4_KB + (SLOT) * 8192, qr, fr, g4, s); \
                    attn_step2x_nomax(lds + AT4_VB + (SLOT) * 8192, s, sw, 64 * j, g4, lo2, trow, full, edge, vlane, swz, onesf); } while (0)
                AT_DMA(2, jt0, 0); if (nt_ > 1) AT_DMA(2, jt0 + 1, 1); __syncthreads();
#define WIN_LOOP(TILE) for (int j0 = 0; j0 < nt_; j0 += 2) { const int sb = (j0 & 2); \
                    if (j0 + 2 < nt_) AT_DMA(2, jt0 + j0 + 2, sb ^ 2); \
                    if (j0 + 3 < nt_) AT_DMA(2, jt0 + j0 + 3, (sb ^ 2) + 1); \
                    TILE(j0, sb); if (j0 + 1 < nt_) TILE(j0 + 1, sb + 1); \
                    __syncthreads(); }
                if (nomax_win) { WIN_LOOP(WIN_TILE_NM) } else { WIN_LOOP(WIN_TILE) }
#undef WIN_LOOP
#undef WIN_TILE_NM
#undef WIN_PRE
#undef WIN_TILE
                TROW_PIN();
#pragma unroll
                for (int rb = 0; rb < 2; ++rb) { const float l = __shfl(sw[rb].ol[0], fr); const float sc2 = (l > 0.f) ? GATE(rb, 2) / l : 0.f;
                    bf16_t* op = O + TOKROW(rb) * 1024 + head * 64 + 4 * g4;
#pragma unroll
                    for (int dt = 0; dt < 4; ++dt) { const u32x2 pv = *(const u32x2*)(op + 16 * dt); f32x4 v = sw[rb].o[dt] * sc2;
                        v[0] += __uint_as_float(pv.x << 16); v[1] += __uint_as_float(pv.x & 0xffff0000u); v[2] += __uint_as_float(pv.y << 16); v[3] += __uint_as_float(pv.y & 0xffff0000u);
                        u32x2 w; w.x = cvt_pk_bf16(v[0], v[1]); w.y = cvt_pk_bf16(v[2], v[3]); *(u32x2*)(op + 16 * dt) = w; } }
            }
#undef AT_DMA
#undef ATK
#undef ATV
#undef TROW_PIN
#undef TOKROW
#undef GATE
            {
                const int npr = half ? pr + (int)gridDim.x : pr, nhalf = half ^ 1;
                cmp_pref = npr < 1024;
                if (cmp_pref) { const int nbg = npr >> 6, ncc = nhalf ? (127 - (npr & 63)) : (npr & 63);
                    const int nnct = (((ncc * 64 + 63 - 31) / 16 + 1) + 63) >> 6;
                    const bf16_t* nk = KC + (size_t)nbg * 512 * 64;
                    __builtin_amdgcn_global_load_lds((const unsigned*)(nk + ksrc), (LAS unsigned*)(lds + AT4_KB + wave * 1024), 16, 0, 0);
                    __builtin_amdgcn_global_load_lds((const unsigned*)(nk + (size_t)8192 * 64 + vsrc), (LAS unsigned*)(lds + AT4_VB + wave * 1024), 16, 0, 0);
                    if (nnct > 1) {
                        __builtin_amdgcn_global_load_lds((const unsigned*)(nk + 4096 + ksrc), (LAS unsigned*)(lds + AT4_KB + 8192 + wave * 1024), 16, 0, 0);
                        __builtin_amdgcn_global_load_lds((const unsigned*)(nk + (size_t)8192 * 64 + 4096 + vsrc), (LAS unsigned*)(lds + AT4_VB + 8192 + wave * 1024), 16, 0, 0); } } }
            cvt1_run(a, cvt_next, cvt_stride, 2, cvt_scr, lane);
        }
    }
    cvt1_run(a, cvt_next, cvt_stride, 1 << 20, cvt_scr, lane);
}

__device__ __forceinline__ void unpack8(const u32x4 w, float (&f)[8]) {
    f[0] = __uint_as_float(w.x << 16); f[1] = __uint_as_float(w.x & 0xffff0000u); f[2] = __uint_as_float(w.y << 16); f[3] = __uint_as_float(w.y & 0xffff0000u);
    f[4] = __uint_as_float(w.z << 16); f[5] = __uint_as_float(w.z & 0xffff0000u); f[6] = __uint_as_float(w.w << 16); f[7] = __uint_as_float(w.w & 0xffff0000u);
}
__device__ __forceinline__ void ph_convpool_fast(const Args& a, LAS unsigned char* lds) {
    const bf16_t* H0 = (const bf16_t*)(a.ws + WS_H0);
    bf16_t* CAT = (bf16_t*)(a.ws + WS_CAT);
    const float* cw = a.in[4]; const float* cb = a.in[5]; const float* lg = a.in[6]; const float* lb = a.in[7];
    const int tid = threadIdx.x, lane = tid & 63, wave = tid >> 6, ch = lane * 8;
    constexpr int VT_OFF = 0, UT_OFF = 62 * 1024, CW_OFF = UT_OFF + 47 * 1024;
    for (int i = tid; i < 31 * 64; i += 512) { const int k = i >> 6, c8 = (i & 63) * 8;
        const f32x4 w0 = *(const f32x4*)(cw + k * 512 + c8), w1 = *(const f32x4*)(cw + k * 512 + c8 + 4);
        u32x4 o; o.x = pk2(w0[0], w0[1]); o.y = pk2(w0[2], w0[3]); o.z = pk2(w1[0], w1[1]); o.w = pk2(w1[2], w1[3]);
        *(LAS u32x4*)(lds + CW_OFF + k * 1024 + c8 * 2) = o; }
    float bias[8], gam[8], bet[8];
#pragma unroll
    for (int j = 0; j < 8; ++j) { bias[j] = cb[ch + j]; gam[j] = lg[ch + j]; bet[j] = lb[ch + j]; }
    for (int tile = blockIdx.x; tile < M / 32; tile += gridDim.x) {
        const int tok0 = tile * 32, t0 = tok0 & (T - 1);
        __syncthreads();
        for (int i = tid; i < 62 * 64; i += 512) { const int r = i >> 6, c8 = (i & 63) * 8; const int tt = t0 - 30 + r;
            u32x4 v = (u32x4){0u, 0u, 0u, 0u}; if (tt >= 0) v = *(const u32x4*)(H0 + (size_t)(tok0 - 30 + r) * 1024 + 512 + c8);
            *(LAS u32x4*)(lds + VT_OFF + r * 1024 + c8 * 2) = v; }
        for (int i = tid; i < 47 * 64; i += 512) { const int r = i >> 6, c8 = (i & 63) * 8; const int tt = t0 - 15 + r;
            u32x4 v = (u32x4){0u, 0u, 0u, 0u}; if (tt >= 0) v = *(const u32x4*)(H0 + (size_t)(tok0 - 15 + r) * 1024 + c8);
            *(LAS u32x4*)(lds + UT_OFF + r * 1024 + c8 * 2) = v; }
        __syncthreads();
        float acc[4][8];
#pragma unroll
        for (int j = 0; j < 4; ++j)
#pragma unroll
            for (int c = 0; c < 8; ++c) acc[j][c] = bias[c];
#pragma unroll 1
        for (int k = 0; k < 31; ++k) {
            float w[8]; unpack8(*(const LAS u32x4*)(lds + CW_OFF + k * 1024 + ch * 2), w);
#pragma unroll
            for (int j = 0; j < 4; ++j) { float v[8]; unpack8(*(const LAS u32x4*)(lds + VT_OFF + (4 * wave + j + k) * 1024 + ch * 2), v);
#pragma unroll
                for (int c = 0; c < 8; ++c) acc[j][c] += w[c] * v[c]; }
        }
        const int wnd = 2 << (lane >> 4);
#pragma unroll
        for (int j = 0; j < 4; ++j) {
            const int tl = 4 * wave + j, t = t0 + tl; const size_t tok = (size_t)tok0 + tl;
            const int cnt = (t + 1 < wnd) ? (t + 1) : wnd;
            float s[8], self[8];
            unpack8(*(const LAS u32x4*)(lds + UT_OFF + (15 + tl) * 1024 + ch * 2), self);
#pragma unroll
            for (int c = 0; c < 8; ++c) s[c] = self[c];
            for (int k = 1; k < cnt; ++k) { float v[8]; unpack8(*(const LAS u32x4*)(lds + UT_OFF + (15 + tl - k) * 1024 + ch * 2), v);
#pragma unroll
                for (int c = 0; c < 8; ++c) s[c] += v[c]; }
            const float inv = 1.0f / (float)cnt;
            u32x4 o; o.x = pk2(s[0] * inv - self[0], s[1] * inv - self[1]); o.y = pk2(s[2] * inv - self[2], s[3] * inv - self[3]);
            o.z = pk2(s[4] * inv - self[4], s[5] * inv - self[5]); o.w = pk2(s[6] * inv - self[6], s[7] * inv - self[7]);
            *(u32x4*)(CAT + tok * 1024 + ch) = o;
            float sm = 0.f;
#pragma unroll
            for (int c = 0; c < 8; ++c) sm += acc[j][c];
            const float mean = wave_sum(sm) * (1.0f / 512.0f);
            float sq = 0.f;
#pragma unroll
            for (int c = 0; c < 8; ++c) { acc[j][c] -= mean; sq += acc[j][c] * acc[j][c]; }
            const float rstd = rsqrtf(wave_sum(sq) * (1.0f / 512.0f) + LN_EPS);
            float y[8];
#pragma unroll
            for (int c = 0; c < 8; ++c) { const float z = acc[j][c] * rstd * gam[c] + bet[c]; y[c] = z * sigmoidf_(z); }
            u32x4 o2; o2.x = pk2(y[0], y[1]); o2.y = pk2(y[2], y[3]); o2.z = pk2(y[4], y[5]); o2.w = pk2(y[6], y[7]);
            *(u32x4*)(CAT + tok * 1024 + 512 + ch) = o2;
        }
    }
}


__device__ __forceinline__ void ph_route_fast(const float* LOG, const float* bias, unsigned* gcnt, int2* list, unsigned char* ldsg) {
    unsigned* hist = (unsigned*)ldsg; unsigned* base = hist + 256; u32x2* sel = (u32x2*)(ldsg + 2048);
    const int tid = threadIdx.x, lane = tid & 63, wave = tid >> 6;
    const float NEG = -INFINITY;
    const float4 bb = *(const float4*)(bias + lane * 4);
    for (int chunk = blockIdx.x; chunk < M / 128; chunk += gridDim.x) {
        __syncthreads();
        if (tid < 256) hist[tid] = 0u;
        __syncthreads();
        for (int i = 0; i < 16; ++i) {
            const int tl = wave * 16 + i, tok = chunk * 128 + tl;
            const float4 lg = *(const float4*)(LOG + (size_t)tok * 256 + lane * 4);
            const float s0 = sigmoidf_(lg.x), s1 = sigmoidf_(lg.y), s2 = sigmoidf_(lg.z), s3 = sigmoidf_(lg.w);
            float v0 = s0 + bb.x, v1 = s1 + bb.y, v2 = s2 + bb.z, v3 = s3 + bb.w;
            float m1 = fmaxf(v0, v1), m2 = fminf(v0, v1);
            { const float hi = fmaxf(v2, v3), lo = fminf(v2, v3); const float n1 = fmaxf(m1, hi); const float n2 = fmaxf(fminf(m1, hi), fmaxf(m2, lo)); m1 = n1; m2 = n2; }
#pragma unroll
            for (int o = 1; o < 8; o <<= 1) { const float a1 = __shfl_xor(m1, o), a2 = __shfl_xor(m2, o); const float n1 = fmaxf(m1, a1), n2 = fmaxf(fminf(m1, a1), fmaxf(m2, a2)); m1 = n1; m2 = n2; }
            const float gs = m1 + m2; const int mygrp = lane >> 3;
            int rank = 0;
#pragma unroll
            for (int g2 = 0; g2 < 8; ++g2) { const float og = __shfl(gs, g2 * 8); rank += (og > gs || (og == gs && g2 < mygrp)) ? 1 : 0; }
            if (rank >= 4) { v0 = NEG; v1 = NEG; v2 = NEG; v3 = NEG; }
            int my_e = 0; float my_s = 0.f;
#pragma unroll
            for (int it = 0; it < 8; ++it) {
                float bv = v0; int bj = 0;
                if (v1 > bv) { bv = v1; bj = 1; }
                if (v2 > bv) { bv = v2; bj = 2; }
                if (v3 > bv) { bv = v3; bj = 3; }
                int bi = lane * 4 + bj;
#pragma unroll
                for (int o = 1; o < 64; o <<= 1) { const float ov = __shfl_xor(bv, o); const int oi = __shfl_xor(bi, o); if (ov > bv || (ov == bv && oi < bi)) { bv = ov; bi = oi; } }
                const int jj = bi & 3, ol = bi >> 2;
                const float mys = (jj == 0) ? s0 : (jj == 1) ? s1 : (jj == 2) ? s2 : s3;
                const float wsc = __shfl(mys, ol);
                if (lane == ol) { if (jj == 0) v0 = NEG; else if (jj == 1) v1 = NEG; else if (jj == 2) v2 = NEG; else v3 = NEG; }
                if (lane == it) { my_e = bi; my_s = wsc; }
            }
            const float ssum = wave_sum(lane < 8 ? my_s : 0.f);
            if (lane < 8) { const unsigned rk = atomicAdd(&hist[my_e], 1u); u32x2 en; en.x = (unsigned)my_e | (rk << 16); en.y = __float_as_uint(my_s / ssum * 2.5f); sel[tl * 8 + lane] = en; }
        }
        __syncthreads();
        if (tid < 256) { const unsigned h = hist[tid]; base[tid] = h ? atomicAdd(&gcnt[tid], h) : 0u; }
        __syncthreads();
#pragma unroll
        for (int rep = 0; rep < 2; ++rep) { const int idx = tid + rep * 512, tok = chunk * 128 + (idx >> 3), k = idx & 7;
            const u32x2 en = sel[idx]; const unsigned e = en.x & 0xffffu, pos = base[e] + (en.x >> 16);
            list[(size_t)e * LISTCAP + pos] = make_int2(tok * 10 + k, (int)en.y); }
    }
}

__global__ void __launch_bounds__(512, 2) fwd_kernel(Args a) {
    extern __shared__ __attribute__((aligned(16))) unsigned char lds[];
    volatile LAS unsigned* MISC = (volatile LAS unsigned*)((LAS unsigned char*)lds + (LDS_BYTES - 64));
    if (threadIdx.x < 16) MISC[threadIdx.x] = 0u;
    __syncthreads();
    unsigned* ctl = (unsigned*)(a.ws + WS_CTL);
#if MK_ONE_LAUNCH
    (void)xcd_barrier_post(ctl + CW_BAR, MISC + 8);
#define SEAM() do { XcdBarrier b_; b_.bar = (unsigned*)(a.ws + WS_CTL) + CW_BAR; b_.x = xb_xcc_id(); b_.st = MISC + 8; xcd_barrier(b_); } while (0)
#else
#define SEAM() do {} while (0)
#endif
    const int lo = a.ph_lo, hi = a.ph_hi;
#define IN(k) (lo <= (k) && (k) < hi)
#define BOTH(k) (IN(k) && (k) + 1 < hi)
#define X1 ((bf16_t*)(a.ws + WS_X1))
#define X2 ((bf16_t*)(a.ws + WS_X2))
#define LOG ((float*)(a.ws + WS_LOG))

    LAS unsigned char* L = (LAS unsigned char*)lds;
#define LIST ((int2*)(a.ws + WS_LIST))
#ifndef PROBE_DUP_MASK
#define PROBE_DUP_MASK 0u
#endif
#define RUN(k, ...) if (IN(k)) { { __VA_ARGS__ } if ((PROBE_DUP_MASK >> (k)) & 1u) { __syncthreads(); { __VA_ARGS__ } } if (BOTH(k)) SEAM(); }
    RUN(0, ph_prologue(a, L);)
    RUN(1, pg8::DenseSched S; S.init((const bf16_t*)(a.ws + WS_XA), D, (const bf16_t*)(a.ws + WS_WIN0), D, M, 1536);
           EpiInproj0 E{(bf16_t*)(a.ws + WS_H0)};
           pg8::gemm_phase<EpiInproj0, pg8::DenseSched, true>(L, D, 128u, S, E);)
    RUN(2, ph_convpool_fast(a, L);)
    RUN(4, pg8::DenseSched S; S.init((const bf16_t*)(a.ws + WS_CAT), D, (const bf16_t*)(a.ws + WS_WOUT0), D, M, D);
           EpiRes E{a.in[0], nullptr, (bf16_t*)(a.ws + WS_Y)};
           pg8::gemm_phase<EpiRes, pg8::DenseSched, true>(L, D, 128u, S, E);)
    RUN(5, ph_ln((const bf16_t*)(a.ws + WS_Y), a.in[17], a.in[18], X1, (unsigned char*)(a.ws + WS_X8));)
#define MOE_LAYER(P, LAYER, XIN, XOUT, OUTF) \
    RUN(P, pg8::DenseSched S; S.init(XIN, D, (const bf16_t*)(a.ws + WS_WR) + (size_t)(LAYER) * NE * D, D, M, NE); \
           EpiLogits E{LOG}; pg8::gemm_phase<EpiLogits, pg8::DenseSched, true>(L, D, 128u, S, E);) \
    if (IN(P + 1)) { ph_route_fast(LOG, a.in[22] + (LAYER) * NE, ctl + CW_CNT + (LAYER) * 256, LIST, lds); if (BOTH(P + 1)) SEAM(); } \
    RUN(P + 2, const int R = moe_setup256(ctl + CW_CNT + (LAYER) * 256, L); \
            MoeGuSched S{(const char*)(a.ws + WS_X8), (const char*)(a.ws + WS_WGU) + (size_t)(LAYER) * 257 * 512 * 1024, LIST, L, R, (R + 128) * 2, (int)gridDim.x, (int)blockIdx.x}; \
            S.prepare(); EpiGateUp E{(unsigned char*)(a.ws + WS_HID)}; pg8::gemm_phase<EpiGateUp, MoeGuSched, true, true>(L, D / 2, 128u, S, E);) \
    RUN(P + 3, const int R = moe_setup256(ctl + CW_CNT + (LAYER) * 256, L); \
            MoeDownSched S{(const char*)(a.ws + WS_HID), (const char*)(a.ws + WS_WD) + (size_t)(LAYER) * 257 * 1024 * 256, LIST, L, R, R + 128, (int)gridDim.x, (int)blockIdx.x}; \
            S.prepare(); EpiDown E{(unsigned char*)(a.ws + WS_YB), L}; pg8::gemm_phase<EpiDown, MoeDownSched, true, true>(L, FF / 2, 128u, S, E);) \
    RUN(P + 4, ph_combine(a, XIN, a.in[19] + (LAYER) * D, a.in[20] + (LAYER) * D, XOUT, OUTF);)
    MOE_LAYER(6, 0, X1, X2, nullptr)
    RUN(11, pg8::DenseSched S; S.init(X2, D, (const bf16_t*)(a.ws + WS_WINN), D, M, HNW);
            EpiInprojN E{(bf16_t*)(a.ws + WS_HN), (bf16_t*)(a.ws + WS_QR), (bf16_t*)(a.ws + WS_KV6), (float*)(a.ws + WS_GATES), (const float*)(a.ws + WS_MISC) + 1024};
            pg8::gemm_phase<EpiInprojN, pg8::DenseSched, true>(L, D, 128u, S, E);)
    RUN(13, Cmp1Sched S{(const char*)(a.ws + WS_KV6), (const char*)(a.ws + WS_CW1), (int)gridDim.x, (int)blockIdx.x};
            EpiCmp1 E{(bf16_t*)(a.ws + WS_CH1), (const float*)(a.ws + WS_MISC)};
            pg8::gemm_phase<EpiCmp1, Cmp1Sched, true>(L, 2048, 128u, S, E); ph_knorm(a);)
    RUN(14, ph_cmp2(a, lds);)
    RUN(15, ph_attn_fast2(a, L);)
    RUN(16, pg8::DenseSched S; S.init((const bf16_t*)(a.ws + WS_O), D, (const bf16_t*)(a.ws + WS_WOUTN), D, M, D);
            EpiRes E{nullptr, X2, (bf16_t*)(a.ws + WS_Y2)};
            pg8::gemm_phase<EpiRes, pg8::DenseSched, true>(L, D, 128u, S, E);)
    RUN(17, ph_ln((const bf16_t*)(a.ws + WS_Y2), a.in[17] + D, a.in[18] + D, X1, (unsigned char*)(a.ws + WS_X8));)
    MOE_LAYER(18, 1, X1, (bf16_t*)nullptr, a.out)
}

extern "C" void kernel_launch(void* const* d_in, const int* in_sizes, int n_in, void* d_out, int out_size, void* d_ws, size_t ws_size, hipStream_t stream) {
    static int grid = 0;
    if (grid == 0) {
        if (n_in != 29 || out_size != M * D || ws_size < WS_END) { fprintf(stderr, "kernel_launch: unexpected problem (n_in %d out %d ws %zu)\n", n_in, out_size, ws_size); grid = -1; return; }
        int dev = 0, cus = 0;
        if (hipGetDevice(&dev) != hipSuccess || hipDeviceGetAttribute(&cus, hipDeviceAttributeMultiprocessorCount, dev) != hipSuccess) { grid = -1; return; }
        if (hipFuncSetAttribute((const void*)fwd_kernel, hipFuncAttributeMaxDynamicSharedMemorySize, LDS_BYTES) != hipSuccess) { grid = -1; return; }
        int per_cu = 0;
        (void)hipOccupancyMaxActiveBlocksPerMultiprocessor(&per_cu, (const void*)fwd_kernel, 512, LDS_BYTES);
        (void)hipGetLastError();
        grid = cus;
    }
    if (grid < 0) return;
    (void)hipMemsetAsync((char*)d_ws + WS_CTL, 0, CTL_BYTES, stream);
    Args a{};
    for (int i = 0; i < 29; ++i) a.in[i] = (const float*)d_in[i];
    a.out = (float*)d_out; a.ws = (unsigned char*)d_ws;
    for (int i = 0; i < 8; ++i) a.inv_freq[i] = powf(500000.0f, -(float)(2 * i) / 16.0f);
#if MK_ONE_LAUNCH
    a.ph_lo = 0; a.ph_hi = NPHASE;
    hipLaunchKernelGGL(fwd_kernel, dim3(grid), dim3(512), LDS_BYTES, stream, a);
#else
    for (int p = 0; p < NPHASE; ++p) { a.ph_lo = p; a.ph_hi = p + 1; hipLaunchKernelGGL(fwd_kernel, dim3(grid), dim3(512), LDS_BYTES, stream, a); }
#endif
}
```

```cpp
#include <hip/hip_runtime.h>
#include <cstdint>
#include <cstdio>
#include <cmath>

#ifndef MK_ONE_LAUNCH
#define MK_ONE_LAUNCH 1
#endif

#define LAS __attribute__((address_space(3)))
typedef unsigned short bf16_t;
typedef short bf16x8 __attribute__((ext_vector_type(8)));
typedef float f32x4 __attribute__((ext_vector_type(4)));
typedef unsigned u32x2 __attribute__((ext_vector_type(2)));
typedef unsigned u32x4 __attribute__((ext_vector_type(4)));

constexpr int NB = 4, T = 8192, D = 1024, M = NB * T;
constexpr int NE = 256, TOPK = 8, FF = 256;
constexpr int HNW = 2816;
constexpr int LISTCAP = 32768;
constexpr float ALPHA = 1.4142135623730951f;
constexpr float LN_EPS = 1e-5f;
constexpr float QSCALE = 0.125f * 1.4426950408889634f;
constexpr int YB_NSLOT = 9;
constexpr float YB_SCALE = 16.0f;
constexpr int NPHASE = 23;

constexpr size_t MiB = 1u << 20;
constexpr size_t WS_CTL = 0, CTL_BYTES = 1 * MiB;
constexpr size_t WS_X1 = 1 * MiB;
constexpr size_t WS_X2 = WS_X1 + 64 * MiB;
constexpr size_t WS_LOG = WS_X2 + 64 * MiB;
constexpr size_t WS_LIST = WS_LOG + 32 * MiB;
constexpr size_t WS_WTS = WS_LIST + 64 * MiB;
constexpr size_t WS_HID = WS_WTS + 2 * MiB;
constexpr size_t WS_YB = WS_HID + 184 * MiB;
constexpr size_t WS_END_NAIVE = WS_YB + 576 * MiB;
constexpr size_t WS_WIN0 = WS_END_NAIVE;
constexpr size_t WS_WOUT0 = WS_WIN0 + 3 * MiB;
constexpr size_t WS_WINN = WS_WOUT0 + 2 * MiB;
constexpr size_t WS_WOUTN = WS_WINN + 6 * MiB;
constexpr size_t WS_WR = WS_WOUTN + 2 * MiB;
constexpr size_t WS_CW1 = WS_WR + 1 * MiB;
constexpr size_t WS_MISC = WS_CW1 + 2 * MiB;
constexpr size_t WS_WGU = WS_MISC + 1 * MiB;
constexpr size_t WS_X8 = WS_WGU + 257 * MiB;
constexpr size_t WS_O8 = WS_X8 + 32 * MiB;
constexpr float X8_SCALE = 8.0f, W8_SCALE = 64.0f, H8_SCALE = 16.0f;
constexpr size_t WS_WD = WS_WGU + 514 * MiB;
constexpr size_t WS_END = WS_WD + 257 * MiB;
constexpr size_t WS_XA = WS_X2;
constexpr size_t WS_H0 = WS_YB;
constexpr size_t WS_PM = WS_H0 + 64 * MiB;
constexpr size_t WS_CAT = WS_PM + 32 * MiB;
constexpr size_t WS_Y = WS_CAT + 64 * MiB;
constexpr size_t WS_HN = WS_YB;
constexpr size_t WS_KV6 = WS_HN + 64 * MiB;
constexpr size_t WS_QR = WS_HN + 176 * MiB;
constexpr size_t WS_GATES = WS_QR + 64 * MiB;
constexpr size_t WS_CH1 = WS_GATES + 8 * MiB;
constexpr size_t WS_KC = WS_CH1 + 4 * MiB;
constexpr size_t WS_O = WS_KC + 2 * MiB;
constexpr size_t WS_Y2 = WS_O + 64 * MiB;
static_assert(WS_Y2 + 64 * MiB <= WS_END_NAIVE, "overlay");
static_assert(WS_Y + 64 * MiB <= WS_END_NAIVE, "overlay");

constexpr int CW_CNT = 64;
constexpr int CW_BAR = 4096;

constexpr int LDS_BYTES = 163840;

__device__ __forceinline__ float bf2f(bf16_t h) { return __uint_as_float(((unsigned)h) << 16); }
__device__ __forceinline__ bf16_t f2bf(float f) { unsigned u = __float_as_uint(f); return (bf16_t)((u + 0x7fffu + ((u >> 16) & 1u)) >> 16); }
__device__ __forceinline__ unsigned pk2(float lo, float hi) { return (unsigned)f2bf(lo) | ((unsigned)f2bf(hi) << 16); }
#define WR_DPP(x, ctrl) __builtin_bit_cast(float, __builtin_amdgcn_update_dpp(__builtin_bit_cast(int, (float)(x)), __builtin_bit_cast(int, (float)(x)), (ctrl), 0xF, 0xF, true))
#define WR_ROW(x, r) __builtin_bit_cast(float, __builtin_amdgcn_readlane(__builtin_bit_cast(int, (float)(x)), 16 * (r)))
__device__ __forceinline__ float wave_sum(float v) {
    v += WR_DPP(v, 0xB1); v += WR_DPP(v, 0x4E); v += WR_DPP(v, 0x141); v += WR_DPP(v, 0x140);
    return (WR_ROW(v, 0) + WR_ROW(v, 1)) + (WR_ROW(v, 2) + WR_ROW(v, 3));
}
__device__ __forceinline__ float wave_max(float v) {
    v = fmaxf(v, WR_DPP(v, 0xB1)); v = fmaxf(v, WR_DPP(v, 0x4E)); v = fmaxf(v, WR_DPP(v, 0x141)); v = fmaxf(v, WR_DPP(v, 0x140));
    return fmaxf(fmaxf(WR_ROW(v, 0), WR_ROW(v, 1)), fmaxf(WR_ROW(v, 2), WR_ROW(v, 3)));
}
__device__ __forceinline__ float sigmoidf_(float x) { return 1.0f / (1.0f + __expf(-x)); }
__device__ __forceinline__ float gelu_tanh(float x) {
    const float u = 0.7978845608028654f * (x + 0.044715f * x * x * x);
    const float e = __expf(2.0f * u);
    const float th = 1.0f - 2.0f / (e + 1.0f);
    return 0.5f * x * (1.0f + th);
}
__device__ __forceinline__ bf16x8 cvt8(const float* p) {
    const float4 a = *(const float4*)p, b = *(const float4*)(p + 4);
    bf16x8 r;
    r[0] = (short)f2bf(a.x); r[1] = (short)f2bf(a.y); r[2] = (short)f2bf(a.z); r[3] = (short)f2bf(a.w);
    r[4] = (short)f2bf(b.x); r[5] = (short)f2bf(b.y); r[6] = (short)f2bf(b.z); r[7] = (short)f2bf(b.w);
    return r;
}
__device__ __forceinline__ bf16x8 colk8(const float* W, int N, int k, int col) {
    bf16x8 r;
#pragma unroll
    for (int j = 0; j < 8; ++j) r[j] = (short)f2bf(W[(size_t)(k + j) * N + col]);
    return r;
}
__device__ __forceinline__ bf16x8 zero8() { return (bf16x8){0, 0, 0, 0, 0, 0, 0, 0}; }
#define WSYNC() asm volatile("s_waitcnt lgkmcnt(0)" ::: "memory")

#define XB_TMO      128
#define XB_XCNT(j)  (256  + 64 * (j))
#define XB_XSUB(j)  (1280 + 64 * (j))
#define XB_XGEN(j)  (2304 + 64 * (j))
#define XB_TOP      3328
#define XB_TOPGEN   3392
#define XCD_BAR_WORDS 3456
#define XB_SPIN_CAP (1u << 22)
__device__ __forceinline__ unsigned xb_ld(unsigned* p)              { return __hip_atomic_load(p, __ATOMIC_RELAXED, __HIP_MEMORY_SCOPE_AGENT); }
__device__ __forceinline__ unsigned xb_add(unsigned* p, unsigned v) { return __hip_atomic_fetch_add(p, v, __ATOMIC_RELAXED, __HIP_MEMORY_SCOPE_AGENT); }
__device__ __forceinline__ unsigned xb_xcc_id() { return (unsigned)__builtin_amdgcn_s_getreg((3 << 11) | 20) & 0xFu; }
#define XB_SPIN(cond, bar) do { unsigned _sp = 0; while (cond) { __builtin_amdgcn_s_sleep(1); \
    if ((++_sp & 255u) == 0u) { if (xb_ld(&(bar)[XB_TMO])) break; if (_sp > XB_SPIN_CAP) { atomicAdd(&(bar)[XB_TMO], 1u); break; } } } } while (0)
struct XcdBarrier { unsigned* bar; unsigned x; volatile LAS unsigned* st; };
__device__ __forceinline__ XcdBarrier xcd_barrier_post(unsigned* bar, volatile LAS unsigned* st) {
    XcdBarrier b; b.bar = bar; b.x = xb_xcc_id(); b.st = st;
    if (threadIdx.x == 0) (void)xb_add(&bar[XB_XCNT(b.x)], 1u);
    return b;
}
__device__ __forceinline__ void xcd_barrier_complete(unsigned* bar, unsigned x, unsigned& nloc, unsigned& nx) {
    const unsigned G = gridDim.x * gridDim.y * gridDim.z;
    unsigned sum, cnt, mine, sp = 0u;
    for (;;) {
        sum = 0u; cnt = 0u; mine = 0u;
#pragma unroll
        for (unsigned j = 0; j < 16; ++j) { const unsigned c = xb_ld(&bar[XB_XCNT(j)]); sum += c; cnt += (c > 0u) ? 1u : 0u; mine = (j == x) ? c : mine; }
        if (sum == G) break;
        __builtin_amdgcn_s_sleep(1);
        if ((++sp & 255u) == 0u) { if (xb_ld(&bar[XB_TMO])) break; if (sp > XB_SPIN_CAP) { atomicAdd(&bar[XB_TMO], 1u); break; } }
    }
    nloc = mine > 0u ? mine : 1u; nx = cnt > 0u ? cnt : 1u;
}
__device__ __forceinline__ void xcd_barrier(const XcdBarrier& b) {
    asm volatile("s_waitcnt vmcnt(0)" ::: "memory");
    __syncthreads();
    if (threadIdx.x == 0) {
        unsigned* bar = b.bar;
        __builtin_amdgcn_s_waitcnt(0);
        unsigned nloc = b.st[0], nx = b.st[1];
        if (nloc == 0u) { xcd_barrier_complete(bar, b.x, nloc, nx); b.st[0] = nloc; b.st[1] = nx; }
        const unsigned old = xb_add(&bar[XB_XSUB(b.x)], 1u);
        const unsigned gen = old / nloc;
        if (old + 1u == (gen + 1u) * nloc) {
            __builtin_amdgcn_fence(__ATOMIC_RELEASE, "agent");
            asm volatile("s_waitcnt vmcnt(0)" ::: "memory");
            const unsigned og = xb_add(&bar[XB_TOP], 1u);
            const unsigned tg = og / nx;
            if (og + 1u == (tg + 1u) * nx) xb_add(&bar[XB_TOPGEN], 1u);
            else XB_SPIN(xb_ld(&bar[XB_TOPGEN]) == tg, bar);
            __builtin_amdgcn_fence(__ATOMIC_ACQUIRE, "agent");
            xb_add(&bar[XB_XGEN(b.x)], 1u);
            asm volatile("s_waitcnt vmcnt(0)" ::: "memory");
        } else {
            XB_SPIN(xb_ld(&bar[XB_XGEN(b.x)]) == gen, bar);
            __builtin_amdgcn_fence(__ATOMIC_ACQUIRE, "agent");
            asm volatile("s_waitcnt vmcnt(0)" ::: "memory");
        }
    }
    __syncthreads();
}

template <class AL, class BL, class EP>
__device__ __forceinline__ void mgemm_tile(unsigned char* lds, int K, const AL& al, const BL& bl, const EP& ep) {
    bf16_t* As = (bf16_t*)lds;
    bf16_t* Bs = As + 128 * 40;
    const int tid = threadIdx.x, lane = tid & 63, wave = tid >> 6;
    const int ar = tid >> 2, ac = (tid & 3) * 8;
    const int bn = tid & 127, bc = (tid >> 7) * 8;
    f32x4 acc[8];
#pragma unroll
    for (int s = 0; s < 8; ++s) acc[s] = (f32x4){0.f, 0.f, 0.f, 0.f};
    bf16x8 ra = al(ac), rb = bl(bc);
    for (int k0 = 0; k0 < K; k0 += 32) {
        __syncthreads();
        *(bf16x8*)(As + ar * 40 + ac) = ra;
        *(bf16x8*)(Bs + bn * 40 + bc) = rb;
        __syncthreads();
        if (k0 + 32 < K) { ra = al(k0 + 32 + ac); rb = bl(k0 + 32 + bc); }
        const bf16x8 af = *(const bf16x8*)(As + (wave * 16 + (lane & 15)) * 40 + (lane >> 4) * 8);
#pragma unroll
        for (int s = 0; s < 8; ++s) {
            const bf16x8 wf = *(const bf16x8*)(Bs + (16 * s + (lane & 15)) * 40 + (lane >> 4) * 8);
            acc[s] = __builtin_amdgcn_mfma_f32_16x16x32_bf16(wf, af, acc[s], 0, 0, 0);
        }
    }
    ep(wave * 16 + (lane & 15), (lane >> 4) * 4, acc);
}
__device__ __forceinline__ void store4bf(bf16_t* p, const f32x4 v) { u32x2 w; w.x = pk2(v[0], v[1]); w.y = pk2(v[2], v[3]); *(u32x2*)p = w; }

struct Args {
    const float* in[29];
    float* out;
    unsigned char* ws;
    float inv_freq[8];
    int ph_lo, ph_hi;
};

__device__ __forceinline__ unsigned pk4_fp8(float a, float b, float c, float d) { int w = __builtin_amdgcn_cvt_pk_fp8_f32(a, b, 0, false); return (unsigned)__builtin_amdgcn_cvt_pk_fp8_f32(c, d, w, true); }
__device__ __forceinline__ u32x2 pack8_fp8(const f32x4 v0, const f32x4 v1) {
    int a = __builtin_amdgcn_cvt_pk_fp8_f32(v0[0], v0[1], 0, false); a = __builtin_amdgcn_cvt_pk_fp8_f32(v0[2], v0[3], a, true);
    int b = __builtin_amdgcn_cvt_pk_fp8_f32(v1[0], v1[1], 0, false); b = __builtin_amdgcn_cvt_pk_fp8_f32(v1[2], v1[3], b, true);
    u32x2 w; w.x = (unsigned)a; w.y = (unsigned)b; return w;
}
__device__ __forceinline__ float clamp8(float v) { return __builtin_amdgcn_fmed3f(v, -448.0f, 448.0f); }
__device__ __forceinline__ void ph_ln(const bf16_t* Y, const float* g, const float* b, bf16_t* X, unsigned char* X8) {
    const int lane = threadIdx.x & 63, wave = threadIdx.x >> 6;
    const int gw = blockIdx.x * 8 + wave, ngw = gridDim.x * 8;
    float gg[16], bb[16];
#pragma unroll
    for (int j = 0; j < 8; ++j) { gg[j] = g[lane * 8 + j]; gg[8 + j] = g[512 + lane * 8 + j]; bb[j] = b[lane * 8 + j]; bb[8 + j] = b[512 + lane * 8 + j]; }
    for (int row0 = gw * 4; row0 < M; row0 += ngw * 4) {
        bf16x8 p0[4], p1[4];
#pragma unroll
        for (int r = 0; r < 4; ++r) { p0[r] = __builtin_nontemporal_load((const bf16x8*)(Y + (size_t)(row0 + r) * 1024 + lane * 8)); p1[r] = __builtin_nontemporal_load((const bf16x8*)(Y + (size_t)(row0 + r) * 1024 + 512 + lane * 8)); }
#pragma unroll
        for (int r = 0; r < 4; ++r) {
            float v[16];
#pragma unroll
            for (int j = 0; j < 8; ++j) { v[j] = bf2f((bf16_t)p0[r][j]); v[8 + j] = bf2f((bf16_t)p1[r][j]); }
            float s = 0.f;
#pragma unroll
            for (int j = 0; j < 16; ++j) s += v[j];
            const float mean = wave_sum(s) * (1.0f / 1024.0f);
            float q = 0.f;
#pragma unroll
            for (int j = 0; j < 16; ++j) { v[j] -= mean; q += v[j] * v[j]; }
            const float rstd = rsqrtf(wave_sum(q) * (1.0f / 1024.0f) + LN_EPS);
            float o[16];
#pragma unroll
            for (int j = 0; j < 16; ++j) o[j] = v[j] * rstd * gg[j] + bb[j];
            u32x4 w0, w1;
            w0.x = pk2(o[0], o[1]); w0.y = pk2(o[2], o[3]); w0.z = pk2(o[4], o[5]); w0.w = pk2(o[6], o[7]);
            w1.x = pk2(o[8], o[9]); w1.y = pk2(o[10], o[11]); w1.z = pk2(o[12], o[13]); w1.w = pk2(o[14], o[15]);
            *(u32x4*)(X + (size_t)(row0 + r) * 1024 + lane * 8) = w0; *(u32x4*)(X + (size_t)(row0 + r) * 1024 + 512 + lane * 8) = w1;
#pragma unroll
            for (int j = 0; j < 16; ++j) o[j] = clamp8(o[j] * X8_SCALE);
            u32x2 q0, q1; q0.x = pk4_fp8(o[0], o[1], o[2], o[3]); q0.y = pk4_fp8(o[4], o[5], o[6], o[7]); q1.x = pk4_fp8(o[8], o[9], o[10], o[11]); q1.y = pk4_fp8(o[12], o[13], o[14], o[15]);
            *(u32x2*)(X8 + (size_t)(row0 + r) * 1024 + lane * 8) = q0; *(u32x2*)(X8 + (size_t)(row0 + r) * 1024 + 512 + lane * 8) = q1;
        }
    }
}

__device__ __forceinline__ void ph_combine(const Args& a, const bf16_t* X, const float* g, const float* b, bf16_t* Xo, float* outf) {
    const unsigned char* YB = (const unsigned char*)(a.ws + WS_YB);
    const int lane = threadIdx.x & 63, wave = threadIdx.x >> 6;
    const int gw = blockIdx.x * 8 + wave, ngw = gridDim.x * 8;
    for (int row = gw; row < M; row += ngw) {
        float v[16];
#pragma unroll
        for (int j = 0; j < 16; ++j) v[j] = 0.f;
        u32x2 q0[YB_NSLOT], q1[YB_NSLOT];
#pragma unroll
        for (int k = 0; k < YB_NSLOT; ++k) { const unsigned char* yr = YB + ((size_t)row * 10 + k) * 1024; q0[k] = __builtin_nontemporal_load((const u32x2*)(yr + lane * 8)); q1[k] = __builtin_nontemporal_load((const u32x2*)(yr + 512 + lane * 8)); }
#pragma unroll
        for (int k = 0; k < YB_NSLOT; ++k) {
            const auto a0 = __builtin_amdgcn_cvt_pk_f32_fp8((int)q0[k].x, false), a1 = __builtin_amdgcn_cvt_pk_f32_fp8((int)q0[k].x, true), a2 = __builtin_amdgcn_cvt_pk_f32_fp8((int)q0[k].y, false), a3 = __builtin_amdgcn_cvt_pk_f32_fp8((int)q0[k].y, true);
            const auto b0 = __builtin_amdgcn_cvt_pk_f32_fp8((int)q1[k].x, false), b1 = __builtin_amdgcn_cvt_pk_f32_fp8((int)q1[k].x, true), b2 = __builtin_amdgcn_cvt_pk_f32_fp8((int)q1[k].y, false), b3 = __builtin_amdgcn_cvt_pk_f32_fp8((int)q1[k].y, true);
            v[0] += a0[0]; v[1] += a0[1]; v[2] += a1[0]; v[3] += a1[1]; v[4] += a2[0]; v[5] += a2[1]; v[6] += a3[0]; v[7] += a3[1];
            v[8] += b0[0]; v[9] += b0[1]; v[10] += b1[0]; v[11] += b1[1]; v[12] += b2[0]; v[13] += b2[1]; v[14] += b3[0]; v[15] += b3[1];
        }
        {
            const bf16x8 p0 = *(const bf16x8*)(X + (size_t)row * 1024 + lane * 8), p1 = *(const bf16x8*)(X + (size_t)row * 1024 + 512 + lane * 8);
#pragma unroll
            for (int j = 0; j < 8; ++j) { v[j] = v[j] * (1.0f / YB_SCALE) + ALPHA * bf2f((bf16_t)p0[j]); v[8 + j] = v[8 + j] * (1.0f / YB_SCALE) + ALPHA * bf2f((bf16_t)p1[j]); }
        }
        float s = 0.f;
#pragma unroll
        for (int j = 0; j < 16; ++j) s += v[j];
        const float mean = wave_sum(s) * (1.0f / 1024.0f);
        float q = 0.f;
#pragma unroll
        for (int j = 0; j < 16; ++j) { v[j] -= mean; q += v[j] * v[j]; }
        const float rstd = rsqrtf(wave_sum(q) * (1.0f / 1024.0f) + LN_EPS);
        float o[16];
#pragma unroll
        for (int j = 0; j < 8; ++j) { o[j] = v[j] * rstd * g[lane * 8 + j] + b[lane * 8 + j]; o[8 + j] = v[8 + j] * rstd * g[512 + lane * 8 + j] + b[512 + lane * 8 + j]; }
        if (outf) {
            float* op = outf + (size_t)row * 1024;
            *(float4*)(op + lane * 8) = make_float4(o[0], o[1], o[2], o[3]); *(float4*)(op + lane * 8 + 4) = make_float4(o[4], o[5], o[6], o[7]);
            *(float4*)(op + 512 + lane * 8) = make_float4(o[8], o[9], o[10], o[11]); *(float4*)(op + 512 + lane * 8 + 4) = make_float4(o[12], o[13], o[14], o[15]);
        } else {
            u32x4 w0, w1;
            w0.x = pk2(o[0], o[1]); w0.y = pk2(o[2], o[3]); w0.z = pk2(o[4], o[5]); w0.w = pk2(o[6], o[7]);
            w1.x = pk2(o[8], o[9]); w1.y = pk2(o[10], o[11]); w1.z = pk2(o[12], o[13]); w1.w = pk2(o[14], o[15]);
            *(u32x4*)(Xo + (size_t)row * 1024 + lane * 8) = w0; *(u32x4*)(Xo + (size_t)row * 1024 + 512 + lane * 8) = w1;
        }
    }
}

__device__ __forceinline__ void ph_cmp2(const Args& a, unsigned char* lds) {
    const bf16_t* CH1 = (const bf16_t*)(a.ws + WS_CH1);
    bf16_t* KC = (bf16_t*)(a.ws + WS_KC);
    const int tid = threadIdx.x;
    for (int u = blockIdx.x; u < 64 * 2; u += gridDim.x) {
        const int rt = u >> 1, kv = u & 1;
        const bf16_t* ar = CH1 + ((size_t)kv * 8192 + rt * 128 + (tid >> 2)) * 128;
        const float* w2 = a.in[kv ? 15 : 12];
        const int col = tid & 127;
        auto al = [&](int k) { return *(const bf16x8*)(ar + k); };
        auto bl = [&](int k) { return (col < 64) ? colk8(w2, 64, k, col) : zero8(); };
        auto ep = [&](int r, int cb, const f32x4 (&acc)[8]) {
            bf16_t* o = KC + ((size_t)kv * 8192 + rt * 128 + r) * 64;
#pragma unroll
            for (int s = 0; s < 4; ++s) store4bf(o + 16 * s + cb, acc[s]);
        };
        mgemm_tile(lds, 128, al, bl, ep);
    }
}

namespace pg8 {
constexpr int BM = 256, BK = 64, HALF = 128, HTB = HALF * BK * 2, STAGE_BYTES = 8 * HTB;
__device__ __forceinline__ int lds_byte(int r, int c) { const int st = (r >> 4) * 2 + (c >> 5), rr = r & 15, cc = c & 31, ob = rr * 64 + cc * 2; return st * 1024 + (ob ^ (((ob >> 9) & 1) << 5)); }
__device__ __forceinline__ void stage_rc(int b, int& R, int& C) { const int st = b / 1024, sb = b % 1024, swz = sb ^ (((sb >> 9) & 1) << 5); R = (st >> 1) * 16 + swz / 64; C = (st & 1) * 32 + (swz % 64) / 2; }
__device__ __forceinline__ int perm32(int rho) { const int n = rho >> 4, i = rho & 15; return 8 * (i >> 2) + 4 * n + (i & 3); }
struct Unit { int pm, pn, ord; };
typedef float f32x16 __attribute__((ext_vector_type(16)));
typedef int i32x8 __attribute__((ext_vector_type(8))); typedef int i32x4_ __attribute__((ext_vector_type(4)));
__device__ __forceinline__ i32x8 f8cat(const bf16x8 lo, const bf16x8 hi) { return __builtin_shufflevector(__builtin_bit_cast(i32x4_, lo), __builtin_bit_cast(i32x4_, hi), 0, 1, 2, 3, 4, 5, 6, 7); }
template <class Epi, class Sched, bool ALIGN_EPI, bool F8 = false>
__device__ __forceinline__ void gemm_phase(LAS unsigned char* lds, const int K, const unsigned kstepA, const Sched& S, const Epi& E) {
    const int tid = threadIdx.x, wid = __builtin_amdgcn_readfirstlane(tid >> 6), lane = tid & 63, wr = wid >> 2, wc = wid & 3, fr = lane & 15, fq = lane >> 4;
    const int nt = K / BK;
    constexpr bool GA = Sched::GATHER;
    int RA[2]; unsigned CA2[2], voffB[2], voffB1[2], voffA[2];
    constexpr bool P16 = Epi::PERM16;
#pragma unroll
    for (int i = 0; i < 2; ++i) { int R, C; stage_rc(tid * 16 + i * 8192, R, C); const int Rb = Epi::PERM ? ((R & ~31) + perm32(R & 31)) : R;
        RA[i] = R; CA2[i] = (unsigned)C * 2u; voffB[i] = (unsigned)(Rb * K + C) * 2u; voffA[i] = GA ? 0u : (S.lane_off(R) + (unsigned)C * 2u);
        if (P16) { const int c16 = 64 * (R >> 5) + 16 * ((R >> 2) & 3) + 4 * ((R >> 4) & 1) + (R & 3); voffB[i] = (unsigned)(c16 * K + C) * 2u; voffB1[i] = (unsigned)((c16 + 8) * K + C) * 2u; } else voffB1[i] = 0u; }
    const size_t kstepB = (size_t)(BK * 2);
    const size_t hstepB = (size_t)HALF * K * 2;
    const unsigned ldsw = (unsigned)wid * 1024u;
    const int aoff = lds_byte(wr * 64 + fr, fq * 8), boff = lds_byte(wc * 32 + fr, fq * 8);
    const char* const Ab = S.abase();
    unsigned aoC[2][2], aoN[2][2];
    unsigned uC[2], uN[2];
#define PG8_SA(b, h) (((b) * 2 + (h)) * HTB)
#define PG8_SB(b, h) ((4 + (b) * 2 + (h)) * HTB)
#define PG8_GLDS(sbase, voff, ldsoff) do { const char* _b = (const char*)(sbase); unsigned _v = (voff); asm volatile("" : "+s"(_b), "+v"(_v)); \
        __builtin_amdgcn_global_load_lds((const unsigned*)(_b + _v), (LAS unsigned*)(lds + (ldsoff)), 16, 0, 0); } while (0)
#define PG8_STAGE_B(bufoff, gbase) do { _Pragma("unroll") for (int _i = 0; _i < 2; ++_i) PG8_GLDS(gbase, voffB[_i], (bufoff) + ldsw + _i * 8192); } while (0)
#define PG8_STAGE_B1(bufoff, gbase) do { _Pragma("unroll") for (int _i = 0; _i < 2; ++_i) PG8_GLDS((const char*)(gbase) + (P16 ? (size_t)0 : hstepB), (P16 ? voffB1[_i] : voffB[_i]), (bufoff) + ldsw + _i * 8192); } while (0)
#define PG8_STAGE_A(bufoff, kb, UO, LO) do { _Pragma("unroll") for (int _i = 0; _i < 2; ++_i) PG8_GLDS(Ab + (size_t)((kb) + (UO)), (GA ? (LO)[_i] : voffA[_i]), (bufoff) + ldsw + _i * 8192); } while (0)
#define PG8_LDA(dst, b, h) do { _Pragma("unroll") for (int m = 0; m < 4; ++m) _Pragma("unroll") for (int k = 0; k < 2; ++k) dst[m][k] = *(const LAS bf16x8*)(lds + PG8_SA(b, h) + aoff + m * 2048 + k * 1024); } while (0)
#define PG8_LDB(dst, b, h) do { _Pragma("unroll") for (int n = 0; n < 2; ++n) _Pragma("unroll") for (int k = 0; k < 2; ++k) dst[n][k] = *(const LAS bf16x8*)(lds + PG8_SB(b, h) + boff + n * 2048 + k * 1024); } while (0)
#define PG8_MMA(ai, bj, At, Bt) do { __builtin_amdgcn_s_setprio(1); _Pragma("unroll") for (int m = 0; m < 4; ++m) _Pragma("unroll") for (int n = 0; n < 2; ++n) { \
        if constexpr (F8) { f32x16& _w = accw[ai][bj][m >> 1]; const int _q = ((m & 1) * 2 + n) * 4; f32x4 _c = {_w[_q], _w[_q + 1], _w[_q + 2], _w[_q + 3]}; \
            _c = __builtin_amdgcn_mfma_scale_f32_16x16x128_f8f6f4(f8cat(Bt[n][0], Bt[n][1]), f8cat(At[m][0], At[m][1]), _c, 0, 0, 0, 0, 0, 0); _w[_q] = _c[0]; _w[_q + 1] = _c[1]; _w[_q + 2] = _c[2]; _w[_q + 3] = _c[3]; } \
        else { _Pragma("unroll") for (int k = 0; k < 2; ++k) acc[ai][bj][m][n] = __builtin_amdgcn_mfma_f32_16x16x32_bf16(Bt[n][k], At[m][k], acc[ai][bj][m][n], 0, 0, 0); } } __builtin_amdgcn_s_setprio(0); } while (0)
#define PG8_WAIT_V(n) asm volatile("s_waitcnt vmcnt(" #n ")" ::: "memory")
#define PG8_WAIT_L(n) asm volatile("s_waitcnt lgkmcnt(" #n ")" ::: "memory")
#define PG8_BAR __builtin_amdgcn_s_barrier()
#define PG8_SCHED __builtin_amdgcn_sched_barrier(0)
#define PG8_KPAIR(KB1, KB2, KB3, BP2, BP3) do { \
            PG8_LDB(B0, 0, 0); PG8_LDB(B1, 0, 1); PG8_SCHED; PG8_LDA(At, 0, 0); PG8_STAGE_A(PG8_SA(1, 1), KB1, uC[1], aoC[1]); \
            PG8_WAIT_V(8); PG8_WAIT_L(0); PG8_BAR; PG8_MMA(0, 0, At, B0); PG8_MMA(0, 1, At, B1); PG8_BAR; PG8_SCHED; \
            PG8_LDA(At, 0, 1); PG8_STAGE_B(PG8_SB(0, 0), BP2); PG8_STAGE_B1(PG8_SB(0, 1), BP2); PG8_STAGE_A(PG8_SA(0, 0), KB2, u2[0], a2o[0]); \
            PG8_WAIT_V(8); PG8_WAIT_L(0); PG8_BAR; PG8_MMA(1, 0, At, B0); PG8_MMA(1, 1, At, B1); PG8_BAR; PG8_SCHED; \
            PG8_LDB(B0, 1, 0); PG8_LDB(B1, 1, 1); PG8_SCHED; PG8_LDA(At, 1, 0); PG8_STAGE_A(PG8_SA(0, 1), KB2, u2[1], a2o[1]); \
            PG8_WAIT_V(8); PG8_WAIT_L(0); PG8_BAR; PG8_MMA(0, 0, At, B0); PG8_MMA(0, 1, At, B1); PG8_BAR; PG8_SCHED; \
            PG8_LDA(At, 1, 1); PG8_STAGE_B(PG8_SB(1, 0), BP3); PG8_STAGE_B1(PG8_SB(1, 1), BP3); PG8_STAGE_A(PG8_SA(1, 0), KB3, u2[0], a2o[0]); \
            PG8_WAIT_V(8); PG8_WAIT_L(0); PG8_BAR; PG8_MMA(1, 0, At, B0); PG8_MMA(1, 1, At, B1); PG8_BAR; PG8_SCHED; } while (0)
    Unit cur, nxt; int ui = 0;
    if (!S.next(0, cur)) return;
    f32x4 acc[2][2][4][2];
#pragma unroll
    for (int a = 0; a < 2; ++a)
#pragma unroll
        for (int b = 0; b < 2; ++b)
#pragma unroll
            for (int m = 0; m < 4; ++m)
#pragma unroll
                for (int n = 0; n < 2; ++n) acc[a][b][m][n] = (f32x4){0.f, 0.f, 0.f, 0.f};
    bf16x8 At[4][2], B0[2][2], B1[2][2];
    f32x16 accw[2][2][2];
#define PG8_ZERO_W() do { if constexpr (F8) { _Pragma("unroll") for (int _a = 0; _a < 2; ++_a) _Pragma("unroll") for (int _b = 0; _b < 2; ++_b) _Pragma("unroll") for (int _m = 0; _m < 2; ++_m) _Pragma("unroll") for (int _e = 0; _e < 16; ++_e) accw[_a][_b][_m][_e] = 0.f; } } while (0)
    PG8_ZERO_W();
#pragma unroll
    for (int h = 0; h < 2; ++h) { uC[h] = GA ? 0u : S.unit_off(cur, h); uN[h] = uC[h];
#pragma unroll
        for (int i = 0; i < 2; ++i) { aoC[h][i] = GA ? (S.aoff(cur, h * HALF + RA[i]) + CA2[i]) : 0u; aoN[h][i] = aoC[h][i]; } }
    const char* cB = S.bptr(cur);
    PG8_STAGE_B(PG8_SB(0, 0), cB); PG8_STAGE_B1(PG8_SB(0, 1), cB); PG8_STAGE_A(PG8_SA(0, 0), 0u, uC[0], aoC[0]); PG8_STAGE_A(PG8_SA(0, 1), 0u, uC[1], aoC[1]);
    if (wr == 1) PG8_BAR;
    PG8_WAIT_V(2); PG8_BAR;
    PG8_STAGE_B(PG8_SB(1, 0), cB + kstepB); PG8_STAGE_A(PG8_SA(1, 0), kstepA, uC[0], aoC[0]); PG8_STAGE_B1(PG8_SB(1, 1), cB + kstepB);
    PG8_WAIT_V(6); PG8_BAR;
    for (;;) {
        const bool has_next = S.next(ui + 1, nxt);
        const char* nB = has_next ? S.bptr(nxt) : cB;
#pragma unroll
        for (int h = 0; h < 2; ++h) { uN[h] = (GA || !has_next) ? uC[h] : S.unit_off(nxt, h);
#pragma unroll
            for (int i = 0; i < 2; ++i) aoN[h][i] = (GA && has_next) ? (S.aoff(nxt, h * HALF + RA[i]) + CA2[i]) : aoC[h][i]; }
#pragma nounroll
        for (int t = 0; t < nt; t += 2) {
            const bool last = (t == nt - 2);
            const unsigned kb1 = (unsigned)(t + 1) * kstepA, kb2 = last ? 0u : (unsigned)(t + 2) * kstepA, kb3 = kb2 + kstepA;
            const char* b2 = last ? nB : cB + (size_t)(t + 2) * kstepB; const char* b3 = b2 + kstepB;
            unsigned u2[2], a2o[2][2];
#pragma unroll
            for (int h = 0; h < 2; ++h) { u2[h] = last ? uN[h] : uC[h];
#pragma unroll
                for (int i = 0; i < 2; ++i) a2o[h][i] = GA ? (last ? aoN[h][i] : aoC[h][i]) : 0u; }
            PG8_KPAIR(kb1, kb2, kb3, b2, b3);
        }
        if constexpr (ALIGN_EPI) { if (wr == 0) PG8_BAR; }
        if constexpr (F8) {
#pragma unroll
            for (int _a = 0; _a < 2; ++_a)
#pragma unroll
                for (int _b = 0; _b < 2; ++_b)
#pragma unroll
                    for (int _m = 0; _m < 4; ++_m)
#pragma unroll
                        for (int _n = 0; _n < 2; ++_n) { const f32x16& _w = accw[_a][_b][_m >> 1]; const int _q = ((_m & 1) * 2 + _n) * 4; acc[_a][_b][_m][_n] = (f32x4){_w[_q], _w[_q + 1], _w[_q + 2], _w[_q + 3]}; }
        }
        E(acc, cur, wr, wc, fr, fq);
        PG8_ZERO_W();
        if (!has_next) break;
#pragma unroll
        for (int a = 0; a < 2; ++a)
#pragma unroll
            for (int b = 0; b < 2; ++b)
#pragma unroll
                for (int m = 0; m < 4; ++m)
#pragma unroll
                    for (int n = 0; n < 2; ++n) acc[a][b][m][n] = (f32x4){0.f, 0.f, 0.f, 0.f};
        cur = nxt; cB = nB; ++ui;
#pragma unroll
        for (int h = 0; h < 2; ++h) { uC[h] = uN[h];
#pragma unroll
            for (int i = 0; i < 2; ++i) aoC[h][i] = aoN[h][i]; }
        if constexpr (ALIGN_EPI) { if (wr == 1) PG8_BAR; }
    }
    PG8_WAIT_V(0);
    if constexpr (!ALIGN_EPI) { if (wr == 0) PG8_BAR; }
    PG8_BAR;
#undef PG8_SA
#undef PG8_ZERO_W
#undef PG8_GLDS
#undef PG8_SB
#undef PG8_STAGE_A
#undef PG8_STAGE_B
#undef PG8_STAGE_B1
#undef PG8_LDA
#undef PG8_LDB
#undef PG8_MMA
#undef PG8_WAIT_V
#undef PG8_WAIT_L
#undef PG8_BAR
#undef PG8_SCHED
#undef PG8_KPAIR
}

struct DenseSched {
    const char* A; const char* Bt; unsigned lda2; size_t btile; int nM, nN, nwg, G, c;
    __device__ __forceinline__ void init(const bf16_t* A_, int lda, const bf16_t* Bt_, int K, int Mrows, int N) {
        A = (const char*)A_; Bt = (const char*)Bt_; lda2 = (unsigned)lda * 2u; btile = (size_t)256 * K * 2; nM = Mrows / BM; nN = N / BM; nwg = nM * nN; G = gridDim.x; c = blockIdx.x; }
    __device__ __forceinline__ bool next(int i, Unit& u) const {
        const long L = (long)i * G + c; if (L >= nwg) return false;
        int wgid = (int)L; { const int q = nwg / 8, r = nwg % 8, xcd = wgid % 8, off = wgid / 8; wgid = (xcd < r ? xcd * (q + 1) : r * (q + 1) + (xcd - r) * q) + off; }
        const int nig = 8 * nN, gid = wgid / nig, fm = gid * 8, gsz = (nM - fm) < 8 ? (nM - fm) : 8;
        u.pm = fm + ((wgid % nig) % gsz); u.pn = (wgid % nig) / gsz; u.ord = i; return true;
    }
    static constexpr bool GATHER = false;
    __device__ __forceinline__ unsigned lane_off(int r) const { return (unsigned)r * lda2; }
    __device__ __forceinline__ unsigned unit_off(const Unit& u, int h) const { return (unsigned)(u.pm * BM + h * HALF) * lda2; }
    __device__ __forceinline__ unsigned aoff(const Unit&, int) const { return 0u; }
    __device__ __forceinline__ const char* abase() const { return A; }
    __device__ __forceinline__ const char* bptr(const Unit& u) const { return Bt + (size_t)u.pn * btile; }
};
}
typedef float f32x2_t __attribute__((ext_vector_type(2))); typedef __bf16 bf16x2_t __attribute__((ext_vector_type(2)));
__device__ __forceinline__ unsigned cvt_pk_bf16(float lo, float hi) { const f32x2_t v = {lo, hi}; const bf16x2_t b = __builtin_convertvector(v, bf16x2_t); return __builtin_bit_cast(unsigned, b); }
__device__ __forceinline__ u32x4 pack8(const f32x4 v0, const f32x4 v1) { u32x4 w; w.x = cvt_pk_bf16(v0[0], v0[1]); w.y = cvt_pk_bf16(v0[2], v0[3]); w.z = cvt_pk_bf16(v1[0], v1[1]); w.w = cvt_pk_bf16(v1[2], v1[3]); return w; }
__device__ __forceinline__ unsigned cvtpk_m(float lo, float hi) { const f32x2_t v = {lo, hi}; const bf16x2_t b = __builtin_convertvector(v, bf16x2_t); return __builtin_bit_cast(unsigned, b); }
__device__ __forceinline__ u32x4 pack8m(const f32x4 v0, const f32x4 v1) { u32x4 w; w.x = cvtpk_m(v0[0], v0[1]); w.y = cvtpk_m(v0[2], v0[3]); w.z = cvtpk_m(v1[0], v1[1]); w.w = cvtpk_m(v1[2], v1[3]); return w; }
#define MFMA_SETTLE(S) asm volatile("s_nop 15\n\ts_nop 7" : "+v"(S[0][0]), "+v"(S[0][1]), "+v"(S[0][2]), "+v"(S[0][3]), "+v"(S[1][0]), "+v"(S[1][1]), "+v"(S[1][2]), "+v"(S[1][3]))
__device__ __forceinline__ f32x4 sig4(const f32x4 v) { f32x4 r; r[0] = sigmoidf_(v[0]); r[1] = sigmoidf_(v[1]); r[2] = sigmoidf_(v[2]); r[3] = sigmoidf_(v[3]); return r; }

#define EPI_ROWLOOP for (int ai = 0; ai < 2; ++ai) _Pragma("unroll") for (int m = 0; m < 4; ++m)
struct EpiInproj0 {
    static constexpr bool PERM = true, PERM16 = false; bf16_t* H0;
    __device__ __forceinline__ void operator()(const f32x4 (&acc)[2][2][4][2], const pg8::Unit& u, int wr, int wc, int fr, int fq) const {
        const int row0 = u.pm * 256 + wr * 64 + fr, cl = wc * 32 + 8 * fq;
#pragma unroll
        EPI_ROWLOOP { bf16_t* rp = H0 + (size_t)(row0 + ai * 128 + m * 16) * 1024;
            if (u.pn < 2) {
#pragma unroll
                for (int bj = 0; bj < 2; ++bj) *(u32x4*)(rp + u.pn * 256 + bj * 128 + cl) = pack8(acc[ai][bj][m][0], acc[ai][bj][m][1]);
            } else {
                const f32x4 v0 = acc[ai][0][m][0] * sig4(acc[ai][1][m][0]), v1 = acc[ai][0][m][1] * sig4(acc[ai][1][m][1]);
                *(u32x4*)(rp + 512 + (u.pn - 2) * 128 + cl) = pack8(v0, v1);
            } }
    }
};
struct EpiRes {
    static constexpr bool PERM = true, PERM16 = false; const float* resf; const bf16_t* resb; bf16_t* Y; float sc;
    __device__ __forceinline__ void operator()(const f32x4 (&acc)[2][2][4][2], const pg8::Unit& u, int wr, int wc, int fr, int fq) const {
        const int row0 = u.pm * 256 + wr * 64 + fr, c0 = u.pn * 256 + wc * 32 + 8 * fq;
#pragma unroll
        EPI_ROWLOOP { const size_t ro = (size_t)(row0 + ai * 128 + m * 16) * 1024 + c0;
#pragma unroll
            for (int bj = 0; bj < 2; ++bj) {
                f32x4 r0, r1;
                if (resf) { r0 = *(const f32x4*)(resf + ro + bj * 128); r1 = *(const f32x4*)(resf + ro + bj * 128 + 4); }
                else { const u32x4 xv = *(const u32x4*)(resb + ro + bj * 128);
                    r0[0] = __uint_as_float(xv.x << 16); r0[1] = __uint_as_float(xv.x & 0xffff0000u); r0[2] = __uint_as_float(xv.y << 16); r0[3] = __uint_as_float(xv.y & 0xffff0000u);
                    r1[0] = __uint_as_float(xv.z << 16); r1[1] = __uint_as_float(xv.z & 0xffff0000u); r1[2] = __uint_as_float(xv.w << 16); r1[3] = __uint_as_float(xv.w & 0xffff0000u); }
                *(u32x4*)(Y + ro + bj * 128) = pack8(acc[ai][bj][m][0] * sc + r0 * ALPHA, acc[ai][bj][m][1] * sc + r1 * ALPHA);
            } }
    }
};
struct EpiLogits {
    static constexpr bool PERM = true, PERM16 = false; float* LOG;
    __device__ __forceinline__ void operator()(const f32x4 (&acc)[2][2][4][2], const pg8::Unit& u, int wr, int wc, int fr, int fq) const {
        const int row0 = u.pm * 256 + wr * 64 + fr, cl = wc * 32 + 8 * fq;
#pragma unroll
        EPI_ROWLOOP { float* rp = LOG + (size_t)(row0 + ai * 128 + m * 16) * 256 + cl;
#pragma unroll
            for (int bj = 0; bj < 2; ++bj) { *(f32x4*)(rp + bj * 128) = acc[ai][bj][m][0]; *(f32x4*)(rp + bj * 128 + 4) = acc[ai][bj][m][1]; } }
    }
};

constexpr int MOE_TAB_OFF = 131072;
__device__ __forceinline__ int moe_setup256(const unsigned* cnt, LAS unsigned char* lds) {
    LAS int* tstart = (LAS int*)(lds + MOE_TAB_OFF);
    LAS int* scnt = (LAS int*)(lds + MOE_TAB_OFF + 1088);
    LAS unsigned short* texp = (LAS unsigned short*)(lds + MOE_TAB_OFF + 2176);
    const int tid = threadIdx.x;
    __syncthreads();
    const int lane = tid & 63, wave = tid >> 6;
    LAS int* wtot = tstart + 260;
    int c = 0;
    if (tid < 256) { const int n = (int)cnt[tid]; scnt[tid] = n; c = (n + 255) >> 8; }
    int incl = c;
#pragma unroll
    for (int o = 1; o < 64; o <<= 1) { const int t = __shfl_up(incl, o); if (lane >= o) incl += t; }
    if (tid < 256 && lane == 63) wtot[wave] = incl;
    __syncthreads();
    if (tid < 256) { int off = 0;
#pragma unroll
        for (int w = 0; w < 3; ++w) off += (w < wave) ? wtot[w] : 0;
        tstart[tid] = off + incl - c; if (tid == 255) tstart[256] = off + incl; }
    __syncthreads();
    if (tid < 256) for (int q = tstart[tid]; q < tstart[tid + 1]; ++q) texp[q] = (unsigned short)tid;
    __syncthreads();
    return __builtin_amdgcn_readfirstlane(tstart[256]);
}
constexpr int MOE_TOK_OFF = MOE_TAB_OFF + 5120;
constexpr int MOE_MAX_ORD = 20;
struct MoeGuSched {
    static constexpr bool GATHER = true;
    const char* X; const char* W; const int2* list; LAS unsigned char* lds; int R, nunits, G, c;
    __device__ __forceinline__ int vcu() const { return (G % 8 == 0) ? (c % 8) * (G / 8) + c / 8 : c; }
    __device__ __forceinline__ bool next(int i, pg8::Unit& u) const {
        const int L = i * G + vcu(); if (L >= nunits || i >= MOE_MAX_ORD) return false;
        const int q = L >> 1; const int e = __builtin_amdgcn_readfirstlane((q < R) ? (int)((LAS unsigned short*)(lds + MOE_TAB_OFF + 2176))[q] : 256);
        u.pm = q; u.pn = e * 2 + (L & 1); u.ord = i; return true; }
    __device__ __forceinline__ void prepare() const {
        const int tid = threadIdx.x, r = tid & 255;
        pg8::Unit u;
        for (int i = tid >> 8; next(i, u); i += 2) {
            const int e = u.pn >> 1; int token;
            if (e < 256) { const int ts = ((LAS int*)(lds + MOE_TAB_OFF))[e], cn = ((LAS int*)(lds + MOE_TAB_OFF + 1088))[e]; int lr = (u.pm - ts) * 256 + r; if (lr >= cn) lr = cn - 1;
                token = list[(size_t)e * LISTCAP + lr].x / 10; }
            else token = (u.pm - R) * 256 + r;
            ((LAS unsigned short*)(lds + MOE_TOK_OFF))[i * 256 + r] = (unsigned short)token;
        }
        __syncthreads();
    }
    __device__ __forceinline__ unsigned aoff(const pg8::Unit& u, int r) const { return (unsigned)((LAS unsigned short*)(lds + MOE_TOK_OFF))[u.ord * 256 + r] * 1024u; }
    __device__ __forceinline__ unsigned lane_off(int) const { return 0u; }
    __device__ __forceinline__ unsigned unit_off(const pg8::Unit&, int) const { return 0u; }
    __device__ __forceinline__ const char* abase() const { return X; }
    __device__ __forceinline__ const char* bptr(const pg8::Unit& u) const { return W + (size_t)u.pn * (256 * 1024); }
};
constexpr float GU_SC = 1.0f / (X8_SCALE * W8_SCALE);
struct EpiGateUp {
    static constexpr bool PERM = true, PERM16 = false; unsigned char* HID;
    __device__ __forceinline__ void operator()(const f32x4 (&acc)[2][2][4][2], const pg8::Unit& u, int wr, int wc, int fr, int fq) const {
        const int row0 = u.pm * 256 + wr * 64 + fr, c0 = (u.pn & 1) * 128 + wc * 32 + 8 * fq;
#pragma unroll
        EPI_ROWLOOP { const f32x4 g0 = acc[ai][0][m][0] * GU_SC, g1 = acc[ai][0][m][1] * GU_SC;
            f32x4 h0 = g0 * sig4(g0) * (acc[ai][1][m][0] * (GU_SC * H8_SCALE)), h1 = g1 * sig4(g1) * (acc[ai][1][m][1] * (GU_SC * H8_SCALE));
#pragma unroll
            for (int i = 0; i < 4; ++i) { h0[i] = clamp8(h0[i]); h1[i] = clamp8(h1[i]); }
            *(u32x2*)(HID + (size_t)(row0 + ai * 128 + m * 16) * 256 + c0) = pack8_fp8(h0, h1); }
    }
};
constexpr int MOE_RI_OFF = MOE_TAB_OFF + 5120;
constexpr int MOE_MAX_RT = 6;
struct MoeDownSched {
    const char* HID; const char* W; const int2* list; LAS unsigned char* lds; int R, ntile, G, c;
    __device__ __forceinline__ int vcu() const { return (G % 8 == 0) ? (c % 8) * (G / 8) + c / 8 : c; }
    __device__ __forceinline__ bool next(int i, pg8::Unit& u) const {
        const int q = vcu() + G * (i >> 2); if (q >= ntile || (i >> 2) >= MOE_MAX_RT) return false;
        const int e = (q < R) ? (int)((LAS unsigned short*)(lds + MOE_TAB_OFF + 2176))[q] : 256;
        u.pm = q; u.pn = e * 4 + (i & 3); u.ord = i >> 2; return true; }
    __device__ __forceinline__ void prepare() const {
        const int tid = threadIdx.x, r = tid & 255;
        for (int o = tid >> 8; o < MOE_MAX_RT; o += 2) {
            const int q = vcu() + G * o; if (q >= ntile) break;
            u32x2 en;
            if (q < R) { const int e = ((LAS unsigned short*)(lds + MOE_TAB_OFF + 2176))[q]; const int ts = ((LAS int*)(lds + MOE_TAB_OFF))[e], cn = ((LAS int*)(lds + MOE_TAB_OFF + 1088))[e];
                const int lr = (q - ts) * 256 + r; if (lr < cn) { const int2 le = list[(size_t)e * LISTCAP + lr]; en.x = (unsigned)le.x; en.y = (unsigned)le.y; } else { en.x = 0xffffffffu; en.y = 0u; } }
            else { en.x = (unsigned)(((q - R) * 256 + r) * 10 + 8); en.y = __float_as_uint(1.0f); }
            ((LAS u32x2*)(lds + MOE_RI_OFF))[o * 256 + r] = en;
        }
        __syncthreads();
    }
    static constexpr bool GATHER = false;
    __device__ __forceinline__ unsigned lane_off(int r) const { return (unsigned)r * 256u; }
    __device__ __forceinline__ unsigned unit_off(const pg8::Unit& u, int h) const { return (unsigned)(u.pm * 256 + h * 128) * 256u; }
    __device__ __forceinline__ unsigned aoff(const pg8::Unit&, int) const { return 0u; }
    __device__ __forceinline__ const char* abase() const { return HID; }
    __device__ __forceinline__ const char* bptr(const pg8::Unit& u) const { return W + (size_t)u.pn * (256 * 256); }
};
struct EpiDown {
    static constexpr bool PERM = true, PERM16 = true;
    unsigned char* YB; LAS unsigned char* lds;
    __device__ __forceinline__ void operator()(const f32x4 (&acc)[2][2][4][2], const pg8::Unit& u, int wr, int wc, int fr, int fq) const {
        asm volatile("" : "+v"(fr), "+v"(fq));
        const unsigned c0b = (unsigned)((u.pn & 3) * 256 + wc * 64 + 16 * fq); const bool shared = (u.pn >> 2) == 256;
        const LAS u32x2* ri = (const LAS u32x2*)(lds + MOE_RI_OFF) + u.ord * 256 + wr * 64 + fr;
#pragma unroll
        for (int ai = 0; ai < 2; ++ai)
#pragma unroll
            for (int m = 0; m < 4; ++m) { const u32x2 en = ri[ai * 128 + m * 16]; const float wv = __uint_as_float(en.y) * (YB_SCALE / (H8_SCALE * W8_SCALE));
                if ((int)en.x >= 0) { unsigned char* rp = YB + (size_t)(en.x * 1024u + c0b);
                    const f32x4 v00 = acc[ai][0][m][0] * wv, v01 = acc[ai][0][m][1] * wv, v10 = acc[ai][1][m][0] * wv, v11 = acc[ai][1][m][1] * wv;
                    const u32x2 h0 = pack8_fp8(v00, v01), h1 = pack8_fp8(v10, v11);
                    *(u32x4*)rp = (u32x4){h0.x, h0.y, h1.x, h1.y};
                    if (YB_NSLOT == 10 && shared) {
                        u32x2 r_[2];
#pragma unroll
                        for (int bj = 0; bj < 2; ++bj) { const u32x2 h = bj ? h1 : h0; const f32x4 v0 = bj ? v10 : v00, v1 = bj ? v11 : v01;
                            const auto a0 = __builtin_amdgcn_cvt_pk_f32_fp8((int)h.x, false), a1 = __builtin_amdgcn_cvt_pk_f32_fp8((int)h.x, true), a2 = __builtin_amdgcn_cvt_pk_f32_fp8((int)h.y, false), a3 = __builtin_amdgcn_cvt_pk_f32_fp8((int)h.y, true);
                            const f32x4 r0 = {v0[0] - a0[0], v0[1] - a0[1], v0[2] - a1[0], v0[3] - a1[1]}, r1 = {v1[0] - a2[0], v1[1] - a2[1], v1[2] - a3[0], v1[3] - a3[1]};
                            r_[bj] = pack8_fp8(r0, r1); }
                        *(u32x4*)(rp + 1024) = (u32x4){r_[0].x, r_[0].y, r_[1].x, r_[1].y}; } } }
    }
};

struct EpiInprojN {
    static constexpr bool PERM = true, PERM16 = false; bf16_t* QN; bf16_t* QR; bf16_t* KV6; float* GATES; const float* ROT;
    __device__ __forceinline__ void operator()(const f32x4 (&acc)[2][2][4][2], const pg8::Unit& u, int wr, int wc, int fr, int fq) const {
        const int row0 = u.pm * 256 + wr * 64 + fr, cl = wc * 32 + 8 * fq, pn = u.pn;
        const bool isq = pn < 4, rotk = (pn == 6 || pn == 8), dorot = (isq || rotk) && ((wc & 1) == 0);
#pragma unroll
        EPI_ROWLOOP { const int row = row0 + ai * 128 + m * 16;
            if (pn == 10) {
                if (cl < 48) { *(f32x4*)(GATES + (size_t)row * 48 + cl) = sig4(acc[ai][0][m][0]); *(f32x4*)(GATES + (size_t)row * 48 + cl + 4) = sig4(acc[ai][0][m][1]); }
            } else {
                f32x4 cs0, cs1, sn0, sn1;
                if (dorot) { const float* rt = ROT + (size_t)(row & (T - 1)) * 16; cs0 = *(const f32x4*)rt; cs1 = *(const f32x4*)(rt + 4); sn0 = *(const f32x4*)(rt + 8); sn1 = *(const f32x4*)(rt + 12); }
#pragma unroll
                for (int bj = 0; bj < 2; ++bj) {
                    const f32x4 v0 = acc[ai][bj][m][0], v1 = acc[ai][bj][m][1];
                    f32x4 r0 = v0, r1 = v1;
                    if (dorot) {
                        f32x4 p0, p1;
#pragma unroll
                        for (int i = 0; i < 4; ++i) { p0[i] = __shfl_xor(v0[i], 16); p1[i] = __shfl_xor(v1[i], 16); }
                        if (fq == 0) { r0 = v0 * cs0 - p0 * sn0; r1 = v1 * cs1 - p1 * sn1; }
                        else if (fq == 1) { r0 = v0 * cs0 + p0 * sn0; r1 = v1 * cs1 + p1 * sn1; }
                    }
                    if (isq) { const int c = pn * 256 + bj * 128 + cl;
                        *(u32x4*)(QN + (size_t)row * 1024 + c) = pack8(v0 * QSCALE, v1 * QSCALE); *(u32x4*)(QR + (size_t)row * 1024 + c) = pack8(r0 * QSCALE, r1 * QSCALE); }
                    else { const int cc = bj * 128 + cl, g = cc >> 6, d = cc & 63, b = row >> 13, t = row & (T - 1);
                        *(u32x4*)(KV6 + ((size_t)((pn - 4) * 16 + b * 4 + g) * T + t) * 64 + d) = pack8(r0, r1); }
                }
            } }
    }
};

struct Cmp1Sched {
    const char* KV6; const char* W; int G, c;
    static constexpr bool GATHER = false;
    __device__ __forceinline__ bool next(int i, pg8::Unit& u) const { const int L = i * G + c; if (L >= 64) return false; u.pm = L >> 1; u.pn = L & 1; u.ord = i; return true; }
    __device__ __forceinline__ unsigned lane_off(int r) const { return (unsigned)r * 2048u; }
    __device__ __forceinline__ unsigned unit_off(const pg8::Unit& u, int h) const { return (unsigned)u.pn * (unsigned)(16 * T * 64 * 2) + (unsigned)(u.pm * 256 + h * 128) * 2048u; }
    __device__ __forceinline__ unsigned aoff(const pg8::Unit&, int) const { return 0u; }
    __device__ __forceinline__ const char* abase() const { return KV6; }
    __device__ __forceinline__ const char* bptr(const pg8::Unit& u) const { return W + (size_t)u.pn * (256 * 2048 * 2); }
};
struct EpiCmp1 {
    static constexpr bool PERM = true, PERM16 = false; bf16_t* CH1; const float* bias1;
    __device__ __forceinline__ void operator()(const f32x4 (&acc)[2][2][4][2], const pg8::Unit& u, int wr, int wc, int fr, int fq) const {
        const int row0 = u.pm * 256 + wr * 64 + fr, cl = wc * 32 + 8 * fq;
        const f32x4 b0 = *(const f32x4*)(bias1 + u.pn * 128 + cl), b1 = *(const f32x4*)(bias1 + u.pn * 128 + cl + 4);
#pragma unroll
        EPI_ROWLOOP { f32x4 v0 = acc[ai][0][m][0] + b0, v1 = acc[ai][0][m][1] + b1;
#pragma unroll
            for (int i = 0; i < 4; ++i) { v0[i] = gelu_tanh(v0[i]); v1[i] = gelu_tanh(v1[i]); }
            *(u32x4*)(CH1 + ((size_t)u.pn * 8192 + row0 + ai * 128 + m * 16) * 128 + cl) = pack8(v0, v1); }
    }
};

__device__ __forceinline__ void p0_item(const float* W, int K, int N, bf16_t* WT, int kb, int n0, int drow0, LAS float* scr, int lane, bool f8 = false) {
    const int k0 = 64 * kb, n4 = (lane & 15) * 4;
    const bool cok = (n0 + n4) < N;
    f32x4 v[16];
#pragma unroll
    for (int i = 0; i < 16; ++i) { const int kk = 4 * i + (lane >> 4); v[i] = cok ? __builtin_nontemporal_load((const f32x4*)(W + (size_t)(k0 + kk) * N + n0 + n4)) : (f32x4){0.f, 0.f, 0.f, 0.f}; }
#pragma unroll
    for (int i = 0; i < 16; ++i) { const int kk = 4 * i + (lane >> 4); LAS float* d = scr + kk * 65 + n4; d[0] = v[i][0]; d[1] = v[i][1]; d[2] = v[i][2]; d[3] = v[i][3]; }
    asm volatile("s_waitcnt lgkmcnt(0)" ::: "memory");
    if (f8) {
        const int c4 = lane & 3;
#pragma unroll
        for (int j = 0; j < 4; ++j) { const int n = (lane >> 2) + 16 * j; const LAS float* sp = scr + (16 * c4) * 65 + n;
            u32x4 o;
            o.x = pk4_fp8(sp[0 * 65] * W8_SCALE, sp[1 * 65] * W8_SCALE, sp[2 * 65] * W8_SCALE, sp[3 * 65] * W8_SCALE); o.y = pk4_fp8(sp[4 * 65] * W8_SCALE, sp[5 * 65] * W8_SCALE, sp[6 * 65] * W8_SCALE, sp[7 * 65] * W8_SCALE);
            o.z = pk4_fp8(sp[8 * 65] * W8_SCALE, sp[9 * 65] * W8_SCALE, sp[10 * 65] * W8_SCALE, sp[11 * 65] * W8_SCALE); o.w = pk4_fp8(sp[12 * 65] * W8_SCALE, sp[13 * 65] * W8_SCALE, sp[14 * 65] * W8_SCALE, sp[15 * 65] * W8_SCALE);
            if (n0 + n < N) __builtin_nontemporal_store(o, (u32x4*)((unsigned char*)WT + (size_t)(drow0 + n) * K + k0 + 16 * c4)); }
        asm volatile("s_waitcnt lgkmcnt(0)" ::: "memory");
        return;
    }
    const int c = lane & 7;
#pragma unroll
    for (int j = 0; j < 8; ++j) { const int n = (lane >> 3) + 8 * j; const LAS float* sp = scr + (8 * c) * 65 + n;
        u32x4 o; o.x = pk2(sp[0 * 65], sp[1 * 65]); o.y = pk2(sp[2 * 65], sp[3 * 65]); o.z = pk2(sp[4 * 65], sp[5 * 65]); o.w = pk2(sp[6 * 65], sp[7 * 65]);
        if (n0 + n < N) __builtin_nontemporal_store(o, (u32x4*)(WT + (size_t)(drow0 + n) * K + k0 + 8 * c)); }
    asm volatile("s_waitcnt lgkmcnt(0)" ::: "memory");
}
struct CvtItem { const float* W; bf16_t* WT; int K, N, k0, n0, drow0; };
__device__ __forceinline__ void cvt32_load(const CvtItem& it, int lane, f32x4 (&v)[8]) {
    const int n4 = (lane & 7) * 4;
#pragma unroll
    for (int i = 0; i < 8; ++i) { const int kk = 8 * i + (lane >> 3); v[i] = __builtin_nontemporal_load((const f32x4*)(it.W + (size_t)(it.k0 + kk) * it.N + it.n0 + n4)); }
}
__device__ __forceinline__ void cvt32_finish(const CvtItem& it, int lane, const f32x4 (&v)[8], LAS float* scr) {
    const int n4 = (lane & 7) * 4;
#pragma unroll
    for (int i = 0; i < 8; ++i) { const int kk = 8 * i + (lane >> 3); LAS float* d = scr + kk * 33 + n4; d[0] = v[i][0]; d[1] = v[i][1]; d[2] = v[i][2]; d[3] = v[i][3]; }
    asm volatile("s_waitcnt lgkmcnt(0)" ::: "memory");
    const int c = lane & 7;
#pragma unroll
    for (int j = 0; j < 4; ++j) { const int n = (lane >> 3) + 8 * j; const LAS float* sp = scr + (8 * c) * 33 + n;
        const float v0 = sp[0 * 33], v1 = sp[1 * 33], v2 = sp[2 * 33], v3 = sp[3 * 33], v4 = sp[4 * 33], v5 = sp[5 * 33], v6 = sp[6 * 33], v7 = sp[7 * 33];
        u32x2 o; o.x = pk4_fp8(v0 * W8_SCALE, v1 * W8_SCALE, v2 * W8_SCALE, v3 * W8_SCALE); o.y = pk4_fp8(v4 * W8_SCALE, v5 * W8_SCALE, v6 * W8_SCALE, v7 * W8_SCALE);
        __builtin_nontemporal_store(o, (u32x2*)((unsigned char*)it.WT + (size_t)(it.drow0 + n) * it.K + it.k0 + 8 * c)); }
    asm volatile("s_waitcnt lgkmcnt(0)" ::: "memory");
}
constexpr int CVT1_ITEMS = 257 * 384;
__device__ __forceinline__ CvtItem cvt1_item(const Args& a, int idx) {
    const int e = idx / 384, sub = idx % 384, mat = sub >> 7, r = sub & 127;
    CvtItem it;
    if (mat < 2) { it.W = (e < 256) ? a.in[23 + mat] + ((size_t)256 + e) * (size_t)(D * FF) : a.in[26 + mat] + (size_t)(D * FF);
        it.K = D; it.N = FF; it.k0 = (r >> 3) * 64; it.n0 = (r & 7) * 32; it.drow0 = (it.n0 >> 7) * 256 + mat * 128 + (it.n0 & 127);
        it.WT = (bf16_t*)(a.ws + WS_WGU + (size_t)(257 + e) * 512 * 1024); }
    else { it.W = (e < 256) ? a.in[25] + ((size_t)256 + e) * (size_t)(FF * D) : a.in[28] + (size_t)(FF * D);
        it.K = FF; it.N = D; it.k0 = (r >> 5) * 64; it.n0 = (r & 31) * 32; it.drow0 = it.n0;
        it.WT = (bf16_t*)(a.ws + WS_WD + (size_t)(257 + e) * 1024 * 256); }
    return it;
}
__device__ __forceinline__ void cvt1_run(const Args& a, int& next, int stride, int quota, LAS float* scr, int lane) {
#pragma unroll 1
    for (int q = 0; q < quota && next < CVT1_ITEMS; ++q) {
        CvtItem t[4]; f32x4 v[4][8]; bool ok[4];
#pragma unroll
        for (int u = 0; u < 4; ++u) { const int idx = next + u * stride; ok[u] = idx < CVT1_ITEMS; t[u] = cvt1_item(a, ok[u] ? idx : 0); if (ok[u]) cvt32_load(t[u], lane, v[u]); }
        next += 4 * stride;
#pragma unroll
        for (int u = 0; u < 4; ++u) if (ok[u]) cvt32_finish(t[u], lane, v[u], scr);
    }
}
__device__ __forceinline__ void ph_prologue(const Args& a, LAS unsigned char* lds) {
    const int lane = threadIdx.x & 63, wave = threadIdx.x >> 6;
    LAS float* scr = (LAS float*)(lds + wave * 16640);
    const int gw = blockIdx.x * 8 + wave, ngw = gridDim.x * 8;
    for (int it = gw; it < 257 * 192; it += ngw) {
        const int le = it / 192, sub = it % 192, l = 0, e = le, mat = sub >> 6, r = sub & 63;
        if (mat < 2) {
            const float* W = (e < 256) ? a.in[23 + mat] + ((size_t)l * 256 + e) * (size_t)(D * FF) : a.in[26 + mat] + (size_t)l * (D * FF);
            const int kb = r >> 2, n0 = (r & 3) * 64;
            p0_item(W, D, FF, (bf16_t*)(a.ws + WS_WGU + (size_t)le * 512 * 1024), kb, n0, (n0 >> 7) * 256 + mat * 128 + (n0 & 127), scr, lane, true);
        } else {
            const float* W = (e < 256) ? a.in[25] + ((size_t)l * 256 + e) * (size_t)(FF * D) : a.in[28] + (size_t)l * (FF * D);
            const int kb = r >> 4, n0 = (r & 15) * 64;
            p0_item(W, FF, D, (bf16_t*)(a.ws + WS_WD + (size_t)le * 1024 * 256), kb, n0, n0, scr, lane, true);
        }
    }
    {
        for (int it = gw; it < 512; it += ngw) { const int w = it >> 8, r = it & 255;
            p0_item(a.in[w ? 16 : 8], D, D, (bf16_t*)(a.ws + (w ? WS_WOUTN : WS_WOUT0)), r >> 4, (r & 15) * 64, (r & 15) * 64, scr, lane, w != 0); }
        for (int it = gw; it < 16 * 41; it += ngw) p0_item(a.in[9], D, 2608, (bf16_t*)(a.ws + WS_WINN), it / 41, (it % 41) * 64, (it % 41) * 64, scr, lane);
        for (int it = gw; it < 128; it += ngw) { const int l = it >> 6, r = it & 63;
            p0_item(a.in[21] + (size_t)l * D * NE, D, NE, (bf16_t*)(a.ws + WS_WR) + (size_t)l * NE * D, r >> 2, (r & 3) * 64, (r & 3) * 64, scr, lane); }
        for (int it = gw; it < 16 * 16; it += ngw) { const int kb = it >> 4, n0 = (8 + (it & 15)) * 64;
            const int isg = (n0 >= 1024) ? 1 : 0, rel = n0 - 512 - isg * 512;
            p0_item(a.in[1], D, 1536, (bf16_t*)(a.ws + WS_WIN0), kb, n0, 512 + (rel >> 7) * 256 + isg * 128 + (rel & 127), scr, lane); }
        for (int it = gw; it < 128; it += ngw) { const int kv = it >> 6, r = it & 63;
            p0_item(a.in[kv ? 14 : 11], 2048, 128, (bf16_t*)(a.ws + WS_CW1) + (size_t)kv * 256 * 2048, r >> 1, (r & 1) * 64, (r & 1) * 64, scr, lane); }
    }
    {
        const int gt = blockIdx.x * 512 + threadIdx.x, ngt = gridDim.x * 512;
        u32x4* z0 = (u32x4*)((bf16_t*)(a.ws + WS_WINN) + (size_t)2608 * 1024);
        for (int i = gt; i < 208 * 1024 / 8; i += ngt) z0[i] = (u32x4){0u, 0u, 0u, 0u};
        for (int kv = 0; kv < 2; ++kv) { u32x4* z1 = (u32x4*)((bf16_t*)(a.ws + WS_CW1) + ((size_t)kv * 256 + 128) * 2048);
            for (int i = gt; i < 128 * 2048 / 8; i += ngt) z1[i] = (u32x4){0u, 0u, 0u, 0u}; }
        const float* x = a.in[0]; bf16_t* XA = (bf16_t*)(a.ws + WS_XA);
        for (size_t i = gt; i < (size_t)M * D / 8; i += ngt) { const f32x4 v0 = *(const f32x4*)(x + i * 8), v1 = *(const f32x4*)(x + i * 8 + 4);
            u32x4 o; o.x = pk2(v0[0], v0[1]); o.y = pk2(v0[2], v0[3]); o.z = pk2(v1[0], v1[1]); o.w = pk2(v1[2], v1[3]); *(u32x4*)(XA + i * 8) = o; }
        const float* win = a.in[1]; const float* mix = a.in[2]; const float* psc = a.in[3]; bf16_t* WIN0 = (bf16_t*)(a.ws + WS_WIN0);
        for (int i = gt; i < 512 * 1024; i += ngt) { const int n = i & 511, k = i >> 9, g = n >> 7, nn = n & 127;
            const float* wr_ = win + (size_t)k * 1536 + g * 128; const float* mx = mix + (size_t)g * 128 * 128 + nn;
            float s = 0.f;
            for (int c = 0; c < 128; ++c) s += wr_[c] * mx[(size_t)c * 128];
            WIN0[(size_t)n * 1024 + k] = f2bf(s * psc[n]); }
        float* misc = (float*)(a.ws + WS_MISC);
        for (int i = gt; i < 256; i += ngt) { const int kv = i >> 7, j = i & 127; const float* pos = a.in[kv ? 13 : 10]; const float* w1 = a.in[kv ? 14 : 11];
            float s = 0.f; for (int k = 0; k < 2048; ++k) s += pos[k] * w1[(size_t)k * 128 + j]; misc[i] = s; }
        float* rot = misc + 1024;
        for (int i = gt; i < T * 8; i += ngt) { const int t = i >> 3, f = i & 7;
            const float ang = (float)t * a.inv_freq[f]; const double rev = (double)ang * 0.15915494309189535; const float fr = (float)(rev - floor(rev));
            rot[t * 16 + f] = __builtin_amdgcn_cosf(fr); rot[t * 16 + 8 + f] = __builtin_amdgcn_sinf(fr); }
    }
}

typedef short v4i16_t __attribute__((ext_vector_type(4)));
constexpr int AT_KB = 0, AT_VB = 16384, AT_PS = 32768, AT_MSK = 32768 + 65536;
#define DPP_I(x, ctrl) __builtin_amdgcn_update_dpp((int)(x), (int)(x), (ctrl), 0xF, 0xF, true)
#define DPP_F(x, ctrl) __builtin_bit_cast(float, __builtin_amdgcn_update_dpp(__builtin_bit_cast(int, (float)(x)), __builtin_bit_cast(int, (float)(x)), (ctrl), 0xF, 0xF, true))
__device__ __forceinline__ bf16x8 tr_frag(LAS unsigned char* p0, LAS unsigned char* p1) {
    const v4i16_t a = __builtin_amdgcn_ds_read_tr16_b64_v4i16((LAS v4i16_t*)p0), b = __builtin_amdgcn_ds_read_tr16_b64_v4i16((LAS v4i16_t*)p1);
    return (bf16x8){a[0], a[1], a[2], a[3], b[0], b[1], b[2], b[3]};
}
constexpr size_t TN2_OFF = 786432;
__device__ __forceinline__ void ph_knorm(const Args& a) {
    const bf16_t* KV6 = (const bf16_t*)(a.ws + WS_KV6);
    float* TN2 = (float*)(a.ws + WS_MISC + TN2_OFF);
    const int lane = threadIdx.x & 63, wave = threadIdx.x >> 6;
    const int first = (gridDim.x > 64) ? 64 : 0;
    if ((int)blockIdx.x < first) return;
    const int wi = ((int)blockIdx.x - first) * 8 + wave, nw = ((int)gridDim.x - first) * 8;
    for (int id = wi; id < 4096; id += nw) {
        const int ty = id >> 11, bg = (id >> 7) & 15, tile = id & 127;
        const bf16_t* rp = KV6 + ((size_t)((ty ? 4 : 2) * 16 + bg) * T + tile * 64 + lane) * 64;
        float ssq = 0.f;
#pragma unroll
        for (int c = 0; c < 8; ++c) { const bf16x8 v = *(const bf16x8*)(rp + 8 * c);
#pragma unroll
            for (int j = 0; j < 8; ++j) { const float f = bf2f((bf16_t)v[j]); ssq += f * f; } }
        ssq = wave_max(ssq);
        if (lane == 0) TN2[id] = ssq;
    }
}
__device__ __forceinline__ void attn_qk2(LAS unsigned char* Kb, const bf16x8 (&q)[2][2], int fr, int g4, const float (&cinit)[2], f32x4 (&s)[2][4]) {
#pragma unroll
    for (int c = 0; c < 4; ++c) {
#pragma unroll
        for (int rb = 0; rb < 2; ++rb) s[rb][c] = (f32x4){cinit[rb], cinit[rb], cinit[rb], cinit[rb]};
#pragma unroll
        for (int ks = 0; ks < 2; ++ks) {
            const bf16x8 kf = *(const LAS bf16x8*)(Kb + pg8::lds_byte(16 * c + fr, 32 * ks + 8 * g4));
#pragma unroll
            for (int rb = 0; rb < 2; ++rb) s[rb][c] = __builtin_amdgcn_mfma_f32_16x16x32_bf16(kf, q[rb][ks], s[rb][c], 0, 0, 0);
        }
    }
}
__device__ __forceinline__ void attn_qk2m(LAS unsigned char* Kb, const bf16x8 (&q)[2][2], int fr, int g4, const float (&cinit)[2], f32x4 (&s)[2][4]) {
    bf16x8 kf[4][2];
#pragma unroll
    for (int c = 0; c < 4; ++c)
#pragma unroll
        for (int ks = 0; ks < 2; ++ks) kf[c][ks] = *(const LAS bf16x8*)(Kb + pg8::lds_byte(16 * c + fr, 32 * ks + 8 * g4));
    __builtin_amdgcn_sched_barrier(0);
    f32x4 ci[2];
#pragma unroll
    for (int rb = 0; rb < 2; ++rb) ci[rb] = (f32x4){cinit[rb], cinit[rb], cinit[rb], cinit[rb]};
#pragma unroll
    for (int c = 0; c < 4; ++c) {
#pragma unroll
        for (int ks = 0; ks < 2; ++ks) {
#pragma unroll
            for (int rb = 0; rb < 2; ++rb) s[rb][c] = __builtin_amdgcn_mfma_f32_16x16x32_bf16(kf[c][ks], q[rb][ks], ks == 0 ? ci[rb] : s[rb][c], 0, 0, 0);
        }
    }
}
__device__ __forceinline__ void attn_qk2z(LAS unsigned char* Kb, const bf16x8 (&q)[2][2], int fr, int g4, f32x4 (&s)[2][4]) {
    bf16x8 kf[4][2];
#pragma unroll
    for (int c = 0; c < 4; ++c)
#pragma unroll
        for (int ks = 0; ks < 2; ++ks) kf[c][ks] = *(const LAS bf16x8*)(Kb + pg8::lds_byte(16 * c + fr, 32 * ks + 8 * g4));
    __builtin_amdgcn_sched_barrier(0);
#pragma unroll
    for (int c = 0; c < 4; ++c) {
#pragma unroll
        for (int ks = 0; ks < 2; ++ks) {
#pragma unroll
            for (int rb = 0; rb < 2; ++rb) s[rb][c] = __builtin_amdgcn_mfma_f32_16x16x32_bf16(kf[c][ks], q[rb][ks], ks == 0 ? (f32x4){0.f, 0.f, 0.f, 0.f} : s[rb][c], 0, 0, 0);
        }
    }
}
struct AttnRow { float m; f32x4 o[4]; f32x4 ol; };
__device__ __forceinline__ float max3f(float a, float b, float c) { float r; asm("v_max3_f32 %0, %1, %2, %3" : "=v"(r) : "v"(a), "v"(b), "v"(c)); return r; }
__device__ __forceinline__ bool attn_sm2(f32x4 (&s)[4], AttnRow& st, int kbase, int g4, int lo, int hi, bool en, bool emask) {
    const float NEG = -INFINITY;
    if (emask) {
#pragma unroll
        for (int c = 0; c < 4; ++c)
#pragma unroll
            for (int i = 0; i < 4; ++i) { const int key = kbase + 16 * c + 4 * g4 + i; if (key < lo || key > hi) s[c][i] = NEG; }
    }
    float mx = max3f(s[0][0], s[0][1], s[0][2]); mx = max3f(mx, s[0][3], s[1][0]); mx = max3f(mx, s[1][1], s[1][2]); mx = max3f(mx, s[1][3], s[2][0]);
    mx = max3f(mx, s[2][1], s[2][2]); mx = max3f(mx, s[2][3], s[3][0]); mx = max3f(mx, s[3][1], s[3][2]); mx = max3f(mx, s[3][3], mx);
    if (!en) mx = NEG;
    mx = max3f(mx, __shfl_xor(mx, 16), mx); mx = max3f(mx, __shfl_xor(mx, 32), mx);
    const float delta = (mx > 20.0f) ? mx : 0.f;
    const bool moved = __builtin_amdgcn_ballot_w64(delta != 0.f) != 0ull;
    if (moved) {
        const float alpha = __builtin_amdgcn_exp2f(-delta);
#pragma unroll
        for (int c = 0; c < 4; ++c) s[c] = s[c] - delta;
#pragma unroll
        for (int dt = 0; dt < 4; ++dt) st.o[dt] *= alpha;
        st.ol *= alpha;
        st.m += delta;
    }
#pragma unroll
    for (int c = 0; c < 4; ++c)
#pragma unroll
        for (int i = 0; i < 4; ++i) s[c][i] = __builtin_amdgcn_exp2f(s[c][i]);
    return moved;
}
__device__ __forceinline__ bool attn_sm2x(f32x4 (&s)[2][4], AttnRow (&st)[2], int kbase, int g4, const int (&lo)[2], const int (&hi)[2], const bool (&en)[2], bool emask) {
    const float NEG = -INFINITY;
    if (emask) {
#pragma unroll
        for (int rb = 0; rb < 2; ++rb)
#pragma unroll
            for (int c = 0; c < 4; ++c)
#pragma unroll
                for (int i = 0; i < 4; ++i) { const int key = kbase + 16 * c + 4 * g4 + i; if (key < lo[rb] || key > hi[rb]) s[rb][c][i] = NEG; }
    }
    float mx[2];
#pragma unroll
    for (int rb = 0; rb < 2; ++rb) {
        float m = max3f(s[rb][0][0], s[rb][0][1], s[rb][0][2]); m = max3f(m, s[rb][0][3], s[rb][1][0]); m = max3f(m, s[rb][1][1], s[rb][1][2]); m = max3f(m, s[rb][1][3], s[rb][2][0]);
        m = max3f(m, s[rb][2][1], s[rb][2][2]); m = max3f(m, s[rb][2][3], s[rb][3][0]); m = max3f(m, s[rb][3][1], s[rb][3][2]); m = max3f(m, s[rb][3][3], m);
        mx[rb] = en[rb] ? m : NEG;
    }
    { const float t0 = __shfl_xor(mx[0], 16), t1 = __shfl_xor(mx[1], 16); mx[0] = max3f(mx[0], t0, t0); mx[1] = max3f(mx[1], t1, t1); }
    { const float t0 = __shfl_xor(mx[0], 32), t1 = __shfl_xor(mx[1], 32); mx[0] = max3f(mx[0], t0, t0); mx[1] = max3f(mx[1], t1, t1); }
    const float d0 = (mx[0] > 20.0f) ? mx[0] : 0.f, d1 = (mx[1] > 20.0f) ? mx[1] : 0.f;
    const bool moved = __builtin_amdgcn_ballot_w64((d0 != 0.f) || (d1 != 0.f)) != 0ull;
    if (moved) {
        const float dl[2] = {d0, d1};
#pragma unroll
        for (int rb = 0; rb < 2; ++rb) {
            const float alpha = __builtin_amdgcn_exp2f(-dl[rb]);
#pragma unroll
            for (int c = 0; c < 4; ++c) s[rb][c] = s[rb][c] - dl[rb];
#pragma unroll
            for (int dt = 0; dt < 4; ++dt) st[rb].o[dt] *= alpha;
            st[rb].ol *= alpha; st[rb].m += dl[rb];
        }
    }
#pragma unroll
    for (int rb = 0; rb < 2; ++rb)
#pragma unroll
        for (int c = 0; c < 4; ++c)
#pragma unroll
            for (int i = 0; i < 4; ++i) s[rb][c][i] = __builtin_amdgcn_exp2f(s[rb][c][i]);
    return moved;
}
__device__ __forceinline__ void attn_pv2x(LAS unsigned char* Vb, const f32x4 (&p)[2][4], int vlane, int swz, const unsigned (&enm)[2], const bool (&act)[2], const bf16x8 onesf, AttnRow (&st)[2]) {
#pragma unroll
    for (int ks = 0; ks < 2; ++ks) {
        bf16x8 pb[2];
#pragma unroll
        for (int rb = 0; rb < 2; ++rb) { u32x4 pw = pack8m(p[rb][2 * ks], p[rb][2 * ks + 1]); pw.x &= enm[rb]; pw.y &= enm[rb]; pw.z &= enm[rb]; pw.w &= enm[rb]; pb[rb] = __builtin_bit_cast(bf16x8, pw); }
#pragma unroll
        for (int dt = 0; dt < 4; ++dt) {
            LAS unsigned char* a0 = Vb + vlane + (2 * ks) * 2048 + ((dt ^ swz) * 32);
            const bf16x8 vf = tr_frag(a0, a0 + 2048);
#pragma unroll
            for (int rb = 0; rb < 2; ++rb) if (act[rb]) st[rb].o[dt] = __builtin_amdgcn_mfma_f32_16x16x32_bf16(vf, pb[rb], st[rb].o[dt], 0, 0, 0);
        }
#pragma unroll
        for (int rb = 0; rb < 2; ++rb) if (act[rb]) st[rb].ol = __builtin_amdgcn_mfma_f32_16x16x32_bf16(onesf, pb[rb], st[rb].ol, 0, 0, 0);
    }
}
__device__ __forceinline__ bool attn_max2x(f32x4 (&s)[2][4], int kbase, int g4, const int (&lo)[2], const int (&hi)[2], const bool (&en)[2], bool emask, float (&d)[2]) {
    const float NEG = -INFINITY;
    MFMA_SETTLE(s);
    if (emask) {
#pragma unroll
        for (int rb = 0; rb < 2; ++rb)
#pragma unroll
            for (int c = 0; c < 4; ++c)
#pragma unroll
                for (int i = 0; i < 4; ++i) { const int key = kbase + 16 * c + 4 * g4 + i; if (key < lo[rb] || key > hi[rb]) s[rb][c][i] = NEG; }
    }
    float mx[2];
#pragma unroll
    for (int rb = 0; rb < 2; ++rb) {
        float m = max3f(s[rb][0][0], s[rb][0][1], s[rb][0][2]); m = max3f(m, s[rb][0][3], s[rb][1][0]); m = max3f(m, s[rb][1][1], s[rb][1][2]); m = max3f(m, s[rb][1][3], s[rb][2][0]);
        m = max3f(m, s[rb][2][1], s[rb][2][2]); m = max3f(m, s[rb][2][3], s[rb][3][0]); m = max3f(m, s[rb][3][1], s[rb][3][2]); m = max3f(m, s[rb][3][3], m);
        mx[rb] = en[rb] ? m : NEG;
    }
    { const float t0 = __shfl_xor(mx[0], 16), t1 = __shfl_xor(mx[1], 16); mx[0] = max3f(mx[0], t0, t0); mx[1] = max3f(mx[1], t1, t1); }
    { const float t0 = __shfl_xor(mx[0], 32), t1 = __shfl_xor(mx[1], 32); mx[0] = max3f(mx[0], t0, t0); mx[1] = max3f(mx[1], t1, t1); }
    d[0] = (mx[0] > 20.0f) ? mx[0] : 0.f; d[1] = (mx[1] > 20.0f) ? mx[1] : 0.f;
    return __builtin_amdgcn_ballot_w64((d[0] != 0.f) || (d[1] != 0.f)) != 0ull;
}
__device__ __forceinline__ void attn_rescale2x(f32x4 (&s)[2][4], AttnRow (&st)[2], const float (&d)[2]) {
#pragma unroll
    for (int rb = 0; rb < 2; ++rb) {
        const float alpha = __builtin_amdgcn_exp2f(-d[rb]);
#pragma unroll
        for (int c = 0; c < 4; ++c) s[rb][c] = s[rb][c] - d[rb];
#pragma unroll
        for (int dt = 0; dt < 4; ++dt) st[rb].o[dt] *= alpha;
        st[rb].ol *= alpha; st[rb].m += d[rb];
    }
}
__device__ __forceinline__ void attn_exp1(f32x4 (&s)[4], unsigned enm, bf16x8 (&pb)[2]) {
#pragma unroll
    for (int c = 0; c < 4; ++c)
#pragma unroll
        for (int i = 0; i < 4; ++i) s[c][i] = __builtin_amdgcn_exp2f(s[c][i]);
#pragma unroll
    for (int ks = 0; ks < 2; ++ks) { u32x4 pw = pack8m(s[2 * ks], s[2 * ks + 1]); pw.x &= enm; pw.y &= enm; pw.z &= enm; pw.w &= enm; pb[ks] = __builtin_bit_cast(bf16x8, pw); }
}
__device__ __forceinline__ void attn_pv1(LAS unsigned char* Vb, const bf16x8 (&pb)[2], int vlane, int swz, const bf16x8 onesf, AttnRow& st) {
#pragma unroll
    for (int ks = 0; ks < 2; ++ks) {
#pragma unroll
        for (int dt = 0; dt < 4; ++dt) {
            LAS unsigned char* a0 = Vb + vlane + (2 * ks) * 2048 + ((dt ^ swz) * 32);
            const bf16x8 vf = tr_frag(a0, a0 + 2048);
            st.o[dt] = __builtin_amdgcn_mfma_f32_16x16x32_bf16(vf, pb[ks], st.o[dt], 0, 0, 0);
        }
        st.ol = __builtin_amdgcn_mfma_f32_16x16x32_bf16(onesf, pb[ks], st.ol, 0, 0, 0);
    }
}
__device__ __forceinline__ bool attn_step2x(LAS unsigned char* Vb, f32x4 (&s)[2][4], AttnRow (&st)[2], int kbase, int g4, const int (&lo)[2], const int (&hi)[2], const bool (&en)[2], const unsigned (&enm)[2], bool emask,
                                            int vlane, int swz, const bf16x8 onesf) {
    float d[2];
    const bool moved = attn_max2x(s, kbase, g4, lo, hi, en, emask, d);
    if (moved) attn_rescale2x(s, st, d);
    bf16x8 p0[2], p1[2];
    attn_exp1(s[0], enm[0], p0);
    attn_pv1(Vb, p0, vlane, swz, onesf, st[0]);
    attn_exp1(s[1], enm[1], p1);
    attn_pv1(Vb, p1, vlane, swz, onesf, st[1]);
    return moved;
}
__device__ __forceinline__ void attn_step2x_nomax(LAS unsigned char* Vb, f32x4 (&s)[2][4], AttnRow (&st)[2], int kbase, int g4, const int (&lo)[2], const int (&hi)[2], const unsigned (&enm)[2], bool emask,
                                                  int vlane, int swz, const bf16x8 onesf) {
    if (emask) {
#pragma unroll
        for (int rb = 0; rb < 2; ++rb)
#pragma unroll
            for (int c = 0; c < 4; ++c)
#pragma unroll
                for (int i = 0; i < 4; ++i) { const int key = kbase + 16 * c + 4 * g4 + i; if (key < lo[rb] || key > hi[rb]) s[rb][c][i] = -INFINITY; }
    }
    bf16x8 p0[2], p1[2];
    attn_exp1(s[0], enm[0], p0);
    attn_pv1(Vb, p0, vlane, swz, onesf, st[0]);
    attn_exp1(s[1], enm[1], p1);
    attn_pv1(Vb, p1, vlane, swz, onesf, st[1]);
}
typedef _Float16 f16x4 __attribute__((ext_vector_type(4)));
constexpr int AT4_KB = 0, AT4_VB = 32768, AT2_PS = 65536, AT2_MSK = 65536 + 65536;
__device__ __forceinline__ void ph_attn_fast2(const Args& a, LAS unsigned char* lds) {
    const bf16_t* QN = (const bf16_t*)(a.ws + WS_HN);
    const bf16_t* QR = (const bf16_t*)(a.ws + WS_QR);
    const bf16_t* KV6 = (const bf16_t*)(a.ws + WS_KV6);
    const float* GATES = (const float*)(a.ws + WS_GATES);
    const bf16_t* KC = (const bf16_t*)(a.ws + WS_KC);
    const bf16_t* VC = KC + (size_t)8192 * 64;
    bf16_t* O = (bf16_t*)(a.ws + WS_O);
    const int tid = threadIdx.x, lane = tid & 63, wave = __builtin_amdgcn_readfirstlane(tid >> 6);
    const int fr = lane & 15, g4 = lane >> 4;
    int ksrc, vsrc;
    { int R, C; pg8::stage_rc(wave * 1024 + lane * 16, R, C); ksrc = R * 64 + C;
      const int key = 8 * wave + (lane >> 3), pos = lane & 7, chunk = (pos >> 1) ^ ((key >> 1) & 3); vsrc = key * 64 + (chunk * 2 + (pos & 1)) * 8; }
    const int vlane = (4 * g4 + (fr >> 2)) * 128 + (fr & 3) * 8, swz = (2 * g4 + (fr >> 3)) & 3;
    LAS _Float16* ps = (LAS _Float16*)(lds + AT2_PS + wave * 8192);
    LAS unsigned* mskl = (LAS unsigned*)(lds + AT2_MSK + wave * 128);
    const float NEG = -INFINITY;
    const bf16x8 onesf = (fr == 0) ? (bf16x8){0x3F80, 0x3F80, 0x3F80, 0x3F80, 0x3F80, 0x3F80, 0x3F80, 0x3F80} : (bf16x8){0, 0, 0, 0, 0, 0, 0, 0};
    const int vcu = (gridDim.x % 8 == 0) ? (int)((blockIdx.x % 8) * (gridDim.x / 8) + blockIdx.x / 8) : (int)blockIdx.x;
    int cvt_next = (int)blockIdx.x * 8 + wave; const int cvt_stride = (int)gridDim.x * 8;
    LAS float* cvt_scr = (LAS float*)(lds + AT2_PS + wave * 8448);
    bool cmp_pref = false;
    for (int pr = vcu; pr < 1024; pr += gridDim.x) {
#pragma unroll 1
        for (int half = 0; half < 2; ++half) {
            const int bg = pr >> 6, cc = half ? (127 - (pr & 63)) : (pr & 63);
            const int b = bg >> 2, g = bg & 3, t0 = cc * 64, cur = cc;
            const int head = g * 4 + (fr & 3);
            int trow[2];
            bf16x8 qn[2][2];
#pragma unroll
            for (int rb = 0; rb < 2; ++rb) {
                trow[rb] = t0 + 8 * wave + 4 * rb + (fr >> 2);
#pragma unroll
                for (int ks = 0; ks < 2; ++ks) qn[rb][ks] = *(const bf16x8*)(QN + ((size_t)b * T + trow[rb]) * 1024 + head * 64 + 32 * ks + 8 * g4);
            }
#define TROW_PIN() asm volatile("" : "+v"(trow[0]), "+v"(trow[1]))
#define TOKROW(rb) ((size_t)b * T + trow[rb])
#define GATE(rb, br) (GATES[TOKROW(rb) * 48 + head * 3 + (br)])
            const bf16_t* kcb = KC + (size_t)bg * 512 * 64;
            const bf16_t* kvb = KV6 + (size_t)bg * T * 64;
#define ATK(sl) (((sl) < 4 ? AT4_KB : AT2_PS - 4 * 8192) + (sl) * 8192)
#define ATV(sl) (((sl) < 4 ? AT4_VB : AT2_PS + 32768 - 4 * 8192) + (sl) * 8192)
#define AT_DMA(BR, tile, slot) do { const bf16_t* kp_; const bf16_t* vp_; \
                if ((BR) == 0) { kp_ = kcb + (size_t)(tile) * 4096; vp_ = kp_ + (size_t)8192 * 64; } \
                else { kp_ = kvb + (size_t)((BR) == 1 ? 2 : 4) * 16 * T * 64 + (size_t)(tile) * 4096; vp_ = kp_ + (size_t)16 * T * 64; } \
                __builtin_amdgcn_global_load_lds((const unsigned*)(kp_ + ksrc), (LAS unsigned*)(lds + ATK(slot) + wave * 1024), 16, 0, 0); \
                __builtin_amdgcn_global_load_lds((const unsigned*)(vp_ + vsrc), (LAS unsigned*)(lds + ATV(slot) + wave * 1024), 16, 0, 0); } while (0)
            int ncv[2];
#pragma unroll
            for (int rb = 0; rb < 2; ++rb) ncv[rb] = (trow[rb] >= 31) ? ((trow[rb] - 31) / 16 + 1) : 0;
            const int nct = (((t0 + 63 - 31) / 16 + 1) + 63) >> 6;
            float mc[2], invc[2];
            const int t_lo = t0 + 8 * wave, ncv_lo = (t_lo >= 31) ? ((t_lo - 31) / 16 + 1) : 0;
            {
                float m1[2] = {NEG, NEG}, l1[2] = {0.f, 0.f};
                const float zero2[2] = {0.f, 0.f};
#define CMP1_TILE(J, SLOT, MASKED) do { const int j = (J); const int SLOT_ = (SLOT); \
                    f32x4 s[2][4]; attn_qk2(lds + AT4_KB + SLOT_ * 8192, qn, fr, g4, zero2, s); \
                    _Pragma("unroll") \
                    for (int rb = 0; rb < 2; ++rb) { \
                        float mx = NEG; \
                    _Pragma("unroll") \
                        for (int c = 0; c < 4; ++c) \
                    _Pragma("unroll") \
                            for (int i = 0; i < 4; ++i) { const int n = 64 * j + 16 * c + 4 * g4 + i; if ((MASKED) && n >= ncv[rb]) s[rb][c][i] = NEG; mx = fmaxf(mx, s[rb][c][i]); } \
                        mx = fmaxf(mx, __shfl_xor(mx, 16)); mx = fmaxf(mx, __shfl_xor(mx, 32)); \
                        const float mn = fmaxf(m1[rb], mx), msafe = (mn == NEG) ? 0.f : mn; \
                        const float alpha = (m1[rb] == NEG) ? 0.f : __builtin_amdgcn_exp2f(m1[rb] - msafe); \
                        float sum = 0.f; \
                    _Pragma("unroll") \
                        for (int c = 0; c < 4; ++c) \
                    _Pragma("unroll") \
                            for (int i = 0; i < 4; ++i) sum += __builtin_amdgcn_exp2f(s[rb][c][i] - msafe); \
                        l1[rb] = l1[rb] * alpha + sum; m1[rb] = mn; \
                    } \
                } while (0)
                if (!cmp_pref) { AT_DMA(0, 0, 0); if (nct > 1) AT_DMA(0, 1, 1); } __syncthreads();
                for (int j0 = 0; j0 < nct; j0 += 2) { const int sb = (j0 & 2);
                    if (j0 + 2 < nct) AT_DMA(0, j0 + 2, sb ^ 2);
                    if (j0 + 3 < nct) AT_DMA(0, j0 + 3, (sb ^ 2) + 1);
                    CMP1_TILE(j0, sb, true); if (j0 + 1 < nct) CMP1_TILE(j0 + 1, sb + 1, true);
                    __syncthreads();
                }
#undef CMP1_TILE
#pragma unroll
                for (int rb = 0; rb < 2; ++rb) { float lc = l1[rb]; lc += __shfl_xor(lc, 16); lc += __shfl_xor(lc, 32); invc[rb] = (lc > 0.f) ? -(((m1[rb] == NEG) ? 0.f : m1[rb]) + __builtin_amdgcn_logf(lc)) : 0.f; mc[rb] = (m1[rb] == NEG) ? 0.f : m1[rb]; }
            }
            {
                AttnRow oc[2];
#pragma unroll
                for (int rb = 0; rb < 2; ++rb) { oc[rb].m = 0.f; oc[rb].ol = (f32x4){0.f, 0.f, 0.f, 0.f};
#pragma unroll
                    for (int dt = 0; dt < 4; ++dt) oc[rb].o[dt] = (f32x4){0.f, 0.f, 0.f, 0.f}; }
                const float cin[2] = {invc[0], invc[1]};
                const unsigned full[2] = {0xffffffffu, 0xffffffffu}; const bool both[2] = {true, true};
#define CMP2_TILE(J, SLOT, MASKED) do { const int j = (J); const int SLOT_ = (SLOT); \
                    f32x4 s[2][4]; attn_qk2(lds + AT4_KB + SLOT_ * 8192, qn, fr, g4, cin, s); \
                    _Pragma("unroll") \
                    for (int rb = 0; rb < 2; ++rb) \
                    _Pragma("unroll") \
                        for (int c = 0; c < 4; ++c) { \
                            f16x4 hs; \
                    _Pragma("unroll") \
                            for (int i = 0; i < 4; ++i) { const int n = 64 * j + 16 * c + 4 * g4 + i; const float p = (!(MASKED) || n < ncv[rb]) ? __builtin_amdgcn_exp2f(s[rb][c][i]) : 0.f; s[rb][c][i] = p; \
                                float h = p; h += DPP_F(h, 0xB1); h += DPP_F(h, 0x4E); hs[i] = (_Float16)h; }        \
                            if ((fr & 3) == 0) *(LAS f16x4*)(ps + (4 * rb + (fr >> 2)) * 512 + 64 * j + 16 * c + 4 * g4) = hs; \
                        } \
                    attn_pv2x(lds + AT4_VB + SLOT_ * 8192, s, vlane, swz, full, both, onesf, oc); \
                } while (0)
                const bool reload = nct > 4;
                if (reload) { AT_DMA(0, 0, 0); AT_DMA(0, 1, 1); __syncthreads(); }
                for (int j0 = 0; j0 < nct; j0 += 2) { const int sb = (j0 & 2);
                    if (reload && j0 + 2 < nct) AT_DMA(0, j0 + 2, sb ^ 2);
                    if (reload && j0 + 3 < nct) AT_DMA(0, j0 + 3, (sb ^ 2) + 1);
                    CMP2_TILE(j0, sb, true); if (j0 + 1 < nct) CMP2_TILE(j0 + 1, sb + 1, true);
                    __syncthreads();
                }
#undef CMP2_TILE
                TROW_PIN();
#pragma unroll
                for (int rb = 0; rb < 2; ++rb) { bf16_t* op = O + TOKROW(rb) * 1024 + head * 64 + 4 * g4; const float g0 = GATE(rb, 0);
#pragma unroll
                    for (int dt = 0; dt < 4; ++dt) { const f32x4 v = oc[rb].o[dt] * g0; u32x2 w; w.x = cvt_pk_bf16(v[0], v[1]); w.y = cvt_pk_bf16(v[2], v[3]); *(u32x2*)(op + 16 * dt) = w; } }
            }
            {
                WSYNC();
                const int tl = lane >> 4, li = lane & 15;
                const int nsel = (cur + 1 < 16) ? (cur + 1) : 16;
#pragma unroll 1
                for (int rnd = 0; rnd < 2; ++rnd) {
                    const LAS _Float16* pst = ps + (4 * rnd + tl) * 512;
                    float v[8];
#pragma unroll
                    for (int k = 0; k < 8; ++k) { const int j = li + 16 * k;
                        float x;
                        if (j > cur) x = NEG;
                        else if (j == 0 || j == cur || j == cur - 1) x = NEG;
                        else { const int n0 = 4 * j; x = (float)pst[n0 - 1] + 2.0f * ((float)pst[n0] + (float)pst[n0 + 1] + (float)pst[n0 + 2]) + (float)pst[n0 + 3]; }
                        v[k] = x; }
                    int vi[8];
#pragma unroll
                    for (int k = 0; k < 8; ++k) vi[k] = __builtin_bit_cast(int, v[k]);
                    unsigned mm[4] = {1u, 0u, 0u, 0u};
                    {
                        const unsigned bc = 1u << (cur & 31); const int wc_ = cur >> 5;
                        mm[0] |= (wc_ == 0) ? bc : 0u; mm[1] |= (wc_ == 1) ? bc : 0u; mm[2] |= (wc_ == 2) ? bc : 0u; mm[3] |= (wc_ == 3) ? bc : 0u;
                        if (cur >= 1) { const unsigned bp = 1u << ((cur - 1) & 31); const int wp_ = (cur - 1) >> 5;
                            mm[0] |= (wp_ == 0) ? bp : 0u; mm[1] |= (wp_ == 1) ? bp : 0u; mm[2] |= (wp_ == 2) ? bp : 0u; mm[3] |= (wp_ == 3) ? bp : 0u; }
                    }
                    const int nforced = (cur >= 2) ? 3 : (cur + 1);
                    for (int it = 0; it < nsel - nforced; ++it) {
                        int bv = max(max(max(vi[0], vi[1]), max(vi[2], vi[3])), max(max(vi[4], vi[5]), max(vi[6], vi[7])));
                        bv = max(bv, DPP_I(bv, 0xB1)); bv = max(bv, DPP_I(bv, 0x4E)); bv = max(bv, DPP_I(bv, 0x141)); bv = max(bv, DPP_I(bv, 0x140));
                        int bi = 255;
#pragma unroll
                        for (int k = 7; k >= 0; --k) bi = (vi[k] == bv) ? (li + 16 * k) : bi;
                        bi = min(bi, DPP_I(bi, 0xB1)); bi = min(bi, DPP_I(bi, 0x4E)); bi = min(bi, DPP_I(bi, 0x141)); bi = min(bi, DPP_I(bi, 0x140));
                        const unsigned bit = 1u << (bi & 31); const int wsel = bi >> 5;
                        mm[0] |= (wsel == 0) ? bit : 0u; mm[1] |= (wsel == 1) ? bit : 0u; mm[2] |= (wsel == 2) ? bit : 0u; mm[3] |= (wsel == 3) ? bit : 0u;
                        if ((bi & 15) == li) {
#pragma unroll
                            for (int k = 0; k < 8; ++k) if ((bi >> 4) == k) vi[k] = (int)0xFF800000;
                        }
                    }
                    if (li == 0) { mskl[(4 * rnd + tl) * 4 + 0] = mm[0]; mskl[(4 * rnd + tl) * 4 + 1] = mm[1]; mskl[(4 * rnd + tl) * 4 + 2] = mm[2]; mskl[(4 * rnd + tl) * 4 + 3] = mm[3]; }
                }
                WSYNC();
            }
            bf16x8 qr[2][2];
            TROW_PIN();
#pragma unroll
            for (int rb = 0; rb < 2; ++rb)
#pragma unroll
                for (int ks = 0; ks < 2; ++ks) qr[rb][ks] = *(const bf16x8*)(QR + TOKROW(rb) * 1024 + head * 64 + 32 * ks + 8 * g4);
            bool nomax_slc, nomax_win;
            {
                float qq = 0.f;
#pragma unroll
                for (int rb = 0; rb < 2; ++rb) { float q2 = 0.f;
#pragma unroll
                    for (int ks = 0; ks < 2; ++ks)
#pragma unroll
                        for (int j = 0; j < 8; ++j) { const float x = bf2f((bf16_t)qr[rb][ks][j]); q2 += x * x; }
                    q2 += __shfl_xor(q2, 16); q2 += __shfl_xor(q2, 32); qq = fmaxf(qq, q2); }
                qq = wave_max(qq);
                const float* tn = (const float*)(a.ws + WS_MISC + TN2_OFF) + bg * 128;
                const int jt0w = (t0 >= 511) ? ((t0 - 511) >> 6) : 0;
                float ts = 0.f, tw = 0.f;
#pragma unroll
                for (int h2 = 0; h2 < 2; ++h2) { const int tl_ = lane + 64 * h2; if (tl_ <= cur) { ts = fmaxf(ts, tn[tl_]); if (tl_ >= jt0w) tw = fmaxf(tw, tn[2048 + tl_]); } }
                ts = wave_max(ts); tw = wave_max(tw);
                nomax_slc = __builtin_amdgcn_readfirstlane((qq * ts <= 3500.0f) ? 1 : 0) != 0;
                nomax_win = __builtin_amdgcn_readfirstlane((qq * tw <= 3500.0f) ? 1 : 0) != 0;
            }
            {
                AttnRow ss[2];
#pragma unroll
                for (int rb = 0; rb < 2; ++rb) { ss[rb].m = 0.f; ss[rb].ol = (f32x4){0.f, 0.f, 0.f, 0.f};
#pragma unroll
                    for (int dt = 0; dt < 4; ++dt) ss[rb].o[dt] = (f32x4){0.f, 0.f, 0.f, 0.f}; }
                const int nt_ = cur + 1;
                bool refmoved = false;
#define SLC_PRE(J) const int j_ = (J); bool en[2], act[2]; unsigned enm[2]; \
                    _Pragma("unroll") for (int rb = 0; rb < 2; ++rb) { const unsigned mw = mwg[rb]; \
                        en[rb] = (mw >> (j_ & 31)) & 1u; act[rb] = __any(en[rb]); enm[rb] = en[rb] ? 0xffffffffu : 0u; } const int lo2[2] = {0, 0};
#define SLC_TILE(J, SLOT) do { SLC_PRE(J) \
                    if (act[0] || act[1]) { f32x4 s[2][4]; \
                        if (refmoved) { const float cin[2] = {-ss[0].m, -ss[1].m}; attn_qk2(lds + ATK(SLOT), qr, fr, g4, cin, s); } \
                        else attn_qk2z(lds + ATK(SLOT), qr, fr, g4, s); \
                        refmoved |= attn_step2x(lds + ATV(SLOT), s, ss, 64 * j_, g4, lo2, trow, en, enm, j_ == cur, vlane, swz, onesf); } } while (0)
#define SLC_TILE_NM(J, SLOT) do { SLC_PRE(J) \
                    if (act[0] || act[1]) { f32x4 s[2][4]; const float cm_[2] = {en[0] ? 0.f : -1e30f, en[1] ? 0.f : -1e30f}; attn_qk2m(lds + ATK(SLOT), qr, fr, g4, cm_, s); \
                        const unsigned fullm_[2] = {0xffffffffu, 0xffffffffu}; \
                        attn_step2x_nomax(lds + ATV(SLOT), s, ss, 64 * j_, g4, lo2, trow, fullm_, j_ == cur, vlane, swz, onesf); } } while (0)
#pragma unroll
                for (int i = 0; i < 4; ++i) if (i < nt_) AT_DMA(1, i, i);
                __syncthreads();
#define SLC_LOOP(TILE) for (int j0 = 0; j0 < nt_; j0 += 4) { const int sb = (j0 & 4); \
                    const unsigned mwg[2] = {mskl[(fr >> 2) * 4 + (j0 >> 5)], mskl[(4 + (fr >> 2)) * 4 + (j0 >> 5)]};       \
                    _Pragma("unroll") for (int i = 0; i < 4; ++i) if (j0 + 4 + i < nt_) AT_DMA(1, j0 + 4 + i, (sb ^ 4) + i); \
                    TILE(j0, sb); if (j0 + 1 < nt_) TILE(j0 + 1, sb + 1); if (j0 + 2 < nt_) TILE(j0 + 2, sb + 2); if (j0 + 3 < nt_) TILE(j0 + 3, sb + 3); \
                    __syncthreads(); }
                if (nomax_slc) { SLC_LOOP(SLC_TILE_NM) } else { SLC_LOOP(SLC_TILE) }
#undef SLC_LOOP
#undef SLC_TILE_NM
#undef SLC_PRE
#undef SLC_TILE
                TROW_PIN();
#pragma unroll
                for (int rb = 0; rb < 2; ++rb) { const float l = __shfl(ss[rb].ol[0], fr); const float sc1 = (l > 0.f) ? GATE(rb, 1) / l : 0.f;
                    bf16_t* op = O + TOKROW(rb) * 1024 + head * 64 + 4 * g4;
#pragma unroll
                    for (int dt = 0; dt < 4; ++dt) { const u32x2 pv = *(const u32x2*)(op + 16 * dt); f32x4 v = ss[rb].o[dt] * sc1;
                        v[0] += __uint_as_float(pv.x << 16); v[1] += __uint_as_float(pv.x & 0xffff0000u); v[2] += __uint_as_float(pv.y << 16); v[3] += __uint_as_float(pv.y & 0xffff0000u);
                        u32x2 w; w.x = cvt_pk_bf16(v[0], v[1]); w.y = cvt_pk_bf16(v[2], v[3]); *(u32x2*)(op + 16 * dt) = w; } }
            }
            {
                AttnRow sw[2];
#pragma unroll
                for (int rb = 0; rb < 2; ++rb) { sw[rb].m = 0.f; sw[rb].ol = (f32x4){0.f, 0.f, 0.f, 0.f};
#pragma unroll
                    for (int dt = 0; dt < 4; ++dt) sw[rb].o[dt] = (f32x4){0.f, 0.f, 0.f, 0.f}; }
                const int jt0 = (t0 >= 511) ? ((t0 - 511) >> 6) : 0;
                const int nt_ = cur - jt0 + 1;
                const unsigned full[2] = {0xffffffffu, 0xffffffffu}; const bool both[2] = {true, true};
                bool refmoved = false;
#define WIN_PRE(JJ) const int j = jt0 + (JJ); f32x4 s[2][4]; const bool edge = (j == cur) || (64 * j < t0 + 63 - 511); const int lo2[2] = {trow[0] - 511, trow[1] - 511};
#define WIN_TILE(JJ, SLOT) do { WIN_PRE(JJ) \
                    if (refmoved) { const float cin[2] = {-sw[0].m, -sw[1].m}; attn_qk2(lds + AT4_KB + (SLOT) * 8192, qr, fr, g4, cin, s); } \
                    else attn_qk2z(lds + AT4_KB + (SLOT) * 8192, qr, fr, g4, s); \
                    refmoved |= attn_step2x(lds + AT4_VB + (SLOT) * 8192, s, sw, 64 * j, g4, lo2, trow, both, full, edge, vlane, swz, onesf); } while (0)
#define WIN_TILE_NM(JJ, SLOT) do { WIN_PRE(JJ) attn_qk2z(lds + AT4_KB + (SLOT) * 8192, qr, fr, g4, s); \
                    attn_step2x_nomax(lds + AT4_VB + (SLOT) * 8192, s, sw, 64 * j, g4, lo2, trow, full, edge, vlane, swz, onesf); } while (0)
                AT_DMA(2, jt0, 0); if (nt_ > 1) AT_DMA(2, jt0 + 1, 1); __syncthreads();
#define WIN_LOOP(TILE) for (int j0 = 0; j0 < nt_; j0 += 2) { const int sb = (j0 & 2); \
                    if (j0 + 2 < nt_) AT_DMA(2, jt0 + j0 + 2, sb ^ 2); \
                    if (j0 + 3 < nt_) AT_DMA(2, jt0 + j0 + 3, (sb ^ 2) + 1); \
                    TILE(j0, sb); if (j0 + 1 < nt_) TILE(j0 + 1, sb + 1); \
                    __syncthreads(); }
                if (nomax_win) { WIN_LOOP(WIN_TILE_NM) } else { WIN_LOOP(WIN_TILE) }
#undef WIN_LOOP
#undef WIN_TILE_NM
#undef WIN_PRE
#undef WIN_TILE
                TROW_PIN();
#pragma unroll
                for (int rb = 0; rb < 2; ++rb) { const float l = __shfl(sw[rb].ol[0], fr); const float sc2 = (l > 0.f) ? GATE(rb, 2) / l : 0.f;
                    bf16_t* op = O + TOKROW(rb) * 1024 + head * 64 + 4 * g4;
                    unsigned char* o8 = (unsigned char*)(a.ws + WS_O8) + TOKROW(rb) * 1024 + head * 64 + 4 * g4;
#pragma unroll
                    for (int dt = 0; dt < 4; ++dt) { const u32x2 pv = *(const u32x2*)(op + 16 * dt); f32x4 v = sw[rb].o[dt] * sc2;
                        v[0] += __uint_as_float(pv.x << 16); v[1] += __uint_as_float(pv.x & 0xffff0000u); v[2] += __uint_as_float(pv.y << 16); v[3] += __uint_as_float(pv.y & 0xffff0000u);
                        *(unsigned*)(o8 + 16 * dt) = pk4_fp8(clamp8(v[0] * X8_SCALE), clamp8(v[1] * X8_SCALE), clamp8(v[2] * X8_SCALE), clamp8(v[3] * X8_SCALE)); } }
            }
#undef AT_DMA
#undef ATK
#undef ATV
#undef TROW_PIN
#undef TOKROW
#undef GATE
            {
                const int npr = half ? pr + (int)gridDim.x : pr, nhalf = half ^ 1;
                cmp_pref = npr < 1024;
                if (cmp_pref) { const int nbg = npr >> 6, ncc = nhalf ? (127 - (npr & 63)) : (npr & 63);
                    const int nnct = (((ncc * 64 + 63 - 31) / 16 + 1) + 63) >> 6;
                    const bf16_t* nk = KC + (size_t)nbg * 512 * 64;
                    __builtin_amdgcn_global_load_lds((const unsigned*)(nk + ksrc), (LAS unsigned*)(lds + AT4_KB + wave * 1024), 16, 0, 0);
                    __builtin_amdgcn_global_load_lds((const unsigned*)(nk + (size_t)8192 * 64 + vsrc), (LAS unsigned*)(lds + AT4_VB + wave * 1024), 16, 0, 0);
                    if (nnct > 1) {
                        __builtin_amdgcn_global_load_lds((const unsigned*)(nk + 4096 + ksrc), (LAS unsigned*)(lds + AT4_KB + 8192 + wave * 1024), 16, 0, 0);
                        __builtin_amdgcn_global_load_lds((const unsigned*)(nk + (size_t)8192 * 64 + 4096 + vsrc), (LAS unsigned*)(lds + AT4_VB + 8192 + wave * 1024), 16, 0, 0); } } }
            cvt1_run(a, cvt_next, cvt_stride, 2, cvt_scr, lane);
        }
    }
    cvt1_run(a, cvt_next, cvt_stride, 1 << 20, cvt_scr, lane);
}

__device__ __forceinline__ void unpack8(const u32x4 w, float (&f)[8]) {
    f[0] = __uint_as_float(w.x << 16); f[1] = __uint_as_float(w.x & 0xffff0000u); f[2] = __uint_as_float(w.y << 16); f[3] = __uint_as_float(w.y & 0xffff0000u);
    f[4] = __uint_as_float(w.z << 16); f[5] = __uint_as_float(w.z & 0xffff0000u); f[6] = __uint_as_float(w.w << 16); f[7] = __uint_as_float(w.w & 0xffff0000u);
}
__device__ __forceinline__ void ph_convpool_fast(const Args& a, LAS unsigned char* lds) {
    const bf16_t* H0 = (const bf16_t*)(a.ws + WS_H0);
    bf16_t* CAT = (bf16_t*)(a.ws + WS_CAT);
    const float* cw = a.in[4]; const float* cb = a.in[5]; const float* lg = a.in[6]; const float* lb = a.in[7];
    const int tid = threadIdx.x, lane = tid & 63, wave = tid >> 6, ch = lane * 8;
    constexpr int VT_OFF = 0, UT_OFF = 62 * 1024, CW_OFF = UT_OFF + 47 * 1024;
    for (int i = tid; i < 31 * 64; i += 512) { const int k = i >> 6, c8 = (i & 63) * 8;
        const f32x4 w0 = *(const f32x4*)(cw + k * 512 + c8), w1 = *(const f32x4*)(cw + k * 512 + c8 + 4);
        u32x4 o; o.x = pk2(w0[0], w0[1]); o.y = pk2(w0[2], w0[3]); o.z = pk2(w1[0], w1[1]); o.w = pk2(w1[2], w1[3]);
        *(LAS u32x4*)(lds + CW_OFF + k * 1024 + c8 * 2) = o; }
    float bias[8], gam[8], bet[8];
#pragma unroll
    for (int j = 0; j < 8; ++j) { bias[j] = cb[ch + j]; gam[j] = lg[ch + j]; bet[j] = lb[ch + j]; }
    for (int tile = blockIdx.x; tile < M / 32; tile += gridDim.x) {
        const int tok0 = tile * 32, t0 = tok0 & (T - 1);
        __syncthreads();
        for (int i = tid; i < 62 * 64; i += 512) { const int r = i >> 6, c8 = (i & 63) * 8; const int tt = t0 - 30 + r;
            u32x4 v = (u32x4){0u, 0u, 0u, 0u}; if (tt >= 0) v = *(const u32x4*)(H0 + (size_t)(tok0 - 30 + r) * 1024 + 512 + c8);
            *(LAS u32x4*)(lds + VT_OFF + r * 1024 + c8 * 2) = v; }
        for (int i = tid; i < 47 * 64; i += 512) { const int r = i >> 6, c8 = (i & 63) * 8; const int tt = t0 - 15 + r;
            u32x4 v = (u32x4){0u, 0u, 0u, 0u}; if (tt >= 0) v = *(const u32x4*)(H0 + (size_t)(tok0 - 15 + r) * 1024 + c8);
            *(LAS u32x4*)(lds + UT_OFF + r * 1024 + c8 * 2) = v; }
        __syncthreads();
        float acc[4][8];
#pragma unroll
        for (int j = 0; j < 4; ++j)
#pragma unroll
            for (int c = 0; c < 8; ++c) acc[j][c] = bias[c];
#pragma unroll 1
        for (int k = 0; k < 31; ++k) {
            float w[8]; unpack8(*(const LAS u32x4*)(lds + CW_OFF + k * 1024 + ch * 2), w);
#pragma unroll
            for (int j = 0; j < 4; ++j) { float v[8]; unpack8(*(const LAS u32x4*)(lds + VT_OFF + (4 * wave + j + k) * 1024 + ch * 2), v);
#pragma unroll
                for (int c = 0; c < 8; ++c) acc[j][c] += w[c] * v[c]; }
        }
        const int wnd = 2 << (lane >> 4);
#pragma unroll
        for (int j = 0; j < 4; ++j) {
            const int tl = 4 * wave + j, t = t0 + tl; const size_t tok = (size_t)tok0 + tl;
            const int cnt = (t + 1 < wnd) ? (t + 1) : wnd;
            float s[8], self[8];
            unpack8(*(const LAS u32x4*)(lds + UT_OFF + (15 + tl) * 1024 + ch * 2), self);
#pragma unroll
            for (int c = 0; c < 8; ++c) s[c] = self[c];
            for (int k = 1; k < cnt; ++k) { float v[8]; unpack8(*(const LAS u32x4*)(lds + UT_OFF + (15 + tl - k) * 1024 + ch * 2), v);
#pragma unroll
                for (int c = 0; c < 8; ++c) s[c] += v[c]; }
            const float inv = 1.0f / (float)cnt;
            u32x4 o; o.x = pk2(s[0] * inv - self[0], s[1] * inv - self[1]); o.y = pk2(s[2] * inv - self[2], s[3] * inv - self[3]);
            o.z = pk2(s[4] * inv - self[4], s[5] * inv - self[5]); o.w = pk2(s[6] * inv - self[6], s[7] * inv - self[7]);
            *(u32x4*)(CAT + tok * 1024 + ch) = o;
            float sm = 0.f;
#pragma unroll
            for (int c = 0; c < 8; ++c) sm += acc[j][c];
            const float mean = wave_sum(sm) * (1.0f / 512.0f);
            float sq = 0.f;
#pragma unroll
            for (int c = 0; c < 8; ++c) { acc[j][c] -= mean; sq += acc[j][c] * acc[j][c]; }
            const float rstd = rsqrtf(wave_sum(sq) * (1.0f / 512.0f) + LN_EPS);
            float y[8];
#pragma unroll
            for (int c = 0; c < 8; ++c) { const float z = acc[j][c] * rstd * gam[c] + bet[c]; y[c] = z * sigmoidf_(z); }
            u32x4 o2; o2.x = pk2(y[0], y[1]); o2.y = pk2(y[2], y[3]); o2.z = pk2(y[4], y[5]); o2.w = pk2(y[6], y[7]);
            *(u32x4*)(CAT + tok * 1024 + 512 + ch) = o2;
        }
    }
}


__device__ __forceinline__ void ph_route_fast(const float* LOG, const float* bias, unsigned* gcnt, int2* list, unsigned char* ldsg) {
    unsigned* hist = (unsigned*)ldsg; unsigned* base = hist + 256; u32x2* sel = (u32x2*)(ldsg + 2048);
    const int tid = threadIdx.x, lane = tid & 63, wave = tid >> 6;
    const float NEG = -INFINITY;
    const float4 bb = *(const float4*)(bias + lane * 4);
    for (int chunk = blockIdx.x; chunk < M / 128; chunk += gridDim.x) {
        __syncthreads();
        if (tid < 256) hist[tid] = 0u;
        __syncthreads();
        for (int i = 0; i < 16; ++i) {
            const int tl = wave * 16 + i, tok = chunk * 128 + tl;
            const float4 lg = *(const float4*)(LOG + (size_t)tok * 256 + lane * 4);
            const float s0 = sigmoidf_(lg.x), s1 = sigmoidf_(lg.y), s2 = sigmoidf_(lg.z), s3 = sigmoidf_(lg.w);
            float v0 = s0 + bb.x, v1 = s1 + bb.y, v2 = s2 + bb.z, v3 = s3 + bb.w;
            float m1 = fmaxf(v0, v1), m2 = fminf(v0, v1);
            { const float hi = fmaxf(v2, v3), lo = fminf(v2, v3); const float n1 = fmaxf(m1, hi); const float n2 = fmaxf(fminf(m1, hi), fmaxf(m2, lo)); m1 = n1; m2 = n2; }
#pragma unroll
            for (int o = 1; o < 8; o <<= 1) { const float a1 = __shfl_xor(m1, o), a2 = __shfl_xor(m2, o); const float n1 = fmaxf(m1, a1), n2 = fmaxf(fminf(m1, a1), fmaxf(m2, a2)); m1 = n1; m2 = n2; }
            const float gs = m1 + m2; const int mygrp = lane >> 3;
            int rank = 0;
#pragma unroll
            for (int g2 = 0; g2 < 8; ++g2) { const float og = __shfl(gs, g2 * 8); rank += (og > gs || (og == gs && g2 < mygrp)) ? 1 : 0; }
            if (rank >= 4) { v0 = NEG; v1 = NEG; v2 = NEG; v3 = NEG; }
            int my_e = 0; float my_s = 0.f;
#pragma unroll
            for (int it = 0; it < 8; ++it) {
                float bv = v0; int bj = 0;
                if (v1 > bv) { bv = v1; bj = 1; }
                if (v2 > bv) { bv = v2; bj = 2; }
                if (v3 > bv) { bv = v3; bj = 3; }
                int bi = lane * 4 + bj;
#pragma unroll
                for (int o = 1; o < 64; o <<= 1) { const float ov = __shfl_xor(bv, o); const int oi = __shfl_xor(bi, o); if (ov > bv || (ov == bv && oi < bi)) { bv = ov; bi = oi; } }
                const int jj = bi & 3, ol = bi >> 2;
                const float mys = (jj == 0) ? s0 : (jj == 1) ? s1 : (jj == 2) ? s2 : s3;
                const float wsc = __shfl(mys, ol);
                if (lane == ol) { if (jj == 0) v0 = NEG; else if (jj == 1) v1 = NEG; else if (jj == 2) v2 = NEG; else v3 = NEG; }
                if (lane == it) { my_e = bi; my_s = wsc; }
            }
            const float ssum = wave_sum(lane < 8 ? my_s : 0.f);
            if (lane < 8) { const unsigned rk = atomicAdd(&hist[my_e], 1u); u32x2 en; en.x = (unsigned)my_e | (rk << 16); en.y = __float_as_uint(my_s / ssum * 2.5f); sel[tl * 8 + lane] = en; }
        }
        __syncthreads();
        if (tid < 256) { const unsigned h = hist[tid]; base[tid] = h ? atomicAdd(&gcnt[tid], h) : 0u; }
        __syncthreads();
#pragma unroll
        for (int rep = 0; rep < 2; ++rep) { const int idx = tid + rep * 512, tok = chunk * 128 + (idx >> 3), k = idx & 7;
            const u32x2 en = sel[idx]; const unsigned e = en.x & 0xffffu, pos = base[e] + (en.x >> 16);
            list[(size_t)e * LISTCAP + pos] = make_int2(tok * 10 + k, (int)en.y); }
    }
}

__global__ void __launch_bounds__(512, 2) fwd_kernel(Args a) {
    extern __shared__ __attribute__((aligned(16))) unsigned char lds[];
    volatile LAS unsigned* MISC = (volatile LAS unsigned*)((LAS unsigned char*)lds + (LDS_BYTES - 64));
    if (threadIdx.x < 16) MISC[threadIdx.x] = 0u;
    __syncthreads();
    unsigned* ctl = (unsigned*)(a.ws + WS_CTL);
#if MK_ONE_LAUNCH
    (void)xcd_barrier_post(ctl + CW_BAR, MISC + 8);
#define SEAM() do { XcdBarrier b_; b_.bar = (unsigned*)(a.ws + WS_CTL) + CW_BAR; b_.x = xb_xcc_id(); b_.st = MISC + 8; xcd_barrier(b_); } while (0)
#else
#define SEAM() do {} while (0)
#endif
    const int lo = a.ph_lo, hi = a.ph_hi;
#define IN(k) (lo <= (k) && (k) < hi)
#define BOTH(k) (IN(k) && (k) + 1 < hi)
#define X1 ((bf16_t*)(a.ws + WS_X1))
#define X2 ((bf16_t*)(a.ws + WS_X2))
#define LOG ((float*)(a.ws + WS_LOG))

    LAS unsigned char* L = (LAS unsigned char*)lds;
#define LIST ((int2*)(a.ws + WS_LIST))
#ifndef PROBE_DUP_MASK
#define PROBE_DUP_MASK 0u
#endif
#define RUN(k, ...) if (IN(k)) { { __VA_ARGS__ } if ((PROBE_DUP_MASK >> (k)) & 1u) { __syncthreads(); { __VA_ARGS__ } } if (BOTH(k)) SEAM(); }
    RUN(0, ph_prologue(a, L);)
    RUN(1, pg8::DenseSched S; S.init((const bf16_t*)(a.ws + WS_XA), D, (const bf16_t*)(a.ws + WS_WIN0), D, M, 1536);
           EpiInproj0 E{(bf16_t*)(a.ws + WS_H0)};
           pg8::gemm_phase<EpiInproj0, pg8::DenseSched, true>(L, D, 128u, S, E);)
    RUN(2, ph_convpool_fast(a, L);)
    RUN(4, pg8::DenseSched S; S.init((const bf16_t*)(a.ws + WS_CAT), D, (const bf16_t*)(a.ws + WS_WOUT0), D, M, D);
           EpiRes E{a.in[0], nullptr, (bf16_t*)(a.ws + WS_Y), 1.0f};
           pg8::gemm_phase<EpiRes, pg8::DenseSched, true>(L, D, 128u, S, E);)
    RUN(5, ph_ln((const bf16_t*)(a.ws + WS_Y), a.in[17], a.in[18], X1, (unsigned char*)(a.ws + WS_X8));)
#define MOE_LAYER(P, LAYER, XIN, XOUT, OUTF) \
    RUN(P, pg8::DenseSched S; S.init(XIN, D, (const bf16_t*)(a.ws + WS_WR) + (size_t)(LAYER) * NE * D, D, M, NE); \
           EpiLogits E{LOG}; pg8::gemm_phase<EpiLogits, pg8::DenseSched, true>(L, D, 128u, S, E);) \
    if (IN(P + 1)) { ph_route_fast(LOG, a.in[22] + (LAYER) * NE, ctl + CW_CNT + (LAYER) * 256, LIST, lds); if (BOTH(P + 1)) SEAM(); } \
    RUN(P + 2, const int R = moe_setup256(ctl + CW_CNT + (LAYER) * 256, L); \
            MoeGuSched S{(const char*)(a.ws + WS_X8), (const char*)(a.ws + WS_WGU) + (size_t)(LAYER) * 257 * 512 * 1024, LIST, L, R, (R + 128) * 2, (int)gridDim.x, (int)blockIdx.x}; \
            S.prepare(); EpiGateUp E{(unsigned char*)(a.ws + WS_HID)}; pg8::gemm_phase<EpiGateUp, MoeGuSched, true, true>(L, D / 2, 128u, S, E);) \
    RUN(P + 3, const int R = moe_setup256(ctl + CW_CNT + (LAYER) * 256, L); \
            MoeDownSched S{(const char*)(a.ws + WS_HID), (const char*)(a.ws + WS_WD) + (size_t)(LAYER) * 257 * 1024 * 256, LIST, L, R, R + 128, (int)gridDim.x, (int)blockIdx.x}; \
            S.prepare(); EpiDown E{(unsigned char*)(a.ws + WS_YB), L}; pg8::gemm_phase<EpiDown, MoeDownSched, true, true>(L, FF / 2, 128u, S, E);) \
    RUN(P + 4, ph_combine(a, XIN, a.in[19] + (LAYER) * D, a.in[20] + (LAYER) * D, XOUT, OUTF);)
    MOE_LAYER(6, 0, X1, X2, nullptr)
    RUN(11, pg8::DenseSched S; S.init(X2, D, (const bf16_t*)(a.ws + WS_WINN), D, M, HNW);
            EpiInprojN E{(bf16_t*)(a.ws + WS_HN), (bf16_t*)(a.ws + WS_QR), (bf16_t*)(a.ws + WS_KV6), (float*)(a.ws + WS_GATES), (const float*)(a.ws + WS_MISC) + 1024};
            pg8::gemm_phase<EpiInprojN, pg8::DenseSched, true>(L, D, 128u, S, E);)
    RUN(13, Cmp1Sched S{(const char*)(a.ws + WS_KV6), (const char*)(a.ws + WS_CW1), (int)gridDim.x, (int)blockIdx.x};
            EpiCmp1 E{(bf16_t*)(a.ws + WS_CH1), (const float*)(a.ws + WS_MISC)};
            pg8::gemm_phase<EpiCmp1, Cmp1Sched, true>(L, 2048, 128u, S, E); ph_knorm(a);)
    RUN(14, ph_cmp2(a, lds);)
    RUN(15, ph_attn_fast2(a, L);)
    RUN(16, pg8::DenseSched S; S.init((const bf16_t*)(a.ws + WS_O8), D / 2, (const bf16_t*)(a.ws + WS_WOUTN), D / 2, M, D);
            EpiRes E{nullptr, X2, (bf16_t*)(a.ws + WS_Y2), 1.0f / (X8_SCALE * W8_SCALE)};
            pg8::gemm_phase<EpiRes, pg8::DenseSched, true, true>(L, D / 2, 128u, S, E);)
    RUN(17, ph_ln((const bf16_t*)(a.ws + WS_Y2), a.in[17] + D, a.in[18] + D, X1, (unsigned char*)(a.ws + WS_X8));)
    MOE_LAYER(18, 1, X1, (bf16_t*)nullptr, a.out)
}

extern "C" void kernel_launch(void* const* d_in, const int* in_sizes, int n_in, void* d_out, int out_size, void* d_ws, size_t ws_size, hipStream_t stream) {
    static int grid = 0;
    if (grid == 0) {
        if (n_in != 29 || out_size != M * D || ws_size < WS_END) { fprintf(stderr, "kernel_launch: unexpected problem (n_in %d out %d ws %zu)\n", n_in, out_size, ws_size); grid = -1; return; }
        int dev = 0, cus = 0;
        if (hipGetDevice(&dev) != hipSuccess || hipDeviceGetAttribute(&cus, hipDeviceAttributeMultiprocessorCount, dev) != hipSuccess) { grid = -1; return; }
        if (hipFuncSetAttribute((const void*)fwd_kernel, hipFuncAttributeMaxDynamicSharedMemorySize, LDS_BYTES) != hipSuccess) { grid = -1; return; }
        int per_cu = 0;
        (void)hipOccupancyMaxActiveBlocksPerMultiprocessor(&per_cu, (const void*)fwd_kernel, 512, LDS_BYTES);
        (void)hipGetLastError();
        grid = cus;
    }
    if (grid < 0) return;
    (void)hipMemsetAsync((char*)d_ws + WS_CTL, 0, CTL_BYTES, stream);
    Args a{};
    for (int i = 0; i < 29; ++i) a.in[i] = (const float*)d_in[i];
    a.out = (float*)d_out; a.ws = (unsigned char*)d_ws;
    for (int i = 0; i < 8; ++i) a.inv_freq[i] = powf(500000.0f, -(float)(2 * i) / 16.0f);
#if MK_ONE_LAUNCH
    a.ph_lo = 0; a.ph_hi = NPHASE;
    hipLaunchKernelGGL(fwd_kernel, dim3(grid), dim3(512), LDS_BYTES, stream, a);
#else
    for (int p = 0; p < NPHASE; ++p) { a.ph_lo = p; a.ph_hi = p + 1; hipLaunchKernelGGL(fwd_kernel, dim3(grid), dim3(512), LDS_BYTES, stream, a); }
#endif
}
```

```cpp
#include <hip/hip_runtime.h>
#include <cstdint>
#include <cstdio>
#include <cmath>

#ifndef MK_ONE_LAUNCH
#define MK_ONE_LAUNCH 1
#endif

#define LAS __attribute__((address_space(3)))
typedef unsigned short bf16_t;
typedef short bf16x8 __attribute__((ext_vector_type(8)));
typedef float f32x4 __attribute__((ext_vector_type(4)));
typedef unsigned u32x2 __attribute__((ext_vector_type(2)));
typedef unsigned u32x4 __attribute__((ext_vector_type(4)));

constexpr int NB = 4, T = 8192, D = 1024, M = NB * T;
constexpr int NE = 256, TOPK = 8, FF = 256;
constexpr int HNW = 2816;
constexpr int LISTCAP = 32768;
constexpr float ALPHA = 1.4142135623730951f;
constexpr float LN_EPS = 1e-5f;
constexpr float QSCALE = 0.125f * 1.4426950408889634f;
constexpr int YB_NSLOT = 9;
constexpr float YB_SCALE = 16.0f;
constexpr int NPHASE = 23;

constexpr size_t MiB = 1u << 20;
constexpr size_t WS_CTL = 0, CTL_BYTES = 1 * MiB;
constexpr size_t WS_X1 = 1 * MiB;
constexpr size_t WS_X2 = WS_X1 + 64 * MiB;
constexpr size_t WS_LOG = WS_X2 + 64 * MiB;
constexpr size_t WS_LIST = WS_LOG + 32 * MiB;
constexpr size_t WS_WTS = WS_LIST + 64 * MiB;
constexpr size_t WS_HID = WS_WTS + 2 * MiB;
constexpr size_t WS_YB = WS_HID + 184 * MiB;
constexpr size_t WS_END_NAIVE = WS_YB + 576 * MiB;
constexpr size_t WS_WIN0 = WS_END_NAIVE;
constexpr size_t WS_WOUT0 = WS_WIN0 + 3 * MiB;
constexpr size_t WS_WINN = WS_WOUT0 + 2 * MiB;
constexpr size_t WS_WOUTN = WS_WINN + 6 * MiB;
constexpr size_t WS_WR = WS_WOUTN + 2 * MiB;
constexpr size_t WS_CW1 = WS_WR + 1 * MiB;
constexpr size_t WS_MISC = WS_CW1 + 2 * MiB;
constexpr size_t WS_WGU = WS_MISC + 1 * MiB;
constexpr size_t WS_X8 = WS_WGU + 257 * MiB;
constexpr size_t WS_O8 = WS_X8 + 32 * MiB;
constexpr float X8_SCALE = 8.0f, W8_SCALE = 64.0f, H8_SCALE = 16.0f;
constexpr size_t WS_WD = WS_WGU + 514 * MiB;
constexpr size_t WS_END = WS_WD + 257 * MiB;
constexpr size_t WS_XA = WS_X2;
constexpr size_t WS_H0 = WS_YB;
constexpr size_t WS_PM = WS_H0 + 64 * MiB;
constexpr size_t WS_CAT = WS_PM + 32 * MiB;
constexpr size_t WS_Y = WS_CAT + 64 * MiB;
constexpr size_t WS_HN = WS_YB;
constexpr size_t WS_KV6 = WS_HN + 64 * MiB;
constexpr size_t WS_QR = WS_HN + 176 * MiB;
constexpr size_t WS_GATES = WS_QR + 64 * MiB;
constexpr size_t WS_CH1 = WS_GATES + 8 * MiB;
constexpr size_t WS_KC = WS_CH1 + 4 * MiB;
constexpr size_t WS_O = WS_KC + 2 * MiB;
constexpr size_t WS_Y2 = WS_O + 64 * MiB;
static_assert(WS_Y2 + 64 * MiB <= WS_END_NAIVE, "overlay");
static_assert(WS_Y + 64 * MiB <= WS_END_NAIVE, "overlay");

constexpr int CW_CNT = 64;
constexpr int CW_BAR = 4096;

constexpr int LDS_BYTES = 163840;

__device__ __forceinline__ float bf2f(bf16_t h) { return __uint_as_float(((unsigned)h) << 16); }
__device__ __forceinline__ bf16_t f2bf(float f) { unsigned u = __float_as_uint(f); return (bf16_t)((u + 0x7fffu + ((u >> 16) & 1u)) >> 16); }
__device__ __forceinline__ unsigned pk2(float lo, float hi) { return (unsigned)f2bf(lo) | ((unsigned)f2bf(hi) << 16); }
#define WR_DPP(x, ctrl) __builtin_bit_cast(float, __builtin_amdgcn_update_dpp(__builtin_bit_cast(int, (float)(x)), __builtin_bit_cast(int, (float)(x)), (ctrl), 0xF, 0xF, true))
#define WR_ROW(x, r) __builtin_bit_cast(float, __builtin_amdgcn_readlane(__builtin_bit_cast(int, (float)(x)), 16 * (r)))
__device__ __forceinline__ float wave_sum(float v) {
    v += WR_DPP(v, 0xB1); v += WR_DPP(v, 0x4E); v += WR_DPP(v, 0x141); v += WR_DPP(v, 0x140);
    return (WR_ROW(v, 0) + WR_ROW(v, 1)) + (WR_ROW(v, 2) + WR_ROW(v, 3));
}
__device__ __forceinline__ float wave_max(float v) {
    v = fmaxf(v, WR_DPP(v, 0xB1)); v = fmaxf(v, WR_DPP(v, 0x4E)); v = fmaxf(v, WR_DPP(v, 0x141)); v = fmaxf(v, WR_DPP(v, 0x140));
    return fmaxf(fmaxf(WR_ROW(v, 0), WR_ROW(v, 1)), fmaxf(WR_ROW(v, 2), WR_ROW(v, 3)));
}
__device__ __forceinline__ float sigmoidf_(float x) { return 1.0f / (1.0f + __expf(-x)); }
__device__ __forceinline__ float gelu_tanh(float x) {
    const float u = 0.7978845608028654f * (x + 0.044715f * x * x * x);
    const float e = __expf(2.0f * u);
    const float th = 1.0f - 2.0f / (e + 1.0f);
    return 0.5f * x * (1.0f + th);
}
__device__ __forceinline__ bf16x8 cvt8(const float* p) {
    const float4 a = *(const float4*)p, b = *(const float4*)(p + 4);
    bf16x8 r;
    r[0] = (short)f2bf(a.x); r[1] = (short)f2bf(a.y); r[2] = (short)f2bf(a.z); r[3] = (short)f2bf(a.w);
    r[4] = (short)f2bf(b.x); r[5] = (short)f2bf(b.y); r[6] = (short)f2bf(b.z); r[7] = (short)f2bf(b.w);
    return r;
}
__device__ __forceinline__ bf16x8 colk8(const float* W, int N, int k, int col) {
    bf16x8 r;
#pragma unroll
    for (int j = 0; j < 8; ++j) r[j] = (short)f2bf(W[(size_t)(k + j) * N + col]);
    return r;
}
__device__ __forceinline__ bf16x8 zero8() { return (bf16x8){0, 0, 0, 0, 0, 0, 0, 0}; }
#define WSYNC() asm volatile("s_waitcnt lgkmcnt(0)" ::: "memory")

#define XB_TMO      128
#define XB_XCNT(j)  (256  + 64 * (j))
#define XB_XSUB(j)  (1280 + 64 * (j))
#define XB_XGEN(j)  (2304 + 64 * (j))
#define XB_TOP      3328
#define XB_TOPGEN   3392
#define XCD_BAR_WORDS 3456
#define XB_SPIN_CAP (1u << 22)
__device__ __forceinline__ unsigned xb_ld(unsigned* p)              { return __hip_atomic_load(p, __ATOMIC_RELAXED, __HIP_MEMORY_SCOPE_AGENT); }
__device__ __forceinline__ unsigned xb_add(unsigned* p, unsigned v) { return __hip_atomic_fetch_add(p, v, __ATOMIC_RELAXED, __HIP_MEMORY_SCOPE_AGENT); }
__device__ __forceinline__ unsigned xb_xcc_id() { return (unsigned)__builtin_amdgcn_s_getreg((3 << 11) | 20) & 0xFu; }
#define XB_SPIN(cond, bar) do { unsigned _sp = 0; while (cond) { __builtin_amdgcn_s_sleep(1); \
    if ((++_sp & 255u) == 0u) { if (xb_ld(&(bar)[XB_TMO])) break; if (_sp > XB_SPIN_CAP) { atomicAdd(&(bar)[XB_TMO], 1u); break; } } } } while (0)
struct XcdBarrier { unsigned* bar; unsigned x; volatile LAS unsigned* st; };
__device__ __forceinline__ XcdBarrier xcd_barrier_post(unsigned* bar, volatile LAS unsigned* st) {
    XcdBarrier b; b.bar = bar; b.x = xb_xcc_id(); b.st = st;
    if (threadIdx.x == 0) (void)xb_add(&bar[XB_XCNT(b.x)], 1u);
    return b;
}
__device__ __forceinline__ void xcd_barrier_complete(unsigned* bar, unsigned x, unsigned& nloc, unsigned& nx) {
    const unsigned G = gridDim.x * gridDim.y * gridDim.z;
    unsigned sum, cnt, mine, sp = 0u;
    for (;;) {
        sum = 0u; cnt = 0u; mine = 0u;
#pragma unroll
        for (unsigned j = 0; j < 16; ++j) { const unsigned c = xb_ld(&bar[XB_XCNT(j)]); sum += c; cnt += (c > 0u) ? 1u : 0u; mine = (j == x) ? c : mine; }
        if (sum == G) break;
        __builtin_amdgcn_s_sleep(1);
        if ((++sp & 255u) == 0u) { if (xb_ld(&bar[XB_TMO])) break; if (sp > XB_SPIN_CAP) { atomicAdd(&bar[XB_TMO], 1u); break; } }
    }
    nloc = mine > 0u ? mine : 1u; nx = cnt > 0u ? cnt : 1u;
}
__device__ __forceinline__ void xcd_barrier(const XcdBarrier& b) {
    asm volatile("s_waitcnt vmcnt(0)" ::: "memory");
    __syncthreads();
    if (threadIdx.x == 0) {
        unsigned* bar = b.bar;
        __builtin_amdgcn_s_waitcnt(0);
        unsigned nloc = b.st[0], nx = b.st[1];
        if (nloc == 0u) { xcd_barrier_complete(bar, b.x, nloc, nx); b.st[0] = nloc; b.st[1] = nx; }
        const unsigned old = xb_add(&bar[XB_XSUB(b.x)], 1u);
        const unsigned gen = old / nloc;
        if (old + 1u == (gen + 1u) * nloc) {
            __builtin_amdgcn_fence(__ATOMIC_RELEASE, "agent");
            asm volatile("s_waitcnt vmcnt(0)" ::: "memory");
            const unsigned og = xb_add(&bar[XB_TOP], 1u);
            const unsigned tg = og / nx;
            if (og + 1u == (tg + 1u) * nx) xb_add(&bar[XB_TOPGEN], 1u);
            else XB_SPIN(xb_ld(&bar[XB_TOPGEN]) == tg, bar);
            __builtin_amdgcn_fence(__ATOMIC_ACQUIRE, "agent");
            xb_add(&bar[XB_XGEN(b.x)], 1u);
            asm volatile("s_waitcnt vmcnt(0)" ::: "memory");
        } else {
            XB_SPIN(xb_ld(&bar[XB_XGEN(b.x)]) == gen, bar);
            __builtin_amdgcn_fence(__ATOMIC_ACQUIRE, "agent");
            asm volatile("s_waitcnt vmcnt(0)" ::: "memory");
        }
    }
    __syncthreads();
}

template <class AL, class BL, class EP>
__device__ __forceinline__ void mgemm_tile(unsigned char* lds, int K, const AL& al, const BL& bl, const EP& ep) {
    bf16_t* As = (bf16_t*)lds;
    bf16_t* Bs = As + 128 * 40;
    const int tid = threadIdx.x, lane = tid & 63, wave = tid >> 6;
    const int ar = tid >> 2, ac = (tid & 3) * 8;
    const int bn = tid & 127, bc = (tid >> 7) * 8;
    f32x4 acc[8];
#pragma unroll
    for (int s = 0; s < 8; ++s) acc[s] = (f32x4){0.f, 0.f, 0.f, 0.f};
    bf16x8 ra = al(ac), rb = bl(bc);
    for (int k0 = 0; k0 < K; k0 += 32) {
        __syncthreads();
        *(bf16x8*)(As + ar * 40 + ac) = ra;
        *(bf16x8*)(Bs + bn * 40 + bc) = rb;
        __syncthreads();
        if (k0 + 32 < K) { ra = al(k0 + 32 + ac); rb = bl(k0 + 32 + bc); }
        const bf16x8 af = *(const bf16x8*)(As + (wave * 16 + (lane & 15)) * 40 + (lane >> 4) * 8);
#pragma unroll
        for (int s = 0; s < 8; ++s) {
            const bf16x8 wf = *(const bf16x8*)(Bs + (16 * s + (lane & 15)) * 40 + (lane >> 4) * 8);
            acc[s] = __builtin_amdgcn_mfma_f32_16x16x32_bf16(wf, af, acc[s], 0, 0, 0);
        }
    }
    ep(wave * 16 + (lane & 15), (lane >> 4) * 4, acc);
}
__device__ __forceinline__ void store4bf(bf16_t* p, const f32x4 v) { u32x2 w; w.x = pk2(v[0], v[1]); w.y = pk2(v[2], v[3]); *(u32x2*)p = w; }

struct Args {
    const float* in[29];
    float* out;
    unsigned char* ws;
    float inv_freq[8];
    int ph_lo, ph_hi;
};

__device__ __forceinline__ unsigned pk4_fp8(float a, float b, float c, float d) { int w = __builtin_amdgcn_cvt_pk_fp8_f32(a, b, 0, false); return (unsigned)__builtin_amdgcn_cvt_pk_fp8_f32(c, d, w, true); }
__device__ __forceinline__ u32x2 pack8_fp8(const f32x4 v0, const f32x4 v1) {
    int a = __builtin_amdgcn_cvt_pk_fp8_f32(v0[0], v0[1], 0, false); a = __builtin_amdgcn_cvt_pk_fp8_f32(v0[2], v0[3], a, true);
    int b = __builtin_amdgcn_cvt_pk_fp8_f32(v1[0], v1[1], 0, false); b = __builtin_amdgcn_cvt_pk_fp8_f32(v1[2], v1[3], b, true);
    u32x2 w; w.x = (unsigned)a; w.y = (unsigned)b; return w;
}
__device__ __forceinline__ float clamp8(float v) { return __builtin_amdgcn_fmed3f(v, -448.0f, 448.0f); }
__device__ __forceinline__ void ph_ln(const bf16_t* Y, const float* g, const float* b, bf16_t* X, unsigned char* X8) {
    const int lane = threadIdx.x & 63, wave = threadIdx.x >> 6;
    const int gw = blockIdx.x * 8 + wave, ngw = gridDim.x * 8;
    float gg[16], bb[16];
#pragma unroll
    for (int j = 0; j < 8; ++j) { gg[j] = g[lane * 8 + j]; gg[8 + j] = g[512 + lane * 8 + j]; bb[j] = b[lane * 8 + j]; bb[8 + j] = b[512 + lane * 8 + j]; }
    for (int row0 = gw * 4; row0 < M; row0 += ngw * 4) {
        bf16x8 p0[4], p1[4];
#pragma unroll
        for (int r = 0; r < 4; ++r) { p0[r] = __builtin_nontemporal_load((const bf16x8*)(Y + (size_t)(row0 + r) * 1024 + lane * 8)); p1[r] = __builtin_nontemporal_load((const bf16x8*)(Y + (size_t)(row0 + r) * 1024 + 512 + lane * 8)); }
#pragma unroll
        for (int r = 0; r < 4; ++r) {
            float v[16];
#pragma unroll
            for (int j = 0; j < 8; ++j) { v[j] = bf2f((bf16_t)p0[r][j]); v[8 + j] = bf2f((bf16_t)p1[r][j]); }
            float s = 0.f;
#pragma unroll
            for (int j = 0; j < 16; ++j) s += v[j];
            const float mean = wave_sum(s) * (1.0f / 1024.0f);
            float q = 0.f;
#pragma unroll
            for (int j = 0; j < 16; ++j) { v[j] -= mean; q += v[j] * v[j]; }
            const float rstd = rsqrtf(wave_sum(q) * (1.0f / 1024.0f) + LN_EPS);
            float o[16];
#pragma unroll
            for (int j = 0; j < 16; ++j) o[j] = v[j] * rstd * gg[j] + bb[j];
            u32x4 w0, w1;
            w0.x = pk2(o[0], o[1]); w0.y = pk2(o[2], o[3]); w0.z = pk2(o[4], o[5]); w0.w = pk2(o[6], o[7]);
            w1.x = pk2(o[8], o[9]); w1.y = pk2(o[10], o[11]); w1.z = pk2(o[12], o[13]); w1.w = pk2(o[14], o[15]);
            *(u32x4*)(X + (size_t)(row0 + r) * 1024 + lane * 8) = w0; *(u32x4*)(X + (size_t)(row0 + r) * 1024 + 512 + lane * 8) = w1;
#pragma unroll
            for (int j = 0; j < 16; ++j) o[j] = clamp8(o[j] * X8_SCALE);
            u32x2 q0, q1; q0.x = pk4_fp8(o[0], o[1], o[2], o[3]); q0.y = pk4_fp8(o[4], o[5], o[6], o[7]); q1.x = pk4_fp8(o[8], o[9], o[10], o[11]); q1.y = pk4_fp8(o[12], o[13], o[14], o[15]);
            *(u32x2*)(X8 + (size_t)(row0 + r) * 1024 + lane * 8) = q0; *(u32x2*)(X8 + (size_t)(row0 + r) * 1024 + 512 + lane * 8) = q1;
        }
    }
}

__device__ __forceinline__ void ph_combine(const Args& a, const bf16_t* X, const float* g, const float* b, bf16_t* Xo, float* outf) {
    const unsigned char* YB = (const unsigned char*)(a.ws + WS_YB);
    const int lane = threadIdx.x & 63, wave = threadIdx.x >> 6;
    const int gw = blockIdx.x * 8 + wave, ngw = gridDim.x * 8;
    for (int row = gw; row < M; row += ngw) {
        float v[16];
#pragma unroll
        for (int j = 0; j < 16; ++j) v[j] = 0.f;
        u32x2 q0[YB_NSLOT], q1[YB_NSLOT];
#pragma unroll
        for (int k = 0; k < YB_NSLOT; ++k) { const unsigned char* yr = YB + ((size_t)row * 10 + k) * 1024; q0[k] = __builtin_nontemporal_load((const u32x2*)(yr + lane * 8)); q1[k] = __builtin_nontemporal_load((const u32x2*)(yr + 512 + lane * 8)); }
#pragma unroll
        for (int k = 0; k < YB_NSLOT; ++k) {
            const auto a0 = __builtin_amdgcn_cvt_pk_f32_fp8((int)q0[k].x, false), a1 = __builtin_amdgcn_cvt_pk_f32_fp8((int)q0[k].x, true), a2 = __builtin_amdgcn_cvt_pk_f32_fp8((int)q0[k].y, false), a3 = __builtin_amdgcn_cvt_pk_f32_fp8((int)q0[k].y, true);
            const auto b0 = __builtin_amdgcn_cvt_pk_f32_fp8((int)q1[k].x, false), b1 = __builtin_amdgcn_cvt_pk_f32_fp8((int)q1[k].x, true), b2 = __builtin_amdgcn_cvt_pk_f32_fp8((int)q1[k].y, false), b3 = __builtin_amdgcn_cvt_pk_f32_fp8((int)q1[k].y, true);
            v[0] += a0[0]; v[1] += a0[1]; v[2] += a1[0]; v[3] += a1[1]; v[4] += a2[0]; v[5] += a2[1]; v[6] += a3[0]; v[7] += a3[1];
            v[8] += b0[0]; v[9] += b0[1]; v[10] += b1[0]; v[11] += b1[1]; v[12] += b2[0]; v[13] += b2[1]; v[14] += b3[0]; v[15] += b3[1];
        }
        {
            const bf16x8 p0 = *(const bf16x8*)(X + (size_t)row * 1024 + lane * 8), p1 = *(const bf16x8*)(X + (size_t)row * 1024 + 512 + lane * 8);
#pragma unroll
            for (int j = 0; j < 8; ++j) { v[j] = v[j] * (1.0f / YB_SCALE) + ALPHA * bf2f((bf16_t)p0[j]); v[8 + j] = v[8 + j] * (1.0f / YB_SCALE) + ALPHA * bf2f((bf16_t)p1[j]); }
        }
        float s = 0.f;
#pragma unroll
        for (int j = 0; j < 16; ++j) s += v[j];
        const float mean = wave_sum(s) * (1.0f / 1024.0f);
        float q = 0.f;
#pragma unroll
        for (int j = 0; j < 16; ++j) { v[j] -= mean; q += v[j] * v[j]; }
        const float rstd = rsqrtf(wave_sum(q) * (1.0f / 1024.0f) + LN_EPS);
        float o[16];
#pragma unroll
        for (int j = 0; j < 8; ++j) { o[j] = v[j] * rstd * g[lane * 8 + j] + b[lane * 8 + j]; o[8 + j] = v[8 + j] * rstd * g[512 + lane * 8 + j] + b[512 + lane * 8 + j]; }
        if (outf) {
            float* op = outf + (size_t)row * 1024;
            *(float4*)(op + lane * 8) = make_float4(o[0], o[1], o[2], o[3]); *(float4*)(op + lane * 8 + 4) = make_float4(o[4], o[5], o[6], o[7]);
            *(float4*)(op + 512 + lane * 8) = make_float4(o[8], o[9], o[10], o[11]); *(float4*)(op + 512 + lane * 8 + 4) = make_float4(o[12], o[13], o[14], o[15]);
        } else {
            u32x4 w0, w1;
            w0.x = pk2(o[0], o[1]); w0.y = pk2(o[2], o[3]); w0.z = pk2(o[4], o[5]); w0.w = pk2(o[6], o[7]);
            w1.x = pk2(o[8], o[9]); w1.y = pk2(o[10], o[11]); w1.z = pk2(o[12], o[13]); w1.w = pk2(o[14], o[15]);
            *(u32x4*)(Xo + (size_t)row * 1024 + lane * 8) = w0; *(u32x4*)(Xo + (size_t)row * 1024 + 512 + lane * 8) = w1;
        }
    }
}

__device__ __forceinline__ void ph_cmp2(const Args& a, unsigned char* lds) {
    const bf16_t* CH1 = (const bf16_t*)(a.ws + WS_CH1);
    bf16_t* KC = (bf16_t*)(a.ws + WS_KC);
    const int tid = threadIdx.x;
    for (int u = blockIdx.x; u < 64 * 2; u += gridDim.x) {
        const int rt = u >> 1, kv = u & 1;
        const bf16_t* ar = CH1 + ((size_t)kv * 8192 + rt * 128 + (tid >> 2)) * 128;
        const float* w2 = a.in[kv ? 15 : 12];
        const int col = tid & 127;
        auto al = [&](int k) { return *(const bf16x8*)(ar + k); };
        auto bl = [&](int k) { return (col < 64) ? colk8(w2, 64, k, col) : zero8(); };
        auto ep = [&](int r, int cb, const f32x4 (&acc)[8]) {
            bf16_t* o = KC + ((size_t)kv * 8192 + rt * 128 + r) * 64;
#pragma unroll
            for (int s = 0; s < 4; ++s) store4bf(o + 16 * s + cb, acc[s]);
        };
        mgemm_tile(lds, 128, al, bl, ep);
    }
}

namespace pg8 {
constexpr int BM = 256, BK = 64, HALF = 128, HTB = HALF * BK * 2, STAGE_BYTES = 8 * HTB;
__device__ __forceinline__ int lds_byte(int r, int c) { const int st = (r >> 4) * 2 + (c >> 5), rr = r & 15, cc = c & 31, ob = rr * 64 + cc * 2; return st * 1024 + (ob ^ (((ob >> 9) & 1) << 5)); }
__device__ __forceinline__ void stage_rc(int b, int& R, int& C) { const int st = b / 1024, sb = b % 1024, swz = sb ^ (((sb >> 9) & 1) << 5); R = (st >> 1) * 16 + swz / 64; C = (st & 1) * 32 + (swz % 64) / 2; }
__device__ __forceinline__ int perm32(int rho) { const int n = rho >> 4, i = rho & 15; return 8 * (i >> 2) + 4 * n + (i & 3); }
struct Unit { int pm, pn, ord; };
typedef float f32x16 __attribute__((ext_vector_type(16)));
typedef int i32x8 __attribute__((ext_vector_type(8))); typedef int i32x4_ __attribute__((ext_vector_type(4)));
__device__ __forceinline__ i32x8 f8cat(const bf16x8 lo, const bf16x8 hi) { return __builtin_shufflevector(__builtin_bit_cast(i32x4_, lo), __builtin_bit_cast(i32x4_, hi), 0, 1, 2, 3, 4, 5, 6, 7); }
template <class Epi, class Sched, bool ALIGN_EPI, bool F8 = false>
__device__ __forceinline__ void gemm_phase(LAS unsigned char* lds, const int K, const unsigned kstepA, const Sched& S, const Epi& E) {
    const int tid = threadIdx.x, wid = __builtin_amdgcn_readfirstlane(tid >> 6), lane = tid & 63, wr = wid >> 2, wc = wid & 3, fr = lane & 15, fq = lane >> 4;
    const int nt = K / BK;
    constexpr bool GA = Sched::GATHER;
    int RA[2]; unsigned CA2[2], voffB[2], voffB1[2], voffA[2];
    constexpr bool P16 = Epi::PERM16;
#pragma unroll
    for (int i = 0; i < 2; ++i) { int R, C; stage_rc(tid * 16 + i * 8192, R, C); const int Rb = Epi::PERM ? ((R & ~31) + perm32(R & 31)) : R;
        RA[i] = R; CA2[i] = (unsigned)C * 2u; voffB[i] = (unsigned)(Rb * K + C) * 2u; voffA[i] = GA ? 0u : (S.lane_off(R) + (unsigned)C * 2u);
        if (P16) { const int c16 = 64 * (R >> 5) + 16 * ((R >> 2) & 3) + 4 * ((R >> 4) & 1) + (R & 3); voffB[i] = (unsigned)(c16 * K + C) * 2u; voffB1[i] = (unsigned)((c16 + 8) * K + C) * 2u; } else voffB1[i] = 0u; }
    const size_t kstepB = (size_t)(BK * 2);
    const size_t hstepB = (size_t)HALF * K * 2;
    const unsigned ldsw = (unsigned)wid * 1024u;
    const int aoff = lds_byte(wr * 64 + fr, fq * 8), boff = lds_byte(wc * 32 + fr, fq * 8);
    const char* const Ab = S.abase();
    unsigned aoC[2][2], aoN[2][2];
    unsigned uC[2], uN[2];
#define PG8_SA(b, h) (((b) * 2 + (h)) * HTB)
#define PG8_SB(b, h) ((4 + (b) * 2 + (h)) * HTB)
#define PG8_GLDS(sbase, voff, ldsoff) do { const char* _b = (const char*)(sbase); unsigned _v = (voff); asm volatile("" : "+s"(_b), "+v"(_v)); \
        __builtin_amdgcn_global_load_lds((const unsigned*)(_b + _v), (LAS unsigned*)(lds + (ldsoff)), 16, 0, 0); } while (0)
#define PG8_STAGE_B(bufoff, gbase) do { _Pragma("unroll") for (int _i = 0; _i < 2; ++_i) PG8_GLDS(gbase, voffB[_i], (bufoff) + ldsw + _i * 8192); } while (0)
#define PG8_STAGE_B1(bufoff, gbase) do { _Pragma("unroll") for (int _i = 0; _i < 2; ++_i) PG8_GLDS((const char*)(gbase) + (P16 ? (size_t)0 : hstepB), (P16 ? voffB1[_i] : voffB[_i]), (bufoff) + ldsw + _i * 8192); } while (0)
#define PG8_STAGE_A(bufoff, kb, UO, LO) do { _Pragma("unroll") for (int _i = 0; _i < 2; ++_i) PG8_GLDS(Ab + (size_t)((kb) + (UO)), (GA ? (LO)[_i] : voffA[_i]), (bufoff) + ldsw + _i * 8192); } while (0)
#define PG8_LDA(dst, b, h) do { _Pragma("unroll") for (int m = 0; m < 4; ++m) _Pragma("unroll") for (int k = 0; k < 2; ++k) dst[m][k] = *(const LAS bf16x8*)(lds + PG8_SA(b, h) + aoff + m * 2048 + k * 1024); } while (0)
#define PG8_LDB(dst, b, h) do { _Pragma("unroll") for (int n = 0; n < 2; ++n) _Pragma("unroll") for (int k = 0; k < 2; ++k) dst[n][k] = *(const LAS bf16x8*)(lds + PG8_SB(b, h) + boff + n * 2048 + k * 1024); } while (0)
#define PG8_MMA(ai, bj, At, Bt) do { __builtin_amdgcn_s_setprio(1); _Pragma("unroll") for (int m = 0; m < 4; ++m) _Pragma("unroll") for (int n = 0; n < 2; ++n) { \
        if constexpr (F8) { f32x16& _w = accw[ai][bj][m >> 1]; const int _q = ((m & 1) * 2 + n) * 4; f32x4 _c = {_w[_q], _w[_q + 1], _w[_q + 2], _w[_q + 3]}; \
            _c = __builtin_amdgcn_mfma_scale_f32_16x16x128_f8f6f4(f8cat(Bt[n][0], Bt[n][1]), f8cat(At[m][0], At[m][1]), _c, 0, 0, 0, 0, 0, 0); _w[_q] = _c[0]; _w[_q + 1] = _c[1]; _w[_q + 2] = _c[2]; _w[_q + 3] = _c[3]; } \
        else { _Pragma("unroll") for (int k = 0; k < 2; ++k) acc[ai][bj][m][n] = __builtin_amdgcn_mfma_f32_16x16x32_bf16(Bt[n][k], At[m][k], acc[ai][bj][m][n], 0, 0, 0); } } __builtin_amdgcn_s_setprio(0); } while (0)
#define PG8_WAIT_V(n) asm volatile("s_waitcnt vmcnt(" #n ")" ::: "memory")
#define PG8_WAIT_L(n) asm volatile("s_waitcnt lgkmcnt(" #n ")" ::: "memory")
#define PG8_BAR __builtin_amdgcn_s_barrier()
#define PG8_SCHED __builtin_amdgcn_sched_barrier(0)
#define PG8_KPAIR(KB1, KB2, KB3, BP2, BP3) do { \
            PG8_LDB(B0, 0, 0); PG8_LDB(B1, 0, 1); PG8_SCHED; PG8_LDA(At, 0, 0); PG8_STAGE_A(PG8_SA(1, 1), KB1, uC[1], aoC[1]); \
            PG8_WAIT_V(8); PG8_WAIT_L(0); PG8_BAR; PG8_MMA(0, 0, At, B0); PG8_MMA(0, 1, At, B1); PG8_BAR; PG8_SCHED; \
            PG8_LDA(At, 0, 1); PG8_STAGE_B(PG8_SB(0, 0), BP2); PG8_STAGE_B1(PG8_SB(0, 1), BP2); PG8_STAGE_A(PG8_SA(0, 0), KB2, u2[0], a2o[0]); \
            PG8_WAIT_V(8); PG8_WAIT_L(0); PG8_BAR; PG8_MMA(1, 0, At, B0); PG8_MMA(1, 1, At, B1); PG8_BAR; PG8_SCHED; \
            PG8_LDB(B0, 1, 0); PG8_LDB(B1, 1, 1); PG8_SCHED; PG8_LDA(At, 1, 0); PG8_STAGE_A(PG8_SA(0, 1), KB2, u2[1], a2o[1]); \
            PG8_WAIT_V(8); PG8_WAIT_L(0); PG8_BAR; PG8_MMA(0, 0, At, B0); PG8_MMA(0, 1, At, B1); PG8_BAR; PG8_SCHED; \
            PG8_LDA(At, 1, 1); PG8_STAGE_B(PG8_SB(1, 0), BP3); PG8_STAGE_B1(PG8_SB(1, 1), BP3); PG8_STAGE_A(PG8_SA(1, 0), KB3, u2[0], a2o[0]); \
            PG8_WAIT_V(8); PG8_WAIT_L(0); PG8_BAR; PG8_MMA(1, 0, At, B0); PG8_MMA(1, 1, At, B1); PG8_BAR; PG8_SCHED; } while (0)
    Unit cur, nxt; int ui = 0;
    if (!S.next(0, cur)) return;
    f32x4 acc[2][2][4][2];
#pragma unroll
    for (int a = 0; a < 2; ++a)
#pragma unroll
        for (int b = 0; b < 2; ++b)
#pragma unroll
            for (int m = 0; m < 4; ++m)
#pragma unroll
                for (int n = 0; n < 2; ++n) acc[a][b][m][n] = (f32x4){0.f, 0.f, 0.f, 0.f};
    bf16x8 At[4][2], B0[2][2], B1[2][2];
    f32x16 accw[2][2][2];
#define PG8_ZERO_W() do { if constexpr (F8) { _Pragma("unroll") for (int _a = 0; _a < 2; ++_a) _Pragma("unroll") for (int _b = 0; _b < 2; ++_b) _Pragma("unroll") for (int _m = 0; _m < 2; ++_m) _Pragma("unroll") for (int _e = 0; _e < 16; ++_e) accw[_a][_b][_m][_e] = 0.f; } } while (0)
    PG8_ZERO_W();
#pragma unroll
    for (int h = 0; h < 2; ++h) { uC[h] = GA ? 0u : S.unit_off(cur, h); uN[h] = uC[h];
#pragma unroll
        for (int i = 0; i < 2; ++i) { aoC[h][i] = GA ? (S.aoff(cur, h * HALF + RA[i]) + CA2[i]) : 0u; aoN[h][i] = aoC[h][i]; } }
    const char* cB = S.bptr(cur);
    PG8_STAGE_B(PG8_SB(0, 0), cB); PG8_STAGE_B1(PG8_SB(0, 1), cB); PG8_STAGE_A(PG8_SA(0, 0), 0u, uC[0], aoC[0]); PG8_STAGE_A(PG8_SA(0, 1), 0u, uC[1], aoC[1]);
    if (wr == 1) PG8_BAR;
    PG8_WAIT_V(2); PG8_BAR;
    PG8_STAGE_B(PG8_SB(1, 0), cB + kstepB); PG8_STAGE_A(PG8_SA(1, 0), kstepA, uC[0], aoC[0]); PG8_STAGE_B1(PG8_SB(1, 1), cB + kstepB);
    PG8_WAIT_V(6); PG8_BAR;
    for (;;) {
        const bool has_next = S.next(ui + 1, nxt);
        const char* nB = has_next ? S.bptr(nxt) : cB;
#pragma unroll
        for (int h = 0; h < 2; ++h) { uN[h] = (GA || !has_next) ? uC[h] : S.unit_off(nxt, h);
#pragma unroll
            for (int i = 0; i < 2; ++i) aoN[h][i] = (GA && has_next) ? (S.aoff(nxt, h * HALF + RA[i]) + CA2[i]) : aoC[h][i]; }
#pragma nounroll
        for (int t = 0; t < nt; t += 2) {
            const bool last = (t == nt - 2);
            const unsigned kb1 = (unsigned)(t + 1) * kstepA, kb2 = last ? 0u : (unsigned)(t + 2) * kstepA, kb3 = kb2 + kstepA;
            const char* b2 = last ? nB : cB + (size_t)(t + 2) * kstepB; const char* b3 = b2 + kstepB;
            unsigned u2[2], a2o[2][2];
#pragma unroll
            for (int h = 0; h < 2; ++h) { u2[h] = last ? uN[h] : uC[h];
#pragma unroll
                for (int i = 0; i < 2; ++i) a2o[h][i] = GA ? (last ? aoN[h][i] : aoC[h][i]) : 0u; }
            PG8_KPAIR(kb1, kb2, kb3, b2, b3);
        }
        if constexpr (ALIGN_EPI) { if (wr == 0) PG8_BAR; }
        if constexpr (F8) {
#pragma unroll
            for (int _a = 0; _a < 2; ++_a)
#pragma unroll
                for (int _b = 0; _b < 2; ++_b)
#pragma unroll
                    for (int _m = 0; _m < 4; ++_m)
#pragma unroll
                        for (int _n = 0; _n < 2; ++_n) { const f32x16& _w = accw[_a][_b][_m >> 1]; const int _q = ((_m & 1) * 2 + _n) * 4; acc[_a][_b][_m][_n] = (f32x4){_w[_q], _w[_q + 1], _w[_q + 2], _w[_q + 3]}; }
        }
        E(acc, cur, wr, wc, fr, fq);
        PG8_ZERO_W();
        if (!has_next) break;
#pragma unroll
        for (int a = 0; a < 2; ++a)
#pragma unroll
            for (int b = 0; b < 2; ++b)
#pragma unroll
                for (int m = 0; m < 4; ++m)
#pragma unroll
                    for (int n = 0; n < 2; ++n) acc[a][b][m][n] = (f32x4){0.f, 0.f, 0.f, 0.f};
        cur = nxt; cB = nB; ++ui;
#pragma unroll
        for (int h = 0; h < 2; ++h) { uC[h] = uN[h];
#pragma unroll
            for (int i = 0; i < 2; ++i) aoC[h][i] = aoN[h][i]; }
        if constexpr (ALIGN_EPI) { if (wr == 1) PG8_BAR; }
    }
    PG8_WAIT_V(0);
    if constexpr (!ALIGN_EPI) { if (wr == 0) PG8_BAR; }
    PG8_BAR;
#undef PG8_SA
#undef PG8_ZERO_W
#undef PG8_GLDS
#undef PG8_SB
#undef PG8_STAGE_A
#undef PG8_STAGE_B
#undef PG8_STAGE_B1
#undef PG8_LDA
#undef PG8_LDB
#undef PG8_MMA
#undef PG8_WAIT_V
#undef PG8_WAIT_L
#undef PG8_BAR
#undef PG8_SCHED
#undef PG8_KPAIR
}

struct DenseSched {
    const char* A; const char* Bt; unsigned lda2; size_t btile; int nM, nN, nwg, G, c;
    __device__ __forceinline__ void init(const bf16_t* A_, int lda, const bf16_t* Bt_, int K, int Mrows, int N) {
        A = (const char*)A_; Bt = (const char*)Bt_; lda2 = (unsigned)lda * 2u; btile = (size_t)256 * K * 2; nM = Mrows / BM; nN = N / BM; nwg = nM * nN; G = gridDim.x; c = blockIdx.x; }
    __device__ __forceinline__ bool next(int i, Unit& u) const {
        const long L = (long)i * G + c; if (L >= nwg) return false;
        int wgid = (int)L; { const int q = nwg / 8, r = nwg % 8, xcd = wgid % 8, off = wgid / 8; wgid = (xcd < r ? xcd * (q + 1) : r * (q + 1) + (xcd - r) * q) + off; }
        const int nig = 8 * nN, gid = wgid / nig, fm = gid * 8, gsz = (nM - fm) < 8 ? (nM - fm) : 8;
        u.pm = fm + ((wgid % nig) % gsz); u.pn = (wgid % nig) / gsz; u.ord = i; return true;
    }
    static constexpr bool GATHER = false;
    __device__ __forceinline__ unsigned lane_off(int r) const { return (unsigned)r * lda2; }
    __device__ __forceinline__ unsigned unit_off(const Unit& u, int h) const { return (unsigned)(u.pm * BM + h * HALF) * lda2; }
    __device__ __forceinline__ unsigned aoff(const Unit&, int) const { return 0u; }
    __device__ __forceinline__ const char* abase() const { return A; }
    __device__ __forceinline__ const char* bptr(const Unit& u) const { return Bt + (size_t)u.pn * btile; }
};
}
typedef float f32x2_t __attribute__((ext_vector_type(2))); typedef __bf16 bf16x2_t __attribute__((ext_vector_type(2)));
__device__ __forceinline__ unsigned cvt_pk_bf16(float lo, float hi) { const f32x2_t v = {lo, hi}; const bf16x2_t b = __builtin_convertvector(v, bf16x2_t); return __builtin_bit_cast(unsigned, b); }
__device__ __forceinline__ u32x4 pack8(const f32x4 v0, const f32x4 v1) { u32x4 w; w.x = cvt_pk_bf16(v0[0], v0[1]); w.y = cvt_pk_bf16(v0[2], v0[3]); w.z = cvt_pk_bf16(v1[0], v1[1]); w.w = cvt_pk_bf16(v1[2], v1[3]); return w; }
__device__ __forceinline__ unsigned cvtpk_m(float lo, float hi) { const f32x2_t v = {lo, hi}; const bf16x2_t b = __builtin_convertvector(v, bf16x2_t); return __builtin_bit_cast(unsigned, b); }
__device__ __forceinline__ u32x4 pack8m(const f32x4 v0, const f32x4 v1) { u32x4 w; w.x = cvtpk_m(v0[0], v0[1]); w.y = cvtpk_m(v0[2], v0[3]); w.z = cvtpk_m(v1[0], v1[1]); w.w = cvtpk_m(v1[2], v1[3]); return w; }
#define MFMA_SETTLE(S) asm volatile("s_nop 15\n\ts_nop 7" : "+v"(S[0][0]), "+v"(S[0][1]), "+v"(S[0][2]), "+v"(S[0][3]), "+v"(S[1][0]), "+v"(S[1][1]), "+v"(S[1][2]), "+v"(S[1][3]))
__device__ __forceinline__ f32x4 sig4(const f32x4 v) { f32x4 r; r[0] = sigmoidf_(v[0]); r[1] = sigmoidf_(v[1]); r[2] = sigmoidf_(v[2]); r[3] = sigmoidf_(v[3]); return r; }

#define EPI_ROWLOOP for (int ai = 0; ai < 2; ++ai) _Pragma("unroll") for (int m = 0; m < 4; ++m)
struct EpiInproj0 {
    static constexpr bool PERM = true, PERM16 = false; bf16_t* H0;
    __device__ __forceinline__ void operator()(const f32x4 (&acc)[2][2][4][2], const pg8::Unit& u, int wr, int wc, int fr, int fq) const {
        const int row0 = u.pm * 256 + wr * 64 + fr, cl = wc * 32 + 8 * fq;
#pragma unroll
        EPI_ROWLOOP { bf16_t* rp = H0 + (size_t)(row0 + ai * 128 + m * 16) * 1024;
            if (u.pn < 2) {
#pragma unroll
                for (int bj = 0; bj < 2; ++bj) *(u32x4*)(rp + u.pn * 256 + bj * 128 + cl) = pack8(acc[ai][bj][m][0], acc[ai][bj][m][1]);
            } else {
                const f32x4 v0 = acc[ai][0][m][0] * sig4(acc[ai][1][m][0]), v1 = acc[ai][0][m][1] * sig4(acc[ai][1][m][1]);
                *(u32x4*)(rp + 512 + (u.pn - 2) * 128 + cl) = pack8(v0, v1);
            } }
    }
};
struct EpiRes {
    static constexpr bool PERM = true, PERM16 = false; const float* resf; const bf16_t* resb; bf16_t* Y; float sc;
    __device__ __forceinline__ void operator()(const f32x4 (&acc)[2][2][4][2], const pg8::Unit& u, int wr, int wc, int fr, int fq) const {
        const int row0 = u.pm * 256 + wr * 64 + fr, c0 = u.pn * 256 + wc * 32 + 8 * fq;
#pragma unroll
        EPI_ROWLOOP { const size_t ro = (size_t)(row0 + ai * 128 + m * 16) * 1024 + c0;
#pragma unroll
            for (int bj = 0; bj < 2; ++bj) {
                f32x4 r0, r1;
                if (resf) { r0 = *(const f32x4*)(resf + ro + bj * 128); r1 = *(const f32x4*)(resf + ro + bj * 128 + 4); }
                else { const u32x4 xv = *(const u32x4*)(resb + ro + bj * 128);
                    r0[0] = __uint_as_float(xv.x << 16); r0[1] = __uint_as_float(xv.x & 0xffff0000u); r0[2] = __uint_as_float(xv.y << 16); r0[3] = __uint_as_float(xv.y & 0xffff0000u);
                    r1[0] = __uint_as_float(xv.z << 16); r1[1] = __uint_as_float(xv.z & 0xffff0000u); r1[2] = __uint_as_float(xv.w << 16); r1[3] = __uint_as_float(xv.w & 0xffff0000u); }
                *(u32x4*)(Y + ro + bj * 128) = pack8(acc[ai][bj][m][0] * sc + r0 * ALPHA, acc[ai][bj][m][1] * sc + r1 * ALPHA);
            } }
    }
};
struct EpiLogits {
    static constexpr bool PERM = true, PERM16 = false; float* LOG;
    __device__ __forceinline__ void operator()(const f32x4 (&acc)[2][2][4][2], const pg8::Unit& u, int wr, int wc, int fr, int fq) const {
        const int row0 = u.pm * 256 + wr * 64 + fr, cl = wc * 32 + 8 * fq;
#pragma unroll
        EPI_ROWLOOP { float* rp = LOG + (size_t)(row0 + ai * 128 + m * 16) * 256 + cl;
#pragma unroll
            for (int bj = 0; bj < 2; ++bj) { *(f32x4*)(rp + bj * 128) = acc[ai][bj][m][0]; *(f32x4*)(rp + bj * 128 + 4) = acc[ai][bj][m][1]; } }
    }
};

constexpr int MOE_TAB_OFF = 131072;
__device__ __forceinline__ int moe_setup256(const unsigned* cnt, LAS unsigned char* lds) {
    LAS int* tstart = (LAS int*)(lds + MOE_TAB_OFF);
    LAS int* scnt = (LAS int*)(lds + MOE_TAB_OFF + 1088);
    LAS unsigned short* texp = (LAS unsigned short*)(lds + MOE_TAB_OFF + 2176);
    const int tid = threadIdx.x;
    __syncthreads();
    const int lane = tid & 63, wave = tid >> 6;
    LAS int* wtot = tstart + 260;
    int c = 0;
    if (tid < 256) { const int n = (int)cnt[tid]; scnt[tid] = n; c = (n + 255) >> 8; }
    int incl = c;
#pragma unroll
    for (int o = 1; o < 64; o <<= 1) { const int t = __shfl_up(incl, o); if (lane >= o) incl += t; }
    if (tid < 256 && lane == 63) wtot[wave] = incl;
    __syncthreads();
    if (tid < 256) { int off = 0;
#pragma unroll
        for (int w = 0; w < 3; ++w) off += (w < wave) ? wtot[w] : 0;
        tstart[tid] = off + incl - c; if (tid == 255) tstart[256] = off + incl; }
    __syncthreads();
    if (tid < 256) for (int q = tstart[tid]; q < tstart[tid + 1]; ++q) texp[q] = (unsigned short)tid;
    __syncthreads();
    return __builtin_amdgcn_readfirstlane(tstart[256]);
}
constexpr int MOE_TOK_OFF = MOE_TAB_OFF + 5120;
constexpr int MOE_MAX_ORD = 20;
struct MoeGuSched {
    static constexpr bool GATHER = true;
    const char* X; const char* W; const int2* list; LAS unsigned char* lds; int R, nunits, G, c;
    __device__ __forceinline__ int vcu() const { return (G % 8 == 0) ? (c % 8) * (G / 8) + c / 8 : c; }
    __device__ __forceinline__ bool next(int i, pg8::Unit& u) const {
        const int L = i * G + vcu(); if (L >= nunits || i >= MOE_MAX_ORD) return false;
        const int q = L >> 1; const int e = __builtin_amdgcn_readfirstlane((q < R) ? (int)((LAS unsigned short*)(lds + MOE_TAB_OFF + 2176))[q] : 256);
        u.pm = q; u.pn = e * 2 + (L & 1); u.ord = i; return true; }
    __device__ __forceinline__ void prepare() const {
        const int tid = threadIdx.x, r = tid & 255;
        pg8::Unit u;
        for (int i = tid >> 8; next(i, u); i += 2) {
            const int e = u.pn >> 1; int token;
            if (e < 256) { const int ts = ((LAS int*)(lds + MOE_TAB_OFF))[e], cn = ((LAS int*)(lds + MOE_TAB_OFF + 1088))[e]; int lr = (u.pm - ts) * 256 + r; if (lr >= cn) lr = cn - 1;
                token = list[(size_t)e * LISTCAP + lr].x / 10; }
            else token = (u.pm - R) * 256 + r;
            ((LAS unsigned short*)(lds + MOE_TOK_OFF))[i * 256 + r] = (unsigned short)token;
        }
        __syncthreads();
    }
    __device__ __forceinline__ unsigned aoff(const pg8::Unit& u, int r) const { return (unsigned)((LAS unsigned short*)(lds + MOE_TOK_OFF))[u.ord * 256 + r] * 1024u; }
    __device__ __forceinline__ unsigned lane_off(int) const { return 0u; }
    __device__ __forceinline__ unsigned unit_off(const pg8::Unit&, int) const { return 0u; }
    __device__ __forceinline__ const char* abase() const { return X; }
    __device__ __forceinline__ const char* bptr(const pg8::Unit& u) const { return W + (size_t)u.pn * (256 * 1024); }
};
constexpr float GU_SC = 1.0f / (X8_SCALE * W8_SCALE);
struct EpiGateUp {
    static constexpr bool PERM = true, PERM16 = false; unsigned char* HID;
    __device__ __forceinline__ void operator()(const f32x4 (&acc)[2][2][4][2], const pg8::Unit& u, int wr, int wc, int fr, int fq) const {
        const int row0 = u.pm * 256 + wr * 64 + fr, c0 = (u.pn & 1) * 128 + wc * 32 + 8 * fq;
#pragma unroll
        EPI_ROWLOOP { const f32x4 g0 = acc[ai][0][m][0] * GU_SC, g1 = acc[ai][0][m][1] * GU_SC;
            f32x4 h0 = g0 * sig4(g0) * (acc[ai][1][m][0] * (GU_SC * H8_SCALE)), h1 = g1 * sig4(g1) * (acc[ai][1][m][1] * (GU_SC * H8_SCALE));
#pragma unroll
            for (int i = 0; i < 4; ++i) { h0[i] = clamp8(h0[i]); h1[i] = clamp8(h1[i]); }
            *(u32x2*)(HID + (size_t)(row0 + ai * 128 + m * 16) * 256 + c0) = pack8_fp8(h0, h1); }
    }
};
constexpr int MOE_RI_OFF = MOE_TAB_OFF + 5120;
constexpr int MOE_MAX_RT = 6;
struct MoeDownSched {
    const char* HID; const char* W; const int2* list; LAS unsigned char* lds; int R, ntile, G, c;
    __device__ __forceinline__ int vcu() const { return (G % 8 == 0) ? (c % 8) * (G / 8) + c / 8 : c; }
    __device__ __forceinline__ bool next(int i, pg8::Unit& u) const {
        const int q = vcu() + G * (i >> 2); if (q >= ntile || (i >> 2) >= MOE_MAX_RT) return false;
        const int e = (q < R) ? (int)((LAS unsigned short*)(lds + MOE_TAB_OFF + 2176))[q] : 256;
        u.pm = q; u.pn = e * 4 + (i & 3); u.ord = i >> 2; return true; }
    __device__ __forceinline__ void prepare() const {
        const int tid = threadIdx.x, r = tid & 255;
        for (int o = tid >> 8; o < MOE_MAX_RT; o += 2) {
            const int q = vcu() + G * o; if (q >= ntile) break;
            u32x2 en;
            if (q < R) { const int e = ((LAS unsigned short*)(lds + MOE_TAB_OFF + 2176))[q]; const int ts = ((LAS int*)(lds + MOE_TAB_OFF))[e], cn = ((LAS int*)(lds + MOE_TAB_OFF + 1088))[e];
                const int lr = (q - ts) * 256 + r; if (lr < cn) { const int2 le = list[(size_t)e * LISTCAP + lr]; en.x = (unsigned)le.x; en.y = (unsigned)le.y; } else { en.x = 0xffffffffu; en.y = 0u; } }
            else { en.x = (unsigned)(((q - R) * 256 + r) * 10 + 8); en.y = __float_as_uint(1.0f); }
            ((LAS u32x2*)(lds + MOE_RI_OFF))[o * 256 + r] = en;
        }
        __syncthreads();
    }
    static constexpr bool GATHER = false;
    __device__ __forceinline__ unsigned lane_off(int r) const { return (unsigned)r * 256u; }
    __device__ __forceinline__ unsigned unit_off(const pg8::Unit& u, int h) const { return (unsigned)(u.pm * 256 + h * 128) * 256u; }
    __device__ __forceinline__ unsigned aoff(const pg8::Unit&, int) const { return 0u; }
    __device__ __forceinline__ const char* abase() const { return HID; }
    __device__ __forceinline__ const char* bptr(const pg8::Unit& u) const { return W + (size_t)u.pn * (256 * 256); }
};
struct EpiDown {
    static constexpr bool PERM = true, PERM16 = true;
    unsigned char* YB; LAS unsigned char* lds;
    __device__ __forceinline__ void operator()(const f32x4 (&acc)[2][2][4][2], const pg8::Unit& u, int wr, int wc, int fr, int fq) const {
        asm volatile("" : "+v"(fr), "+v"(fq));
        const unsigned c0b = (unsigned)((u.pn & 3) * 256 + wc * 64 + 16 * fq); const bool shared = (u.pn >> 2) == 256;
        const LAS u32x2* ri = (const LAS u32x2*)(lds + MOE_RI_OFF) + u.ord * 256 + wr * 64 + fr;
#pragma unroll
        for (int ai = 0; ai < 2; ++ai)
#pragma unroll
            for (int m = 0; m < 4; ++m) { const u32x2 en = ri[ai * 128 + m * 16]; const float wv = __uint_as_float(en.y) * (YB_SCALE / (H8_SCALE * W8_SCALE));
                if ((int)en.x >= 0) { unsigned char* rp = YB + (size_t)(en.x * 1024u + c0b);
                    const f32x4 v00 = acc[ai][0][m][0] * wv, v01 = acc[ai][0][m][1] * wv, v10 = acc[ai][1][m][0] * wv, v11 = acc[ai][1][m][1] * wv;
                    const u32x2 h0 = pack8_fp8(v00, v01), h1 = pack8_fp8(v10, v11);
                    *(u32x4*)rp = (u32x4){h0.x, h0.y, h1.x, h1.y};
                    if (YB_NSLOT == 10 && shared) {
                        u32x2 r_[2];
#pragma unroll
                        for (int bj = 0; bj < 2; ++bj) { const u32x2 h = bj ? h1 : h0; const f32x4 v0 = bj ? v10 : v00, v1 = bj ? v11 : v01;
                            const auto a0 = __builtin_amdgcn_cvt_pk_f32_fp8((int)h.x, false), a1 = __builtin_amdgcn_cvt_pk_f32_fp8((int)h.x, true), a2 = __builtin_amdgcn_cvt_pk_f32_fp8((int)h.y, false), a3 = __builtin_amdgcn_cvt_pk_f32_fp8((int)h.y, true);
                            const f32x4 r0 = {v0[0] - a0[0], v0[1] - a0[1], v0[2] - a1[0], v0[3] - a1[1]}, r1 = {v1[0] - a2[0], v1[1] - a2[1], v1[2] - a3[0], v1[3] - a3[1]};
                            r_[bj] = pack8_fp8(r0, r1); }
                        *(u32x4*)(rp + 1024) = (u32x4){r_[0].x, r_[0].y, r_[1].x, r_[1].y}; } } }
    }
};

struct EpiInprojN {
    static constexpr bool PERM = true, PERM16 = false; bf16_t* QN; bf16_t* QR; bf16_t* KV6; float* GATES; const float* ROT;
    __device__ __forceinline__ void operator()(const f32x4 (&acc)[2][2][4][2], const pg8::Unit& u, int wr, int wc, int fr, int fq) const {
        const int row0 = u.pm * 256 + wr * 64 + fr, cl = wc * 32 + 8 * fq, pn = u.pn;
        const bool isq = pn < 4, rotk = (pn == 6 || pn == 8), dorot = (isq || rotk) && ((wc & 1) == 0);
#pragma unroll
        EPI_ROWLOOP { const int row = row0 + ai * 128 + m * 16;
            if (pn == 10) {
                if (cl < 48) { *(f32x4*)(GATES + (size_t)row * 48 + cl) = sig4(acc[ai][0][m][0]); *(f32x4*)(GATES + (size_t)row * 48 + cl + 4) = sig4(acc[ai][0][m][1]); }
            } else {
                f32x4 cs0, cs1, sn0, sn1;
                if (dorot) { const float* rt = ROT + (size_t)(row & (T - 1)) * 16; cs0 = *(const f32x4*)rt; cs1 = *(const f32x4*)(rt + 4); sn0 = *(const f32x4*)(rt + 8); sn1 = *(const f32x4*)(rt + 12); }
#pragma unroll
                for (int bj = 0; bj < 2; ++bj) {
                    const f32x4 v0 = acc[ai][bj][m][0], v1 = acc[ai][bj][m][1];
                    f32x4 r0 = v0, r1 = v1;
                    if (dorot) {
                        f32x4 p0, p1;
#pragma unroll
                        for (int i = 0; i < 4; ++i) { p0[i] = __shfl_xor(v0[i], 16); p1[i] = __shfl_xor(v1[i], 16); }
                        if (fq == 0) { r0 = v0 * cs0 - p0 * sn0; r1 = v1 * cs1 - p1 * sn1; }
                        else if (fq == 1) { r0 = v0 * cs0 + p0 * sn0; r1 = v1 * cs1 + p1 * sn1; }
                    }
                    if (isq) { const int c = pn * 256 + bj * 128 + cl;
                        *(u32x4*)(QN + (size_t)row * 1024 + c) = pack8(v0 * QSCALE, v1 * QSCALE); *(u32x4*)(QR + (size_t)row * 1024 + c) = pack8(r0 * QSCALE, r1 * QSCALE); }
                    else { const int cc = bj * 128 + cl, g = cc >> 6, d = cc & 63, b = row >> 13, t = row & (T - 1);
                        *(u32x4*)(KV6 + ((size_t)((pn - 4) * 16 + b * 4 + g) * T + t) * 64 + d) = pack8(r0, r1); }
                }
            } }
    }
};

struct Cmp1Sched {
    const char* KV6; const char* W; int G, c;
    static constexpr bool GATHER = false;
    __device__ __forceinline__ bool next(int i, pg8::Unit& u) const { const int L = i * G + c; if (L >= 64) return false; u.pm = L >> 1; u.pn = L & 1; u.ord = i; return true; }
    __device__ __forceinline__ unsigned lane_off(int r) const { return (unsigned)r * 2048u; }
    __device__ __forceinline__ unsigned unit_off(const pg8::Unit& u, int h) const { return (unsigned)u.pn * (unsigned)(16 * T * 64 * 2) + (unsigned)(u.pm * 256 + h * 128) * 2048u; }
    __device__ __forceinline__ unsigned aoff(const pg8::Unit&, int) const { return 0u; }
    __device__ __forceinline__ const char* abase() const { return KV6; }
    __device__ __forceinline__ const char* bptr(const pg8::Unit& u) const { return W + (size_t)u.pn * (256 * 2048 * 2); }
};
struct EpiCmp1 {
    static constexpr bool PERM = true, PERM16 = false; bf16_t* CH1; const float* bias1;
    __device__ __forceinline__ void operator()(const f32x4 (&acc)[2][2][4][2], const pg8::Unit& u, int wr, int wc, int fr, int fq) const {
        const int row0 = u.pm * 256 + wr * 64 + fr, cl = wc * 32 + 8 * fq;
        const f32x4 b0 = *(const f32x4*)(bias1 + u.pn * 128 + cl), b1 = *(const f32x4*)(bias1 + u.pn * 128 + cl + 4);
#pragma unroll
        EPI_ROWLOOP { f32x4 v0 = acc[ai][0][m][0] + b0, v1 = acc[ai][0][m][1] + b1;
#pragma unroll
            for (int i = 0; i < 4; ++i) { v0[i] = gelu_tanh(v0[i]); v1[i] = gelu_tanh(v1[i]); }
            *(u32x4*)(CH1 + ((size_t)u.pn * 8192 + row0 + ai * 128 + m * 16) * 128 + cl) = pack8(v0, v1); }
    }
};

__device__ __forceinline__ void p0_item(const float* W, int K, int N, bf16_t* WT, int kb, int n0, int drow0, LAS float* scr, int lane, bool f8 = false) {
    const int k0 = 64 * kb, n4 = (lane & 15) * 4;
    const bool cok = (n0 + n4) < N;
    f32x4 v[16];
#pragma unroll
    for (int i = 0; i < 16; ++i) { const int kk = 4 * i + (lane >> 4); v[i] = cok ? __builtin_nontemporal_load((const f32x4*)(W + (size_t)(k0 + kk) * N + n0 + n4)) : (f32x4){0.f, 0.f, 0.f, 0.f}; }
#pragma unroll
    for (int i = 0; i < 16; ++i) { const int kk = 4 * i + (lane >> 4); LAS float* d = scr + kk * 65 + n4; d[0] = v[i][0]; d[1] = v[i][1]; d[2] = v[i][2]; d[3] = v[i][3]; }
    asm volatile("s_waitcnt lgkmcnt(0)" ::: "memory");
    if (f8) {
        const int c4 = lane & 3;
#pragma unroll
        for (int j = 0; j < 4; ++j) { const int n = (lane >> 2) + 16 * j; const LAS float* sp = scr + (16 * c4) * 65 + n;
            u32x4 o;
            o.x = pk4_fp8(sp[0 * 65] * W8_SCALE, sp[1 * 65] * W8_SCALE, sp[2 * 65] * W8_SCALE, sp[3 * 65] * W8_SCALE); o.y = pk4_fp8(sp[4 * 65] * W8_SCALE, sp[5 * 65] * W8_SCALE, sp[6 * 65] * W8_SCALE, sp[7 * 65] * W8_SCALE);
            o.z = pk4_fp8(sp[8 * 65] * W8_SCALE, sp[9 * 65] * W8_SCALE, sp[10 * 65] * W8_SCALE, sp[11 * 65] * W8_SCALE); o.w = pk4_fp8(sp[12 * 65] * W8_SCALE, sp[13 * 65] * W8_SCALE, sp[14 * 65] * W8_SCALE, sp[15 * 65] * W8_SCALE);
            if (n0 + n < N) __builtin_nontemporal_store(o, (u32x4*)((unsigned char*)WT + (size_t)(drow0 + n) * K + k0 + 16 * c4)); }
        asm volatile("s_waitcnt lgkmcnt(0)" ::: "memory");
        return;
    }
    const int c = lane & 7;
#pragma unroll
    for (int j = 0; j < 8; ++j) { const int n = (lane >> 3) + 8 * j; const LAS float* sp = scr + (8 * c) * 65 + n;
        u32x4 o; o.x = pk2(sp[0 * 65], sp[1 * 65]); o.y = pk2(sp[2 * 65], sp[3 * 65]); o.z = pk2(sp[4 * 65], sp[5 * 65]); o.w = pk2(sp[6 * 65], sp[7 * 65]);
        if (n0 + n < N) __builtin_nontemporal_store(o, (u32x4*)(WT + (size_t)(drow0 + n) * K + k0 + 8 * c)); }
    asm volatile("s_waitcnt lgkmcnt(0)" ::: "memory");
}
struct CvtItem { const float* W; bf16_t* WT; int K, N, k0, n0, drow0; };
__device__ __forceinline__ void cvt32_load(const CvtItem& it, int lane, f32x4 (&v)[8]) {
    const int n4 = (lane & 7) * 4;
#pragma unroll
    for (int i = 0; i < 8; ++i) { const int kk = 8 * i + (lane >> 3); v[i] = __builtin_nontemporal_load((const f32x4*)(it.W + (size_t)(it.k0 + kk) * it.N + it.n0 + n4)); }
}
__device__ __forceinline__ void cvt32_finish(const CvtItem& it, int lane, const f32x4 (&v)[8], LAS float* scr) {
    const int n4 = (lane & 7) * 4;
#pragma unroll
    for (int i = 0; i < 8; ++i) { const int kk = 8 * i + (lane >> 3); LAS float* d = scr + kk * 33 + n4; d[0] = v[i][0]; d[1] = v[i][1]; d[2] = v[i][2]; d[3] = v[i][3]; }
    asm volatile("s_waitcnt lgkmcnt(0)" ::: "memory");
    const int c = lane & 7;
#pragma unroll
    for (int j = 0; j < 4; ++j) { const int n = (lane >> 3) + 8 * j; const LAS float* sp = scr + (8 * c) * 33 + n;
        const float v0 = sp[0 * 33], v1 = sp[1 * 33], v2 = sp[2 * 33], v3 = sp[3 * 33], v4 = sp[4 * 33], v5 = sp[5 * 33], v6 = sp[6 * 33], v7 = sp[7 * 33];
        u32x2 o; o.x = pk4_fp8(v0 * W8_SCALE, v1 * W8_SCALE, v2 * W8_SCALE, v3 * W8_SCALE); o.y = pk4_fp8(v4 * W8_SCALE, v5 * W8_SCALE, v6 * W8_SCALE, v7 * W8_SCALE);
        __builtin_nontemporal_store(o, (u32x2*)((unsigned char*)it.WT + (size_t)(it.drow0 + n) * it.K + it.k0 + 8 * c)); }
    asm volatile("s_waitcnt lgkmcnt(0)" ::: "memory");
}
constexpr int CVT1_ITEMS = 257 * 384;
__device__ __forceinline__ CvtItem cvt1_item(const Args& a, int idx) {
    const int e = idx / 384, sub = idx % 384, mat = sub >> 7, r = sub & 127;
    CvtItem it;
    if (mat < 2) { it.W = (e < 256) ? a.in[23 + mat] + ((size_t)256 + e) * (size_t)(D * FF) : a.in[26 + mat] + (size_t)(D * FF);
        it.K = D; it.N = FF; it.k0 = (r >> 3) * 64; it.n0 = (r & 7) * 32; it.drow0 = (it.n0 >> 7) * 256 + mat * 128 + (it.n0 & 127);
        it.WT = (bf16_t*)(a.ws + WS_WGU + (size_t)(257 + e) * 512 * 1024); }
    else { it.W = (e < 256) ? a.in[25] + ((size_t)256 + e) * (size_t)(FF * D) : a.in[28] + (size_t)(FF * D);
        it.K = FF; it.N = D; it.k0 = (r >> 5) * 64; it.n0 = (r & 31) * 32; it.drow0 = it.n0;
        it.WT = (bf16_t*)(a.ws + WS_WD + (size_t)(257 + e) * 1024 * 256); }
    return it;
}
__device__ __forceinline__ void cvt1_run(const Args& a, int& next, int stride, int quota, LAS float* scr, int lane) {
#pragma unroll 1
    for (int q = 0; q < quota && next < CVT1_ITEMS; ++q) {
        CvtItem t[4]; f32x4 v[4][8]; bool ok[4];
#pragma unroll
        for (int u = 0; u < 4; ++u) { const int idx = next + u * stride; ok[u] = idx < CVT1_ITEMS; t[u] = cvt1_item(a, ok[u] ? idx : 0); if (ok[u]) cvt32_load(t[u], lane, v[u]); }
        next += 4 * stride;
#pragma unroll
        for (int u = 0; u < 4; ++u) if (ok[u]) cvt32_finish(t[u], lane, v[u], scr);
    }
}
__device__ __forceinline__ void ph_prologue(const Args& a, LAS unsigned char* lds) {
    const int lane = threadIdx.x & 63, wave = threadIdx.x >> 6;
    LAS float* scr = (LAS float*)(lds + wave * 16640);
    const int gw = blockIdx.x * 8 + wave, ngw = gridDim.x * 8;
    for (int it = gw; it < 257 * 192; it += ngw) {
        const int le = it / 192, sub = it % 192, l = 0, e = le, mat = sub >> 6, r = sub & 63;
        if (mat < 2) {
            const float* W = (e < 256) ? a.in[23 + mat] + ((size_t)l * 256 + e) * (size_t)(D * FF) : a.in[26 + mat] + (size_t)l * (D * FF);
            const int kb = r >> 2, n0 = (r & 3) * 64;
            p0_item(W, D, FF, (bf16_t*)(a.ws + WS_WGU + (size_t)le * 512 * 1024), kb, n0, (n0 >> 7) * 256 + mat * 128 + (n0 & 127), scr, lane, true);
        } else {
            const float* W = (e < 256) ? a.in[25] + ((size_t)l * 256 + e) * (size_t)(FF * D) : a.in[28] + (size_t)l * (FF * D);
            const int kb = r >> 4, n0 = (r & 15) * 64;
            p0_item(W, FF, D, (bf16_t*)(a.ws + WS_WD + (size_t)le * 1024 * 256), kb, n0, n0, scr, lane, true);
        }
    }
    {
        for (int it = gw; it < 512; it += ngw) { const int w = it >> 8, r = it & 255;
            p0_item(a.in[w ? 16 : 8], D, D, (bf16_t*)(a.ws + (w ? WS_WOUTN : WS_WOUT0)), r >> 4, (r & 15) * 64, (r & 15) * 64, scr, lane, w != 0); }
        for (int it = gw; it < 16 * 41; it += ngw) p0_item(a.in[9], D, 2608, (bf16_t*)(a.ws + WS_WINN), it / 41, (it % 41) * 64, (it % 41) * 64, scr, lane);
        for (int it = gw; it < 128; it += ngw) { const int l = it >> 6, r = it & 63;
            p0_item(a.in[21] + (size_t)l * D * NE, D, NE, (bf16_t*)(a.ws + WS_WR) + (size_t)l * NE * D, r >> 2, (r & 3) * 64, (r & 3) * 64, scr, lane); }
        for (int it = gw; it < 16 * 16; it += ngw) { const int kb = it >> 4, n0 = (8 + (it & 15)) * 64;
            const int isg = (n0 >= 1024) ? 1 : 0, rel = n0 - 512 - isg * 512;
            p0_item(a.in[1], D, 1536, (bf16_t*)(a.ws + WS_WIN0), kb, n0, 512 + (rel >> 7) * 256 + isg * 128 + (rel & 127), scr, lane); }
        for (int it = gw; it < 128; it += ngw) { const int kv = it >> 6, r = it & 63;
            p0_item(a.in[kv ? 14 : 11], 2048, 128, (bf16_t*)(a.ws + WS_CW1) + (size_t)kv * 256 * 2048, r >> 1, (r & 1) * 64, (r & 1) * 64, scr, lane); }
    }
    {
        const int gt = blockIdx.x * 512 + threadIdx.x, ngt = gridDim.x * 512;
        u32x4* z0 = (u32x4*)((bf16_t*)(a.ws + WS_WINN) + (size_t)2608 * 1024);
        for (int i = gt; i < 208 * 1024 / 8; i += ngt) z0[i] = (u32x4){0u, 0u, 0u, 0u};
        for (int kv = 0; kv < 2; ++kv) { u32x4* z1 = (u32x4*)((bf16_t*)(a.ws + WS_CW1) + ((size_t)kv * 256 + 128) * 2048);
            for (int i = gt; i < 128 * 2048 / 8; i += ngt) z1[i] = (u32x4){0u, 0u, 0u, 0u}; }
        const float* x = a.in[0]; bf16_t* XA = (bf16_t*)(a.ws + WS_XA);
        for (size_t i = gt; i < (size_t)M * D / 8; i += ngt) { const f32x4 v0 = *(const f32x4*)(x + i * 8), v1 = *(const f32x4*)(x + i * 8 + 4);
            u32x4 o; o.x = pk2(v0[0], v0[1]); o.y = pk2(v0[2], v0[3]); o.z = pk2(v1[0], v1[1]); o.w = pk2(v1[2], v1[3]); *(u32x4*)(XA + i * 8) = o; }
        const float* win = a.in[1]; const float* mix = a.in[2]; const float* psc = a.in[3]; bf16_t* WIN0 = (bf16_t*)(a.ws + WS_WIN0);
        for (int i = gt; i < 512 * 1024; i += ngt) { const int n = i & 511, k = i >> 9, g = n >> 7, nn = n & 127;
            const float* wr_ = win + (size_t)k * 1536 + g * 128; const float* mx = mix + (size_t)g * 128 * 128 + nn;
            float s = 0.f;
            for (int c = 0; c < 128; ++c) s += wr_[c] * mx[(size_t)c * 128];
            WIN0[(size_t)n * 1024 + k] = f2bf(s * psc[n]); }
        float* misc = (float*)(a.ws + WS_MISC);
        for (int i = gt; i < 256; i += ngt) { const int kv = i >> 7, j = i & 127; const float* pos = a.in[kv ? 13 : 10]; const float* w1 = a.in[kv ? 14 : 11];
            float s = 0.f; for (int k = 0; k < 2048; ++k) s += pos[k] * w1[(size_t)k * 128 + j]; misc[i] = s; }
        float* rot = misc + 1024;
        for (int i = gt; i < T * 8; i += ngt) { const int t = i >> 3, f = i & 7;
            const float ang = (float)t * a.inv_freq[f]; const double rev = (double)ang * 0.15915494309189535; const float fr = (float)(rev - floor(rev));
            rot[t * 16 + f] = __builtin_amdgcn_cosf(fr); rot[t * 16 + 8 + f] = __builtin_amdgcn_sinf(fr); }
    }
}

typedef short v4i16_t __attribute__((ext_vector_type(4)));
constexpr int AT_KB = 0, AT_VB = 16384, AT_PS = 32768, AT_MSK = 32768 + 65536;
#define DPP_I(x, ctrl) __builtin_amdgcn_update_dpp((int)(x), (int)(x), (ctrl), 0xF, 0xF, true)
#define DPP_F(x, ctrl) __builtin_bit_cast(float, __builtin_amdgcn_update_dpp(__builtin_bit_cast(int, (float)(x)), __builtin_bit_cast(int, (float)(x)), (ctrl), 0xF, 0xF, true))
__device__ __forceinline__ bf16x8 tr_frag(LAS unsigned char* p0, LAS unsigned char* p1) {
    const v4i16_t a = __builtin_amdgcn_ds_read_tr16_b64_v4i16((LAS v4i16_t*)p0), b = __builtin_amdgcn_ds_read_tr16_b64_v4i16((LAS v4i16_t*)p1);
    return (bf16x8){a[0], a[1], a[2], a[3], b[0], b[1], b[2], b[3]};
}
constexpr size_t TN2_OFF = 786432;
__device__ __forceinline__ void ph_knorm(const Args& a) {
    const bf16_t* KV6 = (const bf16_t*)(a.ws + WS_KV6);
    float* TN2 = (float*)(a.ws + WS_MISC + TN2_OFF);
    const int lane = threadIdx.x & 63, wave = threadIdx.x >> 6;
    const int first = (gridDim.x > 64) ? 64 : 0;
    if ((int)blockIdx.x < first) return;
    const int wi = ((int)blockIdx.x - first) * 8 + wave, nw = ((int)gridDim.x - first) * 8;
    for (int id = wi; id < 4096; id += nw) {
        const int ty = id >> 11, bg = (id >> 7) & 15, tile = id & 127;
        const bf16_t* rp = KV6 + ((size_t)((ty ? 4 : 2) * 16 + bg) * T + tile * 64 + lane) * 64;
        float ssq = 0.f;
#pragma unroll
        for (int c = 0; c < 8; ++c) { const bf16x8 v = *(const bf16x8*)(rp + 8 * c);
#pragma unroll
            for (int j = 0; j < 8; ++j) { const float f = bf2f((bf16_t)v[j]); ssq += f * f; } }
        ssq = wave_max(ssq);
        if (lane == 0) TN2[id] = ssq;
    }
}
__device__ __forceinline__ void attn_qk2(LAS unsigned char* Kb, const bf16x8 (&q)[2][2], int fr, int g4, const float (&cinit)[2], f32x4 (&s)[2][4]) {
#pragma unroll
    for (int c = 0; c < 4; ++c) {
#pragma unroll
        for (int rb = 0; rb < 2; ++rb) s[rb][c] = (f32x4){cinit[rb], cinit[rb], cinit[rb], cinit[rb]};
#pragma unroll
        for (int ks = 0; ks < 2; ++ks) {
            const bf16x8 kf = *(const LAS bf16x8*)(Kb + pg8::lds_byte(16 * c + fr, 32 * ks + 8 * g4));
#pragma unroll
            for (int rb = 0; rb < 2; ++rb) s[rb][c] = __builtin_amdgcn_mfma_f32_16x16x32_bf16(kf, q[rb][ks], s[rb][c], 0, 0, 0);
        }
    }
}
__device__ __forceinline__ void attn_qk2m(LAS unsigned char* Kb, const bf16x8 (&q)[2][2], int fr, int g4, const float (&cinit)[2], f32x4 (&s)[2][4]) {
    bf16x8 kf[4][2];
#pragma unroll
    for (int c = 0; c < 4; ++c)
#pragma unroll
        for (int ks = 0; ks < 2; ++ks) kf[c][ks] = *(const LAS bf16x8*)(Kb + pg8::lds_byte(16 * c + fr, 32 * ks + 8 * g4));
    __builtin_amdgcn_sched_barrier(0);
    f32x4 ci[2];
#pragma unroll
    for (int rb = 0; rb < 2; ++rb) ci[rb] = (f32x4){cinit[rb], cinit[rb], cinit[rb], cinit[rb]};
#pragma unroll
    for (int c = 0; c < 4; ++c) {
#pragma unroll
        for (int ks = 0; ks < 2; ++ks) {
#pragma unroll
            for (int rb = 0; rb < 2; ++rb) s[rb][c] = __builtin_amdgcn_mfma_f32_16x16x32_bf16(kf[c][ks], q[rb][ks], ks == 0 ? ci[rb] : s[rb][c], 0, 0, 0);
        }
    }
}
__device__ __forceinline__ void attn_qk2z(LAS unsigned char* Kb, const bf16x8 (&q)[2][2], int fr, int g4, f32x4 (&s)[2][4]) {
    bf16x8 kf[4][2];
#pragma unroll
    for (int c = 0; c < 4; ++c)
#pragma unroll
        for (int ks = 0; ks < 2; ++ks) kf[c][ks] = *(const LAS bf16x8*)(Kb + pg8::lds_byte(16 * c + fr, 32 * ks + 8 * g4));
    __builtin_amdgcn_sched_barrier(0);
#pragma unroll
    for (int c = 0; c < 4; ++c) {
#pragma unroll
        for (int ks = 0; ks < 2; ++ks) {
#pragma unroll
            for (int rb = 0; rb < 2; ++rb) s[rb][c] = __builtin_amdgcn_mfma_f32_16x16x32_bf16(kf[c][ks], q[rb][ks], ks == 0 ? (f32x4){0.f, 0.f, 0.f, 0.f} : s[rb][c], 0, 0, 0);
        }
    }
}
struct AttnRow { float m; f32x4 o[4]; f32x4 ol; };
__device__ __forceinline__ float max3f(float a, float b, float c) { float r; asm("v_max3_f32 %0, %1, %2, %3" : "=v"(r) : "v"(a), "v"(b), "v"(c)); return r; }
__device__ __forceinline__ bool attn_sm2(f32x4 (&s)[4], AttnRow& st, int kbase, int g4, int lo, int hi, bool en, bool emask) {
    const float NEG = -INFINITY;
    if (emask) {
#pragma unroll
        for (int c = 0; c < 4; ++c)
#pragma unroll
            for (int i = 0; i < 4; ++i) { const int key = kbase + 16 * c + 4 * g4 + i; if (key < lo || key > hi) s[c][i] = NEG; }
    }
    float mx = max3f(s[0][0], s[0][1], s[0][2]); mx = max3f(mx, s[0][3], s[1][0]); mx = max3f(mx, s[1][1], s[1][2]); mx = max3f(mx, s[1][3], s[2][0]);
    mx = max3f(mx, s[2][1], s[2][2]); mx = max3f(mx, s[2][3], s[3][0]); mx = max3f(mx, s[3][1], s[3][2]); mx = max3f(mx, s[3][3], mx);
    if (!en) mx = NEG;
    mx = max3f(mx, __shfl_xor(mx, 16), mx); mx = max3f(mx, __shfl_xor(mx, 32), mx);
    const float delta = (mx > 20.0f) ? mx : 0.f;
    const bool moved = __builtin_amdgcn_ballot_w64(delta != 0.f) != 0ull;
    if (moved) {
        const float alpha = __builtin_amdgcn_exp2f(-delta);
#pragma unroll
        for (int c = 0; c < 4; ++c) s[c] = s[c] - delta;
#pragma unroll
        for (int dt = 0; dt < 4; ++dt) st.o[dt] *= alpha;
        st.ol *= alpha;
        st.m += delta;
    }
#pragma unroll
    for (int c = 0; c < 4; ++c)
#pragma unroll
        for (int i = 0; i < 4; ++i) s[c][i] = __builtin_amdgcn_exp2f(s[c][i]);
    return moved;
}
__device__ __forceinline__ bool attn_sm2x(f32x4 (&s)[2][4], AttnRow (&st)[2], int kbase, int g4, const int (&lo)[2], const int (&hi)[2], const bool (&en)[2], bool emask) {
    const float NEG = -INFINITY;
    if (emask) {
#pragma unroll
        for (int rb = 0; rb < 2; ++rb)
#pragma unroll
            for (int c = 0; c < 4; ++c)
#pragma unroll
                for (int i = 0; i < 4; ++i) { const int key = kbase + 16 * c + 4 * g4 + i; if (key < lo[rb] || key > hi[rb]) s[rb][c][i] = NEG; }
    }
    float mx[2];
#pragma unroll
    for (int rb = 0; rb < 2; ++rb) {
        float m = max3f(s[rb][0][0], s[rb][0][1], s[rb][0][2]); m = max3f(m, s[rb][0][3], s[rb][1][0]); m = max3f(m, s[rb][1][1], s[rb][1][2]); m = max3f(m, s[rb][1][3], s[rb][2][0]);
        m = max3f(m, s[rb][2][1], s[rb][2][2]); m = max3f(m, s[rb][2][3], s[rb][3][0]); m = max3f(m, s[rb][3][1], s[rb][3][2]); m = max3f(m, s[rb][3][3], m);
        mx[rb] = en[rb] ? m : NEG;
    }
    { const float t0 = __shfl_xor(mx[0], 16), t1 = __shfl_xor(mx[1], 16); mx[0] = max3f(mx[0], t0, t0); mx[1] = max3f(mx[1], t1, t1); }
    { const float t0 = __shfl_xor(mx[0], 32), t1 = __shfl_xor(mx[1], 32); mx[0] = max3f(mx[0], t0, t0); mx[1] = max3f(mx[1], t1, t1); }
    const float d0 = (mx[0] > 20.0f) ? mx[0] : 0.f, d1 = (mx[1] > 20.0f) ? mx[1] : 0.f;
    const bool moved = __builtin_amdgcn_ballot_w64((d0 != 0.f) || (d1 != 0.f)) != 0ull;
    if (moved) {
        const float dl[2] = {d0, d1};
#pragma unroll
        for (int rb = 0; rb < 2; ++rb) {
            const float alpha = __builtin_amdgcn_exp2f(-dl[rb]);
#pragma unroll
            for (int c = 0; c < 4; ++c) s[rb][c] = s[rb][c] - dl[rb];
#pragma unroll
            for (int dt = 0; dt < 4; ++dt) st[rb].o[dt] *= alpha;
            st[rb].ol *= alpha; st[rb].m += dl[rb];
        }
    }
#pragma unroll
    for (int rb = 0; rb < 2; ++rb)
#pragma unroll
        for (int c = 0; c < 4; ++c)
#pragma unroll
            for (int i = 0; i < 4; ++i) s[rb][c][i] = __builtin_amdgcn_exp2f(s[rb][c][i]);
    return moved;
}
__device__ __forceinline__ void attn_pv2x(LAS unsigned char* Vb, const f32x4 (&p)[2][4], int vlane, int swz, const unsigned (&enm)[2], const bool (&act)[2], const bf16x8 onesf, AttnRow (&st)[2]) {
#pragma unroll
    for (int ks = 0; ks < 2; ++ks) {
        bf16x8 pb[2];
#pragma unroll
        for (int rb = 0; rb < 2; ++rb) { u32x4 pw = pack8m(p[rb][2 * ks], p[rb][2 * ks + 1]); pw.x &= enm[rb]; pw.y &= enm[rb]; pw.z &= enm[rb]; pw.w &= enm[rb]; pb[rb] = __builtin_bit_cast(bf16x8, pw); }
#pragma unroll
        for (int dt = 0; dt < 4; ++dt) {
            LAS unsigned char* a0 = Vb + vlane + (2 * ks) * 2048 + ((dt ^ swz) * 32);
            const bf16x8 vf = tr_frag(a0, a0 + 2048);
#pragma unroll
            for (int rb = 0; rb < 2; ++rb) if (act[rb]) st[rb].o[dt] = __builtin_amdgcn_mfma_f32_16x16x32_bf16(vf, pb[rb], st[rb].o[dt], 0, 0, 0);
        }
#pragma unroll
        for (int rb = 0; rb < 2; ++rb) if (act[rb]) st[rb].ol = __builtin_amdgcn_mfma_f32_16x16x32_bf16(onesf, pb[rb], st[rb].ol, 0, 0, 0);
    }
}
__device__ __forceinline__ bool attn_max2x(f32x4 (&s)[2][4], int kbase, int g4, const int (&lo)[2], const int (&hi)[2], const bool (&en)[2], bool emask, float (&d)[2]) {
    const float NEG = -INFINITY;
    MFMA_SETTLE(s);
    if (emask) {
#pragma unroll
        for (int rb = 0; rb < 2; ++rb)
#pragma unroll
            for (int c = 0; c < 4; ++c)
#pragma unroll
                for (int i = 0; i < 4; ++i) { const int key = kbase + 16 * c + 4 * g4 + i; if (key < lo[rb] || key > hi[rb]) s[rb][c][i] = NEG; }
    }
    float mx[2];
#pragma unroll
    for (int rb = 0; rb < 2; ++rb) {
        float m = max3f(s[rb][0][0], s[rb][0][1], s[rb][0][2]); m = max3f(m, s[rb][0][3], s[rb][1][0]); m = max3f(m, s[rb][1][1], s[rb][1][2]); m = max3f(m, s[rb][1][3], s[rb][2][0]);
        m = max3f(m, s[rb][2][1], s[rb][2][2]); m = max3f(m, s[rb][2][3], s[rb][3][0]); m = max3f(m, s[rb][3][1], s[rb][3][2]); m = max3f(m, s[rb][3][3], m);
        mx[rb] = en[rb] ? m : NEG;
    }
    { const float t0 = __shfl_xor(mx[0], 16), t1 = __shfl_xor(mx[1], 16); mx[0] = max3f(mx[0], t0, t0); mx[1] = max3f(mx[1], t1, t1); }
    { const float t0 = __shfl_xor(mx[0], 32), t1 = __shfl_xor(mx[1], 32); mx[0] = max3f(mx[0], t0, t0); mx[1] = max3f(mx[1], t1, t1); }
    d[0] = (mx[0] > 20.0f) ? mx[0] : 0.f; d[1] = (mx[1] > 20.0f) ? mx[1] : 0.f;
    return __builtin_amdgcn_ballot_w64((d[0] != 0.f) || (d[1] != 0.f)) != 0ull;
}
__device__ __forceinline__ void attn_rescale2x(f32x4 (&s)[2][4], AttnRow (&st)[2], const float (&d)[2]) {
#pragma unroll
    for (int rb = 0; rb < 2; ++rb) {
        const float alpha = __builtin_amdgcn_exp2f(-d[rb]);
#pragma unroll
        for (int c = 0; c < 4; ++c) s[rb][c] = s[rb][c] - d[rb];
#pragma unroll
        for (int dt = 0; dt < 4; ++dt) st[rb].o[dt] *= alpha;
        st[rb].ol *= alpha; st[rb].m += d[rb];
    }
}
__device__ __forceinline__ void attn_exp1(f32x4 (&s)[4], unsigned enm, bf16x8 (&pb)[2]) {
#pragma unroll
    for (int c = 0; c < 4; ++c)
#pragma unroll
        for (int i = 0; i < 4; ++i) s[c][i] = __builtin_amdgcn_exp2f(s[c][i]);
#pragma unroll
    for (int ks = 0; ks < 2; ++ks) { u32x4 pw = pack8m(s[2 * ks], s[2 * ks + 1]); pw.x &= enm; pw.y &= enm; pw.z &= enm; pw.w &= enm; pb[ks] = __builtin_bit_cast(bf16x8, pw); }
}
__device__ __forceinline__ void attn_pv1(LAS unsigned char* Vb, const bf16x8 (&pb)[2], int vlane, int swz, const bf16x8 onesf, AttnRow& st) {
#pragma unroll
    for (int ks = 0; ks < 2; ++ks) {
#pragma unroll
        for (int dt = 0; dt < 4; ++dt) {
            LAS unsigned char* a0 = Vb + vlane + (2 * ks) * 2048 + ((dt ^ swz) * 32);
            const bf16x8 vf = tr_frag(a0, a0 + 2048);
            st.o[dt] = __builtin_amdgcn_mfma_f32_16x16x32_bf16(vf, pb[ks], st.o[dt], 0, 0, 0);
        }
        st.ol = __builtin_amdgcn_mfma_f32_16x16x32_bf16(onesf, pb[ks], st.ol, 0, 0, 0);
    }
}
__device__ __forceinline__ bool attn_step2x(LAS unsigned char* Vb, f32x4 (&s)[2][4], AttnRow (&st)[2], int kbase, int g4, const int (&lo)[2], const int (&hi)[2], const bool (&en)[2], const unsigned (&enm)[2], bool emask,
                                            int vlane, int swz, const bf16x8 onesf) {
    float d[2];
    const bool moved = attn_max2x(s, kbase, g4, lo, hi, en, emask, d);
    if (moved) attn_rescale2x(s, st, d);
    bf16x8 p0[2], p1[2];
    attn_exp1(s[0], enm[0], p0);
    attn_pv1(Vb, p0, vlane, swz, onesf, st[0]);
    attn_exp1(s[1], enm[1], p1);
    attn_pv1(Vb, p1, vlane, swz, onesf, st[1]);
    return moved;
}
__device__ __forceinline__ void attn_step2x_nomax(LAS unsigned char* Vb, f32x4 (&s)[2][4], AttnRow (&st)[2], int kbase, int g4, const int (&lo)[2], const int (&hi)[2], const unsigned (&enm)[2], bool emask,
                                                  int vlane, int swz, const bf16x8 onesf) {
    if (emask) {
#pragma unroll
        for (int rb = 0; rb < 2; ++rb)
#pragma unroll
            for (int c = 0; c < 4; ++c)
#pragma unroll
                for (int i = 0; i < 4; ++i) { const int key = kbase + 16 * c + 4 * g4 + i; if (key < lo[rb] || key > hi[rb]) s[rb][c][i] = -INFINITY; }
    }
    bf16x8 p0[2], p1[2];
    attn_exp1(s[0], enm[0], p0);
    attn_pv1(Vb, p0, vlane, swz, onesf, st[0]);
    attn_exp1(s[1], enm[1], p1);
    attn_pv1(Vb, p1, vlane, swz, onesf, st[1]);
}
typedef _Float16 f16x4 __attribute__((ext_vector_type(4)));
constexpr int AT4_KB = 0, AT4_VB = 32768, AT2_PS = 65536, AT2_MSK = 65536 + 65536;
__device__ __forceinline__ int attn_pair_of(int pr) { const int p = pr & 63, k = pr >> 8; const int q = (k & 2) ? ((p + 32) & 63) : p; return (k & 1) ? 63 - q : q; }
__device__ __forceinline__ void ph_attn_fast2(const Args& a, LAS unsigned char* lds) {
    const bf16_t* QN = (const bf16_t*)(a.ws + WS_HN);
    const bf16_t* QR = (const bf16_t*)(a.ws + WS_QR);
    const bf16_t* KV6 = (const bf16_t*)(a.ws + WS_KV6);
    const float* GATES = (const float*)(a.ws + WS_GATES);
    const bf16_t* KC = (const bf16_t*)(a.ws + WS_KC);
    const bf16_t* VC = KC + (size_t)8192 * 64;
    bf16_t* O = (bf16_t*)(a.ws + WS_O);
    const int tid = threadIdx.x, lane = tid & 63, wave = __builtin_amdgcn_readfirstlane(tid >> 6);
    const int fr = lane & 15, g4 = lane >> 4;
    int ksrc, vsrc;
    { int R, C; pg8::stage_rc(wave * 1024 + lane * 16, R, C); ksrc = R * 64 + C;
      const int key = 8 * wave + (lane >> 3), pos = lane & 7, chunk = (pos >> 1) ^ ((key >> 1) & 3); vsrc = key * 64 + (chunk * 2 + (pos & 1)) * 8; }
    const int vlane = (4 * g4 + (fr >> 2)) * 128 + (fr & 3) * 8, swz = (2 * g4 + (fr >> 3)) & 3;
    LAS _Float16* ps = (LAS _Float16*)(lds + AT2_PS + wave * 8192);
    LAS unsigned* mskl = (LAS unsigned*)(lds + AT2_MSK + wave * 128);
    const float NEG = -INFINITY;
    const bf16x8 onesf = (fr == 0) ? (bf16x8){0x3F80, 0x3F80, 0x3F80, 0x3F80, 0x3F80, 0x3F80, 0x3F80, 0x3F80} : (bf16x8){0, 0, 0, 0, 0, 0, 0, 0};
    const int vcu = (gridDim.x % 8 == 0) ? (int)((blockIdx.x % 8) * (gridDim.x / 8) + blockIdx.x / 8) : (int)blockIdx.x;
    int cvt_next = (int)blockIdx.x * 8 + wave; const int cvt_stride = (int)gridDim.x * 8;
    LAS float* cvt_scr = (LAS float*)(lds + AT2_PS + wave * 8448);
    bool cmp_pref = false;
    for (int pr = vcu; pr < 1024; pr += gridDim.x) {
#pragma unroll 1
        for (int half = 0; half < 2; ++half) {
            const int bg = pr >> 6, pp = attn_pair_of(pr), cc = half ? (127 - pp) : pp;
            const int b = bg >> 2, g = bg & 3, t0 = cc * 64, cur = cc;
            const int head = g * 4 + (fr & 3);
            int trow[2];
            bf16x8 qn[2][2];
#pragma unroll
            for (int rb = 0; rb < 2; ++rb) {
                trow[rb] = t0 + 8 * wave + 4 * rb + (fr >> 2);
#pragma unroll
                for (int ks = 0; ks < 2; ++ks) qn[rb][ks] = *(const bf16x8*)(QN + ((size_t)b * T + trow[rb]) * 1024 + head * 64 + 32 * ks + 8 * g4);
            }
#define TROW_PIN() asm volatile("" : "+v"(trow[0]), "+v"(trow[1]))
#define TOKROW(rb) ((size_t)b * T + trow[rb])
#define GATE(rb, br) (GATES[TOKROW(rb) * 48 + head * 3 + (br)])
            const bf16_t* kcb = KC + (size_t)bg * 512 * 64;
            const bf16_t* kvb = KV6 + (size_t)bg * T * 64;
#define ATK(sl) (((sl) < 4 ? AT4_KB : AT2_PS - 4 * 8192) + (sl) * 8192)
#define ATV(sl) (((sl) < 4 ? AT4_VB : AT2_PS + 32768 - 4 * 8192) + (sl) * 8192)
#define AT_DMA(BR, tile, slot) do { const bf16_t* kp_; const bf16_t* vp_; \
                if ((BR) == 0) { kp_ = kcb + (size_t)(tile) * 4096; vp_ = kp_ + (size_t)8192 * 64; } \
                else { kp_ = kvb + (size_t)((BR) == 1 ? 2 : 4) * 16 * T * 64 + (size_t)(tile) * 4096; vp_ = kp_ + (size_t)16 * T * 64; } \
                __builtin_amdgcn_global_load_lds((const unsigned*)(kp_ + ksrc), (LAS unsigned*)(lds + ATK(slot) + wave * 1024), 16, 0, 0); \
                __builtin_amdgcn_global_load_lds((const unsigned*)(vp_ + vsrc), (LAS unsigned*)(lds + ATV(slot) + wave * 1024), 16, 0, 0); } while (0)
            int ncv[2];
#pragma unroll
            for (int rb = 0; rb < 2; ++rb) ncv[rb] = (trow[rb] >= 31) ? ((trow[rb] - 31) / 16 + 1) : 0;
            const int nct = (((t0 + 63 - 31) / 16 + 1) + 63) >> 6;
            float mc[2], invc[2];
            const int t_lo = t0 + 8 * wave, ncv_lo = (t_lo >= 31) ? ((t_lo - 31) / 16 + 1) : 0;
            {
                float m1[2] = {NEG, NEG}, l1[2] = {0.f, 0.f};
                const float zero2[2] = {0.f, 0.f};
#define CMP1_TILE(J, SLOT, MASKED) do { const int j = (J); const int SLOT_ = (SLOT); \
                    f32x4 s[2][4]; attn_qk2(lds + AT4_KB + SLOT_ * 8192, qn, fr, g4, zero2, s); \
                    _Pragma("unroll") \
                    for (int rb = 0; rb < 2; ++rb) { \
                        float mx = NEG; \
                    _Pragma("unroll") \
                        for (int c = 0; c < 4; ++c) \
                    _Pragma("unroll") \
                            for (int i = 0; i < 4; ++i) { const int n = 64 * j + 16 * c + 4 * g4 + i; if ((MASKED) && n >= ncv[rb]) s[rb][c][i] = NEG; mx = fmaxf(mx, s[rb][c][i]); } \
                        mx = fmaxf(mx, __shfl_xor(mx, 16)); mx = fmaxf(mx, __shfl_xor(mx, 32)); \
                        const float mn = fmaxf(m1[rb], mx), msafe = (mn == NEG) ? 0.f : mn; \
                        const float alpha = (m1[rb] == NEG) ? 0.f : __builtin_amdgcn_exp2f(m1[rb] - msafe); \
                        float sum = 0.f; \
                    _Pragma("unroll") \
                        for (int c = 0; c < 4; ++c) \
                    _Pragma("unroll") \
                            for (int i = 0; i < 4; ++i) sum += __builtin_amdgcn_exp2f(s[rb][c][i] - msafe); \
                        l1[rb] = l1[rb] * alpha + sum; m1[rb] = mn; \
                    } \
                } while (0)
                if (!cmp_pref) { AT_DMA(0, 0, 0); if (nct > 1) AT_DMA(0, 1, 1); } __syncthreads();
                for (int j0 = 0; j0 < nct; j0 += 2) { const int sb = (j0 & 2);
                    if (j0 + 2 < nct) AT_DMA(0, j0 + 2, sb ^ 2);
                    if (j0 + 3 < nct) AT_DMA(0, j0 + 3, (sb ^ 2) + 1);
                    CMP1_TILE(j0, sb, true); if (j0 + 1 < nct) CMP1_TILE(j0 + 1, sb + 1, true);
                    __syncthreads();
                }
#undef CMP1_TILE
#pragma unroll
                for (int rb = 0; rb < 2; ++rb) { float lc = l1[rb]; lc += __shfl_xor(lc, 16); lc += __shfl_xor(lc, 32); invc[rb] = (lc > 0.f) ? -(((m1[rb] == NEG) ? 0.f : m1[rb]) + __builtin_amdgcn_logf(lc)) : 0.f; mc[rb] = (m1[rb] == NEG) ? 0.f : m1[rb]; }
            }
            {
                AttnRow oc[2];
#pragma unroll
                for (int rb = 0; rb < 2; ++rb) { oc[rb].m = 0.f; oc[rb].ol = (f32x4){0.f, 0.f, 0.f, 0.f};
#pragma unroll
                    for (int dt = 0; dt < 4; ++dt) oc[rb].o[dt] = (f32x4){0.f, 0.f, 0.f, 0.f}; }
                const float cin[2] = {invc[0], invc[1]};
                const unsigned full[2] = {0xffffffffu, 0xffffffffu}; const bool both[2] = {true, true};
#define CMP2_TILE(J, SLOT, MASKED) do { const int j = (J); const int SLOT_ = (SLOT); \
                    f32x4 s[2][4]; attn_qk2(lds + AT4_KB + SLOT_ * 8192, qn, fr, g4, cin, s); \
                    _Pragma("unroll") \
                    for (int rb = 0; rb < 2; ++rb) \
                    _Pragma("unroll") \
                        for (int c = 0; c < 4; ++c) { \
                            f16x4 hs; \
                    _Pragma("unroll") \
                            for (int i = 0; i < 4; ++i) { const int n = 64 * j + 16 * c + 4 * g4 + i; const float p = (!(MASKED) || n < ncv[rb]) ? __builtin_amdgcn_exp2f(s[rb][c][i]) : 0.f; s[rb][c][i] = p; \
                                float h = p; h += DPP_F(h, 0xB1); h += DPP_F(h, 0x4E); hs[i] = (_Float16)h; }        \
                            if ((fr & 3) == 0) *(LAS f16x4*)(ps + (4 * rb + (fr >> 2)) * 512 + 64 * j + 16 * c + 4 * g4) = hs; \
                        } \
                    attn_pv2x(lds + AT4_VB + SLOT_ * 8192, s, vlane, swz, full, both, onesf, oc); \
                } while (0)
                const bool reload = nct > 4;
                if (reload) { AT_DMA(0, 0, 0); AT_DMA(0, 1, 1); __syncthreads(); }
                for (int j0 = 0; j0 < nct; j0 += 2) { const int sb = (j0 & 2);
                    if (reload && j0 + 2 < nct) AT_DMA(0, j0 + 2, sb ^ 2);
                    if (reload && j0 + 3 < nct) AT_DMA(0, j0 + 3, (sb ^ 2) + 1);
                    CMP2_TILE(j0, sb, true); if (j0 + 1 < nct) CMP2_TILE(j0 + 1, sb + 1, true);
                    __syncthreads();
                }
#undef CMP2_TILE
                TROW_PIN();
#pragma unroll
                for (int rb = 0; rb < 2; ++rb) { bf16_t* op = O + TOKROW(rb) * 1024 + head * 64 + 4 * g4; const float g0 = GATE(rb, 0);
#pragma unroll
                    for (int dt = 0; dt < 4; ++dt) { const f32x4 v = oc[rb].o[dt] * g0; u32x2 w; w.x = cvt_pk_bf16(v[0], v[1]); w.y = cvt_pk_bf16(v[2], v[3]); *(u32x2*)(op + 16 * dt) = w; } }
            }
            {
                WSYNC();
                const int tl = lane >> 4, li = lane & 15;
                const int nsel = (cur + 1 < 16) ? (cur + 1) : 16;
#pragma unroll 1
                for (int rnd = 0; rnd < 2; ++rnd) {
                    const LAS _Float16* pst = ps + (4 * rnd + tl) * 512;
                    float v[8];
#pragma unroll
                    for (int k = 0; k < 8; ++k) { const int j = li + 16 * k;
                        float x;
                        if (j > cur) x = NEG;
                        else if (j == 0 || j == cur || j == cur - 1) x = NEG;
                        else { const int n0 = 4 * j; x = (float)pst[n0 - 1] + 2.0f * ((float)pst[n0] + (float)pst[n0 + 1] + (float)pst[n0 + 2]) + (float)pst[n0 + 3]; }
                        v[k] = x; }
                    int vi[8];
#pragma unroll
                    for (int k = 0; k < 8; ++k) vi[k] = __builtin_bit_cast(int, v[k]);
                    unsigned mm[4] = {1u, 0u, 0u, 0u};
                    {
                        const unsigned bc = 1u << (cur & 31); const int wc_ = cur >> 5;
                        mm[0] |= (wc_ == 0) ? bc : 0u; mm[1] |= (wc_ == 1) ? bc : 0u; mm[2] |= (wc_ == 2) ? bc : 0u; mm[3] |= (wc_ == 3) ? bc : 0u;
                        if (cur >= 1) { const unsigned bp = 1u << ((cur - 1) & 31); const int wp_ = (cur - 1) >> 5;
                            mm[0] |= (wp_ == 0) ? bp : 0u; mm[1] |= (wp_ == 1) ? bp : 0u; mm[2] |= (wp_ == 2) ? bp : 0u; mm[3] |= (wp_ == 3) ? bp : 0u; }
                    }
                    const int nforced = (cur >= 2) ? 3 : (cur + 1);
                    for (int it = 0; it < nsel - nforced; ++it) {
                        int bv = max(max(max(vi[0], vi[1]), max(vi[2], vi[3])), max(max(vi[4], vi[5]), max(vi[6], vi[7])));
                        bv = max(bv, DPP_I(bv, 0xB1)); bv = max(bv, DPP_I(bv, 0x4E)); bv = max(bv, DPP_I(bv, 0x141)); bv = max(bv, DPP_I(bv, 0x140));
                        int bi = 255;
#pragma unroll
                        for (int k = 7; k >= 0; --k) bi = (vi[k] == bv) ? (li + 16 * k) : bi;
                        bi = min(bi, DPP_I(bi, 0xB1)); bi = min(bi, DPP_I(bi, 0x4E)); bi = min(bi, DPP_I(bi, 0x141)); bi = min(bi, DPP_I(bi, 0x140));
                        const unsigned bit = 1u << (bi & 31); const int wsel = bi >> 5;
                        mm[0] |= (wsel == 0) ? bit : 0u; mm[1] |= (wsel == 1) ? bit : 0u; mm[2] |= (wsel == 2) ? bit : 0u; mm[3] |= (wsel == 3) ? bit : 0u;
                        if ((bi & 15) == li) {
#pragma unroll
                            for (int k = 0; k < 8; ++k) if ((bi >> 4) == k) vi[k] = (int)0xFF800000;
                        }
                    }
                    if (li == 0) { mskl[(4 * rnd + tl) * 4 + 0] = mm[0]; mskl[(4 * rnd + tl) * 4 + 1] = mm[1]; mskl[(4 * rnd + tl) * 4 + 2] = mm[2]; mskl[(4 * rnd + tl) * 4 + 3] = mm[3]; }
                }
                WSYNC();
            }
            bf16x8 qr[2][2];
            TROW_PIN();
#pragma unroll
            for (int rb = 0; rb < 2; ++rb)
#pragma unroll
                for (int ks = 0; ks < 2; ++ks) qr[rb][ks] = *(const bf16x8*)(QR + TOKROW(rb) * 1024 + head * 64 + 32 * ks + 8 * g4);
            bool nomax_slc, nomax_win;
            {
                float qq = 0.f;
#pragma unroll
                for (int rb = 0; rb < 2; ++rb) { float q2 = 0.f;
#pragma unroll
                    for (int ks = 0; ks < 2; ++ks)
#pragma unroll
                        for (int j = 0; j < 8; ++j) { const float x = bf2f((bf16_t)qr[rb][ks][j]); q2 += x * x; }
                    q2 += __shfl_xor(q2, 16); q2 += __shfl_xor(q2, 32); qq = fmaxf(qq, q2); }
                qq = wave_max(qq);
                const float* tn = (const float*)(a.ws + WS_MISC + TN2_OFF) + bg * 128;
                const int jt0w = (t0 >= 511) ? ((t0 - 511) >> 6) : 0;
                float ts = 0.f, tw = 0.f;
#pragma unroll
                for (int h2 = 0; h2 < 2; ++h2) { const int tl_ = lane + 64 * h2; if (tl_ <= cur) { ts = fmaxf(ts, tn[tl_]); if (tl_ >= jt0w) tw = fmaxf(tw, tn[2048 + tl_]); } }
                ts = wave_max(ts); tw = wave_max(tw);
                nomax_slc = __builtin_amdgcn_readfirstlane((qq * ts <= 3500.0f) ? 1 : 0) != 0;
                nomax_win = __builtin_amdgcn_readfirstlane((qq * tw <= 3500.0f) ? 1 : 0) != 0;
            }
            {
                AttnRow ss[2];
#pragma unroll
                for (int rb = 0; rb < 2; ++rb) { ss[rb].m = 0.f; ss[rb].ol = (f32x4){0.f, 0.f, 0.f, 0.f};
#pragma unroll
                    for (int dt = 0; dt < 4; ++dt) ss[rb].o[dt] = (f32x4){0.f, 0.f, 0.f, 0.f}; }
                const int nt_ = cur + 1;
                bool refmoved = false;
#define SLC_PRE(J) const int j_ = (J); bool en[2], act[2]; unsigned enm[2]; \
                    _Pragma("unroll") for (int rb = 0; rb < 2; ++rb) { const unsigned mw = mwg[rb]; \
                        en[rb] = (mw >> (j_ & 31)) & 1u; act[rb] = __any(en[rb]); enm[rb] = en[rb] ? 0xffffffffu : 0u; } const int lo2[2] = {0, 0};
#define SLC_TILE(J, SLOT) do { SLC_PRE(J) \
                    if (act[0] || act[1]) { f32x4 s[2][4]; \
                        if (refmoved) { const float cin[2] = {-ss[0].m, -ss[1].m}; attn_qk2(lds + ATK(SLOT), qr, fr, g4, cin, s); } \
                        else attn_qk2z(lds + ATK(SLOT), qr, fr, g4, s); \
                        refmoved |= attn_step2x(lds + ATV(SLOT), s, ss, 64 * j_, g4, lo2, trow, en, enm, j_ == cur, vlane, swz, onesf); } } while (0)
#define SLC_TILE_NM(J, SLOT) do { SLC_PRE(J) \
                    if (act[0] || act[1]) { f32x4 s[2][4]; const float cm_[2] = {en[0] ? 0.f : -1e30f, en[1] ? 0.f : -1e30f}; attn_qk2m(lds + ATK(SLOT), qr, fr, g4, cm_, s); \
                        const unsigned fullm_[2] = {0xffffffffu, 0xffffffffu}; \
                        attn_step2x_nomax(lds + ATV(SLOT), s, ss, 64 * j_, g4, lo2, trow, fullm_, j_ == cur, vlane, swz, onesf); } } while (0)
#pragma unroll
                for (int i = 0; i < 4; ++i) if (i < nt_) AT_DMA(1, i, i);
                __syncthreads();
#define SLC_LOOP(TILE) for (int j0 = 0; j0 < nt_; j0 += 4) { const int sb = (j0 & 4); \
                    const unsigned mwg[2] = {mskl[(fr >> 2) * 4 + (j0 >> 5)], mskl[(4 + (fr >> 2)) * 4 + (j0 >> 5)]};       \
                    _Pragma("unroll") for (int i = 0; i < 4; ++i) if (j0 + 4 + i < nt_) AT_DMA(1, j0 + 4 + i, (sb ^ 4) + i); \
                    TILE(j0, sb); if (j0 + 1 < nt_) TILE(j0 + 1, sb + 1); if (j0 + 2 < nt_) TILE(j0 + 2, sb + 2); if (j0 + 3 < nt_) TILE(j0 + 3, sb + 3); \
                    __syncthreads(); }
                if (nomax_slc) { SLC_LOOP(SLC_TILE_NM) } else { SLC_LOOP(SLC_TILE) }
#undef SLC_LOOP
#undef SLC_TILE_NM
#undef SLC_PRE
#undef SLC_TILE
                TROW_PIN();
#pragma unroll
                for (int rb = 0; rb < 2; ++rb) { const float l = __shfl(ss[rb].ol[0], fr); const float sc1 = (l > 0.f) ? GATE(rb, 1) / l : 0.f;
                    bf16_t* op = O + TOKROW(rb) * 1024 + head * 64 + 4 * g4;
#pragma unroll
                    for (int dt = 0; dt < 4; ++dt) { const u32x2 pv = *(const u32x2*)(op + 16 * dt); f32x4 v = ss[rb].o[dt] * sc1;
                        v[0] += __uint_as_float(pv.x << 16); v[1] += __uint_as_float(pv.x & 0xffff0000u); v[2] += __uint_as_float(pv.y << 16); v[3] += __uint_as_float(pv.y & 0xffff0000u);
                        u32x2 w; w.x = cvt_pk_bf16(v[0], v[1]); w.y = cvt_pk_bf16(v[2], v[3]); *(u32x2*)(op + 16 * dt) = w; } }
            }
            {
                AttnRow sw[2];
#pragma unroll
                for (int rb = 0; rb < 2; ++rb) { sw[rb].m = 0.f; sw[rb].ol = (f32x4){0.f, 0.f, 0.f, 0.f};
#pragma unroll
                    for (int dt = 0; dt < 4; ++dt) sw[rb].o[dt] = (f32x4){0.f, 0.f, 0.f, 0.f}; }
                const int jt0 = (t0 >= 511) ? ((t0 - 511) >> 6) : 0;
                const int nt_ = cur - jt0 + 1;
                const unsigned full[2] = {0xffffffffu, 0xffffffffu}; const bool both[2] = {true, true};
                bool refmoved = false;
#define WIN_PRE(JJ) const int j = jt0 + (JJ); f32x4 s[2][4]; const bool edge = (j == cur) || (64 * j < t0 + 63 - 511); const int lo2[2] = {trow[0] - 511, trow[1] - 511};
#define WIN_TILE(JJ, SLOT) do { WIN_PRE(JJ) \
                    if (refmoved) { const float cin[2] = {-sw[0].m, -sw[1].m}; attn_qk2(lds + AT4_KB + (SLOT) * 8192, qr, fr, g4, cin, s); } \
                    else attn_qk2z(lds + AT4_KB + (SLOT) * 8192, qr, fr, g4, s); \
                    refmoved |= attn_step2x(lds + AT4_VB + (SLOT) * 8192, s, sw, 64 * j, g4, lo2, trow, both, full, edge, vlane, swz, onesf); } while (0)
#define WIN_TILE_NM(JJ, SLOT) do { WIN_PRE(JJ) attn_qk2z(lds + AT4_KB + (SLOT) * 8192, qr, fr, g4, s); \
                    attn_step2x_nomax(lds + AT4_VB + (SLOT) * 8192, s, sw, 64 * j, g4, lo2, trow, full, edge, vlane, swz, onesf); } while (0)
                AT_DMA(2, jt0, 0); if (nt_ > 1) AT_DMA(2, jt0 + 1, 1); __syncthreads();
#define WIN_LOOP(TILE) for (int j0 = 0; j0 < nt_; j0 += 2) { const int sb = (j0 & 2); \
                    if (j0 + 2 < nt_) AT_DMA(2, jt0 + j0 + 2, sb ^ 2); \
                    if (j0 + 3 < nt_) AT_DMA(2, jt0 + j0 + 3, (sb ^ 2) + 1); \
                    TILE(j0, sb); if (j0 + 1 < nt_) TILE(j0 + 1, sb + 1); \
                    __syncthreads(); }
                if (nomax_win) { WIN_LOOP(WIN_TILE_NM) } else { WIN_LOOP(WIN_TILE) }
#undef WIN_LOOP
#undef WIN_TILE_NM
#undef WIN_PRE
#undef WIN_TILE
                TROW_PIN();
#pragma unroll
                for (int rb = 0; rb < 2; ++rb) { const float l = __shfl(sw[rb].ol[0], fr); const float sc2 = (l > 0.f) ? GATE(rb, 2) / l : 0.f;
                    bf16_t* op = O + TOKROW(rb) * 1024 + head * 64 + 4 * g4;
                    unsigned char* o8 = (unsigned char*)(a.ws + WS_O8) + TOKROW(rb) * 1024 + head * 64 + 4 * g4;
#pragma unroll
                    for (int dt = 0; dt < 4; ++dt) { const u32x2 pv = *(const u32x2*)(op + 16 * dt); f32x4 v = sw[rb].o[dt] * sc2;
                        v[0] += __uint_as_float(pv.x << 16); v[1] += __uint_as_float(pv.x & 0xffff0000u); v[2] += __uint_as_float(pv.y << 16); v[3] += __uint_as_float(pv.y & 0xffff0000u);
                        *(unsigned*)(o8 + 16 * dt) = pk4_fp8(clamp8(v[0] * X8_SCALE), clamp8(v[1] * X8_SCALE), clamp8(v[2] * X8_SCALE), clamp8(v[3] * X8_SCALE)); } }
            }
#undef AT_DMA
#undef ATK
#undef ATV
#undef TROW_PIN
#undef TOKROW
#undef GATE
            {
                const int npr = half ? pr + (int)gridDim.x : pr, nhalf = half ^ 1;
                cmp_pref = npr < 1024;
                if (cmp_pref) { const int nbg = npr >> 6, npp = attn_pair_of(npr), ncc = nhalf ? (127 - npp) : npp;
                    const int nnct = (((ncc * 64 + 63 - 31) / 16 + 1) + 63) >> 6;
                    const bf16_t* nk = KC + (size_t)nbg * 512 * 64;
                    __builtin_amdgcn_global_load_lds((const unsigned*)(nk + ksrc), (LAS unsigned*)(lds + AT4_KB + wave * 1024), 16, 0, 0);
                    __builtin_amdgcn_global_load_lds((const unsigned*)(nk + (size_t)8192 * 64 + vsrc), (LAS unsigned*)(lds + AT4_VB + wave * 1024), 16, 0, 0);
                    if (nnct > 1) {
                        __builtin_amdgcn_global_load_lds((const unsigned*)(nk + 4096 + ksrc), (LAS unsigned*)(lds + AT4_KB + 8192 + wave * 1024), 16, 0, 0);
                        __builtin_amdgcn_global_load_lds((const unsigned*)(nk + (size_t)8192 * 64 + 4096 + vsrc), (LAS unsigned*)(lds + AT4_VB + 8192 + wave * 1024), 16, 0, 0); } } }
            cvt1_run(a, cvt_next, cvt_stride, 2, cvt_scr, lane);
        }
    }
    cvt1_run(a, cvt_next, cvt_stride, 1 << 20, cvt_scr, lane);
}

__device__ __forceinline__ void unpack8(const u32x4 w, float (&f)[8]) {
    f[0] = __uint_as_float(w.x << 16); f[1] = __uint_as_float(w.x & 0xffff0000u); f[2] = __uint_as_float(w.y << 16); f[3] = __uint_as_float(w.y & 0xffff0000u);
    f[4] = __uint_as_float(w.z << 16); f[5] = __uint_as_float(w.z & 0xffff0000u); f[6] = __uint_as_float(w.w << 16); f[7] = __uint_as_float(w.w & 0xffff0000u);
}
__device__ __forceinline__ void ph_convpool_fast(const Args& a, LAS unsigned char* lds) {
    const bf16_t* H0 = (const bf16_t*)(a.ws + WS_H0);
    bf16_t* CAT = (bf16_t*)(a.ws + WS_CAT);
    const float* cw = a.in[4]; const float* cb = a.in[5]; const float* lg = a.in[6]; const float* lb = a.in[7];
    const int tid = threadIdx.x, lane = tid & 63, wave = tid >> 6, ch = lane * 8;
    constexpr int VT_OFF = 0, UT_OFF = 62 * 1024, CW_OFF = UT_OFF + 47 * 1024;
    for (int i = tid; i < 31 * 64; i += 512) { const int k = i >> 6, c8 = (i & 63) * 8;
        const f32x4 w0 = *(const f32x4*)(cw + k * 512 + c8), w1 = *(const f32x4*)(cw + k * 512 + c8 + 4);
        u32x4 o; o.x = pk2(w0[0], w0[1]); o.y = pk2(w0[2], w0[3]); o.z = pk2(w1[0], w1[1]); o.w = pk2(w1[2], w1[3]);
        *(LAS u32x4*)(lds + CW_OFF + k * 1024 + c8 * 2) = o; }
    float bias[8], gam[8], bet[8];
#pragma unroll
    for (int j = 0; j < 8; ++j) { bias[j] = cb[ch + j]; gam[j] = lg[ch + j]; bet[j] = lb[ch + j]; }
    for (int tile = blockIdx.x; tile < M / 32; tile += gridDim.x) {
        const int tok0 = tile * 32, t0 = tok0 & (T - 1);
        __syncthreads();
        for (int i = tid; i < 62 * 64; i += 512) { const int r = i >> 6, c8 = (i & 63) * 8; const int tt = t0 - 30 + r;
            u32x4 v = (u32x4){0u, 0u, 0u, 0u}; if (tt >= 0) v = *(const u32x4*)(H0 + (size_t)(tok0 - 30 + r) * 1024 + 512 + c8);
            *(LAS u32x4*)(lds + VT_OFF + r * 1024 + c8 * 2) = v; }
        for (int i = tid; i < 47 * 64; i += 512) { const int r = i >> 6, c8 = (i & 63) * 8; const int tt = t0 - 15 + r;
            u32x4 v = (u32x4){0u, 0u, 0u, 0u}; if (tt >= 0) v = *(const u32x4*)(H0 + (size_t)(tok0 - 15 + r) * 1024 + c8);
            *(LAS u32x4*)(lds + UT_OFF + r * 1024 + c8 * 2) = v; }
        __syncthreads();
        float acc[4][8];
#pragma unroll
        for (int j = 0; j < 4; ++j)
#pragma unroll
            for (int c = 0; c < 8; ++c) acc[j][c] = bias[c];
#pragma unroll 1
        for (int k = 0; k < 31; ++k) {
            float w[8]; unpack8(*(const LAS u32x4*)(lds + CW_OFF + k * 1024 + ch * 2), w);
#pragma unroll
            for (int j = 0; j < 4; ++j) { float v[8]; unpack8(*(const LAS u32x4*)(lds + VT_OFF + (4 * wave + j + k) * 1024 + ch * 2), v);
#pragma unroll
                for (int c = 0; c < 8; ++c) acc[j][c] += w[c] * v[c]; }
        }
        const int wnd = 2 << (lane >> 4);
#pragma unroll
        for (int j = 0; j < 4; ++j) {
            const int tl = 4 * wave + j, t = t0 + tl; const size_t tok = (size_t)tok0 + tl;
            const int cnt = (t + 1 < wnd) ? (t + 1) : wnd;
            float s[8], self[8];
            unpack8(*(const LAS u32x4*)(lds + UT_OFF + (15 + tl) * 1024 + ch * 2), self);
#pragma unroll
            for (int c = 0; c < 8; ++c) s[c] = self[c];
            for (int k = 1; k < cnt; ++k) { float v[8]; unpack8(*(const LAS u32x4*)(lds + UT_OFF + (15 + tl - k) * 1024 + ch * 2), v);
#pragma unroll
                for (int c = 0; c < 8; ++c) s[c] += v[c]; }
            const float inv = 1.0f / (float)cnt;
            u32x4 o; o.x = pk2(s[0] * inv - self[0], s[1] * inv - self[1]); o.y = pk2(s[2] * inv - self[2], s[3] * inv - self[3]);
            o.z = pk2(s[4] * inv - self[4], s[5] * inv - self[5]); o.w = pk2(s[6] * inv - self[6], s[7] * inv - self[7]);
            *(u32x4*)(CAT + tok * 1024 + ch) = o;
            float sm = 0.f;
#pragma unroll
            for (int c = 0; c < 8; ++c) sm += acc[j][c];
            const float mean = wave_sum(sm) * (1.0f / 512.0f);
            float sq = 0.f;
#pragma unroll
            for (int c = 0; c < 8; ++c) { acc[j][c] -= mean; sq += acc[j][c] * acc[j][c]; }
            const float rstd = rsqrtf(wave_sum(sq) * (1.0f / 512.0f) + LN_EPS);
            float y[8];
#pragma unroll
            for (int c = 0; c < 8; ++c) { const float z = acc[j][c] * rstd * gam[c] + bet[c]; y[c] = z * sigmoidf_(z); }
            u32x4 o2; o2.x = pk2(y[0], y[1]); o2.y = pk2(y[2], y[3]); o2.z = pk2(y[4], y[5]); o2.w = pk2(y[6], y[7]);
            *(u32x4*)(CAT + tok * 1024 + 512 + ch) = o2;
        }
    }
}


__device__ __forceinline__ void ph_route_fast(const float* LOG, const float* bias, unsigned* gcnt, int2* list, unsigned char* ldsg) {
    unsigned* hist = (unsigned*)ldsg; unsigned* base = hist + 256; u32x2* sel = (u32x2*)(ldsg + 2048);
    const int tid = threadIdx.x, lane = tid & 63, wave = tid >> 6;
    const float NEG = -INFINITY;
    const float4 bb = *(const float4*)(bias + lane * 4);
    for (int chunk = blockIdx.x; chunk < M / 128; chunk += gridDim.x) {
        __syncthreads();
        if (tid < 256) hist[tid] = 0u;
        __syncthreads();
        for (int i = 0; i < 16; ++i) {
            const int tl = wave * 16 + i, tok = chunk * 128 + tl;
            const float4 lg = *(const float4*)(LOG + (size_t)tok * 256 + lane * 4);
            const float s0 = sigmoidf_(lg.x), s1 = sigmoidf_(lg.y), s2 = sigmoidf_(lg.z), s3 = sigmoidf_(lg.w);
            float v0 = s0 + bb.x, v1 = s1 + bb.y, v2 = s2 + bb.z, v3 = s3 + bb.w;
            float m1 = fmaxf(v0, v1), m2 = fminf(v0, v1);
            { const float hi = fmaxf(v2, v3), lo = fminf(v2, v3); const float n1 = fmaxf(m1, hi); const float n2 = fmaxf(fminf(m1, hi), fmaxf(m2, lo)); m1 = n1; m2 = n2; }
#pragma unroll
            for (int o = 1; o < 8; o <<= 1) { const float a1 = __shfl_xor(m1, o), a2 = __shfl_xor(m2, o); const float n1 = fmaxf(m1, a1), n2 = fmaxf(fminf(m1, a1), fmaxf(m2, a2)); m1 = n1; m2 = n2; }
            const float gs = m1 + m2; const int mygrp = lane >> 3;
            int rank = 0;
#pragma unroll
            for (int g2 = 0; g2 < 8; ++g2) { const float og = __shfl(gs, g2 * 8); rank += (og > gs || (og == gs && g2 < mygrp)) ? 1 : 0; }
            if (rank >= 4) { v0 = NEG; v1 = NEG; v2 = NEG; v3 = NEG; }
            int my_e = 0; float my_s = 0.f;
#pragma unroll
            for (int it = 0; it < 8; ++it) {
                float bv = v0; int bj = 0;
                if (v1 > bv) { bv = v1; bj = 1; }
                if (v2 > bv) { bv = v2; bj = 2; }
                if (v3 > bv) { bv = v3; bj = 3; }
                int bi = lane * 4 + bj;
#pragma unroll
                for (int o = 1; o < 64; o <<= 1) { const float ov = __shfl_xor(bv, o); const int oi = __shfl_xor(bi, o); if (ov > bv || (ov == bv && oi < bi)) { bv = ov; bi = oi; } }
                const int jj = bi & 3, ol = bi >> 2;
                const float mys = (jj == 0) ? s0 : (jj == 1) ? s1 : (jj == 2) ? s2 : s3;
                const float wsc = __shfl(mys, ol);
                if (lane == ol) { if (jj == 0) v0 = NEG; else if (jj == 1) v1 = NEG; else if (jj == 2) v2 = NEG; else v3 = NEG; }
                if (lane == it) { my_e = bi; my_s = wsc; }
            }
            const float ssum = wave_sum(lane < 8 ? my_s : 0.f);
            if (lane < 8) { const unsigned rk = atomicAdd(&hist[my_e], 1u); u32x2 en; en.x = (unsigned)my_e | (rk << 16); en.y = __float_as_uint(my_s / ssum * 2.5f); sel[tl * 8 + lane] = en; }
        }
        __syncthreads();
        if (tid < 256) { const unsigned h = hist[tid]; base[tid] = h ? atomicAdd(&gcnt[tid], h) : 0u; }
        __syncthreads();
#pragma unroll
        for (int rep = 0; rep < 2; ++rep) { const int idx = tid + rep * 512, tok = chunk * 128 + (idx >> 3), k = idx & 7;
            const u32x2 en = sel[idx]; const unsigned e = en.x & 0xffffu, pos = base[e] + (en.x >> 16);
            list[(size_t)e * LISTCAP + pos] = make_int2(tok * 10 + k, (int)en.y); }
    }
}

__global__ void __launch_bounds__(512, 2) fwd_kernel(Args a) {
    extern __shared__ __attribute__((aligned(16))) unsigned char lds[];
    volatile LAS unsigned* MISC = (volatile LAS unsigned*)((LAS unsigned char*)lds + (LDS_BYTES - 64));
    if (threadIdx.x < 16) MISC[threadIdx.x] = 0u;
    __syncthreads();
    unsigned* ctl = (unsigned*)(a.ws + WS_CTL);
#if MK_ONE_LAUNCH
    (void)xcd_barrier_post(ctl + CW_BAR, MISC + 8);
#define SEAM() do { XcdBarrier b_; b_.bar = (unsigned*)(a.ws + WS_CTL) + CW_BAR; b_.x = xb_xcc_id(); b_.st = MISC + 8; xcd_barrier(b_); } while (0)
#else
#define SEAM() do {} while (0)
#endif
    const int lo = a.ph_lo, hi = a.ph_hi;
#define IN(k) (lo <= (k) && (k) < hi)
#define BOTH(k) (IN(k) && (k) + 1 < hi)
#define X1 ((bf16_t*)(a.ws + WS_X1))
#define X2 ((bf16_t*)(a.ws + WS_X2))
#define LOG ((float*)(a.ws + WS_LOG))

    LAS unsigned char* L = (LAS unsigned char*)lds;
#define LIST ((int2*)(a.ws + WS_LIST))
#ifndef PROBE_DUP_MASK
#define PROBE_DUP_MASK 0u
#endif
#define RUN(k, ...) if (IN(k)) { { __VA_ARGS__ } if ((PROBE_DUP_MASK >> (k)) & 1u) { __syncthreads(); { __VA_ARGS__ } } if (BOTH(k)) SEAM(); }
    RUN(0, ph_prologue(a, L);)
    RUN(1, pg8::DenseSched S; S.init((const bf16_t*)(a.ws + WS_XA), D, (const bf16_t*)(a.ws + WS_WIN0), D, M, 1536);
           EpiInproj0 E{(bf16_t*)(a.ws + WS_H0)};
           pg8::gemm_phase<EpiInproj0, pg8::DenseSched, true>(L, D, 128u, S, E);)
    RUN(2, ph_convpool_fast(a, L);)
    RUN(4, pg8::DenseSched S; S.init((const bf16_t*)(a.ws + WS_CAT), D, (const bf16_t*)(a.ws + WS_WOUT0), D, M, D);
           EpiRes E{a.in[0], nullptr, (bf16_t*)(a.ws + WS_Y), 1.0f};
           pg8::gemm_phase<EpiRes, pg8::DenseSched, true>(L, D, 128u, S, E);)
    RUN(5, ph_ln((const bf16_t*)(a.ws + WS_Y), a.in[17], a.in[18], X1, (unsigned char*)(a.ws + WS_X8));)
#define MOE_LAYER(P, LAYER, XIN, XOUT, OUTF) \
    RUN(P, pg8::DenseSched S; S.init(XIN, D, (const bf16_t*)(a.ws + WS_WR) + (size_t)(LAYER) * NE * D, D, M, NE); \
           EpiLogits E{LOG}; pg8::gemm_phase<EpiLogits, pg8::DenseSched, true>(L, D, 128u, S, E);) \
    if (IN(P + 1)) { ph_route_fast(LOG, a.in[22] + (LAYER) * NE, ctl + CW_CNT + (LAYER) * 256, LIST, lds); if (BOTH(P + 1)) SEAM(); } \
    RUN(P + 2, const int R = moe_setup256(ctl + CW_CNT + (LAYER) * 256, L); \
            MoeGuSched S{(const char*)(a.ws + WS_X8), (const char*)(a.ws + WS_WGU) + (size_t)(LAYER) * 257 * 512 * 1024, LIST, L, R, (R + 128) * 2, (int)gridDim.x, (int)blockIdx.x}; \
            S.prepare(); EpiGateUp E{(unsigned char*)(a.ws + WS_HID)}; pg8::gemm_phase<EpiGateUp, MoeGuSched, true, true>(L, D / 2, 128u, S, E);) \
    RUN(P + 3, const int R = moe_setup256(ctl + CW_CNT + (LAYER) * 256, L); \
            MoeDownSched S{(const char*)(a.ws + WS_HID), (const char*)(a.ws + WS_WD) + (size_t)(LAYER) * 257 * 1024 * 256, LIST, L, R, R + 128, (int)gridDim.x, (int)blockIdx.x}; \
            S.prepare(); EpiDown E{(unsigned char*)(a.ws + WS_YB), L}; pg8::gemm_phase<EpiDown, MoeDownSched, true, true>(L, FF / 2, 128u, S, E);) \
    RUN(P + 4, ph_combine(a, XIN, a.in[19] + (LAYER) * D, a.in[20] + (LAYER) * D, XOUT, OUTF);)
    MOE_LAYER(6, 0, X1, X2, nullptr)
    RUN(11, pg8::DenseSched S; S.init(X2, D, (const bf16_t*)(a.ws + WS_WINN), D, M, HNW);
            EpiInprojN E{(bf16_t*)(a.ws + WS_HN), (bf16_t*)(a.ws + WS_QR), (bf16_t*)(a.ws + WS_KV6), (float*)(a.ws + WS_GATES), (const float*)(a.ws + WS_MISC) + 1024};
            pg8::gemm_phase<EpiInprojN, pg8::DenseSched, true>(L, D, 128u, S, E);)
    RUN(13, Cmp1Sched S{(const char*)(a.ws + WS_KV6), (const char*)(a.ws + WS_CW1), (int)gridDim.x, (int)blockIdx.x};
            EpiCmp1 E{(bf16_t*)(a.ws + WS_CH1), (const float*)(a.ws + WS_MISC)};
            pg8::gemm_phase<EpiCmp1, Cmp1Sched, true>(L, 2048, 128u, S, E); ph_knorm(a);)
    RUN(14, ph_cmp2(a, lds);)
    RUN(15, ph_attn_fast2(a, L);)
    RUN(16, pg8::DenseSched S; S.init((const bf16_t*)(a.ws + WS_O8), D / 2, (const bf16_t*)(a.ws + WS_WOUTN), D / 2, M, D);
            EpiRes E{nullptr, X2, (bf16_t*)(a.ws + WS_Y2), 1.0f / (X8_SCALE * W8_SCALE)};
            pg8::gemm_phase<EpiRes, pg8::DenseSched, true, true>(L, D / 2, 128u, S, E);)
    RUN(17, ph_ln((const bf16_t*)(a.ws + WS_Y2), a.in[17] + D, a.in[18] + D, X1, (unsigned char*)(a.ws + WS_X8));)
    MOE_LAYER(18, 1, X1, (bf16_t*)nullptr, a.out)
}

extern "C" void kernel_launch(void* const* d_in, const int* in_sizes, int n_in, void* d_out, int out_size, void* d_ws, size_t ws_size, hipStream_t stream) {
    static int grid = 0;
    if (grid == 0) {
        if (n_in != 29 || out_size != M * D || ws_size < WS_END) { fprintf(stderr, "kernel_launch: unexpected problem (n_in %d out %d ws %zu)\n", n_in, out_size, ws_size); grid = -1; return; }
        int dev = 0, cus = 0;
        if (hipGetDevice(&dev) != hipSuccess || hipDeviceGetAttribute(&cus, hipDeviceAttributeMultiprocessorCount, dev) != hipSuccess) { grid = -1; return; }
        if (hipFuncSetAttribute((const void*)fwd_kernel, hipFuncAttributeMaxDynamicSharedMemorySize, LDS_BYTES) != hipSuccess) { grid = -1; return; }
        int per_cu = 0;
        (void)hipOccupancyMaxActiveBlocksPerMultiprocessor(&per_cu, (const void*)fwd_kernel, 512, LDS_BYTES);
        (void)hipGetLastError();
        grid = cus;
    }
    if (grid < 0) return;
    (void)hipMemsetAsync((char*)d_ws + WS_CTL, 0, CTL_BYTES, stream);
    Args a{};
    for (int i = 0; i < 29; ++i) a.in[i] = (const float*)d_in[i];
    a.out = (float*)d_out; a.ws = (unsigned char*)d_ws;
    for (int i = 0; i < 8; ++i) a.inv_freq[i] = powf(500000.0f, -(float)(2 * i) / 16.0f);
#if MK_ONE_LAUNCH
    a.ph_lo = 0; a.ph_hi = NPHASE;
    hipLaunchKernelGGL(fwd_kernel, dim3(grid), dim3(512), LDS_BYTES, stream, a);
#else
    for (int p = 0; p < NPHASE; ++p) { a.ph_lo = p; a.ph_hi = p + 1; hipLaunchKernelGGL(fwd_kernel, dim3(grid), dim3(512), LDS_BYTES, stream, a); }
#endif
}
```

```cpp
#include <hip/hip_runtime.h>
#include <cstdint>
#include <cstdio>
#include <cmath>

#ifndef MK_ONE_LAUNCH
#define MK_ONE_LAUNCH 1
#endif

#define LAS __attribute__((address_space(3)))
typedef unsigned short bf16_t;
typedef short bf16x8 __attribute__((ext_vector_type(8)));
typedef float f32x4 __attribute__((ext_vector_type(4)));
typedef unsigned u32x2 __attribute__((ext_vector_type(2)));
typedef unsigned u32x4 __attribute__((ext_vector_type(4)));

constexpr int NB = 4, T = 8192, D = 1024, M = NB * T;
constexpr int NE = 256, TOPK = 8, FF = 256;
constexpr int HNW = 2816;
constexpr int LISTCAP = 32768;
constexpr float ALPHA = 1.4142135623730951f;
constexpr float LN_EPS = 1e-5f;
constexpr float QSCALE = 0.125f * 1.4426950408889634f;
constexpr int YB_NSLOT = 9;
constexpr float YB_SCALE = 16.0f;
constexpr int NPHASE = 23;

constexpr size_t MiB = 1u << 20;
constexpr size_t WS_CTL = 0, CTL_BYTES = 1 * MiB;
constexpr size_t WS_X1 = 1 * MiB;
constexpr size_t WS_X2 = WS_X1 + 64 * MiB;
constexpr size_t WS_LOG = WS_X2 + 64 * MiB;
constexpr size_t WS_LIST = WS_LOG + 32 * MiB;
constexpr size_t WS_WTS = WS_LIST + 64 * MiB;
constexpr size_t WS_HID = WS_WTS + 2 * MiB;
constexpr size_t WS_YB = WS_HID + 184 * MiB;
constexpr size_t WS_END_NAIVE = WS_YB + 576 * MiB;
constexpr size_t WS_WIN0 = WS_END_NAIVE;
constexpr size_t WS_WOUT0 = WS_WIN0 + 3 * MiB;
constexpr size_t WS_WINN = WS_WOUT0 + 2 * MiB;
constexpr size_t WS_WOUTN = WS_WINN + 6 * MiB;
constexpr size_t WS_WR = WS_WOUTN + 2 * MiB;
constexpr size_t WS_CW1 = WS_WR + 1 * MiB;
constexpr size_t WS_MISC = WS_CW1 + 2 * MiB;
constexpr size_t WS_WGU = WS_MISC + 1 * MiB;
constexpr size_t WS_X8 = WS_WGU + 257 * MiB;
constexpr size_t WS_O8 = WS_X8 + 32 * MiB;
constexpr float X8_SCALE = 8.0f, W8_SCALE = 64.0f, H8_SCALE = 16.0f;
constexpr size_t WS_WD = WS_WGU + 514 * MiB;
constexpr size_t WS_END = WS_WD + 257 * MiB;
constexpr size_t WS_XA = WS_X2;
constexpr size_t WS_H0 = WS_YB;
constexpr size_t WS_PM = WS_H0 + 64 * MiB;
constexpr size_t WS_CAT = WS_PM + 32 * MiB;
constexpr size_t WS_Y = WS_CAT + 64 * MiB;
constexpr size_t WS_HN = WS_YB;
constexpr size_t WS_KV6 = WS_HN + 64 * MiB;
constexpr size_t WS_QR = WS_HN + 176 * MiB;
constexpr size_t WS_GATES = WS_QR + 64 * MiB;
constexpr size_t WS_CH1 = WS_GATES + 8 * MiB;
constexpr size_t WS_KC = WS_CH1 + 4 * MiB;
constexpr size_t WS_O = WS_KC + 2 * MiB;
constexpr size_t WS_Y2 = WS_O + 64 * MiB;
static_assert(WS_Y2 + 64 * MiB <= WS_END_NAIVE, "overlay");
static_assert(WS_Y + 64 * MiB <= WS_END_NAIVE, "overlay");

constexpr int CW_CNT = 64;
constexpr int CW_BAR = 4096;

constexpr int LDS_BYTES = 163840;

__device__ __forceinline__ float bf2f(bf16_t h) { return __uint_as_float(((unsigned)h) << 16); }
__device__ __forceinline__ bf16_t f2bf(float f) { unsigned u = __float_as_uint(f); return (bf16_t)((u + 0x7fffu + ((u >> 16) & 1u)) >> 16); }
__device__ __forceinline__ unsigned pk2(float lo, float hi) { return (unsigned)f2bf(lo) | ((unsigned)f2bf(hi) << 16); }
#define WR_DPP(x, ctrl) __builtin_bit_cast(float, __builtin_amdgcn_update_dpp(__builtin_bit_cast(int, (float)(x)), __builtin_bit_cast(int, (float)(x)), (ctrl), 0xF, 0xF, true))
#define WR_ROW(x, r) __builtin_bit_cast(float, __builtin_amdgcn_readlane(__builtin_bit_cast(int, (float)(x)), 16 * (r)))
__device__ __forceinline__ float wave_sum(float v) {
    v += WR_DPP(v, 0xB1); v += WR_DPP(v, 0x4E); v += WR_DPP(v, 0x141); v += WR_DPP(v, 0x140);
    return (WR_ROW(v, 0) + WR_ROW(v, 1)) + (WR_ROW(v, 2) + WR_ROW(v, 3));
}
__device__ __forceinline__ float wave_max(float v) {
    v = fmaxf(v, WR_DPP(v, 0xB1)); v = fmaxf(v, WR_DPP(v, 0x4E)); v = fmaxf(v, WR_DPP(v, 0x141)); v = fmaxf(v, WR_DPP(v, 0x140));
    return fmaxf(fmaxf(WR_ROW(v, 0), WR_ROW(v, 1)), fmaxf(WR_ROW(v, 2), WR_ROW(v, 3)));
}
__device__ __forceinline__ float sigmoidf_(float x) { return 1.0f / (1.0f + __expf(-x)); }
__device__ __forceinline__ float gelu_tanh(float x) {
    const float u = 0.7978845608028654f * (x + 0.044715f * x * x * x);
    const float e = __expf(2.0f * u);
    const float th = 1.0f - 2.0f / (e + 1.0f);
    return 0.5f * x * (1.0f + th);
}
__device__ __forceinline__ bf16x8 cvt8(const float* p) {
    const float4 a = *(const float4*)p, b = *(const float4*)(p + 4);
    bf16x8 r;
    r[0] = (short)f2bf(a.x); r[1] = (short)f2bf(a.y); r[2] = (short)f2bf(a.z); r[3] = (short)f2bf(a.w);
    r[4] = (short)f2bf(b.x); r[5] = (short)f2bf(b.y); r[6] = (short)f2bf(b.z); r[7] = (short)f2bf(b.w);
    return r;
}
__device__ __forceinline__ bf16x8 colk8(const float* W, int N, int k, int col) {
    bf16x8 r;
#pragma unroll
    for (int j = 0; j < 8; ++j) r[j] = (short)f2bf(W[(size_t)(k + j) * N + col]);
    return r;
}
__device__ __forceinline__ bf16x8 zero8() { return (bf16x8){0, 0, 0, 0, 0, 0, 0, 0}; }
#define WSYNC() asm volatile("s_waitcnt lgkmcnt(0)" ::: "memory")

#define XB_TMO      128
#define XB_XCNT(j)  (256  + 64 * (j))
#define XB_XSUB(j)  (1280 + 64 * (j))
#define XB_XGEN(j)  (2304 + 64 * (j))
#define XB_TOP      3328
#define XB_TOPGEN   3392
#define XCD_BAR_WORDS 3456
#define XB_SPIN_CAP (1u << 22)
__device__ __forceinline__ unsigned xb_ld(unsigned* p)              { return __hip_atomic_load(p, __ATOMIC_RELAXED, __HIP_MEMORY_SCOPE_AGENT); }
__device__ __forceinline__ unsigned xb_add(unsigned* p, unsigned v) { return __hip_atomic_fetch_add(p, v, __ATOMIC_RELAXED, __HIP_MEMORY_SCOPE_AGENT); }
__device__ __forceinline__ unsigned xb_xcc_id() { return (unsigned)__builtin_amdgcn_s_getreg((3 << 11) | 20) & 0xFu; }
#define XB_SPIN(cond, bar) do { unsigned _sp = 0; while (cond) { __builtin_amdgcn_s_sleep(1); \
    if ((++_sp & 255u) == 0u) { if (xb_ld(&(bar)[XB_TMO])) break; if (_sp > XB_SPIN_CAP) { atomicAdd(&(bar)[XB_TMO], 1u); break; } } } } while (0)
struct XcdBarrier { unsigned* bar; unsigned x; volatile LAS unsigned* st; };
__device__ __forceinline__ XcdBarrier xcd_barrier_post(unsigned* bar, volatile LAS unsigned* st) {
    XcdBarrier b; b.bar = bar; b.x = xb_xcc_id(); b.st = st;
    if (threadIdx.x == 0) (void)xb_add(&bar[XB_XCNT(b.x)], 1u);
    return b;
}
__device__ __forceinline__ void xcd_barrier_complete(unsigned* bar, unsigned x, unsigned& nloc, unsigned& nx) {
    const unsigned G = gridDim.x * gridDim.y * gridDim.z;
    unsigned sum, cnt, mine, sp = 0u;
    for (;;) {
        sum = 0u; cnt = 0u; mine = 0u;
#pragma unroll
        for (unsigned j = 0; j < 16; ++j) { const unsigned c = xb_ld(&bar[XB_XCNT(j)]); sum += c; cnt += (c > 0u) ? 1u : 0u; mine = (j == x) ? c : mine; }
        if (sum == G) break;
        __builtin_amdgcn_s_sleep(1);
        if ((++sp & 255u) == 0u) { if (xb_ld(&bar[XB_TMO])) break; if (sp > XB_SPIN_CAP) { atomicAdd(&bar[XB_TMO], 1u); break; } }
    }
    nloc = mine > 0u ? mine : 1u; nx = cnt > 0u ? cnt : 1u;
}
__device__ __forceinline__ void xcd_barrier(const XcdBarrier& b) {
    asm volatile("s_waitcnt vmcnt(0)" ::: "memory");
    __syncthreads();
    if (threadIdx.x == 0) {
        unsigned* bar = b.bar;
        __builtin_amdgcn_s_waitcnt(0);
        unsigned nloc = b.st[0], nx = b.st[1];
        if (nloc == 0u) { xcd_barrier_complete(bar, b.x, nloc, nx); b.st[0] = nloc; b.st[1] = nx; }
        const unsigned old = xb_add(&bar[XB_XSUB(b.x)], 1u);
        const unsigned gen = old / nloc;
        if (old + 1u == (gen + 1u) * nloc) {
            __builtin_amdgcn_fence(__ATOMIC_RELEASE, "agent");
            asm volatile("s_waitcnt vmcnt(0)" ::: "memory");
            const unsigned og = xb_add(&bar[XB_TOP], 1u);
            const unsigned tg = og / nx;
            if (og + 1u == (tg + 1u) * nx) xb_add(&bar[XB_TOPGEN], 1u);
            else XB_SPIN(xb_ld(&bar[XB_TOPGEN]) == tg, bar);
            __builtin_amdgcn_fence(__ATOMIC_ACQUIRE, "agent");
            xb_add(&bar[XB_XGEN(b.x)], 1u);
            asm volatile("s_waitcnt vmcnt(0)" ::: "memory");
        } else {
            XB_SPIN(xb_ld(&bar[XB_XGEN(b.x)]) == gen, bar);
            __builtin_amdgcn_fence(__ATOMIC_ACQUIRE, "agent");
            asm volatile("s_waitcnt vmcnt(0)" ::: "memory");
        }
    }
    __syncthreads();
}

template <class AL, class BL, class EP>
__device__ __forceinline__ void mgemm_tile(unsigned char* lds, int K, const AL& al, const BL& bl, const EP& ep) {
    bf16_t* As = (bf16_t*)lds;
    bf16_t* Bs = As + 128 * 40;
    const int tid = threadIdx.x, lane = tid & 63, wave = tid >> 6;
    const int ar = tid >> 2, ac = (tid & 3) * 8;
    const int bn = tid & 127, bc = (tid >> 7) * 8;
    f32x4 acc[8];
#pragma unroll
    for (int s = 0; s < 8; ++s) acc[s] = (f32x4){0.f, 0.f, 0.f, 0.f};
    bf16x8 ra = al(ac), rb = bl(bc);
    for (int k0 = 0; k0 < K; k0 += 32) {
        __syncthreads();
        *(bf16x8*)(As + ar * 40 + ac) = ra;
        *(bf16x8*)(Bs + bn * 40 + bc) = rb;
        __syncthreads();
        if (k0 + 32 < K) { ra = al(k0 + 32 + ac); rb = bl(k0 + 32 + bc); }
        const bf16x8 af = *(const bf16x8*)(As + (wave * 16 + (lane & 15)) * 40 + (lane >> 4) * 8);
#pragma unroll
        for (int s = 0; s < 8; ++s) {
            const bf16x8 wf = *(const bf16x8*)(Bs + (16 * s + (lane & 15)) * 40 + (lane >> 4) * 8);
            acc[s] = __builtin_amdgcn_mfma_f32_16x16x32_bf16(wf, af, acc[s], 0, 0, 0);
        }
    }
    ep(wave * 16 + (lane & 15), (lane >> 4) * 4, acc);
}
__device__ __forceinline__ void store4bf(bf16_t* p, const f32x4 v) { u32x2 w; w.x = pk2(v[0], v[1]); w.y = pk2(v[2], v[3]); *(u32x2*)p = w; }

struct Args {
    const float* in[29];
    float* out;
    unsigned char* ws;
    float inv_freq[8];
    int ph_lo, ph_hi;
};

__device__ __forceinline__ unsigned pk4_fp8(float a, float b, float c, float d) { int w = __builtin_amdgcn_cvt_pk_fp8_f32(a, b, 0, false); return (unsigned)__builtin_amdgcn_cvt_pk_fp8_f32(c, d, w, true); }
__device__ __forceinline__ u32x2 pack8_fp8(const f32x4 v0, const f32x4 v1) {
    int a = __builtin_amdgcn_cvt_pk_fp8_f32(v0[0], v0[1], 0, false); a = __builtin_amdgcn_cvt_pk_fp8_f32(v0[2], v0[3], a, true);
    int b = __builtin_amdgcn_cvt_pk_fp8_f32(v1[0], v1[1], 0, false); b = __builtin_amdgcn_cvt_pk_fp8_f32(v1[2], v1[3], b, true);
    u32x2 w; w.x = (unsigned)a; w.y = (unsigned)b; return w;
}
__device__ __forceinline__ float clamp8(float v) { return __builtin_amdgcn_fmed3f(v, -448.0f, 448.0f); }
__device__ __forceinline__ void ph_ln(const bf16_t* Y, const float* g, const float* b, bf16_t* X, unsigned char* X8) {
    const int lane = threadIdx.x & 63, wave = threadIdx.x >> 6;
    const int gw = blockIdx.x * 8 + wave, ngw = gridDim.x * 8;
    float gg[16], bb[16];
#pragma unroll
    for (int j = 0; j < 8; ++j) { gg[j] = g[lane * 8 + j]; gg[8 + j] = g[512 + lane * 8 + j]; bb[j] = b[lane * 8 + j]; bb[8 + j] = b[512 + lane * 8 + j]; }
    for (int row0 = gw * 4; row0 < M; row0 += ngw * 4) {
        bf16x8 p0[4], p1[4];
#pragma unroll
        for (int r = 0; r < 4; ++r) { p0[r] = __builtin_nontemporal_load((const bf16x8*)(Y + (size_t)(row0 + r) * 1024 + lane * 8)); p1[r] = __builtin_nontemporal_load((const bf16x8*)(Y + (size_t)(row0 + r) * 1024 + 512 + lane * 8)); }
#pragma unroll
        for (int r = 0; r < 4; ++r) {
            float v[16];
#pragma unroll
            for (int j = 0; j < 8; ++j) { v[j] = bf2f((bf16_t)p0[r][j]); v[8 + j] = bf2f((bf16_t)p1[r][j]); }
            float s = 0.f;
#pragma unroll
            for (int j = 0; j < 16; ++j) s += v[j];
            const float mean = wave_sum(s) * (1.0f / 1024.0f);
            float q = 0.f;
#pragma unroll
            for (int j = 0; j < 16; ++j) { v[j] -= mean; q += v[j] * v[j]; }
            const float rstd = rsqrtf(wave_sum(q) * (1.0f / 1024.0f) + LN_EPS);
            float o[16];
#pragma unroll
            for (int j = 0; j < 16; ++j) o[j] = v[j] * rstd * gg[j] + bb[j];
            u32x4 w0, w1;
            w0.x = pk2(o[0], o[1]); w0.y = pk2(o[2], o[3]); w0.z = pk2(o[4], o[5]); w0.w = pk2(o[6], o[7]);
            w1.x = pk2(o[8], o[9]); w1.y = pk2(o[10], o[11]); w1.z = pk2(o[12], o[13]); w1.w = pk2(o[14], o[15]);
            *(u32x4*)(X + (size_t)(row0 + r) * 1024 + lane * 8) = w0; *(u32x4*)(X + (size_t)(row0 + r) * 1024 + 512 + lane * 8) = w1;
#pragma unroll
            for (int j = 0; j < 16; ++j) o[j] = clamp8(o[j] * X8_SCALE);
            u32x2 q0, q1; q0.x = pk4_fp8(o[0], o[1], o[2], o[3]); q0.y = pk4_fp8(o[4], o[5], o[6], o[7]); q1.x = pk4_fp8(o[8], o[9], o[10], o[11]); q1.y = pk4_fp8(o[12], o[13], o[14], o[15]);
            *(u32x2*)(X8 + (size_t)(row0 + r) * 1024 + lane * 8) = q0; *(u32x2*)(X8 + (size_t)(row0 + r) * 1024 + 512 + lane * 8) = q1;
        }
    }
}

__device__ __forceinline__ void ph_combine(const Args& a, const bf16_t* X, const float* g, const float* b, bf16_t* Xo, float* outf) {
    const unsigned char* YB = (const unsigned char*)(a.ws + WS_YB);
    const int lane = threadIdx.x & 63, wave = threadIdx.x >> 6;
    const int gw = blockIdx.x * 8 + wave, ngw = gridDim.x * 8;
    for (int row = gw; row < M; row += ngw) {
        float v[16];
#pragma unroll
        for (int j = 0; j < 16; ++j) v[j] = 0.f;
        u32x2 q0[YB_NSLOT], q1[YB_NSLOT];
#pragma unroll
        for (int k = 0; k < YB_NSLOT; ++k) { const unsigned char* yr = YB + ((size_t)row * 10 + k) * 1024; q0[k] = __builtin_nontemporal_load((const u32x2*)(yr + lane * 8)); q1[k] = __builtin_nontemporal_load((const u32x2*)(yr + 512 + lane * 8)); }
#pragma unroll
        for (int k = 0; k < YB_NSLOT; ++k) {
            const auto a0 = __builtin_amdgcn_cvt_pk_f32_fp8((int)q0[k].x, false), a1 = __builtin_amdgcn_cvt_pk_f32_fp8((int)q0[k].x, true), a2 = __builtin_amdgcn_cvt_pk_f32_fp8((int)q0[k].y, false), a3 = __builtin_amdgcn_cvt_pk_f32_fp8((int)q0[k].y, true);
            const auto b0 = __builtin_amdgcn_cvt_pk_f32_fp8((int)q1[k].x, false), b1 = __builtin_amdgcn_cvt_pk_f32_fp8((int)q1[k].x, true), b2 = __builtin_amdgcn_cvt_pk_f32_fp8((int)q1[k].y, false), b3 = __builtin_amdgcn_cvt_pk_f32_fp8((int)q1[k].y, true);
            v[0] += a0[0]; v[1] += a0[1]; v[2] += a1[0]; v[3] += a1[1]; v[4] += a2[0]; v[5] += a2[1]; v[6] += a3[0]; v[7] += a3[1];
            v[8] += b0[0]; v[9] += b0[1]; v[10] += b1[0]; v[11] += b1[1]; v[12] += b2[0]; v[13] += b2[1]; v[14] += b3[0]; v[15] += b3[1];
        }
        {
            const bf16x8 p0 = *(const bf16x8*)(X + (size_t)row * 1024 + lane * 8), p1 = *(const bf16x8*)(X + (size_t)row * 1024 + 512 + lane * 8);
#pragma unroll
            for (int j = 0; j < 8; ++j) { v[j] = v[j] * (1.0f / YB_SCALE) + ALPHA * bf2f((bf16_t)p0[j]); v[8 + j] = v[8 + j] * (1.0f / YB_SCALE) + ALPHA * bf2f((bf16_t)p1[j]); }
        }
        float s = 0.f;
#pragma unroll
        for (int j = 0; j < 16; ++j) s += v[j];
        const float mean = wave_sum(s) * (1.0f / 1024.0f);
        float q = 0.f;
#pragma unroll
        for (int j = 0; j < 16; ++j) { v[j] -= mean; q += v[j] * v[j]; }
        const float rstd = rsqrtf(wave_sum(q) * (1.0f / 1024.0f) + LN_EPS);
        float o[16];
#pragma unroll
        for (int j = 0; j < 8; ++j) { o[j] = v[j] * rstd * g[lane * 8 + j] + b[lane * 8 + j]; o[8 + j] = v[8 + j] * rstd * g[512 + lane * 8 + j] + b[512 + lane * 8 + j]; }
        if (outf) {
            float* op = outf + (size_t)row * 1024;
            *(float4*)(op + lane * 8) = make_float4(o[0], o[1], o[2], o[3]); *(float4*)(op + lane * 8 + 4) = make_float4(o[4], o[5], o[6], o[7]);
            *(float4*)(op + 512 + lane * 8) = make_float4(o[8], o[9], o[10], o[11]); *(float4*)(op + 512 + lane * 8 + 4) = make_float4(o[12], o[13], o[14], o[15]);
        } else {
            u32x4 w0, w1;
            w0.x = pk2(o[0], o[1]); w0.y = pk2(o[2], o[3]); w0.z = pk2(o[4], o[5]); w0.w = pk2(o[6], o[7]);
            w1.x = pk2(o[8], o[9]); w1.y = pk2(o[10], o[11]); w1.z = pk2(o[12], o[13]); w1.w = pk2(o[14], o[15]);
            *(u32x4*)(Xo + (size_t)row * 1024 + lane * 8) = w0; *(u32x4*)(Xo + (size_t)row * 1024 + 512 + lane * 8) = w1;
        }
    }
}

__device__ __forceinline__ void ph_cmp2(const Args& a, unsigned char* lds) {
    const bf16_t* CH1 = (const bf16_t*)(a.ws + WS_CH1);
    bf16_t* KC = (bf16_t*)(a.ws + WS_KC);
    const int tid = threadIdx.x;
    for (int u = blockIdx.x; u < 64 * 2; u += gridDim.x) {
        const int rt = u >> 1, kv = u & 1;
        const bf16_t* ar = CH1 + ((size_t)kv * 8192 + rt * 128 + (tid >> 2)) * 128;
        const float* w2 = a.in[kv ? 15 : 12];
        const int col = tid & 127;
        auto al = [&](int k) { return *(const bf16x8*)(ar + k); };
        auto bl = [&](int k) { return (col < 64) ? colk8(w2, 64, k, col) : zero8(); };
        auto ep = [&](int r, int cb, const f32x4 (&acc)[8]) {
            bf16_t* o = KC + ((size_t)kv * 8192 + rt * 128 + r) * 64;
#pragma unroll
            for (int s = 0; s < 4; ++s) store4bf(o + 16 * s + cb, acc[s]);
        };
        mgemm_tile(lds, 128, al, bl, ep);
    }
}

namespace pg8 {
constexpr int BM = 256, BK = 64, HALF = 128, HTB = HALF * BK * 2, STAGE_BYTES = 8 * HTB;
__device__ __forceinline__ int lds_byte(int r, int c) { const int st = (r >> 4) * 2 + (c >> 5), rr = r & 15, cc = c & 31, ob = rr * 64 + cc * 2; return st * 1024 + (ob ^ (((ob >> 9) & 1) << 5)); }
__device__ __forceinline__ void stage_rc(int b, int& R, int& C) { const int st = b / 1024, sb = b % 1024, swz = sb ^ (((sb >> 9) & 1) << 5); R = (st >> 1) * 16 + swz / 64; C = (st & 1) * 32 + (swz % 64) / 2; }
__device__ __forceinline__ int perm32(int rho) { const int n = rho >> 4, i = rho & 15; return 8 * (i >> 2) + 4 * n + (i & 3); }
struct Unit { int pm, pn, ord; };
typedef float f32x16 __attribute__((ext_vector_type(16)));
typedef int i32x8 __attribute__((ext_vector_type(8))); typedef int i32x4_ __attribute__((ext_vector_type(4)));
__device__ __forceinline__ i32x8 f8cat(const bf16x8 lo, const bf16x8 hi) { return __builtin_shufflevector(__builtin_bit_cast(i32x4_, lo), __builtin_bit_cast(i32x4_, hi), 0, 1, 2, 3, 4, 5, 6, 7); }
template <class Epi, class Sched, bool ALIGN_EPI, bool F8 = false>
__device__ __forceinline__ void gemm_phase(LAS unsigned char* lds, const int K, const unsigned kstepA, const Sched& S, const Epi& E) {
    const int tid = threadIdx.x, wid = __builtin_amdgcn_readfirstlane(tid >> 6), lane = tid & 63, wr = wid >> 2, wc = wid & 3, fr = lane & 15, fq = lane >> 4;
    const int nt = K / BK;
    constexpr bool GA = Sched::GATHER;
    int RA[2]; unsigned CA2[2], voffB[2], voffB1[2], voffA[2];
    constexpr bool P16 = Epi::PERM16;
#pragma unroll
    for (int i = 0; i < 2; ++i) { int R, C; stage_rc(tid * 16 + i * 8192, R, C); const int Rb = Epi::PERM ? ((R & ~31) + perm32(R & 31)) : R;
        RA[i] = R; CA2[i] = (unsigned)C * 2u; voffB[i] = (unsigned)(Rb * K + C) * 2u; voffA[i] = GA ? 0u : (S.lane_off(R) + (unsigned)C * 2u);
        if (P16) { const int c16 = 64 * (R >> 5) + 16 * ((R >> 2) & 3) + 4 * ((R >> 4) & 1) + (R & 3); voffB[i] = (unsigned)(c16 * K + C) * 2u; voffB1[i] = (unsigned)((c16 + 8) * K + C) * 2u; } else voffB1[i] = 0u; }
    const size_t kstepB = (size_t)(BK * 2);
    const size_t hstepB = (size_t)HALF * K * 2;
    const unsigned ldsw = (unsigned)wid * 1024u;
    const int aoff = lds_byte(wr * 64 + fr, fq * 8), boff = lds_byte(wc * 32 + fr, fq * 8);
    const char* const Ab = S.abase();
    unsigned aoC[2][2], aoN[2][2];
    unsigned uC[2], uN[2];
#define PG8_SA(b, h) (((b) * 2 + (h)) * HTB)
#define PG8_SB(b, h) ((4 + (b) * 2 + (h)) * HTB)
#define PG8_GLDS(sbase, voff, ldsoff) do { const char* _b = (const char*)(sbase); unsigned _v = (voff); asm volatile("" : "+s"(_b), "+v"(_v)); \
        __builtin_amdgcn_global_load_lds((const unsigned*)(_b + _v), (LAS unsigned*)(lds + (ldsoff)), 16, 0, 0); } while (0)
#define PG8_STAGE_B(bufoff, gbase) do { _Pragma("unroll") for (int _i = 0; _i < 2; ++_i) PG8_GLDS(gbase, voffB[_i], (bufoff) + ldsw + _i * 8192); } while (0)
#define PG8_STAGE_B1(bufoff, gbase) do { _Pragma("unroll") for (int _i = 0; _i < 2; ++_i) PG8_GLDS((const char*)(gbase) + (P16 ? (size_t)0 : hstepB), (P16 ? voffB1[_i] : voffB[_i]), (bufoff) + ldsw + _i * 8192); } while (0)
#define PG8_STAGE_A(bufoff, kb, UO, LO) do { _Pragma("unroll") for (int _i = 0; _i < 2; ++_i) PG8_GLDS(Ab + (size_t)((kb) + (UO)), (GA ? (LO)[_i] : voffA[_i]), (bufoff) + ldsw + _i * 8192); } while (0)
#define PG8_LDA(dst, b, h) do { _Pragma("unroll") for (int m = 0; m < 4; ++m) _Pragma("unroll") for (int k = 0; k < 2; ++k) dst[m][k] = *(const LAS bf16x8*)(lds + PG8_SA(b, h) + aoff + m * 2048 + k * 1024); } while (0)
#define PG8_LDB(dst, b, h) do { _Pragma("unroll") for (int n = 0; n < 2; ++n) _Pragma("unroll") for (int k = 0; k < 2; ++k) dst[n][k] = *(const LAS bf16x8*)(lds + PG8_SB(b, h) + boff + n * 2048 + k * 1024); } while (0)
#define PG8_MMA(ai, bj, At, Bt) do { __builtin_amdgcn_s_setprio(1); _Pragma("unroll") for (int m = 0; m < 4; ++m) _Pragma("unroll") for (int n = 0; n < 2; ++n) { \
        if constexpr (F8) { f32x16& _w = accw[ai][bj][m >> 1]; const int _q = ((m & 1) * 2 + n) * 4; f32x4 _c = {_w[_q], _w[_q + 1], _w[_q + 2], _w[_q + 3]}; \
            _c = __builtin_amdgcn_mfma_scale_f32_16x16x128_f8f6f4(f8cat(Bt[n][0], Bt[n][1]), f8cat(At[m][0], At[m][1]), _c, 0, 0, 0, 0, 0, 0); _w[_q] = _c[0]; _w[_q + 1] = _c[1]; _w[_q + 2] = _c[2]; _w[_q + 3] = _c[3]; } \
        else { _Pragma("unroll") for (int k = 0; k < 2; ++k) acc[ai][bj][m][n] = __builtin_amdgcn_mfma_f32_16x16x32_bf16(Bt[n][k], At[m][k], acc[ai][bj][m][n], 0, 0, 0); } } __builtin_amdgcn_s_setprio(0); } while (0)
#define PG8_WAIT_V(n) asm volatile("s_waitcnt vmcnt(" #n ")" ::: "memory")
#define PG8_WAIT_L(n) asm volatile("s_waitcnt lgkmcnt(" #n ")" ::: "memory")
#define PG8_BAR __builtin_amdgcn_s_barrier()
#define PG8_SCHED __builtin_amdgcn_sched_barrier(0)
#define PG8_KPAIR(KB1, KB2, KB3, BP2, BP3) do { \
            PG8_LDB(B0, 0, 0); PG8_LDB(B1, 0, 1); PG8_SCHED; PG8_LDA(At, 0, 0); PG8_STAGE_A(PG8_SA(1, 1), KB1, uC[1], aoC[1]); \
            PG8_WAIT_V(8); PG8_WAIT_L(0); PG8_BAR; PG8_MMA(0, 0, At, B0); PG8_MMA(0, 1, At, B1); PG8_BAR; PG8_SCHED; \
            PG8_LDA(At, 0, 1); PG8_STAGE_B(PG8_SB(0, 0), BP2); PG8_STAGE_B1(PG8_SB(0, 1), BP2); PG8_STAGE_A(PG8_SA(0, 0), KB2, u2[0], a2o[0]); \
            PG8_WAIT_V(8); PG8_WAIT_L(0); PG8_BAR; PG8_MMA(1, 0, At, B0); PG8_MMA(1, 1, At, B1); PG8_BAR; PG8_SCHED; \
            PG8_LDB(B0, 1, 0); PG8_LDB(B1, 1, 1); PG8_SCHED; PG8_LDA(At, 1, 0); PG8_STAGE_A(PG8_SA(0, 1), KB2, u2[1], a2o[1]); \
            PG8_WAIT_V(8); PG8_WAIT_L(0); PG8_BAR; PG8_MMA(0, 0, At, B0); PG8_MMA(0, 1, At, B1); PG8_BAR; PG8_SCHED; \
            PG8_LDA(At, 1, 1); PG8_STAGE_B(PG8_SB(1, 0), BP3); PG8_STAGE_B1(PG8_SB(1, 1), BP3); PG8_STAGE_A(PG8_SA(1, 0), KB3, u2[0], a2o[0]); \
            PG8_WAIT_V(8); PG8_WAIT_L(0); PG8_BAR; PG8_MMA(1, 0, At, B0); PG8_MMA(1, 1, At, B1); PG8_BAR; PG8_SCHED; } while (0)
    Unit cur, nxt; int ui = 0;
    if (!S.next(0, cur)) return;
    f32x4 acc[2][2][4][2];
#pragma unroll
    for (int a = 0; a < 2; ++a)
#pragma unroll
        for (int b = 0; b < 2; ++b)
#pragma unroll
            for (int m = 0; m < 4; ++m)
#pragma unroll
                for (int n = 0; n < 2; ++n) acc[a][b][m][n] = (f32x4){0.f, 0.f, 0.f, 0.f};
    bf16x8 At[4][2], B0[2][2], B1[2][2];
    f32x16 accw[2][2][2];
#define PG8_ZERO_W() do { if constexpr (F8) { _Pragma("unroll") for (int _a = 0; _a < 2; ++_a) _Pragma("unroll") for (int _b = 0; _b < 2; ++_b) _Pragma("unroll") for (int _m = 0; _m < 2; ++_m) _Pragma("unroll") for (int _e = 0; _e < 16; ++_e) accw[_a][_b][_m][_e] = 0.f; } } while (0)
    PG8_ZERO_W();
#pragma unroll
    for (int h = 0; h < 2; ++h) { uC[h] = GA ? 0u : S.unit_off(cur, h); uN[h] = uC[h];
#pragma unroll
        for (int i = 0; i < 2; ++i) { aoC[h][i] = GA ? (S.aoff(cur, h * HALF + RA[i]) + CA2[i]) : 0u; aoN[h][i] = aoC[h][i]; } }
    const char* cB = S.bptr(cur);
    PG8_STAGE_B(PG8_SB(0, 0), cB); PG8_STAGE_B1(PG8_SB(0, 1), cB); PG8_STAGE_A(PG8_SA(0, 0), 0u, uC[0], aoC[0]); PG8_STAGE_A(PG8_SA(0, 1), 0u, uC[1], aoC[1]);
    if (wr == 1) PG8_BAR;
    PG8_WAIT_V(2); PG8_BAR;
    PG8_STAGE_B(PG8_SB(1, 0), cB + kstepB); PG8_STAGE_A(PG8_SA(1, 0), kstepA, uC[0], aoC[0]); PG8_STAGE_B1(PG8_SB(1, 1), cB + kstepB);
    PG8_WAIT_V(6); PG8_BAR;
    for (;;) {
        const bool has_next = S.next(ui + 1, nxt);
        const char* nB = has_next ? S.bptr(nxt) : cB;
#pragma unroll
        for (int h = 0; h < 2; ++h) { uN[h] = (GA || !has_next) ? uC[h] : S.unit_off(nxt, h);
#pragma unroll
            for (int i = 0; i < 2; ++i) aoN[h][i] = (GA && has_next) ? (S.aoff(nxt, h * HALF + RA[i]) + CA2[i]) : aoC[h][i]; }
#pragma nounroll
        for (int t = 0; t < nt; t += 2) {
            const bool last = (t == nt - 2);
            const unsigned kb1 = (unsigned)(t + 1) * kstepA, kb2 = last ? 0u : (unsigned)(t + 2) * kstepA, kb3 = kb2 + kstepA;
            const char* b2 = last ? nB : cB + (size_t)(t + 2) * kstepB; const char* b3 = b2 + kstepB;
            unsigned u2[2], a2o[2][2];
#pragma unroll
            for (int h = 0; h < 2; ++h) { u2[h] = last ? uN[h] : uC[h];
#pragma unroll
                for (int i = 0; i < 2; ++i) a2o[h][i] = GA ? (last ? aoN[h][i] : aoC[h][i]) : 0u; }
            PG8_KPAIR(kb1, kb2, kb3, b2, b3);
        }
        if constexpr (ALIGN_EPI) { if (wr == 0) PG8_BAR; }
        if constexpr (F8) {
#pragma unroll
            for (int _a = 0; _a < 2; ++_a)
#pragma unroll
                for (int _b = 0; _b < 2; ++_b)
#pragma unroll
                    for (int _m = 0; _m < 4; ++_m)
#pragma unroll
                        for (int _n = 0; _n < 2; ++_n) { const f32x16& _w = accw[_a][_b][_m >> 1]; const int _q = ((_m & 1) * 2 + _n) * 4; acc[_a][_b][_m][_n] = (f32x4){_w[_q], _w[_q + 1], _w[_q + 2], _w[_q + 3]}; }
        }
        E(acc, cur, wr, wc, fr, fq);
        PG8_ZERO_W();
        if (!has_next) break;
#pragma unroll
        for (int a = 0; a < 2; ++a)
#pragma unroll
            for (int b = 0; b < 2; ++b)
#pragma unroll
                for (int m = 0; m < 4; ++m)
#pragma unroll
                    for (int n = 0; n < 2; ++n) acc[a][b][m][n] = (f32x4){0.f, 0.f, 0.f, 0.f};
        cur = nxt; cB = nB; ++ui;
#pragma unroll
        for (int h = 0; h < 2; ++h) { uC[h] = uN[h];
#pragma unroll
            for (int i = 0; i < 2; ++i) aoC[h][i] = aoN[h][i]; }
        if constexpr (ALIGN_EPI) { if (wr == 1) PG8_BAR; }
    }
    PG8_WAIT_V(0);
    if constexpr (!ALIGN_EPI) { if (wr == 0) PG8_BAR; }
    PG8_BAR;
#undef PG8_SA
#undef PG8_ZERO_W
#undef PG8_GLDS
#undef PG8_SB
#undef PG8_STAGE_A
#undef PG8_STAGE_B
#undef PG8_STAGE_B1
#undef PG8_LDA
#undef PG8_LDB
#undef PG8_MMA
#undef PG8_WAIT_V
#undef PG8_WAIT_L
#undef PG8_BAR
#undef PG8_SCHED
#undef PG8_KPAIR
}

struct DenseSched {
    const char* A; const char* Bt; unsigned lda2; size_t btile; int nM, nN, nwg, G, c;
    __device__ __forceinline__ void init(const bf16_t* A_, int lda, const bf16_t* Bt_, int K, int Mrows, int N) {
        A = (const char*)A_; Bt = (const char*)Bt_; lda2 = (unsigned)lda * 2u; btile = (size_t)256 * K * 2; nM = Mrows / BM; nN = N / BM; nwg = nM * nN; G = gridDim.x; c = blockIdx.x; }
    __device__ __forceinline__ bool next(int i, Unit& u) const {
        const long L = (long)i * G + c; if (L >= nwg) return false;
        int wgid = (int)L; { const int q = nwg / 8, r = nwg % 8, xcd = wgid % 8, off = wgid / 8; wgid = (xcd < r ? xcd * (q + 1) : r * (q + 1) + (xcd - r) * q) + off; }
        const int nig = 8 * nN, gid = wgid / nig, fm = gid * 8, gsz = (nM - fm) < 8 ? (nM - fm) : 8;
        u.pm = fm + ((wgid % nig) % gsz); u.pn = (wgid % nig) / gsz; u.ord = i; return true;
    }
    static constexpr bool GATHER = false;
    __device__ __forceinline__ unsigned lane_off(int r) const { return (unsigned)r * lda2; }
    __device__ __forceinline__ unsigned unit_off(const Unit& u, int h) const { return (unsigned)(u.pm * BM + h * HALF) * lda2; }
    __device__ __forceinline__ unsigned aoff(const Unit&, int) const { return 0u; }
    __device__ __forceinline__ const char* abase() const { return A; }
    __device__ __forceinline__ const char* bptr(const Unit& u) const { return Bt + (size_t)u.pn * btile; }
};
}
typedef float f32x2_t __attribute__((ext_vector_type(2))); typedef __bf16 bf16x2_t __attribute__((ext_vector_type(2)));
__device__ __forceinline__ unsigned cvt_pk_bf16(float lo, float hi) { const f32x2_t v = {lo, hi}; const bf16x2_t b = __builtin_convertvector(v, bf16x2_t); return __builtin_bit_cast(unsigned, b); }
__device__ __forceinline__ u32x4 pack8(const f32x4 v0, const f32x4 v1) { u32x4 w; w.x = cvt_pk_bf16(v0[0], v0[1]); w.y = cvt_pk_bf16(v0[2], v0[3]); w.z = cvt_pk_bf16(v1[0], v1[1]); w.w = cvt_pk_bf16(v1[2], v1[3]); return w; }
__device__ __forceinline__ unsigned cvtpk_m(float lo, float hi) { const f32x2_t v = {lo, hi}; const bf16x2_t b = __builtin_convertvector(v, bf16x2_t); return __builtin_bit_cast(unsigned, b); }
__device__ __forceinline__ u32x4 pack8m(const f32x4 v0, const f32x4 v1) { u32x4 w; w.x = cvtpk_m(v0[0], v0[1]); w.y = cvtpk_m(v0[2], v0[3]); w.z = cvtpk_m(v1[0], v1[1]); w.w = cvtpk_m(v1[2], v1[3]); return w; }
#define MFMA_SETTLE(S) asm volatile("s_nop 15\n\ts_nop 7" : "+v"(S[0][0]), "+v"(S[0][1]), "+v"(S[0][2]), "+v"(S[0][3]), "+v"(S[1][0]), "+v"(S[1][1]), "+v"(S[1][2]), "+v"(S[1][3]))
__device__ __forceinline__ f32x4 sig4(const f32x4 v) { f32x4 r; r[0] = sigmoidf_(v[0]); r[1] = sigmoidf_(v[1]); r[2] = sigmoidf_(v[2]); r[3] = sigmoidf_(v[3]); return r; }

#define EPI_ROWLOOP for (int ai = 0; ai < 2; ++ai) _Pragma("unroll") for (int m = 0; m < 4; ++m)
struct EpiInproj0 {
    static constexpr bool PERM = true, PERM16 = false; bf16_t* H0;
    __device__ __forceinline__ void operator()(const f32x4 (&acc)[2][2][4][2], const pg8::Unit& u, int wr, int wc, int fr, int fq) const {
        const int row0 = u.pm * 256 + wr * 64 + fr, cl = wc * 32 + 8 * fq;
#pragma unroll
        EPI_ROWLOOP { bf16_t* rp = H0 + (size_t)(row0 + ai * 128 + m * 16) * 1024;
            if (u.pn < 2) {
#pragma unroll
                for (int bj = 0; bj < 2; ++bj) *(u32x4*)(rp + u.pn * 256 + bj * 128 + cl) = pack8(acc[ai][bj][m][0], acc[ai][bj][m][1]);
            } else {
                const f32x4 v0 = acc[ai][0][m][0] * sig4(acc[ai][1][m][0]), v1 = acc[ai][0][m][1] * sig4(acc[ai][1][m][1]);
                *(u32x4*)(rp + 512 + (u.pn - 2) * 128 + cl) = pack8(v0, v1);
            } }
    }
};
struct EpiRes {
    static constexpr bool PERM = true, PERM16 = false; const float* resf; const bf16_t* resb; bf16_t* Y; float sc;
    __device__ __forceinline__ void operator()(const f32x4 (&acc)[2][2][4][2], const pg8::Unit& u, int wr, int wc, int fr, int fq) const {
        const int row0 = u.pm * 256 + wr * 64 + fr, c0 = u.pn * 256 + wc * 32 + 8 * fq;
#pragma unroll
        EPI_ROWLOOP { const size_t ro = (size_t)(row0 + ai * 128 + m * 16) * 1024 + c0;
#pragma unroll
            for (int bj = 0; bj < 2; ++bj) {
                f32x4 r0, r1;
                if (resf) { r0 = *(const f32x4*)(resf + ro + bj * 128); r1 = *(const f32x4*)(resf + ro + bj * 128 + 4); }
                else { const u32x4 xv = *(const u32x4*)(resb + ro + bj * 128);
                    r0[0] = __uint_as_float(xv.x << 16); r0[1] = __uint_as_float(xv.x & 0xffff0000u); r0[2] = __uint_as_float(xv.y << 16); r0[3] = __uint_as_float(xv.y & 0xffff0000u);
                    r1[0] = __uint_as_float(xv.z << 16); r1[1] = __uint_as_float(xv.z & 0xffff0000u); r1[2] = __uint_as_float(xv.w << 16); r1[3] = __uint_as_float(xv.w & 0xffff0000u); }
                *(u32x4*)(Y + ro + bj * 128) = pack8(acc[ai][bj][m][0] * sc + r0 * ALPHA, acc[ai][bj][m][1] * sc + r1 * ALPHA);
            } }
    }
};
struct EpiLogits {
    static constexpr bool PERM = true, PERM16 = false; float* LOG;
    __device__ __forceinline__ void operator()(const f32x4 (&acc)[2][2][4][2], const pg8::Unit& u, int wr, int wc, int fr, int fq) const {
        const int row0 = u.pm * 256 + wr * 64 + fr, cl = wc * 32 + 8 * fq;
#pragma unroll
        EPI_ROWLOOP { float* rp = LOG + (size_t)(row0 + ai * 128 + m * 16) * 256 + cl;
#pragma unroll
            for (int bj = 0; bj < 2; ++bj) { *(f32x4*)(rp + bj * 128) = acc[ai][bj][m][0]; *(f32x4*)(rp + bj * 128 + 4) = acc[ai][bj][m][1]; } }
    }
};

constexpr int MOE_TAB_OFF = 131072;
__device__ __forceinline__ int moe_setup256(const unsigned* cnt, LAS unsigned char* lds) {
    LAS int* tstart = (LAS int*)(lds + MOE_TAB_OFF);
    LAS int* scnt = (LAS int*)(lds + MOE_TAB_OFF + 1088);
    LAS unsigned short* texp = (LAS unsigned short*)(lds + MOE_TAB_OFF + 2176);
    const int tid = threadIdx.x;
    __syncthreads();
    const int lane = tid & 63, wave = tid >> 6;
    LAS int* wtot = tstart + 260;
    int c = 0;
    if (tid < 256) { const int n = (int)cnt[tid]; scnt[tid] = n; c = (n + 255) >> 8; }
    int incl = c;
#pragma unroll
    for (int o = 1; o < 64; o <<= 1) { const int t = __shfl_up(incl, o); if (lane >= o) incl += t; }
    if (tid < 256 && lane == 63) wtot[wave] = incl;
    __syncthreads();
    if (tid < 256) { int off = 0;
#pragma unroll
        for (int w = 0; w < 3; ++w) off += (w < wave) ? wtot[w] : 0;
        tstart[tid] = off + incl - c; if (tid == 255) tstart[256] = off + incl; }
    __syncthreads();
    if (tid < 256) for (int q = tstart[tid]; q < tstart[tid + 1]; ++q) texp[q] = (unsigned short)tid;
    __syncthreads();
    return __builtin_amdgcn_readfirstlane(tstart[256]);
}
constexpr int MOE_TOK_OFF = MOE_TAB_OFF + 5120;
constexpr int MOE_MAX_ORD = 20;
struct MoeGuSched {
    static constexpr bool GATHER = true;
    const char* X; const char* W; const int2* list; LAS unsigned char* lds; int R, nunits, G, c;
    __device__ __forceinline__ int vcu() const { return (G % 8 == 0) ? (c % 8) * (G / 8) + c / 8 : c; }
    __device__ __forceinline__ bool next(int i, pg8::Unit& u) const {
        const int L = i * G + vcu(); if (L >= nunits || i >= MOE_MAX_ORD) return false;
        const int q = L >> 1; const int e = __builtin_amdgcn_readfirstlane((q < R) ? (int)((LAS unsigned short*)(lds + MOE_TAB_OFF + 2176))[q] : 256);
        u.pm = q; u.pn = e * 2 + (L & 1); u.ord = i; return true; }
    __device__ __forceinline__ void prepare() const {
        const int tid = threadIdx.x, r = tid & 255;
        pg8::Unit u;
        for (int i = tid >> 8; next(i, u); i += 2) {
            const int e = u.pn >> 1; int token;
            if (e < 256) { const int ts = ((LAS int*)(lds + MOE_TAB_OFF))[e], cn = ((LAS int*)(lds + MOE_TAB_OFF + 1088))[e]; int lr = (u.pm - ts) * 256 + r; if (lr >= cn) lr = cn - 1;
                token = list[(size_t)e * LISTCAP + lr].x / 10; }
            else token = (u.pm - R) * 256 + r;
            ((LAS unsigned short*)(lds + MOE_TOK_OFF))[i * 256 + r] = (unsigned short)token;
        }
        __syncthreads();
    }
    __device__ __forceinline__ unsigned aoff(const pg8::Unit& u, int r) const { return (unsigned)((LAS unsigned short*)(lds + MOE_TOK_OFF))[u.ord * 256 + r] * 1024u; }
    __device__ __forceinline__ unsigned lane_off(int) const { return 0u; }
    __device__ __forceinline__ unsigned unit_off(const pg8::Unit&, int) const { return 0u; }
    __device__ __forceinline__ const char* abase() const { return X; }
    __device__ __forceinline__ const char* bptr(const pg8::Unit& u) const { return W + (size_t)u.pn * (256 * 1024); }
};
constexpr float GU_SC = 1.0f / (X8_SCALE * W8_SCALE);
struct EpiGateUp {
    static constexpr bool PERM = true, PERM16 = false; unsigned char* HID;
    __device__ __forceinline__ void operator()(const f32x4 (&acc)[2][2][4][2], const pg8::Unit& u, int wr, int wc, int fr, int fq) const {
        const int row0 = u.pm * 256 + wr * 64 + fr, c0 = (u.pn & 1) * 128 + wc * 32 + 8 * fq;
#pragma unroll
        EPI_ROWLOOP { const f32x4 g0 = acc[ai][0][m][0] * GU_SC, g1 = acc[ai][0][m][1] * GU_SC;
            f32x4 h0 = g0 * sig4(g0) * (acc[ai][1][m][0] * (GU_SC * H8_SCALE)), h1 = g1 * sig4(g1) * (acc[ai][1][m][1] * (GU_SC * H8_SCALE));
#pragma unroll
            for (int i = 0; i < 4; ++i) { h0[i] = clamp8(h0[i]); h1[i] = clamp8(h1[i]); }
            *(u32x2*)(HID + (size_t)(row0 + ai * 128 + m * 16) * 256 + c0) = pack8_fp8(h0, h1); }
    }
};
constexpr int MOE_RI_OFF = MOE_TAB_OFF + 5120;
constexpr int MOE_MAX_RT = 6;
struct MoeDownSched {
    const char* HID; const char* W; const int2* list; LAS unsigned char* lds; int R, ntile, G, c;
    __device__ __forceinline__ int vcu() const { return (G % 8 == 0) ? (c % 8) * (G / 8) + c / 8 : c; }
    __device__ __forceinline__ bool next(int i, pg8::Unit& u) const {
        const int q = vcu() + G * (i >> 2); if (q >= ntile || (i >> 2) >= MOE_MAX_RT) return false;
        const int e = (q < R) ? (int)((LAS unsigned short*)(lds + MOE_TAB_OFF + 2176))[q] : 256;
        u.pm = q; u.pn = e * 4 + (i & 3); u.ord = i >> 2; return true; }
    __device__ __forceinline__ void prepare() const {
        const int tid = threadIdx.x, r = tid & 255;
        for (int o = tid >> 8; o < MOE_MAX_RT; o += 2) {
            const int q = vcu() + G * o; if (q >= ntile) break;
            u32x2 en;
            if (q < R) { const int e = ((LAS unsigned short*)(lds + MOE_TAB_OFF + 2176))[q]; const int ts = ((LAS int*)(lds + MOE_TAB_OFF))[e], cn = ((LAS int*)(lds + MOE_TAB_OFF + 1088))[e];
                const int lr = (q - ts) * 256 + r; if (lr < cn) { const int2 le = list[(size_t)e * LISTCAP + lr]; en.x = (unsigned)le.x; en.y = (unsigned)le.y; } else { en.x = 0xffffffffu; en.y = 0u; } }
            else { en.x = (unsigned)(((q - R) * 256 + r) * 10 + 8); en.y = __float_as_uint(1.0f); }
            ((LAS u32x2*)(lds + MOE_RI_OFF))[o * 256 + r] = en;
        }
        __syncthreads();
    }
    static constexpr bool GATHER = false;
    __device__ __forceinline__ unsigned lane_off(int r) const { return (unsigned)r * 256u; }
    __device__ __forceinline__ unsigned unit_off(const pg8::Unit& u, int h) const { return (unsigned)(u.pm * 256 + h * 128) * 256u; }
    __device__ __forceinline__ unsigned aoff(const pg8::Unit&, int) const { return 0u; }
    __device__ __forceinline__ const char* abase() const { return HID; }
    __device__ __forceinline__ const char* bptr(const pg8::Unit& u) const { return W + (size_t)u.pn * (256 * 256); }
};
struct EpiDown {
    static constexpr bool PERM = true, PERM16 = true;
    unsigned char* YB; LAS unsigned char* lds;
    __device__ __forceinline__ void operator()(const f32x4 (&acc)[2][2][4][2], const pg8::Unit& u, int wr, int wc, int fr, int fq) const {
        asm volatile("" : "+v"(fr), "+v"(fq));
        const unsigned c0b = (unsigned)((u.pn & 3) * 256 + wc * 64 + 16 * fq); const bool shared = (u.pn >> 2) == 256;
        const LAS u32x2* ri = (const LAS u32x2*)(lds + MOE_RI_OFF) + u.ord * 256 + wr * 64 + fr;
#pragma unroll
        for (int ai = 0; ai < 2; ++ai)
#pragma unroll
            for (int m = 0; m < 4; ++m) { const u32x2 en = ri[ai * 128 + m * 16]; const float wv = __uint_as_float(en.y) * (YB_SCALE / (H8_SCALE * W8_SCALE));
                if ((int)en.x >= 0) { unsigned char* rp = YB + (size_t)(en.x * 1024u + c0b);
                    const f32x4 v00 = acc[ai][0][m][0] * wv, v01 = acc[ai][0][m][1] * wv, v10 = acc[ai][1][m][0] * wv, v11 = acc[ai][1][m][1] * wv;
                    const u32x2 h0 = pack8_fp8(v00, v01), h1 = pack8_fp8(v10, v11);
                    *(u32x4*)rp = (u32x4){h0.x, h0.y, h1.x, h1.y};
                    if (YB_NSLOT == 10 && shared) {
                        u32x2 r_[2];
#pragma unroll
                        for (int bj = 0; bj < 2; ++bj) { const u32x2 h = bj ? h1 : h0; const f32x4 v0 = bj ? v10 : v00, v1 = bj ? v11 : v01;
                            const auto a0 = __builtin_amdgcn_cvt_pk_f32_fp8((int)h.x, false), a1 = __builtin_amdgcn_cvt_pk_f32_fp8((int)h.x, true), a2 = __builtin_amdgcn_cvt_pk_f32_fp8((int)h.y, false), a3 = __builtin_amdgcn_cvt_pk_f32_fp8((int)h.y, true);
                            const f32x4 r0 = {v0[0] - a0[0], v0[1] - a0[1], v0[2] - a1[0], v0[3] - a1[1]}, r1 = {v1[0] - a2[0], v1[1] - a2[1], v1[2] - a3[0], v1[3] - a3[1]};
                            r_[bj] = pack8_fp8(r0, r1); }
                        *(u32x4*)(rp + 1024) = (u32x4){r_[0].x, r_[0].y, r_[1].x, r_[1].y}; } } }
    }
};

struct EpiInprojN {
    static constexpr bool PERM = true, PERM16 = false; bf16_t* QN; bf16_t* QR; bf16_t* KV6; float* GATES; const float* ROT;
    __device__ __forceinline__ void operator()(const f32x4 (&acc)[2][2][4][2], const pg8::Unit& u, int wr, int wc, int fr, int fq) const {
        const int row0 = u.pm * 256 + wr * 64 + fr, cl = wc * 32 + 8 * fq, pn = u.pn;
        const bool isq = pn < 4, rotk = (pn == 6 || pn == 8), dorot = (isq || rotk) && ((wc & 1) == 0);
#pragma unroll
        EPI_ROWLOOP { const int row = row0 + ai * 128 + m * 16;
            if (pn == 10) {
                if (cl < 48) { *(f32x4*)(GATES + (size_t)row * 48 + cl) = sig4(acc[ai][0][m][0]); *(f32x4*)(GATES + (size_t)row * 48 + cl + 4) = sig4(acc[ai][0][m][1]); }
            } else {
                f32x4 cs0, cs1, sn0, sn1;
                if (dorot) { const float* rt = ROT + (size_t)(row & (T - 1)) * 16; cs0 = *(const f32x4*)rt; cs1 = *(const f32x4*)(rt + 4); sn0 = *(const f32x4*)(rt + 8); sn1 = *(const f32x4*)(rt + 12); }
#pragma unroll
                for (int bj = 0; bj < 2; ++bj) {
                    const f32x4 v0 = acc[ai][bj][m][0], v1 = acc[ai][bj][m][1];
                    f32x4 r0 = v0, r1 = v1;
                    if (dorot) {
                        f32x4 p0, p1;
#pragma unroll
                        for (int i = 0; i < 4; ++i) { p0[i] = __shfl_xor(v0[i], 16); p1[i] = __shfl_xor(v1[i], 16); }
                        if (fq == 0) { r0 = v0 * cs0 - p0 * sn0; r1 = v1 * cs1 - p1 * sn1; }
                        else if (fq == 1) { r0 = v0 * cs0 + p0 * sn0; r1 = v1 * cs1 + p1 * sn1; }
                    }
                    if (isq) { const int c = pn * 256 + bj * 128 + cl;
                        *(u32x4*)(QN + (size_t)row * 1024 + c) = pack8(v0 * QSCALE, v1 * QSCALE); *(u32x4*)(QR + (size_t)row * 1024 + c) = pack8(r0 * QSCALE, r1 * QSCALE); }
                    else { const int cc = bj * 128 + cl, g = cc >> 6, d = cc & 63, b = row >> 13, t = row & (T - 1);
                        *(u32x4*)(KV6 + ((size_t)((pn - 4) * 16 + b * 4 + g) * T + t) * 64 + d) = pack8(r0, r1); }
                }
            } }
    }
};

struct Cmp1Sched {
    const char* KV6; const char* W; int G, c;
    static constexpr bool GATHER = false;
    __device__ __forceinline__ bool next(int i, pg8::Unit& u) const { const int L = i * G + c; if (L >= 64) return false; u.pm = L >> 1; u.pn = L & 1; u.ord = i; return true; }
    __device__ __forceinline__ unsigned lane_off(int r) const { return (unsigned)r * 2048u; }
    __device__ __forceinline__ unsigned unit_off(const pg8::Unit& u, int h) const { return (unsigned)u.pn * (unsigned)(16 * T * 64 * 2) + (unsigned)(u.pm * 256 + h * 128) * 2048u; }
    __device__ __forceinline__ unsigned aoff(const pg8::Unit&, int) const { return 0u; }
    __device__ __forceinline__ const char* abase() const { return KV6; }
    __device__ __forceinline__ const char* bptr(const pg8::Unit& u) const { return W + (size_t)u.pn * (256 * 2048 * 2); }
};
struct EpiCmp1 {
    static constexpr bool PERM = true, PERM16 = false; bf16_t* CH1; const float* bias1;
    __device__ __forceinline__ void operator()(const f32x4 (&acc)[2][2][4][2], const pg8::Unit& u, int wr, int wc, int fr, int fq) const {
        const int row0 = u.pm * 256 + wr * 64 + fr, cl = wc * 32 + 8 * fq;
        const f32x4 b0 = *(const f32x4*)(bias1 + u.pn * 128 + cl), b1 = *(const f32x4*)(bias1 + u.pn * 128 + cl + 4);
#pragma unroll
        EPI_ROWLOOP { f32x4 v0 = acc[ai][0][m][0] + b0, v1 = acc[ai][0][m][1] + b1;
#pragma unroll
            for (int i = 0; i < 4; ++i) { v0[i] = gelu_tanh(v0[i]); v1[i] = gelu_tanh(v1[i]); }
            *(u32x4*)(CH1 + ((size_t)u.pn * 8192 + row0 + ai * 128 + m * 16) * 128 + cl) = pack8(v0, v1); }
    }
};

__device__ __forceinline__ void p0_item(const float* W, int K, int N, bf16_t* WT, int kb, int n0, int drow0, LAS float* scr, int lane, bool f8 = false) {
    const int k0 = 64 * kb, n4 = (lane & 15) * 4;
    const bool cok = (n0 + n4) < N;
    f32x4 v[16];
#pragma unroll
    for (int i = 0; i < 16; ++i) { const int kk = 4 * i + (lane >> 4); v[i] = cok ? __builtin_nontemporal_load((const f32x4*)(W + (size_t)(k0 + kk) * N + n0 + n4)) : (f32x4){0.f, 0.f, 0.f, 0.f}; }
#pragma unroll
    for (int i = 0; i < 16; ++i) { const int kk = 4 * i + (lane >> 4); LAS float* d = scr + kk * 65 + n4; d[0] = v[i][0]; d[1] = v[i][1]; d[2] = v[i][2]; d[3] = v[i][3]; }
    asm volatile("s_waitcnt lgkmcnt(0)" ::: "memory");
    if (f8) {
        const int c4 = lane & 3;
#pragma unroll
        for (int j = 0; j < 4; ++j) { const int n = (lane >> 2) + 16 * j; const LAS float* sp = scr + (16 * c4) * 65 + n;
            u32x4 o;
            o.x = pk4_fp8(sp[0 * 65] * W8_SCALE, sp[1 * 65] * W8_SCALE, sp[2 * 65] * W8_SCALE, sp[3 * 65] * W8_SCALE); o.y = pk4_fp8(sp[4 * 65] * W8_SCALE, sp[5 * 65] * W8_SCALE, sp[6 * 65] * W8_SCALE, sp[7 * 65] * W8_SCALE);
            o.z = pk4_fp8(sp[8 * 65] * W8_SCALE, sp[9 * 65] * W8_SCALE, sp[10 * 65] * W8_SCALE, sp[11 * 65] * W8_SCALE); o.w = pk4_fp8(sp[12 * 65] * W8_SCALE, sp[13 * 65] * W8_SCALE, sp[14 * 65] * W8_SCALE, sp[15 * 65] * W8_SCALE);
            if (n0 + n < N) __builtin_nontemporal_store(o, (u32x4*)((unsigned char*)WT + (size_t)(drow0 + n) * K + k0 + 16 * c4)); }
        asm volatile("s_waitcnt lgkmcnt(0)" ::: "memory");
        return;
    }
    const int c = lane & 7;
#pragma unroll
    for (int j = 0; j < 8; ++j) { const int n = (lane >> 3) + 8 * j; const LAS float* sp = scr + (8 * c) * 65 + n;
        u32x4 o; o.x = pk2(sp[0 * 65], sp[1 * 65]); o.y = pk2(sp[2 * 65], sp[3 * 65]); o.z = pk2(sp[4 * 65], sp[5 * 65]); o.w = pk2(sp[6 * 65], sp[7 * 65]);
        if (n0 + n < N) __builtin_nontemporal_store(o, (u32x4*)(WT + (size_t)(drow0 + n) * K + k0 + 8 * c)); }
    asm volatile("s_waitcnt lgkmcnt(0)" ::: "memory");
}
struct CvtItem { const float* W; bf16_t* WT; int K, N, k0, n0, drow0; };
__device__ __forceinline__ void cvt32_load(const CvtItem& it, int lane, f32x4 (&v)[8]) {
    const int n4 = (lane & 7) * 4;
#pragma unroll
    for (int i = 0; i < 8; ++i) { const int kk = 8 * i + (lane >> 3); v[i] = __builtin_nontemporal_load((const f32x4*)(it.W + (size_t)(it.k0 + kk) * it.N + it.n0 + n4)); }
}
__device__ __forceinline__ void cvt32_finish(const CvtItem& it, int lane, const f32x4 (&v)[8], LAS float* scr) {
    const int n4 = (lane & 7) * 4;
#pragma unroll
    for (int i = 0; i < 8; ++i) { const int kk = 8 * i + (lane >> 3); LAS float* d = scr + kk * 33 + n4; d[0] = v[i][0]; d[1] = v[i][1]; d[2] = v[i][2]; d[3] = v[i][3]; }
    asm volatile("s_waitcnt lgkmcnt(0)" ::: "memory");
    const int c = lane & 7;
#pragma unroll
    for (int j = 0; j < 4; ++j) { const int n = (lane >> 3) + 8 * j; const LAS float* sp = scr + (8 * c) * 33 + n;
        const float v0 = sp[0 * 33], v1 = sp[1 * 33], v2 = sp[2 * 33], v3 = sp[3 * 33], v4 = sp[4 * 33], v5 = sp[5 * 33], v6 = sp[6 * 33], v7 = sp[7 * 33];
        u32x2 o; o.x = pk4_fp8(v0 * W8_SCALE, v1 * W8_SCALE, v2 * W8_SCALE, v3 * W8_SCALE); o.y = pk4_fp8(v4 * W8_SCALE, v5 * W8_SCALE, v6 * W8_SCALE, v7 * W8_SCALE);
        __builtin_nontemporal_store(o, (u32x2*)((unsigned char*)it.WT + (size_t)(it.drow0 + n) * it.K + it.k0 + 8 * c)); }
    asm volatile("s_waitcnt lgkmcnt(0)" ::: "memory");
}
constexpr int CVT1_ITEMS = 257 * 384;
__device__ __forceinline__ CvtItem cvt1_item(const Args& a, int idx) {
    const int e = idx / 384, sub = idx % 384, mat = sub >> 7, r = sub & 127;
    CvtItem it;
    if (mat < 2) { it.W = (e < 256) ? a.in[23 + mat] + ((size_t)256 + e) * (size_t)(D * FF) : a.in[26 + mat] + (size_t)(D * FF);
        it.K = D; it.N = FF; it.k0 = (r >> 3) * 64; it.n0 = (r & 7) * 32; it.drow0 = (it.n0 >> 7) * 256 + mat * 128 + (it.n0 & 127);
        it.WT = (bf16_t*)(a.ws + WS_WGU + (size_t)(257 + e) * 512 * 1024); }
    else { it.W = (e < 256) ? a.in[25] + ((size_t)256 + e) * (size_t)(FF * D) : a.in[28] + (size_t)(FF * D);
        it.K = FF; it.N = D; it.k0 = (r >> 5) * 64; it.n0 = (r & 31) * 32; it.drow0 = it.n0;
        it.WT = (bf16_t*)(a.ws + WS_WD + (size_t)(257 + e) * 1024 * 256); }
    return it;
}
__device__ __forceinline__ void cvt1_run(const Args& a, int& next, int stride, int quota, LAS float* scr, int lane) {
#pragma unroll 1
    for (int q = 0; q < quota && next < CVT1_ITEMS; ++q) {
        CvtItem t[4]; f32x4 v[4][8]; bool ok[4];
#pragma unroll
        for (int u = 0; u < 4; ++u) { const int idx = next + u * stride; ok[u] = idx < CVT1_ITEMS; t[u] = cvt1_item(a, ok[u] ? idx : 0); if (ok[u]) cvt32_load(t[u], lane, v[u]); }
        next += 4 * stride;
#pragma unroll
        for (int u = 0; u < 4; ++u) if (ok[u]) cvt32_finish(t[u], lane, v[u], scr);
    }
}
__device__ __forceinline__ void ph_prologue(const Args& a, LAS unsigned char* lds) {
    const int lane = threadIdx.x & 63, wave = threadIdx.x >> 6;
    LAS float* scr = (LAS float*)(lds + wave * 16640);
    const int gw = blockIdx.x * 8 + wave, ngw = gridDim.x * 8;
    for (int it = gw; it < 257 * 192; it += ngw) {
        const int le = it / 192, sub = it % 192, l = 0, e = le, mat = sub >> 6, r = sub & 63;
        if (mat < 2) {
            const float* W = (e < 256) ? a.in[23 + mat] + ((size_t)l * 256 + e) * (size_t)(D * FF) : a.in[26 + mat] + (size_t)l * (D * FF);
            const int kb = r >> 2, n0 = (r & 3) * 64;
            p0_item(W, D, FF, (bf16_t*)(a.ws + WS_WGU + (size_t)le * 512 * 1024), kb, n0, (n0 >> 7) * 256 + mat * 128 + (n0 & 127), scr, lane, true);
        } else {
            const float* W = (e < 256) ? a.in[25] + ((size_t)l * 256 + e) * (size_t)(FF * D) : a.in[28] + (size_t)l * (FF * D);
            const int kb = r >> 4, n0 = (r & 15) * 64;
            p0_item(W, FF, D, (bf16_t*)(a.ws + WS_WD + (size_t)le * 1024 * 256), kb, n0, n0, scr, lane, true);
        }
    }
    {
        for (int it = gw; it < 512; it += ngw) { const int w = it >> 8, r = it & 255;
            p0_item(a.in[w ? 16 : 8], D, D, (bf16_t*)(a.ws + (w ? WS_WOUTN : WS_WOUT0)), r >> 4, (r & 15) * 64, (r & 15) * 64, scr, lane, w != 0); }
        for (int it = gw; it < 16 * 41; it += ngw) p0_item(a.in[9], D, 2608, (bf16_t*)(a.ws + WS_WINN), it / 41, (it % 41) * 64, (it % 41) * 64, scr, lane);
        for (int it = gw; it < 128; it += ngw) { const int l = it >> 6, r = it & 63;
            p0_item(a.in[21] + (size_t)l * D * NE, D, NE, (bf16_t*)(a.ws + WS_WR) + (size_t)l * NE * D, r >> 2, (r & 3) * 64, (r & 3) * 64, scr, lane); }
        for (int it = gw; it < 16 * 16; it += ngw) { const int kb = it >> 4, n0 = (8 + (it & 15)) * 64;
            const int isg = (n0 >= 1024) ? 1 : 0, rel = n0 - 512 - isg * 512;
            p0_item(a.in[1], D, 1536, (bf16_t*)(a.ws + WS_WIN0), kb, n0, 512 + (rel >> 7) * 256 + isg * 128 + (rel & 127), scr, lane); }
        for (int it = gw; it < 128; it += ngw) { const int kv = it >> 6, r = it & 63;
            p0_item(a.in[kv ? 14 : 11], 2048, 128, (bf16_t*)(a.ws + WS_CW1) + (size_t)kv * 256 * 2048, r >> 1, (r & 1) * 64, (r & 1) * 64, scr, lane); }
    }
    {
        const int gt = blockIdx.x * 512 + threadIdx.x, ngt = gridDim.x * 512;
        u32x4* z0 = (u32x4*)((bf16_t*)(a.ws + WS_WINN) + (size_t)2608 * 1024);
        for (int i = gt; i < 208 * 1024 / 8; i += ngt) z0[i] = (u32x4){0u, 0u, 0u, 0u};
        for (int kv = 0; kv < 2; ++kv) { u32x4* z1 = (u32x4*)((bf16_t*)(a.ws + WS_CW1) + ((size_t)kv * 256 + 128) * 2048);
            for (int i = gt; i < 128 * 2048 / 8; i += ngt) z1[i] = (u32x4){0u, 0u, 0u, 0u}; }
        const float* x = a.in[0]; bf16_t* XA = (bf16_t*)(a.ws + WS_XA);
        for (size_t i = gt; i < (size_t)M * D / 8; i += ngt) { const f32x4 v0 = *(const f32x4*)(x + i * 8), v1 = *(const f32x4*)(x + i * 8 + 4);
            u32x4 o; o.x = pk2(v0[0], v0[1]); o.y = pk2(v0[2], v0[3]); o.z = pk2(v1[0], v1[1]); o.w = pk2(v1[2], v1[3]); *(u32x4*)(XA + i * 8) = o; }
        const float* win = a.in[1]; const float* mix = a.in[2]; const float* psc = a.in[3]; bf16_t* WIN0 = (bf16_t*)(a.ws + WS_WIN0);
        for (int i = gt; i < 512 * 1024; i += ngt) { const int n = i & 511, k = i >> 9, g = n >> 7, nn = n & 127;
            const float* wr_ = win + (size_t)k * 1536 + g * 128; const float* mx = mix + (size_t)g * 128 * 128 + nn;
            float s = 0.f;
            for (int c = 0; c < 128; ++c) s += wr_[c] * mx[(size_t)c * 128];
            WIN0[(size_t)n * 1024 + k] = f2bf(s * psc[n]); }
        float* misc = (float*)(a.ws + WS_MISC);
        for (int i = gt; i < 256; i += ngt) { const int kv = i >> 7, j = i & 127; const float* pos = a.in[kv ? 13 : 10]; const float* w1 = a.in[kv ? 14 : 11];
            float s = 0.f; for (int k = 0; k < 2048; ++k) s += pos[k] * w1[(size_t)k * 128 + j]; misc[i] = s; }
        float* rot = misc + 1024;
        for (int i = gt; i < T * 8; i += ngt) { const int t = i >> 3, f = i & 7;
            const float ang = (float)t * a.inv_freq[f]; const double rev = (double)ang * 0.15915494309189535; const float fr = (float)(rev - floor(rev));
            rot[t * 16 + f] = __builtin_amdgcn_cosf(fr); rot[t * 16 + 8 + f] = __builtin_amdgcn_sinf(fr); }
    }
}

typedef short v4i16_t __attribute__((ext_vector_type(4)));
constexpr int AT_KB = 0, AT_VB = 16384, AT_PS = 32768, AT_MSK = 32768 + 65536;
#define DPP_I(x, ctrl) __builtin_amdgcn_update_dpp((int)(x), (int)(x), (ctrl), 0xF, 0xF, true)
#define DPP_F(x, ctrl) __builtin_bit_cast(float, __builtin_amdgcn_update_dpp(__builtin_bit_cast(int, (float)(x)), __builtin_bit_cast(int, (float)(x)), (ctrl), 0xF, 0xF, true))
__device__ __forceinline__ bf16x8 tr_frag(LAS unsigned char* p0, LAS unsigned char* p1) {
    const v4i16_t a = __builtin_amdgcn_ds_read_tr16_b64_v4i16((LAS v4i16_t*)p0), b = __builtin_amdgcn_ds_read_tr16_b64_v4i16((LAS v4i16_t*)p1);
    return (bf16x8){a[0], a[1], a[2], a[3], b[0], b[1], b[2], b[3]};
}
constexpr size_t TN2_OFF = 786432;
__device__ __forceinline__ void ph_knorm(const Args& a) {
    const bf16_t* KV6 = (const bf16_t*)(a.ws + WS_KV6);
    float* TN2 = (float*)(a.ws + WS_MISC + TN2_OFF);
    const int lane = threadIdx.x & 63, wave = threadIdx.x >> 6;
    const int first = (gridDim.x > 64) ? 64 : 0;
    if ((int)blockIdx.x < first) return;
    const int wi = ((int)blockIdx.x - first) * 8 + wave, nw = ((int)gridDim.x - first) * 8;
    for (int id = wi; id < 4096; id += nw) {
        const int ty = id >> 11, bg = (id >> 7) & 15, tile = id & 127;
        const bf16_t* rp = KV6 + ((size_t)((ty ? 4 : 2) * 16 + bg) * T + tile * 64 + lane) * 64;
        float ssq = 0.f;
#pragma unroll
        for (int c = 0; c < 8; ++c) { const bf16x8 v = *(const bf16x8*)(rp + 8 * c);
#pragma unroll
            for (int j = 0; j < 8; ++j) { const float f = bf2f((bf16_t)v[j]); ssq += f * f; } }
        ssq = wave_max(ssq);
        if (lane == 0) TN2[id] = ssq;
    }
}
__device__ __forceinline__ void attn_qk2(LAS unsigned char* Kb, const bf16x8 (&q)[2][2], int fr, int g4, const float (&cinit)[2], f32x4 (&s)[2][4]) {
#pragma unroll
    for (int c = 0; c < 4; ++c) {
#pragma unroll
        for (int rb = 0; rb < 2; ++rb) s[rb][c] = (f32x4){cinit[rb], cinit[rb], cinit[rb], cinit[rb]};
#pragma unroll
        for (int ks = 0; ks < 2; ++ks) {
            const bf16x8 kf = *(const LAS bf16x8*)(Kb + pg8::lds_byte(16 * c + fr, 32 * ks + 8 * g4));
#pragma unroll
            for (int rb = 0; rb < 2; ++rb) s[rb][c] = __builtin_amdgcn_mfma_f32_16x16x32_bf16(kf, q[rb][ks], s[rb][c], 0, 0, 0);
        }
    }
}
__device__ __forceinline__ void attn_qk2m(LAS unsigned char* Kb, const bf16x8 (&q)[2][2], int fr, int g4, const float (&cinit)[2], f32x4 (&s)[2][4]) {
    bf16x8 kf[4][2];
#pragma unroll
    for (int c = 0; c < 4; ++c)
#pragma unroll
        for (int ks = 0; ks < 2; ++ks) kf[c][ks] = *(const LAS bf16x8*)(Kb + pg8::lds_byte(16 * c + fr, 32 * ks + 8 * g4));
    __builtin_amdgcn_sched_barrier(0);
    f32x4 ci[2];
#pragma unroll
    for (int rb = 0; rb < 2; ++rb) ci[rb] = (f32x4){cinit[rb], cinit[rb], cinit[rb], cinit[rb]};
#pragma unroll
    for (int c = 0; c < 4; ++c) {
#pragma unroll
        for (int ks = 0; ks < 2; ++ks) {
#pragma unroll
            for (int rb = 0; rb < 2; ++rb) s[rb][c] = __builtin_amdgcn_mfma_f32_16x16x32_bf16(kf[c][ks], q[rb][ks], ks == 0 ? ci[rb] : s[rb][c], 0, 0, 0);
        }
    }
}
__device__ __forceinline__ void attn_qk2z(LAS unsigned char* Kb, const bf16x8 (&q)[2][2], int fr, int g4, f32x4 (&s)[2][4]) {
    bf16x8 kf[4][2];
#pragma unroll
    for (int c = 0; c < 4; ++c)
#pragma unroll
        for (int ks = 0; ks < 2; ++ks) kf[c][ks] = *(const LAS bf16x8*)(Kb + pg8::lds_byte(16 * c + fr, 32 * ks + 8 * g4));
    __builtin_amdgcn_sched_barrier(0);
#pragma unroll
    for (int c = 0; c < 4; ++c) {
#pragma unroll
        for (int ks = 0; ks < 2; ++ks) {
#pragma unroll
            for (int rb = 0; rb < 2; ++rb) s[rb][c] = __builtin_amdgcn_mfma_f32_16x16x32_bf16(kf[c][ks], q[rb][ks], ks == 0 ? (f32x4){0.f, 0.f, 0.f, 0.f} : s[rb][c], 0, 0, 0);
        }
    }
}
struct AttnRow { float m; f32x4 o[4]; f32x4 ol; };
__device__ __forceinline__ float max3f(float a, float b, float c) { float r; asm("v_max3_f32 %0, %1, %2, %3" : "=v"(r) : "v"(a), "v"(b), "v"(c)); return r; }
__device__ __forceinline__ bool attn_sm2(f32x4 (&s)[4], AttnRow& st, int kbase, int g4, int lo, int hi, bool en, bool emask) {
    const float NEG = -INFINITY;
    if (emask) {
#pragma unroll
        for (int c = 0; c < 4; ++c)
#pragma unroll
            for (int i = 0; i < 4; ++i) { const int key = kbase + 16 * c + 4 * g4 + i; if (key < lo || key > hi) s[c][i] = NEG; }
    }
    float mx = max3f(s[0][0], s[0][1], s[0][2]); mx = max3f(mx, s[0][3], s[1][0]); mx = max3f(mx, s[1][1], s[1][2]); mx = max3f(mx, s[1][3], s[2][0]);
    mx = max3f(mx, s[2][1], s[2][2]); mx = max3f(mx, s[2][3], s[3][0]); mx = max3f(mx, s[3][1], s[3][2]); mx = max3f(mx, s[3][3], mx);
    if (!en) mx = NEG;
    mx = max3f(mx, __shfl_xor(mx, 16), mx); mx = max3f(mx, __shfl_xor(mx, 32), mx);
    const float delta = (mx > 20.0f) ? mx : 0.f;
    const bool moved = __builtin_amdgcn_ballot_w64(delta != 0.f) != 0ull;
    if (moved) {
        const float alpha = __builtin_amdgcn_exp2f(-delta);
#pragma unroll
        for (int c = 0; c < 4; ++c) s[c] = s[c] - delta;
#pragma unroll
        for (int dt = 0; dt < 4; ++dt) st.o[dt] *= alpha;
        st.ol *= alpha;
        st.m += delta;
    }
#pragma unroll
    for (int c = 0; c < 4; ++c)
#pragma unroll
        for (int i = 0; i < 4; ++i) s[c][i] = __builtin_amdgcn_exp2f(s[c][i]);
    return moved;
}
__device__ __forceinline__ bool attn_sm2x(f32x4 (&s)[2][4], AttnRow (&st)[2], int kbase, int g4, const int (&lo)[2], const int (&hi)[2], const bool (&en)[2], bool emask) {
    const float NEG = -INFINITY;
    if (emask) {
#pragma unroll
        for (int rb = 0; rb < 2; ++rb)
#pragma unroll
            for (int c = 0; c < 4; ++c)
#pragma unroll
                for (int i = 0; i < 4; ++i) { const int key = kbase + 16 * c + 4 * g4 + i; if (key < lo[rb] || key > hi[rb]) s[rb][c][i] = NEG; }
    }
    float mx[2];
#pragma unroll
    for (int rb = 0; rb < 2; ++rb) {
        float m = max3f(s[rb][0][0], s[rb][0][1], s[rb][0][2]); m = max3f(m, s[rb][0][3], s[rb][1][0]); m = max3f(m, s[rb][1][1], s[rb][1][2]); m = max3f(m, s[rb][1][3], s[rb][2][0]);
        m = max3f(m, s[rb][2][1], s[rb][2][2]); m = max3f(m, s[rb][2][3], s[rb][3][0]); m = max3f(m, s[rb][3][1], s[rb][3][2]); m = max3f(m, s[rb][3][3], m);
        mx[rb] = en[rb] ? m : NEG;
    }
    { const float t0 = __shfl_xor(mx[0], 16), t1 = __shfl_xor(mx[1], 16); mx[0] = max3f(mx[0], t0, t0); mx[1] = max3f(mx[1], t1, t1); }
    { const float t0 = __shfl_xor(mx[0], 32), t1 = __shfl_xor(mx[1], 32); mx[0] = max3f(mx[0], t0, t0); mx[1] = max3f(mx[1], t1, t1); }
    const float d0 = (mx[0] > 20.0f) ? mx[0] : 0.f, d1 = (mx[1] > 20.0f) ? mx[1] : 0.f;
    const bool moved = __builtin_amdgcn_ballot_w64((d0 != 0.f) || (d1 != 0.f)) != 0ull;
    if (moved) {
        const float dl[2] = {d0, d1};
#pragma unroll
        for (int rb = 0; rb < 2; ++rb) {
            const float alpha = __builtin_amdgcn_exp2f(-dl[rb]);
#pragma unroll
            for (int c = 0; c < 4; ++c) s[rb][c] = s[rb][c] - dl[rb];
#pragma unroll
            for (int dt = 0; dt < 4; ++dt) st[rb].o[dt] *= alpha;
            st[rb].ol *= alpha; st[rb].m += dl[rb];
        }
    }
#pragma unroll
    for (int rb = 0; rb < 2; ++rb)
#pragma unroll
        for (int c = 0; c < 4; ++c)
#pragma unroll
            for (int i = 0; i < 4; ++i) s[rb][c][i] = __builtin_amdgcn_exp2f(s[rb][c][i]);
    return moved;
}
__device__ __forceinline__ void attn_pv2x(LAS unsigned char* Vb, const f32x4 (&p)[2][4], int vlane, int swz, const unsigned (&enm)[2], const bool (&act)[2], const bf16x8 onesf, AttnRow (&st)[2]) {
#pragma unroll
    for (int ks = 0; ks < 2; ++ks) {
        bf16x8 pb[2];
#pragma unroll
        for (int rb = 0; rb < 2; ++rb) { u32x4 pw = pack8m(p[rb][2 * ks], p[rb][2 * ks + 1]); pw.x &= enm[rb]; pw.y &= enm[rb]; pw.z &= enm[rb]; pw.w &= enm[rb]; pb[rb] = __builtin_bit_cast(bf16x8, pw); }
#pragma unroll
        for (int dt = 0; dt < 4; ++dt) {
            LAS unsigned char* a0 = Vb + vlane + (2 * ks) * 2048 + ((dt ^ swz) * 32);
            const bf16x8 vf = tr_frag(a0, a0 + 2048);
#pragma unroll
            for (int rb = 0; rb < 2; ++rb) if (act[rb]) st[rb].o[dt] = __builtin_amdgcn_mfma_f32_16x16x32_bf16(vf, pb[rb], st[rb].o[dt], 0, 0, 0);
        }
#pragma unroll
        for (int rb = 0; rb < 2; ++rb) if (act[rb]) st[rb].ol = __builtin_amdgcn_mfma_f32_16x16x32_bf16(onesf, pb[rb], st[rb].ol, 0, 0, 0);
    }
}
__device__ __forceinline__ bool attn_max2x(f32x4 (&s)[2][4], int kbase, int g4, const int (&lo)[2], const int (&hi)[2], const bool (&en)[2], bool emask, float (&d)[2]) {
    const float NEG = -INFINITY;
    MFMA_SETTLE(s);
    if (emask) {
#pragma unroll
        for (int rb = 0; rb < 2; ++rb)
#pragma unroll
            for (int c = 0; c < 4; ++c)
#pragma unroll
                for (int i = 0; i < 4; ++i) { const int key = kbase + 16 * c + 4 * g4 + i; if (key < lo[rb] || key > hi[rb]) s[rb][c][i] = NEG; }
    }
    float mx[2];
#pragma unroll
    for (int rb = 0; rb < 2; ++rb) {
        float m = max3f(s[rb][0][0], s[rb][0][1], s[rb][0][2]); m = max3f(m, s[rb][0][3], s[rb][1][0]); m = max3f(m, s[rb][1][1], s[rb][1][2]); m = max3f(m, s[rb][1][3], s[rb][2][0]);
        m = max3f(m, s[rb][2][1], s[rb][2][2]); m = max3f(m, s[rb][2][3], s[rb][3][0]); m = max3f(m, s[rb][3][1], s[rb][3][2]); m = max3f(m, s[rb][3][3], m);
        mx[rb] = en[rb] ? m : NEG;
    }
    { const float t0 = __shfl_xor(mx[0], 16), t1 = __shfl_xor(mx[1], 16); mx[0] = max3f(mx[0], t0, t0); mx[1] = max3f(mx[1], t1, t1); }
    { const float t0 = __shfl_xor(mx[0], 32), t1 = __shfl_xor(mx[1], 32); mx[0] = max3f(mx[0], t0, t0); mx[1] = max3f(mx[1], t1, t1); }
    d[0] = (mx[0] > 20.0f) ? mx[0] : 0.f; d[1] = (mx[1] > 20.0f) ? mx[1] : 0.f;
    return __builtin_amdgcn_ballot_w64((d[0] != 0.f) || (d[1] != 0.f)) != 0ull;
}
__device__ __forceinline__ void attn_rescale2x(f32x4 (&s)[2][4], AttnRow (&st)[2], const float (&d)[2]) {
#pragma unroll
    for (int rb = 0; rb < 2; ++rb) {
        const float alpha = __builtin_amdgcn_exp2f(-d[rb]);
#pragma unroll
        for (int c = 0; c < 4; ++c) s[rb][c] = s[rb][c] - d[rb];
#pragma unroll
        for (int dt = 0; dt < 4; ++dt) st[rb].o[dt] *= alpha;
        st[rb].ol *= alpha; st[rb].m += d[rb];
    }
}
__device__ __forceinline__ void attn_exp1(f32x4 (&s)[4], unsigned enm, bf16x8 (&pb)[2]) {
#pragma unroll
    for (int c = 0; c < 4; ++c)
#pragma unroll
        for (int i = 0; i < 4; ++i) s[c][i] = __builtin_amdgcn_exp2f(s[c][i]);
#pragma unroll
    for (int ks = 0; ks < 2; ++ks) { u32x4 pw = pack8m(s[2 * ks], s[2 * ks + 1]); pw.x &= enm; pw.y &= enm; pw.z &= enm; pw.w &= enm; pb[ks] = __builtin_bit_cast(bf16x8, pw); }
}
__device__ __forceinline__ void attn_pv1(LAS unsigned char* Vb, const bf16x8 (&pb)[2], int vlane, int swz, const bf16x8 onesf, AttnRow& st) {
#pragma unroll
    for (int ks = 0; ks < 2; ++ks) {
#pragma unroll
        for (int dt = 0; dt < 4; ++dt) {
            LAS unsigned char* a0 = Vb + vlane + (2 * ks) * 2048 + ((dt ^ swz) * 32);
            const bf16x8 vf = tr_frag(a0, a0 + 2048);
            st.o[dt] = __builtin_amdgcn_mfma_f32_16x16x32_bf16(vf, pb[ks], st.o[dt], 0, 0, 0);
        }
        st.ol = __builtin_amdgcn_mfma_f32_16x16x32_bf16(onesf, pb[ks], st.ol, 0, 0, 0);
    }
}
__device__ __forceinline__ bool attn_step2x(LAS unsigned char* Vb, f32x4 (&s)[2][4], AttnRow (&st)[2], int kbase, int g4, const int (&lo)[2], const int (&hi)[2], const bool (&en)[2], const unsigned (&enm)[2], bool emask,
                                            int vlane, int swz, const bf16x8 onesf) {
    float d[2];
    const bool moved = attn_max2x(s, kbase, g4, lo, hi, en, emask, d);
    if (moved) attn_rescale2x(s, st, d);
    bf16x8 p0[2], p1[2];
    attn_exp1(s[0], enm[0], p0);
    attn_pv1(Vb, p0, vlane, swz, onesf, st[0]);
    attn_exp1(s[1], enm[1], p1);
    attn_pv1(Vb, p1, vlane, swz, onesf, st[1]);
    return moved;
}
__device__ __forceinline__ void attn_step2x_nomax(LAS unsigned char* Vb, f32x4 (&s)[2][4], AttnRow (&st)[2], int kbase, int g4, const int (&lo)[2], const int (&hi)[2], const unsigned (&enm)[2], bool emask,
                                                  int vlane, int swz, const bf16x8 onesf) {
    if (emask) {
#pragma unroll
        for (int rb = 0; rb < 2; ++rb)
#pragma unroll
            for (int c = 0; c < 4; ++c)
#pragma unroll
                for (int i = 0; i < 4; ++i) { const int key = kbase + 16 * c + 4 * g4 + i; if (key < lo[rb] || key > hi[rb]) s[rb][c][i] = -INFINITY; }
    }
    bf16x8 p0[2], p1[2];
    attn_exp1(s[0], enm[0], p0);
    attn_pv1(Vb, p0, vlane, swz, onesf, st[0]);
    attn_exp1(s[1], enm[1], p1);
    attn_pv1(Vb, p1, vlane, swz, onesf, st[1]);
}
typedef _Float16 f16x4 __attribute__((ext_vector_type(4)));
constexpr int AT4_KB = 0, AT4_VB = 32768, AT2_PS = 65536, AT2_MSK = 65536 + 65536;
__device__ __forceinline__ int attn_pair_of(int pr) { const int p = pr & 63, k = pr >> 8; const int q = (k & 2) ? ((p + 32) & 63) : p; return (k & 1) ? 63 - q : q; }
__device__ __forceinline__ void ph_attn_fast2(const Args& a, LAS unsigned char* lds) {
    const bf16_t* QN = (const bf16_t*)(a.ws + WS_HN);
    const bf16_t* QR = (const bf16_t*)(a.ws + WS_QR);
    const bf16_t* KV6 = (const bf16_t*)(a.ws + WS_KV6);
    const float* GATES = (const float*)(a.ws + WS_GATES);
    const bf16_t* KC = (const bf16_t*)(a.ws + WS_KC);
    const bf16_t* VC = KC + (size_t)8192 * 64;
    bf16_t* O = (bf16_t*)(a.ws + WS_O);
    const int tid = threadIdx.x, lane = tid & 63, wave = __builtin_amdgcn_readfirstlane(tid >> 6);
    const int fr = lane & 15, g4 = lane >> 4;
    int ksrc, vsrc;
    { int R, C; pg8::stage_rc(wave * 1024 + lane * 16, R, C); ksrc = R * 64 + C;
      const int key = 8 * wave + (lane >> 3), pos = lane & 7, chunk = (pos >> 1) ^ ((key >> 1) & 3); vsrc = key * 64 + (chunk * 2 + (pos & 1)) * 8; }
    const int vlane = (4 * g4 + (fr >> 2)) * 128 + (fr & 3) * 8, swz = (2 * g4 + (fr >> 3)) & 3;
    LAS _Float16* ps = (LAS _Float16*)(lds + AT2_PS + wave * 8192);
    LAS unsigned* mskl = (LAS unsigned*)(lds + AT2_MSK + wave * 128);
    const float NEG = -INFINITY;
    const bf16x8 onesf = (fr == 0) ? (bf16x8){0x3F80, 0x3F80, 0x3F80, 0x3F80, 0x3F80, 0x3F80, 0x3F80, 0x3F80} : (bf16x8){0, 0, 0, 0, 0, 0, 0, 0};
    const int vcu = (gridDim.x % 8 == 0) ? (int)((blockIdx.x % 8) * (gridDim.x / 8) + blockIdx.x / 8) : (int)blockIdx.x;
    int cvt_next = (int)blockIdx.x * 8 + wave; const int cvt_stride = (int)gridDim.x * 8;
    LAS float* cvt_scr = (LAS float*)(lds + AT2_PS + wave * 8448);
    bool cmp_pref = false;
    for (int pr = vcu; pr < 1024; pr += gridDim.x) {
#pragma unroll 1
        for (int half = 0; half < 2; ++half) {
            const int bg = pr >> 6, pp = attn_pair_of(pr), cc = half ? (127 - pp) : pp;
            const int b = bg >> 2, g = bg & 3, t0 = cc * 64, cur = cc;
            const int head = g * 4 + (fr & 3);
            int trow[2];
            bf16x8 qn[2][2];
#pragma unroll
            for (int rb = 0; rb < 2; ++rb) {
                trow[rb] = t0 + 8 * wave + 4 * rb + (fr >> 2);
#pragma unroll
                for (int ks = 0; ks < 2; ++ks) qn[rb][ks] = *(const bf16x8*)(QN + ((size_t)b * T + trow[rb]) * 1024 + head * 64 + 32 * ks + 8 * g4);
            }
#define TROW_PIN() asm volatile("" : "+v"(trow[0]), "+v"(trow[1]))
#define TOKROW(rb) ((size_t)b * T + trow[rb])
#define GATE(rb, br) (GATES[TOKROW(rb) * 48 + head * 3 + (br)])
            const bf16_t* kcb = KC + (size_t)bg * 512 * 64;
            const bf16_t* kvb = KV6 + (size_t)bg * T * 64;
#define ATK(sl) (((sl) < 4 ? AT4_KB : AT2_PS - 4 * 8192) + (sl) * 8192)
#define ATV(sl) (((sl) < 4 ? AT4_VB : AT2_PS + 32768 - 4 * 8192) + (sl) * 8192)
#define AT_DMA(BR, tile, slot) do { const bf16_t* kp_; const bf16_t* vp_; \
                if ((BR) == 0) { kp_ = kcb + (size_t)(tile) * 4096; vp_ = kp_ + (size_t)8192 * 64; } \
                else { kp_ = kvb + (size_t)((BR) == 1 ? 2 : 4) * 16 * T * 64 + (size_t)(tile) * 4096; vp_ = kp_ + (size_t)16 * T * 64; } \
                __builtin_amdgcn_global_load_lds((const unsigned*)(kp_ + ksrc), (LAS unsigned*)(lds + ATK(slot) + wave * 1024), 16, 0, 0); \
                __builtin_amdgcn_global_load_lds((const unsigned*)(vp_ + vsrc), (LAS unsigned*)(lds + ATV(slot) + wave * 1024), 16, 0, 0); } while (0)
            int ncv[2];
#pragma unroll
            for (int rb = 0; rb < 2; ++rb) ncv[rb] = (trow[rb] >= 31) ? ((trow[rb] - 31) / 16 + 1) : 0;
            const int nct = (((t0 + 63 - 31) / 16 + 1) + 63) >> 6;
            float mc[2], invc[2];
            const int t_lo = t0 + 8 * wave, ncv_lo = (t_lo >= 31) ? ((t_lo - 31) / 16 + 1) : 0;
            {
                float m1[2] = {NEG, NEG}, l1[2] = {0.f, 0.f};
                const float zero2[2] = {0.f, 0.f};
#define CMP1_TILE(J, SLOT, MASKED) do { const int j = (J); const int SLOT_ = (SLOT); \
                    f32x4 s[2][4]; attn_qk2(lds + AT4_KB + SLOT_ * 8192, qn, fr, g4, zero2, s); \
                    _Pragma("unroll") \
                    for (int rb = 0; rb < 2; ++rb) { \
                        float mx = NEG; \
                    _Pragma("unroll") \
                        for (int c = 0; c < 4; ++c) \
                    _Pragma("unroll") \
                            for (int i = 0; i < 4; ++i) { const int n = 64 * j + 16 * c + 4 * g4 + i; if ((MASKED) && n >= ncv[rb]) s[rb][c][i] = NEG; mx = fmaxf(mx, s[rb][c][i]); } \
                        mx = fmaxf(mx, __shfl_xor(mx, 16)); mx = fmaxf(mx, __shfl_xor(mx, 32)); \
                        const float mn = fmaxf(m1[rb], mx), msafe = (mn == NEG) ? 0.f : mn; \
                        const float alpha = (m1[rb] == NEG) ? 0.f : __builtin_amdgcn_exp2f(m1[rb] - msafe); \
                        float sum = 0.f; \
                    _Pragma("unroll") \
                        for (int c = 0; c < 4; ++c) \
                    _Pragma("unroll") \
                            for (int i = 0; i < 4; ++i) sum += __builtin_amdgcn_exp2f(s[rb][c][i] - msafe); \
                        l1[rb] = l1[rb] * alpha + sum; m1[rb] = mn; \
                    } \
                } while (0)
                if (!cmp_pref) { AT_DMA(0, 0, 0); if (nct > 1) AT_DMA(0, 1, 1); } __syncthreads();
                for (int j0 = 0; j0 < nct; j0 += 2) { const int sb = (j0 & 2);
                    if (j0 + 2 < nct) AT_DMA(0, j0 + 2, sb ^ 2);
                    if (j0 + 3 < nct) AT_DMA(0, j0 + 3, (sb ^ 2) + 1);
                    CMP1_TILE(j0, sb, true); if (j0 + 1 < nct) CMP1_TILE(j0 + 1, sb + 1, true);
                    __syncthreads();
                }
#undef CMP1_TILE
#pragma unroll
                for (int rb = 0; rb < 2; ++rb) { float lc = l1[rb]; lc += __shfl_xor(lc, 16); lc += __shfl_xor(lc, 32); invc[rb] = (lc > 0.f) ? -(((m1[rb] == NEG) ? 0.f : m1[rb]) + __builtin_amdgcn_logf(lc)) : 0.f; mc[rb] = (m1[rb] == NEG) ? 0.f : m1[rb]; }
            }
            {
                AttnRow oc[2];
#pragma unroll
                for (int rb = 0; rb < 2; ++rb) { oc[rb].m = 0.f; oc[rb].ol = (f32x4){0.f, 0.f, 0.f, 0.f};
#pragma unroll
                    for (int dt = 0; dt < 4; ++dt) oc[rb].o[dt] = (f32x4){0.f, 0.f, 0.f, 0.f}; }
                const float cin[2] = {invc[0], invc[1]};
                const unsigned full[2] = {0xffffffffu, 0xffffffffu}; const bool both[2] = {true, true};
#define CMP2_TILE(J, SLOT, MASKED) do { const int j = (J); const int SLOT_ = (SLOT); \
                    f32x4 s[2][4]; attn_qk2(lds + AT4_KB + SLOT_ * 8192, qn, fr, g4, cin, s); \
                    _Pragma("unroll") \
                    for (int rb = 0; rb < 2; ++rb) \
                    _Pragma("unroll") \
                        for (int c = 0; c < 4; ++c) { \
                            f16x4 hs; \
                    _Pragma("unroll") \
                            for (int i = 0; i < 4; ++i) { const int n = 64 * j + 16 * c + 4 * g4 + i; const float p = (!(MASKED) || n < ncv[rb]) ? __builtin_amdgcn_exp2f(s[rb][c][i]) : 0.f; s[rb][c][i] = p; \
                                float h = p; h += DPP_F(h, 0xB1); h += DPP_F(h, 0x4E); hs[i] = (_Float16)h; }        \
                            if ((fr & 3) == 0) *(LAS f16x4*)(ps + (4 * rb + (fr >> 2)) * 512 + 64 * j + 16 * c + 4 * g4) = hs; \
                        } \
                    attn_pv2x(lds + AT4_VB + SLOT_ * 8192, s, vlane, swz, full, both, onesf, oc); \
                } while (0)
                const bool reload = nct > 4;
                if (reload) { AT_DMA(0, 0, 0); AT_DMA(0, 1, 1); __syncthreads(); }
                for (int j0 = 0; j0 < nct; j0 += 2) { const int sb = (j0 & 2);
                    if (reload && j0 + 2 < nct) AT_DMA(0, j0 + 2, sb ^ 2);
                    if (reload && j0 + 3 < nct) AT_DMA(0, j0 + 3, (sb ^ 2) + 1);
                    CMP2_TILE(j0, sb, true); if (j0 + 1 < nct) CMP2_TILE(j0 + 1, sb + 1, true);
                    __syncthreads();
                }
#undef CMP2_TILE
                TROW_PIN();
#pragma unroll
                for (int rb = 0; rb < 2; ++rb) { bf16_t* op = O + TOKROW(rb) * 1024 + head * 64 + 4 * g4; const float g0 = GATE(rb, 0);
#pragma unroll
                    for (int dt = 0; dt < 4; ++dt) { const f32x4 v = oc[rb].o[dt] * g0; u32x2 w; w.x = cvt_pk_bf16(v[0], v[1]); w.y = cvt_pk_bf16(v[2], v[3]); *(u32x2*)(op + 16 * dt) = w; } }
            }
            {
                WSYNC();
                const int tl = lane >> 4, li = lane & 15;
                const int nsel = (cur + 1 < 16) ? (cur + 1) : 16;
#pragma unroll 1
                for (int rnd = 0; rnd < 2; ++rnd) {
                    const LAS _Float16* pst = ps + (4 * rnd + tl) * 512;
                    float v[8];
#pragma unroll
                    for (int k = 0; k < 8; ++k) { const int j = li + 16 * k;
                        float x;
                        if (j > cur) x = NEG;
                        else if (j == 0 || j == cur || j == cur - 1) x = NEG;
                        else { const int n0 = 4 * j; x = (float)pst[n0 - 1] + 2.0f * ((float)pst[n0] + (float)pst[n0 + 1] + (float)pst[n0 + 2]) + (float)pst[n0 + 3]; }
                        v[k] = x; }
                    int vi[8];
#pragma unroll
                    for (int k = 0; k < 8; ++k) vi[k] = __builtin_bit_cast(int, v[k]);
                    unsigned mm[4] = {1u, 0u, 0u, 0u};
                    {
                        const unsigned bc = 1u << (cur & 31); const int wc_ = cur >> 5;
                        mm[0] |= (wc_ == 0) ? bc : 0u; mm[1] |= (wc_ == 1) ? bc : 0u; mm[2] |= (wc_ == 2) ? bc : 0u; mm[3] |= (wc_ == 3) ? bc : 0u;
                        if (cur >= 1) { const unsigned bp = 1u << ((cur - 1) & 31); const int wp_ = (cur - 1) >> 5;
                            mm[0] |= (wp_ == 0) ? bp : 0u; mm[1] |= (wp_ == 1) ? bp : 0u; mm[2] |= (wp_ == 2) ? bp : 0u; mm[3] |= (wp_ == 3) ? bp : 0u; }
                    }
                    const int nforced = (cur >= 2) ? 3 : (cur + 1);
                    for (int it = 0; it < nsel - nforced; ++it) {
                        int bv = max(max(max(vi[0], vi[1]), max(vi[2], vi[3])), max(max(vi[4], vi[5]), max(vi[6], vi[7])));
                        bv = max(bv, DPP_I(bv, 0xB1)); bv = max(bv, DPP_I(bv, 0x4E)); bv = max(bv, DPP_I(bv, 0x141)); bv = max(bv, DPP_I(bv, 0x140));
                        int bi = 255;
#pragma unroll
                        for (int k = 7; k >= 0; --k) bi = (vi[k] == bv) ? (li + 16 * k) : bi;
                        bi = min(bi, DPP_I(bi, 0xB1)); bi = min(bi, DPP_I(bi, 0x4E)); bi = min(bi, DPP_I(bi, 0x141)); bi = min(bi, DPP_I(bi, 0x140));
                        const unsigned bit = 1u << (bi & 31); const int wsel = bi >> 5;
                        mm[0] |= (wsel == 0) ? bit : 0u; mm[1] |= (wsel == 1) ? bit : 0u; mm[2] |= (wsel == 2) ? bit : 0u; mm[3] |= (wsel == 3) ? bit : 0u;
                        if ((bi & 15) == li) {
#pragma unroll
                            for (int k = 0; k < 8; ++k) if ((bi >> 4) == k) vi[k] = (int)0xFF800000;
                        }
                    }
                    if (li == 0) { mskl[(4 * rnd + tl) * 4 + 0] = mm[0]; mskl[(4 * rnd + tl) * 4 + 1] = mm[1]; mskl[(4 * rnd + tl) * 4 + 2] = mm[2]; mskl[(4 * rnd + tl) * 4 + 3] = mm[3]; }
                }
                WSYNC();
            }
            bf16x8 qr[2][2];
            TROW_PIN();
#pragma unroll
            for (int rb = 0; rb < 2; ++rb)
#pragma unroll
                for (int ks = 0; ks < 2; ++ks) qr[rb][ks] = *(const bf16x8*)(QR + TOKROW(rb) * 1024 + head * 64 + 32 * ks + 8 * g4);
            bool nomax_slc, nomax_win;
            {
                float qq = 0.f;
#pragma unroll
                for (int rb = 0; rb < 2; ++rb) { float q2 = 0.f;
#pragma unroll
                    for (int ks = 0; ks < 2; ++ks)
#pragma unroll
                        for (int j = 0; j < 8; ++j) { const float x = bf2f((bf16_t)qr[rb][ks][j]); q2 += x * x; }
                    q2 += __shfl_xor(q2, 16); q2 += __shfl_xor(q2, 32); qq = fmaxf(qq, q2); }
                qq = wave_max(qq);
                const float* tn = (const float*)(a.ws + WS_MISC + TN2_OFF) + bg * 128;
                const int jt0w = (t0 >= 511) ? ((t0 - 511) >> 6) : 0;
                float ts = 0.f, tw = 0.f;
#pragma unroll
                for (int h2 = 0; h2 < 2; ++h2) { const int tl_ = lane + 64 * h2; if (tl_ <= cur) { ts = fmaxf(ts, tn[tl_]); if (tl_ >= jt0w) tw = fmaxf(tw, tn[2048 + tl_]); } }
                ts = wave_max(ts); tw = wave_max(tw);
                nomax_slc = __builtin_amdgcn_readfirstlane((qq * ts <= 3500.0f) ? 1 : 0) != 0;
                nomax_win = __builtin_amdgcn_readfirstlane((qq * tw <= 3500.0f) ? 1 : 0) != 0;
            }
            {
                AttnRow ss[2];
#pragma unroll
                for (int rb = 0; rb < 2; ++rb) { ss[rb].m = 0.f; ss[rb].ol = (f32x4){0.f, 0.f, 0.f, 0.f};
#pragma unroll
                    for (int dt = 0; dt < 4; ++dt) ss[rb].o[dt] = (f32x4){0.f, 0.f, 0.f, 0.f}; }
                const int nt_ = cur + 1;
                bool refmoved = false;
#define SLC_PRE(J) const int j_ = (J); bool en[2], act[2]; unsigned enm[2]; \
                    _Pragma("unroll") for (int rb = 0; rb < 2; ++rb) { const unsigned mw = mwg[rb]; \
                        en[rb] = (mw >> (j_ & 31)) & 1u; act[rb] = __any(en[rb]); enm[rb] = en[rb] ? 0xffffffffu : 0u; } const int lo2[2] = {0, 0};
#define SLC_TILE(J, SLOT) do { SLC_PRE(J) \
                    if (act[0] || act[1]) { f32x4 s[2][4]; \
                        if (refmoved) { const float cin[2] = {-ss[0].m, -ss[1].m}; attn_qk2(lds + ATK(SLOT), qr, fr, g4, cin, s); } \
                        else attn_qk2z(lds + ATK(SLOT), qr, fr, g4, s); \
                        refmoved |= attn_step2x(lds + ATV(SLOT), s, ss, 64 * j_, g4, lo2, trow, en, enm, j_ == cur, vlane, swz, onesf); } } while (0)
#define SLC_TILE_NM(J, SLOT) do { SLC_PRE(J) \
                    if (act[0] || act[1]) { f32x4 s[2][4]; const float cm_[2] = {en[0] ? 0.f : -1e30f, en[1] ? 0.f : -1e30f}; attn_qk2m(lds + ATK(SLOT), qr, fr, g4, cm_, s); \
                        const unsigned fullm_[2] = {0xffffffffu, 0xffffffffu}; \
                        attn_step2x_nomax(lds + ATV(SLOT), s, ss, 64 * j_, g4, lo2, trow, fullm_, j_ == cur, vlane, swz, onesf); } } while (0)
#pragma unroll
                for (int i = 0; i < 4; ++i) if (i < nt_) AT_DMA(1, i, i);
                __syncthreads();
#define SLC_LOOP(TILE) for (int j0 = 0; j0 < nt_; j0 += 4) { const int sb = (j0 & 4); \
                    const unsigned mwg[2] = {mskl[(fr >> 2) * 4 + (j0 >> 5)], mskl[(4 + (fr >> 2)) * 4 + (j0 >> 5)]};       \
                    _Pragma("unroll") for (int i = 0; i < 4; ++i) if (j0 + 4 + i < nt_) AT_DMA(1, j0 + 4 + i, (sb ^ 4) + i); \
                    TILE(j0, sb); if (j0 + 1 < nt_) TILE(j0 + 1, sb + 1); if (j0 + 2 < nt_) TILE(j0 + 2, sb + 2); if (j0 + 3 < nt_) TILE(j0 + 3, sb + 3); \
                    __syncthreads(); }
                if (nomax_slc) { SLC_LOOP(SLC_TILE_NM) } else { SLC_LOOP(SLC_TILE) }
#undef SLC_LOOP
#undef SLC_TILE_NM
#undef SLC_PRE
#undef SLC_TILE
                TROW_PIN();
#pragma unroll
                for (int rb = 0; rb < 2; ++rb) { const float l = __shfl(ss[rb].ol[0], fr); const float sc1 = (l > 0.f) ? GATE(rb, 1) / l : 0.f;
                    bf16_t* op = O + TOKROW(rb) * 1024 + head * 64 + 4 * g4;
#pragma unroll
                    for (int dt = 0; dt < 4; ++dt) { const u32x2 pv = *(const u32x2*)(op + 16 * dt); f32x4 v = ss[rb].o[dt] * sc1;
                        v[0] += __uint_as_float(pv.x << 16); v[1] += __uint_as_float(pv.x & 0xffff0000u); v[2] += __uint_as_float(pv.y << 16); v[3] += __uint_as_float(pv.y & 0xffff0000u);
                        u32x2 w; w.x = cvt_pk_bf16(v[0], v[1]); w.y = cvt_pk_bf16(v[2], v[3]); *(u32x2*)(op + 16 * dt) = w; } }
            }
            {
                AttnRow sw[2];
#pragma unroll
                for (int rb = 0; rb < 2; ++rb) { sw[rb].m = 0.f; sw[rb].ol = (f32x4){0.f, 0.f, 0.f, 0.f};
#pragma unroll
                    for (int dt = 0; dt < 4; ++dt) sw[rb].o[dt] = (f32x4){0.f, 0.f, 0.f, 0.f}; }
                const int jt0 = (t0 >= 511) ? ((t0 - 511) >> 6) : 0;
                const int nt_ = cur - jt0 + 1;
                const unsigned full[2] = {0xffffffffu, 0xffffffffu}; const bool both[2] = {true, true};
                bool refmoved = false;
#define WIN_PRE(JJ) const int j = jt0 + (JJ); f32x4 s[2][4]; const bool edge = (j == cur) || (64 * j < t0 + 63 - 511); const int lo2[2] = {trow[0] - 511, trow[1] - 511};
#define WIN_TILE(JJ, SLOT) do { WIN_PRE(JJ) \
                    if (refmoved) { const float cin[2] = {-sw[0].m, -sw[1].m}; attn_qk2(lds + AT4_KB + (SLOT) * 8192, qr, fr, g4, cin, s); } \
                    else attn_qk2z(lds + AT4_KB + (SLOT) * 8192, qr, fr, g4, s); \
                    refmoved |= attn_step2x(lds + AT4_VB + (SLOT) * 8192, s, sw, 64 * j, g4, lo2, trow, both, full, edge, vlane, swz, onesf); } while (0)
#define WIN_TILE_NM(JJ, SLOT) do { WIN_PRE(JJ) attn_qk2z(lds + AT4_KB + (SLOT) * 8192, qr, fr, g4, s); \
                    attn_step2x_nomax(lds + AT4_VB + (SLOT) * 8192, s, sw, 64 * j, g4, lo2, trow, full, edge, vlane, swz, onesf); } while (0)
                AT_DMA(2, jt0, 0); if (nt_ > 1) AT_DMA(2, jt0 + 1, 1); __syncthreads();
#define WIN_LOOP(TILE) for (int j0 = 0; j0 < nt_; j0 += 2) { const int sb = (j0 & 2); \
                    if (j0 + 2 < nt_) AT_DMA(2, jt0 + j0 + 2, sb ^ 2); \
                    if (j0 + 3 < nt_) AT_DMA(2, jt0 + j0 + 3, (sb ^ 2) + 1); \
                    TILE(j0, sb); if (j0 + 1 < nt_) TILE(j0 + 1, sb + 1); \
                    __syncthreads(); }
                if (nomax_win) { WIN_LOOP(WIN_TILE_NM) } else { WIN_LOOP(WIN_TILE) }
#undef WIN_LOOP
#undef WIN_TILE_NM
#undef WIN_PRE
#undef WIN_TILE
                TROW_PIN();
#pragma unroll
                for (int rb = 0; rb < 2; ++rb) { const float l = __shfl(sw[rb].ol[0], fr); const float sc2 = (l > 0.f) ? GATE(rb, 2) / l : 0.f;
                    bf16_t* op = O + TOKROW(rb) * 1024 + head * 64 + 4 * g4;
                    unsigned char* o8 = (unsigned char*)(a.ws + WS_O8) + TOKROW(rb) * 1024 + head * 64 + 4 * g4;
#pragma unroll
                    for (int dt = 0; dt < 4; ++dt) { const u32x2 pv = *(const u32x2*)(op + 16 * dt); f32x4 v = sw[rb].o[dt] * sc2;
                        v[0] += __uint_as_float(pv.x << 16); v[1] += __uint_as_float(pv.x & 0xffff0000u); v[2] += __uint_as_float(pv.y << 16); v[3] += __uint_as_float(pv.y & 0xffff0000u);
                        *(unsigned*)(o8 + 16 * dt) = pk4_fp8(clamp8(v[0] * X8_SCALE), clamp8(v[1] * X8_SCALE), clamp8(v[2] * X8_SCALE), clamp8(v[3] * X8_SCALE)); } }
            }
#undef AT_DMA
#undef ATK
#undef ATV
#undef TROW_PIN
#undef TOKROW
#undef GATE
            {
                const int npr = half ? pr + (int)gridDim.x : pr, nhalf = half ^ 1;
                cmp_pref = npr < 1024;
                if (cmp_pref) { const int nbg = npr >> 6, npp = attn_pair_of(npr), ncc = nhalf ? (127 - npp) : npp;
                    const int nnct = (((ncc * 64 + 63 - 31) / 16 + 1) + 63) >> 6;
                    const bf16_t* nk = KC + (size_t)nbg * 512 * 64;
                    __builtin_amdgcn_global_load_lds((const unsigned*)(nk + ksrc), (LAS unsigned*)(lds + AT4_KB + wave * 1024), 16, 0, 0);
                    __builtin_amdgcn_global_load_lds((const unsigned*)(nk + (size_t)8192 * 64 + vsrc), (LAS unsigned*)(lds + AT4_VB + wave * 1024), 16, 0, 0);
                    if (nnct > 1) {
                        __builtin_amdgcn_global_load_lds((const unsigned*)(nk + 4096 + ksrc), (LAS unsigned*)(lds + AT4_KB + 8192 + wave * 1024), 16, 0, 0);
                        __builtin_amdgcn_global_load_lds((const unsigned*)(nk + (size_t)8192 * 64 + 4096 + vsrc), (LAS unsigned*)(lds + AT4_VB + 8192 + wave * 1024), 16, 0, 0); } } }
            cvt1_run(a, cvt_next, cvt_stride, 2, cvt_scr, lane);
        }
    }
    cvt1_run(a, cvt_next, cvt_stride, 1 << 20, cvt_scr, lane);
}

__device__ __forceinline__ void unpack8(const u32x4 w, float (&f)[8]) {
    f[0] = __uint_as_float(w.x << 16); f[1] = __uint_as_float(w.x & 0xffff0000u); f[2] = __uint_as_float(w.y << 16); f[3] = __uint_as_float(w.y & 0xffff0000u);
    f[4] = __uint_as_float(w.z << 16); f[5] = __uint_as_float(w.z & 0xffff0000u); f[6] = __uint_as_float(w.w << 16); f[7] = __uint_as_float(w.w & 0xffff0000u);
}
__device__ __forceinline__ void ph_convpool_fast(const Args& a, LAS unsigned char* lds) {
    const bf16_t* H0 = (const bf16_t*)(a.ws + WS_H0);
    bf16_t* CAT = (bf16_t*)(a.ws + WS_CAT);
    const float* cw = a.in[4]; const float* cb = a.in[5]; const float* lg = a.in[6]; const float* lb = a.in[7];
    const int tid = threadIdx.x, lane = tid & 63, wave = tid >> 6, ch = lane * 8;
    constexpr int VT_OFF = 0, UT_OFF = 62 * 1024, CW_OFF = UT_OFF + 47 * 1024;
    for (int i = tid; i < 31 * 64; i += 512) { const int k = i >> 6, c8 = (i & 63) * 8;
        const f32x4 w0 = *(const f32x4*)(cw + k * 512 + c8), w1 = *(const f32x4*)(cw + k * 512 + c8 + 4);
        u32x4 o; o.x = pk2(w0[0], w0[1]); o.y = pk2(w0[2], w0[3]); o.z = pk2(w1[0], w1[1]); o.w = pk2(w1[2], w1[3]);
        *(LAS u32x4*)(lds + CW_OFF + k * 1024 + c8 * 2) = o; }
    float bias[8], gam[8], bet[8];
#pragma unroll
    for (int j = 0; j < 8; ++j) { bias[j] = cb[ch + j]; gam[j] = lg[ch + j]; bet[j] = lb[ch + j]; }
    for (int tile = blockIdx.x; tile < M / 32; tile += gridDim.x) {
        const int tok0 = tile * 32, t0 = tok0 & (T - 1);
        __syncthreads();
        for (int i = tid; i < 62 * 64; i += 512) { const int r = i >> 6, c8 = (i & 63) * 8; const int tt = t0 - 30 + r;
            u32x4 v = (u32x4){0u, 0u, 0u, 0u}; if (tt >= 0) v = *(const u32x4*)(H0 + (size_t)(tok0 - 30 + r) * 1024 + 512 + c8);
            *(LAS u32x4*)(lds + VT_OFF + r * 1024 + c8 * 2) = v; }
        for (int i = tid; i < 47 * 64; i += 512) { const int r = i >> 6, c8 = (i & 63) * 8; const int tt = t0 - 15 + r;
            u32x4 v = (u32x4){0u, 0u, 0u, 0u}; if (tt >= 0) v = *(const u32x4*)(H0 + (size_t)(tok0 - 15 + r) * 1024 + c8);
            *(LAS u32x4*)(lds + UT_OFF + r * 1024 + c8 * 2) = v; }
        __syncthreads();
        float acc[4][8];
#pragma unroll
        for (int j = 0; j < 4; ++j)
#pragma unroll
            for (int c = 0; c < 8; ++c) acc[j][c] = bias[c];
#pragma unroll 1
        for (int k = 0; k < 31; ++k) {
            float w[8]; unpack8(*(const LAS u32x4*)(lds + CW_OFF + k * 1024 + ch * 2), w);
#pragma unroll
            for (int j = 0; j < 4; ++j) { float v[8]; unpack8(*(const LAS u32x4*)(lds + VT_OFF + (4 * wave + j + k) * 1024 + ch * 2), v);
#pragma unroll
                for (int c = 0; c < 8; ++c) acc[j][c] += w[c] * v[c]; }
        }
        const int wnd = 2 << (lane >> 4);
#pragma unroll
        for (int j = 0; j < 4; ++j) {
            const int tl = 4 * wave + j, t = t0 + tl; const size_t tok = (size_t)tok0 + tl;
            const int cnt = (t + 1 < wnd) ? (t + 1) : wnd;
            float s[8], self[8];
            unpack8(*(const LAS u32x4*)(lds + UT_OFF + (15 + tl) * 1024 + ch * 2), self);
#pragma unroll
            for (int c = 0; c < 8; ++c) s[c] = self[c];
            for (int k = 1; k < cnt; ++k) { float v[8]; unpack8(*(const LAS u32x4*)(lds + UT_OFF + (15 + tl - k) * 1024 + ch * 2), v);
#pragma unroll
                for (int c = 0; c < 8; ++c) s[c] += v[c]; }
            const float inv = 1.0f / (float)cnt;
            u32x4 o; o.x = pk2(s[0] * inv - self[0], s[1] * inv - self[1]); o.y = pk2(s[2] * inv - self[2], s[3] * inv - self[3]);
            o.z = pk2(s[4] * inv - self[4], s[5] * inv - self[5]); o.w = pk2(s[6] * inv - self[6], s[7] * inv - self[7]);
            *(u32x4*)(CAT + tok * 1024 + ch) = o;
            float sm = 0.f;
#pragma unroll
            for (int c = 0; c < 8; ++c) sm += acc[j][c];
            const float mean = wave_sum(sm) * (1.0f / 512.0f);
            float sq = 0.f;
#pragma unroll
            for (int c = 0; c < 8; ++c) { acc[j][c] -= mean; sq += acc[j][c] * acc[j][c]; }
            const float rstd = rsqrtf(wave_sum(sq) * (1.0f / 512.0f) + LN_EPS);
            float y[8];
#pragma unroll
            for (int c = 0; c < 8; ++c) { const float z = acc[j][c] * rstd * gam[c] + bet[c]; y[c] = z * sigmoidf_(z); }
            u32x4 o2; o2.x = pk2(y[0], y[1]); o2.y = pk2(y[2], y[3]); o2.z = pk2(y[4], y[5]); o2.w = pk2(y[6], y[7]);
            *(u32x4*)(CAT + tok * 1024 + 512 + ch) = o2;
        }
    }
}


#define RT_DPPI(x, ctrl) __builtin_amdgcn_update_dpp((int)(x), (int)(x), (ctrl), 0xF, 0xF, true)
#define RT_DPPF(x, ctrl) __builtin_bit_cast(float, __builtin_amdgcn_update_dpp(__builtin_bit_cast(int, (float)(x)), __builtin_bit_cast(int, (float)(x)), (ctrl), 0xF, 0xF, true))
#define RT_LANEI(x, l) __builtin_amdgcn_readlane((int)(x), (l))
#define RT_LANEF(x, l) __builtin_bit_cast(float, __builtin_amdgcn_readlane(__builtin_bit_cast(int, (float)(x)), (l)))
__device__ __forceinline__ int RT_KEY(float x) { const int b = __builtin_bit_cast(int, x); return b ^ ((b >> 31) & 0x7fffffff); }
__device__ __forceinline__ void ph_route_fast(const float* LOG, const float* bias, unsigned* gcnt, int2* list, unsigned char* ldsg) {
    unsigned* hist = (unsigned*)ldsg; unsigned* base = hist + 256; u32x2* sel = (u32x2*)(ldsg + 2048);
    const int tid = threadIdx.x, lane = tid & 63, wave = tid >> 6;
    const float NEG = -INFINITY;
    const float4 bb = *(const float4*)(bias + lane * 4);
    for (int chunk = blockIdx.x; chunk < M / 128; chunk += gridDim.x) {
        __syncthreads();
        if (tid < 256) hist[tid] = 0u;
        __syncthreads();
        for (int i = 0; i < 16; ++i) {
            const int tl = wave * 16 + i, tok = chunk * 128 + tl;
            const float4 lg = *(const float4*)(LOG + (size_t)tok * 256 + lane * 4);
            const float s0 = sigmoidf_(lg.x), s1 = sigmoidf_(lg.y), s2 = sigmoidf_(lg.z), s3 = sigmoidf_(lg.w);
            const float v0 = s0 + bb.x + 0.0f, v1 = s1 + bb.y + 0.0f, v2 = s2 + bb.z + 0.0f, v3 = s3 + bb.w + 0.0f;
            float m1 = fmaxf(v0, v1), m2 = fminf(v0, v1);
            { const float hi = fmaxf(v2, v3), lo = fminf(v2, v3); const float n1 = fmaxf(m1, hi); const float n2 = fmaxf(fminf(m1, hi), fmaxf(m2, lo)); m1 = n1; m2 = n2; }
#define RT_STEP(ctrl) { const float a1 = RT_DPPF(m1, ctrl), a2 = RT_DPPF(m2, ctrl); const float n1 = fmaxf(m1, a1), n2 = fmaxf(fminf(m1, a1), fmaxf(m2, a2)); m1 = n1; m2 = n2; }
            RT_STEP(0xB1) RT_STEP(0x4E) RT_STEP(0x141)
#undef RT_STEP
            const float gs = m1 + m2; const int mygrp = lane >> 3;
            int rank = 0;
#pragma unroll
            for (int g2 = 0; g2 < 8; ++g2) { const float og = RT_LANEF(gs, g2 * 8); rank += (og > gs || (og == gs && g2 < mygrp)) ? 1 : 0; }
            const bool dead = rank >= 4;
            constexpr int KMIN = (int)0x80000000;
            int k0 = dead ? KMIN : RT_KEY(v0), k1 = dead ? KMIN : RT_KEY(v1), k2 = dead ? KMIN : RT_KEY(v2), k3 = dead ? KMIN : RT_KEY(v3);
            int my_e = 0; float my_s = 0.f;
#pragma unroll
            for (int it = 0; it < 8; ++it) {
                int lm = max(max(k0, k1), max(k2, k3));
                lm = max(lm, RT_DPPI(lm, 0xB1)); lm = max(lm, RT_DPPI(lm, 0x4E)); lm = max(lm, RT_DPPI(lm, 0x141)); lm = max(lm, RT_DPPI(lm, 0x140));
                const int gmax = max(max(RT_LANEI(lm, 0), RT_LANEI(lm, 16)), max(RT_LANEI(lm, 32), RT_LANEI(lm, 48)));
                int cand = (k0 == gmax) ? lane * 4 : (k1 == gmax) ? lane * 4 + 1 : (k2 == gmax) ? lane * 4 + 2 : (k3 == gmax) ? lane * 4 + 3 : 0x7fffffff;
                cand = min(cand, RT_DPPI(cand, 0xB1)); cand = min(cand, RT_DPPI(cand, 0x4E)); cand = min(cand, RT_DPPI(cand, 0x141)); cand = min(cand, RT_DPPI(cand, 0x140));
                const int bi = min(min(RT_LANEI(cand, 0), RT_LANEI(cand, 16)), min(RT_LANEI(cand, 32), RT_LANEI(cand, 48)));
                const int jj = bi & 3, ol = bi >> 2;
                const float mys = (jj == 0) ? s0 : (jj == 1) ? s1 : (jj == 2) ? s2 : s3;
                const float wsc = RT_LANEF(mys, ol);
                const bool me = (lane == ol);
                k0 = (me && jj == 0) ? KMIN : k0; k1 = (me && jj == 1) ? KMIN : k1; k2 = (me && jj == 2) ? KMIN : k2; k3 = (me && jj == 3) ? KMIN : k3;
                if (lane == it) { my_e = bi; my_s = wsc; }
            }
            const float ssum = wave_sum(lane < 8 ? my_s : 0.f);
            if (lane < 8) { const unsigned rk = atomicAdd(&hist[my_e], 1u); u32x2 en; en.x = (unsigned)my_e | (rk << 16); en.y = __float_as_uint(my_s / ssum * 2.5f); sel[tl * 8 + lane] = en; }
        }
        __syncthreads();
        if (tid < 256) { const unsigned h = hist[tid]; base[tid] = h ? atomicAdd(&gcnt[tid], h) : 0u; }
        __syncthreads();
#pragma unroll
        for (int rep = 0; rep < 2; ++rep) { const int idx = tid + rep * 512, tok = chunk * 128 + (idx >> 3), k = idx & 7;
            const u32x2 en = sel[idx]; const unsigned e = en.x & 0xffffu, pos = base[e] + (en.x >> 16);
            list[(size_t)e * LISTCAP + pos] = make_int2(tok * 10 + k, (int)en.y); }
    }
}

__global__ void __launch_bounds__(512, 2) fwd_kernel(Args a) {
    extern __shared__ __attribute__((aligned(16))) unsigned char lds[];
    volatile LAS unsigned* MISC = (volatile LAS unsigned*)((LAS unsigned char*)lds + (LDS_BYTES - 64));
    if (threadIdx.x < 16) MISC[threadIdx.x] = 0u;
    __syncthreads();
    unsigned* ctl = (unsigned*)(a.ws + WS_CTL);
#if MK_ONE_LAUNCH
    (void)xcd_barrier_post(ctl + CW_BAR, MISC + 8);
#define SEAM() do { XcdBarrier b_; b_.bar = (unsigned*)(a.ws + WS_CTL) + CW_BAR; b_.x = xb_xcc_id(); b_.st = MISC + 8; xcd_barrier(b_); } while (0)
#else
#define SEAM() do {} while (0)
#endif
    const int lo = a.ph_lo, hi = a.ph_hi;
#define IN(k) (lo <= (k) && (k) < hi)
#define BOTH(k) (IN(k) && (k) + 1 < hi)
#define X1 ((bf16_t*)(a.ws + WS_X1))
#define X2 ((bf16_t*)(a.ws + WS_X2))
#define LOG ((float*)(a.ws + WS_LOG))

    LAS unsigned char* L = (LAS unsigned char*)lds;
#define LIST ((int2*)(a.ws + WS_LIST))
#ifndef PROBE_DUP_MASK
#define PROBE_DUP_MASK 0u
#endif
#define RUN(k, ...) if (IN(k)) { { __VA_ARGS__ } if ((PROBE_DUP_MASK >> (k)) & 1u) { __syncthreads(); { __VA_ARGS__ } } if (BOTH(k)) SEAM(); }
    RUN(0, ph_prologue(a, L);)
    RUN(1, pg8::DenseSched S; S.init((const bf16_t*)(a.ws + WS_XA), D, (const bf16_t*)(a.ws + WS_WIN0), D, M, 1536);
           EpiInproj0 E{(bf16_t*)(a.ws + WS_H0)};
           pg8::gemm_phase<EpiInproj0, pg8::DenseSched, true>(L, D, 128u, S, E);)
    RUN(2, ph_convpool_fast(a, L);)
    RUN(4, pg8::DenseSched S; S.init((const bf16_t*)(a.ws + WS_CAT), D, (const bf16_t*)(a.ws + WS_WOUT0), D, M, D);
           EpiRes E{a.in[0], nullptr, (bf16_t*)(a.ws + WS_Y), 1.0f};
           pg8::gemm_phase<EpiRes, pg8::DenseSched, true>(L, D, 128u, S, E);)
    RUN(5, ph_ln((const bf16_t*)(a.ws + WS_Y), a.in[17], a.in[18], X1, (unsigned char*)(a.ws + WS_X8));)
#define MOE_LAYER(P, LAYER, XIN, XOUT, OUTF) \
    RUN(P, pg8::DenseSched S; S.init(XIN, D, (const bf16_t*)(a.ws + WS_WR) + (size_t)(LAYER) * NE * D, D, M, NE); \
           EpiLogits E{LOG}; pg8::gemm_phase<EpiLogits, pg8::DenseSched, true>(L, D, 128u, S, E);) \
    if (IN(P + 1)) { ph_route_fast(LOG, a.in[22] + (LAYER) * NE, ctl + CW_CNT + (LAYER) * 256, LIST, lds); if (BOTH(P + 1)) SEAM(); } \
    RUN(P + 2, const int R = moe_setup256(ctl + CW_CNT + (LAYER) * 256, L); \
            MoeGuSched S{(const char*)(a.ws + WS_X8), (const char*)(a.ws + WS_WGU) + (size_t)(LAYER) * 257 * 512 * 1024, LIST, L, R, (R + 128) * 2, (int)gridDim.x, (int)blockIdx.x}; \
            S.prepare(); EpiGateUp E{(unsigned char*)(a.ws + WS_HID)}; pg8::gemm_phase<EpiGateUp, MoeGuSched, true, true>(L, D / 2, 128u, S, E);) \
    RUN(P + 3, const int R = moe_setup256(ctl + CW_CNT + (LAYER) * 256, L); \
            MoeDownSched S{(const char*)(a.ws + WS_HID), (const char*)(a.ws + WS_WD) + (size_t)(LAYER) * 257 * 1024 * 256, LIST, L, R, R + 128, (int)gridDim.x, (int)blockIdx.x}; \
            S.prepare(); EpiDown E{(unsigned char*)(a.ws + WS_YB), L}; pg8::gemm_phase<EpiDown, MoeDownSched, true, true>(L, FF / 2, 128u, S, E);) \
    RUN(P + 4, ph_combine(a, XIN, a.in[19] + (LAYER) * D, a.in[20] + (LAYER) * D, XOUT, OUTF);)
    MOE_LAYER(6, 0, X1, X2, nullptr)
    RUN(11, pg8::DenseSched S; S.init(X2, D, (const bf16_t*)(a.ws + WS_WINN), D, M, HNW);
            EpiInprojN E{(bf16_t*)(a.ws + WS_HN), (bf16_t*)(a.ws + WS_QR), (bf16_t*)(a.ws + WS_KV6), (float*)(a.ws + WS_GATES), (const float*)(a.ws + WS_MISC) + 1024};
            pg8::gemm_phase<EpiInprojN, pg8::DenseSched, true>(L, D, 128u, S, E);)
    RUN(13, Cmp1Sched S{(const char*)(a.ws + WS_KV6), (const char*)(a.ws + WS_CW1), (int)gridDim.x, (int)blockIdx.x};
            EpiCmp1 E{(bf16_t*)(a.ws + WS_CH1), (const float*)(a.ws + WS_MISC)};
            pg8::gemm_phase<EpiCmp1, Cmp1Sched, true>(L, 2048, 128u, S, E); ph_knorm(a);)
    RUN(14, ph_cmp2(a, lds);)
    RUN(15, ph_attn_fast2(a, L);)
    RUN(16, pg8::DenseSched S; S.init((const bf16_t*)(a.ws + WS_O8), D / 2, (const bf16_t*)(a.ws + WS_WOUTN), D / 2, M, D);
            EpiRes E{nullptr, X2, (bf16_t*)(a.ws + WS_Y2), 1.0f / (X8_SCALE * W8_SCALE)};
            pg8::gemm_phase<EpiRes, pg8::DenseSched, true, true>(L, D / 2, 128u, S, E);)
    RUN(17, ph_ln((const bf16_t*)(a.ws + WS_Y2), a.in[17] + D, a.in[18] + D, X1, (unsigned char*)(a.ws + WS_X8));)
    MOE_LAYER(18, 1, X1, (bf16_t*)nullptr, a.out)
}

extern "C" void kernel_launch(void* const* d_in, const int* in_sizes, int n_in, void* d_out, int out_size, void* d_ws, size_t ws_size, hipStream_t stream) {
    static int grid = 0;
    if (grid == 0) {
        if (n_in != 29 || out_size != M * D || ws_size < WS_END) { fprintf(stderr, "kernel_launch: unexpected problem (n_in %d out %d ws %zu)\n", n_in, out_size, ws_size); grid = -1; return; }
        int dev = 0, cus = 0;
        if (hipGetDevice(&dev) != hipSuccess || hipDeviceGetAttribute(&cus, hipDeviceAttributeMultiprocessorCount, dev) != hipSuccess) { grid = -1; return; }
        if (hipFuncSetAttribute((const void*)fwd_kernel, hipFuncAttributeMaxDynamicSharedMemorySize, LDS_BYTES) != hipSuccess) { grid = -1; return; }
        int per_cu = 0;
        (void)hipOccupancyMaxActiveBlocksPerMultiprocessor(&per_cu, (const void*)fwd_kernel, 512, LDS_BYTES);
        (void)hipGetLastError();
        grid = cus;
    }
    if (grid < 0) return;
    (void)hipMemsetAsync((char*)d_ws + WS_CTL, 0, CTL_BYTES, stream);
    Args a{};
    for (int i = 0; i < 29; ++i) a.in[i] = (const float*)d_in[i];
    a.out = (float*)d_out; a.ws = (unsigned char*)d_ws;
    for (int i = 0; i < 8; ++i) a.inv_freq[i] = powf(500000.0f, -(float)(2 * i) / 16.0f);
#if MK_ONE_LAUNCH
    a.ph_lo = 0; a.ph_hi = NPHASE;
    hipLaunchKernelGGL(fwd_kernel, dim3(grid), dim3(512), LDS_BYTES, stream, a);
#else
    for (int p = 0; p < NPHASE; ++p) { a.ph_lo = p; a.ph_hi = p + 1; hipLaunchKernelGGL(fwd_kernel, dim3(grid), dim3(512), LDS_BYTES, stream, a); }
#endif
}
```

```cpp
#include <hip/hip_runtime.h>
#include <cstdint>
#include <cstdio>
#include <cmath>

#ifndef MK_ONE_LAUNCH
#define MK_ONE_LAUNCH 1
#endif

#define LAS __attribute__((address_space(3)))
typedef unsigned short bf16_t;
typedef short bf16x8 __attribute__((ext_vector_type(8)));
typedef float f32x4 __attribute__((ext_vector_type(4)));
typedef unsigned u32x2 __attribute__((ext_vector_type(2)));
typedef unsigned u32x4 __attribute__((ext_vector_type(4)));

constexpr int NB = 4, T = 8192, D = 1024, M = NB * T;
constexpr int NE = 256, TOPK = 8, FF = 256;
constexpr int HNW = 2816;
constexpr int LISTCAP = 32768;
constexpr float ALPHA = 1.4142135623730951f;
constexpr float LN_EPS = 1e-5f;
constexpr float QSCALE = 0.125f * 1.4426950408889634f;
constexpr int YB_NSLOT = 9;
constexpr float YB_SCALE = 16.0f;
constexpr int NPHASE = 23;

constexpr size_t MiB = 1u << 20;
constexpr size_t WS_CTL = 0, CTL_BYTES = 1 * MiB;
constexpr size_t WS_X1 = 1 * MiB;
constexpr size_t WS_X2 = WS_X1 + 64 * MiB;
constexpr size_t WS_LOG = WS_X2 + 64 * MiB;
constexpr size_t WS_LIST = WS_LOG + 32 * MiB;
constexpr size_t WS_WTS = WS_LIST + 64 * MiB;
constexpr size_t WS_HID = WS_WTS + 2 * MiB;
constexpr size_t WS_YB = WS_HID + 184 * MiB;
constexpr size_t WS_END_NAIVE = WS_YB + 576 * MiB;
constexpr size_t WS_WIN0 = WS_END_NAIVE;
constexpr size_t WS_WOUT0 = WS_WIN0 + 3 * MiB;
constexpr size_t WS_WINN = WS_WOUT0 + 2 * MiB;
constexpr size_t WS_WOUTN = WS_WINN + 6 * MiB;
constexpr size_t WS_WR = WS_WOUTN + 2 * MiB;
constexpr size_t WS_CW1 = WS_WR + 1 * MiB;
constexpr size_t WS_MISC = WS_CW1 + 2 * MiB;
constexpr size_t WS_WGU = WS_MISC + 1 * MiB;
constexpr size_t WS_X8 = WS_WGU + 257 * MiB;
constexpr size_t WS_O8 = WS_X8 + 32 * MiB;
constexpr float X8_SCALE = 8.0f, W8_SCALE = 64.0f, H8_SCALE = 16.0f;
constexpr size_t WS_WD = WS_WGU + 514 * MiB;
constexpr size_t WS_END = WS_WD + 257 * MiB;
constexpr size_t WS_XA = WS_X2;
constexpr size_t WS_H0 = WS_YB;
constexpr size_t WS_PM = WS_H0 + 64 * MiB;
constexpr size_t WS_CAT = WS_PM + 32 * MiB;
constexpr size_t WS_Y = WS_CAT + 64 * MiB;
constexpr size_t WS_HN = WS_YB;
constexpr size_t WS_KV6 = WS_HN + 64 * MiB;
constexpr size_t WS_QR = WS_HN + 176 * MiB;
constexpr size_t WS_GATES = WS_QR + 64 * MiB;
constexpr size_t WS_CH1 = WS_GATES + 8 * MiB;
constexpr size_t WS_KC = WS_CH1 + 4 * MiB;
constexpr size_t WS_O = WS_KC + 2 * MiB;
constexpr size_t WS_Y2 = WS_O + 64 * MiB;
static_assert(WS_Y2 + 64 * MiB <= WS_END_NAIVE, "overlay");
static_assert(WS_Y + 64 * MiB <= WS_END_NAIVE, "overlay");

constexpr int CW_CNT = 64;
constexpr int CW_BAR = 4096;

constexpr int LDS_BYTES = 163840;

__device__ __forceinline__ float bf2f(bf16_t h) { return __uint_as_float(((unsigned)h) << 16); }
__device__ __forceinline__ bf16_t f2bf(float f) { unsigned u = __float_as_uint(f); return (bf16_t)((u + 0x7fffu + ((u >> 16) & 1u)) >> 16); }
__device__ __forceinline__ unsigned pk2(float lo, float hi) { return (unsigned)f2bf(lo) | ((unsigned)f2bf(hi) << 16); }
#define WR_DPP(x, ctrl) __builtin_bit_cast(float, __builtin_amdgcn_update_dpp(__builtin_bit_cast(int, (float)(x)), __builtin_bit_cast(int, (float)(x)), (ctrl), 0xF, 0xF, true))
#define WR_ROW(x, r) __builtin_bit_cast(float, __builtin_amdgcn_readlane(__builtin_bit_cast(int, (float)(x)), 16 * (r)))
__device__ __forceinline__ float wave_sum(float v) {
    v += WR_DPP(v, 0xB1); v += WR_DPP(v, 0x4E); v += WR_DPP(v, 0x141); v += WR_DPP(v, 0x140);
    return (WR_ROW(v, 0) + WR_ROW(v, 1)) + (WR_ROW(v, 2) + WR_ROW(v, 3));
}
__device__ __forceinline__ float wave_max(float v) {
    v = fmaxf(v, WR_DPP(v, 0xB1)); v = fmaxf(v, WR_DPP(v, 0x4E)); v = fmaxf(v, WR_DPP(v, 0x141)); v = fmaxf(v, WR_DPP(v, 0x140));
    return fmaxf(fmaxf(WR_ROW(v, 0), WR_ROW(v, 1)), fmaxf(WR_ROW(v, 2), WR_ROW(v, 3)));
}
__device__ __forceinline__ float sigmoidf_(float x) { return 1.0f / (1.0f + __expf(-x)); }
__device__ __forceinline__ float gelu_tanh(float x) {
    const float u = 0.7978845608028654f * (x + 0.044715f * x * x * x);
    const float e = __expf(2.0f * u);
    const float th = 1.0f - 2.0f / (e + 1.0f);
    return 0.5f * x * (1.0f + th);
}
__device__ __forceinline__ bf16x8 cvt8(const float* p) {
    const float4 a = *(const float4*)p, b = *(const float4*)(p + 4);
    bf16x8 r;
    r[0] = (short)f2bf(a.x); r[1] = (short)f2bf(a.y); r[2] = (short)f2bf(a.z); r[3] = (short)f2bf(a.w);
    r[4] = (short)f2bf(b.x); r[5] = (short)f2bf(b.y); r[6] = (short)f2bf(b.z); r[7] = (short)f2bf(b.w);
    return r;
}
__device__ __forceinline__ bf16x8 colk8(const float* W, int N, int k, int col) {
    bf16x8 r;
#pragma unroll
    for (int j = 0; j < 8; ++j) r[j] = (short)f2bf(W[(size_t)(k + j) * N + col]);
    return r;
}
__device__ __forceinline__ bf16x8 zero8() { return (bf16x8){0, 0, 0, 0, 0, 0, 0, 0}; }
#define WSYNC() asm volatile("s_waitcnt lgkmcnt(0)" ::: "memory")

#define XB_TMO      128
#define XB_XCNT(j)  (256  + 64 * (j))
#define XB_XSUB(j)  (1280 + 64 * (j))
#define XB_XGEN(j)  (2304 + 64 * (j))
#define XB_TOP      3328
#define XB_TOPGEN   3392
#define XCD_BAR_WORDS 3456
#define XB_SPIN_CAP (1u << 22)
__device__ __forceinline__ unsigned xb_ld(unsigned* p)              { return __hip_atomic_load(p, __ATOMIC_RELAXED, __HIP_MEMORY_SCOPE_AGENT); }
__device__ __forceinline__ unsigned xb_add(unsigned* p, unsigned v) { return __hip_atomic_fetch_add(p, v, __ATOMIC_RELAXED, __HIP_MEMORY_SCOPE_AGENT); }
__device__ __forceinline__ unsigned xb_xcc_id() { return (unsigned)__builtin_amdgcn_s_getreg((3 << 11) | 20) & 0xFu; }
#define XB_SPIN(cond, bar) do { unsigned _sp = 0; while (cond) { __builtin_amdgcn_s_sleep(1); \
    if ((++_sp & 255u) == 0u) { if (xb_ld(&(bar)[XB_TMO])) break; if (_sp > XB_SPIN_CAP) { atomicAdd(&(bar)[XB_TMO], 1u); break; } } } } while (0)
struct XcdBarrier { unsigned* bar; unsigned x; volatile LAS unsigned* st; };
__device__ __forceinline__ XcdBarrier xcd_barrier_post(unsigned* bar, volatile LAS unsigned* st) {
    XcdBarrier b; b.bar = bar; b.x = xb_xcc_id(); b.st = st;
    if (threadIdx.x == 0) (void)xb_add(&bar[XB_XCNT(b.x)], 1u);
    return b;
}
__device__ __forceinline__ void xcd_barrier_complete(unsigned* bar, unsigned x, unsigned& nloc, unsigned& nx) {
    const unsigned G = gridDim.x * gridDim.y * gridDim.z;
    unsigned sum, cnt, mine, sp = 0u;
    for (;;) {
        sum = 0u; cnt = 0u; mine = 0u;
#pragma unroll
        for (unsigned j = 0; j < 16; ++j) { const unsigned c = xb_ld(&bar[XB_XCNT(j)]); sum += c; cnt += (c > 0u) ? 1u : 0u; mine = (j == x) ? c : mine; }
        if (sum == G) break;
        __builtin_amdgcn_s_sleep(1);
        if ((++sp & 255u) == 0u) { if (xb_ld(&bar[XB_TMO])) break; if (sp > XB_SPIN_CAP) { atomicAdd(&bar[XB_TMO], 1u); break; } }
    }
    nloc = mine > 0u ? mine : 1u; nx = cnt > 0u ? cnt : 1u;
}
__device__ __forceinline__ void xcd_barrier(const XcdBarrier& b) {
    asm volatile("s_waitcnt vmcnt(0)" ::: "memory");
    __syncthreads();
    if (threadIdx.x == 0) {
        unsigned* bar = b.bar;
        __builtin_amdgcn_s_waitcnt(0);
        unsigned nloc = b.st[0], nx = b.st[1];
        if (nloc == 0u) { xcd_barrier_complete(bar, b.x, nloc, nx); b.st[0] = nloc; b.st[1] = nx; }
        const unsigned old = xb_add(&bar[XB_XSUB(b.x)], 1u);
        const unsigned gen = old / nloc;
        if (old + 1u == (gen + 1u) * nloc) {
            __builtin_amdgcn_fence(__ATOMIC_RELEASE, "agent");
            asm volatile("s_waitcnt vmcnt(0)" ::: "memory");
            const unsigned og = xb_add(&bar[XB_TOP], 1u);
            const unsigned tg = og / nx;
            if (og + 1u == (tg + 1u) * nx) xb_add(&bar[XB_TOPGEN], 1u);
            else XB_SPIN(xb_ld(&bar[XB_TOPGEN]) == tg, bar);
            __builtin_amdgcn_fence(__ATOMIC_ACQUIRE, "agent");
            xb_add(&bar[XB_XGEN(b.x)], 1u);
            asm volatile("s_waitcnt vmcnt(0)" ::: "memory");
        } else {
            XB_SPIN(xb_ld(&bar[XB_XGEN(b.x)]) == gen, bar);
            __builtin_amdgcn_fence(__ATOMIC_ACQUIRE, "agent");
            asm volatile("s_waitcnt vmcnt(0)" ::: "memory");
        }
    }
    __syncthreads();
}

template <class AL, class BL, class EP>
__device__ __forceinline__ void mgemm_tile(unsigned char* lds, int K, const AL& al, const BL& bl, const EP& ep) {
    bf16_t* As = (bf16_t*)lds;
    bf16_t* Bs = As + 128 * 40;
    const int tid = threadIdx.x, lane = tid & 63, wave = tid >> 6;
    const int ar = tid >> 2, ac = (tid & 3) * 8;
    const int bn = tid & 127, bc = (tid >> 7) * 8;
    f32x4 acc[8];
#pragma unroll
    for (int s = 0; s < 8; ++s) acc[s] = (f32x4){0.f, 0.f, 0.f, 0.f};
    bf16x8 ra = al(ac), rb = bl(bc);
    for (int k0 = 0; k0 < K; k0 += 32) {
        __syncthreads();
        *(bf16x8*)(As + ar * 40 + ac) = ra;
        *(bf16x8*)(Bs + bn * 40 + bc) = rb;
        __syncthreads();
        if (k0 + 32 < K) { ra = al(k0 + 32 + ac); rb = bl(k0 + 32 + bc); }
        const bf16x8 af = *(const bf16x8*)(As + (wave * 16 + (lane & 15)) * 40 + (lane >> 4) * 8);
#pragma unroll
        for (int s = 0; s < 8; ++s) {
            const bf16x8 wf = *(const bf16x8*)(Bs + (16 * s + (lane & 15)) * 40 + (lane >> 4) * 8);
            acc[s] = __builtin_amdgcn_mfma_f32_16x16x32_bf16(wf, af, acc[s], 0, 0, 0);
        }
    }
    ep(wave * 16 + (lane & 15), (lane >> 4) * 4, acc);
}
__device__ __forceinline__ void store4bf(bf16_t* p, const f32x4 v) { u32x2 w; w.x = pk2(v[0], v[1]); w.y = pk2(v[2], v[3]); *(u32x2*)p = w; }

struct Args {
    const float* in[29];
    float* out;
    unsigned char* ws;
    float inv_freq[8];
    int ph_lo, ph_hi;
};

__device__ __forceinline__ unsigned pk4_fp8(float a, float b, float c, float d) { int w = __builtin_amdgcn_cvt_pk_fp8_f32(a, b, 0, false); return (unsigned)__builtin_amdgcn_cvt_pk_fp8_f32(c, d, w, true); }
__device__ __forceinline__ u32x2 pack8_fp8(const f32x4 v0, const f32x4 v1) {
    int a = __builtin_amdgcn_cvt_pk_fp8_f32(v0[0], v0[1], 0, false); a = __builtin_amdgcn_cvt_pk_fp8_f32(v0[2], v0[3], a, true);
    int b = __builtin_amdgcn_cvt_pk_fp8_f32(v1[0], v1[1], 0, false); b = __builtin_amdgcn_cvt_pk_fp8_f32(v1[2], v1[3], b, true);
    u32x2 w; w.x = (unsigned)a; w.y = (unsigned)b; return w;
}
__device__ __forceinline__ float clamp8(float v) { return __builtin_amdgcn_fmed3f(v, -448.0f, 448.0f); }
__device__ __forceinline__ void ph_ln(const bf16_t* Y, const float* g, const float* b, bf16_t* X, unsigned char* X8) {
    const int lane = threadIdx.x & 63, wave = threadIdx.x >> 6;
    const int gw = blockIdx.x * 8 + wave, ngw = gridDim.x * 8;
    float gg[16], bb[16];
#pragma unroll
    for (int j = 0; j < 8; ++j) { gg[j] = g[lane * 8 + j]; gg[8 + j] = g[512 + lane * 8 + j]; bb[j] = b[lane * 8 + j]; bb[8 + j] = b[512 + lane * 8 + j]; }
    for (int row0 = gw * 4; row0 < M; row0 += ngw * 4) {
        bf16x8 p0[4], p1[4];
#pragma unroll
        for (int r = 0; r < 4; ++r) { p0[r] = __builtin_nontemporal_load((const bf16x8*)(Y + (size_t)(row0 + r) * 1024 + lane * 8)); p1[r] = __builtin_nontemporal_load((const bf16x8*)(Y + (size_t)(row0 + r) * 1024 + 512 + lane * 8)); }
#pragma unroll
        for (int r = 0; r < 4; ++r) {
            float v[16];
#pragma unroll
            for (int j = 0; j < 8; ++j) { v[j] = bf2f((bf16_t)p0[r][j]); v[8 + j] = bf2f((bf16_t)p1[r][j]); }
            float s = 0.f;
#pragma unroll
            for (int j = 0; j < 16; ++j) s += v[j];
            const float mean = wave_sum(s) * (1.0f / 1024.0f);
            float q = 0.f;
#pragma unroll
            for (int j = 0; j < 16; ++j) { v[j] -= mean; q += v[j] * v[j]; }
            const float rstd = rsqrtf(wave_sum(q) * (1.0f / 1024.0f) + LN_EPS);
            float o[16];
#pragma unroll
            for (int j = 0; j < 16; ++j) o[j] = v[j] * rstd * gg[j] + bb[j];
            u32x4 w0, w1;
            w0.x = pk2(o[0], o[1]); w0.y = pk2(o[2], o[3]); w0.z = pk2(o[4], o[5]); w0.w = pk2(o[6], o[7]);
            w1.x = pk2(o[8], o[9]); w1.y = pk2(o[10], o[11]); w1.z = pk2(o[12], o[13]); w1.w = pk2(o[14], o[15]);
            *(u32x4*)(X + (size_t)(row0 + r) * 1024 + lane * 8) = w0; *(u32x4*)(X + (size_t)(row0 + r) * 1024 + 512 + lane * 8) = w1;
#pragma unroll
            for (int j = 0; j < 16; ++j) o[j] = clamp8(o[j] * X8_SCALE);
            u32x2 q0, q1; q0.x = pk4_fp8(o[0], o[1], o[2], o[3]); q0.y = pk4_fp8(o[4], o[5], o[6], o[7]); q1.x = pk4_fp8(o[8], o[9], o[10], o[11]); q1.y = pk4_fp8(o[12], o[13], o[14], o[15]);
            *(u32x2*)(X8 + (size_t)(row0 + r) * 1024 + lane * 8) = q0; *(u32x2*)(X8 + (size_t)(row0 + r) * 1024 + 512 + lane * 8) = q1;
        }
    }
}

__device__ __forceinline__ void ph_combine(const Args& a, const bf16_t* X, const float* g, const float* b, bf16_t* Xo, float* outf) {
    const unsigned char* YB = (const unsigned char*)(a.ws + WS_YB);
    const int lane = threadIdx.x & 63, wave = threadIdx.x >> 6;
    const int gw = blockIdx.x * 8 + wave, ngw = gridDim.x * 8;
    for (int row = gw; row < M; row += ngw) {
        float v[16];
#pragma unroll
        for (int j = 0; j < 16; ++j) v[j] = 0.f;
        u32x2 q0[YB_NSLOT], q1[YB_NSLOT];
#pragma unroll
        for (int k = 0; k < YB_NSLOT; ++k) { const unsigned char* yr = YB + ((size_t)row * 10 + k) * 1024; q0[k] = __builtin_nontemporal_load((const u32x2*)(yr + lane * 8)); q1[k] = __builtin_nontemporal_load((const u32x2*)(yr + 512 + lane * 8)); }
#pragma unroll
        for (int k = 0; k < YB_NSLOT; ++k) {
            const auto a0 = __builtin_amdgcn_cvt_pk_f32_fp8((int)q0[k].x, false), a1 = __builtin_amdgcn_cvt_pk_f32_fp8((int)q0[k].x, true), a2 = __builtin_amdgcn_cvt_pk_f32_fp8((int)q0[k].y, false), a3 = __builtin_amdgcn_cvt_pk_f32_fp8((int)q0[k].y, true);
            const auto b0 = __builtin_amdgcn_cvt_pk_f32_fp8((int)q1[k].x, false), b1 = __builtin_amdgcn_cvt_pk_f32_fp8((int)q1[k].x, true), b2 = __builtin_amdgcn_cvt_pk_f32_fp8((int)q1[k].y, false), b3 = __builtin_amdgcn_cvt_pk_f32_fp8((int)q1[k].y, true);
            v[0] += a0[0]; v[1] += a0[1]; v[2] += a1[0]; v[3] += a1[1]; v[4] += a2[0]; v[5] += a2[1]; v[6] += a3[0]; v[7] += a3[1];
            v[8] += b0[0]; v[9] += b0[1]; v[10] += b1[0]; v[11] += b1[1]; v[12] += b2[0]; v[13] += b2[1]; v[14] += b3[0]; v[15] += b3[1];
        }
        {
            const bf16x8 p0 = *(const bf16x8*)(X + (size_t)row * 1024 + lane * 8), p1 = *(const bf16x8*)(X + (size_t)row * 1024 + 512 + lane * 8);
#pragma unroll
            for (int j = 0; j < 8; ++j) { v[j] = v[j] * (1.0f / YB_SCALE) + ALPHA * bf2f((bf16_t)p0[j]); v[8 + j] = v[8 + j] * (1.0f / YB_SCALE) + ALPHA * bf2f((bf16_t)p1[j]); }
        }
        float s = 0.f;
#pragma unroll
        for (int j = 0; j < 16; ++j) s += v[j];
        const float mean = wave_sum(s) * (1.0f / 1024.0f);
        float q = 0.f;
#pragma unroll
        for (int j = 0; j < 16; ++j) { v[j] -= mean; q += v[j] * v[j]; }
        const float rstd = rsqrtf(wave_sum(q) * (1.0f / 1024.0f) + LN_EPS);
        float o[16];
#pragma unroll
        for (int j = 0; j < 8; ++j) { o[j] = v[j] * rstd * g[lane * 8 + j] + b[lane * 8 + j]; o[8 + j] = v[8 + j] * rstd * g[512 + lane * 8 + j] + b[512 + lane * 8 + j]; }
        if (outf) {
            float* op = outf + (size_t)row * 1024;
            *(float4*)(op + lane * 8) = make_float4(o[0], o[1], o[2], o[3]); *(float4*)(op + lane * 8 + 4) = make_float4(o[4], o[5], o[6], o[7]);
            *(float4*)(op + 512 + lane * 8) = make_float4(o[8], o[9], o[10], o[11]); *(float4*)(op + 512 + lane * 8 + 4) = make_float4(o[12], o[13], o[14], o[15]);
        } else {
            u32x4 w0, w1;
            w0.x = pk2(o[0], o[1]); w0.y = pk2(o[2], o[3]); w0.z = pk2(o[4], o[5]); w0.w = pk2(o[6], o[7]);
            w1.x = pk2(o[8], o[9]); w1.y = pk2(o[10], o[11]); w1.z = pk2(o[12], o[13]); w1.w = pk2(o[14], o[15]);
            *(u32x4*)(Xo + (size_t)row * 1024 + lane * 8) = w0; *(u32x4*)(Xo + (size_t)row * 1024 + 512 + lane * 8) = w1;
        }
    }
}

__device__ __forceinline__ void ph_cmp2(const Args& a, unsigned char* lds) {
    const bf16_t* CH1 = (const bf16_t*)(a.ws + WS_CH1);
    bf16_t* KC = (bf16_t*)(a.ws + WS_KC);
    const int tid = threadIdx.x;
    for (int u = blockIdx.x; u < 64 * 2; u += gridDim.x) {
        const int rt = u >> 1, kv = u & 1;
        const bf16_t* ar = CH1 + ((size_t)kv * 8192 + rt * 128 + (tid >> 2)) * 128;
        const float* w2 = a.in[kv ? 15 : 12];
        const int col = tid & 127;
        auto al = [&](int k) { return *(const bf16x8*)(ar + k); };
        auto bl = [&](int k) { return (col < 64) ? colk8(w2, 64, k, col) : zero8(); };
        auto ep = [&](int r, int cb, const f32x4 (&acc)[8]) {
            bf16_t* o = KC + ((size_t)kv * 8192 + rt * 128 + r) * 64;
#pragma unroll
            for (int s = 0; s < 4; ++s) store4bf(o + 16 * s + cb, acc[s]);
        };
        mgemm_tile(lds, 128, al, bl, ep);
    }
}

namespace pg8 {
constexpr int BM = 256, BK = 64, HALF = 128, HTB = HALF * BK * 2, STAGE_BYTES = 8 * HTB;
__device__ __forceinline__ int lds_byte(int r, int c) { const int st = (r >> 4) * 2 + (c >> 5), rr = r & 15, cc = c & 31, ob = rr * 64 + cc * 2; return st * 1024 + (ob ^ (((ob >> 9) & 1) << 5)); }
__device__ __forceinline__ void stage_rc(int b, int& R, int& C) { const int st = b / 1024, sb = b % 1024, swz = sb ^ (((sb >> 9) & 1) << 5); R = (st >> 1) * 16 + swz / 64; C = (st & 1) * 32 + (swz % 64) / 2; }
__device__ __forceinline__ int perm32(int rho) { const int n = rho >> 4, i = rho & 15; return 8 * (i >> 2) + 4 * n + (i & 3); }
struct Unit { int pm, pn, ord; };
typedef float f32x16 __attribute__((ext_vector_type(16)));
typedef int i32x8 __attribute__((ext_vector_type(8))); typedef int i32x4_ __attribute__((ext_vector_type(4)));
__device__ __forceinline__ i32x8 f8cat(const bf16x8 lo, const bf16x8 hi) { return __builtin_shufflevector(__builtin_bit_cast(i32x4_, lo), __builtin_bit_cast(i32x4_, hi), 0, 1, 2, 3, 4, 5, 6, 7); }
template <class Epi, class Sched, bool ALIGN_EPI, bool F8 = false>
__device__ __forceinline__ void gemm_phase(LAS unsigned char* lds, const int K, const unsigned kstepA, const Sched& S, const Epi& E) {
    const int tid = threadIdx.x, wid = __builtin_amdgcn_readfirstlane(tid >> 6), lane = tid & 63, wr = wid >> 2, wc = wid & 3, fr = lane & 15, fq = lane >> 4;
    const int nt = K / BK;
    constexpr bool GA = Sched::GATHER;
    int RA[2]; unsigned CA2[2], voffB[2], voffB1[2], voffA[2];
    constexpr bool P16 = Epi::PERM16;
#pragma unroll
    for (int i = 0; i < 2; ++i) { int R, C; stage_rc(tid * 16 + i * 8192, R, C); const int Rb = Epi::PERM ? ((R & ~31) + perm32(R & 31)) : R;
        RA[i] = R; CA2[i] = (unsigned)C * 2u; voffB[i] = (unsigned)(Rb * K + C) * 2u; voffA[i] = GA ? 0u : (S.lane_off(R) + (unsigned)C * 2u);
        if (P16) { const int c16 = 64 * (R >> 5) + 16 * ((R >> 2) & 3) + 4 * ((R >> 4) & 1) + (R & 3); voffB[i] = (unsigned)(c16 * K + C) * 2u; voffB1[i] = (unsigned)((c16 + 8) * K + C) * 2u; } else voffB1[i] = 0u; }
    const size_t kstepB = (size_t)(BK * 2);
    const size_t hstepB = (size_t)HALF * K * 2;
    const unsigned ldsw = (unsigned)wid * 1024u;
    const int aoff = lds_byte(wr * 64 + fr, fq * 8), boff = lds_byte(wc * 32 + fr, fq * 8);
    const char* const Ab = S.abase();
    unsigned aoC[2][2], aoN[2][2];
    unsigned uC[2], uN[2];
#define PG8_SA(b, h) (((b) * 2 + (h)) * HTB)
#define PG8_SB(b, h) ((4 + (b) * 2 + (h)) * HTB)
#define PG8_GLDS(sbase, voff, ldsoff) do { const char* _b = (const char*)(sbase); unsigned _v = (voff); asm volatile("" : "+s"(_b), "+v"(_v)); \
        __builtin_amdgcn_global_load_lds((const unsigned*)(_b + _v), (LAS unsigned*)(lds + (ldsoff)), 16, 0, 0); } while (0)
#define PG8_STAGE_B(bufoff, gbase) do { _Pragma("unroll") for (int _i = 0; _i < 2; ++_i) PG8_GLDS(gbase, voffB[_i], (bufoff) + ldsw + _i * 8192); } while (0)
#define PG8_STAGE_B1(bufoff, gbase) do { _Pragma("unroll") for (int _i = 0; _i < 2; ++_i) PG8_GLDS((const char*)(gbase) + (P16 ? (size_t)0 : hstepB), (P16 ? voffB1[_i] : voffB[_i]), (bufoff) + ldsw + _i * 8192); } while (0)
#define PG8_STAGE_A(bufoff, kb, UO, LO) do { _Pragma("unroll") for (int _i = 0; _i < 2; ++_i) PG8_GLDS(Ab + (size_t)((kb) + (UO)), (GA ? (LO)[_i] : voffA[_i]), (bufoff) + ldsw + _i * 8192); } while (0)
#define PG8_LDA(dst, b, h) do { _Pragma("unroll") for (int m = 0; m < 4; ++m) _Pragma("unroll") for (int k = 0; k < 2; ++k) dst[m][k] = *(const LAS bf16x8*)(lds + PG8_SA(b, h) + aoff + m * 2048 + k * 1024); } while (0)
#define PG8_LDB(dst, b, h) do { _Pragma("unroll") for (int n = 0; n < 2; ++n) _Pragma("unroll") for (int k = 0; k < 2; ++k) dst[n][k] = *(const LAS bf16x8*)(lds + PG8_SB(b, h) + boff + n * 2048 + k * 1024); } while (0)
#define PG8_MMA(ai, bj, At, Bt) do { __builtin_amdgcn_s_setprio(1); _Pragma("unroll") for (int m = 0; m < 4; ++m) _Pragma("unroll") for (int n = 0; n < 2; ++n) { \
        if constexpr (F8) { f32x16& _w = accw[ai][bj][m >> 1]; const int _q = ((m & 1) * 2 + n) * 4; f32x4 _c = {_w[_q], _w[_q + 1], _w[_q + 2], _w[_q + 3]}; \
            _c = __builtin_amdgcn_mfma_scale_f32_16x16x128_f8f6f4(f8cat(Bt[n][0], Bt[n][1]), f8cat(At[m][0], At[m][1]), _c, 0, 0, 0, 0, 0, 0); _w[_q] = _c[0]; _w[_q + 1] = _c[1]; _w[_q + 2] = _c[2]; _w[_q + 3] = _c[3]; } \
        else { _Pragma("unroll") for (int k = 0; k < 2; ++k) acc[ai][bj][m][n] = __builtin_amdgcn_mfma_f32_16x16x32_bf16(Bt[n][k], At[m][k], acc[ai][bj][m][n], 0, 0, 0); } } __builtin_amdgcn_s_setprio(0); } while (0)
#define PG8_WAIT_V(n) asm volatile("s_waitcnt vmcnt(" #n ")" ::: "memory")
#define PG8_WAIT_L(n) asm volatile("s_waitcnt lgkmcnt(" #n ")" ::: "memory")
#define PG8_BAR __builtin_amdgcn_s_barrier()
#define PG8_SCHED __builtin_amdgcn_sched_barrier(0)
#define PG8_KPAIR(KB1, KB2, KB3, BP2, BP3) do { \
            PG8_LDB(B0, 0, 0); PG8_LDB(B1, 0, 1); PG8_SCHED; PG8_LDA(At, 0, 0); PG8_STAGE_A(PG8_SA(1, 1), KB1, uC[1], aoC[1]); \
            PG8_WAIT_V(8); PG8_WAIT_L(0); PG8_BAR; PG8_MMA(0, 0, At, B0); PG8_MMA(0, 1, At, B1); PG8_BAR; PG8_SCHED; \
            PG8_LDA(At, 0, 1); PG8_STAGE_B(PG8_SB(0, 0), BP2); PG8_STAGE_B1(PG8_SB(0, 1), BP2); PG8_STAGE_A(PG8_SA(0, 0), KB2, u2[0], a2o[0]); \
            PG8_WAIT_V(8); PG8_WAIT_L(0); PG8_BAR; PG8_MMA(1, 0, At, B0); PG8_MMA(1, 1, At, B1); PG8_BAR; PG8_SCHED; \
            PG8_LDB(B0, 1, 0); PG8_LDB(B1, 1, 1); PG8_SCHED; PG8_LDA(At, 1, 0); PG8_STAGE_A(PG8_SA(0, 1), KB2, u2[1], a2o[1]); \
            PG8_WAIT_V(8); PG8_WAIT_L(0); PG8_BAR; PG8_MMA(0, 0, At, B0); PG8_MMA(0, 1, At, B1); PG8_BAR; PG8_SCHED; \
            PG8_LDA(At, 1, 1); PG8_STAGE_B(PG8_SB(1, 0), BP3); PG8_STAGE_B1(PG8_SB(1, 1), BP3); PG8_STAGE_A(PG8_SA(1, 0), KB3, u2[0], a2o[0]); \
            PG8_WAIT_V(8); PG8_WAIT_L(0); PG8_BAR; PG8_MMA(1, 0, At, B0); PG8_MMA(1, 1, At, B1); PG8_BAR; PG8_SCHED; } while (0)
    Unit cur, nxt; int ui = 0;
    if (!S.next(0, cur)) return;
    f32x4 acc[2][2][4][2];
#pragma unroll
    for (int a = 0; a < 2; ++a)
#pragma unroll
        for (int b = 0; b < 2; ++b)
#pragma unroll
            for (int m = 0; m < 4; ++m)
#pragma unroll
                for (int n = 0; n < 2; ++n) acc[a][b][m][n] = (f32x4){0.f, 0.f, 0.f, 0.f};
    bf16x8 At[4][2], B0[2][2], B1[2][2];
    f32x16 accw[2][2][2];
#define PG8_ZERO_W() do { if constexpr (F8) { _Pragma("unroll") for (int _a = 0; _a < 2; ++_a) _Pragma("unroll") for (int _b = 0; _b < 2; ++_b) _Pragma("unroll") for (int _m = 0; _m < 2; ++_m) _Pragma("unroll") for (int _e = 0; _e < 16; ++_e) accw[_a][_b][_m][_e] = 0.f; } } while (0)
    PG8_ZERO_W();
#pragma unroll
    for (int h = 0; h < 2; ++h) { uC[h] = GA ? 0u : S.unit_off(cur, h); uN[h] = uC[h];
#pragma unroll
        for (int i = 0; i < 2; ++i) { aoC[h][i] = GA ? (S.aoff(cur, h * HALF + RA[i]) + CA2[i]) : 0u; aoN[h][i] = aoC[h][i]; } }
    const char* cB = S.bptr(cur);
    PG8_STAGE_B(PG8_SB(0, 0), cB); PG8_STAGE_B1(PG8_SB(0, 1), cB); PG8_STAGE_A(PG8_SA(0, 0), 0u, uC[0], aoC[0]); PG8_STAGE_A(PG8_SA(0, 1), 0u, uC[1], aoC[1]);
    if (wr == 1) PG8_BAR;
    PG8_WAIT_V(2); PG8_BAR;
    PG8_STAGE_B(PG8_SB(1, 0), cB + kstepB); PG8_STAGE_A(PG8_SA(1, 0), kstepA, uC[0], aoC[0]); PG8_STAGE_B1(PG8_SB(1, 1), cB + kstepB);
    PG8_WAIT_V(6); PG8_BAR;
    for (;;) {
        const bool has_next = S.next(ui + 1, nxt);
        const char* nB = has_next ? S.bptr(nxt) : cB;
#pragma unroll
        for (int h = 0; h < 2; ++h) { uN[h] = (GA || !has_next) ? uC[h] : S.unit_off(nxt, h);
#pragma unroll
            for (int i = 0; i < 2; ++i) aoN[h][i] = (GA && has_next) ? (S.aoff(nxt, h * HALF + RA[i]) + CA2[i]) : aoC[h][i]; }
#pragma nounroll
        for (int t = 0; t < nt; t += 2) {
            const bool last = (t == nt - 2);
            const unsigned kb1 = (unsigned)(t + 1) * kstepA, kb2 = last ? 0u : (unsigned)(t + 2) * kstepA, kb3 = kb2 + kstepA;
            const char* b2 = last ? nB : cB + (size_t)(t + 2) * kstepB; const char* b3 = b2 + kstepB;
            unsigned u2[2], a2o[2][2];
#pragma unroll
            for (int h = 0; h < 2; ++h) { u2[h] = last ? uN[h] : uC[h];
#pragma unroll
                for (int i = 0; i < 2; ++i) a2o[h][i] = GA ? (last ? aoN[h][i] : aoC[h][i]) : 0u; }
            PG8_KPAIR(kb1, kb2, kb3, b2, b3);
        }
        if constexpr (ALIGN_EPI) { if (wr == 0) PG8_BAR; }
        if constexpr (F8) {
#pragma unroll
            for (int _a = 0; _a < 2; ++_a)
#pragma unroll
                for (int _b = 0; _b < 2; ++_b)
#pragma unroll
                    for (int _m = 0; _m < 4; ++_m)
#pragma unroll
                        for (int _n = 0; _n < 2; ++_n) { const f32x16& _w = accw[_a][_b][_m >> 1]; const int _q = ((_m & 1) * 2 + _n) * 4; acc[_a][_b][_m][_n] = (f32x4){_w[_q], _w[_q + 1], _w[_q + 2], _w[_q + 3]}; }
        }
        E(acc, cur, wr, wc, fr, fq);
        PG8_ZERO_W();
        if (!has_next) break;
#pragma unroll
        for (int a = 0; a < 2; ++a)
#pragma unroll
            for (int b = 0; b < 2; ++b)
#pragma unroll
                for (int m = 0; m < 4; ++m)
#pragma unroll
                    for (int n = 0; n < 2; ++n) acc[a][b][m][n] = (f32x4){0.f, 0.f, 0.f, 0.f};
        cur = nxt; cB = nB; ++ui;
#pragma unroll
        for (int h = 0; h < 2; ++h) { uC[h] = uN[h];
#pragma unroll
            for (int i = 0; i < 2; ++i) aoC[h][i] = aoN[h][i]; }
        if constexpr (ALIGN_EPI) { if (wr == 1) PG8_BAR; }
    }
    PG8_WAIT_V(0);
    if constexpr (!ALIGN_EPI) { if (wr == 0) PG8_BAR; }
    PG8_BAR;
#undef PG8_SA
#undef PG8_ZERO_W
#undef PG8_GLDS
#undef PG8_SB
#undef PG8_STAGE_A
#undef PG8_STAGE_B
#undef PG8_STAGE_B1
#undef PG8_LDA
#undef PG8_LDB
#undef PG8_MMA
#undef PG8_WAIT_V
#undef PG8_WAIT_L
#undef PG8_BAR
#undef PG8_SCHED
#undef PG8_KPAIR
}

struct DenseSched {
    const char* A; const char* Bt; unsigned lda2; size_t btile; int nM, nN, nwg, G, c;
    __device__ __forceinline__ void init(const bf16_t* A_, int lda, const bf16_t* Bt_, int K, int Mrows, int N) {
        A = (const char*)A_; Bt = (const char*)Bt_; lda2 = (unsigned)lda * 2u; btile = (size_t)256 * K * 2; nM = Mrows / BM; nN = N / BM; nwg = nM * nN; G = gridDim.x; c = blockIdx.x; }
    __device__ __forceinline__ bool next(int i, Unit& u) const {
        const long L = (long)i * G + c; if (L >= nwg) return false;
        int wgid = (int)L; { const int q = nwg / 8, r = nwg % 8, xcd = wgid % 8, off = wgid / 8; wgid = (xcd < r ? xcd * (q + 1) : r * (q + 1) + (xcd - r) * q) + off; }
        const int nig = 8 * nN, gid = wgid / nig, fm = gid * 8, gsz = (nM - fm) < 8 ? (nM - fm) : 8;
        u.pm = fm + ((wgid % nig) % gsz); u.pn = (wgid % nig) / gsz; u.ord = i; return true;
    }
    static constexpr bool GATHER = false;
    __device__ __forceinline__ unsigned lane_off(int r) const { return (unsigned)r * lda2; }
    __device__ __forceinline__ unsigned unit_off(const Unit& u, int h) const { return (unsigned)(u.pm * BM + h * HALF) * lda2; }
    __device__ __forceinline__ unsigned aoff(const Unit&, int) const { return 0u; }
    __device__ __forceinline__ const char* abase() const { return A; }
    __device__ __forceinline__ const char* bptr(const Unit& u) const { return Bt + (size_t)u.pn * btile; }
};
}
typedef float f32x2_t __attribute__((ext_vector_type(2))); typedef __bf16 bf16x2_t __attribute__((ext_vector_type(2)));
__device__ __forceinline__ unsigned cvt_pk_bf16(float lo, float hi) { const f32x2_t v = {lo, hi}; const bf16x2_t b = __builtin_convertvector(v, bf16x2_t); return __builtin_bit_cast(unsigned, b); }
__device__ __forceinline__ u32x4 pack8(const f32x4 v0, const f32x4 v1) { u32x4 w; w.x = cvt_pk_bf16(v0[0], v0[1]); w.y = cvt_pk_bf16(v0[2], v0[3]); w.z = cvt_pk_bf16(v1[0], v1[1]); w.w = cvt_pk_bf16(v1[2], v1[3]); return w; }
__device__ __forceinline__ unsigned cvtpk_m(float lo, float hi) { const f32x2_t v = {lo, hi}; const bf16x2_t b = __builtin_convertvector(v, bf16x2_t); return __builtin_bit_cast(unsigned, b); }
__device__ __forceinline__ u32x4 pack8m(const f32x4 v0, const f32x4 v1) { u32x4 w; w.x = cvtpk_m(v0[0], v0[1]); w.y = cvtpk_m(v0[2], v0[3]); w.z = cvtpk_m(v1[0], v1[1]); w.w = cvtpk_m(v1[2], v1[3]); return w; }
#define MFMA_SETTLE(S) asm volatile("s_nop 15\n\ts_nop 7" : "+v"(S[0][0]), "+v"(S[0][1]), "+v"(S[0][2]), "+v"(S[0][3]), "+v"(S[1][0]), "+v"(S[1][1]), "+v"(S[1][2]), "+v"(S[1][3]))
__device__ __forceinline__ f32x4 sig4(const f32x4 v) { f32x4 r; r[0] = sigmoidf_(v[0]); r[1] = sigmoidf_(v[1]); r[2] = sigmoidf_(v[2]); r[3] = sigmoidf_(v[3]); return r; }

#define EPI_ROWLOOP for (int ai = 0; ai < 2; ++ai) _Pragma("unroll") for (int m = 0; m < 4; ++m)
struct EpiInproj0 {
    static constexpr bool PERM = true, PERM16 = false; bf16_t* H0;
    __device__ __forceinline__ void operator()(const f32x4 (&acc)[2][2][4][2], const pg8::Unit& u, int wr, int wc, int fr, int fq) const {
        const int row0 = u.pm * 256 + wr * 64 + fr, cl = wc * 32 + 8 * fq;
#pragma unroll
        EPI_ROWLOOP { bf16_t* rp = H0 + (size_t)(row0 + ai * 128 + m * 16) * 1024;
            if (u.pn < 2) {
#pragma unroll
                for (int bj = 0; bj < 2; ++bj) *(u32x4*)(rp + u.pn * 256 + bj * 128 + cl) = pack8(acc[ai][bj][m][0], acc[ai][bj][m][1]);
            } else {
                const f32x4 v0 = acc[ai][0][m][0] * sig4(acc[ai][1][m][0]), v1 = acc[ai][0][m][1] * sig4(acc[ai][1][m][1]);
                *(u32x4*)(rp + 512 + (u.pn - 2) * 128 + cl) = pack8(v0, v1);
            } }
    }
};
struct EpiRes {
    static constexpr bool PERM = true, PERM16 = false; const float* resf; const bf16_t* resb; bf16_t* Y; float sc;
    __device__ __forceinline__ void operator()(const f32x4 (&acc)[2][2][4][2], const pg8::Unit& u, int wr, int wc, int fr, int fq) const {
        const int row0 = u.pm * 256 + wr * 64 + fr, c0 = u.pn * 256 + wc * 32 + 8 * fq;
#pragma unroll
        EPI_ROWLOOP { const size_t ro = (size_t)(row0 + ai * 128 + m * 16) * 1024 + c0;
#pragma unroll
            for (int bj = 0; bj < 2; ++bj) {
                f32x4 r0, r1;
                if (resf) { r0 = *(const f32x4*)(resf + ro + bj * 128); r1 = *(const f32x4*)(resf + ro + bj * 128 + 4); }
                else { const u32x4 xv = *(const u32x4*)(resb + ro + bj * 128);
                    r0[0] = __uint_as_float(xv.x << 16); r0[1] = __uint_as_float(xv.x & 0xffff0000u); r0[2] = __uint_as_float(xv.y << 16); r0[3] = __uint_as_float(xv.y & 0xffff0000u);
                    r1[0] = __uint_as_float(xv.z << 16); r1[1] = __uint_as_float(xv.z & 0xffff0000u); r1[2] = __uint_as_float(xv.w << 16); r1[3] = __uint_as_float(xv.w & 0xffff0000u); }
                *(u32x4*)(Y + ro + bj * 128) = pack8(acc[ai][bj][m][0] * sc + r0 * ALPHA, acc[ai][bj][m][1] * sc + r1 * ALPHA);
            } }
    }
};
struct EpiLogits {
    static constexpr bool PERM = true, PERM16 = false; float* LOG;
    __device__ __forceinline__ void operator()(const f32x4 (&acc)[2][2][4][2], const pg8::Unit& u, int wr, int wc, int fr, int fq) const {
        const int row0 = u.pm * 256 + wr * 64 + fr, cl = wc * 32 + 8 * fq;
#pragma unroll
        EPI_ROWLOOP { float* rp = LOG + (size_t)(row0 + ai * 128 + m * 16) * 256 + cl;
#pragma unroll
            for (int bj = 0; bj < 2; ++bj) { *(f32x4*)(rp + bj * 128) = acc[ai][bj][m][0]; *(f32x4*)(rp + bj * 128 + 4) = acc[ai][bj][m][1]; } }
    }
};

constexpr int MOE_TAB_OFF = 131072;
__device__ __forceinline__ int moe_setup256(const unsigned* cnt, LAS unsigned char* lds) {
    LAS int* tstart = (LAS int*)(lds + MOE_TAB_OFF);
    LAS int* scnt = (LAS int*)(lds + MOE_TAB_OFF + 1088);
    LAS unsigned short* texp = (LAS unsigned short*)(lds + MOE_TAB_OFF + 2176);
    const int tid = threadIdx.x;
    __syncthreads();
    const int lane = tid & 63, wave = tid >> 6;
    LAS int* wtot = tstart + 260;
    int c = 0;
    if (tid < 256) { const int n = (int)cnt[tid]; scnt[tid] = n; c = (n + 255) >> 8; }
    int incl = c;
#pragma unroll
    for (int o = 1; o < 64; o <<= 1) { const int t = __shfl_up(incl, o); if (lane >= o) incl += t; }
    if (tid < 256 && lane == 63) wtot[wave] = incl;
    __syncthreads();
    if (tid < 256) { int off = 0;
#pragma unroll
        for (int w = 0; w < 3; ++w) off += (w < wave) ? wtot[w] : 0;
        tstart[tid] = off + incl - c; if (tid == 255) tstart[256] = off + incl; }
    __syncthreads();
    if (tid < 256) for (int q = tstart[tid]; q < tstart[tid + 1]; ++q) texp[q] = (unsigned short)tid;
    __syncthreads();
    return __builtin_amdgcn_readfirstlane(tstart[256]);
}
constexpr int MOE_TOK_OFF = MOE_TAB_OFF + 5120;
constexpr int MOE_MAX_ORD = 20;
struct MoeGuSched {
    static constexpr bool GATHER = true;
    const char* X; const char* W; const int2* list; LAS unsigned char* lds; int R, nunits, G, c;
    __device__ __forceinline__ int vcu() const { return (G % 8 == 0) ? (c % 8) * (G / 8) + c / 8 : c; }
    __device__ __forceinline__ bool next(int i, pg8::Unit& u) const {
        const int L = i * G + vcu(); if (L >= nunits || i >= MOE_MAX_ORD) return false;
        const int q = L >> 1; const int e = __builtin_amdgcn_readfirstlane((q < R) ? (int)((LAS unsigned short*)(lds + MOE_TAB_OFF + 2176))[q] : 256);
        u.pm = q; u.pn = e * 2 + (L & 1); u.ord = i; return true; }
    __device__ __forceinline__ void prepare() const {
        const int tid = threadIdx.x, r = tid & 255;
        pg8::Unit u;
        for (int i = tid >> 8; next(i, u); i += 2) {
            const int e = u.pn >> 1; int token;
            if (e < 256) { const int ts = ((LAS int*)(lds + MOE_TAB_OFF))[e], cn = ((LAS int*)(lds + MOE_TAB_OFF + 1088))[e]; int lr = (u.pm - ts) * 256 + r; if (lr >= cn) lr = cn - 1;
                token = list[(size_t)e * LISTCAP + lr].x / 10; }
            else token = (u.pm - R) * 256 + r;
            ((LAS unsigned short*)(lds + MOE_TOK_OFF))[i * 256 + r] = (unsigned short)token;
        }
        __syncthreads();
    }
    __device__ __forceinline__ unsigned aoff(const pg8::Unit& u, int r) const { return (unsigned)((LAS unsigned short*)(lds + MOE_TOK_OFF))[u.ord * 256 + r] * 1024u; }
    __device__ __forceinline__ unsigned lane_off(int) const { return 0u; }
    __device__ __forceinline__ unsigned unit_off(const pg8::Unit&, int) const { return 0u; }
    __device__ __forceinline__ const char* abase() const { return X; }
    __device__ __forceinline__ const char* bptr(const pg8::Unit& u) const { return W + (size_t)u.pn * (256 * 1024); }
};
constexpr float GU_SC = 1.0f / (X8_SCALE * W8_SCALE);
struct EpiGateUp {
    static constexpr bool PERM = true, PERM16 = false; unsigned char* HID;
    __device__ __forceinline__ void operator()(const f32x4 (&acc)[2][2][4][2], const pg8::Unit& u, int wr, int wc, int fr, int fq) const {
        const int row0 = u.pm * 256 + wr * 64 + fr, c0 = (u.pn & 1) * 128 + wc * 32 + 8 * fq;
#pragma unroll
        EPI_ROWLOOP { const f32x4 g0 = acc[ai][0][m][0] * GU_SC, g1 = acc[ai][0][m][1] * GU_SC;
            f32x4 h0 = g0 * sig4(g0) * (acc[ai][1][m][0] * (GU_SC * H8_SCALE)), h1 = g1 * sig4(g1) * (acc[ai][1][m][1] * (GU_SC * H8_SCALE));
#pragma unroll
            for (int i = 0; i < 4; ++i) { h0[i] = clamp8(h0[i]); h1[i] = clamp8(h1[i]); }
            *(u32x2*)(HID + (size_t)(row0 + ai * 128 + m * 16) * 256 + c0) = pack8_fp8(h0, h1); }
    }
};
constexpr int MOE_RI_OFF = MOE_TAB_OFF + 5120;
constexpr int MOE_MAX_RT = 6;
struct MoeDownSched {
    const char* HID; const char* W; const int2* list; LAS unsigned char* lds; int R, ntile, G, c;
    __device__ __forceinline__ int vcu() const { return (G % 8 == 0) ? (c % 8) * (G / 8) + c / 8 : c; }
    __device__ __forceinline__ bool next(int i, pg8::Unit& u) const {
        const int q = vcu() + G * (i >> 2); if (q >= ntile || (i >> 2) >= MOE_MAX_RT) return false;
        const int e = (q < R) ? (int)((LAS unsigned short*)(lds + MOE_TAB_OFF + 2176))[q] : 256;
        u.pm = q; u.pn = e * 4 + (i & 3); u.ord = i >> 2; return true; }
    __device__ __forceinline__ void prepare() const {
        const int tid = threadIdx.x, r = tid & 255;
        for (int o = tid >> 8; o < MOE_MAX_RT; o += 2) {
            const int q = vcu() + G * o; if (q >= ntile) break;
            u32x2 en;
            if (q < R) { const int e = ((LAS unsigned short*)(lds + MOE_TAB_OFF + 2176))[q]; const int ts = ((LAS int*)(lds + MOE_TAB_OFF))[e], cn = ((LAS int*)(lds + MOE_TAB_OFF + 1088))[e];
                const int lr = (q - ts) * 256 + r; if (lr < cn) { const int2 le = list[(size_t)e * LISTCAP + lr]; en.x = (unsigned)le.x; en.y = (unsigned)le.y; } else { en.x = 0xffffffffu; en.y = 0u; } }
            else { en.x = (unsigned)(((q - R) * 256 + r) * 10 + 8); en.y = __float_as_uint(1.0f); }
            ((LAS u32x2*)(lds + MOE_RI_OFF))[o * 256 + r] = en;
        }
        __syncthreads();
    }
    static constexpr bool GATHER = false;
    __device__ __forceinline__ unsigned lane_off(int r) const { return (unsigned)r * 256u; }
    __device__ __forceinline__ unsigned unit_off(const pg8::Unit& u, int h) const { return (unsigned)(u.pm * 256 + h * 128) * 256u; }
    __device__ __forceinline__ unsigned aoff(const pg8::Unit&, int) const { return 0u; }
    __device__ __forceinline__ const char* abase() const { return HID; }
    __device__ __forceinline__ const char* bptr(const pg8::Unit& u) const { return W + (size_t)u.pn * (256 * 256); }
};
struct EpiDown {
    static constexpr bool PERM = true, PERM16 = true;
    unsigned char* YB; LAS unsigned char* lds;
    __device__ __forceinline__ void operator()(const f32x4 (&acc)[2][2][4][2], const pg8::Unit& u, int wr, int wc, int fr, int fq) const {
        asm volatile("" : "+v"(fr), "+v"(fq));
        const unsigned c0b = (unsigned)((u.pn & 3) * 256 + wc * 64 + 16 * fq); const bool shared = (u.pn >> 2) == 256;
        const LAS u32x2* ri = (const LAS u32x2*)(lds + MOE_RI_OFF) + u.ord * 256 + wr * 64 + fr;
#pragma unroll
        for (int ai = 0; ai < 2; ++ai)
#pragma unroll
            for (int m = 0; m < 4; ++m) { const u32x2 en = ri[ai * 128 + m * 16]; const float wv = __uint_as_float(en.y) * (YB_SCALE / (H8_SCALE * W8_SCALE));
                if ((int)en.x >= 0) { unsigned char* rp = YB + (size_t)(en.x * 1024u + c0b);
                    const f32x4 v00 = acc[ai][0][m][0] * wv, v01 = acc[ai][0][m][1] * wv, v10 = acc[ai][1][m][0] * wv, v11 = acc[ai][1][m][1] * wv;
                    const u32x2 h0 = pack8_fp8(v00, v01), h1 = pack8_fp8(v10, v11);
                    *(u32x4*)rp = (u32x4){h0.x, h0.y, h1.x, h1.y};
                    if (YB_NSLOT == 10 && shared) {
                        u32x2 r_[2];
#pragma unroll
                        for (int bj = 0; bj < 2; ++bj) { const u32x2 h = bj ? h1 : h0; const f32x4 v0 = bj ? v10 : v00, v1 = bj ? v11 : v01;
                            const auto a0 = __builtin_amdgcn_cvt_pk_f32_fp8((int)h.x, false), a1 = __builtin_amdgcn_cvt_pk_f32_fp8((int)h.x, true), a2 = __builtin_amdgcn_cvt_pk_f32_fp8((int)h.y, false), a3 = __builtin_amdgcn_cvt_pk_f32_fp8((int)h.y, true);
                            const f32x4 r0 = {v0[0] - a0[0], v0[1] - a0[1], v0[2] - a1[0], v0[3] - a1[1]}, r1 = {v1[0] - a2[0], v1[1] - a2[1], v1[2] - a3[0], v1[3] - a3[1]};
                            r_[bj] = pack8_fp8(r0, r1); }
                        *(u32x4*)(rp + 1024) = (u32x4){r_[0].x, r_[0].y, r_[1].x, r_[1].y}; } } }
    }
};

struct EpiInprojN {
    static constexpr bool PERM = true, PERM16 = false; bf16_t* QN; bf16_t* QR; bf16_t* KV6; float* GATES; const float* ROT;
    __device__ __forceinline__ void operator()(const f32x4 (&acc)[2][2][4][2], const pg8::Unit& u, int wr, int wc, int fr, int fq) const {
        const int row0 = u.pm * 256 + wr * 64 + fr, cl = wc * 32 + 8 * fq, pn = u.pn;
        const bool isq = pn < 4, rotk = (pn == 6 || pn == 8), dorot = (isq || rotk) && ((wc & 1) == 0);
#pragma unroll
        EPI_ROWLOOP { const int row = row0 + ai * 128 + m * 16;
            if (pn == 10) {
                if (cl < 48) { *(f32x4*)(GATES + (size_t)row * 48 + cl) = sig4(acc[ai][0][m][0]); *(f32x4*)(GATES + (size_t)row * 48 + cl + 4) = sig4(acc[ai][0][m][1]); }
            } else {
                f32x4 cs0, cs1, sn0, sn1;
                if (dorot) { const float* rt = ROT + (size_t)(row & (T - 1)) * 16; cs0 = *(const f32x4*)rt; cs1 = *(const f32x4*)(rt + 4); sn0 = *(const f32x4*)(rt + 8); sn1 = *(const f32x4*)(rt + 12); }
#pragma unroll
                for (int bj = 0; bj < 2; ++bj) {
                    const f32x4 v0 = acc[ai][bj][m][0], v1 = acc[ai][bj][m][1];
                    f32x4 r0 = v0, r1 = v1;
                    if (dorot) {
                        f32x4 p0, p1;
#pragma unroll
                        for (int i = 0; i < 4; ++i) { p0[i] = __shfl_xor(v0[i], 16); p1[i] = __shfl_xor(v1[i], 16); }
                        if (fq == 0) { r0 = v0 * cs0 - p0 * sn0; r1 = v1 * cs1 - p1 * sn1; }
                        else if (fq == 1) { r0 = v0 * cs0 + p0 * sn0; r1 = v1 * cs1 + p1 * sn1; }
                    }
                    if (isq) { const int c = pn * 256 + bj * 128 + cl;
                        *(u32x4*)(QN + (size_t)row * 1024 + c) = pack8(v0 * QSCALE, v1 * QSCALE); *(u32x4*)(QR + (size_t)row * 1024 + c) = pack8(r0 * QSCALE, r1 * QSCALE); }
                    else { const int cc = bj * 128 + cl, g = cc >> 6, d = cc & 63, b = row >> 13, t = row & (T - 1);
                        *(u32x4*)(KV6 + ((size_t)((pn - 4) * 16 + b * 4 + g) * T + t) * 64 + d) = pack8(r0, r1); }
                }
            } }
    }
};

struct Cmp1Sched {
    const char* KV6; const char* W; int G, c;
    static constexpr bool GATHER = false;
    __device__ __forceinline__ bool next(int i, pg8::Unit& u) const { const int L = i * G + c; if (L >= 64) return false; u.pm = L >> 1; u.pn = L & 1; u.ord = i; return true; }
    __device__ __forceinline__ unsigned lane_off(int r) const { return (unsigned)r * 2048u; }
    __device__ __forceinline__ unsigned unit_off(const pg8::Unit& u, int h) const { return (unsigned)u.pn * (unsigned)(16 * T * 64 * 2) + (unsigned)(u.pm * 256 + h * 128) * 2048u; }
    __device__ __forceinline__ unsigned aoff(const pg8::Unit&, int) const { return 0u; }
    __device__ __forceinline__ const char* abase() const { return KV6; }
    __device__ __forceinline__ const char* bptr(const pg8::Unit& u) const { return W + (size_t)u.pn * (256 * 2048 * 2); }
};
struct EpiCmp1 {
    static constexpr bool PERM = true, PERM16 = false; bf16_t* CH1; const float* bias1;
    __device__ __forceinline__ void operator()(const f32x4 (&acc)[2][2][4][2], const pg8::Unit& u, int wr, int wc, int fr, int fq) const {
        const int row0 = u.pm * 256 + wr * 64 + fr, cl = wc * 32 + 8 * fq;
        const f32x4 b0 = *(const f32x4*)(bias1 + u.pn * 128 + cl), b1 = *(const f32x4*)(bias1 + u.pn * 128 + cl + 4);
#pragma unroll
        EPI_ROWLOOP { f32x4 v0 = acc[ai][0][m][0] + b0, v1 = acc[ai][0][m][1] + b1;
#pragma unroll
            for (int i = 0; i < 4; ++i) { v0[i] = gelu_tanh(v0[i]); v1[i] = gelu_tanh(v1[i]); }
            *(u32x4*)(CH1 + ((size_t)u.pn * 8192 + row0 + ai * 128 + m * 16) * 128 + cl) = pack8(v0, v1); }
    }
};

__device__ __forceinline__ void p0_item(const float* W, int K, int N, bf16_t* WT, int kb, int n0, int drow0, LAS float* scr, int lane, bool f8 = false) {
    const int k0 = 64 * kb, n4 = (lane & 15) * 4;
    const bool cok = (n0 + n4) < N;
    f32x4 v[16];
#pragma unroll
    for (int i = 0; i < 16; ++i) { const int kk = 4 * i + (lane >> 4); v[i] = cok ? __builtin_nontemporal_load((const f32x4*)(W + (size_t)(k0 + kk) * N + n0 + n4)) : (f32x4){0.f, 0.f, 0.f, 0.f}; }
#pragma unroll
    for (int i = 0; i < 16; ++i) { const int kk = 4 * i + (lane >> 4); LAS float* d = scr + kk * 65 + n4; d[0] = v[i][0]; d[1] = v[i][1]; d[2] = v[i][2]; d[3] = v[i][3]; }
    asm volatile("s_waitcnt lgkmcnt(0)" ::: "memory");
    if (f8) {
        const int c4 = lane & 3;
#pragma unroll
        for (int j = 0; j < 4; ++j) { const int n = (lane >> 2) + 16 * j; const LAS float* sp = scr + (16 * c4) * 65 + n;
            u32x4 o;
            o.x = pk4_fp8(sp[0 * 65] * W8_SCALE, sp[1 * 65] * W8_SCALE, sp[2 * 65] * W8_SCALE, sp[3 * 65] * W8_SCALE); o.y = pk4_fp8(sp[4 * 65] * W8_SCALE, sp[5 * 65] * W8_SCALE, sp[6 * 65] * W8_SCALE, sp[7 * 65] * W8_SCALE);
            o.z = pk4_fp8(sp[8 * 65] * W8_SCALE, sp[9 * 65] * W8_SCALE, sp[10 * 65] * W8_SCALE, sp[11 * 65] * W8_SCALE); o.w = pk4_fp8(sp[12 * 65] * W8_SCALE, sp[13 * 65] * W8_SCALE, sp[14 * 65] * W8_SCALE, sp[15 * 65] * W8_SCALE);
            if (n0 + n < N) __builtin_nontemporal_store(o, (u32x4*)((unsigned char*)WT + (size_t)(drow0 + n) * K + k0 + 16 * c4)); }
        asm volatile("s_waitcnt lgkmcnt(0)" ::: "memory");
        return;
    }
    const int c = lane & 7;
#pragma unroll
    for (int j = 0; j < 8; ++j) { const int n = (lane >> 3) + 8 * j; const LAS float* sp = scr + (8 * c) * 65 + n;
        u32x4 o; o.x = pk2(sp[0 * 65], sp[1 * 65]); o.y = pk2(sp[2 * 65], sp[3 * 65]); o.z = pk2(sp[4 * 65], sp[5 * 65]); o.w = pk2(sp[6 * 65], sp[7 * 65]);
        if (n0 + n < N) __builtin_nontemporal_store(o, (u32x4*)(WT + (size_t)(drow0 + n) * K + k0 + 8 * c)); }
    asm volatile("s_waitcnt lgkmcnt(0)" ::: "memory");
}
struct CvtItem { const float* W; bf16_t* WT; int K, N, k0, n0, drow0; };
__device__ __forceinline__ void cvt32_load(const CvtItem& it, int lane, f32x4 (&v)[8]) {
    const int n4 = (lane & 7) * 4;
#pragma unroll
    for (int i = 0; i < 8; ++i) { const int kk = 8 * i + (lane >> 3); v[i] = __builtin_nontemporal_load((const f32x4*)(it.W + (size_t)(it.k0 + kk) * it.N + it.n0 + n4)); }
}
__device__ __forceinline__ void cvt32_finish(const CvtItem& it, int lane, const f32x4 (&v)[8], LAS float* scr) {
    const int n4 = (lane & 7) * 4;
#pragma unroll
    for (int i = 0; i < 8; ++i) { const int kk = 8 * i + (lane >> 3); LAS float* d = scr + kk * 33 + n4; d[0] = v[i][0]; d[1] = v[i][1]; d[2] = v[i][2]; d[3] = v[i][3]; }
    asm volatile("s_waitcnt lgkmcnt(0)" ::: "memory");
    const int c = lane & 7;
#pragma unroll
    for (int j = 0; j < 4; ++j) { const int n = (lane >> 3) + 8 * j; const LAS float* sp = scr + (8 * c) * 33 + n;
        const float v0 = sp[0 * 33], v1 = sp[1 * 33], v2 = sp[2 * 33], v3 = sp[3 * 33], v4 = sp[4 * 33], v5 = sp[5 * 33], v6 = sp[6 * 33], v7 = sp[7 * 33];
        u32x2 o; o.x = pk4_fp8(v0 * W8_SCALE, v1 * W8_SCALE, v2 * W8_SCALE, v3 * W8_SCALE); o.y = pk4_fp8(v4 * W8_SCALE, v5 * W8_SCALE, v6 * W8_SCALE, v7 * W8_SCALE);
        __builtin_nontemporal_store(o, (u32x2*)((unsigned char*)it.WT + (size_t)(it.drow0 + n) * it.K + it.k0 + 8 * c)); }
    asm volatile("s_waitcnt lgkmcnt(0)" ::: "memory");
}
constexpr int CVT1_ITEMS = 257 * 384;
__device__ __forceinline__ CvtItem cvt1_item(const Args& a, int idx) {
    const int e = idx / 384, sub = idx % 384, mat = sub >> 7, r = sub & 127;
    CvtItem it;
    if (mat < 2) { it.W = (e < 256) ? a.in[23 + mat] + ((size_t)256 + e) * (size_t)(D * FF) : a.in[26 + mat] + (size_t)(D * FF);
        it.K = D; it.N = FF; it.k0 = (r >> 3) * 64; it.n0 = (r & 7) * 32; it.drow0 = (it.n0 >> 7) * 256 + mat * 128 + (it.n0 & 127);
        it.WT = (bf16_t*)(a.ws + WS_WGU + (size_t)(257 + e) * 512 * 1024); }
    else { it.W = (e < 256) ? a.in[25] + ((size_t)256 + e) * (size_t)(FF * D) : a.in[28] + (size_t)(FF * D);
        it.K = FF; it.N = D; it.k0 = (r >> 5) * 64; it.n0 = (r & 31) * 32; it.drow0 = it.n0;
        it.WT = (bf16_t*)(a.ws + WS_WD + (size_t)(257 + e) * 1024 * 256); }
    return it;
}
__device__ __forceinline__ void cvt1_run(const Args& a, int& next, int stride, int quota, LAS float* scr, int lane) {
#pragma unroll 1
    for (int q = 0; q < quota && next < CVT1_ITEMS; ++q) {
        CvtItem t[4]; f32x4 v[4][8]; bool ok[4];
#pragma unroll
        for (int u = 0; u < 4; ++u) { const int idx = next + u * stride; ok[u] = idx < CVT1_ITEMS; t[u] = cvt1_item(a, ok[u] ? idx : 0); if (ok[u]) cvt32_load(t[u], lane, v[u]); }
        next += 4 * stride;
#pragma unroll
        for (int u = 0; u < 4; ++u) if (ok[u]) cvt32_finish(t[u], lane, v[u], scr);
    }
}
__device__ __forceinline__ void ph_prologue(const Args& a, LAS unsigned char* lds) {
    const int lane = threadIdx.x & 63, wave = threadIdx.x >> 6;
    LAS float* scr = (LAS float*)(lds + wave * 16640);
    const int gw = blockIdx.x * 8 + wave, ngw = gridDim.x * 8;
    for (int it = gw; it < 257 * 192; it += ngw) {
        const int le = it / 192, sub = it % 192, l = 0, e = le, mat = sub >> 6, r = sub & 63;
        if (mat < 2) {
            const float* W = (e < 256) ? a.in[23 + mat] + ((size_t)l * 256 + e) * (size_t)(D * FF) : a.in[26 + mat] + (size_t)l * (D * FF);
            const int kb = r >> 2, n0 = (r & 3) * 64;
            p0_item(W, D, FF, (bf16_t*)(a.ws + WS_WGU + (size_t)le * 512 * 1024), kb, n0, (n0 >> 7) * 256 + mat * 128 + (n0 & 127), scr, lane, true);
        } else {
            const float* W = (e < 256) ? a.in[25] + ((size_t)l * 256 + e) * (size_t)(FF * D) : a.in[28] + (size_t)l * (FF * D);
            const int kb = r >> 4, n0 = (r & 15) * 64;
            p0_item(W, FF, D, (bf16_t*)(a.ws + WS_WD + (size_t)le * 1024 * 256), kb, n0, n0, scr, lane, true);
        }
    }
    {
        for (int it = gw; it < 512; it += ngw) { const int w = it >> 8, r = it & 255;
            p0_item(a.in[w ? 16 : 8], D, D, (bf16_t*)(a.ws + (w ? WS_WOUTN : WS_WOUT0)), r >> 4, (r & 15) * 64, (r & 15) * 64, scr, lane, w != 0); }
        for (int it = gw; it < 16 * 41; it += ngw) p0_item(a.in[9], D, 2608, (bf16_t*)(a.ws + WS_WINN), it / 41, (it % 41) * 64, (it % 41) * 64, scr, lane);
        for (int it = gw; it < 128; it += ngw) { const int l = it >> 6, r = it & 63;
            p0_item(a.in[21] + (size_t)l * D * NE, D, NE, (bf16_t*)(a.ws + WS_WR) + (size_t)l * NE * D, r >> 2, (r & 3) * 64, (r & 3) * 64, scr, lane); }
        for (int it = gw; it < 16 * 16; it += ngw) { const int kb = it >> 4, n0 = (8 + (it & 15)) * 64;
            const int isg = (n0 >= 1024) ? 1 : 0, rel = n0 - 512 - isg * 512;
            p0_item(a.in[1], D, 1536, (bf16_t*)(a.ws + WS_WIN0), kb, n0, 512 + (rel >> 7) * 256 + isg * 128 + (rel & 127), scr, lane); }
        for (int it = gw; it < 128; it += ngw) { const int kv = it >> 6, r = it & 63;
            p0_item(a.in[kv ? 14 : 11], 2048, 128, (bf16_t*)(a.ws + WS_CW1) + (size_t)kv * 256 * 2048, r >> 1, (r & 1) * 64, (r & 1) * 64, scr, lane); }
    }
    {
        const int gt = blockIdx.x * 512 + threadIdx.x, ngt = gridDim.x * 512;
        u32x4* z0 = (u32x4*)((bf16_t*)(a.ws + WS_WINN) + (size_t)2608 * 1024);
        for (int i = gt; i < 208 * 1024 / 8; i += ngt) z0[i] = (u32x4){0u, 0u, 0u, 0u};
        for (int kv = 0; kv < 2; ++kv) { u32x4* z1 = (u32x4*)((bf16_t*)(a.ws + WS_CW1) + ((size_t)kv * 256 + 128) * 2048);
            for (int i = gt; i < 128 * 2048 / 8; i += ngt) z1[i] = (u32x4){0u, 0u, 0u, 0u}; }
        const float* x = a.in[0]; bf16_t* XA = (bf16_t*)(a.ws + WS_XA);
        for (size_t i = gt; i < (size_t)M * D / 8; i += ngt) { const f32x4 v0 = *(const f32x4*)(x + i * 8), v1 = *(const f32x4*)(x + i * 8 + 4);
            u32x4 o; o.x = pk2(v0[0], v0[1]); o.y = pk2(v0[2], v0[3]); o.z = pk2(v1[0], v1[1]); o.w = pk2(v1[2], v1[3]); *(u32x4*)(XA + i * 8) = o; }
        const float* win = a.in[1]; const float* mix = a.in[2]; const float* psc = a.in[3]; bf16_t* WIN0 = (bf16_t*)(a.ws + WS_WIN0);
        for (int i = gt; i < 512 * 1024; i += ngt) { const int n = i & 511, k = i >> 9, g = n >> 7, nn = n & 127;
            const float* wr_ = win + (size_t)k * 1536 + g * 128; const float* mx = mix + (size_t)g * 128 * 128 + nn;
            float s = 0.f;
            for (int c = 0; c < 128; ++c) s += wr_[c] * mx[(size_t)c * 128];
            WIN0[(size_t)n * 1024 + k] = f2bf(s * psc[n]); }
        float* misc = (float*)(a.ws + WS_MISC);
        for (int i = gt; i < 256; i += ngt) { const int kv = i >> 7, j = i & 127; const float* pos = a.in[kv ? 13 : 10]; const float* w1 = a.in[kv ? 14 : 11];
            float s = 0.f; for (int k = 0; k < 2048; ++k) s += pos[k] * w1[(size_t)k * 128 + j]; misc[i] = s; }
        float* rot = misc + 1024;
        for (int i = gt; i < T * 8; i += ngt) { const int t = i >> 3, f = i & 7;
            const float ang = (float)t * a.inv_freq[f]; const double rev = (double)ang * 0.15915494309189535; const float fr = (float)(rev - floor(rev));
            rot[t * 16 + f] = __builtin_amdgcn_cosf(fr); rot[t * 16 + 8 + f] = __builtin_amdgcn_sinf(fr); }
    }
}

typedef short v4i16_t __attribute__((ext_vector_type(4)));
constexpr int AT_KB = 0, AT_VB = 16384, AT_PS = 32768, AT_MSK = 32768 + 65536;
#define DPP_I(x, ctrl) __builtin_amdgcn_update_dpp((int)(x), (int)(x), (ctrl), 0xF, 0xF, true)
#define DPP_F(x, ctrl) __builtin_bit_cast(float, __builtin_amdgcn_update_dpp(__builtin_bit_cast(int, (float)(x)), __builtin_bit_cast(int, (float)(x)), (ctrl), 0xF, 0xF, true))
__device__ __forceinline__ bf16x8 tr_frag(LAS unsigned char* p0, LAS unsigned char* p1) {
    const v4i16_t a = __builtin_amdgcn_ds_read_tr16_b64_v4i16((LAS v4i16_t*)p0), b = __builtin_amdgcn_ds_read_tr16_b64_v4i16((LAS v4i16_t*)p1);
    return (bf16x8){a[0], a[1], a[2], a[3], b[0], b[1], b[2], b[3]};
}
constexpr size_t TN2_OFF = 786432;
__device__ __forceinline__ void ph_knorm(const Args& a) {
    const bf16_t* KV6 = (const bf16_t*)(a.ws + WS_KV6);
    float* TN2 = (float*)(a.ws + WS_MISC + TN2_OFF);
    const int lane = threadIdx.x & 63, wave = threadIdx.x >> 6;
    const int first = (gridDim.x > 64) ? 64 : 0;
    if ((int)blockIdx.x < first) return;
    const int wi = ((int)blockIdx.x - first) * 8 + wave, nw = ((int)gridDim.x - first) * 8;
    for (int id = wi; id < 4096; id += nw) {
        const int ty = id >> 11, bg = (id >> 7) & 15, tile = id & 127;
        const bf16_t* rp = KV6 + ((size_t)((ty ? 4 : 2) * 16 + bg) * T + tile * 64 + lane) * 64;
        float ssq = 0.f;
#pragma unroll
        for (int c = 0; c < 8; ++c) { const bf16x8 v = *(const bf16x8*)(rp + 8 * c);
#pragma unroll
            for (int j = 0; j < 8; ++j) { const float f = bf2f((bf16_t)v[j]); ssq += f * f; } }
        ssq = wave_max(ssq);
        if (lane == 0) TN2[id] = ssq;
    }
}
__device__ __forceinline__ void attn_qk2(LAS unsigned char* Kb, const bf16x8 (&q)[2][2], int fr, int g4, const float (&cinit)[2], f32x4 (&s)[2][4]) {
#pragma unroll
    for (int c = 0; c < 4; ++c) {
#pragma unroll
        for (int rb = 0; rb < 2; ++rb) s[rb][c] = (f32x4){cinit[rb], cinit[rb], cinit[rb], cinit[rb]};
#pragma unroll
        for (int ks = 0; ks < 2; ++ks) {
            const bf16x8 kf = *(const LAS bf16x8*)(Kb + pg8::lds_byte(16 * c + fr, 32 * ks + 8 * g4));
#pragma unroll
            for (int rb = 0; rb < 2; ++rb) s[rb][c] = __builtin_amdgcn_mfma_f32_16x16x32_bf16(kf, q[rb][ks], s[rb][c], 0, 0, 0);
        }
    }
}
__device__ __forceinline__ void attn_qk2m(LAS unsigned char* Kb, const bf16x8 (&q)[2][2], int fr, int g4, const float (&cinit)[2], f32x4 (&s)[2][4]) {
    bf16x8 kf[4][2];
#pragma unroll
    for (int c = 0; c < 4; ++c)
#pragma unroll
        for (int ks = 0; ks < 2; ++ks) kf[c][ks] = *(const LAS bf16x8*)(Kb + pg8::lds_byte(16 * c + fr, 32 * ks + 8 * g4));
    __builtin_amdgcn_sched_barrier(0);
    f32x4 ci[2];
#pragma unroll
    for (int rb = 0; rb < 2; ++rb) ci[rb] = (f32x4){cinit[rb], cinit[rb], cinit[rb], cinit[rb]};
#pragma unroll
    for (int c = 0; c < 4; ++c) {
#pragma unroll
        for (int ks = 0; ks < 2; ++ks) {
#pragma unroll
            for (int rb = 0; rb < 2; ++rb) s[rb][c] = __builtin_amdgcn_mfma_f32_16x16x32_bf16(kf[c][ks], q[rb][ks], ks == 0 ? ci[rb] : s[rb][c], 0, 0, 0);
        }
    }
}
__device__ __forceinline__ void attn_qk2z(LAS unsigned char* Kb, const bf16x8 (&q)[2][2], int fr, int g4, f32x4 (&s)[2][4]) {
    bf16x8 kf[4][2];
#pragma unroll
    for (int c = 0; c < 4; ++c)
#pragma unroll
        for (int ks = 0; ks < 2; ++ks) kf[c][ks] = *(const LAS bf16x8*)(Kb + pg8::lds_byte(16 * c + fr, 32 * ks + 8 * g4));
    __builtin_amdgcn_sched_barrier(0);
#pragma unroll
    for (int c = 0; c < 4; ++c) {
#pragma unroll
        for (int ks = 0; ks < 2; ++ks) {
#pragma unroll
            for (int rb = 0; rb < 2; ++rb) s[rb][c] = __builtin_amdgcn_mfma_f32_16x16x32_bf16(kf[c][ks], q[rb][ks], ks == 0 ? (f32x4){0.f, 0.f, 0.f, 0.f} : s[rb][c], 0, 0, 0);
        }
    }
}
struct AttnRow { float m; f32x4 o[4]; f32x4 ol; };
__device__ __forceinline__ float max3f(float a, float b, float c) { float r; asm("v_max3_f32 %0, %1, %2, %3" : "=v"(r) : "v"(a), "v"(b), "v"(c)); return r; }
__device__ __forceinline__ bool attn_sm2(f32x4 (&s)[4], AttnRow& st, int kbase, int g4, int lo, int hi, bool en, bool emask) {
    const float NEG = -INFINITY;
    if (emask) {
#pragma unroll
        for (int c = 0; c < 4; ++c)
#pragma unroll
            for (int i = 0; i < 4; ++i) { const int key = kbase + 16 * c + 4 * g4 + i; if (key < lo || key > hi) s[c][i] = NEG; }
    }
    float mx = max3f(s[0][0], s[0][1], s[0][2]); mx = max3f(mx, s[0][3], s[1][0]); mx = max3f(mx, s[1][1], s[1][2]); mx = max3f(mx, s[1][3], s[2][0]);
    mx = max3f(mx, s[2][1], s[2][2]); mx = max3f(mx, s[2][3], s[3][0]); mx = max3f(mx, s[3][1], s[3][2]); mx = max3f(mx, s[3][3], mx);
    if (!en) mx = NEG;
    mx = max3f(mx, __shfl_xor(mx, 16), mx); mx = max3f(mx, __shfl_xor(mx, 32), mx);
    const float delta = (mx > 20.0f) ? mx : 0.f;
    const bool moved = __builtin_amdgcn_ballot_w64(delta != 0.f) != 0ull;
    if (moved) {
        const float alpha = __builtin_amdgcn_exp2f(-delta);
#pragma unroll
        for (int c = 0; c < 4; ++c) s[c] = s[c] - delta;
#pragma unroll
        for (int dt = 0; dt < 4; ++dt) st.o[dt] *= alpha;
        st.ol *= alpha;
        st.m += delta;
    }
#pragma unroll
    for (int c = 0; c < 4; ++c)
#pragma unroll
        for (int i = 0; i < 4; ++i) s[c][i] = __builtin_amdgcn_exp2f(s[c][i]);
    return moved;
}
__device__ __forceinline__ bool attn_sm2x(f32x4 (&s)[2][4], AttnRow (&st)[2], int kbase, int g4, const int (&lo)[2], const int (&hi)[2], const bool (&en)[2], bool emask) {
    const float NEG = -INFINITY;
    if (emask) {
#pragma unroll
        for (int rb = 0; rb < 2; ++rb)
#pragma unroll
            for (int c = 0; c < 4; ++c)
#pragma unroll
                for (int i = 0; i < 4; ++i) { const int key = kbase + 16 * c + 4 * g4 + i; if (key < lo[rb] || key > hi[rb]) s[rb][c][i] = NEG; }
    }
    float mx[2];
#pragma unroll
    for (int rb = 0; rb < 2; ++rb) {
        float m = max3f(s[rb][0][0], s[rb][0][1], s[rb][0][2]); m = max3f(m, s[rb][0][3], s[rb][1][0]); m = max3f(m, s[rb][1][1], s[rb][1][2]); m = max3f(m, s[rb][1][3], s[rb][2][0]);
        m = max3f(m, s[rb][2][1], s[rb][2][2]); m = max3f(m, s[rb][2][3], s[rb][3][0]); m = max3f(m, s[rb][3][1], s[rb][3][2]); m = max3f(m, s[rb][3][3], m);
        mx[rb] = en[rb] ? m : NEG;
    }
    { const float t0 = __shfl_xor(mx[0], 16), t1 = __shfl_xor(mx[1], 16); mx[0] = max3f(mx[0], t0, t0); mx[1] = max3f(mx[1], t1, t1); }
    { const float t0 = __shfl_xor(mx[0], 32), t1 = __shfl_xor(mx[1], 32); mx[0] = max3f(mx[0], t0, t0); mx[1] = max3f(mx[1], t1, t1); }
    const float d0 = (mx[0] > 20.0f) ? mx[0] : 0.f, d1 = (mx[1] > 20.0f) ? mx[1] : 0.f;
    const bool moved = __builtin_amdgcn_ballot_w64((d0 != 0.f) || (d1 != 0.f)) != 0ull;
    if (moved) {
        const float dl[2] = {d0, d1};
#pragma unroll
        for (int rb = 0; rb < 2; ++rb) {
            const float alpha = __builtin_amdgcn_exp2f(-dl[rb]);
#pragma unroll
            for (int c = 0; c < 4; ++c) s[rb][c] = s[rb][c] - dl[rb];
#pragma unroll
            for (int dt = 0; dt < 4; ++dt) st[rb].o[dt] *= alpha;
            st[rb].ol *= alpha; st[rb].m += dl[rb];
        }
    }
#pragma unroll
    for (int rb = 0; rb < 2; ++rb)
#pragma unroll
        for (int c = 0; c < 4; ++c)
#pragma unroll
            for (int i = 0; i < 4; ++i) s[rb][c][i] = __builtin_amdgcn_exp2f(s[rb][c][i]);
    return moved;
}
__device__ __forceinline__ void attn_pv2x(LAS unsigned char* Vb, const f32x4 (&p)[2][4], int vlane, int swz, const unsigned (&enm)[2], const bool (&act)[2], const bf16x8 onesf, AttnRow (&st)[2]) {
#pragma unroll
    for (int ks = 0; ks < 2; ++ks) {
        bf16x8 pb[2];
#pragma unroll
        for (int rb = 0; rb < 2; ++rb) { u32x4 pw = pack8m(p[rb][2 * ks], p[rb][2 * ks + 1]); pw.x &= enm[rb]; pw.y &= enm[rb]; pw.z &= enm[rb]; pw.w &= enm[rb]; pb[rb] = __builtin_bit_cast(bf16x8, pw); }
#pragma unroll
        for (int dt = 0; dt < 4; ++dt) {
            LAS unsigned char* a0 = Vb + vlane + (2 * ks) * 2048 + ((dt ^ swz) * 32);
            const bf16x8 vf = tr_frag(a0, a0 + 2048);
#pragma unroll
            for (int rb = 0; rb < 2; ++rb) if (act[rb]) st[rb].o[dt] = __builtin_amdgcn_mfma_f32_16x16x32_bf16(vf, pb[rb], st[rb].o[dt], 0, 0, 0);
        }
#pragma unroll
        for (int rb = 0; rb < 2; ++rb) if (act[rb]) st[rb].ol = __builtin_amdgcn_mfma_f32_16x16x32_bf16(onesf, pb[rb], st[rb].ol, 0, 0, 0);
    }
}
__device__ __forceinline__ bool attn_max2x(f32x4 (&s)[2][4], int kbase, int g4, const int (&lo)[2], const int (&hi)[2], const bool (&en)[2], bool emask, float (&d)[2]) {
    const float NEG = -INFINITY;
    MFMA_SETTLE(s);
    if (emask) {
#pragma unroll
        for (int rb = 0; rb < 2; ++rb)
#pragma unroll
            for (int c = 0; c < 4; ++c)
#pragma unroll
                for (int i = 0; i < 4; ++i) { const int key = kbase + 16 * c + 4 * g4 + i; if (key < lo[rb] || key > hi[rb]) s[rb][c][i] = NEG; }
    }
    float mx[2];
#pragma unroll
    for (int rb = 0; rb < 2; ++rb) {
        float m = max3f(s[rb][0][0], s[rb][0][1], s[rb][0][2]); m = max3f(m, s[rb][0][3], s[rb][1][0]); m = max3f(m, s[rb][1][1], s[rb][1][2]); m = max3f(m, s[rb][1][3], s[rb][2][0]);
        m = max3f(m, s[rb][2][1], s[rb][2][2]); m = max3f(m, s[rb][2][3], s[rb][3][0]); m = max3f(m, s[rb][3][1], s[rb][3][2]); m = max3f(m, s[rb][3][3], m);
        mx[rb] = en[rb] ? m : NEG;
    }
    { const float t0 = __shfl_xor(mx[0], 16), t1 = __shfl_xor(mx[1], 16); mx[0] = max3f(mx[0], t0, t0); mx[1] = max3f(mx[1], t1, t1); }
    { const float t0 = __shfl_xor(mx[0], 32), t1 = __shfl_xor(mx[1], 32); mx[0] = max3f(mx[0], t0, t0); mx[1] = max3f(mx[1], t1, t1); }
    d[0] = (mx[0] > 20.0f) ? mx[0] : 0.f; d[1] = (mx[1] > 20.0f) ? mx[1] : 0.f;
    return __builtin_amdgcn_ballot_w64((d[0] != 0.f) || (d[1] != 0.f)) != 0ull;
}
__device__ __forceinline__ void attn_rescale2x(f32x4 (&s)[2][4], AttnRow (&st)[2], const float (&d)[2]) {
#pragma unroll
    for (int rb = 0; rb < 2; ++rb) {
        const float alpha = __builtin_amdgcn_exp2f(-d[rb]);
#pragma unroll
        for (int c = 0; c < 4; ++c) s[rb][c] = s[rb][c] - d[rb];
#pragma unroll
        for (int dt = 0; dt < 4; ++dt) st[rb].o[dt] *= alpha;
        st[rb].ol *= alpha; st[rb].m += d[rb];
    }
}
__device__ __forceinline__ void attn_exp1(f32x4 (&s)[4], unsigned enm, bf16x8 (&pb)[2]) {
#pragma unroll
    for (int c = 0; c < 4; ++c)
#pragma unroll
        for (int i = 0; i < 4; ++i) s[c][i] = __builtin_amdgcn_exp2f(s[c][i]);
#pragma unroll
    for (int ks = 0; ks < 2; ++ks) { u32x4 pw = pack8m(s[2 * ks], s[2 * ks + 1]); pw.x &= enm; pw.y &= enm; pw.z &= enm; pw.w &= enm; pb[ks] = __builtin_bit_cast(bf16x8, pw); }
}
__device__ __forceinline__ void attn_pv1(LAS unsigned char* Vb, const bf16x8 (&pb)[2], int vlane, int swz, const bf16x8 onesf, AttnRow& st) {
#pragma unroll
    for (int ks = 0; ks < 2; ++ks) {
#pragma unroll
        for (int dt = 0; dt < 4; ++dt) {
            LAS unsigned char* a0 = Vb + vlane + (2 * ks) * 2048 + ((dt ^ swz) * 32);
            const bf16x8 vf = tr_frag(a0, a0 + 2048);
            st.o[dt] = __builtin_amdgcn_mfma_f32_16x16x32_bf16(vf, pb[ks], st.o[dt], 0, 0, 0);
        }
        st.ol = __builtin_amdgcn_mfma_f32_16x16x32_bf16(onesf, pb[ks], st.ol, 0, 0, 0);
    }
}
__device__ __forceinline__ bool attn_step2x(LAS unsigned char* Vb, f32x4 (&s)[2][4], AttnRow (&st)[2], int kbase, int g4, const int (&lo)[2], const int (&hi)[2], const bool (&en)[2], const unsigned (&enm)[2], bool emask,
                                            int vlane, int swz, const bf16x8 onesf) {
    float d[2];
    const bool moved = attn_max2x(s, kbase, g4, lo, hi, en, emask, d);
    if (moved) attn_rescale2x(s, st, d);
    bf16x8 p0[2], p1[2];
    attn_exp1(s[0], enm[0], p0);
    attn_pv1(Vb, p0, vlane, swz, onesf, st[0]);
    attn_exp1(s[1], enm[1], p1);
    attn_pv1(Vb, p1, vlane, swz, onesf, st[1]);
    return moved;
}
__device__ __forceinline__ void attn_step2x_nomax(LAS unsigned char* Vb, f32x4 (&s)[2][4], AttnRow (&st)[2], int kbase, int g4, const int (&lo)[2], const int (&hi)[2], const unsigned (&enm)[2], bool emask,
                                                  int vlane, int swz, const bf16x8 onesf) {
    if (emask) {
#pragma unroll
        for (int rb = 0; rb < 2; ++rb)
#pragma unroll
            for (int c = 0; c < 4; ++c)
#pragma unroll
                for (int i = 0; i < 4; ++i) { const int key = kbase + 16 * c + 4 * g4 + i; if (key < lo[rb] || key > hi[rb]) s[rb][c][i] = -INFINITY; }
    }
    bf16x8 p0[2], p1[2];
    attn_exp1(s[0], enm[0], p0);
    attn_pv1(Vb, p0, vlane, swz, onesf, st[0]);
    attn_exp1(s[1], enm[1], p1);
    attn_pv1(Vb, p1, vlane, swz, onesf, st[1]);
}
typedef _Float16 f16x4 __attribute__((ext_vector_type(4)));
constexpr int AT4_KB = 0, AT4_VB = 32768, AT2_PS = 65536, AT2_MSK = 65536 + 65536;
__device__ __forceinline__ int attn_pair_of(int pr) { const int p = pr & 63, k = pr >> 8; const int q = (k & 2) ? ((p + 32) & 63) : p; return (k & 1) ? 63 - q : q; }
__device__ __forceinline__ void ph_attn_fast2(const Args& a, LAS unsigned char* lds) {
    const bf16_t* QN = (const bf16_t*)(a.ws + WS_HN);
    const bf16_t* QR = (const bf16_t*)(a.ws + WS_QR);
    const bf16_t* KV6 = (const bf16_t*)(a.ws + WS_KV6);
    const float* GATES = (const float*)(a.ws + WS_GATES);
    const bf16_t* KC = (const bf16_t*)(a.ws + WS_KC);
    const bf16_t* VC = KC + (size_t)8192 * 64;
    bf16_t* O = (bf16_t*)(a.ws + WS_O);
    const int tid = threadIdx.x, lane = tid & 63, wave = __builtin_amdgcn_readfirstlane(tid >> 6);
    const int fr = lane & 15, g4 = lane >> 4;
    int ksrc, vsrc;
    { int R, C; pg8::stage_rc(wave * 1024 + lane * 16, R, C); ksrc = R * 64 + C;
      const int key = 8 * wave + (lane >> 3), pos = lane & 7, chunk = (pos >> 1) ^ ((key >> 1) & 3); vsrc = key * 64 + (chunk * 2 + (pos & 1)) * 8; }
    const int vlane = (4 * g4 + (fr >> 2)) * 128 + (fr & 3) * 8, swz = (2 * g4 + (fr >> 3)) & 3;
    LAS _Float16* ps = (LAS _Float16*)(lds + AT2_PS + wave * 8192);
    LAS unsigned* mskl = (LAS unsigned*)(lds + AT2_MSK + wave * 128);
    const float NEG = -INFINITY;
    const bf16x8 onesf = (fr == 0) ? (bf16x8){0x3F80, 0x3F80, 0x3F80, 0x3F80, 0x3F80, 0x3F80, 0x3F80, 0x3F80} : (bf16x8){0, 0, 0, 0, 0, 0, 0, 0};
    const int vcu = (gridDim.x % 8 == 0) ? (int)((blockIdx.x % 8) * (gridDim.x / 8) + blockIdx.x / 8) : (int)blockIdx.x;
    int cvt_next = (int)blockIdx.x * 8 + wave; const int cvt_stride = (int)gridDim.x * 8;
    LAS float* cvt_scr = (LAS float*)(lds + AT2_PS + wave * 8448);
    bool cmp_pref = false;
    for (int pr = vcu; pr < 1024; pr += gridDim.x) {
#pragma unroll 1
        for (int half = 0; half < 2; ++half) {
            const int bg = pr >> 6, pp = attn_pair_of(pr), cc = half ? (127 - pp) : pp;
            const int b = bg >> 2, g = bg & 3, t0 = cc * 64, cur = cc;
            const int head = g * 4 + (fr & 3);
            int trow[2];
            bf16x8 qn[2][2];
#pragma unroll
            for (int rb = 0; rb < 2; ++rb) {
                trow[rb] = t0 + 8 * wave + 4 * rb + (fr >> 2);
#pragma unroll
                for (int ks = 0; ks < 2; ++ks) qn[rb][ks] = *(const bf16x8*)(QN + ((size_t)b * T + trow[rb]) * 1024 + head * 64 + 32 * ks + 8 * g4);
            }
#define TROW_PIN() asm volatile("" : "+v"(trow[0]), "+v"(trow[1]))
#define TOKROW(rb) ((size_t)b * T + trow[rb])
#define GATE(rb, br) (GATES[TOKROW(rb) * 48 + head * 3 + (br)])
            const bf16_t* kcb = KC + (size_t)bg * 512 * 64;
            const bf16_t* kvb = KV6 + (size_t)bg * T * 64;
#define ATK(sl) (((sl) < 4 ? AT4_KB : AT2_PS - 4 * 8192) + (sl) * 8192)
#define ATV(sl) (((sl) < 4 ? AT4_VB : AT2_PS + 32768 - 4 * 8192) + (sl) * 8192)
#define AT_DMA(BR, tile, slot) do { const bf16_t* kp_; const bf16_t* vp_; \
                if ((BR) == 0) { kp_ = kcb + (size_t)(tile) * 4096; vp_ = kp_ + (size_t)8192 * 64; } \
                else { kp_ = kvb + (size_t)((BR) == 1 ? 2 : 4) * 16 * T * 64 + (size_t)(tile) * 4096; vp_ = kp_ + (size_t)16 * T * 64; } \
                __builtin_amdgcn_global_load_lds((const unsigned*)(kp_ + ksrc), (LAS unsigned*)(lds + ATK(slot) + wave * 1024), 16, 0, 0); \
                __builtin_amdgcn_global_load_lds((const unsigned*)(vp_ + vsrc), (LAS unsigned*)(lds + ATV(slot) + wave * 1024), 16, 0, 0); } while (0)
            int ncv[2];
#pragma unroll
            for (int rb = 0; rb < 2; ++rb) ncv[rb] = (trow[rb] >= 31) ? ((trow[rb] - 31) / 16 + 1) : 0;
            const int nct = (((t0 + 63 - 31) / 16 + 1) + 63) >> 6;
            float mc[2], invc[2];
            const int t_lo = t0 + 8 * wave, ncv_lo = (t_lo >= 31) ? ((t_lo - 31) / 16 + 1) : 0;
            {
                float m1[2] = {NEG, NEG}, l1[2] = {0.f, 0.f};
                const float zero2[2] = {0.f, 0.f};
#define CMP1_TILE(J, SLOT, MASKED) do { const int j = (J); const int SLOT_ = (SLOT); \
                    f32x4 s[2][4]; attn_qk2(lds + AT4_KB + SLOT_ * 8192, qn, fr, g4, zero2, s); \
                    _Pragma("unroll") \
                    for (int rb = 0; rb < 2; ++rb) { \
                        float mx = NEG; \
                    _Pragma("unroll") \
                        for (int c = 0; c < 4; ++c) \
                    _Pragma("unroll") \
                            for (int i = 0; i < 4; ++i) { const int n = 64 * j + 16 * c + 4 * g4 + i; if ((MASKED) && n >= ncv[rb]) s[rb][c][i] = NEG; mx = fmaxf(mx, s[rb][c][i]); } \
                        mx = fmaxf(mx, __shfl_xor(mx, 16)); mx = fmaxf(mx, __shfl_xor(mx, 32)); \
                        const float mn = fmaxf(m1[rb], mx), msafe = (mn == NEG) ? 0.f : mn; \
                        const float alpha = (m1[rb] == NEG) ? 0.f : __builtin_amdgcn_exp2f(m1[rb] - msafe); \
                        float sum = 0.f; \
                    _Pragma("unroll") \
                        for (int c = 0; c < 4; ++c) \
                    _Pragma("unroll") \
                            for (int i = 0; i < 4; ++i) sum += __builtin_amdgcn_exp2f(s[rb][c][i] - msafe); \
                        l1[rb] = l1[rb] * alpha + sum; m1[rb] = mn; \
                    } \
                } while (0)
                if (!cmp_pref) { AT_DMA(0, 0, 0); if (nct > 1) AT_DMA(0, 1, 1); } __syncthreads();
                for (int j0 = 0; j0 < nct; j0 += 2) { const int sb = (j0 & 2);
                    if (j0 + 2 < nct) AT_DMA(0, j0 + 2, sb ^ 2);
                    if (j0 + 3 < nct) AT_DMA(0, j0 + 3, (sb ^ 2) + 1);
                    CMP1_TILE(j0, sb, true); if (j0 + 1 < nct) CMP1_TILE(j0 + 1, sb + 1, true);
                    __syncthreads();
                }
#undef CMP1_TILE
#pragma unroll
                for (int rb = 0; rb < 2; ++rb) { float lc = l1[rb]; lc += __shfl_xor(lc, 16); lc += __shfl_xor(lc, 32); invc[rb] = (lc > 0.f) ? -(((m1[rb] == NEG) ? 0.f : m1[rb]) + __builtin_amdgcn_logf(lc)) : 0.f; mc[rb] = (m1[rb] == NEG) ? 0.f : m1[rb]; }
            }
            {
                AttnRow oc[2];
#pragma unroll
                for (int rb = 0; rb < 2; ++rb) { oc[rb].m = 0.f; oc[rb].ol = (f32x4){0.f, 0.f, 0.f, 0.f};
#pragma unroll
                    for (int dt = 0; dt < 4; ++dt) oc[rb].o[dt] = (f32x4){0.f, 0.f, 0.f, 0.f}; }
                const float cin[2] = {invc[0], invc[1]};
                const unsigned full[2] = {0xffffffffu, 0xffffffffu}; const bool both[2] = {true, true};
#define CMP2_TILE(J, SLOT, MASKED) do { const int j = (J); const int SLOT_ = (SLOT); \
                    f32x4 s[2][4]; attn_qk2(lds + AT4_KB + SLOT_ * 8192, qn, fr, g4, cin, s); \
                    _Pragma("unroll") \
                    for (int rb = 0; rb < 2; ++rb) \
                    _Pragma("unroll") \
                        for (int c = 0; c < 4; ++c) { \
                            f16x4 hs; \
                    _Pragma("unroll") \
                            for (int i = 0; i < 4; ++i) { const int n = 64 * j + 16 * c + 4 * g4 + i; const float p = (!(MASKED) || n < ncv[rb]) ? __builtin_amdgcn_exp2f(s[rb][c][i]) : 0.f; s[rb][c][i] = p; \
                                float h = p; h += DPP_F(h, 0xB1); h += DPP_F(h, 0x4E); hs[i] = (_Float16)h; }        \
                            if ((fr & 3) == 0) *(LAS f16x4*)(ps + (4 * rb + (fr >> 2)) * 512 + 64 * j + 16 * c + 4 * g4) = hs; \
                        } \
                    attn_pv2x(lds + AT4_VB + SLOT_ * 8192, s, vlane, swz, full, both, onesf, oc); \
                } while (0)
                const bool reload = nct > 4;
                if (reload) { AT_DMA(0, 0, 0); AT_DMA(0, 1, 1); __syncthreads(); }
                for (int j0 = 0; j0 < nct; j0 += 2) { const int sb = (j0 & 2);
                    if (reload && j0 + 2 < nct) AT_DMA(0, j0 + 2, sb ^ 2);
                    if (reload && j0 + 3 < nct) AT_DMA(0, j0 + 3, (sb ^ 2) + 1);
                    CMP2_TILE(j0, sb, true); if (j0 + 1 < nct) CMP2_TILE(j0 + 1, sb + 1, true);
                    __syncthreads();
                }
#undef CMP2_TILE
                TROW_PIN();
#pragma unroll
                for (int rb = 0; rb < 2; ++rb) { bf16_t* op = O + TOKROW(rb) * 1024 + head * 64 + 4 * g4; const float g0 = GATE(rb, 0);
#pragma unroll
                    for (int dt = 0; dt < 4; ++dt) { const f32x4 v = oc[rb].o[dt] * g0; u32x2 w; w.x = cvt_pk_bf16(v[0], v[1]); w.y = cvt_pk_bf16(v[2], v[3]); *(u32x2*)(op + 16 * dt) = w; } }
            }
            {
                WSYNC();
                const int tl = lane >> 4, li = lane & 15;
                const int nsel = (cur + 1 < 16) ? (cur + 1) : 16;
#pragma unroll 1
                for (int rnd = 0; rnd < 2; ++rnd) {
                    const LAS _Float16* pst = ps + (4 * rnd + tl) * 512;
                    float v[8];
#pragma unroll
                    for (int k = 0; k < 8; ++k) { const int j = li + 16 * k;
                        float x;
                        if (j > cur) x = NEG;
                        else if (j == 0 || j == cur || j == cur - 1) x = NEG;
                        else { const int n0 = 4 * j; x = (float)pst[n0 - 1] + 2.0f * ((float)pst[n0] + (float)pst[n0 + 1] + (float)pst[n0 + 2]) + (float)pst[n0 + 3]; }
                        v[k] = x; }
                    int vi[8];
#pragma unroll
                    for (int k = 0; k < 8; ++k) vi[k] = __builtin_bit_cast(int, v[k]);
                    unsigned mm[4] = {1u, 0u, 0u, 0u};
                    {
                        const unsigned bc = 1u << (cur & 31); const int wc_ = cur >> 5;
                        mm[0] |= (wc_ == 0) ? bc : 0u; mm[1] |= (wc_ == 1) ? bc : 0u; mm[2] |= (wc_ == 2) ? bc : 0u; mm[3] |= (wc_ == 3) ? bc : 0u;
                        if (cur >= 1) { const unsigned bp = 1u << ((cur - 1) & 31); const int wp_ = (cur - 1) >> 5;
                            mm[0] |= (wp_ == 0) ? bp : 0u; mm[1] |= (wp_ == 1) ? bp : 0u; mm[2] |= (wp_ == 2) ? bp : 0u; mm[3] |= (wp_ == 3) ? bp : 0u; }
                    }
                    const int nforced = (cur >= 2) ? 3 : (cur + 1);
                    for (int it = 0; it < nsel - nforced; ++it) {
                        int bv = max(max(max(vi[0], vi[1]), max(vi[2], vi[3])), max(max(vi[4], vi[5]), max(vi[6], vi[7])));
                        bv = max(bv, DPP_I(bv, 0xB1)); bv = max(bv, DPP_I(bv, 0x4E)); bv = max(bv, DPP_I(bv, 0x141)); bv = max(bv, DPP_I(bv, 0x140));
                        int bi = 255;
#pragma unroll
                        for (int k = 7; k >= 0; --k) bi = (vi[k] == bv) ? (li + 16 * k) : bi;
                        bi = min(bi, DPP_I(bi, 0xB1)); bi = min(bi, DPP_I(bi, 0x4E)); bi = min(bi, DPP_I(bi, 0x141)); bi = min(bi, DPP_I(bi, 0x140));
                        const unsigned bit = 1u << (bi & 31); const int wsel = bi >> 5;
                        mm[0] |= (wsel == 0) ? bit : 0u; mm[1] |= (wsel == 1) ? bit : 0u; mm[2] |= (wsel == 2) ? bit : 0u; mm[3] |= (wsel == 3) ? bit : 0u;
                        if ((bi & 15) == li) {
#pragma unroll
                            for (int k = 0; k < 8; ++k) if ((bi >> 4) == k) vi[k] = (int)0xFF800000;
                        }
                    }
                    if (li == 0) { mskl[(4 * rnd + tl) * 4 + 0] = mm[0]; mskl[(4 * rnd + tl) * 4 + 1] = mm[1]; mskl[(4 * rnd + tl) * 4 + 2] = mm[2]; mskl[(4 * rnd + tl) * 4 + 3] = mm[3]; }
                }
                WSYNC();
            }
            bf16x8 qr[2][2];
            TROW_PIN();
#pragma unroll
            for (int rb = 0; rb < 2; ++rb)
#pragma unroll
                for (int ks = 0; ks < 2; ++ks) qr[rb][ks] = *(const bf16x8*)(QR + TOKROW(rb) * 1024 + head * 64 + 32 * ks + 8 * g4);
            bool nomax_slc, nomax_win;
            {
                float qq = 0.f;
#pragma unroll
                for (int rb = 0; rb < 2; ++rb) { float q2 = 0.f;
#pragma unroll
                    for (int ks = 0; ks < 2; ++ks)
#pragma unroll
                        for (int j = 0; j < 8; ++j) { const float x = bf2f((bf16_t)qr[rb][ks][j]); q2 += x * x; }
                    q2 += __shfl_xor(q2, 16); q2 += __shfl_xor(q2, 32); qq = fmaxf(qq, q2); }
                qq = wave_max(qq);
                const float* tn = (const float*)(a.ws + WS_MISC + TN2_OFF) + bg * 128;
                const int jt0w = (t0 >= 511) ? ((t0 - 511) >> 6) : 0;
                float ts = 0.f, tw = 0.f;
#pragma unroll
                for (int h2 = 0; h2 < 2; ++h2) { const int tl_ = lane + 64 * h2; if (tl_ <= cur) { ts = fmaxf(ts, tn[tl_]); if (tl_ >= jt0w) tw = fmaxf(tw, tn[2048 + tl_]); } }
                ts = wave_max(ts); tw = wave_max(tw);
                nomax_slc = __builtin_amdgcn_readfirstlane((qq * ts <= 3500.0f) ? 1 : 0) != 0;
                nomax_win = __builtin_amdgcn_readfirstlane((qq * tw <= 3500.0f) ? 1 : 0) != 0;
            }
            {
                AttnRow ss[2];
#pragma unroll
                for (int rb = 0; rb < 2; ++rb) { ss[rb].m = 0.f; ss[rb].ol = (f32x4){0.f, 0.f, 0.f, 0.f};
#pragma unroll
                    for (int dt = 0; dt < 4; ++dt) ss[rb].o[dt] = (f32x4){0.f, 0.f, 0.f, 0.f}; }
                const int nt_ = cur + 1;
                bool refmoved = false;
#define SLC_PRE(J) const int j_ = (J); bool en[2], act[2]; unsigned enm[2]; \
                    _Pragma("unroll") for (int rb = 0; rb < 2; ++rb) { const unsigned mw = mwg[rb]; \
                        en[rb] = (mw >> (j_ & 31)) & 1u; act[rb] = __any(en[rb]); enm[rb] = en[rb] ? 0xffffffffu : 0u; } const int lo2[2] = {0, 0};
#define SLC_TILE(J, SLOT) do { SLC_PRE(J) \
                    if (act[0] || act[1]) { f32x4 s[2][4]; \
                        if (refmoved) { const float cin[2] = {-ss[0].m, -ss[1].m}; attn_qk2(lds + ATK(SLOT), qr, fr, g4, cin, s); } \
                        else attn_qk2z(lds + ATK(SLOT), qr, fr, g4, s); \
                        refmoved |= attn_step2x(lds + ATV(SLOT), s, ss, 64 * j_, g4, lo2, trow, en, enm, j_ == cur, vlane, swz, onesf); } } while (0)
#define SLC_TILE_NM(J, SLOT) do { SLC_PRE(J) \
                    if (act[0] || act[1]) { f32x4 s[2][4]; const float cm_[2] = {en[0] ? 0.f : -1e30f, en[1] ? 0.f : -1e30f}; attn_qk2m(lds + ATK(SLOT), qr, fr, g4, cm_, s); \
                        const unsigned fullm_[2] = {0xffffffffu, 0xffffffffu}; \
                        attn_step2x_nomax(lds + ATV(SLOT), s, ss, 64 * j_, g4, lo2, trow, fullm_, j_ == cur, vlane, swz, onesf); } } while (0)
#pragma unroll
                for (int i = 0; i < 4; ++i) if (i < nt_) AT_DMA(1, i, i);
                __syncthreads();
#define SLC_LOOP(TILE) for (int j0 = 0; j0 < nt_; j0 += 4) { const int sb = (j0 & 4); \
                    const unsigned mwg[2] = {mskl[(fr >> 2) * 4 + (j0 >> 5)], mskl[(4 + (fr >> 2)) * 4 + (j0 >> 5)]};       \
                    _Pragma("unroll") for (int i = 0; i < 4; ++i) if (j0 + 4 + i < nt_) AT_DMA(1, j0 + 4 + i, (sb ^ 4) + i); \
                    TILE(j0, sb); if (j0 + 1 < nt_) TILE(j0 + 1, sb + 1); if (j0 + 2 < nt_) TILE(j0 + 2, sb + 2); if (j0 + 3 < nt_) TILE(j0 + 3, sb + 3); \
                    __syncthreads(); }
                if (nomax_slc) { SLC_LOOP(SLC_TILE_NM) } else { SLC_LOOP(SLC_TILE) }
#undef SLC_LOOP
#undef SLC_TILE_NM
#undef SLC_PRE
#undef SLC_TILE
                TROW_PIN();
#pragma unroll
                for (int rb = 0; rb < 2; ++rb) { const float l = __shfl(ss[rb].ol[0], fr); const float sc1 = (l > 0.f) ? GATE(rb, 1) / l : 0.f;
                    bf16_t* op = O + TOKROW(rb) * 1024 + head * 64 + 4 * g4;
#pragma unroll
                    for (int dt = 0; dt < 4; ++dt) { const u32x2 pv = *(const u32x2*)(op + 16 * dt); f32x4 v = ss[rb].o[dt] * sc1;
                        v[0] += __uint_as_float(pv.x << 16); v[1] += __uint_as_float(pv.x & 0xffff0000u); v[2] += __uint_as_float(pv.y << 16); v[3] += __uint_as_float(pv.y & 0xffff0000u);
                        u32x2 w; w.x = cvt_pk_bf16(v[0], v[1]); w.y = cvt_pk_bf16(v[2], v[3]); *(u32x2*)(op + 16 * dt) = w; } }
            }
            {
                AttnRow sw[2];
#pragma unroll
                for (int rb = 0; rb < 2; ++rb) { sw[rb].m = 0.f; sw[rb].ol = (f32x4){0.f, 0.f, 0.f, 0.f};
#pragma unroll
                    for (int dt = 0; dt < 4; ++dt) sw[rb].o[dt] = (f32x4){0.f, 0.f, 0.f, 0.f}; }
                const int jt0 = (t0 >= 511) ? ((t0 - 511) >> 6) : 0;
                const int nt_ = cur - jt0 + 1;
                const unsigned full[2] = {0xffffffffu, 0xffffffffu}; const bool both[2] = {true, true};
                bool refmoved = false;
#define WIN_PRE(JJ) const int j = jt0 + (JJ); f32x4 s[2][4]; const bool edge = (j == cur) || (64 * j < t0 + 63 - 511); const int lo2[2] = {trow[0] - 511, trow[1] - 511};
#define WIN_TILE(JJ, SLOT) do { WIN_PRE(JJ) \
                    if (refmoved) { const float cin[2] = {-sw[0].m, -sw[1].m}; attn_qk2(lds + AT4_KB + (SLOT) * 8192, qr, fr, g4, cin, s); } \
                    else attn_qk2z(lds + AT4_KB + (SLOT) * 8192, qr, fr, g4, s); \
                    refmoved |= attn_step2x(lds + AT4_VB + (SLOT) * 8192, s, sw, 64 * j, g4, lo2, trow, both, full, edge, vlane, swz, onesf); } while (0)
#define WIN_TILE_NM(JJ, SLOT) do { WIN_PRE(JJ) attn_qk2z(lds + AT4_KB + (SLOT) * 8192, qr, fr, g4, s); \
                    attn_step2x_nomax(lds + AT4_VB + (SLOT) * 8192, s, sw, 64 * j, g4, lo2, trow, full, edge, vlane, swz, onesf); } while (0)
                AT_DMA(2, jt0, 0); if (nt_ > 1) AT_DMA(2, jt0 + 1, 1); __syncthreads();
#define WIN_LOOP(TILE) for (int j0 = 0; j0 < nt_; j0 += 2) { const int sb = (j0 & 2); \
                    if (j0 + 2 < nt_) AT_DMA(2, jt0 + j0 + 2, sb ^ 2); \
                    if (j0 + 3 < nt_) AT_DMA(2, jt0 + j0 + 3, (sb ^ 2) + 1); \
                    TILE(j0, sb); if (j0 + 1 < nt_) TILE(j0 + 1, sb + 1); \
                    __syncthreads(); }
                if (nomax_win) { WIN_LOOP(WIN_TILE_NM) } else { WIN_LOOP(WIN_TILE) }
#undef WIN_LOOP
#undef WIN_TILE_NM
#undef WIN_PRE
#undef WIN_TILE
                TROW_PIN();
#pragma unroll
                for (int rb = 0; rb < 2; ++rb) { const float l = __shfl(sw[rb].ol[0], fr); const float sc2 = (l > 0.f) ? GATE(rb, 2) / l : 0.f;
                    bf16_t* op = O + TOKROW(rb) * 1024 + head * 64 + 4 * g4;
                    unsigned char* o8 = (unsigned char*)(a.ws + WS_O8) + TOKROW(rb) * 1024 + head * 64 + 4 * g4;
#pragma unroll
                    for (int dt = 0; dt < 4; ++dt) { const u32x2 pv = *(const u32x2*)(op + 16 * dt); f32x4 v = sw[rb].o[dt] * sc2;
                        v[0] += __uint_as_float(pv.x << 16); v[1] += __uint_as_float(pv.x & 0xffff0000u); v[2] += __uint_as_float(pv.y << 16); v[3] += __uint_as_float(pv.y & 0xffff0000u);
                        *(unsigned*)(o8 + 16 * dt) = pk4_fp8(clamp8(v[0] * X8_SCALE), clamp8(v[1] * X8_SCALE), clamp8(v[2] * X8_SCALE), clamp8(v[3] * X8_SCALE)); } }
            }
#undef AT_DMA
#undef ATK
#undef ATV
#undef TROW_PIN
#undef TOKROW
#undef GATE
            {
                const int npr = half ? pr + (int)gridDim.x : pr, nhalf = half ^ 1;
                cmp_pref = npr < 1024;
                if (cmp_pref) { const int nbg = npr >> 6, npp = attn_pair_of(npr), ncc = nhalf ? (127 - npp) : npp;
                    const int nnct = (((ncc * 64 + 63 - 31) / 16 + 1) + 63) >> 6;
                    const bf16_t* nk = KC + (size_t)nbg * 512 * 64;
                    __builtin_amdgcn_global_load_lds((const unsigned*)(nk + ksrc), (LAS unsigned*)(lds + AT4_KB + wave * 1024), 16, 0, 0);
                    __builtin_amdgcn_global_load_lds((const unsigned*)(nk + (size_t)8192 * 64 + vsrc), (LAS unsigned*)(lds + AT4_VB + wave * 1024), 16, 0, 0);
                    if (nnct > 1) {
                        __builtin_amdgcn_global_load_lds((const unsigned*)(nk + 4096 + ksrc), (LAS unsigned*)(lds + AT4_KB + 8192 + wave * 1024), 16, 0, 0);
                        __builtin_amdgcn_global_load_lds((const unsigned*)(nk + (size_t)8192 * 64 + 4096 + vsrc), (LAS unsigned*)(lds + AT4_VB + 8192 + wave * 1024), 16, 0, 0); } } }
            cvt1_run(a, cvt_next, cvt_stride, 2, cvt_scr, lane);
        }
    }
    cvt1_run(a, cvt_next, cvt_stride, 1 << 20, cvt_scr, lane);
}

__device__ __forceinline__ void unpack8(const u32x4 w, float (&f)[8]) {
    f[0] = __uint_as_float(w.x << 16); f[1] = __uint_as_float(w.x & 0xffff0000u); f[2] = __uint_as_float(w.y << 16); f[3] = __uint_as_float(w.y & 0xffff0000u);
    f[4] = __uint_as_float(w.z << 16); f[5] = __uint_as_float(w.z & 0xffff0000u); f[6] = __uint_as_float(w.w << 16); f[7] = __uint_as_float(w.w & 0xffff0000u);
}
__device__ __forceinline__ void ph_convpool_fast(const Args& a, LAS unsigned char* lds) {
    const bf16_t* H0 = (const bf16_t*)(a.ws + WS_H0);
    bf16_t* CAT = (bf16_t*)(a.ws + WS_CAT);
    const float* cw = a.in[4]; const float* cb = a.in[5]; const float* lg = a.in[6]; const float* lb = a.in[7];
    const int tid = threadIdx.x, lane = tid & 63, wave = tid >> 6, ch = lane * 8;
    constexpr int VT_OFF = 0, UT_OFF = 62 * 1024, CW_OFF = UT_OFF + 47 * 1024;
    for (int i = tid; i < 31 * 64; i += 512) { const int k = i >> 6, c8 = (i & 63) * 8;
        const f32x4 w0 = *(const f32x4*)(cw + k * 512 + c8), w1 = *(const f32x4*)(cw + k * 512 + c8 + 4);
        u32x4 o; o.x = pk2(w0[0], w0[1]); o.y = pk2(w0[2], w0[3]); o.z = pk2(w1[0], w1[1]); o.w = pk2(w1[2], w1[3]);
        *(LAS u32x4*)(lds + CW_OFF + k * 1024 + c8 * 2) = o; }
    float bias[8], gam[8], bet[8];
#pragma unroll
    for (int j = 0; j < 8; ++j) { bias[j] = cb[ch + j]; gam[j] = lg[ch + j]; bet[j] = lb[ch + j]; }
    for (int tile = blockIdx.x; tile < M / 32; tile += gridDim.x) {
        const int tok0 = tile * 32, t0 = tok0 & (T - 1);
        __syncthreads();
        for (int i = tid; i < 62 * 64; i += 512) { const int r = i >> 6, c8 = (i & 63) * 8; const int tt = t0 - 30 + r;
            u32x4 v = (u32x4){0u, 0u, 0u, 0u}; if (tt >= 0) v = *(const u32x4*)(H0 + (size_t)(tok0 - 30 + r) * 1024 + 512 + c8);
            *(LAS u32x4*)(lds + VT_OFF + r * 1024 + c8 * 2) = v; }
        for (int i = tid; i < 47 * 64; i += 512) { const int r = i >> 6, c8 = (i & 63) * 8; const int tt = t0 - 15 + r;
            u32x4 v = (u32x4){0u, 0u, 0u, 0u}; if (tt >= 0) v = *(const u32x4*)(H0 + (size_t)(tok0 - 15 + r) * 1024 + c8);
            *(LAS u32x4*)(lds + UT_OFF + r * 1024 + c8 * 2) = v; }
        __syncthreads();
        float acc[4][8];
#pragma unroll
        for (int j = 0; j < 4; ++j)
#pragma unroll
            for (int c = 0; c < 8; ++c) acc[j][c] = bias[c];
#pragma unroll 1
        for (int k = 0; k < 31; ++k) {
            float w[8]; unpack8(*(const LAS u32x4*)(lds + CW_OFF + k * 1024 + ch * 2), w);
#pragma unroll
            for (int j = 0; j < 4; ++j) { float v[8]; unpack8(*(const LAS u32x4*)(lds + VT_OFF + (4 * wave + j + k) * 1024 + ch * 2), v);
#pragma unroll
                for (int c = 0; c < 8; ++c) acc[j][c] += w[c] * v[c]; }
        }
        const int wnd = 2 << (lane >> 4);
#pragma unroll
        for (int j = 0; j < 4; ++j) {
            const int tl = 4 * wave + j, t = t0 + tl; const size_t tok = (size_t)tok0 + tl;
            const int cnt = (t + 1 < wnd) ? (t + 1) : wnd;
            float s[8], self[8];
            unpack8(*(const LAS u32x4*)(lds + UT_OFF + (15 + tl) * 1024 + ch * 2), self);
#pragma unroll
            for (int c = 0; c < 8; ++c) s[c] = self[c];
            for (int k = 1; k < cnt; ++k) { float v[8]; unpack8(*(const LAS u32x4*)(lds + UT_OFF + (15 + tl - k) * 1024 + ch * 2), v);
#pragma unroll
                for (int c = 0; c < 8; ++c) s[c] += v[c]; }
            const float inv = 1.0f / (float)cnt;
            u32x4 o; o.x = pk2(s[0] * inv - self[0], s[1] * inv - self[1]); o.y = pk2(s[2] * inv - self[2], s[3] * inv - self[3]);
            o.z = pk2(s[4] * inv - self[4], s[5] * inv - self[5]); o.w = pk2(s[6] * inv - self[6], s[7] * inv - self[7]);
            *(u32x4*)(CAT + tok * 1024 + ch) = o;
            float sm = 0.f;
#pragma unroll
            for (int c = 0; c < 8; ++c) sm += acc[j][c];
            const float mean = wave_sum(sm) * (1.0f / 512.0f);
            float sq = 0.f;
#pragma unroll
            for (int c = 0; c < 8; ++c) { acc[j][c] -= mean; sq += acc[j][c] * acc[j][c]; }
            const float rstd = rsqrtf(wave_sum(sq) * (1.0f / 512.0f) + LN_EPS);
            float y[8];
#pragma unroll
            for (int c = 0; c < 8; ++c) { const float z = acc[j][c] * rstd * gam[c] + bet[c]; y[c] = z * sigmoidf_(z); }
            u32x4 o2; o2.x = pk2(y[0], y[1]); o2.y = pk2(y[2], y[3]); o2.z = pk2(y[4], y[5]); o2.w = pk2(y[6], y[7]);
            *(u32x4*)(CAT + tok * 1024 + 512 + ch) = o2;
        }
    }
}


#define RT_DPPI(x, ctrl) __builtin_amdgcn_update_dpp((int)(x), (int)(x), (ctrl), 0xF, 0xF, true)
#define RT_DPPF(x, ctrl) __builtin_bit_cast(float, __builtin_amdgcn_update_dpp(__builtin_bit_cast(int, (float)(x)), __builtin_bit_cast(int, (float)(x)), (ctrl), 0xF, 0xF, true))
#define RT_LANEI(x, l) __builtin_amdgcn_readlane((int)(x), (l))
#define RT_LANEF(x, l) __builtin_bit_cast(float, __builtin_amdgcn_readlane(__builtin_bit_cast(int, (float)(x)), (l)))
__device__ __forceinline__ int RT_KEY(float x) { const int b = __builtin_bit_cast(int, x); return b ^ ((b >> 31) & 0x7fffffff); }
__device__ __forceinline__ void ph_route_fast(const float* LOG, const float* bias, unsigned* gcnt, int2* list, unsigned char* ldsg) {
    unsigned* hist = (unsigned*)ldsg; unsigned* base = hist + 256; u32x2* sel = (u32x2*)(ldsg + 2048);
    const int tid = threadIdx.x, lane = tid & 63, wave = tid >> 6;
    const float NEG = -INFINITY;
    const float4 bb = *(const float4*)(bias + lane * 4);
    for (int chunk = blockIdx.x; chunk < M / 128; chunk += gridDim.x) {
        __syncthreads();
        if (tid < 256) hist[tid] = 0u;
        __syncthreads();
        float4 lgn = *(const float4*)(LOG + (size_t)(chunk * 128 + wave * 16) * 256 + lane * 4);
        for (int i = 0; i < 16; ++i) {
            const int tl = wave * 16 + i, tok = chunk * 128 + tl;
            const float4 lg = lgn;
            if (i + 1 < 16) lgn = *(const float4*)(LOG + (size_t)(tok + 1) * 256 + lane * 4);
            const float s0 = sigmoidf_(lg.x), s1 = sigmoidf_(lg.y), s2 = sigmoidf_(lg.z), s3 = sigmoidf_(lg.w);
            const float v0 = s0 + bb.x + 0.0f, v1 = s1 + bb.y + 0.0f, v2 = s2 + bb.z + 0.0f, v3 = s3 + bb.w + 0.0f;
            float m1 = fmaxf(v0, v1), m2 = fminf(v0, v1);
            { const float hi = fmaxf(v2, v3), lo = fminf(v2, v3); const float n1 = fmaxf(m1, hi); const float n2 = fmaxf(fminf(m1, hi), fmaxf(m2, lo)); m1 = n1; m2 = n2; }
#define RT_STEP(ctrl) { const float a1 = RT_DPPF(m1, ctrl), a2 = RT_DPPF(m2, ctrl); const float n1 = fmaxf(m1, a1), n2 = fmaxf(fminf(m1, a1), fmaxf(m2, a2)); m1 = n1; m2 = n2; }
            RT_STEP(0xB1) RT_STEP(0x4E) RT_STEP(0x141)
#undef RT_STEP
            const float gs = m1 + m2; const int mygrp = lane >> 3;
            int rank = 0;
#pragma unroll
            for (int g2 = 0; g2 < 8; ++g2) { const float og = RT_LANEF(gs, g2 * 8); rank += (og > gs || (og == gs && g2 < mygrp)) ? 1 : 0; }
            const bool dead = rank >= 4;
            constexpr int KMIN = (int)0x80000000;
            int k0 = dead ? KMIN : RT_KEY(v0), k1 = dead ? KMIN : RT_KEY(v1), k2 = dead ? KMIN : RT_KEY(v2), k3 = dead ? KMIN : RT_KEY(v3);
            int my_e = 0; float my_s = 0.f;
#pragma unroll
            for (int it = 0; it < 8; ++it) {
                int lm = max(max(k0, k1), max(k2, k3));
                lm = max(lm, RT_DPPI(lm, 0xB1)); lm = max(lm, RT_DPPI(lm, 0x4E)); lm = max(lm, RT_DPPI(lm, 0x141)); lm = max(lm, RT_DPPI(lm, 0x140));
                const int gmax = max(max(RT_LANEI(lm, 0), RT_LANEI(lm, 16)), max(RT_LANEI(lm, 32), RT_LANEI(lm, 48)));
                int cand = (k0 == gmax) ? lane * 4 : (k1 == gmax) ? lane * 4 + 1 : (k2 == gmax) ? lane * 4 + 2 : (k3 == gmax) ? lane * 4 + 3 : 0x7fffffff;
                cand = min(cand, RT_DPPI(cand, 0xB1)); cand = min(cand, RT_DPPI(cand, 0x4E)); cand = min(cand, RT_DPPI(cand, 0x141)); cand = min(cand, RT_DPPI(cand, 0x140));
                const int bi = min(min(RT_LANEI(cand, 0), RT_LANEI(cand, 16)), min(RT_LANEI(cand, 32), RT_LANEI(cand, 48)));
                const int jj = bi & 3, ol = bi >> 2;
                const float mys = (jj == 0) ? s0 : (jj == 1) ? s1 : (jj == 2) ? s2 : s3;
                const float wsc = RT_LANEF(mys, ol);
                const bool me = (lane == ol);
                k0 = (me && jj == 0) ? KMIN : k0; k1 = (me && jj == 1) ? KMIN : k1; k2 = (me && jj == 2) ? KMIN : k2; k3 = (me && jj == 3) ? KMIN : k3;
                if (lane == it) { my_e = bi; my_s = wsc; }
            }
            const float ssum = wave_sum(lane < 8 ? my_s : 0.f);
            if (lane < 8) { const unsigned rk = atomicAdd(&hist[my_e], 1u); u32x2 en; en.x = (unsigned)my_e | (rk << 16); en.y = __float_as_uint(my_s / ssum * 2.5f); sel[tl * 8 + lane] = en; }
        }
        __syncthreads();
        if (tid < 256) { const unsigned h = hist[tid]; base[tid] = h ? atomicAdd(&gcnt[tid], h) : 0u; }
        __syncthreads();
#pragma unroll
        for (int rep = 0; rep < 2; ++rep) { const int idx = tid + rep * 512, tok = chunk * 128 + (idx >> 3), k = idx & 7;
            const u32x2 en = sel[idx]; const unsigned e = en.x & 0xffffu, pos = base[e] + (en.x >> 16);
            list[(size_t)e * LISTCAP + pos] = make_int2(tok * 10 + k, (int)en.y); }
    }
}

__global__ void __launch_bounds__(512, 2) fwd_kernel(Args a) {
    extern __shared__ __attribute__((aligned(16))) unsigned char lds[];
    volatile LAS unsigned* MISC = (volatile LAS unsigned*)((LAS unsigned char*)lds + (LDS_BYTES - 64));
    if (threadIdx.x < 16) MISC[threadIdx.x] = 0u;
    __syncthreads();
    unsigned* ctl = (unsigned*)(a.ws + WS_CTL);
#if MK_ONE_LAUNCH
    (void)xcd_barrier_post(ctl + CW_BAR, MISC + 8);
#define SEAM() do { XcdBarrier b_; b_.bar = (unsigned*)(a.ws + WS_CTL) + CW_BAR; b_.x = xb_xcc_id(); b_.st = MISC + 8; xcd_barrier(b_); } while (0)
#else
#define SEAM() do {} while (0)
#endif
    const int lo = a.ph_lo, hi = a.ph_hi;
#define IN(k) (lo <= (k) && (k) < hi)
#define BOTH(k) (IN(k) && (k) + 1 < hi)
#define X1 ((bf16_t*)(a.ws + WS_X1))
#define X2 ((bf16_t*)(a.ws + WS_X2))
#define LOG ((float*)(a.ws + WS_LOG))

    LAS unsigned char* L = (LAS unsigned char*)lds;
#define LIST ((int2*)(a.ws + WS_LIST))
#ifndef PROBE_DUP_MASK
#define PROBE_DUP_MASK 0u
#endif
#define RUN(k, ...) if (IN(k)) { { __VA_ARGS__ } if ((PROBE_DUP_MASK >> (k)) & 1u) { __syncthreads(); { __VA_ARGS__ } } if (BOTH(k)) SEAM(); }
    RUN(0, ph_prologue(a, L);)
    RUN(1, pg8::DenseSched S; S.init((const bf16_t*)(a.ws + WS_XA), D, (const bf16_t*)(a.ws + WS_WIN0), D, M, 1536);
           EpiInproj0 E{(bf16_t*)(a.ws + WS_H0)};
           pg8::gemm_phase<EpiInproj0, pg8::DenseSched, true>(L, D, 128u, S, E);)
    RUN(2, ph_convpool_fast(a, L);)
    RUN(4, pg8::DenseSched S; S.init((const bf16_t*)(a.ws + WS_CAT), D, (const bf16_t*)(a.ws + WS_WOUT0), D, M, D);
           EpiRes E{a.in[0], nullptr, (bf16_t*)(a.ws + WS_Y), 1.0f};
           pg8::gemm_phase<EpiRes, pg8::DenseSched, true>(L, D, 128u, S, E);)
    RUN(5, ph_ln((const bf16_t*)(a.ws + WS_Y), a.in[17], a.in[18], X1, (unsigned char*)(a.ws + WS_X8));)
#define MOE_LAYER(P, LAYER, XIN, XOUT, OUTF) \
    RUN(P, pg8::DenseSched S; S.init(XIN, D, (const bf16_t*)(a.ws + WS_WR) + (size_t)(LAYER) * NE * D, D, M, NE); \
           EpiLogits E{LOG}; pg8::gemm_phase<EpiLogits, pg8::DenseSched, true>(L, D, 128u, S, E);) \
    if (IN(P + 1)) { ph_route_fast(LOG, a.in[22] + (LAYER) * NE, ctl + CW_CNT + (LAYER) * 256, LIST, lds); if (BOTH(P + 1)) SEAM(); } \
    RUN(P + 2, const int R = moe_setup256(ctl + CW_CNT + (LAYER) * 256, L); \
            MoeGuSched S{(const char*)(a.ws + WS_X8), (const char*)(a.ws + WS_WGU) + (size_t)(LAYER) * 257 * 512 * 1024, LIST, L, R, (R + 128) * 2, (int)gridDim.x, (int)blockIdx.x}; \
            S.prepare(); EpiGateUp E{(unsigned char*)(a.ws + WS_HID)}; pg8::gemm_phase<EpiGateUp, MoeGuSched, true, true>(L, D / 2, 128u, S, E);) \
    RUN(P + 3, const int R = moe_setup256(ctl + CW_CNT + (LAYER) * 256, L); \
            MoeDownSched S{(const char*)(a.ws + WS_HID), (const char*)(a.ws + WS_WD) + (size_t)(LAYER) * 257 * 1024 * 256, LIST, L, R, R + 128, (int)gridDim.x, (int)blockIdx.x}; \
            S.prepare(); EpiDown E{(unsigned char*)(a.ws + WS_YB), L}; pg8::gemm_phase<EpiDown, MoeDownSched, true, true>(L, FF / 2, 128u, S, E);) \
    RUN(P + 4, ph_combine(a, XIN, a.in[19] + (LAYER) * D, a.in[20] + (LAYER) * D, XOUT, OUTF);)
    MOE_LAYER(6, 0, X1, X2, nullptr)
    RUN(11, pg8::DenseSched S; S.init(X2, D, (const bf16_t*)(a.ws + WS_WINN), D, M, HNW);
            EpiInprojN E{(bf16_t*)(a.ws + WS_HN), (bf16_t*)(a.ws + WS_QR), (bf16_t*)(a.ws + WS_KV6), (float*)(a.ws + WS_GATES), (const float*)(a.ws + WS_MISC) + 1024};
            pg8::gemm_phase<EpiInprojN, pg8::DenseSched, true>(L, D, 128u, S, E);)
    RUN(13, Cmp1Sched S{(const char*)(a.ws + WS_KV6), (const char*)(a.ws + WS_CW1), (int)gridDim.x, (int)blockIdx.x};
            EpiCmp1 E{(bf16_t*)(a.ws + WS_CH1), (const float*)(a.ws + WS_MISC)};
            pg8::gemm_phase<EpiCmp1, Cmp1Sched, true>(L, 2048, 128u, S, E); ph_knorm(a);)
    RUN(14, ph_cmp2(a, lds);)
    RUN(15, ph_attn_fast2(a, L);)
    RUN(16, pg8::DenseSched S; S.init((const bf16_t*)(a.ws + WS_O8), D / 2, (const bf16_t*)(a.ws + WS_WOUTN), D / 2, M, D);
            EpiRes E{nullptr, X2, (bf16_t*)(a.ws + WS_Y2), 1.0f / (X8_SCALE * W8_SCALE)};
            pg8::gemm_phase<EpiRes, pg8::DenseSched, true, true>(L, D / 2, 128u, S, E);)
    RUN(17, ph_ln((const bf16_t*)(a.ws + WS_Y2), a.in[17] + D, a.in[18] + D, X1, (unsigned char*)(a.ws + WS_X8));)
    MOE_LAYER(18, 1, X1, (bf16_t*)nullptr, a.out)
}

extern "C" void kernel_launch(void* const* d_in, const int* in_sizes, int n_in, void* d_out, int out_size, void* d_ws, size_t ws_size, hipStream_t stream) {
    static int grid = 0;
    if (grid == 0) {
        if (n_in != 29 || out_size != M * D || ws_size < WS_END) { fprintf(stderr, "kernel_launch: unexpected problem (n_in %d out %d ws %zu)\n", n_in, out_size, ws_size); grid = -1; return; }
        int dev = 0, cus = 0;
        if (hipGetDevice(&dev) != hipSuccess || hipDeviceGetAttribute(&cus, hipDeviceAttributeMultiprocessorCount, dev) != hipSuccess) { grid = -1; return; }
        if (hipFuncSetAttribute((const void*)fwd_kernel, hipFuncAttributeMaxDynamicSharedMemorySize, LDS_BYTES) != hipSuccess) { grid = -1; return; }
        int per_cu = 0;
        (void)hipOccupancyMaxActiveBlocksPerMultiprocessor(&per_cu, (const void*)fwd_kernel, 512, LDS_BYTES);
        (void)hipGetLastError();
        grid = cus;
    }
    if (grid < 0) return;
    (void)hipMemsetAsync((char*)d_ws + WS_CTL, 0, CTL_BYTES, stream);
    Args a{};
    for (int i = 0; i < 29; ++i) a.in[i] = (const float*)d_in[i];
    a.out = (float*)d_out; a.ws = (unsigned char*)d_ws;
    for (int i = 0; i < 8; ++i) a.inv_freq[i] = powf(500000.0f, -(float)(2 * i) / 16.0f);
#if MK_ONE_LAUNCH
    a.ph_lo = 0; a.ph_hi = NPHASE;
    hipLaunchKernelGGL(fwd_kernel, dim3(grid), dim3(512), LDS_BYTES, stream, a);
#else
    for (int p = 0; p < NPHASE; ++p) { a.ph_lo = p; a.ph_hi = p + 1; hipLaunchKernelGGL(fwd_kernel, dim3(grid), dim3(512), LDS_BYTES, stream, a); }
#endif
}
```

```cpp
#include <hip/hip_runtime.h>
#include <cstdint>
#include <cstdio>
#include <cmath>

#ifndef MK_ONE_LAUNCH
#define MK_ONE_LAUNCH 1
#endif

#define LAS __attribute__((address_space(3)))
typedef unsigned short bf16_t;
typedef short bf16x8 __attribute__((ext_vector_type(8)));
typedef float f32x4 __attribute__((ext_vector_type(4)));
typedef unsigned u32x2 __attribute__((ext_vector_type(2)));
typedef unsigned u32x4 __attribute__((ext_vector_type(4)));

constexpr int NB = 4, T = 8192, D = 1024, M = NB * T;
constexpr int NE = 256, TOPK = 8, FF = 256;
constexpr int HNW = 2816;
constexpr int LISTCAP = 32768;
constexpr float ALPHA = 1.4142135623730951f;
constexpr float LN_EPS = 1e-5f;
constexpr float QSCALE = 0.125f * 1.4426950408889634f;
constexpr int YB_NSLOT = 9;
constexpr float YB_SCALE = 16.0f;
constexpr int NPHASE = 23;

constexpr size_t MiB = 1u << 20;
constexpr size_t WS_CTL = 0, CTL_BYTES = 1 * MiB;
constexpr size_t WS_X1 = 1 * MiB;
constexpr size_t WS_X2 = WS_X1 + 64 * MiB;
constexpr size_t WS_LOG = WS_X2 + 64 * MiB;
constexpr size_t WS_LIST = WS_LOG + 32 * MiB;
constexpr size_t WS_WTS = WS_LIST + 64 * MiB;
constexpr size_t WS_HID = WS_WTS + 2 * MiB;
constexpr size_t WS_YB = WS_HID + 184 * MiB;
constexpr size_t WS_END_NAIVE = WS_YB + 576 * MiB;
constexpr size_t WS_WIN0 = WS_END_NAIVE;
constexpr size_t WS_WOUT0 = WS_WIN0 + 3 * MiB;
constexpr size_t WS_WINN = WS_WOUT0 + 2 * MiB;
constexpr size_t WS_WOUTN = WS_WINN + 6 * MiB;
constexpr size_t WS_WR = WS_WOUTN + 2 * MiB;
constexpr size_t WS_CW1 = WS_WR + 1 * MiB;
constexpr size_t WS_MISC = WS_CW1 + 2 * MiB;
constexpr size_t WS_WGU = WS_MISC + 1 * MiB;
constexpr size_t WS_X8 = WS_WGU + 257 * MiB;
constexpr size_t WS_O8 = WS_X8 + 32 * MiB;
constexpr float X8_SCALE = 8.0f, W8_SCALE = 64.0f, H8_SCALE = 16.0f;
constexpr size_t WS_WD = WS_WGU + 514 * MiB;
constexpr size_t WS_END = WS_WD + 257 * MiB;
constexpr size_t WS_XA = WS_X2;
constexpr size_t WS_H0 = WS_YB;
constexpr size_t WS_PM = WS_H0 + 64 * MiB;
constexpr size_t WS_CAT = WS_PM + 32 * MiB;
constexpr size_t WS_Y = WS_CAT + 64 * MiB;
constexpr size_t WS_HN = WS_YB;
constexpr size_t WS_KV6 = WS_HN + 64 * MiB;
constexpr size_t WS_QR = WS_HN + 176 * MiB;
constexpr size_t WS_GATES = WS_QR + 64 * MiB;
constexpr size_t WS_CH1 = WS_GATES + 8 * MiB;
constexpr size_t WS_KC = WS_CH1 + 4 * MiB;
constexpr size_t WS_O = WS_KC + 2 * MiB;
constexpr size_t WS_Y2 = WS_O + 64 * MiB;
static_assert(WS_Y2 + 64 * MiB <= WS_END_NAIVE, "overlay");
static_assert(WS_Y + 64 * MiB <= WS_END_NAIVE, "overlay");

constexpr int CW_CNT = 64;
constexpr int CW_BAR = 4096;

constexpr int LDS_BYTES = 163840;

__device__ __forceinline__ float bf2f(bf16_t h) { return __uint_as_float(((unsigned)h) << 16); }
__device__ __forceinline__ bf16_t f2bf(float f) { unsigned u = __float_as_uint(f); return (bf16_t)((u + 0x7fffu + ((u >> 16) & 1u)) >> 16); }
__device__ __forceinline__ unsigned pk2(float lo, float hi) { return (unsigned)f2bf(lo) | ((unsigned)f2bf(hi) << 16); }
#define WR_DPP(x, ctrl) __builtin_bit_cast(float, __builtin_amdgcn_update_dpp(__builtin_bit_cast(int, (float)(x)), __builtin_bit_cast(int, (float)(x)), (ctrl), 0xF, 0xF, true))
#define WR_ROW(x, r) __builtin_bit_cast(float, __builtin_amdgcn_readlane(__builtin_bit_cast(int, (float)(x)), 16 * (r)))
__device__ __forceinline__ float wave_sum(float v) {
    v += WR_DPP(v, 0xB1); v += WR_DPP(v, 0x4E); v += WR_DPP(v, 0x141); v += WR_DPP(v, 0x140);
    return (WR_ROW(v, 0) + WR_ROW(v, 1)) + (WR_ROW(v, 2) + WR_ROW(v, 3));
}
__device__ __forceinline__ float wave_max(float v) {
    v = fmaxf(v, WR_DPP(v, 0xB1)); v = fmaxf(v, WR_DPP(v, 0x4E)); v = fmaxf(v, WR_DPP(v, 0x141)); v = fmaxf(v, WR_DPP(v, 0x140));
    return fmaxf(fmaxf(WR_ROW(v, 0), WR_ROW(v, 1)), fmaxf(WR_ROW(v, 2), WR_ROW(v, 3)));
}
__device__ __forceinline__ float sigmoidf_(float x) { return 1.0f / (1.0f + __expf(-x)); }
__device__ __forceinline__ float gelu_tanh(float x) {
    const float u = 0.7978845608028654f * (x + 0.044715f * x * x * x);
    const float e = __expf(2.0f * u);
    const float th = 1.0f - 2.0f / (e + 1.0f);
    return 0.5f * x * (1.0f + th);
}
__device__ __forceinline__ bf16x8 cvt8(const float* p) {
    const float4 a = *(const float4*)p, b = *(const float4*)(p + 4);
    bf16x8 r;
    r[0] = (short)f2bf(a.x); r[1] = (short)f2bf(a.y); r[2] = (short)f2bf(a.z); r[3] = (short)f2bf(a.w);
    r[4] = (short)f2bf(b.x); r[5] = (short)f2bf(b.y); r[6] = (short)f2bf(b.z); r[7] = (short)f2bf(b.w);
    return r;
}
__device__ __forceinline__ bf16x8 colk8(const float* W, int N, int k, int col) {
    bf16x8 r;
#pragma unroll
    for (int j = 0; j < 8; ++j) r[j] = (short)f2bf(W[(size_t)(k + j) * N + col]);
    return r;
}
__device__ __forceinline__ bf16x8 zero8() { return (bf16x8){0, 0, 0, 0, 0, 0, 0, 0}; }
#define WSYNC() asm volatile("s_waitcnt lgkmcnt(0)" ::: "memory")

#define XB_TMO      128
#define XB_XCNT(j)  (256  + 64 * (j))
#define XB_XSUB(j)  (1280 + 64 * (j))
#define XB_XGEN(j)  (2304 + 64 * (j))
#define XB_TOP      3328
#define XB_TOPGEN   3392
#define XCD_BAR_WORDS 3456
#define XB_SPIN_CAP (1u << 22)
__device__ __forceinline__ unsigned xb_ld(unsigned* p)              { return __hip_atomic_load(p, __ATOMIC_RELAXED, __HIP_MEMORY_SCOPE_AGENT); }
__device__ __forceinline__ unsigned xb_add(unsigned* p, unsigned v) { return __hip_atomic_fetch_add(p, v, __ATOMIC_RELAXED, __HIP_MEMORY_SCOPE_AGENT); }
__device__ __forceinline__ unsigned xb_xcc_id() { return (unsigned)__builtin_amdgcn_s_getreg((3 << 11) | 20) & 0xFu; }
#define XB_SPIN(cond, bar) do { unsigned _sp = 0; while (cond) { __builtin_amdgcn_s_sleep(1); \
    if ((++_sp & 255u) == 0u) { if (xb_ld(&(bar)[XB_TMO])) break; if (_sp > XB_SPIN_CAP) { atomicAdd(&(bar)[XB_TMO], 1u); break; } } } } while (0)
struct XcdBarrier { unsigned* bar; unsigned x; volatile LAS unsigned* st; };
__device__ __forceinline__ XcdBarrier xcd_barrier_post(unsigned* bar, volatile LAS unsigned* st) {
    XcdBarrier b; b.bar = bar; b.x = xb_xcc_id(); b.st = st;
    if (threadIdx.x == 0) (void)xb_add(&bar[XB_XCNT(b.x)], 1u);
    return b;
}
__device__ __forceinline__ void xcd_barrier_complete(unsigned* bar, unsigned x, unsigned& nloc, unsigned& nx) {
    const unsigned G = gridDim.x * gridDim.y * gridDim.z;
    unsigned sum, cnt, mine, sp = 0u;
    for (;;) {
        sum = 0u; cnt = 0u; mine = 0u;
#pragma unroll
        for (unsigned j = 0; j < 16; ++j) { const unsigned c = xb_ld(&bar[XB_XCNT(j)]); sum += c; cnt += (c > 0u) ? 1u : 0u; mine = (j == x) ? c : mine; }
        if (sum == G) break;
        __builtin_amdgcn_s_sleep(1);
        if ((++sp & 255u) == 0u) { if (xb_ld(&bar[XB_TMO])) break; if (sp > XB_SPIN_CAP) { atomicAdd(&bar[XB_TMO], 1u); break; } }
    }
    nloc = mine > 0u ? mine : 1u; nx = cnt > 0u ? cnt : 1u;
}
__device__ __forceinline__ void xcd_barrier(const XcdBarrier& b) {
    asm volatile("s_waitcnt vmcnt(0)" ::: "memory");
    __syncthreads();
    if (threadIdx.x == 0) {
        unsigned* bar = b.bar;
        __builtin_amdgcn_s_waitcnt(0);
        unsigned nloc = b.st[0], nx = b.st[1];
        if (nloc == 0u) { xcd_barrier_complete(bar, b.x, nloc, nx); b.st[0] = nloc; b.st[1] = nx; }
        const unsigned old = xb_add(&bar[XB_XSUB(b.x)], 1u);
        const unsigned gen = old / nloc;
        if (old + 1u == (gen + 1u) * nloc) {
            __builtin_amdgcn_fence(__ATOMIC_RELEASE, "agent");
            asm volatile("s_waitcnt vmcnt(0)" ::: "memory");
            const unsigned og = xb_add(&bar[XB_TOP], 1u);
            const unsigned tg = og / nx;
            if (og + 1u == (tg + 1u) * nx) xb_add(&bar[XB_TOPGEN], 1u);
            else XB_SPIN(xb_ld(&bar[XB_TOPGEN]) == tg, bar);
            __builtin_amdgcn_fence(__ATOMIC_ACQUIRE, "agent");
            xb_add(&bar[XB_XGEN(b.x)], 1u);
            asm volatile("s_waitcnt vmcnt(0)" ::: "memory");
        } else {
            XB_SPIN(xb_ld(&bar[XB_XGEN(b.x)]) == gen, bar);
            __builtin_amdgcn_fence(__ATOMIC_ACQUIRE, "agent");
            asm volatile("s_waitcnt vmcnt(0)" ::: "memory");
        }
    }
    __syncthreads();
}

template <class AL, class BL, class EP>
__device__ __forceinline__ void mgemm_tile(unsigned char* lds, int K, const AL& al, const BL& bl, const EP& ep) {
    bf16_t* As = (bf16_t*)lds;
    bf16_t* Bs = As + 128 * 40;
    const int tid = threadIdx.x, lane = tid & 63, wave = tid >> 6;
    const int ar = tid >> 2, ac = (tid & 3) * 8;
    const int bn = tid & 127, bc = (tid >> 7) * 8;
    f32x4 acc[8];
#pragma unroll
    for (int s = 0; s < 8; ++s) acc[s] = (f32x4){0.f, 0.f, 0.f, 0.f};
    bf16x8 ra = al(ac), rb = bl(bc);
    for (int k0 = 0; k0 < K; k0 += 32) {
        __syncthreads();
        *(bf16x8*)(As + ar * 40 + ac) = ra;
        *(bf16x8*)(Bs + bn * 40 + bc) = rb;
        __syncthreads();
        if (k0 + 32 < K) { ra = al(k0 + 32 + ac); rb = bl(k0 + 32 + bc); }
        const bf16x8 af = *(const bf16x8*)(As + (wave * 16 + (lane & 15)) * 40 + (lane >> 4) * 8);
#pragma unroll
        for (int s = 0; s < 8; ++s) {
            const bf16x8 wf = *(const bf16x8*)(Bs + (16 * s + (lane & 15)) * 40 + (lane >> 4) * 8);
            acc[s] = __builtin_amdgcn_mfma_f32_16x16x32_bf16(wf, af, acc[s], 0, 0, 0);
        }
    }
    ep(wave * 16 + (lane & 15), (lane >> 4) * 4, acc);
}
__device__ __forceinline__ void store4bf(bf16_t* p, const f32x4 v) { u32x2 w; w.x = pk2(v[0], v[1]); w.y = pk2(v[2], v[3]); *(u32x2*)p = w; }

struct Args {
    const float* in[29];
    float* out;
    unsigned char* ws;
    float inv_freq[8];
    int ph_lo, ph_hi;
};

__device__ __forceinline__ unsigned pk4_fp8(float a, float b, float c, float d) { int w = __builtin_amdgcn_cvt_pk_fp8_f32(a, b, 0, false); return (unsigned)__builtin_amdgcn_cvt_pk_fp8_f32(c, d, w, true); }
__device__ __forceinline__ u32x2 pack8_fp8(const f32x4 v0, const f32x4 v1) {
    int a = __builtin_amdgcn_cvt_pk_fp8_f32(v0[0], v0[1], 0, false); a = __builtin_amdgcn_cvt_pk_fp8_f32(v0[2], v0[3], a, true);
    int b = __builtin_amdgcn_cvt_pk_fp8_f32(v1[0], v1[1], 0, false); b = __builtin_amdgcn_cvt_pk_fp8_f32(v1[2], v1[3], b, true);
    u32x2 w; w.x = (unsigned)a; w.y = (unsigned)b; return w;
}
__device__ __forceinline__ float clamp8(float v) { return __builtin_amdgcn_fmed3f(v, -448.0f, 448.0f); }
__device__ __forceinline__ void ph_ln(const bf16_t* Y, const float* g, const float* b, bf16_t* X, unsigned char* X8) {
    const int lane = threadIdx.x & 63, wave = threadIdx.x >> 6;
    const int gw = blockIdx.x * 8 + wave, ngw = gridDim.x * 8;
    float gg[16], bb[16];
#pragma unroll
    for (int j = 0; j < 8; ++j) { gg[j] = g[lane * 8 + j]; gg[8 + j] = g[512 + lane * 8 + j]; bb[j] = b[lane * 8 + j]; bb[8 + j] = b[512 + lane * 8 + j]; }
    for (int row0 = gw * 4; row0 < M; row0 += ngw * 4) {
        bf16x8 p0[4], p1[4];
#pragma unroll
        for (int r = 0; r < 4; ++r) { p0[r] = __builtin_nontemporal_load((const bf16x8*)(Y + (size_t)(row0 + r) * 1024 + lane * 8)); p1[r] = __builtin_nontemporal_load((const bf16x8*)(Y + (size_t)(row0 + r) * 1024 + 512 + lane * 8)); }
#pragma unroll
        for (int r = 0; r < 4; ++r) {
            float v[16];
#pragma unroll
            for (int j = 0; j < 8; ++j) { v[j] = bf2f((bf16_t)p0[r][j]); v[8 + j] = bf2f((bf16_t)p1[r][j]); }
            float s = 0.f;
#pragma unroll
            for (int j = 0; j < 16; ++j) s += v[j];
            const float mean = wave_sum(s) * (1.0f / 1024.0f);
            float q = 0.f;
#pragma unroll
            for (int j = 0; j < 16; ++j) { v[j] -= mean; q += v[j] * v[j]; }
            const float rstd = rsqrtf(wave_sum(q) * (1.0f / 1024.0f) + LN_EPS);
            float o[16];
#pragma unroll
            for (int j = 0; j < 16; ++j) o[j] = v[j] * rstd * gg[j] + bb[j];
            u32x4 w0, w1;
            w0.x = pk2(o[0], o[1]); w0.y = pk2(o[2], o[3]); w0.z = pk2(o[4], o[5]); w0.w = pk2(o[6], o[7]);
            w1.x = pk2(o[8], o[9]); w1.y = pk2(o[10], o[11]); w1.z = pk2(o[12], o[13]); w1.w = pk2(o[14], o[15]);
            *(u32x4*)(X + (size_t)(row0 + r) * 1024 + lane * 8) = w0; *(u32x4*)(X + (size_t)(row0 + r) * 1024 + 512 + lane * 8) = w1;
#pragma unroll
            for (int j = 0; j < 16; ++j) o[j] = clamp8(o[j] * X8_SCALE);
            u32x2 q0, q1; q0.x = pk4_fp8(o[0], o[1], o[2], o[3]); q0.y = pk4_fp8(o[4], o[5], o[6], o[7]); q1.x = pk4_fp8(o[8], o[9], o[10], o[11]); q1.y = pk4_fp8(o[12], o[13], o[14], o[15]);
            *(u32x2*)(X8 + (size_t)(row0 + r) * 1024 + lane * 8) = q0; *(u32x2*)(X8 + (size_t)(row0 + r) * 1024 + 512 + lane * 8) = q1;
        }
    }
}

__device__ __forceinline__ void ph_combine(const Args& a, const bf16_t* X, const float* g, const float* b, bf16_t* Xo, float* outf) {
    const unsigned char* YB = (const unsigned char*)(a.ws + WS_YB);
    const int lane = threadIdx.x & 63, wave = threadIdx.x >> 6;
    const int gw = blockIdx.x * 8 + wave, ngw = gridDim.x * 8;
    for (int row = gw; row < M; row += ngw) {
        float v[16];
#pragma unroll
        for (int j = 0; j < 16; ++j) v[j] = 0.f;
        u32x2 q0[YB_NSLOT], q1[YB_NSLOT];
#pragma unroll
        for (int k = 0; k < YB_NSLOT; ++k) { const unsigned char* yr = YB + ((size_t)row * 10 + k) * 1024; q0[k] = __builtin_nontemporal_load((const u32x2*)(yr + lane * 8)); q1[k] = __builtin_nontemporal_load((const u32x2*)(yr + 512 + lane * 8)); }
#pragma unroll
        for (int k = 0; k < YB_NSLOT; ++k) {
            const auto a0 = __builtin_amdgcn_cvt_pk_f32_fp8((int)q0[k].x, false), a1 = __builtin_amdgcn_cvt_pk_f32_fp8((int)q0[k].x, true), a2 = __builtin_amdgcn_cvt_pk_f32_fp8((int)q0[k].y, false), a3 = __builtin_amdgcn_cvt_pk_f32_fp8((int)q0[k].y, true);
            const auto b0 = __builtin_amdgcn_cvt_pk_f32_fp8((int)q1[k].x, false), b1 = __builtin_amdgcn_cvt_pk_f32_fp8((int)q1[k].x, true), b2 = __builtin_amdgcn_cvt_pk_f32_fp8((int)q1[k].y, false), b3 = __builtin_amdgcn_cvt_pk_f32_fp8((int)q1[k].y, true);
            v[0] += a0[0]; v[1] += a0[1]; v[2] += a1[0]; v[3] += a1[1]; v[4] += a2[0]; v[5] += a2[1]; v[6] += a3[0]; v[7] += a3[1];
            v[8] += b0[0]; v[9] += b0[1]; v[10] += b1[0]; v[11] += b1[1]; v[12] += b2[0]; v[13] += b2[1]; v[14] += b3[0]; v[15] += b3[1];
        }
        {
            const bf16x8 p0 = *(const bf16x8*)(X + (size_t)row * 1024 + lane * 8), p1 = *(const bf16x8*)(X + (size_t)row * 1024 + 512 + lane * 8);
#pragma unroll
            for (int j = 0; j < 8; ++j) { v[j] = v[j] * (1.0f / YB_SCALE) + ALPHA * bf2f((bf16_t)p0[j]); v[8 + j] = v[8 + j] * (1.0f / YB_SCALE) + ALPHA * bf2f((bf16_t)p1[j]); }
        }
        float s = 0.f;
#pragma unroll
        for (int j = 0; j < 16; ++j) s += v[j];
        const float mean = wave_sum(s) * (1.0f / 1024.0f);
        float q = 0.f;
#pragma unroll
        for (int j = 0; j < 16; ++j) { v[j] -= mean; q += v[j] * v[j]; }
        const float rstd = rsqrtf(wave_sum(q) * (1.0f / 1024.0f) + LN_EPS);
        float o[16];
#pragma unroll
        for (int j = 0; j < 8; ++j) { o[j] = v[j] * rstd * g[lane * 8 + j] + b[lane * 8 + j]; o[8 + j] = v[8 + j] * rstd * g[512 + lane * 8 + j] + b[512 + lane * 8 + j]; }
        if (outf) {
            float* op = outf + (size_t)row * 1024;
            *(float4*)(op + lane * 8) = make_float4(o[0], o[1], o[2], o[3]); *(float4*)(op + lane * 8 + 4) = make_float4(o[4], o[5], o[6], o[7]);
            *(float4*)(op + 512 + lane * 8) = make_float4(o[8], o[9], o[10], o[11]); *(float4*)(op + 512 + lane * 8 + 4) = make_float4(o[12], o[13], o[14], o[15]);
        } else {
            u32x4 w0, w1;
            w0.x = pk2(o[0], o[1]); w0.y = pk2(o[2], o[3]); w0.z = pk2(o[4], o[5]); w0.w = pk2(o[6], o[7]);
            w1.x = pk2(o[8], o[9]); w1.y = pk2(o[10], o[11]); w1.z = pk2(o[12], o[13]); w1.w = pk2(o[14], o[15]);
            *(u32x4*)(Xo + (size_t)row * 1024 + lane * 8) = w0; *(u32x4*)(Xo + (size_t)row * 1024 + 512 + lane * 8) = w1;
        }
    }
}

__device__ __forceinline__ void ph_cmp2(const Args& a, unsigned char* lds) {
    const bf16_t* CH1 = (const bf16_t*)(a.ws + WS_CH1);
    bf16_t* KC = (bf16_t*)(a.ws + WS_KC);
    const int tid = threadIdx.x;
    for (int u = blockIdx.x; u < 64 * 2; u += gridDim.x) {
        const int rt = u >> 1, kv = u & 1;
        const bf16_t* ar = CH1 + ((size_t)kv * 8192 + rt * 128 + (tid >> 2)) * 128;
        const float* w2 = a.in[kv ? 15 : 12];
        const int col = tid & 127;
        auto al = [&](int k) { return *(const bf16x8*)(ar + k); };
        auto bl = [&](int k) { return (col < 64) ? colk8(w2, 64, k, col) : zero8(); };
        auto ep = [&](int r, int cb, const f32x4 (&acc)[8]) {
            bf16_t* o = KC + ((size_t)kv * 8192 + rt * 128 + r) * 64;
#pragma unroll
            for (int s = 0; s < 4; ++s) store4bf(o + 16 * s + cb, acc[s]);
        };
        mgemm_tile(lds, 128, al, bl, ep);
    }
}

namespace pg8 {
constexpr int BM = 256, BK = 64, HALF = 128, HTB = HALF * BK * 2, STAGE_BYTES = 8 * HTB;
__device__ __forceinline__ int lds_byte(int r, int c) { const int st = (r >> 4) * 2 + (c >> 5), rr = r & 15, cc = c & 31, ob = rr * 64 + cc * 2; return st * 1024 + (ob ^ (((ob >> 9) & 1) << 5)); }
__device__ __forceinline__ void stage_rc(int b, int& R, int& C) { const int st = b / 1024, sb = b % 1024, swz = sb ^ (((sb >> 9) & 1) << 5); R = (st >> 1) * 16 + swz / 64; C = (st & 1) * 32 + (swz % 64) / 2; }
__device__ __forceinline__ int perm32(int rho) { const int n = rho >> 4, i = rho & 15; return 8 * (i >> 2) + 4 * n + (i & 3); }
struct Unit { int pm, pn, ord; };
typedef float f32x16 __attribute__((ext_vector_type(16)));
typedef int i32x8 __attribute__((ext_vector_type(8))); typedef int i32x4_ __attribute__((ext_vector_type(4)));
__device__ __forceinline__ i32x8 f8cat(const bf16x8 lo, const bf16x8 hi) { return __builtin_shufflevector(__builtin_bit_cast(i32x4_, lo), __builtin_bit_cast(i32x4_, hi), 0, 1, 2, 3, 4, 5, 6, 7); }
template <class Epi, class Sched, bool ALIGN_EPI, bool F8 = false>
__device__ __forceinline__ void gemm_phase(LAS unsigned char* lds, const int K, const unsigned kstepA, const Sched& S, const Epi& E) {
    const int tid = threadIdx.x, wid = __builtin_amdgcn_readfirstlane(tid >> 6), lane = tid & 63, wr = wid >> 2, wc = wid & 3, fr = lane & 15, fq = lane >> 4;
    const int nt = K / BK;
    constexpr bool GA = Sched::GATHER;
    int RA[2]; unsigned CA2[2], voffB[2], voffB1[2], voffA[2];
    constexpr bool P16 = Epi::PERM16;
#pragma unroll
    for (int i = 0; i < 2; ++i) { int R, C; stage_rc(tid * 16 + i * 8192, R, C); const int Rb = Epi::PERM ? ((R & ~31) + perm32(R & 31)) : R;
        RA[i] = R; CA2[i] = (unsigned)C * 2u; voffB[i] = (unsigned)(Rb * K + C) * 2u; voffA[i] = GA ? 0u : (S.lane_off(R) + (unsigned)C * 2u);
        if (P16) { const int c16 = 64 * (R >> 5) + 16 * ((R >> 2) & 3) + 4 * ((R >> 4) & 1) + (R & 3); voffB[i] = (unsigned)(c16 * K + C) * 2u; voffB1[i] = (unsigned)((c16 + 8) * K + C) * 2u; } else voffB1[i] = 0u; }
    const size_t kstepB = (size_t)(BK * 2);
    const size_t hstepB = (size_t)HALF * K * 2;
    const unsigned ldsw = (unsigned)wid * 1024u;
    const int aoff = lds_byte(wr * 64 + fr, fq * 8), boff = lds_byte(wc * 32 + fr, fq * 8);
    const char* const Ab = S.abase();
    unsigned aoC[2][2], aoN[2][2];
    unsigned uC[2], uN[2];
#define PG8_SA(b, h) (((b) * 2 + (h)) * HTB)
#define PG8_SB(b, h) ((4 + (b) * 2 + (h)) * HTB)
#define PG8_GLDS(sbase, voff, ldsoff) do { const char* _b = (const char*)(sbase); unsigned _v = (voff); asm volatile("" : "+s"(_b), "+v"(_v)); \
        __builtin_amdgcn_global_load_lds((const unsigned*)(_b + _v), (LAS unsigned*)(lds + (ldsoff)), 16, 0, 0); } while (0)
#define PG8_STAGE_B(bufoff, gbase) do { _Pragma("unroll") for (int _i = 0; _i < 2; ++_i) PG8_GLDS(gbase, voffB[_i], (bufoff) + ldsw + _i * 8192); } while (0)
#define PG8_STAGE_B1(bufoff, gbase) do { _Pragma("unroll") for (int _i = 0; _i < 2; ++_i) PG8_GLDS((const char*)(gbase) + (P16 ? (size_t)0 : hstepB), (P16 ? voffB1[_i] : voffB[_i]), (bufoff) + ldsw + _i * 8192); } while (0)
#define PG8_STAGE_A(bufoff, kb, UO, LO) do { _Pragma("unroll") for (int _i = 0; _i < 2; ++_i) PG8_GLDS(Ab + (size_t)((kb) + (UO)), (GA ? (LO)[_i] : voffA[_i]), (bufoff) + ldsw + _i * 8192); } while (0)
#define PG8_LDA(dst, b, h) do { _Pragma("unroll") for (int m = 0; m < 4; ++m) _Pragma("unroll") for (int k = 0; k < 2; ++k) dst[m][k] = *(const LAS bf16x8*)(lds + PG8_SA(b, h) + aoff + m * 2048 + k * 1024); } while (0)
#define PG8_LDB(dst, b, h) do { _Pragma("unroll") for (int n = 0; n < 2; ++n) _Pragma("unroll") for (int k = 0; k < 2; ++k) dst[n][k] = *(const LAS bf16x8*)(lds + PG8_SB(b, h) + boff + n * 2048 + k * 1024); } while (0)
#define PG8_MMA(ai, bj, At, Bt) do { __builtin_amdgcn_s_setprio(1); _Pragma("unroll") for (int m = 0; m < 4; ++m) _Pragma("unroll") for (int n = 0; n < 2; ++n) { \
        if constexpr (F8) { f32x16& _w = accw[ai][bj][m >> 1]; const int _q = ((m & 1) * 2 + n) * 4; f32x4 _c = {_w[_q], _w[_q + 1], _w[_q + 2], _w[_q + 3]}; \
            _c = __builtin_amdgcn_mfma_scale_f32_16x16x128_f8f6f4(f8cat(Bt[n][0], Bt[n][1]), f8cat(At[m][0], At[m][1]), _c, 0, 0, 0, 0, 0, 0); _w[_q] = _c[0]; _w[_q + 1] = _c[1]; _w[_q + 2] = _c[2]; _w[_q + 3] = _c[3]; } \
        else { _Pragma("unroll") for (int k = 0; k < 2; ++k) acc[ai][bj][m][n] = __builtin_amdgcn_mfma_f32_16x16x32_bf16(Bt[n][k], At[m][k], acc[ai][bj][m][n], 0, 0, 0); } } __builtin_amdgcn_s_setprio(0); } while (0)
#define PG8_WAIT_V(n) asm volatile("s_waitcnt vmcnt(" #n ")" ::: "memory")
#define PG8_WAIT_L(n) asm volatile("s_waitcnt lgkmcnt(" #n ")" ::: "memory")
#define PG8_BAR __builtin_amdgcn_s_barrier()
#define PG8_SCHED __builtin_amdgcn_sched_barrier(0)
#define PG8_KPAIR(KB1, KB2, KB3, BP2, BP3) do { \
            PG8_LDB(B0, 0, 0); PG8_LDB(B1, 0, 1); PG8_SCHED; PG8_LDA(At, 0, 0); PG8_STAGE_A(PG8_SA(1, 1), KB1, uC[1], aoC[1]); \
            PG8_WAIT_V(8); PG8_WAIT_L(0); PG8_BAR; PG8_MMA(0, 0, At, B0); PG8_MMA(0, 1, At, B1); PG8_BAR; PG8_SCHED; \
            PG8_LDA(At, 0, 1); PG8_STAGE_B(PG8_SB(0, 0), BP2); PG8_STAGE_B1(PG8_SB(0, 1), BP2); PG8_STAGE_A(PG8_SA(0, 0), KB2, u2[0], a2o[0]); \
            PG8_WAIT_V(8); PG8_WAIT_L(0); PG8_BAR; PG8_MMA(1, 0, At, B0); PG8_MMA(1, 1, At, B1); PG8_BAR; PG8_SCHED; \
            PG8_LDB(B0, 1, 0); PG8_LDB(B1, 1, 1); PG8_SCHED; PG8_LDA(At, 1, 0); PG8_STAGE_A(PG8_SA(0, 1), KB2, u2[1], a2o[1]); \
            PG8_WAIT_V(8); PG8_WAIT_L(0); PG8_BAR; PG8_MMA(0, 0, At, B0); PG8_MMA(0, 1, At, B1); PG8_BAR; PG8_SCHED; \
            PG8_LDA(At, 1, 1); PG8_STAGE_B(PG8_SB(1, 0), BP3); PG8_STAGE_B1(PG8_SB(1, 1), BP3); PG8_STAGE_A(PG8_SA(1, 0), KB3, u2[0], a2o[0]); \
            PG8_WAIT_V(8); PG8_WAIT_L(0); PG8_BAR; PG8_MMA(1, 0, At, B0); PG8_MMA(1, 1, At, B1); PG8_BAR; PG8_SCHED; } while (0)
    Unit cur, nxt; int ui = 0;
    if (!S.next(0, cur)) return;
    f32x4 acc[2][2][4][2];
#pragma unroll
    for (int a = 0; a < 2; ++a)
#pragma unroll
        for (int b = 0; b < 2; ++b)
#pragma unroll
            for (int m = 0; m < 4; ++m)
#pragma unroll
                for (int n = 0; n < 2; ++n) acc[a][b][m][n] = (f32x4){0.f, 0.f, 0.f, 0.f};
    bf16x8 At[4][2], B0[2][2], B1[2][2];
    f32x16 accw[2][2][2];
#define PG8_ZERO_W() do { if constexpr (F8) { _Pragma("unroll") for (int _a = 0; _a < 2; ++_a) _Pragma("unroll") for (int _b = 0; _b < 2; ++_b) _Pragma("unroll") for (int _m = 0; _m < 2; ++_m) _Pragma("unroll") for (int _e = 0; _e < 16; ++_e) accw[_a][_b][_m][_e] = 0.f; } } while (0)
    PG8_ZERO_W();
#pragma unroll
    for (int h = 0; h < 2; ++h) { uC[h] = GA ? 0u : S.unit_off(cur, h); uN[h] = uC[h];
#pragma unroll
        for (int i = 0; i < 2; ++i) { aoC[h][i] = GA ? (S.aoff(cur, h * HALF + RA[i]) + CA2[i]) : 0u; aoN[h][i] = aoC[h][i]; } }
    const char* cB = S.bptr(cur);
    PG8_STAGE_B(PG8_SB(0, 0), cB); PG8_STAGE_B1(PG8_SB(0, 1), cB); PG8_STAGE_A(PG8_SA(0, 0), 0u, uC[0], aoC[0]); PG8_STAGE_A(PG8_SA(0, 1), 0u, uC[1], aoC[1]);
    if (wr == 1) PG8_BAR;
    PG8_WAIT_V(2); PG8_BAR;
    PG8_STAGE_B(PG8_SB(1, 0), cB + kstepB); PG8_STAGE_A(PG8_SA(1, 0), kstepA, uC[0], aoC[0]); PG8_STAGE_B1(PG8_SB(1, 1), cB + kstepB);
    PG8_WAIT_V(6); PG8_BAR;
    for (;;) {
        const bool has_next = S.next(ui + 1, nxt);
        const char* nB = has_next ? S.bptr(nxt) : cB;
#pragma unroll
        for (int h = 0; h < 2; ++h) { uN[h] = (GA || !has_next) ? uC[h] : S.unit_off(nxt, h);
#pragma unroll
            for (int i = 0; i < 2; ++i) aoN[h][i] = (GA && has_next) ? (S.aoff(nxt, h * HALF + RA[i]) + CA2[i]) : aoC[h][i]; }
#pragma nounroll
        for (int t = 0; t < nt; t += 2) {
            const bool last = (t == nt - 2);
            const unsigned kb1 = (unsigned)(t + 1) * kstepA, kb2 = last ? 0u : (unsigned)(t + 2) * kstepA, kb3 = kb2 + kstepA;
            const char* b2 = last ? nB : cB + (size_t)(t + 2) * kstepB; const char* b3 = b2 + kstepB;
            unsigned u2[2], a2o[2][2];
#pragma unroll
            for (int h = 0; h < 2; ++h) { u2[h] = last ? uN[h] : uC[h];
#pragma unroll
                for (int i = 0; i < 2; ++i) a2o[h][i] = GA ? (last ? aoN[h][i] : aoC[h][i]) : 0u; }
            PG8_KPAIR(kb1, kb2, kb3, b2, b3);
        }
        if constexpr (ALIGN_EPI) { if (wr == 0) PG8_BAR; }
        if constexpr (F8) {
#pragma unroll
            for (int _a = 0; _a < 2; ++_a)
#pragma unroll
                for (int _b = 0; _b < 2; ++_b)
#pragma unroll
                    for (int _m = 0; _m < 4; ++_m)
#pragma unroll
                        for (int _n = 0; _n < 2; ++_n) { const f32x16& _w = accw[_a][_b][_m >> 1]; const int _q = ((_m & 1) * 2 + _n) * 4; acc[_a][_b][_m][_n] = (f32x4){_w[_q], _w[_q + 1], _w[_q + 2], _w[_q + 3]}; }
        }
        E(acc, cur, wr, wc, fr, fq);
        PG8_ZERO_W();
        if (!has_next) break;
#pragma unroll
        for (int a = 0; a < 2; ++a)
#pragma unroll
            for (int b = 0; b < 2; ++b)
#pragma unroll
                for (int m = 0; m < 4; ++m)
#pragma unroll
                    for (int n = 0; n < 2; ++n) acc[a][b][m][n] = (f32x4){0.f, 0.f, 0.f, 0.f};
        cur = nxt; cB = nB; ++ui;
#pragma unroll
        for (int h = 0; h < 2; ++h) { uC[h] = uN[h];
#pragma unroll
            for (int i = 0; i < 2; ++i) aoC[h][i] = aoN[h][i]; }
        if constexpr (ALIGN_EPI) { if (wr == 1) PG8_BAR; }
    }
    PG8_WAIT_V(0);
    if constexpr (!ALIGN_EPI) { if (wr == 0) PG8_BAR; }
    PG8_BAR;
#undef PG8_SA
#undef PG8_ZERO_W
#undef PG8_GLDS
#undef PG8_SB
#undef PG8_STAGE_A
#undef PG8_STAGE_B
#undef PG8_STAGE_B1
#undef PG8_LDA
#undef PG8_LDB
#undef PG8_MMA
#undef PG8_WAIT_V
#undef PG8_WAIT_L
#undef PG8_BAR
#undef PG8_SCHED
#undef PG8_KPAIR
}

struct DenseSched {
    const char* A; const char* Bt; unsigned lda2; size_t btile; int nM, nN, nwg, G, c;
    __device__ __forceinline__ void init(const bf16_t* A_, int lda, const bf16_t* Bt_, int K, int Mrows, int N) {
        A = (const char*)A_; Bt = (const char*)Bt_; lda2 = (unsigned)lda * 2u; btile = (size_t)256 * K * 2; nM = Mrows / BM; nN = N / BM; nwg = nM * nN; G = gridDim.x; c = blockIdx.x; }
    __device__ __forceinline__ bool next(int i, Unit& u) const {
        const long L = (long)i * G + c; if (L >= nwg) return false;
        int wgid = (int)L; { const int q = nwg / 8, r = nwg % 8, xcd = wgid % 8, off = wgid / 8; wgid = (xcd < r ? xcd * (q + 1) : r * (q + 1) + (xcd - r) * q) + off; }
        const int nig = 8 * nN, gid = wgid / nig, fm = gid * 8, gsz = (nM - fm) < 8 ? (nM - fm) : 8;
        u.pm = fm + ((wgid % nig) % gsz); u.pn = (wgid % nig) / gsz; u.ord = i; return true;
    }
    static constexpr bool GATHER = false;
    __device__ __forceinline__ unsigned lane_off(int r) const { return (unsigned)r * lda2; }
    __device__ __forceinline__ unsigned unit_off(const Unit& u, int h) const { return (unsigned)(u.pm * BM + h * HALF) * lda2; }
    __device__ __forceinline__ unsigned aoff(const Unit&, int) const { return 0u; }
    __device__ __forceinline__ const char* abase() const { return A; }
    __device__ __forceinline__ const char* bptr(const Unit& u) const { return Bt + (size_t)u.pn * btile; }
};
}
typedef float f32x2_t __attribute__((ext_vector_type(2))); typedef __bf16 bf16x2_t __attribute__((ext_vector_type(2)));
__device__ __forceinline__ unsigned cvt_pk_bf16(float lo, float hi) { const f32x2_t v = {lo, hi}; const bf16x2_t b = __builtin_convertvector(v, bf16x2_t); return __builtin_bit_cast(unsigned, b); }
__device__ __forceinline__ u32x4 pack8(const f32x4 v0, const f32x4 v1) { u32x4 w; w.x = cvt_pk_bf16(v0[0], v0[1]); w.y = cvt_pk_bf16(v0[2], v0[3]); w.z = cvt_pk_bf16(v1[0], v1[1]); w.w = cvt_pk_bf16(v1[2], v1[3]); return w; }
__device__ __forceinline__ unsigned cvtpk_m(float lo, float hi) { const f32x2_t v = {lo, hi}; const bf16x2_t b = __builtin_convertvector(v, bf16x2_t); return __builtin_bit_cast(unsigned, b); }
__device__ __forceinline__ u32x4 pack8m(const f32x4 v0, const f32x4 v1) { u32x4 w; w.x = cvtpk_m(v0[0], v0[1]); w.y = cvtpk_m(v0[2], v0[3]); w.z = cvtpk_m(v1[0], v1[1]); w.w = cvtpk_m(v1[2], v1[3]); return w; }
#define MFMA_SETTLE(S) asm volatile("s_nop 15\n\ts_nop 7" : "+v"(S[0][0]), "+v"(S[0][1]), "+v"(S[0][2]), "+v"(S[0][3]), "+v"(S[1][0]), "+v"(S[1][1]), "+v"(S[1][2]), "+v"(S[1][3]))
__device__ __forceinline__ f32x4 sig4(const f32x4 v) { f32x4 r; r[0] = sigmoidf_(v[0]); r[1] = sigmoidf_(v[1]); r[2] = sigmoidf_(v[2]); r[3] = sigmoidf_(v[3]); return r; }

#define EPI_ROWLOOP for (int ai = 0; ai < 2; ++ai) _Pragma("unroll") for (int m = 0; m < 4; ++m)
struct EpiInproj0 {
    static constexpr bool PERM = true, PERM16 = false; bf16_t* H0;
    __device__ __forceinline__ void operator()(const f32x4 (&acc)[2][2][4][2], const pg8::Unit& u, int wr, int wc, int fr, int fq) const {
        const int row0 = u.pm * 256 + wr * 64 + fr, cl = wc * 32 + 8 * fq;
#pragma unroll
        EPI_ROWLOOP { bf16_t* rp = H0 + (size_t)(row0 + ai * 128 + m * 16) * 1024;
            if (u.pn < 2) {
#pragma unroll
                for (int bj = 0; bj < 2; ++bj) *(u32x4*)(rp + u.pn * 256 + bj * 128 + cl) = pack8(acc[ai][bj][m][0], acc[ai][bj][m][1]);
            } else {
                const f32x4 v0 = acc[ai][0][m][0] * sig4(acc[ai][1][m][0]), v1 = acc[ai][0][m][1] * sig4(acc[ai][1][m][1]);
                *(u32x4*)(rp + 512 + (u.pn - 2) * 128 + cl) = pack8(v0, v1);
            } }
    }
};
struct EpiRes {
    static constexpr bool PERM = true, PERM16 = false; const float* resf; const bf16_t* resb; bf16_t* Y; float sc;
    __device__ __forceinline__ void operator()(const f32x4 (&acc)[2][2][4][2], const pg8::Unit& u, int wr, int wc, int fr, int fq) const {
        const int row0 = u.pm * 256 + wr * 64 + fr, c0 = u.pn * 256 + wc * 32 + 8 * fq;
#pragma unroll
        EPI_ROWLOOP { const size_t ro = (size_t)(row0 + ai * 128 + m * 16) * 1024 + c0;
#pragma unroll
            for (int bj = 0; bj < 2; ++bj) {
                f32x4 r0, r1;
                if (resf) { r0 = *(const f32x4*)(resf + ro + bj * 128); r1 = *(const f32x4*)(resf + ro + bj * 128 + 4); }
                else { const u32x4 xv = *(const u32x4*)(resb + ro + bj * 128);
                    r0[0] = __uint_as_float(xv.x << 16); r0[1] = __uint_as_float(xv.x & 0xffff0000u); r0[2] = __uint_as_float(xv.y << 16); r0[3] = __uint_as_float(xv.y & 0xffff0000u);
                    r1[0] = __uint_as_float(xv.z << 16); r1[1] = __uint_as_float(xv.z & 0xffff0000u); r1[2] = __uint_as_float(xv.w << 16); r1[3] = __uint_as_float(xv.w & 0xffff0000u); }
                *(u32x4*)(Y + ro + bj * 128) = pack8(acc[ai][bj][m][0] * sc + r0 * ALPHA, acc[ai][bj][m][1] * sc + r1 * ALPHA);
            } }
    }
};
struct EpiLogits {
    static constexpr bool PERM = true, PERM16 = false; float* LOG;
    __device__ __forceinline__ void operator()(const f32x4 (&acc)[2][2][4][2], const pg8::Unit& u, int wr, int wc, int fr, int fq) const {
        const int row0 = u.pm * 256 + wr * 64 + fr, cl = wc * 32 + 8 * fq;
#pragma unroll
        EPI_ROWLOOP { float* rp = LOG + (size_t)(row0 + ai * 128 + m * 16) * 256 + cl;
#pragma unroll
            for (int bj = 0; bj < 2; ++bj) { *(f32x4*)(rp + bj * 128) = acc[ai][bj][m][0]; *(f32x4*)(rp + bj * 128 + 4) = acc[ai][bj][m][1]; } }
    }
};

constexpr int MOE_TAB_OFF = 131072;
__device__ __forceinline__ int moe_setup256(const unsigned* cnt, LAS unsigned char* lds) {
    LAS int* tstart = (LAS int*)(lds + MOE_TAB_OFF);
    LAS int* scnt = (LAS int*)(lds + MOE_TAB_OFF + 1088);
    LAS unsigned short* texp = (LAS unsigned short*)(lds + MOE_TAB_OFF + 2176);
    const int tid = threadIdx.x;
    __syncthreads();
    const int lane = tid & 63, wave = tid >> 6;
    LAS int* wtot = tstart + 260;
    int c = 0;
    if (tid < 256) { const int n = (int)cnt[tid]; scnt[tid] = n; c = (n + 255) >> 8; }
    int incl = c;
#pragma unroll
    for (int o = 1; o < 64; o <<= 1) { const int t = __shfl_up(incl, o); if (lane >= o) incl += t; }
    if (tid < 256 && lane == 63) wtot[wave] = incl;
    __syncthreads();
    if (tid < 256) { int off = 0;
#pragma unroll
        for (int w = 0; w < 3; ++w) off += (w < wave) ? wtot[w] : 0;
        tstart[tid] = off + incl - c; if (tid == 255) tstart[256] = off + incl; }
    __syncthreads();
    if (tid < 256) for (int q = tstart[tid]; q < tstart[tid + 1]; ++q) texp[q] = (unsigned short)tid;
    __syncthreads();
    return __builtin_amdgcn_readfirstlane(tstart[256]);
}
constexpr int MOE_TOK_OFF = MOE_TAB_OFF + 5120;
constexpr int MOE_MAX_ORD = 20;
struct MoeGuSched {
    static constexpr bool GATHER = true;
    const char* X; const char* W; const int2* list; LAS unsigned char* lds; int R, nunits, G, c;
    __device__ __forceinline__ int vcu() const { return (G % 8 == 0) ? (c % 8) * (G / 8) + c / 8 : c; }
    __device__ __forceinline__ bool next(int i, pg8::Unit& u) const {
        const int L = i * G + vcu(); if (L >= nunits || i >= MOE_MAX_ORD) return false;
        const int q = L >> 1; const int e = __builtin_amdgcn_readfirstlane((q < R) ? (int)((LAS unsigned short*)(lds + MOE_TAB_OFF + 2176))[q] : 256);
        u.pm = q; u.pn = e * 2 + (L & 1); u.ord = i; return true; }
    __device__ __forceinline__ void prepare() const {
        const int tid = threadIdx.x, r = tid & 255;
        pg8::Unit u;
        for (int i = tid >> 8; next(i, u); i += 2) {
            const int e = u.pn >> 1; int token;
            if (e < 256) { const int ts = ((LAS int*)(lds + MOE_TAB_OFF))[e], cn = ((LAS int*)(lds + MOE_TAB_OFF + 1088))[e]; int lr = (u.pm - ts) * 256 + r; if (lr >= cn) lr = cn - 1;
                token = list[(size_t)e * LISTCAP + lr].x / 10; }
            else token = (u.pm - R) * 256 + r;
            ((LAS unsigned short*)(lds + MOE_TOK_OFF))[i * 256 + r] = (unsigned short)token;
        }
        __syncthreads();
    }
    __device__ __forceinline__ unsigned aoff(const pg8::Unit& u, int r) const { return (unsigned)((LAS unsigned short*)(lds + MOE_TOK_OFF))[u.ord * 256 + r] * 1024u; }
    __device__ __forceinline__ unsigned lane_off(int) const { return 0u; }
    __device__ __forceinline__ unsigned unit_off(const pg8::Unit&, int) const { return 0u; }
    __device__ __forceinline__ const char* abase() const { return X; }
    __device__ __forceinline__ const char* bptr(const pg8::Unit& u) const { return W + (size_t)u.pn * (256 * 1024); }
};
constexpr float GU_SC = 1.0f / (X8_SCALE * W8_SCALE);
struct EpiGateUp {
    static constexpr bool PERM = true, PERM16 = false; unsigned char* HID;
    __device__ __forceinline__ void operator()(const f32x4 (&acc)[2][2][4][2], const pg8::Unit& u, int wr, int wc, int fr, int fq) const {
        const int row0 = u.pm * 256 + wr * 64 + fr, c0 = (u.pn & 1) * 128 + wc * 32 + 8 * fq;
#pragma unroll
        EPI_ROWLOOP { const f32x4 g0 = acc[ai][0][m][0] * GU_SC, g1 = acc[ai][0][m][1] * GU_SC;
            f32x4 h0 = g0 * sig4(g0) * (acc[ai][1][m][0] * (GU_SC * H8_SCALE)), h1 = g1 * sig4(g1) * (acc[ai][1][m][1] * (GU_SC * H8_SCALE));
#pragma unroll
            for (int i = 0; i < 4; ++i) { h0[i] = clamp8(h0[i]); h1[i] = clamp8(h1[i]); }
            *(u32x2*)(HID + (size_t)(row0 + ai * 128 + m * 16) * 256 + c0) = pack8_fp8(h0, h1); }
    }
};
constexpr int MOE_RI_OFF = MOE_TAB_OFF + 5120;
constexpr int MOE_MAX_RT = 6;
struct MoeDownSched {
    const char* HID; const char* W; const int2* list; LAS unsigned char* lds; int R, ntile, G, c;
    __device__ __forceinline__ int vcu() const { return (G % 8 == 0) ? (c % 8) * (G / 8) + c / 8 : c; }
    __device__ __forceinline__ bool next(int i, pg8::Unit& u) const {
        const int q = vcu() + G * (i >> 2); if (q >= ntile || (i >> 2) >= MOE_MAX_RT) return false;
        const int e = (q < R) ? (int)((LAS unsigned short*)(lds + MOE_TAB_OFF + 2176))[q] : 256;
        u.pm = q; u.pn = e * 4 + (i & 3); u.ord = i >> 2; return true; }
    __device__ __forceinline__ void prepare() const {
        const int tid = threadIdx.x, r = tid & 255;
        for (int o = tid >> 8; o < MOE_MAX_RT; o += 2) {
            const int q = vcu() + G * o; if (q >= ntile) break;
            u32x2 en;
            if (q < R) { const int e = ((LAS unsigned short*)(lds + MOE_TAB_OFF + 2176))[q]; const int ts = ((LAS int*)(lds + MOE_TAB_OFF))[e], cn = ((LAS int*)(lds + MOE_TAB_OFF + 1088))[e];
                const int lr = (q - ts) * 256 + r; if (lr < cn) { const int2 le = list[(size_t)e * LISTCAP + lr]; en.x = (unsigned)le.x; en.y = (unsigned)le.y; } else { en.x = 0xffffffffu; en.y = 0u; } }
            else { en.x = (unsigned)(((q - R) * 256 + r) * 10 + 8); en.y = __float_as_uint(1.0f); }
            ((LAS u32x2*)(lds + MOE_RI_OFF))[o * 256 + r] = en;
        }
        __syncthreads();
    }
    static constexpr bool GATHER = false;
    __device__ __forceinline__ unsigned lane_off(int r) const { return (unsigned)r * 256u; }
    __device__ __forceinline__ unsigned unit_off(const pg8::Unit& u, int h) const { return (unsigned)(u.pm * 256 + h * 128) * 256u; }
    __device__ __forceinline__ unsigned aoff(const pg8::Unit&, int) const { return 0u; }
    __device__ __forceinline__ const char* abase() const { return HID; }
    __device__ __forceinline__ const char* bptr(const pg8::Unit& u) const { return W + (size_t)u.pn * (256 * 256); }
};
struct EpiDown {
    static constexpr bool PERM = true, PERM16 = true;
    unsigned char* YB; LAS unsigned char* lds;
    __device__ __forceinline__ void operator()(const f32x4 (&acc)[2][2][4][2], const pg8::Unit& u, int wr, int wc, int fr, int fq) const {
        asm volatile("" : "+v"(fr), "+v"(fq));
        const unsigned c0b = (unsigned)((u.pn & 3) * 256 + wc * 64 + 16 * fq); const bool shared = (u.pn >> 2) == 256;
        const LAS u32x2* ri = (const LAS u32x2*)(lds + MOE_RI_OFF) + u.ord * 256 + wr * 64 + fr;
#pragma unroll
        for (int ai = 0; ai < 2; ++ai)
#pragma unroll
            for (int m = 0; m < 4; ++m) { const u32x2 en = ri[ai * 128 + m * 16]; const float wv = __uint_as_float(en.y) * (YB_SCALE / (H8_SCALE * W8_SCALE));
                if ((int)en.x >= 0) { unsigned char* rp = YB + (size_t)(en.x * 1024u + c0b);
                    const f32x4 v00 = acc[ai][0][m][0] * wv, v01 = acc[ai][0][m][1] * wv, v10 = acc[ai][1][m][0] * wv, v11 = acc[ai][1][m][1] * wv;
                    const u32x2 h0 = pack8_fp8(v00, v01), h1 = pack8_fp8(v10, v11);
                    *(u32x4*)rp = (u32x4){h0.x, h0.y, h1.x, h1.y};
                    if (YB_NSLOT == 10 && shared) {
                        u32x2 r_[2];
#pragma unroll
                        for (int bj = 0; bj < 2; ++bj) { const u32x2 h = bj ? h1 : h0; const f32x4 v0 = bj ? v10 : v00, v1 = bj ? v11 : v01;
                            const auto a0 = __builtin_amdgcn_cvt_pk_f32_fp8((int)h.x, false), a1 = __builtin_amdgcn_cvt_pk_f32_fp8((int)h.x, true), a2 = __builtin_amdgcn_cvt_pk_f32_fp8((int)h.y, false), a3 = __builtin_amdgcn_cvt_pk_f32_fp8((int)h.y, true);
                            const f32x4 r0 = {v0[0] - a0[0], v0[1] - a0[1], v0[2] - a1[0], v0[3] - a1[1]}, r1 = {v1[0] - a2[0], v1[1] - a2[1], v1[2] - a3[0], v1[3] - a3[1]};
                            r_[bj] = pack8_fp8(r0, r1); }
                        *(u32x4*)(rp + 1024) = (u32x4){r_[0].x, r_[0].y, r_[1].x, r_[1].y}; } } }
    }
};

struct EpiInprojN {
    static constexpr bool PERM = true, PERM16 = false; bf16_t* QN; bf16_t* QR; bf16_t* KV6; float* GATES; const float* ROT;
    __device__ __forceinline__ void operator()(const f32x4 (&acc)[2][2][4][2], const pg8::Unit& u, int wr, int wc, int fr, int fq) const {
        const int row0 = u.pm * 256 + wr * 64 + fr, cl = wc * 32 + 8 * fq, pn = u.pn;
        const bool isq = pn < 4, rotk = (pn == 6 || pn == 8), dorot = (isq || rotk) && ((wc & 1) == 0);
#pragma unroll
        EPI_ROWLOOP { const int row = row0 + ai * 128 + m * 16;
            if (pn == 10) {
                if (cl < 48) { *(f32x4*)(GATES + (size_t)row * 48 + cl) = sig4(acc[ai][0][m][0]); *(f32x4*)(GATES + (size_t)row * 48 + cl + 4) = sig4(acc[ai][0][m][1]); }
            } else {
                f32x4 cs0, cs1, sn0, sn1;
                if (dorot) { const float* rt = ROT + (size_t)(row & (T - 1)) * 16; cs0 = *(const f32x4*)rt; cs1 = *(const f32x4*)(rt + 4); sn0 = *(const f32x4*)(rt + 8); sn1 = *(const f32x4*)(rt + 12); }
#pragma unroll
                for (int bj = 0; bj < 2; ++bj) {
                    const f32x4 v0 = acc[ai][bj][m][0], v1 = acc[ai][bj][m][1];
                    f32x4 r0 = v0, r1 = v1;
                    if (dorot) {
                        f32x4 p0, p1;
#pragma unroll
                        for (int i = 0; i < 4; ++i) { p0[i] = __shfl_xor(v0[i], 16); p1[i] = __shfl_xor(v1[i], 16); }
                        if (fq == 0) { r0 = v0 * cs0 - p0 * sn0; r1 = v1 * cs1 - p1 * sn1; }
                        else if (fq == 1) { r0 = v0 * cs0 + p0 * sn0; r1 = v1 * cs1 + p1 * sn1; }
                    }
                    if (isq) { const int c = pn * 256 + bj * 128 + cl;
                        *(u32x4*)(QN + (size_t)row * 1024 + c) = pack8(v0 * QSCALE, v1 * QSCALE); *(u32x4*)(QR + (size_t)row * 1024 + c) = pack8(r0 * QSCALE, r1 * QSCALE); }
                    else { const int cc = bj * 128 + cl, g = cc >> 6, d = cc & 63, b = row >> 13, t = row & (T - 1);
                        *(u32x4*)(KV6 + ((size_t)((pn - 4) * 16 + b * 4 + g) * T + t) * 64 + d) = pack8(r0, r1); }
                }
            } }
    }
};

struct Cmp1Sched {
    const char* KV6; const char* W; int G, c;
    static constexpr bool GATHER = false;
    __device__ __forceinline__ bool next(int i, pg8::Unit& u) const { const int L = i * G + c; if (L >= 64) return false; u.pm = L >> 1; u.pn = L & 1; u.ord = i; return true; }
    __device__ __forceinline__ unsigned lane_off(int r) const { return (unsigned)r * 2048u; }
    __device__ __forceinline__ unsigned unit_off(const pg8::Unit& u, int h) const { return (unsigned)u.pn * (unsigned)(16 * T * 64 * 2) + (unsigned)(u.pm * 256 + h * 128) * 2048u; }
    __device__ __forceinline__ unsigned aoff(const pg8::Unit&, int) const { return 0u; }
    __device__ __forceinline__ const char* abase() const { return KV6; }
    __device__ __forceinline__ const char* bptr(const pg8::Unit& u) const { return W + (size_t)u.pn * (256 * 2048 * 2); }
};
struct EpiCmp1 {
    static constexpr bool PERM = true, PERM16 = false; bf16_t* CH1; const float* bias1;
    __device__ __forceinline__ void operator()(const f32x4 (&acc)[2][2][4][2], const pg8::Unit& u, int wr, int wc, int fr, int fq) const {
        const int row0 = u.pm * 256 + wr * 64 + fr, cl = wc * 32 + 8 * fq;
        const f32x4 b0 = *(const f32x4*)(bias1 + u.pn * 128 + cl), b1 = *(const f32x4*)(bias1 + u.pn * 128 + cl + 4);
#pragma unroll
        EPI_ROWLOOP { f32x4 v0 = acc[ai][0][m][0] + b0, v1 = acc[ai][0][m][1] + b1;
#pragma unroll
            for (int i = 0; i < 4; ++i) { v0[i] = gelu_tanh(v0[i]); v1[i] = gelu_tanh(v1[i]); }
            *(u32x4*)(CH1 + ((size_t)u.pn * 8192 + row0 + ai * 128 + m * 16) * 128 + cl) = pack8(v0, v1); }
    }
};

__device__ __forceinline__ void p0_item(const float* W, int K, int N, bf16_t* WT, int kb, int n0, int drow0, LAS float* scr, int lane, bool f8 = false) {
    const int k0 = 64 * kb, n4 = (lane & 15) * 4;
    const bool cok = (n0 + n4) < N;
    f32x4 v[16];
#pragma unroll
    for (int i = 0; i < 16; ++i) { const int kk = 4 * i + (lane >> 4); v[i] = cok ? __builtin_nontemporal_load((const f32x4*)(W + (size_t)(k0 + kk) * N + n0 + n4)) : (f32x4){0.f, 0.f, 0.f, 0.f}; }
#pragma unroll
    for (int i = 0; i < 16; ++i) { const int kk = 4 * i + (lane >> 4); LAS float* d = scr + kk * 65 + n4; d[0] = v[i][0]; d[1] = v[i][1]; d[2] = v[i][2]; d[3] = v[i][3]; }
    asm volatile("s_waitcnt lgkmcnt(0)" ::: "memory");
    if (f8) {
        const int c4 = lane & 3;
#pragma unroll
        for (int j = 0; j < 4; ++j) { const int n = (lane >> 2) + 16 * j; const LAS float* sp = scr + (16 * c4) * 65 + n;
            u32x4 o;
            o.x = pk4_fp8(sp[0 * 65] * W8_SCALE, sp[1 * 65] * W8_SCALE, sp[2 * 65] * W8_SCALE, sp[3 * 65] * W8_SCALE); o.y = pk4_fp8(sp[4 * 65] * W8_SCALE, sp[5 * 65] * W8_SCALE, sp[6 * 65] * W8_SCALE, sp[7 * 65] * W8_SCALE);
            o.z = pk4_fp8(sp[8 * 65] * W8_SCALE, sp[9 * 65] * W8_SCALE, sp[10 * 65] * W8_SCALE, sp[11 * 65] * W8_SCALE); o.w = pk4_fp8(sp[12 * 65] * W8_SCALE, sp[13 * 65] * W8_SCALE, sp[14 * 65] * W8_SCALE, sp[15 * 65] * W8_SCALE);
            if (n0 + n < N) __builtin_nontemporal_store(o, (u32x4*)((unsigned char*)WT + (size_t)(drow0 + n) * K + k0 + 16 * c4)); }
        asm volatile("s_waitcnt lgkmcnt(0)" ::: "memory");
        return;
    }
    const int c = lane & 7;
#pragma unroll
    for (int j = 0; j < 8; ++j) { const int n = (lane >> 3) + 8 * j; const LAS float* sp = scr + (8 * c) * 65 + n;
        u32x4 o; o.x = pk2(sp[0 * 65], sp[1 * 65]); o.y = pk2(sp[2 * 65], sp[3 * 65]); o.z = pk2(sp[4 * 65], sp[5 * 65]); o.w = pk2(sp[6 * 65], sp[7 * 65]);
        if (n0 + n < N) __builtin_nontemporal_store(o, (u32x4*)(WT + (size_t)(drow0 + n) * K + k0 + 8 * c)); }
    asm volatile("s_waitcnt lgkmcnt(0)" ::: "memory");
}
struct CvtItem { const float* W; bf16_t* WT; int K, N, k0, n0, drow0; };
__device__ __forceinline__ void cvt32_load(const CvtItem& it, int lane, f32x4 (&v)[8]) {
    const int n4 = (lane & 7) * 4;
#pragma unroll
    for (int i = 0; i < 8; ++i) { const int kk = 8 * i + (lane >> 3); v[i] = __builtin_nontemporal_load((const f32x4*)(it.W + (size_t)(it.k0 + kk) * it.N + it.n0 + n4)); }
}
__device__ __forceinline__ void cvt32_finish(const CvtItem& it, int lane, const f32x4 (&v)[8], LAS float* scr) {
    const int n4 = (lane & 7) * 4;
#pragma unroll
    for (int i = 0; i < 8; ++i) { const int kk = 8 * i + (lane >> 3); LAS float* d = scr + kk * 33 + n4; d[0] = v[i][0]; d[1] = v[i][1]; d[2] = v[i][2]; d[3] = v[i][3]; }
    asm volatile("s_waitcnt lgkmcnt(0)" ::: "memory");
    const int c = lane & 7;
#pragma unroll
    for (int j = 0; j < 4; ++j) { const int n = (lane >> 3) + 8 * j; const LAS float* sp = scr + (8 * c) * 33 + n;
        const float v0 = sp[0 * 33], v1 = sp[1 * 33], v2 = sp[2 * 33], v3 = sp[3 * 33], v4 = sp[4 * 33], v5 = sp[5 * 33], v6 = sp[6 * 33], v7 = sp[7 * 33];
        u32x2 o; o.x = pk4_fp8(v0 * W8_SCALE, v1 * W8_SCALE, v2 * W8_SCALE, v3 * W8_SCALE); o.y = pk4_fp8(v4 * W8_SCALE, v5 * W8_SCALE, v6 * W8_SCALE, v7 * W8_SCALE);
        __builtin_nontemporal_store(o, (u32x2*)((unsigned char*)it.WT + (size_t)(it.drow0 + n) * it.K + it.k0 + 8 * c)); }
    asm volatile("s_waitcnt lgkmcnt(0)" ::: "memory");
}
constexpr int CVT1_ITEMS = 257 * 384;
__device__ __forceinline__ CvtItem cvt1_item(const Args& a, int idx) {
    const int e = idx / 384, sub = idx % 384, mat = sub >> 7, r = sub & 127;
    CvtItem it;
    if (mat < 2) { it.W = (e < 256) ? a.in[23 + mat] + ((size_t)256 + e) * (size_t)(D * FF) : a.in[26 + mat] + (size_t)(D * FF);
        it.K = D; it.N = FF; it.k0 = (r >> 3) * 64; it.n0 = (r & 7) * 32; it.drow0 = (it.n0 >> 7) * 256 + mat * 128 + (it.n0 & 127);
        it.WT = (bf16_t*)(a.ws + WS_WGU + (size_t)(257 + e) * 512 * 1024); }
    else { it.W = (e < 256) ? a.in[25] + ((size_t)256 + e) * (size_t)(FF * D) : a.in[28] + (size_t)(FF * D);
        it.K = FF; it.N = D; it.k0 = (r >> 5) * 64; it.n0 = (r & 31) * 32; it.drow0 = it.n0;
        it.WT = (bf16_t*)(a.ws + WS_WD + (size_t)(257 + e) * 1024 * 256); }
    return it;
}
__device__ __forceinline__ void cvt1_run(const Args& a, int& next, int stride, int quota, LAS float* scr, int lane) {
#pragma unroll 1
    for (int q = 0; q < quota && next < CVT1_ITEMS; ++q) {
        CvtItem t[4]; f32x4 v[4][8]; bool ok[4];
#pragma unroll
        for (int u = 0; u < 4; ++u) { const int idx = next + u * stride; ok[u] = idx < CVT1_ITEMS; t[u] = cvt1_item(a, ok[u] ? idx : 0); if (ok[u]) cvt32_load(t[u], lane, v[u]); }
        next += 4 * stride;
#pragma unroll
        for (int u = 0; u < 4; ++u) if (ok[u]) cvt32_finish(t[u], lane, v[u], scr);
    }
}
__device__ __forceinline__ void ph_prologue(const Args& a, LAS unsigned char* lds) {
    const int lane = threadIdx.x & 63, wave = threadIdx.x >> 6;
    LAS float* scr = (LAS float*)(lds + wave * 16640);
    const int gw = blockIdx.x * 8 + wave, ngw = gridDim.x * 8;
    for (int it = gw; it < 257 * 192; it += ngw) {
        const int le = it / 192, sub = it % 192, l = 0, e = le, mat = sub >> 6, r = sub & 63;
        if (mat < 2) {
            const float* W = (e < 256) ? a.in[23 + mat] + ((size_t)l * 256 + e) * (size_t)(D * FF) : a.in[26 + mat] + (size_t)l * (D * FF);
            const int kb = r >> 2, n0 = (r & 3) * 64;
            p0_item(W, D, FF, (bf16_t*)(a.ws + WS_WGU + (size_t)le * 512 * 1024), kb, n0, (n0 >> 7) * 256 + mat * 128 + (n0 & 127), scr, lane, true);
        } else {
            const float* W = (e < 256) ? a.in[25] + ((size_t)l * 256 + e) * (size_t)(FF * D) : a.in[28] + (size_t)l * (FF * D);
            const int kb = r >> 4, n0 = (r & 15) * 64;
            p0_item(W, FF, D, (bf16_t*)(a.ws + WS_WD + (size_t)le * 1024 * 256), kb, n0, n0, scr, lane, true);
        }
    }
    {
        for (int it = gw; it < 512; it += ngw) { const int w = it >> 8, r = it & 255;
            p0_item(a.in[w ? 16 : 8], D, D, (bf16_t*)(a.ws + (w ? WS_WOUTN : WS_WOUT0)), r >> 4, (r & 15) * 64, (r & 15) * 64, scr, lane, w != 0); }
        for (int it = gw; it < 16 * 41; it += ngw) p0_item(a.in[9], D, 2608, (bf16_t*)(a.ws + WS_WINN), it / 41, (it % 41) * 64, (it % 41) * 64, scr, lane);
        for (int it = gw; it < 128; it += ngw) { const int l = it >> 6, r = it & 63;
            p0_item(a.in[21] + (size_t)l * D * NE, D, NE, (bf16_t*)(a.ws + WS_WR) + (size_t)l * NE * D, r >> 2, (r & 3) * 64, (r & 3) * 64, scr, lane); }
        for (int it = gw; it < 16 * 16; it += ngw) { const int kb = it >> 4, n0 = (8 + (it & 15)) * 64;
            const int isg = (n0 >= 1024) ? 1 : 0, rel = n0 - 512 - isg * 512;
            p0_item(a.in[1], D, 1536, (bf16_t*)(a.ws + WS_WIN0), kb, n0, 512 + (rel >> 7) * 256 + isg * 128 + (rel & 127), scr, lane); }
        for (int it = gw; it < 128; it += ngw) { const int kv = it >> 6, r = it & 63;
            p0_item(a.in[kv ? 14 : 11], 2048, 128, (bf16_t*)(a.ws + WS_CW1) + (size_t)kv * 256 * 2048, r >> 1, (r & 1) * 64, (r & 1) * 64, scr, lane); }
    }
    {
        const int gt = blockIdx.x * 512 + threadIdx.x, ngt = gridDim.x * 512;
        u32x4* z0 = (u32x4*)((bf16_t*)(a.ws + WS_WINN) + (size_t)2608 * 1024);
        for (int i = gt; i < 208 * 1024 / 8; i += ngt) z0[i] = (u32x4){0u, 0u, 0u, 0u};
        for (int kv = 0; kv < 2; ++kv) { u32x4* z1 = (u32x4*)((bf16_t*)(a.ws + WS_CW1) + ((size_t)kv * 256 + 128) * 2048);
            for (int i = gt; i < 128 * 2048 / 8; i += ngt) z1[i] = (u32x4){0u, 0u, 0u, 0u}; }
        const float* x = a.in[0]; bf16_t* XA = (bf16_t*)(a.ws + WS_XA);
        for (size_t i = gt; i < (size_t)M * D / 8; i += ngt) { const f32x4 v0 = *(const f32x4*)(x + i * 8), v1 = *(const f32x4*)(x + i * 8 + 4);
            u32x4 o; o.x = pk2(v0[0], v0[1]); o.y = pk2(v0[2], v0[3]); o.z = pk2(v1[0], v1[1]); o.w = pk2(v1[2], v1[3]); *(u32x4*)(XA + i * 8) = o; }
        const float* win = a.in[1]; const float* mix = a.in[2]; const float* psc = a.in[3]; bf16_t* WIN0 = (bf16_t*)(a.ws + WS_WIN0);
        for (int i = gt; i < 512 * 1024; i += ngt) { const int n = i & 511, k = i >> 9, g = n >> 7, nn = n & 127;
            const float* wr_ = win + (size_t)k * 1536 + g * 128; const float* mx = mix + (size_t)g * 128 * 128 + nn;
            float s = 0.f;
            for (int c = 0; c < 128; ++c) s += wr_[c] * mx[(size_t)c * 128];
            WIN0[(size_t)n * 1024 + k] = f2bf(s * psc[n]); }
        float* misc = (float*)(a.ws + WS_MISC);
        for (int o = gw; o < 256; o += ngw) { const int kv = o >> 7, j = o & 127; const float* pos = a.in[kv ? 13 : 10]; const float* w1 = a.in[kv ? 14 : 11];
            float s = 0.f;
#pragma unroll 8
            for (int k = lane; k < 2048; k += 64) s += pos[k] * w1[(size_t)k * 128 + j];
            s = wave_sum(s);
            if (lane == 0) misc[o] = s; }
        float* rot = misc + 1024;
        for (int i = gt; i < T * 8; i += ngt) { const int t = i >> 3, f = i & 7;
            const float ang = (float)t * a.inv_freq[f]; const double rev = (double)ang * 0.15915494309189535; const float fr = (float)(rev - floor(rev));
            rot[t * 16 + f] = __builtin_amdgcn_cosf(fr); rot[t * 16 + 8 + f] = __builtin_amdgcn_sinf(fr); }
    }
}

typedef short v4i16_t __attribute__((ext_vector_type(4)));
constexpr int AT_KB = 0, AT_VB = 16384, AT_PS = 32768, AT_MSK = 32768 + 65536;
#define DPP_I(x, ctrl) __builtin_amdgcn_update_dpp((int)(x), (int)(x), (ctrl), 0xF, 0xF, true)
#define DPP_F(x, ctrl) __builtin_bit_cast(float, __builtin_amdgcn_update_dpp(__builtin_bit_cast(int, (float)(x)), __builtin_bit_cast(int, (float)(x)), (ctrl), 0xF, 0xF, true))
__device__ __forceinline__ bf16x8 tr_frag(LAS unsigned char* p0, LAS unsigned char* p1) {
    const v4i16_t a = __builtin_amdgcn_ds_read_tr16_b64_v4i16((LAS v4i16_t*)p0), b = __builtin_amdgcn_ds_read_tr16_b64_v4i16((LAS v4i16_t*)p1);
    return (bf16x8){a[0], a[1], a[2], a[3], b[0], b[1], b[2], b[3]};
}
constexpr size_t TN2_OFF = 786432;
__device__ __forceinline__ void ph_knorm(const Args& a) {
    const bf16_t* KV6 = (const bf16_t*)(a.ws + WS_KV6);
    float* TN2 = (float*)(a.ws + WS_MISC + TN2_OFF);
    const int lane = threadIdx.x & 63, wave = threadIdx.x >> 6;
    const int first = (gridDim.x > 64) ? 64 : 0;
    if ((int)blockIdx.x < first) return;
    const int wi = ((int)blockIdx.x - first) * 8 + wave, nw = ((int)gridDim.x - first) * 8;
    for (int id = wi; id < 4096; id += nw) {
        const int ty = id >> 11, bg = (id >> 7) & 15, tile = id & 127;
        const bf16_t* rp = KV6 + ((size_t)((ty ? 4 : 2) * 16 + bg) * T + tile * 64 + lane) * 64;
        float ssq = 0.f;
#pragma unroll
        for (int c = 0; c < 8; ++c) { const bf16x8 v = *(const bf16x8*)(rp + 8 * c);
#pragma unroll
            for (int j = 0; j < 8; ++j) { const float f = bf2f((bf16_t)v[j]); ssq += f * f; } }
        ssq = wave_max(ssq);
        if (lane == 0) TN2[id] = ssq;
    }
}
__device__ __forceinline__ void attn_qk2(LAS unsigned char* Kb, const bf16x8 (&q)[2][2], int fr, int g4, const float (&cinit)[2], f32x4 (&s)[2][4]) {
#pragma unroll
    for (int c = 0; c < 4; ++c) {
#pragma unroll
        for (int rb = 0; rb < 2; ++rb) s[rb][c] = (f32x4){cinit[rb], cinit[rb], cinit[rb], cinit[rb]};
#pragma unroll
        for (int ks = 0; ks < 2; ++ks) {
            const bf16x8 kf = *(const LAS bf16x8*)(Kb + pg8::lds_byte(16 * c + fr, 32 * ks + 8 * g4));
#pragma unroll
            for (int rb = 0; rb < 2; ++rb) s[rb][c] = __builtin_amdgcn_mfma_f32_16x16x32_bf16(kf, q[rb][ks], s[rb][c], 0, 0, 0);
        }
    }
}
__device__ __forceinline__ void attn_qk2m(LAS unsigned char* Kb, const bf16x8 (&q)[2][2], int fr, int g4, const float (&cinit)[2], f32x4 (&s)[2][4]) {
    bf16x8 kf[4][2];
#pragma unroll
    for (int c = 0; c < 4; ++c)
#pragma unroll
        for (int ks = 0; ks < 2; ++ks) kf[c][ks] = *(const LAS bf16x8*)(Kb + pg8::lds_byte(16 * c + fr, 32 * ks + 8 * g4));
    __builtin_amdgcn_sched_barrier(0);
    f32x4 ci[2];
#pragma unroll
    for (int rb = 0; rb < 2; ++rb) ci[rb] = (f32x4){cinit[rb], cinit[rb], cinit[rb], cinit[rb]};
#pragma unroll
    for (int c = 0; c < 4; ++c) {
#pragma unroll
        for (int ks = 0; ks < 2; ++ks) {
#pragma unroll
            for (int rb = 0; rb < 2; ++rb) s[rb][c] = __builtin_amdgcn_mfma_f32_16x16x32_bf16(kf[c][ks], q[rb][ks], ks == 0 ? ci[rb] : s[rb][c], 0, 0, 0);
        }
    }
}
__device__ __forceinline__ void attn_qk2z(LAS unsigned char* Kb, const bf16x8 (&q)[2][2], int fr, int g4, f32x4 (&s)[2][4]) {
    bf16x8 kf[4][2];
#pragma unroll
    for (int c = 0; c < 4; ++c)
#pragma unroll
        for (int ks = 0; ks < 2; ++ks) kf[c][ks] = *(const LAS bf16x8*)(Kb + pg8::lds_byte(16 * c + fr, 32 * ks + 8 * g4));
    __builtin_amdgcn_sched_barrier(0);
#pragma unroll
    for (int c = 0; c < 4; ++c) {
#pragma unroll
        for (int ks = 0; ks < 2; ++ks) {
#pragma unroll
            for (int rb = 0; rb < 2; ++rb) s[rb][c] = __builtin_amdgcn_mfma_f32_16x16x32_bf16(kf[c][ks], q[rb][ks], ks == 0 ? (f32x4){0.f, 0.f, 0.f, 0.f} : s[rb][c], 0, 0, 0);
        }
    }
}
struct AttnRow { float m; f32x4 o[4]; f32x4 ol; };
__device__ __forceinline__ float max3f(float a, float b, float c) { float r; asm("v_max3_f32 %0, %1, %2, %3" : "=v"(r) : "v"(a), "v"(b), "v"(c)); return r; }
__device__ __forceinline__ bool attn_sm2(f32x4 (&s)[4], AttnRow& st, int kbase, int g4, int lo, int hi, bool en, bool emask) {
    const float NEG = -INFINITY;
    if (emask) {
#pragma unroll
        for (int c = 0; c < 4; ++c)
#pragma unroll
            for (int i = 0; i < 4; ++i) { const int key = kbase + 16 * c + 4 * g4 + i; if (key < lo || key > hi) s[c][i] = NEG; }
    }
    float mx = max3f(s[0][0], s[0][1], s[0][2]); mx = max3f(mx, s[0][3], s[1][0]); mx = max3f(mx, s[1][1], s[1][2]); mx = max3f(mx, s[1][3], s[2][0]);
    mx = max3f(mx, s[2][1], s[2][2]); mx = max3f(mx, s[2][3], s[3][0]); mx = max3f(mx, s[3][1], s[3][2]); mx = max3f(mx, s[3][3], mx);
    if (!en) mx = NEG;
    mx = max3f(mx, __shfl_xor(mx, 16), mx); mx = max3f(mx, __shfl_xor(mx, 32), mx);
    const float delta = (mx > 20.0f) ? mx : 0.f;
    const bool moved = __builtin_amdgcn_ballot_w64(delta != 0.f) != 0ull;
    if (moved) {
        const float alpha = __builtin_amdgcn_exp2f(-delta);
#pragma unroll
        for (int c = 0; c < 4; ++c) s[c] = s[c] - delta;
#pragma unroll
        for (int dt = 0; dt < 4; ++dt) st.o[dt] *= alpha;
        st.ol *= alpha;
        st.m += delta;
    }
#pragma unroll
    for (int c = 0; c < 4; ++c)
#pragma unroll
        for (int i = 0; i < 4; ++i) s[c][i] = __builtin_amdgcn_exp2f(s[c][i]);
    return moved;
}
__device__ __forceinline__ bool attn_sm2x(f32x4 (&s)[2][4], AttnRow (&st)[2], int kbase, int g4, const int (&lo)[2], const int (&hi)[2], const bool (&en)[2], bool emask) {
    const float NEG = -INFINITY;
    if (emask) {
#pragma unroll
        for (int rb = 0; rb < 2; ++rb)
#pragma unroll
            for (int c = 0; c < 4; ++c)
#pragma unroll
                for (int i = 0; i < 4; ++i) { const int key = kbase + 16 * c + 4 * g4 + i; if (key < lo[rb] || key > hi[rb]) s[rb][c][i] = NEG; }
    }
    float mx[2];
#pragma unroll
    for (int rb = 0; rb < 2; ++rb) {
        float m = max3f(s[rb][0][0], s[rb][0][1], s[rb][0][2]); m = max3f(m, s[rb][0][3], s[rb][1][0]); m = max3f(m, s[rb][1][1], s[rb][1][2]); m = max3f(m, s[rb][1][3], s[rb][2][0]);
        m = max3f(m, s[rb][2][1], s[rb][2][2]); m = max3f(m, s[rb][2][3], s[rb][3][0]); m = max3f(m, s[rb][3][1], s[rb][3][2]); m = max3f(m, s[rb][3][3], m);
        mx[rb] = en[rb] ? m : NEG;
    }
    { const float t0 = __shfl_xor(mx[0], 16), t1 = __shfl_xor(mx[1], 16); mx[0] = max3f(mx[0], t0, t0); mx[1] = max3f(mx[1], t1, t1); }
    { const float t0 = __shfl_xor(mx[0], 32), t1 = __shfl_xor(mx[1], 32); mx[0] = max3f(mx[0], t0, t0); mx[1] = max3f(mx[1], t1, t1); }
    const float d0 = (mx[0] > 20.0f) ? mx[0] : 0.f, d1 = (mx[1] > 20.0f) ? mx[1] : 0.f;
    const bool moved = __builtin_amdgcn_ballot_w64((d0 != 0.f) || (d1 != 0.f)) != 0ull;
    if (moved) {
        const float dl[2] = {d0, d1};
#pragma unroll
        for (int rb = 0; rb < 2; ++rb) {
            const float alpha = __builtin_amdgcn_exp2f(-dl[rb]);
#pragma unroll
            for (int c = 0; c < 4; ++c) s[rb][c] = s[rb][c] - dl[rb];
#pragma unroll
            for (int dt = 0; dt < 4; ++dt) st[rb].o[dt] *= alpha;
            st[rb].ol *= alpha; st[rb].m += dl[rb];
        }
    }
#pragma unroll
    for (int rb = 0; rb < 2; ++rb)
#pragma unroll
        for (int c = 0; c < 4; ++c)
#pragma unroll
            for (int i = 0; i < 4; ++i) s[rb][c][i] = __builtin_amdgcn_exp2f(s[rb][c][i]);
    return moved;
}
__device__ __forceinline__ void attn_pv2x(LAS unsigned char* Vb, const f32x4 (&p)[2][4], int vlane, int swz, const unsigned (&enm)[2], const bool (&act)[2], const bf16x8 onesf, AttnRow (&st)[2]) {
#pragma unroll
    for (int ks = 0; ks < 2; ++ks) {
        bf16x8 pb[2];
#pragma unroll
        for (int rb = 0; rb < 2; ++rb) { u32x4 pw = pack8m(p[rb][2 * ks], p[rb][2 * ks + 1]); pw.x &= enm[rb]; pw.y &= enm[rb]; pw.z &= enm[rb]; pw.w &= enm[rb]; pb[rb] = __builtin_bit_cast(bf16x8, pw); }
#pragma unroll
        for (int dt = 0; dt < 4; ++dt) {
            LAS unsigned char* a0 = Vb + vlane + (2 * ks) * 2048 + ((dt ^ swz) * 32);
            const bf16x8 vf = tr_frag(a0, a0 + 2048);
#pragma unroll
            for (int rb = 0; rb < 2; ++rb) if (act[rb]) st[rb].o[dt] = __builtin_amdgcn_mfma_f32_16x16x32_bf16(vf, pb[rb], st[rb].o[dt], 0, 0, 0);
        }
#pragma unroll
        for (int rb = 0; rb < 2; ++rb) if (act[rb]) st[rb].ol = __builtin_amdgcn_mfma_f32_16x16x32_bf16(onesf, pb[rb], st[rb].ol, 0, 0, 0);
    }
}
__device__ __forceinline__ bool attn_max2x(f32x4 (&s)[2][4], int kbase, int g4, const int (&lo)[2], const int (&hi)[2], const bool (&en)[2], bool emask, float (&d)[2]) {
    const float NEG = -INFINITY;
    MFMA_SETTLE(s);
    if (emask) {
#pragma unroll
        for (int rb = 0; rb < 2; ++rb)
#pragma unroll
            for (int c = 0; c < 4; ++c)
#pragma unroll
                for (int i = 0; i < 4; ++i) { const int key = kbase + 16 * c + 4 * g4 + i; if (key < lo[rb] || key > hi[rb]) s[rb][c][i] = NEG; }
    }
    float mx[2];
#pragma unroll
    for (int rb = 0; rb < 2; ++rb) {
        float m = max3f(s[rb][0][0], s[rb][0][1], s[rb][0][2]); m = max3f(m, s[rb][0][3], s[rb][1][0]); m = max3f(m, s[rb][1][1], s[rb][1][2]); m = max3f(m, s[rb][1][3], s[rb][2][0]);
        m = max3f(m, s[rb][2][1], s[rb][2][2]); m = max3f(m, s[rb][2][3], s[rb][3][0]); m = max3f(m, s[rb][3][1], s[rb][3][2]); m = max3f(m, s[rb][3][3], m);
        mx[rb] = en[rb] ? m : NEG;
    }
    { const float t0 = __shfl_xor(mx[0], 16), t1 = __shfl_xor(mx[1], 16); mx[0] = max3f(mx[0], t0, t0); mx[1] = max3f(mx[1], t1, t1); }
    { const float t0 = __shfl_xor(mx[0], 32), t1 = __shfl_xor(mx[1], 32); mx[0] = max3f(mx[0], t0, t0); mx[1] = max3f(mx[1], t1, t1); }
    d[0] = (mx[0] > 20.0f) ? mx[0] : 0.f; d[1] = (mx[1] > 20.0f) ? mx[1] : 0.f;
    return __builtin_amdgcn_ballot_w64((d[0] != 0.f) || (d[1] != 0.f)) != 0ull;
}
__device__ __forceinline__ void attn_rescale2x(f32x4 (&s)[2][4], AttnRow (&st)[2], const float (&d)[2]) {
#pragma unroll
    for (int rb = 0; rb < 2; ++rb) {
        const float alpha = __builtin_amdgcn_exp2f(-d[rb]);
#pragma unroll
        for (int c = 0; c < 4; ++c) s[rb][c] = s[rb][c] - d[rb];
#pragma unroll
        for (int dt = 0; dt < 4; ++dt) st[rb].o[dt] *= alpha;
        st[rb].ol *= alpha; st[rb].m += d[rb];
    }
}
__device__ __forceinline__ void attn_exp1(f32x4 (&s)[4], unsigned enm, bf16x8 (&pb)[2]) {
#pragma unroll
    for (int c = 0; c < 4; ++c)
#pragma unroll
        for (int i = 0; i < 4; ++i) s[c][i] = __builtin_amdgcn_exp2f(s[c][i]);
#pragma unroll
    for (int ks = 0; ks < 2; ++ks) { u32x4 pw = pack8m(s[2 * ks], s[2 * ks + 1]); pw.x &= enm; pw.y &= enm; pw.z &= enm; pw.w &= enm; pb[ks] = __builtin_bit_cast(bf16x8, pw); }
}
__device__ __forceinline__ void attn_pv1(LAS unsigned char* Vb, const bf16x8 (&pb)[2], int vlane, int swz, const bf16x8 onesf, AttnRow& st) {
#pragma unroll
    for (int ks = 0; ks < 2; ++ks) {
#pragma unroll
        for (int dt = 0; dt < 4; ++dt) {
            LAS unsigned char* a0 = Vb + vlane + (2 * ks) * 2048 + ((dt ^ swz) * 32);
            const bf16x8 vf = tr_frag(a0, a0 + 2048);
            st.o[dt] = __builtin_amdgcn_mfma_f32_16x16x32_bf16(vf, pb[ks], st.o[dt], 0, 0, 0);
        }
        st.ol = __builtin_amdgcn_mfma_f32_16x16x32_bf16(onesf, pb[ks], st.ol, 0, 0, 0);
    }
}
__device__ __forceinline__ bool attn_step2x(LAS unsigned char* Vb, f32x4 (&s)[2][4], AttnRow (&st)[2], int kbase, int g4, const int (&lo)[2], const int (&hi)[2], const bool (&en)[2], const unsigned (&enm)[2], bool emask,
                                            int vlane, int swz, const bf16x8 onesf) {
    float d[2];
    const bool moved = attn_max2x(s, kbase, g4, lo, hi, en, emask, d);
    if (moved) attn_rescale2x(s, st, d);
    bf16x8 p0[2], p1[2];
    attn_exp1(s[0], enm[0], p0);
    attn_pv1(Vb, p0, vlane, swz, onesf, st[0]);
    attn_exp1(s[1], enm[1], p1);
    attn_pv1(Vb, p1, vlane, swz, onesf, st[1]);
    return moved;
}
__device__ __forceinline__ void attn_step2x_nomax(LAS unsigned char* Vb, f32x4 (&s)[2][4], AttnRow (&st)[2], int kbase, int g4, const int (&lo)[2], const int (&hi)[2], const unsigned (&enm)[2], bool emask,
                                                  int vlane, int swz, const bf16x8 onesf) {
    if (emask) {
#pragma unroll
        for (int rb = 0; rb < 2; ++rb)
#pragma unroll
            for (int c = 0; c < 4; ++c)
#pragma unroll
                for (int i = 0; i < 4; ++i) { const int key = kbase + 16 * c + 4 * g4 + i; if (key < lo[rb] || key > hi[rb]) s[rb][c][i] = -INFINITY; }
    }
    bf16x8 p0[2], p1[2];
    attn_exp1(s[0], enm[0], p0);
    attn_pv1(Vb, p0, vlane, swz, onesf, st[0]);
    attn_exp1(s[1], enm[1], p1);
    attn_pv1(Vb, p1, vlane, swz, onesf, st[1]);
}
typedef _Float16 f16x4 __attribute__((ext_vector_type(4)));
constexpr int AT4_KB = 0, AT4_VB = 32768, AT2_PS = 65536, AT2_MSK = 65536 + 65536;
__device__ __forceinline__ int attn_pair_of(int pr) { const int p = pr & 63, k = pr >> 8; const int q = (k & 2) ? ((p + 32) & 63) : p; return (k & 1) ? 63 - q : q; }
__device__ __forceinline__ void ph_attn_fast2(const Args& a, LAS unsigned char* lds) {
    const bf16_t* QN = (const bf16_t*)(a.ws + WS_HN);
    const bf16_t* QR = (const bf16_t*)(a.ws + WS_QR);
    const bf16_t* KV6 = (const bf16_t*)(a.ws + WS_KV6);
    const float* GATES = (const float*)(a.ws + WS_GATES);
    const bf16_t* KC = (const bf16_t*)(a.ws + WS_KC);
    const bf16_t* VC = KC + (size_t)8192 * 64;
    bf16_t* O = (bf16_t*)(a.ws + WS_O);
    const int tid = threadIdx.x, lane = tid & 63, wave = __builtin_amdgcn_readfirstlane(tid >> 6);
    const int fr = lane & 15, g4 = lane >> 4;
    int ksrc, vsrc;
    { int R, C; pg8::stage_rc(wave * 1024 + lane * 16, R, C); ksrc = R * 64 + C;
      const int key = 8 * wave + (lane >> 3), pos = lane & 7, chunk = (pos >> 1) ^ ((key >> 1) & 3); vsrc = key * 64 + (chunk * 2 + (pos & 1)) * 8; }
    const int vlane = (4 * g4 + (fr >> 2)) * 128 + (fr & 3) * 8, swz = (2 * g4 + (fr >> 3)) & 3;
    LAS _Float16* ps = (LAS _Float16*)(lds + AT2_PS + wave * 8192);
    LAS unsigned* mskl = (LAS unsigned*)(lds + AT2_MSK + wave * 128);
    const float NEG = -INFINITY;
    const bf16x8 onesf = (fr == 0) ? (bf16x8){0x3F80, 0x3F80, 0x3F80, 0x3F80, 0x3F80, 0x3F80, 0x3F80, 0x3F80} : (bf16x8){0, 0, 0, 0, 0, 0, 0, 0};
    const int vcu = (gridDim.x % 8 == 0) ? (int)((blockIdx.x % 8) * (gridDim.x / 8) + blockIdx.x / 8) : (int)blockIdx.x;
    int cvt_next = (int)blockIdx.x * 8 + wave; const int cvt_stride = (int)gridDim.x * 8;
    LAS float* cvt_scr = (LAS float*)(lds + AT2_PS + wave * 8448);
    bool cmp_pref = false;
    for (int pr = vcu; pr < 1024; pr += gridDim.x) {
#pragma unroll 1
        for (int half = 0; half < 2; ++half) {
            const int bg = pr >> 6, pp = attn_pair_of(pr), cc = half ? (127 - pp) : pp;
            const int b = bg >> 2, g = bg & 3, t0 = cc * 64, cur = cc;
            const int head = g * 4 + (fr & 3);
            int trow[2];
            bf16x8 qn[2][2];
#pragma unroll
            for (int rb = 0; rb < 2; ++rb) {
                trow[rb] = t0 + 8 * wave + 4 * rb + (fr >> 2);
#pragma unroll
                for (int ks = 0; ks < 2; ++ks) qn[rb][ks] = *(const bf16x8*)(QN + ((size_t)b * T + trow[rb]) * 1024 + head * 64 + 32 * ks + 8 * g4);
            }
#define TROW_PIN() asm volatile("" : "+v"(trow[0]), "+v"(trow[1]))
#define TOKROW(rb) ((size_t)b * T + trow[rb])
#define GATE(rb, br) (GATES[TOKROW(rb) * 48 + head * 3 + (br)])
            const bf16_t* kcb = KC + (size_t)bg * 512 * 64;
            const bf16_t* kvb = KV6 + (size_t)bg * T * 64;
#define ATK(sl) (((sl) < 4 ? AT4_KB : AT2_PS - 4 * 8192) + (sl) * 8192)
#define ATV(sl) (((sl) < 4 ? AT4_VB : AT2_PS + 32768 - 4 * 8192) + (sl) * 8192)
#define AT_DMA(BR, tile, slot) do { const bf16_t* kp_; const bf16_t* vp_; \
                if ((BR) == 0) { kp_ = kcb + (size_t)(tile) * 4096; vp_ = kp_ + (size_t)8192 * 64; } \
                else { kp_ = kvb + (size_t)((BR) == 1 ? 2 : 4) * 16 * T * 64 + (size_t)(tile) * 4096; vp_ = kp_ + (size_t)16 * T * 64; } \
                __builtin_amdgcn_global_load_lds((const unsigned*)(kp_ + ksrc), (LAS unsigned*)(lds + ATK(slot) + wave * 1024), 16, 0, 0); \
                __builtin_amdgcn_global_load_lds((const unsigned*)(vp_ + vsrc), (LAS unsigned*)(lds + ATV(slot) + wave * 1024), 16, 0, 0); } while (0)
            int ncv[2];
#pragma unroll
            for (int rb = 0; rb < 2; ++rb) ncv[rb] = (trow[rb] >= 31) ? ((trow[rb] - 31) / 16 + 1) : 0;
            const int nct = (((t0 + 63 - 31) / 16 + 1) + 63) >> 6;
            float mc[2], invc[2];
            const int t_lo = t0 + 8 * wave, ncv_lo = (t_lo >= 31) ? ((t_lo - 31) / 16 + 1) : 0;
            {
                float m1[2] = {NEG, NEG}, l1[2] = {0.f, 0.f};
                const float zero2[2] = {0.f, 0.f};
#define CMP1_TILE(J, SLOT, MASKED) do { const int j = (J); const int SLOT_ = (SLOT); \
                    f32x4 s[2][4]; attn_qk2(lds + AT4_KB + SLOT_ * 8192, qn, fr, g4, zero2, s); \
                    _Pragma("unroll") \
                    for (int rb = 0; rb < 2; ++rb) { \
                        float mx = NEG; \
                    _Pragma("unroll") \
                        for (int c = 0; c < 4; ++c) \
                    _Pragma("unroll") \
                            for (int i = 0; i < 4; ++i) { const int n = 64 * j + 16 * c + 4 * g4 + i; if ((MASKED) && n >= ncv[rb]) s[rb][c][i] = NEG; mx = fmaxf(mx, s[rb][c][i]); } \
                        mx = fmaxf(mx, __shfl_xor(mx, 16)); mx = fmaxf(mx, __shfl_xor(mx, 32)); \
                        const float mn = fmaxf(m1[rb], mx), msafe = (mn == NEG) ? 0.f : mn; \
                        const float alpha = (m1[rb] == NEG) ? 0.f : __builtin_amdgcn_exp2f(m1[rb] - msafe); \
                        float sum = 0.f; \
                    _Pragma("unroll") \
                        for (int c = 0; c < 4; ++c) \
                    _Pragma("unroll") \
                            for (int i = 0; i < 4; ++i) sum += __builtin_amdgcn_exp2f(s[rb][c][i] - msafe); \
                        l1[rb] = l1[rb] * alpha + sum; m1[rb] = mn; \
                    } \
                } while (0)
                if (!cmp_pref) { AT_DMA(0, 0, 0); if (nct > 1) AT_DMA(0, 1, 1); } __syncthreads();
                for (int j0 = 0; j0 < nct; j0 += 2) { const int sb = (j0 & 2);
                    if (j0 + 2 < nct) AT_DMA(0, j0 + 2, sb ^ 2);
                    if (j0 + 3 < nct) AT_DMA(0, j0 + 3, (sb ^ 2) + 1);
                    CMP1_TILE(j0, sb, true); if (j0 + 1 < nct) CMP1_TILE(j0 + 1, sb + 1, true);
                    __syncthreads();
                }
#undef CMP1_TILE
#pragma unroll
                for (int rb = 0; rb < 2; ++rb) { float lc = l1[rb]; lc += __shfl_xor(lc, 16); lc += __shfl_xor(lc, 32); invc[rb] = (lc > 0.f) ? -(((m1[rb] == NEG) ? 0.f : m1[rb]) + __builtin_amdgcn_logf(lc)) : 0.f; mc[rb] = (m1[rb] == NEG) ? 0.f : m1[rb]; }
            }
            {
                AttnRow oc[2];
#pragma unroll
                for (int rb = 0; rb < 2; ++rb) { oc[rb].m = 0.f; oc[rb].ol = (f32x4){0.f, 0.f, 0.f, 0.f};
#pragma unroll
                    for (int dt = 0; dt < 4; ++dt) oc[rb].o[dt] = (f32x4){0.f, 0.f, 0.f, 0.f}; }
                const float cin[2] = {invc[0], invc[1]};
                const unsigned full[2] = {0xffffffffu, 0xffffffffu}; const bool both[2] = {true, true};
#define CMP2_TILE(J, SLOT, MASKED) do { const int j = (J); const int SLOT_ = (SLOT); \
                    f32x4 s[2][4]; attn_qk2(lds + AT4_KB + SLOT_ * 8192, qn, fr, g4, cin, s); \
                    _Pragma("unroll") \
                    for (int rb = 0; rb < 2; ++rb) \
                    _Pragma("unroll") \
                        for (int c = 0; c < 4; ++c) { \
                            f16x4 hs; \
                    _Pragma("unroll") \
                            for (int i = 0; i < 4; ++i) { const int n = 64 * j + 16 * c + 4 * g4 + i; const float p = (!(MASKED) || n < ncv[rb]) ? __builtin_amdgcn_exp2f(s[rb][c][i]) : 0.f; s[rb][c][i] = p; \
                                float h = p; h += DPP_F(h, 0xB1); h += DPP_F(h, 0x4E); hs[i] = (_Float16)h; }        \
                            if ((fr & 3) == 0) *(LAS f16x4*)(ps + (4 * rb + (fr >> 2)) * 512 + 64 * j + 16 * c + 4 * g4) = hs; \
                        } \
                    attn_pv2x(lds + AT4_VB + SLOT_ * 8192, s, vlane, swz, full, both, onesf, oc); \
                } while (0)
                const bool reload = nct > 4;
                if (reload) { AT_DMA(0, 0, 0); AT_DMA(0, 1, 1); __syncthreads(); }
                for (int j0 = 0; j0 < nct; j0 += 2) { const int sb = (j0 & 2);
                    if (reload && j0 + 2 < nct) AT_DMA(0, j0 + 2, sb ^ 2);
                    if (reload && j0 + 3 < nct) AT_DMA(0, j0 + 3, (sb ^ 2) + 1);
                    CMP2_TILE(j0, sb, true); if (j0 + 1 < nct) CMP2_TILE(j0 + 1, sb + 1, true);
                    __syncthreads();
                }
#undef CMP2_TILE
                TROW_PIN();
#pragma unroll
                for (int rb = 0; rb < 2; ++rb) { bf16_t* op = O + TOKROW(rb) * 1024 + head * 64 + 4 * g4; const float g0 = GATE(rb, 0);
#pragma unroll
                    for (int dt = 0; dt < 4; ++dt) { const f32x4 v = oc[rb].o[dt] * g0; u32x2 w; w.x = cvt_pk_bf16(v[0], v[1]); w.y = cvt_pk_bf16(v[2], v[3]); *(u32x2*)(op + 16 * dt) = w; } }
            }
            {
                WSYNC();
                const int tl = lane >> 4, li = lane & 15;
                const int nsel = (cur + 1 < 16) ? (cur + 1) : 16;
#pragma unroll 1
                for (int rnd = 0; rnd < 2; ++rnd) {
                    const LAS _Float16* pst = ps + (4 * rnd + tl) * 512;
                    float v[8];
#pragma unroll
                    for (int k = 0; k < 8; ++k) { const int j = li + 16 * k;
                        float x;
                        if (j > cur) x = NEG;
                        else if (j == 0 || j == cur || j == cur - 1) x = NEG;
                        else { const int n0 = 4 * j; x = (float)pst[n0 - 1] + 2.0f * ((float)pst[n0] + (float)pst[n0 + 1] + (float)pst[n0 + 2]) + (float)pst[n0 + 3]; }
                        v[k] = x; }
                    int vi[8];
#pragma unroll
                    for (int k = 0; k < 8; ++k) vi[k] = __builtin_bit_cast(int, v[k]);
                    unsigned mm[4] = {1u, 0u, 0u, 0u};
                    {
                        const unsigned bc = 1u << (cur & 31); const int wc_ = cur >> 5;
                        mm[0] |= (wc_ == 0) ? bc : 0u; mm[1] |= (wc_ == 1) ? bc : 0u; mm[2] |= (wc_ == 2) ? bc : 0u; mm[3] |= (wc_ == 3) ? bc : 0u;
                        if (cur >= 1) { const unsigned bp = 1u << ((cur - 1) & 31); const int wp_ = (cur - 1) >> 5;
                            mm[0] |= (wp_ == 0) ? bp : 0u; mm[1] |= (wp_ == 1) ? bp : 0u; mm[2] |= (wp_ == 2) ? bp : 0u; mm[3] |= (wp_ == 3) ? bp : 0u; }
                    }
                    const int nforced = (cur >= 2) ? 3 : (cur + 1);
                    for (int it = 0; it < nsel - nforced; ++it) {
                        int bv = max(max(max(vi[0], vi[1]), max(vi[2], vi[3])), max(max(vi[4], vi[5]), max(vi[6], vi[7])));
                        bv = max(bv, DPP_I(bv, 0xB1)); bv = max(bv, DPP_I(bv, 0x4E)); bv = max(bv, DPP_I(bv, 0x141)); bv = max(bv, DPP_I(bv, 0x140));
                        int bi = 255;
#pragma unroll
                        for (int k = 7; k >= 0; --k) bi = (vi[k] == bv) ? (li + 16 * k) : bi;
                        bi = min(bi, DPP_I(bi, 0xB1)); bi = min(bi, DPP_I(bi, 0x4E)); bi = min(bi, DPP_I(bi, 0x141)); bi = min(bi, DPP_I(bi, 0x140));
                        const unsigned bit = 1u << (bi & 31); const int wsel = bi >> 5;
                        mm[0] |= (wsel == 0) ? bit : 0u; mm[1] |= (wsel == 1) ? bit : 0u; mm[2] |= (wsel == 2) ? bit : 0u; mm[3] |= (wsel == 3) ? bit : 0u;
                        if ((bi & 15) == li) {
#pragma unroll
                            for (int k = 0; k < 8; ++k) if ((bi >> 4) == k) vi[k] = (int)0xFF800000;
                        }
                    }
                    if (li == 0) { mskl[(4 * rnd + tl) * 4 + 0] = mm[0]; mskl[(4 * rnd + tl) * 4 + 1] = mm[1]; mskl[(4 * rnd + tl) * 4 + 2] = mm[2]; mskl[(4 * rnd + tl) * 4 + 3] = mm[3]; }
                }
                WSYNC();
            }
            bf16x8 qr[2][2];
            TROW_PIN();
#pragma unroll
            for (int rb = 0; rb < 2; ++rb)
#pragma unroll
                for (int ks = 0; ks < 2; ++ks) qr[rb][ks] = *(const bf16x8*)(QR + TOKROW(rb) * 1024 + head * 64 + 32 * ks + 8 * g4);
            bool nomax_slc, nomax_win;
            {
                float qq = 0.f;
#pragma unroll
                for (int rb = 0; rb < 2; ++rb) { float q2 = 0.f;
#pragma unroll
                    for (int ks = 0; ks < 2; ++ks)
#pragma unroll
                        for (int j = 0; j < 8; ++j) { const float x = bf2f((bf16_t)qr[rb][ks][j]); q2 += x * x; }
                    q2 += __shfl_xor(q2, 16); q2 += __shfl_xor(q2, 32); qq = fmaxf(qq, q2); }
                qq = wave_max(qq);
                const float* tn = (const float*)(a.ws + WS_MISC + TN2_OFF) + bg * 128;
                const int jt0w = (t0 >= 511) ? ((t0 - 511) >> 6) : 0;
                float ts = 0.f, tw = 0.f;
#pragma unroll
                for (int h2 = 0; h2 < 2; ++h2) { const int tl_ = lane + 64 * h2; if (tl_ <= cur) { ts = fmaxf(ts, tn[tl_]); if (tl_ >= jt0w) tw = fmaxf(tw, tn[2048 + tl_]); } }
                ts = wave_max(ts); tw = wave_max(tw);
                nomax_slc = __builtin_amdgcn_readfirstlane((qq * ts <= 3500.0f) ? 1 : 0) != 0;
                nomax_win = __builtin_amdgcn_readfirstlane((qq * tw <= 3500.0f) ? 1 : 0) != 0;
            }
            {
                AttnRow ss[2];
#pragma unroll
                for (int rb = 0; rb < 2; ++rb) { ss[rb].m = 0.f; ss[rb].ol = (f32x4){0.f, 0.f, 0.f, 0.f};
#pragma unroll
                    for (int dt = 0; dt < 4; ++dt) ss[rb].o[dt] = (f32x4){0.f, 0.f, 0.f, 0.f}; }
                const int nt_ = cur + 1;
                bool refmoved = false;
#define SLC_PRE(J) const int j_ = (J); bool en[2], act[2]; unsigned enm[2]; \
                    _Pragma("unroll") for (int rb = 0; rb < 2; ++rb) { const unsigned mw = mwg[rb]; \
                        en[rb] = (mw >> (j_ & 31)) & 1u; act[rb] = __any(en[rb]); enm[rb] = en[rb] ? 0xffffffffu : 0u; } const int lo2[2] = {0, 0};
#define SLC_TILE(J, SLOT) do { SLC_PRE(J) \
                    if (act[0] || act[1]) { f32x4 s[2][4]; \
                        if (refmoved) { const float cin[2] = {-ss[0].m, -ss[1].m}; attn_qk2(lds + ATK(SLOT), qr, fr, g4, cin, s); } \
                        else attn_qk2z(lds + ATK(SLOT), qr, fr, g4, s); \
                        refmoved |= attn_step2x(lds + ATV(SLOT), s, ss, 64 * j_, g4, lo2, trow, en, enm, j_ == cur, vlane, swz, onesf); } } while (0)
#define SLC_TILE_NM(J, SLOT) do { SLC_PRE(J) \
                    if (act[0] || act[1]) { f32x4 s[2][4]; const float cm_[2] = {en[0] ? 0.f : -1e30f, en[1] ? 0.f : -1e30f}; attn_qk2m(lds + ATK(SLOT), qr, fr, g4, cm_, s); \
                        const unsigned fullm_[2] = {0xffffffffu, 0xffffffffu}; \
                        attn_step2x_nomax(lds + ATV(SLOT), s, ss, 64 * j_, g4, lo2, trow, fullm_, j_ == cur, vlane, swz, onesf); } } while (0)
#pragma unroll
                for (int i = 0; i < 4; ++i) if (i < nt_) AT_DMA(1, i, i);
                __syncthreads();
#define SLC_LOOP(TILE) for (int j0 = 0; j0 < nt_; j0 += 4) { const int sb = (j0 & 4); \
                    const unsigned mwg[2] = {mskl[(fr >> 2) * 4 + (j0 >> 5)], mskl[(4 + (fr >> 2)) * 4 + (j0 >> 5)]};       \
                    _Pragma("unroll") for (int i = 0; i < 4; ++i) if (j0 + 4 + i < nt_) AT_DMA(1, j0 + 4 + i, (sb ^ 4) + i); \
                    TILE(j0, sb); if (j0 + 1 < nt_) TILE(j0 + 1, sb + 1); if (j0 + 2 < nt_) TILE(j0 + 2, sb + 2); if (j0 + 3 < nt_) TILE(j0 + 3, sb + 3); \
                    __syncthreads(); }
                if (nomax_slc) { SLC_LOOP(SLC_TILE_NM) } else { SLC_LOOP(SLC_TILE) }
#undef SLC_LOOP
#undef SLC_TILE_NM
#undef SLC_PRE
#undef SLC_TILE
                TROW_PIN();
#pragma unroll
                for (int rb = 0; rb < 2; ++rb) { const float l = __shfl(ss[rb].ol[0], fr); const float sc1 = (l > 0.f) ? GATE(rb, 1) / l : 0.f;
                    bf16_t* op = O + TOKROW(rb) * 1024 + head * 64 + 4 * g4;
#pragma unroll
                    for (int dt = 0; dt < 4; ++dt) { const u32x2 pv = *(const u32x2*)(op + 16 * dt); f32x4 v = ss[rb].o[dt] * sc1;
                        v[0] += __uint_as_float(pv.x << 16); v[1] += __uint_as_float(pv.x & 0xffff0000u); v[2] += __uint_as_float(pv.y << 16); v[3] += __uint_as_float(pv.y & 0xffff0000u);
                        u32x2 w; w.x = cvt_pk_bf16(v[0], v[1]); w.y = cvt_pk_bf16(v[2], v[3]); *(u32x2*)(op + 16 * dt) = w; } }
            }
            {
                AttnRow sw[2];
#pragma unroll
                for (int rb = 0; rb < 2; ++rb) { sw[rb].m = 0.f; sw[rb].ol = (f32x4){0.f, 0.f, 0.f, 0.f};
#pragma unroll
                    for (int dt = 0; dt < 4; ++dt) sw[rb].o[dt] = (f32x4){0.f, 0.f, 0.f, 0.f}; }
                const int jt0 = (t0 >= 511) ? ((t0 - 511) >> 6) : 0;
                const int nt_ = cur - jt0 + 1;
                const unsigned full[2] = {0xffffffffu, 0xffffffffu}; const bool both[2] = {true, true};
                bool refmoved = false;
#define WIN_PRE(JJ) const int j = jt0 + (JJ); f32x4 s[2][4]; const bool edge = (j == cur) || (64 * j < t0 + 63 - 511); const int lo2[2] = {trow[0] - 511, trow[1] - 511};
#define WIN_TILE(JJ, SLOT) do { WIN_PRE(JJ) \
                    if (refmoved) { const float cin[2] = {-sw[0].m, -sw[1].m}; attn_qk2(lds + AT4_KB + (SLOT) * 8192, qr, fr, g4, cin, s); } \
                    else attn_qk2z(lds + AT4_KB + (SLOT) * 8192, qr, fr, g4, s); \
                    refmoved |= attn_step2x(lds + AT4_VB + (SLOT) * 8192, s, sw, 64 * j, g4, lo2, trow, both, full, edge, vlane, swz, onesf); } while (0)
#define WIN_TILE_NM(JJ, SLOT) do { WIN_PRE(JJ) attn_qk2z(lds + AT4_KB + (SLOT) * 8192, qr, fr, g4, s); \
                    attn_step2x_nomax(lds + AT4_VB + (SLOT) * 8192, s, sw, 64 * j, g4, lo2, trow, full, edge, vlane, swz, onesf); } while (0)
                AT_DMA(2, jt0, 0); if (nt_ > 1) AT_DMA(2, jt0 + 1, 1); __syncthreads();
#define WIN_LOOP(TILE) for (int j0 = 0; j0 < nt_; j0 += 2) { const int sb = (j0 & 2); \
                    if (j0 + 2 < nt_) AT_DMA(2, jt0 + j0 + 2, sb ^ 2); \
                    if (j0 + 3 < nt_) AT_DMA(2, jt0 + j0 + 3, (sb ^ 2) + 1); \
                    TILE(j0, sb); if (j0 + 1 < nt_) TILE(j0 + 1, sb + 1); \
                    __syncthreads(); }
                if (nomax_win) { WIN_LOOP(WIN_TILE_NM) } else { WIN_LOOP(WIN_TILE) }
#undef WIN_LOOP
#undef WIN_TILE_NM
#undef WIN_PRE
#undef WIN_TILE
                TROW_PIN();
#pragma unroll
                for (int rb = 0; rb < 2; ++rb) { const float l = __shfl(sw[rb].ol[0], fr); const float sc2 = (l > 0.f) ? GATE(rb, 2) / l : 0.f;
                    bf16_t* op = O + TOKROW(rb) * 1024 + head * 64 + 4 * g4;
                    unsigned char* o8 = (unsigned char*)(a.ws + WS_O8) + TOKROW(rb) * 1024 + head * 64 + 4 * g4;
#pragma unroll
                    for (int dt = 0; dt < 4; ++dt) { const u32x2 pv = *(const u32x2*)(op + 16 * dt); f32x4 v = sw[rb].o[dt] * sc2;
                        v[0] += __uint_as_float(pv.x << 16); v[1] += __uint_as_float(pv.x & 0xffff0000u); v[2] += __uint_as_float(pv.y << 16); v[3] += __uint_as_float(pv.y & 0xffff0000u);
                        *(unsigned*)(o8 + 16 * dt) = pk4_fp8(clamp8(v[0] * X8_SCALE), clamp8(v[1] * X8_SCALE), clamp8(v[2] * X8_SCALE), clamp8(v[3] * X8_SCALE)); } }
            }
#undef AT_DMA
#undef ATK
#undef ATV
#undef TROW_PIN
#undef TOKROW
#undef GATE
            {
                const int npr = half ? pr + (int)gridDim.x : pr, nhalf = half ^ 1;
                cmp_pref = npr < 1024;
                if (cmp_pref) { const int nbg = npr >> 6, npp = attn_pair_of(npr), ncc = nhalf ? (127 - npp) : npp;
                    const int nnct = (((ncc * 64 + 63 - 31) / 16 + 1) + 63) >> 6;
                    const bf16_t* nk = KC + (size_t)nbg * 512 * 64;
                    __builtin_amdgcn_global_load_lds((const unsigned*)(nk + ksrc), (LAS unsigned*)(lds + AT4_KB + wave * 1024), 16, 0, 0);
                    __builtin_amdgcn_global_load_lds((const unsigned*)(nk + (size_t)8192 * 64 + vsrc), (LAS unsigned*)(lds + AT4_VB + wave * 1024), 16, 0, 0);
                    if (nnct > 1) {
                        __builtin_amdgcn_global_load_lds((const unsigned*)(nk + 4096 + ksrc), (LAS unsigned*)(lds + AT4_KB + 8192 + wave * 1024), 16, 0, 0);
                        __builtin_amdgcn_global_load_lds((const unsigned*)(nk + (size_t)8192 * 64 + 4096 + vsrc), (LAS unsigned*)(lds + AT4_VB + 8192 + wave * 1024), 16, 0, 0); } } }
            cvt1_run(a, cvt_next, cvt_stride, 2, cvt_scr, lane);
        }
    }
    cvt1_run(a, cvt_next, cvt_stride, 1 << 20, cvt_scr, lane);
}

__device__ __forceinline__ void unpack8(const u32x4 w, float (&f)[8]) {
    f[0] = __uint_as_float(w.x << 16); f[1] = __uint_as_float(w.x & 0xffff0000u); f[2] = __uint_as_float(w.y << 16); f[3] = __uint_as_float(w.y & 0xffff0000u);
    f[4] = __uint_as_float(w.z << 16); f[5] = __uint_as_float(w.z & 0xffff0000u); f[6] = __uint_as_float(w.w << 16); f[7] = __uint_as_float(w.w & 0xffff0000u);
}
__device__ __forceinline__ void ph_convpool_fast(const Args& a, LAS unsigned char* lds) {
    const bf16_t* H0 = (const bf16_t*)(a.ws + WS_H0);
    bf16_t* CAT = (bf16_t*)(a.ws + WS_CAT);
    const float* cw = a.in[4]; const float* cb = a.in[5]; const float* lg = a.in[6]; const float* lb = a.in[7];
    const int tid = threadIdx.x, lane = tid & 63, wave = tid >> 6, ch = lane * 8;
    constexpr int VT_OFF = 0, UT_OFF = 62 * 1024, CW_OFF = UT_OFF + 47 * 1024;
    for (int i = tid; i < 31 * 64; i += 512) { const int k = i >> 6, c8 = (i & 63) * 8;
        const f32x4 w0 = *(const f32x4*)(cw + k * 512 + c8), w1 = *(const f32x4*)(cw + k * 512 + c8 + 4);
        u32x4 o; o.x = pk2(w0[0], w0[1]); o.y = pk2(w0[2], w0[3]); o.z = pk2(w1[0], w1[1]); o.w = pk2(w1[2], w1[3]);
        *(LAS u32x4*)(lds + CW_OFF + k * 1024 + c8 * 2) = o; }
    float bias[8], gam[8], bet[8];
#pragma unroll
    for (int j = 0; j < 8; ++j) { bias[j] = cb[ch + j]; gam[j] = lg[ch + j]; bet[j] = lb[ch + j]; }
    for (int tile = blockIdx.x; tile < M / 32; tile += gridDim.x) {
        const int tok0 = tile * 32, t0 = tok0 & (T - 1);
        __syncthreads();
        for (int i = tid; i < 62 * 64; i += 512) { const int r = i >> 6, c8 = (i & 63) * 8; const int tt = t0 - 30 + r;
            u32x4 v = (u32x4){0u, 0u, 0u, 0u}; if (tt >= 0) v = *(const u32x4*)(H0 + (size_t)(tok0 - 30 + r) * 1024 + 512 + c8);
            *(LAS u32x4*)(lds + VT_OFF + r * 1024 + c8 * 2) = v; }
        for (int i = tid; i < 47 * 64; i += 512) { const int r = i >> 6, c8 = (i & 63) * 8; const int tt = t0 - 15 + r;
            u32x4 v = (u32x4){0u, 0u, 0u, 0u}; if (tt >= 0) v = *(const u32x4*)(H0 + (size_t)(tok0 - 15 + r) * 1024 + c8);
            *(LAS u32x4*)(lds + UT_OFF + r * 1024 + c8 * 2) = v; }
        __syncthreads();
        float acc[4][8];
#pragma unroll
        for (int j = 0; j < 4; ++j)
#pragma unroll
            for (int c = 0; c < 8; ++c) acc[j][c] = bias[c];
#pragma unroll 1
        for (int k = 0; k < 31; ++k) {
            float w[8]; unpack8(*(const LAS u32x4*)(lds + CW_OFF + k * 1024 + ch * 2), w);
#pragma unroll
            for (int j = 0; j < 4; ++j) { float v[8]; unpack8(*(const LAS u32x4*)(lds + VT_OFF + (4 * wave + j + k) * 1024 + ch * 2), v);
#pragma unroll
                for (int c = 0; c < 8; ++c) acc[j][c] += w[c] * v[c]; }
        }
        const int wnd = 2 << (lane >> 4);
#pragma unroll
        for (int j = 0; j < 4; ++j) {
            const int tl = 4 * wave + j, t = t0 + tl; const size_t tok = (size_t)tok0 + tl;
            const int cnt = (t + 1 < wnd) ? (t + 1) : wnd;
            float s[8], self[8];
            unpack8(*(const LAS u32x4*)(lds + UT_OFF + (15 + tl) * 1024 + ch * 2), self);
#pragma unroll
            for (int c = 0; c < 8; ++c) s[c] = self[c];
            for (int k = 1; k < cnt; ++k) { float v[8]; unpack8(*(const LAS u32x4*)(lds + UT_OFF + (15 + tl - k) * 1024 + ch * 2), v);
#pragma unroll
                for (int c = 0; c < 8; ++c) s[c] += v[c]; }
            const float inv = 1.0f / (float)cnt;
            u32x4 o; o.x = pk2(s[0] * inv - self[0], s[1] * inv - self[1]); o.y = pk2(s[2] * inv - self[2], s[3] * inv - self[3]);
            o.z = pk2(s[4] * inv - self[4], s[5] * inv - self[5]); o.w = pk2(s[6] * inv - self[6], s[7] * inv - self[7]);
            *(u32x4*)(CAT + tok * 1024 + ch) = o;
            float sm = 0.f;
#pragma unroll
            for (int c = 0; c < 8; ++c) sm += acc[j][c];
            const float mean = wave_sum(sm) * (1.0f / 512.0f);
            float sq = 0.f;
#pragma unroll
            for (int c = 0; c < 8; ++c) { acc[j][c] -= mean; sq += acc[j][c] * acc[j][c]; }
            const float rstd = rsqrtf(wave_sum(sq) * (1.0f / 512.0f) + LN_EPS);
            float y[8];
#pragma unroll
            for (int c = 0; c < 8; ++c) { const float z = acc[j][c] * rstd * gam[c] + bet[c]; y[c] = z * sigmoidf_(z); }
            u32x4 o2; o2.x = pk2(y[0], y[1]); o2.y = pk2(y[2], y[3]); o2.z = pk2(y[4], y[5]); o2.w = pk2(y[6], y[7]);
            *(u32x4*)(CAT + tok * 1024 + 512 + ch) = o2;
        }
    }
}


#define RT_DPPI(x, ctrl) __builtin_amdgcn_update_dpp((int)(x), (int)(x), (ctrl), 0xF, 0xF, true)
#define RT_DPPF(x, ctrl) __builtin_bit_cast(float, __builtin_amdgcn_update_dpp(__builtin_bit_cast(int, (float)(x)), __builtin_bit_cast(int, (float)(x)), (ctrl), 0xF, 0xF, true))
#define RT_LANEI(x, l) __builtin_amdgcn_readlane((int)(x), (l))
#define RT_LANEF(x, l) __builtin_bit_cast(float, __builtin_amdgcn_readlane(__builtin_bit_cast(int, (float)(x)), (l)))
__device__ __forceinline__ int RT_KEY(float x) { const int b = __builtin_bit_cast(int, x); return b ^ ((b >> 31) & 0x7fffffff); }
__device__ __forceinline__ void ph_route_fast(const float* LOG, const float* bias, unsigned* gcnt, int2* list, unsigned char* ldsg) {
    unsigned* hist = (unsigned*)ldsg; unsigned* base = hist + 256; u32x2* sel = (u32x2*)(ldsg + 2048);
    const int tid = threadIdx.x, lane = tid & 63, wave = tid >> 6;
    const float NEG = -INFINITY;
    const float4 bb = *(const float4*)(bias + lane * 4);
    for (int chunk = blockIdx.x; chunk < M / 128; chunk += gridDim.x) {
        __syncthreads();
        if (tid < 256) hist[tid] = 0u;
        __syncthreads();
        float4 lgn = *(const float4*)(LOG + (size_t)(chunk * 128 + wave * 16) * 256 + lane * 4);
        for (int i = 0; i < 16; ++i) {
            const int tl = wave * 16 + i, tok = chunk * 128 + tl;
            const float4 lg = lgn;
            if (i + 1 < 16) lgn = *(const float4*)(LOG + (size_t)(tok + 1) * 256 + lane * 4);
            const float s0 = sigmoidf_(lg.x), s1 = sigmoidf_(lg.y), s2 = sigmoidf_(lg.z), s3 = sigmoidf_(lg.w);
            const float v0 = s0 + bb.x + 0.0f, v1 = s1 + bb.y + 0.0f, v2 = s2 + bb.z + 0.0f, v3 = s3 + bb.w + 0.0f;
            float m1 = fmaxf(v0, v1), m2 = fminf(v0, v1);
            { const float hi = fmaxf(v2, v3), lo = fminf(v2, v3); const float n1 = fmaxf(m1, hi); const float n2 = fmaxf(fminf(m1, hi), fmaxf(m2, lo)); m1 = n1; m2 = n2; }
#define RT_STEP(ctrl) { const float a1 = RT_DPPF(m1, ctrl), a2 = RT_DPPF(m2, ctrl); const float n1 = fmaxf(m1, a1), n2 = fmaxf(fminf(m1, a1), fmaxf(m2, a2)); m1 = n1; m2 = n2; }
            RT_STEP(0xB1) RT_STEP(0x4E) RT_STEP(0x141)
#undef RT_STEP
            const float gs = m1 + m2; const int mygrp = lane >> 3;
            int rank = 0;
#pragma unroll
            for (int g2 = 0; g2 < 8; ++g2) { const float og = RT_LANEF(gs, g2 * 8); rank += (og > gs || (og == gs && g2 < mygrp)) ? 1 : 0; }
            const bool dead = rank >= 4;
            constexpr int KMIN = (int)0x80000000;
            int k0 = dead ? KMIN : RT_KEY(v0), k1 = dead ? KMIN : RT_KEY(v1), k2 = dead ? KMIN : RT_KEY(v2), k3 = dead ? KMIN : RT_KEY(v3);
            int my_e = 0; float my_s = 0.f;
#pragma unroll
            for (int it = 0; it < 8; ++it) {
                int lm = max(max(k0, k1), max(k2, k3));
                lm = max(lm, RT_DPPI(lm, 0xB1)); lm = max(lm, RT_DPPI(lm, 0x4E)); lm = max(lm, RT_DPPI(lm, 0x141)); lm = max(lm, RT_DPPI(lm, 0x140));
                const int gmax = max(max(RT_LANEI(lm, 0), RT_LANEI(lm, 16)), max(RT_LANEI(lm, 32), RT_LANEI(lm, 48)));
                int cand = (k0 == gmax) ? lane * 4 : (k1 == gmax) ? lane * 4 + 1 : (k2 == gmax) ? lane * 4 + 2 : (k3 == gmax) ? lane * 4 + 3 : 0x7fffffff;
                cand = min(cand, RT_DPPI(cand, 0xB1)); cand = min(cand, RT_DPPI(cand, 0x4E)); cand = min(cand, RT_DPPI(cand, 0x141)); cand = min(cand, RT_DPPI(cand, 0x140));
                const int bi = min(min(RT_LANEI(cand, 0), RT_LANEI(cand, 16)), min(RT_LANEI(cand, 32), RT_LANEI(cand, 48)));
                const int jj = bi & 3, ol = bi >> 2;
                const float mys = (jj == 0) ? s0 : (jj == 1) ? s1 : (jj == 2) ? s2 : s3;
                const float wsc = RT_LANEF(mys, ol);
                const bool me = (lane == ol);
                k0 = (me && jj == 0) ? KMIN : k0; k1 = (me && jj == 1) ? KMIN : k1; k2 = (me && jj == 2) ? KMIN : k2; k3 = (me && jj == 3) ? KMIN : k3;
                if (lane == it) { my_e = bi; my_s = wsc; }
            }
            const float ssum = wave_sum(lane < 8 ? my_s : 0.f);
            if (lane < 8) { const unsigned rk = atomicAdd(&hist[my_e], 1u); u32x2 en; en.x = (unsigned)my_e | (rk << 16); en.y = __float_as_uint(my_s / ssum * 2.5f); sel[tl * 8 + lane] = en; }
        }
        __syncthreads();
        if (tid < 256) { const unsigned h = hist[tid]; base[tid] = h ? atomicAdd(&gcnt[tid], h) : 0u; }
        __syncthreads();
#pragma unroll
        for (int rep = 0; rep < 2; ++rep) { const int idx = tid + rep * 512, tok = chunk * 128 + (idx >> 3), k = idx & 7;
            const u32x2 en = sel[idx]; const unsigned e = en.x & 0xffffu, pos = base[e] + (en.x >> 16);
            list[(size_t)e * LISTCAP + pos] = make_int2(tok * 10 + k, (int)en.y); }
    }
}

__global__ void __launch_bounds__(512, 2) fwd_kernel(Args a) {
    extern __shared__ __attribute__((aligned(16))) unsigned char lds[];
    volatile LAS unsigned* MISC = (volatile LAS unsigned*)((LAS unsigned char*)lds + (LDS_BYTES - 64));
    if (threadIdx.x < 16) MISC[threadIdx.x] = 0u;
    __syncthreads();
    unsigned* ctl = (unsigned*)(a.ws + WS_CTL);
#if MK_ONE_LAUNCH
    (void)xcd_barrier_post(ctl + CW_BAR, MISC + 8);
#define SEAM() do { XcdBarrier b_; b_.bar = (unsigned*)(a.ws + WS_CTL) + CW_BAR; b_.x = xb_xcc_id(); b_.st = MISC + 8; xcd_barrier(b_); } while (0)
#else
#define SEAM() do {} while (0)
#endif
    const int lo = a.ph_lo, hi = a.ph_hi;
#define IN(k) (lo <= (k) && (k) < hi)
#define BOTH(k) (IN(k) && (k) + 1 < hi)
#define X1 ((bf16_t*)(a.ws + WS_X1))
#define X2 ((bf16_t*)(a.ws + WS_X2))
#define LOG ((float*)(a.ws + WS_LOG))

    LAS unsigned char* L = (LAS unsigned char*)lds;
#define LIST ((int2*)(a.ws + WS_LIST))
#ifndef PROBE_DUP_MASK
#define PROBE_DUP_MASK 0u
#endif
#define RUN(k, ...) if (IN(k)) { { __VA_ARGS__ } if ((PROBE_DUP_MASK >> (k)) & 1u) { __syncthreads(); { __VA_ARGS__ } } if (BOTH(k)) SEAM(); }
    RUN(0, ph_prologue(a, L);)
    RUN(1, pg8::DenseSched S; S.init((const bf16_t*)(a.ws + WS_XA), D, (const bf16_t*)(a.ws + WS_WIN0), D, M, 1536);
           EpiInproj0 E{(bf16_t*)(a.ws + WS_H0)};
           pg8::gemm_phase<EpiInproj0, pg8::DenseSched, true>(L, D, 128u, S, E);)
    RUN(2, ph_convpool_fast(a, L);)
    RUN(4, pg8::DenseSched S; S.init((const bf16_t*)(a.ws + WS_CAT), D, (const bf16_t*)(a.ws + WS_WOUT0), D, M, D);
           EpiRes E{a.in[0], nullptr, (bf16_t*)(a.ws + WS_Y), 1.0f};
           pg8::gemm_phase<EpiRes, pg8::DenseSched, true>(L, D, 128u, S, E);)
    RUN(5, ph_ln((const bf16_t*)(a.ws + WS_Y), a.in[17], a.in[18], X1, (unsigned char*)(a.ws + WS_X8));)
#define MOE_LAYER(P, LAYER, XIN, XOUT, OUTF) \
    RUN(P, pg8::DenseSched S; S.init(XIN, D, (const bf16_t*)(a.ws + WS_WR) + (size_t)(LAYER) * NE * D, D, M, NE); \
           EpiLogits E{LOG}; pg8::gemm_phase<EpiLogits, pg8::DenseSched, true>(L, D, 128u, S, E);) \
    if (IN(P + 1)) { ph_route_fast(LOG, a.in[22] + (LAYER) * NE, ctl + CW_CNT + (LAYER) * 256, LIST, lds); if (BOTH(P + 1)) SEAM(); } \
    RUN(P + 2, const int R = moe_setup256(ctl + CW_CNT + (LAYER) * 256, L); \
            MoeGuSched S{(const char*)(a.ws + WS_X8), (const char*)(a.ws + WS_WGU) + (size_t)(LAYER) * 257 * 512 * 1024, LIST, L, R, (R + 128) * 2, (int)gridDim.x, (int)blockIdx.x}; \
            S.prepare(); EpiGateUp E{(unsigned char*)(a.ws + WS_HID)}; pg8::gemm_phase<EpiGateUp, MoeGuSched, true, true>(L, D / 2, 128u, S, E);) \
    RUN(P + 3, const int R = moe_setup256(ctl + CW_CNT + (LAYER) * 256, L); \
            MoeDownSched S{(const char*)(a.ws + WS_HID), (const char*)(a.ws + WS_WD) + (size_t)(LAYER) * 257 * 1024 * 256, LIST, L, R, R + 128, (int)gridDim.x, (int)blockIdx.x}; \
            S.prepare(); EpiDown E{(unsigned char*)(a.ws + WS_YB), L}; pg8::gemm_phase<EpiDown, MoeDownSched, true, true>(L, FF / 2, 128u, S, E);) \
    RUN(P + 4, ph_combine(a, XIN, a.in[19] + (LAYER) * D, a.in[20] + (LAYER) * D, XOUT, OUTF);)
    MOE_LAYER(6, 0, X1, X2, nullptr)
    RUN(11, pg8::DenseSched S; S.init(X2, D, (const bf16_t*)(a.ws + WS_WINN), D, M, HNW);
            EpiInprojN E{(bf16_t*)(a.ws + WS_HN), (bf16_t*)(a.ws + WS_QR), (bf16_t*)(a.ws + WS_KV6), (float*)(a.ws + WS_GATES), (const float*)(a.ws + WS_MISC) + 1024};
            pg8::gemm_phase<EpiInprojN, pg8::DenseSched, true>(L, D, 128u, S, E);)
    RUN(13, Cmp1Sched S{(const char*)(a.ws + WS_KV6), (const char*)(a.ws + WS_CW1), (int)gridDim.x, (int)blockIdx.x};
            EpiCmp1 E{(bf16_t*)(a.ws + WS_CH1), (const float*)(a.ws + WS_MISC)};
            pg8::gemm_phase<EpiCmp1, Cmp1Sched, true>(L, 2048, 128u, S, E); ph_knorm(a);)
    RUN(14, ph_cmp2(a, lds);)
    RUN(15, ph_attn_fast2(a, L);)
    RUN(16, pg8::DenseSched S; S.init((const bf16_t*)(a.ws + WS_O8), D / 2, (const bf16_t*)(a.ws + WS_WOUTN), D / 2, M, D);
            EpiRes E{nullptr, X2, (bf16_t*)(a.ws + WS_Y2), 1.0f / (X8_SCALE * W8_SCALE)};
            pg8::gemm_phase<EpiRes, pg8::DenseSched, true, true>(L, D / 2, 128u, S, E);)
    RUN(17, ph_ln((const bf16_t*)(a.ws + WS_Y2), a.in[17] + D, a.in[18] + D, X1, (unsigned char*)(a.ws + WS_X8));)
    MOE_LAYER(18, 1, X1, (bf16_t*)nullptr, a.out)
}

extern "C" void kernel_launch(void* const* d_in, const int* in_sizes, int n_in, void* d_out, int out_size, void* d_ws, size_t ws_size, hipStream_t stream) {
    static int grid = 0;
    if (grid == 0) {
        if (n_in != 29 || out_size != M * D || ws_size < WS_END) { fprintf(stderr, "kernel_launch: unexpected problem (n_in %d out %d ws %zu)\n", n_in, out_size, ws_size); grid = -1; return; }
        int dev = 0, cus = 0;
        if (hipGetDevice(&dev) != hipSuccess || hipDeviceGetAttribute(&cus, hipDeviceAttributeMultiprocessorCount, dev) != hipSuccess) { grid = -1; return; }
        if (hipFuncSetAttribute((const void*)fwd_kernel, hipFuncAttributeMaxDynamicSharedMemorySize, LDS_BYTES) != hipSuccess) { grid = -1; return; }
        int per_cu = 0;
        (void)hipOccupancyMaxActiveBlocksPerMultiprocessor(&per_cu, (const void*)fwd_kernel, 512, LDS_BYTES);
        (void)hipGetLastError();
        grid = cus;
    }
    if (grid < 0) return;
    (void)hipMemsetAsync((char*)d_ws + WS_CTL, 0, CTL_BYTES, stream);
    Args a{};
    for (int i = 0; i < 29; ++i) a.in[i] = (const float*)d_in[i];
    a.out = (float*)d_out; a.ws = (unsigned char*)d_ws;
    for (int i = 0; i < 8; ++i) a.inv_freq[i] = powf(500000.0f, -(float)(2 * i) / 16.0f);
#if MK_ONE_LAUNCH
    a.ph_lo = 0; a.ph_hi = NPHASE;
    hipLaunchKernelGGL(fwd_kernel, dim3(grid), dim3(512), LDS_BYTES, stream, a);
#else
    for (int p = 0; p < NPHASE; ++p) { a.ph_lo = p; a.ph_hi = p + 1; hipLaunchKernelGGL(fwd_kernel, dim3(grid), dim3(512), LDS_BYTES, stream, a); }
#endif
}
```

```cpp
#include <hip/hip_runtime.h>
#include <cstdint>
#include <cstdio>
#include <cmath>

#ifndef MK_ONE_LAUNCH
#define MK_ONE_LAUNCH 1
#endif

#define LAS __attribute__((address_space(3)))
typedef unsigned short bf16_t;
typedef short bf16x8 __attribute__((ext_vector_type(8)));
typedef float f32x4 __attribute__((ext_vector_type(4)));
typedef unsigned u32x2 __attribute__((ext_vector_type(2)));
typedef unsigned u32x4 __attribute__((ext_vector_type(4)));

constexpr int NB = 4, T = 8192, D = 1024, M = NB * T;
constexpr int NE = 256, TOPK = 8, FF = 256;
constexpr int HNW = 2816;
constexpr int LISTCAP = 32768;
constexpr float ALPHA = 1.4142135623730951f;
constexpr float LN_EPS = 1e-5f;
constexpr float QSCALE = 0.125f * 1.4426950408889634f;
constexpr int YB_NSLOT = 9;
constexpr float YB_SCALE = 16.0f;
constexpr int NPHASE = 23;

constexpr size_t MiB = 1u << 20;
constexpr size_t WS_CTL = 0, CTL_BYTES = 1 * MiB;
constexpr size_t WS_X1 = 1 * MiB;
constexpr size_t WS_X2 = WS_X1 + 64 * MiB;
constexpr size_t WS_LOG = WS_X2 + 64 * MiB;
constexpr size_t WS_LIST = WS_LOG + 32 * MiB;
constexpr size_t WS_WTS = WS_LIST + 64 * MiB;
constexpr size_t WS_HID = WS_WTS + 2 * MiB;
constexpr size_t WS_YB = WS_HID + 184 * MiB;
constexpr size_t WS_END_NAIVE = WS_YB + 576 * MiB;
constexpr size_t WS_WIN0 = WS_END_NAIVE;
constexpr size_t WS_WOUT0 = WS_WIN0 + 3 * MiB;
constexpr size_t WS_WINN = WS_WOUT0 + 2 * MiB;
constexpr size_t WS_WOUTN = WS_WINN + 6 * MiB;
constexpr size_t WS_WR = WS_WOUTN + 2 * MiB;
constexpr size_t WS_CW1 = WS_WR + 1 * MiB;
constexpr size_t WS_MISC = WS_CW1 + 2 * MiB;
constexpr size_t WS_WGU = WS_MISC + 1 * MiB;
constexpr size_t WS_X8 = WS_WGU + 257 * MiB;
constexpr size_t WS_O8 = WS_X8 + 32 * MiB;
constexpr float X8_SCALE = 8.0f, W8_SCALE = 64.0f, H8_SCALE = 16.0f;
constexpr size_t WS_WD = WS_WGU + 514 * MiB;
constexpr size_t WS_END = WS_WD + 257 * MiB;
constexpr size_t WS_XA = WS_X2;
constexpr size_t WS_H0 = WS_YB;
constexpr size_t WS_PM = WS_H0 + 64 * MiB;
constexpr size_t WS_CAT = WS_PM + 32 * MiB;
constexpr size_t WS_Y = WS_CAT + 64 * MiB;
constexpr size_t WS_HN = WS_YB;
constexpr size_t WS_KV6 = WS_HN + 64 * MiB;
constexpr size_t WS_QR = WS_HN + 176 * MiB;
constexpr size_t WS_GATES = WS_QR + 64 * MiB;
constexpr size_t WS_CH1 = WS_GATES + 8 * MiB;
constexpr size_t WS_KC = WS_CH1 + 4 * MiB;
constexpr size_t WS_O = WS_KC + 2 * MiB;
constexpr size_t WS_Y2 = WS_O + 64 * MiB;
static_assert(WS_Y2 + 64 * MiB <= WS_END_NAIVE, "overlay");
static_assert(WS_Y + 64 * MiB <= WS_END_NAIVE, "overlay");

constexpr int CW_CNT = 64;
constexpr int CW_BAR = 4096;

constexpr int LDS_BYTES = 163840;

__device__ __forceinline__ float bf2f(bf16_t h) { return __uint_as_float(((unsigned)h) << 16); }
__device__ __forceinline__ bf16_t f2bf(float f) { unsigned u = __float_as_uint(f); return (bf16_t)((u + 0x7fffu + ((u >> 16) & 1u)) >> 16); }
__device__ __forceinline__ unsigned pk2(float lo, float hi) { return (unsigned)f2bf(lo) | ((unsigned)f2bf(hi) << 16); }
#define WR_DPP(x, ctrl) __builtin_bit_cast(float, __builtin_amdgcn_update_dpp(__builtin_bit_cast(int, (float)(x)), __builtin_bit_cast(int, (float)(x)), (ctrl), 0xF, 0xF, true))
#define WR_ROW(x, r) __builtin_bit_cast(float, __builtin_amdgcn_readlane(__builtin_bit_cast(int, (float)(x)), 16 * (r)))
__device__ __forceinline__ float wave_sum(float v) {
    v += WR_DPP(v, 0xB1); v += WR_DPP(v, 0x4E); v += WR_DPP(v, 0x141); v += WR_DPP(v, 0x140);
    return (WR_ROW(v, 0) + WR_ROW(v, 1)) + (WR_ROW(v, 2) + WR_ROW(v, 3));
}
__device__ __forceinline__ float wave_max(float v) {
    v = fmaxf(v, WR_DPP(v, 0xB1)); v = fmaxf(v, WR_DPP(v, 0x4E)); v = fmaxf(v, WR_DPP(v, 0x141)); v = fmaxf(v, WR_DPP(v, 0x140));
    return fmaxf(fmaxf(WR_ROW(v, 0), WR_ROW(v, 1)), fmaxf(WR_ROW(v, 2), WR_ROW(v, 3)));
}
__device__ __forceinline__ float sigmoidf_(float x) { return 1.0f / (1.0f + __expf(-x)); }
__device__ __forceinline__ float gelu_tanh(float x) {
    const float u = 0.7978845608028654f * (x + 0.044715f * x * x * x);
    const float e = __expf(2.0f * u);
    const float th = 1.0f - 2.0f / (e + 1.0f);
    return 0.5f * x * (1.0f + th);
}
__device__ __forceinline__ bf16x8 cvt8(const float* p) {
    const float4 a = *(const float4*)p, b = *(const float4*)(p + 4);
    bf16x8 r;
    r[0] = (short)f2bf(a.x); r[1] = (short)f2bf(a.y); r[2] = (short)f2bf(a.z); r[3] = (short)f2bf(a.w);
    r[4] = (short)f2bf(b.x); r[5] = (short)f2bf(b.y); r[6] = (short)f2bf(b.z); r[7] = (short)f2bf(b.w);
    return r;
}
__device__ __forceinline__ bf16x8 colk8(const float* W, int N, int k, int col) {
    bf16x8 r;
#pragma unroll
    for (int j = 0; j < 8; ++j) r[j] = (short)f2bf(W[(size_t)(k + j) * N + col]);
    return r;
}
__device__ __forceinline__ bf16x8 zero8() { return (bf16x8){0, 0, 0, 0, 0, 0, 0, 0}; }
#define WSYNC() asm volatile("s_waitcnt lgkmcnt(0)" ::: "memory")

#define XB_TMO      128
#define XB_XCNT(j)  (256  + 64 * (j))
#define XB_XSUB(j)  (1280 + 64 * (j))
#define XB_XGEN(j)  (2304 + 64 * (j))
#define XB_TOP      3328
#define XB_TOPGEN   3392
#define XCD_BAR_WORDS 3456
#define XB_SPIN_CAP (1u << 22)
__device__ __forceinline__ unsigned xb_ld(unsigned* p)              { return __hip_atomic_load(p, __ATOMIC_RELAXED, __HIP_MEMORY_SCOPE_AGENT); }
__device__ __forceinline__ unsigned xb_add(unsigned* p, unsigned v) { return __hip_atomic_fetch_add(p, v, __ATOMIC_RELAXED, __HIP_MEMORY_SCOPE_AGENT); }
__device__ __forceinline__ unsigned xb_xcc_id() { return (unsigned)__builtin_amdgcn_s_getreg((3 << 11) | 20) & 0xFu; }
#define XB_SPIN(cond, bar) do { unsigned _sp = 0; while (cond) { __builtin_amdgcn_s_sleep(1); \
    if ((++_sp & 255u) == 0u) { if (xb_ld(&(bar)[XB_TMO])) break; if (_sp > XB_SPIN_CAP) { atomicAdd(&(bar)[XB_TMO], 1u); break; } } } } while (0)
struct XcdBarrier { unsigned* bar; unsigned x; volatile LAS unsigned* st; };
__device__ __forceinline__ XcdBarrier xcd_barrier_post(unsigned* bar, volatile LAS unsigned* st) {
    XcdBarrier b; b.bar = bar; b.x = xb_xcc_id(); b.st = st;
    if (threadIdx.x == 0) (void)xb_add(&bar[XB_XCNT(b.x)], 1u);
    return b;
}
__device__ __forceinline__ void xcd_barrier_complete(unsigned* bar, unsigned x, unsigned& nloc, unsigned& nx) {
    const unsigned G = gridDim.x * gridDim.y * gridDim.z;
    unsigned sum, cnt, mine, sp = 0u;
    for (;;) {
        sum = 0u; cnt = 0u; mine = 0u;
#pragma unroll
        for (unsigned j = 0; j < 16; ++j) { const unsigned c = xb_ld(&bar[XB_XCNT(j)]); sum += c; cnt += (c > 0u) ? 1u : 0u; mine = (j == x) ? c : mine; }
        if (sum == G) break;
        __builtin_amdgcn_s_sleep(1);
        if ((++sp & 255u) == 0u) { if (xb_ld(&bar[XB_TMO])) break; if (sp > XB_SPIN_CAP) { atomicAdd(&bar[XB_TMO], 1u); break; } }
    }
    nloc = mine > 0u ? mine : 1u; nx = cnt > 0u ? cnt : 1u;
}
__device__ __forceinline__ void xcd_barrier(const XcdBarrier& b) {
    asm volatile("s_waitcnt vmcnt(0)" ::: "memory");
    __syncthreads();
    if (threadIdx.x == 0) {
        unsigned* bar = b.bar;
        __builtin_amdgcn_s_waitcnt(0);
        unsigned nloc = b.st[0], nx = b.st[1];
        if (nloc == 0u) { xcd_barrier_complete(bar, b.x, nloc, nx); b.st[0] = nloc; b.st[1] = nx; }
        const unsigned old = xb_add(&bar[XB_XSUB(b.x)], 1u);
        const unsigned gen = old / nloc;
        if (old + 1u == (gen + 1u) * nloc) {
            __builtin_amdgcn_fence(__ATOMIC_RELEASE, "agent");
            asm volatile("s_waitcnt vmcnt(0)" ::: "memory");
            const unsigned og = xb_add(&bar[XB_TOP], 1u);
            const unsigned tg = og / nx;
            if (og + 1u == (tg + 1u) * nx) xb_add(&bar[XB_TOPGEN], 1u);
            else XB_SPIN(xb_ld(&bar[XB_TOPGEN]) == tg, bar);
            __builtin_amdgcn_fence(__ATOMIC_ACQUIRE, "agent");
            xb_add(&bar[XB_XGEN(b.x)], 1u);
            asm volatile("s_waitcnt vmcnt(0)" ::: "memory");
        } else {
            XB_SPIN(xb_ld(&bar[XB_XGEN(b.x)]) == gen, bar);
            __builtin_amdgcn_fence(__ATOMIC_ACQUIRE, "agent");
            asm volatile("s_waitcnt vmcnt(0)" ::: "memory");
        }
    }
    __syncthreads();
}

template <class AL, class BL, class EP>
__device__ __forceinline__ void mgemm_tile(unsigned char* lds, int K, const AL& al, const BL& bl, const EP& ep) {
    bf16_t* As = (bf16_t*)lds;
    bf16_t* Bs = As + 128 * 40;
    const int tid = threadIdx.x, lane = tid & 63, wave = tid >> 6;
    const int ar = tid >> 2, ac = (tid & 3) * 8;
    const int bn = tid & 127, bc = (tid >> 7) * 8;
    f32x4 acc[8];
#pragma unroll
    for (int s = 0; s < 8; ++s) acc[s] = (f32x4){0.f, 0.f, 0.f, 0.f};
    bf16x8 ra = al(ac), rb = bl(bc);
    for (int k0 = 0; k0 < K; k0 += 32) {
        __syncthreads();
        *(bf16x8*)(As + ar * 40 + ac) = ra;
        *(bf16x8*)(Bs + bn * 40 + bc) = rb;
        __syncthreads();
        if (k0 + 32 < K) { ra = al(k0 + 32 + ac); rb = bl(k0 + 32 + bc); }
        const bf16x8 af = *(const bf16x8*)(As + (wave * 16 + (lane & 15)) * 40 + (lane >> 4) * 8);
#pragma unroll
        for (int s = 0; s < 8; ++s) {
            const bf16x8 wf = *(const bf16x8*)(Bs + (16 * s + (lane & 15)) * 40 + (lane >> 4) * 8);
            acc[s] = __builtin_amdgcn_mfma_f32_16x16x32_bf16(wf, af, acc[s], 0, 0, 0);
        }
    }
    ep(wave * 16 + (lane & 15), (lane >> 4) * 4, acc);
}
__device__ __forceinline__ void store4bf(bf16_t* p, const f32x4 v) { u32x2 w; w.x = pk2(v[0], v[1]); w.y = pk2(v[2], v[3]); *(u32x2*)p = w; }

struct Args {
    const float* in[29];
    float* out;
    unsigned char* ws;
    float inv_freq[8];
    int ph_lo, ph_hi;
};

__device__ __forceinline__ unsigned pk4_fp8(float a, float b, float c, float d) { int w = __builtin_amdgcn_cvt_pk_fp8_f32(a, b, 0, false); return (unsigned)__builtin_amdgcn_cvt_pk_fp8_f32(c, d, w, true); }
__device__ __forceinline__ u32x2 pack8_fp8(const f32x4 v0, const f32x4 v1) {
    int a = __builtin_amdgcn_cvt_pk_fp8_f32(v0[0], v0[1], 0, false); a = __builtin_amdgcn_cvt_pk_fp8_f32(v0[2], v0[3], a, true);
    int b = __builtin_amdgcn_cvt_pk_fp8_f32(v1[0], v1[1], 0, false); b = __builtin_amdgcn_cvt_pk_fp8_f32(v1[2], v1[3], b, true);
    u32x2 w; w.x = (unsigned)a; w.y = (unsigned)b; return w;
}
__device__ __forceinline__ float clamp8(float v) { return __builtin_amdgcn_fmed3f(v, -448.0f, 448.0f); }
__device__ __forceinline__ void ph_ln(const bf16_t* Y, const float* g, const float* b, bf16_t* X, unsigned char* X8) {
    const int lane = threadIdx.x & 63, wave = threadIdx.x >> 6;
    const int gw = blockIdx.x * 8 + wave, ngw = gridDim.x * 8;
    float gg[16], bb[16];
#pragma unroll
    for (int j = 0; j < 8; ++j) { gg[j] = g[lane * 8 + j]; gg[8 + j] = g[512 + lane * 8 + j]; bb[j] = b[lane * 8 + j]; bb[8 + j] = b[512 + lane * 8 + j]; }
    for (int row0 = gw * 4; row0 < M; row0 += ngw * 4) {
        bf16x8 p0[4], p1[4];
#pragma unroll
        for (int r = 0; r < 4; ++r) { p0[r] = __builtin_nontemporal_load((const bf16x8*)(Y + (size_t)(row0 + r) * 1024 + lane * 8)); p1[r] = __builtin_nontemporal_load((const bf16x8*)(Y + (size_t)(row0 + r) * 1024 + 512 + lane * 8)); }
#pragma unroll
        for (int r = 0; r < 4; ++r) {
            float v[16];
#pragma unroll
            for (int j = 0; j < 8; ++j) { v[j] = bf2f((bf16_t)p0[r][j]); v[8 + j] = bf2f((bf16_t)p1[r][j]); }
            float s = 0.f;
#pragma unroll
            for (int j = 0; j < 16; ++j) s += v[j];
            const float mean = wave_sum(s) * (1.0f / 1024.0f);
            float q = 0.f;
#pragma unroll
            for (int j = 0; j < 16; ++j) { v[j] -= mean; q += v[j] * v[j]; }
            const float rstd = rsqrtf(wave_sum(q) * (1.0f / 1024.0f) + LN_EPS);
            float o[16];
#pragma unroll
            for (int j = 0; j < 16; ++j) o[j] = v[j] * rstd * gg[j] + bb[j];
            u32x4 w0, w1;
            w0.x = pk2(o[0], o[1]); w0.y = pk2(o[2], o[3]); w0.z = pk2(o[4], o[5]); w0.w = pk2(o[6], o[7]);
            w1.x = pk2(o[8], o[9]); w1.y = pk2(o[10], o[11]); w1.z = pk2(o[12], o[13]); w1.w = pk2(o[14], o[15]);
            *(u32x4*)(X + (size_t)(row0 + r) * 1024 + lane * 8) = w0; *(u32x4*)(X + (size_t)(row0 + r) * 1024 + 512 + lane * 8) = w1;
#pragma unroll
            for (int j = 0; j < 16; ++j) o[j] = clamp8(o[j] * X8_SCALE);
            u32x2 q0, q1; q0.x = pk4_fp8(o[0], o[1], o[2], o[3]); q0.y = pk4_fp8(o[4], o[5], o[6], o[7]); q1.x = pk4_fp8(o[8], o[9], o[10], o[11]); q1.y = pk4_fp8(o[12], o[13], o[14], o[15]);
            *(u32x2*)(X8 + (size_t)(row0 + r) * 1024 + lane * 8) = q0; *(u32x2*)(X8 + (size_t)(row0 + r) * 1024 + 512 + lane * 8) = q1;
        }
    }
}

__device__ __forceinline__ void ph_combine(const Args& a, const bf16_t* X, const float* g, const float* b, bf16_t* Xo, float* outf) {
    const unsigned char* YB = (const unsigned char*)(a.ws + WS_YB);
    const int lane = threadIdx.x & 63, wave = threadIdx.x >> 6;
    const int gw = blockIdx.x * 8 + wave, ngw = gridDim.x * 8;
    for (int row = gw; row < M; row += ngw) {
        float v[16];
#pragma unroll
        for (int j = 0; j < 16; ++j) v[j] = 0.f;
        u32x2 q0[YB_NSLOT], q1[YB_NSLOT];
#pragma unroll
        for (int k = 0; k < YB_NSLOT; ++k) { const unsigned char* yr = YB + ((size_t)row * 10 + k) * 1024; q0[k] = __builtin_nontemporal_load((const u32x2*)(yr + lane * 8)); q1[k] = __builtin_nontemporal_load((const u32x2*)(yr + 512 + lane * 8)); }
#pragma unroll
        for (int k = 0; k < YB_NSLOT; ++k) {
            const auto a0 = __builtin_amdgcn_cvt_pk_f32_fp8((int)q0[k].x, false), a1 = __builtin_amdgcn_cvt_pk_f32_fp8((int)q0[k].x, true), a2 = __builtin_amdgcn_cvt_pk_f32_fp8((int)q0[k].y, false), a3 = __builtin_amdgcn_cvt_pk_f32_fp8((int)q0[k].y, true);
            const auto b0 = __builtin_amdgcn_cvt_pk_f32_fp8((int)q1[k].x, false), b1 = __builtin_amdgcn_cvt_pk_f32_fp8((int)q1[k].x, true), b2 = __builtin_amdgcn_cvt_pk_f32_fp8((int)q1[k].y, false), b3 = __builtin_amdgcn_cvt_pk_f32_fp8((int)q1[k].y, true);
            v[0] += a0[0]; v[1] += a0[1]; v[2] += a1[0]; v[3] += a1[1]; v[4] += a2[0]; v[5] += a2[1]; v[6] += a3[0]; v[7] += a3[1];
            v[8] += b0[0]; v[9] += b0[1]; v[10] += b1[0]; v[11] += b1[1]; v[12] += b2[0]; v[13] += b2[1]; v[14] += b3[0]; v[15] += b3[1];
        }
        {
            const bf16x8 p0 = *(const bf16x8*)(X + (size_t)row * 1024 + lane * 8), p1 = *(const bf16x8*)(X + (size_t)row * 1024 + 512 + lane * 8);
#pragma unroll
            for (int j = 0; j < 8; ++j) { v[j] = v[j] * (1.0f / YB_SCALE) + ALPHA * bf2f((bf16_t)p0[j]); v[8 + j] = v[8 + j] * (1.0f / YB_SCALE) + ALPHA * bf2f((bf16_t)p1[j]); }
        }
        float s = 0.f;
#pragma unroll
        for (int j = 0; j < 16; ++j) s += v[j];
        const float mean = wave_sum(s) * (1.0f / 1024.0f);
        float q = 0.f;
#pragma unroll
        for (int j = 0; j < 16; ++j) { v[j] -= mean; q += v[j] * v[j]; }
        const float rstd = rsqrtf(wave_sum(q) * (1.0f / 1024.0f) + LN_EPS);
        float o[16];
#pragma unroll
        for (int j = 0; j < 8; ++j) { o[j] = v[j] * rstd * g[lane * 8 + j] + b[lane * 8 + j]; o[8 + j] = v[8 + j] * rstd * g[512 + lane * 8 + j] + b[512 + lane * 8 + j]; }
        if (outf) {
            float* op = outf + (size_t)row * 1024;
            *(float4*)(op + lane * 8) = make_float4(o[0], o[1], o[2], o[3]); *(float4*)(op + lane * 8 + 4) = make_float4(o[4], o[5], o[6], o[7]);
            *(float4*)(op + 512 + lane * 8) = make_float4(o[8], o[9], o[10], o[11]); *(float4*)(op + 512 + lane * 8 + 4) = make_float4(o[12], o[13], o[14], o[15]);
        } else {
            u32x4 w0, w1;
            w0.x = pk2(o[0], o[1]); w0.y = pk2(o[2], o[3]); w0.z = pk2(o[4], o[5]); w0.w = pk2(o[6], o[7]);
            w1.x = pk2(o[8], o[9]); w1.y = pk2(o[10], o[11]); w1.z = pk2(o[12], o[13]); w1.w = pk2(o[14], o[15]);
            *(u32x4*)(Xo + (size_t)row * 1024 + lane * 8) = w0; *(u32x4*)(Xo + (size_t)row * 1024 + 512 + lane * 8) = w1;
        }
    }
}

__device__ __forceinline__ void ph_cmp2(const Args& a, unsigned char* lds) {
    const bf16_t* CH1 = (const bf16_t*)(a.ws + WS_CH1);
    bf16_t* KC = (bf16_t*)(a.ws + WS_KC);
    const int tid = threadIdx.x;
    for (int u = blockIdx.x; u < 64 * 2; u += gridDim.x) {
        const int rt = u >> 1, kv = u & 1;
        const bf16_t* ar = CH1 + ((size_t)kv * 8192 + rt * 128 + (tid >> 2)) * 128;
        const float* w2 = a.in[kv ? 15 : 12];
        const int col = tid & 127;
        auto al = [&](int k) { return *(const bf16x8*)(ar + k); };
        auto bl = [&](int k) { return (col < 64) ? colk8(w2, 64, k, col) : zero8(); };
        auto ep = [&](int r, int cb, const f32x4 (&acc)[8]) {
            bf16_t* o = KC + ((size_t)kv * 8192 + rt * 128 + r) * 64;
#pragma unroll
            for (int s = 0; s < 4; ++s) store4bf(o + 16 * s + cb, acc[s]);
        };
        mgemm_tile(lds, 128, al, bl, ep);
    }
}

namespace pg8 {
constexpr int BM = 256, BK = 64, HALF = 128, HTB = HALF * BK * 2, STAGE_BYTES = 8 * HTB;
__device__ __forceinline__ int lds_byte(int r, int c) { const int st = (r >> 4) * 2 + (c >> 5), rr = r & 15, cc = c & 31, ob = rr * 64 + cc * 2; return st * 1024 + (ob ^ (((ob >> 9) & 1) << 5)); }
__device__ __forceinline__ void stage_rc(int b, int& R, int& C) { const int st = b / 1024, sb = b % 1024, swz = sb ^ (((sb >> 9) & 1) << 5); R = (st >> 1) * 16 + swz / 64; C = (st & 1) * 32 + (swz % 64) / 2; }
__device__ __forceinline__ int perm32(int rho) { const int n = rho >> 4, i = rho & 15; return 8 * (i >> 2) + 4 * n + (i & 3); }
struct Unit { int pm, pn, ord; };
typedef float f32x16 __attribute__((ext_vector_type(16)));
typedef int i32x8 __attribute__((ext_vector_type(8))); typedef int i32x4_ __attribute__((ext_vector_type(4)));
__device__ __forceinline__ i32x8 f8cat(const bf16x8 lo, const bf16x8 hi) { return __builtin_shufflevector(__builtin_bit_cast(i32x4_, lo), __builtin_bit_cast(i32x4_, hi), 0, 1, 2, 3, 4, 5, 6, 7); }
template <class Epi, class Sched, bool ALIGN_EPI, bool F8 = false>
__device__ __forceinline__ void gemm_phase(LAS unsigned char* lds, const int K, const unsigned kstepA, const Sched& S, const Epi& E) {
    const int tid = threadIdx.x, wid = __builtin_amdgcn_readfirstlane(tid >> 6), lane = tid & 63, wr = wid >> 2, wc = wid & 3, fr = lane & 15, fq = lane >> 4;
    const int nt = K / BK;
    constexpr bool GA = Sched::GATHER;
    int RA[2]; unsigned CA2[2], voffB[2], voffB1[2], voffA[2];
    constexpr bool P16 = Epi::PERM16;
#pragma unroll
    for (int i = 0; i < 2; ++i) { int R, C; stage_rc(tid * 16 + i * 8192, R, C); const int Rb = Epi::PERM ? ((R & ~31) + perm32(R & 31)) : R;
        RA[i] = R; CA2[i] = (unsigned)C * 2u; voffB[i] = (unsigned)(Rb * K + C) * 2u; voffA[i] = GA ? 0u : (S.lane_off(R) + (unsigned)C * 2u);
        if (P16) { const int c16 = 64 * (R >> 5) + 16 * ((R >> 2) & 3) + 4 * ((R >> 4) & 1) + (R & 3); voffB[i] = (unsigned)(c16 * K + C) * 2u; voffB1[i] = (unsigned)((c16 + 8) * K + C) * 2u; } else voffB1[i] = 0u; }
    const size_t kstepB = (size_t)(BK * 2);
    const size_t hstepB = (size_t)HALF * K * 2;
    const unsigned ldsw = (unsigned)wid * 1024u;
    const int aoff = lds_byte(wr * 64 + fr, fq * 8), boff = lds_byte(wc * 32 + fr, fq * 8);
    const char* const Ab = S.abase();
    unsigned aoC[2][2], aoN[2][2];
    unsigned uC[2], uN[2];
#define PG8_SA(b, h) (((b) * 2 + (h)) * HTB)
#define PG8_SB(b, h) ((4 + (b) * 2 + (h)) * HTB)
#define PG8_GLDS(sbase, voff, ldsoff) do { const char* _b = (const char*)(sbase); unsigned _v = (voff); asm volatile("" : "+s"(_b), "+v"(_v)); \
        __builtin_amdgcn_global_load_lds((const unsigned*)(_b + _v), (LAS unsigned*)(lds + (ldsoff)), 16, 0, 0); } while (0)
#define PG8_STAGE_B(bufoff, gbase) do { _Pragma("unroll") for (int _i = 0; _i < 2; ++_i) PG8_GLDS(gbase, voffB[_i], (bufoff) + ldsw + _i * 8192); } while (0)
#define PG8_STAGE_B1(bufoff, gbase) do { _Pragma("unroll") for (int _i = 0; _i < 2; ++_i) PG8_GLDS((const char*)(gbase) + (P16 ? (size_t)0 : hstepB), (P16 ? voffB1[_i] : voffB[_i]), (bufoff) + ldsw + _i * 8192); } while (0)
#define PG8_STAGE_A(bufoff, kb, UO, LO) do { _Pragma("unroll") for (int _i = 0; _i < 2; ++_i) PG8_GLDS(Ab + (size_t)((kb) + (UO)), (GA ? (LO)[_i] : voffA[_i]), (bufoff) + ldsw + _i * 8192); } while (0)
#define PG8_LDA(dst, b, h) do { _Pragma("unroll") for (int m = 0; m < 4; ++m) _Pragma("unroll") for (int k = 0; k < 2; ++k) dst[m][k] = *(const LAS bf16x8*)(lds + PG8_SA(b, h) + aoff + m * 2048 + k * 1024); } while (0)
#define PG8_LDB(dst, b, h) do { _Pragma("unroll") for (int n = 0; n < 2; ++n) _Pragma("unroll") for (int k = 0; k < 2; ++k) dst[n][k] = *(const LAS bf16x8*)(lds + PG8_SB(b, h) + boff + n * 2048 + k * 1024); } while (0)
#define PG8_MMA(ai, bj, At, Bt) do { __builtin_amdgcn_s_setprio(1); _Pragma("unroll") for (int m = 0; m < 4; ++m) _Pragma("unroll") for (int n = 0; n < 2; ++n) { \
        if constexpr (F8) { f32x16& _w = accw[ai][bj][m >> 1]; const int _q = ((m & 1) * 2 + n) * 4; f32x4 _c = {_w[_q], _w[_q + 1], _w[_q + 2], _w[_q + 3]}; \
            _c = __builtin_amdgcn_mfma_scale_f32_16x16x128_f8f6f4(f8cat(Bt[n][0], Bt[n][1]), f8cat(At[m][0], At[m][1]), _c, 0, 0, 0, 0, 0, 0); _w[_q] = _c[0]; _w[_q + 1] = _c[1]; _w[_q + 2] = _c[2]; _w[_q + 3] = _c[3]; } \
        else { _Pragma("unroll") for (int k = 0; k < 2; ++k) acc[ai][bj][m][n] = __builtin_amdgcn_mfma_f32_16x16x32_bf16(Bt[n][k], At[m][k], acc[ai][bj][m][n], 0, 0, 0); } } __builtin_amdgcn_s_setprio(0); } while (0)
#define PG8_WAIT_V(n) asm volatile("s_waitcnt vmcnt(" #n ")" ::: "memory")
#define PG8_WAIT_L(n) asm volatile("s_waitcnt lgkmcnt(" #n ")" ::: "memory")
#define PG8_BAR __builtin_amdgcn_s_barrier()
#define PG8_SCHED __builtin_amdgcn_sched_barrier(0)
#define PG8_KPAIR(KB1, KB2, KB3, BP2, BP3) do { \
            PG8_LDB(B0, 0, 0); PG8_LDB(B1, 0, 1); PG8_SCHED; PG8_LDA(At, 0, 0); PG8_STAGE_A(PG8_SA(1, 1), KB1, uC[1], aoC[1]); \
            PG8_WAIT_V(8); PG8_WAIT_L(0); PG8_BAR; PG8_MMA(0, 0, At, B0); PG8_MMA(0, 1, At, B1); PG8_BAR; PG8_SCHED; \
            PG8_LDA(At, 0, 1); PG8_STAGE_B(PG8_SB(0, 0), BP2); PG8_STAGE_B1(PG8_SB(0, 1), BP2); PG8_STAGE_A(PG8_SA(0, 0), KB2, u2[0], a2o[0]); \
            PG8_WAIT_V(8); PG8_WAIT_L(0); PG8_BAR; PG8_MMA(1, 0, At, B0); PG8_MMA(1, 1, At, B1); PG8_BAR; PG8_SCHED; \
            PG8_LDB(B0, 1, 0); PG8_LDB(B1, 1, 1); PG8_SCHED; PG8_LDA(At, 1, 0); PG8_STAGE_A(PG8_SA(0, 1), KB2, u2[1], a2o[1]); \
            PG8_WAIT_V(8); PG8_WAIT_L(0); PG8_BAR; PG8_MMA(0, 0, At, B0); PG8_MMA(0, 1, At, B1); PG8_BAR; PG8_SCHED; \
            PG8_LDA(At, 1, 1); PG8_STAGE_B(PG8_SB(1, 0), BP3); PG8_STAGE_B1(PG8_SB(1, 1), BP3); PG8_STAGE_A(PG8_SA(1, 0), KB3, u2[0], a2o[0]); \
            PG8_WAIT_V(8); PG8_WAIT_L(0); PG8_BAR; PG8_MMA(1, 0, At, B0); PG8_MMA(1, 1, At, B1); PG8_BAR; PG8_SCHED; } while (0)
    Unit cur, nxt; int ui = 0;
    if (!S.next(0, cur)) return;
    f32x4 acc[2][2][4][2];
#pragma unroll
    for (int a = 0; a < 2; ++a)
#pragma unroll
        for (int b = 0; b < 2; ++b)
#pragma unroll
            for (int m = 0; m < 4; ++m)
#pragma unroll
                for (int n = 0; n < 2; ++n) acc[a][b][m][n] = (f32x4){0.f, 0.f, 0.f, 0.f};
    bf16x8 At[4][2], B0[2][2], B1[2][2];
    f32x16 accw[2][2][2];
#define PG8_ZERO_W() do { if constexpr (F8) { _Pragma("unroll") for (int _a = 0; _a < 2; ++_a) _Pragma("unroll") for (int _b = 0; _b < 2; ++_b) _Pragma("unroll") for (int _m = 0; _m < 2; ++_m) _Pragma("unroll") for (int _e = 0; _e < 16; ++_e) accw[_a][_b][_m][_e] = 0.f; } } while (0)
    PG8_ZERO_W();
#pragma unroll
    for (int h = 0; h < 2; ++h) { uC[h] = GA ? 0u : S.unit_off(cur, h); uN[h] = uC[h];
#pragma unroll
        for (int i = 0; i < 2; ++i) { aoC[h][i] = GA ? (S.aoff(cur, h * HALF + RA[i]) + CA2[i]) : 0u; aoN[h][i] = aoC[h][i]; } }
    const char* cB = S.bptr(cur);
    PG8_STAGE_B(PG8_SB(0, 0), cB); PG8_STAGE_B1(PG8_SB(0, 1), cB); PG8_STAGE_A(PG8_SA(0, 0), 0u, uC[0], aoC[0]); PG8_STAGE_A(PG8_SA(0, 1), 0u, uC[1], aoC[1]);
    if (wr == 1) PG8_BAR;
    PG8_WAIT_V(2); PG8_BAR;
    PG8_STAGE_B(PG8_SB(1, 0), cB + kstepB); PG8_STAGE_A(PG8_SA(1, 0), kstepA, uC[0], aoC[0]); PG8_STAGE_B1(PG8_SB(1, 1), cB + kstepB);
    PG8_WAIT_V(6); PG8_BAR;
    for (;;) {
        const bool has_next = S.next(ui + 1, nxt);
        const char* nB = has_next ? S.bptr(nxt) : cB;
#pragma unroll
        for (int h = 0; h < 2; ++h) { uN[h] = (GA || !has_next) ? uC[h] : S.unit_off(nxt, h);
#pragma unroll
            for (int i = 0; i < 2; ++i) aoN[h][i] = (GA && has_next) ? (S.aoff(nxt, h * HALF + RA[i]) + CA2[i]) : aoC[h][i]; }
#pragma nounroll
        for (int t = 0; t < nt; t += 2) {
            const bool last = (t == nt - 2);
            const unsigned kb1 = (unsigned)(t + 1) * kstepA, kb2 = last ? 0u : (unsigned)(t + 2) * kstepA, kb3 = kb2 + kstepA;
            const char* b2 = last ? nB : cB + (size_t)(t + 2) * kstepB; const char* b3 = b2 + kstepB;
            unsigned u2[2], a2o[2][2];
#pragma unroll
            for (int h = 0; h < 2; ++h) { u2[h] = last ? uN[h] : uC[h];
#pragma unroll
                for (int i = 0; i < 2; ++i) a2o[h][i] = GA ? (last ? aoN[h][i] : aoC[h][i]) : 0u; }
            PG8_KPAIR(kb1, kb2, kb3, b2, b3);
        }
        if constexpr (ALIGN_EPI) { if (wr == 0) PG8_BAR; }
        if constexpr (F8) {
#pragma unroll
            for (int _a = 0; _a < 2; ++_a)
#pragma unroll
                for (int _b = 0; _b < 2; ++_b)
#pragma unroll
                    for (int _m = 0; _m < 4; ++_m)
#pragma unroll
                        for (int _n = 0; _n < 2; ++_n) { const f32x16& _w = accw[_a][_b][_m >> 1]; const int _q = ((_m & 1) * 2 + _n) * 4; acc[_a][_b][_m][_n] = (f32x4){_w[_q], _w[_q + 1], _w[_q + 2], _w[_q + 3]}; }
        }
        E(acc, cur, wr, wc, fr, fq);
        PG8_ZERO_W();
        if (!has_next) break;
#pragma unroll
        for (int a = 0; a < 2; ++a)
#pragma unroll
            for (int b = 0; b < 2; ++b)
#pragma unroll
                for (int m = 0; m < 4; ++m)
#pragma unroll
                    for (int n = 0; n < 2; ++n) acc[a][b][m][n] = (f32x4){0.f, 0.f, 0.f, 0.f};
        cur = nxt; cB = nB; ++ui;
#pragma unroll
        for (int h = 0; h < 2; ++h) { uC[h] = uN[h];
#pragma unroll
            for (int i = 0; i < 2; ++i) aoC[h][i] = aoN[h][i]; }
        if constexpr (ALIGN_EPI) { if (wr == 1) PG8_BAR; }
    }
    PG8_WAIT_V(0);
    if constexpr (!ALIGN_EPI) { if (wr == 0) PG8_BAR; }
    PG8_BAR;
#undef PG8_SA
#undef PG8_ZERO_W
#undef PG8_GLDS
#undef PG8_SB
#undef PG8_STAGE_A
#undef PG8_STAGE_B
#undef PG8_STAGE_B1
#undef PG8_LDA
#undef PG8_LDB
#undef PG8_MMA
#undef PG8_WAIT_V
#undef PG8_WAIT_L
#undef PG8_BAR
#undef PG8_SCHED
#undef PG8_KPAIR
}

struct DenseSched {
    const char* A; const char* Bt; unsigned lda2; size_t btile; int nM, nN, nwg, G, c;
    __device__ __forceinline__ void init(const bf16_t* A_, int lda, const bf16_t* Bt_, int K, int Mrows, int N) {
        A = (const char*)A_; Bt = (const char*)Bt_; lda2 = (unsigned)lda * 2u; btile = (size_t)256 * K * 2; nM = Mrows / BM; nN = N / BM; nwg = nM * nN; G = gridDim.x; c = blockIdx.x; }
    __device__ __forceinline__ bool next(int i, Unit& u) const {
        const long L = (long)i * G + c; if (L >= nwg) return false;
        int wgid = (int)L; { const int q = nwg / 8, r = nwg % 8, xcd = wgid % 8, off = wgid / 8; wgid = (xcd < r ? xcd * (q + 1) : r * (q + 1) + (xcd - r) * q) + off; }
        const int nig = 8 * nN, gid = wgid / nig, fm = gid * 8, gsz = (nM - fm) < 8 ? (nM - fm) : 8;
        u.pm = fm + ((wgid % nig) % gsz); u.pn = (wgid % nig) / gsz; u.ord = i; return true;
    }
    static constexpr bool GATHER = false;
    __device__ __forceinline__ unsigned lane_off(int r) const { return (unsigned)r * lda2; }
    __device__ __forceinline__ unsigned unit_off(const Unit& u, int h) const { return (unsigned)(u.pm * BM + h * HALF) * lda2; }
    __device__ __forceinline__ unsigned aoff(const Unit&, int) const { return 0u; }
    __device__ __forceinline__ const char* abase() const { return A; }
    __device__ __forceinline__ const char* bptr(const Unit& u) const { return Bt + (size_t)u.pn * btile; }
};
}
typedef float f32x2_t __attribute__((ext_vector_type(2))); typedef __bf16 bf16x2_t __attribute__((ext_vector_type(2)));
__device__ __forceinline__ unsigned cvt_pk_bf16(float lo, float hi) { const f32x2_t v = {lo, hi}; const bf16x2_t b = __builtin_convertvector(v, bf16x2_t); return __builtin_bit_cast(unsigned, b); }
__device__ __forceinline__ u32x4 pack8(const f32x4 v0, const f32x4 v1) { u32x4 w; w.x = cvt_pk_bf16(v0[0], v0[1]); w.y = cvt_pk_bf16(v0[2], v0[3]); w.z = cvt_pk_bf16(v1[0], v1[1]); w.w = cvt_pk_bf16(v1[2], v1[3]); return w; }
__device__ __forceinline__ unsigned cvtpk_m(float lo, float hi) { const f32x2_t v = {lo, hi}; const bf16x2_t b = __builtin_convertvector(v, bf16x2_t); return __builtin_bit_cast(unsigned, b); }
__device__ __forceinline__ u32x4 pack8m(const f32x4 v0, const f32x4 v1) { u32x4 w; w.x = cvtpk_m(v0[0], v0[1]); w.y = cvtpk_m(v0[2], v0[3]); w.z = cvtpk_m(v1[0], v1[1]); w.w = cvtpk_m(v1[2], v1[3]); return w; }
#define MFMA_SETTLE(S) asm volatile("s_nop 15\n\ts_nop 7" : "+v"(S[0][0]), "+v"(S[0][1]), "+v"(S[0][2]), "+v"(S[0][3]), "+v"(S[1][0]), "+v"(S[1][1]), "+v"(S[1][2]), "+v"(S[1][3]))
__device__ __forceinline__ f32x4 sig4(const f32x4 v) { f32x4 r; r[0] = sigmoidf_(v[0]); r[1] = sigmoidf_(v[1]); r[2] = sigmoidf_(v[2]); r[3] = sigmoidf_(v[3]); return r; }

#define EPI_ROWLOOP for (int ai = 0; ai < 2; ++ai) _Pragma("unroll") for (int m = 0; m < 4; ++m)
struct EpiInproj0 {
    static constexpr bool PERM = true, PERM16 = false; bf16_t* H0;
    __device__ __forceinline__ void operator()(const f32x4 (&acc)[2][2][4][2], const pg8::Unit& u, int wr, int wc, int fr, int fq) const {
        const int row0 = u.pm * 256 + wr * 64 + fr, cl = wc * 32 + 8 * fq;
#pragma unroll
        EPI_ROWLOOP { bf16_t* rp = H0 + (size_t)(row0 + ai * 128 + m * 16) * 1024;
            if (u.pn < 2) {
#pragma unroll
                for (int bj = 0; bj < 2; ++bj) *(u32x4*)(rp + u.pn * 256 + bj * 128 + cl) = pack8(acc[ai][bj][m][0], acc[ai][bj][m][1]);
            } else {
                const f32x4 v0 = acc[ai][0][m][0] * sig4(acc[ai][1][m][0]), v1 = acc[ai][0][m][1] * sig4(acc[ai][1][m][1]);
                *(u32x4*)(rp + 512 + (u.pn - 2) * 128 + cl) = pack8(v0, v1);
            } }
    }
};
struct EpiRes {
    static constexpr bool PERM = true, PERM16 = false; const float* resf; const bf16_t* resb; bf16_t* Y; float sc;
    __device__ __forceinline__ void operator()(const f32x4 (&acc)[2][2][4][2], const pg8::Unit& u, int wr, int wc, int fr, int fq) const {
        const int row0 = u.pm * 256 + wr * 64 + fr, c0 = u.pn * 256 + wc * 32 + 8 * fq;
#pragma unroll
        EPI_ROWLOOP { const size_t ro = (size_t)(row0 + ai * 128 + m * 16) * 1024 + c0;
#pragma unroll
            for (int bj = 0; bj < 2; ++bj) {
                f32x4 r0, r1;
                if (resf) { r0 = *(const f32x4*)(resf + ro + bj * 128); r1 = *(const f32x4*)(resf + ro + bj * 128 + 4); }
                else { const u32x4 xv = *(const u32x4*)(resb + ro + bj * 128);
                    r0[0] = __uint_as_float(xv.x << 16); r0[1] = __uint_as_float(xv.x & 0xffff0000u); r0[2] = __uint_as_float(xv.y << 16); r0[3] = __uint_as_float(xv.y & 0xffff0000u);
                    r1[0] = __uint_as_float(xv.z << 16); r1[1] = __uint_as_float(xv.z & 0xffff0000u); r1[2] = __uint_as_float(xv.w << 16); r1[3] = __uint_as_float(xv.w & 0xffff0000u); }
                *(u32x4*)(Y + ro + bj * 128) = pack8(acc[ai][bj][m][0] * sc + r0 * ALPHA, acc[ai][bj][m][1] * sc + r1 * ALPHA);
            } }
    }
};
struct EpiLogits {
    static constexpr bool PERM = true, PERM16 = false; float* LOG;
    __device__ __forceinline__ void operator()(const f32x4 (&acc)[2][2][4][2], const pg8::Unit& u, int wr, int wc, int fr, int fq) const {
        const int row0 = u.pm * 256 + wr * 64 + fr, cl = wc * 32 + 8 * fq;
#pragma unroll
        EPI_ROWLOOP { float* rp = LOG + (size_t)(row0 + ai * 128 + m * 16) * 256 + cl;
#pragma unroll
            for (int bj = 0; bj < 2; ++bj) { *(f32x4*)(rp + bj * 128) = acc[ai][bj][m][0]; *(f32x4*)(rp + bj * 128 + 4) = acc[ai][bj][m][1]; } }
    }
};

constexpr int MOE_TAB_OFF = 131072;
__device__ __forceinline__ int moe_setup256(const unsigned* cnt, LAS unsigned char* lds) {
    LAS int* tstart = (LAS int*)(lds + MOE_TAB_OFF);
    LAS int* scnt = (LAS int*)(lds + MOE_TAB_OFF + 1088);
    LAS unsigned short* texp = (LAS unsigned short*)(lds + MOE_TAB_OFF + 2176);
    const int tid = threadIdx.x;
    __syncthreads();
    const int lane = tid & 63, wave = tid >> 6;
    LAS int* wtot = tstart + 260;
    int c = 0;
    if (tid < 256) { const int n = (int)cnt[tid]; scnt[tid] = n; c = (n + 255) >> 8; }
    int incl = c;
#pragma unroll
    for (int o = 1; o < 64; o <<= 1) { const int t = __shfl_up(incl, o); if (lane >= o) incl += t; }
    if (tid < 256 && lane == 63) wtot[wave] = incl;
    __syncthreads();
    if (tid < 256) { int off = 0;
#pragma unroll
        for (int w = 0; w < 3; ++w) off += (w < wave) ? wtot[w] : 0;
        tstart[tid] = off + incl - c; if (tid == 255) tstart[256] = off + incl; }
    __syncthreads();
    if (tid < 256) for (int q = tstart[tid]; q < tstart[tid + 1]; ++q) texp[q] = (unsigned short)tid;
    __syncthreads();
    return __builtin_amdgcn_readfirstlane(tstart[256]);
}
constexpr int MOE_TOK_OFF = MOE_TAB_OFF + 5120;
constexpr int MOE_MAX_ORD = 20;
struct MoeGuSched {
    static constexpr bool GATHER = true;
    const char* X; const char* W; const int2* list; LAS unsigned char* lds; int R, nunits, G, c;
    __device__ __forceinline__ int vcu() const { return (G % 8 == 0) ? (c % 8) * (G / 8) + c / 8 : c; }
    __device__ __forceinline__ bool next(int i, pg8::Unit& u) const {
        const int L = i * G + vcu(); if (L >= nunits || i >= MOE_MAX_ORD) return false;
        const int q = L >> 1; const int e = __builtin_amdgcn_readfirstlane((q < R) ? (int)((LAS unsigned short*)(lds + MOE_TAB_OFF + 2176))[q] : 256);
        u.pm = q; u.pn = e * 2 + (L & 1); u.ord = i; return true; }
    __device__ __forceinline__ void prepare() const {
        const int tid = threadIdx.x, r = tid & 255;
        pg8::Unit u;
        for (int i = tid >> 8; next(i, u); i += 2) {
            const int e = u.pn >> 1; int token;
            if (e < 256) { const int ts = ((LAS int*)(lds + MOE_TAB_OFF))[e], cn = ((LAS int*)(lds + MOE_TAB_OFF + 1088))[e]; int lr = (u.pm - ts) * 256 + r; if (lr >= cn) lr = cn - 1;
                token = list[(size_t)e * LISTCAP + lr].x / 10; }
            else token = (u.pm - R) * 256 + r;
            ((LAS unsigned short*)(lds + MOE_TOK_OFF))[i * 256 + r] = (unsigned short)token;
        }
        __syncthreads();
    }
    __device__ __forceinline__ unsigned aoff(const pg8::Unit& u, int r) const { return (unsigned)((LAS unsigned short*)(lds + MOE_TOK_OFF))[u.ord * 256 + r] * 1024u; }
    __device__ __forceinline__ unsigned lane_off(int) const { return 0u; }
    __device__ __forceinline__ unsigned unit_off(const pg8::Unit&, int) const { return 0u; }
    __device__ __forceinline__ const char* abase() const { return X; }
    __device__ __forceinline__ const char* bptr(const pg8::Unit& u) const { return W + (size_t)u.pn * (256 * 1024); }
};
constexpr float GU_SC = 1.0f / (X8_SCALE * W8_SCALE);
struct EpiGateUp {
    static constexpr bool PERM = true, PERM16 = false; unsigned char* HID;
    __device__ __forceinline__ void operator()(const f32x4 (&acc)[2][2][4][2], const pg8::Unit& u, int wr, int wc, int fr, int fq) const {
        const int row0 = u.pm * 256 + wr * 64 + fr, c0 = (u.pn & 1) * 128 + wc * 32 + 8 * fq;
#pragma unroll
        EPI_ROWLOOP { const f32x4 g0 = acc[ai][0][m][0] * GU_SC, g1 = acc[ai][0][m][1] * GU_SC;
            f32x4 h0 = g0 * sig4(g0) * (acc[ai][1][m][0] * (GU_SC * H8_SCALE)), h1 = g1 * sig4(g1) * (acc[ai][1][m][1] * (GU_SC * H8_SCALE));
#pragma unroll
            for (int i = 0; i < 4; ++i) { h0[i] = clamp8(h0[i]); h1[i] = clamp8(h1[i]); }
            *(u32x2*)(HID + (size_t)(row0 + ai * 128 + m * 16) * 256 + c0) = pack8_fp8(h0, h1); }
    }
};
constexpr int MOE_RI_OFF = MOE_TAB_OFF + 5120;
constexpr int MOE_MAX_RT = 6;
struct MoeDownSched {
    const char* HID; const char* W; const int2* list; LAS unsigned char* lds; int R, ntile, G, c;
    __device__ __forceinline__ int vcu() const { return (G % 8 == 0) ? (c % 8) * (G / 8) + c / 8 : c; }
    __device__ __forceinline__ bool next(int i, pg8::Unit& u) const {
        const int q = vcu() + G * (i >> 2); if (q >= ntile || (i >> 2) >= MOE_MAX_RT) return false;
        const int e = (q < R) ? (int)((LAS unsigned short*)(lds + MOE_TAB_OFF + 2176))[q] : 256;
        u.pm = q; u.pn = e * 4 + (i & 3); u.ord = i >> 2; return true; }
    __device__ __forceinline__ void prepare() const {
        const int tid = threadIdx.x, r = tid & 255;
        for (int o = tid >> 8; o < MOE_MAX_RT; o += 2) {
            const int q = vcu() + G * o; if (q >= ntile) break;
            u32x2 en;
            if (q < R) { const int e = ((LAS unsigned short*)(lds + MOE_TAB_OFF + 2176))[q]; const int ts = ((LAS int*)(lds + MOE_TAB_OFF))[e], cn = ((LAS int*)(lds + MOE_TAB_OFF + 1088))[e];
                const int lr = (q - ts) * 256 + r; if (lr < cn) { const int2 le = list[(size_t)e * LISTCAP + lr]; en.x = (unsigned)le.x; en.y = (unsigned)le.y; } else { en.x = 0xffffffffu; en.y = 0u; } }
            else { en.x = (unsigned)(((q - R) * 256 + r) * 10 + 8); en.y = __float_as_uint(1.0f); }
            ((LAS u32x2*)(lds + MOE_RI_OFF))[o * 256 + r] = en;
        }
        __syncthreads();
    }
    static constexpr bool GATHER = false;
    __device__ __forceinline__ unsigned lane_off(int r) const { return (unsigned)r * 256u; }
    __device__ __forceinline__ unsigned unit_off(const pg8::Unit& u, int h) const { return (unsigned)(u.pm * 256 + h * 128) * 256u; }
    __device__ __forceinline__ unsigned aoff(const pg8::Unit&, int) const { return 0u; }
    __device__ __forceinline__ const char* abase() const { return HID; }
    __device__ __forceinline__ const char* bptr(const pg8::Unit& u) const { return W + (size_t)u.pn * (256 * 256); }
};
struct EpiDown {
    static constexpr bool PERM = true, PERM16 = true;
    unsigned char* YB; LAS unsigned char* lds;
    __device__ __forceinline__ void operator()(const f32x4 (&acc)[2][2][4][2], const pg8::Unit& u, int wr, int wc, int fr, int fq) const {
        asm volatile("" : "+v"(fr), "+v"(fq));
        const unsigned c0b = (unsigned)((u.pn & 3) * 256 + wc * 64 + 16 * fq); const bool shared = (u.pn >> 2) == 256;
        const LAS u32x2* ri = (const LAS u32x2*)(lds + MOE_RI_OFF) + u.ord * 256 + wr * 64 + fr;
#pragma unroll
        for (int ai = 0; ai < 2; ++ai)
#pragma unroll
            for (int m = 0; m < 4; ++m) { const u32x2 en = ri[ai * 128 + m * 16]; const float wv = __uint_as_float(en.y) * (YB_SCALE / (H8_SCALE * W8_SCALE));
                if ((int)en.x >= 0) { unsigned char* rp = YB + (size_t)(en.x * 1024u + c0b);
                    const f32x4 v00 = acc[ai][0][m][0] * wv, v01 = acc[ai][0][m][1] * wv, v10 = acc[ai][1][m][0] * wv, v11 = acc[ai][1][m][1] * wv;
                    const u32x2 h0 = pack8_fp8(v00, v01), h1 = pack8_fp8(v10, v11);
                    *(u32x4*)rp = (u32x4){h0.x, h0.y, h1.x, h1.y};
                    if (YB_NSLOT == 10 && shared) {
                        u32x2 r_[2];
#pragma unroll
                        for (int bj = 0; bj < 2; ++bj) { const u32x2 h = bj ? h1 : h0; const f32x4 v0 = bj ? v10 : v00, v1 = bj ? v11 : v01;
                            const auto a0 = __builtin_amdgcn_cvt_pk_f32_fp8((int)h.x, false), a1 = __builtin_amdgcn_cvt_pk_f32_fp8((int)h.x, true), a2 = __builtin_amdgcn_cvt_pk_f32_fp8((int)h.y, false), a3 = __builtin_amdgcn_cvt_pk_f32_fp8((int)h.y, true);
                            const f32x4 r0 = {v0[0] - a0[0], v0[1] - a0[1], v0[2] - a1[0], v0[3] - a1[1]}, r1 = {v1[0] - a2[0], v1[1] - a2[1], v1[2] - a3[0], v1[3] - a3[1]};
                            r_[bj] = pack8_fp8(r0, r1); }
                        *(u32x4*)(rp + 1024) = (u32x4){r_[0].x, r_[0].y, r_[1].x, r_[1].y}; } } }
    }
};

struct EpiInprojN {
    static constexpr bool PERM = true, PERM16 = false; bf16_t* QN; bf16_t* QR; bf16_t* KV6; float* GATES; const float* ROT;
    __device__ __forceinline__ void operator()(const f32x4 (&acc)[2][2][4][2], const pg8::Unit& u, int wr, int wc, int fr, int fq) const {
        const int row0 = u.pm * 256 + wr * 64 + fr, cl = wc * 32 + 8 * fq, pn = u.pn;
        const bool isq = pn < 4, rotk = (pn == 6 || pn == 8), dorot = (isq || rotk) && ((wc & 1) == 0);
#pragma unroll
        EPI_ROWLOOP { const int row = row0 + ai * 128 + m * 16;
            if (pn == 10) {
                if (cl < 48) { *(f32x4*)(GATES + (size_t)row * 48 + cl) = sig4(acc[ai][0][m][0]); *(f32x4*)(GATES + (size_t)row * 48 + cl + 4) = sig4(acc[ai][0][m][1]); }
            } else {
                f32x4 cs0, cs1, sn0, sn1;
                if (dorot) { const float* rt = ROT + (size_t)(row & (T - 1)) * 16; cs0 = *(const f32x4*)rt; cs1 = *(const f32x4*)(rt + 4); sn0 = *(const f32x4*)(rt + 8); sn1 = *(const f32x4*)(rt + 12); }
#pragma unroll
                for (int bj = 0; bj < 2; ++bj) {
                    const f32x4 v0 = acc[ai][bj][m][0], v1 = acc[ai][bj][m][1];
                    f32x4 r0 = v0, r1 = v1;
                    if (dorot) {
                        f32x4 p0, p1;
#pragma unroll
                        for (int i = 0; i < 4; ++i) { p0[i] = __shfl_xor(v0[i], 16); p1[i] = __shfl_xor(v1[i], 16); }
                        if (fq == 0) { r0 = v0 * cs0 - p0 * sn0; r1 = v1 * cs1 - p1 * sn1; }
                        else if (fq == 1) { r0 = v0 * cs0 + p0 * sn0; r1 = v1 * cs1 + p1 * sn1; }
                    }
                    if (isq) { const int c = pn * 256 + bj * 128 + cl;
                        *(u32x4*)(QN + (size_t)row * 1024 + c) = pack8(v0 * QSCALE, v1 * QSCALE); *(u32x4*)(QR + (size_t)row * 1024 + c) = pack8(r0 * QSCALE, r1 * QSCALE); }
                    else { const int cc = bj * 128 + cl, g = cc >> 6, d = cc & 63, b = row >> 13, t = row & (T - 1);
                        *(u32x4*)(KV6 + ((size_t)((pn - 4) * 16 + b * 4 + g) * T + t) * 64 + d) = pack8(r0, r1); }
                }
            } }
    }
};

struct Cmp1Sched {
    const char* KV6; const char* W; int G, c;
    static constexpr bool GATHER = false;
    __device__ __forceinline__ bool next(int i, pg8::Unit& u) const { const int L = i * G + c; if (L >= 64) return false; u.pm = L >> 1; u.pn = L & 1; u.ord = i; return true; }
    __device__ __forceinline__ unsigned lane_off(int r) const { return (unsigned)r * 2048u; }
    __device__ __forceinline__ unsigned unit_off(const pg8::Unit& u, int h) const { return (unsigned)u.pn * (unsigned)(16 * T * 64 * 2) + (unsigned)(u.pm * 256 + h * 128) * 2048u; }
    __device__ __forceinline__ unsigned aoff(const pg8::Unit&, int) const { return 0u; }
    __device__ __forceinline__ const char* abase() const { return KV6; }
    __device__ __forceinline__ const char* bptr(const pg8::Unit& u) const { return W + (size_t)u.pn * (256 * 2048 * 2); }
};
struct EpiCmp1 {
    static constexpr bool PERM = true, PERM16 = false; bf16_t* CH1; const float* bias1;
    __device__ __forceinline__ void operator()(const f32x4 (&acc)[2][2][4][2], const pg8::Unit& u, int wr, int wc, int fr, int fq) const {
        const int row0 = u.pm * 256 + wr * 64 + fr, cl = wc * 32 + 8 * fq;
        const f32x4 b0 = *(const f32x4*)(bias1 + u.pn * 128 + cl), b1 = *(const f32x4*)(bias1 + u.pn * 128 + cl + 4);
#pragma unroll
        EPI_ROWLOOP { f32x4 v0 = acc[ai][0][m][0] + b0, v1 = acc[ai][0][m][1] + b1;
#pragma unroll
            for (int i = 0; i < 4; ++i) { v0[i] = gelu_tanh(v0[i]); v1[i] = gelu_tanh(v1[i]); }
            *(u32x4*)(CH1 + ((size_t)u.pn * 8192 + row0 + ai * 128 + m * 16) * 128 + cl) = pack8(v0, v1); }
    }
};

__device__ __forceinline__ void p0_item(const float* W, int K, int N, bf16_t* WT, int kb, int n0, int drow0, LAS float* scr, int lane, bool f8 = false) {
    const int k0 = 64 * kb, n4 = (lane & 15) * 4;
    const bool cok = (n0 + n4) < N;
    f32x4 v[16];
#pragma unroll
    for (int i = 0; i < 16; ++i) { const int kk = 4 * i + (lane >> 4); v[i] = cok ? __builtin_nontemporal_load((const f32x4*)(W + (size_t)(k0 + kk) * N + n0 + n4)) : (f32x4){0.f, 0.f, 0.f, 0.f}; }
#pragma unroll
    for (int i = 0; i < 16; ++i) { const int kk = 4 * i + (lane >> 4); LAS float* d = scr + kk * 65 + n4; d[0] = v[i][0]; d[1] = v[i][1]; d[2] = v[i][2]; d[3] = v[i][3]; }
    asm volatile("s_waitcnt lgkmcnt(0)" ::: "memory");
    if (f8) {
        const int c4 = lane & 3;
#pragma unroll
        for (int j = 0; j < 4; ++j) { const int n = (lane >> 2) + 16 * j; const LAS float* sp = scr + (16 * c4) * 65 + n;
            u32x4 o;
            o.x = pk4_fp8(sp[0 * 65] * W8_SCALE, sp[1 * 65] * W8_SCALE, sp[2 * 65] * W8_SCALE, sp[3 * 65] * W8_SCALE); o.y = pk4_fp8(sp[4 * 65] * W8_SCALE, sp[5 * 65] * W8_SCALE, sp[6 * 65] * W8_SCALE, sp[7 * 65] * W8_SCALE);
            o.z = pk4_fp8(sp[8 * 65] * W8_SCALE, sp[9 * 65] * W8_SCALE, sp[10 * 65] * W8_SCALE, sp[11 * 65] * W8_SCALE); o.w = pk4_fp8(sp[12 * 65] * W8_SCALE, sp[13 * 65] * W8_SCALE, sp[14 * 65] * W8_SCALE, sp[15 * 65] * W8_SCALE);
            if (n0 + n < N) __builtin_nontemporal_store(o, (u32x4*)((unsigned char*)WT + (size_t)(drow0 + n) * K + k0 + 16 * c4)); }
        asm volatile("s_waitcnt lgkmcnt(0)" ::: "memory");
        return;
    }
    const int c = lane & 7;
#pragma unroll
    for (int j = 0; j < 8; ++j) { const int n = (lane >> 3) + 8 * j; const LAS float* sp = scr + (8 * c) * 65 + n;
        u32x4 o; o.x = pk2(sp[0 * 65], sp[1 * 65]); o.y = pk2(sp[2 * 65], sp[3 * 65]); o.z = pk2(sp[4 * 65], sp[5 * 65]); o.w = pk2(sp[6 * 65], sp[7 * 65]);
        if (n0 + n < N) __builtin_nontemporal_store(o, (u32x4*)(WT + (size_t)(drow0 + n) * K + k0 + 8 * c)); }
    asm volatile("s_waitcnt lgkmcnt(0)" ::: "memory");
}
struct CvtItem { const float* W; bf16_t* WT; int K, N, k0, n0, drow0; };
__device__ __forceinline__ void cvt32_load(const CvtItem& it, int lane, f32x4 (&v)[8]) {
    const int n4 = (lane & 7) * 4;
#pragma unroll
    for (int i = 0; i < 8; ++i) { const int kk = 8 * i + (lane >> 3); v[i] = __builtin_nontemporal_load((const f32x4*)(it.W + (size_t)(it.k0 + kk) * it.N + it.n0 + n4)); }
}
__device__ __forceinline__ void cvt32_finish(const CvtItem& it, int lane, const f32x4 (&v)[8], LAS float* scr) {
    const int n4 = (lane & 7) * 4;
#pragma unroll
    for (int i = 0; i < 8; ++i) { const int kk = 8 * i + (lane >> 3); LAS float* d = scr + kk * 33 + n4; d[0] = v[i][0]; d[1] = v[i][1]; d[2] = v[i][2]; d[3] = v[i][3]; }
    asm volatile("s_waitcnt lgkmcnt(0)" ::: "memory");
    const int c = lane & 7;
#pragma unroll
    for (int j = 0; j < 4; ++j) { const int n = (lane >> 3) + 8 * j; const LAS float* sp = scr + (8 * c) * 33 + n;
        const float v0 = sp[0 * 33], v1 = sp[1 * 33], v2 = sp[2 * 33], v3 = sp[3 * 33], v4 = sp[4 * 33], v5 = sp[5 * 33], v6 = sp[6 * 33], v7 = sp[7 * 33];
        u32x2 o; o.x = pk4_fp8(v0 * W8_SCALE, v1 * W8_SCALE, v2 * W8_SCALE, v3 * W8_SCALE); o.y = pk4_fp8(v4 * W8_SCALE, v5 * W8_SCALE, v6 * W8_SCALE, v7 * W8_SCALE);
        __builtin_nontemporal_store(o, (u32x2*)((unsigned char*)it.WT + (size_t)(it.drow0 + n) * it.K + it.k0 + 8 * c)); }
    asm volatile("s_waitcnt lgkmcnt(0)" ::: "memory");
}
constexpr int CVT1_ITEMS = 257 * 384;
__device__ __forceinline__ CvtItem cvt1_item(const Args& a, int idx) {
    const int e = idx / 384, sub = idx % 384, mat = sub >> 7, r = sub & 127;
    CvtItem it;
    if (mat < 2) { it.W = (e < 256) ? a.in[23 + mat] + ((size_t)256 + e) * (size_t)(D * FF) : a.in[26 + mat] + (size_t)(D * FF);
        it.K = D; it.N = FF; it.k0 = (r >> 3) * 64; it.n0 = (r & 7) * 32; it.drow0 = (it.n0 >> 7) * 256 + mat * 128 + (it.n0 & 127);
        it.WT = (bf16_t*)(a.ws + WS_WGU + (size_t)(257 + e) * 512 * 1024); }
    else { it.W = (e < 256) ? a.in[25] + ((size_t)256 + e) * (size_t)(FF * D) : a.in[28] + (size_t)(FF * D);
        it.K = FF; it.N = D; it.k0 = (r >> 5) * 64; it.n0 = (r & 31) * 32; it.drow0 = it.n0;
        it.WT = (bf16_t*)(a.ws + WS_WD + (size_t)(257 + e) * 1024 * 256); }
    return it;
}
__device__ __forceinline__ void cvt1_run(const Args& a, int& next, int stride, int quota, LAS float* scr, int lane) {
#pragma unroll 1
    for (int q = 0; q < quota && next < CVT1_ITEMS; ++q) {
        CvtItem t[4]; f32x4 v[4][8]; bool ok[4];
#pragma unroll
        for (int u = 0; u < 4; ++u) { const int idx = next + u * stride; ok[u] = idx < CVT1_ITEMS; t[u] = cvt1_item(a, ok[u] ? idx : 0); if (ok[u]) cvt32_load(t[u], lane, v[u]); }
        next += 4 * stride;
#pragma unroll
        for (int u = 0; u < 4; ++u) if (ok[u]) cvt32_finish(t[u], lane, v[u], scr);
    }
}
__device__ __forceinline__ void ph_prologue(const Args& a, LAS unsigned char* lds) {
    const int lane = threadIdx.x & 63, wave = threadIdx.x >> 6;
    LAS float* scr = (LAS float*)(lds + wave * 16640);
    const int gw = blockIdx.x * 8 + wave, ngw = gridDim.x * 8;
    for (int it = gw; it < 257 * 192; it += ngw) {
        const int le = it / 192, sub = it % 192, l = 0, e = le, mat = sub >> 6, r = sub & 63;
        if (mat < 2) {
            const float* W = (e < 256) ? a.in[23 + mat] + ((size_t)l * 256 + e) * (size_t)(D * FF) : a.in[26 + mat] + (size_t)l * (D * FF);
            const int kb = r >> 2, n0 = (r & 3) * 64;
            p0_item(W, D, FF, (bf16_t*)(a.ws + WS_WGU + (size_t)le * 512 * 1024), kb, n0, (n0 >> 7) * 256 + mat * 128 + (n0 & 127), scr, lane, true);
        } else {
            const float* W = (e < 256) ? a.in[25] + ((size_t)l * 256 + e) * (size_t)(FF * D) : a.in[28] + (size_t)l * (FF * D);
            const int kb = r >> 4, n0 = (r & 15) * 64;
            p0_item(W, FF, D, (bf16_t*)(a.ws + WS_WD + (size_t)le * 1024 * 256), kb, n0, n0, scr, lane, true);
        }
    }
    {
        for (int itg = gw; itg < 1680; itg += ngw) {
            if (itg < 512) { const int it = itg; const int w = it >> 8, r = it & 255;
                p0_item(a.in[w ? 16 : 8], D, D, (bf16_t*)(a.ws + (w ? WS_WOUTN : WS_WOUT0)), r >> 4, (r & 15) * 64, (r & 15) * 64, scr, lane, w != 0); }
            else if (itg < 1168) { const int it = itg - 512;
                p0_item(a.in[9], D, 2608, (bf16_t*)(a.ws + WS_WINN), it / 41, (it % 41) * 64, (it % 41) * 64, scr, lane); }
            else if (itg < 1296) { const int it = itg - 1168; const int l = it >> 6, r = it & 63;
                p0_item(a.in[21] + (size_t)l * D * NE, D, NE, (bf16_t*)(a.ws + WS_WR) + (size_t)l * NE * D, r >> 2, (r & 3) * 64, (r & 3) * 64, scr, lane); }
            else if (itg < 1552) { const int it = itg - 1296; const int kb = it >> 4, n0 = (8 + (it & 15)) * 64;
                const int isg = (n0 >= 1024) ? 1 : 0, rel = n0 - 512 - isg * 512;
                p0_item(a.in[1], D, 1536, (bf16_t*)(a.ws + WS_WIN0), kb, n0, 512 + (rel >> 7) * 256 + isg * 128 + (rel & 127), scr, lane); }
            else { const int it = itg - 1552; const int kv = it >> 6, r = it & 63;
                p0_item(a.in[kv ? 14 : 11], 2048, 128, (bf16_t*)(a.ws + WS_CW1) + (size_t)kv * 256 * 2048, r >> 1, (r & 1) * 64, (r & 1) * 64, scr, lane); }
        }
    }
    {
        const int gt = blockIdx.x * 512 + threadIdx.x, ngt = gridDim.x * 512;
        const int gtz = (gt >= ngt / 16 * 13) ? gt - ngt / 16 * 13 : gt + ngt - ngt / 16 * 13, gtr = (gt >= ngt / 2) ? gt - ngt / 2 : gt + ngt - ngt / 2;
        const int gwb = (gw >= ngw / 8 * 7) ? gw - ngw / 8 * 7 : gw + ngw - ngw / 8 * 7;
        u32x4* z0 = (u32x4*)((bf16_t*)(a.ws + WS_WINN) + (size_t)2608 * 1024);
        for (int i = gtz; i < 208 * 1024 / 8; i += ngt) z0[i] = (u32x4){0u, 0u, 0u, 0u};
        for (int kv = 0; kv < 2; ++kv) { u32x4* z1 = (u32x4*)((bf16_t*)(a.ws + WS_CW1) + ((size_t)kv * 256 + 128) * 2048);
            for (int i = gtz; i < 128 * 2048 / 8; i += ngt) z1[i] = (u32x4){0u, 0u, 0u, 0u}; }
        const float* x = a.in[0]; bf16_t* XA = (bf16_t*)(a.ws + WS_XA);
        for (size_t i = gt; i < (size_t)M * D / 8; i += ngt) { const f32x4 v0 = *(const f32x4*)(x + i * 8), v1 = *(const f32x4*)(x + i * 8 + 4);
            u32x4 o; o.x = pk2(v0[0], v0[1]); o.y = pk2(v0[2], v0[3]); o.z = pk2(v1[0], v1[1]); o.w = pk2(v1[2], v1[3]); *(u32x4*)(XA + i * 8) = o; }
        const float* win = a.in[1]; const float* mix = a.in[2]; const float* psc = a.in[3]; bf16_t* WIN0 = (bf16_t*)(a.ws + WS_WIN0);
        for (int i = gt; i < 512 * 1024; i += ngt) { const int n = i & 511, k = i >> 9, g = n >> 7, nn = n & 127;
            const float* wr_ = win + (size_t)k * 1536 + g * 128; const float* mx = mix + (size_t)g * 128 * 128 + nn;
            float s = 0.f;
            for (int c = 0; c < 128; ++c) s += wr_[c] * mx[(size_t)c * 128];
            WIN0[(size_t)n * 1024 + k] = f2bf(s * psc[n]); }
        float* misc = (float*)(a.ws + WS_MISC);
        for (int o = gwb; o < 256; o += ngw) { const int kv = o >> 7, j = o & 127; const float* pos = a.in[kv ? 13 : 10]; const float* w1 = a.in[kv ? 14 : 11];
            float s = 0.f;
#pragma unroll 8
            for (int k = lane; k < 2048; k += 64) s += pos[k] * w1[(size_t)k * 128 + j];
            s = wave_sum(s);
            if (lane == 0) misc[o] = s; }
        float* rot = misc + 1024;
        for (int i = gtr; i < T * 8; i += ngt) { const int t = i >> 3, f = i & 7;
            const float ang = (float)t * a.inv_freq[f]; const double rev = (double)ang * 0.15915494309189535; const float fr = (float)(rev - floor(rev));
            rot[t * 16 + f] = __builtin_amdgcn_cosf(fr); rot[t * 16 + 8 + f] = __builtin_amdgcn_sinf(fr); }
    }
}

typedef short v4i16_t __attribute__((ext_vector_type(4)));
constexpr int AT_KB = 0, AT_VB = 16384, AT_PS = 32768, AT_MSK = 32768 + 65536;
#define DPP_I(x, ctrl) __builtin_amdgcn_update_dpp((int)(x), (int)(x), (ctrl), 0xF, 0xF, true)
#define DPP_F(x, ctrl) __builtin_bit_cast(float, __builtin_amdgcn_update_dpp(__builtin_bit_cast(int, (float)(x)), __builtin_bit_cast(int, (float)(x)), (ctrl), 0xF, 0xF, true))
__device__ __forceinline__ bf16x8 tr_frag(LAS unsigned char* p0, LAS unsigned char* p1) {
    const v4i16_t a = __builtin_amdgcn_ds_read_tr16_b64_v4i16((LAS v4i16_t*)p0), b = __builtin_amdgcn_ds_read_tr16_b64_v4i16((LAS v4i16_t*)p1);
    return (bf16x8){a[0], a[1], a[2], a[3], b[0], b[1], b[2], b[3]};
}
constexpr size_t TN2_OFF = 786432;
__device__ __forceinline__ void ph_knorm(const Args& a) {
    const bf16_t* KV6 = (const bf16_t*)(a.ws + WS_KV6);
    float* TN2 = (float*)(a.ws + WS_MISC + TN2_OFF);
    const int lane = threadIdx.x & 63, wave = threadIdx.x >> 6;
    const int first = (gridDim.x > 64) ? 64 : 0;
    if ((int)blockIdx.x < first) return;
    const int wi = ((int)blockIdx.x - first) * 8 + wave, nw = ((int)gridDim.x - first) * 8;
    for (int id = wi; id < 4096; id += nw) {
        const int ty = id >> 11, bg = (id >> 7) & 15, tile = id & 127;
        const bf16_t* rp = KV6 + ((size_t)((ty ? 4 : 2) * 16 + bg) * T + tile * 64 + lane) * 64;
        float ssq = 0.f;
#pragma unroll
        for (int c = 0; c < 8; ++c) { const bf16x8 v = *(const bf16x8*)(rp + 8 * c);
#pragma unroll
            for (int j = 0; j < 8; ++j) { const float f = bf2f((bf16_t)v[j]); ssq += f * f; } }
        ssq = wave_max(ssq);
        if (lane == 0) TN2[id] = ssq;
    }
}
__device__ __forceinline__ void attn_qk2(LAS unsigned char* Kb, const bf16x8 (&q)[2][2], int fr, int g4, const float (&cinit)[2], f32x4 (&s)[2][4]) {
#pragma unroll
    for (int c = 0; c < 4; ++c) {
#pragma unroll
        for (int rb = 0; rb < 2; ++rb) s[rb][c] = (f32x4){cinit[rb], cinit[rb], cinit[rb], cinit[rb]};
#pragma unroll
        for (int ks = 0; ks < 2; ++ks) {
            const bf16x8 kf = *(const LAS bf16x8*)(Kb + pg8::lds_byte(16 * c + fr, 32 * ks + 8 * g4));
#pragma unroll
            for (int rb = 0; rb < 2; ++rb) s[rb][c] = __builtin_amdgcn_mfma_f32_16x16x32_bf16(kf, q[rb][ks], s[rb][c], 0, 0, 0);
        }
    }
}
__device__ __forceinline__ void attn_qk2m(LAS unsigned char* Kb, const bf16x8 (&q)[2][2], int fr, int g4, const float (&cinit)[2], f32x4 (&s)[2][4]) {
    bf16x8 kf[4][2];
#pragma unroll
    for (int c = 0; c < 4; ++c)
#pragma unroll
        for (int ks = 0; ks < 2; ++ks) kf[c][ks] = *(const LAS bf16x8*)(Kb + pg8::lds_byte(16 * c + fr, 32 * ks + 8 * g4));
    __builtin_amdgcn_sched_barrier(0);
    f32x4 ci[2];
#pragma unroll
    for (int rb = 0; rb < 2; ++rb) ci[rb] = (f32x4){cinit[rb], cinit[rb], cinit[rb], cinit[rb]};
#pragma unroll
    for (int c = 0; c < 4; ++c) {
#pragma unroll
        for (int ks = 0; ks < 2; ++ks) {
#pragma unroll
            for (int rb = 0; rb < 2; ++rb) s[rb][c] = __builtin_amdgcn_mfma_f32_16x16x32_bf16(kf[c][ks], q[rb][ks], ks == 0 ? ci[rb] : s[rb][c], 0, 0, 0);
        }
    }
}
__device__ __forceinline__ void attn_qk2z(LAS unsigned char* Kb, const bf16x8 (&q)[2][2], int fr, int g4, f32x4 (&s)[2][4]) {
    bf16x8 kf[4][2];
#pragma unroll
    for (int c = 0; c < 4; ++c)
#pragma unroll
        for (int ks = 0; ks < 2; ++ks) kf[c][ks] = *(const LAS bf16x8*)(Kb + pg8::lds_byte(16 * c + fr, 32 * ks + 8 * g4));
    __builtin_amdgcn_sched_barrier(0);
#pragma unroll
    for (int c = 0; c < 4; ++c) {
#pragma unroll
        for (int ks = 0; ks < 2; ++ks) {
#pragma unroll
            for (int rb = 0; rb < 2; ++rb) s[rb][c] = __builtin_amdgcn_mfma_f32_16x16x32_bf16(kf[c][ks], q[rb][ks], ks == 0 ? (f32x4){0.f, 0.f, 0.f, 0.f} : s[rb][c], 0, 0, 0);
        }
    }
}
struct AttnRow { float m; f32x4 o[4]; f32x4 ol; };
__device__ __forceinline__ float max3f(float a, float b, float c) { float r; asm("v_max3_f32 %0, %1, %2, %3" : "=v"(r) : "v"(a), "v"(b), "v"(c)); return r; }
__device__ __forceinline__ bool attn_sm2(f32x4 (&s)[4], AttnRow& st, int kbase, int g4, int lo, int hi, bool en, bool emask) {
    const float NEG = -INFINITY;
    if (emask) {
#pragma unroll
        for (int c = 0; c < 4; ++c)
#pragma unroll
            for (int i = 0; i < 4; ++i) { const int key = kbase + 16 * c + 4 * g4 + i; if (key < lo || key > hi) s[c][i] = NEG; }
    }
    float mx = max3f(s[0][0], s[0][1], s[0][2]); mx = max3f(mx, s[0][3], s[1][0]); mx = max3f(mx, s[1][1], s[1][2]); mx = max3f(mx, s[1][3], s[2][0]);
    mx = max3f(mx, s[2][1], s[2][2]); mx = max3f(mx, s[2][3], s[3][0]); mx = max3f(mx, s[3][1], s[3][2]); mx = max3f(mx, s[3][3], mx);
    if (!en) mx = NEG;
    mx = max3f(mx, __shfl_xor(mx, 16), mx); mx = max3f(mx, __shfl_xor(mx, 32), mx);
    const float delta = (mx > 20.0f) ? mx : 0.f;
    const bool moved = __builtin_amdgcn_ballot_w64(delta != 0.f) != 0ull;
    if (moved) {
        const float alpha = __builtin_amdgcn_exp2f(-delta);
#pragma unroll
        for (int c = 0; c < 4; ++c) s[c] = s[c] - delta;
#pragma unroll
        for (int dt = 0; dt < 4; ++dt) st.o[dt] *= alpha;
        st.ol *= alpha;
        st.m += delta;
    }
#pragma unroll
    for (int c = 0; c < 4; ++c)
#pragma unroll
        for (int i = 0; i < 4; ++i) s[c][i] = __builtin_amdgcn_exp2f(s[c][i]);
    return moved;
}
__device__ __forceinline__ bool attn_sm2x(f32x4 (&s)[2][4], AttnRow (&st)[2], int kbase, int g4, const int (&lo)[2], const int (&hi)[2], const bool (&en)[2], bool emask) {
    const float NEG = -INFINITY;
    if (emask) {
#pragma unroll
        for (int rb = 0; rb < 2; ++rb)
#pragma unroll
            for (int c = 0; c < 4; ++c)
#pragma unroll
                for (int i = 0; i < 4; ++i) { const int key = kbase + 16 * c + 4 * g4 + i; if (key < lo[rb] || key > hi[rb]) s[rb][c][i] = NEG; }
    }
    float mx[2];
#pragma unroll
    for (int rb = 0; rb < 2; ++rb) {
        float m = max3f(s[rb][0][0], s[rb][0][1], s[rb][0][2]); m = max3f(m, s[rb][0][3], s[rb][1][0]); m = max3f(m, s[rb][1][1], s[rb][1][2]); m = max3f(m, s[rb][1][3], s[rb][2][0]);
        m = max3f(m, s[rb][2][1], s[rb][2][2]); m = max3f(m, s[rb][2][3], s[rb][3][0]); m = max3f(m, s[rb][3][1], s[rb][3][2]); m = max3f(m, s[rb][3][3], m);
        mx[rb] = en[rb] ? m : NEG;
    }
    { const float t0 = __shfl_xor(mx[0], 16), t1 = __shfl_xor(mx[1], 16); mx[0] = max3f(mx[0], t0, t0); mx[1] = max3f(mx[1], t1, t1); }
    { const float t0 = __shfl_xor(mx[0], 32), t1 = __shfl_xor(mx[1], 32); mx[0] = max3f(mx[0], t0, t0); mx[1] = max3f(mx[1], t1, t1); }
    const float d0 = (mx[0] > 20.0f) ? mx[0] : 0.f, d1 = (mx[1] > 20.0f) ? mx[1] : 0.f;
    const bool moved = __builtin_amdgcn_ballot_w64((d0 != 0.f) || (d1 != 0.f)) != 0ull;
    if (moved) {
        const float dl[2] = {d0, d1};
#pragma unroll
        for (int rb = 0; rb < 2; ++rb) {
            const float alpha = __builtin_amdgcn_exp2f(-dl[rb]);
#pragma unroll
            for (int c = 0; c < 4; ++c) s[rb][c] = s[rb][c] - dl[rb];
#pragma unroll
            for (int dt = 0; dt < 4; ++dt) st[rb].o[dt] *= alpha;
            st[rb].ol *= alpha; st[rb].m += dl[rb];
        }
    }
#pragma unroll
    for (int rb = 0; rb < 2; ++rb)
#pragma unroll
        for (int c = 0; c < 4; ++c)
#pragma unroll
            for (int i = 0; i < 4; ++i) s[rb][c][i] = __builtin_amdgcn_exp2f(s[rb][c][i]);
    return moved;
}
__device__ __forceinline__ void attn_pv2x(LAS unsigned char* Vb, const f32x4 (&p)[2][4], int vlane, int swz, const unsigned (&enm)[2], const bool (&act)[2], const bf16x8 onesf, AttnRow (&st)[2]) {
#pragma unroll
    for (int ks = 0; ks < 2; ++ks) {
        bf16x8 pb[2];
#pragma unroll
        for (int rb = 0; rb < 2; ++rb) { u32x4 pw = pack8m(p[rb][2 * ks], p[rb][2 * ks + 1]); pw.x &= enm[rb]; pw.y &= enm[rb]; pw.z &= enm[rb]; pw.w &= enm[rb]; pb[rb] = __builtin_bit_cast(bf16x8, pw); }
#pragma unroll
        for (int dt = 0; dt < 4; ++dt) {
            LAS unsigned char* a0 = Vb + vlane + (2 * ks) * 2048 + ((dt ^ swz) * 32);
            const bf16x8 vf = tr_frag(a0, a0 + 2048);
#pragma unroll
            for (int rb = 0; rb < 2; ++rb) if (act[rb]) st[rb].o[dt] = __builtin_amdgcn_mfma_f32_16x16x32_bf16(vf, pb[rb], st[rb].o[dt], 0, 0, 0);
        }
#pragma unroll
        for (int rb = 0; rb < 2; ++rb) if (act[rb]) st[rb].ol = __builtin_amdgcn_mfma_f32_16x16x32_bf16(onesf, pb[rb], st[rb].ol, 0, 0, 0);
    }
}
__device__ __forceinline__ bool attn_max2x(f32x4 (&s)[2][4], int kbase, int g4, const int (&lo)[2], const int (&hi)[2], const bool (&en)[2], bool emask, float (&d)[2]) {
    const float NEG = -INFINITY;
    MFMA_SETTLE(s);
    if (emask) {
#pragma unroll
        for (int rb = 0; rb < 2; ++rb)
#pragma unroll
            for (int c = 0; c < 4; ++c)
#pragma unroll
                for (int i = 0; i < 4; ++i) { const int key = kbase + 16 * c + 4 * g4 + i; if (key < lo[rb] || key > hi[rb]) s[rb][c][i] = NEG; }
    }
    float mx[2];
#pragma unroll
    for (int rb = 0; rb < 2; ++rb) {
        float m = max3f(s[rb][0][0], s[rb][0][1], s[rb][0][2]); m = max3f(m, s[rb][0][3], s[rb][1][0]); m = max3f(m, s[rb][1][1], s[rb][1][2]); m = max3f(m, s[rb][1][3], s[rb][2][0]);
        m = max3f(m, s[rb][2][1], s[rb][2][2]); m = max3f(m, s[rb][2][3], s[rb][3][0]); m = max3f(m, s[rb][3][1], s[rb][3][2]); m = max3f(m, s[rb][3][3], m);
        mx[rb] = en[rb] ? m : NEG;
    }
    { const float t0 = __shfl_xor(mx[0], 16), t1 = __shfl_xor(mx[1], 16); mx[0] = max3f(mx[0], t0, t0); mx[1] = max3f(mx[1], t1, t1); }
    { const float t0 = __shfl_xor(mx[0], 32), t1 = __shfl_xor(mx[1], 32); mx[0] = max3f(mx[0], t0, t0); mx[1] = max3f(mx[1], t1, t1); }
    d[0] = (mx[0] > 20.0f) ? mx[0] : 0.f; d[1] = (mx[1] > 20.0f) ? mx[1] : 0.f;
    return __builtin_amdgcn_ballot_w64((d[0] != 0.f) || (d[1] != 0.f)) != 0ull;
}
__device__ __forceinline__ void attn_rescale2x(f32x4 (&s)[2][4], AttnRow (&st)[2], const float (&d)[2]) {
#pragma unroll
    for (int rb = 0; rb < 2; ++rb) {
        const float alpha = __builtin_amdgcn_exp2f(-d[rb]);
#pragma unroll
        for (int c = 0; c < 4; ++c) s[rb][c] = s[rb][c] - d[rb];
#pragma unroll
        for (int dt = 0; dt < 4; ++dt) st[rb].o[dt] *= alpha;
        st[rb].ol *= alpha; st[rb].m += d[rb];
    }
}
__device__ __forceinline__ void attn_exp1(f32x4 (&s)[4], unsigned enm, bf16x8 (&pb)[2]) {
#pragma unroll
    for (int c = 0; c < 4; ++c)
#pragma unroll
        for (int i = 0; i < 4; ++i) s[c][i] = __builtin_amdgcn_exp2f(s[c][i]);
#pragma unroll
    for (int ks = 0; ks < 2; ++ks) { u32x4 pw = pack8m(s[2 * ks], s[2 * ks + 1]); pw.x &= enm; pw.y &= enm; pw.z &= enm; pw.w &= enm; pb[ks] = __builtin_bit_cast(bf16x8, pw); }
}
__device__ __forceinline__ void attn_pv1(LAS unsigned char* Vb, const bf16x8 (&pb)[2], int vlane, int swz, const bf16x8 onesf, AttnRow& st) {
#pragma unroll
    for (int ks = 0; ks < 2; ++ks) {
#pragma unroll
        for (int dt = 0; dt < 4; ++dt) {
            LAS unsigned char* a0 = Vb + vlane + (2 * ks) * 2048 + ((dt ^ swz) * 32);
            const bf16x8 vf = tr_frag(a0, a0 + 2048);
            st.o[dt] = __builtin_amdgcn_mfma_f32_16x16x32_bf16(vf, pb[ks], st.o[dt], 0, 0, 0);
        }
        st.ol = __builtin_amdgcn_mfma_f32_16x16x32_bf16(onesf, pb[ks], st.ol, 0, 0, 0);
    }
}
__device__ __forceinline__ bool attn_step2x(LAS unsigned char* Vb, f32x4 (&s)[2][4], AttnRow (&st)[2], int kbase, int g4, const int (&lo)[2], const int (&hi)[2], const bool (&en)[2], const unsigned (&enm)[2], bool emask,
                                            int vlane, int swz, const bf16x8 onesf) {
    float d[2];
    const bool moved = attn_max2x(s, kbase, g4, lo, hi, en, emask, d);
    if (moved) attn_rescale2x(s, st, d);
    bf16x8 p0[2], p1[2];
    attn_exp1(s[0], enm[0], p0);
    attn_pv1(Vb, p0, vlane, swz, onesf, st[0]);
    attn_exp1(s[1], enm[1], p1);
    attn_pv1(Vb, p1, vlane, swz, onesf, st[1]);
    return moved;
}
__device__ __forceinline__ void attn_step2x_nomax(LAS unsigned char* Vb, f32x4 (&s)[2][4], AttnRow (&st)[2], int kbase, int g4, const int (&lo)[2], const int (&hi)[2], const unsigned (&enm)[2], bool emask,
                                                  int vlane, int swz, const bf16x8 onesf) {
    if (emask) {
#pragma unroll
        for (int rb = 0; rb < 2; ++rb)
#pragma unroll
            for (int c = 0; c < 4; ++c)
#pragma unroll
                for (int i = 0; i < 4; ++i) { const int key = kbase + 16 * c + 4 * g4 + i; if (key < lo[rb] || key > hi[rb]) s[rb][c][i] = -INFINITY; }
    }
    bf16x8 p0[2], p1[2];
    attn_exp1(s[0], enm[0], p0);
    attn_pv1(Vb, p0, vlane, swz, onesf, st[0]);
    attn_exp1(s[1], enm[1], p1);
    attn_pv1(Vb, p1, vlane, swz, onesf, st[1]);
}
typedef _Float16 f16x4 __attribute__((ext_vector_type(4)));
constexpr int AT4_KB = 0, AT4_VB = 32768, AT2_PS = 65536, AT2_MSK = 65536 + 65536;
__device__ __forceinline__ int attn_pair_of(int pr) { const int p = pr & 63, k = pr >> 8; const int q = (k & 2) ? ((p + 32) & 63) : p; return (k & 1) ? 63 - q : q; }
__device__ __forceinline__ void ph_attn_fast2(const Args& a, LAS unsigned char* lds) {
    const bf16_t* QN = (const bf16_t*)(a.ws + WS_HN);
    const bf16_t* QR = (const bf16_t*)(a.ws + WS_QR);
    const bf16_t* KV6 = (const bf16_t*)(a.ws + WS_KV6);
    const float* GATES = (const float*)(a.ws + WS_GATES);
    const bf16_t* KC = (const bf16_t*)(a.ws + WS_KC);
    const bf16_t* VC = KC + (size_t)8192 * 64;
    bf16_t* O = (bf16_t*)(a.ws + WS_O);
    const int tid = threadIdx.x, lane = tid & 63, wave = __builtin_amdgcn_readfirstlane(tid >> 6);
    const int fr = lane & 15, g4 = lane >> 4;
    int ksrc, vsrc;
    { int R, C; pg8::stage_rc(wave * 1024 + lane * 16, R, C); ksrc = R * 64 + C;
      const int key = 8 * wave + (lane >> 3), pos = lane & 7, chunk = (pos >> 1) ^ ((key >> 1) & 3); vsrc = key * 64 + (chunk * 2 + (pos & 1)) * 8; }
    const int vlane = (4 * g4 + (fr >> 2)) * 128 + (fr & 3) * 8, swz = (2 * g4 + (fr >> 3)) & 3;
    LAS _Float16* ps = (LAS _Float16*)(lds + AT2_PS + wave * 8192);
    LAS unsigned* mskl = (LAS unsigned*)(lds + AT2_MSK + wave * 128);
    const float NEG = -INFINITY;
    const bf16x8 onesf = (fr == 0) ? (bf16x8){0x3F80, 0x3F80, 0x3F80, 0x3F80, 0x3F80, 0x3F80, 0x3F80, 0x3F80} : (bf16x8){0, 0, 0, 0, 0, 0, 0, 0};
    const int vcu = (gridDim.x % 8 == 0) ? (int)((blockIdx.x % 8) * (gridDim.x / 8) + blockIdx.x / 8) : (int)blockIdx.x;
    int cvt_next = (int)blockIdx.x * 8 + wave; const int cvt_stride = (int)gridDim.x * 8;
    LAS float* cvt_scr = (LAS float*)(lds + AT2_PS + wave * 8448);
    bool cmp_pref = false;
    for (int pr = vcu; pr < 1024; pr += gridDim.x) {
#pragma unroll 1
        for (int half = 0; half < 2; ++half) {
            const int bg = pr >> 6, pp = attn_pair_of(pr), cc = half ? (127 - pp) : pp;
            const int b = bg >> 2, g = bg & 3, t0 = cc * 64, cur = cc;
            const int head = g * 4 + (fr & 3);
            int trow[2];
            bf16x8 qn[2][2];
#pragma unroll
            for (int rb = 0; rb < 2; ++rb) {
                trow[rb] = t0 + 8 * wave + 4 * rb + (fr >> 2);
#pragma unroll
                for (int ks = 0; ks < 2; ++ks) qn[rb][ks] = *(const bf16x8*)(QN + ((size_t)b * T + trow[rb]) * 1024 + head * 64 + 32 * ks + 8 * g4);
            }
#define TROW_PIN() asm volatile("" : "+v"(trow[0]), "+v"(trow[1]))
#define TOKROW(rb) ((size_t)b * T + trow[rb])
#define GATE(rb, br) (GATES[TOKROW(rb) * 48 + head * 3 + (br)])
            const bf16_t* kcb = KC + (size_t)bg * 512 * 64;
            const bf16_t* kvb = KV6 + (size_t)bg * T * 64;
#define ATK(sl) (((sl) < 4 ? AT4_KB : AT2_PS - 4 * 8192) + (sl) * 8192)
#define ATV(sl) (((sl) < 4 ? AT4_VB : AT2_PS + 32768 - 4 * 8192) + (sl) * 8192)
#define AT_DMA(BR, tile, slot) do { const bf16_t* kp_; const bf16_t* vp_; \
                if ((BR) == 0) { kp_ = kcb + (size_t)(tile) * 4096; vp_ = kp_ + (size_t)8192 * 64; } \
                else { kp_ = kvb + (size_t)((BR) == 1 ? 2 : 4) * 16 * T * 64 + (size_t)(tile) * 4096; vp_ = kp_ + (size_t)16 * T * 64; } \
                __builtin_amdgcn_global_load_lds((const unsigned*)(kp_ + ksrc), (LAS unsigned*)(lds + ATK(slot) + wave * 1024), 16, 0, 0); \
                __builtin_amdgcn_global_load_lds((const unsigned*)(vp_ + vsrc), (LAS unsigned*)(lds + ATV(slot) + wave * 1024), 16, 0, 0); } while (0)
            int ncv[2];
#pragma unroll
            for (int rb = 0; rb < 2; ++rb) ncv[rb] = (trow[rb] >= 31) ? ((trow[rb] - 31) / 16 + 1) : 0;
            const int nct = (((t0 + 63 - 31) / 16 + 1) + 63) >> 6;
            float mc[2], invc[2];
            const int t_lo = t0 + 8 * wave, ncv_lo = (t_lo >= 31) ? ((t_lo - 31) / 16 + 1) : 0;
            {
                float m1[2] = {NEG, NEG}, l1[2] = {0.f, 0.f};
                const float zero2[2] = {0.f, 0.f};
#define CMP1_TILE(J, SLOT, MASKED) do { const int j = (J); const int SLOT_ = (SLOT); \
                    f32x4 s[2][4]; attn_qk2(lds + AT4_KB + SLOT_ * 8192, qn, fr, g4, zero2, s); \
                    _Pragma("unroll") \
                    for (int rb = 0; rb < 2; ++rb) { \
                        float mx = NEG; \
                    _Pragma("unroll") \
                        for (int c = 0; c < 4; ++c) \
                    _Pragma("unroll") \
                            for (int i = 0; i < 4; ++i) { const int n = 64 * j + 16 * c + 4 * g4 + i; if ((MASKED) && n >= ncv[rb]) s[rb][c][i] = NEG; mx = fmaxf(mx, s[rb][c][i]); } \
                        mx = fmaxf(mx, __shfl_xor(mx, 16)); mx = fmaxf(mx, __shfl_xor(mx, 32)); \
                        const float mn = fmaxf(m1[rb], mx), msafe = (mn == NEG) ? 0.f : mn; \
                        const float alpha = (m1[rb] == NEG) ? 0.f : __builtin_amdgcn_exp2f(m1[rb] - msafe); \
                        float sum = 0.f; \
                    _Pragma("unroll") \
                        for (int c = 0; c < 4; ++c) \
                    _Pragma("unroll") \
                            for (int i = 0; i < 4; ++i) sum += __builtin_amdgcn_exp2f(s[rb][c][i] - msafe); \
                        l1[rb] = l1[rb] * alpha + sum; m1[rb] = mn; \
                    } \
                } while (0)
                if (!cmp_pref) { AT_DMA(0, 0, 0); if (nct > 1) AT_DMA(0, 1, 1); } __syncthreads();
                for (int j0 = 0; j0 < nct; j0 += 2) { const int sb = (j0 & 2);
                    if (j0 + 2 < nct) AT_DMA(0, j0 + 2, sb ^ 2);
                    if (j0 + 3 < nct) AT_DMA(0, j0 + 3, (sb ^ 2) + 1);
                    CMP1_TILE(j0, sb, true); if (j0 + 1 < nct) CMP1_TILE(j0 + 1, sb + 1, true);
                    __syncthreads();
                }
#undef CMP1_TILE
#pragma unroll
                for (int rb = 0; rb < 2; ++rb) { float lc = l1[rb]; lc += __shfl_xor(lc, 16); lc += __shfl_xor(lc, 32); invc[rb] = (lc > 0.f) ? -(((m1[rb] == NEG) ? 0.f : m1[rb]) + __builtin_amdgcn_logf(lc)) : 0.f; mc[rb] = (m1[rb] == NEG) ? 0.f : m1[rb]; }
            }
            {
                AttnRow oc[2];
#pragma unroll
                for (int rb = 0; rb < 2; ++rb) { oc[rb].m = 0.f; oc[rb].ol = (f32x4){0.f, 0.f, 0.f, 0.f};
#pragma unroll
                    for (int dt = 0; dt < 4; ++dt) oc[rb].o[dt] = (f32x4){0.f, 0.f, 0.f, 0.f}; }
                const float cin[2] = {invc[0], invc[1]};
                const unsigned full[2] = {0xffffffffu, 0xffffffffu}; const bool both[2] = {true, true};
#define CMP2_TILE(J, SLOT, MASKED) do { const int j = (J); const int SLOT_ = (SLOT); \
                    f32x4 s[2][4]; attn_qk2(lds + AT4_KB + SLOT_ * 8192, qn, fr, g4, cin, s); \
                    _Pragma("unroll") \
                    for (int rb = 0; rb < 2; ++rb) \
                    _Pragma("unroll") \
                        for (int c = 0; c < 4; ++c) { \
                            f16x4 hs; \
                    _Pragma("unroll") \
                            for (int i = 0; i < 4; ++i) { const int n = 64 * j + 16 * c + 4 * g4 + i; const float p = (!(MASKED) || n < ncv[rb]) ? __builtin_amdgcn_exp2f(s[rb][c][i]) : 0.f; s[rb][c][i] = p; \
                                float h = p; h += DPP_F(h, 0xB1); h += DPP_F(h, 0x4E); hs[i] = (_Float16)h; }        \
                            if ((fr & 3) == 0) *(LAS f16x4*)(ps + (4 * rb + (fr >> 2)) * 512 + 64 * j + 16 * c + 4 * g4) = hs; \
                        } \
                    attn_pv2x(lds + AT4_VB + SLOT_ * 8192, s, vlane, swz, full, both, onesf, oc); \
                } while (0)
                const bool reload = nct > 4;
                if (reload) { AT_DMA(0, 0, 0); AT_DMA(0, 1, 1); __syncthreads(); }
                for (int j0 = 0; j0 < nct; j0 += 2) { const int sb = (j0 & 2);
                    if (reload && j0 + 2 < nct) AT_DMA(0, j0 + 2, sb ^ 2);
                    if (reload && j0 + 3 < nct) AT_DMA(0, j0 + 3, (sb ^ 2) + 1);
                    CMP2_TILE(j0, sb, true); if (j0 + 1 < nct) CMP2_TILE(j0 + 1, sb + 1, true);
                    __syncthreads();
                }
#undef CMP2_TILE
                TROW_PIN();
#pragma unroll
                for (int rb = 0; rb < 2; ++rb) { bf16_t* op = O + TOKROW(rb) * 1024 + head * 64 + 4 * g4; const float g0 = GATE(rb, 0);
#pragma unroll
                    for (int dt = 0; dt < 4; ++dt) { const f32x4 v = oc[rb].o[dt] * g0; u32x2 w; w.x = cvt_pk_bf16(v[0], v[1]); w.y = cvt_pk_bf16(v[2], v[3]); *(u32x2*)(op + 16 * dt) = w; } }
            }
            {
                WSYNC();
                const int tl = lane >> 4, li = lane & 15;
                const int nsel = (cur + 1 < 16) ? (cur + 1) : 16;
#pragma unroll 1
                for (int rnd = 0; rnd < 2; ++rnd) {
                    const LAS _Float16* pst = ps + (4 * rnd + tl) * 512;
                    float v[8];
#pragma unroll
                    for (int k = 0; k < 8; ++k) { const int j = li + 16 * k;
                        float x;
                        if (j > cur) x = NEG;
                        else if (j == 0 || j == cur || j == cur - 1) x = NEG;
                        else { const int n0 = 4 * j; x = (float)pst[n0 - 1] + 2.0f * ((float)pst[n0] + (float)pst[n0 + 1] + (float)pst[n0 + 2]) + (float)pst[n0 + 3]; }
                        v[k] = x; }
                    int vi[8];
#pragma unroll
                    for (int k = 0; k < 8; ++k) vi[k] = __builtin_bit_cast(int, v[k]);
                    unsigned mm[4] = {1u, 0u, 0u, 0u};
                    {
                        const unsigned bc = 1u << (cur & 31); const int wc_ = cur >> 5;
                        mm[0] |= (wc_ == 0) ? bc : 0u; mm[1] |= (wc_ == 1) ? bc : 0u; mm[2] |= (wc_ == 2) ? bc : 0u; mm[3] |= (wc_ == 3) ? bc : 0u;
                        if (cur >= 1) { const unsigned bp = 1u << ((cur - 1) & 31); const int wp_ = (cur - 1) >> 5;
                            mm[0] |= (wp_ == 0) ? bp : 0u; mm[1] |= (wp_ == 1) ? bp : 0u; mm[2] |= (wp_ == 2) ? bp : 0u; mm[3] |= (wp_ == 3) ? bp : 0u; }
                    }
                    const int nforced = (cur >= 2) ? 3 : (cur + 1);
                    for (int it = 0; it < nsel - nforced; ++it) {
                        int bv = max(max(max(vi[0], vi[1]), max(vi[2], vi[3])), max(max(vi[4], vi[5]), max(vi[6], vi[7])));
                        bv = max(bv, DPP_I(bv, 0xB1)); bv = max(bv, DPP_I(bv, 0x4E)); bv = max(bv, DPP_I(bv, 0x141)); bv = max(bv, DPP_I(bv, 0x140));
                        int bi = 255;
#pragma unroll
                        for (int k = 7; k >= 0; --k) bi = (vi[k] == bv) ? (li + 16 * k) : bi;
                        bi = min(bi, DPP_I(bi, 0xB1)); bi = min(bi, DPP_I(bi, 0x4E)); bi = min(bi, DPP_I(bi, 0x141)); bi = min(bi, DPP_I(bi, 0x140));
                        const unsigned bit = 1u << (bi & 31); const int wsel = bi >> 5;
                        mm[0] |= (wsel == 0) ? bit : 0u; mm[1] |= (wsel == 1) ? bit : 0u; mm[2] |= (wsel == 2) ? bit : 0u; mm[3] |= (wsel == 3) ? bit : 0u;
                        if ((bi & 15) == li) {
#pragma unroll
                            for (int k = 0; k < 8; ++k) if ((bi >> 4) == k) vi[k] = (int)0xFF800000;
                        }
                    }
                    if (li == 0) { mskl[(4 * rnd + tl) * 4 + 0] = mm[0]; mskl[(4 * rnd + tl) * 4 + 1] = mm[1]; mskl[(4 * rnd + tl) * 4 + 2] = mm[2]; mskl[(4 * rnd + tl) * 4 + 3] = mm[3]; }
                }
                WSYNC();
            }
            bf16x8 qr[2][2];
            TROW_PIN();
#pragma unroll
            for (int rb = 0; rb < 2; ++rb)
#pragma unroll
                for (int ks = 0; ks < 2; ++ks) qr[rb][ks] = *(const bf16x8*)(QR + TOKROW(rb) * 1024 + head * 64 + 32 * ks + 8 * g4);
            bool nomax_slc, nomax_win;
            {
                float qq = 0.f;
#pragma unroll
                for (int rb = 0; rb < 2; ++rb) { float q2 = 0.f;
#pragma unroll
                    for (int ks = 0; ks < 2; ++ks)
#pragma unroll
                        for (int j = 0; j < 8; ++j) { const float x = bf2f((bf16_t)qr[rb][ks][j]); q2 += x * x; }
                    q2 += __shfl_xor(q2, 16); q2 += __shfl_xor(q2, 32); qq = fmaxf(qq, q2); }
                qq = wave_max(qq);
                const float* tn = (const float*)(a.ws + WS_MISC + TN2_OFF) + bg * 128;
                const int jt0w = (t0 >= 511) ? ((t0 - 511) >> 6) : 0;
                float ts = 0.f, tw = 0.f;
#pragma unroll
                for (int h2 = 0; h2 < 2; ++h2) { const int tl_ = lane + 64 * h2; if (tl_ <= cur) { ts = fmaxf(ts, tn[tl_]); if (tl_ >= jt0w) tw = fmaxf(tw, tn[2048 + tl_]); } }
                ts = wave_max(ts); tw = wave_max(tw);
                nomax_slc = __builtin_amdgcn_readfirstlane((qq * ts <= 3500.0f) ? 1 : 0) != 0;
                nomax_win = __builtin_amdgcn_readfirstlane((qq * tw <= 3500.0f) ? 1 : 0) != 0;
            }
            {
                AttnRow ss[2];
#pragma unroll
                for (int rb = 0; rb < 2; ++rb) { ss[rb].m = 0.f; ss[rb].ol = (f32x4){0.f, 0.f, 0.f, 0.f};
#pragma unroll
                    for (int dt = 0; dt < 4; ++dt) ss[rb].o[dt] = (f32x4){0.f, 0.f, 0.f, 0.f}; }
                const int nt_ = cur + 1;
                bool refmoved = false;
#define SLC_PRE(J) const int j_ = (J); bool en[2], act[2]; unsigned enm[2]; \
                    _Pragma("unroll") for (int rb = 0; rb < 2; ++rb) { const unsigned mw = mwg[rb]; \
                        en[rb] = (mw >> (j_ & 31)) & 1u; act[rb] = __any(en[rb]); enm[rb] = en[rb] ? 0xffffffffu : 0u; } const int lo2[2] = {0, 0};
#define SLC_TILE(J, SLOT) do { SLC_PRE(J) \
                    if (act[0] || act[1]) { f32x4 s[2][4]; \
                        if (refmoved) { const float cin[2] = {-ss[0].m, -ss[1].m}; attn_qk2(lds + ATK(SLOT), qr, fr, g4, cin, s); } \
                        else attn_qk2z(lds + ATK(SLOT), qr, fr, g4, s); \
                        refmoved |= attn_step2x(lds + ATV(SLOT), s, ss, 64 * j_, g4, lo2, trow, en, enm, j_ == cur, vlane, swz, onesf); } } while (0)
#define SLC_TILE_NM(J, SLOT) do { SLC_PRE(J) \
                    if (act[0] || act[1]) { f32x4 s[2][4]; const float cm_[2] = {en[0] ? 0.f : -1e30f, en[1] ? 0.f : -1e30f}; attn_qk2m(lds + ATK(SLOT), qr, fr, g4, cm_, s); \
                        const unsigned fullm_[2] = {0xffffffffu, 0xffffffffu}; \
                        attn_step2x_nomax(lds + ATV(SLOT), s, ss, 64 * j_, g4, lo2, trow, fullm_, j_ == cur, vlane, swz, onesf); } } while (0)
#pragma unroll
                for (int i = 0; i < 4; ++i) if (i < nt_) AT_DMA(1, i, i);
                __syncthreads();
#define SLC_LOOP(TILE) for (int j0 = 0; j0 < nt_; j0 += 4) { const int sb = (j0 & 4); \
                    const unsigned mwg[2] = {mskl[(fr >> 2) * 4 + (j0 >> 5)], mskl[(4 + (fr >> 2)) * 4 + (j0 >> 5)]};       \
                    _Pragma("unroll") for (int i = 0; i < 4; ++i) if (j0 + 4 + i < nt_) AT_DMA(1, j0 + 4 + i, (sb ^ 4) + i); \
                    TILE(j0, sb); if (j0 + 1 < nt_) TILE(j0 + 1, sb + 1); if (j0 + 2 < nt_) TILE(j0 + 2, sb + 2); if (j0 + 3 < nt_) TILE(j0 + 3, sb + 3); \
                    __syncthreads(); }
                if (nomax_slc) { SLC_LOOP(SLC_TILE_NM) } else { SLC_LOOP(SLC_TILE) }
#undef SLC_LOOP
#undef SLC_TILE_NM
#undef SLC_PRE
#undef SLC_TILE
                TROW_PIN();
#pragma unroll
                for (int rb = 0; rb < 2; ++rb) { const float l = __shfl(ss[rb].ol[0], fr); const float sc1 = (l > 0.f) ? GATE(rb, 1) / l : 0.f;
                    bf16_t* op = O + TOKROW(rb) * 1024 + head * 64 + 4 * g4;
#pragma unroll
                    for (int dt = 0; dt < 4; ++dt) { const u32x2 pv = *(const u32x2*)(op + 16 * dt); f32x4 v = ss[rb].o[dt] * sc1;
                        v[0] += __uint_as_float(pv.x << 16); v[1] += __uint_as_float(pv.x & 0xffff0000u); v[2] += __uint_as_float(pv.y << 16); v[3] += __uint_as_float(pv.y & 0xffff0000u);
                        u32x2 w; w.x = cvt_pk_bf16(v[0], v[1]); w.y = cvt_pk_bf16(v[2], v[3]); *(u32x2*)(op + 16 * dt) = w; } }
            }
            {
                AttnRow sw[2];
#pragma unroll
                for (int rb = 0; rb < 2; ++rb) { sw[rb].m = 0.f; sw[rb].ol = (f32x4){0.f, 0.f, 0.f, 0.f};
#pragma unroll
                    for (int dt = 0; dt < 4; ++dt) sw[rb].o[dt] = (f32x4){0.f, 0.f, 0.f, 0.f}; }
                const int jt0 = (t0 >= 511) ? ((t0 - 511) >> 6) : 0;
                const int nt_ = cur - jt0 + 1;
                const unsigned full[2] = {0xffffffffu, 0xffffffffu}; const bool both[2] = {true, true};
                bool refmoved = false;
#define WIN_PRE(JJ) const int j = jt0 + (JJ); f32x4 s[2][4]; const bool edge = (j == cur) || (64 * j < t0 + 63 - 511); const int lo2[2] = {trow[0] - 511, trow[1] - 511};
#define WIN_TILE(JJ, SLOT) do { WIN_PRE(JJ) \
                    if (refmoved) { const float cin[2] = {-sw[0].m, -sw[1].m}; attn_qk2(lds + AT4_KB + (SLOT) * 8192, qr, fr, g4, cin, s); } \
                    else attn_qk2z(lds + AT4_KB + (SLOT) * 8192, qr, fr, g4, s); \
                    refmoved |= attn_step2x(lds + AT4_VB + (SLOT) * 8192, s, sw, 64 * j, g4, lo2, trow, both, full, edge, vlane, swz, onesf); } while (0)
#define WIN_TILE_NM(JJ, SLOT) do { WIN_PRE(JJ) attn_qk2z(lds + AT4_KB + (SLOT) * 8192, qr, fr, g4, s); \
                    attn_step2x_nomax(lds + AT4_VB + (SLOT) * 8192, s, sw, 64 * j, g4, lo2, trow, full, edge, vlane, swz, onesf); } while (0)
                AT_DMA(2, jt0, 0); if (nt_ > 1) AT_DMA(2, jt0 + 1, 1); __syncthreads();
#define WIN_LOOP(TILE) for (int j0 = 0; j0 < nt_; j0 += 2) { const int sb = (j0 & 2); \
                    if (j0 + 2 < nt_) AT_DMA(2, jt0 + j0 + 2, sb ^ 2); \
                    if (j0 + 3 < nt_) AT_DMA(2, jt0 + j0 + 3, (sb ^ 2) + 1); \
                    TILE(j0, sb); if (j0 + 1 < nt_) TILE(j0 + 1, sb + 1); \
                    __syncthreads(); }
                if (nomax_win) { WIN_LOOP(WIN_TILE_NM) } else { WIN_LOOP(WIN_TILE) }
#undef WIN_LOOP
#undef WIN_TILE_NM
#undef WIN_PRE
#undef WIN_TILE
                TROW_PIN();
#pragma unroll
                for (int rb = 0; rb < 2; ++rb) { const float l = __shfl(sw[rb].ol[0], fr); const float sc2 = (l > 0.f) ? GATE(rb, 2) / l : 0.f;
                    bf16_t* op = O + TOKROW(rb) * 1024 + head * 64 + 4 * g4;
                    unsigned char* o8 = (unsigned char*)(a.ws + WS_O8) + TOKROW(rb) * 1024 + head * 64 + 4 * g4;
#pragma unroll
                    for (int dt = 0; dt < 4; ++dt) { const u32x2 pv = *(const u32x2*)(op + 16 * dt); f32x4 v = sw[rb].o[dt] * sc2;
                        v[0] += __uint_as_float(pv.x << 16); v[1] += __uint_as_float(pv.x & 0xffff0000u); v[2] += __uint_as_float(pv.y << 16); v[3] += __uint_as_float(pv.y & 0xffff0000u);
                        *(unsigned*)(o8 + 16 * dt) = pk4_fp8(clamp8(v[0] * X8_SCALE), clamp8(v[1] * X8_SCALE), clamp8(v[2] * X8_SCALE), clamp8(v[3] * X8_SCALE)); } }
            }
#undef AT_DMA
#undef ATK
#undef ATV
#undef TROW_PIN
#undef TOKROW
#undef GATE
            {
                const int npr = half ? pr + (int)gridDim.x : pr, nhalf = half ^ 1;
                cmp_pref = npr < 1024;
                if (cmp_pref) { const int nbg = npr >> 6, npp = attn_pair_of(npr), ncc = nhalf ? (127 - npp) : npp;
                    const int nnct = (((ncc * 64 + 63 - 31) / 16 + 1) + 63) >> 6;
                    const bf16_t* nk = KC + (size_t)nbg * 512 * 64;
                    __builtin_amdgcn_global_load_lds((const unsigned*)(nk + ksrc), (LAS unsigned*)(lds + AT4_KB + wave * 1024), 16, 0, 0);
                    __builtin_amdgcn_global_load_lds((const unsigned*)(nk + (size_t)8192 * 64 + vsrc), (LAS unsigned*)(lds + AT4_VB + wave * 1024), 16, 0, 0);
                    if (nnct > 1) {
                        __builtin_amdgcn_global_load_lds((const unsigned*)(nk + 4096 + ksrc), (LAS unsigned*)(lds + AT4_KB + 8192 + wave * 1024), 16, 0, 0);
                        __builtin_amdgcn_global_load_lds((const unsigned*)(nk + (size_t)8192 * 64 + 4096 + vsrc), (LAS unsigned*)(lds + AT4_VB + 8192 + wave * 1024), 16, 0, 0); } } }
            cvt1_run(a, cvt_next, cvt_stride, 2, cvt_scr, lane);
        }
    }
    cvt1_run(a, cvt_next, cvt_stride, 1 << 20, cvt_scr, lane);
}

__device__ __forceinline__ void unpack8(const u32x4 w, float (&f)[8]) {
    f[0] = __uint_as_float(w.x << 16); f[1] = __uint_as_float(w.x & 0xffff0000u); f[2] = __uint_as_float(w.y << 16); f[3] = __uint_as_float(w.y & 0xffff0000u);
    f[4] = __uint_as_float(w.z << 16); f[5] = __uint_as_float(w.z & 0xffff0000u); f[6] = __uint_as_float(w.w << 16); f[7] = __uint_as_float(w.w & 0xffff0000u);
}
__device__ __forceinline__ void ph_convpool_fast(const Args& a, LAS unsigned char* lds) {
    const bf16_t* H0 = (const bf16_t*)(a.ws + WS_H0);
    bf16_t* CAT = (bf16_t*)(a.ws + WS_CAT);
    const float* cw = a.in[4]; const float* cb = a.in[5]; const float* lg = a.in[6]; const float* lb = a.in[7];
    const int tid = threadIdx.x, lane = tid & 63, wave = tid >> 6, ch = lane * 8;
    constexpr int VT_OFF = 0, UT_OFF = 62 * 1024, CW_OFF = UT_OFF + 47 * 1024;
    for (int i = tid; i < 31 * 64; i += 512) { const int k = i >> 6, c8 = (i & 63) * 8;
        const f32x4 w0 = *(const f32x4*)(cw + k * 512 + c8), w1 = *(const f32x4*)(cw + k * 512 + c8 + 4);
        u32x4 o; o.x = pk2(w0[0], w0[1]); o.y = pk2(w0[2], w0[3]); o.z = pk2(w1[0], w1[1]); o.w = pk2(w1[2], w1[3]);
        *(LAS u32x4*)(lds + CW_OFF + k * 1024 + c8 * 2) = o; }
    float bias[8], gam[8], bet[8];
#pragma unroll
    for (int j = 0; j < 8; ++j) { bias[j] = cb[ch + j]; gam[j] = lg[ch + j]; bet[j] = lb[ch + j]; }
    for (int tile = blockIdx.x; tile < M / 32; tile += gridDim.x) {
        const int tok0 = tile * 32, t0 = tok0 & (T - 1);
        __syncthreads();
        for (int i = tid; i < 62 * 64; i += 512) { const int r = i >> 6, c8 = (i & 63) * 8; const int tt = t0 - 30 + r;
            u32x4 v = (u32x4){0u, 0u, 0u, 0u}; if (tt >= 0) v = *(const u32x4*)(H0 + (size_t)(tok0 - 30 + r) * 1024 + 512 + c8);
            *(LAS u32x4*)(lds + VT_OFF + r * 1024 + c8 * 2) = v; }
        for (int i = tid; i < 47 * 64; i += 512) { const int r = i >> 6, c8 = (i & 63) * 8; const int tt = t0 - 15 + r;
            u32x4 v = (u32x4){0u, 0u, 0u, 0u}; if (tt >= 0) v = *(const u32x4*)(H0 + (size_t)(tok0 - 15 + r) * 1024 + c8);
            *(LAS u32x4*)(lds + UT_OFF + r * 1024 + c8 * 2) = v; }
        __syncthreads();
        float acc[4][8];
#pragma unroll
        for (int j = 0; j < 4; ++j)
#pragma unroll
            for (int c = 0; c < 8; ++c) acc[j][c] = bias[c];
#pragma unroll 1
        for (int k = 0; k < 31; ++k) {
            float w[8]; unpack8(*(const LAS u32x4*)(lds + CW_OFF + k * 1024 + ch * 2), w);
#pragma unroll
            for (int j = 0; j < 4; ++j) { float v[8]; unpack8(*(const LAS u32x4*)(lds + VT_OFF + (4 * wave + j + k) * 1024 + ch * 2), v);
#pragma unroll
                for (int c = 0; c < 8; ++c) acc[j][c] += w[c] * v[c]; }
        }
        const int wnd = 2 << (lane >> 4);
#pragma unroll
        for (int j = 0; j < 4; ++j) {
            const int tl = 4 * wave + j, t = t0 + tl; const size_t tok = (size_t)tok0 + tl;
            const int cnt = (t + 1 < wnd) ? (t + 1) : wnd;
            float s[8], self[8];
            unpack8(*(const LAS u32x4*)(lds + UT_OFF + (15 + tl) * 1024 + ch * 2), self);
#pragma unroll
            for (int c = 0; c < 8; ++c) s[c] = self[c];
            for (int k = 1; k < cnt; ++k) { float v[8]; unpack8(*(const LAS u32x4*)(lds + UT_OFF + (15 + tl - k) * 1024 + ch * 2), v);
#pragma unroll
                for (int c = 0; c < 8; ++c) s[c] += v[c]; }
            const float inv = 1.0f / (float)cnt;
            u32x4 o; o.x = pk2(s[0] * inv - self[0], s[1] * inv - self[1]); o.y = pk2(s[2] * inv - self[2], s[3] * inv - self[3]);
            o.z = pk2(s[4] * inv - self[4], s[5] * inv - self[5]); o.w = pk2(s[6] * inv - self[6], s[7] * inv - self[7]);
            *(u32x4*)(CAT + tok * 1024 + ch) = o;
            float sm = 0.f;
#pragma unroll
            for (int c = 0; c < 8; ++c) sm += acc[j][c];
            const float mean = wave_sum(sm) * (1.0f / 512.0f);
            float sq = 0.f;
#pragma unroll
            for (int c = 0; c < 8; ++c) { acc[j][c] -= mean; sq += acc[j][c] * acc[j][c]; }
            const float rstd = rsqrtf(wave_sum(sq) * (1.0f / 512.0f) + LN_EPS);
            float y[8];
#pragma unroll
            for (int c = 0; c < 8; ++c) { const float z = acc[j][c] * rstd * gam[c] + bet[c]; y[c] = z * sigmoidf_(z); }
            u32x4 o2; o2.x = pk2(y[0], y[1]); o2.y = pk2(y[2], y[3]); o2.z = pk2(y[4], y[5]); o2.w = pk2(y[6], y[7]);
            *(u32x4*)(CAT + tok * 1024 + 512 + ch) = o2;
        }
    }
}


#define RT_DPPI(x, ctrl) __builtin_amdgcn_update_dpp((int)(x), (int)(x), (ctrl), 0xF, 0xF, true)
#define RT_DPPF(x, ctrl) __builtin_bit_cast(float, __builtin_amdgcn_update_dpp(__builtin_bit_cast(int, (float)(x)), __builtin_bit_cast(int, (float)(x)), (ctrl), 0xF, 0xF, true))
#define RT_LANEI(x, l) __builtin_amdgcn_readlane((int)(x), (l))
#define RT_LANEF(x, l) __builtin_bit_cast(float, __builtin_amdgcn_readlane(__builtin_bit_cast(int, (float)(x)), (l)))
__device__ __forceinline__ int RT_KEY(float x) { const int b = __builtin_bit_cast(int, x); return b ^ ((b >> 31) & 0x7fffffff); }
__device__ __forceinline__ void ph_route_fast(const float* LOG, const float* bias, unsigned* gcnt, int2* list, unsigned char* ldsg) {
    unsigned* hist = (unsigned*)ldsg; unsigned* base = hist + 256; u32x2* sel = (u32x2*)(ldsg + 2048);
    const int tid = threadIdx.x, lane = tid & 63, wave = tid >> 6;
    const float NEG = -INFINITY;
    const float4 bb = *(const float4*)(bias + lane * 4);
    for (int chunk = blockIdx.x; chunk < M / 128; chunk += gridDim.x) {
        __syncthreads();
        if (tid < 256) hist[tid] = 0u;
        __syncthreads();
        float4 lgn = *(const float4*)(LOG + (size_t)(chunk * 128 + wave * 16) * 256 + lane * 4);
        for (int i = 0; i < 16; ++i) {
            const int tl = wave * 16 + i, tok = chunk * 128 + tl;
            const float4 lg = lgn;
            if (i + 1 < 16) lgn = *(const float4*)(LOG + (size_t)(tok + 1) * 256 + lane * 4);
            const float s0 = sigmoidf_(lg.x), s1 = sigmoidf_(lg.y), s2 = sigmoidf_(lg.z), s3 = sigmoidf_(lg.w);
            const float v0 = s0 + bb.x + 0.0f, v1 = s1 + bb.y + 0.0f, v2 = s2 + bb.z + 0.0f, v3 = s3 + bb.w + 0.0f;
            float m1 = fmaxf(v0, v1), m2 = fminf(v0, v1);
            { const float hi = fmaxf(v2, v3), lo = fminf(v2, v3); const float n1 = fmaxf(m1, hi); const float n2 = fmaxf(fminf(m1, hi), fmaxf(m2, lo)); m1 = n1; m2 = n2; }
#define RT_STEP(ctrl) { const float a1 = RT_DPPF(m1, ctrl), a2 = RT_DPPF(m2, ctrl); const float n1 = fmaxf(m1, a1), n2 = fmaxf(fminf(m1, a1), fmaxf(m2, a2)); m1 = n1; m2 = n2; }
            RT_STEP(0xB1) RT_STEP(0x4E) RT_STEP(0x141)
#undef RT_STEP
            const float gs = m1 + m2; const int mygrp = lane >> 3;
            int rank = 0;
#pragma unroll
            for (int g2 = 0; g2 < 8; ++g2) { const float og = RT_LANEF(gs, g2 * 8); rank += (og > gs || (og == gs && g2 < mygrp)) ? 1 : 0; }
            const bool dead = rank >= 4;
            constexpr int KMIN = (int)0x80000000;
            int k0 = dead ? KMIN : RT_KEY(v0), k1 = dead ? KMIN : RT_KEY(v1), k2 = dead ? KMIN : RT_KEY(v2), k3 = dead ? KMIN : RT_KEY(v3);
            int my_e = 0; float my_s = 0.f;
#pragma unroll
            for (int it = 0; it < 8; ++it) {
                int lm = max(max(k0, k1), max(k2, k3));
                lm = max(lm, RT_DPPI(lm, 0xB1)); lm = max(lm, RT_DPPI(lm, 0x4E)); lm = max(lm, RT_DPPI(lm, 0x141)); lm = max(lm, RT_DPPI(lm, 0x140));
                const int gmax = max(max(RT_LANEI(lm, 0), RT_LANEI(lm, 16)), max(RT_LANEI(lm, 32), RT_LANEI(lm, 48)));
                int cand = (k0 == gmax) ? lane * 4 : (k1 == gmax) ? lane * 4 + 1 : (k2 == gmax) ? lane * 4 + 2 : (k3 == gmax) ? lane * 4 + 3 : 0x7fffffff;
                cand = min(cand, RT_DPPI(cand, 0xB1)); cand = min(cand, RT_DPPI(cand, 0x4E)); cand = min(cand, RT_DPPI(cand, 0x141)); cand = min(cand, RT_DPPI(cand, 0x140));
                const int bi = min(min(RT_LANEI(cand, 0), RT_LANEI(cand, 16)), min(RT_LANEI(cand, 32), RT_LANEI(cand, 48)));
                const int jj = bi & 3, ol = bi >> 2;
                const float mys = (jj == 0) ? s0 : (jj == 1) ? s1 : (jj == 2) ? s2 : s3;
                const float wsc = RT_LANEF(mys, ol);
                const bool me = (lane == ol);
                k0 = (me && jj == 0) ? KMIN : k0; k1 = (me && jj == 1) ? KMIN : k1; k2 = (me && jj == 2) ? KMIN : k2; k3 = (me && jj == 3) ? KMIN : k3;
                if (lane == it) { my_e = bi; my_s = wsc; }
            }
            const float ssum = wave_sum(lane < 8 ? my_s : 0.f);
            if (lane < 8) { const unsigned rk = atomicAdd(&hist[my_e], 1u); u32x2 en; en.x = (unsigned)my_e | (rk << 16); en.y = __float_as_uint(my_s / ssum * 2.5f); sel[tl * 8 + lane] = en; }
        }
        __syncthreads();
        if (tid < 256) { const unsigned h = hist[tid]; base[tid] = h ? atomicAdd(&gcnt[tid], h) : 0u; }
        __syncthreads();
#pragma unroll
        for (int rep = 0; rep < 2; ++rep) { const int idx = tid + rep * 512, tok = chunk * 128 + (idx >> 3), k = idx & 7;
            const u32x2 en = sel[idx]; const unsigned e = en.x & 0xffffu, pos = base[e] + (en.x >> 16);
            list[(size_t)e * LISTCAP + pos] = make_int2(tok * 10 + k, (int)en.y); }
    }
}

__global__ void __launch_bounds__(512, 2) fwd_kernel(Args a) {
    extern __shared__ __attribute__((aligned(16))) unsigned char lds[];
    volatile LAS unsigned* MISC = (volatile LAS unsigned*)((LAS unsigned char*)lds + (LDS_BYTES - 64));
    if (threadIdx.x < 16) MISC[threadIdx.x] = 0u;
    __syncthreads();
    unsigned* ctl = (unsigned*)(a.ws + WS_CTL);
#if MK_ONE_LAUNCH
    (void)xcd_barrier_post(ctl + CW_BAR, MISC + 8);
#define SEAM() do { XcdBarrier b_; b_.bar = (unsigned*)(a.ws + WS_CTL) + CW_BAR; b_.x = xb_xcc_id(); b_.st = MISC + 8; xcd_barrier(b_); } while (0)
#else
#define SEAM() do {} while (0)
#endif
    const int lo = a.ph_lo, hi = a.ph_hi;
#define IN(k) (lo <= (k) && (k) < hi)
#define BOTH(k) (IN(k) && (k) + 1 < hi)
#define X1 ((bf16_t*)(a.ws + WS_X1))
#define X2 ((bf16_t*)(a.ws + WS_X2))
#define LOG ((float*)(a.ws + WS_LOG))

    LAS unsigned char* L = (LAS unsigned char*)lds;
#define LIST ((int2*)(a.ws + WS_LIST))
#ifndef PROBE_DUP_MASK
#define PROBE_DUP_MASK 0u
#endif
#define RUN(k, ...) if (IN(k)) { { __VA_ARGS__ } if ((PROBE_DUP_MASK >> (k)) & 1u) { __syncthreads(); { __VA_ARGS__ } } if (BOTH(k)) SEAM(); }
    RUN(0, ph_prologue(a, L);)
    RUN(1, pg8::DenseSched S; S.init((const bf16_t*)(a.ws + WS_XA), D, (const bf16_t*)(a.ws + WS_WIN0), D, M, 1536);
           EpiInproj0 E{(bf16_t*)(a.ws + WS_H0)};
           pg8::gemm_phase<EpiInproj0, pg8::DenseSched, true>(L, D, 128u, S, E);)
    RUN(2, ph_convpool_fast(a, L);)
    RUN(4, pg8::DenseSched S; S.init((const bf16_t*)(a.ws + WS_CAT), D, (const bf16_t*)(a.ws + WS_WOUT0), D, M, D);
           EpiRes E{a.in[0], nullptr, (bf16_t*)(a.ws + WS_Y), 1.0f};
           pg8::gemm_phase<EpiRes, pg8::DenseSched, true>(L, D, 128u, S, E);)
    RUN(5, ph_ln((const bf16_t*)(a.ws + WS_Y), a.in[17], a.in[18], X1, (unsigned char*)(a.ws + WS_X8));)
#define MOE_LAYER(P, LAYER, XIN, XOUT, OUTF) \
    RUN(P, pg8::DenseSched S; S.init(XIN, D, (const bf16_t*)(a.ws + WS_WR) + (size_t)(LAYER) * NE * D, D, M, NE); \
           EpiLogits E{LOG}; pg8::gemm_phase<EpiLogits, pg8::DenseSched, true>(L, D, 128u, S, E);) \
    if (IN(P + 1)) { ph_route_fast(LOG, a.in[22] + (LAYER) * NE, ctl + CW_CNT + (LAYER) * 256, LIST, lds); if (BOTH(P + 1)) SEAM(); } \
    RUN(P + 2, const int R = moe_setup256(ctl + CW_CNT + (LAYER) * 256, L); \
            MoeGuSched S{(const char*)(a.ws + WS_X8), (const char*)(a.ws + WS_WGU) + (size_t)(LAYER) * 257 * 512 * 1024, LIST, L, R, (R + 128) * 2, (int)gridDim.x, (int)blockIdx.x}; \
            S.prepare(); EpiGateUp E{(unsigned char*)(a.ws + WS_HID)}; pg8::gemm_phase<EpiGateUp, MoeGuSched, true, true>(L, D / 2, 128u, S, E);) \
    RUN(P + 3, const int R = moe_setup256(ctl + CW_CNT + (LAYER) * 256, L); \
            MoeDownSched S{(const char*)(a.ws + WS_HID), (const char*)(a.ws + WS_WD) + (size_t)(LAYER) * 257 * 1024 * 256, LIST, L, R, R + 128, (int)gridDim.x, (int)blockIdx.x}; \
            S.prepare(); EpiDown E{(unsigned char*)(a.ws + WS_YB), L}; pg8::gemm_phase<EpiDown, MoeDownSched, true, true>(L, FF / 2, 128u, S, E);) \
    RUN(P + 4, ph_combine(a, XIN, a.in[19] + (LAYER) * D, a.in[20] + (LAYER) * D, XOUT, OUTF);)
    MOE_LAYER(6, 0, X1, X2, nullptr)
    RUN(11, pg8::DenseSched S; S.init(X2, D, (const bf16_t*)(a.ws + WS_WINN), D, M, HNW);
            EpiInprojN E{(bf16_t*)(a.ws + WS_HN), (bf16_t*)(a.ws + WS_QR), (bf16_t*)(a.ws + WS_KV6), (float*)(a.ws + WS_GATES), (const float*)(a.ws + WS_MISC) + 1024};
            pg8::gemm_phase<EpiInprojN, pg8::DenseSched, true>(L, D, 128u, S, E);)
    RUN(13, Cmp1Sched S{(const char*)(a.ws + WS_KV6), (const char*)(a.ws + WS_CW1), (int)gridDim.x, (int)blockIdx.x};
            EpiCmp1 E{(bf16_t*)(a.ws + WS_CH1), (const float*)(a.ws + WS_MISC)};
            pg8::gemm_phase<EpiCmp1, Cmp1Sched, true>(L, 2048, 128u, S, E); ph_knorm(a);)
    RUN(14, ph_cmp2(a, lds);)
    RUN(15, ph_attn_fast2(a, L);)
    RUN(16, pg8::DenseSched S; S.init((const bf16_t*)(a.ws + WS_O8), D / 2, (const bf16_t*)(a.ws + WS_WOUTN), D / 2, M, D);
            EpiRes E{nullptr, X2, (bf16_t*)(a.ws + WS_Y2), 1.0f / (X8_SCALE * W8_SCALE)};
            pg8::gemm_phase<EpiRes, pg8::DenseSched, true, true>(L, D / 2, 128u, S, E);)
    RUN(17, ph_ln((const bf16_t*)(a.ws + WS_Y2), a.in[17] + D, a.in[18] + D, X1, (unsigned char*)(a.ws + WS_X8));)
    MOE_LAYER(18, 1, X1, (bf16_t*)nullptr, a.out)
}

extern "C" void kernel_launch(void* const* d_in, const int* in_sizes, int n_in, void* d_out, int out_size, void* d_ws, size_t ws_size, hipStream_t stream) {
    static int grid = 0;
    if (grid == 0) {
        if (n_in != 29 || out_size != M * D || ws_size < WS_END) { fprintf(stderr, "kernel_launch: unexpected problem (n_in %d out %d ws %zu)\n", n_in, out_size, ws_size); grid = -1; return; }
        int dev = 0, cus = 0;
        if (hipGetDevice(&dev) != hipSuccess || hipDeviceGetAttribute(&cus, hipDeviceAttributeMultiprocessorCount, dev) != hipSuccess) { grid = -1; return; }
        if (hipFuncSetAttribute((const void*)fwd_kernel, hipFuncAttributeMaxDynamicSharedMemorySize, LDS_BYTES) != hipSuccess) { grid = -1; return; }
        int per_cu = 0;
        (void)hipOccupancyMaxActiveBlocksPerMultiprocessor(&per_cu, (const void*)fwd_kernel, 512, LDS_BYTES);
        (void)hipGetLastError();
        grid = cus;
    }
    if (grid < 0) return;
    (void)hipMemsetAsync((char*)d_ws + WS_CTL, 0, CTL_BYTES, stream);
    Args a{};
    for (int i = 0; i < 29; ++i) a.in[i] = (const float*)d_in[i];
    a.out = (float*)d_out; a.ws = (unsigned char*)d_ws;
    for (int i = 0; i < 8; ++i) a.inv_freq[i] = powf(500000.0f, -(float)(2 * i) / 16.0f);
#if MK_ONE_LAUNCH
    a.ph_lo = 0; a.ph_hi = NPHASE;
    hipLaunchKernelGGL(fwd_kernel, dim3(grid), dim3(512), LDS_BYTES, stream, a);
#else
    for (int p = 0; p < NPHASE; ++p) { a.ph_lo = p; a.ph_hi = p + 1; hipLaunchKernelGGL(fwd_kernel, dim3(grid), dim3(512), LDS_BYTES, stream, a); }
#endif
}
```

```cpp
#include <hip/hip_runtime.h>
#include <cstdint>
#include <cstdio>
#include <cmath>

#ifndef MK_ONE_LAUNCH
#define MK_ONE_LAUNCH 1
#endif

#define LAS __attribute__((address_space(3)))
typedef unsigned short bf16_t;
typedef short bf16x8 __attribute__((ext_vector_type(8)));
typedef float f32x4 __attribute__((ext_vector_type(4)));
typedef unsigned u32x2 __attribute__((ext_vector_type(2)));
typedef unsigned u32x4 __attribute__((ext_vector_type(4)));

constexpr int NB = 4, T = 8192, D = 1024, M = NB * T;
constexpr int NE = 256, TOPK = 8, FF = 256;
constexpr int HNW = 2816;
constexpr int LISTCAP = 32768;
constexpr float ALPHA = 1.4142135623730951f;
constexpr float LN_EPS = 1e-5f;
constexpr float QSCALE = 0.125f * 1.4426950408889634f;
constexpr int YB_NSLOT = 9;
constexpr float YB_SCALE = 16.0f;
constexpr int NPHASE = 23;

constexpr size_t MiB = 1u << 20;
constexpr size_t WS_CTL = 0, CTL_BYTES = 1 * MiB;
constexpr size_t WS_X1 = 1 * MiB;
constexpr size_t WS_X2 = WS_X1 + 64 * MiB;
constexpr size_t WS_LOG = WS_X2 + 64 * MiB;
constexpr size_t WS_LIST = WS_LOG + 32 * MiB;
constexpr size_t WS_WTS = WS_LIST + 64 * MiB;
constexpr size_t WS_HID = WS_WTS + 2 * MiB;
constexpr size_t WS_YB = WS_HID + 184 * MiB;
constexpr size_t WS_END_NAIVE = WS_YB + 576 * MiB;
constexpr size_t WS_WIN0 = WS_END_NAIVE;
constexpr size_t WS_WOUT0 = WS_WIN0 + 3 * MiB;
constexpr size_t WS_WINN = WS_WOUT0 + 2 * MiB;
constexpr size_t WS_WOUTN = WS_WINN + 6 * MiB;
constexpr size_t WS_WR = WS_WOUTN + 2 * MiB;
constexpr size_t WS_CW1 = WS_WR + 1 * MiB;
constexpr size_t WS_MISC = WS_CW1 + 2 * MiB;
constexpr size_t WS_WGU = WS_MISC + 1 * MiB;
constexpr size_t WS_X8 = WS_WGU + 257 * MiB;
constexpr size_t WS_O8 = WS_X8 + 32 * MiB;
constexpr float X8_SCALE = 8.0f, W8_SCALE = 64.0f, H8_SCALE = 16.0f;
constexpr size_t WS_WD = WS_WGU + 514 * MiB;
constexpr size_t WS_END = WS_WD + 257 * MiB;
constexpr size_t WS_XA = WS_X2;
constexpr size_t WS_H0 = WS_YB;
constexpr size_t WS_PM = WS_H0 + 64 * MiB;
constexpr size_t WS_CAT = WS_PM + 32 * MiB;
constexpr size_t WS_Y = WS_CAT + 64 * MiB;
constexpr size_t WS_HN = WS_YB;
constexpr size_t WS_KV6 = WS_HN + 64 * MiB;
constexpr size_t WS_QR = WS_HN + 176 * MiB;
constexpr size_t WS_GATES = WS_QR + 64 * MiB;
constexpr size_t WS_CH1 = WS_GATES + 8 * MiB;
constexpr size_t WS_KC = WS_CH1 + 4 * MiB;
constexpr size_t WS_O = WS_KC + 2 * MiB;
constexpr size_t WS_Y2 = WS_O + 64 * MiB;
static_assert(WS_Y2 + 64 * MiB <= WS_END_NAIVE, "overlay");
static_assert(WS_Y + 64 * MiB <= WS_END_NAIVE, "overlay");

constexpr int CW_CNT = 64;
constexpr int CW_BAR = 4096;

constexpr int LDS_BYTES = 163840;

__device__ __forceinline__ float bf2f(bf16_t h) { return __uint_as_float(((unsigned)h) << 16); }
__device__ __forceinline__ bf16_t f2bf(float f) { unsigned u = __float_as_uint(f); return (bf16_t)((u + 0x7fffu + ((u >> 16) & 1u)) >> 16); }
__device__ __forceinline__ unsigned pk2(float lo, float hi) { return (unsigned)f2bf(lo) | ((unsigned)f2bf(hi) << 16); }
#define WR_DPP(x, ctrl) __builtin_bit_cast(float, __builtin_amdgcn_update_dpp(__builtin_bit_cast(int, (float)(x)), __builtin_bit_cast(int, (float)(x)), (ctrl), 0xF, 0xF, true))
#define WR_ROW(x, r) __builtin_bit_cast(float, __builtin_amdgcn_readlane(__builtin_bit_cast(int, (float)(x)), 16 * (r)))
__device__ __forceinline__ float wave_sum(float v) {
    v += WR_DPP(v, 0xB1); v += WR_DPP(v, 0x4E); v += WR_DPP(v, 0x141); v += WR_DPP(v, 0x140);
    return (WR_ROW(v, 0) + WR_ROW(v, 1)) + (WR_ROW(v, 2) + WR_ROW(v, 3));
}
__device__ __forceinline__ float wave_max(float v) {
    v = fmaxf(v, WR_DPP(v, 0xB1)); v = fmaxf(v, WR_DPP(v, 0x4E)); v = fmaxf(v, WR_DPP(v, 0x141)); v = fmaxf(v, WR_DPP(v, 0x140));
    return fmaxf(fmaxf(WR_ROW(v, 0), WR_ROW(v, 1)), fmaxf(WR_ROW(v, 2), WR_ROW(v, 3)));
}
__device__ __forceinline__ float sigmoidf_(float x) { return 1.0f / (1.0f + __expf(-x)); }
__device__ __forceinline__ float gelu_tanh(float x) {
    const float u = 0.7978845608028654f * (x + 0.044715f * x * x * x);
    const float e = __expf(2.0f * u);
    const float th = 1.0f - 2.0f / (e + 1.0f);
    return 0.5f * x * (1.0f + th);
}
__device__ __forceinline__ bf16x8 cvt8(const float* p) {
    const float4 a = *(const float4*)p, b = *(const float4*)(p + 4);
    bf16x8 r;
    r[0] = (short)f2bf(a.x); r[1] = (short)f2bf(a.y); r[2] = (short)f2bf(a.z); r[3] = (short)f2bf(a.w);
    r[4] = (short)f2bf(b.x); r[5] = (short)f2bf(b.y); r[6] = (short)f2bf(b.z); r[7] = (short)f2bf(b.w);
    return r;
}
__device__ __forceinline__ bf16x8 colk8(const float* W, int N, int k, int col) {
    bf16x8 r;
#pragma unroll
    for (int j = 0; j < 8; ++j) r[j] = (short)f2bf(W[(size_t)(k + j) * N + col]);
    return r;
}
__device__ __forceinline__ bf16x8 zero8() { return (bf16x8){0, 0, 0, 0, 0, 0, 0, 0}; }
#define WSYNC() asm volatile("s_waitcnt lgkmcnt(0)" ::: "memory")

#define XB_TMO      128
#define XB_XCNT(j)  (256  + 64 * (j))
#define XB_XSUB(j)  (1280 + 64 * (j))
#define XB_XGEN(j)  (2304 + 64 * (j))
#define XB_TOP      3328
#define XB_TOPGEN   3392
#define XCD_BAR_WORDS 3456
#define XB_SPIN_CAP (1u << 22)
__device__ __forceinline__ unsigned xb_ld(unsigned* p)              { return __hip_atomic_load(p, __ATOMIC_RELAXED, __HIP_MEMORY_SCOPE_AGENT); }
__device__ __forceinline__ unsigned xb_add(unsigned* p, unsigned v) { return __hip_atomic_fetch_add(p, v, __ATOMIC_RELAXED, __HIP_MEMORY_SCOPE_AGENT); }
__device__ __forceinline__ unsigned xb_xcc_id() { return (unsigned)__builtin_amdgcn_s_getreg((3 << 11) | 20) & 0xFu; }
#define XB_SPIN(cond, bar) do { unsigned _sp = 0; while (cond) { __builtin_amdgcn_s_sleep(1); \
    if ((++_sp & 255u) == 0u) { if (xb_ld(&(bar)[XB_TMO])) break; if (_sp > XB_SPIN_CAP) { atomicAdd(&(bar)[XB_TMO], 1u); break; } } } } while (0)
struct XcdBarrier { unsigned* bar; unsigned x; volatile LAS unsigned* st; };
__device__ __forceinline__ XcdBarrier xcd_barrier_post(unsigned* bar, volatile LAS unsigned* st) {
    XcdBarrier b; b.bar = bar; b.x = xb_xcc_id(); b.st = st;
    if (threadIdx.x == 0) (void)xb_add(&bar[XB_XCNT(b.x)], 1u);
    return b;
}
__device__ __forceinline__ void xcd_barrier_complete(unsigned* bar, unsigned x, unsigned& nloc, unsigned& nx) {
    const unsigned G = gridDim.x * gridDim.y * gridDim.z;
    unsigned sum, cnt, mine, sp = 0u;
    for (;;) {
        sum = 0u; cnt = 0u; mine = 0u;
#pragma unroll
        for (unsigned j = 0; j < 16; ++j) { const unsigned c = xb_ld(&bar[XB_XCNT(j)]); sum += c; cnt += (c > 0u) ? 1u : 0u; mine = (j == x) ? c : mine; }
        if (sum == G) break;
        __builtin_amdgcn_s_sleep(1);
        if ((++sp & 255u) == 0u) { if (xb_ld(&bar[XB_TMO])) break; if (sp > XB_SPIN_CAP) { atomicAdd(&bar[XB_TMO], 1u); break; } }
    }
    nloc = mine > 0u ? mine : 1u; nx = cnt > 0u ? cnt : 1u;
}
__device__ __forceinline__ void xcd_barrier(const XcdBarrier& b) {
    asm volatile("s_waitcnt vmcnt(0)" ::: "memory");
    __syncthreads();
    if (threadIdx.x == 0) {
        unsigned* bar = b.bar;
        __builtin_amdgcn_s_waitcnt(0);
        unsigned nloc = b.st[0], nx = b.st[1];
        if (nloc == 0u) { xcd_barrier_complete(bar, b.x, nloc, nx); b.st[0] = nloc; b.st[1] = nx; }
        const unsigned old = xb_add(&bar[XB_XSUB(b.x)], 1u);
        const unsigned gen = old / nloc;
        if (old + 1u == (gen + 1u) * nloc) {
            __builtin_amdgcn_fence(__ATOMIC_RELEASE, "agent");
            asm volatile("s_waitcnt vmcnt(0)" ::: "memory");
            const unsigned og = xb_add(&bar[XB_TOP], 1u);
            const unsigned tg = og / nx;
            if (og + 1u == (tg + 1u) * nx) xb_add(&bar[XB_TOPGEN], 1u);
            else XB_SPIN(xb_ld(&bar[XB_TOPGEN]) == tg, bar);
            __builtin_amdgcn_fence(__ATOMIC_ACQUIRE, "agent");
            xb_add(&bar[XB_XGEN(b.x)], 1u);
            asm volatile("s_waitcnt vmcnt(0)" ::: "memory");
        } else {
            XB_SPIN(xb_ld(&bar[XB_XGEN(b.x)]) == gen, bar);
            __builtin_amdgcn_fence(__ATOMIC_ACQUIRE, "agent");
            asm volatile("s_waitcnt vmcnt(0)" ::: "memory");
        }
    }
    __syncthreads();
}

template <class AL, class BL, class EP>
__device__ __forceinline__ void mgemm_tile(unsigned char* lds, int K, const AL& al, const BL& bl, const EP& ep) {
    bf16_t* As = (bf16_t*)lds;
    bf16_t* Bs = As + 128 * 40;
    const int tid = threadIdx.x, lane = tid & 63, wave = tid >> 6;
    const int ar = tid >> 2, ac = (tid & 3) * 8;
    const int bn = tid & 127, bc = (tid >> 7) * 8;
    f32x4 acc[8];
#pragma unroll
    for (int s = 0; s < 8; ++s) acc[s] = (f32x4){0.f, 0.f, 0.f, 0.f};
    bf16x8 ra = al(ac), rb = bl(bc);
    for (int k0 = 0; k0 < K; k0 += 32) {
        __syncthreads();
        *(bf16x8*)(As + ar * 40 + ac) = ra;
        *(bf16x8*)(Bs + bn * 40 + bc) = rb;
        __syncthreads();
        if (k0 + 32 < K) { ra = al(k0 + 32 + ac); rb = bl(k0 + 32 + bc); }
        const bf16x8 af = *(const bf16x8*)(As + (wave * 16 + (lane & 15)) * 40 + (lane >> 4) * 8);
#pragma unroll
        for (int s = 0; s < 8; ++s) {
            const bf16x8 wf = *(const bf16x8*)(Bs + (16 * s + (lane & 15)) * 40 + (lane >> 4) * 8);
            acc[s] = __builtin_amdgcn_mfma_f32_16x16x32_bf16(wf, af, acc[s], 0, 0, 0);
        }
    }
    ep(wave * 16 + (lane & 15), (lane >> 4) * 4, acc);
}
__device__ __forceinline__ void store4bf(bf16_t* p, const f32x4 v) { u32x2 w; w.x = pk2(v[0], v[1]); w.y = pk2(v[2], v[3]); *(u32x2*)p = w; }

struct Args {
    const float* in[29];
    float* out;
    unsigned char* ws;
    float inv_freq[8];
    int ph_lo, ph_hi;
};

__device__ __forceinline__ unsigned pk4_fp8(float a, float b, float c, float d) { int w = __builtin_amdgcn_cvt_pk_fp8_f32(a, b, 0, false); return (unsigned)__builtin_amdgcn_cvt_pk_fp8_f32(c, d, w, true); }
__device__ __forceinline__ u32x2 pack8_fp8(const f32x4 v0, const f32x4 v1) {
    int a = __builtin_amdgcn_cvt_pk_fp8_f32(v0[0], v0[1], 0, false); a = __builtin_amdgcn_cvt_pk_fp8_f32(v0[2], v0[3], a, true);
    int b = __builtin_amdgcn_cvt_pk_fp8_f32(v1[0], v1[1], 0, false); b = __builtin_amdgcn_cvt_pk_fp8_f32(v1[2], v1[3], b, true);
    u32x2 w; w.x = (unsigned)a; w.y = (unsigned)b; return w;
}
__device__ __forceinline__ float clamp8(float v) { return __builtin_amdgcn_fmed3f(v, -448.0f, 448.0f); }
__device__ __forceinline__ void ph_ln(const bf16_t* Y, const float* g, const float* b, bf16_t* X, unsigned char* X8) {
    const int lane = threadIdx.x & 63, wave = threadIdx.x >> 6;
    const int gw = blockIdx.x * 8 + wave, ngw = gridDim.x * 8;
    float gg[16], bb[16];
#pragma unroll
    for (int j = 0; j < 8; ++j) { gg[j] = g[lane * 8 + j]; gg[8 + j] = g[512 + lane * 8 + j]; bb[j] = b[lane * 8 + j]; bb[8 + j] = b[512 + lane * 8 + j]; }
    for (int row0 = gw * 4; row0 < M; row0 += ngw * 4) {
        bf16x8 p0[4], p1[4];
#pragma unroll
        for (int r = 0; r < 4; ++r) { p0[r] = __builtin_nontemporal_load((const bf16x8*)(Y + (size_t)(row0 + r) * 1024 + lane * 8)); p1[r] = __builtin_nontemporal_load((const bf16x8*)(Y + (size_t)(row0 + r) * 1024 + 512 + lane * 8)); }
#pragma unroll
        for (int r = 0; r < 4; ++r) {
            float v[16];
#pragma unroll
            for (int j = 0; j < 8; ++j) { v[j] = bf2f((bf16_t)p0[r][j]); v[8 + j] = bf2f((bf16_t)p1[r][j]); }
            float s = 0.f;
#pragma unroll
            for (int j = 0; j < 16; ++j) s += v[j];
            const float mean = wave_sum(s) * (1.0f / 1024.0f);
            float q = 0.f;
#pragma unroll
            for (int j = 0; j < 16; ++j) { v[j] -= mean; q += v[j] * v[j]; }
            const float rstd = rsqrtf(wave_sum(q) * (1.0f / 1024.0f) + LN_EPS);
            float o[16];
#pragma unroll
            for (int j = 0; j < 16; ++j) o[j] = v[j] * rstd * gg[j] + bb[j];
            u32x4 w0, w1;
            w0.x = pk2(o[0], o[1]); w0.y = pk2(o[2], o[3]); w0.z = pk2(o[4], o[5]); w0.w = pk2(o[6], o[7]);
            w1.x = pk2(o[8], o[9]); w1.y = pk2(o[10], o[11]); w1.z = pk2(o[12], o[13]); w1.w = pk2(o[14], o[15]);
            *(u32x4*)(X + (size_t)(row0 + r) * 1024 + lane * 8) = w0; *(u32x4*)(X + (size_t)(row0 + r) * 1024 + 512 + lane * 8) = w1;
#pragma unroll
            for (int j = 0; j < 16; ++j) o[j] = clamp8(o[j] * X8_SCALE);
            u32x2 q0, q1; q0.x = pk4_fp8(o[0], o[1], o[2], o[3]); q0.y = pk4_fp8(o[4], o[5], o[6], o[7]); q1.x = pk4_fp8(o[8], o[9], o[10], o[11]); q1.y = pk4_fp8(o[12], o[13], o[14], o[15]);
            *(u32x2*)(X8 + (size_t)(row0 + r) * 1024 + lane * 8) = q0; *(u32x2*)(X8 + (size_t)(row0 + r) * 1024 + 512 + lane * 8) = q1;
        }
    }
}

__device__ __forceinline__ void ph_combine(const Args& a, const bf16_t* X, const float* g, const float* b, bf16_t* Xo, float* outf) {
    const unsigned char* YB = (const unsigned char*)(a.ws + WS_YB);
    const int lane = threadIdx.x & 63, wave = threadIdx.x >> 6;
    const int gw = blockIdx.x * 8 + wave, ngw = gridDim.x * 8;
    for (int row = gw; row < M; row += ngw) {
        float v[16];
#pragma unroll
        for (int j = 0; j < 16; ++j) v[j] = 0.f;
        u32x2 q0[YB_NSLOT], q1[YB_NSLOT];
#pragma unroll
        for (int k = 0; k < YB_NSLOT; ++k) { const unsigned char* yr = YB + ((size_t)row * 10 + k) * 1024; q0[k] = __builtin_nontemporal_load((const u32x2*)(yr + lane * 8)); q1[k] = __builtin_nontemporal_load((const u32x2*)(yr + 512 + lane * 8)); }
#pragma unroll
        for (int k = 0; k < YB_NSLOT; ++k) {
            const auto a0 = __builtin_amdgcn_cvt_pk_f32_fp8((int)q0[k].x, false), a1 = __builtin_amdgcn_cvt_pk_f32_fp8((int)q0[k].x, true), a2 = __builtin_amdgcn_cvt_pk_f32_fp8((int)q0[k].y, false), a3 = __builtin_amdgcn_cvt_pk_f32_fp8((int)q0[k].y, true);
            const auto b0 = __builtin_amdgcn_cvt_pk_f32_fp8((int)q1[k].x, false), b1 = __builtin_amdgcn_cvt_pk_f32_fp8((int)q1[k].x, true), b2 = __builtin_amdgcn_cvt_pk_f32_fp8((int)q1[k].y, false), b3 = __builtin_amdgcn_cvt_pk_f32_fp8((int)q1[k].y, true);
            v[0] += a0[0]; v[1] += a0[1]; v[2] += a1[0]; v[3] += a1[1]; v[4] += a2[0]; v[5] += a2[1]; v[6] += a3[0]; v[7] += a3[1];
            v[8] += b0[0]; v[9] += b0[1]; v[10] += b1[0]; v[11] += b1[1]; v[12] += b2[0]; v[13] += b2[1]; v[14] += b3[0]; v[15] += b3[1];
        }
        {
            const bf16x8 p0 = *(const bf16x8*)(X + (size_t)row * 1024 + lane * 8), p1 = *(const bf16x8*)(X + (size_t)row * 1024 + 512 + lane * 8);
#pragma unroll
            for (int j = 0; j < 8; ++j) { v[j] = v[j] * (1.0f / YB_SCALE) + ALPHA * bf2f((bf16_t)p0[j]); v[8 + j] = v[8 + j] * (1.0f / YB_SCALE) + ALPHA * bf2f((bf16_t)p1[j]); }
        }
        float s = 0.f;
#pragma unroll
        for (int j = 0; j < 16; ++j) s += v[j];
        const float mean = wave_sum(s) * (1.0f / 1024.0f);
        float q = 0.f;
#pragma unroll
        for (int j = 0; j < 16; ++j) { v[j] -= mean; q += v[j] * v[j]; }
        const float rstd = rsqrtf(wave_sum(q) * (1.0f / 1024.0f) + LN_EPS);
        float o[16];
#pragma unroll
        for (int j = 0; j < 8; ++j) { o[j] = v[j] * rstd * g[lane * 8 + j] + b[lane * 8 + j]; o[8 + j] = v[8 + j] * rstd * g[512 + lane * 8 + j] + b[512 + lane * 8 + j]; }
        if (outf) {
            float* op = outf + (size_t)row * 1024;
            *(float4*)(op + lane * 8) = make_float4(o[0], o[1], o[2], o[3]); *(float4*)(op + lane * 8 + 4) = make_float4(o[4], o[5], o[6], o[7]);
            *(float4*)(op + 512 + lane * 8) = make_float4(o[8], o[9], o[10], o[11]); *(float4*)(op + 512 + lane * 8 + 4) = make_float4(o[12], o[13], o[14], o[15]);
        } else {
            u32x4 w0, w1;
            w0.x = pk2(o[0], o[1]); w0.y = pk2(o[2], o[3]); w0.z = pk2(o[4], o[5]); w0.w = pk2(o[6], o[7]);
            w1.x = pk2(o[8], o[9]); w1.y = pk2(o[10], o[11]); w1.z = pk2(o[12], o[13]); w1.w = pk2(o[14], o[15]);
            *(u32x4*)(Xo + (size_t)row * 1024 + lane * 8) = w0; *(u32x4*)(Xo + (size_t)row * 1024 + 512 + lane * 8) = w1;
        }
    }
}

__device__ __forceinline__ void ph_cmp2(const Args& a, unsigned char* lds) {
    const bf16_t* CH1 = (const bf16_t*)(a.ws + WS_CH1);
    bf16_t* KC = (bf16_t*)(a.ws + WS_KC);
    const int tid = threadIdx.x;
    for (int u = blockIdx.x; u < 64 * 2; u += gridDim.x) {
        const int rt = u >> 1, kv = u & 1;
        const bf16_t* ar = CH1 + ((size_t)kv * 8192 + rt * 128 + (tid >> 2)) * 128;
        const float* w2 = a.in[kv ? 15 : 12];
        const int col = tid & 127;
        auto al = [&](int k) { return *(const bf16x8*)(ar + k); };
        auto bl = [&](int k) { return (col < 64) ? colk8(w2, 64, k, col) : zero8(); };
        auto ep = [&](int r, int cb, const f32x4 (&acc)[8]) {
            bf16_t* o = KC + ((size_t)kv * 8192 + rt * 128 + r) * 64;
#pragma unroll
            for (int s = 0; s < 4; ++s) store4bf(o + 16 * s + cb, acc[s]);
        };
        mgemm_tile(lds, 128, al, bl, ep);
    }
}

namespace pg8 {
constexpr int BM = 256, BK = 64, HALF = 128, HTB = HALF * BK * 2, STAGE_BYTES = 8 * HTB;
__device__ __forceinline__ int lds_byte(int r, int c) { const int st = (r >> 4) * 2 + (c >> 5), rr = r & 15, cc = c & 31, ob = rr * 64 + cc * 2; return st * 1024 + (ob ^ (((ob >> 9) & 1) << 5)); }
__device__ __forceinline__ void stage_rc(int b, int& R, int& C) { const int st = b / 1024, sb = b % 1024, swz = sb ^ (((sb >> 9) & 1) << 5); R = (st >> 1) * 16 + swz / 64; C = (st & 1) * 32 + (swz % 64) / 2; }
__device__ __forceinline__ int perm32(int rho) { const int n = rho >> 4, i = rho & 15; return 8 * (i >> 2) + 4 * n + (i & 3); }
struct Unit { int pm, pn, ord; };
typedef float f32x16 __attribute__((ext_vector_type(16)));
typedef int i32x8 __attribute__((ext_vector_type(8))); typedef int i32x4_ __attribute__((ext_vector_type(4)));
__device__ __forceinline__ i32x8 f8cat(const bf16x8 lo, const bf16x8 hi) { return __builtin_shufflevector(__builtin_bit_cast(i32x4_, lo), __builtin_bit_cast(i32x4_, hi), 0, 1, 2, 3, 4, 5, 6, 7); }
template <class Epi, class Sched, bool ALIGN_EPI, bool F8 = false>
__device__ __forceinline__ void gemm_phase(LAS unsigned char* lds, const int K, const unsigned kstepA, const Sched& S, const Epi& E, const int Kpitch = 0) {
    const int KP = Kpitch ? Kpitch : K;
    const int tid = threadIdx.x, wid = __builtin_amdgcn_readfirstlane(tid >> 6), lane = tid & 63, wr = wid >> 2, wc = wid & 3, fr = lane & 15, fq = lane >> 4;
    const int nt = K / BK;
    constexpr bool GA = Sched::GATHER;
    int RA[2]; unsigned CA2[2], voffB[2], voffB1[2], voffA[2];
    constexpr bool P16 = Epi::PERM16;
#pragma unroll
    for (int i = 0; i < 2; ++i) { int R, C; stage_rc(tid * 16 + i * 8192, R, C); const int Rb = Epi::PERM ? ((R & ~31) + perm32(R & 31)) : R;
        RA[i] = R; CA2[i] = (unsigned)C * 2u; voffB[i] = (unsigned)(Rb * KP + C) * 2u; voffA[i] = GA ? 0u : (S.lane_off(R) + (unsigned)C * 2u);
        if (P16) { const int c16 = 64 * (R >> 5) + 16 * ((R >> 2) & 3) + 4 * ((R >> 4) & 1) + (R & 3); voffB[i] = (unsigned)(c16 * KP + C) * 2u; voffB1[i] = (unsigned)((c16 + 8) * KP + C) * 2u; } else voffB1[i] = 0u; }
    const size_t kstepB = (size_t)(BK * 2);
    const size_t hstepB = (size_t)HALF * KP * 2;
    const unsigned ldsw = (unsigned)wid * 1024u;
    const int aoff = lds_byte(wr * 64 + fr, fq * 8), boff = lds_byte(wc * 32 + fr, fq * 8);
    const char* const Ab = S.abase();
    unsigned aoC[2][2], aoN[2][2];
    unsigned uC[2], uN[2];
#define PG8_SA(b, h) (((b) * 2 + (h)) * HTB)
#define PG8_SB(b, h) ((4 + (b) * 2 + (h)) * HTB)
#define PG8_GLDS(sbase, voff, ldsoff) do { const char* _b = (const char*)(sbase); unsigned _v = (voff); asm volatile("" : "+s"(_b), "+v"(_v)); \
        __builtin_amdgcn_global_load_lds((const unsigned*)(_b + _v), (LAS unsigned*)(lds + (ldsoff)), 16, 0, 0); } while (0)
#define PG8_STAGE_B(bufoff, gbase) do { _Pragma("unroll") for (int _i = 0; _i < 2; ++_i) PG8_GLDS(gbase, voffB[_i], (bufoff) + ldsw + _i * 8192); } while (0)
#define PG8_STAGE_B1(bufoff, gbase) do { _Pragma("unroll") for (int _i = 0; _i < 2; ++_i) PG8_GLDS((const char*)(gbase) + (P16 ? (size_t)0 : hstepB), (P16 ? voffB1[_i] : voffB[_i]), (bufoff) + ldsw + _i * 8192); } while (0)
#define PG8_STAGE_A(bufoff, kb, UO, LO) do { _Pragma("unroll") for (int _i = 0; _i < 2; ++_i) PG8_GLDS(Ab + (size_t)((kb) + (UO)), (GA ? (LO)[_i] : voffA[_i]), (bufoff) + ldsw + _i * 8192); } while (0)
#define PG8_LDA(dst, b, h) do { _Pragma("unroll") for (int m = 0; m < 4; ++m) _Pragma("unroll") for (int k = 0; k < 2; ++k) dst[m][k] = *(const LAS bf16x8*)(lds + PG8_SA(b, h) + aoff + m * 2048 + k * 1024); } while (0)
#define PG8_LDB(dst, b, h) do { _Pragma("unroll") for (int n = 0; n < 2; ++n) _Pragma("unroll") for (int k = 0; k < 2; ++k) dst[n][k] = *(const LAS bf16x8*)(lds + PG8_SB(b, h) + boff + n * 2048 + k * 1024); } while (0)
#define PG8_MMA(ai, bj, At, Bt) do { __builtin_amdgcn_s_setprio(1); _Pragma("unroll") for (int m = 0; m < 4; ++m) _Pragma("unroll") for (int n = 0; n < 2; ++n) { \
        if constexpr (F8) { f32x16& _w = accw[ai][bj][m >> 1]; const int _q = ((m & 1) * 2 + n) * 4; f32x4 _c = {_w[_q], _w[_q + 1], _w[_q + 2], _w[_q + 3]}; \
            _c = __builtin_amdgcn_mfma_scale_f32_16x16x128_f8f6f4(f8cat(Bt[n][0], Bt[n][1]), f8cat(At[m][0], At[m][1]), _c, 0, 0, 0, 0, 0, 0); _w[_q] = _c[0]; _w[_q + 1] = _c[1]; _w[_q + 2] = _c[2]; _w[_q + 3] = _c[3]; } \
        else { _Pragma("unroll") for (int k = 0; k < 2; ++k) acc[ai][bj][m][n] = __builtin_amdgcn_mfma_f32_16x16x32_bf16(Bt[n][k], At[m][k], acc[ai][bj][m][n], 0, 0, 0); } } __builtin_amdgcn_s_setprio(0); } while (0)
#define PG8_WAIT_V(n) asm volatile("s_waitcnt vmcnt(" #n ")" ::: "memory")
#define PG8_WAIT_L(n) asm volatile("s_waitcnt lgkmcnt(" #n ")" ::: "memory")
#define PG8_BAR __builtin_amdgcn_s_barrier()
#define PG8_SCHED __builtin_amdgcn_sched_barrier(0)
#define PG8_KPAIR(KB1, KB2, KB3, BP2, BP3) do { \
            PG8_LDB(B0, 0, 0); PG8_LDB(B1, 0, 1); PG8_SCHED; PG8_LDA(At, 0, 0); PG8_STAGE_A(PG8_SA(1, 1), KB1, uC[1], aoC[1]); \
            PG8_WAIT_V(8); PG8_WAIT_L(0); PG8_BAR; PG8_MMA(0, 0, At, B0); PG8_MMA(0, 1, At, B1); PG8_BAR; PG8_SCHED; \
            PG8_LDA(At, 0, 1); PG8_STAGE_B(PG8_SB(0, 0), BP2); PG8_STAGE_B1(PG8_SB(0, 1), BP2); PG8_STAGE_A(PG8_SA(0, 0), KB2, u2[0], a2o[0]); \
            PG8_WAIT_V(8); PG8_WAIT_L(0); PG8_BAR; PG8_MMA(1, 0, At, B0); PG8_MMA(1, 1, At, B1); PG8_BAR; PG8_SCHED; \
            PG8_LDB(B0, 1, 0); PG8_LDB(B1, 1, 1); PG8_SCHED; PG8_LDA(At, 1, 0); PG8_STAGE_A(PG8_SA(0, 1), KB2, u2[1], a2o[1]); \
            PG8_WAIT_V(8); PG8_WAIT_L(0); PG8_BAR; PG8_MMA(0, 0, At, B0); PG8_MMA(0, 1, At, B1); PG8_BAR; PG8_SCHED; \
            PG8_LDA(At, 1, 1); PG8_STAGE_B(PG8_SB(1, 0), BP3); PG8_STAGE_B1(PG8_SB(1, 1), BP3); PG8_STAGE_A(PG8_SA(1, 0), KB3, u2[0], a2o[0]); \
            PG8_WAIT_V(8); PG8_WAIT_L(0); PG8_BAR; PG8_MMA(1, 0, At, B0); PG8_MMA(1, 1, At, B1); PG8_BAR; PG8_SCHED; } while (0)
    Unit cur, nxt; int ui = 0;
    if (!S.next(0, cur)) return;
    f32x4 acc[2][2][4][2];
#pragma unroll
    for (int a = 0; a < 2; ++a)
#pragma unroll
        for (int b = 0; b < 2; ++b)
#pragma unroll
            for (int m = 0; m < 4; ++m)
#pragma unroll
                for (int n = 0; n < 2; ++n) acc[a][b][m][n] = (f32x4){0.f, 0.f, 0.f, 0.f};
    bf16x8 At[4][2], B0[2][2], B1[2][2];
    f32x16 accw[2][2][2];
#define PG8_ZERO_W() do { if constexpr (F8) { _Pragma("unroll") for (int _a = 0; _a < 2; ++_a) _Pragma("unroll") for (int _b = 0; _b < 2; ++_b) _Pragma("unroll") for (int _m = 0; _m < 2; ++_m) _Pragma("unroll") for (int _e = 0; _e < 16; ++_e) accw[_a][_b][_m][_e] = 0.f; } } while (0)
    PG8_ZERO_W();
#pragma unroll
    for (int h = 0; h < 2; ++h) { uC[h] = GA ? 0u : S.unit_off(cur, h); uN[h] = uC[h];
#pragma unroll
        for (int i = 0; i < 2; ++i) { aoC[h][i] = GA ? (S.aoff(cur, h * HALF + RA[i]) + CA2[i]) : 0u; aoN[h][i] = aoC[h][i]; } }
    const char* cB = S.bptr(cur);
    PG8_STAGE_B(PG8_SB(0, 0), cB); PG8_STAGE_B1(PG8_SB(0, 1), cB); PG8_STAGE_A(PG8_SA(0, 0), 0u, uC[0], aoC[0]); PG8_STAGE_A(PG8_SA(0, 1), 0u, uC[1], aoC[1]);
    if (wr == 1) PG8_BAR;
    PG8_WAIT_V(2); PG8_BAR;
    PG8_STAGE_B(PG8_SB(1, 0), cB + kstepB); PG8_STAGE_A(PG8_SA(1, 0), kstepA, uC[0], aoC[0]); PG8_STAGE_B1(PG8_SB(1, 1), cB + kstepB);
    PG8_WAIT_V(6); PG8_BAR;
    for (;;) {
        const bool has_next = S.next(ui + 1, nxt);
        const char* nB = has_next ? S.bptr(nxt) : cB;
#pragma unroll
        for (int h = 0; h < 2; ++h) { uN[h] = (GA || !has_next) ? uC[h] : S.unit_off(nxt, h);
#pragma unroll
            for (int i = 0; i < 2; ++i) aoN[h][i] = (GA && has_next) ? (S.aoff(nxt, h * HALF + RA[i]) + CA2[i]) : aoC[h][i]; }
#pragma nounroll
        for (int t = 0; t < nt; t += 2) {
            const bool last = (t == nt - 2);
            const unsigned kb1 = (unsigned)(t + 1) * kstepA, kb2 = last ? 0u : (unsigned)(t + 2) * kstepA, kb3 = kb2 + kstepA;
            const char* b2 = last ? nB : cB + (size_t)(t + 2) * kstepB; const char* b3 = b2 + kstepB;
            unsigned u2[2], a2o[2][2];
#pragma unroll
            for (int h = 0; h < 2; ++h) { u2[h] = last ? uN[h] : uC[h];
#pragma unroll
                for (int i = 0; i < 2; ++i) a2o[h][i] = GA ? (last ? aoN[h][i] : aoC[h][i]) : 0u; }
            PG8_KPAIR(kb1, kb2, kb3, b2, b3);
        }
        if constexpr (ALIGN_EPI) { if (wr == 0) PG8_BAR; }
        if constexpr (F8) {
#pragma unroll
            for (int _a = 0; _a < 2; ++_a)
#pragma unroll
                for (int _b = 0; _b < 2; ++_b)
#pragma unroll
                    for (int _m = 0; _m < 4; ++_m)
#pragma unroll
                        for (int _n = 0; _n < 2; ++_n) { const f32x16& _w = accw[_a][_b][_m >> 1]; const int _q = ((_m & 1) * 2 + _n) * 4; acc[_a][_b][_m][_n] = (f32x4){_w[_q], _w[_q + 1], _w[_q + 2], _w[_q + 3]}; }
        }
        E(acc, cur, wr, wc, fr, fq);
        PG8_ZERO_W();
        if (!has_next) break;
#pragma unroll
        for (int a = 0; a < 2; ++a)
#pragma unroll
            for (int b = 0; b < 2; ++b)
#pragma unroll
                for (int m = 0; m < 4; ++m)
#pragma unroll
                    for (int n = 0; n < 2; ++n) acc[a][b][m][n] = (f32x4){0.f, 0.f, 0.f, 0.f};
        cur = nxt; cB = nB; ++ui;
#pragma unroll
        for (int h = 0; h < 2; ++h) { uC[h] = uN[h];
#pragma unroll
            for (int i = 0; i < 2; ++i) aoC[h][i] = aoN[h][i]; }
        if constexpr (ALIGN_EPI) { if (wr == 1) PG8_BAR; }
    }
    PG8_WAIT_V(0);
    if constexpr (!ALIGN_EPI) { if (wr == 0) PG8_BAR; }
    PG8_BAR;
#undef PG8_SA
#undef PG8_ZERO_W
#undef PG8_GLDS
#undef PG8_SB
#undef PG8_STAGE_A
#undef PG8_STAGE_B
#undef PG8_STAGE_B1
#undef PG8_LDA
#undef PG8_LDB
#undef PG8_MMA
#undef PG8_WAIT_V
#undef PG8_WAIT_L
#undef PG8_BAR
#undef PG8_SCHED
#undef PG8_KPAIR
}

struct DenseSched {
    const char* A; const char* Bt; unsigned lda2; size_t btile; int nM, nN, nwg, G, c;
    __device__ __forceinline__ void init(const bf16_t* A_, int lda, const bf16_t* Bt_, int K, int Mrows, int N) {
        A = (const char*)A_; Bt = (const char*)Bt_; lda2 = (unsigned)lda * 2u; btile = (size_t)256 * K * 2; nM = Mrows / BM; nN = N / BM; nwg = nM * nN; G = gridDim.x; c = blockIdx.x; }
    __device__ __forceinline__ bool next(int i, Unit& u) const {
        const long L = (long)i * G + c; if (L >= nwg) return false;
        int wgid = (int)L; { const int q = nwg / 8, r = nwg % 8, xcd = wgid % 8, off = wgid / 8; wgid = (xcd < r ? xcd * (q + 1) : r * (q + 1) + (xcd - r) * q) + off; }
        const int nig = 8 * nN, gid = wgid / nig, fm = gid * 8, gsz = (nM - fm) < 8 ? (nM - fm) : 8;
        u.pm = fm + ((wgid % nig) % gsz); u.pn = (wgid % nig) / gsz; u.ord = i; return true;
    }
    static constexpr bool GATHER = false;
    __device__ __forceinline__ unsigned lane_off(int r) const { return (unsigned)r * lda2; }
    __device__ __forceinline__ unsigned unit_off(const Unit& u, int h) const { return (unsigned)(u.pm * BM + h * HALF) * lda2; }
    __device__ __forceinline__ unsigned aoff(const Unit&, int) const { return 0u; }
    __device__ __forceinline__ const char* abase() const { return A; }
    __device__ __forceinline__ const char* bptr(const Unit& u) const { return Bt + (size_t)u.pn * btile; }
};
}
typedef float f32x2_t __attribute__((ext_vector_type(2))); typedef __bf16 bf16x2_t __attribute__((ext_vector_type(2)));
__device__ __forceinline__ unsigned cvt_pk_bf16(float lo, float hi) { const f32x2_t v = {lo, hi}; const bf16x2_t b = __builtin_convertvector(v, bf16x2_t); return __builtin_bit_cast(unsigned, b); }
__device__ __forceinline__ u32x4 pack8(const f32x4 v0, const f32x4 v1) { u32x4 w; w.x = cvt_pk_bf16(v0[0], v0[1]); w.y = cvt_pk_bf16(v0[2], v0[3]); w.z = cvt_pk_bf16(v1[0], v1[1]); w.w = cvt_pk_bf16(v1[2], v1[3]); return w; }
__device__ __forceinline__ unsigned cvtpk_m(float lo, float hi) { const f32x2_t v = {lo, hi}; const bf16x2_t b = __builtin_convertvector(v, bf16x2_t); return __builtin_bit_cast(unsigned, b); }
__device__ __forceinline__ u32x4 pack8m(const f32x4 v0, const f32x4 v1) { u32x4 w; w.x = cvtpk_m(v0[0], v0[1]); w.y = cvtpk_m(v0[2], v0[3]); w.z = cvtpk_m(v1[0], v1[1]); w.w = cvtpk_m(v1[2], v1[3]); return w; }
#define MFMA_SETTLE(S) asm volatile("s_nop 15\n\ts_nop 7" : "+v"(S[0][0]), "+v"(S[0][1]), "+v"(S[0][2]), "+v"(S[0][3]), "+v"(S[1][0]), "+v"(S[1][1]), "+v"(S[1][2]), "+v"(S[1][3]))
__device__ __forceinline__ f32x4 sig4(const f32x4 v) { f32x4 r; r[0] = sigmoidf_(v[0]); r[1] = sigmoidf_(v[1]); r[2] = sigmoidf_(v[2]); r[3] = sigmoidf_(v[3]); return r; }

#define EPI_ROWLOOP for (int ai = 0; ai < 2; ++ai) _Pragma("unroll") for (int m = 0; m < 4; ++m)
struct EpiInproj0 {
    static constexpr bool PERM = true, PERM16 = false; bf16_t* H0;
    __device__ __forceinline__ void operator()(const f32x4 (&acc)[2][2][4][2], const pg8::Unit& u, int wr, int wc, int fr, int fq) const {
        const int row0 = u.pm * 256 + wr * 64 + fr, cl = wc * 32 + 8 * fq;
#pragma unroll
        EPI_ROWLOOP { bf16_t* rp = H0 + (size_t)(row0 + ai * 128 + m * 16) * 1024;
            if (u.pn < 2) {
#pragma unroll
                for (int bj = 0; bj < 2; ++bj) *(u32x4*)(rp + u.pn * 256 + bj * 128 + cl) = pack8(acc[ai][bj][m][0], acc[ai][bj][m][1]);
            } else {
                const f32x4 v0 = acc[ai][0][m][0] * sig4(acc[ai][1][m][0]), v1 = acc[ai][0][m][1] * sig4(acc[ai][1][m][1]);
                *(u32x4*)(rp + 512 + (u.pn - 2) * 128 + cl) = pack8(v0, v1);
            } }
    }
};
struct EpiRes {
    static constexpr bool PERM = true, PERM16 = false; const float* resf; const bf16_t* resb; bf16_t* Y; float sc;
    __device__ __forceinline__ void operator()(const f32x4 (&acc)[2][2][4][2], const pg8::Unit& u, int wr, int wc, int fr, int fq) const {
        const int row0 = u.pm * 256 + wr * 64 + fr, c0 = u.pn * 256 + wc * 32 + 8 * fq;
#pragma unroll
        EPI_ROWLOOP { const size_t ro = (size_t)(row0 + ai * 128 + m * 16) * 1024 + c0;
#pragma unroll
            for (int bj = 0; bj < 2; ++bj) {
                f32x4 r0, r1;
                if (resf) { r0 = *(const f32x4*)(resf + ro + bj * 128); r1 = *(const f32x4*)(resf + ro + bj * 128 + 4); }
                else { const u32x4 xv = *(const u32x4*)(resb + ro + bj * 128);
                    r0[0] = __uint_as_float(xv.x << 16); r0[1] = __uint_as_float(xv.x & 0xffff0000u); r0[2] = __uint_as_float(xv.y << 16); r0[3] = __uint_as_float(xv.y & 0xffff0000u);
                    r1[0] = __uint_as_float(xv.z << 16); r1[1] = __uint_as_float(xv.z & 0xffff0000u); r1[2] = __uint_as_float(xv.w << 16); r1[3] = __uint_as_float(xv.w & 0xffff0000u); }
                *(u32x4*)(Y + ro + bj * 128) = pack8(acc[ai][bj][m][0] * sc + r0 * ALPHA, acc[ai][bj][m][1] * sc + r1 * ALPHA);
            } }
    }
};
struct RouterSched {
    const char* A; const char* Bt; int G, c;
    static constexpr bool GATHER = false;
    __device__ __forceinline__ bool next(int i, pg8::Unit& u) const { const int L = i * G + c; if (L >= 256) return false; u.pm = L >> 1; u.pn = L & 1; u.ord = i; return true; }
    __device__ __forceinline__ unsigned lane_off(int r) const { return (unsigned)r * 2048u; }
    __device__ __forceinline__ unsigned unit_off(const pg8::Unit& u, int h) const { return (unsigned)(u.pm * 256 + h * 128) * 2048u + (unsigned)u.pn * 1024u; }
    __device__ __forceinline__ unsigned aoff(const pg8::Unit&, int) const { return 0u; }
    __device__ __forceinline__ const char* abase() const { return A; }
    __device__ __forceinline__ const char* bptr(const pg8::Unit& u) const { return Bt + (size_t)u.pn * 1024; }
};
struct EpiLogits {
    static constexpr bool PERM = true, PERM16 = false; float* LOG; float* LOG1;
    __device__ __forceinline__ void operator()(const f32x4 (&acc)[2][2][4][2], const pg8::Unit& u, int wr, int wc, int fr, int fq) const {
        const int row0 = u.pm * 256 + wr * 64 + fr, cl = wc * 32 + 8 * fq;
#pragma unroll
        EPI_ROWLOOP { float* rp = (u.pn ? LOG1 : LOG) + (size_t)(row0 + ai * 128 + m * 16) * 256 + cl;
#pragma unroll
            for (int bj = 0; bj < 2; ++bj) { *(f32x4*)(rp + bj * 128) = acc[ai][bj][m][0]; *(f32x4*)(rp + bj * 128 + 4) = acc[ai][bj][m][1]; } }
    }
};

constexpr int MOE_TAB_OFF = 131072;
__device__ __forceinline__ int moe_setup256(const unsigned* cnt, LAS unsigned char* lds) {
    LAS int* tstart = (LAS int*)(lds + MOE_TAB_OFF);
    LAS int* scnt = (LAS int*)(lds + MOE_TAB_OFF + 1088);
    LAS unsigned short* texp = (LAS unsigned short*)(lds + MOE_TAB_OFF + 2176);
    const int tid = threadIdx.x;
    __syncthreads();
    const int lane = tid & 63, wave = tid >> 6;
    LAS int* wtot = tstart + 260;
    int c = 0;
    if (tid < 256) { const int n = (int)cnt[tid]; scnt[tid] = n; c = (n + 255) >> 8; }
    int incl = c;
#pragma unroll
    for (int o = 1; o < 64; o <<= 1) { const int t = __shfl_up(incl, o); if (lane >= o) incl += t; }
    if (tid < 256 && lane == 63) wtot[wave] = incl;
    __syncthreads();
    if (tid < 256) { int off = 0;
#pragma unroll
        for (int w = 0; w < 3; ++w) off += (w < wave) ? wtot[w] : 0;
        tstart[tid] = off + incl - c; if (tid == 255) tstart[256] = off + incl; }
    __syncthreads();
    if (tid < 256) for (int q = tstart[tid]; q < tstart[tid + 1]; ++q) texp[q] = (unsigned short)tid;
    __syncthreads();
    return __builtin_amdgcn_readfirstlane(tstart[256]);
}
constexpr int MOE_TOK_OFF = MOE_TAB_OFF + 5120;
constexpr int MOE_MAX_ORD = 20;
struct MoeGuSched {
    static constexpr bool GATHER = true;
    const char* X; const char* W; const int2* list; LAS unsigned char* lds; int R, nunits, G, c;
    __device__ __forceinline__ int vcu() const { return (G % 8 == 0) ? (c % 8) * (G / 8) + c / 8 : c; }
    __device__ __forceinline__ bool next(int i, pg8::Unit& u) const {
        const int L = i * G + vcu(); if (L >= nunits || i >= MOE_MAX_ORD) return false;
        const int q = L >> 1; const int e = __builtin_amdgcn_readfirstlane((q < R) ? (int)((LAS unsigned short*)(lds + MOE_TAB_OFF + 2176))[q] : 256);
        u.pm = q; u.pn = e * 2 + (L & 1); u.ord = i; return true; }
    __device__ __forceinline__ void prepare() const {
        const int tid = threadIdx.x, r = tid & 255;
        pg8::Unit u;
        for (int i = tid >> 8; next(i, u); i += 2) {
            const int e = u.pn >> 1; int token;
            if (e < 256) { const int ts = ((LAS int*)(lds + MOE_TAB_OFF))[e], cn = ((LAS int*)(lds + MOE_TAB_OFF + 1088))[e]; int lr = (u.pm - ts) * 256 + r; if (lr >= cn) lr = cn - 1;
                token = list[(size_t)e * LISTCAP + lr].x / 10; }
            else token = (u.pm - R) * 256 + r;
            ((LAS unsigned short*)(lds + MOE_TOK_OFF))[i * 256 + r] = (unsigned short)token;
        }
        __syncthreads();
    }
    __device__ __forceinline__ unsigned aoff(const pg8::Unit& u, int r) const { return (unsigned)((LAS unsigned short*)(lds + MOE_TOK_OFF))[u.ord * 256 + r] * 1024u; }
    __device__ __forceinline__ unsigned lane_off(int) const { return 0u; }
    __device__ __forceinline__ unsigned unit_off(const pg8::Unit&, int) const { return 0u; }
    __device__ __forceinline__ const char* abase() const { return X; }
    __device__ __forceinline__ const char* bptr(const pg8::Unit& u) const { return W + (size_t)u.pn * (256 * 1024); }
};
constexpr float GU_SC = 1.0f / (X8_SCALE * W8_SCALE);
struct EpiGateUp {
    static constexpr bool PERM = true, PERM16 = false; unsigned char* HID;
    __device__ __forceinline__ void operator()(const f32x4 (&acc)[2][2][4][2], const pg8::Unit& u, int wr, int wc, int fr, int fq) const {
        const int row0 = u.pm * 256 + wr * 64 + fr, c0 = (u.pn & 1) * 128 + wc * 32 + 8 * fq;
#pragma unroll
        EPI_ROWLOOP { const f32x4 g0 = acc[ai][0][m][0] * GU_SC, g1 = acc[ai][0][m][1] * GU_SC;
            f32x4 h0 = g0 * sig4(g0) * (acc[ai][1][m][0] * (GU_SC * H8_SCALE)), h1 = g1 * sig4(g1) * (acc[ai][1][m][1] * (GU_SC * H8_SCALE));
#pragma unroll
            for (int i = 0; i < 4; ++i) { h0[i] = clamp8(h0[i]); h1[i] = clamp8(h1[i]); }
            *(u32x2*)(HID + (size_t)(row0 + ai * 128 + m * 16) * 256 + c0) = pack8_fp8(h0, h1); }
    }
};
constexpr int MOE_RI_OFF = MOE_TAB_OFF + 5120;
constexpr int MOE_MAX_RT = 6;
struct MoeDownSched {
    const char* HID; const char* W; const int2* list; LAS unsigned char* lds; int R, ntile, G, c;
    __device__ __forceinline__ int vcu() const { return (G % 8 == 0) ? (c % 8) * (G / 8) + c / 8 : c; }
    __device__ __forceinline__ bool next(int i, pg8::Unit& u) const {
        const int q = vcu() + G * (i >> 2); if (q >= ntile || (i >> 2) >= MOE_MAX_RT) return false;
        const int e = (q < R) ? (int)((LAS unsigned short*)(lds + MOE_TAB_OFF + 2176))[q] : 256;
        u.pm = q; u.pn = e * 4 + (i & 3); u.ord = i >> 2; return true; }
    __device__ __forceinline__ void prepare() const {
        const int tid = threadIdx.x, r = tid & 255;
        for (int o = tid >> 8; o < MOE_MAX_RT; o += 2) {
            const int q = vcu() + G * o; if (q >= ntile) break;
            u32x2 en;
            if (q < R) { const int e = ((LAS unsigned short*)(lds + MOE_TAB_OFF + 2176))[q]; const int ts = ((LAS int*)(lds + MOE_TAB_OFF))[e], cn = ((LAS int*)(lds + MOE_TAB_OFF + 1088))[e];
                const int lr = (q - ts) * 256 + r; if (lr < cn) { const int2 le = list[(size_t)e * LISTCAP + lr]; en.x = (unsigned)le.x; en.y = (unsigned)le.y; } else { en.x = 0xffffffffu; en.y = 0u; } }
            else { en.x = (unsigned)(((q - R) * 256 + r) * 10 + 8); en.y = __float_as_uint(1.0f); }
            ((LAS u32x2*)(lds + MOE_RI_OFF))[o * 256 + r] = en;
        }
        __syncthreads();
    }
    static constexpr bool GATHER = false;
    __device__ __forceinline__ unsigned lane_off(int r) const { return (unsigned)r * 256u; }
    __device__ __forceinline__ unsigned unit_off(const pg8::Unit& u, int h) const { return (unsigned)(u.pm * 256 + h * 128) * 256u; }
    __device__ __forceinline__ unsigned aoff(const pg8::Unit&, int) const { return 0u; }
    __device__ __forceinline__ const char* abase() const { return HID; }
    __device__ __forceinline__ const char* bptr(const pg8::Unit& u) const { return W + (size_t)u.pn * (256 * 256); }
};
struct EpiDown {
    static constexpr bool PERM = true, PERM16 = true;
    unsigned char* YB; LAS unsigned char* lds;
    __device__ __forceinline__ void operator()(const f32x4 (&acc)[2][2][4][2], const pg8::Unit& u, int wr, int wc, int fr, int fq) const {
        asm volatile("" : "+v"(fr), "+v"(fq));
        const unsigned c0b = (unsigned)((u.pn & 3) * 256 + wc * 64 + 16 * fq); const bool shared = (u.pn >> 2) == 256;
        const LAS u32x2* ri = (const LAS u32x2*)(lds + MOE_RI_OFF) + u.ord * 256 + wr * 64 + fr;
#pragma unroll
        for (int ai = 0; ai < 2; ++ai)
#pragma unroll
            for (int m = 0; m < 4; ++m) { const u32x2 en = ri[ai * 128 + m * 16]; const float wv = __uint_as_float(en.y) * (YB_SCALE / (H8_SCALE * W8_SCALE));
                if ((int)en.x >= 0) { unsigned char* rp = YB + (size_t)(en.x * 1024u + c0b);
                    const f32x4 v00 = acc[ai][0][m][0] * wv, v01 = acc[ai][0][m][1] * wv, v10 = acc[ai][1][m][0] * wv, v11 = acc[ai][1][m][1] * wv;
                    const u32x2 h0 = pack8_fp8(v00, v01), h1 = pack8_fp8(v10, v11);
                    *(u32x4*)rp = (u32x4){h0.x, h0.y, h1.x, h1.y};
                    if (YB_NSLOT == 10 && shared) {
                        u32x2 r_[2];
#pragma unroll
                        for (int bj = 0; bj < 2; ++bj) { const u32x2 h = bj ? h1 : h0; const f32x4 v0 = bj ? v10 : v00, v1 = bj ? v11 : v01;
                            const auto a0 = __builtin_amdgcn_cvt_pk_f32_fp8((int)h.x, false), a1 = __builtin_amdgcn_cvt_pk_f32_fp8((int)h.x, true), a2 = __builtin_amdgcn_cvt_pk_f32_fp8((int)h.y, false), a3 = __builtin_amdgcn_cvt_pk_f32_fp8((int)h.y, true);
                            const f32x4 r0 = {v0[0] - a0[0], v0[1] - a0[1], v0[2] - a1[0], v0[3] - a1[1]}, r1 = {v1[0] - a2[0], v1[1] - a2[1], v1[2] - a3[0], v1[3] - a3[1]};
                            r_[bj] = pack8_fp8(r0, r1); }
                        *(u32x4*)(rp + 1024) = (u32x4){r_[0].x, r_[0].y, r_[1].x, r_[1].y}; } } }
    }
};

struct EpiInprojN {
    static constexpr bool PERM = true, PERM16 = false; bf16_t* QN; bf16_t* QR; bf16_t* KV6; float* GATES; const float* ROT;
    __device__ __forceinline__ void operator()(const f32x4 (&acc)[2][2][4][2], const pg8::Unit& u, int wr, int wc, int fr, int fq) const {
        const int row0 = u.pm * 256 + wr * 64 + fr, cl = wc * 32 + 8 * fq, pn = u.pn;
        const bool isq = pn < 4, rotk = (pn == 6 || pn == 8), dorot = (isq || rotk) && ((wc & 1) == 0);
#pragma unroll
        EPI_ROWLOOP { const int row = row0 + ai * 128 + m * 16;
            if (pn == 10) {
                if (cl < 48) { *(f32x4*)(GATES + (size_t)row * 48 + cl) = sig4(acc[ai][0][m][0]); *(f32x4*)(GATES + (size_t)row * 48 + cl + 4) = sig4(acc[ai][0][m][1]); }
            } else {
                f32x4 cs0, cs1, sn0, sn1;
                if (dorot) { const float* rt = ROT + (size_t)(row & (T - 1)) * 16; cs0 = *(const f32x4*)rt; cs1 = *(const f32x4*)(rt + 4); sn0 = *(const f32x4*)(rt + 8); sn1 = *(const f32x4*)(rt + 12); }
#pragma unroll
                for (int bj = 0; bj < 2; ++bj) {
                    const f32x4 v0 = acc[ai][bj][m][0], v1 = acc[ai][bj][m][1];
                    f32x4 r0 = v0, r1 = v1;
                    if (dorot) {
                        f32x4 p0, p1;
#pragma unroll
                        for (int i = 0; i < 4; ++i) { p0[i] = __shfl_xor(v0[i], 16); p1[i] = __shfl_xor(v1[i], 16); }
                        if (fq == 0) { r0 = v0 * cs0 - p0 * sn0; r1 = v1 * cs1 - p1 * sn1; }
                        else if (fq == 1) { r0 = v0 * cs0 + p0 * sn0; r1 = v1 * cs1 + p1 * sn1; }
                    }
                    if (isq) { const int c = pn * 256 + bj * 128 + cl;
                        *(u32x4*)(QN + (size_t)row * 1024 + c) = pack8(v0 * QSCALE, v1 * QSCALE); *(u32x4*)(QR + (size_t)row * 1024 + c) = pack8(r0 * QSCALE, r1 * QSCALE); }
                    else { const int cc = bj * 128 + cl, g = cc >> 6, d = cc & 63, b = row >> 13, t = row & (T - 1);
                        *(u32x4*)(KV6 + ((size_t)((pn - 4) * 16 + b * 4 + g) * T + t) * 64 + d) = pack8(r0, r1); }
                }
            } }
    }
};

struct Cmp1Sched {
    const char* KV6; const char* W; int G, c;
    static constexpr bool GATHER = false;
    __device__ __forceinline__ bool next(int i, pg8::Unit& u) const { const int L = i * G + c; if (L >= 64) return false; u.pm = L >> 1; u.pn = L & 1; u.ord = i; return true; }
    __device__ __forceinline__ unsigned lane_off(int r) const { return (unsigned)r * 2048u; }
    __device__ __forceinline__ unsigned unit_off(const pg8::Unit& u, int h) const { return (unsigned)u.pn * (unsigned)(16 * T * 64 * 2) + (unsigned)(u.pm * 256 + h * 128) * 2048u; }
    __device__ __forceinline__ unsigned aoff(const pg8::Unit&, int) const { return 0u; }
    __device__ __forceinline__ const char* abase() const { return KV6; }
    __device__ __forceinline__ const char* bptr(const pg8::Unit& u) const { return W + (size_t)u.pn * (256 * 2048 * 2); }
};
struct EpiCmp1 {
    static constexpr bool PERM = true, PERM16 = false; bf16_t* CH1; const float* bias1;
    __device__ __forceinline__ void operator()(const f32x4 (&acc)[2][2][4][2], const pg8::Unit& u, int wr, int wc, int fr, int fq) const {
        const int row0 = u.pm * 256 + wr * 64 + fr, cl = wc * 32 + 8 * fq;
        const f32x4 b0 = *(const f32x4*)(bias1 + u.pn * 128 + cl), b1 = *(const f32x4*)(bias1 + u.pn * 128 + cl + 4);
#pragma unroll
        EPI_ROWLOOP { f32x4 v0 = acc[ai][0][m][0] + b0, v1 = acc[ai][0][m][1] + b1;
#pragma unroll
            for (int i = 0; i < 4; ++i) { v0[i] = gelu_tanh(v0[i]); v1[i] = gelu_tanh(v1[i]); }
            *(u32x4*)(CH1 + ((size_t)u.pn * 8192 + row0 + ai * 128 + m * 16) * 128 + cl) = pack8(v0, v1); }
    }
};

__device__ __forceinline__ void p0_item(const float* W, int K, int N, bf16_t* WT, int kb, int n0, int drow0, LAS float* scr, int lane, bool f8 = false) {
    const int k0 = 64 * kb, n4 = (lane & 15) * 4;
    const bool cok = (n0 + n4) < N;
    f32x4 v[16];
#pragma unroll
    for (int i = 0; i < 16; ++i) { const int kk = 4 * i + (lane >> 4); v[i] = cok ? __builtin_nontemporal_load((const f32x4*)(W + (size_t)(k0 + kk) * N + n0 + n4)) : (f32x4){0.f, 0.f, 0.f, 0.f}; }
#pragma unroll
    for (int i = 0; i < 16; ++i) { const int kk = 4 * i + (lane >> 4); LAS float* d = scr + kk * 65 + n4; d[0] = v[i][0]; d[1] = v[i][1]; d[2] = v[i][2]; d[3] = v[i][3]; }
    asm volatile("s_waitcnt lgkmcnt(0)" ::: "memory");
    if (f8) {
        const int c4 = lane & 3;
#pragma unroll
        for (int j = 0; j < 4; ++j) { const int n = (lane >> 2) + 16 * j; const LAS float* sp = scr + (16 * c4) * 65 + n;
            u32x4 o;
            o.x = pk4_fp8(sp[0 * 65] * W8_SCALE, sp[1 * 65] * W8_SCALE, sp[2 * 65] * W8_SCALE, sp[3 * 65] * W8_SCALE); o.y = pk4_fp8(sp[4 * 65] * W8_SCALE, sp[5 * 65] * W8_SCALE, sp[6 * 65] * W8_SCALE, sp[7 * 65] * W8_SCALE);
            o.z = pk4_fp8(sp[8 * 65] * W8_SCALE, sp[9 * 65] * W8_SCALE, sp[10 * 65] * W8_SCALE, sp[11 * 65] * W8_SCALE); o.w = pk4_fp8(sp[12 * 65] * W8_SCALE, sp[13 * 65] * W8_SCALE, sp[14 * 65] * W8_SCALE, sp[15 * 65] * W8_SCALE);
            if (n0 + n < N) __builtin_nontemporal_store(o, (u32x4*)((unsigned char*)WT + (size_t)(drow0 + n) * K + k0 + 16 * c4)); }
        asm volatile("s_waitcnt lgkmcnt(0)" ::: "memory");
        return;
    }
    const int c = lane & 7;
#pragma unroll
    for (int j = 0; j < 8; ++j) { const int n = (lane >> 3) + 8 * j; const LAS float* sp = scr + (8 * c) * 65 + n;
        u32x4 o; o.x = pk2(sp[0 * 65], sp[1 * 65]); o.y = pk2(sp[2 * 65], sp[3 * 65]); o.z = pk2(sp[4 * 65], sp[5 * 65]); o.w = pk2(sp[6 * 65], sp[7 * 65]);
        if (n0 + n < N) __builtin_nontemporal_store(o, (u32x4*)(WT + (size_t)(drow0 + n) * K + k0 + 8 * c)); }
    asm volatile("s_waitcnt lgkmcnt(0)" ::: "memory");
}
struct CvtItem { const float* W; bf16_t* WT; int K, N, k0, n0, drow0; };
__device__ __forceinline__ void cvt32_load(const CvtItem& it, int lane, f32x4 (&v)[8]) {
    const int n4 = (lane & 7) * 4;
#pragma unroll
    for (int i = 0; i < 8; ++i) { const int kk = 8 * i + (lane >> 3); v[i] = __builtin_nontemporal_load((const f32x4*)(it.W + (size_t)(it.k0 + kk) * it.N + it.n0 + n4)); }
}
__device__ __forceinline__ void cvt32_finish(const CvtItem& it, int lane, const f32x4 (&v)[8], LAS float* scr) {
    const int n4 = (lane & 7) * 4;
#pragma unroll
    for (int i = 0; i < 8; ++i) { const int kk = 8 * i + (lane >> 3); LAS float* d = scr + kk * 33 + n4; d[0] = v[i][0]; d[1] = v[i][1]; d[2] = v[i][2]; d[3] = v[i][3]; }
    asm volatile("s_waitcnt lgkmcnt(0)" ::: "memory");
    const int c = lane & 7;
#pragma unroll
    for (int j = 0; j < 4; ++j) { const int n = (lane >> 3) + 8 * j; const LAS float* sp = scr + (8 * c) * 33 + n;
        const float v0 = sp[0 * 33], v1 = sp[1 * 33], v2 = sp[2 * 33], v3 = sp[3 * 33], v4 = sp[4 * 33], v5 = sp[5 * 33], v6 = sp[6 * 33], v7 = sp[7 * 33];
        u32x2 o; o.x = pk4_fp8(v0 * W8_SCALE, v1 * W8_SCALE, v2 * W8_SCALE, v3 * W8_SCALE); o.y = pk4_fp8(v4 * W8_SCALE, v5 * W8_SCALE, v6 * W8_SCALE, v7 * W8_SCALE);
        __builtin_nontemporal_store(o, (u32x2*)((unsigned char*)it.WT + (size_t)(it.drow0 + n) * it.K + it.k0 + 8 * c)); }
    asm volatile("s_waitcnt lgkmcnt(0)" ::: "memory");
}
constexpr int CVT1_ITEMS = 257 * 384;
__device__ __forceinline__ CvtItem cvt1_item(const Args& a, int idx) {
    const int e = idx / 384, sub = idx % 384, mat = sub >> 7, r = sub & 127;
    CvtItem it;
    if (mat < 2) { it.W = (e < 256) ? a.in[23 + mat] + ((size_t)256 + e) * (size_t)(D * FF) : a.in[26 + mat] + (size_t)(D * FF);
        it.K = D; it.N = FF; it.k0 = (r >> 3) * 64; it.n0 = (r & 7) * 32; it.drow0 = (it.n0 >> 7) * 256 + mat * 128 + (it.n0 & 127);
        it.WT = (bf16_t*)(a.ws + WS_WGU + (size_t)(257 + e) * 512 * 1024); }
    else { it.W = (e < 256) ? a.in[25] + ((size_t)256 + e) * (size_t)(FF * D) : a.in[28] + (size_t)(FF * D);
        it.K = FF; it.N = D; it.k0 = (r >> 5) * 64; it.n0 = (r & 31) * 32; it.drow0 = it.n0;
        it.WT = (bf16_t*)(a.ws + WS_WD + (size_t)(257 + e) * 1024 * 256); }
    return it;
}
__device__ __forceinline__ void cvt1_run(const Args& a, int& next, int stride, int quota, LAS float* scr, int lane) {
#pragma unroll 1
    for (int q = 0; q < quota && next < CVT1_ITEMS; ++q) {
        CvtItem t[4]; f32x4 v[4][8]; bool ok[4];
#pragma unroll
        for (int u = 0; u < 4; ++u) { const int idx = next + u * stride; ok[u] = idx < CVT1_ITEMS; t[u] = cvt1_item(a, ok[u] ? idx : 0); if (ok[u]) cvt32_load(t[u], lane, v[u]); }
        next += 4 * stride;
#pragma unroll
        for (int u = 0; u < 4; ++u) if (ok[u]) cvt32_finish(t[u], lane, v[u], scr);
    }
}
__device__ __forceinline__ void ph_prologue(const Args& a, LAS unsigned char* lds) {
    const int lane = threadIdx.x & 63, wave = threadIdx.x >> 6;
    LAS float* scr = (LAS float*)(lds + wave * 16640);
    const int gw = blockIdx.x * 8 + wave, ngw = gridDim.x * 8;
    for (int it = gw; it < 257 * 192; it += ngw) {
        const int le = it / 192, sub = it % 192, l = 0, e = le, mat = sub >> 6, r = sub & 63;
        if (mat < 2) {
            const float* W = (e < 256) ? a.in[23 + mat] + ((size_t)l * 256 + e) * (size_t)(D * FF) : a.in[26 + mat] + (size_t)l * (D * FF);
            const int kb = r >> 2, n0 = (r & 3) * 64;
            p0_item(W, D, FF, (bf16_t*)(a.ws + WS_WGU + (size_t)le * 512 * 1024), kb, n0, (n0 >> 7) * 256 + mat * 128 + (n0 & 127), scr, lane, true);
        } else {
            const float* W = (e < 256) ? a.in[25] + ((size_t)l * 256 + e) * (size_t)(FF * D) : a.in[28] + (size_t)l * (FF * D);
            const int kb = r >> 4, n0 = (r & 15) * 64;
            p0_item(W, FF, D, (bf16_t*)(a.ws + WS_WD + (size_t)le * 1024 * 256), kb, n0, n0, scr, lane, true);
        }
    }
    {
        for (int itg = gw; itg < 1680; itg += ngw) {
            if (itg < 512) { const int it = itg; const int w = it >> 8, r = it & 255;
                p0_item(a.in[w ? 16 : 8], D, D, (bf16_t*)(a.ws + (w ? WS_WOUTN : WS_WOUT0)), r >> 4, (r & 15) * 64, (r & 15) * 64, scr, lane, w != 0); }
            else if (itg < 1168) { const int it = itg - 512;
                p0_item(a.in[9], D, 2608, (bf16_t*)(a.ws + WS_WINN), it / 41, (it % 41) * 64, (it % 41) * 64, scr, lane); }
            else if (itg < 1296) { const int it = itg - 1168; const int l = it >> 6, r = it & 63;
                p0_item(a.in[21] + (size_t)l * D * NE, D, NE, (bf16_t*)(a.ws + WS_WR) + (size_t)l * NE * D, r >> 2, (r & 3) * 64, (r & 3) * 64, scr, lane); }
            else if (itg < 1552) { const int it = itg - 1296; const int kb = it >> 4, n0 = (8 + (it & 15)) * 64;
                const int isg = (n0 >= 1024) ? 1 : 0, rel = n0 - 512 - isg * 512;
                p0_item(a.in[1], D, 1536, (bf16_t*)(a.ws + WS_WIN0), kb, n0, 512 + (rel >> 7) * 256 + isg * 128 + (rel & 127), scr, lane); }
            else { const int it = itg - 1552; const int kv = it >> 6, r = it & 63;
                p0_item(a.in[kv ? 14 : 11], 2048, 128, (bf16_t*)(a.ws + WS_CW1) + (size_t)kv * 256 * 2048, r >> 1, (r & 1) * 64, (r & 1) * 64, scr, lane); }
        }
    }
    {
        const int gt = blockIdx.x * 512 + threadIdx.x, ngt = gridDim.x * 512;
        const int gtz = (gt >= ngt / 16 * 13) ? gt - ngt / 16 * 13 : gt + ngt - ngt / 16 * 13, gtr = (gt >= ngt / 2) ? gt - ngt / 2 : gt + ngt - ngt / 2;
        const int gwb = (gw >= ngw / 8 * 7) ? gw - ngw / 8 * 7 : gw + ngw - ngw / 8 * 7;
        u32x4* z0 = (u32x4*)((bf16_t*)(a.ws + WS_WINN) + (size_t)2608 * 1024);
        for (int i = gtz; i < 208 * 1024 / 8; i += ngt) z0[i] = (u32x4){0u, 0u, 0u, 0u};
        for (int kv = 0; kv < 2; ++kv) { u32x4* z1 = (u32x4*)((bf16_t*)(a.ws + WS_CW1) + ((size_t)kv * 256 + 128) * 2048);
            for (int i = gtz; i < 128 * 2048 / 8; i += ngt) z1[i] = (u32x4){0u, 0u, 0u, 0u}; }
        const float* x = a.in[0]; bf16_t* XA = (bf16_t*)(a.ws + WS_XA);
        for (size_t i = gt; i < (size_t)M * D / 8; i += ngt) { const f32x4 v0 = *(const f32x4*)(x + i * 8), v1 = *(const f32x4*)(x + i * 8 + 4);
            u32x4 o; o.x = pk2(v0[0], v0[1]); o.y = pk2(v0[2], v0[3]); o.z = pk2(v1[0], v1[1]); o.w = pk2(v1[2], v1[3]); *(u32x4*)(XA + i * 8) = o; }
        const float* win = a.in[1]; const float* mix = a.in[2]; const float* psc = a.in[3]; bf16_t* WIN0 = (bf16_t*)(a.ws + WS_WIN0);
        for (int i = gt; i < 512 * 1024; i += ngt) { const int n = i & 511, k = i >> 9, g = n >> 7, nn = n & 127;
            const float* wr_ = win + (size_t)k * 1536 + g * 128; const float* mx = mix + (size_t)g * 128 * 128 + nn;
            float s = 0.f;
            for (int c = 0; c < 128; ++c) s += wr_[c] * mx[(size_t)c * 128];
            WIN0[(size_t)n * 1024 + k] = f2bf(s * psc[n]); }
        float* misc = (float*)(a.ws + WS_MISC);
        for (int o = gwb; o < 256; o += ngw) { const int kv = o >> 7, j = o & 127; const float* pos = a.in[kv ? 13 : 10]; const float* w1 = a.in[kv ? 14 : 11];
            float s = 0.f;
#pragma unroll 8
            for (int k = lane; k < 2048; k += 64) s += pos[k] * w1[(size_t)k * 128 + j];
            s = wave_sum(s);
            if (lane == 0) misc[o] = s; }
        float* rot = misc + 1024;
        for (int i = gtr; i < T * 8; i += ngt) { const int t = i >> 3, f = i & 7;
            const float ang = (float)t * a.inv_freq[f]; const double rev = (double)ang * 0.15915494309189535; const float fr = (float)(rev - floor(rev));
            rot[t * 16 + f] = __builtin_amdgcn_cosf(fr); rot[t * 16 + 8 + f] = __builtin_amdgcn_sinf(fr); }
    }
}

typedef short v4i16_t __attribute__((ext_vector_type(4)));
constexpr int AT_KB = 0, AT_VB = 16384, AT_PS = 32768, AT_MSK = 32768 + 65536;
#define DPP_I(x, ctrl) __builtin_amdgcn_update_dpp((int)(x), (int)(x), (ctrl), 0xF, 0xF, true)
#define DPP_F(x, ctrl) __builtin_bit_cast(float, __builtin_amdgcn_update_dpp(__builtin_bit_cast(int, (float)(x)), __builtin_bit_cast(int, (float)(x)), (ctrl), 0xF, 0xF, true))
__device__ __forceinline__ bf16x8 tr_frag(LAS unsigned char* p0, LAS unsigned char* p1) {
    const v4i16_t a = __builtin_amdgcn_ds_read_tr16_b64_v4i16((LAS v4i16_t*)p0), b = __builtin_amdgcn_ds_read_tr16_b64_v4i16((LAS v4i16_t*)p1);
    return (bf16x8){a[0], a[1], a[2], a[3], b[0], b[1], b[2], b[3]};
}
constexpr size_t TN2_OFF = 786432;
__device__ __forceinline__ void ph_knorm(const Args& a) {
    const bf16_t* KV6 = (const bf16_t*)(a.ws + WS_KV6);
    float* TN2 = (float*)(a.ws + WS_MISC + TN2_OFF);
    const int lane = threadIdx.x & 63, wave = threadIdx.x >> 6;
    const int first = (gridDim.x > 64) ? 64 : 0;
    if ((int)blockIdx.x < first) return;
    const int wi = ((int)blockIdx.x - first) * 8 + wave, nw = ((int)gridDim.x - first) * 8;
    for (int id = wi; id < 4096; id += nw) {
        const int ty = id >> 11, bg = (id >> 7) & 15, tile = id & 127;
        const bf16_t* rp = KV6 + ((size_t)((ty ? 4 : 2) * 16 + bg) * T + tile * 64 + lane) * 64;
        float ssq = 0.f;
#pragma unroll
        for (int c = 0; c < 8; ++c) { const bf16x8 v = *(const bf16x8*)(rp + 8 * c);
#pragma unroll
            for (int j = 0; j < 8; ++j) { const float f = bf2f((bf16_t)v[j]); ssq += f * f; } }
        ssq = wave_max(ssq);
        if (lane == 0) TN2[id] = ssq;
    }
}
__device__ __forceinline__ void attn_qk2(LAS unsigned char* Kb, const bf16x8 (&q)[2][2], int fr, int g4, const float (&cinit)[2], f32x4 (&s)[2][4]) {
#pragma unroll
    for (int c = 0; c < 4; ++c) {
#pragma unroll
        for (int rb = 0; rb < 2; ++rb) s[rb][c] = (f32x4){cinit[rb], cinit[rb], cinit[rb], cinit[rb]};
#pragma unroll
        for (int ks = 0; ks < 2; ++ks) {
            const bf16x8 kf = *(const LAS bf16x8*)(Kb + pg8::lds_byte(16 * c + fr, 32 * ks + 8 * g4));
#pragma unroll
            for (int rb = 0; rb < 2; ++rb) s[rb][c] = __builtin_amdgcn_mfma_f32_16x16x32_bf16(kf, q[rb][ks], s[rb][c], 0, 0, 0);
        }
    }
}
__device__ __forceinline__ void attn_qk2m(LAS unsigned char* Kb, const bf16x8 (&q)[2][2], int fr, int g4, const float (&cinit)[2], f32x4 (&s)[2][4]) {
    bf16x8 kf[4][2];
#pragma unroll
    for (int c = 0; c < 4; ++c)
#pragma unroll
        for (int ks = 0; ks < 2; ++ks) kf[c][ks] = *(const LAS bf16x8*)(Kb + pg8::lds_byte(16 * c + fr, 32 * ks + 8 * g4));
    __builtin_amdgcn_sched_barrier(0);
    f32x4 ci[2];
#pragma unroll
    for (int rb = 0; rb < 2; ++rb) ci[rb] = (f32x4){cinit[rb], cinit[rb], cinit[rb], cinit[rb]};
#pragma unroll
    for (int c = 0; c < 4; ++c) {
#pragma unroll
        for (int ks = 0; ks < 2; ++ks) {
#pragma unroll
            for (int rb = 0; rb < 2; ++rb) s[rb][c] = __builtin_amdgcn_mfma_f32_16x16x32_bf16(kf[c][ks], q[rb][ks], ks == 0 ? ci[rb] : s[rb][c], 0, 0, 0);
        }
    }
}
__device__ __forceinline__ void attn_qk2z(LAS unsigned char* Kb, const bf16x8 (&q)[2][2], int fr, int g4, f32x4 (&s)[2][4]) {
    bf16x8 kf[4][2];
#pragma unroll
    for (int c = 0; c < 4; ++c)
#pragma unroll
        for (int ks = 0; ks < 2; ++ks) kf[c][ks] = *(const LAS bf16x8*)(Kb + pg8::lds_byte(16 * c + fr, 32 * ks + 8 * g4));
    __builtin_amdgcn_sched_barrier(0);
#pragma unroll
    for (int c = 0; c < 4; ++c) {
#pragma unroll
        for (int ks = 0; ks < 2; ++ks) {
#pragma unroll
            for (int rb = 0; rb < 2; ++rb) s[rb][c] = __builtin_amdgcn_mfma_f32_16x16x32_bf16(kf[c][ks], q[rb][ks], ks == 0 ? (f32x4){0.f, 0.f, 0.f, 0.f} : s[rb][c], 0, 0, 0);
        }
    }
}
struct AttnRow { float m; f32x4 o[4]; f32x4 ol; };
__device__ __forceinline__ float max3f(float a, float b, float c) { float r; asm("v_max3_f32 %0, %1, %2, %3" : "=v"(r) : "v"(a), "v"(b), "v"(c)); return r; }
__device__ __forceinline__ bool attn_sm2(f32x4 (&s)[4], AttnRow& st, int kbase, int g4, int lo, int hi, bool en, bool emask) {
    const float NEG = -INFINITY;
    if (emask) {
#pragma unroll
        for (int c = 0; c < 4; ++c)
#pragma unroll
            for (int i = 0; i < 4; ++i) { const int key = kbase + 16 * c + 4 * g4 + i; if (key < lo || key > hi) s[c][i] = NEG; }
    }
    float mx = max3f(s[0][0], s[0][1], s[0][2]); mx = max3f(mx, s[0][3], s[1][0]); mx = max3f(mx, s[1][1], s[1][2]); mx = max3f(mx, s[1][3], s[2][0]);
    mx = max3f(mx, s[2][1], s[2][2]); mx = max3f(mx, s[2][3], s[3][0]); mx = max3f(mx, s[3][1], s[3][2]); mx = max3f(mx, s[3][3], mx);
    if (!en) mx = NEG;
    mx = max3f(mx, __shfl_xor(mx, 16), mx); mx = max3f(mx, __shfl_xor(mx, 32), mx);
    const float delta = (mx > 20.0f) ? mx : 0.f;
    const bool moved = __builtin_amdgcn_ballot_w64(delta != 0.f) != 0ull;
    if (moved) {
        const float alpha = __builtin_amdgcn_exp2f(-delta);
#pragma unroll
        for (int c = 0; c < 4; ++c) s[c] = s[c] - delta;
#pragma unroll
        for (int dt = 0; dt < 4; ++dt) st.o[dt] *= alpha;
        st.ol *= alpha;
        st.m += delta;
    }
#pragma unroll
    for (int c = 0; c < 4; ++c)
#pragma unroll
        for (int i = 0; i < 4; ++i) s[c][i] = __builtin_amdgcn_exp2f(s[c][i]);
    return moved;
}
__device__ __forceinline__ bool attn_sm2x(f32x4 (&s)[2][4], AttnRow (&st)[2], int kbase, int g4, const int (&lo)[2], const int (&hi)[2], const bool (&en)[2], bool emask) {
    const float NEG = -INFINITY;
    if (emask) {
#pragma unroll
        for (int rb = 0; rb < 2; ++rb)
#pragma unroll
            for (int c = 0; c < 4; ++c)
#pragma unroll
                for (int i = 0; i < 4; ++i) { const int key = kbase + 16 * c + 4 * g4 + i; if (key < lo[rb] || key > hi[rb]) s[rb][c][i] = NEG; }
    }
    float mx[2];
#pragma unroll
    for (int rb = 0; rb < 2; ++rb) {
        float m = max3f(s[rb][0][0], s[rb][0][1], s[rb][0][2]); m = max3f(m, s[rb][0][3], s[rb][1][0]); m = max3f(m, s[rb][1][1], s[rb][1][2]); m = max3f(m, s[rb][1][3], s[rb][2][0]);
        m = max3f(m, s[rb][2][1], s[rb][2][2]); m = max3f(m, s[rb][2][3], s[rb][3][0]); m = max3f(m, s[rb][3][1], s[rb][3][2]); m = max3f(m, s[rb][3][3], m);
        mx[rb] = en[rb] ? m : NEG;
    }
    { const float t0 = __shfl_xor(mx[0], 16), t1 = __shfl_xor(mx[1], 16); mx[0] = max3f(mx[0], t0, t0); mx[1] = max3f(mx[1], t1, t1); }
    { const float t0 = __shfl_xor(mx[0], 32), t1 = __shfl_xor(mx[1], 32); mx[0] = max3f(mx[0], t0, t0); mx[1] = max3f(mx[1], t1, t1); }
    const float d0 = (mx[0] > 20.0f) ? mx[0] : 0.f, d1 = (mx[1] > 20.0f) ? mx[1] : 0.f;
    const bool moved = __builtin_amdgcn_ballot_w64((d0 != 0.f) || (d1 != 0.f)) != 0ull;
    if (moved) {
        const float dl[2] = {d0, d1};
#pragma unroll
        for (int rb = 0; rb < 2; ++rb) {
            const float alpha = __builtin_amdgcn_exp2f(-dl[rb]);
#pragma unroll
            for (int c = 0; c < 4; ++c) s[rb][c] = s[rb][c] - dl[rb];
#pragma unroll
            for (int dt = 0; dt < 4; ++dt) st[rb].o[dt] *= alpha;
            st[rb].ol *= alpha; st[rb].m += dl[rb];
        }
    }
#pragma unroll
    for (int rb = 0; rb < 2; ++rb)
#pragma unroll
        for (int c = 0; c < 4; ++c)
#pragma unroll
            for (int i = 0; i < 4; ++i) s[rb][c][i] = __builtin_amdgcn_exp2f(s[rb][c][i]);
    return moved;
}
__device__ __forceinline__ void attn_pv2x(LAS unsigned char* Vb, const f32x4 (&p)[2][4], int vlane, int swz, const unsigned (&enm)[2], const bool (&act)[2], const bf16x8 onesf, AttnRow (&st)[2]) {
#pragma unroll
    for (int ks = 0; ks < 2; ++ks) {
        bf16x8 pb[2];
#pragma unroll
        for (int rb = 0; rb < 2; ++rb) { u32x4 pw = pack8m(p[rb][2 * ks], p[rb][2 * ks + 1]); pw.x &= enm[rb]; pw.y &= enm[rb]; pw.z &= enm[rb]; pw.w &= enm[rb]; pb[rb] = __builtin_bit_cast(bf16x8, pw); }
#pragma unroll
        for (int dt = 0; dt < 4; ++dt) {
            LAS unsigned char* a0 = Vb + vlane + (2 * ks) * 2048 + ((dt ^ swz) * 32);
            const bf16x8 vf = tr_frag(a0, a0 + 2048);
#pragma unroll
            for (int rb = 0; rb < 2; ++rb) if (act[rb]) st[rb].o[dt] = __builtin_amdgcn_mfma_f32_16x16x32_bf16(vf, pb[rb], st[rb].o[dt], 0, 0, 0);
        }
#pragma unroll
        for (int rb = 0; rb < 2; ++rb) if (act[rb]) st[rb].ol = __builtin_amdgcn_mfma_f32_16x16x32_bf16(onesf, pb[rb], st[rb].ol, 0, 0, 0);
    }
}
__device__ __forceinline__ bool attn_max2x(f32x4 (&s)[2][4], int kbase, int g4, const int (&lo)[2], const int (&hi)[2], const bool (&en)[2], bool emask, float (&d)[2]) {
    const float NEG = -INFINITY;
    MFMA_SETTLE(s);
    if (emask) {
#pragma unroll
        for (int rb = 0; rb < 2; ++rb)
#pragma unroll
            for (int c = 0; c < 4; ++c)
#pragma unroll
                for (int i = 0; i < 4; ++i) { const int key = kbase + 16 * c + 4 * g4 + i; if (key < lo[rb] || key > hi[rb]) s[rb][c][i] = NEG; }
    }
    float mx[2];
#pragma unroll
    for (int rb = 0; rb < 2; ++rb) {
        float m = max3f(s[rb][0][0], s[rb][0][1], s[rb][0][2]); m = max3f(m, s[rb][0][3], s[rb][1][0]); m = max3f(m, s[rb][1][1], s[rb][1][2]); m = max3f(m, s[rb][1][3], s[rb][2][0]);
        m = max3f(m, s[rb][2][1], s[rb][2][2]); m = max3f(m, s[rb][2][3], s[rb][3][0]); m = max3f(m, s[rb][3][1], s[rb][3][2]); m = max3f(m, s[rb][3][3], m);
        mx[rb] = en[rb] ? m : NEG;
    }
    { const float t0 = __shfl_xor(mx[0], 16), t1 = __shfl_xor(mx[1], 16); mx[0] = max3f(mx[0], t0, t0); mx[1] = max3f(mx[1], t1, t1); }
    { const float t0 = __shfl_xor(mx[0], 32), t1 = __shfl_xor(mx[1], 32); mx[0] = max3f(mx[0], t0, t0); mx[1] = max3f(mx[1], t1, t1); }
    d[0] = (mx[0] > 20.0f) ? mx[0] : 0.f; d[1] = (mx[1] > 20.0f) ? mx[1] : 0.f;
    return __builtin_amdgcn_ballot_w64((d[0] != 0.f) || (d[1] != 0.f)) != 0ull;
}
__device__ __forceinline__ void attn_rescale2x(f32x4 (&s)[2][4], AttnRow (&st)[2], const float (&d)[2]) {
#pragma unroll
    for (int rb = 0; rb < 2; ++rb) {
        const float alpha = __builtin_amdgcn_exp2f(-d[rb]);
#pragma unroll
        for (int c = 0; c < 4; ++c) s[rb][c] = s[rb][c] - d[rb];
#pragma unroll
        for (int dt = 0; dt < 4; ++dt) st[rb].o[dt] *= alpha;
        st[rb].ol *= alpha; st[rb].m += d[rb];
    }
}
__device__ __forceinline__ void attn_exp1(f32x4 (&s)[4], unsigned enm, bf16x8 (&pb)[2]) {
#pragma unroll
    for (int c = 0; c < 4; ++c)
#pragma unroll
        for (int i = 0; i < 4; ++i) s[c][i] = __builtin_amdgcn_exp2f(s[c][i]);
#pragma unroll
    for (int ks = 0; ks < 2; ++ks) { u32x4 pw = pack8m(s[2 * ks], s[2 * ks + 1]); pw.x &= enm; pw.y &= enm; pw.z &= enm; pw.w &= enm; pb[ks] = __builtin_bit_cast(bf16x8, pw); }
}
__device__ __forceinline__ void attn_pv1(LAS unsigned char* Vb, const bf16x8 (&pb)[2], int vlane, int swz, const bf16x8 onesf, AttnRow& st) {
#pragma unroll
    for (int ks = 0; ks < 2; ++ks) {
#pragma unroll
        for (int dt = 0; dt < 4; ++dt) {
            LAS unsigned char* a0 = Vb + vlane + (2 * ks) * 2048 + ((dt ^ swz) * 32);
            const bf16x8 vf = tr_frag(a0, a0 + 2048);
            st.o[dt] = __builtin_amdgcn_mfma_f32_16x16x32_bf16(vf, pb[ks], st.o[dt], 0, 0, 0);
        }
        st.ol = __builtin_amdgcn_mfma_f32_16x16x32_bf16(onesf, pb[ks], st.ol, 0, 0, 0);
    }
}
__device__ __forceinline__ bool attn_step2x(LAS unsigned char* Vb, f32x4 (&s)[2][4], AttnRow (&st)[2], int kbase, int g4, const int (&lo)[2], const int (&hi)[2], const bool (&en)[2], const unsigned (&enm)[2], bool emask,
                                            int vlane, int swz, const bf16x8 onesf) {
    float d[2];
    const bool moved = attn_max2x(s, kbase, g4, lo, hi, en, emask, d);
    if (moved) attn_rescale2x(s, st, d);
    bf16x8 p0[2], p1[2];
    attn_exp1(s[0], enm[0], p0);
    attn_pv1(Vb, p0, vlane, swz, onesf, st[0]);
    attn_exp1(s[1], enm[1], p1);
    attn_pv1(Vb, p1, vlane, swz, onesf, st[1]);
    return moved;
}
__device__ __forceinline__ void attn_step2x_nomax(LAS unsigned char* Vb, f32x4 (&s)[2][4], AttnRow (&st)[2], int kbase, int g4, const int (&lo)[2], const int (&hi)[2], const unsigned (&enm)[2], bool emask,
                                                  int vlane, int swz, const bf16x8 onesf) {
    if (emask) {
#pragma unroll
        for (int rb = 0; rb < 2; ++rb)
#pragma unroll
            for (int c = 0; c < 4; ++c)
#pragma unroll
                for (int i = 0; i < 4; ++i) { const int key = kbase + 16 * c + 4 * g4 + i; if (key < lo[rb] || key > hi[rb]) s[rb][c][i] = -INFINITY; }
    }
    bf16x8 p0[2], p1[2];
    attn_exp1(s[0], enm[0], p0);
    attn_pv1(Vb, p0, vlane, swz, onesf, st[0]);
    attn_exp1(s[1], enm[1], p1);
    attn_pv1(Vb, p1, vlane, swz, onesf, st[1]);
}
typedef _Float16 f16x4 __attribute__((ext_vector_type(4)));
constexpr int AT4_KB = 0, AT4_VB = 32768, AT2_PS = 65536, AT2_MSK = 65536 + 65536;
__device__ __forceinline__ int attn_pair_of(int pr) { const int p = pr & 63, k = pr >> 8; const int q = (k & 2) ? ((p + 32) & 63) : p; return (k & 1) ? 63 - q : q; }
__device__ __forceinline__ void ph_attn_fast2(const Args& a, LAS unsigned char* lds) {
    const bf16_t* QN = (const bf16_t*)(a.ws + WS_HN);
    const bf16_t* QR = (const bf16_t*)(a.ws + WS_QR);
    const bf16_t* KV6 = (const bf16_t*)(a.ws + WS_KV6);
    const float* GATES = (const float*)(a.ws + WS_GATES);
    const bf16_t* KC = (const bf16_t*)(a.ws + WS_KC);
    const bf16_t* VC = KC + (size_t)8192 * 64;
    bf16_t* O = (bf16_t*)(a.ws + WS_O);
    const int tid = threadIdx.x, lane = tid & 63, wave = __builtin_amdgcn_readfirstlane(tid >> 6);
    const int fr = lane & 15, g4 = lane >> 4;
    int ksrc, vsrc;
    { int R, C; pg8::stage_rc(wave * 1024 + lane * 16, R, C); ksrc = R * 64 + C;
      const int key = 8 * wave + (lane >> 3), pos = lane & 7, chunk = (pos >> 1) ^ ((key >> 1) & 3); vsrc = key * 64 + (chunk * 2 + (pos & 1)) * 8; }
    const int vlane = (4 * g4 + (fr >> 2)) * 128 + (fr & 3) * 8, swz = (2 * g4 + (fr >> 3)) & 3;
    LAS _Float16* ps = (LAS _Float16*)(lds + AT2_PS + wave * 8192);
    LAS unsigned* mskl = (LAS unsigned*)(lds + AT2_MSK + wave * 128);
    const float NEG = -INFINITY;
    const bf16x8 onesf = (fr == 0) ? (bf16x8){0x3F80, 0x3F80, 0x3F80, 0x3F80, 0x3F80, 0x3F80, 0x3F80, 0x3F80} : (bf16x8){0, 0, 0, 0, 0, 0, 0, 0};
    const int vcu = (gridDim.x % 8 == 0) ? (int)((blockIdx.x % 8) * (gridDim.x / 8) + blockIdx.x / 8) : (int)blockIdx.x;
    int cvt_next = (int)blockIdx.x * 8 + wave; const int cvt_stride = (int)gridDim.x * 8;
    LAS float* cvt_scr = (LAS float*)(lds + AT2_PS + wave * 8448);
    bool cmp_pref = false;
    for (int pr = vcu; pr < 1024; pr += gridDim.x) {
#pragma unroll 1
        for (int half = 0; half < 2; ++half) {
            const int bg = pr >> 6, pp = attn_pair_of(pr), cc = half ? (127 - pp) : pp;
            const int b = bg >> 2, g = bg & 3, t0 = cc * 64, cur = cc;
            const int head = g * 4 + (fr & 3);
            int trow[2];
            bf16x8 qn[2][2];
#pragma unroll
            for (int rb = 0; rb < 2; ++rb) {
                trow[rb] = t0 + 8 * wave + 4 * rb + (fr >> 2);
#pragma unroll
                for (int ks = 0; ks < 2; ++ks) qn[rb][ks] = *(const bf16x8*)(QN + ((size_t)b * T + trow[rb]) * 1024 + head * 64 + 32 * ks + 8 * g4);
            }
#define TROW_PIN() asm volatile("" : "+v"(trow[0]), "+v"(trow[1]))
#define TOKROW(rb) ((size_t)b * T + trow[rb])
#define GATE(rb, br) (GATES[TOKROW(rb) * 48 + head * 3 + (br)])
            const bf16_t* kcb = KC + (size_t)bg * 512 * 64;
            const bf16_t* kvb = KV6 + (size_t)bg * T * 64;
#define ATK(sl) (((sl) < 4 ? AT4_KB : AT2_PS - 4 * 8192) + (sl) * 8192)
#define ATV(sl) (((sl) < 4 ? AT4_VB : AT2_PS + 32768 - 4 * 8192) + (sl) * 8192)
#define AT_DMA(BR, tile, slot) do { const bf16_t* kp_; const bf16_t* vp_; \
                if ((BR) == 0) { kp_ = kcb + (size_t)(tile) * 4096; vp_ = kp_ + (size_t)8192 * 64; } \
                else { kp_ = kvb + (size_t)((BR) == 1 ? 2 : 4) * 16 * T * 64 + (size_t)(tile) * 4096; vp_ = kp_ + (size_t)16 * T * 64; } \
                __builtin_amdgcn_global_load_lds((const unsigned*)(kp_ + ksrc), (LAS unsigned*)(lds + ATK(slot) + wave * 1024), 16, 0, 0); \
                __builtin_amdgcn_global_load_lds((const unsigned*)(vp_ + vsrc), (LAS unsigned*)(lds + ATV(slot) + wave * 1024), 16, 0, 0); } while (0)
            int ncv[2];
#pragma unroll
            for (int rb = 0; rb < 2; ++rb) ncv[rb] = (trow[rb] >= 31) ? ((trow[rb] - 31) / 16 + 1) : 0;
            const int nct = (((t0 + 63 - 31) / 16 + 1) + 63) >> 6;
            float mc[2], invc[2];
            const int t_lo = t0 + 8 * wave, ncv_lo = (t_lo >= 31) ? ((t_lo - 31) / 16 + 1) : 0;
            {
                float m1[2] = {NEG, NEG}, l1[2] = {0.f, 0.f};
                const float zero2[2] = {0.f, 0.f};
#define CMP1_TILE(J, SLOT, MASKED) do { const int j = (J); const int SLOT_ = (SLOT); \
                    f32x4 s[2][4]; attn_qk2(lds + AT4_KB + SLOT_ * 8192, qn, fr, g4, zero2, s); \
                    _Pragma("unroll") \
                    for (int rb = 0; rb < 2; ++rb) { \
                        float mx = NEG; \
                    _Pragma("unroll") \
                        for (int c = 0; c < 4; ++c) \
                    _Pragma("unroll") \
                            for (int i = 0; i < 4; ++i) { const int n = 64 * j + 16 * c + 4 * g4 + i; if ((MASKED) && n >= ncv[rb]) s[rb][c][i] = NEG; mx = fmaxf(mx, s[rb][c][i]); } \
                        mx = fmaxf(mx, __shfl_xor(mx, 16)); mx = fmaxf(mx, __shfl_xor(mx, 32)); \
                        const float mn = fmaxf(m1[rb], mx), msafe = (mn == NEG) ? 0.f : mn; \
                        const float alpha = (m1[rb] == NEG) ? 0.f : __builtin_amdgcn_exp2f(m1[rb] - msafe); \
                        float sum = 0.f; \
                    _Pragma("unroll") \
                        for (int c = 0; c < 4; ++c) \
                    _Pragma("unroll") \
                            for (int i = 0; i < 4; ++i) sum += __builtin_amdgcn_exp2f(s[rb][c][i] - msafe); \
                        l1[rb] = l1[rb] * alpha + sum; m1[rb] = mn; \
                    } \
                } while (0)
                if (!cmp_pref) { AT_DMA(0, 0, 0); if (nct > 1) AT_DMA(0, 1, 1); } __syncthreads();
                for (int j0 = 0; j0 < nct; j0 += 2) { const int sb = (j0 & 2);
                    if (j0 + 2 < nct) AT_DMA(0, j0 + 2, sb ^ 2);
                    if (j0 + 3 < nct) AT_DMA(0, j0 + 3, (sb ^ 2) + 1);
                    CMP1_TILE(j0, sb, true); if (j0 + 1 < nct) CMP1_TILE(j0 + 1, sb + 1, true);
                    __syncthreads();
                }
#undef CMP1_TILE
#pragma unroll
                for (int rb = 0; rb < 2; ++rb) { float lc = l1[rb]; lc += __shfl_xor(lc, 16); lc += __shfl_xor(lc, 32); invc[rb] = (lc > 0.f) ? -(((m1[rb] == NEG) ? 0.f : m1[rb]) + __builtin_amdgcn_logf(lc)) : 0.f; mc[rb] = (m1[rb] == NEG) ? 0.f : m1[rb]; }
            }
            {
                AttnRow oc[2];
#pragma unroll
                for (int rb = 0; rb < 2; ++rb) { oc[rb].m = 0.f; oc[rb].ol = (f32x4){0.f, 0.f, 0.f, 0.f};
#pragma unroll
                    for (int dt = 0; dt < 4; ++dt) oc[rb].o[dt] = (f32x4){0.f, 0.f, 0.f, 0.f}; }
                const float cin[2] = {invc[0], invc[1]};
                const unsigned full[2] = {0xffffffffu, 0xffffffffu}; const bool both[2] = {true, true};
#define CMP2_TILE(J, SLOT, MASKED) do { const int j = (J); const int SLOT_ = (SLOT); \
                    f32x4 s[2][4]; attn_qk2(lds + AT4_KB + SLOT_ * 8192, qn, fr, g4, cin, s); \
                    _Pragma("unroll") \
                    for (int rb = 0; rb < 2; ++rb) \
                    _Pragma("unroll") \
                        for (int c = 0; c < 4; ++c) { \
                            f16x4 hs; \
                    _Pragma("unroll") \
                            for (int i = 0; i < 4; ++i) { const int n = 64 * j + 16 * c + 4 * g4 + i; const float p = (!(MASKED) || n < ncv[rb]) ? __builtin_amdgcn_exp2f(s[rb][c][i]) : 0.f; s[rb][c][i] = p; \
                                float h = p; h += DPP_F(h, 0xB1); h += DPP_F(h, 0x4E); hs[i] = (_Float16)h; }        \
                            if ((fr & 3) == 0) *(LAS f16x4*)(ps + (4 * rb + (fr >> 2)) * 512 + 64 * j + 16 * c + 4 * g4) = hs; \
                        } \
                    attn_pv2x(lds + AT4_VB + SLOT_ * 8192, s, vlane, swz, full, both, onesf, oc); \
                } while (0)
                const bool reload = nct > 4;
                if (reload) { AT_DMA(0, 0, 0); AT_DMA(0, 1, 1); __syncthreads(); }
                for (int j0 = 0; j0 < nct; j0 += 2) { const int sb = (j0 & 2);
                    if (reload && j0 + 2 < nct) AT_DMA(0, j0 + 2, sb ^ 2);
                    if (reload && j0 + 3 < nct) AT_DMA(0, j0 + 3, (sb ^ 2) + 1);
                    CMP2_TILE(j0, sb, true); if (j0 + 1 < nct) CMP2_TILE(j0 + 1, sb + 1, true);
                    __syncthreads();
                }
#undef CMP2_TILE
                TROW_PIN();
#pragma unroll
                for (int rb = 0; rb < 2; ++rb) { bf16_t* op = O + TOKROW(rb) * 1024 + head * 64 + 4 * g4; const float g0 = GATE(rb, 0);
#pragma unroll
                    for (int dt = 0; dt < 4; ++dt) { const f32x4 v = oc[rb].o[dt] * g0; u32x2 w; w.x = cvt_pk_bf16(v[0], v[1]); w.y = cvt_pk_bf16(v[2], v[3]); *(u32x2*)(op + 16 * dt) = w; } }
            }
            {
                WSYNC();
                const int tl = lane >> 4, li = lane & 15;
                const int nsel = (cur + 1 < 16) ? (cur + 1) : 16;
#pragma unroll 1
                for (int rnd = 0; rnd < 2; ++rnd) {
                    const LAS _Float16* pst = ps + (4 * rnd + tl) * 512;
                    float v[8];
#pragma unroll
                    for (int k = 0; k < 8; ++k) { const int j = li + 16 * k;
                        float x;
                        if (j > cur) x = NEG;
                        else if (j == 0 || j == cur || j == cur - 1) x = NEG;
                        else { const int n0 = 4 * j; x = (float)pst[n0 - 1] + 2.0f * ((float)pst[n0] + (float)pst[n0 + 1] + (float)pst[n0 + 2]) + (float)pst[n0 + 3]; }
                        v[k] = x; }
                    int vi[8];
#pragma unroll
                    for (int k = 0; k < 8; ++k) vi[k] = __builtin_bit_cast(int, v[k]);
                    unsigned mm[4] = {1u, 0u, 0u, 0u};
                    {
                        const unsigned bc = 1u << (cur & 31); const int wc_ = cur >> 5;
                        mm[0] |= (wc_ == 0) ? bc : 0u; mm[1] |= (wc_ == 1) ? bc : 0u; mm[2] |= (wc_ == 2) ? bc : 0u; mm[3] |= (wc_ == 3) ? bc : 0u;
                        if (cur >= 1) { const unsigned bp = 1u << ((cur - 1) & 31); const int wp_ = (cur - 1) >> 5;
                            mm[0] |= (wp_ == 0) ? bp : 0u; mm[1] |= (wp_ == 1) ? bp : 0u; mm[2] |= (wp_ == 2) ? bp : 0u; mm[3] |= (wp_ == 3) ? bp : 0u; }
                    }
                    const int nforced = (cur >= 2) ? 3 : (cur + 1);
                    for (int it = 0; it < nsel - nforced; ++it) {
                        int bv = max(max(max(vi[0], vi[1]), max(vi[2], vi[3])), max(max(vi[4], vi[5]), max(vi[6], vi[7])));
                        bv = max(bv, DPP_I(bv, 0xB1)); bv = max(bv, DPP_I(bv, 0x4E)); bv = max(bv, DPP_I(bv, 0x141)); bv = max(bv, DPP_I(bv, 0x140));
                        int bi = 255;
#pragma unroll
                        for (int k = 7; k >= 0; --k) bi = (vi[k] == bv) ? (li + 16 * k) : bi;
                        bi = min(bi, DPP_I(bi, 0xB1)); bi = min(bi, DPP_I(bi, 0x4E)); bi = min(bi, DPP_I(bi, 0x141)); bi = min(bi, DPP_I(bi, 0x140));
                        const unsigned bit = 1u << (bi & 31); const int wsel = bi >> 5;
                        mm[0] |= (wsel == 0) ? bit : 0u; mm[1] |= (wsel == 1) ? bit : 0u; mm[2] |= (wsel == 2) ? bit : 0u; mm[3] |= (wsel == 3) ? bit : 0u;
                        if ((bi & 15) == li) {
#pragma unroll
                            for (int k = 0; k < 8; ++k) if ((bi >> 4) == k) vi[k] = (int)0xFF800000;
                        }
                    }
                    if (li == 0) { mskl[(4 * rnd + tl) * 4 + 0] = mm[0]; mskl[(4 * rnd + tl) * 4 + 1] = mm[1]; mskl[(4 * rnd + tl) * 4 + 2] = mm[2]; mskl[(4 * rnd + tl) * 4 + 3] = mm[3]; }
                }
                WSYNC();
            }
            bf16x8 qr[2][2];
            TROW_PIN();
#pragma unroll
            for (int rb = 0; rb < 2; ++rb)
#pragma unroll
                for (int ks = 0; ks < 2; ++ks) qr[rb][ks] = *(const bf16x8*)(QR + TOKROW(rb) * 1024 + head * 64 + 32 * ks + 8 * g4);
            bool nomax_slc, nomax_win;
            {
                float qq = 0.f;
#pragma unroll
                for (int rb = 0; rb < 2; ++rb) { float q2 = 0.f;
#pragma unroll
                    for (int ks = 0; ks < 2; ++ks)
#pragma unroll
                        for (int j = 0; j < 8; ++j) { const float x = bf2f((bf16_t)qr[rb][ks][j]); q2 += x * x; }
                    q2 += __shfl_xor(q2, 16); q2 += __shfl_xor(q2, 32); qq = fmaxf(qq, q2); }
                qq = wave_max(qq);
                const float* tn = (const float*)(a.ws + WS_MISC + TN2_OFF) + bg * 128;
                const int jt0w = (t0 >= 511) ? ((t0 - 511) >> 6) : 0;
                float ts = 0.f, tw = 0.f;
#pragma unroll
                for (int h2 = 0; h2 < 2; ++h2) { const int tl_ = lane + 64 * h2; if (tl_ <= cur) { ts = fmaxf(ts, tn[tl_]); if (tl_ >= jt0w) tw = fmaxf(tw, tn[2048 + tl_]); } }
                ts = wave_max(ts); tw = wave_max(tw);
                nomax_slc = __builtin_amdgcn_readfirstlane((qq * ts <= 3500.0f) ? 1 : 0) != 0;
                nomax_win = __builtin_amdgcn_readfirstlane((qq * tw <= 3500.0f) ? 1 : 0) != 0;
            }
            {
                AttnRow ss[2];
#pragma unroll
                for (int rb = 0; rb < 2; ++rb) { ss[rb].m = 0.f; ss[rb].ol = (f32x4){0.f, 0.f, 0.f, 0.f};
#pragma unroll
                    for (int dt = 0; dt < 4; ++dt) ss[rb].o[dt] = (f32x4){0.f, 0.f, 0.f, 0.f}; }
                const int nt_ = cur + 1;
                bool refmoved = false;
#define SLC_PRE(J) const int j_ = (J); bool en[2], act[2]; unsigned enm[2]; \
                    _Pragma("unroll") for (int rb = 0; rb < 2; ++rb) { const unsigned mw = mwg[rb]; \
                        en[rb] = (mw >> (j_ & 31)) & 1u; act[rb] = __any(en[rb]); enm[rb] = en[rb] ? 0xffffffffu : 0u; } const int lo2[2] = {0, 0};
#define SLC_TILE(J, SLOT) do { SLC_PRE(J) \
                    if (act[0] || act[1]) { f32x4 s[2][4]; \
                        if (refmoved) { const float cin[2] = {-ss[0].m, -ss[1].m}; attn_qk2(lds + ATK(SLOT), qr, fr, g4, cin, s); } \
                        else attn_qk2z(lds + ATK(SLOT), qr, fr, g4, s); \
                        refmoved |= attn_step2x(lds + ATV(SLOT), s, ss, 64 * j_, g4, lo2, trow, en, enm, j_ == cur, vlane, swz, onesf); } } while (0)
#define SLC_TILE_NM(J, SLOT) do { SLC_PRE(J) \
                    if (act[0] || act[1]) { f32x4 s[2][4]; const float cm_[2] = {en[0] ? 0.f : -1e30f, en[1] ? 0.f : -1e30f}; attn_qk2m(lds + ATK(SLOT), qr, fr, g4, cm_, s); \
                        const unsigned fullm_[2] = {0xffffffffu, 0xffffffffu}; \
                        attn_step2x_nomax(lds + ATV(SLOT), s, ss, 64 * j_, g4, lo2, trow, fullm_, j_ == cur, vlane, swz, onesf); } } while (0)
#pragma unroll
                for (int i = 0; i < 4; ++i) if (i < nt_) AT_DMA(1, i, i);
                __syncthreads();
#define SLC_LOOP(TILE) for (int j0 = 0; j0 < nt_; j0 += 4) { const int sb = (j0 & 4); \
                    const unsigned mwg[2] = {mskl[(fr >> 2) * 4 + (j0 >> 5)], mskl[(4 + (fr >> 2)) * 4 + (j0 >> 5)]};       \
                    _Pragma("unroll") for (int i = 0; i < 4; ++i) if (j0 + 4 + i < nt_) AT_DMA(1, j0 + 4 + i, (sb ^ 4) + i); \
                    TILE(j0, sb); if (j0 + 1 < nt_) TILE(j0 + 1, sb + 1); if (j0 + 2 < nt_) TILE(j0 + 2, sb + 2); if (j0 + 3 < nt_) TILE(j0 + 3, sb + 3); \
                    __syncthreads(); }
                if (nomax_slc) { SLC_LOOP(SLC_TILE_NM) } else { SLC_LOOP(SLC_TILE) }
#undef SLC_LOOP
#undef SLC_TILE_NM
#undef SLC_PRE
#undef SLC_TILE
                TROW_PIN();
#pragma unroll
                for (int rb = 0; rb < 2; ++rb) { const float l = __shfl(ss[rb].ol[0], fr); const float sc1 = (l > 0.f) ? GATE(rb, 1) / l : 0.f;
                    bf16_t* op = O + TOKROW(rb) * 1024 + head * 64 + 4 * g4;
#pragma unroll
                    for (int dt = 0; dt < 4; ++dt) { const u32x2 pv = *(const u32x2*)(op + 16 * dt); f32x4 v = ss[rb].o[dt] * sc1;
                        v[0] += __uint_as_float(pv.x << 16); v[1] += __uint_as_float(pv.x & 0xffff0000u); v[2] += __uint_as_float(pv.y << 16); v[3] += __uint_as_float(pv.y & 0xffff0000u);
                        u32x2 w; w.x = cvt_pk_bf16(v[0], v[1]); w.y = cvt_pk_bf16(v[2], v[3]); *(u32x2*)(op + 16 * dt) = w; } }
            }
            {
                AttnRow sw[2];
#pragma unroll
                for (int rb = 0; rb < 2; ++rb) { sw[rb].m = 0.f; sw[rb].ol = (f32x4){0.f, 0.f, 0.f, 0.f};
#pragma unroll
                    for (int dt = 0; dt < 4; ++dt) sw[rb].o[dt] = (f32x4){0.f, 0.f, 0.f, 0.f}; }
                const int jt0 = (t0 >= 511) ? ((t0 - 511) >> 6) : 0;
                const int nt_ = cur - jt0 + 1;
                const unsigned full[2] = {0xffffffffu, 0xffffffffu}; const bool both[2] = {true, true};
                bool refmoved = false;
#define WIN_PRE(JJ) const int j = jt0 + (JJ); f32x4 s[2][4]; const bool edge = (j == cur) || (64 * j < t0 + 63 - 511); const int lo2[2] = {trow[0] - 511, trow[1] - 511};
#define WIN_TILE(JJ, SLOT) do { WIN_PRE(JJ) \
                    if (refmoved) { const float cin[2] = {-sw[0].m, -sw[1].m}; attn_qk2(lds + AT4_KB + (SLOT) * 8192, qr, fr, g4, cin, s); } \
                    else attn_qk2z(lds + AT4_KB + (SLOT) * 8192, qr, fr, g4, s); \
                    refmoved |= attn_step2x(lds + AT4_VB + (SLOT) * 8192, s, sw, 64 * j, g4, lo2, trow, both, full, edge, vlane, swz, onesf); } while (0)
#define WIN_TILE_NM(JJ, SLOT) do { WIN_PRE(JJ) attn_qk2z(lds + AT4_KB + (SLOT) * 8192, qr, fr, g4, s); \
                    attn_step2x_nomax(lds + AT4_VB + (SLOT) * 8192, s, sw, 64 * j, g4, lo2, trow, full, edge, vlane, swz, onesf); } while (0)
                AT_DMA(2, jt0, 0); if (nt_ > 1) AT_DMA(2, jt0 + 1, 1); __syncthreads();
#define WIN_LOOP(TILE) for (int j0 = 0; j0 < nt_; j0 += 2) { const int sb = (j0 & 2); \
                    if (j0 + 2 < nt_) AT_DMA(2, jt0 + j0 + 2, sb ^ 2); \
                    if (j0 + 3 < nt_) AT_DMA(2, jt0 + j0 + 3, (sb ^ 2) + 1); \
                    TILE(j0, sb); if (j0 + 1 < nt_) TILE(j0 + 1, sb + 1); \
                    __syncthreads(); }
                if (nomax_win) { WIN_LOOP(WIN_TILE_NM) } else { WIN_LOOP(WIN_TILE) }
#undef WIN_LOOP
#undef WIN_TILE_NM
#undef WIN_PRE
#undef WIN_TILE
                TROW_PIN();
#pragma unroll
                for (int rb = 0; rb < 2; ++rb) { const float l = __shfl(sw[rb].ol[0], fr); const float sc2 = (l > 0.f) ? GATE(rb, 2) / l : 0.f;
                    bf16_t* op = O + TOKROW(rb) * 1024 + head * 64 + 4 * g4;
                    unsigned char* o8 = (unsigned char*)(a.ws + WS_O8) + TOKROW(rb) * 1024 + head * 64 + 4 * g4;
#pragma unroll
                    for (int dt = 0; dt < 4; ++dt) { const u32x2 pv = *(const u32x2*)(op + 16 * dt); f32x4 v = sw[rb].o[dt] * sc2;
                        v[0] += __uint_as_float(pv.x << 16); v[1] += __uint_as_float(pv.x & 0xffff0000u); v[2] += __uint_as_float(pv.y << 16); v[3] += __uint_as_float(pv.y & 0xffff0000u);
                        *(unsigned*)(o8 + 16 * dt) = pk4_fp8(clamp8(v[0] * X8_SCALE), clamp8(v[1] * X8_SCALE), clamp8(v[2] * X8_SCALE), clamp8(v[3] * X8_SCALE)); } }
            }
#undef AT_DMA
#undef ATK
#undef ATV
#undef TROW_PIN
#undef TOKROW
#undef GATE
            {
                const int npr = half ? pr + (int)gridDim.x : pr, nhalf = half ^ 1;
                cmp_pref = npr < 1024;
                if (cmp_pref) { const int nbg = npr >> 6, npp = attn_pair_of(npr), ncc = nhalf ? (127 - npp) : npp;
                    const int nnct = (((ncc * 64 + 63 - 31) / 16 + 1) + 63) >> 6;
                    const bf16_t* nk = KC + (size_t)nbg * 512 * 64;
                    __builtin_amdgcn_global_load_lds((const unsigned*)(nk + ksrc), (LAS unsigned*)(lds + AT4_KB + wave * 1024), 16, 0, 0);
                    __builtin_amdgcn_global_load_lds((const unsigned*)(nk + (size_t)8192 * 64 + vsrc), (LAS unsigned*)(lds + AT4_VB + wave * 1024), 16, 0, 0);
                    if (nnct > 1) {
                        __builtin_amdgcn_global_load_lds((const unsigned*)(nk + 4096 + ksrc), (LAS unsigned*)(lds + AT4_KB + 8192 + wave * 1024), 16, 0, 0);
                        __builtin_amdgcn_global_load_lds((const unsigned*)(nk + (size_t)8192 * 64 + 4096 + vsrc), (LAS unsigned*)(lds + AT4_VB + 8192 + wave * 1024), 16, 0, 0); } } }
            cvt1_run(a, cvt_next, cvt_stride, 2, cvt_scr, lane);
        }
    }
    cvt1_run(a, cvt_next, cvt_stride, 1 << 20, cvt_scr, lane);
}

__device__ __forceinline__ void unpack8(const u32x4 w, float (&f)[8]) {
    f[0] = __uint_as_float(w.x << 16); f[1] = __uint_as_float(w.x & 0xffff0000u); f[2] = __uint_as_float(w.y << 16); f[3] = __uint_as_float(w.y & 0xffff0000u);
    f[4] = __uint_as_float(w.z << 16); f[5] = __uint_as_float(w.z & 0xffff0000u); f[6] = __uint_as_float(w.w << 16); f[7] = __uint_as_float(w.w & 0xffff0000u);
}
__device__ __forceinline__ void ph_convpool_fast(const Args& a, LAS unsigned char* lds) {
    const bf16_t* H0 = (const bf16_t*)(a.ws + WS_H0);
    bf16_t* CAT = (bf16_t*)(a.ws + WS_CAT);
    const float* cw = a.in[4]; const float* cb = a.in[5]; const float* lg = a.in[6]; const float* lb = a.in[7];
    const int tid = threadIdx.x, lane = tid & 63, wave = tid >> 6, ch = lane * 8;
    constexpr int VT_OFF = 0, UT_OFF = 62 * 1024, CW_OFF = UT_OFF + 47 * 1024;
    for (int i = tid; i < 31 * 64; i += 512) { const int k = i >> 6, c8 = (i & 63) * 8;
        const f32x4 w0 = *(const f32x4*)(cw + k * 512 + c8), w1 = *(const f32x4*)(cw + k * 512 + c8 + 4);
        u32x4 o; o.x = pk2(w0[0], w0[1]); o.y = pk2(w0[2], w0[3]); o.z = pk2(w1[0], w1[1]); o.w = pk2(w1[2], w1[3]);
        *(LAS u32x4*)(lds + CW_OFF + k * 1024 + c8 * 2) = o; }
    float bias[8], gam[8], bet[8];
#pragma unroll
    for (int j = 0; j < 8; ++j) { bias[j] = cb[ch + j]; gam[j] = lg[ch + j]; bet[j] = lb[ch + j]; }
    for (int tile = blockIdx.x; tile < M / 32; tile += gridDim.x) {
        const int tok0 = tile * 32, t0 = tok0 & (T - 1);
        __syncthreads();
        for (int i = tid; i < 62 * 64; i += 512) { const int r = i >> 6, c8 = (i & 63) * 8; const int tt = t0 - 30 + r;
            u32x4 v = (u32x4){0u, 0u, 0u, 0u}; if (tt >= 0) v = *(const u32x4*)(H0 + (size_t)(tok0 - 30 + r) * 1024 + 512 + c8);
            *(LAS u32x4*)(lds + VT_OFF + r * 1024 + c8 * 2) = v; }
        for (int i = tid; i < 47 * 64; i += 512) { const int r = i >> 6, c8 = (i & 63) * 8; const int tt = t0 - 15 + r;
            u32x4 v = (u32x4){0u, 0u, 0u, 0u}; if (tt >= 0) v = *(const u32x4*)(H0 + (size_t)(tok0 - 15 + r) * 1024 + c8);
            *(LAS u32x4*)(lds + UT_OFF + r * 1024 + c8 * 2) = v; }
        __syncthreads();
        float acc[4][8];
#pragma unroll
        for (int j = 0; j < 4; ++j)
#pragma unroll
            for (int c = 0; c < 8; ++c) acc[j][c] = bias[c];
#pragma unroll 1
        for (int k = 0; k < 31; ++k) {
            float w[8]; unpack8(*(const LAS u32x4*)(lds + CW_OFF + k * 1024 + ch * 2), w);
#pragma unroll
            for (int j = 0; j < 4; ++j) { float v[8]; unpack8(*(const LAS u32x4*)(lds + VT_OFF + (4 * wave + j + k) * 1024 + ch * 2), v);
#pragma unroll
                for (int c = 0; c < 8; ++c) acc[j][c] += w[c] * v[c]; }
        }
        const int wnd = 2 << (lane >> 4);
#pragma unroll
        for (int j = 0; j < 4; ++j) {
            const int tl = 4 * wave + j, t = t0 + tl; const size_t tok = (size_t)tok0 + tl;
            const int cnt = (t + 1 < wnd) ? (t + 1) : wnd;
            float s[8], self[8];
            unpack8(*(const LAS u32x4*)(lds + UT_OFF + (15 + tl) * 1024 + ch * 2), self);
#pragma unroll
            for (int c = 0; c < 8; ++c) s[c] = self[c];
            for (int k = 1; k < cnt; ++k) { float v[8]; unpack8(*(const LAS u32x4*)(lds + UT_OFF + (15 + tl - k) * 1024 + ch * 2), v);
#pragma unroll
                for (int c = 0; c < 8; ++c) s[c] += v[c]; }
            const float inv = 1.0f / (float)cnt;
            u32x4 o; o.x = pk2(s[0] * inv - self[0], s[1] * inv - self[1]); o.y = pk2(s[2] * inv - self[2], s[3] * inv - self[3]);
            o.z = pk2(s[4] * inv - self[4], s[5] * inv - self[5]); o.w = pk2(s[6] * inv - self[6], s[7] * inv - self[7]);
            *(u32x4*)(CAT + tok * 1024 + ch) = o;
            float sm = 0.f;
#pragma unroll
            for (int c = 0; c < 8; ++c) sm += acc[j][c];
            const float mean = wave_sum(sm) * (1.0f / 512.0f);
            float sq = 0.f;
#pragma unroll
            for (int c = 0; c < 8; ++c) { acc[j][c] -= mean; sq += acc[j][c] * acc[j][c]; }
            const float rstd = rsqrtf(wave_sum(sq) * (1.0f / 512.0f) + LN_EPS);
            float y[8];
#pragma unroll
            for (int c = 0; c < 8; ++c) { const float z = acc[j][c] * rstd * gam[c] + bet[c]; y[c] = z * sigmoidf_(z); }
            u32x4 o2; o2.x = pk2(y[0], y[1]); o2.y = pk2(y[2], y[3]); o2.z = pk2(y[4], y[5]); o2.w = pk2(y[6], y[7]);
            *(u32x4*)(CAT + tok * 1024 + 512 + ch) = o2;
        }
    }
}


#define RT_DPPI(x, ctrl) __builtin_amdgcn_update_dpp((int)(x), (int)(x), (ctrl), 0xF, 0xF, true)
#define RT_DPPF(x, ctrl) __builtin_bit_cast(float, __builtin_amdgcn_update_dpp(__builtin_bit_cast(int, (float)(x)), __builtin_bit_cast(int, (float)(x)), (ctrl), 0xF, 0xF, true))
#define RT_LANEI(x, l) __builtin_amdgcn_readlane((int)(x), (l))
#define RT_LANEF(x, l) __builtin_bit_cast(float, __builtin_amdgcn_readlane(__builtin_bit_cast(int, (float)(x)), (l)))
__device__ __forceinline__ int RT_KEY(float x) { const int b = __builtin_bit_cast(int, x); return b ^ ((b >> 31) & 0x7fffffff); }
__device__ __forceinline__ void ph_route_fast(const float* LOG, const float* LOG1, const float* bias, unsigned* gcnt, int2* list, unsigned char* ldsg) {
    unsigned* hist = (unsigned*)ldsg; unsigned* base = hist + 256; u32x2* sel = (u32x2*)(ldsg + 2048);
    const int tid = threadIdx.x, lane = tid & 63, wave = tid >> 6;
    const float NEG = -INFINITY;
    const float4 bb = *(const float4*)(bias + lane * 4);
    for (int chunk = blockIdx.x; chunk < M / 128; chunk += gridDim.x) {
        __syncthreads();
        if (tid < 256) hist[tid] = 0u;
        __syncthreads();
        float4 lgn = *(const float4*)(LOG + (size_t)(chunk * 128 + wave * 16) * 256 + lane * 4), lgm = *(const float4*)(LOG1 + (size_t)(chunk * 128 + wave * 16) * 256 + lane * 4);
        for (int i = 0; i < 16; ++i) {
            const int tl = wave * 16 + i, tok = chunk * 128 + tl;
            const float4 lg = make_float4(lgn.x + lgm.x, lgn.y + lgm.y, lgn.z + lgm.z, lgn.w + lgm.w);
            if (i + 1 < 16) { lgn = *(const float4*)(LOG + (size_t)(tok + 1) * 256 + lane * 4); lgm = *(const float4*)(LOG1 + (size_t)(tok + 1) * 256 + lane * 4); }
            const float s0 = sigmoidf_(lg.x), s1 = sigmoidf_(lg.y), s2 = sigmoidf_(lg.z), s3 = sigmoidf_(lg.w);
            const float v0 = s0 + bb.x + 0.0f, v1 = s1 + bb.y + 0.0f, v2 = s2 + bb.z + 0.0f, v3 = s3 + bb.w + 0.0f;
            float m1 = fmaxf(v0, v1), m2 = fminf(v0, v1);
            { const float hi = fmaxf(v2, v3), lo = fminf(v2, v3); const float n1 = fmaxf(m1, hi); const float n2 = fmaxf(fminf(m1, hi), fmaxf(m2, lo)); m1 = n1; m2 = n2; }
#define RT_STEP(ctrl) { const float a1 = RT_DPPF(m1, ctrl), a2 = RT_DPPF(m2, ctrl); const float n1 = fmaxf(m1, a1), n2 = fmaxf(fminf(m1, a1), fmaxf(m2, a2)); m1 = n1; m2 = n2; }
            RT_STEP(0xB1) RT_STEP(0x4E) RT_STEP(0x141)
#undef RT_STEP
            const float gs = m1 + m2; const int mygrp = lane >> 3;
            int rank = 0;
#pragma unroll
            for (int g2 = 0; g2 < 8; ++g2) { const float og = RT_LANEF(gs, g2 * 8); rank += (og > gs || (og == gs && g2 < mygrp)) ? 1 : 0; }
            const bool dead = rank >= 4;
            constexpr int KMIN = (int)0x80000000;
            int k0 = dead ? KMIN : RT_KEY(v0), k1 = dead ? KMIN : RT_KEY(v1), k2 = dead ? KMIN : RT_KEY(v2), k3 = dead ? KMIN : RT_KEY(v3);
            int my_e = 0; float my_s = 0.f;
#pragma unroll
            for (int it = 0; it < 8; ++it) {
                int lm = max(max(k0, k1), max(k2, k3));
                lm = max(lm, RT_DPPI(lm, 0xB1)); lm = max(lm, RT_DPPI(lm, 0x4E)); lm = max(lm, RT_DPPI(lm, 0x141)); lm = max(lm, RT_DPPI(lm, 0x140));
                const int gmax = max(max(RT_LANEI(lm, 0), RT_LANEI(lm, 16)), max(RT_LANEI(lm, 32), RT_LANEI(lm, 48)));
                int cand = (k0 == gmax) ? lane * 4 : (k1 == gmax) ? lane * 4 + 1 : (k2 == gmax) ? lane * 4 + 2 : (k3 == gmax) ? lane * 4 + 3 : 0x7fffffff;
                cand = min(cand, RT_DPPI(cand, 0xB1)); cand = min(cand, RT_DPPI(cand, 0x4E)); cand = min(cand, RT_DPPI(cand, 0x141)); cand = min(cand, RT_DPPI(cand, 0x140));
                const int bi = min(min(RT_LANEI(cand, 0), RT_LANEI(cand, 16)), min(RT_LANEI(cand, 32), RT_LANEI(cand, 48)));
                const int jj = bi & 3, ol = bi >> 2;
                const float mys = (jj == 0) ? s0 : (jj == 1) ? s1 : (jj == 2) ? s2 : s3;
                const float wsc = RT_LANEF(mys, ol);
                const bool me = (lane == ol);
                k0 = (me && jj == 0) ? KMIN : k0; k1 = (me && jj == 1) ? KMIN : k1; k2 = (me && jj == 2) ? KMIN : k2; k3 = (me && jj == 3) ? KMIN : k3;
                if (lane == it) { my_e = bi; my_s = wsc; }
            }
            const float ssum = wave_sum(lane < 8 ? my_s : 0.f);
            if (lane < 8) { const unsigned rk = atomicAdd(&hist[my_e], 1u); u32x2 en; en.x = (unsigned)my_e | (rk << 16); en.y = __float_as_uint(my_s / ssum * 2.5f); sel[tl * 8 + lane] = en; }
        }
        __syncthreads();
        if (tid < 256) { const unsigned h = hist[tid]; base[tid] = h ? atomicAdd(&gcnt[tid], h) : 0u; }
        __syncthreads();
#pragma unroll
        for (int rep = 0; rep < 2; ++rep) { const int idx = tid + rep * 512, tok = chunk * 128 + (idx >> 3), k = idx & 7;
            const u32x2 en = sel[idx]; const unsigned e = en.x & 0xffffu, pos = base[e] + (en.x >> 16);
            list[(size_t)e * LISTCAP + pos] = make_int2(tok * 10 + k, (int)en.y); }
    }
}

__global__ void __launch_bounds__(512, 2) fwd_kernel(Args a) {
    extern __shared__ __attribute__((aligned(16))) unsigned char lds[];
    volatile LAS unsigned* MISC = (volatile LAS unsigned*)((LAS unsigned char*)lds + (LDS_BYTES - 64));
    if (threadIdx.x < 16) MISC[threadIdx.x] = 0u;
    __syncthreads();
    unsigned* ctl = (unsigned*)(a.ws + WS_CTL);
#if MK_ONE_LAUNCH
    (void)xcd_barrier_post(ctl + CW_BAR, MISC + 8);
#define SEAM() do { XcdBarrier b_; b_.bar = (unsigned*)(a.ws + WS_CTL) + CW_BAR; b_.x = xb_xcc_id(); b_.st = MISC + 8; xcd_barrier(b_); } while (0)
#else
#define SEAM() do {} while (0)
#endif
    const int lo = a.ph_lo, hi = a.ph_hi;
#define IN(k) (lo <= (k) && (k) < hi)
#define BOTH(k) (IN(k) && (k) + 1 < hi)
#define X1 ((bf16_t*)(a.ws + WS_X1))
#define X2 ((bf16_t*)(a.ws + WS_X2))
#define LOG ((float*)(a.ws + WS_LOG))

    LAS unsigned char* L = (LAS unsigned char*)lds;
#define LIST ((int2*)(a.ws + WS_LIST))
#ifndef PROBE_DUP_MASK
#define PROBE_DUP_MASK 0u
#endif
#define RUN(k, ...) if (IN(k)) { { __VA_ARGS__ } if ((PROBE_DUP_MASK >> (k)) & 1u) { __syncthreads(); { __VA_ARGS__ } } if (BOTH(k)) SEAM(); }
    RUN(0, ph_prologue(a, L);)
    RUN(1, pg8::DenseSched S; S.init((const bf16_t*)(a.ws + WS_XA), D, (const bf16_t*)(a.ws + WS_WIN0), D, M, 1536);
           EpiInproj0 E{(bf16_t*)(a.ws + WS_H0)};
           pg8::gemm_phase<EpiInproj0, pg8::DenseSched, true>(L, D, 128u, S, E);)
    RUN(2, ph_convpool_fast(a, L);)
    RUN(4, pg8::DenseSched S; S.init((const bf16_t*)(a.ws + WS_CAT), D, (const bf16_t*)(a.ws + WS_WOUT0), D, M, D);
           EpiRes E{a.in[0], nullptr, (bf16_t*)(a.ws + WS_Y), 1.0f};
           pg8::gemm_phase<EpiRes, pg8::DenseSched, true>(L, D, 128u, S, E);)
    RUN(5, ph_ln((const bf16_t*)(a.ws + WS_Y), a.in[17], a.in[18], X1, (unsigned char*)(a.ws + WS_X8));)
#define MOE_LAYER(P, LAYER, XIN, XOUT, OUTF) \
    RUN(P, RouterSched S{(const char*)(XIN), (const char*)((const bf16_t*)(a.ws + WS_WR) + (size_t)(LAYER) * NE * D), (int)gridDim.x, (int)blockIdx.x}; \
           EpiLogits E{LOG, (float*)(a.ws + WS_HID)}; pg8::gemm_phase<EpiLogits, RouterSched, true>(L, D / 2, 128u, S, E, D);) \
    if (IN(P + 1)) { ph_route_fast(LOG, (const float*)(a.ws + WS_HID), a.in[22] + (LAYER) * NE, ctl + CW_CNT + (LAYER) * 256, LIST, lds); if (BOTH(P + 1)) SEAM(); } \
    RUN(P + 2, const int R = moe_setup256(ctl + CW_CNT + (LAYER) * 256, L); \
            MoeGuSched S{(const char*)(a.ws + WS_X8), (const char*)(a.ws + WS_WGU) + (size_t)(LAYER) * 257 * 512 * 1024, LIST, L, R, (R + 128) * 2, (int)gridDim.x, (int)blockIdx.x}; \
            S.prepare(); EpiGateUp E{(unsigned char*)(a.ws + WS_HID)}; pg8::gemm_phase<EpiGateUp, MoeGuSched, true, true>(L, D / 2, 128u, S, E);) \
    RUN(P + 3, const int R = moe_setup256(ctl + CW_CNT + (LAYER) * 256, L); \
            MoeDownSched S{(const char*)(a.ws + WS_HID), (const char*)(a.ws + WS_WD) + (size_t)(LAYER) * 257 * 1024 * 256, LIST, L, R, R + 128, (int)gridDim.x, (int)blockIdx.x}; \
            S.prepare(); EpiDown E{(unsigned char*)(a.ws + WS_YB), L}; pg8::gemm_phase<EpiDown, MoeDownSched, true, true>(L, FF / 2, 128u, S, E);) \
    RUN(P + 4, ph_combine(a, XIN, a.in[19] + (LAYER) * D, a.in[20] + (LAYER) * D, XOUT, OUTF);)
    MOE_LAYER(6, 0, X1, X2, nullptr)
    RUN(11, pg8::DenseSched S; S.init(X2, D, (const bf16_t*)(a.ws + WS_WINN), D, M, HNW);
            EpiInprojN E{(bf16_t*)(a.ws + WS_HN), (bf16_t*)(a.ws + WS_QR), (bf16_t*)(a.ws + WS_KV6), (float*)(a.ws + WS_GATES), (const float*)(a.ws + WS_MISC) + 1024};
            pg8::gemm_phase<EpiInprojN, pg8::DenseSched, true>(L, D, 128u, S, E);)
    RUN(13, Cmp1Sched S{(const char*)(a.ws + WS_KV6), (const char*)(a.ws + WS_CW1), (int)gridDim.x, (int)blockIdx.x};
            EpiCmp1 E{(bf16_t*)(a.ws + WS_CH1), (const float*)(a.ws + WS_MISC)};
            pg8::gemm_phase<EpiCmp1, Cmp1Sched, true>(L, 2048, 128u, S, E); ph_knorm(a);)
    RUN(14, ph_cmp2(a, lds);)
    RUN(15, ph_attn_fast2(a, L);)
    RUN(16, pg8::DenseSched S; S.init((const bf16_t*)(a.ws + WS_O8), D / 2, (const bf16_t*)(a.ws + WS_WOUTN), D / 2, M, D);
            EpiRes E{nullptr, X2, (bf16_t*)(a.ws + WS_Y2), 1.0f / (X8_SCALE * W8_SCALE)};
            pg8::gemm_phase<EpiRes, pg8::DenseSched, true, true>(L, D / 2, 128u, S, E);)
    RUN(17, ph_ln((const bf16_t*)(a.ws + WS_Y2), a.in[17] + D, a.in[18] + D, X1, (unsigned char*)(a.ws + WS_X8));)
    MOE_LAYER(18, 1, X1, (bf16_t*)nullptr, a.out)
}

extern "C" void kernel_launch(void* const* d_in, const int* in_sizes, int n_in, void* d_out, int out_size, void* d_ws, size_t ws_size, hipStream_t stream) {
    static int grid = 0;
    if (grid == 0) {
        if (n_in != 29 || out_size != M * D || ws_size < WS_END) { fprintf(stderr, "kernel_launch: unexpected problem (n_in %d out %d ws %zu)\n", n_in, out_size, ws_size); grid = -1; return; }
        int dev = 0, cus = 0;
        if (hipGetDevice(&dev) != hipSuccess || hipDeviceGetAttribute(&cus, hipDeviceAttributeMultiprocessorCount, dev) != hipSuccess) { grid = -1; return; }
        if (hipFuncSetAttribute((const void*)fwd_kernel, hipFuncAttributeMaxDynamicSharedMemorySize, LDS_BYTES) != hipSuccess) { grid = -1; return; }
        int per_cu = 0;
        (void)hipOccupancyMaxActiveBlocksPerMultiprocessor(&per_cu, (const void*)fwd_kernel, 512, LDS_BYTES);
        (void)hipGetLastError();
        grid = cus;
    }
    if (grid < 0) return;
    (void)hipMemsetAsync((char*)d_ws + WS_CTL, 0, CTL_BYTES, stream);
    Args a{};
    for (int i = 0; i < 29; ++i) a.in[i] = (const float*)d_in[i];
    a.out = (float*)d_out; a.ws = (unsigned char*)d_ws;
    for (int i = 0; i < 8; ++i) a.inv_freq[i] = powf(500000.0f, -(float)(2 * i) / 16.0f);
#if MK_ONE_LAUNCH
    a.ph_lo = 0; a.ph_hi = NPHASE;
    hipLaunchKernelGGL(fwd_kernel, dim3(grid), dim3(512), LDS_BYTES, stream, a);
#else
    for (int p = 0; p < NPHASE; ++p) { a.ph_lo = p; a.ph_hi = p + 1; hipLaunchKernelGGL(fwd_kernel, dim3(grid), dim3(512), LDS_BYTES, stream, a); }
#endif
}
```

```cpp
#include <hip/hip_runtime.h>
#include <cstdint>
#include <cstdio>
#include <cmath>

#ifndef MK_ONE_LAUNCH
#define MK_ONE_LAUNCH 1
#endif

#define LAS __attribute__((address_space(3)))
typedef unsigned short bf16_t;
typedef short bf16x8 __attribute__((ext_vector_type(8)));
typedef float f32x4 __attribute__((ext_vector_type(4)));
typedef unsigned u32x2 __attribute__((ext_vector_type(2)));
typedef unsigned u32x4 __attribute__((ext_vector_type(4)));

constexpr int NB = 4, T = 8192, D = 1024, M = NB * T;
constexpr int NE = 256, TOPK = 8, FF = 256;
constexpr int HNW = 2816;
constexpr int LISTCAP = 32768;
constexpr float ALPHA = 1.4142135623730951f;
constexpr float LN_EPS = 1e-5f;
constexpr float QSCALE = 0.125f * 1.4426950408889634f;
constexpr int YB_NSLOT = 9;
constexpr float YB_SCALE = 16.0f;
constexpr int NPHASE = 23;

constexpr size_t MiB = 1u << 20;
constexpr size_t WS_CTL = 0, CTL_BYTES = 1 * MiB;
constexpr size_t WS_X1 = 1 * MiB;
constexpr size_t WS_X2 = WS_X1 + 64 * MiB;
constexpr size_t WS_LOG = WS_X2 + 64 * MiB;
constexpr size_t WS_LIST = WS_LOG + 32 * MiB;
constexpr size_t WS_WTS = WS_LIST + 64 * MiB;
constexpr size_t WS_HID = WS_WTS + 2 * MiB;
constexpr size_t WS_YB = WS_HID + 184 * MiB;
constexpr size_t WS_END_NAIVE = WS_YB + 576 * MiB;
constexpr size_t WS_WIN0 = WS_END_NAIVE;
constexpr size_t WS_WOUT0 = WS_WIN0 + 3 * MiB;
constexpr size_t WS_WINN = WS_WOUT0 + 2 * MiB;
constexpr size_t WS_WOUTN = WS_WINN + 6 * MiB;
constexpr size_t WS_WR = WS_WOUTN + 2 * MiB;
constexpr size_t WS_CW1 = WS_WR + 1 * MiB;
constexpr size_t WS_MISC = WS_CW1 + 2 * MiB;
constexpr size_t WS_WGU = WS_MISC + 1 * MiB;
constexpr size_t WS_X8 = WS_WGU + 257 * MiB;
constexpr size_t WS_O8 = WS_X8 + 32 * MiB;
constexpr size_t WS_X2_8 = WS_YB + 400 * MiB;
constexpr float X8_SCALE = 8.0f, W8_SCALE = 64.0f, H8_SCALE = 16.0f;
constexpr size_t WS_WD = WS_WGU + 514 * MiB;
constexpr size_t WS_END = WS_WD + 257 * MiB;
constexpr size_t WS_XA = WS_X2;
constexpr size_t WS_H0 = WS_YB;
constexpr size_t WS_PM = WS_H0 + 64 * MiB;
constexpr size_t WS_CAT = WS_PM + 32 * MiB;
constexpr size_t WS_Y = WS_CAT + 64 * MiB;
constexpr size_t WS_HN = WS_YB;
constexpr size_t WS_KV6 = WS_HN + 64 * MiB;
constexpr size_t WS_QR = WS_HN + 176 * MiB;
constexpr size_t WS_GATES = WS_QR + 64 * MiB;
constexpr size_t WS_CH1 = WS_GATES + 8 * MiB;
constexpr size_t WS_KC = WS_CH1 + 4 * MiB;
constexpr size_t WS_O = WS_KC + 2 * MiB;
constexpr size_t WS_Y2 = WS_O + 64 * MiB;
static_assert(WS_Y2 + 64 * MiB <= WS_END_NAIVE, "overlay");
static_assert(WS_Y + 64 * MiB <= WS_END_NAIVE, "overlay");

constexpr int CW_CNT = 64;
constexpr int CW_BAR = 4096;

constexpr int LDS_BYTES = 163840;

__device__ __forceinline__ float bf2f(bf16_t h) { return __uint_as_float(((unsigned)h) << 16); }
__device__ __forceinline__ bf16_t f2bf(float f) { unsigned u = __float_as_uint(f); return (bf16_t)((u + 0x7fffu + ((u >> 16) & 1u)) >> 16); }
__device__ __forceinline__ unsigned pk2(float lo, float hi) { return (unsigned)f2bf(lo) | ((unsigned)f2bf(hi) << 16); }
#define WR_DPP(x, ctrl) __builtin_bit_cast(float, __builtin_amdgcn_update_dpp(__builtin_bit_cast(int, (float)(x)), __builtin_bit_cast(int, (float)(x)), (ctrl), 0xF, 0xF, true))
#define WR_ROW(x, r) __builtin_bit_cast(float, __builtin_amdgcn_readlane(__builtin_bit_cast(int, (float)(x)), 16 * (r)))
__device__ __forceinline__ float wave_sum(float v) {
    v += WR_DPP(v, 0xB1); v += WR_DPP(v, 0x4E); v += WR_DPP(v, 0x141); v += WR_DPP(v, 0x140);
    return (WR_ROW(v, 0) + WR_ROW(v, 1)) + (WR_ROW(v, 2) + WR_ROW(v, 3));
}
__device__ __forceinline__ float wave_max(float v) {
    v = fmaxf(v, WR_DPP(v, 0xB1)); v = fmaxf(v, WR_DPP(v, 0x4E)); v = fmaxf(v, WR_DPP(v, 0x141)); v = fmaxf(v, WR_DPP(v, 0x140));
    return fmaxf(fmaxf(WR_ROW(v, 0), WR_ROW(v, 1)), fmaxf(WR_ROW(v, 2), WR_ROW(v, 3)));
}
__device__ __forceinline__ float sigmoidf_(float x) { return 1.0f / (1.0f + __expf(-x)); }
__device__ __forceinline__ float gelu_tanh(float x) {
    const float u = 0.7978845608028654f * (x + 0.044715f * x * x * x);
    const float e = __expf(2.0f * u);
    const float th = 1.0f - 2.0f / (e + 1.0f);
    return 0.5f * x * (1.0f + th);
}
__device__ __forceinline__ bf16x8 cvt8(const float* p) {
    const float4 a = *(const float4*)p, b = *(const float4*)(p + 4);
    bf16x8 r;
    r[0] = (short)f2bf(a.x); r[1] = (short)f2bf(a.y); r[2] = (short)f2bf(a.z); r[3] = (short)f2bf(a.w);
    r[4] = (short)f2bf(b.x); r[5] = (short)f2bf(b.y); r[6] = (short)f2bf(b.z); r[7] = (short)f2bf(b.w);
    return r;
}
__device__ __forceinline__ bf16x8 colk8(const float* W, int N, int k, int col) {
    bf16x8 r;
#pragma unroll
    for (int j = 0; j < 8; ++j) r[j] = (short)f2bf(W[(size_t)(k + j) * N + col]);
    return r;
}
__device__ __forceinline__ bf16x8 zero8() { return (bf16x8){0, 0, 0, 0, 0, 0, 0, 0}; }
#define WSYNC() asm volatile("s_waitcnt lgkmcnt(0)" ::: "memory")

#define XB_TMO      128
#define XB_XCNT(j)  (256  + 64 * (j))
#define XB_XSUB(j)  (1280 + 64 * (j))
#define XB_XGEN(j)  (2304 + 64 * (j))
#define XB_TOP      3328
#define XB_TOPGEN   3392
#define XCD_BAR_WORDS 3456
#define XB_SPIN_CAP (1u << 22)
__device__ __forceinline__ unsigned xb_ld(unsigned* p)              { return __hip_atomic_load(p, __ATOMIC_RELAXED, __HIP_MEMORY_SCOPE_AGENT); }
__device__ __forceinline__ unsigned xb_add(unsigned* p, unsigned v) { return __hip_atomic_fetch_add(p, v, __ATOMIC_RELAXED, __HIP_MEMORY_SCOPE_AGENT); }
__device__ __forceinline__ unsigned xb_xcc_id() { return (unsigned)__builtin_amdgcn_s_getreg((3 << 11) | 20) & 0xFu; }
#define XB_SPIN(cond, bar) do { unsigned _sp = 0; while (cond) { __builtin_amdgcn_s_sleep(1); \
    if ((++_sp & 255u) == 0u) { if (xb_ld(&(bar)[XB_TMO])) break; if (_sp > XB_SPIN_CAP) { atomicAdd(&(bar)[XB_TMO], 1u); break; } } } } while (0)
struct XcdBarrier { unsigned* bar; unsigned x; volatile LAS unsigned* st; };
__device__ __forceinline__ XcdBarrier xcd_barrier_post(unsigned* bar, volatile LAS unsigned* st) {
    XcdBarrier b; b.bar = bar; b.x = xb_xcc_id(); b.st = st;
    if (threadIdx.x == 0) (void)xb_add(&bar[XB_XCNT(b.x)], 1u);
    return b;
}
__device__ __forceinline__ void xcd_barrier_complete(unsigned* bar, unsigned x, unsigned& nloc, unsigned& nx) {
    const unsigned G = gridDim.x * gridDim.y * gridDim.z;
    unsigned sum, cnt, mine, sp = 0u;
    for (;;) {
        sum = 0u; cnt = 0u; mine = 0u;
#pragma unroll
        for (unsigned j = 0; j < 16; ++j) { const unsigned c = xb_ld(&bar[XB_XCNT(j)]); sum += c; cnt += (c > 0u) ? 1u : 0u; mine = (j == x) ? c : mine; }
        if (sum == G) break;
        __builtin_amdgcn_s_sleep(1);
        if ((++sp & 255u) == 0u) { if (xb_ld(&bar[XB_TMO])) break; if (sp > XB_SPIN_CAP) { atomicAdd(&bar[XB_TMO], 1u); break; } }
    }
    nloc = mine > 0u ? mine : 1u; nx = cnt > 0u ? cnt : 1u;
}
__device__ __forceinline__ void xcd_barrier(const XcdBarrier& b) {
    asm volatile("s_waitcnt vmcnt(0)" ::: "memory");
    __syncthreads();
    if (threadIdx.x == 0) {
        unsigned* bar = b.bar;
        __builtin_amdgcn_s_waitcnt(0);
        unsigned nloc = b.st[0], nx = b.st[1];
        if (nloc == 0u) { xcd_barrier_complete(bar, b.x, nloc, nx); b.st[0] = nloc; b.st[1] = nx; }
        const unsigned old = xb_add(&bar[XB_XSUB(b.x)], 1u);
        const unsigned gen = old / nloc;
        if (old + 1u == (gen + 1u) * nloc) {
            __builtin_amdgcn_fence(__ATOMIC_RELEASE, "agent");
            asm volatile("s_waitcnt vmcnt(0)" ::: "memory");
            const unsigned og = xb_add(&bar[XB_TOP], 1u);
            const unsigned tg = og / nx;
            if (og + 1u == (tg + 1u) * nx) xb_add(&bar[XB_TOPGEN], 1u);
            else XB_SPIN(xb_ld(&bar[XB_TOPGEN]) == tg, bar);
            __builtin_amdgcn_fence(__ATOMIC_ACQUIRE, "agent");
            xb_add(&bar[XB_XGEN(b.x)], 1u);
            asm volatile("s_waitcnt vmcnt(0)" ::: "memory");
        } else {
            XB_SPIN(xb_ld(&bar[XB_XGEN(b.x)]) == gen, bar);
            __builtin_amdgcn_fence(__ATOMIC_ACQUIRE, "agent");
            asm volatile("s_waitcnt vmcnt(0)" ::: "memory");
        }
    }
    __syncthreads();
}

template <class AL, class BL, class EP>
__device__ __forceinline__ void mgemm_tile(unsigned char* lds, int K, const AL& al, const BL& bl, const EP& ep) {
    bf16_t* As = (bf16_t*)lds;
    bf16_t* Bs = As + 128 * 40;
    const int tid = threadIdx.x, lane = tid & 63, wave = tid >> 6;
    const int ar = tid >> 2, ac = (tid & 3) * 8;
    const int bn = tid & 127, bc = (tid >> 7) * 8;
    f32x4 acc[8];
#pragma unroll
    for (int s = 0; s < 8; ++s) acc[s] = (f32x4){0.f, 0.f, 0.f, 0.f};
    bf16x8 ra = al(ac), rb = bl(bc);
    for (int k0 = 0; k0 < K; k0 += 32) {
        __syncthreads();
        *(bf16x8*)(As + ar * 40 + ac) = ra;
        *(bf16x8*)(Bs + bn * 40 + bc) = rb;
        __syncthreads();
        if (k0 + 32 < K) { ra = al(k0 + 32 + ac); rb = bl(k0 + 32 + bc); }
        const bf16x8 af = *(const bf16x8*)(As + (wave * 16 + (lane & 15)) * 40 + (lane >> 4) * 8);
#pragma unroll
        for (int s = 0; s < 8; ++s) {
            const bf16x8 wf = *(const bf16x8*)(Bs + (16 * s + (lane & 15)) * 40 + (lane >> 4) * 8);
            acc[s] = __builtin_amdgcn_mfma_f32_16x16x32_bf16(wf, af, acc[s], 0, 0, 0);
        }
    }
    ep(wave * 16 + (lane & 15), (lane >> 4) * 4, acc);
}
__device__ __forceinline__ void store4bf(bf16_t* p, const f32x4 v) { u32x2 w; w.x = pk2(v[0], v[1]); w.y = pk2(v[2], v[3]); *(u32x2*)p = w; }

struct Args {
    const float* in[29];
    float* out;
    unsigned char* ws;
    float inv_freq[8];
    int ph_lo, ph_hi;
};

__device__ __forceinline__ unsigned pk4_fp8(float a, float b, float c, float d) { int w = __builtin_amdgcn_cvt_pk_fp8_f32(a, b, 0, false); return (unsigned)__builtin_amdgcn_cvt_pk_fp8_f32(c, d, w, true); }
__device__ __forceinline__ u32x2 pack8_fp8(const f32x4 v0, const f32x4 v1) {
    int a = __builtin_amdgcn_cvt_pk_fp8_f32(v0[0], v0[1], 0, false); a = __builtin_amdgcn_cvt_pk_fp8_f32(v0[2], v0[3], a, true);
    int b = __builtin_amdgcn_cvt_pk_fp8_f32(v1[0], v1[1], 0, false); b = __builtin_amdgcn_cvt_pk_fp8_f32(v1[2], v1[3], b, true);
    u32x2 w; w.x = (unsigned)a; w.y = (unsigned)b; return w;
}
__device__ __forceinline__ float clamp8(float v) { return __builtin_amdgcn_fmed3f(v, -448.0f, 448.0f); }
__device__ __forceinline__ void ph_ln(const bf16_t* Y, const float* g, const float* b, bf16_t* X, unsigned char* X8) {
    const int lane = threadIdx.x & 63, wave = threadIdx.x >> 6;
    const int gw = blockIdx.x * 8 + wave, ngw = gridDim.x * 8;
    float gg[16], bb[16];
#pragma unroll
    for (int j = 0; j < 8; ++j) { gg[j] = g[lane * 8 + j]; gg[8 + j] = g[512 + lane * 8 + j]; bb[j] = b[lane * 8 + j]; bb[8 + j] = b[512 + lane * 8 + j]; }
    for (int row0 = gw * 4; row0 < M; row0 += ngw * 4) {
        bf16x8 p0[4], p1[4];
#pragma unroll
        for (int r = 0; r < 4; ++r) { p0[r] = __builtin_nontemporal_load((const bf16x8*)(Y + (size_t)(row0 + r) * 1024 + lane * 8)); p1[r] = __builtin_nontemporal_load((const bf16x8*)(Y + (size_t)(row0 + r) * 1024 + 512 + lane * 8)); }
#pragma unroll
        for (int r = 0; r < 4; ++r) {
            float v[16];
#pragma unroll
            for (int j = 0; j < 8; ++j) { v[j] = bf2f((bf16_t)p0[r][j]); v[8 + j] = bf2f((bf16_t)p1[r][j]); }
            float s = 0.f;
#pragma unroll
            for (int j = 0; j < 16; ++j) s += v[j];
            const float mean = wave_sum(s) * (1.0f / 1024.0f);
            float q = 0.f;
#pragma unroll
            for (int j = 0; j < 16; ++j) { v[j] -= mean; q += v[j] * v[j]; }
            const float rstd = rsqrtf(wave_sum(q) * (1.0f / 1024.0f) + LN_EPS);
            float o[16];
#pragma unroll
            for (int j = 0; j < 16; ++j) o[j] = v[j] * rstd * gg[j] + bb[j];
            u32x4 w0, w1;
            w0.x = pk2(o[0], o[1]); w0.y = pk2(o[2], o[3]); w0.z = pk2(o[4], o[5]); w0.w = pk2(o[6], o[7]);
            w1.x = pk2(o[8], o[9]); w1.y = pk2(o[10], o[11]); w1.z = pk2(o[12], o[13]); w1.w = pk2(o[14], o[15]);
            *(u32x4*)(X + (size_t)(row0 + r) * 1024 + lane * 8) = w0; *(u32x4*)(X + (size_t)(row0 + r) * 1024 + 512 + lane * 8) = w1;
#pragma unroll
            for (int j = 0; j < 16; ++j) o[j] = clamp8(o[j] * X8_SCALE);
            u32x2 q0, q1; q0.x = pk4_fp8(o[0], o[1], o[2], o[3]); q0.y = pk4_fp8(o[4], o[5], o[6], o[7]); q1.x = pk4_fp8(o[8], o[9], o[10], o[11]); q1.y = pk4_fp8(o[12], o[13], o[14], o[15]);
            *(u32x2*)(X8 + (size_t)(row0 + r) * 1024 + lane * 8) = q0; *(u32x2*)(X8 + (size_t)(row0 + r) * 1024 + 512 + lane * 8) = q1;
        }
    }
}

__device__ __forceinline__ void ph_combine(const Args& a, const bf16_t* X, const float* g, const float* b, bf16_t* Xo, float* outf) {
    const unsigned char* YB = (const unsigned char*)(a.ws + WS_YB);
    const int lane = threadIdx.x & 63, wave = threadIdx.x >> 6;
    const int gw = blockIdx.x * 8 + wave, ngw = gridDim.x * 8;
    for (int row = gw; row < M; row += ngw) {
        float v[16];
#pragma unroll
        for (int j = 0; j < 16; ++j) v[j] = 0.f;
        u32x2 q0[YB_NSLOT], q1[YB_NSLOT];
#pragma unroll
        for (int k = 0; k < YB_NSLOT; ++k) { const unsigned char* yr = YB + ((size_t)row * 10 + k) * 1024; q0[k] = __builtin_nontemporal_load((const u32x2*)(yr + lane * 8)); q1[k] = __builtin_nontemporal_load((const u32x2*)(yr + 512 + lane * 8)); }
#pragma unroll
        for (int k = 0; k < YB_NSLOT; ++k) {
            const auto a0 = __builtin_amdgcn_cvt_pk_f32_fp8((int)q0[k].x, false), a1 = __builtin_amdgcn_cvt_pk_f32_fp8((int)q0[k].x, true), a2 = __builtin_amdgcn_cvt_pk_f32_fp8((int)q0[k].y, false), a3 = __builtin_amdgcn_cvt_pk_f32_fp8((int)q0[k].y, true);
            const auto b0 = __builtin_amdgcn_cvt_pk_f32_fp8((int)q1[k].x, false), b1 = __builtin_amdgcn_cvt_pk_f32_fp8((int)q1[k].x, true), b2 = __builtin_amdgcn_cvt_pk_f32_fp8((int)q1[k].y, false), b3 = __builtin_amdgcn_cvt_pk_f32_fp8((int)q1[k].y, true);
            v[0] += a0[0]; v[1] += a0[1]; v[2] += a1[0]; v[3] += a1[1]; v[4] += a2[0]; v[5] += a2[1]; v[6] += a3[0]; v[7] += a3[1];
            v[8] += b0[0]; v[9] += b0[1]; v[10] += b1[0]; v[11] += b1[1]; v[12] += b2[0]; v[13] += b2[1]; v[14] += b3[0]; v[15] += b3[1];
        }
        {
            const bf16x8 p0 = *(const bf16x8*)(X + (size_t)row * 1024 + lane * 8), p1 = *(const bf16x8*)(X + (size_t)row * 1024 + 512 + lane * 8);
#pragma unroll
            for (int j = 0; j < 8; ++j) { v[j] = v[j] * (1.0f / YB_SCALE) + ALPHA * bf2f((bf16_t)p0[j]); v[8 + j] = v[8 + j] * (1.0f / YB_SCALE) + ALPHA * bf2f((bf16_t)p1[j]); }
        }
        float s = 0.f;
#pragma unroll
        for (int j = 0; j < 16; ++j) s += v[j];
        const float mean = wave_sum(s) * (1.0f / 1024.0f);
        float q = 0.f;
#pragma unroll
        for (int j = 0; j < 16; ++j) { v[j] -= mean; q += v[j] * v[j]; }
        const float rstd = rsqrtf(wave_sum(q) * (1.0f / 1024.0f) + LN_EPS);
        float o[16];
#pragma unroll
        for (int j = 0; j < 8; ++j) { o[j] = v[j] * rstd * g[lane * 8 + j] + b[lane * 8 + j]; o[8 + j] = v[8 + j] * rstd * g[512 + lane * 8 + j] + b[512 + lane * 8 + j]; }
        if (outf) {
            float* op = outf + (size_t)row * 1024;
            *(float4*)(op + lane * 8) = make_float4(o[0], o[1], o[2], o[3]); *(float4*)(op + lane * 8 + 4) = make_float4(o[4], o[5], o[6], o[7]);
            *(float4*)(op + 512 + lane * 8) = make_float4(o[8], o[9], o[10], o[11]); *(float4*)(op + 512 + lane * 8 + 4) = make_float4(o[12], o[13], o[14], o[15]);
        } else {
            u32x4 w0, w1;
            w0.x = pk2(o[0], o[1]); w0.y = pk2(o[2], o[3]); w0.z = pk2(o[4], o[5]); w0.w = pk2(o[6], o[7]);
            w1.x = pk2(o[8], o[9]); w1.y = pk2(o[10], o[11]); w1.z = pk2(o[12], o[13]); w1.w = pk2(o[14], o[15]);
            *(u32x4*)(Xo + (size_t)row * 1024 + lane * 8) = w0; *(u32x4*)(Xo + (size_t)row * 1024 + 512 + lane * 8) = w1;
            unsigned char* X8o = (unsigned char*)(a.ws + WS_X2_8);
#pragma unroll
            for (int j = 0; j < 16; ++j) o[j] = clamp8(o[j] * X8_SCALE);
            u32x2 q0, q1; q0.x = pk4_fp8(o[0], o[1], o[2], o[3]); q0.y = pk4_fp8(o[4], o[5], o[6], o[7]); q1.x = pk4_fp8(o[8], o[9], o[10], o[11]); q1.y = pk4_fp8(o[12], o[13], o[14], o[15]);
            *(u32x2*)(X8o + (size_t)row * 1024 + lane * 8) = q0; *(u32x2*)(X8o + (size_t)row * 1024 + 512 + lane * 8) = q1;
        }
    }
}

__device__ __forceinline__ void ph_cmp2(const Args& a, unsigned char* lds) {
    const bf16_t* CH1 = (const bf16_t*)(a.ws + WS_CH1);
    bf16_t* KC = (bf16_t*)(a.ws + WS_KC);
    const int tid = threadIdx.x;
    for (int u = blockIdx.x; u < 64 * 2; u += gridDim.x) {
        const int rt = u >> 1, kv = u & 1;
        const bf16_t* ar = CH1 + ((size_t)kv * 8192 + rt * 128 + (tid >> 2)) * 128;
        const float* w2 = a.in[kv ? 15 : 12];
        const int col = tid & 127;
        auto al = [&](int k) { return *(const bf16x8*)(ar + k); };
        auto bl = [&](int k) { return (col < 64) ? colk8(w2, 64, k, col) : zero8(); };
        auto ep = [&](int r, int cb, const f32x4 (&acc)[8]) {
            bf16_t* o = KC + ((size_t)kv * 8192 + rt * 128 + r) * 64;
#pragma unroll
            for (int s = 0; s < 4; ++s) store4bf(o + 16 * s + cb, acc[s]);
        };
        mgemm_tile(lds, 128, al, bl, ep);
    }
}

namespace pg8 {
constexpr int BM = 256, BK = 64, HALF = 128, HTB = HALF * BK * 2, STAGE_BYTES = 8 * HTB;
__device__ __forceinline__ int lds_byte(int r, int c) { const int st = (r >> 4) * 2 + (c >> 5), rr = r & 15, cc = c & 31, ob = rr * 64 + cc * 2; return st * 1024 + (ob ^ (((ob >> 9) & 1) << 5)); }
__device__ __forceinline__ void stage_rc(int b, int& R, int& C) { const int st = b / 1024, sb = b % 1024, swz = sb ^ (((sb >> 9) & 1) << 5); R = (st >> 1) * 16 + swz / 64; C = (st & 1) * 32 + (swz % 64) / 2; }
__device__ __forceinline__ int perm32(int rho) { const int n = rho >> 4, i = rho & 15; return 8 * (i >> 2) + 4 * n + (i & 3); }
struct Unit { int pm, pn, ord; };
typedef float f32x16 __attribute__((ext_vector_type(16)));
typedef int i32x8 __attribute__((ext_vector_type(8))); typedef int i32x4_ __attribute__((ext_vector_type(4)));
__device__ __forceinline__ i32x8 f8cat(const bf16x8 lo, const bf16x8 hi) { return __builtin_shufflevector(__builtin_bit_cast(i32x4_, lo), __builtin_bit_cast(i32x4_, hi), 0, 1, 2, 3, 4, 5, 6, 7); }
template <class Epi, class Sched, bool ALIGN_EPI, bool F8 = false>
__device__ __forceinline__ void gemm_phase(LAS unsigned char* lds, const int K, const unsigned kstepA, const Sched& S, const Epi& E, const int Kpitch = 0) {
    const int KP = Kpitch ? Kpitch : K;
    const int tid = threadIdx.x, wid = __builtin_amdgcn_readfirstlane(tid >> 6), lane = tid & 63, wr = wid >> 2, wc = wid & 3, fr = lane & 15, fq = lane >> 4;
    const int nt = K / BK;
    constexpr bool GA = Sched::GATHER;
    int RA[2]; unsigned CA2[2], voffB[2], voffB1[2], voffA[2];
    constexpr bool P16 = Epi::PERM16;
#pragma unroll
    for (int i = 0; i < 2; ++i) { int R, C; stage_rc(tid * 16 + i * 8192, R, C); const int Rb = Epi::PERM ? ((R & ~31) + perm32(R & 31)) : R;
        RA[i] = R; CA2[i] = (unsigned)C * 2u; voffB[i] = (unsigned)(Rb * KP + C) * 2u; voffA[i] = GA ? 0u : (S.lane_off(R) + (unsigned)C * 2u);
        if (P16) { const int c16 = 64 * (R >> 5) + 16 * ((R >> 2) & 3) + 4 * ((R >> 4) & 1) + (R & 3); voffB[i] = (unsigned)(c16 * KP + C) * 2u; voffB1[i] = (unsigned)((c16 + 8) * KP + C) * 2u; } else voffB1[i] = 0u; }
    const size_t kstepB = (size_t)(BK * 2);
    const size_t hstepB = (size_t)HALF * KP * 2;
    const unsigned ldsw = (unsigned)wid * 1024u;
    const int aoff = lds_byte(wr * 64 + fr, fq * 8), boff = lds_byte(wc * 32 + fr, fq * 8);
    const char* const Ab = S.abase();
    unsigned aoC[2][2], aoN[2][2];
    unsigned uC[2], uN[2];
#define PG8_SA(b, h) (((b) * 2 + (h)) * HTB)
#define PG8_SB(b, h) ((4 + (b) * 2 + (h)) * HTB)
#define PG8_GLDS(sbase, voff, ldsoff) do { const char* _b = (const char*)(sbase); unsigned _v = (voff); asm volatile("" : "+s"(_b), "+v"(_v)); \
        __builtin_amdgcn_global_load_lds((const unsigned*)(_b + _v), (LAS unsigned*)(lds + (ldsoff)), 16, 0, 0); } while (0)
#define PG8_STAGE_B(bufoff, gbase) do { _Pragma("unroll") for (int _i = 0; _i < 2; ++_i) PG8_GLDS(gbase, voffB[_i], (bufoff) + ldsw + _i * 8192); } while (0)
#define PG8_STAGE_B1(bufoff, gbase) do { _Pragma("unroll") for (int _i = 0; _i < 2; ++_i) PG8_GLDS((const char*)(gbase) + (P16 ? (size_t)0 : hstepB), (P16 ? voffB1[_i] : voffB[_i]), (bufoff) + ldsw + _i * 8192); } while (0)
#define PG8_STAGE_A(bufoff, kb, UO, LO) do { _Pragma("unroll") for (int _i = 0; _i < 2; ++_i) PG8_GLDS(Ab + (size_t)((kb) + (UO)), (GA ? (LO)[_i] : voffA[_i]), (bufoff) + ldsw + _i * 8192); } while (0)
#define PG8_LDA(dst, b, h) do { _Pragma("unroll") for (int m = 0; m < 4; ++m) _Pragma("unroll") for (int k = 0; k < 2; ++k) dst[m][k] = *(const LAS bf16x8*)(lds + PG8_SA(b, h) + aoff + m * 2048 + k * 1024); } while (0)
#define PG8_LDB(dst, b, h) do { _Pragma("unroll") for (int n = 0; n < 2; ++n) _Pragma("unroll") for (int k = 0; k < 2; ++k) dst[n][k] = *(const LAS bf16x8*)(lds + PG8_SB(b, h) + boff + n * 2048 + k * 1024); } while (0)
#define PG8_MMA(ai, bj, At, Bt) do { __builtin_amdgcn_s_setprio(1); _Pragma("unroll") for (int m = 0; m < 4; ++m) _Pragma("unroll") for (int n = 0; n < 2; ++n) { \
        if constexpr (F8) { f32x16& _w = accw[ai][bj][m >> 1]; const int _q = ((m & 1) * 2 + n) * 4; f32x4 _c = {_w[_q], _w[_q + 1], _w[_q + 2], _w[_q + 3]}; \
            _c = __builtin_amdgcn_mfma_scale_f32_16x16x128_f8f6f4(f8cat(Bt[n][0], Bt[n][1]), f8cat(At[m][0], At[m][1]), _c, 0, 0, 0, 0, 0, 0); _w[_q] = _c[0]; _w[_q + 1] = _c[1]; _w[_q + 2] = _c[2]; _w[_q + 3] = _c[3]; } \
        else { _Pragma("unroll") for (int k = 0; k < 2; ++k) acc[ai][bj][m][n] = __builtin_amdgcn_mfma_f32_16x16x32_bf16(Bt[n][k], At[m][k], acc[ai][bj][m][n], 0, 0, 0); } } __builtin_amdgcn_s_setprio(0); } while (0)
#define PG8_WAIT_V(n) asm volatile("s_waitcnt vmcnt(" #n ")" ::: "memory")
#define PG8_WAIT_L(n) asm volatile("s_waitcnt lgkmcnt(" #n ")" ::: "memory")
#define PG8_BAR __builtin_amdgcn_s_barrier()
#define PG8_SCHED __builtin_amdgcn_sched_barrier(0)
#define PG8_KPAIR(KB1, KB2, KB3, BP2, BP3) do { \
            PG8_LDB(B0, 0, 0); PG8_LDB(B1, 0, 1); PG8_SCHED; PG8_LDA(At, 0, 0); PG8_STAGE_A(PG8_SA(1, 1), KB1, uC[1], aoC[1]); \
            PG8_WAIT_V(8); PG8_WAIT_L(0); PG8_BAR; PG8_MMA(0, 0, At, B0); PG8_MMA(0, 1, At, B1); PG8_BAR; PG8_SCHED; \
            PG8_LDA(At, 0, 1); PG8_STAGE_B(PG8_SB(0, 0), BP2); PG8_STAGE_B1(PG8_SB(0, 1), BP2); PG8_STAGE_A(PG8_SA(0, 0), KB2, u2[0], a2o[0]); \
            PG8_WAIT_V(8); PG8_WAIT_L(0); PG8_BAR; PG8_MMA(1, 0, At, B0); PG8_MMA(1, 1, At, B1); PG8_BAR; PG8_SCHED; \
            PG8_LDB(B0, 1, 0); PG8_LDB(B1, 1, 1); PG8_SCHED; PG8_LDA(At, 1, 0); PG8_STAGE_A(PG8_SA(0, 1), KB2, u2[1], a2o[1]); \
            PG8_WAIT_V(8); PG8_WAIT_L(0); PG8_BAR; PG8_MMA(0, 0, At, B0); PG8_MMA(0, 1, At, B1); PG8_BAR; PG8_SCHED; \
            PG8_LDA(At, 1, 1); PG8_STAGE_B(PG8_SB(1, 0), BP3); PG8_STAGE_B1(PG8_SB(1, 1), BP3); PG8_STAGE_A(PG8_SA(1, 0), KB3, u2[0], a2o[0]); \
            PG8_WAIT_V(8); PG8_WAIT_L(0); PG8_BAR; PG8_MMA(1, 0, At, B0); PG8_MMA(1, 1, At, B1); PG8_BAR; PG8_SCHED; } while (0)
    Unit cur, nxt; int ui = 0;
    if (!S.next(0, cur)) return;
    f32x4 acc[2][2][4][2];
#pragma unroll
    for (int a = 0; a < 2; ++a)
#pragma unroll
        for (int b = 0; b < 2; ++b)
#pragma unroll
            for (int m = 0; m < 4; ++m)
#pragma unroll
                for (int n = 0; n < 2; ++n) acc[a][b][m][n] = (f32x4){0.f, 0.f, 0.f, 0.f};
    bf16x8 At[4][2], B0[2][2], B1[2][2];
    f32x16 accw[2][2][2];
#define PG8_ZERO_W() do { if constexpr (F8) { _Pragma("unroll") for (int _a = 0; _a < 2; ++_a) _Pragma("unroll") for (int _b = 0; _b < 2; ++_b) _Pragma("unroll") for (int _m = 0; _m < 2; ++_m) _Pragma("unroll") for (int _e = 0; _e < 16; ++_e) accw[_a][_b][_m][_e] = 0.f; } } while (0)
    PG8_ZERO_W();
#pragma unroll
    for (int h = 0; h < 2; ++h) { uC[h] = GA ? 0u : S.unit_off(cur, h); uN[h] = uC[h];
#pragma unroll
        for (int i = 0; i < 2; ++i) { aoC[h][i] = GA ? (S.aoff(cur, h * HALF + RA[i]) + CA2[i]) : 0u; aoN[h][i] = aoC[h][i]; } }
    const char* cB = S.bptr(cur);
    PG8_STAGE_B(PG8_SB(0, 0), cB); PG8_STAGE_B1(PG8_SB(0, 1), cB); PG8_STAGE_A(PG8_SA(0, 0), 0u, uC[0], aoC[0]); PG8_STAGE_A(PG8_SA(0, 1), 0u, uC[1], aoC[1]);
    if (wr == 1) PG8_BAR;
    PG8_WAIT_V(2); PG8_BAR;
    PG8_STAGE_B(PG8_SB(1, 0), cB + kstepB); PG8_STAGE_A(PG8_SA(1, 0), kstepA, uC[0], aoC[0]); PG8_STAGE_B1(PG8_SB(1, 1), cB + kstepB);
    PG8_WAIT_V(6); PG8_BAR;
    for (;;) {
        const bool has_next = S.next(ui + 1, nxt);
        const char* nB = has_next ? S.bptr(nxt) : cB;
#pragma unroll
        for (int h = 0; h < 2; ++h) { uN[h] = (GA || !has_next) ? uC[h] : S.unit_off(nxt, h);
#pragma unroll
            for (int i = 0; i < 2; ++i) aoN[h][i] = (GA && has_next) ? (S.aoff(nxt, h * HALF + RA[i]) + CA2[i]) : aoC[h][i]; }
#pragma nounroll
        for (int t = 0; t < nt; t += 2) {
            const bool last = (t == nt - 2);
            const unsigned kb1 = (unsigned)(t + 1) * kstepA, kb2 = last ? 0u : (unsigned)(t + 2) * kstepA, kb3 = kb2 + kstepA;
            const char* b2 = last ? nB : cB + (size_t)(t + 2) * kstepB; const char* b3 = b2 + kstepB;
            unsigned u2[2], a2o[2][2];
#pragma unroll
            for (int h = 0; h < 2; ++h) { u2[h] = last ? uN[h] : uC[h];
#pragma unroll
                for (int i = 0; i < 2; ++i) a2o[h][i] = GA ? (last ? aoN[h][i] : aoC[h][i]) : 0u; }
            PG8_KPAIR(kb1, kb2, kb3, b2, b3);
        }
        if constexpr (ALIGN_EPI) { if (wr == 0) PG8_BAR; }
        if constexpr (F8) {
#pragma unroll
            for (int _a = 0; _a < 2; ++_a)
#pragma unroll
                for (int _b = 0; _b < 2; ++_b)
#pragma unroll
                    for (int _m = 0; _m < 4; ++_m)
#pragma unroll
                        for (int _n = 0; _n < 2; ++_n) { const f32x16& _w = accw[_a][_b][_m >> 1]; const int _q = ((_m & 1) * 2 + _n) * 4; acc[_a][_b][_m][_n] = (f32x4){_w[_q], _w[_q + 1], _w[_q + 2], _w[_q + 3]}; }
        }
        E(acc, cur, wr, wc, fr, fq);
        PG8_ZERO_W();
        if (!has_next) break;
#pragma unroll
        for (int a = 0; a < 2; ++a)
#pragma unroll
            for (int b = 0; b < 2; ++b)
#pragma unroll
                for (int m = 0; m < 4; ++m)
#pragma unroll
                    for (int n = 0; n < 2; ++n) acc[a][b][m][n] = (f32x4){0.f, 0.f, 0.f, 0.f};
        cur = nxt; cB = nB; ++ui;
#pragma unroll
        for (int h = 0; h < 2; ++h) { uC[h] = uN[h];
#pragma unroll
            for (int i = 0; i < 2; ++i) aoC[h][i] = aoN[h][i]; }
        if constexpr (ALIGN_EPI) { if (wr == 1) PG8_BAR; }
    }
    PG8_WAIT_V(0);
    if constexpr (!ALIGN_EPI) { if (wr == 0) PG8_BAR; }
    PG8_BAR;
#undef PG8_SA
#undef PG8_ZERO_W
#undef PG8_GLDS
#undef PG8_SB
#undef PG8_STAGE_A
#undef PG8_STAGE_B
#undef PG8_STAGE_B1
#undef PG8_LDA
#undef PG8_LDB
#undef PG8_MMA
#undef PG8_WAIT_V
#undef PG8_WAIT_L
#undef PG8_BAR
#undef PG8_SCHED
#undef PG8_KPAIR
}

struct DenseSched {
    const char* A; const char* Bt; unsigned lda2; size_t btile; int nM, nN, nwg, G, c, pn0;
    __device__ __forceinline__ void init(const bf16_t* A_, int lda, const bf16_t* Bt_, int K, int Mrows, int N) {
        A = (const char*)A_; Bt = (const char*)Bt_; lda2 = (unsigned)lda * 2u; btile = (size_t)256 * K * 2; nM = Mrows / BM; nN = N / BM; nwg = nM * nN; G = gridDim.x; c = blockIdx.x; pn0 = 0; }
    __device__ __forceinline__ bool next(int i, Unit& u) const {
        const long L = (long)i * G + c; if (L >= nwg) return false;
        int wgid = (int)L; { const int q = nwg / 8, r = nwg % 8, xcd = wgid % 8, off = wgid / 8; wgid = (xcd < r ? xcd * (q + 1) : r * (q + 1) + (xcd - r) * q) + off; }
        const int nig = 8 * nN, gid = wgid / nig, fm = gid * 8, gsz = (nM - fm) < 8 ? (nM - fm) : 8;
        u.pm = fm + ((wgid % nig) % gsz); u.pn = pn0 + (wgid % nig) / gsz; u.ord = i; return true;
    }
    static constexpr bool GATHER = false;
    __device__ __forceinline__ unsigned lane_off(int r) const { return (unsigned)r * lda2; }
    __device__ __forceinline__ unsigned unit_off(const Unit& u, int h) const { return (unsigned)(u.pm * BM + h * HALF) * lda2; }
    __device__ __forceinline__ unsigned aoff(const Unit&, int) const { return 0u; }
    __device__ __forceinline__ const char* abase() const { return A; }
    __device__ __forceinline__ const char* bptr(const Unit& u) const { return Bt + (size_t)u.pn * btile; }
};
}
typedef float f32x2_t __attribute__((ext_vector_type(2))); typedef __bf16 bf16x2_t __attribute__((ext_vector_type(2)));
__device__ __forceinline__ unsigned cvt_pk_bf16(float lo, float hi) { const f32x2_t v = {lo, hi}; const bf16x2_t b = __builtin_convertvector(v, bf16x2_t); return __builtin_bit_cast(unsigned, b); }
__device__ __forceinline__ u32x4 pack8(const f32x4 v0, const f32x4 v1) { u32x4 w; w.x = cvt_pk_bf16(v0[0], v0[1]); w.y = cvt_pk_bf16(v0[2], v0[3]); w.z = cvt_pk_bf16(v1[0], v1[1]); w.w = cvt_pk_bf16(v1[2], v1[3]); return w; }
__device__ __forceinline__ unsigned cvtpk_m(float lo, float hi) { const f32x2_t v = {lo, hi}; const bf16x2_t b = __builtin_convertvector(v, bf16x2_t); return __builtin_bit_cast(unsigned, b); }
__device__ __forceinline__ u32x4 pack8m(const f32x4 v0, const f32x4 v1) { u32x4 w; w.x = cvtpk_m(v0[0], v0[1]); w.y = cvtpk_m(v0[2], v0[3]); w.z = cvtpk_m(v1[0], v1[1]); w.w = cvtpk_m(v1[2], v1[3]); return w; }
#define MFMA_SETTLE(S) asm volatile("s_nop 15\n\ts_nop 7" : "+v"(S[0][0]), "+v"(S[0][1]), "+v"(S[0][2]), "+v"(S[0][3]), "+v"(S[1][0]), "+v"(S[1][1]), "+v"(S[1][2]), "+v"(S[1][3]))
__device__ __forceinline__ f32x4 sig4(const f32x4 v) { f32x4 r; r[0] = sigmoidf_(v[0]); r[1] = sigmoidf_(v[1]); r[2] = sigmoidf_(v[2]); r[3] = sigmoidf_(v[3]); return r; }

#define EPI_ROWLOOP for (int ai = 0; ai < 2; ++ai) _Pragma("unroll") for (int m = 0; m < 4; ++m)
struct EpiInproj0 {
    static constexpr bool PERM = true, PERM16 = false; bf16_t* H0;
    __device__ __forceinline__ void operator()(const f32x4 (&acc)[2][2][4][2], const pg8::Unit& u, int wr, int wc, int fr, int fq) const {
        const int row0 = u.pm * 256 + wr * 64 + fr, cl = wc * 32 + 8 * fq;
#pragma unroll
        EPI_ROWLOOP { bf16_t* rp = H0 + (size_t)(row0 + ai * 128 + m * 16) * 1024;
            if (u.pn < 2) {
#pragma unroll
                for (int bj = 0; bj < 2; ++bj) *(u32x4*)(rp + u.pn * 256 + bj * 128 + cl) = pack8(acc[ai][bj][m][0], acc[ai][bj][m][1]);
            } else {
                const f32x4 v0 = acc[ai][0][m][0] * sig4(acc[ai][1][m][0]), v1 = acc[ai][0][m][1] * sig4(acc[ai][1][m][1]);
                *(u32x4*)(rp + 512 + (u.pn - 2) * 128 + cl) = pack8(v0, v1);
            } }
    }
};
struct EpiRes {
    static constexpr bool PERM = true, PERM16 = false; const float* resf; const bf16_t* resb; bf16_t* Y; float sc;
    __device__ __forceinline__ void operator()(const f32x4 (&acc)[2][2][4][2], const pg8::Unit& u, int wr, int wc, int fr, int fq) const {
        const int row0 = u.pm * 256 + wr * 64 + fr, c0 = u.pn * 256 + wc * 32 + 8 * fq;
#pragma unroll
        EPI_ROWLOOP { const size_t ro = (size_t)(row0 + ai * 128 + m * 16) * 1024 + c0;
#pragma unroll
            for (int bj = 0; bj < 2; ++bj) {
                f32x4 r0, r1;
                if (resf) { r0 = *(const f32x4*)(resf + ro + bj * 128); r1 = *(const f32x4*)(resf + ro + bj * 128 + 4); }
                else { const u32x4 xv = *(const u32x4*)(resb + ro + bj * 128);
                    r0[0] = __uint_as_float(xv.x << 16); r0[1] = __uint_as_float(xv.x & 0xffff0000u); r0[2] = __uint_as_float(xv.y << 16); r0[3] = __uint_as_float(xv.y & 0xffff0000u);
                    r1[0] = __uint_as_float(xv.z << 16); r1[1] = __uint_as_float(xv.z & 0xffff0000u); r1[2] = __uint_as_float(xv.w << 16); r1[3] = __uint_as_float(xv.w & 0xffff0000u); }
                *(u32x4*)(Y + ro + bj * 128) = pack8(acc[ai][bj][m][0] * sc + r0 * ALPHA, acc[ai][bj][m][1] * sc + r1 * ALPHA);
            } }
    }
};
struct RouterSched {
    const char* A; const char* Bt; int G, c;
    static constexpr bool GATHER = false;
    __device__ __forceinline__ bool next(int i, pg8::Unit& u) const { const int L = i * G + c; if (L >= 256) return false; u.pm = L >> 1; u.pn = L & 1; u.ord = i; return true; }
    __device__ __forceinline__ unsigned lane_off(int r) const { return (unsigned)r * 2048u; }
    __device__ __forceinline__ unsigned unit_off(const pg8::Unit& u, int h) const { return (unsigned)(u.pm * 256 + h * 128) * 2048u + (unsigned)u.pn * 1024u; }
    __device__ __forceinline__ unsigned aoff(const pg8::Unit&, int) const { return 0u; }
    __device__ __forceinline__ const char* abase() const { return A; }
    __device__ __forceinline__ const char* bptr(const pg8::Unit& u) const { return Bt + (size_t)u.pn * 1024; }
};
struct EpiLogits {
    static constexpr bool PERM = true, PERM16 = false; float* LOG; float* LOG1;
    __device__ __forceinline__ void operator()(const f32x4 (&acc)[2][2][4][2], const pg8::Unit& u, int wr, int wc, int fr, int fq) const {
        const int row0 = u.pm * 256 + wr * 64 + fr, cl = wc * 32 + 8 * fq;
#pragma unroll
        EPI_ROWLOOP { float* rp = (u.pn ? LOG1 : LOG) + (size_t)(row0 + ai * 128 + m * 16) * 256 + cl;
#pragma unroll
            for (int bj = 0; bj < 2; ++bj) { *(f32x4*)(rp + bj * 128) = acc[ai][bj][m][0]; *(f32x4*)(rp + bj * 128 + 4) = acc[ai][bj][m][1]; } }
    }
};

constexpr int MOE_TAB_OFF = 131072;
__device__ __forceinline__ int moe_setup256(const unsigned* cnt, LAS unsigned char* lds) {
    LAS int* tstart = (LAS int*)(lds + MOE_TAB_OFF);
    LAS int* scnt = (LAS int*)(lds + MOE_TAB_OFF + 1088);
    LAS unsigned short* texp = (LAS unsigned short*)(lds + MOE_TAB_OFF + 2176);
    const int tid = threadIdx.x;
    __syncthreads();
    const int lane = tid & 63, wave = tid >> 6;
    LAS int* wtot = tstart + 260;
    int c = 0;
    if (tid < 256) { const int n = (int)cnt[tid]; scnt[tid] = n; c = (n + 255) >> 8; }
    int incl = c;
#pragma unroll
    for (int o = 1; o < 64; o <<= 1) { const int t = __shfl_up(incl, o); if (lane >= o) incl += t; }
    if (tid < 256 && lane == 63) wtot[wave] = incl;
    __syncthreads();
    if (tid < 256) { int off = 0;
#pragma unroll
        for (int w = 0; w < 3; ++w) off += (w < wave) ? wtot[w] : 0;
        tstart[tid] = off + incl - c; if (tid == 255) tstart[256] = off + incl; }
    __syncthreads();
    if (tid < 256) for (int q = tstart[tid]; q < tstart[tid + 1]; ++q) texp[q] = (unsigned short)tid;
    __syncthreads();
    return __builtin_amdgcn_readfirstlane(tstart[256]);
}
constexpr int MOE_TOK_OFF = MOE_TAB_OFF + 5120;
constexpr int MOE_MAX_ORD = 20;
struct MoeGuSched {
    static constexpr bool GATHER = true;
    const char* X; const char* W; const int2* list; LAS unsigned char* lds; int R, nunits, G, c;
    __device__ __forceinline__ int vcu() const { return (G % 8 == 0) ? (c % 8) * (G / 8) + c / 8 : c; }
    __device__ __forceinline__ bool next(int i, pg8::Unit& u) const {
        const int L = i * G + vcu(); if (L >= nunits || i >= MOE_MAX_ORD) return false;
        const int q = L >> 1; const int e = __builtin_amdgcn_readfirstlane((q < R) ? (int)((LAS unsigned short*)(lds + MOE_TAB_OFF + 2176))[q] : 256);
        u.pm = q; u.pn = e * 2 + (L & 1); u.ord = i; return true; }
    __device__ __forceinline__ void prepare() const {
        const int tid = threadIdx.x, r = tid & 255;
        pg8::Unit u;
        for (int i = tid >> 8; next(i, u); i += 2) {
            const int e = u.pn >> 1; int token;
            if (e < 256) { const int ts = ((LAS int*)(lds + MOE_TAB_OFF))[e], cn = ((LAS int*)(lds + MOE_TAB_OFF + 1088))[e]; int lr = (u.pm - ts) * 256 + r; if (lr >= cn) lr = cn - 1;
                token = list[(size_t)e * LISTCAP + lr].x / 10; }
            else token = (u.pm - R) * 256 + r;
            ((LAS unsigned short*)(lds + MOE_TOK_OFF))[i * 256 + r] = (unsigned short)token;
        }
        __syncthreads();
    }
    __device__ __forceinline__ unsigned aoff(const pg8::Unit& u, int r) const { return (unsigned)((LAS unsigned short*)(lds + MOE_TOK_OFF))[u.ord * 256 + r] * 1024u; }
    __device__ __forceinline__ unsigned lane_off(int) const { return 0u; }
    __device__ __forceinline__ unsigned unit_off(const pg8::Unit&, int) const { return 0u; }
    __device__ __forceinline__ const char* abase() const { return X; }
    __device__ __forceinline__ const char* bptr(const pg8::Unit& u) const { return W + (size_t)u.pn * (256 * 1024); }
};
constexpr float GU_SC = 1.0f / (X8_SCALE * W8_SCALE);
struct EpiGateUp {
    static constexpr bool PERM = true, PERM16 = false; unsigned char* HID;
    __device__ __forceinline__ void operator()(const f32x4 (&acc)[2][2][4][2], const pg8::Unit& u, int wr, int wc, int fr, int fq) const {
        const int row0 = u.pm * 256 + wr * 64 + fr, c0 = (u.pn & 1) * 128 + wc * 32 + 8 * fq;
#pragma unroll
        EPI_ROWLOOP { const f32x4 g0 = acc[ai][0][m][0] * GU_SC, g1 = acc[ai][0][m][1] * GU_SC;
            f32x4 h0 = g0 * sig4(g0) * (acc[ai][1][m][0] * (GU_SC * H8_SCALE)), h1 = g1 * sig4(g1) * (acc[ai][1][m][1] * (GU_SC * H8_SCALE));
#pragma unroll
            for (int i = 0; i < 4; ++i) { h0[i] = clamp8(h0[i]); h1[i] = clamp8(h1[i]); }
            *(u32x2*)(HID + (size_t)(row0 + ai * 128 + m * 16) * 256 + c0) = pack8_fp8(h0, h1); }
    }
};
constexpr int MOE_RI_OFF = MOE_TAB_OFF + 5120;
constexpr int MOE_MAX_RT = 10;
struct MoeDownSched {
    const char* HID; const char* W; const int2* list; LAS unsigned char* lds; int R, ntile, G, c;
    __device__ __forceinline__ int vcu() const { return (G % 8 == 0) ? (c % 8) * (G / 8) + c / 8 : c; }
    __device__ __forceinline__ int nfull() const { return ntile / G + ((ntile % G) * 2 > G ? 1 : 0); }
    __device__ __forceinline__ bool slot(int o, int& q, int& ct) const {
        const int nf = nfull();
        if (o < nf) { q = vcu() + G * o; ct = -1; return q < ntile; }
        const int x = (o - nf) * G + vcu(); q = nf * G + (x >> 2); ct = x & 3; return q < ntile; }
    __device__ __forceinline__ bool next(int i, pg8::Unit& u) const {
        const int nf = nfull(); int o, q, ct;
        if (i < 4 * nf) { o = i >> 2; q = vcu() + G * o; ct = i & 3; if (q >= ntile) return false; }
        else { o = nf + (i - 4 * nf); if (o >= MOE_MAX_RT || !slot(o, q, ct)) return false; }
        const int e = (q < R) ? (int)((LAS unsigned short*)(lds + MOE_TAB_OFF + 2176))[q] : 256;
        u.pm = q; u.pn = e * 4 + ct; u.ord = o; return true; }
    __device__ __forceinline__ void prepare() const {
        const int tid = threadIdx.x, r = tid & 255;
        for (int o = tid >> 8; o < MOE_MAX_RT; o += 2) {
            int q, ct_; if (!slot(o, q, ct_)) break;
            u32x2 en;
            if (q < R) { const int e = ((LAS unsigned short*)(lds + MOE_TAB_OFF + 2176))[q]; const int ts = ((LAS int*)(lds + MOE_TAB_OFF))[e], cn = ((LAS int*)(lds + MOE_TAB_OFF + 1088))[e];
                const int lr = (q - ts) * 256 + r; if (lr < cn) { const int2 le = list[(size_t)e * LISTCAP + lr]; en.x = (unsigned)le.x; en.y = (unsigned)le.y; } else { en.x = 0xffffffffu; en.y = 0u; } }
            else { en.x = (unsigned)(((q - R) * 256 + r) * 10 + 8); en.y = __float_as_uint(1.0f); }
            ((LAS u32x2*)(lds + MOE_RI_OFF))[o * 256 + r] = en;
        }
        __syncthreads();
    }
    static constexpr bool GATHER = false;
    __device__ __forceinline__ unsigned lane_off(int r) const { return (unsigned)r * 256u; }
    __device__ __forceinline__ unsigned unit_off(const pg8::Unit& u, int h) const { return (unsigned)(u.pm * 256 + h * 128) * 256u; }
    __device__ __forceinline__ unsigned aoff(const pg8::Unit&, int) const { return 0u; }
    __device__ __forceinline__ const char* abase() const { return HID; }
    __device__ __forceinline__ const char* bptr(const pg8::Unit& u) const { return W + (size_t)u.pn * (256 * 256); }
};
struct EpiDown {
    static constexpr bool PERM = true, PERM16 = true;
    unsigned char* YB; LAS unsigned char* lds;
    __device__ __forceinline__ void operator()(const f32x4 (&acc)[2][2][4][2], const pg8::Unit& u, int wr, int wc, int fr, int fq) const {
        asm volatile("" : "+v"(fr), "+v"(fq));
        const unsigned c0b = (unsigned)((u.pn & 3) * 256 + wc * 64 + 16 * fq); const bool shared = (u.pn >> 2) == 256;
        const LAS u32x2* ri = (const LAS u32x2*)(lds + MOE_RI_OFF) + u.ord * 256 + wr * 64 + fr;
#pragma unroll
        for (int ai = 0; ai < 2; ++ai)
#pragma unroll
            for (int m = 0; m < 4; ++m) { const u32x2 en = ri[ai * 128 + m * 16]; const float wv = __uint_as_float(en.y) * (YB_SCALE / (H8_SCALE * W8_SCALE));
                if ((int)en.x >= 0) { unsigned char* rp = YB + (size_t)(en.x * 1024u + c0b);
                    const f32x4 v00 = acc[ai][0][m][0] * wv, v01 = acc[ai][0][m][1] * wv, v10 = acc[ai][1][m][0] * wv, v11 = acc[ai][1][m][1] * wv;
                    const u32x2 h0 = pack8_fp8(v00, v01), h1 = pack8_fp8(v10, v11);
                    *(u32x4*)rp = (u32x4){h0.x, h0.y, h1.x, h1.y};
                    if (YB_NSLOT == 10 && shared) {
                        u32x2 r_[2];
#pragma unroll
                        for (int bj = 0; bj < 2; ++bj) { const u32x2 h = bj ? h1 : h0; const f32x4 v0 = bj ? v10 : v00, v1 = bj ? v11 : v01;
                            const auto a0 = __builtin_amdgcn_cvt_pk_f32_fp8((int)h.x, false), a1 = __builtin_amdgcn_cvt_pk_f32_fp8((int)h.x, true), a2 = __builtin_amdgcn_cvt_pk_f32_fp8((int)h.y, false), a3 = __builtin_amdgcn_cvt_pk_f32_fp8((int)h.y, true);
                            const f32x4 r0 = {v0[0] - a0[0], v0[1] - a0[1], v0[2] - a1[0], v0[3] - a1[1]}, r1 = {v1[0] - a2[0], v1[1] - a2[1], v1[2] - a3[0], v1[3] - a3[1]};
                            r_[bj] = pack8_fp8(r0, r1); }
                        *(u32x4*)(rp + 1024) = (u32x4){r_[0].x, r_[0].y, r_[1].x, r_[1].y}; } } }
    }
};

struct EpiInprojN {
    static constexpr bool PERM = true, PERM16 = false; bf16_t* QN; bf16_t* QR; bf16_t* KV6; float* GATES; const float* ROT;
    static constexpr float SC = 1.0f / (X8_SCALE * W8_SCALE);
    __device__ __forceinline__ void operator()(const f32x4 (&acc)[2][2][4][2], const pg8::Unit& u, int wr, int wc, int fr, int fq) const {
        const int row0 = u.pm * 256 + wr * 64 + fr, cl = wc * 32 + 8 * fq, pn = u.pn;
        const bool isq = pn < 4, rotk = (pn == 6 || pn == 8), dorot = (isq || rotk) && ((wc & 1) == 0);
#pragma unroll
        EPI_ROWLOOP { const int row = row0 + ai * 128 + m * 16;
            if (pn == 10) {
                if (cl < 48) { *(f32x4*)(GATES + (size_t)row * 48 + cl) = sig4(acc[ai][0][m][0] * SC); *(f32x4*)(GATES + (size_t)row * 48 + cl + 4) = sig4(acc[ai][0][m][1] * SC); }
            } else {
                f32x4 cs0, cs1, sn0, sn1;
                if (dorot) { const float* rt = ROT + (size_t)(row & (T - 1)) * 16; cs0 = *(const f32x4*)rt; cs1 = *(const f32x4*)(rt + 4); sn0 = *(const f32x4*)(rt + 8); sn1 = *(const f32x4*)(rt + 12); }
#pragma unroll
                for (int bj = 0; bj < 2; ++bj) {
                    const f32x4 v0 = acc[ai][bj][m][0] * SC, v1 = acc[ai][bj][m][1] * SC;
                    f32x4 r0 = v0, r1 = v1;
                    if (dorot) {
                        f32x4 p0, p1;
#pragma unroll
                        for (int i = 0; i < 4; ++i) { p0[i] = __shfl_xor(v0[i], 16); p1[i] = __shfl_xor(v1[i], 16); }
                        if (fq == 0) { r0 = v0 * cs0 - p0 * sn0; r1 = v1 * cs1 - p1 * sn1; }
                        else if (fq == 1) { r0 = v0 * cs0 + p0 * sn0; r1 = v1 * cs1 + p1 * sn1; }
                    }
                    if (isq) { const int c = pn * 256 + bj * 128 + cl;
                        *(u32x4*)(QN + (size_t)row * 1024 + c) = pack8(v0 * QSCALE, v1 * QSCALE); *(u32x4*)(QR + (size_t)row * 1024 + c) = pack8(r0 * QSCALE, r1 * QSCALE); }
                    else { const int cc = bj * 128 + cl, g = cc >> 6, d = cc & 63, b = row >> 13, t = row & (T - 1);
                        if (pn < 6) {
                            f32x4 e0 = r0 * X8_SCALE, e1 = r1 * X8_SCALE;
#pragma unroll
                            for (int i = 0; i < 4; ++i) { e0[i] = clamp8(e0[i]); e1[i] = clamp8(e1[i]); }
                            *(u32x2*)((unsigned char*)KV6 + ((size_t)((pn - 4) * 16 + b * 4 + g) * T + t) * 64 + d) = pack8_fp8(e0, e1); }
                        else *(u32x4*)(KV6 + ((size_t)((pn - 4) * 16 + b * 4 + g) * T + t) * 64 + d) = pack8(r0, r1); }
                }
            } }
    }
};

struct Cmp1Sched {
    const char* KV6; const char* W; int G, c;
    static constexpr bool GATHER = false;
    __device__ __forceinline__ bool next(int i, pg8::Unit& u) const { const int L = i * G + c; if (L >= 64) return false; u.pm = L >> 1; u.pn = L & 1; u.ord = i; return true; }
    __device__ __forceinline__ unsigned lane_off(int r) const { return (unsigned)r * 1024u; }
    __device__ __forceinline__ unsigned unit_off(const pg8::Unit& u, int h) const { return (unsigned)u.pn * (unsigned)(16 * T * 64) + (unsigned)(u.pm * 256 + h * 128) * 1024u; }
    __device__ __forceinline__ unsigned aoff(const pg8::Unit&, int) const { return 0u; }
    __device__ __forceinline__ const char* abase() const { return KV6; }
    __device__ __forceinline__ const char* bptr(const pg8::Unit& u) const { return W + (size_t)u.pn * (256 * 2048); }
};
struct EpiCmp1 {
    static constexpr bool PERM = true, PERM16 = false; bf16_t* CH1; const float* bias1;
    __device__ __forceinline__ void operator()(const f32x4 (&acc)[2][2][4][2], const pg8::Unit& u, int wr, int wc, int fr, int fq) const {
        const int row0 = u.pm * 256 + wr * 64 + fr, cl = wc * 32 + 8 * fq;
        const f32x4 b0 = *(const f32x4*)(bias1 + u.pn * 128 + cl), b1 = *(const f32x4*)(bias1 + u.pn * 128 + cl + 4);
#pragma unroll
        EPI_ROWLOOP { f32x4 v0 = acc[ai][0][m][0] * (1.0f / (X8_SCALE * W8_SCALE)) + b0, v1 = acc[ai][0][m][1] * (1.0f / (X8_SCALE * W8_SCALE)) + b1;
#pragma unroll
            for (int i = 0; i < 4; ++i) { v0[i] = gelu_tanh(v0[i]); v1[i] = gelu_tanh(v1[i]); }
            *(u32x4*)(CH1 + ((size_t)u.pn * 8192 + row0 + ai * 128 + m * 16) * 128 + cl) = pack8(v0, v1); }
    }
};

__device__ __forceinline__ void p0_item(const float* W, int K, int N, bf16_t* WT, int kb, int n0, int drow0, LAS float* scr, int lane, bool f8 = false) {
    const int k0 = 64 * kb, n4 = (lane & 15) * 4;
    const bool cok = (n0 + n4) < N;
    f32x4 v[16];
#pragma unroll
    for (int i = 0; i < 16; ++i) { const int kk = 4 * i + (lane >> 4); v[i] = cok ? __builtin_nontemporal_load((const f32x4*)(W + (size_t)(k0 + kk) * N + n0 + n4)) : (f32x4){0.f, 0.f, 0.f, 0.f}; }
#pragma unroll
    for (int i = 0; i < 16; ++i) { const int kk = 4 * i + (lane >> 4); LAS float* d = scr + kk * 65 + n4; d[0] = v[i][0]; d[1] = v[i][1]; d[2] = v[i][2]; d[3] = v[i][3]; }
    asm volatile("s_waitcnt lgkmcnt(0)" ::: "memory");
    if (f8) {
        const int c4 = lane & 3;
#pragma unroll
        for (int j = 0; j < 4; ++j) { const int n = (lane >> 2) + 16 * j; const LAS float* sp = scr + (16 * c4) * 65 + n;
            u32x4 o;
            o.x = pk4_fp8(sp[0 * 65] * W8_SCALE, sp[1 * 65] * W8_SCALE, sp[2 * 65] * W8_SCALE, sp[3 * 65] * W8_SCALE); o.y = pk4_fp8(sp[4 * 65] * W8_SCALE, sp[5 * 65] * W8_SCALE, sp[6 * 65] * W8_SCALE, sp[7 * 65] * W8_SCALE);
            o.z = pk4_fp8(sp[8 * 65] * W8_SCALE, sp[9 * 65] * W8_SCALE, sp[10 * 65] * W8_SCALE, sp[11 * 65] * W8_SCALE); o.w = pk4_fp8(sp[12 * 65] * W8_SCALE, sp[13 * 65] * W8_SCALE, sp[14 * 65] * W8_SCALE, sp[15 * 65] * W8_SCALE);
            if (n0 + n < N) __builtin_nontemporal_store(o, (u32x4*)((unsigned char*)WT + (size_t)(drow0 + n) * K + k0 + 16 * c4)); }
        asm volatile("s_waitcnt lgkmcnt(0)" ::: "memory");
        return;
    }
    const int c = lane & 7;
#pragma unroll
    for (int j = 0; j < 8; ++j) { const int n = (lane >> 3) + 8 * j; const LAS float* sp = scr + (8 * c) * 65 + n;
        u32x4 o; o.x = pk2(sp[0 * 65], sp[1 * 65]); o.y = pk2(sp[2 * 65], sp[3 * 65]); o.z = pk2(sp[4 * 65], sp[5 * 65]); o.w = pk2(sp[6 * 65], sp[7 * 65]);
        if (n0 + n < N) __builtin_nontemporal_store(o, (u32x4*)(WT + (size_t)(drow0 + n) * K + k0 + 8 * c)); }
    asm volatile("s_waitcnt lgkmcnt(0)" ::: "memory");
}
struct CvtItem { const float* W; bf16_t* WT; int K, N, k0, n0, drow0; };
__device__ __forceinline__ void cvt32_load(const CvtItem& it, int lane, f32x4 (&v)[8]) {
    const int n4 = (lane & 7) * 4;
#pragma unroll
    for (int i = 0; i < 8; ++i) { const int kk = 8 * i + (lane >> 3); v[i] = __builtin_nontemporal_load((const f32x4*)(it.W + (size_t)(it.k0 + kk) * it.N + it.n0 + n4)); }
}
__device__ __forceinline__ void cvt32_finish(const CvtItem& it, int lane, const f32x4 (&v)[8], LAS float* scr) {
    const int n4 = (lane & 7) * 4;
#pragma unroll
    for (int i = 0; i < 8; ++i) { const int kk = 8 * i + (lane >> 3); LAS float* d = scr + kk * 33 + n4; d[0] = v[i][0]; d[1] = v[i][1]; d[2] = v[i][2]; d[3] = v[i][3]; }
    asm volatile("s_waitcnt lgkmcnt(0)" ::: "memory");
    const int c = lane & 7;
#pragma unroll
    for (int j = 0; j < 4; ++j) { const int n = (lane >> 3) + 8 * j; const LAS float* sp = scr + (8 * c) * 33 + n;
        const float v0 = sp[0 * 33], v1 = sp[1 * 33], v2 = sp[2 * 33], v3 = sp[3 * 33], v4 = sp[4 * 33], v5 = sp[5 * 33], v6 = sp[6 * 33], v7 = sp[7 * 33];
        u32x2 o; o.x = pk4_fp8(v0 * W8_SCALE, v1 * W8_SCALE, v2 * W8_SCALE, v3 * W8_SCALE); o.y = pk4_fp8(v4 * W8_SCALE, v5 * W8_SCALE, v6 * W8_SCALE, v7 * W8_SCALE);
        __builtin_nontemporal_store(o, (u32x2*)((unsigned char*)it.WT + (size_t)(it.drow0 + n) * it.K + it.k0 + 8 * c)); }
    asm volatile("s_waitcnt lgkmcnt(0)" ::: "memory");
}
constexpr int CVT1_ITEMS = 257 * 384;
__device__ __forceinline__ CvtItem cvt1_item(const Args& a, int idx) {
    const int e = idx / 384, sub = idx % 384, mat = sub >> 7, r = sub & 127;
    CvtItem it;
    if (mat < 2) { it.W = (e < 256) ? a.in[23 + mat] + ((size_t)256 + e) * (size_t)(D * FF) : a.in[26 + mat] + (size_t)(D * FF);
        it.K = D; it.N = FF; it.k0 = (r >> 3) * 64; it.n0 = (r & 7) * 32; it.drow0 = (it.n0 >> 7) * 256 + mat * 128 + (it.n0 & 127);
        it.WT = (bf16_t*)(a.ws + WS_WGU + (size_t)(257 + e) * 512 * 1024); }
    else { it.W = (e < 256) ? a.in[25] + ((size_t)256 + e) * (size_t)(FF * D) : a.in[28] + (size_t)(FF * D);
        it.K = FF; it.N = D; it.k0 = (r >> 5) * 64; it.n0 = (r & 31) * 32; it.drow0 = it.n0;
        it.WT = (bf16_t*)(a.ws + WS_WD + (size_t)(257 + e) * 1024 * 256); }
    return it;
}
__device__ __forceinline__ void cvt1_run(const Args& a, int& next, int stride, int quota, LAS float* scr, int lane) {
#pragma unroll 1
    for (int q = 0; q < quota && next < CVT1_ITEMS; ++q) {
        CvtItem t[4]; f32x4 v[4][8]; bool ok[4];
#pragma unroll
        for (int u = 0; u < 4; ++u) { const int idx = next + u * stride; ok[u] = idx < CVT1_ITEMS; t[u] = cvt1_item(a, ok[u] ? idx : 0); if (ok[u]) cvt32_load(t[u], lane, v[u]); }
        next += 4 * stride;
#pragma unroll
        for (int u = 0; u < 4; ++u) if (ok[u]) cvt32_finish(t[u], lane, v[u], scr);
    }
}
__device__ __forceinline__ void ph_prologue(const Args& a, LAS unsigned char* lds) {
    const int lane = threadIdx.x & 63, wave = threadIdx.x >> 6;
    LAS float* scr = (LAS float*)(lds + wave * 16640);
    const int gw = blockIdx.x * 8 + wave, ngw = gridDim.x * 8;
    for (int it = gw; it < 257 * 192; it += ngw) {
        const int le = it / 192, sub = it % 192, l = 0, e = le, mat = sub >> 6, r = sub & 63;
        if (mat < 2) {
            const float* W = (e < 256) ? a.in[23 + mat] + ((size_t)l * 256 + e) * (size_t)(D * FF) : a.in[26 + mat] + (size_t)l * (D * FF);
            const int kb = r >> 2, n0 = (r & 3) * 64;
            p0_item(W, D, FF, (bf16_t*)(a.ws + WS_WGU + (size_t)le * 512 * 1024), kb, n0, (n0 >> 7) * 256 + mat * 128 + (n0 & 127), scr, lane, true);
        } else {
            const float* W = (e < 256) ? a.in[25] + ((size_t)l * 256 + e) * (size_t)(FF * D) : a.in[28] + (size_t)l * (FF * D);
            const int kb = r >> 4, n0 = (r & 15) * 64;
            p0_item(W, FF, D, (bf16_t*)(a.ws + WS_WD + (size_t)le * 1024 * 256), kb, n0, n0, scr, lane, true);
        }
    }
    {
        for (int itg = gw; itg < 1680; itg += ngw) {
            if (itg < 512) { const int it = itg; const int w = it >> 8, r = it & 255;
                p0_item(a.in[w ? 16 : 8], D, D, (bf16_t*)(a.ws + (w ? WS_WOUTN : WS_WOUT0)), r >> 4, (r & 15) * 64, (r & 15) * 64, scr, lane, w != 0); }
            else if (itg < 1168) { const int it = itg - 512;
                p0_item(a.in[9], D, 2608, (bf16_t*)(a.ws + WS_WINN), it / 41, (it % 41) * 64, (it % 41) * 64, scr, lane, true); }
            else if (itg < 1296) { const int it = itg - 1168; const int l = it >> 6, r = it & 63;
                p0_item(a.in[21] + (size_t)l * D * NE, D, NE, (bf16_t*)(a.ws + WS_WR) + (size_t)l * NE * D, r >> 2, (r & 3) * 64, (r & 3) * 64, scr, lane); }
            else if (itg < 1552) { const int it = itg - 1296; const int kb = it >> 4, n0 = (8 + (it & 15)) * 64;
                const int isg = (n0 >= 1024) ? 1 : 0, rel = n0 - 512 - isg * 512;
                p0_item(a.in[1], D, 1536, (bf16_t*)(a.ws + WS_WIN0), kb, n0, 512 + (rel >> 7) * 256 + isg * 128 + (rel & 127), scr, lane); }
            else { const int it = itg - 1552; const int kv = it >> 6, r = it & 63;
                p0_item(a.in[kv ? 14 : 11], 2048, 128, (bf16_t*)(a.ws + WS_CW1 + (size_t)kv * 256 * 2048), r >> 1, (r & 1) * 64, (r & 1) * 64, scr, lane, true); }
        }
    }
    {
        const int gt = blockIdx.x * 512 + threadIdx.x, ngt = gridDim.x * 512;
        const int gtz = (gt >= ngt / 16 * 13) ? gt - ngt / 16 * 13 : gt + ngt - ngt / 16 * 13, gtr = (gt >= ngt / 2) ? gt - ngt / 2 : gt + ngt - ngt / 2;
        const int gwb = (gw >= ngw / 8 * 7) ? gw - ngw / 8 * 7 : gw + ngw - ngw / 8 * 7;
        u32x4* z0 = (u32x4*)((unsigned char*)(a.ws + WS_WINN) + (size_t)2608 * 1024);
        for (int i = gtz; i < 208 * 1024 / 16; i += ngt) z0[i] = (u32x4){0u, 0u, 0u, 0u};
        for (int kv = 0; kv < 2; ++kv) { u32x4* z1 = (u32x4*)((unsigned char*)(a.ws + WS_CW1) + ((size_t)kv * 256 + 128) * 2048);
            for (int i = gtz; i < 128 * 2048 / 16; i += ngt) z1[i] = (u32x4){0u, 0u, 0u, 0u}; }
        const float* x = a.in[0]; bf16_t* XA = (bf16_t*)(a.ws + WS_XA);
        for (size_t i = gt; i < (size_t)M * D / 8; i += ngt) { const f32x4 v0 = *(const f32x4*)(x + i * 8), v1 = *(const f32x4*)(x + i * 8 + 4);
            u32x4 o; o.x = pk2(v0[0], v0[1]); o.y = pk2(v0[2], v0[3]); o.z = pk2(v1[0], v1[1]); o.w = pk2(v1[2], v1[3]); *(u32x4*)(XA + i * 8) = o; }
        const float* win = a.in[1]; const float* mix = a.in[2]; const float* psc = a.in[3]; bf16_t* WIN0 = (bf16_t*)(a.ws + WS_WIN0);
        for (int i = gt; i < 512 * 1024; i += ngt) { const int n = i & 511, k = i >> 9, g = n >> 7, nn = n & 127;
            const float* wr_ = win + (size_t)k * 1536 + g * 128; const float* mx = mix + (size_t)g * 128 * 128 + nn;
            float s = 0.f;
            for (int c = 0; c < 128; ++c) s += wr_[c] * mx[(size_t)c * 128];
            WIN0[(size_t)n * 1024 + k] = f2bf(s * psc[n]); }
        float* misc = (float*)(a.ws + WS_MISC);
        for (int o = gwb; o < 256; o += ngw) { const int kv = o >> 7, j = o & 127; const float* pos = a.in[kv ? 13 : 10]; const float* w1 = a.in[kv ? 14 : 11];
            float s = 0.f;
#pragma unroll 8
            for (int k = lane; k < 2048; k += 64) s += pos[k] * w1[(size_t)k * 128 + j];
            s = wave_sum(s);
            if (lane == 0) misc[o] = s; }
        float* rot = misc + 1024;
        for (int i = gtr; i < T * 8; i += ngt) { const int t = i >> 3, f = i & 7;
            const float ang = (float)t * a.inv_freq[f]; const double rev = (double)ang * 0.15915494309189535; const float fr = (float)(rev - floor(rev));
            rot[t * 16 + f] = __builtin_amdgcn_cosf(fr); rot[t * 16 + 8 + f] = __builtin_amdgcn_sinf(fr); }
    }
}

typedef short v4i16_t __attribute__((ext_vector_type(4)));
constexpr int AT_KB = 0, AT_VB = 16384, AT_PS = 32768, AT_MSK = 32768 + 65536;
#define DPP_I(x, ctrl) __builtin_amdgcn_update_dpp((int)(x), (int)(x), (ctrl), 0xF, 0xF, true)
#define DPP_F(x, ctrl) __builtin_bit_cast(float, __builtin_amdgcn_update_dpp(__builtin_bit_cast(int, (float)(x)), __builtin_bit_cast(int, (float)(x)), (ctrl), 0xF, 0xF, true))
__device__ __forceinline__ bf16x8 tr_frag(LAS unsigned char* p0, LAS unsigned char* p1) {
    const v4i16_t a = __builtin_amdgcn_ds_read_tr16_b64_v4i16((LAS v4i16_t*)p0), b = __builtin_amdgcn_ds_read_tr16_b64_v4i16((LAS v4i16_t*)p1);
    return (bf16x8){a[0], a[1], a[2], a[3], b[0], b[1], b[2], b[3]};
}
constexpr size_t TN2_OFF = 786432;
__device__ __forceinline__ void ph_knorm(const Args& a) {
    const bf16_t* KV6 = (const bf16_t*)(a.ws + WS_KV6);
    float* TN2 = (float*)(a.ws + WS_MISC + TN2_OFF);
    const int lane = threadIdx.x & 63, wave = threadIdx.x >> 6;
    const int first = (gridDim.x > 64) ? 64 : 0;
    if ((int)blockIdx.x < first) return;
    const int wi = ((int)blockIdx.x - first) * 8 + wave, nw = ((int)gridDim.x - first) * 8;
    for (int id = wi; id < 4096; id += nw) {
        const int ty = id >> 11, bg = (id >> 7) & 15, tile = id & 127;
        const bf16_t* rp = KV6 + ((size_t)((ty ? 4 : 2) * 16 + bg) * T + tile * 64 + lane) * 64;
        float ssq = 0.f;
#pragma unroll
        for (int c = 0; c < 8; ++c) { const bf16x8 v = *(const bf16x8*)(rp + 8 * c);
#pragma unroll
            for (int j = 0; j < 8; ++j) { const float f = bf2f((bf16_t)v[j]); ssq += f * f; } }
        ssq = wave_max(ssq);
        if (lane == 0) TN2[id] = ssq;
    }
}
__device__ __forceinline__ void attn_qk2(LAS unsigned char* Kb, const bf16x8 (&q)[2][2], int fr, int g4, const float (&cinit)[2], f32x4 (&s)[2][4]) {
#pragma unroll
    for (int c = 0; c < 4; ++c) {
#pragma unroll
        for (int rb = 0; rb < 2; ++rb) s[rb][c] = (f32x4){cinit[rb], cinit[rb], cinit[rb], cinit[rb]};
#pragma unroll
        for (int ks = 0; ks < 2; ++ks) {
            const bf16x8 kf = *(const LAS bf16x8*)(Kb + pg8::lds_byte(16 * c + fr, 32 * ks + 8 * g4));
#pragma unroll
            for (int rb = 0; rb < 2; ++rb) s[rb][c] = __builtin_amdgcn_mfma_f32_16x16x32_bf16(kf, q[rb][ks], s[rb][c], 0, 0, 0);
        }
    }
}
__device__ __forceinline__ void attn_qk2m(LAS unsigned char* Kb, const bf16x8 (&q)[2][2], int fr, int g4, const float (&cinit)[2], f32x4 (&s)[2][4]) {
    bf16x8 kf[4][2];
#pragma unroll
    for (int c = 0; c < 4; ++c)
#pragma unroll
        for (int ks = 0; ks < 2; ++ks) kf[c][ks] = *(const LAS bf16x8*)(Kb + pg8::lds_byte(16 * c + fr, 32 * ks + 8 * g4));
    __builtin_amdgcn_sched_barrier(0);
    f32x4 ci[2];
#pragma unroll
    for (int rb = 0; rb < 2; ++rb) ci[rb] = (f32x4){cinit[rb], cinit[rb], cinit[rb], cinit[rb]};
#pragma unroll
    for (int c = 0; c < 4; ++c) {
#pragma unroll
        for (int ks = 0; ks < 2; ++ks) {
#pragma unroll
            for (int rb = 0; rb < 2; ++rb) s[rb][c] = __builtin_amdgcn_mfma_f32_16x16x32_bf16(kf[c][ks], q[rb][ks], ks == 0 ? ci[rb] : s[rb][c], 0, 0, 0);
        }
    }
}
__device__ __forceinline__ void attn_qk2z(LAS unsigned char* Kb, const bf16x8 (&q)[2][2], int fr, int g4, f32x4 (&s)[2][4]) {
    bf16x8 kf[4][2];
#pragma unroll
    for (int c = 0; c < 4; ++c)
#pragma unroll
        for (int ks = 0; ks < 2; ++ks) kf[c][ks] = *(const LAS bf16x8*)(Kb + pg8::lds_byte(16 * c + fr, 32 * ks + 8 * g4));
    __builtin_amdgcn_sched_barrier(0);
#pragma unroll
    for (int c = 0; c < 4; ++c) {
#pragma unroll
        for (int ks = 0; ks < 2; ++ks) {
#pragma unroll
            for (int rb = 0; rb < 2; ++rb) s[rb][c] = __builtin_amdgcn_mfma_f32_16x16x32_bf16(kf[c][ks], q[rb][ks], ks == 0 ? (f32x4){0.f, 0.f, 0.f, 0.f} : s[rb][c], 0, 0, 0);
        }
    }
}
struct AttnRow { float m; f32x4 o[4]; f32x4 ol; };
__device__ __forceinline__ float max3f(float a, float b, float c) { float r; asm("v_max3_f32 %0, %1, %2, %3" : "=v"(r) : "v"(a), "v"(b), "v"(c)); return r; }
__device__ __forceinline__ bool attn_sm2(f32x4 (&s)[4], AttnRow& st, int kbase, int g4, int lo, int hi, bool en, bool emask) {
    const float NEG = -INFINITY;
    if (emask) {
#pragma unroll
        for (int c = 0; c < 4; ++c)
#pragma unroll
            for (int i = 0; i < 4; ++i) { const int key = kbase + 16 * c + 4 * g4 + i; if (key < lo || key > hi) s[c][i] = NEG; }
    }
    float mx = max3f(s[0][0], s[0][1], s[0][2]); mx = max3f(mx, s[0][3], s[1][0]); mx = max3f(mx, s[1][1], s[1][2]); mx = max3f(mx, s[1][3], s[2][0]);
    mx = max3f(mx, s[2][1], s[2][2]); mx = max3f(mx, s[2][3], s[3][0]); mx = max3f(mx, s[3][1], s[3][2]); mx = max3f(mx, s[3][3], mx);
    if (!en) mx = NEG;
    mx = max3f(mx, __shfl_xor(mx, 16), mx); mx = max3f(mx, __shfl_xor(mx, 32), mx);
    const float delta = (mx > 20.0f) ? mx : 0.f;
    const bool moved = __builtin_amdgcn_ballot_w64(delta != 0.f) != 0ull;
    if (moved) {
        const float alpha = __builtin_amdgcn_exp2f(-delta);
#pragma unroll
        for (int c = 0; c < 4; ++c) s[c] = s[c] - delta;
#pragma unroll
        for (int dt = 0; dt < 4; ++dt) st.o[dt] *= alpha;
        st.ol *= alpha;
        st.m += delta;
    }
#pragma unroll
    for (int c = 0; c < 4; ++c)
#pragma unroll
        for (int i = 0; i < 4; ++i) s[c][i] = __builtin_amdgcn_exp2f(s[c][i]);
    return moved;
}
__device__ __forceinline__ bool attn_sm2x(f32x4 (&s)[2][4], AttnRow (&st)[2], int kbase, int g4, const int (&lo)[2], const int (&hi)[2], const bool (&en)[2], bool emask) {
    const float NEG = -INFINITY;
    if (emask) {
#pragma unroll
        for (int rb = 0; rb < 2; ++rb)
#pragma unroll
            for (int c = 0; c < 4; ++c)
#pragma unroll
                for (int i = 0; i < 4; ++i) { const int key = kbase + 16 * c + 4 * g4 + i; if (key < lo[rb] || key > hi[rb]) s[rb][c][i] = NEG; }
    }
    float mx[2];
#pragma unroll
    for (int rb = 0; rb < 2; ++rb) {
        float m = max3f(s[rb][0][0], s[rb][0][1], s[rb][0][2]); m = max3f(m, s[rb][0][3], s[rb][1][0]); m = max3f(m, s[rb][1][1], s[rb][1][2]); m = max3f(m, s[rb][1][3], s[rb][2][0]);
        m = max3f(m, s[rb][2][1], s[rb][2][2]); m = max3f(m, s[rb][2][3], s[rb][3][0]); m = max3f(m, s[rb][3][1], s[rb][3][2]); m = max3f(m, s[rb][3][3], m);
        mx[rb] = en[rb] ? m : NEG;
    }
    { const float t0 = __shfl_xor(mx[0], 16), t1 = __shfl_xor(mx[1], 16); mx[0] = max3f(mx[0], t0, t0); mx[1] = max3f(mx[1], t1, t1); }
    { const float t0 = __shfl_xor(mx[0], 32), t1 = __shfl_xor(mx[1], 32); mx[0] = max3f(mx[0], t0, t0); mx[1] = max3f(mx[1], t1, t1); }
    const float d0 = (mx[0] > 20.0f) ? mx[0] : 0.f, d1 = (mx[1] > 20.0f) ? mx[1] : 0.f;
    const bool moved = __builtin_amdgcn_ballot_w64((d0 != 0.f) || (d1 != 0.f)) != 0ull;
    if (moved) {
        const float dl[2] = {d0, d1};
#pragma unroll
        for (int rb = 0; rb < 2; ++rb) {
            const float alpha = __builtin_amdgcn_exp2f(-dl[rb]);
#pragma unroll
            for (int c = 0; c < 4; ++c) s[rb][c] = s[rb][c] - dl[rb];
#pragma unroll
            for (int dt = 0; dt < 4; ++dt) st[rb].o[dt] *= alpha;
            st[rb].ol *= alpha; st[rb].m += dl[rb];
        }
    }
#pragma unroll
    for (int rb = 0; rb < 2; ++rb)
#pragma unroll
        for (int c = 0; c < 4; ++c)
#pragma unroll
            for (int i = 0; i < 4; ++i) s[rb][c][i] = __builtin_amdgcn_exp2f(s[rb][c][i]);
    return moved;
}
__device__ __forceinline__ void attn_pv2x(LAS unsigned char* Vb, const f32x4 (&p)[2][4], int vlane, int swz, const unsigned (&enm)[2], const bool (&act)[2], const bf16x8 onesf, AttnRow (&st)[2]) {
#pragma unroll
    for (int ks = 0; ks < 2; ++ks) {
        bf16x8 pb[2];
#pragma unroll
        for (int rb = 0; rb < 2; ++rb) { u32x4 pw = pack8m(p[rb][2 * ks], p[rb][2 * ks + 1]); pw.x &= enm[rb]; pw.y &= enm[rb]; pw.z &= enm[rb]; pw.w &= enm[rb]; pb[rb] = __builtin_bit_cast(bf16x8, pw); }
#pragma unroll
        for (int dt = 0; dt < 4; ++dt) {
            LAS unsigned char* a0 = Vb + vlane + (2 * ks) * 2048 + ((dt ^ swz) * 32);
            const bf16x8 vf = tr_frag(a0, a0 + 2048);
#pragma unroll
            for (int rb = 0; rb < 2; ++rb) if (act[rb]) st[rb].o[dt] = __builtin_amdgcn_mfma_f32_16x16x32_bf16(vf, pb[rb], st[rb].o[dt], 0, 0, 0);
        }
#pragma unroll
        for (int rb = 0; rb < 2; ++rb) if (act[rb]) st[rb].ol = __builtin_amdgcn_mfma_f32_16x16x32_bf16(onesf, pb[rb], st[rb].ol, 0, 0, 0);
    }
}
__device__ __forceinline__ bool attn_max2x(f32x4 (&s)[2][4], int kbase, int g4, const int (&lo)[2], const int (&hi)[2], const bool (&en)[2], bool emask, float (&d)[2]) {
    const float NEG = -INFINITY;
    MFMA_SETTLE(s);
    if (emask) {
#pragma unroll
        for (int rb = 0; rb < 2; ++rb)
#pragma unroll
            for (int c = 0; c < 4; ++c)
#pragma unroll
                for (int i = 0; i < 4; ++i) { const int key = kbase + 16 * c + 4 * g4 + i; if (key < lo[rb] || key > hi[rb]) s[rb][c][i] = NEG; }
    }
    float mx[2];
#pragma unroll
    for (int rb = 0; rb < 2; ++rb) {
        float m = max3f(s[rb][0][0], s[rb][0][1], s[rb][0][2]); m = max3f(m, s[rb][0][3], s[rb][1][0]); m = max3f(m, s[rb][1][1], s[rb][1][2]); m = max3f(m, s[rb][1][3], s[rb][2][0]);
        m = max3f(m, s[rb][2][1], s[rb][2][2]); m = max3f(m, s[rb][2][3], s[rb][3][0]); m = max3f(m, s[rb][3][1], s[rb][3][2]); m = max3f(m, s[rb][3][3], m);
        mx[rb] = en[rb] ? m : NEG;
    }
    { const float t0 = __shfl_xor(mx[0], 16), t1 = __shfl_xor(mx[1], 16); mx[0] = max3f(mx[0], t0, t0); mx[1] = max3f(mx[1], t1, t1); }
    { const float t0 = __shfl_xor(mx[0], 32), t1 = __shfl_xor(mx[1], 32); mx[0] = max3f(mx[0], t0, t0); mx[1] = max3f(mx[1], t1, t1); }
    d[0] = (mx[0] > 20.0f) ? mx[0] : 0.f; d[1] = (mx[1] > 20.0f) ? mx[1] : 0.f;
    return __builtin_amdgcn_ballot_w64((d[0] != 0.f) || (d[1] != 0.f)) != 0ull;
}
__device__ __forceinline__ void attn_rescale2x(f32x4 (&s)[2][4], AttnRow (&st)[2], const float (&d)[2]) {
#pragma unroll
    for (int rb = 0; rb < 2; ++rb) {
        const float alpha = __builtin_amdgcn_exp2f(-d[rb]);
#pragma unroll
        for (int c = 0; c < 4; ++c) s[rb][c] = s[rb][c] - d[rb];
#pragma unroll
        for (int dt = 0; dt < 4; ++dt) st[rb].o[dt] *= alpha;
        st[rb].ol *= alpha; st[rb].m += d[rb];
    }
}
__device__ __forceinline__ void attn_exp1(f32x4 (&s)[4], unsigned enm, bf16x8 (&pb)[2]) {
#pragma unroll
    for (int c = 0; c < 4; ++c)
#pragma unroll
        for (int i = 0; i < 4; ++i) s[c][i] = __builtin_amdgcn_exp2f(s[c][i]);
#pragma unroll
    for (int ks = 0; ks < 2; ++ks) { u32x4 pw = pack8m(s[2 * ks], s[2 * ks + 1]); pw.x &= enm; pw.y &= enm; pw.z &= enm; pw.w &= enm; pb[ks] = __builtin_bit_cast(bf16x8, pw); }
}
__device__ __forceinline__ void attn_pv1(LAS unsigned char* Vb, const bf16x8 (&pb)[2], int vlane, int swz, const bf16x8 onesf, AttnRow& st) {
#pragma unroll
    for (int ks = 0; ks < 2; ++ks) {
#pragma unroll
        for (int dt = 0; dt < 4; ++dt) {
            LAS unsigned char* a0 = Vb + vlane + (2 * ks) * 2048 + ((dt ^ swz) * 32);
            const bf16x8 vf = tr_frag(a0, a0 + 2048);
            st.o[dt] = __builtin_amdgcn_mfma_f32_16x16x32_bf16(vf, pb[ks], st.o[dt], 0, 0, 0);
        }
        st.ol = __builtin_amdgcn_mfma_f32_16x16x32_bf16(onesf, pb[ks], st.ol, 0, 0, 0);
    }
}
__device__ __forceinline__ bool attn_step2x(LAS unsigned char* Vb, f32x4 (&s)[2][4], AttnRow (&st)[2], int kbase, int g4, const int (&lo)[2], const int (&hi)[2], const bool (&en)[2], const unsigned (&enm)[2], bool emask,
                                            int vlane, int swz, const bf16x8 onesf) {
    float d[2];
    const bool moved = attn_max2x(s, kbase, g4, lo, hi, en, emask, d);
    if (moved) attn_rescale2x(s, st, d);
    bf16x8 p0[2], p1[2];
    attn_exp1(s[0], enm[0], p0);
    attn_pv1(Vb, p0, vlane, swz, onesf, st[0]);
    attn_exp1(s[1], enm[1], p1);
    attn_pv1(Vb, p1, vlane, swz, onesf, st[1]);
    return moved;
}
__device__ __forceinline__ void attn_step2x_nomax(LAS unsigned char* Vb, f32x4 (&s)[2][4], AttnRow (&st)[2], int kbase, int g4, const int (&lo)[2], const int (&hi)[2], const unsigned (&enm)[2], bool emask,
                                                  int vlane, int swz, const bf16x8 onesf) {
    if (emask) {
#pragma unroll
        for (int rb = 0; rb < 2; ++rb)
#pragma unroll
            for (int c = 0; c < 4; ++c)
#pragma unroll
                for (int i = 0; i < 4; ++i) { const int key = kbase + 16 * c + 4 * g4 + i; if (key < lo[rb] || key > hi[rb]) s[rb][c][i] = -INFINITY; }
    }
    bf16x8 p0[2], p1[2];
    attn_exp1(s[0], enm[0], p0);
    attn_pv1(Vb, p0, vlane, swz, onesf, st[0]);
    attn_exp1(s[1], enm[1], p1);
    attn_pv1(Vb, p1, vlane, swz, onesf, st[1]);
}
typedef _Float16 f16x4 __attribute__((ext_vector_type(4)));
constexpr int AT4_KB = 0, AT4_VB = 32768, AT2_PS = 65536, AT2_MSK = 65536 + 65536;
__device__ __forceinline__ int attn_pair_of(int pr) { const int p = pr & 63, k = pr >> 8; const int q = (k & 2) ? ((p + 32) & 63) : p; return (k & 1) ? 63 - q : q; }
__device__ __forceinline__ void ph_attn_fast2(const Args& a, LAS unsigned char* lds) {
    const bf16_t* QN = (const bf16_t*)(a.ws + WS_HN);
    const bf16_t* QR = (const bf16_t*)(a.ws + WS_QR);
    const bf16_t* KV6 = (const bf16_t*)(a.ws + WS_KV6);
    const float* GATES = (const float*)(a.ws + WS_GATES);
    const bf16_t* KC = (const bf16_t*)(a.ws + WS_KC);
    const bf16_t* VC = KC + (size_t)8192 * 64;
    bf16_t* O = (bf16_t*)(a.ws + WS_O);
    const int tid = threadIdx.x, lane = tid & 63, wave = __builtin_amdgcn_readfirstlane(tid >> 6);
    const int fr = lane & 15, g4 = lane >> 4;
    int ksrc, vsrc;
    { int R, C; pg8::stage_rc(wave * 1024 + lane * 16, R, C); ksrc = R * 64 + C;
      const int key = 8 * wave + (lane >> 3), pos = lane & 7, chunk = (pos >> 1) ^ ((key >> 1) & 3); vsrc = key * 64 + (chunk * 2 + (pos & 1)) * 8; }
    const int vlane = (4 * g4 + (fr >> 2)) * 128 + (fr & 3) * 8, swz = (2 * g4 + (fr >> 3)) & 3;
    LAS _Float16* ps = (LAS _Float16*)(lds + AT2_PS + wave * 8192);
    LAS unsigned* mskl = (LAS unsigned*)(lds + AT2_MSK + wave * 128);
    const float NEG = -INFINITY;
    const bf16x8 onesf = (fr == 0) ? (bf16x8){0x3F80, 0x3F80, 0x3F80, 0x3F80, 0x3F80, 0x3F80, 0x3F80, 0x3F80} : (bf16x8){0, 0, 0, 0, 0, 0, 0, 0};
    const int vcu = (gridDim.x % 8 == 0) ? (int)((blockIdx.x % 8) * (gridDim.x / 8) + blockIdx.x / 8) : (int)blockIdx.x;
    int cvt_next = (int)blockIdx.x * 8 + wave; const int cvt_stride = (int)gridDim.x * 8;
    LAS float* cvt_scr = (LAS float*)(lds + AT2_PS + wave * 8448);
    int seam = 0;
    bool cmp_pref = false;
    for (int pr = vcu; pr < 1024; pr += gridDim.x) {
#pragma unroll 1
        for (int half = 0; half < 2; ++half) {
            const int bg = pr >> 6, pp = attn_pair_of(pr), cc = half ? (127 - pp) : pp;
            const int b = bg >> 2, g = bg & 3, t0 = cc * 64, cur = cc;
            const int head = g * 4 + (fr & 3);
            int trow[2];
            bf16x8 qn[2][2];
#pragma unroll
            for (int rb = 0; rb < 2; ++rb) {
                trow[rb] = t0 + 8 * wave + 4 * rb + (fr >> 2);
#pragma unroll
                for (int ks = 0; ks < 2; ++ks) qn[rb][ks] = *(const bf16x8*)(QN + ((size_t)b * T + trow[rb]) * 1024 + head * 64 + 32 * ks + 8 * g4);
            }
#define TROW_PIN() asm volatile("" : "+v"(trow[0]), "+v"(trow[1]))
#define TOKROW(rb) ((size_t)b * T + trow[rb])
#define GATE(rb, br) (GATES[TOKROW(rb) * 48 + head * 3 + (br)])
            const bf16_t* kcb = KC + (size_t)bg * 512 * 64;
            const bf16_t* kvb = KV6 + (size_t)bg * T * 64;
#define ATK(sl) (((sl) < 4 ? AT4_KB : AT2_PS - 4 * 8192) + (sl) * 8192)
#define ATV(sl) (((sl) < 4 ? AT4_VB : AT2_PS + 32768 - 4 * 8192) + (sl) * 8192)
#define AT_DMA(BR, tile, slot) do { const bf16_t* kp_; const bf16_t* vp_; \
                if ((BR) == 0) { kp_ = kcb + (size_t)(tile) * 4096; vp_ = kp_ + (size_t)8192 * 64; } \
                else { kp_ = kvb + (size_t)((BR) == 1 ? 2 : 4) * 16 * T * 64 + (size_t)(tile) * 4096; vp_ = kp_ + (size_t)16 * T * 64; } \
                __builtin_amdgcn_global_load_lds((const unsigned*)(kp_ + ksrc), (LAS unsigned*)(lds + ATK(slot) + wave * 1024), 16, 0, 0); \
                __builtin_amdgcn_global_load_lds((const unsigned*)(vp_ + vsrc), (LAS unsigned*)(lds + ATV(slot) + wave * 1024), 16, 0, 0); } while (0)
            int ncv[2];
#pragma unroll
            for (int rb = 0; rb < 2; ++rb) ncv[rb] = (trow[rb] >= 31) ? ((trow[rb] - 31) / 16 + 1) : 0;
            const int nct = (((t0 + 63 - 31) / 16 + 1) + 63) >> 6;
            float mc[2], invc[2];
            const int t_lo = t0 + 8 * wave, ncv_lo = (t_lo >= 31) ? ((t_lo - 31) / 16 + 1) : 0;
            {
                float m1[2] = {NEG, NEG}, l1[2] = {0.f, 0.f};
                const float zero2[2] = {0.f, 0.f};
#define CMP1_TILE(J, SLOT, MASKED) do { const int j = (J); const int SLOT_ = (SLOT); \
                    f32x4 s[2][4]; attn_qk2(lds + AT4_KB + SLOT_ * 8192, qn, fr, g4, zero2, s); \
                    _Pragma("unroll") \
                    for (int rb = 0; rb < 2; ++rb) { \
                        float mx = NEG; \
                    _Pragma("unroll") \
                        for (int c = 0; c < 4; ++c) \
                    _Pragma("unroll") \
                            for (int i = 0; i < 4; ++i) { const int n = 64 * j + 16 * c + 4 * g4 + i; if ((MASKED) && n >= ncv[rb]) s[rb][c][i] = NEG; mx = fmaxf(mx, s[rb][c][i]); } \
                        mx = fmaxf(mx, __shfl_xor(mx, 16)); mx = fmaxf(mx, __shfl_xor(mx, 32)); \
                        const float mn = fmaxf(m1[rb], mx), msafe = (mn == NEG) ? 0.f : mn; \
                        const float alpha = (m1[rb] == NEG) ? 0.f : __builtin_amdgcn_exp2f(m1[rb] - msafe); \
                        float sum = 0.f; \
                    _Pragma("unroll") \
                        for (int c = 0; c < 4; ++c) \
                    _Pragma("unroll") \
                            for (int i = 0; i < 4; ++i) sum += __builtin_amdgcn_exp2f(s[rb][c][i] - msafe); \
                        l1[rb] = l1[rb] * alpha + sum; m1[rb] = mn; \
                    } \
                } while (0)
                if (!cmp_pref) { AT_DMA(0, 0, 0); if (nct > 1) AT_DMA(0, 1, 1); } __syncthreads();
                for (int j0 = 0; j0 < nct; j0 += 2) { const int sb = (j0 & 2);
                    if (j0 + 2 < nct) AT_DMA(0, j0 + 2, sb ^ 2);
                    if (j0 + 3 < nct) AT_DMA(0, j0 + 3, (sb ^ 2) + 1);
                    CMP1_TILE(j0, sb, true); if (j0 + 1 < nct) CMP1_TILE(j0 + 1, sb + 1, true);
                    __syncthreads();
                }
#undef CMP1_TILE
#pragma unroll
                for (int rb = 0; rb < 2; ++rb) { float lc = l1[rb]; lc += __shfl_xor(lc, 16); lc += __shfl_xor(lc, 32); invc[rb] = (lc > 0.f) ? -(((m1[rb] == NEG) ? 0.f : m1[rb]) + __builtin_amdgcn_logf(lc)) : 0.f; mc[rb] = (m1[rb] == NEG) ? 0.f : m1[rb]; }
            }
            {
                AttnRow oc[2];
#pragma unroll
                for (int rb = 0; rb < 2; ++rb) { oc[rb].m = 0.f; oc[rb].ol = (f32x4){0.f, 0.f, 0.f, 0.f};
#pragma unroll
                    for (int dt = 0; dt < 4; ++dt) oc[rb].o[dt] = (f32x4){0.f, 0.f, 0.f, 0.f}; }
                const float cin[2] = {invc[0], invc[1]};
                const unsigned full[2] = {0xffffffffu, 0xffffffffu}; const bool both[2] = {true, true};
#define CMP2_TILE(J, SLOT, MASKED) do { const int j = (J); const int SLOT_ = (SLOT); \
                    f32x4 s[2][4]; attn_qk2(lds + AT4_KB + SLOT_ * 8192, qn, fr, g4, cin, s); \
                    _Pragma("unroll") \
                    for (int rb = 0; rb < 2; ++rb) \
                    _Pragma("unroll") \
                        for (int c = 0; c < 4; ++c) { \
                            f16x4 hs; \
                    _Pragma("unroll") \
                            for (int i = 0; i < 4; ++i) { const int n = 64 * j + 16 * c + 4 * g4 + i; const float p = (!(MASKED) || n < ncv[rb]) ? __builtin_amdgcn_exp2f(s[rb][c][i]) : 0.f; s[rb][c][i] = p; \
                                float h = p; h += DPP_F(h, 0xB1); h += DPP_F(h, 0x4E); hs[i] = (_Float16)h; }        \
                            if ((fr & 3) == 0) *(LAS f16x4*)(ps + (4 * rb + (fr >> 2)) * 512 + 64 * j + 16 * c + 4 * g4) = hs; \
                        } \
                    attn_pv2x(lds + AT4_VB + SLOT_ * 8192, s, vlane, swz, full, both, onesf, oc); \
                } while (0)
                const bool reload = nct > 4;
                if (reload) { AT_DMA(0, 0, 0); AT_DMA(0, 1, 1); __syncthreads(); }
                for (int j0 = 0; j0 < nct; j0 += 2) { const int sb = (j0 & 2);
                    if (reload && j0 + 2 < nct) AT_DMA(0, j0 + 2, sb ^ 2);
                    if (reload && j0 + 3 < nct) AT_DMA(0, j0 + 3, (sb ^ 2) + 1);
                    CMP2_TILE(j0, sb, true); if (j0 + 1 < nct) CMP2_TILE(j0 + 1, sb + 1, true);
                    __syncthreads();
                }
#undef CMP2_TILE
                TROW_PIN();
#pragma unroll
                for (int rb = 0; rb < 2; ++rb) { bf16_t* op = O + TOKROW(rb) * 1024 + head * 64 + 4 * g4; const float g0 = GATE(rb, 0);
#pragma unroll
                    for (int dt = 0; dt < 4; ++dt) { const f32x4 v = oc[rb].o[dt] * g0; u32x2 w; w.x = cvt_pk_bf16(v[0], v[1]); w.y = cvt_pk_bf16(v[2], v[3]); *(u32x2*)(op + 16 * dt) = w; } }
            }
            {
                WSYNC();
                const int tl = lane >> 4, li = lane & 15;
                const int nsel = (cur + 1 < 16) ? (cur + 1) : 16;
#pragma unroll 1
                for (int rnd = 0; rnd < 2; ++rnd) {
                    const LAS _Float16* pst = ps + (4 * rnd + tl) * 512;
                    float v[8];
#pragma unroll
                    for (int k = 0; k < 8; ++k) { const int j = li + 16 * k;
                        float x;
                        if (j > cur) x = NEG;
                        else if (j == 0 || j == cur || j == cur - 1) x = NEG;
                        else { const int n0 = 4 * j; x = (float)pst[n0 - 1] + 2.0f * ((float)pst[n0] + (float)pst[n0 + 1] + (float)pst[n0 + 2]) + (float)pst[n0 + 3]; }
                        v[k] = x; }
                    int vi[8];
#pragma unroll
                    for (int k = 0; k < 8; ++k) vi[k] = __builtin_bit_cast(int, v[k]);
                    unsigned mm[4] = {1u, 0u, 0u, 0u};
                    {
                        const unsigned bc = 1u << (cur & 31); const int wc_ = cur >> 5;
                        mm[0] |= (wc_ == 0) ? bc : 0u; mm[1] |= (wc_ == 1) ? bc : 0u; mm[2] |= (wc_ == 2) ? bc : 0u; mm[3] |= (wc_ == 3) ? bc : 0u;
                        if (cur >= 1) { const unsigned bp = 1u << ((cur - 1) & 31); const int wp_ = (cur - 1) >> 5;
                            mm[0] |= (wp_ == 0) ? bp : 0u; mm[1] |= (wp_ == 1) ? bp : 0u; mm[2] |= (wp_ == 2) ? bp : 0u; mm[3] |= (wp_ == 3) ? bp : 0u; }
                    }
                    const int nforced = (cur >= 2) ? 3 : (cur + 1);
                    for (int it = 0; it < nsel - nforced; ++it) {
                        int bv = max(max(max(vi[0], vi[1]), max(vi[2], vi[3])), max(max(vi[4], vi[5]), max(vi[6], vi[7])));
                        bv = max(bv, DPP_I(bv, 0xB1)); bv = max(bv, DPP_I(bv, 0x4E)); bv = max(bv, DPP_I(bv, 0x141)); bv = max(bv, DPP_I(bv, 0x140));
                        int bi = 255;
#pragma unroll
                        for (int k = 7; k >= 0; --k) bi = (vi[k] == bv) ? (li + 16 * k) : bi;
                        bi = min(bi, DPP_I(bi, 0xB1)); bi = min(bi, DPP_I(bi, 0x4E)); bi = min(bi, DPP_I(bi, 0x141)); bi = min(bi, DPP_I(bi, 0x140));
                        const unsigned bit = 1u << (bi & 31); const int wsel = bi >> 5;
                        mm[0] |= (wsel == 0) ? bit : 0u; mm[1] |= (wsel == 1) ? bit : 0u; mm[2] |= (wsel == 2) ? bit : 0u; mm[3] |= (wsel == 3) ? bit : 0u;
                        if ((bi & 15) == li) {
#pragma unroll
                            for (int k = 0; k < 8; ++k) if ((bi >> 4) == k) vi[k] = (int)0xFF800000;
                        }
                    }
                    if (li == 0) { mskl[(4 * rnd + tl) * 4 + 0] = mm[0]; mskl[(4 * rnd + tl) * 4 + 1] = mm[1]; mskl[(4 * rnd + tl) * 4 + 2] = mm[2]; mskl[(4 * rnd + tl) * 4 + 3] = mm[3]; }
                }
                WSYNC();
            }
            bf16x8 qr[2][2];
            TROW_PIN();
#pragma unroll
            for (int rb = 0; rb < 2; ++rb)
#pragma unroll
                for (int ks = 0; ks < 2; ++ks) qr[rb][ks] = *(const bf16x8*)(QR + TOKROW(rb) * 1024 + head * 64 + 32 * ks + 8 * g4);
            bool nomax_slc, nomax_win;
            {
                float qq = 0.f;
#pragma unroll
                for (int rb = 0; rb < 2; ++rb) { float q2 = 0.f;
#pragma unroll
                    for (int ks = 0; ks < 2; ++ks)
#pragma unroll
                        for (int j = 0; j < 8; ++j) { const float x = bf2f((bf16_t)qr[rb][ks][j]); q2 += x * x; }
                    q2 += __shfl_xor(q2, 16); q2 += __shfl_xor(q2, 32); qq = fmaxf(qq, q2); }
                qq = wave_max(qq);
                const float* tn = (const float*)(a.ws + WS_MISC + TN2_OFF) + bg * 128;
                const int jt0w = (t0 >= 511) ? ((t0 - 511) >> 6) : 0;
                float ts = 0.f, tw = 0.f;
#pragma unroll
                for (int h2 = 0; h2 < 2; ++h2) { const int tl_ = lane + 64 * h2; if (tl_ <= cur) { ts = fmaxf(ts, tn[tl_]); if (tl_ >= jt0w) tw = fmaxf(tw, tn[2048 + tl_]); } }
                ts = wave_max(ts); tw = wave_max(tw);
                nomax_slc = __builtin_amdgcn_readfirstlane((qq * ts <= 3500.0f) ? 1 : 0) != 0;
                nomax_win = __builtin_amdgcn_readfirstlane((qq * tw <= 3500.0f) ? 1 : 0) != 0;
            }
            {
                AttnRow ss[2];
#pragma unroll
                for (int rb = 0; rb < 2; ++rb) { ss[rb].m = 0.f; ss[rb].ol = (f32x4){0.f, 0.f, 0.f, 0.f};
#pragma unroll
                    for (int dt = 0; dt < 4; ++dt) ss[rb].o[dt] = (f32x4){0.f, 0.f, 0.f, 0.f}; }
                const int nt_ = cur + 1;
                bool refmoved = false;
#define SLC_PRE(J) const int j_ = (J); bool en[2], act[2]; unsigned enm[2]; \
                    _Pragma("unroll") for (int rb = 0; rb < 2; ++rb) { const unsigned mw = mwg[rb]; \
                        en[rb] = (mw >> (j_ & 31)) & 1u; act[rb] = __any(en[rb]); enm[rb] = en[rb] ? 0xffffffffu : 0u; } const int lo2[2] = {0, 0};
#define SLC_TILE(J, SLOT) do { SLC_PRE(J) \
                    if (act[0] || act[1]) { f32x4 s[2][4]; \
                        if (refmoved) { const float cin[2] = {-ss[0].m, -ss[1].m}; attn_qk2(lds + ATK(SLOT), qr, fr, g4, cin, s); } \
                        else attn_qk2z(lds + ATK(SLOT), qr, fr, g4, s); \
                        refmoved |= attn_step2x(lds + ATV(SLOT), s, ss, 64 * j_, g4, lo2, trow, en, enm, j_ == cur, vlane, swz, onesf); } } while (0)
#define SLC_TILE_NM(J, SLOT) do { SLC_PRE(J) \
                    if (act[0] || act[1]) { f32x4 s[2][4]; const float cm_[2] = {en[0] ? 0.f : -1e30f, en[1] ? 0.f : -1e30f}; attn_qk2m(lds + ATK(SLOT), qr, fr, g4, cm_, s); \
                        const unsigned fullm_[2] = {0xffffffffu, 0xffffffffu}; \
                        attn_step2x_nomax(lds + ATV(SLOT), s, ss, 64 * j_, g4, lo2, trow, fullm_, j_ == cur, vlane, swz, onesf); } } while (0)
#pragma unroll
                for (int i = 0; i < 4; ++i) if (i < nt_) AT_DMA(1, i, i);
                __syncthreads();
#define SLC_LOOP(TILE) for (int j0 = 0; j0 < nt_; j0 += 4) { const int sb = (j0 & 4); \
                    const unsigned mwg[2] = {mskl[(fr >> 2) * 4 + (j0 >> 5)], mskl[(4 + (fr >> 2)) * 4 + (j0 >> 5)]};       \
                    _Pragma("unroll") for (int i = 0; i < 4; ++i) if (j0 + 4 + i < nt_) AT_DMA(1, j0 + 4 + i, (sb ^ 4) + i); \
                    TILE(j0, sb); if (j0 + 1 < nt_) TILE(j0 + 1, sb + 1); if (j0 + 2 < nt_) TILE(j0 + 2, sb + 2); if (j0 + 3 < nt_) TILE(j0 + 3, sb + 3); \
                    __syncthreads(); }
                if (nomax_slc) { SLC_LOOP(SLC_TILE_NM) } else { SLC_LOOP(SLC_TILE) }
#undef SLC_LOOP
#undef SLC_TILE_NM
#undef SLC_PRE
#undef SLC_TILE
                TROW_PIN();
#pragma unroll
                for (int rb = 0; rb < 2; ++rb) { const float l = __shfl(ss[rb].ol[0], fr); const float sc1 = (l > 0.f) ? GATE(rb, 1) / l : 0.f;
                    bf16_t* op = O + TOKROW(rb) * 1024 + head * 64 + 4 * g4;
#pragma unroll
                    for (int dt = 0; dt < 4; ++dt) { const u32x2 pv = *(const u32x2*)(op + 16 * dt); f32x4 v = ss[rb].o[dt] * sc1;
                        v[0] += __uint_as_float(pv.x << 16); v[1] += __uint_as_float(pv.x & 0xffff0000u); v[2] += __uint_as_float(pv.y << 16); v[3] += __uint_as_float(pv.y & 0xffff0000u);
                        u32x2 w; w.x = cvt_pk_bf16(v[0], v[1]); w.y = cvt_pk_bf16(v[2], v[3]); *(u32x2*)(op + 16 * dt) = w; } }
            }
            {
                AttnRow sw[2];
#pragma unroll
                for (int rb = 0; rb < 2; ++rb) { sw[rb].m = 0.f; sw[rb].ol = (f32x4){0.f, 0.f, 0.f, 0.f};
#pragma unroll
                    for (int dt = 0; dt < 4; ++dt) sw[rb].o[dt] = (f32x4){0.f, 0.f, 0.f, 0.f}; }
                const int jt0 = (t0 >= 511) ? ((t0 - 511) >> 6) : 0;
                const int nt_ = cur - jt0 + 1;
                const unsigned full[2] = {0xffffffffu, 0xffffffffu}; const bool both[2] = {true, true};
                bool refmoved = false;
#define WIN_PRE(JJ) const int j = jt0 + (JJ); f32x4 s[2][4]; const bool edge = (j == cur) || (64 * j < t0 + 63 - 511); const int lo2[2] = {trow[0] - 511, trow[1] - 511};
#define WIN_TILE(JJ, SLOT) do { WIN_PRE(JJ) \
                    if (refmoved) { const float cin[2] = {-sw[0].m, -sw[1].m}; attn_qk2(lds + AT4_KB + (SLOT) * 8192, qr, fr, g4, cin, s); } \
                    else attn_qk2z(lds + AT4_KB + (SLOT) * 8192, qr, fr, g4, s); \
                    refmoved |= attn_step2x(lds + AT4_VB + (SLOT) * 8192, s, sw, 64 * j, g4, lo2, trow, both, full, edge, vlane, swz, onesf); } while (0)
#define WIN_TILE_NM(JJ, SLOT) do { WIN_PRE(JJ) attn_qk2z(lds + AT4_KB + (SLOT) * 8192, qr, fr, g4, s); \
                    attn_step2x_nomax(lds + AT4_VB + (SLOT) * 8192, s, sw, 64 * j, g4, lo2, trow, full, edge, vlane, swz, onesf); } while (0)
                AT_DMA(2, jt0, 0); if (nt_ > 1) AT_DMA(2, jt0 + 1, 1); __syncthreads();
#define WIN_LOOP(TILE) for (int j0 = 0; j0 < nt_; j0 += 2) { const int sb = (j0 & 2); \
                    if (j0 + 2 < nt_) AT_DMA(2, jt0 + j0 + 2, sb ^ 2); \
                    if (j0 + 3 < nt_) AT_DMA(2, jt0 + j0 + 3, (sb ^ 2) + 1); \
                    TILE(j0, sb); if (j0 + 1 < nt_) TILE(j0 + 1, sb + 1); \
                    __syncthreads(); }
                if (nomax_win) { WIN_LOOP(WIN_TILE_NM) } else { WIN_LOOP(WIN_TILE) }
#undef WIN_LOOP
#undef WIN_TILE_NM
#undef WIN_PRE
#undef WIN_TILE
                TROW_PIN();
#pragma unroll
                for (int rb = 0; rb < 2; ++rb) { const float l = __shfl(sw[rb].ol[0], fr); const float sc2 = (l > 0.f) ? GATE(rb, 2) / l : 0.f;
                    bf16_t* op = O + TOKROW(rb) * 1024 + head * 64 + 4 * g4;
                    unsigned char* o8 = (unsigned char*)(a.ws + WS_O8) + TOKROW(rb) * 1024 + head * 64 + 4 * g4;
#pragma unroll
                    for (int dt = 0; dt < 4; ++dt) { const u32x2 pv = *(const u32x2*)(op + 16 * dt); f32x4 v = sw[rb].o[dt] * sc2;
                        v[0] += __uint_as_float(pv.x << 16); v[1] += __uint_as_float(pv.x & 0xffff0000u); v[2] += __uint_as_float(pv.y << 16); v[3] += __uint_as_float(pv.y & 0xffff0000u);
                        *(unsigned*)(o8 + 16 * dt) = pk4_fp8(clamp8(v[0] * X8_SCALE), clamp8(v[1] * X8_SCALE), clamp8(v[2] * X8_SCALE), clamp8(v[3] * X8_SCALE)); } }
            }
#undef AT_DMA
#undef ATK
#undef ATV
#undef TROW_PIN
#undef TOKROW
#undef GATE
            {
                const int npr = half ? pr + (int)gridDim.x : pr, nhalf = half ^ 1;
                cmp_pref = npr < 1024;
                if (cmp_pref) { const int nbg = npr >> 6, npp = attn_pair_of(npr), ncc = nhalf ? (127 - npp) : npp;
                    const int nnct = (((ncc * 64 + 63 - 31) / 16 + 1) + 63) >> 6;
                    const bf16_t* nk = KC + (size_t)nbg * 512 * 64;
                    __builtin_amdgcn_global_load_lds((const unsigned*)(nk + ksrc), (LAS unsigned*)(lds + AT4_KB + wave * 1024), 16, 0, 0);
                    __builtin_amdgcn_global_load_lds((const unsigned*)(nk + (size_t)8192 * 64 + vsrc), (LAS unsigned*)(lds + AT4_VB + wave * 1024), 16, 0, 0);
                    if (nnct > 1) {
                        __builtin_amdgcn_global_load_lds((const unsigned*)(nk + 4096 + ksrc), (LAS unsigned*)(lds + AT4_KB + 8192 + wave * 1024), 16, 0, 0);
                        __builtin_amdgcn_global_load_lds((const unsigned*)(nk + (size_t)8192 * 64 + 4096 + vsrc), (LAS unsigned*)(lds + AT4_VB + 8192 + wave * 1024), 16, 0, 0); } } }
            if ((seam >> 1) == (int)(blockIdx.x & 3u)) cvt1_run(a, cvt_next, cvt_stride, 6, cvt_scr, lane);
            ++seam;
        }
    }
    cvt1_run(a, cvt_next, cvt_stride, 1 << 20, cvt_scr, lane);
}

__device__ __forceinline__ void unpack8(const u32x4 w, float (&f)[8]) {
    f[0] = __uint_as_float(w.x << 16); f[1] = __uint_as_float(w.x & 0xffff0000u); f[2] = __uint_as_float(w.y << 16); f[3] = __uint_as_float(w.y & 0xffff0000u);
    f[4] = __uint_as_float(w.z << 16); f[5] = __uint_as_float(w.z & 0xffff0000u); f[6] = __uint_as_float(w.w << 16); f[7] = __uint_as_float(w.w & 0xffff0000u);
}
__device__ __forceinline__ void ph_convpool_fast(const Args& a, LAS unsigned char* lds) {
    const bf16_t* H0 = (const bf16_t*)(a.ws + WS_H0);
    bf16_t* CAT = (bf16_t*)(a.ws + WS_CAT);
    const float* cw = a.in[4]; const float* cb = a.in[5]; const float* lg = a.in[6]; const float* lb = a.in[7];
    const int tid = threadIdx.x, lane = tid & 63, wave = tid >> 6, ch = lane * 8;
    constexpr int VT_OFF = 0, UT_OFF = 62 * 1024, CW_OFF = UT_OFF + 47 * 1024;
    for (int i = tid; i < 31 * 64; i += 512) { const int k = i >> 6, c8 = (i & 63) * 8;
        const f32x4 w0 = *(const f32x4*)(cw + k * 512 + c8), w1 = *(const f32x4*)(cw + k * 512 + c8 + 4);
        u32x4 o; o.x = pk2(w0[0], w0[1]); o.y = pk2(w0[2], w0[3]); o.z = pk2(w1[0], w1[1]); o.w = pk2(w1[2], w1[3]);
        *(LAS u32x4*)(lds + CW_OFF + k * 1024 + c8 * 2) = o; }
    float bias[8], gam[8], bet[8];
#pragma unroll
    for (int j = 0; j < 8; ++j) { bias[j] = cb[ch + j]; gam[j] = lg[ch + j]; bet[j] = lb[ch + j]; }
    for (int tile = blockIdx.x; tile < M / 32; tile += gridDim.x) {
        const int tok0 = tile * 32, t0 = tok0 & (T - 1);
        __syncthreads();
        for (int i = tid; i < 62 * 64; i += 512) { const int r = i >> 6, c8 = (i & 63) * 8; const int tt = t0 - 30 + r;
            u32x4 v = (u32x4){0u, 0u, 0u, 0u}; if (tt >= 0) v = *(const u32x4*)(H0 + (size_t)(tok0 - 30 + r) * 1024 + 512 + c8);
            *(LAS u32x4*)(lds + VT_OFF + r * 1024 + c8 * 2) = v; }
        for (int i = tid; i < 47 * 64; i += 512) { const int r = i >> 6, c8 = (i & 63) * 8; const int tt = t0 - 15 + r;
            u32x4 v = (u32x4){0u, 0u, 0u, 0u}; if (tt >= 0) v = *(const u32x4*)(H0 + (size_t)(tok0 - 15 + r) * 1024 + c8);
            *(LAS u32x4*)(lds + UT_OFF + r * 1024 + c8 * 2) = v; }
        __syncthreads();
        float acc[4][8];
#pragma unroll
        for (int j = 0; j < 4; ++j)
#pragma unroll
            for (int c = 0; c < 8; ++c) acc[j][c] = bias[c];
        float wq[4][8];
#pragma unroll
        for (int q = 0; q < 4; ++q)
#pragma unroll
            for (int c = 0; c < 8; ++c) wq[q][c] = 0.f;
#pragma unroll 1
        for (int r0 = 0; r0 < 36; r0 += 4) {
#pragma unroll
            for (int u = 0; u < 4; ++u) { const int r = r0 + u;
                if (r < 31) unpack8(*(const LAS u32x4*)(lds + CW_OFF + r * 1024 + ch * 2), wq[u]);
                else {
#pragma unroll
                    for (int c = 0; c < 8; ++c) wq[u][c] = 0.f; }
                float v[8]; unpack8(*(const LAS u32x4*)(lds + VT_OFF + (4 * wave + (r < 33 ? r : 33)) * 1024 + ch * 2), v);
#pragma unroll
                for (int j = 0; j < 4; ++j)
#pragma unroll
                    for (int c = 0; c < 8; ++c) acc[j][c] += wq[(u - j) & 3][c] * v[c];
            }
        }
        const int wnd = 2 << (lane >> 4);
#pragma unroll
        for (int j = 0; j < 4; ++j) {
            const int tl = 4 * wave + j, t = t0 + tl; const size_t tok = (size_t)tok0 + tl;
            const int cnt = (t + 1 < wnd) ? (t + 1) : wnd;
            float s[8], self[8];
            unpack8(*(const LAS u32x4*)(lds + UT_OFF + (15 + tl) * 1024 + ch * 2), self);
#pragma unroll
            for (int c = 0; c < 8; ++c) s[c] = self[c];
            for (int k = 1; k < cnt; ++k) { float v[8]; unpack8(*(const LAS u32x4*)(lds + UT_OFF + (15 + tl - k) * 1024 + ch * 2), v);
#pragma unroll
                for (int c = 0; c < 8; ++c) s[c] += v[c]; }
            const float inv = 1.0f / (float)cnt;
            u32x4 o; o.x = pk2(s[0] * inv - self[0], s[1] * inv - self[1]); o.y = pk2(s[2] * inv - self[2], s[3] * inv - self[3]);
            o.z = pk2(s[4] * inv - self[4], s[5] * inv - self[5]); o.w = pk2(s[6] * inv - self[6], s[7] * inv - self[7]);
            *(u32x4*)(CAT + tok * 1024 + ch) = o;
            float sm = 0.f;
#pragma unroll
            for (int c = 0; c < 8; ++c) sm += acc[j][c];
            const float mean = wave_sum(sm) * (1.0f / 512.0f);
            float sq = 0.f;
#pragma unroll
            for (int c = 0; c < 8; ++c) { acc[j][c] -= mean; sq += acc[j][c] * acc[j][c]; }
            const float rstd = rsqrtf(wave_sum(sq) * (1.0f / 512.0f) + LN_EPS);
            float y[8];
#pragma unroll
            for (int c = 0; c < 8; ++c) { const float z = acc[j][c] * rstd * gam[c] + bet[c]; y[c] = z * sigmoidf_(z); }
            u32x4 o2; o2.x = pk2(y[0], y[1]); o2.y = pk2(y[2], y[3]); o2.z = pk2(y[4], y[5]); o2.w = pk2(y[6], y[7]);
            *(u32x4*)(CAT + tok * 1024 + 512 + ch) = o2;
        }
    }
}


#define RT_DPPI(x, ctrl) __builtin_amdgcn_update_dpp((int)(x), (int)(x), (ctrl), 0xF, 0xF, true)
#define RT_DPPF(x, ctrl) __builtin_bit_cast(float, __builtin_amdgcn_update_dpp(__builtin_bit_cast(int, (float)(x)), __builtin_bit_cast(int, (float)(x)), (ctrl), 0xF, 0xF, true))
#define RT_LANEI(x, l) __builtin_amdgcn_readlane((int)(x), (l))
#define RT_LANEF(x, l) __builtin_bit_cast(float, __builtin_amdgcn_readlane(__builtin_bit_cast(int, (float)(x)), (l)))
__device__ __forceinline__ int RT_KEY(float x) { const int b = __builtin_bit_cast(int, x); return b ^ ((b >> 31) & 0x7fffffff); }
__device__ __forceinline__ void ph_route_fast(const float* LOG, const float* LOG1, const float* bias, unsigned* gcnt, int2* list, unsigned char* ldsg) {
    unsigned* hist = (unsigned*)ldsg; unsigned* base = hist + 256; u32x2* sel = (u32x2*)(ldsg + 2048);
    const int tid = threadIdx.x, lane = tid & 63, wave = tid >> 6;
    const float NEG = -INFINITY;
    const float4 bb = *(const float4*)(bias + lane * 4);
    for (int chunk = blockIdx.x; chunk < M / 128; chunk += gridDim.x) {
        __syncthreads();
        if (tid < 256) hist[tid] = 0u;
        __syncthreads();
        float4 lgn = *(const float4*)(LOG + (size_t)(chunk * 128 + wave * 16) * 256 + lane * 4), lgm = *(const float4*)(LOG1 + (size_t)(chunk * 128 + wave * 16) * 256 + lane * 4);
        for (int i = 0; i < 16; ++i) {
            const int tl = wave * 16 + i, tok = chunk * 128 + tl;
            const float4 lg = make_float4(lgn.x + lgm.x, lgn.y + lgm.y, lgn.z + lgm.z, lgn.w + lgm.w);
            if (i + 1 < 16) { lgn = *(const float4*)(LOG + (size_t)(tok + 1) * 256 + lane * 4); lgm = *(const float4*)(LOG1 + (size_t)(tok + 1) * 256 + lane * 4); }
            const float s0 = sigmoidf_(lg.x), s1 = sigmoidf_(lg.y), s2 = sigmoidf_(lg.z), s3 = sigmoidf_(lg.w);
            const float v0 = s0 + bb.x + 0.0f, v1 = s1 + bb.y + 0.0f, v2 = s2 + bb.z + 0.0f, v3 = s3 + bb.w + 0.0f;
            float m1 = fmaxf(v0, v1), m2 = fminf(v0, v1);
            { const float hi = fmaxf(v2, v3), lo = fminf(v2, v3); const float n1 = fmaxf(m1, hi); const float n2 = fmaxf(fminf(m1, hi), fmaxf(m2, lo)); m1 = n1; m2 = n2; }
#define RT_STEP(ctrl) { const float a1 = RT_DPPF(m1, ctrl), a2 = RT_DPPF(m2, ctrl); const float n1 = fmaxf(m1, a1), n2 = fmaxf(fminf(m1, a1), fmaxf(m2, a2)); m1 = n1; m2 = n2; }
            RT_STEP(0xB1) RT_STEP(0x4E) RT_STEP(0x141)
#undef RT_STEP
            const float gs = m1 + m2; const int mygrp = lane >> 3;
            int rank = 0;
#pragma unroll
            for (int g2 = 0; g2 < 8; ++g2) { const float og = RT_LANEF(gs, g2 * 8); rank += (og > gs || (og == gs && g2 < mygrp)) ? 1 : 0; }
            const bool dead = rank >= 4;
            constexpr int KMIN = (int)0x80000000;
            int k0 = dead ? KMIN : RT_KEY(v0), k1 = dead ? KMIN : RT_KEY(v1), k2 = dead ? KMIN : RT_KEY(v2), k3 = dead ? KMIN : RT_KEY(v3);
            int my_e = 0; float my_s = 0.f;
#pragma unroll
            for (int it = 0; it < 8; ++it) {
                int lm = max(max(k0, k1), max(k2, k3));
                lm = max(lm, RT_DPPI(lm, 0xB1)); lm = max(lm, RT_DPPI(lm, 0x4E)); lm = max(lm, RT_DPPI(lm, 0x141)); lm = max(lm, RT_DPPI(lm, 0x140));
                const int gmax = max(max(RT_LANEI(lm, 0), RT_LANEI(lm, 16)), max(RT_LANEI(lm, 32), RT_LANEI(lm, 48)));
                int cand = (k0 == gmax) ? lane * 4 : (k1 == gmax) ? lane * 4 + 1 : (k2 == gmax) ? lane * 4 + 2 : (k3 == gmax) ? lane * 4 + 3 : 0x7fffffff;
                cand = min(cand, RT_DPPI(cand, 0xB1)); cand = min(cand, RT_DPPI(cand, 0x4E)); cand = min(cand, RT_DPPI(cand, 0x141)); cand = min(cand, RT_DPPI(cand, 0x140));
                const int bi = min(min(RT_LANEI(cand, 0), RT_LANEI(cand, 16)), min(RT_LANEI(cand, 32), RT_LANEI(cand, 48)));
                const int jj = bi & 3, ol = bi >> 2;
                const float mys = (jj == 0) ? s0 : (jj == 1) ? s1 : (jj == 2) ? s2 : s3;
                const float wsc = RT_LANEF(mys, ol);
                const bool me = (lane == ol);
                k0 = (me && jj == 0) ? KMIN : k0; k1 = (me && jj == 1) ? KMIN : k1; k2 = (me && jj == 2) ? KMIN : k2; k3 = (me && jj == 3) ? KMIN : k3;
                if (lane == it) { my_e = bi; my_s = wsc; }
            }
            const float ssum = wave_sum(lane < 8 ? my_s : 0.f);
            if (lane < 8) { const unsigned rk = atomicAdd(&hist[my_e], 1u); u32x2 en; en.x = (unsigned)my_e | (rk << 16); en.y = __float_as_uint(my_s / ssum * 2.5f); sel[tl * 8 + lane] = en; }
        }
        __syncthreads();
        if (tid < 256) { const unsigned h = hist[tid]; base[tid] = h ? atomicAdd(&gcnt[tid], h) : 0u; }
        __syncthreads();
#pragma unroll
        for (int rep = 0; rep < 2; ++rep) { const int idx = tid + rep * 512, tok = chunk * 128 + (idx >> 3), k = idx & 7;
            const u32x2 en = sel[idx]; const unsigned e = en.x & 0xffffu, pos = base[e] + (en.x >> 16);
            list[(size_t)e * LISTCAP + pos] = make_int2(tok * 10 + k, (int)en.y); }
    }
}

__global__ void __launch_bounds__(512, 2) fwd_kernel(Args a) {
    extern __shared__ __attribute__((aligned(16))) unsigned char lds[];
    volatile LAS unsigned* MISC = (volatile LAS unsigned*)((LAS unsigned char*)lds + (LDS_BYTES - 64));
    if (threadIdx.x < 16) MISC[threadIdx.x] = 0u;
    __syncthreads();
    unsigned* ctl = (unsigned*)(a.ws + WS_CTL);
#if MK_ONE_LAUNCH
    (void)xcd_barrier_post(ctl + CW_BAR, MISC + 8);
#define SEAM() do { XcdBarrier b_; b_.bar = (unsigned*)(a.ws + WS_CTL) + CW_BAR; b_.x = xb_xcc_id(); b_.st = MISC + 8; xcd_barrier(b_); } while (0)
#else
#define SEAM() do {} while (0)
#endif
    const int lo = a.ph_lo, hi = a.ph_hi;
#define IN(k) (lo <= (k) && (k) < hi)
#define BOTH(k) (IN(k) && (k) + 1 < hi)
#define X1 ((bf16_t*)(a.ws + WS_X1))
#define X2 ((bf16_t*)(a.ws + WS_X2))
#define LOG ((float*)(a.ws + WS_LOG))

    LAS unsigned char* L = (LAS unsigned char*)lds;
#define LIST ((int2*)(a.ws + WS_LIST))
#ifndef PROBE_DUP_MASK
#define PROBE_DUP_MASK 0u
#endif
#define RUN(k, ...) if (IN(k)) { { __VA_ARGS__ } if ((PROBE_DUP_MASK >> (k)) & 1u) { __syncthreads(); { __VA_ARGS__ } } if (BOTH(k)) SEAM(); }
    RUN(0, ph_prologue(a, L);)
    RUN(1, pg8::DenseSched S; S.init((const bf16_t*)(a.ws + WS_XA), D, (const bf16_t*)(a.ws + WS_WIN0), D, M, 1536);
           EpiInproj0 E{(bf16_t*)(a.ws + WS_H0)};
           pg8::gemm_phase<EpiInproj0, pg8::DenseSched, true>(L, D, 128u, S, E);)
    RUN(2, ph_convpool_fast(a, L);)
    RUN(4, pg8::DenseSched S; S.init((const bf16_t*)(a.ws + WS_CAT), D, (const bf16_t*)(a.ws + WS_WOUT0), D, M, D);
           EpiRes E{a.in[0], nullptr, (bf16_t*)(a.ws + WS_Y), 1.0f};
           pg8::gemm_phase<EpiRes, pg8::DenseSched, true>(L, D, 128u, S, E);)
    RUN(5, ph_ln((const bf16_t*)(a.ws + WS_Y), a.in[17], a.in[18], X1, (unsigned char*)(a.ws + WS_X8));)
#define MOE_LAYER(P, LAYER, XIN, XOUT, OUTF) \
    RUN(P, RouterSched S{(const char*)(XIN), (const char*)((const bf16_t*)(a.ws + WS_WR) + (size_t)(LAYER) * NE * D), (int)gridDim.x, (int)blockIdx.x}; \
           EpiLogits E{LOG, (float*)(a.ws + WS_HID)}; pg8::gemm_phase<EpiLogits, RouterSched, true>(L, D / 2, 128u, S, E, D);) \
    if (IN(P + 1)) { ph_route_fast(LOG, (const float*)(a.ws + WS_HID), a.in[22] + (LAYER) * NE, ctl + CW_CNT + (LAYER) * 256, LIST, lds); if (BOTH(P + 1)) SEAM(); } \
    RUN(P + 2, const int R = moe_setup256(ctl + CW_CNT + (LAYER) * 256, L); \
            MoeGuSched S{(const char*)(a.ws + WS_X8), (const char*)(a.ws + WS_WGU) + (size_t)(LAYER) * 257 * 512 * 1024, LIST, L, R, (R + 128) * 2, (int)gridDim.x, (int)blockIdx.x}; \
            S.prepare(); EpiGateUp E{(unsigned char*)(a.ws + WS_HID)}; pg8::gemm_phase<EpiGateUp, MoeGuSched, true, true>(L, D / 2, 128u, S, E);) \
    RUN(P + 3, const int R = moe_setup256(ctl + CW_CNT + (LAYER) * 256, L); \
            MoeDownSched S{(const char*)(a.ws + WS_HID), (const char*)(a.ws + WS_WD) + (size_t)(LAYER) * 257 * 1024 * 256, LIST, L, R, R + 128, (int)gridDim.x, (int)blockIdx.x}; \
            S.prepare(); EpiDown E{(unsigned char*)(a.ws + WS_YB), L}; pg8::gemm_phase<EpiDown, MoeDownSched, true, true>(L, FF / 2, 128u, S, E);) \
    RUN(P + 4, ph_combine(a, XIN, a.in[19] + (LAYER) * D, a.in[20] + (LAYER) * D, XOUT, OUTF);)
    MOE_LAYER(6, 0, X1, X2, nullptr)
    RUN(11, pg8::DenseSched S; S.init((const bf16_t*)(a.ws + WS_X2_8), D / 2, (const bf16_t*)(a.ws + WS_WINN), D / 2, M, HNW - 256);
            EpiInprojN E{(bf16_t*)(a.ws + WS_HN), (bf16_t*)(a.ws + WS_QR), (bf16_t*)(a.ws + WS_KV6), (float*)(a.ws + WS_GATES), (const float*)(a.ws + WS_MISC) + 1024};
            pg8::gemm_phase<EpiInprojN, pg8::DenseSched, true, true>(L, D / 2, 128u, S, E);)
    RUN(13, const bool split13 = gridDim.x > 64u;
            if (!split13 || blockIdx.x < 64u) {
                Cmp1Sched S{(const char*)(a.ws + WS_KV6), (const char*)(a.ws + WS_CW1), (int)gridDim.x, (int)blockIdx.x};
                EpiCmp1 E{(bf16_t*)(a.ws + WS_CH1), (const float*)(a.ws + WS_MISC)};
                pg8::gemm_phase<EpiCmp1, Cmp1Sched, true, true>(L, 1024, 128u, S, E); }
            if (!split13 || blockIdx.x >= 64u) {
                __syncthreads();
                pg8::DenseSched S; S.init((const bf16_t*)(a.ws + WS_X2_8), D / 2, (const bf16_t*)(a.ws + WS_WINN), D / 2, M, 256); S.pn0 = 10;
                if (split13) { S.G = (int)gridDim.x - 64; S.c = (int)blockIdx.x - 64; }
                EpiInprojN E{(bf16_t*)(a.ws + WS_HN), (bf16_t*)(a.ws + WS_QR), (bf16_t*)(a.ws + WS_KV6), (float*)(a.ws + WS_GATES), (const float*)(a.ws + WS_MISC) + 1024};
                pg8::gemm_phase<EpiInprojN, pg8::DenseSched, true, true>(L, D / 2, 128u, S, E); }
            ph_knorm(a);)
    RUN(14, ph_cmp2(a, lds);)
    RUN(15, ph_attn_fast2(a, L);)
    RUN(16, pg8::DenseSched S; S.init((const bf16_t*)(a.ws + WS_O8), D / 2, (const bf16_t*)(a.ws + WS_WOUTN), D / 2, M, D);
            EpiRes E{nullptr, X2, (bf16_t*)(a.ws + WS_Y2), 1.0f / (X8_SCALE * W8_SCALE)};
            pg8::gemm_phase<EpiRes, pg8::DenseSched, true, true>(L, D / 2, 128u, S, E);)
    RUN(17, ph_ln((const bf16_t*)(a.ws + WS_Y2), a.in[17] + D, a.in[18] + D, X1, (unsigned char*)(a.ws + WS_X8));)
    MOE_LAYER(18, 1, X1, (bf16_t*)nullptr, a.out)
}

extern "C" void kernel_launch(void* const* d_in, const int* in_sizes, int n_in, void* d_out, int out_size, void* d_ws, size_t ws_size, hipStream_t stream) {
    static int grid = 0;
    if (grid == 0) {
        if (n_in != 29 || out_size != M * D || ws_size < WS_END) { fprintf(stderr, "kernel_launch: unexpected problem (n_in %d out %d ws %zu)\n", n_in, out_size, ws_size); grid = -1; return; }
        int dev = 0, cus = 0;
        if (hipGetDevice(&dev) != hipSuccess || hipDeviceGetAttribute(&cus, hipDeviceAttributeMultiprocessorCount, dev) != hipSuccess) { grid = -1; return; }
        if (hipFuncSetAttribute((const void*)fwd_kernel, hipFuncAttributeMaxDynamicSharedMemorySize, LDS_BYTES) != hipSuccess) { grid = -1; return; }
        int per_cu = 0;
        (void)hipOccupancyMaxActiveBlocksPerMultiprocessor(&per_cu, (const void*)fwd_kernel, 512, LDS_BYTES);
        (void)hipGetLastError();
        grid = cus;
    }
    if (grid < 0) return;
    (void)hipMemsetAsync((char*)d_ws + WS_CTL, 0, CTL_BYTES, stream);
    Args a{};
    for (int i = 0; i < 29; ++i) a.in[i] = (const float*)d_in[i];
    a.out = (float*)d_out; a.ws = (unsigned char*)d_ws;
    for (int i = 0; i < 8; ++i) a.inv_freq[i] = powf(500000.0f, -(float)(2 * i) / 16.0f);
#if MK_ONE_LAUNCH
    a.ph_lo = 0; a.ph_hi = NPHASE;
    hipLaunchKernelGGL(fwd_kernel, dim3(grid), dim3(512), LDS_BYTES, stream, a);
#else
    for (int p = 0; p < NPHASE; ++p) { a.ph_lo = p; a.ph_hi = p + 1; hipLaunchKernelGGL(fwd_kernel, dim3(grid), dim3(512), LDS_BYTES, stream, a); }
#endif
}
```
